# Optimizing an MI355X kernel written in HIP

```python
import math
import jax
import jax.numpy as jnp
from jax import lax
import numpy as np

D_MODEL = 1024
BATCH = 4
SEQ = 4096
DEPTH = 2

GRID_W = 64
CTX_LEN = 256
N_BRANCH = 4
MIX_W = D_MODEL // 2
GDN_HEAD_DIM = 128
GDN_HEADS = MIX_W // GDN_HEAD_DIM
HGRN_HEAD_DIM = 128
HGRN_HEADS = MIX_W // HGRN_HEAD_DIM
LRU_BLOCKS = 8
LRU_BLOCK_W = MIX_W // LRU_BLOCKS
LRU_C = 8.0
RET_HEAD_DIM = 128
RET_HEADS = MIX_W // RET_HEAD_DIM
CONV_W = 4
CHUNK = 64
ROPE_BASE = 10000.0
N_EXPERTS = 32
TOP_K = 4
EXPERT_FF = D_MODEL
SWIGLU_ALPHA = 1.702
SWIGLU_LIMIT = 7.0
EXPERT_BLOCK = 128
N_MOD = 6
EPS = 1e-6
LB_MIN = 1e-30
LB_MAX = 1.0 - 1e-4
SQRT_MIN = 1e-12
IN_SIZES = (3 * MIX_W, MIX_W, 2 * GDN_HEADS, 2 * GDN_HEADS,
            MIX_W, MIX_W, 2 * MIX_W, MIX_W,
            MIX_W, MIX_W,
            3 * MIX_W, MIX_W,
            N_BRANCH * D_MODEL)
N_IN = sum(IN_SIZES)

kernel_name = "hybrid_flow_backbone_gdn_hgrn2_rglru_retention_moe"


def rms_norm(x, g):
    x32 = x.astype(jnp.float32)
    y = x32 * lax.rsqrt(jnp.mean(x32 * x32, axis=-1, keepdims=True) + EPS)
    return (y * g.astype(jnp.float32)).astype(x.dtype)


def l2_normalize(x):
    return x * lax.rsqrt(jnp.sum(x * x, axis=-1, keepdims=True) + EPS)


def depthwise_conv(x, w):
    left = CONV_W // 2
    return lax.conv_general_dilated(
        x, w[:, None, :].astype(x.dtype), window_strides=(1,),
        padding=[(left, CONV_W - 1 - left)],
        dimension_numbers=("NWC", "WIO", "NWC"),
        feature_group_count=x.shape[-1])


def to_heads(a, n_heads):
    b, t, _ = a.shape
    return a.reshape(b, t, n_heads, -1).transpose(0, 2, 1, 3)


def from_heads(a):
    b, h, t, d = a.shape
    return a.transpose(0, 2, 1, 3).reshape(b, t, h * d)


def to_chunks(a):
    b, h, t = a.shape[:3]
    a = a.reshape((b, h, t // CHUNK, CHUNK) + a.shape[3:])
    return jnp.moveaxis(a, 2, 0)


def from_chunks(a):
    a = jnp.moveaxis(a, 0, 2)
    return a.reshape(a.shape[:2] + (a.shape[2] * a.shape[3],) + a.shape[4:])


def masked_decay(diff, mask):
    return jnp.where(mask, jnp.exp(jnp.where(mask, diff, 0.0)), 0.0)


def gdn_scan(inputs, s0):
    causal = jnp.tril(jnp.ones((CHUNK, CHUNK), dtype=bool))
    strict = jnp.tril(jnp.ones((CHUNK, CHUNK), dtype=bool), k=-1)

    def step(s, blk):
        qb, kb, vb, gb, betab = blk
        dv = vb.shape[-1]
        bcum = jnp.cumsum(gb, axis=-1)
        decay = masked_decay(bcum[..., :, None] - bcum[..., None, :], causal)
        kbeta = kb * betab[..., None]
        m = jnp.where(strict, jnp.einsum("bhtd,bhsd->bhts", kbeta, kb) * decay, 0.0)
        rhs = jnp.concatenate([vb * betab[..., None], kbeta * jnp.exp(bcum)[..., None]], axis=-1)
        sol = lax.linalg.triangular_solve(m, rhs, left_side=True, lower=True, unit_diagonal=True)
        u, w = sol[..., :dv], sol[..., dv:]
        v_new = u - jnp.einsum("bhtd,bhde->bhte", w, s)
        attn = jnp.einsum("bhtd,bhsd->bhts", qb, kb) * decay
        o = (jnp.einsum("bhtd,bhde->bhte", qb * jnp.exp(bcum)[..., None], s)
             + jnp.einsum("bhts,bhse->bhte", attn, v_new))
        blast = bcum[..., -1:]
        s = s * jnp.exp(blast)[..., None] + jnp.einsum(
            "bhsd,bhse->bhde", kb * jnp.exp(blast - bcum)[..., None], v_new)
        return s, o

    s_fin, o = lax.scan(step, s0, tuple(to_chunks(a) for a in inputs))
    return from_chunks(o), s_fin


def gla_scan(inputs, s0):
    causal = jnp.tril(jnp.ones((CHUNK, CHUNK), dtype=bool))[:, :, None]

    def step(s, blk):
        qb, kb, vb, fb = blk
        bcum = jnp.cumsum(fb, axis=2)
        decay = masked_decay(bcum[:, :, :, None, :] - bcum[:, :, None, :, :], causal)
        scores = jnp.einsum("bhtd,bhtsd,bhsd->bhts", qb, decay, kb)
        o = (jnp.einsum("bhts,bhse->bhte", scores, vb)
             + jnp.einsum("bhtd,bhde->bhte", qb * jnp.exp(bcum), s))
        blast = bcum[:, :, -1:, :]
        s = s * jnp.exp(blast[:, :, 0, :, None]) + jnp.einsum(
            "bhsd,bhse->bhde", kb * jnp.exp(blast - bcum), vb)
        return s, o

    s_fin, o = lax.scan(step, s0, tuple(to_chunks(a) for a in inputs))
    return from_chunks(o), s_fin


def retention_scan(inputs, s0):
    causal = jnp.tril(jnp.ones((CHUNK, CHUNK), dtype=bool))

    def step(s, blk):
        qb, kb, vb, gb = blk
        bcum = jnp.cumsum(gb, axis=-1)
        decay = masked_decay(bcum[..., :, None] - bcum[..., None, :], causal)
        scores = jnp.einsum("bhtd,bhsd->bhts", qb, kb) * decay
        o = (jnp.einsum("bhts,bhse->bhte", scores, vb)
             + jnp.einsum("bhtd,bhde->bhte", qb * jnp.exp(bcum)[..., None], s))
        blast = bcum[..., -1:]
        s = s * jnp.exp(blast)[..., None] + jnp.einsum(
            "bhsd,bhse->bhde", kb * jnp.exp(blast - bcum)[..., None], vb)
        return s, o

    s_fin, o = lax.scan(step, s0, tuple(to_chunks(a) for a in inputs))
    return from_chunks(o), s_fin


def lru_scan(inputs, h0):
    a, u = inputs
    u = u.at[:, 0].add(a[:, 0] * h0)
    _, h = lax.associative_scan(lambda l, r: (l[0] * r[0], r[0] * l[1] + r[1]), (a, u), axis=1)
    return h, h[:, -1]


def two_stream_bidir(scan_fn, ctx_dirs, lat_dirs, s0, axis):
    rev = lambda a: jnp.flip(a, axis=axis)
    o_cf, s_f = scan_fn(ctx_dirs[0], s0)
    o_cb, s_b = scan_fn(tuple(rev(a) for a in ctx_dirs[1]), s0)
    o_lf, _ = scan_fn(lat_dirs[0], s_f)
    o_lb, _ = scan_fn(tuple(rev(a) for a in lat_dirs[1]), s_b)
    return o_cf + rev(o_cb), o_lf + rev(o_lb)


def axial_rope_tables(n_rows):
    row = jnp.repeat(jnp.arange(n_rows, dtype=jnp.float32), GRID_W)
    col = jnp.tile(jnp.arange(GRID_W, dtype=jnp.float32), n_rows)
    n_freq = RET_HEAD_DIM // 4
    inv_freq = ROPE_BASE ** (-jnp.arange(n_freq, dtype=jnp.float32) / n_freq)
    ang = jnp.concatenate([row[:, None] * inv_freq, col[:, None] * inv_freq], axis=-1)
    return jnp.cos(ang), jnp.sin(ang)


def apply_rope(x, cos, sin):
    half = x.shape[-1] // 2
    x1, x2 = x[..., :half], x[..., half:]
    return jnp.concatenate([x1 * cos - x2 * sin, x1 * sin + x2 * cos], axis=-1)


def prepare_stream(h, lp, lb, rope):
    f32 = jnp.float32
    b, t, _ = h.shape
    p = h @ lp["w_in"]
    cols, off = [], 0
    for size in IN_SIZES:
        cols.append(p[..., off:off + size])
        off += size
    (gdn_qkv, gdn_z, gdn_a, gdn_beta, hg_q, hg_i, hg_f, hg_g,
     lru_x, lru_y, ret_qkv, ret_g, merge) = cols

    qkv = jax.nn.silu(depthwise_conv(gdn_qkv, lp["gdn_conv_w"])).astype(f32)
    q, k, v = jnp.split(qkv, 3, axis=-1)
    q = l2_normalize(to_heads(q, GDN_HEADS)) * GDN_HEAD_DIM ** -0.5
    k = l2_normalize(to_heads(k, GDN_HEADS))
    v = to_heads(v, GDN_HEADS)
    a = gdn_a.astype(f32).reshape(b, t, 2, GDN_HEADS).transpose(2, 0, 3, 1)
    g = -jnp.exp(lp["gdn_a_log"].astype(f32))[:, None, :, None] * jax.nn.softplus(
        a + lp["gdn_dt_bias"].astype(f32)[:, None, :, None])
    beta = jax.nn.sigmoid(gdn_beta.astype(f32).reshape(b, t, 2, GDN_HEADS).transpose(2, 0, 3, 1))
    gdn = [(q, k, v, g[d], beta[d]) for d in range(2)]

    hq = to_heads(jax.nn.silu(hg_q.astype(f32)), HGRN_HEADS) * HGRN_HEAD_DIM ** -0.5
    hv = to_heads(hg_i.astype(f32), HGRN_HEADS)
    zf = hg_f.astype(f32).reshape(b, t, 2, MIX_W)
    log_lb = jnp.log(jnp.maximum(lb, LB_MIN))
    log_f = jnp.logaddexp(log_lb, jnp.log1p(-lb) + jax.nn.log_sigmoid(zf))
    key = (1.0 - lb) * jax.nn.sigmoid(-zf)
    hgrn = [(hq, to_heads(key[:, :, d], HGRN_HEADS), hv, to_heads(log_f[:, :, d], HGRN_HEADS))
            for d in range(2)]

    xb = (depthwise_conv(lru_x, lp["lru_conv_w"]) + lp["lru_conv_b"]).astype(f32)
    xr = xb.reshape(b, t, LRU_BLOCKS, LRU_BLOCK_W)
    gate_r = jax.nn.sigmoid(jnp.einsum("btni,dnij->dbtnj", xr, lp["lru_wa"].astype(f32)).reshape(2, b, t, MIX_W)
                            + lp["lru_ba"].astype(f32)[:, None, None, :])
    gate_i = jax.nn.sigmoid(jnp.einsum("btni,dnij->dbtnj", xr, lp["lru_wx"].astype(f32)).reshape(2, b, t, MIX_W)
                            + lp["lru_bx"].astype(f32)[:, None, None, :])
    log_a = LRU_C * gate_r * jax.nn.log_sigmoid(lp["lru_lambda"].astype(f32))[:, None, None, :]
    u = xb[None] * gate_i * jnp.sqrt(jnp.maximum(-jnp.expm1(2.0 * log_a), SQRT_MIN))
    lru = [(jnp.exp(log_a[d]), u[d]) for d in range(2)]

    rq, rk, rv = (to_heads(a_, RET_HEADS) for a_ in jnp.split(ret_qkv.astype(f32), 3, axis=-1))
    if rope is not None:
        rq = apply_rope(rq, rope[0], rope[1])
        rk = apply_rope(rk, rope[0], rope[1])
    rk = rk * RET_HEAD_DIM ** -0.5
    log_gamma = jnp.log1p(-jnp.exp2(-5.0 - jnp.arange(RET_HEADS, dtype=f32)))
    ret = (rq, rk, rv, jnp.broadcast_to(log_gamma[None, :, None], (b, RET_HEADS, t)))

    gates = {"gdn_z": gdn_z, "hgrn_g": hg_g, "lru_y": lru_y, "ret_g": ret_g, "merge": merge}
    return gdn, hgrn, lru, ret, gates


def merge_branches(o_gdn, o_hgrn, h_lru, o_ret, gates, lp, dtype):
    f32 = jnp.float32
    b, t, _ = h_lru.shape

    def gated_head_norm(o, z, g, n_heads):
        return from_heads(rms_norm(o, g) * jax.nn.silu(to_heads(z.astype(f32), n_heads)))

    y_gdn = gated_head_norm(o_gdn, gates["gdn_z"], lp["gdn_norm_g"], GDN_HEADS)
    y_hgrn = gated_head_norm(o_hgrn, gates["hgrn_g"], lp["hgrn_norm_g"], HGRN_HEADS)
    y_lru = h_lru * jax.nn.gelu(gates["lru_y"].astype(f32))
    y_ret = gated_head_norm(o_ret, gates["ret_g"], lp["ret_norm_g"], RET_HEADS)
    branches = jnp.stack([y_gdn, y_hgrn, y_lru, y_ret], axis=2).astype(dtype)
    up = jnp.einsum("btnw,nwd->btnd", branches, lp["w_branch"])
    gate = jax.nn.sigmoid(gates["merge"].reshape(b, t, N_BRANCH, D_MODEL))
    return jnp.sum(gate * up, axis=2) @ lp["w_out"]


def token_mixer(h_lat, h_ctx, lp, lb, rope, with_ctx_output):
    f32 = jnp.float32
    b = h_lat.shape[0]
    gdn_l, hgrn_l, lru_l, ret_l, gates_l = prepare_stream(h_lat, lp, lb, rope)
    gdn_c, hgrn_c, lru_c, ret_c, gates_c = prepare_stream(h_ctx, lp, lb, None)
    s_gdn = jnp.zeros((b, GDN_HEADS, GDN_HEAD_DIM, GDN_HEAD_DIM), f32)
    s_hgrn = jnp.zeros((b, HGRN_HEADS, HGRN_HEAD_DIM, HGRN_HEAD_DIM), f32)
    s_lru = jnp.zeros((b, MIX_W), f32)
    s_ret = jnp.zeros((b, RET_HEADS, RET_HEAD_DIM, RET_HEAD_DIM), f32)
    oc_gdn, ol_gdn = two_stream_bidir(gdn_scan, gdn_c, gdn_l, s_gdn, 2)
    oc_hgrn, ol_hgrn = two_stream_bidir(gla_scan, hgrn_c, hgrn_l, s_hgrn, 2)
    oc_lru, ol_lru = two_stream_bidir(lru_scan, lru_c, lru_l, s_lru, 1)
    oc_ret, ol_ret = two_stream_bidir(retention_scan, [ret_c, ret_c], [ret_l, ret_l], s_ret, 2)
    y_lat = merge_branches(ol_gdn, ol_hgrn, ol_lru, ol_ret, gates_l, lp, h_lat.dtype)
    if not with_ctx_output:
        return y_lat, None
    y_ctx = merge_branches(oc_gdn, oc_hgrn, oc_lru, oc_ret, gates_c, lp, h_ctx.dtype)
    return y_lat, y_ctx


def moe_ffn(h, router_w, router_b, w1, b1, w2, b2):
    m, d = h.shape
    logits = (h @ router_w + router_b).astype(jnp.float32)
    top_logit, top_idx = lax.top_k(logits, TOP_K)
    top_w = jax.nn.softmax(top_logit, axis=-1)
    n_assign = m * TOP_K
    flat_e = top_idx.reshape(-1).astype(jnp.int32)
    order = jnp.argsort(flat_e).astype(jnp.int32)
    sorted_e = flat_e[order]
    counts = jnp.zeros((N_EXPERTS,), jnp.int32).at[flat_e].add(1)
    padded = (counts + EXPERT_BLOCK - 1) // EXPERT_BLOCK * EXPERT_BLOCK
    pad_end = jnp.cumsum(padded)
    pad_start = pad_end - padded
    start = jnp.cumsum(counts) - counts
    dest_sorted = pad_start[sorted_e] + jnp.arange(n_assign, dtype=jnp.int32) - start[sorted_e]
    n_blocks = -(-n_assign // EXPERT_BLOCK) + N_EXPERTS
    cap = n_blocks * EXPERT_BLOCK
    src_tok = jnp.full((cap,), m, jnp.int32).at[dest_sorted].set(order // TOP_K)
    block_expert = jnp.minimum(
        jnp.searchsorted(pad_end, jnp.arange(n_blocks, dtype=jnp.int32) * EXPERT_BLOCK, side="right"),
        N_EXPERTS - 1).astype(jnp.int32)
    h_pad = jnp.concatenate([h, jnp.zeros((1, d), h.dtype)], axis=0)[src_tok].reshape(n_blocks, EXPERT_BLOCK, d)

    def expert_block(args):
        hb, e = args
        z = hb @ w1[e] + b1[e]
        glu = jnp.minimum(z[:, :EXPERT_FF], SWIGLU_LIMIT)
        lin = jnp.clip(z[:, EXPERT_FF:], -SWIGLU_LIMIT, SWIGLU_LIMIT)
        act = glu * jax.nn.sigmoid(SWIGLU_ALPHA * glu) * (lin + 1.0)
        return act @ w2[e] + b2[e]

    y_pad = lax.map(expert_block, (h_pad, block_expert)).reshape(cap, d)
    dest = jnp.zeros((n_assign,), jnp.int32).at[order].set(dest_sorted)
    y = y_pad[dest].reshape(m, TOP_K, d)
    return jnp.einsum("mkd,mk->md", y, top_w.astype(y.dtype))


def setup_inputs(seed: int = 0) -> dict:
    key = jax.random.key(seed)
    ks = iter(jax.random.split(key, 48))
    nrm = lambda shape, scale: scale * jax.random.normal(next(ks), shape, jnp.float32)
    L, D, W = DEPTH, D_MODEL, MIX_W
    a_init = jax.random.uniform(next(ks), (L, 2, GDN_HEADS), minval=1.0, maxval=16.0)
    dt = jnp.exp(jax.random.uniform(next(ks), (L, 2, GDN_HEADS),
                                    minval=math.log(1e-3), maxval=math.log(1e-1)))
    dt_bias = dt + jnp.log(-jnp.expm1(-dt))
    a8 = jax.random.uniform(next(ks), (L, 2, W), minval=0.9, maxval=0.999)
    root = a8 ** (1.0 / LRU_C)
    lru_lambda = jnp.log(root) - jnp.log1p(-root)
    return {
        "x": nrm((BATCH, SEQ, D), 1.0),
        "c": nrm((BATCH, D), 1.0),
        "ctx": nrm((BATCH, CTX_LEN, D), 1.0),
        "c_ctx": nrm((D,), 1.0),
        "w_mod": nrm((L, D, N_MOD * D), D ** -0.5),
        "b_mod": nrm((L, N_MOD * D), 0.02),
        "norm1_g": 1.0 + nrm((L, D), 0.02),
        "norm2_g": 1.0 + nrm((L, D), 0.02),
        "w_in": nrm((L, D, N_IN), D ** -0.5),
        "gdn_conv_w": nrm((L, CONV_W, 3 * W), CONV_W ** -0.5),
        "gdn_a_log": jnp.log(a_init),
        "gdn_dt_bias": dt_bias,
        "gdn_norm_g": 1.0 + nrm((L, GDN_HEAD_DIM), 0.02),
        "hgrn_lb": nrm((L, 2, W), 0.1),
        "hgrn_norm_g": 1.0 + nrm((L, HGRN_HEAD_DIM), 0.02),
        "lru_conv_w": nrm((L, CONV_W, W), CONV_W ** -0.5),
        "lru_conv_b": nrm((L, W), 0.02),
        "lru_wa": nrm((L, 2, LRU_BLOCKS, LRU_BLOCK_W, LRU_BLOCK_W), LRU_BLOCK_W ** -0.5),
        "lru_ba": nrm((L, 2, W), 0.02),
        "lru_wx": nrm((L, 2, LRU_BLOCKS, LRU_BLOCK_W, LRU_BLOCK_W), LRU_BLOCK_W ** -0.5),
        "lru_bx": nrm((L, 2, W), 0.02),
        "lru_lambda": lru_lambda,
        "ret_norm_g": 1.0 + nrm((L, RET_HEAD_DIM), 0.02),
        "w_branch": nrm((L, N_BRANCH, W, D), W ** -0.5),
        "w_out": nrm((L, D, D), D ** -0.5),
        "router_w": nrm((L, D, N_EXPERTS), D ** -0.5),
        "router_b": nrm((L, N_EXPERTS), 0.01),
        "moe_w1": nrm((L, N_EXPERTS, D, 2 * EXPERT_FF), D ** -0.5),
        "moe_b1": nrm((L, N_EXPERTS, 2 * EXPERT_FF), 0.02),
        "moe_w2": nrm((L, N_EXPERTS, EXPERT_FF, D), EXPERT_FF ** -0.5),
        "moe_b2": nrm((L, N_EXPERTS, D), 0.02),
        "final_norm_g": 1.0 + nrm((D,), 0.02),
    }


def reference(x, c, ctx, c_ctx, w_mod, b_mod, norm1_g, norm2_g, w_in, gdn_conv_w, gdn_a_log,
              gdn_dt_bias, gdn_norm_g, hgrn_lb, hgrn_norm_g, lru_conv_w, lru_conv_b, lru_wa, lru_ba,
              lru_wx, lru_bx, lru_lambda, ret_norm_g, w_branch, w_out, router_w, router_b,
              moe_w1, moe_b1, moe_w2, moe_b2, final_norm_g):
    b, n_lat, d = x.shape
    n_ctx = ctx.shape[1]
    ROWS = n_lat // GRID_W
    rope = axial_rope_tables(ROWS)
    lb_soft = jax.nn.softmax(hgrn_lb.astype(jnp.float32), axis=0)
    lower_bounds = jnp.clip(jnp.cumsum(lb_soft, axis=0) - lb_soft[0], 0.0, LB_MAX)
    xl, xc = x, ctx
    for l in range(DEPTH):
        last = l == DEPTH - 1
        lp = {"w_in": w_in[l], "gdn_conv_w": gdn_conv_w[l], "gdn_a_log": gdn_a_log[l],
              "gdn_dt_bias": gdn_dt_bias[l], "gdn_norm_g": gdn_norm_g[l], "hgrn_norm_g": hgrn_norm_g[l],
              "lru_conv_w": lru_conv_w[l], "lru_conv_b": lru_conv_b[l], "lru_wa": lru_wa[l],
              "lru_ba": lru_ba[l], "lru_wx": lru_wx[l], "lru_bx": lru_bx[l], "lru_lambda": lru_lambda[l],
              "ret_norm_g": ret_norm_g[l], "w_branch": w_branch[l], "w_out": w_out[l]}
        sh1, sc1, gt1, sh2, sc2, gt2 = [m_[:, None, :] for m_ in jnp.split(
            jax.nn.silu(c) @ w_mod[l] + b_mod[l], N_MOD, axis=-1)]
        csh1, csc1, cgt1, csh2, csc2, cgt2 = jnp.split(
            jax.nn.silu(c_ctx) @ w_mod[l] + b_mod[l], N_MOD, axis=-1)
        h_lat = rms_norm(xl, norm1_g[l]) * (1.0 + sc1) + sh1
        h_ctx = rms_norm(xc, norm1_g[l]) * (1.0 + csc1) + csh1
        y_lat, y_ctx = token_mixer(h_lat, h_ctx, lp, lower_bounds[l], rope, not last)
        xl = xl + gt1 * y_lat
        f_lat = (rms_norm(xl, norm2_g[l]) * (1.0 + sc2) + sh2).reshape(-1, d)
        moe_args = (router_w[l], router_b[l], moe_w1[l], moe_b1[l], moe_w2[l], moe_b2[l])
        if last:
            xl = xl + gt2 * moe_ffn(f_lat, *moe_args).reshape(b, n_lat, d)
        else:
            xc = xc + cgt1 * y_ctx
            f_ctx = (rms_norm(xc, norm2_g[l]) * (1.0 + csc2) + csh2).reshape(-1, d)
            out = moe_ffn(jnp.concatenate([f_lat, f_ctx], axis=0), *moe_args)
            xl = xl + gt2 * out[: b * n_lat].reshape(b, n_lat, d)
            xc = xc + cgt2 * out[b * n_lat:].reshape(b, n_ctx, d)
    return rms_norm(xl, final_norm_g)
```

```cpp
#include <hip/hip_runtime.h>
#include <stdint.h>
#include <stdio.h>

#define LAS __attribute__((address_space(3)))
typedef unsigned short bf16_t;
typedef short bf16x8 __attribute__((ext_vector_type(8)));
typedef float f32x4 __attribute__((ext_vector_type(4)));
typedef float f32x2 __attribute__((ext_vector_type(2)));
typedef unsigned u32x2 __attribute__((ext_vector_type(2)));
typedef unsigned u32x4 __attribute__((ext_vector_type(4)));

#ifndef MEGA
#define MEGA 0
#endif

constexpr int D = 1024, NB = 4, TL = 4096, TC = 256, NLAT = NB * TL, NCTX = NB * TC, NTOK = NLAT + NCTX;
constexpr int NIN = 11792, NP = 12032, MW = 512, NE = 32, TOPK = 4, NMOD = 6;
constexpr int C_GQKV = 0, C_GZ = 1536, C_GA = 2048, C_GB = 2056, C_HQ = 2064, C_HI = 2576, C_HF = 3088, C_HG = 4112, C_LX = 4624,
              C_LY = 5136, C_RQKV = 5648, C_RG = 7184, C_MG = 7696;
constexpr int NTHREADS = 512, NWAVES = 8;
constexpr int LDS_BYTES = 140 * 1024;
constexpr int CAPROWS = 77824;
constexpr size_t TOKW = (size_t)NTOK * MW;

struct Params {
    const float *x, *c, *ctx, *c_ctx, *w_mod, *b_mod, *norm1_g, *norm2_g, *w_in, *gdn_conv_w, *gdn_a_log, *gdn_dt_bias, *gdn_norm_g, *hgrn_lb,
        *hgrn_norm_g, *lru_conv_w, *lru_conv_b, *lru_wa, *lru_ba, *lru_wx, *lru_bx, *lru_lambda, *ret_norm_g, *w_branch, *w_out, *router_w,
        *router_b, *moe_w1, *moe_b1, *moe_w2, *moe_b2, *final_norm_g;
    float* out;
    unsigned* bar; int* cnt; float* mod;
    bf16_t *winT, *wbT, *woutT, *w1T, *w2T;
    float* xl; bf16_t* H; bf16_t* P; float* prep; float* gg; float* gb; float* O; bf16_t* Y; bf16_t* mix; bf16_t* F;
    int* list; int* tokslot; float* topw; bf16_t* act; bf16_t* yp;
};

__device__ __forceinline__ unsigned f2bf(float f) { unsigned u = __float_as_uint(f); u += 0x7fffu + ((u >> 16) & 1u); return u >> 16; }
__device__ __forceinline__ unsigned pack2(float a, float b) { return f2bf(a) | (f2bf(b) << 16); }
__device__ __forceinline__ float bf2f(bf16_t b) { return __uint_as_float(((unsigned)b) << 16); }
__device__ __forceinline__ float bflo(unsigned u) { return __uint_as_float(u << 16); }
__device__ __forceinline__ float bfhi(unsigned u) { return __uint_as_float(u & 0xffff0000u); }
__device__ __forceinline__ float sigmoidf_(float x) { return 1.0f / (1.0f + __expf(-x)); }
__device__ __forceinline__ float siluf_(float x) { return x * sigmoidf_(x); }
__device__ __forceinline__ float softplusf_(float x) { return x > 20.f ? x : log1pf(__expf(x)); }
__device__ __forceinline__ float logsigmoidf_(float x) { return -softplusf_(-x); }
__device__ __forceinline__ float gelu_tanhf_(float x) { const float u = 0.7978845608028654f * (x + 0.044715f * x * x * x); return 0.5f * x * (1.0f + tanhf(u)); }
__device__ __forceinline__ float wave_sum(float v) {
#pragma unroll
    for (int m = 32; m >= 1; m >>= 1) v += __shfl_xor(v, m);
    return v;
}
__device__ __forceinline__ int tok_modrow(int tok) { return tok < NLAT ? (tok >> 12) : 4; }
__device__ __forceinline__ void tok_info(int tok, int& t, int& T, int& base) {
    if (tok < NLAT) { t = tok & (TL - 1); T = TL; base = tok - t; }
    else { t = (tok - NLAT) & (TC - 1); T = TC; base = tok - t; }
}

namespace gm {
constexpr int HT = 16384;
__device__ __forceinline__ int lds_byte(int r, int c) { const int st = (r >> 4) * 2 + (c >> 5), rr = r & 15, cc = c & 31, ob = rr * 64 + cc * 2; return st * 1024 + (ob ^ (((ob >> 9) & 1) << 5)); }
__device__ __forceinline__ void stage_rc(int b, int& R, int& C) { const int st = b / 1024, sb = b % 1024, swz = sb ^ (((sb >> 9) & 1) << 5); R = (st >> 1) * 16 + swz / 64; C = (st & 1) * 32 + (swz % 64) / 2; }

__device__ __forceinline__ void kloop(LAS unsigned char* lds, const bf16_t* ap00, const bf16_t* ap01, const bf16_t* ap10, const bf16_t* ap11,
                                      const bf16_t* bp0, const bf16_t* bp1, int K, f32x4 (&acc)[4][4]) {
    const int tid = threadIdx.x, wid = __builtin_amdgcn_readfirstlane(tid >> 6), lane = tid & 63, wr = wid >> 1, wc = wid & 1, fr = lane & 15, fq = lane >> 4;
    const unsigned ldsw = (unsigned)wid * 1024u;
    const int aoff = (wr >> 1) * HT + lds_byte((wr & 1) * 64 + fr, fq * 8);
    const int boff = 2 * HT + lds_byte(wc * 64 + fr, fq * 8);
    const int nt = K / 64;
#define GM_GLDS(src, dstoff) __builtin_amdgcn_global_load_lds((const unsigned*)(src), (LAS unsigned*)(lds + (dstoff)), 16, 0, 0)
#define GM_STAGE(buf, kt) do { const int _bo = (buf) * 3 * HT + ldsw; const int _ko = (kt) * 64; \
        GM_GLDS(ap00 + _ko, _bo); GM_GLDS(ap01 + _ko, _bo + 8192); GM_GLDS(ap10 + _ko, _bo + HT); GM_GLDS(ap11 + _ko, _bo + HT + 8192); \
        GM_GLDS(bp0 + _ko, _bo + 2 * HT); GM_GLDS(bp1 + _ko, _bo + 2 * HT + 8192); } while (0)
    GM_STAGE(0, 0);
    for (int t = 0; t < nt; ++t) {
        const int cur = t & 1;
        if (t + 1 < nt) { GM_STAGE(cur ^ 1, t + 1); asm volatile("s_waitcnt vmcnt(6)" ::: "memory"); }
        else asm volatile("s_waitcnt vmcnt(0)" ::: "memory");
        __builtin_amdgcn_s_barrier(); asm volatile("" ::: "memory");
        bf16x8 af[4][2], bfr[4][2];
#pragma unroll
        for (int m = 0; m < 4; ++m)
#pragma unroll
            for (int k = 0; k < 2; ++k) af[m][k] = *(const LAS bf16x8*)(lds + cur * 3 * HT + aoff + m * 2048 + k * 1024);
#pragma unroll
        for (int n = 0; n < 4; ++n)
#pragma unroll
            for (int k = 0; k < 2; ++k) bfr[n][k] = *(const LAS bf16x8*)(lds + cur * 3 * HT + boff + n * 2048 + k * 1024);
#pragma unroll
        for (int k = 0; k < 2; ++k)
#pragma unroll
            for (int m = 0; m < 4; ++m)
#pragma unroll
                for (int n = 0; n < 4; ++n) acc[m][n] = __builtin_amdgcn_mfma_f32_16x16x32_bf16(bfr[n][k], af[m][k], acc[m][n], 0, 0, 0);
        asm volatile("s_waitcnt lgkmcnt(0)" ::: "memory");
        __builtin_amdgcn_s_barrier(); asm volatile("" ::: "memory");
    }
#undef GM_STAGE
#undef GM_GLDS
}
__device__ __forceinline__ void zero_acc(f32x4 (&acc)[4][4]) {
#pragma unroll
    for (int m = 0; m < 4; ++m)
#pragma unroll
        for (int n = 0; n < 4; ++n) acc[m][n] = (f32x4){0.f, 0.f, 0.f, 0.f};
}
}

struct StageRC { int R0, C0, R1, C1; };
__device__ __forceinline__ StageRC my_stage_rc() { StageRC s; gm::stage_rc(threadIdx.x * 16, s.R0, s.C0); gm::stage_rc(threadIdx.x * 16 + 8192, s.R1, s.C1); return s; }

__device__ __forceinline__ int w1_dst_row(int n) { const int half = n >> 10, cc = n & 1023; return (cc >> 6) * 128 + ((cc >> 5) & 1) * 64 + half * 32 + (cc & 31); }

__device__ __forceinline__ void cvt_tile(LAS float* tile, const float* src, int ldsrc, int Nsrc, int k0, int n0, bf16_t* dst, int K, int mode) {
    const int tid = threadIdx.x;
    {
        const int rr = tid >> 6, cc = tid & 63, n = n0 + cc;
#pragma unroll
        for (int i = 0; i < 8; ++i) { const int k = rr + i * 8; tile[k * 65 + cc] = (n < Nsrc) ? src[(size_t)(k0 + k) * ldsrc + n] : 0.f; }
    }
    __syncthreads();
    {
        const int nl = tid >> 3, kg = tid & 7, n = n0 + nl;
        float v[8];
#pragma unroll
        for (int j = 0; j < 8; ++j) v[j] = tile[(kg * 8 + j) * 65 + nl];
        const int drow = mode == 1 ? w1_dst_row(n) : n;
        u32x4 o; o[0] = pack2(v[0], v[1]); o[1] = pack2(v[2], v[3]); o[2] = pack2(v[4], v[5]); o[3] = pack2(v[6], v[7]);
        *(u32x4*)(dst + (size_t)drow * K + k0 + kg * 8) = o;
    }
    __syncthreads();
}

__device__ __forceinline__ void ph_convert(const Params& p, LAS unsigned char* lds) {
    LAS float* tile = (LAS float*)lds;
    constexpr int PER_L = 3008 + 512 + 256 + 16384 + 8192;
    for (int it = blockIdx.x; it < 2 * PER_L; it += gridDim.x) {
        const int l = it / PER_L; int r = it % PER_L;
        if (r < 3008) { const int nt = r % 188, kt = r / 188; cvt_tile(tile, p.w_in + (size_t)l * D * NIN, NIN, NIN, kt * 64, nt * 64, p.winT + (size_t)l * NP * D, D, 0); }
        else if (r < 3520) { r -= 3008; const int n = r / 128; r %= 128; const int nt = r % 16, kt = r / 16;
            cvt_tile(tile, p.w_branch + (size_t)(l * 4 + n) * MW * D, D, D, kt * 64, nt * 64, p.wbT + (size_t)(l * 4 + n) * D * MW, MW, 0); }
        else if (r < 3776) { r -= 3520; const int nt = r % 16, kt = r / 16; cvt_tile(tile, p.w_out + (size_t)l * D * D, D, D, kt * 64, nt * 64, p.woutT + (size_t)l * D * D, D, 0); }
        else if (r < 3776 + 16384) { r -= 3776; const int e = r / 512; r %= 512; const int nt = r % 32, kt = r / 32;
            cvt_tile(tile, p.moe_w1 + (size_t)(l * NE + e) * D * 2 * D, 2 * D, 2 * D, kt * 64, nt * 64, p.w1T + (size_t)(l * NE + e) * 2 * D * D, D, 1); }
        else { r -= 3776 + 16384; const int e = r / 256; r %= 256; const int nt = r % 16, kt = r / 16;
            cvt_tile(tile, p.moe_w2 + (size_t)(l * NE + e) * D * D, D, D, kt * 64, nt * 64, p.w2T + (size_t)(l * NE + e) * D * D, D, 0); }
    }
}

__device__ __forceinline__ void ph_mod(const Params& p, LAS unsigned char* lds) {
    LAS float* sc = (LAS float*)lds;
    LAS float* red = sc + 5 * D;
    const int tid = threadIdx.x, wid = tid >> 6, lane = tid & 63;
    if ((int)blockIdx.x >= 192) return;
    for (int i = tid; i < 5 * D; i += NTHREADS) { const int r = i >> 10, k = i & 1023; const float v = r < 4 ? p.c[r * D + k] : p.c_ctx[k]; sc[i] = siluf_(v); }
    __syncthreads();
    for (int it = blockIdx.x; it < 192; it += gridDim.x) {
        const int l = it / 96, n0 = (it % 96) * 64;
        float acc[5] = {0.f, 0.f, 0.f, 0.f, 0.f};
        const float* wp = p.w_mod + (size_t)l * D * (NMOD * D) + n0 + lane;
        for (int k = wid * 128; k < wid * 128 + 128; ++k) {
            const float wv = wp[(size_t)k * (NMOD * D)];
#pragma unroll
            for (int r = 0; r < 5; ++r) acc[r] += sc[r * D + k] * wv;
        }
#pragma unroll
        for (int r = 0; r < 5; ++r) red[(wid * 5 + r) * 64 + lane] = acc[r];
        __syncthreads();
        if (tid < 320) { const int r = tid >> 6, cidx = tid & 63; float s = p.b_mod[l * NMOD * D + n0 + cidx];
#pragma unroll
            for (int w = 0; w < 8; ++w) s += red[(w * 5 + r) * 64 + cidx];
            p.mod[(size_t)(l * 5 + r) * (NMOD * D) + n0 + cidx] = s; }
        __syncthreads();
    }
}

__device__ __forceinline__ void norm_mod_store(const float4 (&v)[4], float rinv, const float* g, const float* scp, const float* shp, bf16_t* dst, int lane) {
#pragma unroll
    for (int i = 0; i < 4; ++i) {
        const int cidx = i * 256 + lane * 4;
        const float4 gv = *(const float4*)(g + cidx), sv = *(const float4*)(scp + cidx), hv = *(const float4*)(shp + cidx);
        const float h0 = v[i].x * rinv * gv.x * (1.f + sv.x) + hv.x, h1 = v[i].y * rinv * gv.y * (1.f + sv.y) + hv.y;
        const float h2 = v[i].z * rinv * gv.z * (1.f + sv.z) + hv.z, h3 = v[i].w * rinv * gv.w * (1.f + sv.w) + hv.w;
        u32x2 o; o[0] = pack2(h0, h1); o[1] = pack2(h2, h3);
        *(u32x2*)(dst + cidx) = o;
    }
}
__device__ __forceinline__ void ph_norm1_first(const Params& p) {
    const int tid = threadIdx.x, wid = tid >> 6, lane = tid & 63;
    for (int tok = blockIdx.x * NWAVES + wid; tok < NTOK; tok += gridDim.x * NWAVES) {
        const float* src = tok < NLAT ? p.x + (size_t)tok * D : p.ctx + (size_t)(tok - NLAT) * D;
        float4 v[4]; float ss = 0.f;
#pragma unroll
        for (int i = 0; i < 4; ++i) { v[i] = *(const float4*)(src + i * 256 + lane * 4); ss += v[i].x * v[i].x + v[i].y * v[i].y + v[i].z * v[i].z + v[i].w * v[i].w; }
        ss = wave_sum(ss);
        const float rinv = rsqrtf(ss * (1.0f / D) + 1e-6f);
        const float* mb = p.mod + (size_t)(0 * 5 + tok_modrow(tok)) * (NMOD * D);
        norm_mod_store(v, rinv, p.norm1_g, mb + 1 * D, mb + 0 * D, p.H + (size_t)tok * D, lane);
#pragma unroll
        for (int i = 0; i < 4; ++i) *(float4*)(p.xl + (size_t)tok * D + i * 256 + lane * 4) = v[i];
    }
}

__device__ __forceinline__ void ph_g1(const Params& p, int l, LAS unsigned char* lds) {
    const StageRC s = my_stage_rc();
    const int tid = threadIdx.x, wid = tid >> 6, lane = tid & 63, wr = wid >> 1, wc = wid & 1, fr = lane & 15, fq = lane >> 4;
    const bf16_t* Bt = p.winT + (size_t)l * NP * D;
    constexpr int NTN = 93, NTM = NTOK / 256;
    for (int u = blockIdx.x; u < NTM * NTN; u += gridDim.x) {
        const int pm = u / NTN, pn = u % NTN;
        const bf16_t* a0 = p.H + (size_t)(pm * 256) * D;
        f32x4 acc[4][4]; gm::zero_acc(acc);
        gm::kloop(lds, a0 + (size_t)s.R0 * D + s.C0, a0 + (size_t)s.R1 * D + s.C1, a0 + (size_t)(128 + s.R0) * D + s.C0, a0 + (size_t)(128 + s.R1) * D + s.C1,
                  Bt + (size_t)(pn * 128 + s.R0) * D + s.C0, Bt + (size_t)(pn * 128 + s.R1) * D + s.C1, D, acc);
#pragma unroll
        for (int m = 0; m < 4; ++m)
#pragma unroll
            for (int n = 0; n < 4; ++n) {
                const int row = pm * 256 + wr * 64 + m * 16 + fr, col = pn * 128 + wc * 64 + n * 16 + fq * 4;
                u32x2 o; o[0] = pack2(acc[m][n][0], acc[m][n][1]); o[1] = pack2(acc[m][n][2], acc[m][n][3]);
                *(u32x2*)(p.P + (size_t)row * NP + col) = o;
            }
    }
}

__device__ __forceinline__ void ph_prep(const Params& p, int l, LAS unsigned char* lds) {
    const int tid = threadIdx.x, wid = tid >> 6, lane = tid & 63;
    const int gw = blockIdx.x * NWAVES + wid, nw = gridDim.x * NWAVES;
    for (int id = gw; id < NTOK * 12; id += nw) {
        const int tok = id / 12, r = id % 12, part = r >> 2, head = r & 3;
        int t, T, base; tok_info(tok, t, T, base);
        const int cidx = part * 512 + head * 128 + lane * 2;
        float a0 = 0.f, a1 = 0.f;
#pragma unroll
        for (int j = 0; j < 4; ++j) {
            const int tt = t + j - 2;
            if (tt >= 0 && tt < T) {
                const unsigned u = *(const unsigned*)(p.P + (size_t)(base + tt) * NP + C_GQKV + cidx);
                const f32x2 w = *(const f32x2*)(p.gdn_conv_w + (size_t)(l * 4 + j) * 1536 + cidx);
                a0 += w[0] * bflo(u); a1 += w[1] * bfhi(u);
            }
        }
        a0 = siluf_(a0); a1 = siluf_(a1);
        if (part < 2) {
            const float ss = wave_sum(a0 * a0 + a1 * a1);
            const float sc = rsqrtf(ss + 1e-6f) * (part == 0 ? 0.08838834764831845f : 1.0f);
            a0 *= sc; a1 *= sc;
        }
        f32x2 o; o[0] = a0; o[1] = a1;
        *(f32x2*)(p.prep + part * TOKW + (size_t)tok * MW + head * 128 + lane * 2) = o;
        if (r == 0 && lane < 16) {
            const int idx = lane & 7;
            if (lane < 8) { const float a = bf2f(p.P[(size_t)tok * NP + C_GA + idx]);
                p.gg[(size_t)tok * 8 + idx] = -__expf(p.gdn_a_log[l * 8 + idx]) * softplusf_(a + p.gdn_dt_bias[l * 8 + idx]); }
            else { const float bt = bf2f(p.P[(size_t)tok * NP + C_GB + idx]); p.gb[(size_t)tok * 8 + idx] = sigmoidf_(bt); }
        }
    }
    for (int id = gw; id < NTOK * 4; id += nw) {
        const int tok = id >> 2, head = id & 3;
        const int cidx = head * 128 + lane * 2;
        const bf16_t* pr = p.P + (size_t)tok * NP;
        const unsigned uq = *(const unsigned*)(pr + C_HQ + cidx), ui = *(const unsigned*)(pr + C_HI + cidx);
        f32x2 o;
        o[0] = siluf_(bflo(uq)) * 0.08838834764831845f; o[1] = siluf_(bfhi(uq)) * 0.08838834764831845f;
        *(f32x2*)(p.prep + 3 * TOKW + (size_t)tok * MW + cidx) = o;
        o[0] = bflo(ui); o[1] = bfhi(ui);
        *(f32x2*)(p.prep + 4 * TOKW + (size_t)tok * MW + cidx) = o;
#pragma unroll
        for (int d = 0; d < 2; ++d) {
            const unsigned uf = *(const unsigned*)(pr + C_HF + d * 512 + cidx);
            float lb0 = 0.f, lb1 = 0.f;
            if (l == 1) {
                const f32x2 x0 = *(const f32x2*)(p.hgrn_lb + (size_t)(0 * 2 + d) * MW + cidx), x1 = *(const f32x2*)(p.hgrn_lb + (size_t)(1 * 2 + d) * MW + cidx);
                lb0 = fminf(1.0f / (1.0f + __expf(x0[0] - x1[0])), 1.0f - 1e-4f); lb1 = fminf(1.0f / (1.0f + __expf(x0[1] - x1[1])), 1.0f - 1e-4f);
            }
            const float z0 = bflo(uf), z1 = bfhi(uf);
            const float f0 = lb0 + (1.f - lb0) * sigmoidf_(z0), f1 = lb1 + (1.f - lb1) * sigmoidf_(z1);
            f32x2 k; k[0] = (1.f - lb0) * sigmoidf_(-z0); k[1] = (1.f - lb1) * sigmoidf_(-z1);
            *(f32x2*)(p.prep + (5 + d) * TOKW + (size_t)tok * MW + cidx) = k;
            f32x2 lf; lf[0] = __logf(fmaxf(f0, 1e-30f)); lf[1] = __logf(fmaxf(f1, 1e-30f));
            *(f32x2*)(p.prep + (7 + d) * TOKW + (size_t)tok * MW + cidx) = lf;
        }
    }
    for (int id = gw; id < NTOK * 4; id += nw) {
        const int tok = id >> 2, head = id & 3;
        const bf16_t* pr = p.P + (size_t)tok * NP + C_RQKV + head * 128;
        float q1 = bf2f(pr[lane]), q2 = bf2f(pr[64 + lane]), k1 = bf2f(pr[512 + lane]), k2 = bf2f(pr[512 + 64 + lane]);
        const float v1 = bf2f(pr[1024 + lane]), v2 = bf2f(pr[1024 + 64 + lane]);
        if (tok < NLAT) {
            const int t = tok & (TL - 1);
            const float pos = (lane < 32) ? (float)(t >> 6) : (float)(t & 63);
            const float inv = exp2f(-(float)(lane & 31) * (13.287712379549449f / 32.0f));
            const float ang = pos * inv;
            float sn, cs; sincosf(ang, &sn, &cs);
            const float nq1 = q1 * cs - q2 * sn, nq2 = q1 * sn + q2 * cs, nk1 = k1 * cs - k2 * sn, nk2 = k1 * sn + k2 * cs;
            q1 = nq1; q2 = nq2; k1 = nk1; k2 = nk2;
        }
        k1 *= 0.08838834764831845f; k2 *= 0.08838834764831845f;
        const size_t o = (size_t)tok * MW + head * 128;
        p.prep[9 * TOKW + o + lane] = q1; p.prep[9 * TOKW + o + 64 + lane] = q2;
        p.prep[10 * TOKW + o + lane] = k1; p.prep[10 * TOKW + o + 64 + lane] = k2;
        p.prep[11 * TOKW + o + lane] = v1; p.prep[11 * TOKW + o + 64 + lane] = v2;
    }
    {
        LAS float* xs = (LAS float*)lds;
        LAS float* wsm = xs + 64 * 65;
        for (int it = blockIdx.x; it < (NTOK / 64) * 8; it += gridDim.x) {
            const int tile = it >> 3, n = it & 7, tok0 = tile * 64;
            {
                const int tl = tid & 63, cg = tid >> 6, tok = tok0 + tl;
                int t, T, base; tok_info(tok, t, T, base);
                float a[8];
#pragma unroll
                for (int j = 0; j < 8; ++j) a[j] = p.lru_conv_b[l * MW + n * 64 + cg * 8 + j];
#pragma unroll
                for (int j = 0; j < 4; ++j) {
                    const int tt = t + j - 2;
                    if (tt >= 0 && tt < T) {
                        const u32x4 u = *(const u32x4*)(p.P + (size_t)(base + tt) * NP + C_LX + n * 64 + cg * 8);
                        const float* w = p.lru_conv_w + (size_t)(l * 4 + j) * MW + n * 64 + cg * 8;
#pragma unroll
                        for (int q = 0; q < 4; ++q) { a[2 * q] += w[2 * q] * bflo(u[q]); a[2 * q + 1] += w[2 * q + 1] * bfhi(u[q]); }
                    }
                }
#pragma unroll
                for (int j = 0; j < 8; ++j) xs[tl * 65 + cg * 8 + j] = a[j];
                for (int i = tid; i < 4 * 1024; i += NTHREADS) {
                    const int mat = i >> 10, off = (i & 1023) * 4, d = mat >> 1;
                    const float* srcw = ((mat & 1) ? p.lru_wx : p.lru_wa) + (size_t)((l * 2 + d) * 8 + n) * 4096 + off;
                    const float4 v = *(const float4*)srcw;
                    LAS float* dw = wsm + mat * 4096 + off; dw[0] = v.x; dw[1] = v.y; dw[2] = v.z; dw[3] = v.w;
                }
            }
            __syncthreads();
            {
                const int tl = tid & 63, jg = tid >> 6, tok = tok0 + tl;
                float acc[4][8];
#pragma unroll
                for (int m = 0; m < 4; ++m)
#pragma unroll
                    for (int j = 0; j < 8; ++j) acc[m][j] = 0.f;
                for (int i = 0; i < 64; ++i) {
                    const float xv = xs[tl * 65 + i];
#pragma unroll
                    for (int m = 0; m < 4; ++m)
#pragma unroll
                        for (int j = 0; j < 8; ++j) acc[m][j] += xv * wsm[m * 4096 + i * 64 + jg * 8 + j];
                }
#pragma unroll
                for (int d = 0; d < 2; ++d) {
                    float av[8], uv[8];
#pragma unroll
                    for (int j = 0; j < 8; ++j) {
                        const int cidx = n * 64 + jg * 8 + j, pi = (l * 2 + d) * MW + cidx;
                        const float gr = sigmoidf_(acc[d * 2][j] + p.lru_ba[pi]), gi = sigmoidf_(acc[d * 2 + 1][j] + p.lru_bx[pi]);
                        const float la = 8.0f * gr * logsigmoidf_(p.lru_lambda[pi]);
                        av[j] = __expf(la);
                        uv[j] = xs[tl * 65 + jg * 8 + j] * gi * sqrtf(fmaxf(-expm1f(2.0f * la), 1e-12f));
                    }
                    float* da = p.prep + (12 + d) * TOKW + (size_t)tok * MW + n * 64 + jg * 8;
                    float* du = p.prep + (14 + d) * TOKW + (size_t)tok * MW + n * 64 + jg * 8;
                    *(float4*)da = make_float4(av[0], av[1], av[2], av[3]); *(float4*)(da + 4) = make_float4(av[4], av[5], av[6], av[7]);
                    *(float4*)du = make_float4(uv[0], uv[1], uv[2], uv[3]); *(float4*)(du + 4) = make_float4(uv[4], uv[5], uv[6], uv[7]);
                }
            }
            __syncthreads();
        }
    }
}

__device__ __forceinline__ void scan_matrix(const Params& p, int ty, int b, int h, int d, LAS unsigned char* lds) {
    LAS float* sq = (LAS float*)lds;
    LAS float* sk = sq + 32 * 128;
    LAS float* sv = sk + 32 * 128;
    LAS float* sf = sv + 32 * 128;
    LAS float* sdec = sf + 32 * 128;
    LAS float* sbeta = sdec + 32;
    LAS float* red = sbeta + 32;
    const int tid = threadIdx.x, j = tid & 127, g = tid >> 7;
    const float* Q = p.prep + (ty == 0 ? 0 : ty == 1 ? 3 : 9) * TOKW;
    const float* Kp = p.prep + (ty == 0 ? 1 : ty == 1 ? (5 + d) : 10) * TOKW;
    const float* V = p.prep + (ty == 0 ? 2 : ty == 1 ? 4 : 11) * TOKW;
    const float* LF = p.prep + (7 + d) * TOKW;
    float* Op = p.O + (size_t)((ty == 0 ? 0 : ty == 1 ? 1 : 3) * 2 + d) * TOKW;
    const float gamma = 1.0f - exp2f(-5.0f - (float)h);
    float S[32];
#pragma unroll
    for (int i = 0; i < 32; ++i) S[i] = 0.f;
    int par = 0;
    for (int seg = 0; seg < 2; ++seg) {
        const int T = seg ? TL : TC, base = seg ? b * TL : NLAT + b * TC;
        for (int c0 = 0; c0 < T; c0 += 32) {
            __syncthreads();
            for (int idx = tid; idx < 32 * 128; idx += NTHREADS) {
                const int r = idx >> 7, jj = idx & 127, i = c0 + r, t = d ? T - 1 - i : i;
                const size_t o = (size_t)(base + t) * MW + h * 128 + jj;
                sq[idx] = Q[o]; sk[idx] = Kp[o]; sv[idx] = V[o];
                if (ty == 1) sf[idx] = __expf(LF[o]);
            }
            if (tid < 32) {
                const int i = c0 + tid, t = d ? T - 1 - i : i;
                if (ty == 0) { sdec[tid] = __expf(p.gg[(size_t)(base + t) * 8 + d * 4 + h]); sbeta[tid] = p.gb[(size_t)(base + t) * 8 + d * 4 + h]; }
                else { sdec[tid] = gamma; sbeta[tid] = 0.f; }
            }
            __syncthreads();
            for (int r = 0; r < 32; ++r) {
                const int i = c0 + r, t = d ? T - 1 - i : i;
                float kk[32], qq[32];
#pragma unroll
                for (int q4 = 0; q4 < 8; ++q4) {
                    const f32x4 kv = *(const LAS f32x4*)(sk + r * 128 + g * 32 + q4 * 4), qv = *(const LAS f32x4*)(sq + r * 128 + g * 32 + q4 * 4);
                    kk[q4 * 4] = kv[0]; kk[q4 * 4 + 1] = kv[1]; kk[q4 * 4 + 2] = kv[2]; kk[q4 * 4 + 3] = kv[3];
                    qq[q4 * 4] = qv[0]; qq[q4 * 4 + 1] = qv[1]; qq[q4 * 4 + 2] = qv[2]; qq[q4 * 4 + 3] = qv[3];
                }
                const float vj = sv[r * 128 + j];
                LAS float* r1 = red + (par * 2 + 0) * 512; LAS float* r2 = red + (par * 2 + 1) * 512;
                float po = 0.f;
                if (ty == 0) {
                    const float a = sdec[r], bt = sbeta[r];
                    float part = 0.f;
#pragma unroll
                    for (int i2 = 0; i2 < 32; ++i2) part += kk[i2] * S[i2];
                    r1[g * 128 + j] = part;
                    __syncthreads();
                    const float ks = a * (r1[j] + r1[128 + j] + r1[256 + j] + r1[384 + j]);
                    const float vn = bt * (vj - ks);
#pragma unroll
                    for (int i2 = 0; i2 < 32; ++i2) { S[i2] = a * S[i2] + kk[i2] * vn; po += qq[i2] * S[i2]; }
                } else if (ty == 1) {
#pragma unroll
                    for (int q4 = 0; q4 < 8; ++q4) {
                        const f32x4 fv = *(const LAS f32x4*)(sf + r * 128 + g * 32 + q4 * 4);
#pragma unroll
                        for (int e = 0; e < 4; ++e) { const int i2 = q4 * 4 + e; S[i2] = fv[e] * S[i2] + kk[i2] * vj; po += qq[i2] * S[i2]; }
                    }
                } else {
#pragma unroll
                    for (int i2 = 0; i2 < 32; ++i2) { S[i2] = gamma * S[i2] + kk[i2] * vj; po += qq[i2] * S[i2]; }
                }
                r2[g * 128 + j] = po;
                __syncthreads();
                if (g == 0) Op[(size_t)(base + t) * MW + h * 128 + j] = r2[j] + r2[128 + j] + r2[256 + j] + r2[384 + j];
                par ^= 1;
            }
        }
    }
}
__device__ __forceinline__ void scan_lru(const Params& p, int b, int d, int c) {
    const float* A = p.prep + (12 + d) * TOKW; const float* U = p.prep + (14 + d) * TOKW;
    float* Op = p.O + (size_t)(2 * 2 + d) * TOKW;
    float hst = 0.f;
    for (int seg = 0; seg < 2; ++seg) {
        const int T = seg ? TL : TC, base = seg ? b * TL : NLAT + b * TC;
        for (int i0 = 0; i0 < T; i0 += 8) {
            float av[8], uv[8];
#pragma unroll
            for (int q = 0; q < 8; ++q) { const int i = i0 + q, t = d ? T - 1 - i : i; const size_t o = (size_t)(base + t) * MW + c; av[q] = A[o]; uv[q] = U[o]; }
#pragma unroll
            for (int q = 0; q < 8; ++q) { const int i = i0 + q, t = d ? T - 1 - i : i; hst = av[q] * hst + uv[q]; Op[(size_t)(base + t) * MW + c] = hst; }
        }
    }
}
__device__ __forceinline__ void ph_scan(const Params& p, LAS unsigned char* lds) {
    for (int it = blockIdx.x; it < 104; it += gridDim.x) {
        if (it < 96) { const int ty = it >> 5, r = it & 31; scan_matrix(p, ty == 2 ? 3 : ty, r >> 3, (r >> 1) & 3, r & 1, lds); }
        else { const int r = it - 96; scan_lru(p, r >> 1, r & 1, threadIdx.x); }
        __syncthreads();
    }
}

__device__ __forceinline__ void ph_merge(const Params& p, int l, int M) {
    const int tid = threadIdx.x, wid = tid >> 6, lane = tid & 63;
    for (int id = blockIdx.x * NWAVES + wid; id < M * 16; id += gridDim.x * NWAVES) {
        const int tok = id >> 4, r = id & 15, m = r >> 2, head = r & 3;
        const int cidx = head * 128 + lane * 2;
        const size_t o = (size_t)tok * MW + cidx;
        const f32x2 o0 = *(const f32x2*)(p.O + (size_t)(m * 2) * TOKW + o), o1 = *(const f32x2*)(p.O + (size_t)(m * 2 + 1) * TOKW + o);
        const float a0 = o0[0] + o1[0], a1 = o0[1] + o1[1];
        float y0, y1; int nbr;
        if (m == 2) {
            const unsigned u = *(const unsigned*)(p.P + (size_t)tok * NP + C_LY + cidx);
            y0 = a0 * gelu_tanhf_(bflo(u)); y1 = a1 * gelu_tanhf_(bfhi(u)); nbr = 2;
        } else {
            const float ss = wave_sum(a0 * a0 + a1 * a1);
            const float rinv = rsqrtf(ss * (1.0f / 128.0f) + 1e-6f);
            const float* gp = (m == 0 ? p.gdn_norm_g : m == 1 ? p.hgrn_norm_g : p.ret_norm_g) + l * 128 + lane * 2;
            const int zc = m == 0 ? C_GZ : m == 1 ? C_HG : C_RG;
            const unsigned u = *(const unsigned*)(p.P + (size_t)tok * NP + zc + cidx);
            y0 = a0 * rinv * gp[0] * siluf_(bflo(u)); y1 = a1 * rinv * gp[1] * siluf_(bfhi(u)); nbr = m == 3 ? 3 : m;
        }
        *(unsigned*)(p.Y + (size_t)nbr * TOKW + o) = pack2(y0, y1);
    }
}

__device__ __forceinline__ void ph_g2(const Params& p, int l, int M, LAS unsigned char* lds) {
    const StageRC s = my_stage_rc();
    const int tid = threadIdx.x, wid = tid >> 6, lane = tid & 63, wr = wid >> 1, wc = wid & 1, fr = lane & 15, fq = lane >> 4;
    const int ntm = M / 256;
    for (int u = blockIdx.x; u < ntm * 8; u += gridDim.x) {
        const int pm = u >> 3, pn = u & 7;
        f32x4 tot[4][4]; gm::zero_acc(tot);
        for (int nb = 0; nb < 4; ++nb) {
            const bf16_t* a0 = p.Y + (size_t)nb * TOKW + (size_t)(pm * 256) * MW;
            const bf16_t* Bt = p.wbT + (size_t)(l * 4 + nb) * D * MW + (size_t)(pn * 128) * MW;
            f32x4 acc[4][4]; gm::zero_acc(acc);
            gm::kloop(lds, a0 + (size_t)s.R0 * MW + s.C0, a0 + (size_t)s.R1 * MW + s.C1, a0 + (size_t)(128 + s.R0) * MW + s.C0, a0 + (size_t)(128 + s.R1) * MW + s.C1,
                      Bt + (size_t)s.R0 * MW + s.C0, Bt + (size_t)s.R1 * MW + s.C1, MW, acc);
#pragma unroll
            for (int m = 0; m < 4; ++m)
#pragma unroll
                for (int n = 0; n < 4; ++n) {
                    const int row = pm * 256 + wr * 64 + m * 16 + fr, col = pn * 128 + wc * 64 + n * 16 + fq * 4;
                    const u32x2 gu = *(const u32x2*)(p.P + (size_t)row * NP + C_MG + nb * D + col);
                    tot[m][n][0] += sigmoidf_(bflo(gu[0])) * acc[m][n][0]; tot[m][n][1] += sigmoidf_(bfhi(gu[0])) * acc[m][n][1];
                    tot[m][n][2] += sigmoidf_(bflo(gu[1])) * acc[m][n][2]; tot[m][n][3] += sigmoidf_(bfhi(gu[1])) * acc[m][n][3];
                }
        }
#pragma unroll
        for (int m = 0; m < 4; ++m)
#pragma unroll
            for (int n = 0; n < 4; ++n) {
                const int row = pm * 256 + wr * 64 + m * 16 + fr, col = pn * 128 + wc * 64 + n * 16 + fq * 4;
                u32x2 o; o[0] = pack2(tot[m][n][0], tot[m][n][1]); o[1] = pack2(tot[m][n][2], tot[m][n][3]);
                *(u32x2*)(p.mix + (size_t)row * D + col) = o;
            }
    }
}

__device__ __forceinline__ void ph_g3(const Params& p, int l, int M, LAS unsigned char* lds) {
    const StageRC s = my_stage_rc();
    const int tid = threadIdx.x, wid = tid >> 6, lane = tid & 63, wr = wid >> 1, wc = wid & 1, fr = lane & 15, fq = lane >> 4;
    const int ntm = M / 256;
    for (int u = blockIdx.x; u < ntm * 8; u += gridDim.x) {
        const int pm = u >> 3, pn = u & 7;
        const bf16_t* a0 = p.mix + (size_t)(pm * 256) * D;
        const bf16_t* Bt = p.woutT + (size_t)l * D * D + (size_t)(pn * 128) * D;
        f32x4 acc[4][4]; gm::zero_acc(acc);
        gm::kloop(lds, a0 + (size_t)s.R0 * D + s.C0, a0 + (size_t)s.R1 * D + s.C1, a0 + (size_t)(128 + s.R0) * D + s.C0, a0 + (size_t)(128 + s.R1) * D + s.C1,
                  Bt + (size_t)s.R0 * D + s.C0, Bt + (size_t)s.R1 * D + s.C1, D, acc);
#pragma unroll
        for (int m = 0; m < 4; ++m)
#pragma unroll
            for (int n = 0; n < 4; ++n) {
                const int row = pm * 256 + wr * 64 + m * 16 + fr, col = pn * 128 + wc * 64 + n * 16 + fq * 4;
                const float4 gt = *(const float4*)(p.mod + (size_t)(l * 5 + tok_modrow(row)) * (NMOD * D) + 2 * D + col);
                float4* xp = (float4*)(p.xl + (size_t)row * D + col);
                float4 xv = *xp;
                xv.x += gt.x * acc[m][n][0]; xv.y += gt.y * acc[m][n][1]; xv.z += gt.z * acc[m][n][2]; xv.w += gt.w * acc[m][n][3];
                *xp = xv;
            }
    }
}

__device__ __forceinline__ void ph_route(const Params& p, int l, int M, LAS unsigned char* lds) {
    LAS float* fs = (LAS float*)lds;
    LAS float* lg = fs + 32 * 1025;
    const int tid = threadIdx.x, wid = tid >> 6, lane = tid & 63;
    const float* rw = p.router_w + (size_t)l * D * NE;
    for (int it = blockIdx.x; it < M / 32; it += gridDim.x) {
        const int tok0 = it * 32;
        for (int q = 0; q < 4; ++q) {
            const int tl = wid * 4 + q, tok = tok0 + tl;
            const float* src = p.xl + (size_t)tok * D;
            float4 v[4]; float ss = 0.f;
#pragma unroll
            for (int i = 0; i < 4; ++i) { v[i] = *(const float4*)(src + i * 256 + lane * 4); ss += v[i].x * v[i].x + v[i].y * v[i].y + v[i].z * v[i].z + v[i].w * v[i].w; }
            ss = wave_sum(ss);
            const float rinv = rsqrtf(ss * (1.0f / D) + 1e-6f);
            const float* mb = p.mod + (size_t)(l * 5 + tok_modrow(tok)) * (NMOD * D);
#pragma unroll
            for (int i = 0; i < 4; ++i) {
                const int cidx = i * 256 + lane * 4;
                const float4 gv = *(const float4*)(p.norm2_g + l * D + cidx), sv = *(const float4*)(mb + 4 * D + cidx), hv = *(const float4*)(mb + 3 * D + cidx);
                const float h0 = v[i].x * rinv * gv.x * (1.f + sv.x) + hv.x, h1 = v[i].y * rinv * gv.y * (1.f + sv.y) + hv.y;
                const float h2 = v[i].z * rinv * gv.z * (1.f + sv.z) + hv.z, h3 = v[i].w * rinv * gv.w * (1.f + sv.w) + hv.w;
                u32x2 o; o[0] = pack2(h0, h1); o[1] = pack2(h2, h3);
                *(u32x2*)(p.F + (size_t)tok * D + cidx) = o;
                LAS float* fr = fs + tl * 1025 + cidx; fr[0] = h0; fr[1] = h1; fr[2] = h2; fr[3] = h3;
            }
        }
        __syncthreads();
        {
            const int tl = tid & 31, eg = tid >> 5;
            float a0 = 0.f, a1 = 0.f;
            const float* rp = rw + eg * 2;
#pragma unroll 8
            for (int k = 0; k < D; ++k) { const float f = fs[tl * 1025 + k]; const f32x2 w = *(const f32x2*)(rp + (size_t)k * NE); a0 += f * w[0]; a1 += f * w[1]; }
            lg[tl * 33 + eg * 2] = a0 + p.router_b[l * NE + eg * 2]; lg[tl * 33 + eg * 2 + 1] = a1 + p.router_b[l * NE + eg * 2 + 1];
        }
        __syncthreads();
        if (tid < 32) {
            const int tok = tok0 + tid;
            float vals[4]; int idxs[4]; unsigned used = 0u;
#pragma unroll
            for (int k = 0; k < 4; ++k) {
                float best = -3.0e38f; int bi = 0;
                for (int e = 0; e < NE; ++e) { const float v = lg[tid * 33 + e]; if (!((used >> e) & 1u) && v > best) { best = v; bi = e; } }
                used |= 1u << bi; vals[k] = best; idxs[k] = bi;
            }
            const float mx = vals[0];
            float ex[4], sum = 0.f;
#pragma unroll
            for (int k = 0; k < 4; ++k) { ex[k] = __expf(vals[k] - mx); sum += ex[k]; }
            const float inv = 1.0f / sum;
#pragma unroll
            for (int k = 0; k < 4; ++k) {
                const int e = idxs[k];
                const int slot = atomicAdd(p.cnt + l * NE + e, 1);
                p.list[(size_t)e * NTOK + slot] = tok;
                p.tokslot[(size_t)tok * 4 + k] = (e << 16) | slot;
                p.topw[(size_t)tok * 4 + k] = ex[k] * inv;
            }
        }
        __syncthreads();
    }
}

__device__ __forceinline__ void build_expert_tables(const Params& p, int l, LAS int* ts, LAS int* cn) {
    if (threadIdx.x == 0) {
        int acc = 0;
        for (int e = 0; e < NE; ++e) { const int c = __hip_atomic_load(p.cnt + l * NE + e, __ATOMIC_RELAXED, __HIP_MEMORY_SCOPE_AGENT); cn[e] = c; ts[e] = acc; acc += (c + 255) >> 8; }
        ts[NE] = acc;
    }
    __syncthreads();
}

__device__ __forceinline__ void ph_g4(const Params& p, int l, LAS unsigned char* lds) {
    LAS int* ts = (LAS int*)(lds + 6 * gm::HT); LAS int* cn = ts + 40;
    build_expert_tables(p, l, ts, cn);
    const StageRC s = my_stage_rc();
    const int tid = threadIdx.x, wid = tid >> 6, lane = tid & 63, wr = wid >> 1, wc = wid & 1, fr = lane & 15, fq = lane >> 4;
    const int MT = ts[NE];
    for (int u = blockIdx.x; u < MT * 16; u += gridDim.x) {
        const int mt = u >> 4, pn = u & 15;
        int e = 0;
        while (e < NE - 1 && ts[e + 1] <= mt) ++e;
        const int cnt = cn[e], slot0 = (mt - ts[e]) * 256;
        const int* le = p.list + (size_t)e * NTOK;
        int sl;
        sl = slot0 + s.R0;       const bf16_t* a00 = p.F + (size_t)le[sl < cnt ? sl : 0] * D + s.C0;
        sl = slot0 + s.R1;       const bf16_t* a01 = p.F + (size_t)le[sl < cnt ? sl : 0] * D + s.C1;
        sl = slot0 + 128 + s.R0; const bf16_t* a10 = p.F + (size_t)le[sl < cnt ? sl : 0] * D + s.C0;
        sl = slot0 + 128 + s.R1; const bf16_t* a11 = p.F + (size_t)le[sl < cnt ? sl : 0] * D + s.C1;
        const bf16_t* Bt = p.w1T + (size_t)(l * NE + e) * 2 * D * D + (size_t)(pn * 128) * D;
        f32x4 acc[4][4]; gm::zero_acc(acc);
        gm::kloop(lds, a00, a01, a10, a11, Bt + (size_t)s.R0 * D + s.C0, Bt + (size_t)s.R1 * D + s.C1, D, acc);
        const float* b1 = p.moe_b1 + (size_t)(l * NE + e) * 2 * D;
#pragma unroll
        for (int m = 0; m < 4; ++m)
#pragma unroll
            for (int n = 0; n < 2; ++n) {
                const int row = mt * 256 + wr * 64 + m * 16 + fr, col = pn * 64 + wc * 32 + n * 16 + fq * 4;
                const float4 bg = *(const float4*)(b1 + col), bl = *(const float4*)(b1 + D + col);
                float o[4];
#pragma unroll
                for (int q = 0; q < 4; ++q) {
                    const float glu = fminf(acc[m][n][q] + ((const float*)&bg)[q], 7.0f);
                    const float lin = fminf(fmaxf(acc[m][n + 2][q] + ((const float*)&bl)[q], -7.0f), 7.0f);
                    o[q] = glu * sigmoidf_(1.702f * glu) * (lin + 1.0f);
                }
                u32x2 ov; ov[0] = pack2(o[0], o[1]); ov[1] = pack2(o[2], o[3]);
                *(u32x2*)(p.act + (size_t)row * D + col) = ov;
            }
    }
}

__device__ __forceinline__ void ph_g5(const Params& p, int l, LAS unsigned char* lds) {
    LAS int* ts = (LAS int*)(lds + 6 * gm::HT); LAS int* cn = ts + 40;
    build_expert_tables(p, l, ts, cn);
    const StageRC s = my_stage_rc();
    const int tid = threadIdx.x, wid = tid >> 6, lane = tid & 63, wr = wid >> 1, wc = wid & 1, fr = lane & 15, fq = lane >> 4;
    const int MT = ts[NE];
    for (int u = blockIdx.x; u < MT * 8; u += gridDim.x) {
        const int mt = u >> 3, pn = u & 7;
        int e = 0;
        while (e < NE - 1 && ts[e + 1] <= mt) ++e;
        const bf16_t* a0 = p.act + (size_t)(mt * 256) * D;
        const bf16_t* Bt = p.w2T + (size_t)(l * NE + e) * D * D + (size_t)(pn * 128) * D;
        f32x4 acc[4][4]; gm::zero_acc(acc);
        gm::kloop(lds, a0 + (size_t)s.R0 * D + s.C0, a0 + (size_t)s.R1 * D + s.C1, a0 + (size_t)(128 + s.R0) * D + s.C0, a0 + (size_t)(128 + s.R1) * D + s.C1,
                  Bt + (size_t)s.R0 * D + s.C0, Bt + (size_t)s.R1 * D + s.C1, D, acc);
        const float* b2 = p.moe_b2 + (size_t)(l * NE + e) * D;
#pragma unroll
        for (int m = 0; m < 4; ++m)
#pragma unroll
            for (int n = 0; n < 4; ++n) {
                const int row = mt * 256 + wr * 64 + m * 16 + fr, col = pn * 128 + wc * 64 + n * 16 + fq * 4;
                const float4 bb = *(const float4*)(b2 + col);
                u32x2 o; o[0] = pack2(acc[m][n][0] + bb.x, acc[m][n][1] + bb.y); o[1] = pack2(acc[m][n][2] + bb.z, acc[m][n][3] + bb.w);
                *(u32x2*)(p.yp + (size_t)row * D + col) = o;
            }
    }
}

__device__ __forceinline__ void ph_combine(const Params& p, int l, int M, LAS unsigned char* lds) {
    LAS int* ts = (LAS int*)lds; LAS int* cn = ts + 40;
    build_expert_tables(p, l, ts, cn);
    const int tid = threadIdx.x, wid = tid >> 6, lane = tid & 63;
    const bool last = (l == 1);
    for (int tok = blockIdx.x * NWAVES + wid; tok < M; tok += gridDim.x * NWAVES) {
        float4 v[4];
        const float* mb = p.mod + (size_t)(l * 5 + tok_modrow(tok)) * (NMOD * D);
        int rows[4]; float wts[4];
#pragma unroll
        for (int k = 0; k < 4; ++k) { const int tsl = p.tokslot[(size_t)tok * 4 + k]; rows[k] = ts[tsl >> 16] * 256 + (tsl & 0xffff); wts[k] = p.topw[(size_t)tok * 4 + k]; }
        float ss = 0.f;
#pragma unroll
        for (int i = 0; i < 4; ++i) {
            const int cidx = i * 256 + lane * 4;
            float m0 = 0.f, m1 = 0.f, m2 = 0.f, m3 = 0.f;
#pragma unroll
            for (int k = 0; k < 4; ++k) {
                const u32x2 u = *(const u32x2*)(p.yp + (size_t)rows[k] * D + cidx);
                m0 += wts[k] * bflo(u[0]); m1 += wts[k] * bfhi(u[0]); m2 += wts[k] * bflo(u[1]); m3 += wts[k] * bfhi(u[1]);
            }
            const float4 gt = *(const float4*)(mb + 5 * D + cidx);
            float4 xv = *(const float4*)(p.xl + (size_t)tok * D + cidx);
            xv.x += gt.x * m0; xv.y += gt.y * m1; xv.z += gt.z * m2; xv.w += gt.w * m3;
            v[i] = xv; ss += xv.x * xv.x + xv.y * xv.y + xv.z * xv.z + xv.w * xv.w;
        }
        ss = wave_sum(ss);
        const float rinv = rsqrtf(ss * (1.0f / D) + 1e-6f);
        if (!last) {
#pragma unroll
            for (int i = 0; i < 4; ++i) *(float4*)(p.xl + (size_t)tok * D + i * 256 + lane * 4) = v[i];
            const float* mb1 = p.mod + (size_t)((l + 1) * 5 + tok_modrow(tok)) * (NMOD * D);
            norm_mod_store(v, rinv, p.norm1_g + (l + 1) * D, mb1 + 1 * D, mb1 + 0 * D, p.H + (size_t)tok * D, lane);
        } else {
#pragma unroll
            for (int i = 0; i < 4; ++i) {
                const int cidx = i * 256 + lane * 4;
                const float4 gv = *(const float4*)(p.final_norm_g + cidx);
                *(float4*)(p.out + (size_t)tok * D + cidx) = make_float4(v[i].x * rinv * gv.x, v[i].y * rinv * gv.y, v[i].z * rinv * gv.z, v[i].w * rinv * gv.w);
            }
        }
    }
}

extern __shared__ __attribute__((aligned(16))) unsigned char dyn_lds[];
#define KPH(name, call) __global__ void __launch_bounds__(NTHREADS, 2) name(Params p, int l, int M) { LAS unsigned char* lds = (LAS unsigned char*)dyn_lds; (void)l; (void)M; (void)lds; call; }
KPH(k_convert, { ph_convert(p, lds); })
KPH(k_mod, { ph_mod(p, lds); })
KPH(k_norm1, { ph_norm1_first(p); })
KPH(k_g1, { ph_g1(p, l, lds); })
KPH(k_prep, { ph_prep(p, l, lds); })
KPH(k_scan, { ph_scan(p, lds); })
KPH(k_merge, { ph_merge(p, l, M); })
KPH(k_g2, { ph_g2(p, l, M, lds); })
KPH(k_g3, { ph_g3(p, l, M, lds); })
KPH(k_route, { ph_route(p, l, M, lds); })
KPH(k_g4, { ph_g4(p, l, lds); })
KPH(k_g5, { ph_g5(p, l, lds); })
KPH(k_combine, { ph_combine(p, l, M, lds); })

static inline size_t align_up(size_t v, size_t a) { return (v + a - 1) / a * a; }

extern "C" void kernel_launch(void* const* d_in, const int* in_sizes, int n_in, void* d_out, int out_size, void* d_ws, size_t ws_size, hipStream_t stream) {
    (void)in_sizes; (void)n_in; (void)out_size;
    Params p{};
    const float** pf = (const float**)&p;
    for (int i = 0; i < 32; ++i) pf[i] = (const float*)d_in[i];
    p.out = (float*)d_out;
    unsigned char* w = (unsigned char*)d_ws; size_t off = 0;
    auto take = [&](size_t bytes) { void* r = w + off; off = align_up(off + bytes, 256); return r; };
    p.bar = (unsigned*)take(16384);
    p.cnt = (int*)take(1024);
    const size_t ctl_bytes = off;
    p.mod = (float*)take((size_t)2 * 5 * NMOD * D * 4);
    p.winT = (bf16_t*)take((size_t)2 * NP * D * 2);
    p.wbT = (bf16_t*)take((size_t)2 * 4 * D * MW * 2);
    p.woutT = (bf16_t*)take((size_t)2 * D * D * 2);
    p.w1T = (bf16_t*)take((size_t)2 * NE * 2 * D * D * 2);
    p.w2T = (bf16_t*)take((size_t)2 * NE * D * D * 2);
    p.xl = (float*)take((size_t)NTOK * D * 4);
    p.H = (bf16_t*)take((size_t)NTOK * D * 2);
    p.P = (bf16_t*)take((size_t)NTOK * NP * 2);
    p.act = p.P; p.yp = p.P + (size_t)CAPROWS * D;
    p.prep = (float*)take(16 * TOKW * 4);
    p.gg = (float*)take((size_t)NTOK * 8 * 4);
    p.gb = (float*)take((size_t)NTOK * 8 * 4);
    p.O = (float*)take(8 * TOKW * 4);
    p.Y = (bf16_t*)take(4 * TOKW * 2);
    p.mix = (bf16_t*)take((size_t)NTOK * D * 2);
    p.F = p.H;
    p.list = (int*)take((size_t)NE * NTOK * 4);
    p.tokslot = (int*)take((size_t)NTOK * 4 * 4);
    p.topw = (float*)take((size_t)NTOK * 4 * 4);
    if (off > ws_size) { fprintf(stderr, "workspace too small: need %zu have %zu\n", off, ws_size); return; }

    static int grid = 0;
    if (!grid) {
        int dev = 0, cus = 0; hipGetDevice(&dev); hipDeviceGetAttribute(&cus, hipDeviceAttributeMultiprocessorCount, dev);
        grid = cus > 0 ? cus : 256;
        const void* ks[] = {(const void*)k_convert, (const void*)k_mod, (const void*)k_norm1, (const void*)k_g1, (const void*)k_prep, (const void*)k_scan, (const void*)k_merge,
                            (const void*)k_g2, (const void*)k_g3, (const void*)k_route, (const void*)k_g4, (const void*)k_g5, (const void*)k_combine};
        for (const void* k : ks) hipFuncSetAttribute(k, hipFuncAttributeMaxDynamicSharedMemorySize, LDS_BYTES);
    }
    hipMemsetAsync(d_ws, 0, ctl_bytes, stream);
#define LAUNCH(k, l, M) hipLaunchKernelGGL(k, dim3(grid), dim3(NTHREADS), LDS_BYTES, stream, p, l, M)
    LAUNCH(k_convert, 0, 0);
    LAUNCH(k_mod, 0, 0);
    LAUNCH(k_norm1, 0, 0);
    for (int l = 0; l < 2; ++l) {
        const int M = l == 0 ? NTOK : NLAT;
        LAUNCH(k_g1, l, M);
        LAUNCH(k_prep, l, M);
        LAUNCH(k_scan, l, M);
        LAUNCH(k_merge, l, M);
        LAUNCH(k_g2, l, M);
        LAUNCH(k_g3, l, M);
        LAUNCH(k_route, l, M);
        LAUNCH(k_g4, l, M);
        LAUNCH(k_g5, l, M);
        LAUNCH(k_combine, l, M);
    }
}
```

```cpp
#include <hip/hip_runtime.h>
#include <stdint.h>
#include <stdio.h>

#define LAS __attribute__((address_space(3)))
typedef unsigned short bf16_t;
typedef short bf16x8 __attribute__((ext_vector_type(8)));
typedef float f32x4 __attribute__((ext_vector_type(4)));
typedef float f32x2 __attribute__((ext_vector_type(2)));
typedef unsigned u32x2 __attribute__((ext_vector_type(2)));
typedef unsigned u32x4 __attribute__((ext_vector_type(4)));

#ifndef MEGA
#define MEGA 1
#endif

constexpr int D = 1024, NB = 4, TL = 4096, TC = 256, NLAT = NB * TL, NCTX = NB * TC, NTOK = NLAT + NCTX;
constexpr int NIN = 11792, NP = 12032, MW = 512, NE = 32, TOPK = 4, NMOD = 6;
constexpr int C_GQKV = 0, C_GZ = 1536, C_GA = 2048, C_GB = 2056, C_HQ = 2064, C_HI = 2576, C_HF = 3088, C_HG = 4112, C_LX = 4624,
              C_LY = 5136, C_RQKV = 5648, C_RG = 7184, C_MG = 7696;
constexpr int NTHREADS = 512, NWAVES = 8;
constexpr int LDS_BYTES = 140 * 1024;
constexpr int CAPROWS = 77824;
constexpr size_t TOKW = (size_t)NTOK * MW;

struct Params {
    const float *x, *c, *ctx, *c_ctx, *w_mod, *b_mod, *norm1_g, *norm2_g, *w_in, *gdn_conv_w, *gdn_a_log, *gdn_dt_bias, *gdn_norm_g, *hgrn_lb,
        *hgrn_norm_g, *lru_conv_w, *lru_conv_b, *lru_wa, *lru_ba, *lru_wx, *lru_bx, *lru_lambda, *ret_norm_g, *w_branch, *w_out, *router_w,
        *router_b, *moe_w1, *moe_b1, *moe_w2, *moe_b2, *final_norm_g;
    float* out;
    unsigned* bar; int* cnt; float* mod;
    bf16_t *winT, *wbT, *woutT, *w1T, *w2T;
    float* xl; bf16_t* H; bf16_t* P; float* prep; float* gg; float* gb; float* O; bf16_t* Y; bf16_t* mix; bf16_t* F;
    int* list; int* tokslot; float* topw; bf16_t* act; bf16_t* yp;
};

__device__ __forceinline__ unsigned f2bf(float f) { unsigned u = __float_as_uint(f); u += 0x7fffu + ((u >> 16) & 1u); return u >> 16; }
__device__ __forceinline__ unsigned pack2(float a, float b) { return f2bf(a) | (f2bf(b) << 16); }
__device__ __forceinline__ float bf2f(bf16_t b) { return __uint_as_float(((unsigned)b) << 16); }
__device__ __forceinline__ float bflo(unsigned u) { return __uint_as_float(u << 16); }
__device__ __forceinline__ float bfhi(unsigned u) { return __uint_as_float(u & 0xffff0000u); }
__device__ __forceinline__ float sigmoidf_(float x) { return 1.0f / (1.0f + __expf(-x)); }
__device__ __forceinline__ float siluf_(float x) { return x * sigmoidf_(x); }
__device__ __forceinline__ float softplusf_(float x) { return x > 20.f ? x : log1pf(__expf(x)); }
__device__ __forceinline__ float logsigmoidf_(float x) { return -softplusf_(-x); }
__device__ __forceinline__ float gelu_tanhf_(float x) { const float u = 0.7978845608028654f * (x + 0.044715f * x * x * x); return 0.5f * x * (1.0f + tanhf(u)); }
__device__ __forceinline__ float wave_sum(float v) {
#pragma unroll
    for (int m = 32; m >= 1; m >>= 1) v += __shfl_xor(v, m);
    return v;
}
__device__ __forceinline__ int opaque_tid() { int t = threadIdx.x; asm volatile("" : "+v"(t)); return t; }
__device__ __forceinline__ int tok_modrow(int tok) { return tok < NLAT ? (tok >> 12) : 4; }
__device__ __forceinline__ void tok_info(int tok, int& t, int& T, int& base) {
    if (tok < NLAT) { t = tok & (TL - 1); T = TL; base = tok - t; }
    else { t = (tok - NLAT) & (TC - 1); T = TC; base = tok - t; }
}

namespace gm {
constexpr int HT = 16384;
__device__ __forceinline__ int lds_byte(int r, int c) { const int st = (r >> 4) * 2 + (c >> 5), rr = r & 15, cc = c & 31, ob = rr * 64 + cc * 2; return st * 1024 + (ob ^ (((ob >> 9) & 1) << 5)); }
__device__ __forceinline__ void stage_rc(int b, int& R, int& C) { const int st = b / 1024, sb = b % 1024, swz = sb ^ (((sb >> 9) & 1) << 5); R = (st >> 1) * 16 + swz / 64; C = (st & 1) * 32 + (swz % 64) / 2; }

__device__ __forceinline__ void kloop(LAS unsigned char* lds, const bf16_t* ap00, const bf16_t* ap01, const bf16_t* ap10, const bf16_t* ap11,
                                      const bf16_t* bp0, const bf16_t* bp1, int K, f32x4 (&acc)[4][4]) {
    const int tid = opaque_tid(), wid = __builtin_amdgcn_readfirstlane(tid >> 6), lane = tid & 63, wr = wid >> 1, wc = wid & 1, fr = lane & 15, fq = lane >> 4;
    const unsigned ldsw = (unsigned)wid * 1024u;
    const int aoff = (wr >> 1) * HT + lds_byte((wr & 1) * 64 + fr, fq * 8);
    const int boff = 2 * HT + lds_byte(wc * 64 + fr, fq * 8);
    const int nt = K / 64;
#define GM_GLDS(src, dstoff) __builtin_amdgcn_global_load_lds((const unsigned*)(src), (LAS unsigned*)(lds + (dstoff)), 16, 0, 0)
#define GM_STAGE(buf, kt) do { const int _bo = (buf) * 3 * HT + ldsw; const int _ko = (kt) * 64; \
        GM_GLDS(ap00 + _ko, _bo); GM_GLDS(ap01 + _ko, _bo + 8192); GM_GLDS(ap10 + _ko, _bo + HT); GM_GLDS(ap11 + _ko, _bo + HT + 8192); \
        GM_GLDS(bp0 + _ko, _bo + 2 * HT); GM_GLDS(bp1 + _ko, _bo + 2 * HT + 8192); } while (0)
    GM_STAGE(0, 0);
    for (int t = 0; t < nt; ++t) {
        const int cur = t & 1;
        if (t + 1 < nt) { GM_STAGE(cur ^ 1, t + 1); asm volatile("s_waitcnt vmcnt(6)" ::: "memory"); }
        else asm volatile("s_waitcnt vmcnt(0)" ::: "memory");
        __builtin_amdgcn_s_barrier(); asm volatile("" ::: "memory");
        bf16x8 af[4][2], bfr[4][2];
#pragma unroll
        for (int m = 0; m < 4; ++m)
#pragma unroll
            for (int k = 0; k < 2; ++k) af[m][k] = *(const LAS bf16x8*)(lds + cur * 3 * HT + aoff + m * 2048 + k * 1024);
#pragma unroll
        for (int n = 0; n < 4; ++n)
#pragma unroll
            for (int k = 0; k < 2; ++k) bfr[n][k] = *(const LAS bf16x8*)(lds + cur * 3 * HT + boff + n * 2048 + k * 1024);
#pragma unroll
        for (int k = 0; k < 2; ++k)
#pragma unroll
            for (int m = 0; m < 4; ++m)
#pragma unroll
                for (int n = 0; n < 4; ++n) acc[m][n] = __builtin_amdgcn_mfma_f32_16x16x32_bf16(bfr[n][k], af[m][k], acc[m][n], 0, 0, 0);
        asm volatile("s_waitcnt lgkmcnt(0)" ::: "memory");
        __builtin_amdgcn_s_barrier(); asm volatile("" ::: "memory");
    }
#undef GM_STAGE
#undef GM_GLDS
}
__device__ __forceinline__ void zero_acc(f32x4 (&acc)[4][4]) {
#pragma unroll
    for (int m = 0; m < 4; ++m)
#pragma unroll
        for (int n = 0; n < 4; ++n) acc[m][n] = (f32x4){0.f, 0.f, 0.f, 0.f};
}
}

struct StageRC { int R0, C0, R1, C1; };
__device__ __forceinline__ StageRC my_stage_rc() { const int t = opaque_tid(); StageRC s; gm::stage_rc(t * 16, s.R0, s.C0); gm::stage_rc(t * 16 + 8192, s.R1, s.C1); return s; }

__device__ __forceinline__ int w1_dst_row(int n) { const int half = n >> 10, cc = n & 1023; return (cc >> 6) * 128 + ((cc >> 5) & 1) * 64 + half * 32 + (cc & 31); }

__device__ __forceinline__ void cvt_tile(LAS float* tile, const float* src, int ldsrc, int Nsrc, int k0, int n0, bf16_t* dst, int K, int mode) {
    const int tid = opaque_tid();
    {
        const int rr = tid >> 6, cc = tid & 63, n = n0 + cc;
#pragma unroll
        for (int i = 0; i < 8; ++i) { const int k = rr + i * 8; tile[k * 65 + cc] = (n < Nsrc) ? src[(size_t)(k0 + k) * ldsrc + n] : 0.f; }
    }
    __syncthreads();
    {
        const int nl = tid >> 3, kg = tid & 7, n = n0 + nl;
        float v[8];
#pragma unroll
        for (int j = 0; j < 8; ++j) v[j] = tile[(kg * 8 + j) * 65 + nl];
        const int drow = mode == 1 ? w1_dst_row(n) : n;
        u32x4 o; o[0] = pack2(v[0], v[1]); o[1] = pack2(v[2], v[3]); o[2] = pack2(v[4], v[5]); o[3] = pack2(v[6], v[7]);
        *(u32x4*)(dst + (size_t)drow * K + k0 + kg * 8) = o;
    }
    __syncthreads();
}

__device__ __forceinline__ void ph_convert(const Params& p, LAS unsigned char* lds) {
    LAS float* tile = (LAS float*)lds;
    constexpr int PER_L = 3008 + 512 + 256 + 16384 + 8192;
    for (int it = blockIdx.x; it < 2 * PER_L; it += gridDim.x) {
        const int l = it / PER_L; int r = it % PER_L;
        if (r < 3008) { const int nt = r % 188, kt = r / 188; cvt_tile(tile, p.w_in + (size_t)l * D * NIN, NIN, NIN, kt * 64, nt * 64, p.winT + (size_t)l * NP * D, D, 0); }
        else if (r < 3520) { r -= 3008; const int n = r / 128; r %= 128; const int nt = r % 16, kt = r / 16;
            cvt_tile(tile, p.w_branch + (size_t)(l * 4 + n) * MW * D, D, D, kt * 64, nt * 64, p.wbT + (size_t)(l * 4 + n) * D * MW, MW, 0); }
        else if (r < 3776) { r -= 3520; const int nt = r % 16, kt = r / 16; cvt_tile(tile, p.w_out + (size_t)l * D * D, D, D, kt * 64, nt * 64, p.woutT + (size_t)l * D * D, D, 0); }
        else if (r < 3776 + 16384) { r -= 3776; const int e = r / 512; r %= 512; const int nt = r % 32, kt = r / 32;
            cvt_tile(tile, p.moe_w1 + (size_t)(l * NE + e) * D * 2 * D, 2 * D, 2 * D, kt * 64, nt * 64, p.w1T + (size_t)(l * NE + e) * 2 * D * D, D, 1); }
        else { r -= 3776 + 16384; const int e = r / 256; r %= 256; const int nt = r % 16, kt = r / 16;
            cvt_tile(tile, p.moe_w2 + (size_t)(l * NE + e) * D * D, D, D, kt * 64, nt * 64, p.w2T + (size_t)(l * NE + e) * D * D, D, 0); }
    }
}

__device__ __forceinline__ void ph_mod(const Params& p, LAS unsigned char* lds) {
    LAS float* sc = (LAS float*)lds;
    LAS float* red = sc + 5 * D;
    const int tid = opaque_tid(), wid = tid >> 6, lane = tid & 63;
    if ((int)blockIdx.x >= 192) return;
    for (int i = tid; i < 5 * D; i += NTHREADS) { const int r = i >> 10, k = i & 1023; const float v = r < 4 ? p.c[r * D + k] : p.c_ctx[k]; sc[i] = siluf_(v); }
    __syncthreads();
    for (int it = blockIdx.x; it < 192; it += gridDim.x) {
        const int l = it / 96, n0 = (it % 96) * 64;
        float acc[5] = {0.f, 0.f, 0.f, 0.f, 0.f};
        const float* wp = p.w_mod + (size_t)l * D * (NMOD * D) + n0 + lane;
        for (int k = wid * 128; k < wid * 128 + 128; ++k) {
            const float wv = wp[(size_t)k * (NMOD * D)];
#pragma unroll
            for (int r = 0; r < 5; ++r) acc[r] += sc[r * D + k] * wv;
        }
#pragma unroll
        for (int r = 0; r < 5; ++r) red[(wid * 5 + r) * 64 + lane] = acc[r];
        __syncthreads();
        if (tid < 320) { const int r = tid >> 6, cidx = tid & 63; float s = p.b_mod[l * NMOD * D + n0 + cidx];
#pragma unroll
            for (int w = 0; w < 8; ++w) s += red[(w * 5 + r) * 64 + cidx];
            p.mod[(size_t)(l * 5 + r) * (NMOD * D) + n0 + cidx] = s; }
        __syncthreads();
    }
}

__device__ __forceinline__ void norm_mod_store(const float4 (&v)[4], float rinv, const float* g, const float* scp, const float* shp, bf16_t* dst, int lane) {
#pragma unroll
    for (int i = 0; i < 4; ++i) {
        const int cidx = i * 256 + lane * 4;
        const float4 gv = *(const float4*)(g + cidx), sv = *(const float4*)(scp + cidx), hv = *(const float4*)(shp + cidx);
        const float h0 = v[i].x * rinv * gv.x * (1.f + sv.x) + hv.x, h1 = v[i].y * rinv * gv.y * (1.f + sv.y) + hv.y;
        const float h2 = v[i].z * rinv * gv.z * (1.f + sv.z) + hv.z, h3 = v[i].w * rinv * gv.w * (1.f + sv.w) + hv.w;
        u32x2 o; o[0] = pack2(h0, h1); o[1] = pack2(h2, h3);
        *(u32x2*)(dst + cidx) = o;
    }
}
__device__ __forceinline__ void ph_norm1_first(const Params& p) {
    const int tid = opaque_tid(), wid = tid >> 6, lane = tid & 63;
    for (int tok = blockIdx.x * NWAVES + wid; tok < NTOK; tok += gridDim.x * NWAVES) {
        const float* src = tok < NLAT ? p.x + (size_t)tok * D : p.ctx + (size_t)(tok - NLAT) * D;
        float4 v[4]; float ss = 0.f;
#pragma unroll
        for (int i = 0; i < 4; ++i) { v[i] = *(const float4*)(src + i * 256 + lane * 4); ss += v[i].x * v[i].x + v[i].y * v[i].y + v[i].z * v[i].z + v[i].w * v[i].w; }
        ss = wave_sum(ss);
        const float rinv = rsqrtf(ss * (1.0f / D) + 1e-6f);
        const float* mb = p.mod + (size_t)(0 * 5 + tok_modrow(tok)) * (NMOD * D);
        norm_mod_store(v, rinv, p.norm1_g, mb + 1 * D, mb + 0 * D, p.H + (size_t)tok * D, lane);
#pragma unroll
        for (int i = 0; i < 4; ++i) *(float4*)(p.xl + (size_t)tok * D + i * 256 + lane * 4) = v[i];
    }
}

__device__ __forceinline__ void ph_g1(const Params& p, int l, LAS unsigned char* lds) {
    const StageRC s = my_stage_rc();
    const int tid = opaque_tid(), wid = tid >> 6, lane = tid & 63, wr = wid >> 1, wc = wid & 1, fr = lane & 15, fq = lane >> 4;
    const bf16_t* Bt = p.winT + (size_t)l * NP * D;
    constexpr int NTN = 93, NTM = NTOK / 256;
    for (int u = blockIdx.x; u < NTM * NTN; u += gridDim.x) {
        const int pm = u / NTN, pn = u % NTN;
        const bf16_t* a0 = p.H + (size_t)(pm * 256) * D;
        f32x4 acc[4][4]; gm::zero_acc(acc);
        gm::kloop(lds, a0 + (size_t)s.R0 * D + s.C0, a0 + (size_t)s.R1 * D + s.C1, a0 + (size_t)(128 + s.R0) * D + s.C0, a0 + (size_t)(128 + s.R1) * D + s.C1,
                  Bt + (size_t)(pn * 128 + s.R0) * D + s.C0, Bt + (size_t)(pn * 128 + s.R1) * D + s.C1, D, acc);
#pragma unroll
        for (int m = 0; m < 4; ++m)
#pragma unroll
            for (int n = 0; n < 4; ++n) {
                const int row = pm * 256 + wr * 64 + m * 16 + fr, col = pn * 128 + wc * 64 + n * 16 + fq * 4;
                u32x2 o; o[0] = pack2(acc[m][n][0], acc[m][n][1]); o[1] = pack2(acc[m][n][2], acc[m][n][3]);
                *(u32x2*)(p.P + (size_t)row * NP + col) = o;
            }
    }
}

__device__ __forceinline__ void ph_prep(const Params& p, int l, LAS unsigned char* lds) {
    const int tid = opaque_tid(), wid = tid >> 6, lane = tid & 63;
    const int gw = blockIdx.x * NWAVES + wid, nw = gridDim.x * NWAVES;
    for (int id = gw; id < NTOK * 12; id += nw) {
        const int tok = id / 12, r = id % 12, part = r >> 2, head = r & 3;
        int t, T, base; tok_info(tok, t, T, base);
        const int cidx = part * 512 + head * 128 + lane * 2;
        float a0 = 0.f, a1 = 0.f;
#pragma unroll
        for (int j = 0; j < 4; ++j) {
            const int tt = t + j - 2;
            if (tt >= 0 && tt < T) {
                const unsigned u = *(const unsigned*)(p.P + (size_t)(base + tt) * NP + C_GQKV + cidx);
                const f32x2 w = *(const f32x2*)(p.gdn_conv_w + (size_t)(l * 4 + j) * 1536 + cidx);
                a0 += w[0] * bflo(u); a1 += w[1] * bfhi(u);
            }
        }
        a0 = siluf_(a0); a1 = siluf_(a1);
        if (part < 2) {
            const float ss = wave_sum(a0 * a0 + a1 * a1);
            const float sc = rsqrtf(ss + 1e-6f) * (part == 0 ? 0.08838834764831845f : 1.0f);
            a0 *= sc; a1 *= sc;
        }
        f32x2 o; o[0] = a0; o[1] = a1;
        *(f32x2*)(p.prep + part * TOKW + (size_t)tok * MW + head * 128 + lane * 2) = o;
        if (r == 0 && lane < 16) {
            const int idx = lane & 7;
            if (lane < 8) { const float a = bf2f(p.P[(size_t)tok * NP + C_GA + idx]);
                p.gg[(size_t)tok * 8 + idx] = -__expf(p.gdn_a_log[l * 8 + idx]) * softplusf_(a + p.gdn_dt_bias[l * 8 + idx]); }
            else { const float bt = bf2f(p.P[(size_t)tok * NP + C_GB + idx]); p.gb[(size_t)tok * 8 + idx] = sigmoidf_(bt); }
        }
    }
    for (int id = gw; id < NTOK * 4; id += nw) {
        const int tok = id >> 2, head = id & 3;
        const int cidx = head * 128 + lane * 2;
        const bf16_t* pr = p.P + (size_t)tok * NP;
        const unsigned uq = *(const unsigned*)(pr + C_HQ + cidx), ui = *(const unsigned*)(pr + C_HI + cidx);
        f32x2 o;
        o[0] = siluf_(bflo(uq)) * 0.08838834764831845f; o[1] = siluf_(bfhi(uq)) * 0.08838834764831845f;
        *(f32x2*)(p.prep + 3 * TOKW + (size_t)tok * MW + cidx) = o;
        o[0] = bflo(ui); o[1] = bfhi(ui);
        *(f32x2*)(p.prep + 4 * TOKW + (size_t)tok * MW + cidx) = o;
#pragma unroll
        for (int d = 0; d < 2; ++d) {
            const unsigned uf = *(const unsigned*)(pr + C_HF + d * 512 + cidx);
            float lb0 = 0.f, lb1 = 0.f;
            if (l == 1) {
                const f32x2 x0 = *(const f32x2*)(p.hgrn_lb + (size_t)(0 * 2 + d) * MW + cidx), x1 = *(const f32x2*)(p.hgrn_lb + (size_t)(1 * 2 + d) * MW + cidx);
                lb0 = fminf(1.0f / (1.0f + __expf(x0[0] - x1[0])), 1.0f - 1e-4f); lb1 = fminf(1.0f / (1.0f + __expf(x0[1] - x1[1])), 1.0f - 1e-4f);
            }
            const float z0 = bflo(uf), z1 = bfhi(uf);
            const float f0 = lb0 + (1.f - lb0) * sigmoidf_(z0), f1 = lb1 + (1.f - lb1) * sigmoidf_(z1);
            f32x2 k; k[0] = (1.f - lb0) * sigmoidf_(-z0); k[1] = (1.f - lb1) * sigmoidf_(-z1);
            *(f32x2*)(p.prep + (5 + d) * TOKW + (size_t)tok * MW + cidx) = k;
            f32x2 lf; lf[0] = __logf(fmaxf(f0, 1e-30f)); lf[1] = __logf(fmaxf(f1, 1e-30f));
            *(f32x2*)(p.prep + (7 + d) * TOKW + (size_t)tok * MW + cidx) = lf;
        }
    }
    for (int id = gw; id < NTOK * 4; id += nw) {
        const int tok = id >> 2, head = id & 3;
        const bf16_t* pr = p.P + (size_t)tok * NP + C_RQKV + head * 128;
        float q1 = bf2f(pr[lane]), q2 = bf2f(pr[64 + lane]), k1 = bf2f(pr[512 + lane]), k2 = bf2f(pr[512 + 64 + lane]);
        const float v1 = bf2f(pr[1024 + lane]), v2 = bf2f(pr[1024 + 64 + lane]);
        if (tok < NLAT) {
            const int t = tok & (TL - 1);
            const float pos = (lane < 32) ? (float)(t >> 6) : (float)(t & 63);
            const float inv = exp2f(-(float)(lane & 31) * (13.287712379549449f / 32.0f));
            const float ang = pos * inv;
            float sn, cs; sincosf(ang, &sn, &cs);
            const float nq1 = q1 * cs - q2 * sn, nq2 = q1 * sn + q2 * cs, nk1 = k1 * cs - k2 * sn, nk2 = k1 * sn + k2 * cs;
            q1 = nq1; q2 = nq2; k1 = nk1; k2 = nk2;
        }
        k1 *= 0.08838834764831845f; k2 *= 0.08838834764831845f;
        const size_t o = (size_t)tok * MW + head * 128;
        p.prep[9 * TOKW + o + lane] = q1; p.prep[9 * TOKW + o + 64 + lane] = q2;
        p.prep[10 * TOKW + o + lane] = k1; p.prep[10 * TOKW + o + 64 + lane] = k2;
        p.prep[11 * TOKW + o + lane] = v1; p.prep[11 * TOKW + o + 64 + lane] = v2;
    }
    {
        LAS float* xs = (LAS float*)lds;
        LAS float* wsm = xs + 64 * 65;
        for (int it = blockIdx.x; it < (NTOK / 64) * 8; it += gridDim.x) {
            const int tile = it >> 3, n = it & 7, tok0 = tile * 64;
            {
                const int tl = tid & 63, cg = tid >> 6, tok = tok0 + tl;
                int t, T, base; tok_info(tok, t, T, base);
                float a[8];
#pragma unroll
                for (int j = 0; j < 8; ++j) a[j] = p.lru_conv_b[l * MW + n * 64 + cg * 8 + j];
#pragma unroll
                for (int j = 0; j < 4; ++j) {
                    const int tt = t + j - 2;
                    if (tt >= 0 && tt < T) {
                        const u32x4 u = *(const u32x4*)(p.P + (size_t)(base + tt) * NP + C_LX + n * 64 + cg * 8);
                        const float* w = p.lru_conv_w + (size_t)(l * 4 + j) * MW + n * 64 + cg * 8;
#pragma unroll
                        for (int q = 0; q < 4; ++q) { a[2 * q] += w[2 * q] * bflo(u[q]); a[2 * q + 1] += w[2 * q + 1] * bfhi(u[q]); }
                    }
                }
#pragma unroll
                for (int j = 0; j < 8; ++j) xs[tl * 65 + cg * 8 + j] = a[j];
                for (int i = tid; i < 4 * 1024; i += NTHREADS) {
                    const int mat = i >> 10, off = (i & 1023) * 4, d = mat >> 1;
                    const float* srcw = ((mat & 1) ? p.lru_wx : p.lru_wa) + (size_t)((l * 2 + d) * 8 + n) * 4096 + off;
                    const float4 v = *(const float4*)srcw;
                    LAS float* dw = wsm + mat * 4096 + off; dw[0] = v.x; dw[1] = v.y; dw[2] = v.z; dw[3] = v.w;
                }
            }
            __syncthreads();
            {
                const int tl = tid & 63, jg = tid >> 6, tok = tok0 + tl;
                float acc[4][8];
#pragma unroll
                for (int m = 0; m < 4; ++m)
#pragma unroll
                    for (int j = 0; j < 8; ++j) acc[m][j] = 0.f;
                for (int i = 0; i < 64; ++i) {
                    const float xv = xs[tl * 65 + i];
#pragma unroll
                    for (int m = 0; m < 4; ++m)
#pragma unroll
                        for (int j = 0; j < 8; ++j) acc[m][j] += xv * wsm[m * 4096 + i * 64 + jg * 8 + j];
                }
#pragma unroll
                for (int d = 0; d < 2; ++d) {
                    float av[8], uv[8];
#pragma unroll
                    for (int j = 0; j < 8; ++j) {
                        const int cidx = n * 64 + jg * 8 + j, pi = (l * 2 + d) * MW + cidx;
                        const float gr = sigmoidf_(acc[d * 2][j] + p.lru_ba[pi]), gi = sigmoidf_(acc[d * 2 + 1][j] + p.lru_bx[pi]);
                        const float la = 8.0f * gr * logsigmoidf_(p.lru_lambda[pi]);
                        av[j] = __expf(la);
                        uv[j] = xs[tl * 65 + jg * 8 + j] * gi * sqrtf(fmaxf(-expm1f(2.0f * la), 1e-12f));
                    }
                    float* da = p.prep + (12 + d) * TOKW + (size_t)tok * MW + n * 64 + jg * 8;
                    float* du = p.prep + (14 + d) * TOKW + (size_t)tok * MW + n * 64 + jg * 8;
                    *(float4*)da = make_float4(av[0], av[1], av[2], av[3]); *(float4*)(da + 4) = make_float4(av[4], av[5], av[6], av[7]);
                    *(float4*)du = make_float4(uv[0], uv[1], uv[2], uv[3]); *(float4*)(du + 4) = make_float4(uv[4], uv[5], uv[6], uv[7]);
                }
            }
            __syncthreads();
        }
    }
}

__device__ __forceinline__ void scan_matrix(const Params& p, int ty, int b, int h, int d, LAS unsigned char* lds) {
    LAS float* sq = (LAS float*)lds;
    LAS float* sk = sq + 32 * 128;
    LAS float* sv = sk + 32 * 128;
    LAS float* sf = sv + 32 * 128;
    LAS float* sdec = sf + 32 * 128;
    LAS float* sbeta = sdec + 32;
    LAS float* red = sbeta + 32;
    const int tid = opaque_tid(), j = tid & 127, g = tid >> 7;
    const float* Q = p.prep + (ty == 0 ? 0 : ty == 1 ? 3 : 9) * TOKW;
    const float* Kp = p.prep + (ty == 0 ? 1 : ty == 1 ? (5 + d) : 10) * TOKW;
    const float* V = p.prep + (ty == 0 ? 2 : ty == 1 ? 4 : 11) * TOKW;
    const float* LF = p.prep + (7 + d) * TOKW;
    float* Op = p.O + (size_t)((ty == 0 ? 0 : ty == 1 ? 1 : 3) * 2 + d) * TOKW;
    const float gamma = 1.0f - exp2f(-5.0f - (float)h);
    float S[32];
#pragma unroll
    for (int i = 0; i < 32; ++i) S[i] = 0.f;
    int par = 0;
    for (int seg = 0; seg < 2; ++seg) {
        const int T = seg ? TL : TC, base = seg ? b * TL : NLAT + b * TC;
        for (int c0 = 0; c0 < T; c0 += 32) {
            __syncthreads();
            for (int idx = tid; idx < 32 * 128; idx += NTHREADS) {
                const int r = idx >> 7, jj = idx & 127, i = c0 + r, t = d ? T - 1 - i : i;
                const size_t o = (size_t)(base + t) * MW + h * 128 + jj;
                sq[idx] = Q[o]; sk[idx] = Kp[o]; sv[idx] = V[o];
                if (ty == 1) sf[idx] = __expf(LF[o]);
            }
            if (tid < 32) {
                const int i = c0 + tid, t = d ? T - 1 - i : i;
                if (ty == 0) { sdec[tid] = __expf(p.gg[(size_t)(base + t) * 8 + d * 4 + h]); sbeta[tid] = p.gb[(size_t)(base + t) * 8 + d * 4 + h]; }
                else { sdec[tid] = gamma; sbeta[tid] = 0.f; }
            }
            __syncthreads();
            for (int r = 0; r < 32; ++r) {
                const int i = c0 + r, t = d ? T - 1 - i : i;
                float kk[32], qq[32];
#pragma unroll
                for (int q4 = 0; q4 < 8; ++q4) {
                    const f32x4 kv = *(const LAS f32x4*)(sk + r * 128 + g * 32 + q4 * 4), qv = *(const LAS f32x4*)(sq + r * 128 + g * 32 + q4 * 4);
                    kk[q4 * 4] = kv[0]; kk[q4 * 4 + 1] = kv[1]; kk[q4 * 4 + 2] = kv[2]; kk[q4 * 4 + 3] = kv[3];
                    qq[q4 * 4] = qv[0]; qq[q4 * 4 + 1] = qv[1]; qq[q4 * 4 + 2] = qv[2]; qq[q4 * 4 + 3] = qv[3];
                }
                const float vj = sv[r * 128 + j];
                LAS float* r1 = red + (par * 2 + 0) * 512; LAS float* r2 = red + (par * 2 + 1) * 512;
                float po = 0.f;
                if (ty == 0) {
                    const float a = sdec[r], bt = sbeta[r];
                    float part = 0.f;
#pragma unroll
                    for (int i2 = 0; i2 < 32; ++i2) part += kk[i2] * S[i2];
                    r1[g * 128 + j] = part;
                    __syncthreads();
                    const float ks = a * (r1[j] + r1[128 + j] + r1[256 + j] + r1[384 + j]);
                    const float vn = bt * (vj - ks);
#pragma unroll
                    for (int i2 = 0; i2 < 32; ++i2) { S[i2] = a * S[i2] + kk[i2] * vn; po += qq[i2] * S[i2]; }
                } else if (ty == 1) {
#pragma unroll
                    for (int q4 = 0; q4 < 8; ++q4) {
                        const f32x4 fv = *(const LAS f32x4*)(sf + r * 128 + g * 32 + q4 * 4);
#pragma unroll
                        for (int e = 0; e < 4; ++e) { const int i2 = q4 * 4 + e; S[i2] = fv[e] * S[i2] + kk[i2] * vj; po += qq[i2] * S[i2]; }
                    }
                } else {
#pragma unroll
                    for (int i2 = 0; i2 < 32; ++i2) { S[i2] = gamma * S[i2] + kk[i2] * vj; po += qq[i2] * S[i2]; }
                }
                r2[g * 128 + j] = po;
                __syncthreads();
                if (g == 0) Op[(size_t)(base + t) * MW + h * 128 + j] = r2[j] + r2[128 + j] + r2[256 + j] + r2[384 + j];
                par ^= 1;
            }
        }
    }
}
__device__ __forceinline__ void scan_lru(const Params& p, int b, int d, int c) {
    const float* A = p.prep + (12 + d) * TOKW; const float* U = p.prep + (14 + d) * TOKW;
    float* Op = p.O + (size_t)(2 * 2 + d) * TOKW;
    float hst = 0.f;
    for (int seg = 0; seg < 2; ++seg) {
        const int T = seg ? TL : TC, base = seg ? b * TL : NLAT + b * TC;
        for (int i0 = 0; i0 < T; i0 += 8) {
            float av[8], uv[8];
#pragma unroll
            for (int q = 0; q < 8; ++q) { const int i = i0 + q, t = d ? T - 1 - i : i; const size_t o = (size_t)(base + t) * MW + c; av[q] = A[o]; uv[q] = U[o]; }
#pragma unroll
            for (int q = 0; q < 8; ++q) { const int i = i0 + q, t = d ? T - 1 - i : i; hst = av[q] * hst + uv[q]; Op[(size_t)(base + t) * MW + c] = hst; }
        }
    }
}
__device__ __forceinline__ void ph_scan(const Params& p, LAS unsigned char* lds) {
    for (int it = blockIdx.x; it < 104; it += gridDim.x) {
        if (it < 96) { const int ty = it >> 5, r = it & 31; scan_matrix(p, ty == 2 ? 3 : ty, r >> 3, (r >> 1) & 3, r & 1, lds); }
        else { const int r = it - 96; scan_lru(p, r >> 1, r & 1, opaque_tid()); }
        __syncthreads();
    }
}

__device__ __forceinline__ void ph_merge(const Params& p, int l, int M) {
    const int tid = opaque_tid(), wid = tid >> 6, lane = tid & 63;
    for (int id = blockIdx.x * NWAVES + wid; id < M * 16; id += gridDim.x * NWAVES) {
        const int tok = id >> 4, r = id & 15, m = r >> 2, head = r & 3;
        const int cidx = head * 128 + lane * 2;
        const size_t o = (size_t)tok * MW + cidx;
        const f32x2 o0 = *(const f32x2*)(p.O + (size_t)(m * 2) * TOKW + o), o1 = *(const f32x2*)(p.O + (size_t)(m * 2 + 1) * TOKW + o);
        const float a0 = o0[0] + o1[0], a1 = o0[1] + o1[1];
        float y0, y1; int nbr;
        if (m == 2) {
            const unsigned u = *(const unsigned*)(p.P + (size_t)tok * NP + C_LY + cidx);
            y0 = a0 * gelu_tanhf_(bflo(u)); y1 = a1 * gelu_tanhf_(bfhi(u)); nbr = 2;
        } else {
            const float ss = wave_sum(a0 * a0 + a1 * a1);
            const float rinv = rsqrtf(ss * (1.0f / 128.0f) + 1e-6f);
            const float* gp = (m == 0 ? p.gdn_norm_g : m == 1 ? p.hgrn_norm_g : p.ret_norm_g) + l * 128 + lane * 2;
            const int zc = m == 0 ? C_GZ : m == 1 ? C_HG : C_RG;
            const unsigned u = *(const unsigned*)(p.P + (size_t)tok * NP + zc + cidx);
            y0 = a0 * rinv * gp[0] * siluf_(bflo(u)); y1 = a1 * rinv * gp[1] * siluf_(bfhi(u)); nbr = m == 3 ? 3 : m;
        }
        *(unsigned*)(p.Y + (size_t)nbr * TOKW + o) = pack2(y0, y1);
    }
}

__device__ __forceinline__ void ph_g2(const Params& p, int l, int M, LAS unsigned char* lds) {
    const StageRC s = my_stage_rc();
    const int tid = opaque_tid(), wid = tid >> 6, lane = tid & 63, wr = wid >> 1, wc = wid & 1, fr = lane & 15, fq = lane >> 4;
    const int ntm = M / 256;
    for (int u = blockIdx.x; u < ntm * 8; u += gridDim.x) {
        const int pm = u >> 3, pn = u & 7;
        f32x4 acc[4][4]; gm::zero_acc(acc);
        for (int nb = 0; nb < 4; ++nb) {
            const bf16_t* a0 = p.Y + (size_t)nb * TOKW + (size_t)(pm * 256) * MW;
            const bf16_t* Bt = p.wbT + (size_t)(l * 4 + nb) * D * MW + (size_t)(pn * 128) * MW;
            gm::kloop(lds, a0 + (size_t)s.R0 * MW + s.C0, a0 + (size_t)s.R1 * MW + s.C1, a0 + (size_t)(128 + s.R0) * MW + s.C0, a0 + (size_t)(128 + s.R1) * MW + s.C1,
                      Bt + (size_t)s.R0 * MW + s.C0, Bt + (size_t)s.R1 * MW + s.C1, MW, acc);
#pragma unroll
            for (int m = 0; m < 4; ++m)
#pragma unroll
                for (int n = 0; n < 4; ++n) {
                    const int row = pm * 256 + wr * 64 + m * 16 + fr, col = pn * 128 + wc * 64 + n * 16 + fq * 4;
                    const bf16_t* gp = p.P + (size_t)row * NP + C_MG + nb * D + col;
                    const u32x2 gu = *(const u32x2*)gp;
                    const float e0 = __expf(-bflo(gu[0])), e1 = __expf(-bfhi(gu[0])), e2 = __expf(-bflo(gu[1])), e3 = __expf(-bfhi(gu[1]));
                    float n0 = 1.f, n1 = 1.f, n2 = 1.f, n3 = 1.f;
                    if (nb < 3) { const u32x2 gn = *(const u32x2*)(gp + D);
                        n0 = 1.f + __expf(-bflo(gn[0])); n1 = 1.f + __expf(-bfhi(gn[0])); n2 = 1.f + __expf(-bflo(gn[1])); n3 = 1.f + __expf(-bfhi(gn[1])); }
                    acc[m][n][0] *= n0 / (1.f + e0); acc[m][n][1] *= n1 / (1.f + e1); acc[m][n][2] *= n2 / (1.f + e2); acc[m][n][3] *= n3 / (1.f + e3);
                }
        }
#pragma unroll
        for (int m = 0; m < 4; ++m)
#pragma unroll
            for (int n = 0; n < 4; ++n) {
                const int row = pm * 256 + wr * 64 + m * 16 + fr, col = pn * 128 + wc * 64 + n * 16 + fq * 4;
                u32x2 o; o[0] = pack2(acc[m][n][0], acc[m][n][1]); o[1] = pack2(acc[m][n][2], acc[m][n][3]);
                *(u32x2*)(p.mix + (size_t)row * D + col) = o;
            }
    }
}

__device__ __forceinline__ void ph_g3(const Params& p, int l, int M, LAS unsigned char* lds) {
    const StageRC s = my_stage_rc();
    const int tid = opaque_tid(), wid = tid >> 6, lane = tid & 63, wr = wid >> 1, wc = wid & 1, fr = lane & 15, fq = lane >> 4;
    const int ntm = M / 256;
    for (int u = blockIdx.x; u < ntm * 8; u += gridDim.x) {
        const int pm = u >> 3, pn = u & 7;
        const bf16_t* a0 = p.mix + (size_t)(pm * 256) * D;
        const bf16_t* Bt = p.woutT + (size_t)l * D * D + (size_t)(pn * 128) * D;
        f32x4 acc[4][4]; gm::zero_acc(acc);
        gm::kloop(lds, a0 + (size_t)s.R0 * D + s.C0, a0 + (size_t)s.R1 * D + s.C1, a0 + (size_t)(128 + s.R0) * D + s.C0, a0 + (size_t)(128 + s.R1) * D + s.C1,
                  Bt + (size_t)s.R0 * D + s.C0, Bt + (size_t)s.R1 * D + s.C1, D, acc);
#pragma unroll
        for (int m = 0; m < 4; ++m)
#pragma unroll
            for (int n = 0; n < 4; ++n) {
                const int row = pm * 256 + wr * 64 + m * 16 + fr, col = pn * 128 + wc * 64 + n * 16 + fq * 4;
                const float4 gt = *(const float4*)(p.mod + (size_t)(l * 5 + tok_modrow(row)) * (NMOD * D) + 2 * D + col);
                float4* xp = (float4*)(p.xl + (size_t)row * D + col);
                float4 xv = *xp;
                xv.x += gt.x * acc[m][n][0]; xv.y += gt.y * acc[m][n][1]; xv.z += gt.z * acc[m][n][2]; xv.w += gt.w * acc[m][n][3];
                *xp = xv;
            }
    }
}

__device__ __forceinline__ void ph_route(const Params& p, int l, int M, LAS unsigned char* lds) {
    LAS float* fs = (LAS float*)lds;
    LAS float* lg = fs + 32 * 1025;
    const int tid = opaque_tid(), wid = tid >> 6, lane = tid & 63;
    const float* rw = p.router_w + (size_t)l * D * NE;
    for (int it = blockIdx.x; it < M / 32; it += gridDim.x) {
        const int tok0 = it * 32;
        for (int q = 0; q < 4; ++q) {
            const int tl = wid * 4 + q, tok = tok0 + tl;
            const float* src = p.xl + (size_t)tok * D;
            float4 v[4]; float ss = 0.f;
#pragma unroll
            for (int i = 0; i < 4; ++i) { v[i] = *(const float4*)(src + i * 256 + lane * 4); ss += v[i].x * v[i].x + v[i].y * v[i].y + v[i].z * v[i].z + v[i].w * v[i].w; }
            ss = wave_sum(ss);
            const float rinv = rsqrtf(ss * (1.0f / D) + 1e-6f);
            const float* mb = p.mod + (size_t)(l * 5 + tok_modrow(tok)) * (NMOD * D);
#pragma unroll
            for (int i = 0; i < 4; ++i) {
                const int cidx = i * 256 + lane * 4;
                const float4 gv = *(const float4*)(p.norm2_g + l * D + cidx), sv = *(const float4*)(mb + 4 * D + cidx), hv = *(const float4*)(mb + 3 * D + cidx);
                const float h0 = v[i].x * rinv * gv.x * (1.f + sv.x) + hv.x, h1 = v[i].y * rinv * gv.y * (1.f + sv.y) + hv.y;
                const float h2 = v[i].z * rinv * gv.z * (1.f + sv.z) + hv.z, h3 = v[i].w * rinv * gv.w * (1.f + sv.w) + hv.w;
                u32x2 o; o[0] = pack2(h0, h1); o[1] = pack2(h2, h3);
                *(u32x2*)(p.F + (size_t)tok * D + cidx) = o;
                LAS float* fr = fs + tl * 1025 + cidx; fr[0] = h0; fr[1] = h1; fr[2] = h2; fr[3] = h3;
            }
        }
        __syncthreads();
        {
            const int tl = tid & 31, eg = tid >> 5;
            float a0 = 0.f, a1 = 0.f;
            const float* rp = rw + eg * 2;
#pragma unroll 8
            for (int k = 0; k < D; ++k) { const float f = fs[tl * 1025 + k]; const f32x2 w = *(const f32x2*)(rp + (size_t)k * NE); a0 += f * w[0]; a1 += f * w[1]; }
            lg[tl * 33 + eg * 2] = a0 + p.router_b[l * NE + eg * 2]; lg[tl * 33 + eg * 2 + 1] = a1 + p.router_b[l * NE + eg * 2 + 1];
        }
        __syncthreads();
        if (tid < 32) {
            const int tok = tok0 + tid;
            float vals[4]; int idxs[4]; unsigned used = 0u;
#pragma unroll
            for (int k = 0; k < 4; ++k) {
                float best = -3.0e38f; int bi = 0;
                for (int e = 0; e < NE; ++e) { const float v = lg[tid * 33 + e]; if (!((used >> e) & 1u) && v > best) { best = v; bi = e; } }
                used |= 1u << bi; vals[k] = best; idxs[k] = bi;
            }
            const float mx = vals[0];
            float ex[4], sum = 0.f;
#pragma unroll
            for (int k = 0; k < 4; ++k) { ex[k] = __expf(vals[k] - mx); sum += ex[k]; }
            const float inv = 1.0f / sum;
#pragma unroll
            for (int k = 0; k < 4; ++k) {
                const int e = idxs[k];
                const int slot = atomicAdd(p.cnt + l * NE + e, 1);
                p.list[(size_t)e * NTOK + slot] = tok;
                p.tokslot[(size_t)tok * 4 + k] = (e << 16) | slot;
                p.topw[(size_t)tok * 4 + k] = ex[k] * inv;
            }
        }
        __syncthreads();
    }
}

__device__ __forceinline__ void build_expert_tables(const Params& p, int l, LAS int* ts, LAS int* cn) {
    if (opaque_tid() == 0) {
        int acc = 0;
        for (int e = 0; e < NE; ++e) { const int c = __hip_atomic_load(p.cnt + l * NE + e, __ATOMIC_RELAXED, __HIP_MEMORY_SCOPE_AGENT); cn[e] = c; ts[e] = acc; acc += (c + 255) >> 8; }
        ts[NE] = acc;
    }
    __syncthreads();
}

__device__ __forceinline__ void ph_g4(const Params& p, int l, LAS unsigned char* lds) {
    LAS int* ts = (LAS int*)(lds + 6 * gm::HT); LAS int* cn = ts + 40;
    build_expert_tables(p, l, ts, cn);
    const StageRC s = my_stage_rc();
    const int tid = opaque_tid(), wid = tid >> 6, lane = tid & 63, wr = wid >> 1, wc = wid & 1, fr = lane & 15, fq = lane >> 4;
    const int MT = ts[NE];
    for (int u = blockIdx.x; u < MT * 16; u += gridDim.x) {
        const int mt = u >> 4, pn = u & 15;
        int e = 0;
        while (e < NE - 1 && ts[e + 1] <= mt) ++e;
        const int cnt = cn[e], slot0 = (mt - ts[e]) * 256;
        const int* le = p.list + (size_t)e * NTOK;
        int sl;
        sl = slot0 + s.R0;       const bf16_t* a00 = p.F + (size_t)le[sl < cnt ? sl : 0] * D + s.C0;
        sl = slot0 + s.R1;       const bf16_t* a01 = p.F + (size_t)le[sl < cnt ? sl : 0] * D + s.C1;
        sl = slot0 + 128 + s.R0; const bf16_t* a10 = p.F + (size_t)le[sl < cnt ? sl : 0] * D + s.C0;
        sl = slot0 + 128 + s.R1; const bf16_t* a11 = p.F + (size_t)le[sl < cnt ? sl : 0] * D + s.C1;
        const bf16_t* Bt = p.w1T + (size_t)(l * NE + e) * 2 * D * D + (size_t)(pn * 128) * D;
        f32x4 acc[4][4]; gm::zero_acc(acc);
        gm::kloop(lds, a00, a01, a10, a11, Bt + (size_t)s.R0 * D + s.C0, Bt + (size_t)s.R1 * D + s.C1, D, acc);
        const float* b1 = p.moe_b1 + (size_t)(l * NE + e) * 2 * D;
#pragma unroll
        for (int m = 0; m < 4; ++m)
#pragma unroll
            for (int n = 0; n < 2; ++n) {
                const int row = mt * 256 + wr * 64 + m * 16 + fr, col = pn * 64 + wc * 32 + n * 16 + fq * 4;
                const float4 bg = *(const float4*)(b1 + col), bl = *(const float4*)(b1 + D + col);
                float o[4];
#pragma unroll
                for (int q = 0; q < 4; ++q) {
                    const float glu = fminf(acc[m][n][q] + ((const float*)&bg)[q], 7.0f);
                    const float lin = fminf(fmaxf(acc[m][n + 2][q] + ((const float*)&bl)[q], -7.0f), 7.0f);
                    o[q] = glu * sigmoidf_(1.702f * glu) * (lin + 1.0f);
                }
                u32x2 ov; ov[0] = pack2(o[0], o[1]); ov[1] = pack2(o[2], o[3]);
                *(u32x2*)(p.act + (size_t)row * D + col) = ov;
            }
    }
}

__device__ __forceinline__ void ph_g5(const Params& p, int l, LAS unsigned char* lds) {
    LAS int* ts = (LAS int*)(lds + 6 * gm::HT); LAS int* cn = ts + 40;
    build_expert_tables(p, l, ts, cn);
    const StageRC s = my_stage_rc();
    const int tid = opaque_tid(), wid = tid >> 6, lane = tid & 63, wr = wid >> 1, wc = wid & 1, fr = lane & 15, fq = lane >> 4;
    const int MT = ts[NE];
    for (int u = blockIdx.x; u < MT * 8; u += gridDim.x) {
        const int mt = u >> 3, pn = u & 7;
        int e = 0;
        while (e < NE - 1 && ts[e + 1] <= mt) ++e;
        const bf16_t* a0 = p.act + (size_t)(mt * 256) * D;
        const bf16_t* Bt = p.w2T + (size_t)(l * NE + e) * D * D + (size_t)(pn * 128) * D;
        f32x4 acc[4][4]; gm::zero_acc(acc);
        gm::kloop(lds, a0 + (size_t)s.R0 * D + s.C0, a0 + (size_t)s.R1 * D + s.C1, a0 + (size_t)(128 + s.R0) * D + s.C0, a0 + (size_t)(128 + s.R1) * D + s.C1,
                  Bt + (size_t)s.R0 * D + s.C0, Bt + (size_t)s.R1 * D + s.C1, D, acc);
        const float* b2 = p.moe_b2 + (size_t)(l * NE + e) * D;
#pragma unroll
        for (int m = 0; m < 4; ++m)
#pragma unroll
            for (int n = 0; n < 4; ++n) {
                const int row = mt * 256 + wr * 64 + m * 16 + fr, col = pn * 128 + wc * 64 + n * 16 + fq * 4;
                const float4 bb = *(const float4*)(b2 + col);
                u32x2 o; o[0] = pack2(acc[m][n][0] + bb.x, acc[m][n][1] + bb.y); o[1] = pack2(acc[m][n][2] + bb.z, acc[m][n][3] + bb.w);
                *(u32x2*)(p.yp + (size_t)row * D + col) = o;
            }
    }
}

__device__ __forceinline__ void ph_combine(const Params& p, int l, int M, LAS unsigned char* lds) {
    LAS int* ts = (LAS int*)lds; LAS int* cn = ts + 40;
    build_expert_tables(p, l, ts, cn);
    const int tid = opaque_tid(), wid = tid >> 6, lane = tid & 63;
    const bool last = (l == 1);
    for (int tok = blockIdx.x * NWAVES + wid; tok < M; tok += gridDim.x * NWAVES) {
        float4 v[4];
        const float* mb = p.mod + (size_t)(l * 5 + tok_modrow(tok)) * (NMOD * D);
        int rows[4]; float wts[4];
#pragma unroll
        for (int k = 0; k < 4; ++k) { const int tsl = p.tokslot[(size_t)tok * 4 + k]; rows[k] = ts[tsl >> 16] * 256 + (tsl & 0xffff); wts[k] = p.topw[(size_t)tok * 4 + k]; }
        float ss = 0.f;
#pragma unroll
        for (int i = 0; i < 4; ++i) {
            const int cidx = i * 256 + lane * 4;
            float m0 = 0.f, m1 = 0.f, m2 = 0.f, m3 = 0.f;
#pragma unroll
            for (int k = 0; k < 4; ++k) {
                const u32x2 u = *(const u32x2*)(p.yp + (size_t)rows[k] * D + cidx);
                m0 += wts[k] * bflo(u[0]); m1 += wts[k] * bfhi(u[0]); m2 += wts[k] * bflo(u[1]); m3 += wts[k] * bfhi(u[1]);
            }
            const float4 gt = *(const float4*)(mb + 5 * D + cidx);
            float4 xv = *(const float4*)(p.xl + (size_t)tok * D + cidx);
            xv.x += gt.x * m0; xv.y += gt.y * m1; xv.z += gt.z * m2; xv.w += gt.w * m3;
            v[i] = xv; ss += xv.x * xv.x + xv.y * xv.y + xv.z * xv.z + xv.w * xv.w;
        }
        ss = wave_sum(ss);
        const float rinv = rsqrtf(ss * (1.0f / D) + 1e-6f);
        if (!last) {
#pragma unroll
            for (int i = 0; i < 4; ++i) *(float4*)(p.xl + (size_t)tok * D + i * 256 + lane * 4) = v[i];
            const float* mb1 = p.mod + (size_t)((l + 1) * 5 + tok_modrow(tok)) * (NMOD * D);
            norm_mod_store(v, rinv, p.norm1_g + (l + 1) * D, mb1 + 1 * D, mb1 + 0 * D, p.H + (size_t)tok * D, lane);
        } else {
#pragma unroll
            for (int i = 0; i < 4; ++i) {
                const int cidx = i * 256 + lane * 4;
                const float4 gv = *(const float4*)(p.final_norm_g + cidx);
                *(float4*)(p.out + (size_t)tok * D + cidx) = make_float4(v[i].x * rinv * gv.x, v[i].y * rinv * gv.y, v[i].z * rinv * gv.z, v[i].w * rinv * gv.w);
            }
        }
    }
}

#define XB_TMO      128
#define XB_XCNT(j)  (256  + 64 * (j))
#define XB_XSUB(j)  (1280 + 64 * (j))
#define XB_XGEN(j)  (2304 + 64 * (j))
#define XB_TOP      3328
#define XB_TOPGEN   3392
#define XCD_BAR_WORDS 3456
#define XB_SPIN_CAP (1u << 18)

__device__ __forceinline__ unsigned xb_ld(unsigned* p)              { return __hip_atomic_load(p, __ATOMIC_RELAXED, __HIP_MEMORY_SCOPE_AGENT); }
__device__ __forceinline__ unsigned xb_add(unsigned* p, unsigned v) { return __hip_atomic_fetch_add(p, v, __ATOMIC_RELAXED, __HIP_MEMORY_SCOPE_AGENT); }
__device__ __forceinline__ unsigned xb_xcc_id() { return (unsigned)__builtin_amdgcn_s_getreg((3 << 11) | 20) & 0xFu; }
#define XB_SPIN(cond, bar) do { unsigned _sp = 0; while (cond) { __builtin_amdgcn_s_sleep(1); \
    if ((++_sp & 255u) == 0u) { if (xb_ld(&(bar)[XB_TMO])) break; if (_sp > XB_SPIN_CAP) { atomicAdd(&(bar)[XB_TMO], 1u); break; } } } } while (0)

struct XcdBarrier {
    unsigned* bar; unsigned x;
    volatile LAS unsigned* st;
};

__device__ __forceinline__ XcdBarrier xcd_barrier_post(unsigned* bar, volatile LAS unsigned* st) {
    XcdBarrier b; b.bar = bar; b.x = xb_xcc_id(); b.st = st;
    if (threadIdx.x == 0) (void)xb_add(&bar[XB_XCNT(b.x)], 1u);
    return b;
}
__device__ __forceinline__ void xcd_barrier_complete(unsigned* bar, unsigned x, unsigned& nloc, unsigned& nx) {
    const unsigned G = gridDim.x * gridDim.y * gridDim.z;
    unsigned sum, cnt, mine, sp = 0u;
    for (;;) {
        sum = 0u; cnt = 0u; mine = 0u;
#pragma unroll
        for (unsigned j = 0; j < 16; ++j) { const unsigned c = xb_ld(&bar[XB_XCNT(j)]); sum += c; cnt += (c > 0u) ? 1u : 0u; mine = (j == x) ? c : mine; }
        if (sum == G) break;
        __builtin_amdgcn_s_sleep(1);
        if ((++sp & 255u) == 0u) { if (xb_ld(&bar[XB_TMO])) break; if (sp > XB_SPIN_CAP) { atomicAdd(&bar[XB_TMO], 1u); break; } }
    }
    nloc = mine > 0u ? mine : 1u; nx = cnt > 0u ? cnt : 1u;
}

__device__ __forceinline__ void xcd_barrier(const XcdBarrier& b) {
    asm volatile("s_waitcnt vmcnt(0)" ::: "memory");
    __syncthreads();
    if (threadIdx.x == 0) {
        unsigned* bar = b.bar;
        __builtin_amdgcn_s_waitcnt(0);
        unsigned nloc = b.st[0], nx = b.st[1];
        if (nloc == 0u) { xcd_barrier_complete(bar, b.x, nloc, nx); b.st[0] = nloc; b.st[1] = nx; }
        const unsigned old = xb_add(&bar[XB_XSUB(b.x)], 1u);
        const unsigned gen = old / nloc;
        if (old + 1u == (gen + 1u) * nloc) {
            __builtin_amdgcn_fence(__ATOMIC_RELEASE, "agent");
            asm volatile("s_waitcnt vmcnt(0)" ::: "memory");
            const unsigned og = xb_add(&bar[XB_TOP], 1u);
            const unsigned tg = og / nx;
            if (og + 1u == (tg + 1u) * nx) xb_add(&bar[XB_TOPGEN], 1u);
            else XB_SPIN(xb_ld(&bar[XB_TOPGEN]) == tg, bar);
            __builtin_amdgcn_fence(__ATOMIC_ACQUIRE, "agent");
            xb_add(&bar[XB_XGEN(b.x)], 1u);
            asm volatile("s_waitcnt vmcnt(0)" ::: "memory");
        } else {
            XB_SPIN(xb_ld(&bar[XB_XGEN(b.x)]) == gen, bar);
            __builtin_amdgcn_fence(__ATOMIC_ACQUIRE, "agent");
            asm volatile("s_waitcnt vmcnt(0)" ::: "memory");
        }
    }
    __syncthreads();
}


extern __shared__ __attribute__((aligned(16))) unsigned char dyn_lds[];
#define KPH(name, call) __global__ void __launch_bounds__(NTHREADS, 2) name(Params p, int l, int M) { LAS unsigned char* lds = (LAS unsigned char*)dyn_lds; (void)l; (void)M; (void)lds; call; }
KPH(k_convert, { ph_convert(p, lds); })
KPH(k_mod, { ph_mod(p, lds); })
KPH(k_norm1, { ph_norm1_first(p); })
KPH(k_g1, { ph_g1(p, l, lds); })
KPH(k_prep, { ph_prep(p, l, lds); })
KPH(k_scan, { ph_scan(p, lds); })
KPH(k_merge, { ph_merge(p, l, M); })
KPH(k_g2, { ph_g2(p, l, M, lds); })
KPH(k_g3, { ph_g3(p, l, M, lds); })
KPH(k_route, { ph_route(p, l, M, lds); })
KPH(k_g4, { ph_g4(p, l, lds); })
KPH(k_g5, { ph_g5(p, l, lds); })
KPH(k_combine, { ph_combine(p, l, M, lds); })


__global__ void __launch_bounds__(NTHREADS, 2) k_mega(Params p) {
    LAS unsigned char* lds = (LAS unsigned char*)dyn_lds;
    volatile LAS unsigned* xb_words = (volatile LAS unsigned*)(lds + LDS_BYTES - 16);
    if (threadIdx.x == 0) { xb_words[0] = 0u; xb_words[1] = 0u; xb_words[2] = 0u; xb_words[3] = 0u; }
    __syncthreads();
    XcdBarrier bar = xcd_barrier_post(p.bar, xb_words);
    ph_convert(p, lds);
    ph_mod(p, lds);
    xcd_barrier(bar);
    ph_norm1_first(p);
    xcd_barrier(bar);
    for (int l = 0; l < 2; ++l) {
        const int M = l == 0 ? NTOK : NLAT;
        ph_g1(p, l, lds);
        xcd_barrier(bar);
        ph_prep(p, l, lds);
        xcd_barrier(bar);
        ph_scan(p, lds);
        xcd_barrier(bar);
        ph_merge(p, l, M);
        xcd_barrier(bar);
        ph_g2(p, l, M, lds);
        xcd_barrier(bar);
        ph_g3(p, l, M, lds);
        xcd_barrier(bar);
        ph_route(p, l, M, lds);
        xcd_barrier(bar);
        ph_g4(p, l, lds);
        xcd_barrier(bar);
        ph_g5(p, l, lds);
        xcd_barrier(bar);
        ph_combine(p, l, M, lds);
        if (l == 0) xcd_barrier(bar);
    }
}

static inline size_t align_up(size_t v, size_t a) { return (v + a - 1) / a * a; }

extern "C" void kernel_launch(void* const* d_in, const int* in_sizes, int n_in, void* d_out, int out_size, void* d_ws, size_t ws_size, hipStream_t stream) {
    (void)in_sizes; (void)n_in; (void)out_size;
    Params p{};
    const float** pf = (const float**)&p;
    for (int i = 0; i < 32; ++i) pf[i] = (const float*)d_in[i];
    p.out = (float*)d_out;
    unsigned char* w = (unsigned char*)d_ws; size_t off = 0;
    auto take = [&](size_t bytes) { void* r = w + off; off = align_up(off + bytes, 256); return r; };
    p.bar = (unsigned*)take(16384);
    p.cnt = (int*)take(1024);
    const size_t ctl_bytes = off;
    p.mod = (float*)take((size_t)2 * 5 * NMOD * D * 4);
    p.winT = (bf16_t*)take((size_t)2 * NP * D * 2);
    p.wbT = (bf16_t*)take((size_t)2 * 4 * D * MW * 2);
    p.woutT = (bf16_t*)take((size_t)2 * D * D * 2);
    p.w1T = (bf16_t*)take((size_t)2 * NE * 2 * D * D * 2);
    p.w2T = (bf16_t*)take((size_t)2 * NE * D * D * 2);
    p.xl = (float*)take((size_t)NTOK * D * 4);
    p.H = (bf16_t*)take((size_t)NTOK * D * 2);
    p.P = (bf16_t*)take((size_t)NTOK * NP * 2);
    p.act = p.P; p.yp = p.P + (size_t)CAPROWS * D;
    p.prep = (float*)take(16 * TOKW * 4);
    p.gg = (float*)take((size_t)NTOK * 8 * 4);
    p.gb = (float*)take((size_t)NTOK * 8 * 4);
    p.O = (float*)take(8 * TOKW * 4);
    p.Y = (bf16_t*)take(4 * TOKW * 2);
    p.mix = (bf16_t*)take((size_t)NTOK * D * 2);
    p.F = p.H;
    p.list = (int*)take((size_t)NE * NTOK * 4);
    p.tokslot = (int*)take((size_t)NTOK * 4 * 4);
    p.topw = (float*)take((size_t)NTOK * 4 * 4);
    if (off > ws_size) { fprintf(stderr, "workspace too small: need %zu have %zu\n", off, ws_size); return; }

    static int grid = 0;
#if MEGA
    if (!grid) {
        int dev = 0, cus = 0, occ = 0; (void)hipGetDevice(&dev); (void)hipDeviceGetAttribute(&cus, hipDeviceAttributeMultiprocessorCount, dev);
        (void)hipFuncSetAttribute((const void*)k_mega, hipFuncAttributeMaxDynamicSharedMemorySize, LDS_BYTES);
        (void)hipOccupancyMaxActiveBlocksPerMultiprocessor(&occ, (const void*)k_mega, NTHREADS, LDS_BYTES);
        if (cus <= 0) cus = 256;
        grid = cus * (occ < 1 ? 1 : 1);
        if (occ < 1) fprintf(stderr, "occupancy query says %d blocks per CU\n", occ);
    }
    (void)hipMemsetAsync(d_ws, 0, ctl_bytes, stream);
    hipLaunchKernelGGL(k_mega, dim3(grid), dim3(NTHREADS), LDS_BYTES, stream, p);
#else
    if (!grid) {
        int dev = 0, cus = 0; (void)hipGetDevice(&dev); (void)hipDeviceGetAttribute(&cus, hipDeviceAttributeMultiprocessorCount, dev);
        grid = cus > 0 ? cus : 256;
        const void* ks[] = {(const void*)k_convert, (const void*)k_mod, (const void*)k_norm1, (const void*)k_g1, (const void*)k_prep, (const void*)k_scan, (const void*)k_merge,
                            (const void*)k_g2, (const void*)k_g3, (const void*)k_route, (const void*)k_g4, (const void*)k_g5, (const void*)k_combine};
        for (const void* k : ks) (void)hipFuncSetAttribute(k, hipFuncAttributeMaxDynamicSharedMemorySize, LDS_BYTES);
    }
    (void)hipMemsetAsync(d_ws, 0, ctl_bytes, stream);
#define LAUNCH(k, l, M) hipLaunchKernelGGL(k, dim3(grid), dim3(NTHREADS), LDS_BYTES, stream, p, l, M)
    LAUNCH(k_convert, 0, 0);
    LAUNCH(k_mod, 0, 0);
    LAUNCH(k_norm1, 0, 0);
    for (int l = 0; l < 2; ++l) {
        const int M = l == 0 ? NTOK : NLAT;
        LAUNCH(k_g1, l, M);
        LAUNCH(k_prep, l, M);
        LAUNCH(k_scan, l, M);
        LAUNCH(k_merge, l, M);
        LAUNCH(k_g2, l, M);
        LAUNCH(k_g3, l, M);
        LAUNCH(k_route, l, M);
        LAUNCH(k_g4, l, M);
        LAUNCH(k_g5, l, M);
        LAUNCH(k_combine, l, M);
    }
#endif
}
```

```cpp
#include <hip/hip_runtime.h>
#include <stdint.h>
#include <stdio.h>

#define LAS __attribute__((address_space(3)))
typedef unsigned short bf16_t;
typedef short bf16x8 __attribute__((ext_vector_type(8)));
typedef float f32x4 __attribute__((ext_vector_type(4)));
typedef float f32x2 __attribute__((ext_vector_type(2)));
typedef unsigned u32x2 __attribute__((ext_vector_type(2)));
typedef unsigned u32x4 __attribute__((ext_vector_type(4)));

#ifndef MEGA
#define MEGA 1
#endif

constexpr int D = 1024, NB = 4, TL = 4096, TC = 256, NLAT = NB * TL, NCTX = NB * TC, NTOK = NLAT + NCTX;
constexpr int NIN = 11792, NP = 12032, MW = 512, NE = 32, TOPK = 4, NMOD = 6;
constexpr int C_GQKV = 0, C_GZ = 1536, C_GA = 2048, C_GB = 2056, C_HQ = 2064, C_HI = 2576, C_HF = 3088, C_HG = 4112, C_LX = 4624,
              C_LY = 5136, C_RQKV = 5648, C_RG = 7184, C_MG = 7696;
constexpr int NTHREADS = 512, NWAVES = 8;
constexpr int LDS_BYTES = 140 * 1024;
constexpr int CAPROWS = 77824;
constexpr size_t TOKW = (size_t)NTOK * MW;
constexpr int PR_GQ = 0, PR_GK = 1, PR_GV = 2, PR_HQ = 3, PR_HK = 4, PR_HLF = 6, PR_RQ = 8, PR_RK = 9, PR_LA = 10, PR_LU = 12, NPREP = 14;
constexpr int NCHUNK = 68, NITEM = 32 * NCHUNK;

struct Params {
    const float *x, *c, *ctx, *c_ctx, *w_mod, *b_mod, *norm1_g, *norm2_g, *w_in, *gdn_conv_w, *gdn_a_log, *gdn_dt_bias, *gdn_norm_g, *hgrn_lb,
        *hgrn_norm_g, *lru_conv_w, *lru_conv_b, *lru_wa, *lru_ba, *lru_wx, *lru_bx, *lru_lambda, *ret_norm_g, *w_branch, *w_out, *router_w,
        *router_b, *moe_w1, *moe_b1, *moe_w2, *moe_b2, *final_norm_g;
    float* out;
    unsigned* bar; int* cnt; float* mod;
    bf16_t *winT, *wbT, *woutT, *w1T, *w2T;
    float* xl; bf16_t* H; bf16_t* P; float* prep; float* gg; float* gb; float* O; bf16_t* Y; bf16_t* mix; bf16_t* F;
    int* list; int* tokslot; float* topw; bf16_t* act; bf16_t* yp;
    bf16_t *lq, *lo, *lb, *la; float* ld;
};

__device__ __forceinline__ unsigned f2bf(float f) { unsigned u = __float_as_uint(f); u += 0x7fffu + ((u >> 16) & 1u); return u >> 16; }
__device__ __forceinline__ unsigned pack2(float a, float b) { return f2bf(a) | (f2bf(b) << 16); }
__device__ __forceinline__ float bf2f(bf16_t b) { return __uint_as_float(((unsigned)b) << 16); }
__device__ __forceinline__ float bflo(unsigned u) { return __uint_as_float(u << 16); }
__device__ __forceinline__ float bfhi(unsigned u) { return __uint_as_float(u & 0xffff0000u); }
__device__ __forceinline__ float sigmoidf_(float x) { return 1.0f / (1.0f + __expf(-x)); }
__device__ __forceinline__ float siluf_(float x) { return x * sigmoidf_(x); }
__device__ __forceinline__ float softplusf_(float x) { return x > 20.f ? x : log1pf(__expf(x)); }
__device__ __forceinline__ float logsigmoidf_(float x) { return -softplusf_(-x); }
__device__ __forceinline__ float gelu_tanhf_(float x) { const float u = 0.7978845608028654f * (x + 0.044715f * x * x * x); return 0.5f * x * (1.0f + tanhf(u)); }
__device__ __forceinline__ float wave_sum(float v) {
#pragma unroll
    for (int m = 32; m >= 1; m >>= 1) v += __shfl_xor(v, m);
    return v;
}
__device__ __forceinline__ int opaque_tid() { int t = threadIdx.x; asm volatile("" : "+v"(t)); return t; }
__device__ __forceinline__ int tok_modrow(int tok) { return tok < NLAT ? (tok >> 12) : 4; }
__device__ __forceinline__ void tok_info(int tok, int& t, int& T, int& base) {
    if (tok < NLAT) { t = tok & (TL - 1); T = TL; base = tok - t; }
    else { t = (tok - NLAT) & (TC - 1); T = TC; base = tok - t; }
}

namespace gm {
constexpr int HT = 16384;
__device__ __forceinline__ int lds_byte(int r, int c) { const int st = (r >> 4) * 2 + (c >> 5), rr = r & 15, cc = c & 31, ob = rr * 64 + cc * 2; return st * 1024 + (ob ^ (((ob >> 9) & 1) << 5)); }
__device__ __forceinline__ void stage_rc(int b, int& R, int& C) { const int st = b / 1024, sb = b % 1024, swz = sb ^ (((sb >> 9) & 1) << 5); R = (st >> 1) * 16 + swz / 64; C = (st & 1) * 32 + (swz % 64) / 2; }

__device__ __forceinline__ void kloop(LAS unsigned char* lds, const bf16_t* ap00, const bf16_t* ap01, const bf16_t* ap10, const bf16_t* ap11,
                                      const bf16_t* bp0, const bf16_t* bp1, int K, f32x4 (&acc)[4][4]) {
    const int tid = opaque_tid(), wid = __builtin_amdgcn_readfirstlane(tid >> 6), lane = tid & 63, wr = wid >> 1, wc = wid & 1, fr = lane & 15, fq = lane >> 4;
    const unsigned ldsw = (unsigned)wid * 1024u;
    const int aoff = (wr >> 1) * HT + lds_byte((wr & 1) * 64 + fr, fq * 8);
    const int boff = 2 * HT + lds_byte(wc * 64 + fr, fq * 8);
    const int nt = K / 64;
#define GM_GLDS(src, dstoff) __builtin_amdgcn_global_load_lds((const unsigned*)(src), (LAS unsigned*)(lds + (dstoff)), 16, 0, 0)
#define GM_STAGE(buf, kt) do { const int _bo = (buf) * 3 * HT + ldsw; const int _ko = (kt) * 64; \
        GM_GLDS(ap00 + _ko, _bo); GM_GLDS(ap01 + _ko, _bo + 8192); GM_GLDS(ap10 + _ko, _bo + HT); GM_GLDS(ap11 + _ko, _bo + HT + 8192); \
        GM_GLDS(bp0 + _ko, _bo + 2 * HT); GM_GLDS(bp1 + _ko, _bo + 2 * HT + 8192); } while (0)
    GM_STAGE(0, 0);
    for (int t = 0; t < nt; ++t) {
        const int cur = t & 1;
        if (t + 1 < nt) { GM_STAGE(cur ^ 1, t + 1); asm volatile("s_waitcnt vmcnt(6)" ::: "memory"); }
        else asm volatile("s_waitcnt vmcnt(0)" ::: "memory");
        __builtin_amdgcn_s_barrier(); asm volatile("" ::: "memory");
        bf16x8 af[4][2], bfr[4][2];
#pragma unroll
        for (int m = 0; m < 4; ++m)
#pragma unroll
            for (int k = 0; k < 2; ++k) af[m][k] = *(const LAS bf16x8*)(lds + cur * 3 * HT + aoff + m * 2048 + k * 1024);
#pragma unroll
        for (int n = 0; n < 4; ++n)
#pragma unroll
            for (int k = 0; k < 2; ++k) bfr[n][k] = *(const LAS bf16x8*)(lds + cur * 3 * HT + boff + n * 2048 + k * 1024);
#pragma unroll
        for (int k = 0; k < 2; ++k)
#pragma unroll
            for (int m = 0; m < 4; ++m)
#pragma unroll
                for (int n = 0; n < 4; ++n) acc[m][n] = __builtin_amdgcn_mfma_f32_16x16x32_bf16(bfr[n][k], af[m][k], acc[m][n], 0, 0, 0);
        asm volatile("s_waitcnt lgkmcnt(0)" ::: "memory");
        __builtin_amdgcn_s_barrier(); asm volatile("" ::: "memory");
    }
#undef GM_STAGE
#undef GM_GLDS
}
__device__ __forceinline__ void zero_acc(f32x4 (&acc)[4][4]) {
#pragma unroll
    for (int m = 0; m < 4; ++m)
#pragma unroll
        for (int n = 0; n < 4; ++n) acc[m][n] = (f32x4){0.f, 0.f, 0.f, 0.f};
}
}

struct StageRC { int R0, C0, R1, C1; };
__device__ __forceinline__ StageRC my_stage_rc() { const int t = opaque_tid(); StageRC s; gm::stage_rc(t * 16, s.R0, s.C0); gm::stage_rc(t * 16 + 8192, s.R1, s.C1); return s; }

__device__ __forceinline__ int w1_dst_row(int n) { const int half = n >> 10, cc = n & 1023; return (cc >> 6) * 128 + ((cc >> 5) & 1) * 64 + half * 32 + (cc & 31); }

__device__ __forceinline__ void cvt_tile(LAS float* tile, const float* src, int ldsrc, int Nsrc, int k0, int n0, bf16_t* dst, int K, int mode) {
    const int tid = opaque_tid();
    {
        const int rr = tid >> 6, cc = tid & 63, n = n0 + cc;
#pragma unroll
        for (int i = 0; i < 8; ++i) { const int k = rr + i * 8; tile[k * 65 + cc] = (n < Nsrc) ? src[(size_t)(k0 + k) * ldsrc + n] : 0.f; }
    }
    __syncthreads();
    {
        const int nl = tid >> 3, kg = tid & 7, n = n0 + nl;
        float v[8];
#pragma unroll
        for (int j = 0; j < 8; ++j) v[j] = tile[(kg * 8 + j) * 65 + nl];
        const int drow = mode == 1 ? w1_dst_row(n) : n;
        u32x4 o; o[0] = pack2(v[0], v[1]); o[1] = pack2(v[2], v[3]); o[2] = pack2(v[4], v[5]); o[3] = pack2(v[6], v[7]);
        *(u32x4*)(dst + (size_t)drow * K + k0 + kg * 8) = o;
    }
    __syncthreads();
}

__device__ __forceinline__ void ph_convert(const Params& p, LAS unsigned char* lds) {
    LAS float* tile = (LAS float*)lds;
    constexpr int PER_L = 3008 + 512 + 256 + 16384 + 8192;
    for (int it = blockIdx.x; it < 2 * PER_L; it += gridDim.x) {
        const int l = it / PER_L; int r = it % PER_L;
        if (r < 3008) { const int nt = r % 188, kt = r / 188; cvt_tile(tile, p.w_in + (size_t)l * D * NIN, NIN, NIN, kt * 64, nt * 64, p.winT + (size_t)l * NP * D, D, 0); }
        else if (r < 3520) { r -= 3008; const int n = r / 128; r %= 128; const int nt = r % 16, kt = r / 16;
            cvt_tile(tile, p.w_branch + (size_t)(l * 4 + n) * MW * D, D, D, kt * 64, nt * 64, p.wbT + (size_t)(l * 4 + n) * D * MW, MW, 0); }
        else if (r < 3776) { r -= 3520; const int nt = r % 16, kt = r / 16; cvt_tile(tile, p.w_out + (size_t)l * D * D, D, D, kt * 64, nt * 64, p.woutT + (size_t)l * D * D, D, 0); }
        else if (r < 3776 + 16384) { r -= 3776; const int e = r / 512; r %= 512; const int nt = r % 32, kt = r / 32;
            cvt_tile(tile, p.moe_w1 + (size_t)(l * NE + e) * D * 2 * D, 2 * D, 2 * D, kt * 64, nt * 64, p.w1T + (size_t)(l * NE + e) * 2 * D * D, D, 1); }
        else { r -= 3776 + 16384; const int e = r / 256; r %= 256; const int nt = r % 16, kt = r / 16;
            cvt_tile(tile, p.moe_w2 + (size_t)(l * NE + e) * D * D, D, D, kt * 64, nt * 64, p.w2T + (size_t)(l * NE + e) * D * D, D, 0); }
    }
}

__device__ __forceinline__ void ph_mod(const Params& p, LAS unsigned char* lds) {
    LAS float* sc = (LAS float*)lds;
    LAS float* red = sc + 5 * D;
    const int tid = opaque_tid(), wid = tid >> 6, lane = tid & 63;
    if ((int)blockIdx.x >= 192) return;
    for (int i = tid; i < 5 * D; i += NTHREADS) { const int r = i >> 10, k = i & 1023; const float v = r < 4 ? p.c[r * D + k] : p.c_ctx[k]; sc[i] = siluf_(v); }
    __syncthreads();
    for (int it = blockIdx.x; it < 192; it += gridDim.x) {
        const int l = it / 96, n0 = (it % 96) * 64;
        float acc[5] = {0.f, 0.f, 0.f, 0.f, 0.f};
        const float* wp = p.w_mod + (size_t)l * D * (NMOD * D) + n0 + lane;
        for (int k = wid * 128; k < wid * 128 + 128; ++k) {
            const float wv = wp[(size_t)k * (NMOD * D)];
#pragma unroll
            for (int r = 0; r < 5; ++r) acc[r] += sc[r * D + k] * wv;
        }
#pragma unroll
        for (int r = 0; r < 5; ++r) red[(wid * 5 + r) * 64 + lane] = acc[r];
        __syncthreads();
        if (tid < 320) { const int r = tid >> 6, cidx = tid & 63; float s = p.b_mod[l * NMOD * D + n0 + cidx];
#pragma unroll
            for (int w = 0; w < 8; ++w) s += red[(w * 5 + r) * 64 + cidx];
            p.mod[(size_t)(l * 5 + r) * (NMOD * D) + n0 + cidx] = s; }
        __syncthreads();
    }
}

__device__ __forceinline__ void norm_mod_store(const float4 (&v)[4], float rinv, const float* g, const float* scp, const float* shp, bf16_t* dst, int lane) {
#pragma unroll
    for (int i = 0; i < 4; ++i) {
        const int cidx = i * 256 + lane * 4;
        const float4 gv = *(const float4*)(g + cidx), sv = *(const float4*)(scp + cidx), hv = *(const float4*)(shp + cidx);
        const float h0 = v[i].x * rinv * gv.x * (1.f + sv.x) + hv.x, h1 = v[i].y * rinv * gv.y * (1.f + sv.y) + hv.y;
        const float h2 = v[i].z * rinv * gv.z * (1.f + sv.z) + hv.z, h3 = v[i].w * rinv * gv.w * (1.f + sv.w) + hv.w;
        u32x2 o; o[0] = pack2(h0, h1); o[1] = pack2(h2, h3);
        *(u32x2*)(dst + cidx) = o;
    }
}
__device__ __forceinline__ void ph_norm1_first(const Params& p) {
    const int tid = opaque_tid(), wid = tid >> 6, lane = tid & 63;
    for (int tok = blockIdx.x * NWAVES + wid; tok < NTOK; tok += gridDim.x * NWAVES) {
        const float* src = tok < NLAT ? p.x + (size_t)tok * D : p.ctx + (size_t)(tok - NLAT) * D;
        float4 v[4]; float ss = 0.f;
#pragma unroll
        for (int i = 0; i < 4; ++i) { v[i] = *(const float4*)(src + i * 256 + lane * 4); ss += v[i].x * v[i].x + v[i].y * v[i].y + v[i].z * v[i].z + v[i].w * v[i].w; }
        ss = wave_sum(ss);
        const float rinv = rsqrtf(ss * (1.0f / D) + 1e-6f);
        const float* mb = p.mod + (size_t)(0 * 5 + tok_modrow(tok)) * (NMOD * D);
        norm_mod_store(v, rinv, p.norm1_g, mb + 1 * D, mb + 0 * D, p.H + (size_t)tok * D, lane);
#pragma unroll
        for (int i = 0; i < 4; ++i) *(float4*)(p.xl + (size_t)tok * D + i * 256 + lane * 4) = v[i];
    }
}

__device__ __forceinline__ void ph_g1(const Params& p, int l, LAS unsigned char* lds) {
    const StageRC s = my_stage_rc();
    const int tid = opaque_tid(), wid = tid >> 6, lane = tid & 63, wr = wid >> 1, wc = wid & 1, fr = lane & 15, fq = lane >> 4;
    const bf16_t* Bt = p.winT + (size_t)l * NP * D;
    constexpr int NTN = 93, NTM = NTOK / 256;
    for (int u = blockIdx.x; u < NTM * NTN; u += gridDim.x) {
        const int pm = u / NTN, pn = u % NTN;
        const bf16_t* a0 = p.H + (size_t)(pm * 256) * D;
        f32x4 acc[4][4]; gm::zero_acc(acc);
        gm::kloop(lds, a0 + (size_t)s.R0 * D + s.C0, a0 + (size_t)s.R1 * D + s.C1, a0 + (size_t)(128 + s.R0) * D + s.C0, a0 + (size_t)(128 + s.R1) * D + s.C1,
                  Bt + (size_t)(pn * 128 + s.R0) * D + s.C0, Bt + (size_t)(pn * 128 + s.R1) * D + s.C1, D, acc);
#pragma unroll
        for (int m = 0; m < 4; ++m)
#pragma unroll
            for (int n = 0; n < 4; ++n) {
                const int row = pm * 256 + wr * 64 + m * 16 + fr, col = pn * 128 + wc * 64 + n * 16 + fq * 4;
                u32x2 o; o[0] = pack2(acc[m][n][0], acc[m][n][1]); o[1] = pack2(acc[m][n][2], acc[m][n][3]);
                *(u32x2*)(p.P + (size_t)row * NP + col) = o;
            }
    }
}

__device__ __forceinline__ void ph_prep(const Params& p, int l, LAS unsigned char* lds) {
    const int tid = opaque_tid(), wid = tid >> 6, lane = tid & 63;
    const int gw = blockIdx.x * NWAVES + wid, nw = gridDim.x * NWAVES;
    for (int id = gw; id < NTOK * 12; id += nw) {
        const int tok = id / 12, r = id % 12, part = r >> 2, head = r & 3;
        int t, T, base; tok_info(tok, t, T, base);
        const int cidx = part * 512 + head * 128 + lane * 2;
        float a0 = 0.f, a1 = 0.f;
#pragma unroll
        for (int j = 0; j < 4; ++j) {
            const int tt = t + j - 2;
            if (tt >= 0 && tt < T) {
                const unsigned u = *(const unsigned*)(p.P + (size_t)(base + tt) * NP + C_GQKV + cidx);
                const f32x2 w = *(const f32x2*)(p.gdn_conv_w + (size_t)(l * 4 + j) * 1536 + cidx);
                a0 += w[0] * bflo(u); a1 += w[1] * bfhi(u);
            }
        }
        a0 = siluf_(a0); a1 = siluf_(a1);
        if (part < 2) {
            const float ss = wave_sum(a0 * a0 + a1 * a1);
            const float sc = rsqrtf(ss + 1e-6f) * (part == 0 ? 0.08838834764831845f : 1.0f);
            a0 *= sc; a1 *= sc;
        }
        f32x2 o; o[0] = a0; o[1] = a1;
        *(f32x2*)(p.prep + part * TOKW + (size_t)tok * MW + head * 128 + lane * 2) = o;
        if (r == 0 && lane < 16) {
            const int idx = lane & 7;
            if (lane < 8) { const float a = bf2f(p.P[(size_t)tok * NP + C_GA + idx]);
                p.gg[(size_t)tok * 8 + idx] = -__expf(p.gdn_a_log[l * 8 + idx]) * softplusf_(a + p.gdn_dt_bias[l * 8 + idx]); }
            else { const float bt = bf2f(p.P[(size_t)tok * NP + C_GB + idx]); p.gb[(size_t)tok * 8 + idx] = sigmoidf_(bt); }
        }
    }
    for (int id = gw; id < NTOK * 4; id += nw) {
        const int tok = id >> 2, head = id & 3;
        const int cidx = head * 128 + lane * 2;
        const bf16_t* pr = p.P + (size_t)tok * NP;
        const unsigned uq = *(const unsigned*)(pr + C_HQ + cidx);
        f32x2 o;
        o[0] = siluf_(bflo(uq)) * 0.08838834764831845f; o[1] = siluf_(bfhi(uq)) * 0.08838834764831845f;
        *(f32x2*)(p.prep + PR_HQ * TOKW + (size_t)tok * MW + cidx) = o;
#pragma unroll
        for (int d = 0; d < 2; ++d) {
            const unsigned uf = *(const unsigned*)(pr + C_HF + d * 512 + cidx);
            float lb0 = 0.f, lb1 = 0.f;
            if (l == 1) {
                const f32x2 x0 = *(const f32x2*)(p.hgrn_lb + (size_t)(0 * 2 + d) * MW + cidx), x1 = *(const f32x2*)(p.hgrn_lb + (size_t)(1 * 2 + d) * MW + cidx);
                lb0 = fminf(1.0f / (1.0f + __expf(x0[0] - x1[0])), 1.0f - 1e-4f); lb1 = fminf(1.0f / (1.0f + __expf(x0[1] - x1[1])), 1.0f - 1e-4f);
            }
            const float z0 = bflo(uf), z1 = bfhi(uf);
            const float f0 = lb0 + (1.f - lb0) * sigmoidf_(z0), f1 = lb1 + (1.f - lb1) * sigmoidf_(z1);
            f32x2 k; k[0] = (1.f - lb0) * sigmoidf_(-z0); k[1] = (1.f - lb1) * sigmoidf_(-z1);
            *(f32x2*)(p.prep + (PR_HK + d) * TOKW + (size_t)tok * MW + cidx) = k;
            f32x2 lf; lf[0] = __logf(fmaxf(f0, 1e-30f)); lf[1] = __logf(fmaxf(f1, 1e-30f));
            *(f32x2*)(p.prep + (PR_HLF + d) * TOKW + (size_t)tok * MW + cidx) = lf;
        }
    }
    for (int id = gw; id < NTOK * 4; id += nw) {
        const int tok = id >> 2, head = id & 3;
        const bf16_t* pr = p.P + (size_t)tok * NP + C_RQKV + head * 128;
        float q1 = bf2f(pr[lane]), q2 = bf2f(pr[64 + lane]), k1 = bf2f(pr[512 + lane]), k2 = bf2f(pr[512 + 64 + lane]);
        if (tok < NLAT) {
            const int t = tok & (TL - 1);
            const float pos = (lane < 32) ? (float)(t >> 6) : (float)(t & 63);
            const float inv = exp2f(-(float)(lane & 31) * (13.287712379549449f / 32.0f));
            const float ang = pos * inv;
            float sn, cs; sincosf(ang, &sn, &cs);
            const float nq1 = q1 * cs - q2 * sn, nq2 = q1 * sn + q2 * cs, nk1 = k1 * cs - k2 * sn, nk2 = k1 * sn + k2 * cs;
            q1 = nq1; q2 = nq2; k1 = nk1; k2 = nk2;
        }
        k1 *= 0.08838834764831845f; k2 *= 0.08838834764831845f;
        const size_t o = (size_t)tok * MW + head * 128;
        p.prep[PR_RQ * TOKW + o + lane] = q1; p.prep[PR_RQ * TOKW + o + 64 + lane] = q2;
        p.prep[PR_RK * TOKW + o + lane] = k1; p.prep[PR_RK * TOKW + o + 64 + lane] = k2;
    }
    {
        LAS float* xs = (LAS float*)lds;
        LAS float* wsm = xs + 64 * 65;
        for (int it = blockIdx.x; it < (NTOK / 64) * 8; it += gridDim.x) {
            const int tile = it >> 3, n = it & 7, tok0 = tile * 64;
            {
                const int tl = tid & 63, cg = tid >> 6, tok = tok0 + tl;
                int t, T, base; tok_info(tok, t, T, base);
                float a[8];
#pragma unroll
                for (int j = 0; j < 8; ++j) a[j] = p.lru_conv_b[l * MW + n * 64 + cg * 8 + j];
#pragma unroll
                for (int j = 0; j < 4; ++j) {
                    const int tt = t + j - 2;
                    if (tt >= 0 && tt < T) {
                        const u32x4 u = *(const u32x4*)(p.P + (size_t)(base + tt) * NP + C_LX + n * 64 + cg * 8);
                        const float* w = p.lru_conv_w + (size_t)(l * 4 + j) * MW + n * 64 + cg * 8;
#pragma unroll
                        for (int q = 0; q < 4; ++q) { a[2 * q] += w[2 * q] * bflo(u[q]); a[2 * q + 1] += w[2 * q + 1] * bfhi(u[q]); }
                    }
                }
#pragma unroll
                for (int j = 0; j < 8; ++j) xs[tl * 65 + cg * 8 + j] = a[j];
                for (int i = tid; i < 4 * 1024; i += NTHREADS) {
                    const int mat = i >> 10, off = (i & 1023) * 4, d = mat >> 1;
                    const float* srcw = ((mat & 1) ? p.lru_wx : p.lru_wa) + (size_t)((l * 2 + d) * 8 + n) * 4096 + off;
                    const float4 v = *(const float4*)srcw;
                    LAS float* dw = wsm + mat * 4096 + off; dw[0] = v.x; dw[1] = v.y; dw[2] = v.z; dw[3] = v.w;
                }
            }
            __syncthreads();
            {
                const int tl = tid & 63, jg = tid >> 6, tok = tok0 + tl;
                float acc[4][8];
#pragma unroll
                for (int m = 0; m < 4; ++m)
#pragma unroll
                    for (int j = 0; j < 8; ++j) acc[m][j] = 0.f;
                for (int i = 0; i < 64; ++i) {
                    const float xv = xs[tl * 65 + i];
#pragma unroll
                    for (int m = 0; m < 4; ++m)
#pragma unroll
                        for (int j = 0; j < 8; ++j) acc[m][j] += xv * wsm[m * 4096 + i * 64 + jg * 8 + j];
                }
#pragma unroll
                for (int d = 0; d < 2; ++d) {
                    float av[8], uv[8];
#pragma unroll
                    for (int j = 0; j < 8; ++j) {
                        const int cidx = n * 64 + jg * 8 + j, pi = (l * 2 + d) * MW + cidx;
                        const float gr = sigmoidf_(acc[d * 2][j] + p.lru_ba[pi]), gi = sigmoidf_(acc[d * 2 + 1][j] + p.lru_bx[pi]);
                        const float la = 8.0f * gr * logsigmoidf_(p.lru_lambda[pi]);
                        av[j] = __expf(la);
                        uv[j] = xs[tl * 65 + jg * 8 + j] * gi * sqrtf(fmaxf(-expm1f(2.0f * la), 1e-12f));
                    }
                    float* da = p.prep + (PR_LA + d) * TOKW + (size_t)tok * MW + n * 64 + jg * 8;
                    float* du = p.prep + (PR_LU + d) * TOKW + (size_t)tok * MW + n * 64 + jg * 8;
                    *(float4*)da = make_float4(av[0], av[1], av[2], av[3]); *(float4*)(da + 4) = make_float4(av[4], av[5], av[6], av[7]);
                    *(float4*)du = make_float4(uv[0], uv[1], uv[2], uv[3]); *(float4*)(du + 4) = make_float4(uv[4], uv[5], uv[6], uv[7]);
                }
            }
            __syncthreads();
        }
    }
}

__device__ __forceinline__ int chunk_base(int b, int d, int n) {
    if (n < 4) { const int blk = d ? 3 - n : n; return NLAT + b * TC + blk * 64; }
    const int m = n - 4, blk = d ? 63 - m : m; return b * TL + blk * 64;
}
__device__ __forceinline__ f32x4 mfma16(bf16x8 a, bf16x8 b, f32x4 c) { return __builtin_amdgcn_mfma_f32_16x16x32_bf16(a, b, c, 0, 0, 0); }
__device__ __forceinline__ u32x2 pack4(f32x4 v) { u32x2 o; o[0] = pack2(v[0], v[1]); o[1] = pack2(v[2], v[3]); return o; }
__device__ __forceinline__ u32x4 pack8(const float* v) { u32x4 o; o[0] = pack2(v[0], v[1]); o[1] = pack2(v[2], v[3]); o[2] = pack2(v[4], v[5]); o[3] = pack2(v[6], v[7]); return o; }

__device__ __forceinline__ void local_gla(const Params& p, int tz, int chain, int n, LAS unsigned char* lds) {
    const int tid = opaque_tid(), wid = tid >> 6, lane = tid & 63, fr = lane & 15, fq = lane >> 4;
    const int b = chain >> 3, h = (chain >> 1) & 3, d = chain & 1;
    const int base = chunk_base(b, d, n);
    const size_t item = (size_t)tz * NITEM + (size_t)chain * NCHUNK + n;
    LAS bf16_t* kraw = (LAS bf16_t*)lds;
    LAS bf16_t* qh = kraw + 64 * 136;
    LAS bf16_t* kh = qh + 64 * 136;
    LAS bf16_t* sc = kh + 64 * 136;
    LAS bf16_t* vT = sc + 64 * 72;
    LAS bf16_t* kT = vT + 128 * 72;
    LAS float* bc = (LAS float*)(kT + 128 * 72);
    const float* Qg = p.prep + (size_t)(tz == 1 ? PR_HQ : PR_RQ) * TOKW;
    const float* Kg = p.prep + (size_t)(tz == 1 ? PR_HK + d : PR_RK) * TOKW;
    const int vcol = tz == 1 ? C_HI : C_RQKV + 1024;
    const int ti = tid >> 3, d0 = (tid & 7) * 16;
    const int tokI = base + (d ? 63 - ti : ti);
    if (tid < 128) {
        float run = 0.f;
        if (tz == 1) {
            const float* lf = p.prep + (size_t)(PR_HLF + d) * TOKW + h * 128 + tid;
            float lv[64];
#pragma unroll
            for (int i = 0; i < 64; ++i) lv[i] = lf[(size_t)(base + (d ? 63 - i : i)) * MW];
#pragma unroll
            for (int i = 0; i < 64; ++i) { run += lv[i]; bc[i * 132 + tid] = run; }
        } else {
            const float lng = log1pf(-exp2f(-5.0f - (float)h));
            for (int i = 0; i < 64; ++i) { run += lng; bc[i * 132 + tid] = run; }
        }
    }
    {
        const float* kp = Kg + (size_t)tokI * MW + h * 128 + d0;
        float kv[16];
#pragma unroll
        for (int q = 0; q < 4; ++q) { const float4 t = *(const float4*)(kp + q * 4); kv[q * 4] = t.x; kv[q * 4 + 1] = t.y; kv[q * 4 + 2] = t.z; kv[q * 4 + 3] = t.w; }
        *(LAS u32x4*)(kraw + ti * 136 + d0) = pack8(kv); *(LAS u32x4*)(kraw + ti * 136 + d0 + 8) = pack8(kv + 8);
        const bf16_t* vp = p.P + (size_t)tokI * NP + vcol + h * 128 + d0;
        const u32x4 v0 = *(const u32x4*)vp, v1 = *(const u32x4*)(vp + 8);
#pragma unroll
        for (int e = 0; e < 8; ++e) {
            vT[(d0 + e) * 72 + ti] = (bf16_t)((e & 1) ? (v0[e >> 1] >> 16) : (v0[e >> 1] & 0xffffu));
            vT[(d0 + 8 + e) * 72 + ti] = (bf16_t)((e & 1) ? (v1[e >> 1] >> 16) : (v1[e >> 1] & 0xffffu));
        }
    }
    __syncthreads();
    {
        const float* qp = Qg + (size_t)tokI * MW + h * 128 + d0;
        const int I = ti >> 4;
        float qhat[16], qt[16];
#pragma unroll
        for (int q = 0; q < 4; ++q) { const float4 t = *(const float4*)(qp + q * 4); qt[q * 4] = t.x; qt[q * 4 + 1] = t.y; qt[q * 4 + 2] = t.z; qt[q * 4 + 3] = t.w; }
#pragma unroll
        for (int e = 0; e < 16; ++e) {
            const float bi = bc[ti * 132 + d0 + e], rI = I ? bc[(16 * I - 1) * 132 + d0 + e] : 0.f, bl = bc[63 * 132 + d0 + e];
            qhat[e] = qt[e] * __expf(bi - rI); qt[e] = qt[e] * __expf(bi);
            kT[(d0 + e) * 72 + ti] = (bf16_t)f2bf(bf2f(kraw[ti * 136 + d0 + e]) * __expf(bl - bi));
        }
        *(LAS u32x4*)(qh + ti * 136 + d0) = pack8(qhat); *(LAS u32x4*)(qh + ti * 136 + d0 + 8) = pack8(qhat + 8);
        bf16_t* lqp = p.lq + item * 8192 + ti * 128 + d0;
        *(u32x4*)lqp = pack8(qt); *(u32x4*)(lqp + 8) = pack8(qt + 8);
    }
    if (tid < 128) p.ld[item * 128 + tid] = __expf(bc[63 * 132 + tid]);
    for (int I = 0; I < 4; ++I) {
        if (ti < 16 * (I + 1)) {
            float kk[16];
#pragma unroll
            for (int e = 0; e < 16; ++e) {
                const float rI = I ? bc[(16 * I - 1) * 132 + d0 + e] : 0.f, bj = bc[ti * 132 + d0 + e];
                kk[e] = bf2f(kraw[ti * 136 + d0 + e]) * __expf(fminf(rI - bj, 80.f));
            }
            *(LAS u32x4*)(kh + ti * 136 + d0) = pack8(kk); *(LAS u32x4*)(kh + ti * 136 + d0 + 8) = pack8(kk + 8);
        }
        __syncthreads();
        if (wid < 4) {
            const int J = wid;
            u32x2 outv; outv[0] = 0u; outv[1] = 0u;
            if (J <= I) {
                f32x4 acc = (f32x4){0.f, 0.f, 0.f, 0.f};
#pragma unroll
                for (int ks = 0; ks < 4; ++ks)
                    acc = mfma16(*(const LAS bf16x8*)(kh + (J * 16 + fr) * 136 + ks * 32 + fq * 8), *(const LAS bf16x8*)(qh + (I * 16 + fr) * 136 + ks * 32 + fq * 8), acc);
                const int i = 16 * I + fr, j0 = 16 * J + 4 * fq;
#pragma unroll
                for (int r = 0; r < 4; ++r) if (j0 + r > i) acc[r] = 0.f;
                outv = pack4(acc);
            }
            *(LAS u32x2*)(sc + (I * 16 + fr) * 72 + J * 16 + 4 * fq) = outv;
        }
        __syncthreads();
    }
    {
        bf16x8 xv[2], xk[2];
#pragma unroll
        for (int ks = 0; ks < 2; ++ks) { xv[ks] = *(const LAS bf16x8*)(vT + (wid * 16 + fr) * 72 + ks * 32 + fq * 8); xk[ks] = *(const LAS bf16x8*)(kT + (wid * 16 + fr) * 72 + ks * 32 + fq * 8); }
#pragma unroll
        for (int ib = 0; ib < 4; ++ib) {
            f32x4 acc = (f32x4){0.f, 0.f, 0.f, 0.f};
#pragma unroll
            for (int ks = 0; ks < 2; ++ks) acc = mfma16(xv[ks], *(const LAS bf16x8*)(sc + (ib * 16 + fr) * 72 + ks * 32 + fq * 8), acc);
            *(u32x2*)(p.lo + item * 8192 + (ib * 16 + fr) * 128 + wid * 16 + 4 * fq) = pack4(acc);
        }
#pragma unroll
        for (int dvb = 0; dvb < 8; ++dvb) {
            f32x4 acc = (f32x4){0.f, 0.f, 0.f, 0.f};
#pragma unroll
            for (int ks = 0; ks < 2; ++ks) acc = mfma16(xk[ks], *(const LAS bf16x8*)(vT + (dvb * 16 + fr) * 72 + ks * 32 + fq * 8), acc);
            *(u32x2*)(p.lb + item * 16384 + (dvb * 16 + fr) * 128 + wid * 16 + 4 * fq) = pack4(acc);
        }
    }
    __syncthreads();
}


template <int I> struct SolveRows {
    static __device__ __forceinline__ void run(float (&x)[64], const LAS float* Mf, const LAS float* rs) {
        SolveRows<I - 1>::run(x, Mf, rs);
        float r = x[I] * rs[I];
#pragma unroll
        for (int j4 = 0; j4 < (I + 3) / 4; ++j4) {
            const f32x4 m = *(const LAS f32x4*)(Mf + I * 68 + j4 * 4);
            r -= m[0] * x[j4 * 4] + m[1] * x[j4 * 4 + 1] + m[2] * x[j4 * 4 + 2] + m[3] * x[j4 * 4 + 3];
        }
        asm volatile("" : "+v"(r) :: "memory");
        x[I] = r;
    }
};
template <> struct SolveRows<-1> { static __device__ __forceinline__ void run(float (&)[64], const LAS float*, const LAS float*) {} };

__device__ __forceinline__ void local_gdn(const Params& p, int chain, int n, LAS unsigned char* lds) {
    const int tid = opaque_tid(), wid = tid >> 6, lane = tid & 63, fr = lane & 15, fq = lane >> 4;
    const int b = chain >> 3, h = (chain >> 1) & 3, d = chain & 1;
    const int base = chunk_base(b, d, n);
    const size_t item = (size_t)chain * NCHUNK + n;
    LAS bf16_t* ks_ = (LAS bf16_t*)lds;
    LAS bf16_t* qs = ks_ + 64 * 136;
    LAS bf16_t* att = qs + 64 * 136;
    LAS bf16_t* wT = att + 64 * 72;
    LAS bf16_t* uT = wT + 128 * 72;
    LAS bf16_t* kT = uT + 128 * 72;
    LAS float* Mf = (LAS float*)(kT + 128 * 72);
    LAS float* bcs = Mf + 64 * 68;
    LAS float* bts = bcs + 64;
    LAS float* rse = bts + 64;
    const int ti = tid >> 3, d0 = (tid & 7) * 16;
    const int tokI = base + (d ? 63 - ti : ti);
    {
        const float* kp = p.prep + (size_t)PR_GK * TOKW + (size_t)tokI * MW + h * 128 + d0;
        const float* qp = p.prep + (size_t)PR_GQ * TOKW + (size_t)tokI * MW + h * 128 + d0;
        float kv[16], qv[16];
#pragma unroll
        for (int q = 0; q < 4; ++q) {
            const float4 t = *(const float4*)(kp + q * 4); kv[q * 4] = t.x; kv[q * 4 + 1] = t.y; kv[q * 4 + 2] = t.z; kv[q * 4 + 3] = t.w;
            const float4 u = *(const float4*)(qp + q * 4); qv[q * 4] = u.x; qv[q * 4 + 1] = u.y; qv[q * 4 + 2] = u.z; qv[q * 4 + 3] = u.w;
        }
        *(LAS u32x4*)(ks_ + ti * 136 + d0) = pack8(kv); *(LAS u32x4*)(ks_ + ti * 136 + d0 + 8) = pack8(kv + 8);
        *(LAS u32x4*)(qs + ti * 136 + d0) = pack8(qv); *(LAS u32x4*)(qs + ti * 136 + d0 + 8) = pack8(qv + 8);
    }
    if (wid == 0) {
        const int tok = base + (d ? 63 - lane : lane);
        float v = p.gg[(size_t)tok * 8 + d * 4 + h];
#pragma unroll
        for (int off = 1; off < 64; off <<= 1) { const float t = __shfl_up(v, off); if (lane >= off) v += t; }
        const float btv = p.gb[(size_t)tok * 8 + d * 4 + h];
        bcs[lane] = v; bts[lane] = btv; rse[lane] = btv * __expf(v);
    }
    __syncthreads();
#pragma unroll
    for (int e = 0; e < 2; ++e) {
        const int f = wid * 2 + e, ib = f >> 2, jb = f & 3;
        const int i = 16 * ib + fr, j0 = 16 * jb + 4 * fq;
        f32x4 mk = (f32x4){0.f, 0.f, 0.f, 0.f}, mq = (f32x4){0.f, 0.f, 0.f, 0.f};
        if (jb <= ib) {
#pragma unroll
            for (int ks = 0; ks < 4; ++ks) {
                const bf16x8 xk = *(const LAS bf16x8*)(ks_ + (jb * 16 + fr) * 136 + ks * 32 + fq * 8);
                mk = mfma16(xk, *(const LAS bf16x8*)(ks_ + (ib * 16 + fr) * 136 + ks * 32 + fq * 8), mk);
                mq = mfma16(xk, *(const LAS bf16x8*)(qs + (ib * 16 + fr) * 136 + ks * 32 + fq * 8), mq);
            }
            const float bi = bcs[i], bti = bts[i];
#pragma unroll
            for (int r = 0; r < 4; ++r) {
                const int j = j0 + r;
                const float dec = __expf(j <= i ? bi - bcs[j] : 0.f);
                mk[r] = (j < i) ? bti * mk[r] * dec : 0.f;
                mq[r] = (j <= i) ? mq[r] * dec : 0.f;
            }
        }
        *(LAS f32x4*)(Mf + i * 68 + j0) = mk;
        *(LAS u32x2*)(att + i * 72 + j0) = pack4(mq);
    }
    __syncthreads();
    {
        const float sc_ = __expf(bcs[63] - bcs[ti]);
#pragma unroll
        for (int e = 0; e < 16; ++e) kT[(d0 + e) * 72 + ti] = (bf16_t)f2bf(bf2f(ks_[ti * 136 + d0 + e]) * sc_);
    }
    if (tid < 256) {
        const int cidx = tid & 127;
        const bool isw = tid >= 128;
        const float* srcp = p.prep + (size_t)(isw ? PR_GK : PR_GV) * TOKW + h * 128 + cidx;
        float x[64];
#pragma unroll
        for (int i = 0; i < 64; ++i) x[i] = srcp[(size_t)(base + (d ? 63 - i : i)) * MW];
        {
            unsigned mb = (unsigned)(size_t)Mf, rb = (unsigned)(size_t)(isw ? rse : bts);
            asm volatile("" : "+v"(mb), "+v"(rb));
            SolveRows<63>::run(x, (const LAS float*)(size_t)mb, (const LAS float*)(size_t)rb);
        }
        if (isw) {
#pragma unroll
            for (int i = 0; i < 64; ++i) x[i] = -x[i];
        }
        LAS bf16_t* dst = (isw ? wT : uT) + cidx * 72;
#pragma unroll
        for (int q = 0; q < 8; ++q) *(LAS u32x4*)(dst + q * 8) = pack8(x + q * 8);
    }
    if (tid < 128) p.ld[item * 128 + tid] = __expf(bcs[63]);
    __syncthreads();
    {
        const int tid = opaque_tid(), wid = tid >> 6, lane = tid & 63, fr = lane & 15, fq = lane >> 4;
        bf16x8 xw[2], xu[2], xk[2];
#pragma unroll
        for (int ks = 0; ks < 2; ++ks) {
            xw[ks] = *(const LAS bf16x8*)(wT + (wid * 16 + fr) * 72 + ks * 32 + fq * 8);
            xu[ks] = *(const LAS bf16x8*)(uT + (wid * 16 + fr) * 72 + ks * 32 + fq * 8);
            xk[ks] = *(const LAS bf16x8*)(kT + (wid * 16 + fr) * 72 + ks * 32 + fq * 8);
        }
#pragma unroll
        for (int ib = 0; ib < 4; ++ib) {
            const int i = ib * 16 + fr;
            const u32x2 qr = *(const LAS u32x2*)(qs + i * 136 + wid * 16 + 4 * fq);
            const float eb = __expf(bcs[i]);
            f32x4 aq = (f32x4){bflo(qr[0]) * eb, bfhi(qr[0]) * eb, bflo(qr[1]) * eb, bfhi(qr[1]) * eb};
            f32x4 ao = (f32x4){0.f, 0.f, 0.f, 0.f};
#pragma unroll
            for (int ks = 0; ks < 2; ++ks) {
                const bf16x8 ya = *(const LAS bf16x8*)(att + i * 72 + ks * 32 + fq * 8);
                aq = mfma16(xw[ks], ya, aq); ao = mfma16(xu[ks], ya, ao);
            }
            *(u32x2*)(p.lq + item * 8192 + i * 128 + wid * 16 + 4 * fq) = pack4(aq);
            *(u32x2*)(p.lo + item * 8192 + i * 128 + wid * 16 + 4 * fq) = pack4(ao);
        }
#pragma unroll
        for (int db = 0; db < 8; ++db) {
            f32x4 aa = (f32x4){0.f, 0.f, 0.f, 0.f}, ab = (f32x4){0.f, 0.f, 0.f, 0.f};
#pragma unroll
            for (int ks = 0; ks < 2; ++ks) {
                aa = mfma16(xw[ks], *(const LAS bf16x8*)(kT + (db * 16 + fr) * 72 + ks * 32 + fq * 8), aa);
                ab = mfma16(xk[ks], *(const LAS bf16x8*)(uT + (db * 16 + fr) * 72 + ks * 32 + fq * 8), ab);
            }
            *(u32x2*)(p.la + item * 16384 + (db * 16 + fr) * 128 + wid * 16 + 4 * fq) = pack4(aa);
            *(u32x2*)(p.lb + item * 16384 + (db * 16 + fr) * 128 + wid * 16 + 4 * fq) = pack4(ab);
        }
    }
    __syncthreads();
}

__device__ __forceinline__ void ph_local(const Params& p, LAS unsigned char* lds) {
    for (int it = blockIdx.x; it < 3 * NITEM; it += gridDim.x) {
        const int tz = it % 3, ci = it / 3, chain = ci / NCHUNK, n = ci % NCHUNK;
        if (tz == 0) local_gdn(p, chain, n, lds); else local_gla(p, tz, chain, n, lds);
    }
}

__device__ __forceinline__ void seq_matrix(const Params& p, int tz, int chain, int half, LAS unsigned char* lds) {
    const int tid = opaque_tid(), wid = tid >> 6, lane = tid & 63, fr = lane & 15, fq = lane >> 4;
    const int b = chain >> 3, h = (chain >> 1) & 3, d = chain & 1;
    LAS bf16_t* ST = (LAS bf16_t*)lds;
    float* Op = p.O + (size_t)((tz == 0 ? 0 : tz == 1 ? 1 : 3) * 2 + d) * TOKW;
    f32x4 S[4];
#pragma unroll
    for (int q = 0; q < 4; ++q) S[q] = (f32x4){0.f, 0.f, 0.f, 0.f};
    const int ib = wid >> 1, dv2 = (wid & 1) * 2;
    for (int n = 0; n < NCHUNK; ++n) {
        const size_t item = (size_t)tz * NITEM + (size_t)chain * NCHUNK + n;
        bf16x8 yq[4], xa[4];
#pragma unroll
        for (int ks = 0; ks < 4; ++ks) yq[ks] = *(const bf16x8*)(p.lq + item * 8192 + (ib * 16 + fr) * 128 + ks * 32 + fq * 8);
        if (tz == 0) {
#pragma unroll
            for (int ks = 0; ks < 4; ++ks) xa[ks] = *(const bf16x8*)(p.la + ((size_t)chain * NCHUNK + n) * 16384 + (wid * 16 + fr) * 128 + ks * 32 + fq * 8);
        }
        u32x2 oin[2], bin[4];
#pragma unroll
        for (int e = 0; e < 2; ++e) oin[e] = *(const u32x2*)(p.lo + item * 8192 + (ib * 16 + fr) * 128 + half * 64 + (dv2 + e) * 16 + 4 * fq);
#pragma unroll
        for (int q = 0; q < 4; ++q) bin[q] = *(const u32x2*)(p.lb + item * 16384 + (half * 64 + q * 16 + fr) * 128 + wid * 16 + 4 * fq);
        const f32x4 dec = *(const f32x4*)(p.ld + item * 128 + wid * 16 + 4 * fq);
        LAS bf16_t* st = ST + (n & 1) * 64 * 136;
#pragma unroll
        for (int q = 0; q < 4; ++q) *(LAS u32x2*)(st + (q * 16 + fr) * 136 + wid * 16 + 4 * fq) = pack4(S[q]);
        __syncthreads();
        const int base = chunk_base(b, d, n);
        const int tok = base + (d ? 63 - (ib * 16 + fr) : ib * 16 + fr);
#pragma unroll
        for (int e = 0; e < 2; ++e) {
            f32x4 acc = (f32x4){bflo(oin[e][0]), bfhi(oin[e][0]), bflo(oin[e][1]), bfhi(oin[e][1])};
#pragma unroll
            for (int ks = 0; ks < 4; ++ks) acc = mfma16(*(const LAS bf16x8*)(st + ((dv2 + e) * 16 + fr) * 136 + ks * 32 + fq * 8), yq[ks], acc);
            *(f32x4*)(Op + (size_t)tok * MW + h * 128 + half * 64 + (dv2 + e) * 16 + 4 * fq) = acc;
        }
#pragma unroll
        for (int q = 0; q < 4; ++q) {
            f32x4 acc = (f32x4){dec[0] * S[q][0] + bflo(bin[q][0]), dec[1] * S[q][1] + bfhi(bin[q][0]), dec[2] * S[q][2] + bflo(bin[q][1]), dec[3] * S[q][3] + bfhi(bin[q][1])};
            if (tz == 0) {
#pragma unroll
                for (int ks = 0; ks < 4; ++ks) acc = mfma16(xa[ks], *(const LAS bf16x8*)(st + (q * 16 + fr) * 136 + ks * 32 + fq * 8), acc);
            }
            S[q] = acc;
        }
    }
    __syncthreads();
}

__device__ __forceinline__ void seq_lru(const Params& p, int b, int d, int cg, LAS unsigned char* lds) {
    const int tid = opaque_tid(), seg = tid >> 6, ch = cg * 64 + (tid & 63);
    LAS float* sP = (LAS float*)lds;
    LAS float* sL = sP + 512;
    const float* A = p.prep + (size_t)(PR_LA + d) * TOKW + ch; const float* U = p.prep + (size_t)(PR_LU + d) * TOKW + ch;
    float* Op = p.O + (size_t)(2 * 2 + d) * TOKW + ch;
    constexpr int SEG = (TC + TL) / 8;
    auto tok_of = [&](int pos) { return pos < TC ? NLAT + b * TC + (d ? TC - 1 - pos : pos) : b * TL + (d ? TL - 1 - (pos - TC) : pos - TC); };
    float P = 1.f, L = 0.f;
    for (int i0 = 0; i0 < SEG; i0 += 8) {
        float av[8], uv[8];
#pragma unroll
        for (int q = 0; q < 8; ++q) { const size_t o = (size_t)tok_of(seg * SEG + i0 + q) * MW; av[q] = A[o]; uv[q] = U[o]; }
#pragma unroll
        for (int q = 0; q < 8; ++q) { L = av[q] * L + uv[q]; P *= av[q]; }
    }
    sP[tid] = P; sL[tid] = L;
    __syncthreads();
    float hst = 0.f;
    for (int s = 0; s < seg; ++s) hst = sP[s * 64 + (tid & 63)] * hst + sL[s * 64 + (tid & 63)];
    for (int i0 = 0; i0 < SEG; i0 += 8) {
        float av[8], uv[8]; size_t oo[8];
#pragma unroll
        for (int q = 0; q < 8; ++q) { oo[q] = (size_t)tok_of(seg * SEG + i0 + q) * MW; av[q] = A[oo[q]]; uv[q] = U[oo[q]]; }
#pragma unroll
        for (int q = 0; q < 8; ++q) { hst = av[q] * hst + uv[q]; Op[oo[q]] = hst; }
    }
    __syncthreads();
}

__device__ __forceinline__ void ph_seq(const Params& p, LAS unsigned char* lds) {
    for (int it = blockIdx.x; it < 256; it += gridDim.x) {
        if (it < 192) { const int tz = it >> 6, r = it & 63; seq_matrix(p, tz, r >> 1, r & 1, lds); }
        else { const int r = it - 192; seq_lru(p, r >> 4, (r >> 3) & 1, r & 7, lds); }
    }
}

__device__ __forceinline__ void ph_merge(const Params& p, int l, int M) {
    const int tid = opaque_tid(), wid = tid >> 6, lane = tid & 63;
    for (int id = blockIdx.x * NWAVES + wid; id < M * 16; id += gridDim.x * NWAVES) {
        const int tok = id >> 4, r = id & 15, m = r >> 2, head = r & 3;
        const int cidx = head * 128 + lane * 2;
        const size_t o = (size_t)tok * MW + cidx;
        const f32x2 o0 = *(const f32x2*)(p.O + (size_t)(m * 2) * TOKW + o), o1 = *(const f32x2*)(p.O + (size_t)(m * 2 + 1) * TOKW + o);
        const float a0 = o0[0] + o1[0], a1 = o0[1] + o1[1];
        float y0, y1; int nbr;
        if (m == 2) {
            const unsigned u = *(const unsigned*)(p.P + (size_t)tok * NP + C_LY + cidx);
            y0 = a0 * gelu_tanhf_(bflo(u)); y1 = a1 * gelu_tanhf_(bfhi(u)); nbr = 2;
        } else {
            const float ss = wave_sum(a0 * a0 + a1 * a1);
            const float rinv = rsqrtf(ss * (1.0f / 128.0f) + 1e-6f);
            const float* gp = (m == 0 ? p.gdn_norm_g : m == 1 ? p.hgrn_norm_g : p.ret_norm_g) + l * 128 + lane * 2;
            const int zc = m == 0 ? C_GZ : m == 1 ? C_HG : C_RG;
            const unsigned u = *(const unsigned*)(p.P + (size_t)tok * NP + zc + cidx);
            y0 = a0 * rinv * gp[0] * siluf_(bflo(u)); y1 = a1 * rinv * gp[1] * siluf_(bfhi(u)); nbr = m == 3 ? 3 : m;
        }
        *(unsigned*)(p.Y + (size_t)nbr * TOKW + o) = pack2(y0, y1);
    }
}

__device__ __forceinline__ void ph_g2(const Params& p, int l, int M, LAS unsigned char* lds) {
    const StageRC s = my_stage_rc();
    const int tid = opaque_tid(), wid = tid >> 6, lane = tid & 63, wr = wid >> 1, wc = wid & 1, fr = lane & 15, fq = lane >> 4;
    const int ntm = M / 256;
    for (int u = blockIdx.x; u < ntm * 8; u += gridDim.x) {
        const int pm = u >> 3, pn = u & 7;
        f32x4 acc[4][4]; gm::zero_acc(acc);
        for (int nb = 0; nb < 4; ++nb) {
            const bf16_t* a0 = p.Y + (size_t)nb * TOKW + (size_t)(pm * 256) * MW;
            const bf16_t* Bt = p.wbT + (size_t)(l * 4 + nb) * D * MW + (size_t)(pn * 128) * MW;
            gm::kloop(lds, a0 + (size_t)s.R0 * MW + s.C0, a0 + (size_t)s.R1 * MW + s.C1, a0 + (size_t)(128 + s.R0) * MW + s.C0, a0 + (size_t)(128 + s.R1) * MW + s.C1,
                      Bt + (size_t)s.R0 * MW + s.C0, Bt + (size_t)s.R1 * MW + s.C1, MW, acc);
#pragma unroll
            for (int m = 0; m < 4; ++m)
#pragma unroll
                for (int n = 0; n < 4; ++n) {
                    const int row = pm * 256 + wr * 64 + m * 16 + fr, col = pn * 128 + wc * 64 + n * 16 + fq * 4;
                    const bf16_t* gp = p.P + (size_t)row * NP + C_MG + nb * D + col;
                    const u32x2 gu = *(const u32x2*)gp;
                    const float e0 = __expf(-bflo(gu[0])), e1 = __expf(-bfhi(gu[0])), e2 = __expf(-bflo(gu[1])), e3 = __expf(-bfhi(gu[1]));
                    float n0 = 1.f, n1 = 1.f, n2 = 1.f, n3 = 1.f;
                    if (nb < 3) { const u32x2 gn = *(const u32x2*)(gp + D);
                        n0 = 1.f + __expf(-bflo(gn[0])); n1 = 1.f + __expf(-bfhi(gn[0])); n2 = 1.f + __expf(-bflo(gn[1])); n3 = 1.f + __expf(-bfhi(gn[1])); }
                    acc[m][n][0] *= n0 / (1.f + e0); acc[m][n][1] *= n1 / (1.f + e1); acc[m][n][2] *= n2 / (1.f + e2); acc[m][n][3] *= n3 / (1.f + e3);
                }
        }
#pragma unroll
        for (int m = 0; m < 4; ++m)
#pragma unroll
            for (int n = 0; n < 4; ++n) {
                const int row = pm * 256 + wr * 64 + m * 16 + fr, col = pn * 128 + wc * 64 + n * 16 + fq * 4;
                u32x2 o; o[0] = pack2(acc[m][n][0], acc[m][n][1]); o[1] = pack2(acc[m][n][2], acc[m][n][3]);
                *(u32x2*)(p.mix + (size_t)row * D + col) = o;
            }
    }
}

__device__ __forceinline__ void ph_g3(const Params& p, int l, int M, LAS unsigned char* lds) {
    const StageRC s = my_stage_rc();
    const int tid = opaque_tid(), wid = tid >> 6, lane = tid & 63, wr = wid >> 1, wc = wid & 1, fr = lane & 15, fq = lane >> 4;
    const int ntm = M / 256;
    for (int u = blockIdx.x; u < ntm * 8; u += gridDim.x) {
        const int pm = u >> 3, pn = u & 7;
        const bf16_t* a0 = p.mix + (size_t)(pm * 256) * D;
        const bf16_t* Bt = p.woutT + (size_t)l * D * D + (size_t)(pn * 128) * D;
        f32x4 acc[4][4]; gm::zero_acc(acc);
        gm::kloop(lds, a0 + (size_t)s.R0 * D + s.C0, a0 + (size_t)s.R1 * D + s.C1, a0 + (size_t)(128 + s.R0) * D + s.C0, a0 + (size_t)(128 + s.R1) * D + s.C1,
                  Bt + (size_t)s.R0 * D + s.C0, Bt + (size_t)s.R1 * D + s.C1, D, acc);
#pragma unroll
        for (int m = 0; m < 4; ++m)
#pragma unroll
            for (int n = 0; n < 4; ++n) {
                const int row = pm * 256 + wr * 64 + m * 16 + fr, col = pn * 128 + wc * 64 + n * 16 + fq * 4;
                const float4 gt = *(const float4*)(p.mod + (size_t)(l * 5 + tok_modrow(row)) * (NMOD * D) + 2 * D + col);
                float4* xp = (float4*)(p.xl + (size_t)row * D + col);
                float4 xv = *xp;
                xv.x += gt.x * acc[m][n][0]; xv.y += gt.y * acc[m][n][1]; xv.z += gt.z * acc[m][n][2]; xv.w += gt.w * acc[m][n][3];
                *xp = xv;
            }
    }
}

__device__ __forceinline__ void ph_route(const Params& p, int l, int M, LAS unsigned char* lds) {
    LAS float* fs = (LAS float*)lds;
    LAS float* lg = fs + 32 * 1025;
    const int tid = opaque_tid(), wid = tid >> 6, lane = tid & 63;
    const float* rw = p.router_w + (size_t)l * D * NE;
    for (int it = blockIdx.x; it < M / 32; it += gridDim.x) {
        const int tok0 = it * 32;
        for (int q = 0; q < 4; ++q) {
            const int tl = wid * 4 + q, tok = tok0 + tl;
            const float* src = p.xl + (size_t)tok * D;
            float4 v[4]; float ss = 0.f;
#pragma unroll
            for (int i = 0; i < 4; ++i) { v[i] = *(const float4*)(src + i * 256 + lane * 4); ss += v[i].x * v[i].x + v[i].y * v[i].y + v[i].z * v[i].z + v[i].w * v[i].w; }
            ss = wave_sum(ss);
            const float rinv = rsqrtf(ss * (1.0f / D) + 1e-6f);
            const float* mb = p.mod + (size_t)(l * 5 + tok_modrow(tok)) * (NMOD * D);
#pragma unroll
            for (int i = 0; i < 4; ++i) {
                const int cidx = i * 256 + lane * 4;
                const float4 gv = *(const float4*)(p.norm2_g + l * D + cidx), sv = *(const float4*)(mb + 4 * D + cidx), hv = *(const float4*)(mb + 3 * D + cidx);
                const float h0 = v[i].x * rinv * gv.x * (1.f + sv.x) + hv.x, h1 = v[i].y * rinv * gv.y * (1.f + sv.y) + hv.y;
                const float h2 = v[i].z * rinv * gv.z * (1.f + sv.z) + hv.z, h3 = v[i].w * rinv * gv.w * (1.f + sv.w) + hv.w;
                u32x2 o; o[0] = pack2(h0, h1); o[1] = pack2(h2, h3);
                *(u32x2*)(p.F + (size_t)tok * D + cidx) = o;
                LAS float* fr = fs + tl * 1025 + cidx; fr[0] = h0; fr[1] = h1; fr[2] = h2; fr[3] = h3;
            }
        }
        __syncthreads();
        {
            const int tl = tid & 31, eg = tid >> 5;
            float a0 = 0.f, a1 = 0.f;
            const float* rp = rw + eg * 2;
#pragma unroll 8
            for (int k = 0; k < D; ++k) { const float f = fs[tl * 1025 + k]; const f32x2 w = *(const f32x2*)(rp + (size_t)k * NE); a0 += f * w[0]; a1 += f * w[1]; }
            lg[tl * 33 + eg * 2] = a0 + p.router_b[l * NE + eg * 2]; lg[tl * 33 + eg * 2 + 1] = a1 + p.router_b[l * NE + eg * 2 + 1];
        }
        __syncthreads();
        if (tid < 32) {
            const int tok = tok0 + tid;
            float vals[4]; int idxs[4]; unsigned used = 0u;
#pragma unroll
            for (int k = 0; k < 4; ++k) {
                float best = -3.0e38f; int bi = 0;
                for (int e = 0; e < NE; ++e) { const float v = lg[tid * 33 + e]; if (!((used >> e) & 1u) && v > best) { best = v; bi = e; } }
                used |= 1u << bi; vals[k] = best; idxs[k] = bi;
            }
            const float mx = vals[0];
            float ex[4], sum = 0.f;
#pragma unroll
            for (int k = 0; k < 4; ++k) { ex[k] = __expf(vals[k] - mx); sum += ex[k]; }
            const float inv = 1.0f / sum;
#pragma unroll
            for (int k = 0; k < 4; ++k) {
                const int e = idxs[k];
                const int slot = atomicAdd(p.cnt + l * NE + e, 1);
                p.list[(size_t)e * NTOK + slot] = tok;
                p.tokslot[(size_t)tok * 4 + k] = (e << 16) | slot;
                p.topw[(size_t)tok * 4 + k] = ex[k] * inv;
            }
        }
        __syncthreads();
    }
}

__device__ __forceinline__ void build_expert_tables(const Params& p, int l, LAS int* ts, LAS int* cn) {
    if (opaque_tid() == 0) {
        int acc = 0;
        for (int e = 0; e < NE; ++e) { const int c = __hip_atomic_load(p.cnt + l * NE + e, __ATOMIC_RELAXED, __HIP_MEMORY_SCOPE_AGENT); cn[e] = c; ts[e] = acc; acc += (c + 255) >> 8; }
        ts[NE] = acc;
    }
    __syncthreads();
}

__device__ __forceinline__ void ph_g4(const Params& p, int l, LAS unsigned char* lds) {
    LAS int* ts = (LAS int*)(lds + 6 * gm::HT); LAS int* cn = ts + 40;
    build_expert_tables(p, l, ts, cn);
    const StageRC s = my_stage_rc();
    const int tid = opaque_tid(), wid = tid >> 6, lane = tid & 63, wr = wid >> 1, wc = wid & 1, fr = lane & 15, fq = lane >> 4;
    const int MT = ts[NE];
    for (int u = blockIdx.x; u < MT * 16; u += gridDim.x) {
        const int mt = u >> 4, pn = u & 15;
        int e = 0;
        while (e < NE - 1 && ts[e + 1] <= mt) ++e;
        const int cnt = cn[e], slot0 = (mt - ts[e]) * 256;
        const int* le = p.list + (size_t)e * NTOK;
        int sl;
        sl = slot0 + s.R0;       const bf16_t* a00 = p.F + (size_t)le[sl < cnt ? sl : 0] * D + s.C0;
        sl = slot0 + s.R1;       const bf16_t* a01 = p.F + (size_t)le[sl < cnt ? sl : 0] * D + s.C1;
        sl = slot0 + 128 + s.R0; const bf16_t* a10 = p.F + (size_t)le[sl < cnt ? sl : 0] * D + s.C0;
        sl = slot0 + 128 + s.R1; const bf16_t* a11 = p.F + (size_t)le[sl < cnt ? sl : 0] * D + s.C1;
        const bf16_t* Bt = p.w1T + (size_t)(l * NE + e) * 2 * D * D + (size_t)(pn * 128) * D;
        f32x4 acc[4][4]; gm::zero_acc(acc);
        gm::kloop(lds, a00, a01, a10, a11, Bt + (size_t)s.R0 * D + s.C0, Bt + (size_t)s.R1 * D + s.C1, D, acc);
        const float* b1 = p.moe_b1 + (size_t)(l * NE + e) * 2 * D;
#pragma unroll
        for (int m = 0; m < 4; ++m)
#pragma unroll
            for (int n = 0; n < 2; ++n) {
                const int row = mt * 256 + wr * 64 + m * 16 + fr, col = pn * 64 + wc * 32 + n * 16 + fq * 4;
                const float4 bg = *(const float4*)(b1 + col), bl = *(const float4*)(b1 + D + col);
                float o[4];
#pragma unroll
                for (int q = 0; q < 4; ++q) {
                    const float glu = fminf(acc[m][n][q] + ((const float*)&bg)[q], 7.0f);
                    const float lin = fminf(fmaxf(acc[m][n + 2][q] + ((const float*)&bl)[q], -7.0f), 7.0f);
                    o[q] = glu * sigmoidf_(1.702f * glu) * (lin + 1.0f);
                }
                u32x2 ov; ov[0] = pack2(o[0], o[1]); ov[1] = pack2(o[2], o[3]);
                *(u32x2*)(p.act + (size_t)row * D + col) = ov;
            }
    }
}

__device__ __forceinline__ void ph_g5(const Params& p, int l, LAS unsigned char* lds) {
    LAS int* ts = (LAS int*)(lds + 6 * gm::HT); LAS int* cn = ts + 40;
    build_expert_tables(p, l, ts, cn);
    const StageRC s = my_stage_rc();
    const int tid = opaque_tid(), wid = tid >> 6, lane = tid & 63, wr = wid >> 1, wc = wid & 1, fr = lane & 15, fq = lane >> 4;
    const int MT = ts[NE];
    for (int u = blockIdx.x; u < MT * 8; u += gridDim.x) {
        const int mt = u >> 3, pn = u & 7;
        int e = 0;
        while (e < NE - 1 && ts[e + 1] <= mt) ++e;
        const bf16_t* a0 = p.act + (size_t)(mt * 256) * D;
        const bf16_t* Bt = p.w2T + (size_t)(l * NE + e) * D * D + (size_t)(pn * 128) * D;
        f32x4 acc[4][4]; gm::zero_acc(acc);
        gm::kloop(lds, a0 + (size_t)s.R0 * D + s.C0, a0 + (size_t)s.R1 * D + s.C1, a0 + (size_t)(128 + s.R0) * D + s.C0, a0 + (size_t)(128 + s.R1) * D + s.C1,
                  Bt + (size_t)s.R0 * D + s.C0, Bt + (size_t)s.R1 * D + s.C1, D, acc);
        const float* b2 = p.moe_b2 + (size_t)(l * NE + e) * D;
#pragma unroll
        for (int m = 0; m < 4; ++m)
#pragma unroll
            for (int n = 0; n < 4; ++n) {
                const int row = mt * 256 + wr * 64 + m * 16 + fr, col = pn * 128 + wc * 64 + n * 16 + fq * 4;
                const float4 bb = *(const float4*)(b2 + col);
                u32x2 o; o[0] = pack2(acc[m][n][0] + bb.x, acc[m][n][1] + bb.y); o[1] = pack2(acc[m][n][2] + bb.z, acc[m][n][3] + bb.w);
                *(u32x2*)(p.yp + (size_t)row * D + col) = o;
            }
    }
}

__device__ __forceinline__ void ph_combine(const Params& p, int l, int M, LAS unsigned char* lds) {
    LAS int* ts = (LAS int*)lds; LAS int* cn = ts + 40;
    build_expert_tables(p, l, ts, cn);
    const int tid = opaque_tid(), wid = tid >> 6, lane = tid & 63;
    const bool last = (l == 1);
    for (int tok = blockIdx.x * NWAVES + wid; tok < M; tok += gridDim.x * NWAVES) {
        float4 v[4];
        const float* mb = p.mod + (size_t)(l * 5 + tok_modrow(tok)) * (NMOD * D);
        int rows[4]; float wts[4];
#pragma unroll
        for (int k = 0; k < 4; ++k) { const int tsl = p.tokslot[(size_t)tok * 4 + k]; rows[k] = ts[tsl >> 16] * 256 + (tsl & 0xffff); wts[k] = p.topw[(size_t)tok * 4 + k]; }
        float ss = 0.f;
#pragma unroll
        for (int i = 0; i < 4; ++i) {
            const int cidx = i * 256 + lane * 4;
            float m0 = 0.f, m1 = 0.f, m2 = 0.f, m3 = 0.f;
#pragma unroll
            for (int k = 0; k < 4; ++k) {
                const u32x2 u = *(const u32x2*)(p.yp + (size_t)rows[k] * D + cidx);
                m0 += wts[k] * bflo(u[0]); m1 += wts[k] * bfhi(u[0]); m2 += wts[k] * bflo(u[1]); m3 += wts[k] * bfhi(u[1]);
            }
            const float4 gt = *(const float4*)(mb + 5 * D + cidx);
            float4 xv = *(const float4*)(p.xl + (size_t)tok * D + cidx);
            xv.x += gt.x * m0; xv.y += gt.y * m1; xv.z += gt.z * m2; xv.w += gt.w * m3;
            v[i] = xv; ss += xv.x * xv.x + xv.y * xv.y + xv.z * xv.z + xv.w * xv.w;
        }
        ss = wave_sum(ss);
        const float rinv = rsqrtf(ss * (1.0f / D) + 1e-6f);
        if (!last) {
#pragma unroll
            for (int i = 0; i < 4; ++i) *(float4*)(p.xl + (size_t)tok * D + i * 256 + lane * 4) = v[i];
            const float* mb1 = p.mod + (size_t)((l + 1) * 5 + tok_modrow(tok)) * (NMOD * D);
            norm_mod_store(v, rinv, p.norm1_g + (l + 1) * D, mb1 + 1 * D, mb1 + 0 * D, p.H + (size_t)tok * D, lane);
        } else {
#pragma unroll
            for (int i = 0; i < 4; ++i) {
                const int cidx = i * 256 + lane * 4;
                const float4 gv = *(const float4*)(p.final_norm_g + cidx);
                *(float4*)(p.out + (size_t)tok * D + cidx) = make_float4(v[i].x * rinv * gv.x, v[i].y * rinv * gv.y, v[i].z * rinv * gv.z, v[i].w * rinv * gv.w);
            }
        }
    }
}

#define XB_TMO      128
#define XB_XCNT(j)  (256  + 64 * (j))
#define XB_XSUB(j)  (1280 + 64 * (j))
#define XB_XGEN(j)  (2304 + 64 * (j))
#define XB_TOP      3328
#define XB_TOPGEN   3392
#define XCD_BAR_WORDS 3456
#define XB_SPIN_CAP (1u << 18)

__device__ __forceinline__ unsigned xb_ld(unsigned* p)              { return __hip_atomic_load(p, __ATOMIC_RELAXED, __HIP_MEMORY_SCOPE_AGENT); }
__device__ __forceinline__ unsigned xb_add(unsigned* p, unsigned v) { return __hip_atomic_fetch_add(p, v, __ATOMIC_RELAXED, __HIP_MEMORY_SCOPE_AGENT); }
__device__ __forceinline__ unsigned xb_xcc_id() { return (unsigned)__builtin_amdgcn_s_getreg((3 << 11) | 20) & 0xFu; }
#define XB_SPIN(cond, bar) do { unsigned _sp = 0; while (cond) { __builtin_amdgcn_s_sleep(1); \
    if ((++_sp & 255u) == 0u) { if (xb_ld(&(bar)[XB_TMO])) break; if (_sp > XB_SPIN_CAP) { atomicAdd(&(bar)[XB_TMO], 1u); break; } } } } while (0)

struct XcdBarrier {
    unsigned* bar; unsigned x;
    volatile LAS unsigned* st;
};

__device__ __forceinline__ XcdBarrier xcd_barrier_post(unsigned* bar, volatile LAS unsigned* st) {
    XcdBarrier b; b.bar = bar; b.x = xb_xcc_id(); b.st = st;
    if (threadIdx.x == 0) (void)xb_add(&bar[XB_XCNT(b.x)], 1u);
    return b;
}
__device__ __forceinline__ void xcd_barrier_complete(unsigned* bar, unsigned x, unsigned& nloc, unsigned& nx) {
    const unsigned G = gridDim.x * gridDim.y * gridDim.z;
    unsigned sum, cnt, mine, sp = 0u;
    for (;;) {
        sum = 0u; cnt = 0u; mine = 0u;
#pragma unroll
        for (unsigned j = 0; j < 16; ++j) { const unsigned c = xb_ld(&bar[XB_XCNT(j)]); sum += c; cnt += (c > 0u) ? 1u : 0u; mine = (j == x) ? c : mine; }
        if (sum == G) break;
        __builtin_amdgcn_s_sleep(1);
        if ((++sp & 255u) == 0u) { if (xb_ld(&bar[XB_TMO])) break; if (sp > XB_SPIN_CAP) { atomicAdd(&bar[XB_TMO], 1u); break; } }
    }
    nloc = mine > 0u ? mine : 1u; nx = cnt > 0u ? cnt : 1u;
}

__device__ __forceinline__ void xcd_barrier(const XcdBarrier& b) {
    asm volatile("s_waitcnt vmcnt(0)" ::: "memory");
    __syncthreads();
    if (threadIdx.x == 0) {
        unsigned* bar = b.bar;
        __builtin_amdgcn_s_waitcnt(0);
        unsigned nloc = b.st[0], nx = b.st[1];
        if (nloc == 0u) { xcd_barrier_complete(bar, b.x, nloc, nx); b.st[0] = nloc; b.st[1] = nx; }
        const unsigned old = xb_add(&bar[XB_XSUB(b.x)], 1u);
        const unsigned gen = old / nloc;
        if (old + 1u == (gen + 1u) * nloc) {
            __builtin_amdgcn_fence(__ATOMIC_RELEASE, "agent");
            asm volatile("s_waitcnt vmcnt(0)" ::: "memory");
            const unsigned og = xb_add(&bar[XB_TOP], 1u);
            const unsigned tg = og / nx;
            if (og + 1u == (tg + 1u) * nx) xb_add(&bar[XB_TOPGEN], 1u);
            else XB_SPIN(xb_ld(&bar[XB_TOPGEN]) == tg, bar);
            __builtin_amdgcn_fence(__ATOMIC_ACQUIRE, "agent");
            xb_add(&bar[XB_XGEN(b.x)], 1u);
            asm volatile("s_waitcnt vmcnt(0)" ::: "memory");
        } else {
            XB_SPIN(xb_ld(&bar[XB_XGEN(b.x)]) == gen, bar);
            __builtin_amdgcn_fence(__ATOMIC_ACQUIRE, "agent");
            asm volatile("s_waitcnt vmcnt(0)" ::: "memory");
        }
    }
    __syncthreads();
}


extern __shared__ __attribute__((aligned(16))) unsigned char dyn_lds[];
#define KPH(name, call) __global__ void __launch_bounds__(NTHREADS, 2) name(Params p, int l, int M) { LAS unsigned char* lds = (LAS unsigned char*)dyn_lds; (void)l; (void)M; (void)lds; call; }
KPH(k_convert, { ph_convert(p, lds); })
KPH(k_mod, { ph_mod(p, lds); })
KPH(k_norm1, { ph_norm1_first(p); })
KPH(k_g1, { ph_g1(p, l, lds); })
KPH(k_prep, { ph_prep(p, l, lds); })
KPH(k_local, { ph_local(p, lds); })
KPH(k_seq, { ph_seq(p, lds); })
KPH(k_merge, { ph_merge(p, l, M); })
KPH(k_g2, { ph_g2(p, l, M, lds); })
KPH(k_g3, { ph_g3(p, l, M, lds); })
KPH(k_route, { ph_route(p, l, M, lds); })
KPH(k_g4, { ph_g4(p, l, lds); })
KPH(k_g5, { ph_g5(p, l, lds); })
KPH(k_combine, { ph_combine(p, l, M, lds); })


__global__ void __launch_bounds__(NTHREADS, 2) k_mega(Params p) {
    LAS unsigned char* lds = (LAS unsigned char*)dyn_lds;
    volatile LAS unsigned* xb_words = (volatile LAS unsigned*)(lds + LDS_BYTES - 16);
    if (threadIdx.x == 0) { xb_words[0] = 0u; xb_words[1] = 0u; xb_words[2] = 0u; xb_words[3] = 0u; }
    __syncthreads();
    XcdBarrier bar = xcd_barrier_post(p.bar, xb_words);
    ph_convert(p, lds);
    ph_mod(p, lds);
    xcd_barrier(bar);
    ph_norm1_first(p);
    xcd_barrier(bar);
    for (int l = 0; l < 2; ++l) {
        const int M = l == 0 ? NTOK : NLAT;
        ph_g1(p, l, lds);
        xcd_barrier(bar);
        ph_prep(p, l, lds);
        xcd_barrier(bar);
        ph_local(p, lds);
        xcd_barrier(bar);
        ph_seq(p, lds);
        xcd_barrier(bar);
        ph_merge(p, l, M);
        xcd_barrier(bar);
        ph_g2(p, l, M, lds);
        xcd_barrier(bar);
        ph_g3(p, l, M, lds);
        xcd_barrier(bar);
        ph_route(p, l, M, lds);
        xcd_barrier(bar);
        ph_g4(p, l, lds);
        xcd_barrier(bar);
        ph_g5(p, l, lds);
        xcd_barrier(bar);
        ph_combine(p, l, M, lds);
        if (l == 0) xcd_barrier(bar);
    }
}

static inline size_t align_up(size_t v, size_t a) { return (v + a - 1) / a * a; }

extern "C" void kernel_launch(void* const* d_in, const int* in_sizes, int n_in, void* d_out, int out_size, void* d_ws, size_t ws_size, hipStream_t stream) {
    (void)in_sizes; (void)n_in; (void)out_size;
    Params p{};
    const float** pf = (const float**)&p;
    for (int i = 0; i < 32; ++i) pf[i] = (const float*)d_in[i];
    p.out = (float*)d_out;
    unsigned char* w = (unsigned char*)d_ws; size_t off = 0;
    auto take = [&](size_t bytes) { void* r = w + off; off = align_up(off + bytes, 256); return r; };
    p.bar = (unsigned*)take(16384);
    p.cnt = (int*)take(1024);
    const size_t ctl_bytes = off;
    p.mod = (float*)take((size_t)2 * 5 * NMOD * D * 4);
    p.winT = (bf16_t*)take((size_t)2 * NP * D * 2);
    p.wbT = (bf16_t*)take((size_t)2 * 4 * D * MW * 2);
    p.woutT = (bf16_t*)take((size_t)2 * D * D * 2);
    p.w1T = (bf16_t*)take((size_t)2 * NE * 2 * D * D * 2);
    p.w2T = (bf16_t*)take((size_t)2 * NE * D * D * 2);
    p.xl = (float*)take((size_t)NTOK * D * 4);
    p.H = (bf16_t*)take((size_t)NTOK * D * 2);
    p.P = (bf16_t*)take((size_t)NTOK * NP * 2);
    p.act = p.P; p.yp = p.P + (size_t)CAPROWS * D;
    p.prep = (float*)take(NPREP * TOKW * 4);
    p.gg = (float*)take((size_t)NTOK * 8 * 4);
    p.gb = (float*)take((size_t)NTOK * 8 * 4);
    p.O = p.prep;
    p.lq = (bf16_t*)take((size_t)3 * NITEM * 64 * 128 * 2);
    p.lo = (bf16_t*)take((size_t)3 * NITEM * 64 * 128 * 2);
    p.lb = (bf16_t*)take((size_t)3 * NITEM * 128 * 128 * 2);
    p.la = (bf16_t*)take((size_t)NITEM * 128 * 128 * 2);
    p.ld = (float*)take((size_t)3 * NITEM * 128 * 4);
    p.Y = (bf16_t*)take(4 * TOKW * 2);
    p.mix = (bf16_t*)take((size_t)NTOK * D * 2);
    p.F = p.H;
    p.list = (int*)take((size_t)NE * NTOK * 4);
    p.tokslot = (int*)take((size_t)NTOK * 4 * 4);
    p.topw = (float*)take((size_t)NTOK * 4 * 4);
    if (off > ws_size) { fprintf(stderr, "workspace too small: need %zu have %zu\n", off, ws_size); return; }

    static int grid = 0;
#if MEGA
    if (!grid) {
        int dev = 0, cus = 0, occ = 0; (void)hipGetDevice(&dev); (void)hipDeviceGetAttribute(&cus, hipDeviceAttributeMultiprocessorCount, dev);
        (void)hipFuncSetAttribute((const void*)k_mega, hipFuncAttributeMaxDynamicSharedMemorySize, LDS_BYTES);
        (void)hipOccupancyMaxActiveBlocksPerMultiprocessor(&occ, (const void*)k_mega, NTHREADS, LDS_BYTES);
        if (cus <= 0) cus = 256;
        grid = cus * (occ < 1 ? 1 : 1);
        if (occ < 1) fprintf(stderr, "occupancy query says %d blocks per CU\n", occ);
    }
    (void)hipMemsetAsync(d_ws, 0, ctl_bytes, stream);
    hipLaunchKernelGGL(k_mega, dim3(grid), dim3(NTHREADS), LDS_BYTES, stream, p);
#else
    if (!grid) {
        int dev = 0, cus = 0; (void)hipGetDevice(&dev); (void)hipDeviceGetAttribute(&cus, hipDeviceAttributeMultiprocessorCount, dev);
        grid = cus > 0 ? cus : 256;
        const void* ks[] = {(const void*)k_convert, (const void*)k_mod, (const void*)k_norm1, (const void*)k_g1, (const void*)k_prep, (const void*)k_local, (const void*)k_seq, (const void*)k_merge,
                            (const void*)k_g2, (const void*)k_g3, (const void*)k_route, (const void*)k_g4, (const void*)k_g5, (const void*)k_combine};
        for (const void* k : ks) (void)hipFuncSetAttribute(k, hipFuncAttributeMaxDynamicSharedMemorySize, LDS_BYTES);
    }
    (void)hipMemsetAsync(d_ws, 0, ctl_bytes, stream);
#define LAUNCH(k, l, M) hipLaunchKernelGGL(k, dim3(grid), dim3(NTHREADS), LDS_BYTES, stream, p, l, M)
    LAUNCH(k_convert, 0, 0);
    LAUNCH(k_mod, 0, 0);
    LAUNCH(k_norm1, 0, 0);
    for (int l = 0; l < 2; ++l) {
        const int M = l == 0 ? NTOK : NLAT;
        LAUNCH(k_g1, l, M);
        LAUNCH(k_prep, l, M);
        LAUNCH(k_local, l, M);
        LAUNCH(k_seq, l, M);
        LAUNCH(k_merge, l, M);
        LAUNCH(k_g2, l, M);
        LAUNCH(k_g3, l, M);
        LAUNCH(k_route, l, M);
        LAUNCH(k_g4, l, M);
        LAUNCH(k_g5, l, M);
        LAUNCH(k_combine, l, M);
    }
#endif
}
```

```cpp
#include <hip/hip_runtime.h>
#include <stdint.h>
#include <stdio.h>

#define LAS __attribute__((address_space(3)))
typedef unsigned short bf16_t;
typedef short bf16x8 __attribute__((ext_vector_type(8)));
typedef float f32x4 __attribute__((ext_vector_type(4)));
typedef float f32x2 __attribute__((ext_vector_type(2)));
typedef unsigned u32x2 __attribute__((ext_vector_type(2)));
typedef unsigned u32x4 __attribute__((ext_vector_type(4)));

#ifndef MEGA
#define MEGA 1
#endif
#ifndef PROBE
#define PROBE 0
#endif

constexpr int D = 1024, NB = 4, TL = 4096, TC = 256, NLAT = NB * TL, NCTX = NB * TC, NTOK = NLAT + NCTX;
constexpr int NIN = 11792, NP = 12032, MW = 512, NE = 32, TOPK = 4, NMOD = 6;
constexpr int C_GQKV = 0, C_GZ = 1536, C_GA = 2048, C_GB = 2056, C_HQ = 2064, C_HI = 2576, C_HF = 3088, C_HG = 4112, C_LX = 4624,
              C_LY = 5136, C_RQKV = 5648, C_RG = 7184, C_MG = 7696;
constexpr int NTHREADS = 512, NWAVES = 8;
constexpr int LDS_BYTES = 140 * 1024;
constexpr int CAPROWS = 77824;
constexpr size_t TOKW = (size_t)NTOK * MW;
constexpr int PR_LA = 0, PR_LU = 2, NPREP = 4;
constexpr int NCHUNK = 68, NITEM = 32 * NCHUNK;

struct Params {
    const float *x, *c, *ctx, *c_ctx, *w_mod, *b_mod, *norm1_g, *norm2_g, *w_in, *gdn_conv_w, *gdn_a_log, *gdn_dt_bias, *gdn_norm_g, *hgrn_lb,
        *hgrn_norm_g, *lru_conv_w, *lru_conv_b, *lru_wa, *lru_ba, *lru_wx, *lru_bx, *lru_lambda, *ret_norm_g, *w_branch, *w_out, *router_w,
        *router_b, *moe_w1, *moe_b1, *moe_w2, *moe_b2, *final_norm_g;
    float* out;
    unsigned* bar; int* cnt; float* mod;
    bf16_t *winT, *wbT, *woutT, *w1T, *w2T;
    float* xl; bf16_t* H; bf16_t* P; float* prep; float* gg; float* gb; float* O; bf16_t* Y; bf16_t* mix; bf16_t* F;
    int* list; int* tokslot; float* topw; bf16_t* act; bf16_t* yp;
    bf16_t *lq, *lo, *lb, *la; float* ld;
};

__device__ __forceinline__ unsigned f2bf(float f) { unsigned u = __float_as_uint(f); u += 0x7fffu + ((u >> 16) & 1u); return u >> 16; }
__device__ __forceinline__ unsigned pack2(float a, float b) { return f2bf(a) | (f2bf(b) << 16); }
__device__ __forceinline__ float bf2f(bf16_t b) { return __uint_as_float(((unsigned)b) << 16); }
__device__ __forceinline__ float bflo(unsigned u) { return __uint_as_float(u << 16); }
__device__ __forceinline__ float bfhi(unsigned u) { return __uint_as_float(u & 0xffff0000u); }
__device__ __forceinline__ float sigmoidf_(float x) { return 1.0f / (1.0f + __expf(-x)); }
__device__ __forceinline__ float siluf_(float x) { return x * sigmoidf_(x); }
__device__ __forceinline__ float softplusf_(float x) { return x > 20.f ? x : log1pf(__expf(x)); }
__device__ __forceinline__ float logsigmoidf_(float x) { return -softplusf_(-x); }
__device__ __forceinline__ float gelu_tanhf_(float x) { const float u = 0.7978845608028654f * (x + 0.044715f * x * x * x); return 0.5f * x * (1.0f + tanhf(u)); }
__device__ __forceinline__ float wave_sum(float v) {
#pragma unroll
    for (int m = 32; m >= 1; m >>= 1) v += __shfl_xor(v, m);
    return v;
}
__device__ __forceinline__ int opaque_tid() { int t = threadIdx.x; asm volatile("" : "+v"(t)); return t; }
__device__ __forceinline__ int tok_modrow(int tok) { return tok < NLAT ? (tok >> 12) : 4; }
__device__ __forceinline__ void tok_info(int tok, int& t, int& T, int& base) {
    if (tok < NLAT) { t = tok & (TL - 1); T = TL; base = tok - t; }
    else { t = (tok - NLAT) & (TC - 1); T = TC; base = tok - t; }
}

namespace gm {
constexpr int HT = 16384;
__device__ __forceinline__ int lds_byte(int r, int c) { const int st = (r >> 4) * 2 + (c >> 5), rr = r & 15, cc = c & 31, ob = rr * 64 + cc * 2; return st * 1024 + (ob ^ (((ob >> 9) & 1) << 5)); }
__device__ __forceinline__ void stage_rc(int b, int& R, int& C) { const int st = b / 1024, sb = b % 1024, swz = sb ^ (((sb >> 9) & 1) << 5); R = (st >> 1) * 16 + swz / 64; C = (st & 1) * 32 + (swz % 64) / 2; }

__device__ __forceinline__ void kloop(LAS unsigned char* lds, const bf16_t* ap00, const bf16_t* ap01, const bf16_t* ap10, const bf16_t* ap11,
                                      const bf16_t* bp0, const bf16_t* bp1, int K, f32x4 (&acc)[4][4]) {
    const int tid = opaque_tid(), wid = __builtin_amdgcn_readfirstlane(tid >> 6), lane = tid & 63, wr = wid >> 1, wc = wid & 1, fr = lane & 15, fq = lane >> 4;
    const unsigned ldsw = (unsigned)wid * 1024u;
    const int aoff = (wr >> 1) * HT + lds_byte((wr & 1) * 64 + fr, fq * 8);
    const int boff = 2 * HT + lds_byte(wc * 64 + fr, fq * 8);
    const int nt = K / 64;
#define GM_GLDS(src, dstoff) __builtin_amdgcn_global_load_lds((const unsigned*)(src), (LAS unsigned*)(lds + (dstoff)), 16, 0, 0)
#define GM_STAGE(buf, kt) do { const int _bo = (buf) * 3 * HT + ldsw; const int _ko = (kt) * 64; \
        GM_GLDS(ap00 + _ko, _bo); GM_GLDS(ap01 + _ko, _bo + 8192); GM_GLDS(ap10 + _ko, _bo + HT); GM_GLDS(ap11 + _ko, _bo + HT + 8192); \
        GM_GLDS(bp0 + _ko, _bo + 2 * HT); GM_GLDS(bp1 + _ko, _bo + 2 * HT + 8192); } while (0)
    GM_STAGE(0, 0);
    for (int t = 0; t < nt; ++t) {
        const int cur = t & 1;
        if (t + 1 < nt) { GM_STAGE(cur ^ 1, t + 1); asm volatile("s_waitcnt vmcnt(6)" ::: "memory"); }
        else asm volatile("s_waitcnt vmcnt(0)" ::: "memory");
        __builtin_amdgcn_s_barrier(); asm volatile("" ::: "memory");
        bf16x8 af[4][2], bfr[4][2];
#pragma unroll
        for (int m = 0; m < 4; ++m)
#pragma unroll
            for (int k = 0; k < 2; ++k) af[m][k] = *(const LAS bf16x8*)(lds + cur * 3 * HT + aoff + m * 2048 + k * 1024);
#pragma unroll
        for (int n = 0; n < 4; ++n)
#pragma unroll
            for (int k = 0; k < 2; ++k) bfr[n][k] = *(const LAS bf16x8*)(lds + cur * 3 * HT + boff + n * 2048 + k * 1024);
#pragma unroll
        for (int k = 0; k < 2; ++k)
#pragma unroll
            for (int m = 0; m < 4; ++m)
#pragma unroll
                for (int n = 0; n < 4; ++n) acc[m][n] = __builtin_amdgcn_mfma_f32_16x16x32_bf16(bfr[n][k], af[m][k], acc[m][n], 0, 0, 0);
        asm volatile("s_waitcnt lgkmcnt(0)" ::: "memory");
        __builtin_amdgcn_s_barrier(); asm volatile("" ::: "memory");
    }
#undef GM_STAGE
#undef GM_GLDS
}
__device__ __forceinline__ void zero_acc(f32x4 (&acc)[4][4]) {
#pragma unroll
    for (int m = 0; m < 4; ++m)
#pragma unroll
        for (int n = 0; n < 4; ++n) acc[m][n] = (f32x4){0.f, 0.f, 0.f, 0.f};
}
}

struct StageRC { int R0, C0, R1, C1; };
__device__ __forceinline__ StageRC my_stage_rc() { const int t = opaque_tid(); StageRC s; gm::stage_rc(t * 16, s.R0, s.C0); gm::stage_rc(t * 16 + 8192, s.R1, s.C1); return s; }

__device__ __forceinline__ int w1_dst_row(int n) { const int half = n >> 10, cc = n & 1023; return (cc >> 6) * 128 + ((cc >> 5) & 1) * 64 + half * 32 + (cc & 31); }

__device__ __forceinline__ void cvt_tile(LAS float* tile, const float* src, int ldsrc, int Nsrc, int k0, int n0, bf16_t* dst, int K, int mode) {
    const int tid = opaque_tid();
    {
        const int rr = tid >> 6, cc = tid & 63, n = n0 + cc;
#pragma unroll
        for (int i = 0; i < 8; ++i) { const int k = rr + i * 8; tile[k * 65 + cc] = (n < Nsrc) ? src[(size_t)(k0 + k) * ldsrc + n] : 0.f; }
    }
    __syncthreads();
    {
        const int nl = tid >> 3, kg = tid & 7, n = n0 + nl;
        float v[8];
#pragma unroll
        for (int j = 0; j < 8; ++j) v[j] = tile[(kg * 8 + j) * 65 + nl];
        const int drow = mode == 1 ? w1_dst_row(n) : n;
        u32x4 o; o[0] = pack2(v[0], v[1]); o[1] = pack2(v[2], v[3]); o[2] = pack2(v[4], v[5]); o[3] = pack2(v[6], v[7]);
        *(u32x4*)(dst + (size_t)drow * K + k0 + kg * 8) = o;
    }
    __syncthreads();
}

__device__ __forceinline__ void ph_convert(const Params& p, LAS unsigned char* lds) {
    LAS float* tile = (LAS float*)lds;
    constexpr int PER_L = 3008 + 512 + 256 + 16384 + 8192;
    for (int it = blockIdx.x; it < 2 * PER_L; it += gridDim.x) {
        const int l = it / PER_L; int r = it % PER_L;
        if (r < 3008) { const int nt = r % 188, kt = r / 188; cvt_tile(tile, p.w_in + (size_t)l * D * NIN, NIN, NIN, kt * 64, nt * 64, p.winT + (size_t)l * NP * D, D, 0); }
        else if (r < 3520) { r -= 3008; const int n = r / 128; r %= 128; const int nt = r % 16, kt = r / 16;
            cvt_tile(tile, p.w_branch + (size_t)(l * 4 + n) * MW * D, D, D, kt * 64, nt * 64, p.wbT + (size_t)(l * 4 + n) * D * MW, MW, 0); }
        else if (r < 3776) { r -= 3520; const int nt = r % 16, kt = r / 16; cvt_tile(tile, p.w_out + (size_t)l * D * D, D, D, kt * 64, nt * 64, p.woutT + (size_t)l * D * D, D, 0); }
        else if (r < 3776 + 16384) { r -= 3776; const int e = r / 512; r %= 512; const int nt = r % 32, kt = r / 32;
            cvt_tile(tile, p.moe_w1 + (size_t)(l * NE + e) * D * 2 * D, 2 * D, 2 * D, kt * 64, nt * 64, p.w1T + (size_t)(l * NE + e) * 2 * D * D, D, 1); }
        else { r -= 3776 + 16384; const int e = r / 256; r %= 256; const int nt = r % 16, kt = r / 16;
            cvt_tile(tile, p.moe_w2 + (size_t)(l * NE + e) * D * D, D, D, kt * 64, nt * 64, p.w2T + (size_t)(l * NE + e) * D * D, D, 0); }
    }
}

__device__ __forceinline__ void ph_mod(const Params& p, LAS unsigned char* lds) {
    LAS float* sc = (LAS float*)lds;
    LAS float* red = sc + 5 * D;
    const int tid = opaque_tid(), wid = tid >> 6, lane = tid & 63;
    if ((int)blockIdx.x >= 192) return;
    for (int i = tid; i < 5 * D; i += NTHREADS) { const int r = i >> 10, k = i & 1023; const float v = r < 4 ? p.c[r * D + k] : p.c_ctx[k]; sc[i] = siluf_(v); }
    __syncthreads();
    for (int it = blockIdx.x; it < 192; it += gridDim.x) {
        const int l = it / 96, n0 = (it % 96) * 64;
        float acc[5] = {0.f, 0.f, 0.f, 0.f, 0.f};
        const float* wp = p.w_mod + (size_t)l * D * (NMOD * D) + n0 + lane;
        for (int k = wid * 128; k < wid * 128 + 128; ++k) {
            const float wv = wp[(size_t)k * (NMOD * D)];
#pragma unroll
            for (int r = 0; r < 5; ++r) acc[r] += sc[r * D + k] * wv;
        }
#pragma unroll
        for (int r = 0; r < 5; ++r) red[(wid * 5 + r) * 64 + lane] = acc[r];
        __syncthreads();
        if (tid < 320) { const int r = tid >> 6, cidx = tid & 63; float s = p.b_mod[l * NMOD * D + n0 + cidx];
#pragma unroll
            for (int w = 0; w < 8; ++w) s += red[(w * 5 + r) * 64 + cidx];
            p.mod[(size_t)(l * 5 + r) * (NMOD * D) + n0 + cidx] = s; }
        __syncthreads();
    }
}

__device__ __forceinline__ void norm_mod_store(const float4 (&v)[4], float rinv, const float* g, const float* scp, const float* shp, bf16_t* dst, int lane) {
#pragma unroll
    for (int i = 0; i < 4; ++i) {
        const int cidx = i * 256 + lane * 4;
        const float4 gv = *(const float4*)(g + cidx), sv = *(const float4*)(scp + cidx), hv = *(const float4*)(shp + cidx);
        const float h0 = v[i].x * rinv * gv.x * (1.f + sv.x) + hv.x, h1 = v[i].y * rinv * gv.y * (1.f + sv.y) + hv.y;
        const float h2 = v[i].z * rinv * gv.z * (1.f + sv.z) + hv.z, h3 = v[i].w * rinv * gv.w * (1.f + sv.w) + hv.w;
        u32x2 o; o[0] = pack2(h0, h1); o[1] = pack2(h2, h3);
        *(u32x2*)(dst + cidx) = o;
    }
}
__device__ __forceinline__ void ph_norm1_first(const Params& p) {
    const int tid = opaque_tid(), wid = tid >> 6, lane = tid & 63;
    for (int tok = blockIdx.x * NWAVES + wid; tok < NTOK; tok += gridDim.x * NWAVES) {
        const float* src = tok < NLAT ? p.x + (size_t)tok * D : p.ctx + (size_t)(tok - NLAT) * D;
        float4 v[4]; float ss = 0.f;
#pragma unroll
        for (int i = 0; i < 4; ++i) { v[i] = *(const float4*)(src + i * 256 + lane * 4); ss += v[i].x * v[i].x + v[i].y * v[i].y + v[i].z * v[i].z + v[i].w * v[i].w; }
        ss = wave_sum(ss);
        const float rinv = rsqrtf(ss * (1.0f / D) + 1e-6f);
        const float* mb = p.mod + (size_t)(0 * 5 + tok_modrow(tok)) * (NMOD * D);
        norm_mod_store(v, rinv, p.norm1_g, mb + 1 * D, mb + 0 * D, p.H + (size_t)tok * D, lane);
#pragma unroll
        for (int i = 0; i < 4; ++i) *(float4*)(p.xl + (size_t)tok * D + i * 256 + lane * 4) = v[i];
    }
}

__device__ __forceinline__ void ph_g1(const Params& p, int l, LAS unsigned char* lds) {
    const StageRC s = my_stage_rc();
    const int tid = opaque_tid(), wid = tid >> 6, lane = tid & 63, wr = wid >> 1, wc = wid & 1, fr = lane & 15, fq = lane >> 4;
    const bf16_t* Bt = p.winT + (size_t)l * NP * D;
    constexpr int NTN = 93, NTM = NTOK / 256;
    for (int u = blockIdx.x; u < NTM * NTN; u += gridDim.x) {
        const int pm = u / NTN, pn = u % NTN;
        const bf16_t* a0 = p.H + (size_t)(pm * 256) * D;
        f32x4 acc[4][4]; gm::zero_acc(acc);
        gm::kloop(lds, a0 + (size_t)s.R0 * D + s.C0, a0 + (size_t)s.R1 * D + s.C1, a0 + (size_t)(128 + s.R0) * D + s.C0, a0 + (size_t)(128 + s.R1) * D + s.C1,
                  Bt + (size_t)(pn * 128 + s.R0) * D + s.C0, Bt + (size_t)(pn * 128 + s.R1) * D + s.C1, D, acc);
#pragma unroll
        for (int m = 0; m < 4; ++m)
#pragma unroll
            for (int n = 0; n < 4; ++n) {
                const int row = pm * 256 + wr * 64 + m * 16 + fr, col = pn * 128 + wc * 64 + n * 16 + fq * 4;
                u32x2 o; o[0] = pack2(acc[m][n][0], acc[m][n][1]); o[1] = pack2(acc[m][n][2], acc[m][n][3]);
                *(u32x2*)(p.P + (size_t)row * NP + col) = o;
            }
    }
}

__device__ __forceinline__ void ph_prep(const Params& p, int l, LAS unsigned char* lds) {
    const int tid = opaque_tid();
    {
        LAS float* xs = (LAS float*)lds;
        LAS float* wsm = xs + 64 * 65;
        for (int it = blockIdx.x; it < (NTOK / 64) * 8; it += gridDim.x) {
            const int tile = it >> 3, n = it & 7, tok0 = tile * 64;
            {
                const int tl = tid & 63, cg = tid >> 6, tok = tok0 + tl;
                int t, T, base; tok_info(tok, t, T, base);
                float a[8];
#pragma unroll
                for (int j = 0; j < 8; ++j) a[j] = p.lru_conv_b[l * MW + n * 64 + cg * 8 + j];
#pragma unroll
                for (int j = 0; j < 4; ++j) {
                    const int tt = t + j - 2;
                    if (tt >= 0 && tt < T) {
                        const u32x4 u = *(const u32x4*)(p.P + (size_t)(base + tt) * NP + C_LX + n * 64 + cg * 8);
                        const float* w = p.lru_conv_w + (size_t)(l * 4 + j) * MW + n * 64 + cg * 8;
#pragma unroll
                        for (int q = 0; q < 4; ++q) { a[2 * q] += w[2 * q] * bflo(u[q]); a[2 * q + 1] += w[2 * q + 1] * bfhi(u[q]); }
                    }
                }
#pragma unroll
                for (int j = 0; j < 8; ++j) xs[tl * 65 + cg * 8 + j] = a[j];
                for (int i = tid; i < 4 * 1024; i += NTHREADS) {
                    const int mat = i >> 10, off = (i & 1023) * 4, d = mat >> 1;
                    const float* srcw = ((mat & 1) ? p.lru_wx : p.lru_wa) + (size_t)((l * 2 + d) * 8 + n) * 4096 + off;
                    const float4 v = *(const float4*)srcw;
                    LAS float* dw = wsm + mat * 4096 + off; dw[0] = v.x; dw[1] = v.y; dw[2] = v.z; dw[3] = v.w;
                }
            }
            __syncthreads();
            {
                const int tl = tid & 63, jg = tid >> 6, tok = tok0 + tl;
                float acc[4][8];
#pragma unroll
                for (int m = 0; m < 4; ++m)
#pragma unroll
                    for (int j = 0; j < 8; ++j) acc[m][j] = 0.f;
                for (int i = 0; i < 64; ++i) {
                    const float xv = xs[tl * 65 + i];
#pragma unroll
                    for (int m = 0; m < 4; ++m)
#pragma unroll
                        for (int j = 0; j < 8; ++j) acc[m][j] += xv * wsm[m * 4096 + i * 64 + jg * 8 + j];
                }
#pragma unroll
                for (int d = 0; d < 2; ++d) {
                    float av[8], uv[8];
#pragma unroll
                    for (int j = 0; j < 8; ++j) {
                        const int cidx = n * 64 + jg * 8 + j, pi = (l * 2 + d) * MW + cidx;
                        const float gr = sigmoidf_(acc[d * 2][j] + p.lru_ba[pi]), gi = sigmoidf_(acc[d * 2 + 1][j] + p.lru_bx[pi]);
                        const float la = 8.0f * gr * logsigmoidf_(p.lru_lambda[pi]);
                        av[j] = __expf(la);
                        uv[j] = xs[tl * 65 + jg * 8 + j] * gi * sqrtf(fmaxf(-expm1f(2.0f * la), 1e-12f));
                    }
                    float* da = p.prep + (PR_LA + d) * TOKW + (size_t)tok * MW + n * 64 + jg * 8;
                    float* du = p.prep + (PR_LU + d) * TOKW + (size_t)tok * MW + n * 64 + jg * 8;
                    *(float4*)da = make_float4(av[0], av[1], av[2], av[3]); *(float4*)(da + 4) = make_float4(av[4], av[5], av[6], av[7]);
                    *(float4*)du = make_float4(uv[0], uv[1], uv[2], uv[3]); *(float4*)(du + 4) = make_float4(uv[4], uv[5], uv[6], uv[7]);
                }
            }
            __syncthreads();
        }
    }
}

__device__ __forceinline__ int chunk_base(int b, int d, int n) {
    if (n < 4) { const int blk = d ? 3 - n : n; return NLAT + b * TC + blk * 64; }
    const int m = n - 4, blk = d ? 63 - m : m; return b * TL + blk * 64;
}
__device__ __forceinline__ f32x4 mfma16(bf16x8 a, bf16x8 b, f32x4 c) { return __builtin_amdgcn_mfma_f32_16x16x32_bf16(a, b, c, 0, 0, 0); }
__device__ __forceinline__ u32x2 pack4(f32x4 v) { u32x2 o; o[0] = pack2(v[0], v[1]); o[1] = pack2(v[2], v[3]); return o; }
__device__ __forceinline__ u32x4 pack8(const float* v) { u32x4 o; o[0] = pack2(v[0], v[1]); o[1] = pack2(v[2], v[3]); o[2] = pack2(v[4], v[5]); o[3] = pack2(v[6], v[7]); return o; }

__device__ __forceinline__ void local_gla(const Params& p, int l, int tz, int chain, int n, LAS unsigned char* lds) {
    const int tid = opaque_tid(), wid = tid >> 6, lane = tid & 63, fr = lane & 15, fq = lane >> 4;
    const int b = chain >> 3, h = (chain >> 1) & 3, d = chain & 1;
    const int base = chunk_base(b, d, n);
    const size_t item = (size_t)tz * NITEM + (size_t)chain * NCHUNK + n;
    LAS bf16_t* kraw = (LAS bf16_t*)lds;
    LAS bf16_t* qh = kraw + 64 * 136;
    LAS bf16_t* kh = qh + 64 * 136;
    LAS bf16_t* sc = kh + 64 * 136;
    LAS bf16_t* vT = sc + 64 * 72;
    LAS bf16_t* kT = vT + 128 * 72;
    LAS float* bc = (LAS float*)(kT + 128 * 72);
    const int vcol = tz == 1 ? C_HI : C_RQKV + 1024;
    const int ti = tid >> 3, dg = tid & 7, cA = dg * 8, cB = 64 + dg * 8;
    const int tokI = base + (d ? 63 - ti : ti);
    const bf16_t* pr = p.P + (size_t)tokI * NP;
    float qt[16];
    {
        float kv[16], lfv[16];
        if (tz == 1) {
            const u32x4 uqa = *(const u32x4*)(pr + C_HQ + h * 128 + cA), uqb = *(const u32x4*)(pr + C_HQ + h * 128 + cB);
            const u32x4 uza = *(const u32x4*)(pr + C_HF + d * 512 + h * 128 + cA), uzb = *(const u32x4*)(pr + C_HF + d * 512 + h * 128 + cB);
#pragma unroll
            for (int e = 0; e < 16; ++e) {
                const unsigned uq = e < 8 ? uqa[(e & 7) >> 1] : uqb[(e & 7) >> 1], uz = e < 8 ? uza[(e & 7) >> 1] : uzb[(e & 7) >> 1];
                const float qraw = (e & 1) ? bfhi(uq) : bflo(uq), z = (e & 1) ? bfhi(uz) : bflo(uz);
                const int ch = h * 128 + (e < 8 ? cA + e : cB + e - 8);
                float lb = 0.f;
                if (l == 1) lb = fminf(1.0f / (1.0f + __expf(p.hgrn_lb[(size_t)(0 * 2 + d) * MW + ch] - p.hgrn_lb[(size_t)(1 * 2 + d) * MW + ch])), 1.0f - 1e-4f);
                const float sg = sigmoidf_(z);
                qt[e] = siluf_(qraw) * 0.08838834764831845f;
                kv[e] = (1.f - lb) * (1.f - sg);
                lfv[e] = __logf(fmaxf(lb + (1.f - lb) * sg, 1e-30f));
            }
        } else {
            const bf16_t* rp = pr + C_RQKV + h * 128;
            const u32x4 q1 = *(const u32x4*)(rp + cA), q2 = *(const u32x4*)(rp + cB), k1 = *(const u32x4*)(rp + 512 + cA), k2 = *(const u32x4*)(rp + 512 + cB);
            const float lng = log1pf(-exp2f(-5.0f - (float)h));
            const bool lat = tokI < NLAT;
            const int t = tokI & (TL - 1);
#pragma unroll
            for (int e = 0; e < 8; ++e) {
                float a1 = (e & 1) ? bfhi(q1[e >> 1]) : bflo(q1[e >> 1]), a2 = (e & 1) ? bfhi(q2[e >> 1]) : bflo(q2[e >> 1]);
                float b1 = (e & 1) ? bfhi(k1[e >> 1]) : bflo(k1[e >> 1]), b2 = (e & 1) ? bfhi(k2[e >> 1]) : bflo(k2[e >> 1]);
                if (lat) {
                    const int pi = cA + e;
                    const float pos = (pi < 32) ? (float)(t >> 6) : (float)(t & 63);
                    const float ang = pos * exp2f(-(float)(pi & 31) * (13.287712379549449f / 32.0f));
                    float sn, cs; sincosf(ang, &sn, &cs);
                    const float n1 = a1 * cs - a2 * sn, n2 = a1 * sn + a2 * cs, m1 = b1 * cs - b2 * sn, m2 = b1 * sn + b2 * cs;
                    a1 = n1; a2 = n2; b1 = m1; b2 = m2;
                }
                qt[e] = a1; qt[8 + e] = a2; kv[e] = b1 * 0.08838834764831845f; kv[8 + e] = b2 * 0.08838834764831845f;
                lfv[e] = lng; lfv[8 + e] = lng;
            }
        }
        *(LAS u32x4*)(kraw + ti * 136 + cA) = pack8(kv); *(LAS u32x4*)(kraw + ti * 136 + cB) = pack8(kv + 8);
        *(LAS f32x4*)(bc + ti * 132 + cA) = (f32x4){lfv[0], lfv[1], lfv[2], lfv[3]}; *(LAS f32x4*)(bc + ti * 132 + cA + 4) = (f32x4){lfv[4], lfv[5], lfv[6], lfv[7]};
        *(LAS f32x4*)(bc + ti * 132 + cB) = (f32x4){lfv[8], lfv[9], lfv[10], lfv[11]}; *(LAS f32x4*)(bc + ti * 132 + cB + 4) = (f32x4){lfv[12], lfv[13], lfv[14], lfv[15]};
        const bf16_t* vp = pr + vcol + h * 128;
        const u32x4 v0 = *(const u32x4*)(vp + cA), v1 = *(const u32x4*)(vp + cB);
#pragma unroll
        for (int e = 0; e < 8; ++e) {
            vT[(cA + e) * 72 + ti] = (bf16_t)((e & 1) ? (v0[e >> 1] >> 16) : (v0[e >> 1] & 0xffffu));
            vT[(cB + e) * 72 + ti] = (bf16_t)((e & 1) ? (v1[e >> 1] >> 16) : (v1[e >> 1] & 0xffffu));
        }
    }
    __syncthreads();
    if (tid < 128) {
        float run = 0.f;
#pragma unroll 8
        for (int i = 0; i < 64; ++i) { run += bc[i * 132 + tid]; bc[i * 132 + tid] = run; }
    }
    __syncthreads();
    {
        const int I = ti >> 4;
        float qhat[16];
#pragma unroll
        for (int e = 0; e < 16; ++e) {
            const int ch = e < 8 ? cA + e : cB + e - 8;
            const float bi = bc[ti * 132 + ch], rI = I ? bc[(16 * I - 1) * 132 + ch] : 0.f, bl = bc[63 * 132 + ch];
            qhat[e] = qt[e] * __expf(bi - rI); qt[e] = qt[e] * __expf(bi);
            kT[ch * 72 + ti] = (bf16_t)f2bf(bf2f(kraw[ti * 136 + ch]) * __expf(bl - bi));
        }
        *(LAS u32x4*)(qh + ti * 136 + cA) = pack8(qhat); *(LAS u32x4*)(qh + ti * 136 + cB) = pack8(qhat + 8);
        bf16_t* lqp = p.lq + item * 8192 + ti * 128;
        *(u32x4*)(lqp + cA) = pack8(qt); *(u32x4*)(lqp + cB) = pack8(qt + 8);
    }
    if (tid < 128) p.ld[item * 128 + tid] = __expf(bc[63 * 132 + tid]);
    for (int I = 0; I < 4; ++I) {
        if (ti < 16 * (I + 1)) {
            float kk[16];
#pragma unroll
            for (int e = 0; e < 16; ++e) {
                const int ch = e < 8 ? cA + e : cB + e - 8;
                const float rI = I ? bc[(16 * I - 1) * 132 + ch] : 0.f, bj = bc[ti * 132 + ch];
                kk[e] = bf2f(kraw[ti * 136 + ch]) * __expf(fminf(rI - bj, 80.f));
            }
            *(LAS u32x4*)(kh + ti * 136 + cA) = pack8(kk); *(LAS u32x4*)(kh + ti * 136 + cB) = pack8(kk + 8);
        }
        __syncthreads();
        if (wid < 4) {
            const int J = wid;
            u32x2 outv; outv[0] = 0u; outv[1] = 0u;
            if (J <= I) {
                f32x4 acc = (f32x4){0.f, 0.f, 0.f, 0.f};
#pragma unroll
                for (int ks = 0; ks < 4; ++ks)
                    acc = mfma16(*(const LAS bf16x8*)(kh + (J * 16 + fr) * 136 + ks * 32 + fq * 8), *(const LAS bf16x8*)(qh + (I * 16 + fr) * 136 + ks * 32 + fq * 8), acc);
                const int i = 16 * I + fr, j0 = 16 * J + 4 * fq;
#pragma unroll
                for (int r = 0; r < 4; ++r) if (j0 + r > i) acc[r] = 0.f;
                outv = pack4(acc);
            }
            *(LAS u32x2*)(sc + (I * 16 + fr) * 72 + J * 16 + 4 * fq) = outv;
        }
        __syncthreads();
    }
    {
        bf16x8 xv[2], xk[2];
#pragma unroll
        for (int ks = 0; ks < 2; ++ks) { xv[ks] = *(const LAS bf16x8*)(vT + (wid * 16 + fr) * 72 + ks * 32 + fq * 8); xk[ks] = *(const LAS bf16x8*)(kT + (wid * 16 + fr) * 72 + ks * 32 + fq * 8); }
#pragma unroll
        for (int ib = 0; ib < 4; ++ib) {
            f32x4 acc = (f32x4){0.f, 0.f, 0.f, 0.f};
#pragma unroll
            for (int ks = 0; ks < 2; ++ks) acc = mfma16(xv[ks], *(const LAS bf16x8*)(sc + (ib * 16 + fr) * 72 + ks * 32 + fq * 8), acc);
            *(u32x2*)(p.lo + item * 8192 + (ib * 16 + fr) * 128 + wid * 16 + 4 * fq) = pack4(acc);
        }
#pragma unroll
        for (int dvb = 0; dvb < 8; ++dvb) {
            f32x4 acc = (f32x4){0.f, 0.f, 0.f, 0.f};
#pragma unroll
            for (int ks = 0; ks < 2; ++ks) acc = mfma16(xk[ks], *(const LAS bf16x8*)(vT + (dvb * 16 + fr) * 72 + ks * 32 + fq * 8), acc);
            *(u32x2*)(p.lb + item * 16384 + (dvb * 16 + fr) * 128 + wid * 16 + 4 * fq) = pack4(acc);
        }
    }
    __syncthreads();
}


template <int I> struct SolveRows {
    static __device__ __forceinline__ void run(float (&x)[64], const LAS float* Mf, const LAS float* rs) {
        SolveRows<I - 1>::run(x, Mf, rs);
        float r = x[I] * rs[I];
#pragma unroll
        for (int j4 = 0; j4 < (I + 3) / 4; ++j4) {
            const f32x4 m = *(const LAS f32x4*)(Mf + I * 68 + j4 * 4);
            r -= m[0] * x[j4 * 4] + m[1] * x[j4 * 4 + 1] + m[2] * x[j4 * 4 + 2] + m[3] * x[j4 * 4 + 3];
        }
        asm volatile("" : "+v"(r) :: "memory");
        x[I] = r;
    }
};
template <> struct SolveRows<-1> { static __device__ __forceinline__ void run(float (&)[64], const LAS float*, const LAS float*) {} };

__device__ __forceinline__ void local_gdn(const Params& p, int l, int chain, int n, LAS unsigned char* lds) {
    const int tid = opaque_tid(), wid = tid >> 6, lane = tid & 63, fr = lane & 15, fq = lane >> 4;
    const int b = chain >> 3, h = (chain >> 1) & 3, d = chain & 1;
    const int base = chunk_base(b, d, n);
    const size_t item = (size_t)chain * NCHUNK + n;
    LAS bf16_t* ks_ = (LAS bf16_t*)lds;
    LAS bf16_t* qs = ks_ + 64 * 136;
    LAS bf16_t* att = qs + 64 * 136;
    LAS bf16_t* wT = att + 64 * 72;
    LAS bf16_t* uT = wT + 128 * 72;
    LAS bf16_t* kT = uT + 128 * 72;
    LAS float* Mf = (LAS float*)(kT + 128 * 72);
    LAS float* bcs = Mf + 64 * 68;
    LAS float* bts = bcs + 64;
    LAS float* rse = bts + 64;
    LAS bf16_t* vs = (LAS bf16_t*)(rse + 64);
    const int ti = tid >> 3, d0 = (tid & 7) * 16;
    const int tokI = base + (d ? 63 - ti : ti);
    {
        int t, T, sbase; tok_info(tokI, t, T, sbase);
#pragma unroll
        for (int part = 0; part < 3; ++part) {
            float a[16];
#pragma unroll
            for (int e = 0; e < 16; ++e) a[e] = 0.f;
            const int ccol = part * 512 + h * 128 + d0;
#pragma unroll
            for (int j = 0; j < 4; ++j) {
                const int tt = t + j - 2;
                if (tt >= 0 && tt < T) {
                    const bf16_t* xp = p.P + (size_t)(sbase + tt) * NP + C_GQKV + ccol;
                    const u32x4 x0 = *(const u32x4*)xp, x1 = *(const u32x4*)(xp + 8);
                    const float* wp = p.gdn_conv_w + (size_t)(l * 4 + j) * 1536 + ccol;
#pragma unroll
                    for (int q = 0; q < 4; ++q) {
                        const float4 w0 = *(const float4*)(wp + q * 4);
                        const unsigned ua = q < 2 ? x0[2 * q] : x1[2 * q - 4], ub = q < 2 ? x0[2 * q + 1] : x1[2 * q - 3];
                        a[q * 4] += w0.x * bflo(ua); a[q * 4 + 1] += w0.y * bfhi(ua); a[q * 4 + 2] += w0.z * bflo(ub); a[q * 4 + 3] += w0.w * bfhi(ub);
                    }
                }
            }
            float ss = 0.f;
#pragma unroll
            for (int e = 0; e < 16; ++e) { a[e] = siluf_(a[e]); ss += a[e] * a[e]; }
            if (part < 2) {
                ss += __shfl_xor(ss, 1); ss += __shfl_xor(ss, 2); ss += __shfl_xor(ss, 4);
                const float scl = rsqrtf(ss + 1e-6f) * (part == 0 ? 0.08838834764831845f : 1.0f);
#pragma unroll
                for (int e = 0; e < 16; ++e) a[e] *= scl;
            }
            LAS bf16_t* dstt = (part == 0 ? qs : part == 1 ? ks_ : vs) + ti * 136 + d0;
            *(LAS u32x4*)dstt = pack8(a); *(LAS u32x4*)(dstt + 8) = pack8(a + 8);
        }
    }
    if (wid == 0) {
        const int tok = base + (d ? 63 - lane : lane);
        const float av = bf2f(p.P[(size_t)tok * NP + C_GA + d * 4 + h]);
        float v = -__expf(p.gdn_a_log[l * 8 + d * 4 + h]) * softplusf_(av + p.gdn_dt_bias[l * 8 + d * 4 + h]);
#pragma unroll
        for (int off = 1; off < 64; off <<= 1) { const float t = __shfl_up(v, off); if (lane >= off) v += t; }
        const float btv = sigmoidf_(bf2f(p.P[(size_t)tok * NP + C_GB + d * 4 + h]));
        bcs[lane] = v; bts[lane] = btv; rse[lane] = btv * __expf(v);
    }
    __syncthreads();
#pragma unroll
    for (int e = 0; e < 2; ++e) {
        const int f = wid * 2 + e, ib = f >> 2, jb = f & 3;
        const int i = 16 * ib + fr, j0 = 16 * jb + 4 * fq;
        f32x4 mk = (f32x4){0.f, 0.f, 0.f, 0.f}, mq = (f32x4){0.f, 0.f, 0.f, 0.f};
        if (jb <= ib) {
#pragma unroll
            for (int ks = 0; ks < 4; ++ks) {
                const bf16x8 xk = *(const LAS bf16x8*)(ks_ + (jb * 16 + fr) * 136 + ks * 32 + fq * 8);
                mk = mfma16(xk, *(const LAS bf16x8*)(ks_ + (ib * 16 + fr) * 136 + ks * 32 + fq * 8), mk);
                mq = mfma16(xk, *(const LAS bf16x8*)(qs + (ib * 16 + fr) * 136 + ks * 32 + fq * 8), mq);
            }
            const float bi = bcs[i], bti = bts[i];
#pragma unroll
            for (int r = 0; r < 4; ++r) {
                const int j = j0 + r;
                const float dec = __expf(j <= i ? bi - bcs[j] : 0.f);
                mk[r] = (j < i) ? bti * mk[r] * dec : 0.f;
                mq[r] = (j <= i) ? mq[r] * dec : 0.f;
            }
        }
        *(LAS f32x4*)(Mf + i * 68 + j0) = mk;
        *(LAS u32x2*)(att + i * 72 + j0) = pack4(mq);
    }
    __syncthreads();
    {
        const float sc_ = __expf(bcs[63] - bcs[ti]);
#pragma unroll
        for (int e = 0; e < 16; ++e) kT[(d0 + e) * 72 + ti] = (bf16_t)f2bf(bf2f(ks_[ti * 136 + d0 + e]) * sc_);
    }
    if (tid < 256) {
        const int cidx = tid & 127;
        const bool isw = tid >= 128;
        const LAS bf16_t* srcp = (isw ? ks_ : vs) + cidx;
        float x[64];
#pragma unroll
        for (int i = 0; i < 64; ++i) x[i] = bf2f(srcp[i * 136]);
        {
            unsigned mb = (unsigned)(size_t)Mf, rb = (unsigned)(size_t)(isw ? rse : bts);
            asm volatile("" : "+v"(mb), "+v"(rb));
            SolveRows<63>::run(x, (const LAS float*)(size_t)mb, (const LAS float*)(size_t)rb);
        }
        if (isw) {
#pragma unroll
            for (int i = 0; i < 64; ++i) x[i] = -x[i];
        }
        LAS bf16_t* dst = (isw ? wT : uT) + cidx * 72;
#pragma unroll
        for (int q = 0; q < 8; ++q) *(LAS u32x4*)(dst + q * 8) = pack8(x + q * 8);
    }
    if (tid < 128) p.ld[item * 128 + tid] = __expf(bcs[63]);
    __syncthreads();
    {
        const int tid = opaque_tid(), wid = tid >> 6, lane = tid & 63, fr = lane & 15, fq = lane >> 4;
        bf16x8 xw[2], xu[2], xk[2];
#pragma unroll
        for (int ks = 0; ks < 2; ++ks) {
            xw[ks] = *(const LAS bf16x8*)(wT + (wid * 16 + fr) * 72 + ks * 32 + fq * 8);
            xu[ks] = *(const LAS bf16x8*)(uT + (wid * 16 + fr) * 72 + ks * 32 + fq * 8);
            xk[ks] = *(const LAS bf16x8*)(kT + (wid * 16 + fr) * 72 + ks * 32 + fq * 8);
        }
#pragma unroll
        for (int ib = 0; ib < 4; ++ib) {
            const int i = ib * 16 + fr;
            const u32x2 qr = *(const LAS u32x2*)(qs + i * 136 + wid * 16 + 4 * fq);
            const float eb = __expf(bcs[i]);
            f32x4 aq = (f32x4){bflo(qr[0]) * eb, bfhi(qr[0]) * eb, bflo(qr[1]) * eb, bfhi(qr[1]) * eb};
            f32x4 ao = (f32x4){0.f, 0.f, 0.f, 0.f};
#pragma unroll
            for (int ks = 0; ks < 2; ++ks) {
                const bf16x8 ya = *(const LAS bf16x8*)(att + i * 72 + ks * 32 + fq * 8);
                aq = mfma16(xw[ks], ya, aq); ao = mfma16(xu[ks], ya, ao);
            }
            *(u32x2*)(p.lq + item * 8192 + i * 128 + wid * 16 + 4 * fq) = pack4(aq);
            *(u32x2*)(p.lo + item * 8192 + i * 128 + wid * 16 + 4 * fq) = pack4(ao);
        }
#pragma unroll
        for (int db = 0; db < 8; ++db) {
            f32x4 aa = (f32x4){0.f, 0.f, 0.f, 0.f}, ab = (f32x4){0.f, 0.f, 0.f, 0.f};
#pragma unroll
            for (int ks = 0; ks < 2; ++ks) {
                aa = mfma16(xw[ks], *(const LAS bf16x8*)(kT + (db * 16 + fr) * 72 + ks * 32 + fq * 8), aa);
                ab = mfma16(xk[ks], *(const LAS bf16x8*)(uT + (db * 16 + fr) * 72 + ks * 32 + fq * 8), ab);
            }
            *(u32x2*)(p.la + item * 16384 + (db * 16 + fr) * 128 + wid * 16 + 4 * fq) = pack4(aa);
            *(u32x2*)(p.lb + item * 16384 + (db * 16 + fr) * 128 + wid * 16 + 4 * fq) = pack4(ab);
        }
    }
    __syncthreads();
}

__device__ __forceinline__ void ph_local(const Params& p, int l, LAS unsigned char* lds) {
    for (int it = blockIdx.x; it < 3 * NITEM; it += gridDim.x) {
        const int tz = it % 3, ci = it / 3, chain = ci / NCHUNK, n = ci % NCHUNK;
        if (tz == 0) local_gdn(p, l, chain, n, lds); else local_gla(p, l, tz, chain, n, lds);
    }
}

__device__ __forceinline__ void seq_matrix(const Params& p, int tz, int chain, int half, LAS unsigned char* lds) {
    const int tid = opaque_tid(), wid = tid >> 6, lane = tid & 63, fr = lane & 15, fq = lane >> 4;
    const int b = chain >> 3, h = (chain >> 1) & 3, d = chain & 1;
    LAS bf16_t* ST = (LAS bf16_t*)lds;
    float* Op = p.O + (size_t)((tz == 0 ? 0 : tz == 1 ? 1 : 3) * 2 + d) * TOKW;
    f32x4 S[4];
#pragma unroll
    for (int q = 0; q < 4; ++q) S[q] = (f32x4){0.f, 0.f, 0.f, 0.f};
    const int ib = wid >> 1, dv2 = (wid & 1) * 2;
    for (int n = 0; n < NCHUNK; ++n) {
        const size_t item = (size_t)tz * NITEM + (size_t)chain * NCHUNK + n;
        bf16x8 yq[4], xa[4];
#pragma unroll
        for (int ks = 0; ks < 4; ++ks) yq[ks] = *(const bf16x8*)(p.lq + item * 8192 + (ib * 16 + fr) * 128 + ks * 32 + fq * 8);
        if (tz == 0) {
#pragma unroll
            for (int ks = 0; ks < 4; ++ks) xa[ks] = *(const bf16x8*)(p.la + ((size_t)chain * NCHUNK + n) * 16384 + (wid * 16 + fr) * 128 + ks * 32 + fq * 8);
        }
        u32x2 oin[2], bin[4];
#pragma unroll
        for (int e = 0; e < 2; ++e) oin[e] = *(const u32x2*)(p.lo + item * 8192 + (ib * 16 + fr) * 128 + half * 64 + (dv2 + e) * 16 + 4 * fq);
#pragma unroll
        for (int q = 0; q < 4; ++q) bin[q] = *(const u32x2*)(p.lb + item * 16384 + (half * 64 + q * 16 + fr) * 128 + wid * 16 + 4 * fq);
        const f32x4 dec = *(const f32x4*)(p.ld + item * 128 + wid * 16 + 4 * fq);
        LAS bf16_t* st = ST + (n & 1) * 64 * 136;
#pragma unroll
        for (int q = 0; q < 4; ++q) *(LAS u32x2*)(st + (q * 16 + fr) * 136 + wid * 16 + 4 * fq) = pack4(S[q]);
        __syncthreads();
        const int base = chunk_base(b, d, n);
        const int tok = base + (d ? 63 - (ib * 16 + fr) : ib * 16 + fr);
#pragma unroll
        for (int e = 0; e < 2; ++e) {
            f32x4 acc = (f32x4){bflo(oin[e][0]), bfhi(oin[e][0]), bflo(oin[e][1]), bfhi(oin[e][1])};
#pragma unroll
            for (int ks = 0; ks < 4; ++ks) acc = mfma16(*(const LAS bf16x8*)(st + ((dv2 + e) * 16 + fr) * 136 + ks * 32 + fq * 8), yq[ks], acc);
            *(f32x4*)(Op + (size_t)tok * MW + h * 128 + half * 64 + (dv2 + e) * 16 + 4 * fq) = acc;
        }
#pragma unroll
        for (int q = 0; q < 4; ++q) {
            f32x4 acc = (f32x4){dec[0] * S[q][0] + bflo(bin[q][0]), dec[1] * S[q][1] + bfhi(bin[q][0]), dec[2] * S[q][2] + bflo(bin[q][1]), dec[3] * S[q][3] + bfhi(bin[q][1])};
            if (tz == 0) {
#pragma unroll
                for (int ks = 0; ks < 4; ++ks) acc = mfma16(xa[ks], *(const LAS bf16x8*)(st + (q * 16 + fr) * 136 + ks * 32 + fq * 8), acc);
            }
            S[q] = acc;
        }
    }
    __syncthreads();
}

__device__ __forceinline__ void seq_lru(const Params& p, int b, int d, int cg, LAS unsigned char* lds) {
    const int tid = opaque_tid(), seg = tid >> 6, ch = cg * 64 + (tid & 63);
    LAS float* sP = (LAS float*)lds;
    LAS float* sL = sP + 512;
    const float* A = p.prep + (size_t)(PR_LA + d) * TOKW + ch; const float* U = p.prep + (size_t)(PR_LU + d) * TOKW + ch;
    float* Op = p.O + (size_t)(2 * 2 + d) * TOKW + ch;
    constexpr int SEG = (TC + TL) / 8;
    auto tok_of = [&](int pos) { return pos < TC ? NLAT + b * TC + (d ? TC - 1 - pos : pos) : b * TL + (d ? TL - 1 - (pos - TC) : pos - TC); };
    float P = 1.f, L = 0.f;
    for (int i0 = 0; i0 < SEG; i0 += 8) {
        float av[8], uv[8];
#pragma unroll
        for (int q = 0; q < 8; ++q) { const size_t o = (size_t)tok_of(seg * SEG + i0 + q) * MW; av[q] = A[o]; uv[q] = U[o]; }
#pragma unroll
        for (int q = 0; q < 8; ++q) { L = av[q] * L + uv[q]; P *= av[q]; }
    }
    sP[tid] = P; sL[tid] = L;
    __syncthreads();
    float hst = 0.f;
    for (int s = 0; s < seg; ++s) hst = sP[s * 64 + (tid & 63)] * hst + sL[s * 64 + (tid & 63)];
    for (int i0 = 0; i0 < SEG; i0 += 8) {
        float av[8], uv[8]; size_t oo[8];
#pragma unroll
        for (int q = 0; q < 8; ++q) { oo[q] = (size_t)tok_of(seg * SEG + i0 + q) * MW; av[q] = A[oo[q]]; uv[q] = U[oo[q]]; }
#pragma unroll
        for (int q = 0; q < 8; ++q) { hst = av[q] * hst + uv[q]; Op[oo[q]] = hst; }
    }
    __syncthreads();
}

__device__ __forceinline__ void ph_seq(const Params& p, LAS unsigned char* lds) {
    for (int it = blockIdx.x; it < 256; it += gridDim.x) {
        if (it < 192) { const int tz = it >> 6, r = it & 63; seq_matrix(p, tz, r >> 1, r & 1, lds); }
        else { const int r = it - 192; seq_lru(p, r >> 4, (r >> 3) & 1, r & 7, lds); }
    }
}

__device__ __forceinline__ void ph_merge(const Params& p, int l, int M) {
    const int tid = opaque_tid(), wid = tid >> 6, lane = tid & 63;
    for (int id = blockIdx.x * NWAVES + wid; id < M * 16; id += gridDim.x * NWAVES) {
        const int tok = id >> 4, r = id & 15, m = r >> 2, head = r & 3;
        const int cidx = head * 128 + lane * 2;
        const size_t o = (size_t)tok * MW + cidx;
        const f32x2 o0 = *(const f32x2*)(p.O + (size_t)(m * 2) * TOKW + o), o1 = *(const f32x2*)(p.O + (size_t)(m * 2 + 1) * TOKW + o);
        const float a0 = o0[0] + o1[0], a1 = o0[1] + o1[1];
        float y0, y1; int nbr;
        if (m == 2) {
            const unsigned u = *(const unsigned*)(p.P + (size_t)tok * NP + C_LY + cidx);
            y0 = a0 * gelu_tanhf_(bflo(u)); y1 = a1 * gelu_tanhf_(bfhi(u)); nbr = 2;
        } else {
            const float ss = wave_sum(a0 * a0 + a1 * a1);
            const float rinv = rsqrtf(ss * (1.0f / 128.0f) + 1e-6f);
            const float* gp = (m == 0 ? p.gdn_norm_g : m == 1 ? p.hgrn_norm_g : p.ret_norm_g) + l * 128 + lane * 2;
            const int zc = m == 0 ? C_GZ : m == 1 ? C_HG : C_RG;
            const unsigned u = *(const unsigned*)(p.P + (size_t)tok * NP + zc + cidx);
            y0 = a0 * rinv * gp[0] * siluf_(bflo(u)); y1 = a1 * rinv * gp[1] * siluf_(bfhi(u)); nbr = m == 3 ? 3 : m;
        }
        *(unsigned*)(p.Y + (size_t)nbr * TOKW + o) = pack2(y0, y1);
    }
}

__device__ __forceinline__ void ph_g2(const Params& p, int l, int M, LAS unsigned char* lds) {
    const StageRC s = my_stage_rc();
    const int tid = opaque_tid(), wid = tid >> 6, lane = tid & 63, wr = wid >> 1, wc = wid & 1, fr = lane & 15, fq = lane >> 4;
    const int ntm = M / 256;
    for (int u = blockIdx.x; u < ntm * 8; u += gridDim.x) {
        const int pm = u >> 3, pn = u & 7;
        f32x4 acc[4][4]; gm::zero_acc(acc);
        for (int nb = 0; nb < 4; ++nb) {
            const bf16_t* a0 = p.Y + (size_t)nb * TOKW + (size_t)(pm * 256) * MW;
            const bf16_t* Bt = p.wbT + (size_t)(l * 4 + nb) * D * MW + (size_t)(pn * 128) * MW;
            gm::kloop(lds, a0 + (size_t)s.R0 * MW + s.C0, a0 + (size_t)s.R1 * MW + s.C1, a0 + (size_t)(128 + s.R0) * MW + s.C0, a0 + (size_t)(128 + s.R1) * MW + s.C1,
                      Bt + (size_t)s.R0 * MW + s.C0, Bt + (size_t)s.R1 * MW + s.C1, MW, acc);
#pragma unroll
            for (int m = 0; m < 4; ++m)
#pragma unroll
                for (int n = 0; n < 4; ++n) {
                    const int row = pm * 256 + wr * 64 + m * 16 + fr, col = pn * 128 + wc * 64 + n * 16 + fq * 4;
                    const bf16_t* gp = p.P + (size_t)row * NP + C_MG + nb * D + col;
                    const u32x2 gu = *(const u32x2*)gp;
                    const float e0 = __expf(-bflo(gu[0])), e1 = __expf(-bfhi(gu[0])), e2 = __expf(-bflo(gu[1])), e3 = __expf(-bfhi(gu[1]));
                    float n0 = 1.f, n1 = 1.f, n2 = 1.f, n3 = 1.f;
                    if (nb < 3) { const u32x2 gn = *(const u32x2*)(gp + D);
                        n0 = 1.f + __expf(-bflo(gn[0])); n1 = 1.f + __expf(-bfhi(gn[0])); n2 = 1.f + __expf(-bflo(gn[1])); n3 = 1.f + __expf(-bfhi(gn[1])); }
                    acc[m][n][0] *= n0 / (1.f + e0); acc[m][n][1] *= n1 / (1.f + e1); acc[m][n][2] *= n2 / (1.f + e2); acc[m][n][3] *= n3 / (1.f + e3);
                }
        }
#pragma unroll
        for (int m = 0; m < 4; ++m)
#pragma unroll
            for (int n = 0; n < 4; ++n) {
                const int row = pm * 256 + wr * 64 + m * 16 + fr, col = pn * 128 + wc * 64 + n * 16 + fq * 4;
                u32x2 o; o[0] = pack2(acc[m][n][0], acc[m][n][1]); o[1] = pack2(acc[m][n][2], acc[m][n][3]);
                *(u32x2*)(p.mix + (size_t)row * D + col) = o;
            }
    }
}

template <bool DRY = false> __device__ __forceinline__ void ph_g3(const Params& p, int l, int M, LAS unsigned char* lds) {
    const StageRC s = my_stage_rc();
    const int tid = opaque_tid(), wid = tid >> 6, lane = tid & 63, wr = wid >> 1, wc = wid & 1, fr = lane & 15, fq = lane >> 4;
    const int ntm = M / 256;
    for (int u = blockIdx.x; u < ntm * 8; u += gridDim.x) {
        const int pm = u >> 3, pn = u & 7;
        const bf16_t* a0 = p.mix + (size_t)(pm * 256) * D;
        const bf16_t* Bt = p.woutT + (size_t)l * D * D + (size_t)(pn * 128) * D;
        f32x4 acc[4][4]; gm::zero_acc(acc);
        gm::kloop(lds, a0 + (size_t)s.R0 * D + s.C0, a0 + (size_t)s.R1 * D + s.C1, a0 + (size_t)(128 + s.R0) * D + s.C0, a0 + (size_t)(128 + s.R1) * D + s.C1,
                  Bt + (size_t)s.R0 * D + s.C0, Bt + (size_t)s.R1 * D + s.C1, D, acc);
#pragma unroll
        for (int m = 0; m < 4; ++m)
#pragma unroll
            for (int n = 0; n < 4; ++n) {
                const int row = pm * 256 + wr * 64 + m * 16 + fr, col = pn * 128 + wc * 64 + n * 16 + fq * 4;
                const float4 gt = *(const float4*)(p.mod + (size_t)(l * 5 + tok_modrow(row)) * (NMOD * D) + 2 * D + col);
                float4* xp = (float4*)(p.xl + (size_t)row * D + col);
                float4 xv = *xp;
                if (DRY) xp = (float4*)(p.prep + (size_t)row * D + col);
                xv.x += gt.x * acc[m][n][0]; xv.y += gt.y * acc[m][n][1]; xv.z += gt.z * acc[m][n][2]; xv.w += gt.w * acc[m][n][3];
                *xp = xv;
            }
    }
}

template <bool DRY = false> __device__ __forceinline__ void ph_route(const Params& p, int l, int M, LAS unsigned char* lds) {
    int* const r_cnt = DRY ? p.cnt + 64 : p.cnt; int* const r_list = DRY ? (int*)p.act : p.list; int* const r_ts = DRY ? (int*)p.yp : p.tokslot; float* const r_tw = DRY ? (float*)p.yp + (size_t)NTOK * 4 : p.topw;
    LAS float* fs = (LAS float*)lds;
    LAS float* lg = fs + 32 * 1028;
    const int tid = opaque_tid(), wid = tid >> 6, lane = tid & 63;
    const float* rw = p.router_w + (size_t)l * D * NE;
    for (int it = blockIdx.x; it < M / 32; it += gridDim.x) {
        const int tok0 = it * 32;
        for (int q = 0; q < 4; ++q) {
            const int tl = wid * 4 + q, tok = tok0 + tl;
            const float* src = p.xl + (size_t)tok * D;
            float4 v[4]; float ss = 0.f;
#pragma unroll
            for (int i = 0; i < 4; ++i) { v[i] = *(const float4*)(src + i * 256 + lane * 4); ss += v[i].x * v[i].x + v[i].y * v[i].y + v[i].z * v[i].z + v[i].w * v[i].w; }
            ss = wave_sum(ss);
            const float rinv = rsqrtf(ss * (1.0f / D) + 1e-6f);
            const float* mb = p.mod + (size_t)(l * 5 + tok_modrow(tok)) * (NMOD * D);
#pragma unroll
            for (int i = 0; i < 4; ++i) {
                const int cidx = i * 256 + lane * 4;
                const float4 gv = *(const float4*)(p.norm2_g + l * D + cidx), sv = *(const float4*)(mb + 4 * D + cidx), hv = *(const float4*)(mb + 3 * D + cidx);
                const float h0 = v[i].x * rinv * gv.x * (1.f + sv.x) + hv.x, h1 = v[i].y * rinv * gv.y * (1.f + sv.y) + hv.y;
                const float h2 = v[i].z * rinv * gv.z * (1.f + sv.z) + hv.z, h3 = v[i].w * rinv * gv.w * (1.f + sv.w) + hv.w;
                u32x2 o; o[0] = pack2(h0, h1); o[1] = pack2(h2, h3);
                *(u32x2*)(p.F + (size_t)tok * D + cidx) = o;
                *(LAS f32x4*)(fs + tl * 1028 + cidx) = (f32x4){h0, h1, h2, h3};
            }
        }
        __syncthreads();
        {
            typedef float f32x16 __attribute__((ext_vector_type(16)));
            f32x16 acc;
#pragma unroll
            for (int r = 0; r < 16; ++r) acc[r] = 0.f;
            const int tk = lane & 31, hh = lane >> 5;
            const LAS float* ap = fs + tk * 1028 + wid * 128 + 4 * hh;
            const float* bp = rw + (size_t)(wid * 128 + 4 * hh) * NE + tk;
#pragma unroll 4
            for (int kk = 0; kk < 16; ++kk) {
                const f32x4 a4 = *(const LAS f32x4*)(ap + kk * 8);
                const float b0 = bp[(kk * 8 + 0) * NE], b1 = bp[(kk * 8 + 1) * NE], b2 = bp[(kk * 8 + 2) * NE], b3 = bp[(kk * 8 + 3) * NE];
                acc = __builtin_amdgcn_mfma_f32_32x32x2f32(a4[0], b0, acc, 0, 0, 0);
                acc = __builtin_amdgcn_mfma_f32_32x32x2f32(a4[1], b1, acc, 0, 0, 0);
                acc = __builtin_amdgcn_mfma_f32_32x32x2f32(a4[2], b2, acc, 0, 0, 0);
                acc = __builtin_amdgcn_mfma_f32_32x32x2f32(a4[3], b3, acc, 0, 0, 0);
            }
            __syncthreads();
            LAS float* red = fs;
#pragma unroll
            for (int r = 0; r < 16; ++r) red[(wid * 32 + (r & 3) + 8 * (r >> 2) + 4 * hh) * 33 + tk] = acc[r];
            __syncthreads();
            const int t2 = tid >> 4, e0 = (tid & 15) * 2;
            float s0 = p.router_b[l * NE + e0], s1 = p.router_b[l * NE + e0 + 1];
#pragma unroll
            for (int w = 0; w < 8; ++w) { s0 += red[(w * 32 + t2) * 33 + e0]; s1 += red[(w * 32 + t2) * 33 + e0 + 1]; }
            lg[t2 * 33 + e0] = s0; lg[t2 * 33 + e0 + 1] = s1;
        }
        __syncthreads();
        if (tid < 32) {
            const int tok = tok0 + tid;
            float vals[4]; int idxs[4]; unsigned used = 0u;
#pragma unroll
            for (int k = 0; k < 4; ++k) {
                float best = -3.0e38f; int bi = 0;
                for (int e = 0; e < NE; ++e) { const float v = lg[tid * 33 + e]; if (!((used >> e) & 1u) && v > best) { best = v; bi = e; } }
                used |= 1u << bi; vals[k] = best; idxs[k] = bi;
            }
            const float mx = vals[0];
            float ex[4], sum = 0.f;
#pragma unroll
            for (int k = 0; k < 4; ++k) { ex[k] = __expf(vals[k] - mx); sum += ex[k]; }
            const float inv = 1.0f / sum;
#pragma unroll
            for (int k = 0; k < 4; ++k) {
                const int e = idxs[k];
                const int slot = atomicAdd(r_cnt + l * NE + e, 1);
                r_list[(size_t)e * NTOK + slot] = tok;
                r_ts[(size_t)tok * 4 + k] = (e << 16) | slot;
                r_tw[(size_t)tok * 4 + k] = ex[k] * inv;
            }
        }
        __syncthreads();
    }
}

__device__ __forceinline__ void build_expert_tables(const Params& p, int l, LAS int* ts, LAS int* cn) {
    if (opaque_tid() == 0) {
        int acc = 0;
        for (int e = 0; e < NE; ++e) { const int c = __hip_atomic_load(p.cnt + l * NE + e, __ATOMIC_RELAXED, __HIP_MEMORY_SCOPE_AGENT); cn[e] = c; ts[e] = acc; acc += (c + 255) >> 8; }
        ts[NE] = acc;
    }
    __syncthreads();
}

__device__ __forceinline__ void ph_g4(const Params& p, int l, LAS unsigned char* lds) {
    LAS int* ts = (LAS int*)(lds + 6 * gm::HT); LAS int* cn = ts + 40;
    build_expert_tables(p, l, ts, cn);
    const StageRC s = my_stage_rc();
    const int tid = opaque_tid(), wid = tid >> 6, lane = tid & 63, wr = wid >> 1, wc = wid & 1, fr = lane & 15, fq = lane >> 4;
    const int MT = ts[NE];
    for (int u = blockIdx.x; u < MT * 16; u += gridDim.x) {
        const int mt = u >> 4, pn = u & 15;
        int e = 0;
        while (e < NE - 1 && ts[e + 1] <= mt) ++e;
        const int cnt = cn[e], slot0 = (mt - ts[e]) * 256;
        const int* le = p.list + (size_t)e * NTOK;
        int sl;
        sl = slot0 + s.R0;       const bf16_t* a00 = p.F + (size_t)le[sl < cnt ? sl : 0] * D + s.C0;
        sl = slot0 + s.R1;       const bf16_t* a01 = p.F + (size_t)le[sl < cnt ? sl : 0] * D + s.C1;
        sl = slot0 + 128 + s.R0; const bf16_t* a10 = p.F + (size_t)le[sl < cnt ? sl : 0] * D + s.C0;
        sl = slot0 + 128 + s.R1; const bf16_t* a11 = p.F + (size_t)le[sl < cnt ? sl : 0] * D + s.C1;
        const bf16_t* Bt = p.w1T + (size_t)(l * NE + e) * 2 * D * D + (size_t)(pn * 128) * D;
        f32x4 acc[4][4]; gm::zero_acc(acc);
        gm::kloop(lds, a00, a01, a10, a11, Bt + (size_t)s.R0 * D + s.C0, Bt + (size_t)s.R1 * D + s.C1, D, acc);
        const float* b1 = p.moe_b1 + (size_t)(l * NE + e) * 2 * D;
#pragma unroll
        for (int m = 0; m < 4; ++m)
#pragma unroll
            for (int n = 0; n < 2; ++n) {
                const int row = mt * 256 + wr * 64 + m * 16 + fr, col = pn * 64 + wc * 32 + n * 16 + fq * 4;
                const float4 bg = *(const float4*)(b1 + col), bl = *(const float4*)(b1 + D + col);
                float o[4];
#pragma unroll
                for (int q = 0; q < 4; ++q) {
                    const float glu = fminf(acc[m][n][q] + ((const float*)&bg)[q], 7.0f);
                    const float lin = fminf(fmaxf(acc[m][n + 2][q] + ((const float*)&bl)[q], -7.0f), 7.0f);
                    o[q] = glu * sigmoidf_(1.702f * glu) * (lin + 1.0f);
                }
                u32x2 ov; ov[0] = pack2(o[0], o[1]); ov[1] = pack2(o[2], o[3]);
                *(u32x2*)(p.act + (size_t)row * D + col) = ov;
            }
    }
}

__device__ __forceinline__ void ph_g5(const Params& p, int l, LAS unsigned char* lds) {
    LAS int* ts = (LAS int*)(lds + 6 * gm::HT); LAS int* cn = ts + 40;
    build_expert_tables(p, l, ts, cn);
    const StageRC s = my_stage_rc();
    const int tid = opaque_tid(), wid = tid >> 6, lane = tid & 63, wr = wid >> 1, wc = wid & 1, fr = lane & 15, fq = lane >> 4;
    const int MT = ts[NE];
    for (int u = blockIdx.x; u < MT * 8; u += gridDim.x) {
        const int mt = u >> 3, pn = u & 7;
        int e = 0;
        while (e < NE - 1 && ts[e + 1] <= mt) ++e;
        const bf16_t* a0 = p.act + (size_t)(mt * 256) * D;
        const bf16_t* Bt = p.w2T + (size_t)(l * NE + e) * D * D + (size_t)(pn * 128) * D;
        f32x4 acc[4][4]; gm::zero_acc(acc);
        gm::kloop(lds, a0 + (size_t)s.R0 * D + s.C0, a0 + (size_t)s.R1 * D + s.C1, a0 + (size_t)(128 + s.R0) * D + s.C0, a0 + (size_t)(128 + s.R1) * D + s.C1,
                  Bt + (size_t)s.R0 * D + s.C0, Bt + (size_t)s.R1 * D + s.C1, D, acc);
        const float* b2 = p.moe_b2 + (size_t)(l * NE + e) * D;
#pragma unroll
        for (int m = 0; m < 4; ++m)
#pragma unroll
            for (int n = 0; n < 4; ++n) {
                const int row = mt * 256 + wr * 64 + m * 16 + fr, col = pn * 128 + wc * 64 + n * 16 + fq * 4;
                const float4 bb = *(const float4*)(b2 + col);
                u32x2 o; o[0] = pack2(acc[m][n][0] + bb.x, acc[m][n][1] + bb.y); o[1] = pack2(acc[m][n][2] + bb.z, acc[m][n][3] + bb.w);
                *(u32x2*)(p.yp + (size_t)row * D + col) = o;
            }
    }
}

template <bool DRY = false> __device__ __forceinline__ void ph_combine(const Params& p, int l, int M, LAS unsigned char* lds) {
    float* const c_xl = DRY ? p.prep : p.xl; bf16_t* const c_H = DRY ? (bf16_t*)(p.prep + (size_t)NTOK * D) : p.H; float* const c_out = DRY ? p.prep : p.out;
    LAS int* ts = (LAS int*)lds; LAS int* cn = ts + 40;
    build_expert_tables(p, l, ts, cn);
    const int tid = opaque_tid(), wid = tid >> 6, lane = tid & 63;
    const bool last = (l == 1);
    for (int tok = blockIdx.x * NWAVES + wid; tok < M; tok += gridDim.x * NWAVES) {
        float4 v[4];
        const float* mb = p.mod + (size_t)(l * 5 + tok_modrow(tok)) * (NMOD * D);
        int rows[4]; float wts[4];
#pragma unroll
        for (int k = 0; k < 4; ++k) { const int tsl = p.tokslot[(size_t)tok * 4 + k]; rows[k] = ts[tsl >> 16] * 256 + (tsl & 0xffff); wts[k] = p.topw[(size_t)tok * 4 + k]; }
        float ss = 0.f;
#pragma unroll
        for (int i = 0; i < 4; ++i) {
            const int cidx = i * 256 + lane * 4;
            float m0 = 0.f, m1 = 0.f, m2 = 0.f, m3 = 0.f;
#pragma unroll
            for (int k = 0; k < 4; ++k) {
                const u32x2 u = *(const u32x2*)(p.yp + (size_t)rows[k] * D + cidx);
                m0 += wts[k] * bflo(u[0]); m1 += wts[k] * bfhi(u[0]); m2 += wts[k] * bflo(u[1]); m3 += wts[k] * bfhi(u[1]);
            }
            const float4 gt = *(const float4*)(mb + 5 * D + cidx);
            float4 xv = *(const float4*)(p.xl + (size_t)tok * D + cidx);
            xv.x += gt.x * m0; xv.y += gt.y * m1; xv.z += gt.z * m2; xv.w += gt.w * m3;
            v[i] = xv; ss += xv.x * xv.x + xv.y * xv.y + xv.z * xv.z + xv.w * xv.w;
        }
        ss = wave_sum(ss);
        const float rinv = rsqrtf(ss * (1.0f / D) + 1e-6f);
        if (!last) {
#pragma unroll
            for (int i = 0; i < 4; ++i) *(float4*)(c_xl + (size_t)tok * D + i * 256 + lane * 4) = v[i];
            const float* mb1 = p.mod + (size_t)((l + 1) * 5 + tok_modrow(tok)) * (NMOD * D);
            norm_mod_store(v, rinv, p.norm1_g + (l + 1) * D, mb1 + 1 * D, mb1 + 0 * D, c_H + (size_t)tok * D, lane);
        } else {
#pragma unroll
            for (int i = 0; i < 4; ++i) {
                const int cidx = i * 256 + lane * 4;
                const float4 gv = *(const float4*)(p.final_norm_g + cidx);
                *(float4*)(c_out + (size_t)tok * D + cidx) = make_float4(v[i].x * rinv * gv.x, v[i].y * rinv * gv.y, v[i].z * rinv * gv.z, v[i].w * rinv * gv.w);
            }
        }
    }
}

#define XB_TMO      128
#define XB_XCNT(j)  (256  + 64 * (j))
#define XB_XSUB(j)  (1280 + 64 * (j))
#define XB_XGEN(j)  (2304 + 64 * (j))
#define XB_TOP      3328
#define XB_TOPGEN   3392
#define XCD_BAR_WORDS 3456
#define XB_SPIN_CAP (1u << 18)

__device__ __forceinline__ unsigned xb_ld(unsigned* p)              { return __hip_atomic_load(p, __ATOMIC_RELAXED, __HIP_MEMORY_SCOPE_AGENT); }
__device__ __forceinline__ unsigned xb_add(unsigned* p, unsigned v) { return __hip_atomic_fetch_add(p, v, __ATOMIC_RELAXED, __HIP_MEMORY_SCOPE_AGENT); }
__device__ __forceinline__ unsigned xb_xcc_id() { return (unsigned)__builtin_amdgcn_s_getreg((3 << 11) | 20) & 0xFu; }
#define XB_SPIN(cond, bar) do { unsigned _sp = 0; while (cond) { __builtin_amdgcn_s_sleep(1); \
    if ((++_sp & 255u) == 0u) { if (xb_ld(&(bar)[XB_TMO])) break; if (_sp > XB_SPIN_CAP) { atomicAdd(&(bar)[XB_TMO], 1u); break; } } } } while (0)

struct XcdBarrier {
    unsigned* bar; unsigned x;
    volatile LAS unsigned* st;
};

__device__ __forceinline__ XcdBarrier xcd_barrier_post(unsigned* bar, volatile LAS unsigned* st) {
    XcdBarrier b; b.bar = bar; b.x = xb_xcc_id(); b.st = st;
    if (threadIdx.x == 0) (void)xb_add(&bar[XB_XCNT(b.x)], 1u);
    return b;
}
__device__ __forceinline__ void xcd_barrier_complete(unsigned* bar, unsigned x, unsigned& nloc, unsigned& nx) {
    const unsigned G = gridDim.x * gridDim.y * gridDim.z;
    unsigned sum, cnt, mine, sp = 0u;
    for (;;) {
        sum = 0u; cnt = 0u; mine = 0u;
#pragma unroll
        for (unsigned j = 0; j < 16; ++j) { const unsigned c = xb_ld(&bar[XB_XCNT(j)]); sum += c; cnt += (c > 0u) ? 1u : 0u; mine = (j == x) ? c : mine; }
        if (sum == G) break;
        __builtin_amdgcn_s_sleep(1);
        if ((++sp & 255u) == 0u) { if (xb_ld(&bar[XB_TMO])) break; if (sp > XB_SPIN_CAP) { atomicAdd(&bar[XB_TMO], 1u); break; } }
    }
    nloc = mine > 0u ? mine : 1u; nx = cnt > 0u ? cnt : 1u;
}

__device__ __forceinline__ void xcd_barrier(const XcdBarrier& b) {
    asm volatile("s_waitcnt vmcnt(0)" ::: "memory");
    __syncthreads();
    if (threadIdx.x == 0) {
        unsigned* bar = b.bar;
        __builtin_amdgcn_s_waitcnt(0);
        unsigned nloc = b.st[0], nx = b.st[1];
        if (nloc == 0u) { xcd_barrier_complete(bar, b.x, nloc, nx); b.st[0] = nloc; b.st[1] = nx; }
        const unsigned old = xb_add(&bar[XB_XSUB(b.x)], 1u);
        const unsigned gen = old / nloc;
        if (old + 1u == (gen + 1u) * nloc) {
            __builtin_amdgcn_fence(__ATOMIC_RELEASE, "agent");
            asm volatile("s_waitcnt vmcnt(0)" ::: "memory");
            const unsigned og = xb_add(&bar[XB_TOP], 1u);
            const unsigned tg = og / nx;
            if (og + 1u == (tg + 1u) * nx) xb_add(&bar[XB_TOPGEN], 1u);
            else XB_SPIN(xb_ld(&bar[XB_TOPGEN]) == tg, bar);
            __builtin_amdgcn_fence(__ATOMIC_ACQUIRE, "agent");
            xb_add(&bar[XB_XGEN(b.x)], 1u);
            asm volatile("s_waitcnt vmcnt(0)" ::: "memory");
        } else {
            XB_SPIN(xb_ld(&bar[XB_XGEN(b.x)]) == gen, bar);
            __builtin_amdgcn_fence(__ATOMIC_ACQUIRE, "agent");
            asm volatile("s_waitcnt vmcnt(0)" ::: "memory");
        }
    }
    __syncthreads();
}


extern __shared__ __attribute__((aligned(16))) unsigned char dyn_lds[];
#define KPH(name, call) __global__ void __launch_bounds__(NTHREADS, 2) name(Params p, int l, int M) { LAS unsigned char* lds = (LAS unsigned char*)dyn_lds; (void)l; (void)M; (void)lds; call; }
KPH(k_convert, { ph_convert(p, lds); })
KPH(k_mod, { ph_mod(p, lds); })
KPH(k_norm1, { ph_norm1_first(p); })
KPH(k_g1, { ph_g1(p, l, lds); })
KPH(k_prep, { ph_prep(p, l, lds); })
KPH(k_local, { ph_local(p, l, lds); })
KPH(k_seq, { ph_seq(p, lds); })
KPH(k_merge, { ph_merge(p, l, M); })
KPH(k_g2, { ph_g2(p, l, M, lds); })
KPH(k_g3, { ph_g3(p, l, M, lds); })
KPH(k_route, { ph_route(p, l, M, lds); })
KPH(k_g4, { ph_g4(p, l, lds); })
KPH(k_g5, { ph_g5(p, l, lds); })
KPH(k_combine, { ph_combine(p, l, M, lds); })


__global__ void __launch_bounds__(NTHREADS, 2) k_mega(Params p) {
    LAS unsigned char* lds = (LAS unsigned char*)dyn_lds;
    volatile LAS unsigned* xb_words = (volatile LAS unsigned*)(lds + LDS_BYTES - 16);
    if (threadIdx.x == 0) { xb_words[0] = 0u; xb_words[1] = 0u; xb_words[2] = 0u; xb_words[3] = 0u; }
    __syncthreads();
    XcdBarrier bar = xcd_barrier_post(p.bar, xb_words);
#define RUNP(bit, stmt) do { stmt; if (PROBE & (1 << (bit))) { xcd_barrier(bar); stmt; } } while (0)
    RUNP(0, ph_convert(p, lds));
    RUNP(1, ph_mod(p, lds));
    xcd_barrier(bar);
    RUNP(2, ph_norm1_first(p));
    xcd_barrier(bar);
    for (int l = 0; l < 2; ++l) {
        const int M = l == 0 ? NTOK : NLAT;
        RUNP(3, ph_g1(p, l, lds));
        xcd_barrier(bar);
        RUNP(4, ph_prep(p, l, lds));
        xcd_barrier(bar);
        RUNP(5, ph_local(p, l, lds));
        xcd_barrier(bar);
        RUNP(6, ph_seq(p, lds));
        xcd_barrier(bar);
        RUNP(7, ph_merge(p, l, M));
        xcd_barrier(bar);
        RUNP(8, ph_g2(p, l, M, lds));
        xcd_barrier(bar);
        if (PROBE & (1 << 11)) { ph_g3<true>(p, l, M, lds); xcd_barrier(bar); }
        ph_g3(p, l, M, lds);
        xcd_barrier(bar);
        if (PROBE & (1 << 12)) { ph_route<true>(p, l, M, lds); xcd_barrier(bar); }
        ph_route(p, l, M, lds);
        xcd_barrier(bar);
        RUNP(9, ph_g4(p, l, lds));
        xcd_barrier(bar);
        RUNP(10, ph_g5(p, l, lds));
        xcd_barrier(bar);
        if (PROBE & (1 << 13)) { ph_combine<true>(p, l, M, lds); xcd_barrier(bar); }
        ph_combine(p, l, M, lds);
        if (l == 0) xcd_barrier(bar);
    }
}

static inline size_t align_up(size_t v, size_t a) { return (v + a - 1) / a * a; }

extern "C" void kernel_launch(void* const* d_in, const int* in_sizes, int n_in, void* d_out, int out_size, void* d_ws, size_t ws_size, hipStream_t stream) {
    (void)in_sizes; (void)n_in; (void)out_size;
    Params p{};
    const float** pf = (const float**)&p;
    for (int i = 0; i < 32; ++i) pf[i] = (const float*)d_in[i];
    p.out = (float*)d_out;
    unsigned char* w = (unsigned char*)d_ws; size_t off = 0;
    auto take = [&](size_t bytes) { void* r = w + off; off = align_up(off + bytes, 256); return r; };
    p.bar = (unsigned*)take(16384);
    p.cnt = (int*)take(1024);
    const size_t ctl_bytes = off;
    p.mod = (float*)take((size_t)2 * 5 * NMOD * D * 4);
    p.winT = (bf16_t*)take((size_t)2 * NP * D * 2);
    p.wbT = (bf16_t*)take((size_t)2 * 4 * D * MW * 2);
    p.woutT = (bf16_t*)take((size_t)2 * D * D * 2);
    p.w1T = (bf16_t*)take((size_t)2 * NE * 2 * D * D * 2);
    p.w2T = (bf16_t*)take((size_t)2 * NE * D * D * 2);
    p.xl = (float*)take((size_t)NTOK * D * 4);
    p.H = (bf16_t*)take((size_t)NTOK * D * 2);
    p.P = (bf16_t*)take((size_t)NTOK * NP * 2);
    p.act = p.P; p.yp = p.P + (size_t)CAPROWS * D;
    p.prep = (float*)take(NPREP * TOKW * 4);
    p.gg = (float*)take((size_t)NTOK * 8 * 4);
    p.gb = (float*)take((size_t)NTOK * 8 * 4);
    p.O = (float*)take(8 * TOKW * 4);
    p.lq = (bf16_t*)take((size_t)3 * NITEM * 64 * 128 * 2);
    p.lo = (bf16_t*)take((size_t)3 * NITEM * 64 * 128 * 2);
    p.lb = (bf16_t*)take((size_t)3 * NITEM * 128 * 128 * 2);
    p.la = (bf16_t*)take((size_t)NITEM * 128 * 128 * 2);
    p.ld = (float*)take((size_t)3 * NITEM * 128 * 4);
    p.Y = (bf16_t*)take(4 * TOKW * 2);
    p.mix = (bf16_t*)take((size_t)NTOK * D * 2);
    p.F = p.H;
    p.list = (int*)take((size_t)NE * NTOK * 4);
    p.tokslot = (int*)take((size_t)NTOK * 4 * 4);
    p.topw = (float*)take((size_t)NTOK * 4 * 4);
    if (off > ws_size) { fprintf(stderr, "workspace too small: need %zu have %zu\n", off, ws_size); return; }

    static int grid = 0;
#if MEGA
    if (!grid) {
        int dev = 0, cus = 0, occ = 0; (void)hipGetDevice(&dev); (void)hipDeviceGetAttribute(&cus, hipDeviceAttributeMultiprocessorCount, dev);
        (void)hipFuncSetAttribute((const void*)k_mega, hipFuncAttributeMaxDynamicSharedMemorySize, LDS_BYTES);
        (void)hipOccupancyMaxActiveBlocksPerMultiprocessor(&occ, (const void*)k_mega, NTHREADS, LDS_BYTES);
        if (cus <= 0) cus = 256;
        grid = cus * (occ < 1 ? 1 : 1);
        if (occ < 1) fprintf(stderr, "occupancy query says %d blocks per CU\n", occ);
    }
    (void)hipMemsetAsync(d_ws, 0, ctl_bytes, stream);
    hipLaunchKernelGGL(k_mega, dim3(grid), dim3(NTHREADS), LDS_BYTES, stream, p);
#else
    if (!grid) {
        int dev = 0, cus = 0; (void)hipGetDevice(&dev); (void)hipDeviceGetAttribute(&cus, hipDeviceAttributeMultiprocessorCount, dev);
        grid = cus > 0 ? cus : 256;
        const void* ks[] = {(const void*)k_convert, (const void*)k_mod, (const void*)k_norm1, (const void*)k_g1, (const void*)k_prep, (const void*)k_local, (const void*)k_seq, (const void*)k_merge,
                            (const void*)k_g2, (const void*)k_g3, (const void*)k_route, (const void*)k_g4, (const void*)k_g5, (const void*)k_combine};
        for (const void* k : ks) (void)hipFuncSetAttribute(k, hipFuncAttributeMaxDynamicSharedMemorySize, LDS_BYTES);
    }
    (void)hipMemsetAsync(d_ws, 0, ctl_bytes, stream);
#define LAUNCH(k, l, M) hipLaunchKernelGGL(k, dim3(grid), dim3(NTHREADS), LDS_BYTES, stream, p, l, M)
    LAUNCH(k_convert, 0, 0);
    LAUNCH(k_mod, 0, 0);
    LAUNCH(k_norm1, 0, 0);
    for (int l = 0; l < 2; ++l) {
        const int M = l == 0 ? NTOK : NLAT;
        LAUNCH(k_g1, l, M);
        LAUNCH(k_prep, l, M);
        LAUNCH(k_local, l, M);
        LAUNCH(k_seq, l, M);
        LAUNCH(k_merge, l, M);
        LAUNCH(k_g2, l, M);
        LAUNCH(k_g3, l, M);
        LAUNCH(k_route, l, M);
        LAUNCH(k_g4, l, M);
        LAUNCH(k_g5, l, M);
        LAUNCH(k_combine, l, M);
    }
#endif
}
```

```cpp
#include <hip/hip_runtime.h>
#include <stdint.h>
#include <stdio.h>

#define LAS __attribute__((address_space(3)))
typedef unsigned short bf16_t;
typedef short bf16x8 __attribute__((ext_vector_type(8)));
typedef float f32x4 __attribute__((ext_vector_type(4)));
typedef float f32x2 __attribute__((ext_vector_type(2)));
typedef unsigned u32x2 __attribute__((ext_vector_type(2)));
typedef unsigned u32x4 __attribute__((ext_vector_type(4)));

#ifndef MEGA
#define MEGA 1
#endif
#ifndef PROBE
#define PROBE 0
#endif

constexpr int D = 1024, NB = 4, TL = 4096, TC = 256, NLAT = NB * TL, NCTX = NB * TC, NTOK = NLAT + NCTX;
constexpr int NIN = 11792, NP = 12032, MW = 512, NE = 32, TOPK = 4, NMOD = 6;
constexpr int C_GQKV = 0, C_GZ = 1536, C_GA = 2048, C_GB = 2056, C_HQ = 2064, C_HI = 2576, C_HF = 3088, C_HG = 4112, C_LX = 4624,
              C_LY = 5136, C_RQKV = 5648, C_RG = 7184, C_MG = 7696;
constexpr int NTHREADS = 512, NWAVES = 8;
constexpr int LDS_BYTES = 140 * 1024;
constexpr int CAPROWS = 77824;
constexpr size_t TOKW = (size_t)NTOK * MW;
constexpr int PR_LA = 0, PR_LU = 2, NPREP = 4;
constexpr int NCHUNK = 68, NITEM = 32 * NCHUNK;

struct Params {
    const float *x, *c, *ctx, *c_ctx, *w_mod, *b_mod, *norm1_g, *norm2_g, *w_in, *gdn_conv_w, *gdn_a_log, *gdn_dt_bias, *gdn_norm_g, *hgrn_lb,
        *hgrn_norm_g, *lru_conv_w, *lru_conv_b, *lru_wa, *lru_ba, *lru_wx, *lru_bx, *lru_lambda, *ret_norm_g, *w_branch, *w_out, *router_w,
        *router_b, *moe_w1, *moe_b1, *moe_w2, *moe_b2, *final_norm_g;
    float* out;
    unsigned* bar; int* cnt; float* mod;
    bf16_t *winT, *wbT, *woutT, *w1T, *w2T;
    float* xl; bf16_t* H; bf16_t* P; float* prep; float* gg; float* gb; float* O; bf16_t* Y; bf16_t* mix; bf16_t* F;
    int* list; int* tokslot; float* topw; bf16_t* act; bf16_t* yp;
    bf16_t *lq, *lo, *lb, *la; float* ld;
};

__device__ __forceinline__ unsigned f2bf(float f) { unsigned u = __float_as_uint(f); u += 0x7fffu + ((u >> 16) & 1u); return u >> 16; }
__device__ __forceinline__ unsigned pack2(float a, float b) { return f2bf(a) | (f2bf(b) << 16); }
__device__ __forceinline__ float bf2f(bf16_t b) { return __uint_as_float(((unsigned)b) << 16); }
__device__ __forceinline__ float bflo(unsigned u) { return __uint_as_float(u << 16); }
__device__ __forceinline__ float bfhi(unsigned u) { return __uint_as_float(u & 0xffff0000u); }
__device__ __forceinline__ float sigmoidf_(float x) { return 1.0f / (1.0f + __expf(-x)); }
__device__ __forceinline__ float siluf_(float x) { return x * sigmoidf_(x); }
__device__ __forceinline__ float softplusf_(float x) { return x > 20.f ? x : log1pf(__expf(x)); }
__device__ __forceinline__ float logsigmoidf_(float x) { return -softplusf_(-x); }
__device__ __forceinline__ float gelu_tanhf_(float x) { const float u = 0.7978845608028654f * (x + 0.044715f * x * x * x); return 0.5f * x * (1.0f + tanhf(u)); }
__device__ __forceinline__ float wave_sum(float v) {
#pragma unroll
    for (int m = 32; m >= 1; m >>= 1) v += __shfl_xor(v, m);
    return v;
}
__device__ __forceinline__ int opaque_tid() { int t = threadIdx.x; asm volatile("" : "+v"(t)); return t; }
__device__ __forceinline__ int tok_modrow(int tok) { return tok < NLAT ? (tok >> 12) : 4; }
__device__ __forceinline__ void tok_info(int tok, int& t, int& T, int& base) {
    if (tok < NLAT) { t = tok & (TL - 1); T = TL; base = tok - t; }
    else { t = (tok - NLAT) & (TC - 1); T = TC; base = tok - t; }
}

namespace gm {
constexpr int HT = 16384;
__device__ __forceinline__ int lds_byte(int r, int c) { const int st = (r >> 4) * 2 + (c >> 5), rr = r & 15, cc = c & 31, ob = rr * 64 + cc * 2; return st * 1024 + (ob ^ (((ob >> 9) & 1) << 5)); }
__device__ __forceinline__ void stage_rc(int b, int& R, int& C) { const int st = b / 1024, sb = b % 1024, swz = sb ^ (((sb >> 9) & 1) << 5); R = (st >> 1) * 16 + swz / 64; C = (st & 1) * 32 + (swz % 64) / 2; }

__device__ __forceinline__ void kloop(LAS unsigned char* lds, const bf16_t* ap00, const bf16_t* ap01, const bf16_t* ap10, const bf16_t* ap11,
                                      const bf16_t* bp0, const bf16_t* bp1, int K, f32x4 (&acc)[4][4]) {
    const int tid = opaque_tid(), wid = __builtin_amdgcn_readfirstlane(tid >> 6), lane = tid & 63, wr = wid >> 1, wc = wid & 1, fr = lane & 15, fq = lane >> 4;
    const unsigned ldsw = (unsigned)wid * 1024u;
    const int aoff = (wr >> 1) * HT + lds_byte((wr & 1) * 64 + fr, fq * 8);
    const int boff = 2 * HT + lds_byte(wc * 64 + fr, fq * 8);
    const int nt = K / 64;
#define GM_GLDS(src, dstoff) __builtin_amdgcn_global_load_lds((const unsigned*)(src), (LAS unsigned*)(lds + (dstoff)), 16, 0, 0)
#define GM_STAGE(buf, kt) do { const int _bo = (buf) * 3 * HT + ldsw; const int _ko = (kt) * 64; \
        GM_GLDS(ap00 + _ko, _bo); GM_GLDS(ap01 + _ko, _bo + 8192); GM_GLDS(ap10 + _ko, _bo + HT); GM_GLDS(ap11 + _ko, _bo + HT + 8192); \
        GM_GLDS(bp0 + _ko, _bo + 2 * HT); GM_GLDS(bp1 + _ko, _bo + 2 * HT + 8192); } while (0)
    GM_STAGE(0, 0);
    for (int t = 0; t < nt; ++t) {
        const int cur = t & 1;
        if (t + 1 < nt) { GM_STAGE(cur ^ 1, t + 1); asm volatile("s_waitcnt vmcnt(6)" ::: "memory"); }
        else asm volatile("s_waitcnt vmcnt(0)" ::: "memory");
        __builtin_amdgcn_s_barrier(); asm volatile("" ::: "memory");
        bf16x8 af[4][2], bfr[4][2];
#pragma unroll
        for (int m = 0; m < 4; ++m)
#pragma unroll
            for (int k = 0; k < 2; ++k) af[m][k] = *(const LAS bf16x8*)(lds + cur * 3 * HT + aoff + m * 2048 + k * 1024);
#pragma unroll
        for (int n = 0; n < 4; ++n)
#pragma unroll
            for (int k = 0; k < 2; ++k) bfr[n][k] = *(const LAS bf16x8*)(lds + cur * 3 * HT + boff + n * 2048 + k * 1024);
#pragma unroll
        for (int k = 0; k < 2; ++k)
#pragma unroll
            for (int m = 0; m < 4; ++m)
#pragma unroll
                for (int n = 0; n < 4; ++n) acc[m][n] = __builtin_amdgcn_mfma_f32_16x16x32_bf16(bfr[n][k], af[m][k], acc[m][n], 0, 0, 0);
        asm volatile("s_waitcnt lgkmcnt(0)" ::: "memory");
        __builtin_amdgcn_s_barrier(); asm volatile("" ::: "memory");
    }
#undef GM_STAGE
#undef GM_GLDS
}
__device__ __forceinline__ void zero_acc(f32x4 (&acc)[4][4]) {
#pragma unroll
    for (int m = 0; m < 4; ++m)
#pragma unroll
        for (int n = 0; n < 4; ++n) acc[m][n] = (f32x4){0.f, 0.f, 0.f, 0.f};
}
}

namespace g8 {
constexpr int BM = 256, BK = 64, HALF = 128, HTB = HALF * BK * 2, STAGE_BYTES = 8 * HTB;
__device__ __forceinline__ int lds_byte(int r, int c) { const int st = (r >> 4) * 2 + (c >> 5), rr = r & 15, cc = c & 31, ob = rr * 64 + cc * 2; return st * 1024 + (ob ^ (((ob >> 9) & 1) << 5)); }
__device__ __forceinline__ void stage_rc(int b, int& R, int& C) { const int st = b / 1024, sb = b % 1024, swz = sb ^ (((sb >> 9) & 1) << 5); R = (st >> 1) * 16 + swz / 64; C = (st & 1) * 32 + (swz % 64) / 2; }
__device__ __forceinline__ int perm32(int rho) { const int n = rho >> 4, i = rho & 15; return 8 * (i >> 2) + 4 * n + (i & 3); }
struct Unit { int pm, pn, e; };

template <class Epi, class Sched>
__device__ __forceinline__ void gemm_phase(LAS unsigned char* lds, const int K, const Sched& S, const Epi& E) {
    const int tid = opaque_tid(), wid = __builtin_amdgcn_readfirstlane(tid >> 6), lane = tid & 63, wr = wid >> 2, wc = wid & 3, fr = lane & 15, fq = lane >> 4;
    const int nt = K / BK;
    int R0, C0, R1, C1; stage_rc(tid * 16, R0, C0); stage_rc(tid * 16 + 8192, R1, C1);
    unsigned voffB[2];
    voffB[0] = (unsigned)(((R0 & ~31) + perm32(R0 & 31)) * K + C0) * 2u; voffB[1] = (unsigned)(((R1 & ~31) + perm32(R1 & 31)) * K + C1) * 2u;
    const unsigned cb0 = (unsigned)C0 * 2u, cb1 = (unsigned)C1 * 2u;
    const size_t kstep = (size_t)(BK * 2);
    const size_t hstepB = (size_t)HALF * K * 2;
    const unsigned ldsw = (unsigned)wid * 1024u;
    const int aoff = lds_byte(wr * 64 + fr, fq * 8), boff = lds_byte(wc * 32 + fr, fq * 8);
#define G8_SA(b, h) (((b) * 2 + (h)) * HTB)
#define G8_SB(b, h) ((4 + (b) * 2 + (h)) * HTB)
#define G8_GL(src, dstoff) __builtin_amdgcn_global_load_lds((const unsigned*)(src), (LAS unsigned*)(lds + (dstoff)), 16, 0, 0)
#define G8_STAGE_A(bufoff, gbase, vo, h) do { G8_GL((const char*)(gbase) + (vo)[2 * (h)], (bufoff) + ldsw); G8_GL((const char*)(gbase) + (vo)[2 * (h) + 1], (bufoff) + ldsw + 8192); } while (0)
#define G8_STAGE_B(bufoff, gbase) do { G8_GL((const char*)(gbase) + voffB[0], (bufoff) + ldsw); G8_GL((const char*)(gbase) + voffB[1], (bufoff) + ldsw + 8192); } while (0)
#define G8_LDA(dst, b, h) do { _Pragma("unroll") for (int m = 0; m < 4; ++m) _Pragma("unroll") for (int k = 0; k < 2; ++k) dst[m][k] = *(const LAS bf16x8*)(lds + G8_SA(b, h) + aoff + m * 2048 + k * 1024); } while (0)
#define G8_LDB(dst, b, h) do { _Pragma("unroll") for (int n = 0; n < 2; ++n) _Pragma("unroll") for (int k = 0; k < 2; ++k) dst[n][k] = *(const LAS bf16x8*)(lds + G8_SB(b, h) + boff + n * 2048 + k * 1024); } while (0)
#define G8_MMA(ai, bj, At, Bt) do { __builtin_amdgcn_s_setprio(1); _Pragma("unroll") for (int m = 0; m < 4; ++m) _Pragma("unroll") for (int n = 0; n < 2; ++n) _Pragma("unroll") for (int k = 0; k < 2; ++k) \
        acc[ai][bj][m][n] = __builtin_amdgcn_mfma_f32_16x16x32_bf16(Bt[n][k], At[m][k], acc[ai][bj][m][n], 0, 0, 0); __builtin_amdgcn_s_setprio(0); } while (0)
#define G8_WAIT_V(n) asm volatile("s_waitcnt vmcnt(" #n ")" ::: "memory")
#define G8_WAIT_L(n) asm volatile("s_waitcnt lgkmcnt(" #n ")" ::: "memory")
#define G8_BAR __builtin_amdgcn_s_barrier()
#define G8_SCHED __builtin_amdgcn_sched_barrier(0)
    Unit cur, nxt; int ui = 0;
    if (!S.next(0, cur)) return;
    f32x4 acc[2][2][4][2];
#pragma unroll
    for (int a = 0; a < 2; ++a)
#pragma unroll
        for (int b = 0; b < 2; ++b)
#pragma unroll
            for (int m = 0; m < 4; ++m)
#pragma unroll
                for (int n = 0; n < 2; ++n) acc[a][b][m][n] = (f32x4){0.f, 0.f, 0.f, 0.f};
    bf16x8 At[4][2], B0[2][2], B1[2][2];
    unsigned vA[4], vN[4];
    { unsigned rows[4]; S.a_rows(cur, R0, R1, rows); vA[0] = rows[0] * (unsigned)(K * 2) + cb0; vA[1] = rows[1] * (unsigned)(K * 2) + cb1; vA[2] = rows[2] * (unsigned)(K * 2) + cb0; vA[3] = rows[3] * (unsigned)(K * 2) + cb1; }
    const char* cA = S.a_base(cur); const char* cB = S.b_base(cur);
    G8_STAGE_B(G8_SB(0, 0), cB); G8_STAGE_A(G8_SA(0, 0), cA, vA, 0); G8_STAGE_B(G8_SB(0, 1), cB + hstepB); G8_STAGE_A(G8_SA(0, 1), cA, vA, 1);
    if (wr == 1) G8_BAR;
    G8_WAIT_V(4); G8_BAR;
    G8_STAGE_B(G8_SB(1, 0), cB + kstep); G8_STAGE_A(G8_SA(1, 0), cA + kstep, vA, 0); G8_STAGE_B(G8_SB(1, 1), cB + hstepB + kstep);
    G8_WAIT_V(6); G8_BAR;
    for (;;) {
        const bool has_next = S.next(ui + 1, nxt);
        const char* nA = has_next ? S.a_base(nxt) : cA; const char* nB = has_next ? S.b_base(nxt) : cB;
        if (has_next) { unsigned rows[4]; S.a_rows(nxt, R0, R1, rows); vN[0] = rows[0] * (unsigned)(K * 2) + cb0; vN[1] = rows[1] * (unsigned)(K * 2) + cb1; vN[2] = rows[2] * (unsigned)(K * 2) + cb0; vN[3] = rows[3] * (unsigned)(K * 2) + cb1; }
        else { vN[0] = vA[0]; vN[1] = vA[1]; vN[2] = vA[2]; vN[3] = vA[3]; }
        for (int t = 0; t < nt; t += 2) {
            const bool last = (t == nt - 2);
            const char* a1 = cA + (size_t)(t + 1) * kstep;
            const char* a2 = last ? nA : cA + (size_t)(t + 2) * kstep; const char* b2 = last ? nB : cB + (size_t)(t + 2) * kstep;
            const char* a3 = a2 + kstep; const char* b3 = b2 + kstep;
            unsigned v2[4];
#pragma unroll
            for (int q = 0; q < 4; ++q) v2[q] = last ? vN[q] : vA[q];
            G8_LDB(B0, 0, 0); G8_SCHED; G8_LDA(At, 0, 0); G8_STAGE_A(G8_SA(1, 1), a1, vA, 1);
            G8_WAIT_L(8); G8_BAR; G8_WAIT_L(0); G8_MMA(0, 0, At, B0); G8_BAR; G8_SCHED;
            G8_LDB(B1, 0, 1); G8_STAGE_B(G8_SB(0, 0), b2);
            G8_BAR; G8_WAIT_L(0); G8_MMA(0, 1, At, B1); G8_BAR;
            G8_LDA(At, 0, 1); G8_STAGE_A(G8_SA(0, 0), a2, v2, 0);
            G8_BAR; G8_WAIT_L(0); G8_MMA(1, 0, At, B0); G8_BAR; G8_SCHED;
            G8_STAGE_B(G8_SB(0, 1), b2 + hstepB);
            G8_WAIT_V(6); G8_BAR; G8_MMA(1, 1, At, B1); G8_BAR;
            G8_LDB(B0, 1, 0); G8_SCHED; G8_LDA(At, 1, 0); G8_STAGE_A(G8_SA(0, 1), a2, v2, 1);
            G8_WAIT_L(8); G8_BAR; G8_WAIT_L(0); G8_MMA(0, 0, At, B0); G8_BAR; G8_SCHED;
            G8_LDB(B1, 1, 1); G8_STAGE_B(G8_SB(1, 0), b3);
            G8_BAR; G8_WAIT_L(0); G8_MMA(0, 1, At, B1); G8_BAR;
            G8_LDA(At, 1, 1); G8_STAGE_A(G8_SA(1, 0), a3, v2, 0);
            G8_BAR; G8_WAIT_L(0); G8_MMA(1, 0, At, B0); G8_BAR; G8_SCHED;
            G8_STAGE_B(G8_SB(1, 1), b3 + hstepB);
            G8_WAIT_V(6); G8_BAR; G8_MMA(1, 1, At, B1); G8_BAR;
        }
        E(acc, cur, wr, wc, fr, fq);
        if (!has_next) break;
#pragma unroll
        for (int a = 0; a < 2; ++a)
#pragma unroll
            for (int b = 0; b < 2; ++b)
#pragma unroll
                for (int m = 0; m < 4; ++m)
#pragma unroll
                    for (int n = 0; n < 2; ++n) acc[a][b][m][n] = (f32x4){0.f, 0.f, 0.f, 0.f};
        cur = nxt; cA = nA; cB = nB; ++ui;
#pragma unroll
        for (int q = 0; q < 4; ++q) vA[q] = vN[q];
    }
    G8_WAIT_V(0);
    if (wr == 0) G8_BAR;
    G8_BAR;
#undef G8_SA
#undef G8_SB
#undef G8_GL
#undef G8_STAGE_A
#undef G8_STAGE_B
#undef G8_LDA
#undef G8_LDB
#undef G8_MMA
#undef G8_WAIT_V
#undef G8_WAIT_L
#undef G8_BAR
#undef G8_SCHED
}

struct PlainSched {
    const bf16_t* A; const bf16_t* Bt; int K, nM, nN, nwg, G, c;
    __device__ __forceinline__ void init(const bf16_t* A_, const bf16_t* Bt_, int M, int N, int K_) { A = A_; Bt = Bt_; K = K_; nM = M / BM; nN = N / BM; nwg = nM * nN; G = gridDim.x; c = blockIdx.x; }
    __device__ __forceinline__ bool next(int i, Unit& u) const {
        const long L = (long)i * G + c; if (L >= nwg) return false;
        int wgid = (int)L; { const int q = nwg / 8, r = nwg % 8, xcd = wgid % 8, off = wgid / 8; wgid = (xcd < r ? xcd * (q + 1) : r * (q + 1) + (xcd - r) * q) + off; }
        const int nig = 8 * nN, gid = wgid / nig, fm = gid * 8, gsz = (nM - fm) < 8 ? (nM - fm) : 8;
        u.pm = fm + ((wgid % nig) % gsz); u.pn = (wgid % nig) / gsz; u.e = 0; return true;
    }
    __device__ __forceinline__ const char* a_base(const Unit& u) const { return (const char*)(A + (size_t)u.pm * BM * K); }
    __device__ __forceinline__ const char* b_base(const Unit& u) const { return (const char*)(Bt + (size_t)u.pn * BM * K); }
    __device__ __forceinline__ void a_rows(const Unit&, int R0, int R1, unsigned (&rows)[4]) const { rows[0] = R0; rows[1] = R1; rows[2] = HALF + R0; rows[3] = HALF + R1; }
};
}

struct StageRC { int R0, C0, R1, C1; };
__device__ __forceinline__ StageRC my_stage_rc() { const int t = opaque_tid(); StageRC s; gm::stage_rc(t * 16, s.R0, s.C0); gm::stage_rc(t * 16 + 8192, s.R1, s.C1); return s; }

__device__ __forceinline__ int w1_dst_row(int n) { const int half = n >> 10, cc = n & 1023; return (cc >> 7) * 256 + half * 128 + (cc & 127); }

__device__ __forceinline__ void cvt_tile(LAS float* tile, const float* src, int ldsrc, int Nsrc, int k0, int n0, bf16_t* dst, int K, int mode) {
    const int tid = opaque_tid();
    {
        const int rr = tid >> 6, cc = tid & 63, n = n0 + cc;
#pragma unroll
        for (int i = 0; i < 8; ++i) { const int k = rr + i * 8; tile[k * 65 + cc] = (n < Nsrc) ? src[(size_t)(k0 + k) * ldsrc + n] : 0.f; }
    }
    __syncthreads();
    {
        const int nl = tid >> 3, kg = tid & 7, n = n0 + nl;
        float v[8];
#pragma unroll
        for (int j = 0; j < 8; ++j) v[j] = tile[(kg * 8 + j) * 65 + nl];
        const int drow = mode == 1 ? w1_dst_row(n) : n;
        u32x4 o; o[0] = pack2(v[0], v[1]); o[1] = pack2(v[2], v[3]); o[2] = pack2(v[4], v[5]); o[3] = pack2(v[6], v[7]);
        *(u32x4*)(dst + (size_t)drow * K + k0 + kg * 8) = o;
    }
    __syncthreads();
}

__device__ __forceinline__ void ph_convert(const Params& p, LAS unsigned char* lds) {
    LAS float* tile = (LAS float*)lds;
    constexpr int PER_L = 3008 + 512 + 256 + 16384 + 8192;
    for (int it = blockIdx.x; it < 2 * PER_L; it += gridDim.x) {
        const int l = it / PER_L; int r = it % PER_L;
        if (r < 3008) { const int nt = r % 188, kt = r / 188; cvt_tile(tile, p.w_in + (size_t)l * D * NIN, NIN, NIN, kt * 64, nt * 64, p.winT + (size_t)l * NP * D, D, 0); }
        else if (r < 3520) { r -= 3008; const int n = r / 128; r %= 128; const int nt = r % 16, kt = r / 16;
            cvt_tile(tile, p.w_branch + (size_t)(l * 4 + n) * MW * D, D, D, kt * 64, nt * 64, p.wbT + (size_t)(l * 4 + n) * D * MW, MW, 0); }
        else if (r < 3776) { r -= 3520; const int nt = r % 16, kt = r / 16; cvt_tile(tile, p.w_out + (size_t)l * D * D, D, D, kt * 64, nt * 64, p.woutT + (size_t)l * D * D, D, 0); }
        else if (r < 3776 + 16384) { r -= 3776; const int e = r / 512; r %= 512; const int nt = r % 32, kt = r / 32;
            cvt_tile(tile, p.moe_w1 + (size_t)(l * NE + e) * D * 2 * D, 2 * D, 2 * D, kt * 64, nt * 64, p.w1T + (size_t)(l * NE + e) * 2 * D * D, D, 1); }
        else { r -= 3776 + 16384; const int e = r / 256; r %= 256; const int nt = r % 16, kt = r / 16;
            cvt_tile(tile, p.moe_w2 + (size_t)(l * NE + e) * D * D, D, D, kt * 64, nt * 64, p.w2T + (size_t)(l * NE + e) * D * D, D, 0); }
    }
}

__device__ __forceinline__ void ph_mod(const Params& p, LAS unsigned char* lds) {
    LAS float* sc = (LAS float*)lds;
    LAS float* red = sc + 5 * D;
    const int tid = opaque_tid(), wid = tid >> 6, lane = tid & 63;
    if ((int)blockIdx.x >= 192) return;
    for (int i = tid; i < 5 * D; i += NTHREADS) { const int r = i >> 10, k = i & 1023; const float v = r < 4 ? p.c[r * D + k] : p.c_ctx[k]; sc[i] = siluf_(v); }
    __syncthreads();
    for (int it = blockIdx.x; it < 192; it += gridDim.x) {
        const int l = it / 96, n0 = (it % 96) * 64;
        float acc[5] = {0.f, 0.f, 0.f, 0.f, 0.f};
        const float* wp = p.w_mod + (size_t)l * D * (NMOD * D) + n0 + lane;
        for (int k = wid * 128; k < wid * 128 + 128; ++k) {
            const float wv = wp[(size_t)k * (NMOD * D)];
#pragma unroll
            for (int r = 0; r < 5; ++r) acc[r] += sc[r * D + k] * wv;
        }
#pragma unroll
        for (int r = 0; r < 5; ++r) red[(wid * 5 + r) * 64 + lane] = acc[r];
        __syncthreads();
        if (tid < 320) { const int r = tid >> 6, cidx = tid & 63; float s = p.b_mod[l * NMOD * D + n0 + cidx];
#pragma unroll
            for (int w = 0; w < 8; ++w) s += red[(w * 5 + r) * 64 + cidx];
            p.mod[(size_t)(l * 5 + r) * (NMOD * D) + n0 + cidx] = s; }
        __syncthreads();
    }
}

__device__ __forceinline__ void norm_mod_store(const float4 (&v)[4], float rinv, const float* g, const float* scp, const float* shp, bf16_t* dst, int lane) {
#pragma unroll
    for (int i = 0; i < 4; ++i) {
        const int cidx = i * 256 + lane * 4;
        const float4 gv = *(const float4*)(g + cidx), sv = *(const float4*)(scp + cidx), hv = *(const float4*)(shp + cidx);
        const float h0 = v[i].x * rinv * gv.x * (1.f + sv.x) + hv.x, h1 = v[i].y * rinv * gv.y * (1.f + sv.y) + hv.y;
        const float h2 = v[i].z * rinv * gv.z * (1.f + sv.z) + hv.z, h3 = v[i].w * rinv * gv.w * (1.f + sv.w) + hv.w;
        u32x2 o; o[0] = pack2(h0, h1); o[1] = pack2(h2, h3);
        *(u32x2*)(dst + cidx) = o;
    }
}
__device__ __forceinline__ void ph_norm1_first(const Params& p) {
    const int tid = opaque_tid(), wid = tid >> 6, lane = tid & 63;
    for (int tok = blockIdx.x * NWAVES + wid; tok < NTOK; tok += gridDim.x * NWAVES) {
        const float* src = tok < NLAT ? p.x + (size_t)tok * D : p.ctx + (size_t)(tok - NLAT) * D;
        float4 v[4]; float ss = 0.f;
#pragma unroll
        for (int i = 0; i < 4; ++i) { v[i] = *(const float4*)(src + i * 256 + lane * 4); ss += v[i].x * v[i].x + v[i].y * v[i].y + v[i].z * v[i].z + v[i].w * v[i].w; }
        ss = wave_sum(ss);
        const float rinv = rsqrtf(ss * (1.0f / D) + 1e-6f);
        const float* mb = p.mod + (size_t)(0 * 5 + tok_modrow(tok)) * (NMOD * D);
        norm_mod_store(v, rinv, p.norm1_g, mb + 1 * D, mb + 0 * D, p.H + (size_t)tok * D, lane);
#pragma unroll
        for (int i = 0; i < 4; ++i) *(float4*)(p.xl + (size_t)tok * D + i * 256 + lane * 4) = v[i];
    }
}

struct EpiP {
    bf16_t* O;
    __device__ __forceinline__ void operator()(const f32x4 (&acc)[2][2][4][2], const g8::Unit& u, int wr, int wc, int fr, int fq) const {
        const int row0 = u.pm * 256 + wr * 64 + fr, col0 = u.pn * 256 + wc * 32 + 8 * fq;
#pragma unroll
        for (int ai = 0; ai < 2; ++ai)
#pragma unroll
            for (int m = 0; m < 4; ++m) {
                bf16_t* rowp = O + (size_t)(row0 + ai * 128 + m * 16) * NP + col0;
#pragma unroll
                for (int bj = 0; bj < 2; ++bj) {
                    u32x4 w; w[0] = pack2(acc[ai][bj][m][0][0], acc[ai][bj][m][0][1]); w[1] = pack2(acc[ai][bj][m][0][2], acc[ai][bj][m][0][3]);
                    w[2] = pack2(acc[ai][bj][m][1][0], acc[ai][bj][m][1][1]); w[3] = pack2(acc[ai][bj][m][1][2], acc[ai][bj][m][1][3]);
                    *(u32x4*)(rowp + bj * 128) = w;
                }
            }
    }
};
__device__ __forceinline__ void ph_g1(const Params& p, int l, LAS unsigned char* lds) {
    g8::PlainSched S; S.init(p.H, p.winT + (size_t)l * NP * D, NTOK, NP, D);
    EpiP E; E.O = p.P;
    g8::gemm_phase(lds, D, S, E);
}

__device__ __forceinline__ void ph_prep(const Params& p, int l, LAS unsigned char* lds) {
    const int tid = opaque_tid();
    {
        LAS float* xs = (LAS float*)lds;
        LAS float* wsm = xs + 64 * 65;
        for (int it = blockIdx.x; it < (NTOK / 64) * 8; it += gridDim.x) {
            const int tile = it >> 3, n = it & 7, tok0 = tile * 64;
            {
                const int tl = tid & 63, cg = tid >> 6, tok = tok0 + tl;
                int t, T, base; tok_info(tok, t, T, base);
                float a[8];
#pragma unroll
                for (int j = 0; j < 8; ++j) a[j] = p.lru_conv_b[l * MW + n * 64 + cg * 8 + j];
#pragma unroll
                for (int j = 0; j < 4; ++j) {
                    const int tt = t + j - 2;
                    if (tt >= 0 && tt < T) {
                        const u32x4 u = *(const u32x4*)(p.P + (size_t)(base + tt) * NP + C_LX + n * 64 + cg * 8);
                        const float* w = p.lru_conv_w + (size_t)(l * 4 + j) * MW + n * 64 + cg * 8;
#pragma unroll
                        for (int q = 0; q < 4; ++q) { a[2 * q] += w[2 * q] * bflo(u[q]); a[2 * q + 1] += w[2 * q + 1] * bfhi(u[q]); }
                    }
                }
#pragma unroll
                for (int j = 0; j < 8; ++j) xs[tl * 65 + cg * 8 + j] = a[j];
                for (int i = tid; i < 4 * 1024; i += NTHREADS) {
                    const int mat = i >> 10, off = (i & 1023) * 4, d = mat >> 1;
                    const float* srcw = ((mat & 1) ? p.lru_wx : p.lru_wa) + (size_t)((l * 2 + d) * 8 + n) * 4096 + off;
                    const float4 v = *(const float4*)srcw;
                    LAS float* dw = wsm + mat * 4096 + off; dw[0] = v.x; dw[1] = v.y; dw[2] = v.z; dw[3] = v.w;
                }
            }
            __syncthreads();
            {
                const int tl = tid & 63, jg = tid >> 6, tok = tok0 + tl;
                float acc[4][8];
#pragma unroll
                for (int m = 0; m < 4; ++m)
#pragma unroll
                    for (int j = 0; j < 8; ++j) acc[m][j] = 0.f;
                for (int i = 0; i < 64; ++i) {
                    const float xv = xs[tl * 65 + i];
#pragma unroll
                    for (int m = 0; m < 4; ++m)
#pragma unroll
                        for (int j = 0; j < 8; ++j) acc[m][j] += xv * wsm[m * 4096 + i * 64 + jg * 8 + j];
                }
#pragma unroll
                for (int d = 0; d < 2; ++d) {
                    float av[8], uv[8];
#pragma unroll
                    for (int j = 0; j < 8; ++j) {
                        const int cidx = n * 64 + jg * 8 + j, pi = (l * 2 + d) * MW + cidx;
                        const float gr = sigmoidf_(acc[d * 2][j] + p.lru_ba[pi]), gi = sigmoidf_(acc[d * 2 + 1][j] + p.lru_bx[pi]);
                        const float la = 8.0f * gr * logsigmoidf_(p.lru_lambda[pi]);
                        av[j] = __expf(la);
                        uv[j] = xs[tl * 65 + jg * 8 + j] * gi * sqrtf(fmaxf(-expm1f(2.0f * la), 1e-12f));
                    }
                    float* da = p.prep + (PR_LA + d) * TOKW + (size_t)tok * MW + n * 64 + jg * 8;
                    float* du = p.prep + (PR_LU + d) * TOKW + (size_t)tok * MW + n * 64 + jg * 8;
                    *(float4*)da = make_float4(av[0], av[1], av[2], av[3]); *(float4*)(da + 4) = make_float4(av[4], av[5], av[6], av[7]);
                    *(float4*)du = make_float4(uv[0], uv[1], uv[2], uv[3]); *(float4*)(du + 4) = make_float4(uv[4], uv[5], uv[6], uv[7]);
                }
            }
            __syncthreads();
        }
    }
}

__device__ __forceinline__ int chunk_base(int b, int d, int n) {
    if (n < 4) { const int blk = d ? 3 - n : n; return NLAT + b * TC + blk * 64; }
    const int m = n - 4, blk = d ? 63 - m : m; return b * TL + blk * 64;
}
__device__ __forceinline__ f32x4 mfma16(bf16x8 a, bf16x8 b, f32x4 c) { return __builtin_amdgcn_mfma_f32_16x16x32_bf16(a, b, c, 0, 0, 0); }
__device__ __forceinline__ u32x2 pack4(f32x4 v) { u32x2 o; o[0] = pack2(v[0], v[1]); o[1] = pack2(v[2], v[3]); return o; }
__device__ __forceinline__ u32x4 pack8(const float* v) { u32x4 o; o[0] = pack2(v[0], v[1]); o[1] = pack2(v[2], v[3]); o[2] = pack2(v[4], v[5]); o[3] = pack2(v[6], v[7]); return o; }

__device__ __forceinline__ void local_gla(const Params& p, int l, int tz, int chain, int n, LAS unsigned char* lds) {
    const int tid = opaque_tid(), wid = tid >> 6, lane = tid & 63, fr = lane & 15, fq = lane >> 4;
    const int b = chain >> 3, h = (chain >> 1) & 3, d = chain & 1;
    const int base = chunk_base(b, d, n);
    const size_t item = (size_t)tz * NITEM + (size_t)chain * NCHUNK + n;
    LAS bf16_t* kraw = (LAS bf16_t*)lds;
    LAS bf16_t* qh = kraw + 64 * 136;
    LAS bf16_t* kh = qh + 64 * 136;
    LAS bf16_t* sc = kh + 64 * 136;
    LAS bf16_t* vT = sc + 64 * 72;
    LAS bf16_t* kT = vT + 128 * 72;
    LAS float* bc = (LAS float*)(kT + 128 * 72);
    const int vcol = tz == 1 ? C_HI : C_RQKV + 1024;
    const int ti = tid >> 3, dg = tid & 7, cA = dg * 8, cB = 64 + dg * 8;
    const int tokI = base + (d ? 63 - ti : ti);
    const bf16_t* pr = p.P + (size_t)tokI * NP;
    float qt[16];
    {
        float kv[16], lfv[16];
        if (tz == 1) {
            const u32x4 uqa = *(const u32x4*)(pr + C_HQ + h * 128 + cA), uqb = *(const u32x4*)(pr + C_HQ + h * 128 + cB);
            const u32x4 uza = *(const u32x4*)(pr + C_HF + d * 512 + h * 128 + cA), uzb = *(const u32x4*)(pr + C_HF + d * 512 + h * 128 + cB);
#pragma unroll
            for (int e = 0; e < 16; ++e) {
                const unsigned uq = e < 8 ? uqa[(e & 7) >> 1] : uqb[(e & 7) >> 1], uz = e < 8 ? uza[(e & 7) >> 1] : uzb[(e & 7) >> 1];
                const float qraw = (e & 1) ? bfhi(uq) : bflo(uq), z = (e & 1) ? bfhi(uz) : bflo(uz);
                const int ch = h * 128 + (e < 8 ? cA + e : cB + e - 8);
                float lb = 0.f;
                if (l == 1) lb = fminf(1.0f / (1.0f + __expf(p.hgrn_lb[(size_t)(0 * 2 + d) * MW + ch] - p.hgrn_lb[(size_t)(1 * 2 + d) * MW + ch])), 1.0f - 1e-4f);
                const float sg = sigmoidf_(z);
                qt[e] = siluf_(qraw) * 0.08838834764831845f;
                kv[e] = (1.f - lb) * (1.f - sg);
                lfv[e] = __logf(fmaxf(lb + (1.f - lb) * sg, 1e-30f));
            }
        } else {
            const bf16_t* rp = pr + C_RQKV + h * 128;
            const u32x4 q1 = *(const u32x4*)(rp + cA), q2 = *(const u32x4*)(rp + cB), k1 = *(const u32x4*)(rp + 512 + cA), k2 = *(const u32x4*)(rp + 512 + cB);
            const float lng = log1pf(-exp2f(-5.0f - (float)h));
            const bool lat = tokI < NLAT;
            const int t = tokI & (TL - 1);
#pragma unroll
            for (int e = 0; e < 8; ++e) {
                float a1 = (e & 1) ? bfhi(q1[e >> 1]) : bflo(q1[e >> 1]), a2 = (e & 1) ? bfhi(q2[e >> 1]) : bflo(q2[e >> 1]);
                float b1 = (e & 1) ? bfhi(k1[e >> 1]) : bflo(k1[e >> 1]), b2 = (e & 1) ? bfhi(k2[e >> 1]) : bflo(k2[e >> 1]);
                if (lat) {
                    const int pi = cA + e;
                    const float pos = (pi < 32) ? (float)(t >> 6) : (float)(t & 63);
                    const float ang = pos * exp2f(-(float)(pi & 31) * (13.287712379549449f / 32.0f));
                    float sn, cs; sincosf(ang, &sn, &cs);
                    const float n1 = a1 * cs - a2 * sn, n2 = a1 * sn + a2 * cs, m1 = b1 * cs - b2 * sn, m2 = b1 * sn + b2 * cs;
                    a1 = n1; a2 = n2; b1 = m1; b2 = m2;
                }
                qt[e] = a1; qt[8 + e] = a2; kv[e] = b1 * 0.08838834764831845f; kv[8 + e] = b2 * 0.08838834764831845f;
                lfv[e] = lng; lfv[8 + e] = lng;
            }
        }
        *(LAS u32x4*)(kraw + ti * 136 + cA) = pack8(kv); *(LAS u32x4*)(kraw + ti * 136 + cB) = pack8(kv + 8);
        *(LAS f32x4*)(bc + ti * 132 + cA) = (f32x4){lfv[0], lfv[1], lfv[2], lfv[3]}; *(LAS f32x4*)(bc + ti * 132 + cA + 4) = (f32x4){lfv[4], lfv[5], lfv[6], lfv[7]};
        *(LAS f32x4*)(bc + ti * 132 + cB) = (f32x4){lfv[8], lfv[9], lfv[10], lfv[11]}; *(LAS f32x4*)(bc + ti * 132 + cB + 4) = (f32x4){lfv[12], lfv[13], lfv[14], lfv[15]};
        const bf16_t* vp = pr + vcol + h * 128;
        const u32x4 v0 = *(const u32x4*)(vp + cA), v1 = *(const u32x4*)(vp + cB);
#pragma unroll
        for (int e = 0; e < 8; ++e) {
            vT[(cA + e) * 72 + ti] = (bf16_t)((e & 1) ? (v0[e >> 1] >> 16) : (v0[e >> 1] & 0xffffu));
            vT[(cB + e) * 72 + ti] = (bf16_t)((e & 1) ? (v1[e >> 1] >> 16) : (v1[e >> 1] & 0xffffu));
        }
    }
    __syncthreads();
    if (tid < 128) {
        float run = 0.f;
#pragma unroll 8
        for (int i = 0; i < 64; ++i) { run += bc[i * 132 + tid]; bc[i * 132 + tid] = run; }
    }
    __syncthreads();
    {
        const int I = ti >> 4;
        float qhat[16];
#pragma unroll
        for (int e = 0; e < 16; ++e) {
            const int ch = e < 8 ? cA + e : cB + e - 8;
            const float bi = bc[ti * 132 + ch], rI = I ? bc[(16 * I - 1) * 132 + ch] : 0.f, bl = bc[63 * 132 + ch];
            qhat[e] = qt[e] * __expf(bi - rI); qt[e] = qt[e] * __expf(bi);
            kT[ch * 72 + ti] = (bf16_t)f2bf(bf2f(kraw[ti * 136 + ch]) * __expf(bl - bi));
        }
        *(LAS u32x4*)(qh + ti * 136 + cA) = pack8(qhat); *(LAS u32x4*)(qh + ti * 136 + cB) = pack8(qhat + 8);
        bf16_t* lqp = p.lq + item * 8192 + ti * 128;
        *(u32x4*)(lqp + cA) = pack8(qt); *(u32x4*)(lqp + cB) = pack8(qt + 8);
    }
    if (tid < 128) p.ld[item * 128 + tid] = __expf(bc[63 * 132 + tid]);
    for (int I = 0; I < 4; ++I) {
        if (ti < 16 * (I + 1)) {
            float kk[16];
#pragma unroll
            for (int e = 0; e < 16; ++e) {
                const int ch = e < 8 ? cA + e : cB + e - 8;
                const float rI = I ? bc[(16 * I - 1) * 132 + ch] : 0.f, bj = bc[ti * 132 + ch];
                kk[e] = bf2f(kraw[ti * 136 + ch]) * __expf(fminf(rI - bj, 80.f));
            }
            *(LAS u32x4*)(kh + ti * 136 + cA) = pack8(kk); *(LAS u32x4*)(kh + ti * 136 + cB) = pack8(kk + 8);
        }
        __syncthreads();
        if (wid < 4) {
            const int J = wid;
            u32x2 outv; outv[0] = 0u; outv[1] = 0u;
            if (J <= I) {
                f32x4 acc = (f32x4){0.f, 0.f, 0.f, 0.f};
#pragma unroll
                for (int ks = 0; ks < 4; ++ks)
                    acc = mfma16(*(const LAS bf16x8*)(kh + (J * 16 + fr) * 136 + ks * 32 + fq * 8), *(const LAS bf16x8*)(qh + (I * 16 + fr) * 136 + ks * 32 + fq * 8), acc);
                const int i = 16 * I + fr, j0 = 16 * J + 4 * fq;
#pragma unroll
                for (int r = 0; r < 4; ++r) if (j0 + r > i) acc[r] = 0.f;
                outv = pack4(acc);
            }
            *(LAS u32x2*)(sc + (I * 16 + fr) * 72 + J * 16 + 4 * fq) = outv;
        }
        __syncthreads();
    }
    {
        bf16x8 xv[2], xk[2];
#pragma unroll
        for (int ks = 0; ks < 2; ++ks) { xv[ks] = *(const LAS bf16x8*)(vT + (wid * 16 + fr) * 72 + ks * 32 + fq * 8); xk[ks] = *(const LAS bf16x8*)(kT + (wid * 16 + fr) * 72 + ks * 32 + fq * 8); }
#pragma unroll
        for (int ib = 0; ib < 4; ++ib) {
            f32x4 acc = (f32x4){0.f, 0.f, 0.f, 0.f};
#pragma unroll
            for (int ks = 0; ks < 2; ++ks) acc = mfma16(xv[ks], *(const LAS bf16x8*)(sc + (ib * 16 + fr) * 72 + ks * 32 + fq * 8), acc);
            *(u32x2*)(p.lo + item * 8192 + (ib * 16 + fr) * 128 + wid * 16 + 4 * fq) = pack4(acc);
        }
#pragma unroll
        for (int dvb = 0; dvb < 8; ++dvb) {
            f32x4 acc = (f32x4){0.f, 0.f, 0.f, 0.f};
#pragma unroll
            for (int ks = 0; ks < 2; ++ks) acc = mfma16(xk[ks], *(const LAS bf16x8*)(vT + (dvb * 16 + fr) * 72 + ks * 32 + fq * 8), acc);
            *(u32x2*)(p.lb + item * 16384 + (dvb * 16 + fr) * 128 + wid * 16 + 4 * fq) = pack4(acc);
        }
    }
    __syncthreads();
}


template <int I> struct SolveRows {
    static __device__ __forceinline__ void run(float (&x)[64], const LAS float* Mf, const LAS float* rs) {
        SolveRows<I - 1>::run(x, Mf, rs);
        float r = x[I] * rs[I];
#pragma unroll
        for (int j4 = 0; j4 < (I + 3) / 4; ++j4) {
            const f32x4 m = *(const LAS f32x4*)(Mf + I * 68 + j4 * 4);
            r -= m[0] * x[j4 * 4] + m[1] * x[j4 * 4 + 1] + m[2] * x[j4 * 4 + 2] + m[3] * x[j4 * 4 + 3];
        }
        asm volatile("" : "+v"(r) :: "memory");
        x[I] = r;
    }
};
template <> struct SolveRows<-1> { static __device__ __forceinline__ void run(float (&)[64], const LAS float*, const LAS float*) {} };

__device__ __forceinline__ void local_gdn(const Params& p, int l, int chain, int n, LAS unsigned char* lds) {
    const int tid = opaque_tid(), wid = tid >> 6, lane = tid & 63, fr = lane & 15, fq = lane >> 4;
    const int b = chain >> 3, h = (chain >> 1) & 3, d = chain & 1;
    const int base = chunk_base(b, d, n);
    const size_t item = (size_t)chain * NCHUNK + n;
    LAS bf16_t* ks_ = (LAS bf16_t*)lds;
    LAS bf16_t* qs = ks_ + 64 * 136;
    LAS bf16_t* att = qs + 64 * 136;
    LAS bf16_t* wT = att + 64 * 72;
    LAS bf16_t* uT = wT + 128 * 72;
    LAS bf16_t* kT = uT + 128 * 72;
    LAS float* Mf = (LAS float*)(kT + 128 * 72);
    LAS float* bcs = Mf + 64 * 68;
    LAS float* bts = bcs + 64;
    LAS float* rse = bts + 64;
    LAS bf16_t* vs = (LAS bf16_t*)(rse + 64);
    const int ti = tid >> 3, d0 = (tid & 7) * 16;
    const int tokI = base + (d ? 63 - ti : ti);
    {
        int t, T, sbase; tok_info(tokI, t, T, sbase);
#pragma unroll
        for (int part = 0; part < 3; ++part) {
            float a[16];
#pragma unroll
            for (int e = 0; e < 16; ++e) a[e] = 0.f;
            const int ccol = part * 512 + h * 128 + d0;
#pragma unroll
            for (int j = 0; j < 4; ++j) {
                const int tt = t + j - 2;
                if (tt >= 0 && tt < T) {
                    const bf16_t* xp = p.P + (size_t)(sbase + tt) * NP + C_GQKV + ccol;
                    const u32x4 x0 = *(const u32x4*)xp, x1 = *(const u32x4*)(xp + 8);
                    const float* wp = p.gdn_conv_w + (size_t)(l * 4 + j) * 1536 + ccol;
#pragma unroll
                    for (int q = 0; q < 4; ++q) {
                        const float4 w0 = *(const float4*)(wp + q * 4);
                        const unsigned ua = q < 2 ? x0[2 * q] : x1[2 * q - 4], ub = q < 2 ? x0[2 * q + 1] : x1[2 * q - 3];
                        a[q * 4] += w0.x * bflo(ua); a[q * 4 + 1] += w0.y * bfhi(ua); a[q * 4 + 2] += w0.z * bflo(ub); a[q * 4 + 3] += w0.w * bfhi(ub);
                    }
                }
            }
            float ss = 0.f;
#pragma unroll
            for (int e = 0; e < 16; ++e) { a[e] = siluf_(a[e]); ss += a[e] * a[e]; }
            if (part < 2) {
                ss += __shfl_xor(ss, 1); ss += __shfl_xor(ss, 2); ss += __shfl_xor(ss, 4);
                const float scl = rsqrtf(ss + 1e-6f) * (part == 0 ? 0.08838834764831845f : 1.0f);
#pragma unroll
                for (int e = 0; e < 16; ++e) a[e] *= scl;
            }
            LAS bf16_t* dstt = (part == 0 ? qs : part == 1 ? ks_ : vs) + ti * 136 + d0;
            *(LAS u32x4*)dstt = pack8(a); *(LAS u32x4*)(dstt + 8) = pack8(a + 8);
        }
    }
    if (wid == 0) {
        const int tok = base + (d ? 63 - lane : lane);
        const float av = bf2f(p.P[(size_t)tok * NP + C_GA + d * 4 + h]);
        float v = -__expf(p.gdn_a_log[l * 8 + d * 4 + h]) * softplusf_(av + p.gdn_dt_bias[l * 8 + d * 4 + h]);
#pragma unroll
        for (int off = 1; off < 64; off <<= 1) { const float t = __shfl_up(v, off); if (lane >= off) v += t; }
        const float btv = sigmoidf_(bf2f(p.P[(size_t)tok * NP + C_GB + d * 4 + h]));
        bcs[lane] = v; bts[lane] = btv; rse[lane] = btv * __expf(v);
    }
    __syncthreads();
#pragma unroll
    for (int e = 0; e < 2; ++e) {
        const int f = wid * 2 + e, ib = f >> 2, jb = f & 3;
        const int i = 16 * ib + fr, j0 = 16 * jb + 4 * fq;
        f32x4 mk = (f32x4){0.f, 0.f, 0.f, 0.f}, mq = (f32x4){0.f, 0.f, 0.f, 0.f};
        if (jb <= ib) {
#pragma unroll
            for (int ks = 0; ks < 4; ++ks) {
                const bf16x8 xk = *(const LAS bf16x8*)(ks_ + (jb * 16 + fr) * 136 + ks * 32 + fq * 8);
                mk = mfma16(xk, *(const LAS bf16x8*)(ks_ + (ib * 16 + fr) * 136 + ks * 32 + fq * 8), mk);
                mq = mfma16(xk, *(const LAS bf16x8*)(qs + (ib * 16 + fr) * 136 + ks * 32 + fq * 8), mq);
            }
            const float bi = bcs[i], bti = bts[i];
#pragma unroll
            for (int r = 0; r < 4; ++r) {
                const int j = j0 + r;
                const float dec = __expf(j <= i ? bi - bcs[j] : 0.f);
                mk[r] = (j < i) ? bti * mk[r] * dec : 0.f;
                mq[r] = (j <= i) ? mq[r] * dec : 0.f;
            }
        }
        *(LAS f32x4*)(Mf + i * 68 + j0) = mk;
        *(LAS u32x2*)(att + i * 72 + j0) = pack4(mq);
    }
    __syncthreads();
    {
        const float sc_ = __expf(bcs[63] - bcs[ti]);
#pragma unroll
        for (int e = 0; e < 16; ++e) kT[(d0 + e) * 72 + ti] = (bf16_t)f2bf(bf2f(ks_[ti * 136 + d0 + e]) * sc_);
    }
    if (tid < 256) {
        const int cidx = tid & 127;
        const bool isw = tid >= 128;
        const LAS bf16_t* srcp = (isw ? ks_ : vs) + cidx;
        float x[64];
#pragma unroll
        for (int i = 0; i < 64; ++i) x[i] = bf2f(srcp[i * 136]);
        {
            unsigned mb = (unsigned)(size_t)Mf, rb = (unsigned)(size_t)(isw ? rse : bts);
            asm volatile("" : "+v"(mb), "+v"(rb));
            SolveRows<63>::run(x, (const LAS float*)(size_t)mb, (const LAS float*)(size_t)rb);
        }
        if (isw) {
#pragma unroll
            for (int i = 0; i < 64; ++i) x[i] = -x[i];
        }
        LAS bf16_t* dst = (isw ? wT : uT) + cidx * 72;
#pragma unroll
        for (int q = 0; q < 8; ++q) *(LAS u32x4*)(dst + q * 8) = pack8(x + q * 8);
    }
    if (tid < 128) p.ld[item * 128 + tid] = __expf(bcs[63]);
    __syncthreads();
    {
        const int tid = opaque_tid(), wid = tid >> 6, lane = tid & 63, fr = lane & 15, fq = lane >> 4;
        bf16x8 xw[2], xu[2], xk[2];
#pragma unroll
        for (int ks = 0; ks < 2; ++ks) {
            xw[ks] = *(const LAS bf16x8*)(wT + (wid * 16 + fr) * 72 + ks * 32 + fq * 8);
            xu[ks] = *(const LAS bf16x8*)(uT + (wid * 16 + fr) * 72 + ks * 32 + fq * 8);
            xk[ks] = *(const LAS bf16x8*)(kT + (wid * 16 + fr) * 72 + ks * 32 + fq * 8);
        }
#pragma unroll
        for (int ib = 0; ib < 4; ++ib) {
            const int i = ib * 16 + fr;
            const u32x2 qr = *(const LAS u32x2*)(qs + i * 136 + wid * 16 + 4 * fq);
            const float eb = __expf(bcs[i]);
            f32x4 aq = (f32x4){bflo(qr[0]) * eb, bfhi(qr[0]) * eb, bflo(qr[1]) * eb, bfhi(qr[1]) * eb};
            f32x4 ao = (f32x4){0.f, 0.f, 0.f, 0.f};
#pragma unroll
            for (int ks = 0; ks < 2; ++ks) {
                const bf16x8 ya = *(const LAS bf16x8*)(att + i * 72 + ks * 32 + fq * 8);
                aq = mfma16(xw[ks], ya, aq); ao = mfma16(xu[ks], ya, ao);
            }
            *(u32x2*)(p.lq + item * 8192 + i * 128 + wid * 16 + 4 * fq) = pack4(aq);
            *(u32x2*)(p.lo + item * 8192 + i * 128 + wid * 16 + 4 * fq) = pack4(ao);
        }
#pragma unroll
        for (int db = 0; db < 8; ++db) {
            f32x4 aa = (f32x4){0.f, 0.f, 0.f, 0.f}, ab = (f32x4){0.f, 0.f, 0.f, 0.f};
#pragma unroll
            for (int ks = 0; ks < 2; ++ks) {
                aa = mfma16(xw[ks], *(const LAS bf16x8*)(kT + (db * 16 + fr) * 72 + ks * 32 + fq * 8), aa);
                ab = mfma16(xk[ks], *(const LAS bf16x8*)(uT + (db * 16 + fr) * 72 + ks * 32 + fq * 8), ab);
            }
            *(u32x2*)(p.la + item * 16384 + (db * 16 + fr) * 128 + wid * 16 + 4 * fq) = pack4(aa);
            *(u32x2*)(p.lb + item * 16384 + (db * 16 + fr) * 128 + wid * 16 + 4 * fq) = pack4(ab);
        }
    }
    __syncthreads();
}

__device__ __forceinline__ void ph_local(const Params& p, int l, LAS unsigned char* lds) {
    for (int it = blockIdx.x; it < 3 * NITEM; it += gridDim.x) {
        const int tz = it % 3, ci = it / 3, chain = ci / NCHUNK, n = ci % NCHUNK;
        if (tz == 0) local_gdn(p, l, chain, n, lds); else local_gla(p, l, tz, chain, n, lds);
    }
}

__device__ __forceinline__ void seq_matrix(const Params& p, int tz, int chain, int half, LAS unsigned char* lds) {
    const int tid = opaque_tid(), wid = tid >> 6, lane = tid & 63, fr = lane & 15, fq = lane >> 4;
    const int b = chain >> 3, h = (chain >> 1) & 3, d = chain & 1;
    LAS bf16_t* ST = (LAS bf16_t*)lds;
    float* Op = p.O + (size_t)((tz == 0 ? 0 : tz == 1 ? 1 : 3) * 2 + d) * TOKW;
    f32x4 S[4];
#pragma unroll
    for (int q = 0; q < 4; ++q) S[q] = (f32x4){0.f, 0.f, 0.f, 0.f};
    const int ib = wid >> 1, dv2 = (wid & 1) * 2;
    for (int n = 0; n < NCHUNK; ++n) {
        const size_t item = (size_t)tz * NITEM + (size_t)chain * NCHUNK + n;
        bf16x8 yq[4], xa[4];
#pragma unroll
        for (int ks = 0; ks < 4; ++ks) yq[ks] = *(const bf16x8*)(p.lq + item * 8192 + (ib * 16 + fr) * 128 + ks * 32 + fq * 8);
        if (tz == 0) {
#pragma unroll
            for (int ks = 0; ks < 4; ++ks) xa[ks] = *(const bf16x8*)(p.la + ((size_t)chain * NCHUNK + n) * 16384 + (wid * 16 + fr) * 128 + ks * 32 + fq * 8);
        }
        u32x2 oin[2], bin[4];
#pragma unroll
        for (int e = 0; e < 2; ++e) oin[e] = *(const u32x2*)(p.lo + item * 8192 + (ib * 16 + fr) * 128 + half * 64 + (dv2 + e) * 16 + 4 * fq);
#pragma unroll
        for (int q = 0; q < 4; ++q) bin[q] = *(const u32x2*)(p.lb + item * 16384 + (half * 64 + q * 16 + fr) * 128 + wid * 16 + 4 * fq);
        const f32x4 dec = *(const f32x4*)(p.ld + item * 128 + wid * 16 + 4 * fq);
        LAS bf16_t* st = ST + (n & 1) * 64 * 136;
#pragma unroll
        for (int q = 0; q < 4; ++q) *(LAS u32x2*)(st + (q * 16 + fr) * 136 + wid * 16 + 4 * fq) = pack4(S[q]);
        __syncthreads();
        const int base = chunk_base(b, d, n);
        const int tok = base + (d ? 63 - (ib * 16 + fr) : ib * 16 + fr);
#pragma unroll
        for (int e = 0; e < 2; ++e) {
            f32x4 acc = (f32x4){bflo(oin[e][0]), bfhi(oin[e][0]), bflo(oin[e][1]), bfhi(oin[e][1])};
#pragma unroll
            for (int ks = 0; ks < 4; ++ks) acc = mfma16(*(const LAS bf16x8*)(st + ((dv2 + e) * 16 + fr) * 136 + ks * 32 + fq * 8), yq[ks], acc);
            *(f32x4*)(Op + (size_t)tok * MW + h * 128 + half * 64 + (dv2 + e) * 16 + 4 * fq) = acc;
        }
#pragma unroll
        for (int q = 0; q < 4; ++q) {
            f32x4 acc = (f32x4){dec[0] * S[q][0] + bflo(bin[q][0]), dec[1] * S[q][1] + bfhi(bin[q][0]), dec[2] * S[q][2] + bflo(bin[q][1]), dec[3] * S[q][3] + bfhi(bin[q][1])};
            if (tz == 0) {
#pragma unroll
                for (int ks = 0; ks < 4; ++ks) acc = mfma16(xa[ks], *(const LAS bf16x8*)(st + (q * 16 + fr) * 136 + ks * 32 + fq * 8), acc);
            }
            S[q] = acc;
        }
    }
    __syncthreads();
}

__device__ __forceinline__ void seq_lru(const Params& p, int b, int d, int cg, LAS unsigned char* lds) {
    const int tid = opaque_tid(), seg = tid >> 6, ch = cg * 64 + (tid & 63);
    LAS float* sP = (LAS float*)lds;
    LAS float* sL = sP + 512;
    const float* A = p.prep + (size_t)(PR_LA + d) * TOKW + ch; const float* U = p.prep + (size_t)(PR_LU + d) * TOKW + ch;
    float* Op = p.O + (size_t)(2 * 2 + d) * TOKW + ch;
    constexpr int SEG = (TC + TL) / 8;
    auto tok_of = [&](int pos) { return pos < TC ? NLAT + b * TC + (d ? TC - 1 - pos : pos) : b * TL + (d ? TL - 1 - (pos - TC) : pos - TC); };
    float P = 1.f, L = 0.f;
    for (int i0 = 0; i0 < SEG; i0 += 8) {
        float av[8], uv[8];
#pragma unroll
        for (int q = 0; q < 8; ++q) { const size_t o = (size_t)tok_of(seg * SEG + i0 + q) * MW; av[q] = A[o]; uv[q] = U[o]; }
#pragma unroll
        for (int q = 0; q < 8; ++q) { L = av[q] * L + uv[q]; P *= av[q]; }
    }
    sP[tid] = P; sL[tid] = L;
    __syncthreads();
    float hst = 0.f;
    for (int s = 0; s < seg; ++s) hst = sP[s * 64 + (tid & 63)] * hst + sL[s * 64 + (tid & 63)];
    for (int i0 = 0; i0 < SEG; i0 += 8) {
        float av[8], uv[8]; size_t oo[8];
#pragma unroll
        for (int q = 0; q < 8; ++q) { oo[q] = (size_t)tok_of(seg * SEG + i0 + q) * MW; av[q] = A[oo[q]]; uv[q] = U[oo[q]]; }
#pragma unroll
        for (int q = 0; q < 8; ++q) { hst = av[q] * hst + uv[q]; Op[oo[q]] = hst; }
    }
    __syncthreads();
}

__device__ __forceinline__ void ph_seq(const Params& p, LAS unsigned char* lds) {
    for (int it = blockIdx.x; it < 256; it += gridDim.x) {
        if (it < 192) { const int tz = it >> 6, r = it & 63; seq_matrix(p, tz, r >> 1, r & 1, lds); }
        else { const int r = it - 192; seq_lru(p, r >> 4, (r >> 3) & 1, r & 7, lds); }
    }
}

__device__ __forceinline__ void ph_merge(const Params& p, int l, int M) {
    const int tid = opaque_tid(), wid = tid >> 6, lane = tid & 63;
    for (int id = blockIdx.x * NWAVES + wid; id < M * 16; id += gridDim.x * NWAVES) {
        const int tok = id >> 4, r = id & 15, m = r >> 2, head = r & 3;
        const int cidx = head * 128 + lane * 2;
        const size_t o = (size_t)tok * MW + cidx;
        const f32x2 o0 = *(const f32x2*)(p.O + (size_t)(m * 2) * TOKW + o), o1 = *(const f32x2*)(p.O + (size_t)(m * 2 + 1) * TOKW + o);
        const float a0 = o0[0] + o1[0], a1 = o0[1] + o1[1];
        float y0, y1; int nbr;
        if (m == 2) {
            const unsigned u = *(const unsigned*)(p.P + (size_t)tok * NP + C_LY + cidx);
            y0 = a0 * gelu_tanhf_(bflo(u)); y1 = a1 * gelu_tanhf_(bfhi(u)); nbr = 2;
        } else {
            const float ss = wave_sum(a0 * a0 + a1 * a1);
            const float rinv = rsqrtf(ss * (1.0f / 128.0f) + 1e-6f);
            const float* gp = (m == 0 ? p.gdn_norm_g : m == 1 ? p.hgrn_norm_g : p.ret_norm_g) + l * 128 + lane * 2;
            const int zc = m == 0 ? C_GZ : m == 1 ? C_HG : C_RG;
            const unsigned u = *(const unsigned*)(p.P + (size_t)tok * NP + zc + cidx);
            y0 = a0 * rinv * gp[0] * siluf_(bflo(u)); y1 = a1 * rinv * gp[1] * siluf_(bfhi(u)); nbr = m == 3 ? 3 : m;
        }
        *(unsigned*)(p.Y + (size_t)nbr * TOKW + o) = pack2(y0, y1);
    }
}

__device__ __forceinline__ void ph_g2(const Params& p, int l, int M, LAS unsigned char* lds) {
    const StageRC s = my_stage_rc();
    const int tid = opaque_tid(), wid = tid >> 6, lane = tid & 63, wr = wid >> 1, wc = wid & 1, fr = lane & 15, fq = lane >> 4;
    const int ntm = M / 256;
    for (int u = blockIdx.x; u < ntm * 8; u += gridDim.x) {
        const int pm = u >> 3, pn = u & 7;
        f32x4 acc[4][4]; gm::zero_acc(acc);
        for (int nb = 0; nb < 4; ++nb) {
            const bf16_t* a0 = p.Y + (size_t)nb * TOKW + (size_t)(pm * 256) * MW;
            const bf16_t* Bt = p.wbT + (size_t)(l * 4 + nb) * D * MW + (size_t)(pn * 128) * MW;
            gm::kloop(lds, a0 + (size_t)s.R0 * MW + s.C0, a0 + (size_t)s.R1 * MW + s.C1, a0 + (size_t)(128 + s.R0) * MW + s.C0, a0 + (size_t)(128 + s.R1) * MW + s.C1,
                      Bt + (size_t)s.R0 * MW + s.C0, Bt + (size_t)s.R1 * MW + s.C1, MW, acc);
#pragma unroll
            for (int m = 0; m < 4; ++m)
#pragma unroll
                for (int n = 0; n < 4; ++n) {
                    const int row = pm * 256 + wr * 64 + m * 16 + fr, col = pn * 128 + wc * 64 + n * 16 + fq * 4;
                    const bf16_t* gp = p.P + (size_t)row * NP + C_MG + nb * D + col;
                    const u32x2 gu = *(const u32x2*)gp;
                    const float e0 = __expf(-bflo(gu[0])), e1 = __expf(-bfhi(gu[0])), e2 = __expf(-bflo(gu[1])), e3 = __expf(-bfhi(gu[1]));
                    float n0 = 1.f, n1 = 1.f, n2 = 1.f, n3 = 1.f;
                    if (nb < 3) { const u32x2 gn = *(const u32x2*)(gp + D);
                        n0 = 1.f + __expf(-bflo(gn[0])); n1 = 1.f + __expf(-bfhi(gn[0])); n2 = 1.f + __expf(-bflo(gn[1])); n3 = 1.f + __expf(-bfhi(gn[1])); }
                    acc[m][n][0] *= n0 / (1.f + e0); acc[m][n][1] *= n1 / (1.f + e1); acc[m][n][2] *= n2 / (1.f + e2); acc[m][n][3] *= n3 / (1.f + e3);
                }
        }
#pragma unroll
        for (int m = 0; m < 4; ++m)
#pragma unroll
            for (int n = 0; n < 4; ++n) {
                const int row = pm * 256 + wr * 64 + m * 16 + fr, col = pn * 128 + wc * 64 + n * 16 + fq * 4;
                u32x2 o; o[0] = pack2(acc[m][n][0], acc[m][n][1]); o[1] = pack2(acc[m][n][2], acc[m][n][3]);
                *(u32x2*)(p.mix + (size_t)row * D + col) = o;
            }
    }
}

template <bool DRY = false> __device__ __forceinline__ void ph_g3(const Params& p, int l, int M, LAS unsigned char* lds) {
    const StageRC s = my_stage_rc();
    const int tid = opaque_tid(), wid = tid >> 6, lane = tid & 63, wr = wid >> 1, wc = wid & 1, fr = lane & 15, fq = lane >> 4;
    const int ntm = M / 256;
    for (int u = blockIdx.x; u < ntm * 8; u += gridDim.x) {
        const int pm = u >> 3, pn = u & 7;
        const bf16_t* a0 = p.mix + (size_t)(pm * 256) * D;
        const bf16_t* Bt = p.woutT + (size_t)l * D * D + (size_t)(pn * 128) * D;
        f32x4 acc[4][4]; gm::zero_acc(acc);
        gm::kloop(lds, a0 + (size_t)s.R0 * D + s.C0, a0 + (size_t)s.R1 * D + s.C1, a0 + (size_t)(128 + s.R0) * D + s.C0, a0 + (size_t)(128 + s.R1) * D + s.C1,
                  Bt + (size_t)s.R0 * D + s.C0, Bt + (size_t)s.R1 * D + s.C1, D, acc);
#pragma unroll
        for (int m = 0; m < 4; ++m)
#pragma unroll
            for (int n = 0; n < 4; ++n) {
                const int row = pm * 256 + wr * 64 + m * 16 + fr, col = pn * 128 + wc * 64 + n * 16 + fq * 4;
                const float4 gt = *(const float4*)(p.mod + (size_t)(l * 5 + tok_modrow(row)) * (NMOD * D) + 2 * D + col);
                float4* xp = (float4*)(p.xl + (size_t)row * D + col);
                float4 xv = *xp;
                if (DRY) xp = (float4*)(p.prep + (size_t)row * D + col);
                xv.x += gt.x * acc[m][n][0]; xv.y += gt.y * acc[m][n][1]; xv.z += gt.z * acc[m][n][2]; xv.w += gt.w * acc[m][n][3];
                *xp = xv;
            }
    }
}

template <bool DRY = false> __device__ __forceinline__ void ph_route(const Params& p, int l, int M, LAS unsigned char* lds) {
    int* const r_cnt = DRY ? p.cnt + 64 : p.cnt; int* const r_list = DRY ? (int*)p.act : p.list; int* const r_ts = DRY ? (int*)p.yp : p.tokslot; float* const r_tw = DRY ? (float*)p.yp + (size_t)NTOK * 4 : p.topw;
    LAS float* fs = (LAS float*)lds;
    LAS float* lg = fs + 32 * 1028;
    const int tid = opaque_tid(), wid = tid >> 6, lane = tid & 63;
    const float* rw = p.router_w + (size_t)l * D * NE;
    for (int it = blockIdx.x; it < M / 32; it += gridDim.x) {
        const int tok0 = it * 32;
        for (int q = 0; q < 4; ++q) {
            const int tl = wid * 4 + q, tok = tok0 + tl;
            const float* src = p.xl + (size_t)tok * D;
            float4 v[4]; float ss = 0.f;
#pragma unroll
            for (int i = 0; i < 4; ++i) { v[i] = *(const float4*)(src + i * 256 + lane * 4); ss += v[i].x * v[i].x + v[i].y * v[i].y + v[i].z * v[i].z + v[i].w * v[i].w; }
            ss = wave_sum(ss);
            const float rinv = rsqrtf(ss * (1.0f / D) + 1e-6f);
            const float* mb = p.mod + (size_t)(l * 5 + tok_modrow(tok)) * (NMOD * D);
#pragma unroll
            for (int i = 0; i < 4; ++i) {
                const int cidx = i * 256 + lane * 4;
                const float4 gv = *(const float4*)(p.norm2_g + l * D + cidx), sv = *(const float4*)(mb + 4 * D + cidx), hv = *(const float4*)(mb + 3 * D + cidx);
                const float h0 = v[i].x * rinv * gv.x * (1.f + sv.x) + hv.x, h1 = v[i].y * rinv * gv.y * (1.f + sv.y) + hv.y;
                const float h2 = v[i].z * rinv * gv.z * (1.f + sv.z) + hv.z, h3 = v[i].w * rinv * gv.w * (1.f + sv.w) + hv.w;
                u32x2 o; o[0] = pack2(h0, h1); o[1] = pack2(h2, h3);
                *(u32x2*)(p.F + (size_t)tok * D + cidx) = o;
                *(LAS f32x4*)(fs + tl * 1028 + cidx) = (f32x4){h0, h1, h2, h3};
            }
        }
        __syncthreads();
        {
            typedef float f32x16 __attribute__((ext_vector_type(16)));
            f32x16 acc;
#pragma unroll
            for (int r = 0; r < 16; ++r) acc[r] = 0.f;
            const int tk = lane & 31, hh = lane >> 5;
            const LAS float* ap = fs + tk * 1028 + wid * 128 + 4 * hh;
            const float* bp = rw + (size_t)(wid * 128 + 4 * hh) * NE + tk;
#pragma unroll 4
            for (int kk = 0; kk < 16; ++kk) {
                const f32x4 a4 = *(const LAS f32x4*)(ap + kk * 8);
                const float b0 = bp[(kk * 8 + 0) * NE], b1 = bp[(kk * 8 + 1) * NE], b2 = bp[(kk * 8 + 2) * NE], b3 = bp[(kk * 8 + 3) * NE];
                acc = __builtin_amdgcn_mfma_f32_32x32x2f32(a4[0], b0, acc, 0, 0, 0);
                acc = __builtin_amdgcn_mfma_f32_32x32x2f32(a4[1], b1, acc, 0, 0, 0);
                acc = __builtin_amdgcn_mfma_f32_32x32x2f32(a4[2], b2, acc, 0, 0, 0);
                acc = __builtin_amdgcn_mfma_f32_32x32x2f32(a4[3], b3, acc, 0, 0, 0);
            }
            __syncthreads();
            LAS float* red = fs;
#pragma unroll
            for (int r = 0; r < 16; ++r) red[(wid * 32 + (r & 3) + 8 * (r >> 2) + 4 * hh) * 33 + tk] = acc[r];
            __syncthreads();
            const int t2 = tid >> 4, e0 = (tid & 15) * 2;
            float s0 = p.router_b[l * NE + e0], s1 = p.router_b[l * NE + e0 + 1];
#pragma unroll
            for (int w = 0; w < 8; ++w) { s0 += red[(w * 32 + t2) * 33 + e0]; s1 += red[(w * 32 + t2) * 33 + e0 + 1]; }
            lg[t2 * 33 + e0] = s0; lg[t2 * 33 + e0 + 1] = s1;
        }
        __syncthreads();
        if (tid < 32) {
            const int tok = tok0 + tid;
            float vals[4]; int idxs[4]; unsigned used = 0u;
#pragma unroll
            for (int k = 0; k < 4; ++k) {
                float best = -3.0e38f; int bi = 0;
                for (int e = 0; e < NE; ++e) { const float v = lg[tid * 33 + e]; if (!((used >> e) & 1u) && v > best) { best = v; bi = e; } }
                used |= 1u << bi; vals[k] = best; idxs[k] = bi;
            }
            const float mx = vals[0];
            float ex[4], sum = 0.f;
#pragma unroll
            for (int k = 0; k < 4; ++k) { ex[k] = __expf(vals[k] - mx); sum += ex[k]; }
            const float inv = 1.0f / sum;
#pragma unroll
            for (int k = 0; k < 4; ++k) {
                const int e = idxs[k];
                const int slot = atomicAdd(r_cnt + l * NE + e, 1);
                r_list[(size_t)e * NTOK + slot] = tok;
                r_ts[(size_t)tok * 4 + k] = (e << 16) | slot;
                r_tw[(size_t)tok * 4 + k] = ex[k] * inv;
            }
        }
        __syncthreads();
    }
}

__device__ __forceinline__ void build_expert_tables(const Params& p, int l, LAS int* ts, LAS int* cn) {
    if (opaque_tid() == 0) {
        int acc = 0;
        for (int e = 0; e < NE; ++e) { const int c = __hip_atomic_load(p.cnt + l * NE + e, __ATOMIC_RELAXED, __HIP_MEMORY_SCOPE_AGENT); cn[e] = c; ts[e] = acc; acc += (c + 255) >> 8; }
        ts[NE] = acc;
    }
    __syncthreads();
}

struct MoeSched {
    const LAS int* ts; const LAS int* cn; const int* list; const bf16_t* A; const bf16_t* Bt; int K, npn, nunits, G, c, nrowsB; bool gather;
    __device__ __forceinline__ bool next(int i, g8::Unit& u) const {
        const long L = (long)i * G + c; if (L >= nunits) return false;
        u.pm = (int)(L / npn); u.pn = (int)(L % npn);
        int e = 0; while (e < NE - 1 && ts[e + 1] <= u.pm) ++e;
        u.e = e; return true;
    }
    __device__ __forceinline__ const char* a_base(const g8::Unit& u) const { return (const char*)(gather ? A : A + (size_t)u.pm * 256 * K); }
    __device__ __forceinline__ const char* b_base(const g8::Unit& u) const { return (const char*)(Bt + ((size_t)u.e * nrowsB + (size_t)u.pn * 256) * K); }
    __device__ __forceinline__ void a_rows(const g8::Unit& u, int R0, int R1, unsigned (&rows)[4]) const {
        if (!gather) { rows[0] = R0; rows[1] = R1; rows[2] = 128 + R0; rows[3] = 128 + R1; return; }
        const int cnt = cn[u.e], slot0 = (u.pm - ts[u.e]) * 256;
        const int* le = list + (size_t)u.e * NTOK;
        int sl;
        sl = slot0 + R0; rows[0] = (unsigned)le[sl < cnt ? sl : 0];
        sl = slot0 + R1; rows[1] = (unsigned)le[sl < cnt ? sl : 0];
        sl = slot0 + 128 + R0; rows[2] = (unsigned)le[sl < cnt ? sl : 0];
        sl = slot0 + 128 + R1; rows[3] = (unsigned)le[sl < cnt ? sl : 0];
    }
};
struct EpiAct {
    bf16_t* O; const float* b1;
    __device__ __forceinline__ void operator()(const f32x4 (&acc)[2][2][4][2], const g8::Unit& u, int wr, int wc, int fr, int fq) const {
        const int row0 = u.pm * 256 + wr * 64 + fr, col0 = u.pn * 128 + wc * 32 + 8 * fq;
        const float* bb = b1 + (size_t)u.e * 2 * D + col0;
        const float4 g0 = *(const float4*)bb, g1 = *(const float4*)(bb + 4), l0 = *(const float4*)(bb + D), l1 = *(const float4*)(bb + D + 4);
        const float bg[8] = {g0.x, g0.y, g0.z, g0.w, g1.x, g1.y, g1.z, g1.w}, bl[8] = {l0.x, l0.y, l0.z, l0.w, l1.x, l1.y, l1.z, l1.w};
#pragma unroll
        for (int ai = 0; ai < 2; ++ai)
#pragma unroll
            for (int m = 0; m < 4; ++m) {
                float o[8];
#pragma unroll
                for (int n = 0; n < 2; ++n)
#pragma unroll
                    for (int j = 0; j < 4; ++j) {
                        const float glu = fminf(acc[ai][0][m][n][j] + bg[n * 4 + j], 7.0f);
                        const float lin = fminf(fmaxf(acc[ai][1][m][n][j] + bl[n * 4 + j], -7.0f), 7.0f);
                        o[n * 4 + j] = glu * sigmoidf_(1.702f * glu) * (lin + 1.0f);
                    }
                *(u32x4*)(O + (size_t)(row0 + ai * 128 + m * 16) * D + col0) = pack8(o);
            }
    }
};
__device__ __forceinline__ void ph_g4(const Params& p, int l, LAS unsigned char* lds) {
    LAS int* ts = (LAS int*)(lds + g8::STAGE_BYTES); LAS int* cn = ts + 40;
    build_expert_tables(p, l, ts, cn);
    MoeSched S; S.ts = ts; S.cn = cn; S.list = p.list; S.A = p.F; S.Bt = p.w1T + (size_t)l * NE * 2 * D * D; S.K = D; S.npn = 8; S.nunits = ts[NE] * 8; S.G = gridDim.x; S.c = blockIdx.x; S.nrowsB = 2 * D; S.gather = true;
    EpiAct E; E.O = p.act; E.b1 = p.moe_b1 + (size_t)l * NE * 2 * D;
    g8::gemm_phase(lds, D, S, E);
}

struct EpiYp {
    bf16_t* O; const float* b2;
    __device__ __forceinline__ void operator()(const f32x4 (&acc)[2][2][4][2], const g8::Unit& u, int wr, int wc, int fr, int fq) const {
        const int row0 = u.pm * 256 + wr * 64 + fr, col0 = u.pn * 256 + wc * 32 + 8 * fq;
#pragma unroll
        for (int bj = 0; bj < 2; ++bj) {
            const float* bb = b2 + (size_t)u.e * D + col0 + bj * 128;
            const float4 c0 = *(const float4*)bb, c1 = *(const float4*)(bb + 4);
#pragma unroll
            for (int ai = 0; ai < 2; ++ai)
#pragma unroll
                for (int m = 0; m < 4; ++m) {
                    u32x4 w; w[0] = pack2(acc[ai][bj][m][0][0] + c0.x, acc[ai][bj][m][0][1] + c0.y); w[1] = pack2(acc[ai][bj][m][0][2] + c0.z, acc[ai][bj][m][0][3] + c0.w);
                    w[2] = pack2(acc[ai][bj][m][1][0] + c1.x, acc[ai][bj][m][1][1] + c1.y); w[3] = pack2(acc[ai][bj][m][1][2] + c1.z, acc[ai][bj][m][1][3] + c1.w);
                    *(u32x4*)(O + (size_t)(row0 + ai * 128 + m * 16) * D + col0 + bj * 128) = w;
                }
        }
    }
};
__device__ __forceinline__ void ph_g5(const Params& p, int l, LAS unsigned char* lds) {
    LAS int* ts = (LAS int*)(lds + g8::STAGE_BYTES); LAS int* cn = ts + 40;
    build_expert_tables(p, l, ts, cn);
    MoeSched S; S.ts = ts; S.cn = cn; S.list = p.list; S.A = p.act; S.Bt = p.w2T + (size_t)l * NE * D * D; S.K = D; S.npn = 4; S.nunits = ts[NE] * 4; S.G = gridDim.x; S.c = blockIdx.x; S.nrowsB = D; S.gather = false;
    EpiYp E; E.O = p.yp; E.b2 = p.moe_b2 + (size_t)l * NE * D;
    g8::gemm_phase(lds, D, S, E);
}

template <bool DRY = false> __device__ __forceinline__ void ph_combine(const Params& p, int l, int M, LAS unsigned char* lds) {
    float* const c_xl = DRY ? p.prep : p.xl; bf16_t* const c_H = DRY ? (bf16_t*)(p.prep + (size_t)NTOK * D) : p.H; float* const c_out = DRY ? p.prep : p.out;
    LAS int* ts = (LAS int*)lds; LAS int* cn = ts + 40;
    build_expert_tables(p, l, ts, cn);
    const int tid = opaque_tid(), wid = tid >> 6, lane = tid & 63;
    const bool last = (l == 1);
    for (int tok = blockIdx.x * NWAVES + wid; tok < M; tok += gridDim.x * NWAVES) {
        float4 v[4];
        const float* mb = p.mod + (size_t)(l * 5 + tok_modrow(tok)) * (NMOD * D);
        int rows[4]; float wts[4];
#pragma unroll
        for (int k = 0; k < 4; ++k) { const int tsl = p.tokslot[(size_t)tok * 4 + k]; rows[k] = ts[tsl >> 16] * 256 + (tsl & 0xffff); wts[k] = p.topw[(size_t)tok * 4 + k]; }
        float ss = 0.f;
#pragma unroll
        for (int i = 0; i < 4; ++i) {
            const int cidx = i * 256 + lane * 4;
            float m0 = 0.f, m1 = 0.f, m2 = 0.f, m3 = 0.f;
#pragma unroll
            for (int k = 0; k < 4; ++k) {
                const u32x2 u = *(const u32x2*)(p.yp + (size_t)rows[k] * D + cidx);
                m0 += wts[k] * bflo(u[0]); m1 += wts[k] * bfhi(u[0]); m2 += wts[k] * bflo(u[1]); m3 += wts[k] * bfhi(u[1]);
            }
            const float4 gt = *(const float4*)(mb + 5 * D + cidx);
            float4 xv = *(const float4*)(p.xl + (size_t)tok * D + cidx);
            xv.x += gt.x * m0; xv.y += gt.y * m1; xv.z += gt.z * m2; xv.w += gt.w * m3;
            v[i] = xv; ss += xv.x * xv.x + xv.y * xv.y + xv.z * xv.z + xv.w * xv.w;
        }
        ss = wave_sum(ss);
        const float rinv = rsqrtf(ss * (1.0f / D) + 1e-6f);
        if (!last) {
#pragma unroll
            for (int i = 0; i < 4; ++i) *(float4*)(c_xl + (size_t)tok * D + i * 256 + lane * 4) = v[i];
            const float* mb1 = p.mod + (size_t)((l + 1) * 5 + tok_modrow(tok)) * (NMOD * D);
            norm_mod_store(v, rinv, p.norm1_g + (l + 1) * D, mb1 + 1 * D, mb1 + 0 * D, c_H + (size_t)tok * D, lane);
        } else {
#pragma unroll
            for (int i = 0; i < 4; ++i) {
                const int cidx = i * 256 + lane * 4;
                const float4 gv = *(const float4*)(p.final_norm_g + cidx);
                *(float4*)(c_out + (size_t)tok * D + cidx) = make_float4(v[i].x * rinv * gv.x, v[i].y * rinv * gv.y, v[i].z * rinv * gv.z, v[i].w * rinv * gv.w);
            }
        }
    }
}

#define XB_TMO      128
#define XB_XCNT(j)  (256  + 64 * (j))
#define XB_XSUB(j)  (1280 + 64 * (j))
#define XB_XGEN(j)  (2304 + 64 * (j))
#define XB_TOP      3328
#define XB_TOPGEN   3392
#define XCD_BAR_WORDS 3456
#define XB_SPIN_CAP (1u << 18)

__device__ __forceinline__ unsigned xb_ld(unsigned* p)              { return __hip_atomic_load(p, __ATOMIC_RELAXED, __HIP_MEMORY_SCOPE_AGENT); }
__device__ __forceinline__ unsigned xb_add(unsigned* p, unsigned v) { return __hip_atomic_fetch_add(p, v, __ATOMIC_RELAXED, __HIP_MEMORY_SCOPE_AGENT); }
__device__ __forceinline__ unsigned xb_xcc_id() { return (unsigned)__builtin_amdgcn_s_getreg((3 << 11) | 20) & 0xFu; }
#define XB_SPIN(cond, bar) do { unsigned _sp = 0; while (cond) { __builtin_amdgcn_s_sleep(1); \
    if ((++_sp & 255u) == 0u) { if (xb_ld(&(bar)[XB_TMO])) break; if (_sp > XB_SPIN_CAP) { atomicAdd(&(bar)[XB_TMO], 1u); break; } } } } while (0)

struct XcdBarrier {
    unsigned* bar; unsigned x;
    volatile LAS unsigned* st;
};

__device__ __forceinline__ XcdBarrier xcd_barrier_post(unsigned* bar, volatile LAS unsigned* st) {
    XcdBarrier b; b.bar = bar; b.x = xb_xcc_id(); b.st = st;
    if (threadIdx.x == 0) (void)xb_add(&bar[XB_XCNT(b.x)], 1u);
    return b;
}
__device__ __forceinline__ void xcd_barrier_complete(unsigned* bar, unsigned x, unsigned& nloc, unsigned& nx) {
    const unsigned G = gridDim.x * gridDim.y * gridDim.z;
    unsigned sum, cnt, mine, sp = 0u;
    for (;;) {
        sum = 0u; cnt = 0u; mine = 0u;
#pragma unroll
        for (unsigned j = 0; j < 16; ++j) { const unsigned c = xb_ld(&bar[XB_XCNT(j)]); sum += c; cnt += (c > 0u) ? 1u : 0u; mine = (j == x) ? c : mine; }
        if (sum == G) break;
        __builtin_amdgcn_s_sleep(1);
        if ((++sp & 255u) == 0u) { if (xb_ld(&bar[XB_TMO])) break; if (sp > XB_SPIN_CAP) { atomicAdd(&bar[XB_TMO], 1u); break; } }
    }
    nloc = mine > 0u ? mine : 1u; nx = cnt > 0u ? cnt : 1u;
}

__device__ __forceinline__ void xcd_barrier(const XcdBarrier& b) {
    asm volatile("s_waitcnt vmcnt(0)" ::: "memory");
    __syncthreads();
    if (threadIdx.x == 0) {
        unsigned* bar = b.bar;
        __builtin_amdgcn_s_waitcnt(0);
        unsigned nloc = b.st[0], nx = b.st[1];
        if (nloc == 0u) { xcd_barrier_complete(bar, b.x, nloc, nx); b.st[0] = nloc; b.st[1] = nx; }
        const unsigned old = xb_add(&bar[XB_XSUB(b.x)], 1u);
        const unsigned gen = old / nloc;
        if (old + 1u == (gen + 1u) * nloc) {
            __builtin_amdgcn_fence(__ATOMIC_RELEASE, "agent");
            asm volatile("s_waitcnt vmcnt(0)" ::: "memory");
            const unsigned og = xb_add(&bar[XB_TOP], 1u);
            const unsigned tg = og / nx;
            if (og + 1u == (tg + 1u) * nx) xb_add(&bar[XB_TOPGEN], 1u);
            else XB_SPIN(xb_ld(&bar[XB_TOPGEN]) == tg, bar);
            __builtin_amdgcn_fence(__ATOMIC_ACQUIRE, "agent");
            xb_add(&bar[XB_XGEN(b.x)], 1u);
            asm volatile("s_waitcnt vmcnt(0)" ::: "memory");
        } else {
            XB_SPIN(xb_ld(&bar[XB_XGEN(b.x)]) == gen, bar);
            __builtin_amdgcn_fence(__ATOMIC_ACQUIRE, "agent");
            asm volatile("s_waitcnt vmcnt(0)" ::: "memory");
        }
    }
    __syncthreads();
}


extern __shared__ __attribute__((aligned(16))) unsigned char dyn_lds[];
#define KPH(name, call) __global__ void __launch_bounds__(NTHREADS, 2) name(Params p, int l, int M) { LAS unsigned char* lds = (LAS unsigned char*)dyn_lds; (void)l; (void)M; (void)lds; call; }
KPH(k_convert, { ph_convert(p, lds); })
KPH(k_mod, { ph_mod(p, lds); })
KPH(k_norm1, { ph_norm1_first(p); })
KPH(k_g1, { ph_g1(p, l, lds); })
KPH(k_prep, { ph_prep(p, l, lds); })
KPH(k_local, { ph_local(p, l, lds); })
KPH(k_seq, { ph_seq(p, lds); })
KPH(k_merge, { ph_merge(p, l, M); })
KPH(k_g2, { ph_g2(p, l, M, lds); })
KPH(k_g3, { ph_g3(p, l, M, lds); })
KPH(k_route, { ph_route(p, l, M, lds); })
KPH(k_g4, { ph_g4(p, l, lds); })
KPH(k_g5, { ph_g5(p, l, lds); })
KPH(k_combine, { ph_combine(p, l, M, lds); })


__global__ void __launch_bounds__(NTHREADS, 2) k_mega(Params p) {
    LAS unsigned char* lds = (LAS unsigned char*)dyn_lds;
    volatile LAS unsigned* xb_words = (volatile LAS unsigned*)(lds + LDS_BYTES - 16);
    if (threadIdx.x == 0) { xb_words[0] = 0u; xb_words[1] = 0u; xb_words[2] = 0u; xb_words[3] = 0u; }
    __syncthreads();
    (void)xcd_barrier_post(p.bar, xb_words);
#define GRID_BARRIER() do { XcdBarrier b_; b_.bar = p.bar; b_.x = xb_xcc_id(); b_.st = xb_words; xcd_barrier(b_); } while (0)
#define RUNP(bit, stmt) do { stmt; if (PROBE & (1 << (bit))) { GRID_BARRIER(); stmt; } } while (0)
    RUNP(0, ph_convert(p, lds));
    RUNP(1, ph_mod(p, lds));
    GRID_BARRIER();
    RUNP(2, ph_norm1_first(p));
    GRID_BARRIER();
    for (int l = 0; l < 2; ++l) {
        const int M = l == 0 ? NTOK : NLAT;
        RUNP(3, ph_g1(p, l, lds));
        GRID_BARRIER();
        RUNP(4, ph_prep(p, l, lds));
        GRID_BARRIER();
        RUNP(5, ph_local(p, l, lds));
        GRID_BARRIER();
        RUNP(6, ph_seq(p, lds));
        GRID_BARRIER();
        RUNP(7, ph_merge(p, l, M));
        GRID_BARRIER();
        RUNP(8, ph_g2(p, l, M, lds));
        GRID_BARRIER();
        if (PROBE & (1 << 11)) { ph_g3<true>(p, l, M, lds); GRID_BARRIER(); }
        ph_g3(p, l, M, lds);
        GRID_BARRIER();
        if (PROBE & (1 << 12)) { ph_route<true>(p, l, M, lds); GRID_BARRIER(); }
        ph_route(p, l, M, lds);
        GRID_BARRIER();
        RUNP(9, ph_g4(p, l, lds));
        GRID_BARRIER();
        RUNP(10, ph_g5(p, l, lds));
        GRID_BARRIER();
        if (PROBE & (1 << 13)) { ph_combine<true>(p, l, M, lds); GRID_BARRIER(); }
        ph_combine(p, l, M, lds);
        if (l == 0) GRID_BARRIER();
    }
}

static inline size_t align_up(size_t v, size_t a) { return (v + a - 1) / a * a; }

extern "C" void kernel_launch(void* const* d_in, const int* in_sizes, int n_in, void* d_out, int out_size, void* d_ws, size_t ws_size, hipStream_t stream) {
    (void)in_sizes; (void)n_in; (void)out_size;
    Params p{};
    const float** pf = (const float**)&p;
    for (int i = 0; i < 32; ++i) pf[i] = (const float*)d_in[i];
    p.out = (float*)d_out;
    unsigned char* w = (unsigned char*)d_ws; size_t off = 0;
    auto take = [&](size_t bytes) { void* r = w + off; off = align_up(off + bytes, 256); return r; };
    p.bar = (unsigned*)take(16384);
    p.cnt = (int*)take(1024);
    const size_t ctl_bytes = off;
    p.mod = (float*)take((size_t)2 * 5 * NMOD * D * 4);
    p.winT = (bf16_t*)take((size_t)2 * NP * D * 2);
    p.wbT = (bf16_t*)take((size_t)2 * 4 * D * MW * 2);
    p.woutT = (bf16_t*)take((size_t)2 * D * D * 2);
    p.w1T = (bf16_t*)take((size_t)2 * NE * 2 * D * D * 2);
    p.w2T = (bf16_t*)take((size_t)2 * NE * D * D * 2);
    p.xl = (float*)take((size_t)NTOK * D * 4);
    p.H = (bf16_t*)take((size_t)NTOK * D * 2);
    p.P = (bf16_t*)take((size_t)NTOK * NP * 2);
    p.act = p.P; p.yp = p.P + (size_t)CAPROWS * D;
    p.prep = (float*)take(NPREP * TOKW * 4);
    p.gg = (float*)take((size_t)NTOK * 8 * 4);
    p.gb = (float*)take((size_t)NTOK * 8 * 4);
    p.O = (float*)take(8 * TOKW * 4);
    p.lq = (bf16_t*)take((size_t)3 * NITEM * 64 * 128 * 2);
    p.lo = (bf16_t*)take((size_t)3 * NITEM * 64 * 128 * 2);
    p.lb = (bf16_t*)take((size_t)3 * NITEM * 128 * 128 * 2);
    p.la = (bf16_t*)take((size_t)NITEM * 128 * 128 * 2);
    p.ld = (float*)take((size_t)3 * NITEM * 128 * 4);
    p.Y = (bf16_t*)take(4 * TOKW * 2);
    p.mix = (bf16_t*)take((size_t)NTOK * D * 2);
    p.F = p.H;
    p.list = (int*)take((size_t)NE * NTOK * 4);
    p.tokslot = (int*)take((size_t)NTOK * 4 * 4);
    p.topw = (float*)take((size_t)NTOK * 4 * 4);
    if (off > ws_size) { fprintf(stderr, "workspace too small: need %zu have %zu\n", off, ws_size); return; }

    static int grid = 0;
#if MEGA
    if (!grid) {
        int dev = 0, cus = 0, occ = 0; (void)hipGetDevice(&dev); (void)hipDeviceGetAttribute(&cus, hipDeviceAttributeMultiprocessorCount, dev);
        (void)hipFuncSetAttribute((const void*)k_mega, hipFuncAttributeMaxDynamicSharedMemorySize, LDS_BYTES);
        (void)hipOccupancyMaxActiveBlocksPerMultiprocessor(&occ, (const void*)k_mega, NTHREADS, LDS_BYTES);
        if (cus <= 0) cus = 256;
        grid = cus * (occ < 1 ? 1 : 1);
        if (occ < 1) fprintf(stderr, "occupancy query says %d blocks per CU\n", occ);
    }
    (void)hipMemsetAsync(d_ws, 0, ctl_bytes, stream);
    hipLaunchKernelGGL(k_mega, dim3(grid), dim3(NTHREADS), LDS_BYTES, stream, p);
#else
    if (!grid) {
        int dev = 0, cus = 0; (void)hipGetDevice(&dev); (void)hipDeviceGetAttribute(&cus, hipDeviceAttributeMultiprocessorCount, dev);
        grid = cus > 0 ? cus : 256;
        const void* ks[] = {(const void*)k_convert, (const void*)k_mod, (const void*)k_norm1, (const void*)k_g1, (const void*)k_prep, (const void*)k_local, (const void*)k_seq, (const void*)k_merge,
                            (const void*)k_g2, (const void*)k_g3, (const void*)k_route, (const void*)k_g4, (const void*)k_g5, (const void*)k_combine};
        for (const void* k : ks) (void)hipFuncSetAttribute(k, hipFuncAttributeMaxDynamicSharedMemorySize, LDS_BYTES);
    }
    (void)hipMemsetAsync(d_ws, 0, ctl_bytes, stream);
#define LAUNCH(k, l, M) hipLaunchKernelGGL(k, dim3(grid), dim3(NTHREADS), LDS_BYTES, stream, p, l, M)
    LAUNCH(k_convert, 0, 0);
    LAUNCH(k_mod, 0, 0);
    LAUNCH(k_norm1, 0, 0);
    for (int l = 0; l < 2; ++l) {
        const int M = l == 0 ? NTOK : NLAT;
        LAUNCH(k_g1, l, M);
        LAUNCH(k_prep, l, M);
        LAUNCH(k_local, l, M);
        LAUNCH(k_seq, l, M);
        LAUNCH(k_merge, l, M);
        LAUNCH(k_g2, l, M);
        LAUNCH(k_g3, l, M);
        LAUNCH(k_route, l, M);
        LAUNCH(k_g4, l, M);
        LAUNCH(k_g5, l, M);
        LAUNCH(k_combine, l, M);
    }
#endif
}
```

```cpp
#include <hip/hip_runtime.h>
#include <stdint.h>
#include <stdio.h>

#define LAS __attribute__((address_space(3)))
typedef unsigned short bf16_t;
typedef short bf16x8 __attribute__((ext_vector_type(8)));
typedef float f32x4 __attribute__((ext_vector_type(4)));
typedef float f32x2 __attribute__((ext_vector_type(2)));
typedef unsigned u32x2 __attribute__((ext_vector_type(2)));
typedef unsigned u32x4 __attribute__((ext_vector_type(4)));

#ifndef MEGA
#define MEGA 1
#endif
#ifndef PROBE
#define PROBE 0
#endif

constexpr int D = 1024, NB = 4, TL = 4096, TC = 256, NLAT = NB * TL, NCTX = NB * TC, NTOK = NLAT + NCTX;
constexpr int NIN = 11792, NP = 12032, MW = 512, NE = 32, TOPK = 4, NMOD = 6;
constexpr int C_GQKV = 0, C_GZ = 1536, C_GA = 2048, C_GB = 2056, C_HQ = 2064, C_HI = 2576, C_HF = 3088, C_HG = 4112, C_LX = 4624,
              C_LY = 5136, C_RQKV = 5648, C_RG = 7184, C_MG = 7696;
constexpr int NTHREADS = 512, NWAVES = 8;
constexpr int LDS_BYTES = 140 * 1024;
constexpr int CAPROWS = 77824;
constexpr size_t TOKW = (size_t)NTOK * MW;
constexpr int PR_LA = 0, PR_LU = 2, NPREP = 4;
constexpr int NCHUNK = 68, NITEM = 32 * NCHUNK;

struct Params {
    const float *x, *c, *ctx, *c_ctx, *w_mod, *b_mod, *norm1_g, *norm2_g, *w_in, *gdn_conv_w, *gdn_a_log, *gdn_dt_bias, *gdn_norm_g, *hgrn_lb,
        *hgrn_norm_g, *lru_conv_w, *lru_conv_b, *lru_wa, *lru_ba, *lru_wx, *lru_bx, *lru_lambda, *ret_norm_g, *w_branch, *w_out, *router_w,
        *router_b, *moe_w1, *moe_b1, *moe_w2, *moe_b2, *final_norm_g;
    float* out;
    unsigned* bar; int* cnt; float* mod;
    bf16_t *winT, *wbT, *woutT, *w1T, *w2T;
    float* xl; bf16_t* H; bf16_t* P; float* prep; float* gg; float* gb; float* O; bf16_t* Y; bf16_t* mix; bf16_t* F;
    int* list; int* tokslot; float* topw; bf16_t* act; bf16_t* yp;
    bf16_t *lq, *lo, *lb, *la; float* ld;
};

__device__ __forceinline__ unsigned f2bf(float f) { unsigned u = __float_as_uint(f); u += 0x7fffu + ((u >> 16) & 1u); return u >> 16; }
__device__ __forceinline__ unsigned pack2(float a, float b) { return f2bf(a) | (f2bf(b) << 16); }
__device__ __forceinline__ float bf2f(bf16_t b) { return __uint_as_float(((unsigned)b) << 16); }
__device__ __forceinline__ float bflo(unsigned u) { return __uint_as_float(u << 16); }
__device__ __forceinline__ float bfhi(unsigned u) { return __uint_as_float(u & 0xffff0000u); }
__device__ __forceinline__ float sigmoidf_(float x) { return __builtin_amdgcn_rcpf(1.0f + __expf(-x)); }
__device__ __forceinline__ float siluf_(float x) { return x * sigmoidf_(x); }
__device__ __forceinline__ float softplusf_(float x) { return x > 20.f ? x : log1pf(__expf(x)); }
__device__ __forceinline__ float logsigmoidf_(float x) { return -softplusf_(-x); }
__device__ __forceinline__ float gelu_tanhf_(float x) { const float u = 0.7978845608028654f * (x + 0.044715f * x * x * x); return 0.5f * x * (1.0f + tanhf(u)); }
__device__ __forceinline__ float wave_sum(float v) {
#pragma unroll
    for (int m = 32; m >= 1; m >>= 1) v += __shfl_xor(v, m);
    return v;
}
__device__ __forceinline__ int opaque_tid() { int t = threadIdx.x; asm volatile("" : "+v"(t)); return t; }
__device__ __forceinline__ int tok_modrow(int tok) { return tok < NLAT ? (tok >> 12) : 4; }
__device__ __forceinline__ void tok_info(int tok, int& t, int& T, int& base) {
    if (tok < NLAT) { t = tok & (TL - 1); T = TL; base = tok - t; }
    else { t = (tok - NLAT) & (TC - 1); T = TC; base = tok - t; }
}

namespace gm {
constexpr int HT = 16384;
__device__ __forceinline__ int lds_byte(int r, int c) { const int st = (r >> 4) * 2 + (c >> 5), rr = r & 15, cc = c & 31, ob = rr * 64 + cc * 2; return st * 1024 + (ob ^ (((ob >> 9) & 1) << 5)); }
__device__ __forceinline__ void stage_rc(int b, int& R, int& C) { const int st = b / 1024, sb = b % 1024, swz = sb ^ (((sb >> 9) & 1) << 5); R = (st >> 1) * 16 + swz / 64; C = (st & 1) * 32 + (swz % 64) / 2; }

__device__ __forceinline__ void kloop(LAS unsigned char* lds, const bf16_t* ap00, const bf16_t* ap01, const bf16_t* ap10, const bf16_t* ap11,
                                      const bf16_t* bp0, const bf16_t* bp1, int K, f32x4 (&acc)[4][4]) {
    const int tid = opaque_tid(), wid = __builtin_amdgcn_readfirstlane(tid >> 6), lane = tid & 63, wr = wid >> 1, wc = wid & 1, fr = lane & 15, fq = lane >> 4;
    const unsigned ldsw = (unsigned)wid * 1024u;
    const int aoff = (wr >> 1) * HT + lds_byte((wr & 1) * 64 + fr, fq * 8);
    const int boff = 2 * HT + lds_byte(wc * 64 + fr, fq * 8);
    const int nt = K / 64;
#define GM_GLDS(src, dstoff) __builtin_amdgcn_global_load_lds((const unsigned*)(src), (LAS unsigned*)(lds + (dstoff)), 16, 0, 0)
#define GM_STAGE(buf, kt) do { const int _bo = (buf) * 3 * HT + ldsw; const int _ko = (kt) * 64; \
        GM_GLDS(ap00 + _ko, _bo); GM_GLDS(ap01 + _ko, _bo + 8192); GM_GLDS(ap10 + _ko, _bo + HT); GM_GLDS(ap11 + _ko, _bo + HT + 8192); \
        GM_GLDS(bp0 + _ko, _bo + 2 * HT); GM_GLDS(bp1 + _ko, _bo + 2 * HT + 8192); } while (0)
    GM_STAGE(0, 0);
    for (int t = 0; t < nt; ++t) {
        const int cur = t & 1;
        if (t + 1 < nt) { GM_STAGE(cur ^ 1, t + 1); asm volatile("s_waitcnt vmcnt(6)" ::: "memory"); }
        else asm volatile("s_waitcnt vmcnt(0)" ::: "memory");
        __builtin_amdgcn_s_barrier(); asm volatile("" ::: "memory");
        bf16x8 af[4][2], bfr[4][2];
#pragma unroll
        for (int m = 0; m < 4; ++m)
#pragma unroll
            for (int k = 0; k < 2; ++k) af[m][k] = *(const LAS bf16x8*)(lds + cur * 3 * HT + aoff + m * 2048 + k * 1024);
#pragma unroll
        for (int n = 0; n < 4; ++n)
#pragma unroll
            for (int k = 0; k < 2; ++k) bfr[n][k] = *(const LAS bf16x8*)(lds + cur * 3 * HT + boff + n * 2048 + k * 1024);
#pragma unroll
        for (int k = 0; k < 2; ++k)
#pragma unroll
            for (int m = 0; m < 4; ++m)
#pragma unroll
                for (int n = 0; n < 4; ++n) acc[m][n] = __builtin_amdgcn_mfma_f32_16x16x32_bf16(bfr[n][k], af[m][k], acc[m][n], 0, 0, 0);
        asm volatile("s_waitcnt lgkmcnt(0)" ::: "memory");
        __builtin_amdgcn_s_barrier(); asm volatile("" ::: "memory");
    }
#undef GM_STAGE
#undef GM_GLDS
}
__device__ __forceinline__ void zero_acc(f32x4 (&acc)[4][4]) {
#pragma unroll
    for (int m = 0; m < 4; ++m)
#pragma unroll
        for (int n = 0; n < 4; ++n) acc[m][n] = (f32x4){0.f, 0.f, 0.f, 0.f};
}
}

namespace g8 {
constexpr int BM = 256, BK = 64, HALF = 128, HTB = HALF * BK * 2, STAGE_BYTES = 8 * HTB;
__device__ __forceinline__ int lds_byte(int r, int c) { const int st = (r >> 4) * 2 + (c >> 5), rr = r & 15, cc = c & 31, ob = rr * 64 + cc * 2; return st * 1024 + (ob ^ (((ob >> 9) & 1) << 5)); }
__device__ __forceinline__ void stage_rc(int b, int& R, int& C) { const int st = b / 1024, sb = b % 1024, swz = sb ^ (((sb >> 9) & 1) << 5); R = (st >> 1) * 16 + swz / 64; C = (st & 1) * 32 + (swz % 64) / 2; }
__device__ __forceinline__ int perm32(int rho) { const int n = rho >> 4, i = rho & 15; return 8 * (i >> 2) + 4 * n + (i & 3); }
struct Unit { int pm, pn, e; };

template <class Epi, class Sched>
__device__ __forceinline__ void gemm_phase(LAS unsigned char* lds, const int K, const Sched& S, const Epi& E) {
    const int tid = opaque_tid(), wid = __builtin_amdgcn_readfirstlane(tid >> 6), lane = tid & 63, wr = wid >> 2, wc = wid & 3, fr = lane & 15, fq = lane >> 4;
    const int nt = K / BK;
    int R0, C0, R1, C1; stage_rc(tid * 16, R0, C0); stage_rc(tid * 16 + 8192, R1, C1);
    unsigned voffB[2];
    voffB[0] = (unsigned)(((R0 & ~31) + perm32(R0 & 31)) * K + C0) * 2u; voffB[1] = (unsigned)(((R1 & ~31) + perm32(R1 & 31)) * K + C1) * 2u;
    const unsigned cb0 = (unsigned)C0 * 2u, cb1 = (unsigned)C1 * 2u;
    const size_t kstep = (size_t)(BK * 2);
    const size_t hstepB = (size_t)HALF * K * 2;
    const unsigned ldsw = (unsigned)wid * 1024u;
    const int aoff = lds_byte(wr * 64 + fr, fq * 8), boff = lds_byte(wc * 32 + fr, fq * 8);
#define G8_SA(b, h) (((b) * 2 + (h)) * HTB)
#define G8_SB(b, h) ((4 + (b) * 2 + (h)) * HTB)
#define G8_GL(src, dstoff) __builtin_amdgcn_global_load_lds((const unsigned*)(src), (LAS unsigned*)(lds + (dstoff)), 16, 0, 0)
#define G8_STAGE_A(bufoff, gbase, vo, h) do { G8_GL((const char*)(gbase) + (vo)[2 * (h)], (bufoff) + ldsw); G8_GL((const char*)(gbase) + (vo)[2 * (h) + 1], (bufoff) + ldsw + 8192); } while (0)
#define G8_STAGE_B(bufoff, gbase) do { G8_GL((const char*)(gbase) + voffB[0], (bufoff) + ldsw); G8_GL((const char*)(gbase) + voffB[1], (bufoff) + ldsw + 8192); } while (0)
#define G8_LDA(dst, b, h) do { _Pragma("unroll") for (int m = 0; m < 4; ++m) _Pragma("unroll") for (int k = 0; k < 2; ++k) dst[m][k] = *(const LAS bf16x8*)(lds + G8_SA(b, h) + aoff + m * 2048 + k * 1024); } while (0)
#define G8_LDB(dst, b, h) do { _Pragma("unroll") for (int n = 0; n < 2; ++n) _Pragma("unroll") for (int k = 0; k < 2; ++k) dst[n][k] = *(const LAS bf16x8*)(lds + G8_SB(b, h) + boff + n * 2048 + k * 1024); } while (0)
#define G8_MMA(ai, bj, At, Bt) do { __builtin_amdgcn_s_setprio(1); _Pragma("unroll") for (int m = 0; m < 4; ++m) _Pragma("unroll") for (int n = 0; n < 2; ++n) _Pragma("unroll") for (int k = 0; k < 2; ++k) \
        acc[ai][bj][m][n] = __builtin_amdgcn_mfma_f32_16x16x32_bf16(Bt[n][k], At[m][k], acc[ai][bj][m][n], 0, 0, 0); __builtin_amdgcn_s_setprio(0); } while (0)
#define G8_WAIT_V(n) asm volatile("s_waitcnt vmcnt(" #n ")" ::: "memory")
#define G8_WAIT_L(n) asm volatile("s_waitcnt lgkmcnt(" #n ")" ::: "memory")
#define G8_BAR __builtin_amdgcn_s_barrier()
#define G8_SCHED __builtin_amdgcn_sched_barrier(0)
    Unit cur, nxt; int ui = 0;
    if (!S.next(0, cur)) return;
    LAS float* biasbuf = (LAS float*)(lds + STAGE_BYTES + 2048);
    LAS int* rowbuf = (LAS int*)(lds + STAGE_BYTES + 4096);
    f32x4 acc[2][2][4][2];
#pragma unroll
    for (int a = 0; a < 2; ++a)
#pragma unroll
        for (int b = 0; b < 2; ++b)
#pragma unroll
            for (int m = 0; m < 4; ++m)
#pragma unroll
                for (int n = 0; n < 2; ++n) acc[a][b][m][n] = (f32x4){0.f, 0.f, 0.f, 0.f};
    bf16x8 At[4][2], B0[2][2], B1[2][2];
    unsigned vA[4];
    {
        unsigned rows[4] = {(unsigned)R0, (unsigned)R1, (unsigned)(HALF + R0), (unsigned)(HALF + R1)};
        if (S.gather) { rows[0] = (unsigned)*S.row_addr(cur, R0); rows[1] = (unsigned)*S.row_addr(cur, R1); rows[2] = (unsigned)*S.row_addr(cur, HALF + R0); rows[3] = (unsigned)*S.row_addr(cur, HALF + R1); }
        vA[0] = rows[0] * (unsigned)(K * 2) + cb0; vA[1] = rows[1] * (unsigned)(K * 2) + cb1; vA[2] = rows[2] * (unsigned)(K * 2) + cb0; vA[3] = rows[3] * (unsigned)(K * 2) + cb1;
    }
    const char* cA = S.a_base(cur); const char* cB = S.b_base(cur);
    G8_STAGE_B(G8_SB(0, 0), cB); G8_STAGE_A(G8_SA(0, 0), cA, vA, 0); G8_STAGE_B(G8_SB(0, 1), cB + hstepB); G8_STAGE_A(G8_SA(0, 1), cA, vA, 1);
    if (wr == 1) G8_BAR;
    G8_WAIT_V(4); G8_BAR;
    G8_STAGE_B(G8_SB(1, 0), cB + kstep); G8_STAGE_A(G8_SA(1, 0), cA + kstep, vA, 0); G8_STAGE_B(G8_SB(1, 1), cB + hstepB + kstep);
    G8_WAIT_V(6); G8_BAR;
    for (;;) {
        const bool has_next = S.next(ui + 1, nxt);
        const char* nA = has_next ? S.a_base(nxt) : cA; const char* nB = has_next ? S.b_base(nxt) : cB;
        const int nvalid = (S.gather && has_next) ? S.rows_valid(nxt) : 0;
        if (wid == 0) {
            if (Sched::HAS_BIAS) G8_GL(S.bias_src(cur, lane), STAGE_BYTES + 2048 + (ui & 1) * 1024);
            if (S.gather && has_next) G8_GL(S.row_addr(nxt, 0) + lane * 4, STAGE_BYTES + 4096 + ((ui + 1) & 1) * 1024);
        }
        unsigned vlast[4] = {vA[0], vA[1], vA[2], vA[3]};
        for (int t = 0; t < nt; t += 2) {
            const bool last = (t == nt - 2);
            const char* a1 = cA + (size_t)(t + 1) * kstep;
            const char* a2 = last ? nA : cA + (size_t)(t + 2) * kstep; const char* b2 = last ? nB : cB + (size_t)(t + 2) * kstep;
            const char* a3 = a2 + kstep; const char* b3 = b2 + kstep;
            unsigned v2[4];
#pragma unroll
            for (int q = 0; q < 4; ++q) v2[q] = vA[q];
            if (last && S.gather && has_next) {
                const LAS int* rb = rowbuf + ((ui + 1) & 1) * 256;
                const unsigned r0 = R0 < nvalid ? (unsigned)rb[R0] : 0u, r1 = R1 < nvalid ? (unsigned)rb[R1] : 0u;
                const unsigned r2 = HALF + R0 < nvalid ? (unsigned)rb[HALF + R0] : 0u, r3 = HALF + R1 < nvalid ? (unsigned)rb[HALF + R1] : 0u;
                v2[0] = r0 * (unsigned)(K * 2) + cb0; v2[1] = r1 * (unsigned)(K * 2) + cb1; v2[2] = r2 * (unsigned)(K * 2) + cb0; v2[3] = r3 * (unsigned)(K * 2) + cb1;
            }
            if (last) { vlast[0] = v2[0]; vlast[1] = v2[1]; vlast[2] = v2[2]; vlast[3] = v2[3]; }
            G8_LDB(B0, 0, 0); G8_SCHED; G8_LDA(At, 0, 0); G8_STAGE_A(G8_SA(1, 1), a1, vA, 1);
            G8_WAIT_L(8); G8_BAR; G8_WAIT_L(0); G8_MMA(0, 0, At, B0); G8_BAR; G8_SCHED;
            G8_LDB(B1, 0, 1); G8_STAGE_B(G8_SB(0, 0), b2);
            G8_BAR; G8_WAIT_L(0); G8_MMA(0, 1, At, B1); G8_BAR;
            G8_LDA(At, 0, 1); G8_STAGE_A(G8_SA(0, 0), a2, v2, 0);
            G8_BAR; G8_WAIT_L(0); G8_MMA(1, 0, At, B0); G8_BAR; G8_SCHED;
            G8_STAGE_B(G8_SB(0, 1), b2 + hstepB);
            G8_WAIT_V(6); G8_BAR; G8_MMA(1, 1, At, B1); G8_BAR;
            G8_LDB(B0, 1, 0); G8_SCHED; G8_LDA(At, 1, 0); G8_STAGE_A(G8_SA(0, 1), a2, v2, 1);
            G8_WAIT_L(8); G8_BAR; G8_WAIT_L(0); G8_MMA(0, 0, At, B0); G8_BAR; G8_SCHED;
            G8_LDB(B1, 1, 1); G8_STAGE_B(G8_SB(1, 0), b3);
            G8_BAR; G8_WAIT_L(0); G8_MMA(0, 1, At, B1); G8_BAR;
            G8_LDA(At, 1, 1); G8_STAGE_A(G8_SA(1, 0), a3, v2, 0);
            G8_BAR; G8_WAIT_L(0); G8_MMA(1, 0, At, B0); G8_BAR; G8_SCHED;
            G8_STAGE_B(G8_SB(1, 1), b3 + hstepB);
            G8_WAIT_V(6); G8_BAR; G8_MMA(1, 1, At, B1); G8_BAR;
        }
        E(acc, cur, wr, wc, fr, fq, biasbuf + (ui & 1) * 256);
        if (!has_next) break;
#pragma unroll
        for (int a = 0; a < 2; ++a)
#pragma unroll
            for (int b = 0; b < 2; ++b)
#pragma unroll
                for (int m = 0; m < 4; ++m)
#pragma unroll
                    for (int n = 0; n < 2; ++n) acc[a][b][m][n] = (f32x4){0.f, 0.f, 0.f, 0.f};
        cur = nxt; cA = nA; cB = nB; ++ui;
#pragma unroll
        for (int q = 0; q < 4; ++q) vA[q] = vlast[q];
    }
    G8_WAIT_V(0);
    if (wr == 0) G8_BAR;
    G8_BAR;
#undef G8_SA
#undef G8_SB
#undef G8_GL
#undef G8_STAGE_A
#undef G8_STAGE_B
#undef G8_LDA
#undef G8_LDB
#undef G8_MMA
#undef G8_WAIT_V
#undef G8_WAIT_L
#undef G8_BAR
#undef G8_SCHED
}

struct PlainSched {
    const bf16_t* A; const bf16_t* Bt; int K, nM, nN, nwg, G, c;
    __device__ __forceinline__ void init(const bf16_t* A_, const bf16_t* Bt_, int M, int N, int K_) { A = A_; Bt = Bt_; K = K_; nM = M / BM; nN = N / BM; nwg = nM * nN; G = gridDim.x; c = blockIdx.x; }
    __device__ __forceinline__ bool next(int i, Unit& u) const {
        const long L = (long)i * G + c; if (L >= nwg) return false;
        int wgid = (int)L; { const int q = nwg / 8, r = nwg % 8, xcd = wgid % 8, off = wgid / 8; wgid = (xcd < r ? xcd * (q + 1) : r * (q + 1) + (xcd - r) * q) + off; }
        const int nig = 8 * nN, gid = wgid / nig, fm = gid * 8, gsz = (nM - fm) < 8 ? (nM - fm) : 8;
        u.pm = fm + ((wgid % nig) % gsz); u.pn = (wgid % nig) / gsz; u.e = 0; return true;
    }
    __device__ __forceinline__ const char* a_base(const Unit& u) const { return (const char*)(A + (size_t)u.pm * BM * K); }
    __device__ __forceinline__ const char* b_base(const Unit& u) const { return (const char*)(Bt + (size_t)u.pn * BM * K); }
    static constexpr bool HAS_BIAS = false, gather = false;
    __device__ __forceinline__ const int* row_addr(const Unit&, int) const { return nullptr; }
    __device__ __forceinline__ int rows_valid(const Unit&) const { return 256; }
    __device__ __forceinline__ const float* bias_src(const Unit&, int) const { return nullptr; }
};
}

struct StageRC { int R0, C0, R1, C1; };
__device__ __forceinline__ StageRC my_stage_rc() { const int t = opaque_tid(); StageRC s; gm::stage_rc(t * 16, s.R0, s.C0); gm::stage_rc(t * 16 + 8192, s.R1, s.C1); return s; }

__device__ __forceinline__ int w1_dst_row(int n) { const int half = n >> 10, cc = n & 1023; return (cc >> 7) * 256 + half * 128 + (cc & 127); }

__device__ __forceinline__ void cvt_tile(LAS float* tile, const float* src, int ldsrc, int Nsrc, int k0, int n0, bf16_t* dst, int K, int mode) {
    const int tid = opaque_tid();
    {
        const int rr = tid >> 6, cc = tid & 63, n = n0 + cc;
#pragma unroll
        for (int i = 0; i < 8; ++i) { const int k = rr + i * 8; tile[k * 65 + cc] = (n < Nsrc) ? src[(size_t)(k0 + k) * ldsrc + n] : 0.f; }
    }
    __syncthreads();
    {
        const int nl = tid >> 3, kg = tid & 7, n = n0 + nl;
        float v[8];
#pragma unroll
        for (int j = 0; j < 8; ++j) v[j] = tile[(kg * 8 + j) * 65 + nl];
        const int drow = mode == 1 ? w1_dst_row(n) : n;
        u32x4 o; o[0] = pack2(v[0], v[1]); o[1] = pack2(v[2], v[3]); o[2] = pack2(v[4], v[5]); o[3] = pack2(v[6], v[7]);
        *(u32x4*)(dst + (size_t)drow * K + k0 + kg * 8) = o;
    }
    __syncthreads();
}

__device__ __forceinline__ void ph_convert(const Params& p, LAS unsigned char* lds) {
    LAS float* tile = (LAS float*)lds;
    constexpr int PER_L = 3008 + 512 + 256 + 16384 + 8192;
    for (int it = blockIdx.x; it < 2 * PER_L; it += gridDim.x) {
        const int l = it / PER_L; int r = it % PER_L;
        if (r < 3008) { const int nt = r % 188, kt = r / 188; cvt_tile(tile, p.w_in + (size_t)l * D * NIN, NIN, NIN, kt * 64, nt * 64, p.winT + (size_t)l * NP * D, D, 0); }
        else if (r < 3520) { r -= 3008; const int n = r / 128; r %= 128; const int nt = r % 16, kt = r / 16;
            cvt_tile(tile, p.w_branch + (size_t)(l * 4 + n) * MW * D, D, D, kt * 64, nt * 64, p.wbT + (size_t)(l * 4 + n) * D * MW, MW, 0); }
        else if (r < 3776) { r -= 3520; const int nt = r % 16, kt = r / 16; cvt_tile(tile, p.w_out + (size_t)l * D * D, D, D, kt * 64, nt * 64, p.woutT + (size_t)l * D * D, D, 0); }
        else if (r < 3776 + 16384) { r -= 3776; const int e = r / 512; r %= 512; const int nt = r % 32, kt = r / 32;
            cvt_tile(tile, p.moe_w1 + (size_t)(l * NE + e) * D * 2 * D, 2 * D, 2 * D, kt * 64, nt * 64, p.w1T + (size_t)(l * NE + e) * 2 * D * D, D, 1); }
        else { r -= 3776 + 16384; const int e = r / 256; r %= 256; const int nt = r % 16, kt = r / 16;
            cvt_tile(tile, p.moe_w2 + (size_t)(l * NE + e) * D * D, D, D, kt * 64, nt * 64, p.w2T + (size_t)(l * NE + e) * D * D, D, 0); }
    }
}

__device__ __forceinline__ void ph_mod(const Params& p, LAS unsigned char* lds) {
    LAS float* sc = (LAS float*)lds;
    LAS float* red = sc + 5 * D;
    const int tid = opaque_tid(), wid = tid >> 6, lane = tid & 63;
    if ((int)blockIdx.x >= 192) return;
    for (int i = tid; i < 5 * D; i += NTHREADS) { const int r = i >> 10, k = i & 1023; const float v = r < 4 ? p.c[r * D + k] : p.c_ctx[k]; sc[i] = siluf_(v); }
    __syncthreads();
    for (int it = blockIdx.x; it < 192; it += gridDim.x) {
        const int l = it / 96, n0 = (it % 96) * 64;
        float acc[5] = {0.f, 0.f, 0.f, 0.f, 0.f};
        const float* wp = p.w_mod + (size_t)l * D * (NMOD * D) + n0 + lane;
        for (int k = wid * 128; k < wid * 128 + 128; ++k) {
            const float wv = wp[(size_t)k * (NMOD * D)];
#pragma unroll
            for (int r = 0; r < 5; ++r) acc[r] += sc[r * D + k] * wv;
        }
#pragma unroll
        for (int r = 0; r < 5; ++r) red[(wid * 5 + r) * 64 + lane] = acc[r];
        __syncthreads();
        if (tid < 320) { const int r = tid >> 6, cidx = tid & 63; float s = p.b_mod[l * NMOD * D + n0 + cidx];
#pragma unroll
            for (int w = 0; w < 8; ++w) s += red[(w * 5 + r) * 64 + cidx];
            p.mod[(size_t)(l * 5 + r) * (NMOD * D) + n0 + cidx] = s; }
        __syncthreads();
    }
}

__device__ __forceinline__ void norm_mod_store(const float4 (&v)[4], float rinv, const float* g, const float* scp, const float* shp, bf16_t* dst, int lane) {
#pragma unroll
    for (int i = 0; i < 4; ++i) {
        const int cidx = i * 256 + lane * 4;
        const float4 gv = *(const float4*)(g + cidx), sv = *(const float4*)(scp + cidx), hv = *(const float4*)(shp + cidx);
        const float h0 = v[i].x * rinv * gv.x * (1.f + sv.x) + hv.x, h1 = v[i].y * rinv * gv.y * (1.f + sv.y) + hv.y;
        const float h2 = v[i].z * rinv * gv.z * (1.f + sv.z) + hv.z, h3 = v[i].w * rinv * gv.w * (1.f + sv.w) + hv.w;
        u32x2 o; o[0] = pack2(h0, h1); o[1] = pack2(h2, h3);
        *(u32x2*)(dst + cidx) = o;
    }
}
__device__ __forceinline__ void ph_norm1_first(const Params& p) {
    const int tid = opaque_tid(), wid = tid >> 6, lane = tid & 63;
    for (int tok = blockIdx.x * NWAVES + wid; tok < NTOK; tok += gridDim.x * NWAVES) {
        const float* src = tok < NLAT ? p.x + (size_t)tok * D : p.ctx + (size_t)(tok - NLAT) * D;
        float4 v[4]; float ss = 0.f;
#pragma unroll
        for (int i = 0; i < 4; ++i) { v[i] = *(const float4*)(src + i * 256 + lane * 4); ss += v[i].x * v[i].x + v[i].y * v[i].y + v[i].z * v[i].z + v[i].w * v[i].w; }
        ss = wave_sum(ss);
        const float rinv = rsqrtf(ss * (1.0f / D) + 1e-6f);
        const float* mb = p.mod + (size_t)(0 * 5 + tok_modrow(tok)) * (NMOD * D);
        norm_mod_store(v, rinv, p.norm1_g, mb + 1 * D, mb + 0 * D, p.H + (size_t)tok * D, lane);
#pragma unroll
        for (int i = 0; i < 4; ++i) *(float4*)(p.xl + (size_t)tok * D + i * 256 + lane * 4) = v[i];
    }
}

struct EpiP {
    bf16_t* O;
    __device__ __forceinline__ void operator()(const f32x4 (&acc)[2][2][4][2], const g8::Unit& u, int wr, int wc, int fr, int fq, const LAS float*) const {
        const int row0 = u.pm * 256 + wr * 64 + fr, col0 = u.pn * 256 + wc * 32 + 8 * fq;
#pragma unroll
        for (int ai = 0; ai < 2; ++ai)
#pragma unroll
            for (int m = 0; m < 4; ++m) {
                bf16_t* rowp = O + (size_t)(row0 + ai * 128 + m * 16) * NP + col0;
#pragma unroll
                for (int bj = 0; bj < 2; ++bj) {
                    u32x4 w; w[0] = pack2(acc[ai][bj][m][0][0], acc[ai][bj][m][0][1]); w[1] = pack2(acc[ai][bj][m][0][2], acc[ai][bj][m][0][3]);
                    w[2] = pack2(acc[ai][bj][m][1][0], acc[ai][bj][m][1][1]); w[3] = pack2(acc[ai][bj][m][1][2], acc[ai][bj][m][1][3]);
                    *(u32x4*)(rowp + bj * 128) = w;
                }
            }
    }
};
__device__ __forceinline__ void ph_g1(const Params& p, int l, LAS unsigned char* lds) {
    g8::PlainSched S; S.init(p.H, p.winT + (size_t)l * NP * D, NTOK, NP, D);
    EpiP E; E.O = p.P;
    g8::gemm_phase(lds, D, S, E);
}

__device__ __forceinline__ void ph_prep(const Params& p, int l, LAS unsigned char* lds) {
    const int tid = opaque_tid();
    {
        LAS float* xs = (LAS float*)lds;
        LAS float* wsm = xs + 64 * 65;
        for (int it = blockIdx.x; it < (NTOK / 64) * 8; it += gridDim.x) {
            const int tile = it >> 3, n = it & 7, tok0 = tile * 64;
            {
                const int tl = tid & 63, cg = tid >> 6, tok = tok0 + tl;
                int t, T, base; tok_info(tok, t, T, base);
                float a[8];
#pragma unroll
                for (int j = 0; j < 8; ++j) a[j] = p.lru_conv_b[l * MW + n * 64 + cg * 8 + j];
#pragma unroll
                for (int j = 0; j < 4; ++j) {
                    const int tt = t + j - 2;
                    if (tt >= 0 && tt < T) {
                        const u32x4 u = *(const u32x4*)(p.P + (size_t)(base + tt) * NP + C_LX + n * 64 + cg * 8);
                        const float* w = p.lru_conv_w + (size_t)(l * 4 + j) * MW + n * 64 + cg * 8;
#pragma unroll
                        for (int q = 0; q < 4; ++q) { a[2 * q] += w[2 * q] * bflo(u[q]); a[2 * q + 1] += w[2 * q + 1] * bfhi(u[q]); }
                    }
                }
#pragma unroll
                for (int j = 0; j < 8; ++j) xs[tl * 65 + cg * 8 + j] = a[j];
                for (int i = tid; i < 4 * 1024; i += NTHREADS) {
                    const int mat = i >> 10, off = (i & 1023) * 4, d = mat >> 1;
                    const float* srcw = ((mat & 1) ? p.lru_wx : p.lru_wa) + (size_t)((l * 2 + d) * 8 + n) * 4096 + off;
                    const float4 v = *(const float4*)srcw;
                    LAS float* dw = wsm + mat * 4096 + off; dw[0] = v.x; dw[1] = v.y; dw[2] = v.z; dw[3] = v.w;
                }
            }
            __syncthreads();
            {
                const int tl = tid & 63, jg = tid >> 6, tok = tok0 + tl;
                float acc[4][8];
#pragma unroll
                for (int m = 0; m < 4; ++m)
#pragma unroll
                    for (int j = 0; j < 8; ++j) acc[m][j] = 0.f;
                for (int i = 0; i < 64; ++i) {
                    const float xv = xs[tl * 65 + i];
#pragma unroll
                    for (int m = 0; m < 4; ++m)
#pragma unroll
                        for (int j = 0; j < 8; ++j) acc[m][j] += xv * wsm[m * 4096 + i * 64 + jg * 8 + j];
                }
#pragma unroll
                for (int d = 0; d < 2; ++d) {
                    float av[8], uv[8];
#pragma unroll
                    for (int j = 0; j < 8; ++j) {
                        const int cidx = n * 64 + jg * 8 + j, pi = (l * 2 + d) * MW + cidx;
                        const float gr = sigmoidf_(acc[d * 2][j] + p.lru_ba[pi]), gi = sigmoidf_(acc[d * 2 + 1][j] + p.lru_bx[pi]);
                        const float la = 8.0f * gr * logsigmoidf_(p.lru_lambda[pi]);
                        av[j] = __expf(la);
                        uv[j] = xs[tl * 65 + jg * 8 + j] * gi * sqrtf(fmaxf(-expm1f(2.0f * la), 1e-12f));
                    }
                    float* da = p.prep + (PR_LA + d) * TOKW + (size_t)tok * MW + n * 64 + jg * 8;
                    float* du = p.prep + (PR_LU + d) * TOKW + (size_t)tok * MW + n * 64 + jg * 8;
                    *(float4*)da = make_float4(av[0], av[1], av[2], av[3]); *(float4*)(da + 4) = make_float4(av[4], av[5], av[6], av[7]);
                    *(float4*)du = make_float4(uv[0], uv[1], uv[2], uv[3]); *(float4*)(du + 4) = make_float4(uv[4], uv[5], uv[6], uv[7]);
                }
            }
            __syncthreads();
        }
    }
}

__device__ __forceinline__ int chunk_base(int b, int d, int n) {
    if (n < 4) { const int blk = d ? 3 - n : n; return NLAT + b * TC + blk * 64; }
    const int m = n - 4, blk = d ? 63 - m : m; return b * TL + blk * 64;
}
__device__ __forceinline__ f32x4 mfma16(bf16x8 a, bf16x8 b, f32x4 c) { return __builtin_amdgcn_mfma_f32_16x16x32_bf16(a, b, c, 0, 0, 0); }
__device__ __forceinline__ u32x2 pack4(f32x4 v) { u32x2 o; o[0] = pack2(v[0], v[1]); o[1] = pack2(v[2], v[3]); return o; }
__device__ __forceinline__ u32x4 pack8(const float* v) { u32x4 o; o[0] = pack2(v[0], v[1]); o[1] = pack2(v[2], v[3]); o[2] = pack2(v[4], v[5]); o[3] = pack2(v[6], v[7]); return o; }

__device__ __forceinline__ void local_gla(const Params& p, int l, int tz, int chain, int n, LAS unsigned char* lds) {
    const int tid = opaque_tid(), wid = tid >> 6, lane = tid & 63, fr = lane & 15, fq = lane >> 4;
    const int b = chain >> 3, h = (chain >> 1) & 3, d = chain & 1;
    const int base = chunk_base(b, d, n);
    const size_t item = (size_t)tz * NITEM + (size_t)chain * NCHUNK + n;
    LAS bf16_t* kraw = (LAS bf16_t*)lds;
    LAS bf16_t* qh = kraw + 64 * 136;
    LAS bf16_t* kh = qh + 64 * 136;
    LAS bf16_t* sc = kh + 64 * 136;
    LAS bf16_t* vT = sc + 64 * 72;
    LAS bf16_t* kT = vT + 128 * 72;
    LAS float* bc = (LAS float*)(kT + 128 * 72);
    const int vcol = tz == 1 ? C_HI : C_RQKV + 1024;
    const int ti = tid >> 3, dg = tid & 7, cA = dg * 8, cB = 64 + dg * 8;
    const int tokI = base + (d ? 63 - ti : ti);
    const bf16_t* pr = p.P + (size_t)tokI * NP;
    float qt[16];
    {
        float kv[16], lfv[16];
        if (tz == 1) {
            const u32x4 uqa = *(const u32x4*)(pr + C_HQ + h * 128 + cA), uqb = *(const u32x4*)(pr + C_HQ + h * 128 + cB);
            const u32x4 uza = *(const u32x4*)(pr + C_HF + d * 512 + h * 128 + cA), uzb = *(const u32x4*)(pr + C_HF + d * 512 + h * 128 + cB);
#pragma unroll
            for (int e = 0; e < 16; ++e) {
                const unsigned uq = e < 8 ? uqa[(e & 7) >> 1] : uqb[(e & 7) >> 1], uz = e < 8 ? uza[(e & 7) >> 1] : uzb[(e & 7) >> 1];
                const float qraw = (e & 1) ? bfhi(uq) : bflo(uq), z = (e & 1) ? bfhi(uz) : bflo(uz);
                const int ch = h * 128 + (e < 8 ? cA + e : cB + e - 8);
                float lb = 0.f;
                if (l == 1) lb = fminf(1.0f / (1.0f + __expf(p.hgrn_lb[(size_t)(0 * 2 + d) * MW + ch] - p.hgrn_lb[(size_t)(1 * 2 + d) * MW + ch])), 1.0f - 1e-4f);
                const float sg = sigmoidf_(z);
                qt[e] = siluf_(qraw) * 0.08838834764831845f;
                kv[e] = (1.f - lb) * (1.f - sg);
                lfv[e] = __logf(fmaxf(lb + (1.f - lb) * sg, 1e-30f));
            }
        } else {
            const bf16_t* rp = pr + C_RQKV + h * 128;
            const u32x4 q1 = *(const u32x4*)(rp + cA), q2 = *(const u32x4*)(rp + cB), k1 = *(const u32x4*)(rp + 512 + cA), k2 = *(const u32x4*)(rp + 512 + cB);
            const float lng = log1pf(-exp2f(-5.0f - (float)h));
            const bool lat = tokI < NLAT;
            const int t = tokI & (TL - 1);
#pragma unroll
            for (int e = 0; e < 8; ++e) {
                float a1 = (e & 1) ? bfhi(q1[e >> 1]) : bflo(q1[e >> 1]), a2 = (e & 1) ? bfhi(q2[e >> 1]) : bflo(q2[e >> 1]);
                float b1 = (e & 1) ? bfhi(k1[e >> 1]) : bflo(k1[e >> 1]), b2 = (e & 1) ? bfhi(k2[e >> 1]) : bflo(k2[e >> 1]);
                if (lat) {
                    const int pi = cA + e;
                    const float pos = (pi < 32) ? (float)(t >> 6) : (float)(t & 63);
                    const float ang = pos * exp2f(-(float)(pi & 31) * (13.287712379549449f / 32.0f));
                    float sn, cs; sincosf(ang, &sn, &cs);
                    const float n1 = a1 * cs - a2 * sn, n2 = a1 * sn + a2 * cs, m1 = b1 * cs - b2 * sn, m2 = b1 * sn + b2 * cs;
                    a1 = n1; a2 = n2; b1 = m1; b2 = m2;
                }
                qt[e] = a1; qt[8 + e] = a2; kv[e] = b1 * 0.08838834764831845f; kv[8 + e] = b2 * 0.08838834764831845f;
                lfv[e] = lng; lfv[8 + e] = lng;
            }
        }
        *(LAS u32x4*)(kraw + ti * 136 + cA) = pack8(kv); *(LAS u32x4*)(kraw + ti * 136 + cB) = pack8(kv + 8);
        *(LAS f32x4*)(bc + ti * 132 + cA) = (f32x4){lfv[0], lfv[1], lfv[2], lfv[3]}; *(LAS f32x4*)(bc + ti * 132 + cA + 4) = (f32x4){lfv[4], lfv[5], lfv[6], lfv[7]};
        *(LAS f32x4*)(bc + ti * 132 + cB) = (f32x4){lfv[8], lfv[9], lfv[10], lfv[11]}; *(LAS f32x4*)(bc + ti * 132 + cB + 4) = (f32x4){lfv[12], lfv[13], lfv[14], lfv[15]};
        const bf16_t* vp = pr + vcol + h * 128;
        const u32x4 v0 = *(const u32x4*)(vp + cA), v1 = *(const u32x4*)(vp + cB);
#pragma unroll
        for (int e = 0; e < 8; ++e) {
            vT[(cA + e) * 72 + ti] = (bf16_t)((e & 1) ? (v0[e >> 1] >> 16) : (v0[e >> 1] & 0xffffu));
            vT[(cB + e) * 72 + ti] = (bf16_t)((e & 1) ? (v1[e >> 1] >> 16) : (v1[e >> 1] & 0xffffu));
        }
    }
    __syncthreads();
    if (tid < 128) {
        float run = 0.f;
#pragma unroll 8
        for (int i = 0; i < 64; ++i) { run += bc[i * 132 + tid]; bc[i * 132 + tid] = run; }
    }
    __syncthreads();
    {
        const int I = ti >> 4;
        float qhat[16];
#pragma unroll
        for (int e = 0; e < 16; ++e) {
            const int ch = e < 8 ? cA + e : cB + e - 8;
            const float bi = bc[ti * 132 + ch], rI = I ? bc[(16 * I - 1) * 132 + ch] : 0.f, bl = bc[63 * 132 + ch];
            qhat[e] = qt[e] * __expf(bi - rI); qt[e] = qt[e] * __expf(bi);
            kT[ch * 72 + ti] = (bf16_t)f2bf(bf2f(kraw[ti * 136 + ch]) * __expf(bl - bi));
        }
        *(LAS u32x4*)(qh + ti * 136 + cA) = pack8(qhat); *(LAS u32x4*)(qh + ti * 136 + cB) = pack8(qhat + 8);
        bf16_t* lqp = p.lq + item * 8192 + ti * 128;
        *(u32x4*)(lqp + cA) = pack8(qt); *(u32x4*)(lqp + cB) = pack8(qt + 8);
    }
    if (tid < 128) p.ld[item * 128 + tid] = __expf(bc[63 * 132 + tid]);
    for (int I = 0; I < 4; ++I) {
        if (ti < 16 * (I + 1)) {
            float kk[16];
#pragma unroll
            for (int e = 0; e < 16; ++e) {
                const int ch = e < 8 ? cA + e : cB + e - 8;
                const float rI = I ? bc[(16 * I - 1) * 132 + ch] : 0.f, bj = bc[ti * 132 + ch];
                kk[e] = bf2f(kraw[ti * 136 + ch]) * __expf(fminf(rI - bj, 80.f));
            }
            *(LAS u32x4*)(kh + ti * 136 + cA) = pack8(kk); *(LAS u32x4*)(kh + ti * 136 + cB) = pack8(kk + 8);
        }
        __syncthreads();
        if (wid < 4) {
            const int J = wid;
            u32x2 outv; outv[0] = 0u; outv[1] = 0u;
            if (J <= I) {
                f32x4 acc = (f32x4){0.f, 0.f, 0.f, 0.f};
#pragma unroll
                for (int ks = 0; ks < 4; ++ks)
                    acc = mfma16(*(const LAS bf16x8*)(kh + (J * 16 + fr) * 136 + ks * 32 + fq * 8), *(const LAS bf16x8*)(qh + (I * 16 + fr) * 136 + ks * 32 + fq * 8), acc);
                const int i = 16 * I + fr, j0 = 16 * J + 4 * fq;
#pragma unroll
                for (int r = 0; r < 4; ++r) if (j0 + r > i) acc[r] = 0.f;
                outv = pack4(acc);
            }
            *(LAS u32x2*)(sc + (I * 16 + fr) * 72 + J * 16 + 4 * fq) = outv;
        }
        __syncthreads();
    }
    {
        bf16x8 xv[2], xk[2];
#pragma unroll
        for (int ks = 0; ks < 2; ++ks) { xv[ks] = *(const LAS bf16x8*)(vT + (wid * 16 + fr) * 72 + ks * 32 + fq * 8); xk[ks] = *(const LAS bf16x8*)(kT + (wid * 16 + fr) * 72 + ks * 32 + fq * 8); }
#pragma unroll
        for (int ib = 0; ib < 4; ++ib) {
            f32x4 acc = (f32x4){0.f, 0.f, 0.f, 0.f};
#pragma unroll
            for (int ks = 0; ks < 2; ++ks) acc = mfma16(xv[ks], *(const LAS bf16x8*)(sc + (ib * 16 + fr) * 72 + ks * 32 + fq * 8), acc);
            *(u32x2*)(p.lo + item * 8192 + (ib * 16 + fr) * 128 + wid * 16 + 4 * fq) = pack4(acc);
        }
#pragma unroll
        for (int dvb = 0; dvb < 8; ++dvb) {
            f32x4 acc = (f32x4){0.f, 0.f, 0.f, 0.f};
#pragma unroll
            for (int ks = 0; ks < 2; ++ks) acc = mfma16(xk[ks], *(const LAS bf16x8*)(vT + (dvb * 16 + fr) * 72 + ks * 32 + fq * 8), acc);
            *(u32x2*)(p.lb + item * 16384 + (dvb * 16 + fr) * 128 + wid * 16 + 4 * fq) = pack4(acc);
        }
    }
    __syncthreads();
}


template <int I> struct SolveRows {
    static __device__ __forceinline__ void run(float (&x)[64], const LAS float* Mf, const LAS float* rs) {
        SolveRows<I - 1>::run(x, Mf, rs);
        float r = x[I] * rs[I];
#pragma unroll
        for (int j4 = 0; j4 < (I + 3) / 4; ++j4) {
            const f32x4 m = *(const LAS f32x4*)(Mf + I * 68 + j4 * 4);
            r -= m[0] * x[j4 * 4] + m[1] * x[j4 * 4 + 1] + m[2] * x[j4 * 4 + 2] + m[3] * x[j4 * 4 + 3];
        }
        asm volatile("" : "+v"(r) :: "memory");
        x[I] = r;
    }
};
template <> struct SolveRows<-1> { static __device__ __forceinline__ void run(float (&)[64], const LAS float*, const LAS float*) {} };

__device__ __forceinline__ void local_gdn(const Params& p, int l, int chain, int n, LAS unsigned char* lds) {
    const int tid = opaque_tid(), wid = tid >> 6, lane = tid & 63, fr = lane & 15, fq = lane >> 4;
    const int b = chain >> 3, h = (chain >> 1) & 3, d = chain & 1;
    const int base = chunk_base(b, d, n);
    const size_t item = (size_t)chain * NCHUNK + n;
    LAS bf16_t* ks_ = (LAS bf16_t*)lds;
    LAS bf16_t* qs = ks_ + 64 * 136;
    LAS bf16_t* att = qs + 64 * 136;
    LAS bf16_t* wT = att + 64 * 72;
    LAS bf16_t* uT = wT + 128 * 72;
    LAS bf16_t* kT = uT + 128 * 72;
    LAS float* Mf = (LAS float*)(kT + 128 * 72);
    LAS float* bcs = Mf + 64 * 68;
    LAS float* bts = bcs + 64;
    LAS float* rse = bts + 64;
    LAS bf16_t* vs = (LAS bf16_t*)(rse + 64);
    const int ti = tid >> 3, d0 = (tid & 7) * 16;
    const int tokI = base + (d ? 63 - ti : ti);
    {
        int t, T, sbase; tok_info(tokI, t, T, sbase);
#pragma unroll
        for (int part = 0; part < 3; ++part) {
            float a[16];
#pragma unroll
            for (int e = 0; e < 16; ++e) a[e] = 0.f;
            const int ccol = part * 512 + h * 128 + d0;
#pragma unroll
            for (int j = 0; j < 4; ++j) {
                const int tt = t + j - 2;
                if (tt >= 0 && tt < T) {
                    const bf16_t* xp = p.P + (size_t)(sbase + tt) * NP + C_GQKV + ccol;
                    const u32x4 x0 = *(const u32x4*)xp, x1 = *(const u32x4*)(xp + 8);
                    const float* wp = p.gdn_conv_w + (size_t)(l * 4 + j) * 1536 + ccol;
#pragma unroll
                    for (int q = 0; q < 4; ++q) {
                        const float4 w0 = *(const float4*)(wp + q * 4);
                        const unsigned ua = q < 2 ? x0[2 * q] : x1[2 * q - 4], ub = q < 2 ? x0[2 * q + 1] : x1[2 * q - 3];
                        a[q * 4] += w0.x * bflo(ua); a[q * 4 + 1] += w0.y * bfhi(ua); a[q * 4 + 2] += w0.z * bflo(ub); a[q * 4 + 3] += w0.w * bfhi(ub);
                    }
                }
            }
            float ss = 0.f;
#pragma unroll
            for (int e = 0; e < 16; ++e) { a[e] = siluf_(a[e]); ss += a[e] * a[e]; }
            if (part < 2) {
                ss += __shfl_xor(ss, 1); ss += __shfl_xor(ss, 2); ss += __shfl_xor(ss, 4);
                const float scl = rsqrtf(ss + 1e-6f) * (part == 0 ? 0.08838834764831845f : 1.0f);
#pragma unroll
                for (int e = 0; e < 16; ++e) a[e] *= scl;
            }
            LAS bf16_t* dstt = (part == 0 ? qs : part == 1 ? ks_ : vs) + ti * 136 + d0;
            *(LAS u32x4*)dstt = pack8(a); *(LAS u32x4*)(dstt + 8) = pack8(a + 8);
        }
    }
    if (wid == 0) {
        const int tok = base + (d ? 63 - lane : lane);
        const float av = bf2f(p.P[(size_t)tok * NP + C_GA + d * 4 + h]);
        float v = -__expf(p.gdn_a_log[l * 8 + d * 4 + h]) * softplusf_(av + p.gdn_dt_bias[l * 8 + d * 4 + h]);
#pragma unroll
        for (int off = 1; off < 64; off <<= 1) { const float t = __shfl_up(v, off); if (lane >= off) v += t; }
        const float btv = sigmoidf_(bf2f(p.P[(size_t)tok * NP + C_GB + d * 4 + h]));
        bcs[lane] = v; bts[lane] = btv; rse[lane] = btv * __expf(v);
    }
    __syncthreads();
#pragma unroll
    for (int e = 0; e < 2; ++e) {
        const int f = wid * 2 + e, ib = f >> 2, jb = f & 3;
        const int i = 16 * ib + fr, j0 = 16 * jb + 4 * fq;
        f32x4 mk = (f32x4){0.f, 0.f, 0.f, 0.f}, mq = (f32x4){0.f, 0.f, 0.f, 0.f};
        if (jb <= ib) {
#pragma unroll
            for (int ks = 0; ks < 4; ++ks) {
                const bf16x8 xk = *(const LAS bf16x8*)(ks_ + (jb * 16 + fr) * 136 + ks * 32 + fq * 8);
                mk = mfma16(xk, *(const LAS bf16x8*)(ks_ + (ib * 16 + fr) * 136 + ks * 32 + fq * 8), mk);
                mq = mfma16(xk, *(const LAS bf16x8*)(qs + (ib * 16 + fr) * 136 + ks * 32 + fq * 8), mq);
            }
            const float bi = bcs[i], bti = bts[i];
#pragma unroll
            for (int r = 0; r < 4; ++r) {
                const int j = j0 + r;
                const float dec = __expf(j <= i ? bi - bcs[j] : 0.f);
                mk[r] = (j < i) ? bti * mk[r] * dec : 0.f;
                mq[r] = (j <= i) ? mq[r] * dec : 0.f;
            }
        }
        *(LAS f32x4*)(Mf + i * 68 + j0) = mk;
        *(LAS u32x2*)(att + i * 72 + j0) = pack4(mq);
    }
    __syncthreads();
    {
        const float sc_ = __expf(bcs[63] - bcs[ti]);
#pragma unroll
        for (int e = 0; e < 16; ++e) kT[(d0 + e) * 72 + ti] = (bf16_t)f2bf(bf2f(ks_[ti * 136 + d0 + e]) * sc_);
    }
    if (tid < 256) {
        const int cidx = tid & 127;
        const bool isw = tid >= 128;
        const LAS bf16_t* srcp = (isw ? ks_ : vs) + cidx;
        float x[64];
#pragma unroll
        for (int i = 0; i < 64; ++i) x[i] = bf2f(srcp[i * 136]);
        {
            unsigned mb = (unsigned)(size_t)Mf, rb = (unsigned)(size_t)(isw ? rse : bts);
            asm volatile("" : "+v"(mb), "+v"(rb));
            SolveRows<63>::run(x, (const LAS float*)(size_t)mb, (const LAS float*)(size_t)rb);
        }
        if (isw) {
#pragma unroll
            for (int i = 0; i < 64; ++i) x[i] = -x[i];
        }
        LAS bf16_t* dst = (isw ? wT : uT) + cidx * 72;
#pragma unroll
        for (int q = 0; q < 8; ++q) *(LAS u32x4*)(dst + q * 8) = pack8(x + q * 8);
    }
    if (tid < 128) p.ld[item * 128 + tid] = __expf(bcs[63]);
    __syncthreads();
    {
        const int tid = opaque_tid(), wid = tid >> 6, lane = tid & 63, fr = lane & 15, fq = lane >> 4;
        bf16x8 xw[2], xu[2], xk[2];
#pragma unroll
        for (int ks = 0; ks < 2; ++ks) {
            xw[ks] = *(const LAS bf16x8*)(wT + (wid * 16 + fr) * 72 + ks * 32 + fq * 8);
            xu[ks] = *(const LAS bf16x8*)(uT + (wid * 16 + fr) * 72 + ks * 32 + fq * 8);
            xk[ks] = *(const LAS bf16x8*)(kT + (wid * 16 + fr) * 72 + ks * 32 + fq * 8);
        }
#pragma unroll
        for (int ib = 0; ib < 4; ++ib) {
            const int i = ib * 16 + fr;
            const u32x2 qr = *(const LAS u32x2*)(qs + i * 136 + wid * 16 + 4 * fq);
            const float eb = __expf(bcs[i]);
            f32x4 aq = (f32x4){bflo(qr[0]) * eb, bfhi(qr[0]) * eb, bflo(qr[1]) * eb, bfhi(qr[1]) * eb};
            f32x4 ao = (f32x4){0.f, 0.f, 0.f, 0.f};
#pragma unroll
            for (int ks = 0; ks < 2; ++ks) {
                const bf16x8 ya = *(const LAS bf16x8*)(att + i * 72 + ks * 32 + fq * 8);
                aq = mfma16(xw[ks], ya, aq); ao = mfma16(xu[ks], ya, ao);
            }
            *(u32x2*)(p.lq + item * 8192 + i * 128 + wid * 16 + 4 * fq) = pack4(aq);
            *(u32x2*)(p.lo + item * 8192 + i * 128 + wid * 16 + 4 * fq) = pack4(ao);
        }
#pragma unroll
        for (int db = 0; db < 8; ++db) {
            f32x4 aa = (f32x4){0.f, 0.f, 0.f, 0.f}, ab = (f32x4){0.f, 0.f, 0.f, 0.f};
#pragma unroll
            for (int ks = 0; ks < 2; ++ks) {
                aa = mfma16(xw[ks], *(const LAS bf16x8*)(kT + (db * 16 + fr) * 72 + ks * 32 + fq * 8), aa);
                ab = mfma16(xk[ks], *(const LAS bf16x8*)(uT + (db * 16 + fr) * 72 + ks * 32 + fq * 8), ab);
            }
            *(u32x2*)(p.la + item * 16384 + (db * 16 + fr) * 128 + wid * 16 + 4 * fq) = pack4(aa);
            *(u32x2*)(p.lb + item * 16384 + (db * 16 + fr) * 128 + wid * 16 + 4 * fq) = pack4(ab);
        }
    }
    __syncthreads();
}

__device__ __forceinline__ void ph_local(const Params& p, int l, LAS unsigned char* lds) {
    for (int it = blockIdx.x; it < 3 * NITEM; it += gridDim.x) {
        const int tz = it % 3, ci = it / 3, chain = ci / NCHUNK, n = ci % NCHUNK;
        if (tz == 0) local_gdn(p, l, chain, n, lds); else local_gla(p, l, tz, chain, n, lds);
    }
}

__device__ __forceinline__ void seq_matrix(const Params& p, int tz, int chain, int half, LAS unsigned char* lds) {
    const int tid = opaque_tid(), wid = tid >> 6, lane = tid & 63, fr = lane & 15, fq = lane >> 4;
    const int b = chain >> 3, h = (chain >> 1) & 3, d = chain & 1;
    LAS bf16_t* ST = (LAS bf16_t*)lds;
    float* Op = p.O + (size_t)((tz == 0 ? 0 : tz == 1 ? 1 : 3) * 2 + d) * TOKW;
    f32x4 S[4];
#pragma unroll
    for (int q = 0; q < 4; ++q) S[q] = (f32x4){0.f, 0.f, 0.f, 0.f};
    const int ib = wid >> 1, dv2 = (wid & 1) * 2;
    for (int n = 0; n < NCHUNK; ++n) {
        const size_t item = (size_t)tz * NITEM + (size_t)chain * NCHUNK + n;
        bf16x8 yq[4], xa[4];
#pragma unroll
        for (int ks = 0; ks < 4; ++ks) yq[ks] = *(const bf16x8*)(p.lq + item * 8192 + (ib * 16 + fr) * 128 + ks * 32 + fq * 8);
        if (tz == 0) {
#pragma unroll
            for (int ks = 0; ks < 4; ++ks) xa[ks] = *(const bf16x8*)(p.la + ((size_t)chain * NCHUNK + n) * 16384 + (wid * 16 + fr) * 128 + ks * 32 + fq * 8);
        }
        u32x2 oin[2], bin[4];
#pragma unroll
        for (int e = 0; e < 2; ++e) oin[e] = *(const u32x2*)(p.lo + item * 8192 + (ib * 16 + fr) * 128 + half * 64 + (dv2 + e) * 16 + 4 * fq);
#pragma unroll
        for (int q = 0; q < 4; ++q) bin[q] = *(const u32x2*)(p.lb + item * 16384 + (half * 64 + q * 16 + fr) * 128 + wid * 16 + 4 * fq);
        const f32x4 dec = *(const f32x4*)(p.ld + item * 128 + wid * 16 + 4 * fq);
        LAS bf16_t* st = ST + (n & 1) * 64 * 136;
#pragma unroll
        for (int q = 0; q < 4; ++q) *(LAS u32x2*)(st + (q * 16 + fr) * 136 + wid * 16 + 4 * fq) = pack4(S[q]);
        __syncthreads();
        const int base = chunk_base(b, d, n);
        const int tok = base + (d ? 63 - (ib * 16 + fr) : ib * 16 + fr);
#pragma unroll
        for (int e = 0; e < 2; ++e) {
            f32x4 acc = (f32x4){bflo(oin[e][0]), bfhi(oin[e][0]), bflo(oin[e][1]), bfhi(oin[e][1])};
#pragma unroll
            for (int ks = 0; ks < 4; ++ks) acc = mfma16(*(const LAS bf16x8*)(st + ((dv2 + e) * 16 + fr) * 136 + ks * 32 + fq * 8), yq[ks], acc);
            *(f32x4*)(Op + (size_t)tok * MW + h * 128 + half * 64 + (dv2 + e) * 16 + 4 * fq) = acc;
        }
#pragma unroll
        for (int q = 0; q < 4; ++q) {
            f32x4 acc = (f32x4){dec[0] * S[q][0] + bflo(bin[q][0]), dec[1] * S[q][1] + bfhi(bin[q][0]), dec[2] * S[q][2] + bflo(bin[q][1]), dec[3] * S[q][3] + bfhi(bin[q][1])};
            if (tz == 0) {
#pragma unroll
                for (int ks = 0; ks < 4; ++ks) acc = mfma16(xa[ks], *(const LAS bf16x8*)(st + (q * 16 + fr) * 136 + ks * 32 + fq * 8), acc);
            }
            S[q] = acc;
        }
    }
    __syncthreads();
}

__device__ __forceinline__ void seq_lru(const Params& p, int b, int d, int cg, LAS unsigned char* lds) {
    const int tid = opaque_tid(), seg = tid >> 6, ch = cg * 64 + (tid & 63);
    LAS float* sP = (LAS float*)lds;
    LAS float* sL = sP + 512;
    const float* A = p.prep + (size_t)(PR_LA + d) * TOKW + ch; const float* U = p.prep + (size_t)(PR_LU + d) * TOKW + ch;
    float* Op = p.O + (size_t)(2 * 2 + d) * TOKW + ch;
    constexpr int SEG = (TC + TL) / 8;
    auto tok_of = [&](int pos) { return pos < TC ? NLAT + b * TC + (d ? TC - 1 - pos : pos) : b * TL + (d ? TL - 1 - (pos - TC) : pos - TC); };
    float P = 1.f, L = 0.f;
    for (int i0 = 0; i0 < SEG; i0 += 8) {
        float av[8], uv[8];
#pragma unroll
        for (int q = 0; q < 8; ++q) { const size_t o = (size_t)tok_of(seg * SEG + i0 + q) * MW; av[q] = A[o]; uv[q] = U[o]; }
#pragma unroll
        for (int q = 0; q < 8; ++q) { L = av[q] * L + uv[q]; P *= av[q]; }
    }
    sP[tid] = P; sL[tid] = L;
    __syncthreads();
    float hst = 0.f;
    for (int s = 0; s < seg; ++s) hst = sP[s * 64 + (tid & 63)] * hst + sL[s * 64 + (tid & 63)];
    for (int i0 = 0; i0 < SEG; i0 += 8) {
        float av[8], uv[8]; size_t oo[8];
#pragma unroll
        for (int q = 0; q < 8; ++q) { oo[q] = (size_t)tok_of(seg * SEG + i0 + q) * MW; av[q] = A[oo[q]]; uv[q] = U[oo[q]]; }
#pragma unroll
        for (int q = 0; q < 8; ++q) { hst = av[q] * hst + uv[q]; Op[oo[q]] = hst; }
    }
    __syncthreads();
}

__device__ __forceinline__ void ph_seq(const Params& p, LAS unsigned char* lds) {
    for (int it = blockIdx.x; it < 256; it += gridDim.x) {
        if (it < 192) { const int tz = it >> 6, r = it & 63; seq_matrix(p, tz, r >> 1, r & 1, lds); }
        else { const int r = it - 192; seq_lru(p, r >> 4, (r >> 3) & 1, r & 7, lds); }
    }
}

__device__ __forceinline__ void ph_merge(const Params& p, int l, int M) {
    const int tid = opaque_tid(), wid = tid >> 6, lane = tid & 63;
    for (int id = blockIdx.x * NWAVES + wid; id < M * 16; id += gridDim.x * NWAVES) {
        const int tok = id >> 4, r = id & 15, m = r >> 2, head = r & 3;
        const int cidx = head * 128 + lane * 2;
        const size_t o = (size_t)tok * MW + cidx;
        const f32x2 o0 = *(const f32x2*)(p.O + (size_t)(m * 2) * TOKW + o), o1 = *(const f32x2*)(p.O + (size_t)(m * 2 + 1) * TOKW + o);
        const float a0 = o0[0] + o1[0], a1 = o0[1] + o1[1];
        float y0, y1; int nbr;
        if (m == 2) {
            const unsigned u = *(const unsigned*)(p.P + (size_t)tok * NP + C_LY + cidx);
            y0 = a0 * gelu_tanhf_(bflo(u)); y1 = a1 * gelu_tanhf_(bfhi(u)); nbr = 2;
        } else {
            const float ss = wave_sum(a0 * a0 + a1 * a1);
            const float rinv = rsqrtf(ss * (1.0f / 128.0f) + 1e-6f);
            const float* gp = (m == 0 ? p.gdn_norm_g : m == 1 ? p.hgrn_norm_g : p.ret_norm_g) + l * 128 + lane * 2;
            const int zc = m == 0 ? C_GZ : m == 1 ? C_HG : C_RG;
            const unsigned u = *(const unsigned*)(p.P + (size_t)tok * NP + zc + cidx);
            y0 = a0 * rinv * gp[0] * siluf_(bflo(u)); y1 = a1 * rinv * gp[1] * siluf_(bfhi(u)); nbr = m == 3 ? 3 : m;
        }
        *(unsigned*)(p.Y + (size_t)nbr * TOKW + o) = pack2(y0, y1);
    }
}

__device__ __forceinline__ void ph_g2(const Params& p, int l, int M, LAS unsigned char* lds) {
    const StageRC s = my_stage_rc();
    const int tid = opaque_tid(), wid = tid >> 6, lane = tid & 63, wr = wid >> 1, wc = wid & 1, fr = lane & 15, fq = lane >> 4;
    const int ntm = M / 256;
    for (int u = blockIdx.x; u < ntm * 8; u += gridDim.x) {
        const int pm = u >> 3, pn = u & 7;
        f32x4 acc[4][4]; gm::zero_acc(acc);
        for (int nb = 0; nb < 4; ++nb) {
            const bf16_t* a0 = p.Y + (size_t)nb * TOKW + (size_t)(pm * 256) * MW;
            const bf16_t* Bt = p.wbT + (size_t)(l * 4 + nb) * D * MW + (size_t)(pn * 128) * MW;
            gm::kloop(lds, a0 + (size_t)s.R0 * MW + s.C0, a0 + (size_t)s.R1 * MW + s.C1, a0 + (size_t)(128 + s.R0) * MW + s.C0, a0 + (size_t)(128 + s.R1) * MW + s.C1,
                      Bt + (size_t)s.R0 * MW + s.C0, Bt + (size_t)s.R1 * MW + s.C1, MW, acc);
#pragma unroll
            for (int m = 0; m < 4; ++m)
#pragma unroll
                for (int n = 0; n < 4; ++n) {
                    const int row = pm * 256 + wr * 64 + m * 16 + fr, col = pn * 128 + wc * 64 + n * 16 + fq * 4;
                    const bf16_t* gp = p.P + (size_t)row * NP + C_MG + nb * D + col;
                    const u32x2 gu = *(const u32x2*)gp;
                    const float e0 = __expf(-bflo(gu[0])), e1 = __expf(-bfhi(gu[0])), e2 = __expf(-bflo(gu[1])), e3 = __expf(-bfhi(gu[1]));
                    float n0 = 1.f, n1 = 1.f, n2 = 1.f, n3 = 1.f;
                    if (nb < 3) { const u32x2 gn = *(const u32x2*)(gp + D);
                        n0 = 1.f + __expf(-bflo(gn[0])); n1 = 1.f + __expf(-bfhi(gn[0])); n2 = 1.f + __expf(-bflo(gn[1])); n3 = 1.f + __expf(-bfhi(gn[1])); }
                    acc[m][n][0] *= n0 / (1.f + e0); acc[m][n][1] *= n1 / (1.f + e1); acc[m][n][2] *= n2 / (1.f + e2); acc[m][n][3] *= n3 / (1.f + e3);
                }
        }
#pragma unroll
        for (int m = 0; m < 4; ++m)
#pragma unroll
            for (int n = 0; n < 4; ++n) {
                const int row = pm * 256 + wr * 64 + m * 16 + fr, col = pn * 128 + wc * 64 + n * 16 + fq * 4;
                u32x2 o; o[0] = pack2(acc[m][n][0], acc[m][n][1]); o[1] = pack2(acc[m][n][2], acc[m][n][3]);
                *(u32x2*)(p.mix + (size_t)row * D + col) = o;
            }
    }
}

template <bool DRY = false> __device__ __forceinline__ void ph_g3(const Params& p, int l, int M, LAS unsigned char* lds) {
    const StageRC s = my_stage_rc();
    const int tid = opaque_tid(), wid = tid >> 6, lane = tid & 63, wr = wid >> 1, wc = wid & 1, fr = lane & 15, fq = lane >> 4;
    const int ntm = M / 256;
    for (int u = blockIdx.x; u < ntm * 8; u += gridDim.x) {
        const int pm = u >> 3, pn = u & 7;
        const bf16_t* a0 = p.mix + (size_t)(pm * 256) * D;
        const bf16_t* Bt = p.woutT + (size_t)l * D * D + (size_t)(pn * 128) * D;
        f32x4 acc[4][4]; gm::zero_acc(acc);
        gm::kloop(lds, a0 + (size_t)s.R0 * D + s.C0, a0 + (size_t)s.R1 * D + s.C1, a0 + (size_t)(128 + s.R0) * D + s.C0, a0 + (size_t)(128 + s.R1) * D + s.C1,
                  Bt + (size_t)s.R0 * D + s.C0, Bt + (size_t)s.R1 * D + s.C1, D, acc);
#pragma unroll
        for (int m = 0; m < 4; ++m)
#pragma unroll
            for (int n = 0; n < 4; ++n) {
                const int row = pm * 256 + wr * 64 + m * 16 + fr, col = pn * 128 + wc * 64 + n * 16 + fq * 4;
                const float4 gt = *(const float4*)(p.mod + (size_t)(l * 5 + tok_modrow(row)) * (NMOD * D) + 2 * D + col);
                float4* xp = (float4*)(p.xl + (size_t)row * D + col);
                float4 xv = *xp;
                if (DRY) xp = (float4*)(p.prep + (size_t)row * D + col);
                xv.x += gt.x * acc[m][n][0]; xv.y += gt.y * acc[m][n][1]; xv.z += gt.z * acc[m][n][2]; xv.w += gt.w * acc[m][n][3];
                *xp = xv;
            }
    }
}

template <bool DRY = false> __device__ __forceinline__ void ph_route(const Params& p, int l, int M, LAS unsigned char* lds) {
    int* const r_cnt = DRY ? p.cnt + 64 : p.cnt; int* const r_list = DRY ? (int*)p.act : p.list; int* const r_ts = DRY ? (int*)p.yp : p.tokslot; float* const r_tw = DRY ? (float*)p.yp + (size_t)NTOK * 4 : p.topw;
    LAS float* fs = (LAS float*)lds;
    LAS float* lg = fs + 32 * 1028;
    const int tid = opaque_tid(), wid = tid >> 6, lane = tid & 63;
    const float* rw = p.router_w + (size_t)l * D * NE;
    for (int it = blockIdx.x; it < M / 32; it += gridDim.x) {
        const int tok0 = it * 32;
        for (int q = 0; q < 4; ++q) {
            const int tl = wid * 4 + q, tok = tok0 + tl;
            const float* src = p.xl + (size_t)tok * D;
            float4 v[4]; float ss = 0.f;
#pragma unroll
            for (int i = 0; i < 4; ++i) { v[i] = *(const float4*)(src + i * 256 + lane * 4); ss += v[i].x * v[i].x + v[i].y * v[i].y + v[i].z * v[i].z + v[i].w * v[i].w; }
            ss = wave_sum(ss);
            const float rinv = rsqrtf(ss * (1.0f / D) + 1e-6f);
            const float* mb = p.mod + (size_t)(l * 5 + tok_modrow(tok)) * (NMOD * D);
#pragma unroll
            for (int i = 0; i < 4; ++i) {
                const int cidx = i * 256 + lane * 4;
                const float4 gv = *(const float4*)(p.norm2_g + l * D + cidx), sv = *(const float4*)(mb + 4 * D + cidx), hv = *(const float4*)(mb + 3 * D + cidx);
                const float h0 = v[i].x * rinv * gv.x * (1.f + sv.x) + hv.x, h1 = v[i].y * rinv * gv.y * (1.f + sv.y) + hv.y;
                const float h2 = v[i].z * rinv * gv.z * (1.f + sv.z) + hv.z, h3 = v[i].w * rinv * gv.w * (1.f + sv.w) + hv.w;
                u32x2 o; o[0] = pack2(h0, h1); o[1] = pack2(h2, h3);
                *(u32x2*)(p.F + (size_t)tok * D + cidx) = o;
                *(LAS f32x4*)(fs + tl * 1028 + cidx) = (f32x4){h0, h1, h2, h3};
            }
        }
        __syncthreads();
        {
            typedef float f32x16 __attribute__((ext_vector_type(16)));
            f32x16 acc;
#pragma unroll
            for (int r = 0; r < 16; ++r) acc[r] = 0.f;
            const int tk = lane & 31, hh = lane >> 5;
            const LAS float* ap = fs + tk * 1028 + wid * 128 + 4 * hh;
            const float* bp = rw + (size_t)(wid * 128 + 4 * hh) * NE + tk;
#pragma unroll 4
            for (int kk = 0; kk < 16; ++kk) {
                const f32x4 a4 = *(const LAS f32x4*)(ap + kk * 8);
                const float b0 = bp[(kk * 8 + 0) * NE], b1 = bp[(kk * 8 + 1) * NE], b2 = bp[(kk * 8 + 2) * NE], b3 = bp[(kk * 8 + 3) * NE];
                acc = __builtin_amdgcn_mfma_f32_32x32x2f32(a4[0], b0, acc, 0, 0, 0);
                acc = __builtin_amdgcn_mfma_f32_32x32x2f32(a4[1], b1, acc, 0, 0, 0);
                acc = __builtin_amdgcn_mfma_f32_32x32x2f32(a4[2], b2, acc, 0, 0, 0);
                acc = __builtin_amdgcn_mfma_f32_32x32x2f32(a4[3], b3, acc, 0, 0, 0);
            }
            __syncthreads();
            LAS float* red = fs;
#pragma unroll
            for (int r = 0; r < 16; ++r) red[(wid * 32 + (r & 3) + 8 * (r >> 2) + 4 * hh) * 33 + tk] = acc[r];
            __syncthreads();
            const int t2 = tid >> 4, e0 = (tid & 15) * 2;
            float s0 = p.router_b[l * NE + e0], s1 = p.router_b[l * NE + e0 + 1];
#pragma unroll
            for (int w = 0; w < 8; ++w) { s0 += red[(w * 32 + t2) * 33 + e0]; s1 += red[(w * 32 + t2) * 33 + e0 + 1]; }
            lg[t2 * 33 + e0] = s0; lg[t2 * 33 + e0 + 1] = s1;
        }
        __syncthreads();
        if (tid < 32) {
            const int tok = tok0 + tid;
            float vals[4]; int idxs[4]; unsigned used = 0u;
#pragma unroll
            for (int k = 0; k < 4; ++k) {
                float best = -3.0e38f; int bi = 0;
                for (int e = 0; e < NE; ++e) { const float v = lg[tid * 33 + e]; if (!((used >> e) & 1u) && v > best) { best = v; bi = e; } }
                used |= 1u << bi; vals[k] = best; idxs[k] = bi;
            }
            const float mx = vals[0];
            float ex[4], sum = 0.f;
#pragma unroll
            for (int k = 0; k < 4; ++k) { ex[k] = __expf(vals[k] - mx); sum += ex[k]; }
            const float inv = 1.0f / sum;
#pragma unroll
            for (int k = 0; k < 4; ++k) {
                const int e = idxs[k];
                const int slot = atomicAdd(r_cnt + l * NE + e, 1);
                r_list[(size_t)e * NTOK + slot] = tok;
                r_ts[(size_t)tok * 4 + k] = (e << 16) | slot;
                r_tw[(size_t)tok * 4 + k] = ex[k] * inv;
            }
        }
        __syncthreads();
    }
}

__device__ __forceinline__ void build_expert_tables(const Params& p, int l, LAS int* ts, LAS int* cn, LAS int* te) {
    const int tid = opaque_tid();
    if (tid < 64) {
        const int c = tid < NE ? p.cnt[l * NE + tid] : 0;
        const int nt = (c + 255) >> 8;
        int v = nt;
#pragma unroll
        for (int off = 1; off < 32; off <<= 1) { const int t = __shfl_up(v, off); if (tid >= off) v += t; }
        if (tid < NE) { cn[tid] = c; ts[tid] = v - nt; if (tid == NE - 1) ts[NE] = v; }
        if (te && tid < NE) for (int q = 0; q < nt; ++q) te[v - nt + q] = tid;
    }
    __syncthreads();
}

struct MoeSched {
    const LAS int* ts; const LAS int* cn; const LAS int* te; const int* list; const bf16_t* A; const bf16_t* Bt; const float* bias; int K, npn, nunits, G, c, nrowsB, nbias; bool gather;
    static constexpr bool HAS_BIAS = true;
    __device__ __forceinline__ bool next(int i, g8::Unit& u) const {
        const long L = (long)i * G + c; if (L >= nunits) return false;
        u.pm = (int)(L / npn); u.pn = (int)(L % npn); u.e = te[u.pm]; return true;
    }
    __device__ __forceinline__ const char* a_base(const g8::Unit& u) const { return (const char*)(gather ? A : A + (size_t)u.pm * 256 * K); }
    __device__ __forceinline__ const char* b_base(const g8::Unit& u) const { return (const char*)(Bt + ((size_t)u.e * nrowsB + (size_t)u.pn * 256) * K); }
    __device__ __forceinline__ const int* row_addr(const g8::Unit& u, int R) const {
        const int cnt = cn[u.e], sl = (u.pm - ts[u.e]) * 256 + R;
        return list + (size_t)u.e * NTOK + (sl < cnt ? sl : 0);
    }
    __device__ __forceinline__ int rows_valid(const g8::Unit& u) const { return cn[u.e] - (u.pm - ts[u.e]) * 256; }
    __device__ __forceinline__ const float* bias_src(const g8::Unit& u, int lane) const {
        if (nbias == 2) return bias + (size_t)u.e * 2 * D + (lane < 32 ? u.pn * 128 + lane * 4 : D + u.pn * 128 + (lane - 32) * 4);
        return bias + (size_t)u.e * D + u.pn * 256 + lane * 4;
    }
};
struct EpiAct {
    bf16_t* O;
    __device__ __forceinline__ void operator()(const f32x4 (&acc)[2][2][4][2], const g8::Unit& u, int wr, int wc, int fr, int fq, const LAS float* bias) const {
        const int row0 = u.pm * 256 + wr * 64 + fr, col0 = u.pn * 128 + wc * 32 + 8 * fq;
        const LAS float* bb = bias + wc * 32 + 8 * fq;
        const f32x4 g0 = *(const LAS f32x4*)bb, g1 = *(const LAS f32x4*)(bb + 4), l0 = *(const LAS f32x4*)(bb + 128), l1 = *(const LAS f32x4*)(bb + 132);
        const float bg[8] = {g0[0], g0[1], g0[2], g0[3], g1[0], g1[1], g1[2], g1[3]}, bl[8] = {l0[0], l0[1], l0[2], l0[3], l1[0], l1[1], l1[2], l1[3]};
#pragma unroll
        for (int ai = 0; ai < 2; ++ai)
#pragma unroll
            for (int m = 0; m < 4; ++m) {
                float o[8];
#pragma unroll
                for (int n = 0; n < 2; ++n)
#pragma unroll
                    for (int j = 0; j < 4; ++j) {
                        const float glu = fminf(acc[ai][0][m][n][j] + bg[n * 4 + j], 7.0f);
                        const float lin = fminf(fmaxf(acc[ai][1][m][n][j] + bl[n * 4 + j], -7.0f), 7.0f);
                        o[n * 4 + j] = glu * sigmoidf_(1.702f * glu) * (lin + 1.0f);
                    }
                *(u32x4*)(O + (size_t)(row0 + ai * 128 + m * 16) * D + col0) = pack8(o);
            }
    }
};
__device__ __forceinline__ void ph_g4(const Params& p, int l, LAS unsigned char* lds) {
    LAS int* ts = (LAS int*)(lds + g8::STAGE_BYTES); LAS int* cn = ts + 40; LAS int* te = ts + 80;
    build_expert_tables(p, l, ts, cn, te);
    MoeSched S; S.ts = ts; S.cn = cn; S.te = te; S.list = p.list; S.A = p.F; S.Bt = p.w1T + (size_t)l * NE * 2 * D * D; S.bias = p.moe_b1 + (size_t)l * NE * 2 * D; S.nbias = 2;
    S.K = D; S.npn = 8; S.nunits = ts[NE] * 8; S.G = gridDim.x; S.c = blockIdx.x; S.nrowsB = 2 * D; S.gather = true;
    EpiAct E; E.O = p.act;
    g8::gemm_phase(lds, D, S, E);
}

struct EpiYp {
    bf16_t* O;
    __device__ __forceinline__ void operator()(const f32x4 (&acc)[2][2][4][2], const g8::Unit& u, int wr, int wc, int fr, int fq, const LAS float* bias) const {
        const int row0 = u.pm * 256 + wr * 64 + fr, col0 = u.pn * 256 + wc * 32 + 8 * fq;
#pragma unroll
        for (int bj = 0; bj < 2; ++bj) {
            const LAS float* bb = bias + bj * 128 + wc * 32 + 8 * fq;
            const f32x4 c0v = *(const LAS f32x4*)bb, c1v = *(const LAS f32x4*)(bb + 4);
            const float4 c0 = make_float4(c0v[0], c0v[1], c0v[2], c0v[3]), c1 = make_float4(c1v[0], c1v[1], c1v[2], c1v[3]);
#pragma unroll
            for (int ai = 0; ai < 2; ++ai)
#pragma unroll
                for (int m = 0; m < 4; ++m) {
                    u32x4 w; w[0] = pack2(acc[ai][bj][m][0][0] + c0.x, acc[ai][bj][m][0][1] + c0.y); w[1] = pack2(acc[ai][bj][m][0][2] + c0.z, acc[ai][bj][m][0][3] + c0.w);
                    w[2] = pack2(acc[ai][bj][m][1][0] + c1.x, acc[ai][bj][m][1][1] + c1.y); w[3] = pack2(acc[ai][bj][m][1][2] + c1.z, acc[ai][bj][m][1][3] + c1.w);
                    *(u32x4*)(O + (size_t)(row0 + ai * 128 + m * 16) * D + col0 + bj * 128) = w;
                }
        }
    }
};
__device__ __forceinline__ void ph_g5(const Params& p, int l, LAS unsigned char* lds) {
    LAS int* ts = (LAS int*)(lds + g8::STAGE_BYTES); LAS int* cn = ts + 40; LAS int* te = ts + 80;
    build_expert_tables(p, l, ts, cn, te);
    MoeSched S; S.ts = ts; S.cn = cn; S.te = te; S.list = p.list; S.A = p.act; S.Bt = p.w2T + (size_t)l * NE * D * D; S.bias = p.moe_b2 + (size_t)l * NE * D; S.nbias = 1;
    S.K = D; S.npn = 4; S.nunits = ts[NE] * 4; S.G = gridDim.x; S.c = blockIdx.x; S.nrowsB = D; S.gather = false;
    EpiYp E; E.O = p.yp;
    g8::gemm_phase(lds, D, S, E);
}

template <bool DRY = false> __device__ __forceinline__ void ph_combine(const Params& p, int l, int M, LAS unsigned char* lds) {
    float* const c_xl = DRY ? p.prep : p.xl; bf16_t* const c_H = DRY ? (bf16_t*)(p.prep + (size_t)NTOK * D) : p.H; float* const c_out = DRY ? p.prep : p.out;
    LAS int* ts = (LAS int*)lds; LAS int* cn = ts + 40;
    build_expert_tables(p, l, ts, cn, nullptr);
    const int tid = opaque_tid(), wid = tid >> 6, lane = tid & 63;
    const bool last = (l == 1);
    for (int tok = blockIdx.x * NWAVES + wid; tok < M; tok += gridDim.x * NWAVES) {
        float4 v[4];
        const float* mb = p.mod + (size_t)(l * 5 + tok_modrow(tok)) * (NMOD * D);
        int rows[4]; float wts[4];
#pragma unroll
        for (int k = 0; k < 4; ++k) { const int tsl = p.tokslot[(size_t)tok * 4 + k]; rows[k] = ts[tsl >> 16] * 256 + (tsl & 0xffff); wts[k] = p.topw[(size_t)tok * 4 + k]; }
        float ss = 0.f;
#pragma unroll
        for (int i = 0; i < 4; ++i) {
            const int cidx = i * 256 + lane * 4;
            float m0 = 0.f, m1 = 0.f, m2 = 0.f, m3 = 0.f;
#pragma unroll
            for (int k = 0; k < 4; ++k) {
                const u32x2 u = *(const u32x2*)(p.yp + (size_t)rows[k] * D + cidx);
                m0 += wts[k] * bflo(u[0]); m1 += wts[k] * bfhi(u[0]); m2 += wts[k] * bflo(u[1]); m3 += wts[k] * bfhi(u[1]);
            }
            const float4 gt = *(const float4*)(mb + 5 * D + cidx);
            float4 xv = *(const float4*)(p.xl + (size_t)tok * D + cidx);
            xv.x += gt.x * m0; xv.y += gt.y * m1; xv.z += gt.z * m2; xv.w += gt.w * m3;
            v[i] = xv; ss += xv.x * xv.x + xv.y * xv.y + xv.z * xv.z + xv.w * xv.w;
        }
        ss = wave_sum(ss);
        const float rinv = rsqrtf(ss * (1.0f / D) + 1e-6f);
        if (!last) {
#pragma unroll
            for (int i = 0; i < 4; ++i) *(float4*)(c_xl + (size_t)tok * D + i * 256 + lane * 4) = v[i];
            const float* mb1 = p.mod + (size_t)((l + 1) * 5 + tok_modrow(tok)) * (NMOD * D);
            norm_mod_store(v, rinv, p.norm1_g + (l + 1) * D, mb1 + 1 * D, mb1 + 0 * D, c_H + (size_t)tok * D, lane);
        } else {
#pragma unroll
            for (int i = 0; i < 4; ++i) {
                const int cidx = i * 256 + lane * 4;
                const float4 gv = *(const float4*)(p.final_norm_g + cidx);
                *(float4*)(c_out + (size_t)tok * D + cidx) = make_float4(v[i].x * rinv * gv.x, v[i].y * rinv * gv.y, v[i].z * rinv * gv.z, v[i].w * rinv * gv.w);
            }
        }
    }
}

#define XB_TMO      128
#define XB_XCNT(j)  (256  + 64 * (j))
#define XB_XSUB(j)  (1280 + 64 * (j))
#define XB_XGEN(j)  (2304 + 64 * (j))
#define XB_TOP      3328
#define XB_TOPGEN   3392
#define XCD_BAR_WORDS 3456
#define XB_SPIN_CAP (1u << 18)

__device__ __forceinline__ unsigned xb_ld(unsigned* p)              { return __hip_atomic_load(p, __ATOMIC_RELAXED, __HIP_MEMORY_SCOPE_AGENT); }
__device__ __forceinline__ unsigned xb_add(unsigned* p, unsigned v) { return __hip_atomic_fetch_add(p, v, __ATOMIC_RELAXED, __HIP_MEMORY_SCOPE_AGENT); }
__device__ __forceinline__ unsigned xb_xcc_id() { return (unsigned)__builtin_amdgcn_s_getreg((3 << 11) | 20) & 0xFu; }
#define XB_SPIN(cond, bar) do { unsigned _sp = 0; while (cond) { __builtin_amdgcn_s_sleep(1); \
    if ((++_sp & 255u) == 0u) { if (xb_ld(&(bar)[XB_TMO])) break; if (_sp > XB_SPIN_CAP) { atomicAdd(&(bar)[XB_TMO], 1u); break; } } } } while (0)

struct XcdBarrier {
    unsigned* bar; unsigned x;
    volatile LAS unsigned* st;
};

__device__ __forceinline__ XcdBarrier xcd_barrier_post(unsigned* bar, volatile LAS unsigned* st) {
    XcdBarrier b; b.bar = bar; b.x = xb_xcc_id(); b.st = st;
    if (threadIdx.x == 0) (void)xb_add(&bar[XB_XCNT(b.x)], 1u);
    return b;
}
__device__ __forceinline__ void xcd_barrier_complete(unsigned* bar, unsigned x, unsigned& nloc, unsigned& nx) {
    const unsigned G = gridDim.x * gridDim.y * gridDim.z;
    unsigned sum, cnt, mine, sp = 0u;
    for (;;) {
        sum = 0u; cnt = 0u; mine = 0u;
#pragma unroll
        for (unsigned j = 0; j < 16; ++j) { const unsigned c = xb_ld(&bar[XB_XCNT(j)]); sum += c; cnt += (c > 0u) ? 1u : 0u; mine = (j == x) ? c : mine; }
        if (sum == G) break;
        __builtin_amdgcn_s_sleep(1);
        if ((++sp & 255u) == 0u) { if (xb_ld(&bar[XB_TMO])) break; if (sp > XB_SPIN_CAP) { atomicAdd(&bar[XB_TMO], 1u); break; } }
    }
    nloc = mine > 0u ? mine : 1u; nx = cnt > 0u ? cnt : 1u;
}

__device__ __forceinline__ void xcd_barrier(const XcdBarrier& b) {
    asm volatile("s_waitcnt vmcnt(0)" ::: "memory");
    __syncthreads();
    if (threadIdx.x == 0) {
        unsigned* bar = b.bar;
        __builtin_amdgcn_s_waitcnt(0);
        unsigned nloc = b.st[0], nx = b.st[1];
        if (nloc == 0u) { xcd_barrier_complete(bar, b.x, nloc, nx); b.st[0] = nloc; b.st[1] = nx; }
        const unsigned old = xb_add(&bar[XB_XSUB(b.x)], 1u);
        const unsigned gen = old / nloc;
        if (old + 1u == (gen + 1u) * nloc) {
            __builtin_amdgcn_fence(__ATOMIC_RELEASE, "agent");
            asm volatile("s_waitcnt vmcnt(0)" ::: "memory");
            const unsigned og = xb_add(&bar[XB_TOP], 1u);
            const unsigned tg = og / nx;
            if (og + 1u == (tg + 1u) * nx) xb_add(&bar[XB_TOPGEN], 1u);
            else XB_SPIN(xb_ld(&bar[XB_TOPGEN]) == tg, bar);
            __builtin_amdgcn_fence(__ATOMIC_ACQUIRE, "agent");
            xb_add(&bar[XB_XGEN(b.x)], 1u);
            asm volatile("s_waitcnt vmcnt(0)" ::: "memory");
        } else {
            XB_SPIN(xb_ld(&bar[XB_XGEN(b.x)]) == gen, bar);
            __builtin_amdgcn_fence(__ATOMIC_ACQUIRE, "agent");
            asm volatile("s_waitcnt vmcnt(0)" ::: "memory");
        }
    }
    __syncthreads();
}


extern __shared__ __attribute__((aligned(16))) unsigned char dyn_lds[];
#define KPH(name, call) __global__ void __launch_bounds__(NTHREADS, 2) name(Params p, int l, int M) { LAS unsigned char* lds = (LAS unsigned char*)dyn_lds; (void)l; (void)M; (void)lds; call; }
KPH(k_convert, { ph_convert(p, lds); })
KPH(k_mod, { ph_mod(p, lds); })
KPH(k_norm1, { ph_norm1_first(p); })
KPH(k_g1, { ph_g1(p, l, lds); })
KPH(k_prep, { ph_prep(p, l, lds); })
KPH(k_local, { ph_local(p, l, lds); })
KPH(k_seq, { ph_seq(p, lds); })
KPH(k_merge, { ph_merge(p, l, M); })
KPH(k_g2, { ph_g2(p, l, M, lds); })
KPH(k_g3, { ph_g3(p, l, M, lds); })
KPH(k_route, { ph_route(p, l, M, lds); })
KPH(k_g4, { ph_g4(p, l, lds); })
KPH(k_g5, { ph_g5(p, l, lds); })
KPH(k_combine, { ph_combine(p, l, M, lds); })


__global__ void __launch_bounds__(NTHREADS, 2) k_mega(Params p) {
    LAS unsigned char* lds = (LAS unsigned char*)dyn_lds;
    volatile LAS unsigned* xb_words = (volatile LAS unsigned*)(lds + LDS_BYTES - 16);
    if (threadIdx.x == 0) { xb_words[0] = 0u; xb_words[1] = 0u; xb_words[2] = 0u; xb_words[3] = 0u; }
    __syncthreads();
    (void)xcd_barrier_post(p.bar, xb_words);
#define GRID_BARRIER() do { XcdBarrier b_; b_.bar = p.bar; b_.x = xb_xcc_id(); b_.st = xb_words; xcd_barrier(b_); } while (0)
#define RUNP(bit, stmt) do { stmt; if (PROBE & (1 << (bit))) { GRID_BARRIER(); stmt; } } while (0)
    RUNP(0, ph_convert(p, lds));
    RUNP(1, ph_mod(p, lds));
    GRID_BARRIER();
    RUNP(2, ph_norm1_first(p));
    GRID_BARRIER();
    for (int l = 0; l < 2; ++l) {
        const int M = l == 0 ? NTOK : NLAT;
        RUNP(3, ph_g1(p, l, lds));
        GRID_BARRIER();
        RUNP(4, ph_prep(p, l, lds));
        GRID_BARRIER();
        RUNP(5, ph_local(p, l, lds));
        GRID_BARRIER();
        RUNP(6, ph_seq(p, lds));
        GRID_BARRIER();
        RUNP(7, ph_merge(p, l, M));
        GRID_BARRIER();
        RUNP(8, ph_g2(p, l, M, lds));
        GRID_BARRIER();
        if (PROBE & (1 << 11)) { ph_g3<true>(p, l, M, lds); GRID_BARRIER(); }
        ph_g3(p, l, M, lds);
        GRID_BARRIER();
        if (PROBE & (1 << 12)) { ph_route<true>(p, l, M, lds); GRID_BARRIER(); }
        ph_route(p, l, M, lds);
        GRID_BARRIER();
        RUNP(9, ph_g4(p, l, lds));
        GRID_BARRIER();
        RUNP(10, ph_g5(p, l, lds));
        GRID_BARRIER();
        if (PROBE & (1 << 13)) { ph_combine<true>(p, l, M, lds); GRID_BARRIER(); }
        ph_combine(p, l, M, lds);
        if (l == 0) GRID_BARRIER();
    }
}

static inline size_t align_up(size_t v, size_t a) { return (v + a - 1) / a * a; }

extern "C" void kernel_launch(void* const* d_in, const int* in_sizes, int n_in, void* d_out, int out_size, void* d_ws, size_t ws_size, hipStream_t stream) {
    (void)in_sizes; (void)n_in; (void)out_size;
    Params p{};
    const float** pf = (const float**)&p;
    for (int i = 0; i < 32; ++i) pf[i] = (const float*)d_in[i];
    p.out = (float*)d_out;
    unsigned char* w = (unsigned char*)d_ws; size_t off = 0;
    auto take = [&](size_t bytes) { void* r = w + off; off = align_up(off + bytes, 256); return r; };
    p.bar = (unsigned*)take(16384);
    p.cnt = (int*)take(1024);
    const size_t ctl_bytes = off;
    p.mod = (float*)take((size_t)2 * 5 * NMOD * D * 4);
    p.winT = (bf16_t*)take((size_t)2 * NP * D * 2);
    p.wbT = (bf16_t*)take((size_t)2 * 4 * D * MW * 2);
    p.woutT = (bf16_t*)take((size_t)2 * D * D * 2);
    p.w1T = (bf16_t*)take((size_t)2 * NE * 2 * D * D * 2);
    p.w2T = (bf16_t*)take((size_t)2 * NE * D * D * 2);
    p.xl = (float*)take((size_t)NTOK * D * 4);
    p.H = (bf16_t*)take((size_t)NTOK * D * 2);
    p.P = (bf16_t*)take((size_t)NTOK * NP * 2);
    p.act = p.P; p.yp = p.P + (size_t)CAPROWS * D;
    p.prep = (float*)take(NPREP * TOKW * 4);
    p.gg = (float*)take((size_t)NTOK * 8 * 4);
    p.gb = (float*)take((size_t)NTOK * 8 * 4);
    p.O = (float*)take(8 * TOKW * 4);
    p.lq = (bf16_t*)take((size_t)3 * NITEM * 64 * 128 * 2);
    p.lo = (bf16_t*)take((size_t)3 * NITEM * 64 * 128 * 2);
    p.lb = (bf16_t*)take((size_t)3 * NITEM * 128 * 128 * 2);
    p.la = (bf16_t*)take((size_t)NITEM * 128 * 128 * 2);
    p.ld = (float*)take((size_t)3 * NITEM * 128 * 4);
    p.Y = (bf16_t*)take(4 * TOKW * 2);
    p.mix = (bf16_t*)take((size_t)NTOK * D * 2);
    p.F = p.H;
    p.list = (int*)take((size_t)NE * NTOK * 4);
    p.tokslot = (int*)take((size_t)NTOK * 4 * 4);
    p.topw = (float*)take((size_t)NTOK * 4 * 4);
    if (off > ws_size) { fprintf(stderr, "workspace too small: need %zu have %zu\n", off, ws_size); return; }

    static int grid = 0;
#if MEGA
    if (!grid) {
        int dev = 0, cus = 0, occ = 0; (void)hipGetDevice(&dev); (void)hipDeviceGetAttribute(&cus, hipDeviceAttributeMultiprocessorCount, dev);
        (void)hipFuncSetAttribute((const void*)k_mega, hipFuncAttributeMaxDynamicSharedMemorySize, LDS_BYTES);
        (void)hipOccupancyMaxActiveBlocksPerMultiprocessor(&occ, (const void*)k_mega, NTHREADS, LDS_BYTES);
        if (cus <= 0) cus = 256;
        grid = cus * (occ < 1 ? 1 : 1);
        if (occ < 1) fprintf(stderr, "occupancy query says %d blocks per CU\n", occ);
    }
    (void)hipMemsetAsync(d_ws, 0, ctl_bytes, stream);
    hipLaunchKernelGGL(k_mega, dim3(grid), dim3(NTHREADS), LDS_BYTES, stream, p);
#else
    if (!grid) {
        int dev = 0, cus = 0; (void)hipGetDevice(&dev); (void)hipDeviceGetAttribute(&cus, hipDeviceAttributeMultiprocessorCount, dev);
        grid = cus > 0 ? cus : 256;
        const void* ks[] = {(const void*)k_convert, (const void*)k_mod, (const void*)k_norm1, (const void*)k_g1, (const void*)k_prep, (const void*)k_local, (const void*)k_seq, (const void*)k_merge,
                            (const void*)k_g2, (const void*)k_g3, (const void*)k_route, (const void*)k_g4, (const void*)k_g5, (const void*)k_combine};
        for (const void* k : ks) (void)hipFuncSetAttribute(k, hipFuncAttributeMaxDynamicSharedMemorySize, LDS_BYTES);
    }
    (void)hipMemsetAsync(d_ws, 0, ctl_bytes, stream);
#define LAUNCH(k, l, M) hipLaunchKernelGGL(k, dim3(grid), dim3(NTHREADS), LDS_BYTES, stream, p, l, M)
    LAUNCH(k_convert, 0, 0);
    LAUNCH(k_mod, 0, 0);
    LAUNCH(k_norm1, 0, 0);
    for (int l = 0; l < 2; ++l) {
        const int M = l == 0 ? NTOK : NLAT;
        LAUNCH(k_g1, l, M);
        LAUNCH(k_prep, l, M);
        LAUNCH(k_local, l, M);
        LAUNCH(k_seq, l, M);
        LAUNCH(k_merge, l, M);
        LAUNCH(k_g2, l, M);
        LAUNCH(k_g3, l, M);
        LAUNCH(k_route, l, M);
        LAUNCH(k_g4, l, M);
        LAUNCH(k_g5, l, M);
        LAUNCH(k_combine, l, M);
    }
#endif
}
```

```cpp
#include <hip/hip_runtime.h>
#include <stdint.h>
#include <stdio.h>

#define LAS __attribute__((address_space(3)))
typedef unsigned short bf16_t;
typedef short bf16x8 __attribute__((ext_vector_type(8)));
typedef float f32x4 __attribute__((ext_vector_type(4)));
typedef float f32x2 __attribute__((ext_vector_type(2)));
typedef unsigned u32x2 __attribute__((ext_vector_type(2)));
typedef unsigned u32x4 __attribute__((ext_vector_type(4)));

#ifndef MEGA
#define MEGA 1
#endif
#ifndef PROBE
#define PROBE 0
#endif

constexpr int D = 1024, NB = 4, TL = 4096, TC = 256, NLAT = NB * TL, NCTX = NB * TC, NTOK = NLAT + NCTX;
constexpr int NIN = 11792, NP = 12032, MW = 512, NE = 32, TOPK = 4, NMOD = 6;
constexpr int C_GQKV = 0, C_GZ = 1536, C_GA = 2048, C_GB = 2056, C_HQ = 2064, C_HI = 2576, C_HF = 3088, C_HG = 4112, C_LX = 4624,
              C_LY = 5136, C_RQKV = 5648, C_RG = 7184, C_MG = 7696;
constexpr int NTHREADS = 512, NWAVES = 8;
constexpr int LDS_BYTES = 140 * 1024;
constexpr int CAPROWS = 77824;
constexpr size_t TOKW = (size_t)NTOK * MW;
constexpr int PR_LA = 0, PR_LU = 2, NPREP = 4;
constexpr int NCHUNK = 68, NITEM = 32 * NCHUNK;

struct Params {
    const float *x, *c, *ctx, *c_ctx, *w_mod, *b_mod, *norm1_g, *norm2_g, *w_in, *gdn_conv_w, *gdn_a_log, *gdn_dt_bias, *gdn_norm_g, *hgrn_lb,
        *hgrn_norm_g, *lru_conv_w, *lru_conv_b, *lru_wa, *lru_ba, *lru_wx, *lru_bx, *lru_lambda, *ret_norm_g, *w_branch, *w_out, *router_w,
        *router_b, *moe_w1, *moe_b1, *moe_w2, *moe_b2, *final_norm_g;
    float* out;
    unsigned* bar; int* cnt; float* mod;
    bf16_t *winT, *wbT, *woutT, *w1T, *w2T;
    float* xl; bf16_t* H; bf16_t* P; float* prep; float* gg; float* gb; float* O; bf16_t* Y; bf16_t* mix; bf16_t* F;
    int* list; int* tokslot; float* topw; bf16_t* act; bf16_t* yp;
    bf16_t *lq, *lo, *lb, *la; float* ld; bf16_t* lruT;
};

__device__ __forceinline__ unsigned f2bf(float f) { unsigned u = __float_as_uint(f); u += 0x7fffu + ((u >> 16) & 1u); return u >> 16; }
__device__ __forceinline__ unsigned pack2(float a, float b) { return f2bf(a) | (f2bf(b) << 16); }
__device__ __forceinline__ float bf2f(bf16_t b) { return __uint_as_float(((unsigned)b) << 16); }
__device__ __forceinline__ float bflo(unsigned u) { return __uint_as_float(u << 16); }
__device__ __forceinline__ float bfhi(unsigned u) { return __uint_as_float(u & 0xffff0000u); }
__device__ __forceinline__ float sigmoidf_(float x) { return __builtin_amdgcn_rcpf(1.0f + __expf(-x)); }
__device__ __forceinline__ float siluf_(float x) { return x * sigmoidf_(x); }
__device__ __forceinline__ float softplusf_(float x) { return x > 20.f ? x : log1pf(__expf(x)); }
__device__ __forceinline__ float logsigmoidf_(float x) { return -softplusf_(-x); }
__device__ __forceinline__ float gelu_tanhf_(float x) { const float u = 0.7978845608028654f * (x + 0.044715f * x * x * x); return 0.5f * x * (1.0f + tanhf(u)); }
__device__ __forceinline__ float wave_sum(float v) {
#pragma unroll
    for (int m = 32; m >= 1; m >>= 1) v += __shfl_xor(v, m);
    return v;
}
__device__ __forceinline__ int opaque_tid() { int t = threadIdx.x; asm volatile("" : "+v"(t)); return t; }
__device__ __forceinline__ int tok_modrow(int tok) { return tok < NLAT ? (tok >> 12) : 4; }
__device__ __forceinline__ void tok_info(int tok, int& t, int& T, int& base) {
    if (tok < NLAT) { t = tok & (TL - 1); T = TL; base = tok - t; }
    else { t = (tok - NLAT) & (TC - 1); T = TC; base = tok - t; }
}

__device__ __forceinline__ f32x4 mfma16(bf16x8 a, bf16x8 b, f32x4 c) { return __builtin_amdgcn_mfma_f32_16x16x32_bf16(a, b, c, 0, 0, 0); }
__device__ __forceinline__ u32x2 pack4(f32x4 v) { u32x2 o; o[0] = pack2(v[0], v[1]); o[1] = pack2(v[2], v[3]); return o; }
__device__ __forceinline__ u32x4 pack8(const float* v) { u32x4 o; o[0] = pack2(v[0], v[1]); o[1] = pack2(v[2], v[3]); o[2] = pack2(v[4], v[5]); o[3] = pack2(v[6], v[7]); return o; }

namespace gm {
constexpr int HT = 16384;
__device__ __forceinline__ int lds_byte(int r, int c) { const int st = (r >> 4) * 2 + (c >> 5), rr = r & 15, cc = c & 31, ob = rr * 64 + cc * 2; return st * 1024 + (ob ^ (((ob >> 9) & 1) << 5)); }
__device__ __forceinline__ void stage_rc(int b, int& R, int& C) { const int st = b / 1024, sb = b % 1024, swz = sb ^ (((sb >> 9) & 1) << 5); R = (st >> 1) * 16 + swz / 64; C = (st & 1) * 32 + (swz % 64) / 2; }

__device__ __forceinline__ void kloop(LAS unsigned char* lds, const bf16_t* ap00, const bf16_t* ap01, const bf16_t* ap10, const bf16_t* ap11,
                                      const bf16_t* bp0, const bf16_t* bp1, int K, f32x4 (&acc)[4][4]) {
    const int tid = opaque_tid(), wid = __builtin_amdgcn_readfirstlane(tid >> 6), lane = tid & 63, wr = wid >> 1, wc = wid & 1, fr = lane & 15, fq = lane >> 4;
    const unsigned ldsw = (unsigned)wid * 1024u;
    const int aoff = (wr >> 1) * HT + lds_byte((wr & 1) * 64 + fr, fq * 8);
    const int boff = 2 * HT + lds_byte(wc * 64 + fr, fq * 8);
    const int nt = K / 64;
#define GM_GLDS(src, dstoff) __builtin_amdgcn_global_load_lds((const unsigned*)(src), (LAS unsigned*)(lds + (dstoff)), 16, 0, 0)
#define GM_STAGE(buf, kt) do { const int _bo = (buf) * 3 * HT + ldsw; const int _ko = (kt) * 64; \
        GM_GLDS(ap00 + _ko, _bo); GM_GLDS(ap01 + _ko, _bo + 8192); GM_GLDS(ap10 + _ko, _bo + HT); GM_GLDS(ap11 + _ko, _bo + HT + 8192); \
        GM_GLDS(bp0 + _ko, _bo + 2 * HT); GM_GLDS(bp1 + _ko, _bo + 2 * HT + 8192); } while (0)
    GM_STAGE(0, 0);
    for (int t = 0; t < nt; ++t) {
        const int cur = t & 1;
        if (t + 1 < nt) { GM_STAGE(cur ^ 1, t + 1); asm volatile("s_waitcnt vmcnt(6)" ::: "memory"); }
        else asm volatile("s_waitcnt vmcnt(0)" ::: "memory");
        __builtin_amdgcn_s_barrier(); asm volatile("" ::: "memory");
        bf16x8 af[4][2], bfr[4][2];
#pragma unroll
        for (int m = 0; m < 4; ++m)
#pragma unroll
            for (int k = 0; k < 2; ++k) af[m][k] = *(const LAS bf16x8*)(lds + cur * 3 * HT + aoff + m * 2048 + k * 1024);
#pragma unroll
        for (int n = 0; n < 4; ++n)
#pragma unroll
            for (int k = 0; k < 2; ++k) bfr[n][k] = *(const LAS bf16x8*)(lds + cur * 3 * HT + boff + n * 2048 + k * 1024);
#pragma unroll
        for (int k = 0; k < 2; ++k)
#pragma unroll
            for (int m = 0; m < 4; ++m)
#pragma unroll
                for (int n = 0; n < 4; ++n) acc[m][n] = __builtin_amdgcn_mfma_f32_16x16x32_bf16(bfr[n][k], af[m][k], acc[m][n], 0, 0, 0);
        asm volatile("s_waitcnt lgkmcnt(0)" ::: "memory");
        __builtin_amdgcn_s_barrier(); asm volatile("" ::: "memory");
    }
#undef GM_STAGE
#undef GM_GLDS
}
__device__ __forceinline__ void zero_acc(f32x4 (&acc)[4][4]) {
#pragma unroll
    for (int m = 0; m < 4; ++m)
#pragma unroll
        for (int n = 0; n < 4; ++n) acc[m][n] = (f32x4){0.f, 0.f, 0.f, 0.f};
}
}

namespace g8 {
constexpr int BM = 256, BK = 64, HALF = 128, HTB = HALF * BK * 2, STAGE_BYTES = 8 * HTB;
__device__ __forceinline__ int lds_byte(int r, int c) { const int st = (r >> 4) * 2 + (c >> 5), rr = r & 15, cc = c & 31, ob = rr * 64 + cc * 2; return st * 1024 + (ob ^ (((ob >> 9) & 1) << 5)); }
__device__ __forceinline__ void stage_rc(int b, int& R, int& C) { const int st = b / 1024, sb = b % 1024, swz = sb ^ (((sb >> 9) & 1) << 5); R = (st >> 1) * 16 + swz / 64; C = (st & 1) * 32 + (swz % 64) / 2; }
__device__ __forceinline__ int perm32(int rho) { const int n = rho >> 4, i = rho & 15; return 8 * (i >> 2) + 4 * n + (i & 3); }
struct Unit { int pm, pn, e; };

template <class Epi, class Sched>
__device__ __forceinline__ void gemm_phase(LAS unsigned char* lds, const int K, const Sched& S, const Epi& E) {
    const int tid = opaque_tid(), wid = __builtin_amdgcn_readfirstlane(tid >> 6), lane = tid & 63, wr = wid >> 2, wc = wid & 3, fr = lane & 15, fq = lane >> 4;
    const int nt = K / BK;
    int R0, C0, R1, C1; stage_rc(tid * 16, R0, C0); stage_rc(tid * 16 + 8192, R1, C1);
    unsigned voffB[2];
    voffB[0] = (unsigned)(((R0 & ~31) + perm32(R0 & 31)) * K + C0) * 2u; voffB[1] = (unsigned)(((R1 & ~31) + perm32(R1 & 31)) * K + C1) * 2u;
    const unsigned cb0 = (unsigned)C0 * 2u, cb1 = (unsigned)C1 * 2u;
    const size_t kstep = (size_t)(BK * 2);
    const size_t hstepB = (size_t)HALF * K * 2;
    const unsigned ldsw = (unsigned)wid * 1024u;
    const int aoff = lds_byte(wr * 64 + fr, fq * 8), boff = lds_byte(wc * 32 + fr, fq * 8);
#define G8_SA(b, h) (((b) * 2 + (h)) * HTB)
#define G8_SB(b, h) ((4 + (b) * 2 + (h)) * HTB)
#define G8_GL(src, dstoff) __builtin_amdgcn_global_load_lds((const unsigned*)(src), (LAS unsigned*)(lds + (dstoff)), 16, 0, 0)
#define G8_STAGE_A(bufoff, gbase, vo, h) do { G8_GL((const char*)(gbase) + (vo)[2 * (h)], (bufoff) + ldsw); G8_GL((const char*)(gbase) + (vo)[2 * (h) + 1], (bufoff) + ldsw + 8192); } while (0)
#define G8_STAGE_B(bufoff, gbase) do { G8_GL((const char*)(gbase) + voffB[0], (bufoff) + ldsw); G8_GL((const char*)(gbase) + voffB[1], (bufoff) + ldsw + 8192); } while (0)
#define G8_LDA(dst, b, h) do { _Pragma("unroll") for (int m = 0; m < 4; ++m) _Pragma("unroll") for (int k = 0; k < 2; ++k) dst[m][k] = *(const LAS bf16x8*)(lds + G8_SA(b, h) + aoff + m * 2048 + k * 1024); } while (0)
#define G8_LDB(dst, b, h) do { _Pragma("unroll") for (int n = 0; n < 2; ++n) _Pragma("unroll") for (int k = 0; k < 2; ++k) dst[n][k] = *(const LAS bf16x8*)(lds + G8_SB(b, h) + boff + n * 2048 + k * 1024); } while (0)
#define G8_MMA(ai, bj, At, Bt) do { __builtin_amdgcn_s_setprio(1); _Pragma("unroll") for (int m = 0; m < 4; ++m) _Pragma("unroll") for (int n = 0; n < 2; ++n) _Pragma("unroll") for (int k = 0; k < 2; ++k) \
        acc[ai][bj][m][n] = __builtin_amdgcn_mfma_f32_16x16x32_bf16(Bt[n][k], At[m][k], acc[ai][bj][m][n], 0, 0, 0); __builtin_amdgcn_s_setprio(0); } while (0)
#define G8_WAIT_V(n) asm volatile("s_waitcnt vmcnt(" #n ")" ::: "memory")
#define G8_WAIT_L(n) asm volatile("s_waitcnt lgkmcnt(" #n ")" ::: "memory")
#define G8_BAR __builtin_amdgcn_s_barrier()
#define G8_SCHED __builtin_amdgcn_sched_barrier(0)
    Unit cur, nxt; int ui = 0;
    if (!S.next(0, cur)) return;
    LAS float* biasbuf = (LAS float*)(lds + STAGE_BYTES + 2048);
    LAS int* rowbuf = (LAS int*)(lds + STAGE_BYTES + 4096);
    f32x4 acc[2][2][4][2];
#pragma unroll
    for (int a = 0; a < 2; ++a)
#pragma unroll
        for (int b = 0; b < 2; ++b)
#pragma unroll
            for (int m = 0; m < 4; ++m)
#pragma unroll
                for (int n = 0; n < 2; ++n) acc[a][b][m][n] = (f32x4){0.f, 0.f, 0.f, 0.f};
    bf16x8 At[4][2], B0[2][2], B1[2][2];
    unsigned vA[4];
    {
        unsigned rows[4] = {(unsigned)R0, (unsigned)R1, (unsigned)(HALF + R0), (unsigned)(HALF + R1)};
        if (S.gather) { rows[0] = (unsigned)*S.row_addr(cur, R0); rows[1] = (unsigned)*S.row_addr(cur, R1); rows[2] = (unsigned)*S.row_addr(cur, HALF + R0); rows[3] = (unsigned)*S.row_addr(cur, HALF + R1); }
        vA[0] = rows[0] * (unsigned)(K * 2) + cb0; vA[1] = rows[1] * (unsigned)(K * 2) + cb1; vA[2] = rows[2] * (unsigned)(K * 2) + cb0; vA[3] = rows[3] * (unsigned)(K * 2) + cb1;
    }
    const char* cA = S.a_base(cur); const char* cB = S.b_base(cur);
    G8_STAGE_B(G8_SB(0, 0), cB); G8_STAGE_A(G8_SA(0, 0), cA, vA, 0); G8_STAGE_B(G8_SB(0, 1), cB + hstepB); G8_STAGE_A(G8_SA(0, 1), cA, vA, 1);
    if (wr == 1) G8_BAR;
    G8_WAIT_V(4); G8_BAR;
    G8_STAGE_B(G8_SB(1, 0), cB + kstep); G8_STAGE_A(G8_SA(1, 0), cA + kstep, vA, 0); G8_STAGE_B(G8_SB(1, 1), cB + hstepB + kstep);
    G8_WAIT_V(6); G8_BAR;
    for (;;) {
        const bool has_next = S.next(ui + 1, nxt);
        const char* nA = has_next ? S.a_base(nxt) : cA; const char* nB = has_next ? S.b_base(nxt) : cB;
        const int nvalid = (S.gather && has_next) ? S.rows_valid(nxt) : 0;
        if (wid == 0) {
            if (Sched::HAS_BIAS) G8_GL(S.bias_src(cur, lane), STAGE_BYTES + 2048 + (ui & 1) * 1024);
            if (S.gather && has_next) G8_GL(S.row_addr(nxt, 0) + lane * 4, STAGE_BYTES + 4096 + ((ui + 1) & 1) * 1024);
        }
        unsigned vlast[4] = {vA[0], vA[1], vA[2], vA[3]};
        for (int t = 0; t < nt; t += 2) {
            const bool last = (t == nt - 2);
            const char* a1 = cA + (size_t)(t + 1) * kstep;
            const char* a2 = last ? nA : cA + (size_t)(t + 2) * kstep; const char* b2 = last ? nB : cB + (size_t)(t + 2) * kstep;
            const char* a3 = a2 + kstep; const char* b3 = b2 + kstep;
            unsigned v2[4];
#pragma unroll
            for (int q = 0; q < 4; ++q) v2[q] = vA[q];
            if (last && S.gather && has_next) {
                const LAS int* rb = rowbuf + ((ui + 1) & 1) * 256;
                const unsigned r0 = R0 < nvalid ? (unsigned)rb[R0] : 0u, r1 = R1 < nvalid ? (unsigned)rb[R1] : 0u;
                const unsigned r2 = HALF + R0 < nvalid ? (unsigned)rb[HALF + R0] : 0u, r3 = HALF + R1 < nvalid ? (unsigned)rb[HALF + R1] : 0u;
                v2[0] = r0 * (unsigned)(K * 2) + cb0; v2[1] = r1 * (unsigned)(K * 2) + cb1; v2[2] = r2 * (unsigned)(K * 2) + cb0; v2[3] = r3 * (unsigned)(K * 2) + cb1;
            }
            if (last) { vlast[0] = v2[0]; vlast[1] = v2[1]; vlast[2] = v2[2]; vlast[3] = v2[3]; }
            G8_LDB(B0, 0, 0); G8_SCHED; G8_LDA(At, 0, 0); G8_STAGE_A(G8_SA(1, 1), a1, vA, 1);
            G8_WAIT_L(8); G8_BAR; G8_WAIT_L(0); G8_MMA(0, 0, At, B0); G8_BAR; G8_SCHED;
            G8_LDB(B1, 0, 1); G8_STAGE_B(G8_SB(0, 0), b2);
            G8_BAR; G8_WAIT_L(0); G8_MMA(0, 1, At, B1); G8_BAR;
            G8_LDA(At, 0, 1); G8_STAGE_A(G8_SA(0, 0), a2, v2, 0);
            G8_BAR; G8_WAIT_L(0); G8_MMA(1, 0, At, B0); G8_BAR; G8_SCHED;
            G8_STAGE_B(G8_SB(0, 1), b2 + hstepB);
            G8_WAIT_V(6); G8_BAR; G8_MMA(1, 1, At, B1); G8_BAR;
            G8_LDB(B0, 1, 0); G8_SCHED; G8_LDA(At, 1, 0); G8_STAGE_A(G8_SA(0, 1), a2, v2, 1);
            G8_WAIT_L(8); G8_BAR; G8_WAIT_L(0); G8_MMA(0, 0, At, B0); G8_BAR; G8_SCHED;
            G8_LDB(B1, 1, 1); G8_STAGE_B(G8_SB(1, 0), b3);
            G8_BAR; G8_WAIT_L(0); G8_MMA(0, 1, At, B1); G8_BAR;
            G8_LDA(At, 1, 1); G8_STAGE_A(G8_SA(1, 0), a3, v2, 0);
            G8_BAR; G8_WAIT_L(0); G8_MMA(1, 0, At, B0); G8_BAR; G8_SCHED;
            G8_STAGE_B(G8_SB(1, 1), b3 + hstepB);
            G8_WAIT_V(6); G8_BAR; G8_MMA(1, 1, At, B1); G8_BAR;
        }
        E(acc, cur, wr, wc, fr, fq, biasbuf + (ui & 1) * 256);
        if (!has_next) break;
#pragma unroll
        for (int a = 0; a < 2; ++a)
#pragma unroll
            for (int b = 0; b < 2; ++b)
#pragma unroll
                for (int m = 0; m < 4; ++m)
#pragma unroll
                    for (int n = 0; n < 2; ++n) acc[a][b][m][n] = (f32x4){0.f, 0.f, 0.f, 0.f};
        cur = nxt; cA = nA; cB = nB; ++ui;
#pragma unroll
        for (int q = 0; q < 4; ++q) vA[q] = vlast[q];
    }
    G8_WAIT_V(0);
    if (wr == 0) G8_BAR;
    G8_BAR;
#undef G8_SA
#undef G8_SB
#undef G8_GL
#undef G8_STAGE_A
#undef G8_STAGE_B
#undef G8_LDA
#undef G8_LDB
#undef G8_MMA
#undef G8_WAIT_V
#undef G8_WAIT_L
#undef G8_BAR
#undef G8_SCHED
}

struct PlainSched {
    const bf16_t* A; const bf16_t* Bt; int K, nM, nN, nwg, G, c;
    __device__ __forceinline__ void init(const bf16_t* A_, const bf16_t* Bt_, int M, int N, int K_) { A = A_; Bt = Bt_; K = K_; nM = M / BM; nN = N / BM; nwg = nM * nN; G = gridDim.x; c = blockIdx.x; }
    __device__ __forceinline__ bool next(int i, Unit& u) const {
        const long L = (long)i * G + c; if (L >= nwg) return false;
        int wgid = (int)L; { const int q = nwg / 8, r = nwg % 8, xcd = wgid % 8, off = wgid / 8; wgid = (xcd < r ? xcd * (q + 1) : r * (q + 1) + (xcd - r) * q) + off; }
        const int nig = 8 * nN, gid = wgid / nig, fm = gid * 8, gsz = (nM - fm) < 8 ? (nM - fm) : 8;
        u.pm = fm + ((wgid % nig) % gsz); u.pn = (wgid % nig) / gsz; u.e = 0; return true;
    }
    __device__ __forceinline__ const char* a_base(const Unit& u) const { return (const char*)(A + (size_t)u.pm * BM * K); }
    __device__ __forceinline__ const char* b_base(const Unit& u) const { return (const char*)(Bt + (size_t)u.pn * BM * K); }
    static constexpr bool HAS_BIAS = false, gather = false;
    __device__ __forceinline__ const int* row_addr(const Unit&, int) const { return nullptr; }
    __device__ __forceinline__ int rows_valid(const Unit&) const { return 256; }
    __device__ __forceinline__ const float* bias_src(const Unit&, int) const { return nullptr; }
};
}

struct StageRC { int R0, C0, R1, C1; };
__device__ __forceinline__ StageRC my_stage_rc() { const int t = opaque_tid(); StageRC s; gm::stage_rc(t * 16, s.R0, s.C0); gm::stage_rc(t * 16 + 8192, s.R1, s.C1); return s; }

__device__ __forceinline__ int w1_dst_row(int n) { const int half = n >> 10, cc = n & 1023; return (cc >> 7) * 256 + half * 128 + (cc & 127); }

__device__ __forceinline__ void cvt_tile(LAS float* tile, const float* src, int ldsrc, int Nsrc, int k0, int n0, bf16_t* dst, int K, int mode) {
    const int tid = opaque_tid();
    {
        const int rr = tid >> 6, cc = tid & 63, n = n0 + cc;
#pragma unroll
        for (int i = 0; i < 8; ++i) { const int k = rr + i * 8; tile[k * 65 + cc] = (n < Nsrc) ? src[(size_t)(k0 + k) * ldsrc + n] : 0.f; }
    }
    __syncthreads();
    {
        const int nl = tid >> 3, kg = tid & 7, n = n0 + nl;
        float v[8];
#pragma unroll
        for (int j = 0; j < 8; ++j) v[j] = tile[(kg * 8 + j) * 65 + nl];
        const int drow = mode == 1 ? w1_dst_row(n) : n;
        u32x4 o; o[0] = pack2(v[0], v[1]); o[1] = pack2(v[2], v[3]); o[2] = pack2(v[4], v[5]); o[3] = pack2(v[6], v[7]);
        *(u32x4*)(dst + (size_t)drow * K + k0 + kg * 8) = o;
    }
    __syncthreads();
}

__device__ __forceinline__ void ph_convert(const Params& p, LAS unsigned char* lds) {
    LAS float* tile = (LAS float*)lds;
    for (int idx = blockIdx.x * NTHREADS + opaque_tid(); idx < 2 * 8 * 4 * 4096; idx += gridDim.x * NTHREADS) {
        const int i = idx & 63, j = (idx >> 6) & 63, mat = (idx >> 12) & 3, n = (idx >> 14) & 7, ll = idx >> 17, d = mat >> 1;
        p.lruT[idx] = (bf16_t)f2bf(((mat & 1) ? p.lru_wx : p.lru_wa)[(size_t)((ll * 2 + d) * 8 + n) * 4096 + i * 64 + j]);
    }
    constexpr int PER_L = 3008 + 512 + 256 + 16384 + 8192;
    for (int it = blockIdx.x; it < 2 * PER_L; it += gridDim.x) {
        const int l = it / PER_L; int r = it % PER_L;
        if (r < 3008) { const int nt = r % 188, kt = r / 188; cvt_tile(tile, p.w_in + (size_t)l * D * NIN, NIN, NIN, kt * 64, nt * 64, p.winT + (size_t)l * NP * D, D, 0); }
        else if (r < 3520) { r -= 3008; const int n = r / 128; r %= 128; const int nt = r % 16, kt = r / 16;
            cvt_tile(tile, p.w_branch + (size_t)(l * 4 + n) * MW * D, D, D, kt * 64, nt * 64, p.wbT + (size_t)(l * 4 + n) * D * MW, MW, 0); }
        else if (r < 3776) { r -= 3520; const int nt = r % 16, kt = r / 16; cvt_tile(tile, p.w_out + (size_t)l * D * D, D, D, kt * 64, nt * 64, p.woutT + (size_t)l * D * D, D, 0); }
        else if (r < 3776 + 16384) { r -= 3776; const int e = r / 512; r %= 512; const int nt = r % 32, kt = r / 32;
            cvt_tile(tile, p.moe_w1 + (size_t)(l * NE + e) * D * 2 * D, 2 * D, 2 * D, kt * 64, nt * 64, p.w1T + (size_t)(l * NE + e) * 2 * D * D, D, 1); }
        else { r -= 3776 + 16384; const int e = r / 256; r %= 256; const int nt = r % 16, kt = r / 16;
            cvt_tile(tile, p.moe_w2 + (size_t)(l * NE + e) * D * D, D, D, kt * 64, nt * 64, p.w2T + (size_t)(l * NE + e) * D * D, D, 0); }
    }
}

__device__ __forceinline__ void ph_mod(const Params& p, LAS unsigned char* lds) {
    LAS float* sc = (LAS float*)lds;
    LAS float* red = sc + 5 * D;
    const int tid = opaque_tid(), wid = tid >> 6, lane = tid & 63;
    if ((int)blockIdx.x >= 192) return;
    for (int i = tid; i < 5 * D; i += NTHREADS) { const int r = i >> 10, k = i & 1023; const float v = r < 4 ? p.c[r * D + k] : p.c_ctx[k]; sc[i] = siluf_(v); }
    __syncthreads();
    for (int it = blockIdx.x; it < 192; it += gridDim.x) {
        const int l = it / 96, n0 = (it % 96) * 64;
        float acc[5] = {0.f, 0.f, 0.f, 0.f, 0.f};
        const float* wp = p.w_mod + (size_t)l * D * (NMOD * D) + n0 + lane;
        for (int k = wid * 128; k < wid * 128 + 128; ++k) {
            const float wv = wp[(size_t)k * (NMOD * D)];
#pragma unroll
            for (int r = 0; r < 5; ++r) acc[r] += sc[r * D + k] * wv;
        }
#pragma unroll
        for (int r = 0; r < 5; ++r) red[(wid * 5 + r) * 64 + lane] = acc[r];
        __syncthreads();
        if (tid < 320) { const int r = tid >> 6, cidx = tid & 63; float s = p.b_mod[l * NMOD * D + n0 + cidx];
#pragma unroll
            for (int w = 0; w < 8; ++w) s += red[(w * 5 + r) * 64 + cidx];
            p.mod[(size_t)(l * 5 + r) * (NMOD * D) + n0 + cidx] = s; }
        __syncthreads();
    }
}

__device__ __forceinline__ void norm_mod_store(const float4 (&v)[4], float rinv, const float* g, const float* scp, const float* shp, bf16_t* dst, int lane) {
#pragma unroll
    for (int i = 0; i < 4; ++i) {
        const int cidx = i * 256 + lane * 4;
        const float4 gv = *(const float4*)(g + cidx), sv = *(const float4*)(scp + cidx), hv = *(const float4*)(shp + cidx);
        const float h0 = v[i].x * rinv * gv.x * (1.f + sv.x) + hv.x, h1 = v[i].y * rinv * gv.y * (1.f + sv.y) + hv.y;
        const float h2 = v[i].z * rinv * gv.z * (1.f + sv.z) + hv.z, h3 = v[i].w * rinv * gv.w * (1.f + sv.w) + hv.w;
        u32x2 o; o[0] = pack2(h0, h1); o[1] = pack2(h2, h3);
        *(u32x2*)(dst + cidx) = o;
    }
}
__device__ __forceinline__ void ph_norm1_first(const Params& p) {
    const int tid = opaque_tid(), wid = tid >> 6, lane = tid & 63;
    for (int tok = blockIdx.x * NWAVES + wid; tok < NTOK; tok += gridDim.x * NWAVES) {
        const float* src = tok < NLAT ? p.x + (size_t)tok * D : p.ctx + (size_t)(tok - NLAT) * D;
        float4 v[4]; float ss = 0.f;
#pragma unroll
        for (int i = 0; i < 4; ++i) { v[i] = *(const float4*)(src + i * 256 + lane * 4); ss += v[i].x * v[i].x + v[i].y * v[i].y + v[i].z * v[i].z + v[i].w * v[i].w; }
        ss = wave_sum(ss);
        const float rinv = rsqrtf(ss * (1.0f / D) + 1e-6f);
        const float* mb = p.mod + (size_t)(0 * 5 + tok_modrow(tok)) * (NMOD * D);
        norm_mod_store(v, rinv, p.norm1_g, mb + 1 * D, mb + 0 * D, p.H + (size_t)tok * D, lane);
#pragma unroll
        for (int i = 0; i < 4; ++i) *(float4*)(p.xl + (size_t)tok * D + i * 256 + lane * 4) = v[i];
    }
}

struct EpiP {
    bf16_t* O;
    __device__ __forceinline__ void operator()(const f32x4 (&acc)[2][2][4][2], const g8::Unit& u, int wr, int wc, int fr, int fq, const LAS float*) const {
        const int row0 = u.pm * 256 + wr * 64 + fr, col0 = u.pn * 256 + wc * 32 + 8 * fq;
#pragma unroll
        for (int ai = 0; ai < 2; ++ai)
#pragma unroll
            for (int m = 0; m < 4; ++m) {
                bf16_t* rowp = O + (size_t)(row0 + ai * 128 + m * 16) * NP + col0;
#pragma unroll
                for (int bj = 0; bj < 2; ++bj) {
                    u32x4 w; w[0] = pack2(acc[ai][bj][m][0][0], acc[ai][bj][m][0][1]); w[1] = pack2(acc[ai][bj][m][0][2], acc[ai][bj][m][0][3]);
                    w[2] = pack2(acc[ai][bj][m][1][0], acc[ai][bj][m][1][1]); w[3] = pack2(acc[ai][bj][m][1][2], acc[ai][bj][m][1][3]);
                    *(u32x4*)(rowp + bj * 128) = w;
                }
            }
    }
};
__device__ __forceinline__ void ph_g1(const Params& p, int l, LAS unsigned char* lds) {
    g8::PlainSched S; S.init(p.H, p.winT + (size_t)l * NP * D, NTOK, NP, D);
    EpiP E; E.O = p.P;
    g8::gemm_phase(lds, D, S, E);
}

__device__ __forceinline__ void ph_prep(const Params& p, int l, LAS unsigned char* lds) {
    const int tid = opaque_tid(), wid = tid >> 6, lane = tid & 63, fr = lane & 15, fq = lane >> 4;
    LAS float* xs = (LAS float*)lds;
    LAS bf16_t* xb = (LAS bf16_t*)(xs + 64 * 68);
    LAS bf16_t* wt = xb + 64 * 72;
    for (int it = blockIdx.x; it < (NTOK / 64) * 8; it += gridDim.x) {
        const int tile = it >> 3, n = it & 7, tok0 = tile * 64;
        {
            const int tl = tid & 63, cg = tid >> 6, tok = tok0 + tl;
            int t, T, base; tok_info(tok, t, T, base);
            float a[8];
            { const float4 b0 = *(const float4*)(p.lru_conv_b + l * MW + n * 64 + cg * 8), b1 = *(const float4*)(p.lru_conv_b + l * MW + n * 64 + cg * 8 + 4);
              a[0] = b0.x; a[1] = b0.y; a[2] = b0.z; a[3] = b0.w; a[4] = b1.x; a[5] = b1.y; a[6] = b1.z; a[7] = b1.w; }
#pragma unroll
            for (int j = 0; j < 4; ++j) {
                const int tt = t + j - 2;
                const float okf = (tt >= 0 && tt < T) ? 1.0f : 0.0f;
                const int ttc = tt < 0 ? 0 : (tt >= T ? T - 1 : tt);
                const u32x4 u = *(const u32x4*)(p.P + (size_t)(base + ttc) * NP + C_LX + n * 64 + cg * 8);
                const float* w = p.lru_conv_w + (size_t)(l * 4 + j) * MW + n * 64 + cg * 8;
                const float4 wa = *(const float4*)w, wb = *(const float4*)(w + 4);
                const float wv[8] = {wa.x * okf, wa.y * okf, wa.z * okf, wa.w * okf, wb.x * okf, wb.y * okf, wb.z * okf, wb.w * okf};
#pragma unroll
                for (int q = 0; q < 4; ++q) { a[2 * q] += wv[2 * q] * bflo(u[q]); a[2 * q + 1] += wv[2 * q + 1] * bfhi(u[q]); }
            }
            *(LAS f32x4*)(xs + tl * 68 + cg * 8) = (f32x4){a[0], a[1], a[2], a[3]}; *(LAS f32x4*)(xs + tl * 68 + cg * 8 + 4) = (f32x4){a[4], a[5], a[6], a[7]};
            *(LAS u32x4*)(xb + tl * 72 + cg * 8) = pack8(a);
            const bf16_t* wsrc = p.lruT + (size_t)((l * 8 + n) * 4) * 4096;
#pragma unroll
            for (int q = 0; q < 4; ++q) { const int e8 = tid + 512 * q, row = e8 >> 3, c8 = e8 & 7; *(LAS u32x4*)(wt + row * 72 + c8 * 8) = *(const u32x4*)(wsrc + (size_t)e8 * 8); }
        }
        __syncthreads();
        {
            const int jb = wid & 3, tb0 = (wid >> 2) * 2;
            bf16x8 xw[4][2];
#pragma unroll
            for (int m = 0; m < 4; ++m)
#pragma unroll
                for (int ks = 0; ks < 2; ++ks) xw[m][ks] = *(const LAS bf16x8*)(wt + (m * 64 + jb * 16 + fr) * 72 + ks * 32 + fq * 8);
            const int c0 = n * 64 + jb * 16 + 4 * fq;
            float4 bav[2], bxv[2], lsv[2];
#pragma unroll
            for (int d = 0; d < 2; ++d) {
                bav[d] = *(const float4*)(p.lru_ba + (l * 2 + d) * MW + c0); bxv[d] = *(const float4*)(p.lru_bx + (l * 2 + d) * MW + c0);
                const float4 lm = *(const float4*)(p.lru_lambda + (l * 2 + d) * MW + c0);
                lsv[d] = make_float4(8.0f * logsigmoidf_(lm.x), 8.0f * logsigmoidf_(lm.y), 8.0f * logsigmoidf_(lm.z), 8.0f * logsigmoidf_(lm.w));
            }
#pragma unroll
            for (int e = 0; e < 2; ++e) {
                const int tl = (tb0 + e) * 16 + fr, tok = tok0 + tl;
                f32x4 acc[4];
#pragma unroll
                for (int m = 0; m < 4; ++m) acc[m] = (f32x4){0.f, 0.f, 0.f, 0.f};
#pragma unroll
                for (int ks = 0; ks < 2; ++ks) {
                    const bf16x8 y = *(const LAS bf16x8*)(xb + tl * 72 + ks * 32 + fq * 8);
#pragma unroll
                    for (int m = 0; m < 4; ++m) acc[m] = mfma16(xw[m][ks], y, acc[m]);
                }
                const f32x4 xv = *(const LAS f32x4*)(xs + tl * 68 + jb * 16 + 4 * fq);
#pragma unroll
                for (int d = 0; d < 2; ++d) {
                    const float bar_[4] = {bav[d].x, bav[d].y, bav[d].z, bav[d].w}, bxr[4] = {bxv[d].x, bxv[d].y, bxv[d].z, bxv[d].w}, lsr[4] = {lsv[d].x, lsv[d].y, lsv[d].z, lsv[d].w};
                    float av[4], uv[4];
#pragma unroll
                    for (int r = 0; r < 4; ++r) {
                        const float gr = sigmoidf_(acc[d * 2][r] + bar_[r]), gi = sigmoidf_(acc[d * 2 + 1][r] + bxr[r]);
                        const float la = gr * lsr[r];
                        av[r] = __expf(la);
                        uv[r] = xv[r] * gi * sqrtf(fmaxf(-expm1f(2.0f * la), 1e-12f));
                    }
                    *(float4*)(p.prep + (PR_LA + d) * TOKW + (size_t)tok * MW + c0) = make_float4(av[0], av[1], av[2], av[3]);
                    *(float4*)(p.prep + (PR_LU + d) * TOKW + (size_t)tok * MW + c0) = make_float4(uv[0], uv[1], uv[2], uv[3]);
                }
            }
        }
        __syncthreads();
    }
}

__device__ __forceinline__ int chunk_base(int b, int d, int n) {
    if (n < 4) { const int blk = d ? 3 - n : n; return NLAT + b * TC + blk * 64; }
    const int m = n - 4, blk = d ? 63 - m : m; return b * TL + blk * 64;
}

__device__ __forceinline__ void local_gla(const Params& p, int l, int tz, int chain, int n, LAS unsigned char* lds) {
    const int tid = opaque_tid(), wid = tid >> 6, lane = tid & 63, fr = lane & 15, fq = lane >> 4;
    const int b = chain >> 3, h = (chain >> 1) & 3, d = chain & 1;
    const int base = chunk_base(b, d, n);
    const size_t item = (size_t)tz * NITEM + (size_t)chain * NCHUNK + n;
    LAS bf16_t* kraw = (LAS bf16_t*)lds;
    LAS bf16_t* qh = kraw + 64 * 136;
    LAS bf16_t* kh = qh + 64 * 136;
    LAS bf16_t* sc = kh + 64 * 136;
    LAS bf16_t* vT = sc + 64 * 72;
    LAS bf16_t* kT = vT + 128 * 72;
    LAS float* bc = (LAS float*)(kT + 128 * 72);
    const int vcol = tz == 1 ? C_HI : C_RQKV + 1024;
    const int ti = tid >> 3, dg = tid & 7, cA = dg * 8, cB = 64 + dg * 8;
    const int tokI = base + (d ? 63 - ti : ti);
    const bf16_t* pr = p.P + (size_t)tokI * NP;
    float qt[16];
    {
        float kv[16], lfv[16];
        if (tz == 1) {
            float lbv[16];
            {
                const float* lp0 = p.hgrn_lb + (size_t)(0 * 2 + d) * MW + h * 128; const float* lp1 = p.hgrn_lb + (size_t)(1 * 2 + d) * MW + h * 128;
                const float4 a0 = *(const float4*)(lp0 + cA), a1 = *(const float4*)(lp0 + cA + 4), a2 = *(const float4*)(lp0 + cB), a3 = *(const float4*)(lp0 + cB + 4);
                const float4 b0 = *(const float4*)(lp1 + cA), b1 = *(const float4*)(lp1 + cA + 4), b2 = *(const float4*)(lp1 + cB), b3 = *(const float4*)(lp1 + cB + 4);
                const float x0[16] = {a0.x, a0.y, a0.z, a0.w, a1.x, a1.y, a1.z, a1.w, a2.x, a2.y, a2.z, a2.w, a3.x, a3.y, a3.z, a3.w};
                const float x1[16] = {b0.x, b0.y, b0.z, b0.w, b1.x, b1.y, b1.z, b1.w, b2.x, b2.y, b2.z, b2.w, b3.x, b3.y, b3.z, b3.w};
#pragma unroll
                for (int e = 0; e < 16; ++e) lbv[e] = (l == 1) ? fminf(__builtin_amdgcn_rcpf(1.0f + __expf(x0[e] - x1[e])), 1.0f - 1e-4f) : 0.f;
            }
            const u32x4 uqa = *(const u32x4*)(pr + C_HQ + h * 128 + cA), uqb = *(const u32x4*)(pr + C_HQ + h * 128 + cB);
            const u32x4 uza = *(const u32x4*)(pr + C_HF + d * 512 + h * 128 + cA), uzb = *(const u32x4*)(pr + C_HF + d * 512 + h * 128 + cB);
#pragma unroll
            for (int e = 0; e < 16; ++e) {
                const unsigned uq = e < 8 ? uqa[(e & 7) >> 1] : uqb[(e & 7) >> 1], uz = e < 8 ? uza[(e & 7) >> 1] : uzb[(e & 7) >> 1];
                const float qraw = (e & 1) ? bfhi(uq) : bflo(uq), z = (e & 1) ? bfhi(uz) : bflo(uz);
                const float lb = lbv[e];
                const float sg = sigmoidf_(z);
                qt[e] = siluf_(qraw) * 0.08838834764831845f;
                kv[e] = (1.f - lb) * (1.f - sg);
                lfv[e] = __logf(fmaxf(lb + (1.f - lb) * sg, 1e-30f));
            }
        } else {
            const bf16_t* rp = pr + C_RQKV + h * 128;
            const u32x4 q1 = *(const u32x4*)(rp + cA), q2 = *(const u32x4*)(rp + cB), k1 = *(const u32x4*)(rp + 512 + cA), k2 = *(const u32x4*)(rp + 512 + cB);
            const float lng = log1pf(-exp2f(-5.0f - (float)h));
            const bool lat = tokI < NLAT;
            const int t = tokI & (TL - 1);
#pragma unroll
            for (int e = 0; e < 8; ++e) {
                float a1 = (e & 1) ? bfhi(q1[e >> 1]) : bflo(q1[e >> 1]), a2 = (e & 1) ? bfhi(q2[e >> 1]) : bflo(q2[e >> 1]);
                float b1 = (e & 1) ? bfhi(k1[e >> 1]) : bflo(k1[e >> 1]), b2 = (e & 1) ? bfhi(k2[e >> 1]) : bflo(k2[e >> 1]);
                if (lat) {
                    const int pi = cA + e;
                    const float pos = (pi < 32) ? (float)(t >> 6) : (float)(t & 63);
                    const float ang = pos * exp2f(-(float)(pi & 31) * (13.287712379549449f / 32.0f));
                    float sn, cs; sincosf(ang, &sn, &cs);
                    const float n1 = a1 * cs - a2 * sn, n2 = a1 * sn + a2 * cs, m1 = b1 * cs - b2 * sn, m2 = b1 * sn + b2 * cs;
                    a1 = n1; a2 = n2; b1 = m1; b2 = m2;
                }
                qt[e] = a1; qt[8 + e] = a2; kv[e] = b1 * 0.08838834764831845f; kv[8 + e] = b2 * 0.08838834764831845f;
                lfv[e] = lng; lfv[8 + e] = lng;
            }
        }
        *(LAS u32x4*)(kraw + ti * 136 + cA) = pack8(kv); *(LAS u32x4*)(kraw + ti * 136 + cB) = pack8(kv + 8);
        *(LAS f32x4*)(bc + ti * 132 + cA) = (f32x4){lfv[0], lfv[1], lfv[2], lfv[3]}; *(LAS f32x4*)(bc + ti * 132 + cA + 4) = (f32x4){lfv[4], lfv[5], lfv[6], lfv[7]};
        *(LAS f32x4*)(bc + ti * 132 + cB) = (f32x4){lfv[8], lfv[9], lfv[10], lfv[11]}; *(LAS f32x4*)(bc + ti * 132 + cB + 4) = (f32x4){lfv[12], lfv[13], lfv[14], lfv[15]};
        const bf16_t* vp = pr + vcol + h * 128;
        const u32x4 v0 = *(const u32x4*)(vp + cA), v1 = *(const u32x4*)(vp + cB);
#pragma unroll
        for (int e = 0; e < 8; ++e) {
            vT[(cA + e) * 72 + ti] = (bf16_t)((e & 1) ? (v0[e >> 1] >> 16) : (v0[e >> 1] & 0xffffu));
            vT[(cB + e) * 72 + ti] = (bf16_t)((e & 1) ? (v1[e >> 1] >> 16) : (v1[e >> 1] & 0xffffu));
        }
    }
    __syncthreads();
    if (tid < 128) {
        float run = 0.f, lv[64];
#pragma unroll
        for (int i = 0; i < 64; ++i) lv[i] = bc[i * 132 + tid];
#pragma unroll
        for (int i = 0; i < 64; ++i) { run += lv[i]; bc[i * 132 + tid] = run; }
    }
    __syncthreads();
    {
        const int I = ti >> 4;
        float qhat[16];
#pragma unroll
        for (int e = 0; e < 16; ++e) {
            const int ch = e < 8 ? cA + e : cB + e - 8;
            const float bi = bc[ti * 132 + ch], rI = I ? bc[(16 * I - 1) * 132 + ch] : 0.f, bl = bc[63 * 132 + ch];
            qhat[e] = qt[e] * __expf(bi - rI); qt[e] = qt[e] * __expf(bi);
            kT[ch * 72 + ti] = (bf16_t)f2bf(bf2f(kraw[ti * 136 + ch]) * __expf(bl - bi));
        }
        *(LAS u32x4*)(qh + ti * 136 + cA) = pack8(qhat); *(LAS u32x4*)(qh + ti * 136 + cB) = pack8(qhat + 8);
        {
            bf16_t* lqb = p.lq + item * 8192 + (size_t)((ti >> 4) * 8) * 256 + (ti & 15) * 4;
            const u32x4 pa = pack8(qt), pb = pack8(qt + 8);
            u32x2 t0; t0[0] = pa[0]; t0[1] = pa[1]; u32x2 t1; t1[0] = pa[2]; t1[1] = pa[3]; u32x2 t2; t2[0] = pb[0]; t2[1] = pb[1]; u32x2 t3; t3[0] = pb[2]; t3[1] = pb[3];
            *(u32x2*)(lqb + (dg >> 1) * 256 + ((dg & 1) * 2 + 0) * 64) = t0; *(u32x2*)(lqb + (dg >> 1) * 256 + ((dg & 1) * 2 + 1) * 64) = t1;
            *(u32x2*)(lqb + (4 + (dg >> 1)) * 256 + ((dg & 1) * 2 + 0) * 64) = t2; *(u32x2*)(lqb + (4 + (dg >> 1)) * 256 + ((dg & 1) * 2 + 1) * 64) = t3;
        }
    }
    if (tid < 128) p.ld[item * 128 + tid] = __expf(bc[63 * 132 + tid]);
    for (int I = 0; I < 4; ++I) {
        if (ti < 16 * (I + 1)) {
            float kk[16];
#pragma unroll
            for (int e = 0; e < 16; ++e) {
                const int ch = e < 8 ? cA + e : cB + e - 8;
                const float rI = I ? bc[(16 * I - 1) * 132 + ch] : 0.f, bj = bc[ti * 132 + ch];
                kk[e] = bf2f(kraw[ti * 136 + ch]) * __expf(fminf(rI - bj, 80.f));
            }
            *(LAS u32x4*)(kh + ti * 136 + cA) = pack8(kk); *(LAS u32x4*)(kh + ti * 136 + cB) = pack8(kk + 8);
        }
        __syncthreads();
        if (wid < 4) {
            const int J = wid;
            u32x2 outv; outv[0] = 0u; outv[1] = 0u;
            if (J <= I) {
                f32x4 acc = (f32x4){0.f, 0.f, 0.f, 0.f};
#pragma unroll
                for (int ks = 0; ks < 4; ++ks)
                    acc = mfma16(*(const LAS bf16x8*)(kh + (J * 16 + fr) * 136 + ks * 32 + fq * 8), *(const LAS bf16x8*)(qh + (I * 16 + fr) * 136 + ks * 32 + fq * 8), acc);
                const int i = 16 * I + fr, j0 = 16 * J + 4 * fq;
#pragma unroll
                for (int r = 0; r < 4; ++r) if (j0 + r > i) acc[r] = 0.f;
                outv = pack4(acc);
            }
            *(LAS u32x2*)(sc + (I * 16 + fr) * 72 + J * 16 + 4 * fq) = outv;
        }
        __syncthreads();
    }
    {
        bf16x8 xv[2], xk[2];
#pragma unroll
        for (int ks = 0; ks < 2; ++ks) { xv[ks] = *(const LAS bf16x8*)(vT + (wid * 16 + fr) * 72 + ks * 32 + fq * 8); xk[ks] = *(const LAS bf16x8*)(kT + (wid * 16 + fr) * 72 + ks * 32 + fq * 8); }
#pragma unroll
        for (int ib = 0; ib < 4; ++ib) {
            f32x4 acc = (f32x4){0.f, 0.f, 0.f, 0.f};
#pragma unroll
            for (int ks = 0; ks < 2; ++ks) acc = mfma16(xv[ks], *(const LAS bf16x8*)(sc + (ib * 16 + fr) * 72 + ks * 32 + fq * 8), acc);
            *(u32x2*)(p.lo + item * 8192 + ((wid * 4 + ib) * 64 + lane) * 4) = pack4(acc);
        }
#pragma unroll
        for (int dvb = 0; dvb < 8; ++dvb) {
            f32x4 acc = (f32x4){0.f, 0.f, 0.f, 0.f};
#pragma unroll
            for (int ks = 0; ks < 2; ++ks) acc = mfma16(xk[ks], *(const LAS bf16x8*)(vT + (dvb * 16 + fr) * 72 + ks * 32 + fq * 8), acc);
            *(u32x2*)(p.lb + item * 16384 + ((wid * 8 + dvb) * 64 + lane) * 4) = pack4(acc);
        }
    }
    __syncthreads();
}


template <int I> struct SolveRows {
    static __device__ __forceinline__ void run(float (&x)[64], const LAS float* Mf, const LAS float* rs) {
        SolveRows<I - 1>::run(x, Mf, rs);
        float r = x[I] * rs[I];
#pragma unroll
        for (int j4 = 0; j4 < (I + 3) / 4; ++j4) {
            const f32x4 m = *(const LAS f32x4*)(Mf + I * 68 + j4 * 4);
            r -= m[0] * x[j4 * 4] + m[1] * x[j4 * 4 + 1] + m[2] * x[j4 * 4 + 2] + m[3] * x[j4 * 4 + 3];
        }
        asm volatile("" : "+v"(r) :: "memory");
        x[I] = r;
    }
};
template <> struct SolveRows<-1> { static __device__ __forceinline__ void run(float (&)[64], const LAS float*, const LAS float*) {} };

__device__ __forceinline__ void local_gdn(const Params& p, int l, int chain, int n, LAS unsigned char* lds) {
    const int tid = opaque_tid(), wid = tid >> 6, lane = tid & 63, fr = lane & 15, fq = lane >> 4;
    const int b = chain >> 3, h = (chain >> 1) & 3, d = chain & 1;
    const int base = chunk_base(b, d, n);
    const size_t item = (size_t)chain * NCHUNK + n;
    LAS bf16_t* ks_ = (LAS bf16_t*)lds;
    LAS bf16_t* qs = ks_ + 64 * 136;
    LAS bf16_t* att = qs + 64 * 136;
    LAS bf16_t* wT = att + 64 * 72;
    LAS bf16_t* uT = wT + 128 * 72;
    LAS bf16_t* kT = uT + 128 * 72;
    LAS float* Mf = (LAS float*)(kT + 128 * 72);
    LAS float* bcs = Mf + 64 * 68;
    LAS float* bts = bcs + 64;
    LAS float* rse = bts + 64;
    LAS bf16_t* vs = (LAS bf16_t*)(rse + 64);
    const int ti = tid >> 3, d0 = (tid & 7) * 16;
    const int tokI = base + (d ? 63 - ti : ti);
    {
        int t, T, sbase; tok_info(tokI, t, T, sbase);
#pragma unroll
        for (int part = 0; part < 3; ++part) {
            float a[16];
#pragma unroll
            for (int e = 0; e < 16; ++e) a[e] = 0.f;
            const int ccol = part * 512 + h * 128 + d0;
#pragma unroll
            for (int j = 0; j < 4; ++j) {
                const int tt = t + j - 2;
                const float okf = (tt >= 0 && tt < T) ? 1.0f : 0.0f;
                const int ttc = tt < 0 ? 0 : (tt >= T ? T - 1 : tt);
                const bf16_t* xp = p.P + (size_t)(sbase + ttc) * NP + C_GQKV + ccol;
                const u32x4 x0 = *(const u32x4*)xp, x1 = *(const u32x4*)(xp + 8);
                const float* wp = p.gdn_conv_w + (size_t)(l * 4 + j) * 1536 + ccol;
#pragma unroll
                for (int q = 0; q < 4; ++q) {
                    float4 w0 = *(const float4*)(wp + q * 4);
                    w0.x *= okf; w0.y *= okf; w0.z *= okf; w0.w *= okf;
                    const unsigned ua = q < 2 ? x0[2 * q] : x1[2 * q - 4], ub = q < 2 ? x0[2 * q + 1] : x1[2 * q - 3];
                    a[q * 4] += w0.x * bflo(ua); a[q * 4 + 1] += w0.y * bfhi(ua); a[q * 4 + 2] += w0.z * bflo(ub); a[q * 4 + 3] += w0.w * bfhi(ub);
                }
            }
            float ss = 0.f;
#pragma unroll
            for (int e = 0; e < 16; ++e) { a[e] = siluf_(a[e]); ss += a[e] * a[e]; }
            if (part < 2) {
                ss += __shfl_xor(ss, 1); ss += __shfl_xor(ss, 2); ss += __shfl_xor(ss, 4);
                const float scl = rsqrtf(ss + 1e-6f) * (part == 0 ? 0.08838834764831845f : 1.0f);
#pragma unroll
                for (int e = 0; e < 16; ++e) a[e] *= scl;
            }
            LAS bf16_t* dstt = (part == 0 ? qs : part == 1 ? ks_ : vs) + ti * 136 + d0;
            *(LAS u32x4*)dstt = pack8(a); *(LAS u32x4*)(dstt + 8) = pack8(a + 8);
        }
    }
    if (wid == 0) {
        const int tok = base + (d ? 63 - lane : lane);
        const float av = bf2f(p.P[(size_t)tok * NP + C_GA + d * 4 + h]);
        float v = -__expf(p.gdn_a_log[l * 8 + d * 4 + h]) * softplusf_(av + p.gdn_dt_bias[l * 8 + d * 4 + h]);
#pragma unroll
        for (int off = 1; off < 64; off <<= 1) { const float t = __shfl_up(v, off); if (lane >= off) v += t; }
        const float btv = sigmoidf_(bf2f(p.P[(size_t)tok * NP + C_GB + d * 4 + h]));
        bcs[lane] = v; bts[lane] = btv; rse[lane] = btv * __expf(v);
    }
    __syncthreads();
#pragma unroll
    for (int e = 0; e < 2; ++e) {
        const int f = wid * 2 + e, ib = f >> 2, jb = f & 3;
        const int i = 16 * ib + fr, j0 = 16 * jb + 4 * fq;
        f32x4 mk = (f32x4){0.f, 0.f, 0.f, 0.f}, mq = (f32x4){0.f, 0.f, 0.f, 0.f};
        if (jb <= ib) {
#pragma unroll
            for (int ks = 0; ks < 4; ++ks) {
                const bf16x8 xk = *(const LAS bf16x8*)(ks_ + (jb * 16 + fr) * 136 + ks * 32 + fq * 8);
                mk = mfma16(xk, *(const LAS bf16x8*)(ks_ + (ib * 16 + fr) * 136 + ks * 32 + fq * 8), mk);
                mq = mfma16(xk, *(const LAS bf16x8*)(qs + (ib * 16 + fr) * 136 + ks * 32 + fq * 8), mq);
            }
            const float bi = bcs[i], bti = bts[i];
#pragma unroll
            for (int r = 0; r < 4; ++r) {
                const int j = j0 + r;
                const float dec = __expf(j <= i ? bi - bcs[j] : 0.f);
                mk[r] = (j < i) ? bti * mk[r] * dec : 0.f;
                mq[r] = (j <= i) ? mq[r] * dec : 0.f;
            }
        }
        *(LAS f32x4*)(Mf + i * 68 + j0) = mk;
        *(LAS u32x2*)(att + i * 72 + j0) = pack4(mq);
    }
    __syncthreads();
    {
        const float sc_ = __expf(bcs[63] - bcs[ti]);
#pragma unroll
        for (int e = 0; e < 16; ++e) kT[(d0 + e) * 72 + ti] = (bf16_t)f2bf(bf2f(ks_[ti * 136 + d0 + e]) * sc_);
    }
    if (tid < 256) {
        const int cidx = tid & 127;
        const bool isw = tid >= 128;
        const LAS bf16_t* srcp = (isw ? ks_ : vs) + cidx;
        float x[64];
#pragma unroll
        for (int i = 0; i < 64; ++i) x[i] = bf2f(srcp[i * 136]);
        {
            unsigned mb = (unsigned)(size_t)Mf, rb = (unsigned)(size_t)(isw ? rse : bts);
            asm volatile("" : "+v"(mb), "+v"(rb));
            SolveRows<63>::run(x, (const LAS float*)(size_t)mb, (const LAS float*)(size_t)rb);
        }
        if (isw) {
#pragma unroll
            for (int i = 0; i < 64; ++i) x[i] = -x[i];
        }
        LAS bf16_t* dst = (isw ? wT : uT) + cidx * 72;
#pragma unroll
        for (int q = 0; q < 8; ++q) *(LAS u32x4*)(dst + q * 8) = pack8(x + q * 8);
    }
    if (tid < 128) p.ld[item * 128 + tid] = __expf(bcs[63]);
    __syncthreads();
    {
        const int tid = opaque_tid(), wid = tid >> 6, lane = tid & 63, fr = lane & 15, fq = lane >> 4;
        bf16x8 xw[2], xu[2], xk[2];
#pragma unroll
        for (int ks = 0; ks < 2; ++ks) {
            xw[ks] = *(const LAS bf16x8*)(wT + (wid * 16 + fr) * 72 + ks * 32 + fq * 8);
            xu[ks] = *(const LAS bf16x8*)(uT + (wid * 16 + fr) * 72 + ks * 32 + fq * 8);
            xk[ks] = *(const LAS bf16x8*)(kT + (wid * 16 + fr) * 72 + ks * 32 + fq * 8);
        }
#pragma unroll
        for (int ib = 0; ib < 4; ++ib) {
            const int i = ib * 16 + fr;
            const u32x2 qr = *(const LAS u32x2*)(qs + i * 136 + wid * 16 + 4 * fq);
            const float eb = __expf(bcs[i]);
            f32x4 aq = (f32x4){bflo(qr[0]) * eb, bfhi(qr[0]) * eb, bflo(qr[1]) * eb, bfhi(qr[1]) * eb};
            f32x4 ao = (f32x4){0.f, 0.f, 0.f, 0.f};
#pragma unroll
            for (int ks = 0; ks < 2; ++ks) {
                const bf16x8 ya = *(const LAS bf16x8*)(att + i * 72 + ks * 32 + fq * 8);
                aq = mfma16(xw[ks], ya, aq); ao = mfma16(xu[ks], ya, ao);
            }
            *(u32x2*)(p.lq + item * 8192 + ((ib * 8 + wid) * 64 + lane) * 4) = pack4(aq);
            *(u32x2*)(p.lo + item * 8192 + ((wid * 4 + ib) * 64 + lane) * 4) = pack4(ao);
        }
#pragma unroll
        for (int db = 0; db < 8; ++db) {
            f32x4 aa = (f32x4){0.f, 0.f, 0.f, 0.f}, ab = (f32x4){0.f, 0.f, 0.f, 0.f};
#pragma unroll
            for (int ks = 0; ks < 2; ++ks) {
                aa = mfma16(xw[ks], *(const LAS bf16x8*)(kT + (db * 16 + fr) * 72 + ks * 32 + fq * 8), aa);
                ab = mfma16(xk[ks], *(const LAS bf16x8*)(uT + (db * 16 + fr) * 72 + ks * 32 + fq * 8), ab);
            }
            *(u32x2*)(p.la + item * 16384 + ((db * 8 + wid) * 64 + lane) * 4) = pack4(aa);
            *(u32x2*)(p.lb + item * 16384 + ((wid * 8 + db) * 64 + lane) * 4) = pack4(ab);
        }
    }
    __syncthreads();
}

__device__ __forceinline__ void ph_local(const Params& p, int l, LAS unsigned char* lds) {
    for (int it = blockIdx.x; it < 3 * NITEM; it += gridDim.x) {
        const int tz = it % 3, ci = it / 3, chain = ci / NCHUNK, n = ci % NCHUNK;
        if (tz == 0) local_gdn(p, l, chain, n, lds); else local_gla(p, l, tz, chain, n, lds);
    }
}

__device__ __forceinline__ void seq_matrix(const Params& p, int tz, int chain, int half, LAS unsigned char* lds) {
    const int tid = opaque_tid(), wid = tid >> 6, lane = tid & 63, fr = lane & 15, fq = lane >> 4;
    const int b = chain >> 3, h = (chain >> 1) & 3, d = chain & 1;
    LAS bf16_t* ST = (LAS bf16_t*)lds;
    float* Op = p.O + (size_t)((tz == 0 ? 0 : tz == 1 ? 1 : 3) * 2 + d) * TOKW;
    f32x4 S[4];
#pragma unroll
    for (int q = 0; q < 4; ++q) S[q] = (f32x4){0.f, 0.f, 0.f, 0.f};
    const int ib = wid >> 1, dv2 = (wid & 1) * 2;
    for (int n = 0; n < NCHUNK; ++n) {
        const size_t item = (size_t)tz * NITEM + (size_t)chain * NCHUNK + n;
        bf16x8 yq[4], xa[4];
#pragma unroll
        for (int ks = 0; ks < 4; ++ks) {
            const u32x2 a = *(const u32x2*)(p.lq + item * 8192 + ((ib * 8 + 2 * ks) * 64 + lane) * 4), b2 = *(const u32x2*)(p.lq + item * 8192 + ((ib * 8 + 2 * ks + 1) * 64 + lane) * 4);
            u32x4 t; t[0] = a[0]; t[1] = a[1]; t[2] = b2[0]; t[3] = b2[1]; yq[ks] = __builtin_bit_cast(bf16x8, t);
        }
        if (tz == 0) {
#pragma unroll
            for (int ks = 0; ks < 4; ++ks) {
                const bf16_t* lap = p.la + ((size_t)chain * NCHUNK + n) * 16384;
                const u32x2 a = *(const u32x2*)(lap + ((wid * 8 + 2 * ks) * 64 + lane) * 4), b2 = *(const u32x2*)(lap + ((wid * 8 + 2 * ks + 1) * 64 + lane) * 4);
                u32x4 t; t[0] = a[0]; t[1] = a[1]; t[2] = b2[0]; t[3] = b2[1]; xa[ks] = __builtin_bit_cast(bf16x8, t);
            }
        }
        u32x2 oin[2], bin[4];
#pragma unroll
        for (int e = 0; e < 2; ++e) oin[e] = *(const u32x2*)(p.lo + item * 8192 + (((half * 4 + dv2 + e) * 4 + ib) * 64 + lane) * 4);
#pragma unroll
        for (int q = 0; q < 4; ++q) bin[q] = *(const u32x2*)(p.lb + item * 16384 + ((wid * 8 + half * 4 + q) * 64 + lane) * 4);
        const f32x4 dec = *(const f32x4*)(p.ld + item * 128 + wid * 16 + 4 * fq);
        LAS bf16_t* st = ST + (n & 1) * 64 * 136;
#pragma unroll
        for (int q = 0; q < 4; ++q) *(LAS u32x2*)(st + (q * 16 + fr) * 136 + 32 * (wid >> 1) + 8 * fq + 4 * (wid & 1)) = pack4(S[q]);
        __syncthreads();
        const int base = chunk_base(b, d, n);
        const int tok = base + (d ? 63 - (ib * 16 + fr) : ib * 16 + fr);
#pragma unroll
        for (int e = 0; e < 2; ++e) {
            f32x4 acc = (f32x4){bflo(oin[e][0]), bfhi(oin[e][0]), bflo(oin[e][1]), bfhi(oin[e][1])};
#pragma unroll
            for (int ks = 0; ks < 4; ++ks) acc = mfma16(*(const LAS bf16x8*)(st + ((dv2 + e) * 16 + fr) * 136 + ks * 32 + fq * 8), yq[ks], acc);
            *(f32x4*)(Op + (size_t)tok * MW + h * 128 + half * 64 + (dv2 + e) * 16 + 4 * fq) = acc;
        }
#pragma unroll
        for (int q = 0; q < 4; ++q) {
            f32x4 acc = (f32x4){dec[0] * S[q][0] + bflo(bin[q][0]), dec[1] * S[q][1] + bfhi(bin[q][0]), dec[2] * S[q][2] + bflo(bin[q][1]), dec[3] * S[q][3] + bfhi(bin[q][1])};
            if (tz == 0) {
#pragma unroll
                for (int ks = 0; ks < 4; ++ks) acc = mfma16(xa[ks], *(const LAS bf16x8*)(st + (q * 16 + fr) * 136 + ks * 32 + fq * 8), acc);
            }
            S[q] = acc;
        }
    }
    __syncthreads();
}

__device__ __forceinline__ void seq_lru(const Params& p, int b, int d, int cg, LAS unsigned char* lds) {
    const int tid = opaque_tid(), seg = tid >> 6, ch = cg * 64 + (tid & 63);
    LAS float* sP = (LAS float*)lds;
    LAS float* sL = sP + 512;
    const float* A = p.prep + (size_t)(PR_LA + d) * TOKW + ch; const float* U = p.prep + (size_t)(PR_LU + d) * TOKW + ch;
    float* Op = p.O + (size_t)(2 * 2 + d) * TOKW + ch;
    constexpr int SEG = (TC + TL) / 8;
    auto tok_of = [&](int pos) { return pos < TC ? NLAT + b * TC + (d ? TC - 1 - pos : pos) : b * TL + (d ? TL - 1 - (pos - TC) : pos - TC); };
    float P = 1.f, L = 0.f;
    for (int i0 = 0; i0 < SEG; i0 += 8) {
        float av[8], uv[8];
#pragma unroll
        for (int q = 0; q < 8; ++q) { const size_t o = (size_t)tok_of(seg * SEG + i0 + q) * MW; av[q] = A[o]; uv[q] = U[o]; }
#pragma unroll
        for (int q = 0; q < 8; ++q) { L = av[q] * L + uv[q]; P *= av[q]; }
    }
    sP[tid] = P; sL[tid] = L;
    __syncthreads();
    float hst = 0.f;
    for (int s = 0; s < seg; ++s) hst = sP[s * 64 + (tid & 63)] * hst + sL[s * 64 + (tid & 63)];
    for (int i0 = 0; i0 < SEG; i0 += 8) {
        float av[8], uv[8]; size_t oo[8];
#pragma unroll
        for (int q = 0; q < 8; ++q) { oo[q] = (size_t)tok_of(seg * SEG + i0 + q) * MW; av[q] = A[oo[q]]; uv[q] = U[oo[q]]; }
#pragma unroll
        for (int q = 0; q < 8; ++q) { hst = av[q] * hst + uv[q]; Op[oo[q]] = hst; }
    }
    __syncthreads();
}

__device__ __forceinline__ void ph_seq(const Params& p, LAS unsigned char* lds) {
    for (int it = blockIdx.x; it < 256; it += gridDim.x) {
        if (it < 192) { const int tz = it >> 6, r = it & 63; seq_matrix(p, tz, r >> 1, r & 1, lds); }
        else { const int r = it - 192; seq_lru(p, r >> 4, (r >> 3) & 1, r & 7, lds); }
    }
}

__device__ __forceinline__ void ph_merge(const Params& p, int l, int M) {
    const int tid = opaque_tid(), wid = tid >> 6, lane = tid & 63;
    for (int id = blockIdx.x * NWAVES + wid; id < M * 16; id += gridDim.x * NWAVES) {
        const int tok = id >> 4, r = id & 15, m = r >> 2, head = r & 3;
        const int cidx = head * 128 + lane * 2;
        const size_t o = (size_t)tok * MW + cidx;
        const f32x2 o0 = *(const f32x2*)(p.O + (size_t)(m * 2) * TOKW + o), o1 = *(const f32x2*)(p.O + (size_t)(m * 2 + 1) * TOKW + o);
        const float a0 = o0[0] + o1[0], a1 = o0[1] + o1[1];
        float y0, y1; int nbr;
        if (m == 2) {
            const unsigned u = *(const unsigned*)(p.P + (size_t)tok * NP + C_LY + cidx);
            y0 = a0 * gelu_tanhf_(bflo(u)); y1 = a1 * gelu_tanhf_(bfhi(u)); nbr = 2;
        } else {
            const float ss = wave_sum(a0 * a0 + a1 * a1);
            const float rinv = rsqrtf(ss * (1.0f / 128.0f) + 1e-6f);
            const float* gp = (m == 0 ? p.gdn_norm_g : m == 1 ? p.hgrn_norm_g : p.ret_norm_g) + l * 128 + lane * 2;
            const int zc = m == 0 ? C_GZ : m == 1 ? C_HG : C_RG;
            const unsigned u = *(const unsigned*)(p.P + (size_t)tok * NP + zc + cidx);
            y0 = a0 * rinv * gp[0] * siluf_(bflo(u)); y1 = a1 * rinv * gp[1] * siluf_(bfhi(u)); nbr = m == 3 ? 3 : m;
        }
        *(unsigned*)(p.Y + (size_t)nbr * TOKW + o) = pack2(y0, y1);
    }
}

__device__ __forceinline__ void ph_g2(const Params& p, int l, int M, LAS unsigned char* lds) {
    const StageRC s = my_stage_rc();
    const int tid = opaque_tid(), wid = tid >> 6, lane = tid & 63, wr = wid >> 1, wc = wid & 1, fr = lane & 15, fq = lane >> 4;
    const int ntm = M / 256;
    for (int u = blockIdx.x; u < ntm * 8; u += gridDim.x) {
        const int pm = u >> 3, pn = u & 7;
        f32x4 acc[4][4]; gm::zero_acc(acc);
        for (int nb = 0; nb < 4; ++nb) {
            const bf16_t* a0 = p.Y + (size_t)nb * TOKW + (size_t)(pm * 256) * MW;
            const bf16_t* Bt = p.wbT + (size_t)(l * 4 + nb) * D * MW + (size_t)(pn * 128) * MW;
            gm::kloop(lds, a0 + (size_t)s.R0 * MW + s.C0, a0 + (size_t)s.R1 * MW + s.C1, a0 + (size_t)(128 + s.R0) * MW + s.C0, a0 + (size_t)(128 + s.R1) * MW + s.C1,
                      Bt + (size_t)s.R0 * MW + s.C0, Bt + (size_t)s.R1 * MW + s.C1, MW, acc);
#pragma unroll
            for (int m = 0; m < 4; ++m)
#pragma unroll
                for (int n = 0; n < 4; ++n) {
                    const int row = pm * 256 + wr * 64 + m * 16 + fr, col = pn * 128 + wc * 64 + n * 16 + fq * 4;
                    const bf16_t* gp = p.P + (size_t)row * NP + C_MG + nb * D + col;
                    const u32x2 gu = *(const u32x2*)gp;
                    const float e0 = __expf(-bflo(gu[0])), e1 = __expf(-bfhi(gu[0])), e2 = __expf(-bflo(gu[1])), e3 = __expf(-bfhi(gu[1]));
                    float n0 = 1.f, n1 = 1.f, n2 = 1.f, n3 = 1.f;
                    if (nb < 3) { const u32x2 gn = *(const u32x2*)(gp + D);
                        n0 = 1.f + __expf(-bflo(gn[0])); n1 = 1.f + __expf(-bfhi(gn[0])); n2 = 1.f + __expf(-bflo(gn[1])); n3 = 1.f + __expf(-bfhi(gn[1])); }
                    acc[m][n][0] *= n0 / (1.f + e0); acc[m][n][1] *= n1 / (1.f + e1); acc[m][n][2] *= n2 / (1.f + e2); acc[m][n][3] *= n3 / (1.f + e3);
                }
        }
#pragma unroll
        for (int m = 0; m < 4; ++m)
#pragma unroll
            for (int n = 0; n < 4; ++n) {
                const int row = pm * 256 + wr * 64 + m * 16 + fr, col = pn * 128 + wc * 64 + n * 16 + fq * 4;
                u32x2 o; o[0] = pack2(acc[m][n][0], acc[m][n][1]); o[1] = pack2(acc[m][n][2], acc[m][n][3]);
                *(u32x2*)(p.mix + (size_t)row * D + col) = o;
            }
    }
}

template <bool DRY = false> __device__ __forceinline__ void ph_g3(const Params& p, int l, int M, LAS unsigned char* lds) {
    const StageRC s = my_stage_rc();
    const int tid = opaque_tid(), wid = tid >> 6, lane = tid & 63, wr = wid >> 1, wc = wid & 1, fr = lane & 15, fq = lane >> 4;
    const int ntm = M / 256;
    for (int u = blockIdx.x; u < ntm * 8; u += gridDim.x) {
        const int pm = u >> 3, pn = u & 7;
        const bf16_t* a0 = p.mix + (size_t)(pm * 256) * D;
        const bf16_t* Bt = p.woutT + (size_t)l * D * D + (size_t)(pn * 128) * D;
        f32x4 acc[4][4]; gm::zero_acc(acc);
        gm::kloop(lds, a0 + (size_t)s.R0 * D + s.C0, a0 + (size_t)s.R1 * D + s.C1, a0 + (size_t)(128 + s.R0) * D + s.C0, a0 + (size_t)(128 + s.R1) * D + s.C1,
                  Bt + (size_t)s.R0 * D + s.C0, Bt + (size_t)s.R1 * D + s.C1, D, acc);
#pragma unroll
        for (int m = 0; m < 4; ++m)
#pragma unroll
            for (int n = 0; n < 4; ++n) {
                const int row = pm * 256 + wr * 64 + m * 16 + fr, col = pn * 128 + wc * 64 + n * 16 + fq * 4;
                const float4 gt = *(const float4*)(p.mod + (size_t)(l * 5 + tok_modrow(row)) * (NMOD * D) + 2 * D + col);
                float4* xp = (float4*)(p.xl + (size_t)row * D + col);
                float4 xv = *xp;
                if (DRY) xp = (float4*)(p.prep + (size_t)row * D + col);
                xv.x += gt.x * acc[m][n][0]; xv.y += gt.y * acc[m][n][1]; xv.z += gt.z * acc[m][n][2]; xv.w += gt.w * acc[m][n][3];
                *xp = xv;
            }
    }
}

template <bool DRY = false> __device__ __forceinline__ void ph_route(const Params& p, int l, int M, LAS unsigned char* lds) {
    int* const r_cnt = DRY ? p.cnt + 64 : p.cnt; int* const r_list = DRY ? (int*)p.act : p.list; int* const r_ts = DRY ? (int*)p.yp : p.tokslot; float* const r_tw = DRY ? (float*)p.yp + (size_t)NTOK * 4 : p.topw;
    LAS float* fs = (LAS float*)lds;
    LAS float* lg = fs + 32 * 1028;
    const int tid = opaque_tid(), wid = tid >> 6, lane = tid & 63;
    const float* rw = p.router_w + (size_t)l * D * NE;
    for (int it = blockIdx.x; it < M / 32; it += gridDim.x) {
        const int tok0 = it * 32;
        for (int q = 0; q < 4; ++q) {
            const int tl = wid * 4 + q, tok = tok0 + tl;
            const float* src = p.xl + (size_t)tok * D;
            float4 v[4]; float ss = 0.f;
#pragma unroll
            for (int i = 0; i < 4; ++i) { v[i] = *(const float4*)(src + i * 256 + lane * 4); ss += v[i].x * v[i].x + v[i].y * v[i].y + v[i].z * v[i].z + v[i].w * v[i].w; }
            ss = wave_sum(ss);
            const float rinv = rsqrtf(ss * (1.0f / D) + 1e-6f);
            const float* mb = p.mod + (size_t)(l * 5 + tok_modrow(tok)) * (NMOD * D);
#pragma unroll
            for (int i = 0; i < 4; ++i) {
                const int cidx = i * 256 + lane * 4;
                const float4 gv = *(const float4*)(p.norm2_g + l * D + cidx), sv = *(const float4*)(mb + 4 * D + cidx), hv = *(const float4*)(mb + 3 * D + cidx);
                const float h0 = v[i].x * rinv * gv.x * (1.f + sv.x) + hv.x, h1 = v[i].y * rinv * gv.y * (1.f + sv.y) + hv.y;
                const float h2 = v[i].z * rinv * gv.z * (1.f + sv.z) + hv.z, h3 = v[i].w * rinv * gv.w * (1.f + sv.w) + hv.w;
                u32x2 o; o[0] = pack2(h0, h1); o[1] = pack2(h2, h3);
                *(u32x2*)(p.F + (size_t)tok * D + cidx) = o;
                *(LAS f32x4*)(fs + tl * 1028 + cidx) = (f32x4){h0, h1, h2, h3};
            }
        }
        __syncthreads();
        {
            typedef float f32x16 __attribute__((ext_vector_type(16)));
            f32x16 acc;
#pragma unroll
            for (int r = 0; r < 16; ++r) acc[r] = 0.f;
            const int tk = lane & 31, hh = lane >> 5;
            const LAS float* ap = fs + tk * 1028 + wid * 128 + 4 * hh;
            const float* bp = rw + (size_t)(wid * 128 + 4 * hh) * NE + tk;
#pragma unroll 4
            for (int kk = 0; kk < 16; ++kk) {
                const f32x4 a4 = *(const LAS f32x4*)(ap + kk * 8);
                const float b0 = bp[(kk * 8 + 0) * NE], b1 = bp[(kk * 8 + 1) * NE], b2 = bp[(kk * 8 + 2) * NE], b3 = bp[(kk * 8 + 3) * NE];
                acc = __builtin_amdgcn_mfma_f32_32x32x2f32(a4[0], b0, acc, 0, 0, 0);
                acc = __builtin_amdgcn_mfma_f32_32x32x2f32(a4[1], b1, acc, 0, 0, 0);
                acc = __builtin_amdgcn_mfma_f32_32x32x2f32(a4[2], b2, acc, 0, 0, 0);
                acc = __builtin_amdgcn_mfma_f32_32x32x2f32(a4[3], b3, acc, 0, 0, 0);
            }
            __syncthreads();
            LAS float* red = fs;
#pragma unroll
            for (int r = 0; r < 16; ++r) red[(wid * 32 + (r & 3) + 8 * (r >> 2) + 4 * hh) * 33 + tk] = acc[r];
            __syncthreads();
            const int t2 = tid >> 4, e0 = (tid & 15) * 2;
            float s0 = p.router_b[l * NE + e0], s1 = p.router_b[l * NE + e0 + 1];
#pragma unroll
            for (int w = 0; w < 8; ++w) { s0 += red[(w * 32 + t2) * 33 + e0]; s1 += red[(w * 32 + t2) * 33 + e0 + 1]; }
            lg[t2 * 33 + e0] = s0; lg[t2 * 33 + e0 + 1] = s1;
        }
        __syncthreads();
        if (tid < 32) {
            const int tok = tok0 + tid;
            float vals[4]; int idxs[4]; unsigned used = 0u;
#pragma unroll
            for (int k = 0; k < 4; ++k) {
                float best = -3.0e38f; int bi = 0;
                for (int e = 0; e < NE; ++e) { const float v = lg[tid * 33 + e]; if (!((used >> e) & 1u) && v > best) { best = v; bi = e; } }
                used |= 1u << bi; vals[k] = best; idxs[k] = bi;
            }
            const float mx = vals[0];
            float ex[4], sum = 0.f;
#pragma unroll
            for (int k = 0; k < 4; ++k) { ex[k] = __expf(vals[k] - mx); sum += ex[k]; }
            const float inv = 1.0f / sum;
#pragma unroll
            for (int k = 0; k < 4; ++k) {
                const int e = idxs[k];
                const int slot = atomicAdd(r_cnt + l * NE + e, 1);
                r_list[(size_t)e * NTOK + slot] = tok;
                r_ts[(size_t)tok * 4 + k] = (e << 16) | slot;
                r_tw[(size_t)tok * 4 + k] = ex[k] * inv;
            }
        }
        __syncthreads();
    }
}

__device__ __forceinline__ void build_expert_tables(const Params& p, int l, LAS int* ts, LAS int* cn, LAS int* te) {
    const int tid = opaque_tid();
    if (tid < 64) {
        const int c = tid < NE ? p.cnt[l * NE + tid] : 0;
        const int nt = (c + 255) >> 8;
        int v = nt;
#pragma unroll
        for (int off = 1; off < 32; off <<= 1) { const int t = __shfl_up(v, off); if (tid >= off) v += t; }
        if (tid < NE) { cn[tid] = c; ts[tid] = v - nt; if (tid == NE - 1) ts[NE] = v; }
        if (te && tid < NE) for (int q = 0; q < nt; ++q) te[v - nt + q] = tid;
    }
    __syncthreads();
}

struct MoeSched {
    const LAS int* ts; const LAS int* cn; const LAS int* te; const int* list; const bf16_t* A; const bf16_t* Bt; const float* bias; int K, npn, nunits, G, c, nrowsB, nbias; bool gather;
    static constexpr bool HAS_BIAS = true;
    __device__ __forceinline__ bool next(int i, g8::Unit& u) const {
        const long L = (long)i * G + c; if (L >= nunits) return false;
        u.pm = (int)(L / npn); u.pn = (int)(L % npn); u.e = te[u.pm]; return true;
    }
    __device__ __forceinline__ const char* a_base(const g8::Unit& u) const { return (const char*)(gather ? A : A + (size_t)u.pm * 256 * K); }
    __device__ __forceinline__ const char* b_base(const g8::Unit& u) const { return (const char*)(Bt + ((size_t)u.e * nrowsB + (size_t)u.pn * 256) * K); }
    __device__ __forceinline__ const int* row_addr(const g8::Unit& u, int R) const {
        const int cnt = cn[u.e], sl = (u.pm - ts[u.e]) * 256 + R;
        return list + (size_t)u.e * NTOK + (sl < cnt ? sl : 0);
    }
    __device__ __forceinline__ int rows_valid(const g8::Unit& u) const { return cn[u.e] - (u.pm - ts[u.e]) * 256; }
    __device__ __forceinline__ const float* bias_src(const g8::Unit& u, int lane) const {
        if (nbias == 2) return bias + (size_t)u.e * 2 * D + (lane < 32 ? u.pn * 128 + lane * 4 : D + u.pn * 128 + (lane - 32) * 4);
        return bias + (size_t)u.e * D + u.pn * 256 + lane * 4;
    }
};
struct EpiAct {
    bf16_t* O;
    __device__ __forceinline__ void operator()(const f32x4 (&acc)[2][2][4][2], const g8::Unit& u, int wr, int wc, int fr, int fq, const LAS float* bias) const {
        const int row0 = u.pm * 256 + wr * 64 + fr, col0 = u.pn * 128 + wc * 32 + 8 * fq;
        const LAS float* bb = bias + wc * 32 + 8 * fq;
        const f32x4 g0 = *(const LAS f32x4*)bb, g1 = *(const LAS f32x4*)(bb + 4), l0 = *(const LAS f32x4*)(bb + 128), l1 = *(const LAS f32x4*)(bb + 132);
        const float bg[8] = {g0[0], g0[1], g0[2], g0[3], g1[0], g1[1], g1[2], g1[3]}, bl[8] = {l0[0], l0[1], l0[2], l0[3], l1[0], l1[1], l1[2], l1[3]};
#pragma unroll
        for (int ai = 0; ai < 2; ++ai)
#pragma unroll
            for (int m = 0; m < 4; ++m) {
                float o[8];
#pragma unroll
                for (int n = 0; n < 2; ++n)
#pragma unroll
                    for (int j = 0; j < 4; ++j) {
                        const float glu = fminf(acc[ai][0][m][n][j] + bg[n * 4 + j], 7.0f);
                        const float lin = fminf(fmaxf(acc[ai][1][m][n][j] + bl[n * 4 + j], -7.0f), 7.0f);
                        o[n * 4 + j] = glu * sigmoidf_(1.702f * glu) * (lin + 1.0f);
                    }
                *(u32x4*)(O + (size_t)(row0 + ai * 128 + m * 16) * D + col0) = pack8(o);
            }
    }
};
__device__ __forceinline__ void ph_g4(const Params& p, int l, LAS unsigned char* lds) {
    LAS int* ts = (LAS int*)(lds + g8::STAGE_BYTES); LAS int* cn = ts + 40; LAS int* te = ts + 80;
    build_expert_tables(p, l, ts, cn, te);
    MoeSched S; S.ts = ts; S.cn = cn; S.te = te; S.list = p.list; S.A = p.F; S.Bt = p.w1T + (size_t)l * NE * 2 * D * D; S.bias = p.moe_b1 + (size_t)l * NE * 2 * D; S.nbias = 2;
    S.K = D; S.npn = 8; S.nunits = ts[NE] * 8; S.G = gridDim.x; S.c = blockIdx.x; S.nrowsB = 2 * D; S.gather = true;
    EpiAct E; E.O = p.act;
    g8::gemm_phase(lds, D, S, E);
}

struct EpiYp {
    bf16_t* O;
    __device__ __forceinline__ void operator()(const f32x4 (&acc)[2][2][4][2], const g8::Unit& u, int wr, int wc, int fr, int fq, const LAS float* bias) const {
        const int row0 = u.pm * 256 + wr * 64 + fr, col0 = u.pn * 256 + wc * 32 + 8 * fq;
#pragma unroll
        for (int bj = 0; bj < 2; ++bj) {
            const LAS float* bb = bias + bj * 128 + wc * 32 + 8 * fq;
            const f32x4 c0v = *(const LAS f32x4*)bb, c1v = *(const LAS f32x4*)(bb + 4);
            const float4 c0 = make_float4(c0v[0], c0v[1], c0v[2], c0v[3]), c1 = make_float4(c1v[0], c1v[1], c1v[2], c1v[3]);
#pragma unroll
            for (int ai = 0; ai < 2; ++ai)
#pragma unroll
                for (int m = 0; m < 4; ++m) {
                    u32x4 w; w[0] = pack2(acc[ai][bj][m][0][0] + c0.x, acc[ai][bj][m][0][1] + c0.y); w[1] = pack2(acc[ai][bj][m][0][2] + c0.z, acc[ai][bj][m][0][3] + c0.w);
                    w[2] = pack2(acc[ai][bj][m][1][0] + c1.x, acc[ai][bj][m][1][1] + c1.y); w[3] = pack2(acc[ai][bj][m][1][2] + c1.z, acc[ai][bj][m][1][3] + c1.w);
                    *(u32x4*)(O + (size_t)(row0 + ai * 128 + m * 16) * D + col0 + bj * 128) = w;
                }
        }
    }
};
__device__ __forceinline__ void ph_g5(const Params& p, int l, LAS unsigned char* lds) {
    LAS int* ts = (LAS int*)(lds + g8::STAGE_BYTES); LAS int* cn = ts + 40; LAS int* te = ts + 80;
    build_expert_tables(p, l, ts, cn, te);
    MoeSched S; S.ts = ts; S.cn = cn; S.te = te; S.list = p.list; S.A = p.act; S.Bt = p.w2T + (size_t)l * NE * D * D; S.bias = p.moe_b2 + (size_t)l * NE * D; S.nbias = 1;
    S.K = D; S.npn = 4; S.nunits = ts[NE] * 4; S.G = gridDim.x; S.c = blockIdx.x; S.nrowsB = D; S.gather = false;
    EpiYp E; E.O = p.yp;
    g8::gemm_phase(lds, D, S, E);
}

template <bool DRY = false> __device__ __forceinline__ void ph_combine(const Params& p, int l, int M, LAS unsigned char* lds) {
    float* const c_xl = DRY ? p.prep : p.xl; bf16_t* const c_H = DRY ? (bf16_t*)(p.prep + (size_t)NTOK * D) : p.H; float* const c_out = DRY ? p.prep : p.out;
    LAS int* ts = (LAS int*)lds; LAS int* cn = ts + 40;
    build_expert_tables(p, l, ts, cn, nullptr);
    const int tid = opaque_tid(), wid = tid >> 6, lane = tid & 63;
    const bool last = (l == 1);
    for (int tok = blockIdx.x * NWAVES + wid; tok < M; tok += gridDim.x * NWAVES) {
        float4 v[4];
        const float* mb = p.mod + (size_t)(l * 5 + tok_modrow(tok)) * (NMOD * D);
        int rows[4]; float wts[4];
#pragma unroll
        for (int k = 0; k < 4; ++k) { const int tsl = p.tokslot[(size_t)tok * 4 + k]; rows[k] = ts[tsl >> 16] * 256 + (tsl & 0xffff); wts[k] = p.topw[(size_t)tok * 4 + k]; }
        float ss = 0.f;
#pragma unroll
        for (int i = 0; i < 4; ++i) {
            const int cidx = i * 256 + lane * 4;
            float m0 = 0.f, m1 = 0.f, m2 = 0.f, m3 = 0.f;
#pragma unroll
            for (int k = 0; k < 4; ++k) {
                const u32x2 u = *(const u32x2*)(p.yp + (size_t)rows[k] * D + cidx);
                m0 += wts[k] * bflo(u[0]); m1 += wts[k] * bfhi(u[0]); m2 += wts[k] * bflo(u[1]); m3 += wts[k] * bfhi(u[1]);
            }
            const float4 gt = *(const float4*)(mb + 5 * D + cidx);
            float4 xv = *(const float4*)(p.xl + (size_t)tok * D + cidx);
            xv.x += gt.x * m0; xv.y += gt.y * m1; xv.z += gt.z * m2; xv.w += gt.w * m3;
            v[i] = xv; ss += xv.x * xv.x + xv.y * xv.y + xv.z * xv.z + xv.w * xv.w;
        }
        ss = wave_sum(ss);
        const float rinv = rsqrtf(ss * (1.0f / D) + 1e-6f);
        if (!last) {
#pragma unroll
            for (int i = 0; i < 4; ++i) *(float4*)(c_xl + (size_t)tok * D + i * 256 + lane * 4) = v[i];
            const float* mb1 = p.mod + (size_t)((l + 1) * 5 + tok_modrow(tok)) * (NMOD * D);
            norm_mod_store(v, rinv, p.norm1_g + (l + 1) * D, mb1 + 1 * D, mb1 + 0 * D, c_H + (size_t)tok * D, lane);
        } else {
#pragma unroll
            for (int i = 0; i < 4; ++i) {
                const int cidx = i * 256 + lane * 4;
                const float4 gv = *(const float4*)(p.final_norm_g + cidx);
                *(float4*)(c_out + (size_t)tok * D + cidx) = make_float4(v[i].x * rinv * gv.x, v[i].y * rinv * gv.y, v[i].z * rinv * gv.z, v[i].w * rinv * gv.w);
            }
        }
    }
}

#define XB_TMO      128
#define XB_XCNT(j)  (256  + 64 * (j))
#define XB_XSUB(j)  (1280 + 64 * (j))
#define XB_XGEN(j)  (2304 + 64 * (j))
#define XB_TOP      3328
#define XB_TOPGEN   3392
#define XCD_BAR_WORDS 3456
#define XB_SPIN_CAP (1u << 18)

__device__ __forceinline__ unsigned xb_ld(unsigned* p)              { return __hip_atomic_load(p, __ATOMIC_RELAXED, __HIP_MEMORY_SCOPE_AGENT); }
__device__ __forceinline__ unsigned xb_add(unsigned* p, unsigned v) { return __hip_atomic_fetch_add(p, v, __ATOMIC_RELAXED, __HIP_MEMORY_SCOPE_AGENT); }
__device__ __forceinline__ unsigned xb_xcc_id() { return (unsigned)__builtin_amdgcn_s_getreg((3 << 11) | 20) & 0xFu; }
#define XB_SPIN(cond, bar) do { unsigned _sp = 0; while (cond) { __builtin_amdgcn_s_sleep(1); \
    if ((++_sp & 255u) == 0u) { if (xb_ld(&(bar)[XB_TMO])) break; if (_sp > XB_SPIN_CAP) { atomicAdd(&(bar)[XB_TMO], 1u); break; } } } } while (0)

struct XcdBarrier {
    unsigned* bar; unsigned x;
    volatile LAS unsigned* st;
};

__device__ __forceinline__ XcdBarrier xcd_barrier_post(unsigned* bar, volatile LAS unsigned* st) {
    XcdBarrier b; b.bar = bar; b.x = xb_xcc_id(); b.st = st;
    if (threadIdx.x == 0) (void)xb_add(&bar[XB_XCNT(b.x)], 1u);
    return b;
}
__device__ __forceinline__ void xcd_barrier_complete(unsigned* bar, unsigned x, unsigned& nloc, unsigned& nx) {
    const unsigned G = gridDim.x * gridDim.y * gridDim.z;
    unsigned sum, cnt, mine, sp = 0u;
    for (;;) {
        sum = 0u; cnt = 0u; mine = 0u;
#pragma unroll
        for (unsigned j = 0; j < 16; ++j) { const unsigned c = xb_ld(&bar[XB_XCNT(j)]); sum += c; cnt += (c > 0u) ? 1u : 0u; mine = (j == x) ? c : mine; }
        if (sum == G) break;
        __builtin_amdgcn_s_sleep(1);
        if ((++sp & 255u) == 0u) { if (xb_ld(&bar[XB_TMO])) break; if (sp > XB_SPIN_CAP) { atomicAdd(&bar[XB_TMO], 1u); break; } }
    }
    nloc = mine > 0u ? mine : 1u; nx = cnt > 0u ? cnt : 1u;
}

__device__ __forceinline__ void xcd_barrier(const XcdBarrier& b) {
    asm volatile("s_waitcnt vmcnt(0)" ::: "memory");
    __syncthreads();
    if (threadIdx.x == 0) {
        unsigned* bar = b.bar;
        __builtin_amdgcn_s_waitcnt(0);
        unsigned nloc = b.st[0], nx = b.st[1];
        if (nloc == 0u) { xcd_barrier_complete(bar, b.x, nloc, nx); b.st[0] = nloc; b.st[1] = nx; }
        const unsigned old = xb_add(&bar[XB_XSUB(b.x)], 1u);
        const unsigned gen = old / nloc;
        if (old + 1u == (gen + 1u) * nloc) {
            __builtin_amdgcn_fence(__ATOMIC_RELEASE, "agent");
            asm volatile("s_waitcnt vmcnt(0)" ::: "memory");
            const unsigned og = xb_add(&bar[XB_TOP], 1u);
            const unsigned tg = og / nx;
            if (og + 1u == (tg + 1u) * nx) xb_add(&bar[XB_TOPGEN], 1u);
            else XB_SPIN(xb_ld(&bar[XB_TOPGEN]) == tg, bar);
            __builtin_amdgcn_fence(__ATOMIC_ACQUIRE, "agent");
            xb_add(&bar[XB_XGEN(b.x)], 1u);
            asm volatile("s_waitcnt vmcnt(0)" ::: "memory");
        } else {
            XB_SPIN(xb_ld(&bar[XB_XGEN(b.x)]) == gen, bar);
            __builtin_amdgcn_fence(__ATOMIC_ACQUIRE, "agent");
            asm volatile("s_waitcnt vmcnt(0)" ::: "memory");
        }
    }
    __syncthreads();
}


extern __shared__ __attribute__((aligned(16))) unsigned char dyn_lds[];
#define KPH(name, call) __global__ void __launch_bounds__(NTHREADS, 2) name(Params p, int l, int M) { LAS unsigned char* lds = (LAS unsigned char*)dyn_lds; (void)l; (void)M; (void)lds; call; }
KPH(k_convert, { ph_convert(p, lds); })
KPH(k_mod, { ph_mod(p, lds); })
KPH(k_norm1, { ph_norm1_first(p); })
KPH(k_g1, { ph_g1(p, l, lds); })
KPH(k_prep, { ph_prep(p, l, lds); })
KPH(k_local, { ph_local(p, l, lds); })
KPH(k_seq, { ph_seq(p, lds); })
KPH(k_merge, { ph_merge(p, l, M); })
KPH(k_g2, { ph_g2(p, l, M, lds); })
KPH(k_g3, { ph_g3(p, l, M, lds); })
KPH(k_route, { ph_route(p, l, M, lds); })
KPH(k_g4, { ph_g4(p, l, lds); })
KPH(k_g5, { ph_g5(p, l, lds); })
KPH(k_combine, { ph_combine(p, l, M, lds); })


__global__ void __launch_bounds__(NTHREADS, 2) k_mega(Params p) {
    LAS unsigned char* lds = (LAS unsigned char*)dyn_lds;
    volatile LAS unsigned* xb_words = (volatile LAS unsigned*)(lds + LDS_BYTES - 16);
    if (threadIdx.x == 0) { xb_words[0] = 0u; xb_words[1] = 0u; xb_words[2] = 0u; xb_words[3] = 0u; }
    __syncthreads();
    (void)xcd_barrier_post(p.bar, xb_words);
#define GRID_BARRIER() do { XcdBarrier b_; b_.bar = p.bar; b_.x = xb_xcc_id(); b_.st = xb_words; xcd_barrier(b_); } while (0)
#define RUNP(bit, stmt) do { stmt; if (PROBE & (1 << (bit))) { GRID_BARRIER(); stmt; } } while (0)
    RUNP(0, ph_convert(p, lds));
    RUNP(1, ph_mod(p, lds));
    GRID_BARRIER();
    RUNP(2, ph_norm1_first(p));
    GRID_BARRIER();
    for (int l = 0; l < 2; ++l) {
        const int M = l == 0 ? NTOK : NLAT;
        RUNP(3, ph_g1(p, l, lds));
        GRID_BARRIER();
        RUNP(4, ph_prep(p, l, lds));
        GRID_BARRIER();
        RUNP(5, ph_local(p, l, lds));
        GRID_BARRIER();
        RUNP(6, ph_seq(p, lds));
        GRID_BARRIER();
        RUNP(7, ph_merge(p, l, M));
        GRID_BARRIER();
        RUNP(8, ph_g2(p, l, M, lds));
        GRID_BARRIER();
        if (PROBE & (1 << 11)) { ph_g3<true>(p, l, M, lds); GRID_BARRIER(); }
        ph_g3(p, l, M, lds);
        GRID_BARRIER();
        if (PROBE & (1 << 12)) { ph_route<true>(p, l, M, lds); GRID_BARRIER(); }
        ph_route(p, l, M, lds);
        GRID_BARRIER();
        RUNP(9, ph_g4(p, l, lds));
        GRID_BARRIER();
        RUNP(10, ph_g5(p, l, lds));
        GRID_BARRIER();
        if (PROBE & (1 << 13)) { ph_combine<true>(p, l, M, lds); GRID_BARRIER(); }
        ph_combine(p, l, M, lds);
        if (l == 0) GRID_BARRIER();
    }
}

static inline size_t align_up(size_t v, size_t a) { return (v + a - 1) / a * a; }

extern "C" void kernel_launch(void* const* d_in, const int* in_sizes, int n_in, void* d_out, int out_size, void* d_ws, size_t ws_size, hipStream_t stream) {
    (void)in_sizes; (void)n_in; (void)out_size;
    Params p{};
    const float** pf = (const float**)&p;
    for (int i = 0; i < 32; ++i) pf[i] = (const float*)d_in[i];
    p.out = (float*)d_out;
    unsigned char* w = (unsigned char*)d_ws; size_t off = 0;
    auto take = [&](size_t bytes) { void* r = w + off; off = align_up(off + bytes, 256); return r; };
    p.bar = (unsigned*)take(16384);
    p.cnt = (int*)take(1024);
    const size_t ctl_bytes = off;
    p.mod = (float*)take((size_t)2 * 5 * NMOD * D * 4);
    p.winT = (bf16_t*)take((size_t)2 * NP * D * 2);
    p.wbT = (bf16_t*)take((size_t)2 * 4 * D * MW * 2);
    p.woutT = (bf16_t*)take((size_t)2 * D * D * 2);
    p.w1T = (bf16_t*)take((size_t)2 * NE * 2 * D * D * 2);
    p.w2T = (bf16_t*)take((size_t)2 * NE * D * D * 2);
    p.xl = (float*)take((size_t)NTOK * D * 4);
    p.H = (bf16_t*)take((size_t)NTOK * D * 2);
    p.P = (bf16_t*)take((size_t)NTOK * NP * 2);
    p.act = p.P; p.yp = p.P + (size_t)CAPROWS * D;
    p.prep = (float*)take(NPREP * TOKW * 4);
    p.gg = (float*)take((size_t)NTOK * 8 * 4);
    p.gb = (float*)take((size_t)NTOK * 8 * 4);
    p.O = (float*)take(8 * TOKW * 4);
    p.lq = (bf16_t*)take((size_t)3 * NITEM * 64 * 128 * 2);
    p.lo = (bf16_t*)take((size_t)3 * NITEM * 64 * 128 * 2);
    p.lb = (bf16_t*)take((size_t)3 * NITEM * 128 * 128 * 2);
    p.la = (bf16_t*)take((size_t)NITEM * 128 * 128 * 2);
    p.ld = (float*)take((size_t)3 * NITEM * 128 * 4);
    p.lruT = (bf16_t*)take((size_t)2 * 8 * 4 * 4096 * 2);
    p.Y = (bf16_t*)take(4 * TOKW * 2);
    p.mix = (bf16_t*)take((size_t)NTOK * D * 2);
    p.F = p.H;
    p.list = (int*)take((size_t)NE * NTOK * 4);
    p.tokslot = (int*)take((size_t)NTOK * 4 * 4);
    p.topw = (float*)take((size_t)NTOK * 4 * 4);
    if (off > ws_size) { fprintf(stderr, "workspace too small: need %zu have %zu\n", off, ws_size); return; }

    static int grid = 0;
#if MEGA
    if (!grid) {
        int dev = 0, cus = 0, occ = 0; (void)hipGetDevice(&dev); (void)hipDeviceGetAttribute(&cus, hipDeviceAttributeMultiprocessorCount, dev);
        (void)hipFuncSetAttribute((const void*)k_mega, hipFuncAttributeMaxDynamicSharedMemorySize, LDS_BYTES);
        (void)hipOccupancyMaxActiveBlocksPerMultiprocessor(&occ, (const void*)k_mega, NTHREADS, LDS_BYTES);
        if (cus <= 0) cus = 256;
        grid = cus * (occ < 1 ? 1 : 1);
        if (occ < 1) fprintf(stderr, "occupancy query says %d blocks per CU\n", occ);
    }
    (void)hipMemsetAsync(d_ws, 0, ctl_bytes, stream);
    hipLaunchKernelGGL(k_mega, dim3(grid), dim3(NTHREADS), LDS_BYTES, stream, p);
#else
    if (!grid) {
        int dev = 0, cus = 0; (void)hipGetDevice(&dev); (void)hipDeviceGetAttribute(&cus, hipDeviceAttributeMultiprocessorCount, dev);
        grid = cus > 0 ? cus : 256;
        const void* ks[] = {(const void*)k_convert, (const void*)k_mod, (const void*)k_norm1, (const void*)k_g1, (const void*)k_prep, (const void*)k_local, (const void*)k_seq, (const void*)k_merge,
                            (const void*)k_g2, (const void*)k_g3, (const void*)k_route, (const void*)k_g4, (const void*)k_g5, (const void*)k_combine};
        for (const void* k : ks) (void)hipFuncSetAttribute(k, hipFuncAttributeMaxDynamicSharedMemorySize, LDS_BYTES);
    }
    (void)hipMemsetAsync(d_ws, 0, ctl_bytes, stream);
#define LAUNCH(k, l, M) hipLaunchKernelGGL(k, dim3(grid), dim3(NTHREADS), LDS_BYTES, stream, p, l, M)
    LAUNCH(k_convert, 0, 0);
    LAUNCH(k_mod, 0, 0);
    LAUNCH(k_norm1, 0, 0);
    for (int l = 0; l < 2; ++l) {
        const int M = l == 0 ? NTOK : NLAT;
        LAUNCH(k_g1, l, M);
        LAUNCH(k_prep, l, M);
        LAUNCH(k_local, l, M);
        LAUNCH(k_seq, l, M);
        LAUNCH(k_merge, l, M);
        LAUNCH(k_g2, l, M);
        LAUNCH(k_g3, l, M);
        LAUNCH(k_route, l, M);
        LAUNCH(k_g4, l, M);
        LAUNCH(k_g5, l, M);
        LAUNCH(k_combine, l, M);
    }
#endif
}
```

```cpp
#include <hip/hip_runtime.h>
#include <stdint.h>
#include <stdio.h>

#define LAS __attribute__((address_space(3)))
typedef unsigned short bf16_t;
typedef short bf16x8 __attribute__((ext_vector_type(8)));
typedef float f32x4 __attribute__((ext_vector_type(4)));
typedef float f32x2 __attribute__((ext_vector_type(2)));
typedef unsigned u32x2 __attribute__((ext_vector_type(2)));
typedef unsigned u32x4 __attribute__((ext_vector_type(4)));

#ifndef MEGA
#define MEGA 1
#endif
#ifndef PROBE
#define PROBE 0
#endif

constexpr int D = 1024, NB = 4, TL = 4096, TC = 256, NLAT = NB * TL, NCTX = NB * TC, NTOK = NLAT + NCTX;
constexpr int NIN = 11792, NP = 12032, MW = 512, NE = 32, TOPK = 4, NMOD = 6;
constexpr int C_GQKV = 0, C_GZ = 1536, C_GA = 2048, C_GB = 2056, C_HQ = 2064, C_HI = 2576, C_HF = 3088, C_HG = 4112, C_LX = 4624,
              C_LY = 5136, C_RQKV = 5648, C_RG = 7184, C_MG = 7696;
constexpr int NTHREADS = 512, NWAVES = 8;
constexpr int LDS_BYTES = 140 * 1024;
constexpr int CAPROWS = 77824;
constexpr size_t TOKW = (size_t)NTOK * MW;
constexpr int PR_LA = 0, PR_LU = 2, NPREP = 4;
constexpr int NCHUNK = 68, NITEM = 32 * NCHUNK;

struct Params {
    const float *x, *c, *ctx, *c_ctx, *w_mod, *b_mod, *norm1_g, *norm2_g, *w_in, *gdn_conv_w, *gdn_a_log, *gdn_dt_bias, *gdn_norm_g, *hgrn_lb,
        *hgrn_norm_g, *lru_conv_w, *lru_conv_b, *lru_wa, *lru_ba, *lru_wx, *lru_bx, *lru_lambda, *ret_norm_g, *w_branch, *w_out, *router_w,
        *router_b, *moe_w1, *moe_b1, *moe_w2, *moe_b2, *final_norm_g;
    float* out;
    unsigned* bar; int* cnt; float* mod;
    bf16_t *winT, *wbT, *woutT, *w1T, *w2T;
    float* xl; bf16_t* H; bf16_t* P; float* prep; float* gg; float* gb; float* O; bf16_t* Y; bf16_t* mix; bf16_t* F;
    int* list; int* tokslot; float* topw; bf16_t* act; bf16_t* yp;
    bf16_t *lq, *lo, *lb, *la; float* ld; bf16_t* lruT;
};

__device__ __forceinline__ unsigned f2bf(float f) { unsigned u = __float_as_uint(f); u += 0x7fffu + ((u >> 16) & 1u); return u >> 16; }
__device__ __forceinline__ unsigned pack2(float a, float b) { return f2bf(a) | (f2bf(b) << 16); }
__device__ __forceinline__ float bf2f(bf16_t b) { return __uint_as_float(((unsigned)b) << 16); }
__device__ __forceinline__ float bflo(unsigned u) { return __uint_as_float(u << 16); }
__device__ __forceinline__ float bfhi(unsigned u) { return __uint_as_float(u & 0xffff0000u); }
__device__ __forceinline__ float sigmoidf_(float x) { return __builtin_amdgcn_rcpf(1.0f + __expf(-x)); }
__device__ __forceinline__ float siluf_(float x) { return x * sigmoidf_(x); }
__device__ __forceinline__ float softplusf_(float x) { return x > 20.f ? x : log1pf(__expf(x)); }
__device__ __forceinline__ float logsigmoidf_(float x) { return -softplusf_(-x); }
__device__ __forceinline__ float gelu_tanhf_(float x) { const float u = 0.7978845608028654f * (x + 0.044715f * x * x * x); return 0.5f * x * (1.0f + tanhf(u)); }
__device__ __forceinline__ float wave_sum(float v) {
#pragma unroll
    for (int m = 32; m >= 1; m >>= 1) v += __shfl_xor(v, m);
    return v;
}
__device__ __forceinline__ int opaque_tid() { int t = threadIdx.x; asm volatile("" : "+v"(t)); return t; }
__device__ __forceinline__ int tok_modrow(int tok) { return tok < NLAT ? (tok >> 12) : 4; }
__device__ __forceinline__ void tok_info(int tok, int& t, int& T, int& base) {
    if (tok < NLAT) { t = tok & (TL - 1); T = TL; base = tok - t; }
    else { t = (tok - NLAT) & (TC - 1); T = TC; base = tok - t; }
}

__device__ __forceinline__ f32x4 mfma16(bf16x8 a, bf16x8 b, f32x4 c) { return __builtin_amdgcn_mfma_f32_16x16x32_bf16(a, b, c, 0, 0, 0); }
__device__ __forceinline__ u32x2 pack4(f32x4 v) { u32x2 o; o[0] = pack2(v[0], v[1]); o[1] = pack2(v[2], v[3]); return o; }
__device__ __forceinline__ u32x4 pack8(const float* v) { u32x4 o; o[0] = pack2(v[0], v[1]); o[1] = pack2(v[2], v[3]); o[2] = pack2(v[4], v[5]); o[3] = pack2(v[6], v[7]); return o; }

namespace gm {
constexpr int HT = 16384;
__device__ __forceinline__ int lds_byte(int r, int c) { const int st = (r >> 4) * 2 + (c >> 5), rr = r & 15, cc = c & 31, ob = rr * 64 + cc * 2; return st * 1024 + (ob ^ (((ob >> 9) & 1) << 5)); }
__device__ __forceinline__ void stage_rc(int b, int& R, int& C) { const int st = b / 1024, sb = b % 1024, swz = sb ^ (((sb >> 9) & 1) << 5); R = (st >> 1) * 16 + swz / 64; C = (st & 1) * 32 + (swz % 64) / 2; }

__device__ __forceinline__ void kloop(LAS unsigned char* lds, const bf16_t* ap00, const bf16_t* ap01, const bf16_t* ap10, const bf16_t* ap11,
                                      const bf16_t* bp0, const bf16_t* bp1, int K, f32x4 (&acc)[4][4]) {
    const int tid = opaque_tid(), wid = __builtin_amdgcn_readfirstlane(tid >> 6), lane = tid & 63, wr = wid >> 1, wc = wid & 1, fr = lane & 15, fq = lane >> 4;
    const unsigned ldsw = (unsigned)wid * 1024u;
    const int aoff = (wr >> 1) * HT + lds_byte((wr & 1) * 64 + fr, fq * 8);
    const int boff = 2 * HT + lds_byte(wc * 64 + fr, fq * 8);
    const int nt = K / 64;
#define GM_GLDS(src, dstoff) __builtin_amdgcn_global_load_lds((const unsigned*)(src), (LAS unsigned*)(lds + (dstoff)), 16, 0, 0)
#define GM_STAGE(buf, kt) do { const int _bo = (buf) * 3 * HT + ldsw; const int _ko = (kt) * 64; \
        GM_GLDS(ap00 + _ko, _bo); GM_GLDS(ap01 + _ko, _bo + 8192); GM_GLDS(ap10 + _ko, _bo + HT); GM_GLDS(ap11 + _ko, _bo + HT + 8192); \
        GM_GLDS(bp0 + _ko, _bo + 2 * HT); GM_GLDS(bp1 + _ko, _bo + 2 * HT + 8192); } while (0)
    GM_STAGE(0, 0);
    for (int t = 0; t < nt; ++t) {
        const int cur = t & 1;
        if (t + 1 < nt) { GM_STAGE(cur ^ 1, t + 1); asm volatile("s_waitcnt vmcnt(6)" ::: "memory"); }
        else asm volatile("s_waitcnt vmcnt(0)" ::: "memory");
        __builtin_amdgcn_s_barrier(); asm volatile("" ::: "memory");
        bf16x8 af[4][2], bfr[4][2];
#pragma unroll
        for (int m = 0; m < 4; ++m)
#pragma unroll
            for (int k = 0; k < 2; ++k) af[m][k] = *(const LAS bf16x8*)(lds + cur * 3 * HT + aoff + m * 2048 + k * 1024);
#pragma unroll
        for (int n = 0; n < 4; ++n)
#pragma unroll
            for (int k = 0; k < 2; ++k) bfr[n][k] = *(const LAS bf16x8*)(lds + cur * 3 * HT + boff + n * 2048 + k * 1024);
#pragma unroll
        for (int k = 0; k < 2; ++k)
#pragma unroll
            for (int m = 0; m < 4; ++m)
#pragma unroll
                for (int n = 0; n < 4; ++n) acc[m][n] = __builtin_amdgcn_mfma_f32_16x16x32_bf16(bfr[n][k], af[m][k], acc[m][n], 0, 0, 0);
        asm volatile("s_waitcnt lgkmcnt(0)" ::: "memory");
        __builtin_amdgcn_s_barrier(); asm volatile("" ::: "memory");
    }
#undef GM_STAGE
#undef GM_GLDS
}
__device__ __forceinline__ void zero_acc(f32x4 (&acc)[4][4]) {
#pragma unroll
    for (int m = 0; m < 4; ++m)
#pragma unroll
        for (int n = 0; n < 4; ++n) acc[m][n] = (f32x4){0.f, 0.f, 0.f, 0.f};
}
}

namespace g8 {
constexpr int BM = 256, BK = 64, HALF = 128, HTB = HALF * BK * 2, STAGE_BYTES = 8 * HTB;
__device__ __forceinline__ int lds_byte(int r, int c) { const int st = (r >> 4) * 2 + (c >> 5), rr = r & 15, cc = c & 31, ob = rr * 64 + cc * 2; return st * 1024 + (ob ^ (((ob >> 9) & 1) << 5)); }
__device__ __forceinline__ void stage_rc(int b, int& R, int& C) { const int st = b / 1024, sb = b % 1024, swz = sb ^ (((sb >> 9) & 1) << 5); R = (st >> 1) * 16 + swz / 64; C = (st & 1) * 32 + (swz % 64) / 2; }
__device__ __forceinline__ int perm32(int rho) { const int n = rho >> 4, i = rho & 15; return 8 * (i >> 2) + 4 * n + (i & 3); }
struct Unit { int pm, pn, e; };

template <class Epi, class Sched>
__device__ __forceinline__ void gemm_phase(LAS unsigned char* lds, const int K, const Sched& S, const Epi& E) {
    const int tid = opaque_tid(), wid = __builtin_amdgcn_readfirstlane(tid >> 6), lane = tid & 63, wr = wid >> 2, wc = wid & 3, fr = lane & 15, fq = lane >> 4;
    const int nt = K / BK;
    int R0, C0, R1, C1; stage_rc(tid * 16, R0, C0); stage_rc(tid * 16 + 8192, R1, C1);
    unsigned voffB[2];
    voffB[0] = (unsigned)(((R0 & ~31) + perm32(R0 & 31)) * K + C0) * 2u; voffB[1] = (unsigned)(((R1 & ~31) + perm32(R1 & 31)) * K + C1) * 2u;
    const unsigned cb0 = (unsigned)C0 * 2u, cb1 = (unsigned)C1 * 2u;
    const size_t kstep = (size_t)(BK * 2);
    const size_t hstepB = (size_t)HALF * K * 2;
    const unsigned ldsw = (unsigned)wid * 1024u;
    const int aoff = lds_byte(wr * 64 + fr, fq * 8), boff = lds_byte(wc * 32 + fr, fq * 8);
#define G8_SA(b, h) (((b) * 2 + (h)) * HTB)
#define G8_SB(b, h) ((4 + (b) * 2 + (h)) * HTB)
#define G8_GL(src, dstoff) __builtin_amdgcn_global_load_lds((const unsigned*)(src), (LAS unsigned*)(lds + (dstoff)), 16, 0, 0)
#define G8_STAGE_A(bufoff, gbase, vo, h) do { G8_GL((const char*)(gbase) + (vo)[2 * (h)], (bufoff) + ldsw); G8_GL((const char*)(gbase) + (vo)[2 * (h) + 1], (bufoff) + ldsw + 8192); } while (0)
#define G8_STAGE_B(bufoff, gbase) do { G8_GL((const char*)(gbase) + voffB[0], (bufoff) + ldsw); G8_GL((const char*)(gbase) + voffB[1], (bufoff) + ldsw + 8192); } while (0)
#define G8_LDA(dst, b, h) do { _Pragma("unroll") for (int m = 0; m < 4; ++m) _Pragma("unroll") for (int k = 0; k < 2; ++k) dst[m][k] = *(const LAS bf16x8*)(lds + G8_SA(b, h) + aoff + m * 2048 + k * 1024); } while (0)
#define G8_LDB(dst, b, h) do { _Pragma("unroll") for (int n = 0; n < 2; ++n) _Pragma("unroll") for (int k = 0; k < 2; ++k) dst[n][k] = *(const LAS bf16x8*)(lds + G8_SB(b, h) + boff + n * 2048 + k * 1024); } while (0)
#define G8_MMA(ai, bj, At, Bt) do { __builtin_amdgcn_s_setprio(1); _Pragma("unroll") for (int m = 0; m < 4; ++m) _Pragma("unroll") for (int n = 0; n < 2; ++n) _Pragma("unroll") for (int k = 0; k < 2; ++k) \
        acc[ai][bj][m][n] = __builtin_amdgcn_mfma_f32_16x16x32_bf16(Bt[n][k], At[m][k], acc[ai][bj][m][n], 0, 0, 0); __builtin_amdgcn_s_setprio(0); } while (0)
#define G8_WAIT_V(n) asm volatile("s_waitcnt vmcnt(" #n ")" ::: "memory")
#define G8_WAIT_L(n) asm volatile("s_waitcnt lgkmcnt(" #n ")" ::: "memory")
#define G8_BAR __builtin_amdgcn_s_barrier()
#define G8_SCHED __builtin_amdgcn_sched_barrier(0)
    Unit cur, nxt; int ui = 0;
    if (!S.next(0, cur)) return;
    LAS float* biasbuf = (LAS float*)(lds + STAGE_BYTES + 2048);
    LAS int* rowbuf = (LAS int*)(lds + STAGE_BYTES + 4096);
    f32x4 acc[2][2][4][2];
#pragma unroll
    for (int a = 0; a < 2; ++a)
#pragma unroll
        for (int b = 0; b < 2; ++b)
#pragma unroll
            for (int m = 0; m < 4; ++m)
#pragma unroll
                for (int n = 0; n < 2; ++n) acc[a][b][m][n] = (f32x4){0.f, 0.f, 0.f, 0.f};
    bf16x8 At[4][2], B0[2][2], B1[2][2];
    unsigned vA[4];
    {
        unsigned rows[4] = {(unsigned)R0, (unsigned)R1, (unsigned)(HALF + R0), (unsigned)(HALF + R1)};
        if (S.gather) { rows[0] = (unsigned)*S.row_addr(cur, R0); rows[1] = (unsigned)*S.row_addr(cur, R1); rows[2] = (unsigned)*S.row_addr(cur, HALF + R0); rows[3] = (unsigned)*S.row_addr(cur, HALF + R1); }
        vA[0] = rows[0] * (unsigned)(K * 2) + cb0; vA[1] = rows[1] * (unsigned)(K * 2) + cb1; vA[2] = rows[2] * (unsigned)(K * 2) + cb0; vA[3] = rows[3] * (unsigned)(K * 2) + cb1;
    }
    const char* cA = S.a_base(cur); const char* cB = S.b_base(cur);
    G8_STAGE_B(G8_SB(0, 0), cB); G8_STAGE_A(G8_SA(0, 0), cA, vA, 0); G8_STAGE_B(G8_SB(0, 1), cB + hstepB); G8_STAGE_A(G8_SA(0, 1), cA, vA, 1);
    if (wr == 1) G8_BAR;
    G8_WAIT_V(4); G8_BAR;
    G8_STAGE_B(G8_SB(1, 0), cB + kstep); G8_STAGE_A(G8_SA(1, 0), cA + kstep, vA, 0); G8_STAGE_B(G8_SB(1, 1), cB + hstepB + kstep);
    G8_WAIT_V(6); G8_BAR;
    for (;;) {
        const bool has_next = S.next(ui + 1, nxt);
        const char* nA = has_next ? S.a_base(nxt) : cA; const char* nB = has_next ? S.b_base(nxt) : cB;
        const int nvalid = (S.gather && has_next) ? S.rows_valid(nxt) : 0;
        if (wid == 0) {
            if (Sched::HAS_BIAS) G8_GL(S.bias_src(cur, lane), STAGE_BYTES + 2048 + (ui & 1) * 1024);
            if (S.gather && has_next) G8_GL(S.row_addr(nxt, 0) + lane * 4, STAGE_BYTES + 4096 + ((ui + 1) & 1) * 1024);
        }
        unsigned vlast[4] = {vA[0], vA[1], vA[2], vA[3]};
        for (int t = 0; t < nt; t += 2) {
            const bool last = (t == nt - 2);
            const char* a1 = cA + (size_t)(t + 1) * kstep;
            const char* a2 = last ? nA : cA + (size_t)(t + 2) * kstep; const char* b2 = last ? nB : cB + (size_t)(t + 2) * kstep;
            const char* a3 = a2 + kstep; const char* b3 = b2 + kstep;
            unsigned v2[4];
#pragma unroll
            for (int q = 0; q < 4; ++q) v2[q] = vA[q];
            if (last && S.gather && has_next) {
                const LAS int* rb = rowbuf + ((ui + 1) & 1) * 256;
                const unsigned r0 = R0 < nvalid ? (unsigned)rb[R0] : 0u, r1 = R1 < nvalid ? (unsigned)rb[R1] : 0u;
                const unsigned r2 = HALF + R0 < nvalid ? (unsigned)rb[HALF + R0] : 0u, r3 = HALF + R1 < nvalid ? (unsigned)rb[HALF + R1] : 0u;
                v2[0] = r0 * (unsigned)(K * 2) + cb0; v2[1] = r1 * (unsigned)(K * 2) + cb1; v2[2] = r2 * (unsigned)(K * 2) + cb0; v2[3] = r3 * (unsigned)(K * 2) + cb1;
            }
            if (last) { vlast[0] = v2[0]; vlast[1] = v2[1]; vlast[2] = v2[2]; vlast[3] = v2[3]; }
            G8_LDB(B0, 0, 0); G8_SCHED; G8_LDA(At, 0, 0); G8_STAGE_A(G8_SA(1, 1), a1, vA, 1);
            G8_WAIT_L(8); G8_BAR; G8_WAIT_L(0); G8_MMA(0, 0, At, B0); G8_BAR; G8_SCHED;
            G8_LDB(B1, 0, 1); G8_STAGE_B(G8_SB(0, 0), b2);
            G8_BAR; G8_WAIT_L(0); G8_MMA(0, 1, At, B1); G8_BAR;
            G8_LDA(At, 0, 1); G8_STAGE_A(G8_SA(0, 0), a2, v2, 0);
            G8_BAR; G8_WAIT_L(0); G8_MMA(1, 0, At, B0); G8_BAR; G8_SCHED;
            G8_STAGE_B(G8_SB(0, 1), b2 + hstepB);
            G8_WAIT_V(6); G8_BAR; G8_MMA(1, 1, At, B1); G8_BAR;
            G8_LDB(B0, 1, 0); G8_SCHED; G8_LDA(At, 1, 0); G8_STAGE_A(G8_SA(0, 1), a2, v2, 1);
            G8_WAIT_L(8); G8_BAR; G8_WAIT_L(0); G8_MMA(0, 0, At, B0); G8_BAR; G8_SCHED;
            G8_LDB(B1, 1, 1); G8_STAGE_B(G8_SB(1, 0), b3);
            G8_BAR; G8_WAIT_L(0); G8_MMA(0, 1, At, B1); G8_BAR;
            G8_LDA(At, 1, 1); G8_STAGE_A(G8_SA(1, 0), a3, v2, 0);
            G8_BAR; G8_WAIT_L(0); G8_MMA(1, 0, At, B0); G8_BAR; G8_SCHED;
            G8_STAGE_B(G8_SB(1, 1), b3 + hstepB);
            G8_WAIT_V(6); G8_BAR; G8_MMA(1, 1, At, B1); G8_BAR;
        }
        E(acc, cur, wr, wc, fr, fq, biasbuf + (ui & 1) * 256);
        if (!has_next) break;
        if (!E.keep(cur))
#pragma unroll
        for (int a = 0; a < 2; ++a)
#pragma unroll
            for (int b = 0; b < 2; ++b)
#pragma unroll
                for (int m = 0; m < 4; ++m)
#pragma unroll
                    for (int n = 0; n < 2; ++n) acc[a][b][m][n] = (f32x4){0.f, 0.f, 0.f, 0.f};
        cur = nxt; cA = nA; cB = nB; ++ui;
#pragma unroll
        for (int q = 0; q < 4; ++q) vA[q] = vlast[q];
    }
    G8_WAIT_V(0);
    if (wr == 0) G8_BAR;
    G8_BAR;
#undef G8_SA
#undef G8_SB
#undef G8_GL
#undef G8_STAGE_A
#undef G8_STAGE_B
#undef G8_LDA
#undef G8_LDB
#undef G8_MMA
#undef G8_WAIT_V
#undef G8_WAIT_L
#undef G8_BAR
#undef G8_SCHED
}

struct PlainSched {
    const bf16_t* A; const bf16_t* Bt; int K, nM, nN, nwg, G, c;
    __device__ __forceinline__ void init(const bf16_t* A_, const bf16_t* Bt_, int M, int N, int K_) { A = A_; Bt = Bt_; K = K_; nM = M / BM; nN = N / BM; nwg = nM * nN; G = gridDim.x; c = blockIdx.x; }
    __device__ __forceinline__ bool next(int i, Unit& u) const {
        const long L = (long)i * G + c; if (L >= nwg) return false;
        int wgid = (int)L; { const int q = nwg / 8, r = nwg % 8, xcd = wgid % 8, off = wgid / 8; wgid = (xcd < r ? xcd * (q + 1) : r * (q + 1) + (xcd - r) * q) + off; }
        const int nig = 8 * nN, gid = wgid / nig, fm = gid * 8, gsz = (nM - fm) < 8 ? (nM - fm) : 8;
        u.pm = fm + ((wgid % nig) % gsz); u.pn = (wgid % nig) / gsz; u.e = 0; return true;
    }
    __device__ __forceinline__ const char* a_base(const Unit& u) const { return (const char*)(A + (size_t)u.pm * BM * K); }
    __device__ __forceinline__ const char* b_base(const Unit& u) const { return (const char*)(Bt + (size_t)u.pn * BM * K); }
    static constexpr bool HAS_BIAS = false, gather = false;
    __device__ __forceinline__ const int* row_addr(const Unit&, int) const { return nullptr; }
    __device__ __forceinline__ int rows_valid(const Unit&) const { return 256; }
    __device__ __forceinline__ const float* bias_src(const Unit&, int) const { return nullptr; }
};
}

struct StageRC { int R0, C0, R1, C1; };
__device__ __forceinline__ StageRC my_stage_rc() { const int t = opaque_tid(); StageRC s; gm::stage_rc(t * 16, s.R0, s.C0); gm::stage_rc(t * 16 + 8192, s.R1, s.C1); return s; }

__device__ __forceinline__ int w1_dst_row(int n) { const int half = n >> 10, cc = n & 1023; return (cc >> 7) * 256 + half * 128 + (cc & 127); }

__device__ __forceinline__ void cvt_tile(LAS float* tile, const float* src, int ldsrc, int Nsrc, int k0, int n0, bf16_t* dst, int K, int mode) {
    const int tid = opaque_tid();
    {
        const int rr = tid >> 6, cc = tid & 63, n = n0 + cc;
#pragma unroll
        for (int i = 0; i < 8; ++i) { const int k = rr + i * 8; tile[k * 65 + cc] = (n < Nsrc) ? src[(size_t)(k0 + k) * ldsrc + n] : 0.f; }
    }
    __syncthreads();
    {
        const int nl = tid >> 3, kg = tid & 7, n = n0 + nl;
        float v[8];
#pragma unroll
        for (int j = 0; j < 8; ++j) v[j] = tile[(kg * 8 + j) * 65 + nl];
        const int drow = mode == 1 ? w1_dst_row(n) : n;
        u32x4 o; o[0] = pack2(v[0], v[1]); o[1] = pack2(v[2], v[3]); o[2] = pack2(v[4], v[5]); o[3] = pack2(v[6], v[7]);
        *(u32x4*)(dst + (size_t)drow * K + k0 + kg * 8) = o;
    }
    __syncthreads();
}

__device__ __forceinline__ void ph_convert(const Params& p, LAS unsigned char* lds) {
    LAS float* tile = (LAS float*)lds;
    for (int idx = blockIdx.x * NTHREADS + opaque_tid(); idx < 2 * 8 * 4 * 4096; idx += gridDim.x * NTHREADS) {
        const int i = idx & 63, j = (idx >> 6) & 63, mat = (idx >> 12) & 3, n = (idx >> 14) & 7, ll = idx >> 17, d = mat >> 1;
        p.lruT[idx] = (bf16_t)f2bf(((mat & 1) ? p.lru_wx : p.lru_wa)[(size_t)((ll * 2 + d) * 8 + n) * 4096 + i * 64 + j]);
    }
    constexpr int PER_L = 3008 + 512 + 256 + 16384 + 8192;
    for (int it = blockIdx.x; it < 2 * PER_L; it += gridDim.x) {
        const int l = it / PER_L; int r = it % PER_L;
        if (r < 3008) { const int nt = r % 188, kt = r / 188; cvt_tile(tile, p.w_in + (size_t)l * D * NIN, NIN, NIN, kt * 64, nt * 64, p.winT + (size_t)l * NP * D, D, 0); }
        else if (r < 3520) { r -= 3008; const int n = r / 128; r %= 128; const int nt = r % 16, kt = r / 16;
            cvt_tile(tile, p.w_branch + (size_t)(l * 4 + n) * MW * D, D, D, kt * 64, nt * 64, p.wbT + (size_t)(l * 4 + n) * D * MW, MW, 0); }
        else if (r < 3776) { r -= 3520; const int nt = r % 16, kt = r / 16; cvt_tile(tile, p.w_out + (size_t)l * D * D, D, D, kt * 64, nt * 64, p.woutT + (size_t)l * D * D, D, 0); }
        else if (r < 3776 + 16384) { r -= 3776; const int e = r / 512; r %= 512; const int nt = r % 32, kt = r / 32;
            cvt_tile(tile, p.moe_w1 + (size_t)(l * NE + e) * D * 2 * D, 2 * D, 2 * D, kt * 64, nt * 64, p.w1T + (size_t)(l * NE + e) * 2 * D * D, D, 1); }
        else { r -= 3776 + 16384; const int e = r / 256; r %= 256; const int nt = r % 16, kt = r / 16;
            cvt_tile(tile, p.moe_w2 + (size_t)(l * NE + e) * D * D, D, D, kt * 64, nt * 64, p.w2T + (size_t)(l * NE + e) * D * D, D, 0); }
    }
}

__device__ __forceinline__ void ph_mod(const Params& p, LAS unsigned char* lds) {
    LAS float* sc = (LAS float*)lds;
    LAS float* red = sc + 5 * D;
    const int tid = opaque_tid(), wid = tid >> 6, lane = tid & 63;
    if ((int)blockIdx.x >= 192) return;
    for (int i = tid; i < 5 * D; i += NTHREADS) { const int r = i >> 10, k = i & 1023; const float v = r < 4 ? p.c[r * D + k] : p.c_ctx[k]; sc[i] = siluf_(v); }
    __syncthreads();
    for (int it = blockIdx.x; it < 192; it += gridDim.x) {
        const int l = it / 96, n0 = (it % 96) * 64;
        float acc[5] = {0.f, 0.f, 0.f, 0.f, 0.f};
        const float* wp = p.w_mod + (size_t)l * D * (NMOD * D) + n0 + lane;
        for (int k = wid * 128; k < wid * 128 + 128; ++k) {
            const float wv = wp[(size_t)k * (NMOD * D)];
#pragma unroll
            for (int r = 0; r < 5; ++r) acc[r] += sc[r * D + k] * wv;
        }
#pragma unroll
        for (int r = 0; r < 5; ++r) red[(wid * 5 + r) * 64 + lane] = acc[r];
        __syncthreads();
        if (tid < 320) { const int r = tid >> 6, cidx = tid & 63; float s = p.b_mod[l * NMOD * D + n0 + cidx];
#pragma unroll
            for (int w = 0; w < 8; ++w) s += red[(w * 5 + r) * 64 + cidx];
            p.mod[(size_t)(l * 5 + r) * (NMOD * D) + n0 + cidx] = s; }
        __syncthreads();
    }
}

__device__ __forceinline__ void norm_mod_store(const float4 (&v)[4], float rinv, const float* g, const float* scp, const float* shp, bf16_t* dst, int lane) {
#pragma unroll
    for (int i = 0; i < 4; ++i) {
        const int cidx = i * 256 + lane * 4;
        const float4 gv = *(const float4*)(g + cidx), sv = *(const float4*)(scp + cidx), hv = *(const float4*)(shp + cidx);
        const float h0 = v[i].x * rinv * gv.x * (1.f + sv.x) + hv.x, h1 = v[i].y * rinv * gv.y * (1.f + sv.y) + hv.y;
        const float h2 = v[i].z * rinv * gv.z * (1.f + sv.z) + hv.z, h3 = v[i].w * rinv * gv.w * (1.f + sv.w) + hv.w;
        u32x2 o; o[0] = pack2(h0, h1); o[1] = pack2(h2, h3);
        *(u32x2*)(dst + cidx) = o;
    }
}
__device__ __forceinline__ void ph_norm1_first(const Params& p) {
    const int tid = opaque_tid(), wid = tid >> 6, lane = tid & 63;
    for (int tok = blockIdx.x * NWAVES + wid; tok < NTOK; tok += gridDim.x * NWAVES) {
        const float* src = tok < NLAT ? p.x + (size_t)tok * D : p.ctx + (size_t)(tok - NLAT) * D;
        float4 v[4]; float ss = 0.f;
#pragma unroll
        for (int i = 0; i < 4; ++i) { v[i] = *(const float4*)(src + i * 256 + lane * 4); ss += v[i].x * v[i].x + v[i].y * v[i].y + v[i].z * v[i].z + v[i].w * v[i].w; }
        ss = wave_sum(ss);
        const float rinv = rsqrtf(ss * (1.0f / D) + 1e-6f);
        const float* mb = p.mod + (size_t)(0 * 5 + tok_modrow(tok)) * (NMOD * D);
        norm_mod_store(v, rinv, p.norm1_g, mb + 1 * D, mb + 0 * D, p.H + (size_t)tok * D, lane);
#pragma unroll
        for (int i = 0; i < 4; ++i) *(float4*)(p.xl + (size_t)tok * D + i * 256 + lane * 4) = v[i];
    }
}

struct EpiP {
    bf16_t* O;
    __device__ __forceinline__ bool keep(const g8::Unit&) const { return false; }
    __device__ __forceinline__ void operator()(const f32x4 (&acc)[2][2][4][2], const g8::Unit& u, int wr, int wc, int fr, int fq, const LAS float*) const {
        const int row0 = u.pm * 256 + wr * 64 + fr, col0 = u.pn * 256 + wc * 32 + 8 * fq;
#pragma unroll
        for (int ai = 0; ai < 2; ++ai)
#pragma unroll
            for (int m = 0; m < 4; ++m) {
                bf16_t* rowp = O + (size_t)(row0 + ai * 128 + m * 16) * NP + col0;
#pragma unroll
                for (int bj = 0; bj < 2; ++bj) {
                    u32x4 w; w[0] = pack2(acc[ai][bj][m][0][0], acc[ai][bj][m][0][1]); w[1] = pack2(acc[ai][bj][m][0][2], acc[ai][bj][m][0][3]);
                    w[2] = pack2(acc[ai][bj][m][1][0], acc[ai][bj][m][1][1]); w[3] = pack2(acc[ai][bj][m][1][2], acc[ai][bj][m][1][3]);
                    *(u32x4*)(rowp + bj * 128) = w;
                }
            }
    }
};
__device__ __forceinline__ void ph_g1(const Params& p, int l, LAS unsigned char* lds) {
    g8::PlainSched S; S.init(p.H, p.winT + (size_t)l * NP * D, NTOK, NP, D);
    EpiP E; E.O = p.P;
    g8::gemm_phase(lds, D, S, E);
}

__device__ __forceinline__ void ph_prep(const Params& p, int l, LAS unsigned char* lds) {
    const int tid = opaque_tid(), wid = tid >> 6, lane = tid & 63, fr = lane & 15, fq = lane >> 4;
    LAS float* xs = (LAS float*)lds;
    LAS bf16_t* xb = (LAS bf16_t*)(xs + 64 * 68);
    LAS bf16_t* wt = xb + 64 * 72;
    for (int it = blockIdx.x; it < (NTOK / 64) * 8; it += gridDim.x) {
        const int tile = it >> 3, n = it & 7, tok0 = tile * 64;
        {
            const int tl = tid & 63, cg = tid >> 6, tok = tok0 + tl;
            int t, T, base; tok_info(tok, t, T, base);
            float a[8];
            { const float4 b0 = *(const float4*)(p.lru_conv_b + l * MW + n * 64 + cg * 8), b1 = *(const float4*)(p.lru_conv_b + l * MW + n * 64 + cg * 8 + 4);
              a[0] = b0.x; a[1] = b0.y; a[2] = b0.z; a[3] = b0.w; a[4] = b1.x; a[5] = b1.y; a[6] = b1.z; a[7] = b1.w; }
#pragma unroll
            for (int j = 0; j < 4; ++j) {
                const int tt = t + j - 2;
                const float okf = (tt >= 0 && tt < T) ? 1.0f : 0.0f;
                const int ttc = tt < 0 ? 0 : (tt >= T ? T - 1 : tt);
                const u32x4 u = *(const u32x4*)(p.P + (size_t)(base + ttc) * NP + C_LX + n * 64 + cg * 8);
                const float* w = p.lru_conv_w + (size_t)(l * 4 + j) * MW + n * 64 + cg * 8;
                const float4 wa = *(const float4*)w, wb = *(const float4*)(w + 4);
                const float wv[8] = {wa.x * okf, wa.y * okf, wa.z * okf, wa.w * okf, wb.x * okf, wb.y * okf, wb.z * okf, wb.w * okf};
#pragma unroll
                for (int q = 0; q < 4; ++q) { a[2 * q] += wv[2 * q] * bflo(u[q]); a[2 * q + 1] += wv[2 * q + 1] * bfhi(u[q]); }
            }
            *(LAS f32x4*)(xs + tl * 68 + cg * 8) = (f32x4){a[0], a[1], a[2], a[3]}; *(LAS f32x4*)(xs + tl * 68 + cg * 8 + 4) = (f32x4){a[4], a[5], a[6], a[7]};
            *(LAS u32x4*)(xb + tl * 72 + cg * 8) = pack8(a);
            const bf16_t* wsrc = p.lruT + (size_t)((l * 8 + n) * 4) * 4096;
#pragma unroll
            for (int q = 0; q < 4; ++q) { const int e8 = tid + 512 * q, row = e8 >> 3, c8 = e8 & 7; *(LAS u32x4*)(wt + row * 72 + c8 * 8) = *(const u32x4*)(wsrc + (size_t)e8 * 8); }
        }
        __syncthreads();
        {
            const int jb = wid & 3, tb0 = (wid >> 2) * 2;
            bf16x8 xw[4][2];
#pragma unroll
            for (int m = 0; m < 4; ++m)
#pragma unroll
                for (int ks = 0; ks < 2; ++ks) xw[m][ks] = *(const LAS bf16x8*)(wt + (m * 64 + jb * 16 + fr) * 72 + ks * 32 + fq * 8);
            const int c0 = n * 64 + jb * 16 + 4 * fq;
            float4 bav[2], bxv[2], lsv[2];
#pragma unroll
            for (int d = 0; d < 2; ++d) {
                bav[d] = *(const float4*)(p.lru_ba + (l * 2 + d) * MW + c0); bxv[d] = *(const float4*)(p.lru_bx + (l * 2 + d) * MW + c0);
                const float4 lm = *(const float4*)(p.lru_lambda + (l * 2 + d) * MW + c0);
                lsv[d] = make_float4(8.0f * logsigmoidf_(lm.x), 8.0f * logsigmoidf_(lm.y), 8.0f * logsigmoidf_(lm.z), 8.0f * logsigmoidf_(lm.w));
            }
#pragma unroll
            for (int e = 0; e < 2; ++e) {
                const int tl = (tb0 + e) * 16 + fr, tok = tok0 + tl;
                f32x4 acc[4];
#pragma unroll
                for (int m = 0; m < 4; ++m) acc[m] = (f32x4){0.f, 0.f, 0.f, 0.f};
#pragma unroll
                for (int ks = 0; ks < 2; ++ks) {
                    const bf16x8 y = *(const LAS bf16x8*)(xb + tl * 72 + ks * 32 + fq * 8);
#pragma unroll
                    for (int m = 0; m < 4; ++m) acc[m] = mfma16(xw[m][ks], y, acc[m]);
                }
                const f32x4 xv = *(const LAS f32x4*)(xs + tl * 68 + jb * 16 + 4 * fq);
#pragma unroll
                for (int d = 0; d < 2; ++d) {
                    const float bar_[4] = {bav[d].x, bav[d].y, bav[d].z, bav[d].w}, bxr[4] = {bxv[d].x, bxv[d].y, bxv[d].z, bxv[d].w}, lsr[4] = {lsv[d].x, lsv[d].y, lsv[d].z, lsv[d].w};
                    float av[4], uv[4];
#pragma unroll
                    for (int r = 0; r < 4; ++r) {
                        const float gr = sigmoidf_(acc[d * 2][r] + bar_[r]), gi = sigmoidf_(acc[d * 2 + 1][r] + bxr[r]);
                        const float la = gr * lsr[r];
                        av[r] = __expf(la);
                        uv[r] = xv[r] * gi * sqrtf(fmaxf(-expm1f(2.0f * la), 1e-12f));
                    }
                    *(float4*)(p.prep + (PR_LA + d) * TOKW + (size_t)tok * MW + c0) = make_float4(av[0], av[1], av[2], av[3]);
                    *(float4*)(p.prep + (PR_LU + d) * TOKW + (size_t)tok * MW + c0) = make_float4(uv[0], uv[1], uv[2], uv[3]);
                }
            }
        }
        __syncthreads();
    }
}

__device__ __forceinline__ int chunk_base(int b, int d, int n) {
    if (n < 4) { const int blk = d ? 3 - n : n; return NLAT + b * TC + blk * 64; }
    const int m = n - 4, blk = d ? 63 - m : m; return b * TL + blk * 64;
}

__device__ __forceinline__ void local_gla(const Params& p, int l, int tz, int chain, int n, LAS unsigned char* lds) {
    const int tid = opaque_tid(), wid = tid >> 6, lane = tid & 63, fr = lane & 15, fq = lane >> 4;
    const int b = chain >> 3, h = (chain >> 1) & 3, d = chain & 1;
    const int base = chunk_base(b, d, n);
    const size_t item = (size_t)tz * NITEM + (size_t)chain * NCHUNK + n;
    LAS bf16_t* kraw = (LAS bf16_t*)lds;
    LAS bf16_t* qh = kraw + 64 * 136;
    LAS bf16_t* kh = qh + 64 * 136;
    LAS bf16_t* sc = kh + 64 * 136;
    LAS bf16_t* vT = sc + 64 * 72;
    LAS bf16_t* kT = vT + 128 * 72;
    LAS float* bc = (LAS float*)(kT + 128 * 72);
    const int vcol = tz == 1 ? C_HI : C_RQKV + 1024;
    const int ti = tid >> 3, dg = tid & 7, cA = dg * 8, cB = 64 + dg * 8;
    const int tokI = base + (d ? 63 - ti : ti);
    const bf16_t* pr = p.P + (size_t)tokI * NP;
    float qt[16];
    {
        float kv[16], lfv[16];
        if (tz == 1) {
            float lbv[16];
            {
                const float* lp0 = p.hgrn_lb + (size_t)(0 * 2 + d) * MW + h * 128; const float* lp1 = p.hgrn_lb + (size_t)(1 * 2 + d) * MW + h * 128;
                const float4 a0 = *(const float4*)(lp0 + cA), a1 = *(const float4*)(lp0 + cA + 4), a2 = *(const float4*)(lp0 + cB), a3 = *(const float4*)(lp0 + cB + 4);
                const float4 b0 = *(const float4*)(lp1 + cA), b1 = *(const float4*)(lp1 + cA + 4), b2 = *(const float4*)(lp1 + cB), b3 = *(const float4*)(lp1 + cB + 4);
                const float x0[16] = {a0.x, a0.y, a0.z, a0.w, a1.x, a1.y, a1.z, a1.w, a2.x, a2.y, a2.z, a2.w, a3.x, a3.y, a3.z, a3.w};
                const float x1[16] = {b0.x, b0.y, b0.z, b0.w, b1.x, b1.y, b1.z, b1.w, b2.x, b2.y, b2.z, b2.w, b3.x, b3.y, b3.z, b3.w};
#pragma unroll
                for (int e = 0; e < 16; ++e) lbv[e] = (l == 1) ? fminf(__builtin_amdgcn_rcpf(1.0f + __expf(x0[e] - x1[e])), 1.0f - 1e-4f) : 0.f;
            }
            const u32x4 uqa = *(const u32x4*)(pr + C_HQ + h * 128 + cA), uqb = *(const u32x4*)(pr + C_HQ + h * 128 + cB);
            const u32x4 uza = *(const u32x4*)(pr + C_HF + d * 512 + h * 128 + cA), uzb = *(const u32x4*)(pr + C_HF + d * 512 + h * 128 + cB);
#pragma unroll
            for (int e = 0; e < 16; ++e) {
                const unsigned uq = e < 8 ? uqa[(e & 7) >> 1] : uqb[(e & 7) >> 1], uz = e < 8 ? uza[(e & 7) >> 1] : uzb[(e & 7) >> 1];
                const float qraw = (e & 1) ? bfhi(uq) : bflo(uq), z = (e & 1) ? bfhi(uz) : bflo(uz);
                const float lb = lbv[e];
                const float sg = sigmoidf_(z);
                qt[e] = siluf_(qraw) * 0.08838834764831845f;
                kv[e] = (1.f - lb) * (1.f - sg);
                lfv[e] = __logf(fmaxf(lb + (1.f - lb) * sg, 1e-30f));
            }
        } else {
            const bf16_t* rp = pr + C_RQKV + h * 128;
            const u32x4 q1 = *(const u32x4*)(rp + cA), q2 = *(const u32x4*)(rp + cB), k1 = *(const u32x4*)(rp + 512 + cA), k2 = *(const u32x4*)(rp + 512 + cB);
            const float lng = log1pf(-exp2f(-5.0f - (float)h));
            const bool lat = tokI < NLAT;
            const int t = tokI & (TL - 1);
#pragma unroll
            for (int e = 0; e < 8; ++e) {
                float a1 = (e & 1) ? bfhi(q1[e >> 1]) : bflo(q1[e >> 1]), a2 = (e & 1) ? bfhi(q2[e >> 1]) : bflo(q2[e >> 1]);
                float b1 = (e & 1) ? bfhi(k1[e >> 1]) : bflo(k1[e >> 1]), b2 = (e & 1) ? bfhi(k2[e >> 1]) : bflo(k2[e >> 1]);
                if (lat) {
                    const int pi = cA + e;
                    const float pos = (pi < 32) ? (float)(t >> 6) : (float)(t & 63);
                    const float ang = pos * exp2f(-(float)(pi & 31) * (13.287712379549449f / 32.0f));
                    float sn, cs; sincosf(ang, &sn, &cs);
                    const float n1 = a1 * cs - a2 * sn, n2 = a1 * sn + a2 * cs, m1 = b1 * cs - b2 * sn, m2 = b1 * sn + b2 * cs;
                    a1 = n1; a2 = n2; b1 = m1; b2 = m2;
                }
                qt[e] = a1; qt[8 + e] = a2; kv[e] = b1 * 0.08838834764831845f; kv[8 + e] = b2 * 0.08838834764831845f;
                lfv[e] = lng; lfv[8 + e] = lng;
            }
        }
        *(LAS u32x4*)(kraw + ti * 136 + cA) = pack8(kv); *(LAS u32x4*)(kraw + ti * 136 + cB) = pack8(kv + 8);
        *(LAS f32x4*)(bc + ti * 132 + cA) = (f32x4){lfv[0], lfv[1], lfv[2], lfv[3]}; *(LAS f32x4*)(bc + ti * 132 + cA + 4) = (f32x4){lfv[4], lfv[5], lfv[6], lfv[7]};
        *(LAS f32x4*)(bc + ti * 132 + cB) = (f32x4){lfv[8], lfv[9], lfv[10], lfv[11]}; *(LAS f32x4*)(bc + ti * 132 + cB + 4) = (f32x4){lfv[12], lfv[13], lfv[14], lfv[15]};
        const bf16_t* vp = pr + vcol + h * 128;
        const u32x4 v0 = *(const u32x4*)(vp + cA), v1 = *(const u32x4*)(vp + cB);
#pragma unroll
        for (int e = 0; e < 8; ++e) {
            vT[(cA + e) * 72 + ti] = (bf16_t)((e & 1) ? (v0[e >> 1] >> 16) : (v0[e >> 1] & 0xffffu));
            vT[(cB + e) * 72 + ti] = (bf16_t)((e & 1) ? (v1[e >> 1] >> 16) : (v1[e >> 1] & 0xffffu));
        }
    }
    __syncthreads();
    if (tid < 128) {
        float run = 0.f, lv[64];
#pragma unroll
        for (int i = 0; i < 64; ++i) lv[i] = bc[i * 132 + tid];
#pragma unroll
        for (int i = 0; i < 64; ++i) { run += lv[i]; bc[i * 132 + tid] = run; }
    }
    __syncthreads();
    {
        const int I = ti >> 4;
        float qhat[16];
#pragma unroll
        for (int e = 0; e < 16; ++e) {
            const int ch = e < 8 ? cA + e : cB + e - 8;
            const float bi = bc[ti * 132 + ch], rI = I ? bc[(16 * I - 1) * 132 + ch] : 0.f, bl = bc[63 * 132 + ch];
            qhat[e] = qt[e] * __expf(bi - rI); qt[e] = qt[e] * __expf(bi);
            kT[ch * 72 + ti] = (bf16_t)f2bf(bf2f(kraw[ti * 136 + ch]) * __expf(bl - bi));
        }
        *(LAS u32x4*)(qh + ti * 136 + cA) = pack8(qhat); *(LAS u32x4*)(qh + ti * 136 + cB) = pack8(qhat + 8);
        {
            bf16_t* lqb = p.lq + item * 8192 + (size_t)((ti >> 4) * 8) * 256 + (ti & 15) * 4;
            const u32x4 pa = pack8(qt), pb = pack8(qt + 8);
            u32x2 t0; t0[0] = pa[0]; t0[1] = pa[1]; u32x2 t1; t1[0] = pa[2]; t1[1] = pa[3]; u32x2 t2; t2[0] = pb[0]; t2[1] = pb[1]; u32x2 t3; t3[0] = pb[2]; t3[1] = pb[3];
            *(u32x2*)(lqb + (dg >> 1) * 256 + ((dg & 1) * 2 + 0) * 64) = t0; *(u32x2*)(lqb + (dg >> 1) * 256 + ((dg & 1) * 2 + 1) * 64) = t1;
            *(u32x2*)(lqb + (4 + (dg >> 1)) * 256 + ((dg & 1) * 2 + 0) * 64) = t2; *(u32x2*)(lqb + (4 + (dg >> 1)) * 256 + ((dg & 1) * 2 + 1) * 64) = t3;
        }
    }
    if (tid < 128) p.ld[item * 128 + tid] = __expf(bc[63 * 132 + tid]);
    for (int I = 0; I < 4; ++I) {
        if (ti < 16 * (I + 1)) {
            float kk[16];
#pragma unroll
            for (int e = 0; e < 16; ++e) {
                const int ch = e < 8 ? cA + e : cB + e - 8;
                const float rI = I ? bc[(16 * I - 1) * 132 + ch] : 0.f, bj = bc[ti * 132 + ch];
                kk[e] = bf2f(kraw[ti * 136 + ch]) * __expf(fminf(rI - bj, 80.f));
            }
            *(LAS u32x4*)(kh + ti * 136 + cA) = pack8(kk); *(LAS u32x4*)(kh + ti * 136 + cB) = pack8(kk + 8);
        }
        __syncthreads();
        if (wid < 4) {
            const int J = wid;
            u32x2 outv; outv[0] = 0u; outv[1] = 0u;
            if (J <= I) {
                f32x4 acc = (f32x4){0.f, 0.f, 0.f, 0.f};
#pragma unroll
                for (int ks = 0; ks < 4; ++ks)
                    acc = mfma16(*(const LAS bf16x8*)(kh + (J * 16 + fr) * 136 + ks * 32 + fq * 8), *(const LAS bf16x8*)(qh + (I * 16 + fr) * 136 + ks * 32 + fq * 8), acc);
                const int i = 16 * I + fr, j0 = 16 * J + 4 * fq;
#pragma unroll
                for (int r = 0; r < 4; ++r) if (j0 + r > i) acc[r] = 0.f;
                outv = pack4(acc);
            }
            *(LAS u32x2*)(sc + (I * 16 + fr) * 72 + J * 16 + 4 * fq) = outv;
        }
        __syncthreads();
    }
    {
        bf16x8 xv[2], xk[2];
#pragma unroll
        for (int ks = 0; ks < 2; ++ks) { xv[ks] = *(const LAS bf16x8*)(vT + (wid * 16 + fr) * 72 + ks * 32 + fq * 8); xk[ks] = *(const LAS bf16x8*)(kT + (wid * 16 + fr) * 72 + ks * 32 + fq * 8); }
#pragma unroll
        for (int ib = 0; ib < 4; ++ib) {
            f32x4 acc = (f32x4){0.f, 0.f, 0.f, 0.f};
#pragma unroll
            for (int ks = 0; ks < 2; ++ks) acc = mfma16(xv[ks], *(const LAS bf16x8*)(sc + (ib * 16 + fr) * 72 + ks * 32 + fq * 8), acc);
            *(u32x2*)(p.lo + item * 8192 + ((wid * 4 + ib) * 64 + lane) * 4) = pack4(acc);
        }
#pragma unroll
        for (int dvb = 0; dvb < 8; ++dvb) {
            f32x4 acc = (f32x4){0.f, 0.f, 0.f, 0.f};
#pragma unroll
            for (int ks = 0; ks < 2; ++ks) acc = mfma16(xk[ks], *(const LAS bf16x8*)(vT + (dvb * 16 + fr) * 72 + ks * 32 + fq * 8), acc);
            *(u32x2*)(p.lb + item * 16384 + ((wid * 8 + dvb) * 64 + lane) * 4) = pack4(acc);
        }
    }
    __syncthreads();
}


template <int I> struct SolveRows {
    static __device__ __forceinline__ void run(float (&x)[64], const LAS float* Mf, const LAS float* rs) {
        SolveRows<I - 1>::run(x, Mf, rs);
        float r = x[I] * rs[I];
#pragma unroll
        for (int j4 = 0; j4 < (I + 3) / 4; ++j4) {
            const f32x4 m = *(const LAS f32x4*)(Mf + I * 68 + j4 * 4);
            r -= m[0] * x[j4 * 4] + m[1] * x[j4 * 4 + 1] + m[2] * x[j4 * 4 + 2] + m[3] * x[j4 * 4 + 3];
        }
        asm volatile("" : "+v"(r) :: "memory");
        x[I] = r;
    }
};
template <> struct SolveRows<-1> { static __device__ __forceinline__ void run(float (&)[64], const LAS float*, const LAS float*) {} };

__device__ __forceinline__ void local_gdn(const Params& p, int l, int chain, int n, LAS unsigned char* lds) {
    const int tid = opaque_tid(), wid = tid >> 6, lane = tid & 63, fr = lane & 15, fq = lane >> 4;
    const int b = chain >> 3, h = (chain >> 1) & 3, d = chain & 1;
    const int base = chunk_base(b, d, n);
    const size_t item = (size_t)chain * NCHUNK + n;
    LAS bf16_t* ks_ = (LAS bf16_t*)lds;
    LAS bf16_t* qs = ks_ + 64 * 136;
    LAS bf16_t* att = qs + 64 * 136;
    LAS bf16_t* wT = att + 64 * 72;
    LAS bf16_t* uT = wT + 128 * 72;
    LAS bf16_t* kT = uT + 128 * 72;
    LAS float* Mf = (LAS float*)(kT + 128 * 72);
    LAS float* bcs = Mf + 64 * 68;
    LAS float* bts = bcs + 64;
    LAS float* rse = bts + 64;
    LAS bf16_t* vs = (LAS bf16_t*)(rse + 64);
    const int ti = tid >> 3, d0 = (tid & 7) * 16;
    const int tokI = base + (d ? 63 - ti : ti);
    {
        int t, T, sbase; tok_info(tokI, t, T, sbase);
#pragma unroll
        for (int part = 0; part < 3; ++part) {
            float a[16];
#pragma unroll
            for (int e = 0; e < 16; ++e) a[e] = 0.f;
            const int ccol = part * 512 + h * 128 + d0;
#pragma unroll
            for (int j = 0; j < 4; ++j) {
                const int tt = t + j - 2;
                const float okf = (tt >= 0 && tt < T) ? 1.0f : 0.0f;
                const int ttc = tt < 0 ? 0 : (tt >= T ? T - 1 : tt);
                const bf16_t* xp = p.P + (size_t)(sbase + ttc) * NP + C_GQKV + ccol;
                const u32x4 x0 = *(const u32x4*)xp, x1 = *(const u32x4*)(xp + 8);
                const float* wp = p.gdn_conv_w + (size_t)(l * 4 + j) * 1536 + ccol;
#pragma unroll
                for (int q = 0; q < 4; ++q) {
                    float4 w0 = *(const float4*)(wp + q * 4);
                    w0.x *= okf; w0.y *= okf; w0.z *= okf; w0.w *= okf;
                    const unsigned ua = q < 2 ? x0[2 * q] : x1[2 * q - 4], ub = q < 2 ? x0[2 * q + 1] : x1[2 * q - 3];
                    a[q * 4] += w0.x * bflo(ua); a[q * 4 + 1] += w0.y * bfhi(ua); a[q * 4 + 2] += w0.z * bflo(ub); a[q * 4 + 3] += w0.w * bfhi(ub);
                }
            }
            float ss = 0.f;
#pragma unroll
            for (int e = 0; e < 16; ++e) { a[e] = siluf_(a[e]); ss += a[e] * a[e]; }
            if (part < 2) {
                ss += __shfl_xor(ss, 1); ss += __shfl_xor(ss, 2); ss += __shfl_xor(ss, 4);
                const float scl = rsqrtf(ss + 1e-6f) * (part == 0 ? 0.08838834764831845f : 1.0f);
#pragma unroll
                for (int e = 0; e < 16; ++e) a[e] *= scl;
            }
            LAS bf16_t* dstt = (part == 0 ? qs : part == 1 ? ks_ : vs) + ti * 136 + d0;
            *(LAS u32x4*)dstt = pack8(a); *(LAS u32x4*)(dstt + 8) = pack8(a + 8);
        }
    }
    if (wid == 0) {
        const int tok = base + (d ? 63 - lane : lane);
        const float av = bf2f(p.P[(size_t)tok * NP + C_GA + d * 4 + h]);
        float v = -__expf(p.gdn_a_log[l * 8 + d * 4 + h]) * softplusf_(av + p.gdn_dt_bias[l * 8 + d * 4 + h]);
#pragma unroll
        for (int off = 1; off < 64; off <<= 1) { const float t = __shfl_up(v, off); if (lane >= off) v += t; }
        const float btv = sigmoidf_(bf2f(p.P[(size_t)tok * NP + C_GB + d * 4 + h]));
        bcs[lane] = v; bts[lane] = btv; rse[lane] = btv * __expf(v);
    }
    __syncthreads();
#pragma unroll
    for (int e = 0; e < 2; ++e) {
        const int f = wid * 2 + e, ib = f >> 2, jb = f & 3;
        const int i = 16 * ib + fr, j0 = 16 * jb + 4 * fq;
        f32x4 mk = (f32x4){0.f, 0.f, 0.f, 0.f}, mq = (f32x4){0.f, 0.f, 0.f, 0.f};
        if (jb <= ib) {
#pragma unroll
            for (int ks = 0; ks < 4; ++ks) {
                const bf16x8 xk = *(const LAS bf16x8*)(ks_ + (jb * 16 + fr) * 136 + ks * 32 + fq * 8);
                mk = mfma16(xk, *(const LAS bf16x8*)(ks_ + (ib * 16 + fr) * 136 + ks * 32 + fq * 8), mk);
                mq = mfma16(xk, *(const LAS bf16x8*)(qs + (ib * 16 + fr) * 136 + ks * 32 + fq * 8), mq);
            }
            const float bi = bcs[i], bti = bts[i];
#pragma unroll
            for (int r = 0; r < 4; ++r) {
                const int j = j0 + r;
                const float dec = __expf(j <= i ? bi - bcs[j] : 0.f);
                mk[r] = (j < i) ? bti * mk[r] * dec : 0.f;
                mq[r] = (j <= i) ? mq[r] * dec : 0.f;
            }
        }
        *(LAS f32x4*)(Mf + i * 68 + j0) = mk;
        *(LAS u32x2*)(att + i * 72 + j0) = pack4(mq);
    }
    __syncthreads();
    {
        const float sc_ = __expf(bcs[63] - bcs[ti]);
#pragma unroll
        for (int e = 0; e < 16; ++e) kT[(d0 + e) * 72 + ti] = (bf16_t)f2bf(bf2f(ks_[ti * 136 + d0 + e]) * sc_);
    }
    if (tid < 256) {
        const int cidx = tid & 127;
        const bool isw = tid >= 128;
        const LAS bf16_t* srcp = (isw ? ks_ : vs) + cidx;
        float x[64];
#pragma unroll
        for (int i = 0; i < 64; ++i) x[i] = bf2f(srcp[i * 136]);
        {
            unsigned mb = (unsigned)(size_t)Mf, rb = (unsigned)(size_t)(isw ? rse : bts);
            asm volatile("" : "+v"(mb), "+v"(rb));
            SolveRows<63>::run(x, (const LAS float*)(size_t)mb, (const LAS float*)(size_t)rb);
        }
        if (isw) {
#pragma unroll
            for (int i = 0; i < 64; ++i) x[i] = -x[i];
        }
        LAS bf16_t* dst = (isw ? wT : uT) + cidx * 72;
#pragma unroll
        for (int q = 0; q < 8; ++q) *(LAS u32x4*)(dst + q * 8) = pack8(x + q * 8);
    }
    if (tid < 128) p.ld[item * 128 + tid] = __expf(bcs[63]);
    __syncthreads();
    {
        const int tid = opaque_tid(), wid = tid >> 6, lane = tid & 63, fr = lane & 15, fq = lane >> 4;
        bf16x8 xw[2], xu[2], xk[2];
#pragma unroll
        for (int ks = 0; ks < 2; ++ks) {
            xw[ks] = *(const LAS bf16x8*)(wT + (wid * 16 + fr) * 72 + ks * 32 + fq * 8);
            xu[ks] = *(const LAS bf16x8*)(uT + (wid * 16 + fr) * 72 + ks * 32 + fq * 8);
            xk[ks] = *(const LAS bf16x8*)(kT + (wid * 16 + fr) * 72 + ks * 32 + fq * 8);
        }
#pragma unroll
        for (int ib = 0; ib < 4; ++ib) {
            const int i = ib * 16 + fr;
            const u32x2 qr = *(const LAS u32x2*)(qs + i * 136 + wid * 16 + 4 * fq);
            const float eb = __expf(bcs[i]);
            f32x4 aq = (f32x4){bflo(qr[0]) * eb, bfhi(qr[0]) * eb, bflo(qr[1]) * eb, bfhi(qr[1]) * eb};
            f32x4 ao = (f32x4){0.f, 0.f, 0.f, 0.f};
#pragma unroll
            for (int ks = 0; ks < 2; ++ks) {
                const bf16x8 ya = *(const LAS bf16x8*)(att + i * 72 + ks * 32 + fq * 8);
                aq = mfma16(xw[ks], ya, aq); ao = mfma16(xu[ks], ya, ao);
            }
            *(u32x2*)(p.lq + item * 8192 + ((ib * 8 + wid) * 64 + lane) * 4) = pack4(aq);
            *(u32x2*)(p.lo + item * 8192 + ((wid * 4 + ib) * 64 + lane) * 4) = pack4(ao);
        }
#pragma unroll
        for (int db = 0; db < 8; ++db) {
            f32x4 aa = (f32x4){0.f, 0.f, 0.f, 0.f}, ab = (f32x4){0.f, 0.f, 0.f, 0.f};
#pragma unroll
            for (int ks = 0; ks < 2; ++ks) {
                aa = mfma16(xw[ks], *(const LAS bf16x8*)(kT + (db * 16 + fr) * 72 + ks * 32 + fq * 8), aa);
                ab = mfma16(xk[ks], *(const LAS bf16x8*)(uT + (db * 16 + fr) * 72 + ks * 32 + fq * 8), ab);
            }
            *(u32x2*)(p.la + item * 16384 + ((db * 8 + wid) * 64 + lane) * 4) = pack4(aa);
            *(u32x2*)(p.lb + item * 16384 + ((wid * 8 + db) * 64 + lane) * 4) = pack4(ab);
        }
    }
    __syncthreads();
}

__device__ __forceinline__ void ph_local(const Params& p, int l, LAS unsigned char* lds) {
    for (int it = blockIdx.x; it < 3 * NITEM; it += gridDim.x) {
        const int tz = it % 3, ci = it / 3, chain = ci / NCHUNK, n = ci % NCHUNK;
        if (tz == 0) local_gdn(p, l, chain, n, lds); else local_gla(p, l, tz, chain, n, lds);
    }
}

__device__ __forceinline__ void seq_matrix(const Params& p, int tz, int chain, int half, LAS unsigned char* lds) {
    const int tid = opaque_tid(), wid = tid >> 6, lane = tid & 63, fr = lane & 15, fq = lane >> 4;
    const int b = chain >> 3, h = (chain >> 1) & 3, d = chain & 1;
    LAS bf16_t* ST = (LAS bf16_t*)lds;
    float* Op = p.O + (size_t)((tz == 0 ? 0 : tz == 1 ? 1 : 3) * 2 + d) * TOKW;
    f32x4 S[4];
#pragma unroll
    for (int q = 0; q < 4; ++q) S[q] = (f32x4){0.f, 0.f, 0.f, 0.f};
    const int ib = wid >> 1, dv2 = (wid & 1) * 2;
    for (int n = 0; n < NCHUNK; ++n) {
        const size_t item = (size_t)tz * NITEM + (size_t)chain * NCHUNK + n;
        bf16x8 yq[4], xa[4];
#pragma unroll
        for (int ks = 0; ks < 4; ++ks) {
            const u32x2 a = *(const u32x2*)(p.lq + item * 8192 + ((ib * 8 + 2 * ks) * 64 + lane) * 4), b2 = *(const u32x2*)(p.lq + item * 8192 + ((ib * 8 + 2 * ks + 1) * 64 + lane) * 4);
            u32x4 t; t[0] = a[0]; t[1] = a[1]; t[2] = b2[0]; t[3] = b2[1]; yq[ks] = __builtin_bit_cast(bf16x8, t);
        }
        if (tz == 0) {
#pragma unroll
            for (int ks = 0; ks < 4; ++ks) {
                const bf16_t* lap = p.la + ((size_t)chain * NCHUNK + n) * 16384;
                const u32x2 a = *(const u32x2*)(lap + ((wid * 8 + 2 * ks) * 64 + lane) * 4), b2 = *(const u32x2*)(lap + ((wid * 8 + 2 * ks + 1) * 64 + lane) * 4);
                u32x4 t; t[0] = a[0]; t[1] = a[1]; t[2] = b2[0]; t[3] = b2[1]; xa[ks] = __builtin_bit_cast(bf16x8, t);
            }
        }
        u32x2 oin[2], bin[4];
#pragma unroll
        for (int e = 0; e < 2; ++e) oin[e] = *(const u32x2*)(p.lo + item * 8192 + (((half * 4 + dv2 + e) * 4 + ib) * 64 + lane) * 4);
#pragma unroll
        for (int q = 0; q < 4; ++q) bin[q] = *(const u32x2*)(p.lb + item * 16384 + ((wid * 8 + half * 4 + q) * 64 + lane) * 4);
        const f32x4 dec = *(const f32x4*)(p.ld + item * 128 + wid * 16 + 4 * fq);
        LAS bf16_t* st = ST + (n & 1) * 64 * 136;
#pragma unroll
        for (int q = 0; q < 4; ++q) *(LAS u32x2*)(st + (q * 16 + fr) * 136 + 32 * (wid >> 1) + 8 * fq + 4 * (wid & 1)) = pack4(S[q]);
        __syncthreads();
        const int base = chunk_base(b, d, n);
        const int tok = base + (d ? 63 - (ib * 16 + fr) : ib * 16 + fr);
#pragma unroll
        for (int e = 0; e < 2; ++e) {
            f32x4 acc = (f32x4){bflo(oin[e][0]), bfhi(oin[e][0]), bflo(oin[e][1]), bfhi(oin[e][1])};
#pragma unroll
            for (int ks = 0; ks < 4; ++ks) acc = mfma16(*(const LAS bf16x8*)(st + ((dv2 + e) * 16 + fr) * 136 + ks * 32 + fq * 8), yq[ks], acc);
            *(f32x4*)(Op + (size_t)tok * MW + h * 128 + half * 64 + (dv2 + e) * 16 + 4 * fq) = acc;
        }
#pragma unroll
        for (int q = 0; q < 4; ++q) {
            f32x4 acc = (f32x4){dec[0] * S[q][0] + bflo(bin[q][0]), dec[1] * S[q][1] + bfhi(bin[q][0]), dec[2] * S[q][2] + bflo(bin[q][1]), dec[3] * S[q][3] + bfhi(bin[q][1])};
            if (tz == 0) {
#pragma unroll
                for (int ks = 0; ks < 4; ++ks) acc = mfma16(xa[ks], *(const LAS bf16x8*)(st + (q * 16 + fr) * 136 + ks * 32 + fq * 8), acc);
            }
            S[q] = acc;
        }
    }
    __syncthreads();
}

__device__ __forceinline__ void seq_lru(const Params& p, int b, int d, int cg, LAS unsigned char* lds) {
    const int tid = opaque_tid(), seg = tid >> 6, ch = cg * 64 + (tid & 63);
    LAS float* sP = (LAS float*)lds;
    LAS float* sL = sP + 512;
    const float* A = p.prep + (size_t)(PR_LA + d) * TOKW + ch; const float* U = p.prep + (size_t)(PR_LU + d) * TOKW + ch;
    float* Op = p.O + (size_t)(2 * 2 + d) * TOKW + ch;
    constexpr int SEG = (TC + TL) / 8;
    auto tok_of = [&](int pos) { return pos < TC ? NLAT + b * TC + (d ? TC - 1 - pos : pos) : b * TL + (d ? TL - 1 - (pos - TC) : pos - TC); };
    float P = 1.f, L = 0.f;
    for (int i0 = 0; i0 < SEG; i0 += 8) {
        float av[8], uv[8];
#pragma unroll
        for (int q = 0; q < 8; ++q) { const size_t o = (size_t)tok_of(seg * SEG + i0 + q) * MW; av[q] = A[o]; uv[q] = U[o]; }
#pragma unroll
        for (int q = 0; q < 8; ++q) { L = av[q] * L + uv[q]; P *= av[q]; }
    }
    sP[tid] = P; sL[tid] = L;
    __syncthreads();
    float hst = 0.f;
    for (int s = 0; s < seg; ++s) hst = sP[s * 64 + (tid & 63)] * hst + sL[s * 64 + (tid & 63)];
    for (int i0 = 0; i0 < SEG; i0 += 8) {
        float av[8], uv[8]; size_t oo[8];
#pragma unroll
        for (int q = 0; q < 8; ++q) { oo[q] = (size_t)tok_of(seg * SEG + i0 + q) * MW; av[q] = A[oo[q]]; uv[q] = U[oo[q]]; }
#pragma unroll
        for (int q = 0; q < 8; ++q) { hst = av[q] * hst + uv[q]; Op[oo[q]] = hst; }
    }
    __syncthreads();
}

__device__ __forceinline__ void ph_seq(const Params& p, LAS unsigned char* lds) {
    for (int it = blockIdx.x; it < 256; it += gridDim.x) {
        if (it < 192) { const int tz = it >> 6, r = it & 63; seq_matrix(p, tz, r >> 1, r & 1, lds); }
        else { const int r = it - 192; seq_lru(p, r >> 4, (r >> 3) & 1, r & 7, lds); }
    }
}

__device__ __forceinline__ void ph_merge(const Params& p, int l, int M) {
    const int tid = opaque_tid(), wid = tid >> 6, lane = tid & 63;
    for (int id = blockIdx.x * NWAVES + wid; id < M * 16; id += gridDim.x * NWAVES) {
        const int tok = id >> 4, r = id & 15, m = r >> 2, head = r & 3;
        const int cidx = head * 128 + lane * 2;
        const size_t o = (size_t)tok * MW + cidx;
        const f32x2 o0 = *(const f32x2*)(p.O + (size_t)(m * 2) * TOKW + o), o1 = *(const f32x2*)(p.O + (size_t)(m * 2 + 1) * TOKW + o);
        const float a0 = o0[0] + o1[0], a1 = o0[1] + o1[1];
        float y0, y1; int nbr;
        if (m == 2) {
            const unsigned u = *(const unsigned*)(p.P + (size_t)tok * NP + C_LY + cidx);
            y0 = a0 * gelu_tanhf_(bflo(u)); y1 = a1 * gelu_tanhf_(bfhi(u)); nbr = 2;
        } else {
            const float ss = wave_sum(a0 * a0 + a1 * a1);
            const float rinv = rsqrtf(ss * (1.0f / 128.0f) + 1e-6f);
            const float* gp = (m == 0 ? p.gdn_norm_g : m == 1 ? p.hgrn_norm_g : p.ret_norm_g) + l * 128 + lane * 2;
            const int zc = m == 0 ? C_GZ : m == 1 ? C_HG : C_RG;
            const unsigned u = *(const unsigned*)(p.P + (size_t)tok * NP + zc + cidx);
            y0 = a0 * rinv * gp[0] * siluf_(bflo(u)); y1 = a1 * rinv * gp[1] * siluf_(bfhi(u)); nbr = m == 3 ? 3 : m;
        }
        *(unsigned*)(p.Y + (size_t)nbr * TOKW + o) = pack2(y0, y1);
    }
}

struct G2Sched {
    const bf16_t* Y; const bf16_t* Wb; int ntiles, G, c;
    static constexpr bool HAS_BIAS = false, gather = false;
    __device__ __forceinline__ bool next(int i, g8::Unit& u) const {
        const int tile = (i >> 2) * G + c; if (tile >= ntiles) return false;
        u.pm = tile >> 2; u.pn = tile & 3; u.e = i & 3; return true;
    }
    __device__ __forceinline__ const char* a_base(const g8::Unit& u) const { return (const char*)(Y + (size_t)u.e * TOKW + (size_t)u.pm * 256 * MW); }
    __device__ __forceinline__ const char* b_base(const g8::Unit& u) const { return (const char*)(Wb + (size_t)u.e * D * MW + (size_t)u.pn * 256 * MW); }
    __device__ __forceinline__ const int* row_addr(const g8::Unit&, int) const { return nullptr; }
    __device__ __forceinline__ int rows_valid(const g8::Unit&) const { return 256; }
    __device__ __forceinline__ const float* bias_src(const g8::Unit&, int) const { return nullptr; }
};
struct EpiMix {
    const bf16_t* P; bf16_t* O;
    __device__ __forceinline__ bool keep(const g8::Unit& u) const { return u.e < 3; }
    __device__ __forceinline__ void operator()(f32x4 (&acc)[2][2][4][2], const g8::Unit& u, int wr, int wc, int fr, int fq, const LAS float*) const {
        const int row0 = u.pm * 256 + wr * 64 + fr, col0 = u.pn * 256 + wc * 32 + 8 * fq;
        const bool lastseg = u.e == 3;
#pragma unroll
        for (int ai = 0; ai < 2; ++ai)
#pragma unroll
            for (int m = 0; m < 4; ++m)
#pragma unroll
                for (int bj = 0; bj < 2; ++bj) {
                    const size_t row = (size_t)(row0 + ai * 128 + m * 16);
                    const bf16_t* gp = P + row * NP + C_MG + u.e * D + col0 + bj * 128;
                    const u32x4 gc = *(const u32x4*)gp;
                    const u32x4 gn = *(const u32x4*)(gp + (lastseg ? 0 : D));
                    float sc[8];
#pragma unroll
                    for (int q = 0; q < 4; ++q) {
                        const float e0 = __expf(-bflo(gc[q])), e1 = __expf(-bfhi(gc[q]));
                        const float n0 = lastseg ? 1.0f : 1.0f + __expf(-bflo(gn[q])), n1 = lastseg ? 1.0f : 1.0f + __expf(-bfhi(gn[q]));
                        sc[2 * q] = n0 * __builtin_amdgcn_rcpf(1.0f + e0); sc[2 * q + 1] = n1 * __builtin_amdgcn_rcpf(1.0f + e1);
                    }
#pragma unroll
                    for (int n = 0; n < 2; ++n)
#pragma unroll
                        for (int j = 0; j < 4; ++j) acc[ai][bj][m][n][j] *= sc[n * 4 + j];
                    if (lastseg) {
                        u32x4 w; w[0] = pack2(acc[ai][bj][m][0][0], acc[ai][bj][m][0][1]); w[1] = pack2(acc[ai][bj][m][0][2], acc[ai][bj][m][0][3]);
                        w[2] = pack2(acc[ai][bj][m][1][0], acc[ai][bj][m][1][1]); w[3] = pack2(acc[ai][bj][m][1][2], acc[ai][bj][m][1][3]);
                        *(u32x4*)(O + row * D + col0 + bj * 128) = w;
                    }
                }
    }
};
__device__ __forceinline__ void ph_g2(const Params& p, int l, int M, LAS unsigned char* lds) {
    G2Sched S; S.Y = p.Y; S.Wb = p.wbT + (size_t)l * 4 * D * MW; S.ntiles = (M / 256) * 4; S.G = gridDim.x; S.c = blockIdx.x;
    EpiMix E; E.P = p.P; E.O = p.mix;
    g8::gemm_phase(lds, MW, S, E);
}

template <bool DRY> struct EpiRes {
    float* xl; float* xo; const float* mod;
    __device__ __forceinline__ bool keep(const g8::Unit&) const { return false; }
    __device__ __forceinline__ void operator()(const f32x4 (&acc)[2][2][4][2], const g8::Unit& u, int wr, int wc, int fr, int fq, const LAS float*) const {
        const int row0 = u.pm * 256 + wr * 64 + fr, col0 = u.pn * 256 + wc * 32 + 8 * fq;
#pragma unroll
        for (int ai = 0; ai < 2; ++ai)
#pragma unroll
            for (int m = 0; m < 4; ++m) {
                const int row = row0 + ai * 128 + m * 16;
                const float* gtp = mod + (size_t)tok_modrow(row) * (NMOD * D) + 2 * D + col0;
#pragma unroll
                for (int bj = 0; bj < 2; ++bj)
#pragma unroll
                    for (int n = 0; n < 2; ++n) {
                        const float4 gt = *(const float4*)(gtp + bj * 128 + n * 4);
                        const size_t o = (size_t)row * D + col0 + bj * 128 + n * 4;
                        float4 xv = *(const float4*)(xl + o);
                        xv.x += gt.x * acc[ai][bj][m][n][0]; xv.y += gt.y * acc[ai][bj][m][n][1]; xv.z += gt.z * acc[ai][bj][m][n][2]; xv.w += gt.w * acc[ai][bj][m][n][3];
                        *(float4*)(xo + o) = xv;
                    }
            }
    }
};
template <bool DRY = false> __device__ __forceinline__ void ph_g3(const Params& p, int l, int M, LAS unsigned char* lds) {
    g8::PlainSched S; S.init(p.mix, p.woutT + (size_t)l * D * D, M, D, D);
    EpiRes<DRY> E; E.xl = p.xl; E.xo = DRY ? p.prep : p.xl; E.mod = p.mod + (size_t)(l * 5) * (NMOD * D);
    g8::gemm_phase(lds, D, S, E);
}

template <bool DRY = false> __device__ __forceinline__ void ph_route(const Params& p, int l, int M, LAS unsigned char* lds) {
    int* const r_cnt = DRY ? p.cnt + 64 : p.cnt; int* const r_list = DRY ? (int*)p.act : p.list; int* const r_ts = DRY ? (int*)p.yp : p.tokslot; float* const r_tw = DRY ? (float*)p.yp + (size_t)NTOK * 4 : p.topw;
    LAS float* fs = (LAS float*)lds;
    LAS float* lg = fs + 32 * 1028;
    LAS int* lcnt = (LAS int*)(lg + 32 * 36);
    LAS int* lbase = lcnt + 32;
    const int tid = opaque_tid(), wid = tid >> 6, lane = tid & 63;
    const float* rw = p.router_w + (size_t)l * D * NE;
    for (int it = blockIdx.x; it < M / 32; it += gridDim.x) {
        const int tok0 = it * 32;
        {
            float4 v[4][4]; float ss[4];
#pragma unroll
            for (int q = 0; q < 4; ++q) {
                const float* src = p.xl + (size_t)(tok0 + wid * 4 + q) * D;
#pragma unroll
                for (int i = 0; i < 4; ++i) v[q][i] = *(const float4*)(src + i * 256 + lane * 4);
            }
#pragma unroll
            for (int q = 0; q < 4; ++q) {
                float s = 0.f;
#pragma unroll
                for (int i = 0; i < 4; ++i) s += v[q][i].x * v[q][i].x + v[q][i].y * v[q][i].y + v[q][i].z * v[q][i].z + v[q][i].w * v[q][i].w;
                ss[q] = s;
            }
#pragma unroll
            for (int m = 32; m >= 1; m >>= 1)
#pragma unroll
                for (int q = 0; q < 4; ++q) ss[q] += __shfl_xor(ss[q], m);
            const float* mb = p.mod + (size_t)(l * 5 + tok_modrow(tok0)) * (NMOD * D);
#pragma unroll
            for (int i = 0; i < 4; ++i) {
                const int cidx = i * 256 + lane * 4;
                const float4 gv = *(const float4*)(p.norm2_g + l * D + cidx), sv = *(const float4*)(mb + 4 * D + cidx), hv = *(const float4*)(mb + 3 * D + cidx);
#pragma unroll
                for (int q = 0; q < 4; ++q) {
                    const int tl = wid * 4 + q, tok = tok0 + tl;
                    const float rinv = rsqrtf(ss[q] * (1.0f / D) + 1e-6f);
                    const float h0 = v[q][i].x * rinv * gv.x * (1.f + sv.x) + hv.x, h1 = v[q][i].y * rinv * gv.y * (1.f + sv.y) + hv.y;
                    const float h2 = v[q][i].z * rinv * gv.z * (1.f + sv.z) + hv.z, h3 = v[q][i].w * rinv * gv.w * (1.f + sv.w) + hv.w;
                    u32x2 o; o[0] = pack2(h0, h1); o[1] = pack2(h2, h3);
                    *(u32x2*)(p.F + (size_t)tok * D + cidx) = o;
                    *(LAS f32x4*)(fs + tl * 1028 + cidx) = (f32x4){h0, h1, h2, h3};
                }
            }
        }
        __syncthreads();
        {
            typedef float f32x16 __attribute__((ext_vector_type(16)));
            f32x16 acc;
#pragma unroll
            for (int r = 0; r < 16; ++r) acc[r] = 0.f;
            const int tk = lane & 31, hh = lane >> 5;
            const LAS float* ap = fs + tk * 1028 + wid * 128 + 4 * hh;
            const float* bp = rw + (size_t)(wid * 128 + 4 * hh) * NE + tk;
#pragma unroll 4
            for (int kk = 0; kk < 16; ++kk) {
                const f32x4 a4 = *(const LAS f32x4*)(ap + kk * 8);
                const float b0 = bp[(kk * 8 + 0) * NE], b1 = bp[(kk * 8 + 1) * NE], b2 = bp[(kk * 8 + 2) * NE], b3 = bp[(kk * 8 + 3) * NE];
                acc = __builtin_amdgcn_mfma_f32_32x32x2f32(a4[0], b0, acc, 0, 0, 0);
                acc = __builtin_amdgcn_mfma_f32_32x32x2f32(a4[1], b1, acc, 0, 0, 0);
                acc = __builtin_amdgcn_mfma_f32_32x32x2f32(a4[2], b2, acc, 0, 0, 0);
                acc = __builtin_amdgcn_mfma_f32_32x32x2f32(a4[3], b3, acc, 0, 0, 0);
            }
            __syncthreads();
            LAS float* red = fs;
#pragma unroll
            for (int r = 0; r < 16; ++r) red[(wid * 32 + (r & 3) + 8 * (r >> 2) + 4 * hh) * 33 + tk] = acc[r];
            __syncthreads();
            const int t2 = tid >> 4, e0 = (tid & 15) * 2;
            float s0 = p.router_b[l * NE + e0], s1 = p.router_b[l * NE + e0 + 1];
#pragma unroll
            for (int w = 0; w < 8; ++w) { s0 += red[(w * 32 + t2) * 33 + e0]; s1 += red[(w * 32 + t2) * 33 + e0 + 1]; }
            lg[t2 * 36 + e0] = s0; lg[t2 * 36 + e0 + 1] = s1;
            if (tid < 32) lcnt[tid] = 0;
        }
        __syncthreads();
        float vals[4]; int idxs[4], rank[4];
        if (tid < 32) {
            float lv[32];
#pragma unroll
            for (int q = 0; q < 8; ++q) { const f32x4 t = *(const LAS f32x4*)(lg + tid * 36 + q * 4); lv[q * 4] = t[0]; lv[q * 4 + 1] = t[1]; lv[q * 4 + 2] = t[2]; lv[q * 4 + 3] = t[3]; }
#pragma unroll
            for (int k = 0; k < 4; ++k) {
                float best = lv[0]; int bi = 0;
#pragma unroll
                for (int ee = 1; ee < NE; ++ee) { const bool gt = lv[ee] > best; best = gt ? lv[ee] : best; bi = gt ? ee : bi; }
#pragma unroll
                for (int ee = 0; ee < NE; ++ee) lv[ee] = (ee == bi) ? -3.0e38f : lv[ee];
                vals[k] = best; idxs[k] = bi;
                rank[k] = atomicAdd((int*)(lcnt + bi), 1);
            }
        }
        __syncthreads();
        if (tid < 32) { const int c = lcnt[tid]; lbase[tid] = c ? atomicAdd(r_cnt + l * NE + tid, c) : 0; }
        __syncthreads();
        if (tid < 32) {
            const int tok = tok0 + tid;
            const float mx = vals[0];
            float ex[4], sum = 0.f;
#pragma unroll
            for (int k = 0; k < 4; ++k) { ex[k] = __expf(vals[k] - mx); sum += ex[k]; }
            const float inv = 1.0f / sum;
#pragma unroll
            for (int k = 0; k < 4; ++k) {
                const int ee = idxs[k];
                const int slot = lbase[ee] + rank[k];
                r_list[(size_t)ee * NTOK + slot] = tok;
                r_ts[(size_t)tok * 4 + k] = (ee << 16) | slot;
                r_tw[(size_t)tok * 4 + k] = ex[k] * inv;
            }
        }
        __syncthreads();
    }
}

__device__ __forceinline__ void build_expert_tables(const Params& p, int l, LAS int* ts, LAS int* cn, LAS int* te) {
    const int tid = opaque_tid();
    if (tid < 64) {
        const int c = tid < NE ? p.cnt[l * NE + tid] : 0;
        const int nt = (c + 255) >> 8;
        int v = nt;
#pragma unroll
        for (int off = 1; off < 32; off <<= 1) { const int t = __shfl_up(v, off); if (tid >= off) v += t; }
        if (tid < NE) { cn[tid] = c; ts[tid] = v - nt; if (tid == NE - 1) ts[NE] = v; }
        if (te && tid < NE) for (int q = 0; q < nt; ++q) te[v - nt + q] = tid;
    }
    __syncthreads();
}

struct MoeSched {
    const LAS int* ts; const LAS int* cn; const LAS int* te; const int* list; const bf16_t* A; const bf16_t* Bt; const float* bias; int K, npn, nunits, G, c, nrowsB, nbias; bool gather;
    static constexpr bool HAS_BIAS = true;
    __device__ __forceinline__ bool next(int i, g8::Unit& u) const {
        const long L = (long)i * G + c; if (L >= nunits) return false;
        u.pm = (int)(L / npn); u.pn = (int)(L % npn); u.e = te[u.pm]; return true;
    }
    __device__ __forceinline__ const char* a_base(const g8::Unit& u) const { return (const char*)(gather ? A : A + (size_t)u.pm * 256 * K); }
    __device__ __forceinline__ const char* b_base(const g8::Unit& u) const { return (const char*)(Bt + ((size_t)u.e * nrowsB + (size_t)u.pn * 256) * K); }
    __device__ __forceinline__ const int* row_addr(const g8::Unit& u, int R) const {
        const int cnt = cn[u.e], sl = (u.pm - ts[u.e]) * 256 + R;
        return list + (size_t)u.e * NTOK + (sl < cnt ? sl : 0);
    }
    __device__ __forceinline__ int rows_valid(const g8::Unit& u) const { return cn[u.e] - (u.pm - ts[u.e]) * 256; }
    __device__ __forceinline__ const float* bias_src(const g8::Unit& u, int lane) const {
        if (nbias == 2) return bias + (size_t)u.e * 2 * D + (lane < 32 ? u.pn * 128 + lane * 4 : D + u.pn * 128 + (lane - 32) * 4);
        return bias + (size_t)u.e * D + u.pn * 256 + lane * 4;
    }
};
struct EpiAct {
    bf16_t* O;
    __device__ __forceinline__ bool keep(const g8::Unit&) const { return false; }
    __device__ __forceinline__ void operator()(const f32x4 (&acc)[2][2][4][2], const g8::Unit& u, int wr, int wc, int fr, int fq, const LAS float* bias) const {
        const int row0 = u.pm * 256 + wr * 64 + fr, col0 = u.pn * 128 + wc * 32 + 8 * fq;
        const LAS float* bb = bias + wc * 32 + 8 * fq;
        const f32x4 g0 = *(const LAS f32x4*)bb, g1 = *(const LAS f32x4*)(bb + 4), l0 = *(const LAS f32x4*)(bb + 128), l1 = *(const LAS f32x4*)(bb + 132);
        const float bg[8] = {g0[0], g0[1], g0[2], g0[3], g1[0], g1[1], g1[2], g1[3]}, bl[8] = {l0[0], l0[1], l0[2], l0[3], l1[0], l1[1], l1[2], l1[3]};
#pragma unroll
        for (int ai = 0; ai < 2; ++ai)
#pragma unroll
            for (int m = 0; m < 4; ++m) {
                float o[8];
#pragma unroll
                for (int n = 0; n < 2; ++n)
#pragma unroll
                    for (int j = 0; j < 4; ++j) {
                        const float glu = fminf(acc[ai][0][m][n][j] + bg[n * 4 + j], 7.0f);
                        const float lin = fminf(fmaxf(acc[ai][1][m][n][j] + bl[n * 4 + j], -7.0f), 7.0f);
                        o[n * 4 + j] = glu * sigmoidf_(1.702f * glu) * (lin + 1.0f);
                    }
                *(u32x4*)(O + (size_t)(row0 + ai * 128 + m * 16) * D + col0) = pack8(o);
            }
    }
};
__device__ __forceinline__ void ph_g4(const Params& p, int l, LAS unsigned char* lds) {
    LAS int* ts = (LAS int*)(lds + g8::STAGE_BYTES); LAS int* cn = ts + 40; LAS int* te = ts + 80;
    build_expert_tables(p, l, ts, cn, te);
    MoeSched S; S.ts = ts; S.cn = cn; S.te = te; S.list = p.list; S.A = p.F; S.Bt = p.w1T + (size_t)l * NE * 2 * D * D; S.bias = p.moe_b1 + (size_t)l * NE * 2 * D; S.nbias = 2;
    S.K = D; S.npn = 8; S.nunits = ts[NE] * 8; S.G = gridDim.x; S.c = blockIdx.x; S.nrowsB = 2 * D; S.gather = true;
    EpiAct E; E.O = p.act;
    g8::gemm_phase(lds, D, S, E);
}

struct EpiYp {
    bf16_t* O;
    __device__ __forceinline__ bool keep(const g8::Unit&) const { return false; }
    __device__ __forceinline__ void operator()(const f32x4 (&acc)[2][2][4][2], const g8::Unit& u, int wr, int wc, int fr, int fq, const LAS float* bias) const {
        const int row0 = u.pm * 256 + wr * 64 + fr, col0 = u.pn * 256 + wc * 32 + 8 * fq;
#pragma unroll
        for (int bj = 0; bj < 2; ++bj) {
            const LAS float* bb = bias + bj * 128 + wc * 32 + 8 * fq;
            const f32x4 c0v = *(const LAS f32x4*)bb, c1v = *(const LAS f32x4*)(bb + 4);
            const float4 c0 = make_float4(c0v[0], c0v[1], c0v[2], c0v[3]), c1 = make_float4(c1v[0], c1v[1], c1v[2], c1v[3]);
#pragma unroll
            for (int ai = 0; ai < 2; ++ai)
#pragma unroll
                for (int m = 0; m < 4; ++m) {
                    u32x4 w; w[0] = pack2(acc[ai][bj][m][0][0] + c0.x, acc[ai][bj][m][0][1] + c0.y); w[1] = pack2(acc[ai][bj][m][0][2] + c0.z, acc[ai][bj][m][0][3] + c0.w);
                    w[2] = pack2(acc[ai][bj][m][1][0] + c1.x, acc[ai][bj][m][1][1] + c1.y); w[3] = pack2(acc[ai][bj][m][1][2] + c1.z, acc[ai][bj][m][1][3] + c1.w);
                    *(u32x4*)(O + (size_t)(row0 + ai * 128 + m * 16) * D + col0 + bj * 128) = w;
                }
        }
    }
};
__device__ __forceinline__ void ph_g5(const Params& p, int l, LAS unsigned char* lds) {
    LAS int* ts = (LAS int*)(lds + g8::STAGE_BYTES); LAS int* cn = ts + 40; LAS int* te = ts + 80;
    build_expert_tables(p, l, ts, cn, te);
    MoeSched S; S.ts = ts; S.cn = cn; S.te = te; S.list = p.list; S.A = p.act; S.Bt = p.w2T + (size_t)l * NE * D * D; S.bias = p.moe_b2 + (size_t)l * NE * D; S.nbias = 1;
    S.K = D; S.npn = 4; S.nunits = ts[NE] * 4; S.G = gridDim.x; S.c = blockIdx.x; S.nrowsB = D; S.gather = false;
    EpiYp E; E.O = p.yp;
    g8::gemm_phase(lds, D, S, E);
}

template <bool DRY = false> __device__ __forceinline__ void ph_combine(const Params& p, int l, int M, LAS unsigned char* lds) {
    float* const c_xl = DRY ? p.prep : p.xl; bf16_t* const c_H = DRY ? (bf16_t*)(p.prep + (size_t)NTOK * D) : p.H; float* const c_out = DRY ? p.prep : p.out;
    LAS int* ts = (LAS int*)lds; LAS int* cn = ts + 40;
    build_expert_tables(p, l, ts, cn, nullptr);
    const int tid = opaque_tid(), wid = tid >> 6, lane = tid & 63;
    const bool last = (l == 1);
    for (int tok = blockIdx.x * NWAVES + wid; tok < M; tok += gridDim.x * NWAVES) {
        float4 v[4];
        const float* mb = p.mod + (size_t)(l * 5 + tok_modrow(tok)) * (NMOD * D);
        int rows[4]; float wts[4];
#pragma unroll
        for (int k = 0; k < 4; ++k) { const int tsl = p.tokslot[(size_t)tok * 4 + k]; rows[k] = ts[tsl >> 16] * 256 + (tsl & 0xffff); wts[k] = p.topw[(size_t)tok * 4 + k]; }
        float ss = 0.f;
#pragma unroll
        for (int i = 0; i < 4; ++i) {
            const int cidx = i * 256 + lane * 4;
            float m0 = 0.f, m1 = 0.f, m2 = 0.f, m3 = 0.f;
#pragma unroll
            for (int k = 0; k < 4; ++k) {
                const u32x2 u = *(const u32x2*)(p.yp + (size_t)rows[k] * D + cidx);
                m0 += wts[k] * bflo(u[0]); m1 += wts[k] * bfhi(u[0]); m2 += wts[k] * bflo(u[1]); m3 += wts[k] * bfhi(u[1]);
            }
            const float4 gt = *(const float4*)(mb + 5 * D + cidx);
            float4 xv = *(const float4*)(p.xl + (size_t)tok * D + cidx);
            xv.x += gt.x * m0; xv.y += gt.y * m1; xv.z += gt.z * m2; xv.w += gt.w * m3;
            v[i] = xv; ss += xv.x * xv.x + xv.y * xv.y + xv.z * xv.z + xv.w * xv.w;
        }
        ss = wave_sum(ss);
        const float rinv = rsqrtf(ss * (1.0f / D) + 1e-6f);
        if (!last) {
#pragma unroll
            for (int i = 0; i < 4; ++i) *(float4*)(c_xl + (size_t)tok * D + i * 256 + lane * 4) = v[i];
            const float* mb1 = p.mod + (size_t)((l + 1) * 5 + tok_modrow(tok)) * (NMOD * D);
            norm_mod_store(v, rinv, p.norm1_g + (l + 1) * D, mb1 + 1 * D, mb1 + 0 * D, c_H + (size_t)tok * D, lane);
        } else {
#pragma unroll
            for (int i = 0; i < 4; ++i) {
                const int cidx = i * 256 + lane * 4;
                const float4 gv = *(const float4*)(p.final_norm_g + cidx);
                *(float4*)(c_out + (size_t)tok * D + cidx) = make_float4(v[i].x * rinv * gv.x, v[i].y * rinv * gv.y, v[i].z * rinv * gv.z, v[i].w * rinv * gv.w);
            }
        }
    }
}

#define XB_TMO      128
#define XB_XCNT(j)  (256  + 64 * (j))
#define XB_XSUB(j)  (1280 + 64 * (j))
#define XB_XGEN(j)  (2304 + 64 * (j))
#define XB_TOP      3328
#define XB_TOPGEN   3392
#define XCD_BAR_WORDS 3456
#define XB_SPIN_CAP (1u << 18)

__device__ __forceinline__ unsigned xb_ld(unsigned* p)              { return __hip_atomic_load(p, __ATOMIC_RELAXED, __HIP_MEMORY_SCOPE_AGENT); }
__device__ __forceinline__ unsigned xb_add(unsigned* p, unsigned v) { return __hip_atomic_fetch_add(p, v, __ATOMIC_RELAXED, __HIP_MEMORY_SCOPE_AGENT); }
__device__ __forceinline__ unsigned xb_xcc_id() { return (unsigned)__builtin_amdgcn_s_getreg((3 << 11) | 20) & 0xFu; }
#define XB_SPIN(cond, bar) do { unsigned _sp = 0; while (cond) { __builtin_amdgcn_s_sleep(1); \
    if ((++_sp & 255u) == 0u) { if (xb_ld(&(bar)[XB_TMO])) break; if (_sp > XB_SPIN_CAP) { atomicAdd(&(bar)[XB_TMO], 1u); break; } } } } while (0)

struct XcdBarrier {
    unsigned* bar; unsigned x;
    volatile LAS unsigned* st;
};

__device__ __forceinline__ XcdBarrier xcd_barrier_post(unsigned* bar, volatile LAS unsigned* st) {
    XcdBarrier b; b.bar = bar; b.x = xb_xcc_id(); b.st = st;
    if (threadIdx.x == 0) (void)xb_add(&bar[XB_XCNT(b.x)], 1u);
    return b;
}
__device__ __forceinline__ void xcd_barrier_complete(unsigned* bar, unsigned x, unsigned& nloc, unsigned& nx) {
    const unsigned G = gridDim.x * gridDim.y * gridDim.z;
    unsigned sum, cnt, mine, sp = 0u;
    for (;;) {
        sum = 0u; cnt = 0u; mine = 0u;
#pragma unroll
        for (unsigned j = 0; j < 16; ++j) { const unsigned c = xb_ld(&bar[XB_XCNT(j)]); sum += c; cnt += (c > 0u) ? 1u : 0u; mine = (j == x) ? c : mine; }
        if (sum == G) break;
        __builtin_amdgcn_s_sleep(1);
        if ((++sp & 255u) == 0u) { if (xb_ld(&bar[XB_TMO])) break; if (sp > XB_SPIN_CAP) { atomicAdd(&bar[XB_TMO], 1u); break; } }
    }
    nloc = mine > 0u ? mine : 1u; nx = cnt > 0u ? cnt : 1u;
}

__device__ __forceinline__ void xcd_barrier(const XcdBarrier& b) {
    asm volatile("s_waitcnt vmcnt(0)" ::: "memory");
    __syncthreads();
    if (threadIdx.x == 0) {
        unsigned* bar = b.bar;
        __builtin_amdgcn_s_waitcnt(0);
        unsigned nloc = b.st[0], nx = b.st[1];
        if (nloc == 0u) { xcd_barrier_complete(bar, b.x, nloc, nx); b.st[0] = nloc; b.st[1] = nx; }
        const unsigned old = xb_add(&bar[XB_XSUB(b.x)], 1u);
        const unsigned gen = old / nloc;
        if (old + 1u == (gen + 1u) * nloc) {
            __builtin_amdgcn_fence(__ATOMIC_RELEASE, "agent");
            asm volatile("s_waitcnt vmcnt(0)" ::: "memory");
            const unsigned og = xb_add(&bar[XB_TOP], 1u);
            const unsigned tg = og / nx;
            if (og + 1u == (tg + 1u) * nx) xb_add(&bar[XB_TOPGEN], 1u);
            else XB_SPIN(xb_ld(&bar[XB_TOPGEN]) == tg, bar);
            __builtin_amdgcn_fence(__ATOMIC_ACQUIRE, "agent");
            xb_add(&bar[XB_XGEN(b.x)], 1u);
            asm volatile("s_waitcnt vmcnt(0)" ::: "memory");
        } else {
            XB_SPIN(xb_ld(&bar[XB_XGEN(b.x)]) == gen, bar);
            __builtin_amdgcn_fence(__ATOMIC_ACQUIRE, "agent");
            asm volatile("s_waitcnt vmcnt(0)" ::: "memory");
        }
    }
    __syncthreads();
}


extern __shared__ __attribute__((aligned(16))) unsigned char dyn_lds[];
#define KPH(name, call) __global__ void __launch_bounds__(NTHREADS, 2) name(Params p, int l, int M) { LAS unsigned char* lds = (LAS unsigned char*)dyn_lds; (void)l; (void)M; (void)lds; call; }
KPH(k_convert, { ph_convert(p, lds); })
KPH(k_mod, { ph_mod(p, lds); })
KPH(k_norm1, { ph_norm1_first(p); })
KPH(k_g1, { ph_g1(p, l, lds); })
KPH(k_prep, { ph_prep(p, l, lds); })
KPH(k_local, { ph_local(p, l, lds); })
KPH(k_seq, { ph_seq(p, lds); })
KPH(k_merge, { ph_merge(p, l, M); })
KPH(k_g2, { ph_g2(p, l, M, lds); })
KPH(k_g3, { ph_g3(p, l, M, lds); })
KPH(k_route, { ph_route(p, l, M, lds); })
KPH(k_g4, { ph_g4(p, l, lds); })
KPH(k_g5, { ph_g5(p, l, lds); })
KPH(k_combine, { ph_combine(p, l, M, lds); })


__global__ void __launch_bounds__(NTHREADS, 2) k_mega(Params p) {
    LAS unsigned char* lds = (LAS unsigned char*)dyn_lds;
    volatile LAS unsigned* xb_words = (volatile LAS unsigned*)(lds + LDS_BYTES - 16);
    if (threadIdx.x == 0) { xb_words[0] = 0u; xb_words[1] = 0u; xb_words[2] = 0u; xb_words[3] = 0u; }
    __syncthreads();
    (void)xcd_barrier_post(p.bar, xb_words);
#define GRID_BARRIER() do { XcdBarrier b_; b_.bar = p.bar; b_.x = xb_xcc_id(); b_.st = xb_words; xcd_barrier(b_); } while (0)
#define RUNP(bit, stmt) do { stmt; if (PROBE & (1 << (bit))) { GRID_BARRIER(); stmt; } } while (0)
    RUNP(0, ph_convert(p, lds));
    RUNP(1, ph_mod(p, lds));
    GRID_BARRIER();
    RUNP(2, ph_norm1_first(p));
    GRID_BARRIER();
    for (int l = 0; l < 2; ++l) {
        const int M = l == 0 ? NTOK : NLAT;
        RUNP(3, ph_g1(p, l, lds));
        GRID_BARRIER();
        RUNP(4, ph_prep(p, l, lds));
        GRID_BARRIER();
        RUNP(5, ph_local(p, l, lds));
        GRID_BARRIER();
        RUNP(6, ph_seq(p, lds));
        GRID_BARRIER();
        RUNP(7, ph_merge(p, l, M));
        GRID_BARRIER();
        RUNP(8, ph_g2(p, l, M, lds));
        GRID_BARRIER();
        if (PROBE & (1 << 11)) { ph_g3<true>(p, l, M, lds); GRID_BARRIER(); }
        ph_g3(p, l, M, lds);
        GRID_BARRIER();
        if (PROBE & (1 << 12)) { ph_route<true>(p, l, M, lds); GRID_BARRIER(); }
        ph_route(p, l, M, lds);
        GRID_BARRIER();
        RUNP(9, ph_g4(p, l, lds));
        GRID_BARRIER();
        RUNP(10, ph_g5(p, l, lds));
        GRID_BARRIER();
        if (PROBE & (1 << 13)) { ph_combine<true>(p, l, M, lds); GRID_BARRIER(); }
        ph_combine(p, l, M, lds);
        if (l == 0) GRID_BARRIER();
    }
}

static inline size_t align_up(size_t v, size_t a) { return (v + a - 1) / a * a; }

extern "C" void kernel_launch(void* const* d_in, const int* in_sizes, int n_in, void* d_out, int out_size, void* d_ws, size_t ws_size, hipStream_t stream) {
    (void)in_sizes; (void)n_in; (void)out_size;
    Params p{};
    const float** pf = (const float**)&p;
    for (int i = 0; i < 32; ++i) pf[i] = (const float*)d_in[i];
    p.out = (float*)d_out;
    unsigned char* w = (unsigned char*)d_ws; size_t off = 0;
    auto take = [&](size_t bytes) { void* r = w + off; off = align_up(off + bytes, 256); return r; };
    p.bar = (unsigned*)take(16384);
    p.cnt = (int*)take(1024);
    const size_t ctl_bytes = off;
    p.mod = (float*)take((size_t)2 * 5 * NMOD * D * 4);
    p.winT = (bf16_t*)take((size_t)2 * NP * D * 2);
    p.wbT = (bf16_t*)take((size_t)2 * 4 * D * MW * 2);
    p.woutT = (bf16_t*)take((size_t)2 * D * D * 2);
    p.w1T = (bf16_t*)take((size_t)2 * NE * 2 * D * D * 2);
    p.w2T = (bf16_t*)take((size_t)2 * NE * D * D * 2);
    p.xl = (float*)take((size_t)NTOK * D * 4);
    p.H = (bf16_t*)take((size_t)NTOK * D * 2);
    p.P = (bf16_t*)take((size_t)NTOK * NP * 2);
    p.act = p.P; p.yp = p.P + (size_t)CAPROWS * D;
    p.prep = (float*)take(NPREP * TOKW * 4);
    p.gg = (float*)take((size_t)NTOK * 8 * 4);
    p.gb = (float*)take((size_t)NTOK * 8 * 4);
    p.O = (float*)take(8 * TOKW * 4);
    p.lq = (bf16_t*)take((size_t)3 * NITEM * 64 * 128 * 2);
    p.lo = (bf16_t*)take((size_t)3 * NITEM * 64 * 128 * 2);
    p.lb = (bf16_t*)take((size_t)3 * NITEM * 128 * 128 * 2);
    p.la = (bf16_t*)take((size_t)NITEM * 128 * 128 * 2);
    p.ld = (float*)take((size_t)3 * NITEM * 128 * 4);
    p.lruT = (bf16_t*)take((size_t)2 * 8 * 4 * 4096 * 2);
    p.Y = (bf16_t*)take(4 * TOKW * 2);
    p.mix = (bf16_t*)take((size_t)NTOK * D * 2);
    p.F = p.H;
    p.list = (int*)take((size_t)NE * NTOK * 4);
    p.tokslot = (int*)take((size_t)NTOK * 4 * 4);
    p.topw = (float*)take((size_t)NTOK * 4 * 4);
    if (off > ws_size) { fprintf(stderr, "workspace too small: need %zu have %zu\n", off, ws_size); return; }

    static int grid = 0;
#if MEGA
    if (!grid) {
        int dev = 0, cus = 0, occ = 0; (void)hipGetDevice(&dev); (void)hipDeviceGetAttribute(&cus, hipDeviceAttributeMultiprocessorCount, dev);
        (void)hipFuncSetAttribute((const void*)k_mega, hipFuncAttributeMaxDynamicSharedMemorySize, LDS_BYTES);
        (void)hipOccupancyMaxActiveBlocksPerMultiprocessor(&occ, (const void*)k_mega, NTHREADS, LDS_BYTES);
        if (cus <= 0) cus = 256;
        grid = cus * (occ < 1 ? 1 : 1);
        if (occ < 1) fprintf(stderr, "occupancy query says %d blocks per CU\n", occ);
    }
    (void)hipMemsetAsync(d_ws, 0, ctl_bytes, stream);
    hipLaunchKernelGGL(k_mega, dim3(grid), dim3(NTHREADS), LDS_BYTES, stream, p);
#else
    if (!grid) {
        int dev = 0, cus = 0; (void)hipGetDevice(&dev); (void)hipDeviceGetAttribute(&cus, hipDeviceAttributeMultiprocessorCount, dev);
        grid = cus > 0 ? cus : 256;
        const void* ks[] = {(const void*)k_convert, (const void*)k_mod, (const void*)k_norm1, (const void*)k_g1, (const void*)k_prep, (const void*)k_local, (const void*)k_seq, (const void*)k_merge,
                            (const void*)k_g2, (const void*)k_g3, (const void*)k_route, (const void*)k_g4, (const void*)k_g5, (const void*)k_combine};
        for (const void* k : ks) (void)hipFuncSetAttribute(k, hipFuncAttributeMaxDynamicSharedMemorySize, LDS_BYTES);
    }
    (void)hipMemsetAsync(d_ws, 0, ctl_bytes, stream);
#define LAUNCH(k, l, M) hipLaunchKernelGGL(k, dim3(grid), dim3(NTHREADS), LDS_BYTES, stream, p, l, M)
    LAUNCH(k_convert, 0, 0);
    LAUNCH(k_mod, 0, 0);
    LAUNCH(k_norm1, 0, 0);
    for (int l = 0; l < 2; ++l) {
        const int M = l == 0 ? NTOK : NLAT;
        LAUNCH(k_g1, l, M);
        LAUNCH(k_prep, l, M);
        LAUNCH(k_local, l, M);
        LAUNCH(k_seq, l, M);
        LAUNCH(k_merge, l, M);
        LAUNCH(k_g2, l, M);
        LAUNCH(k_g3, l, M);
        LAUNCH(k_route, l, M);
        LAUNCH(k_g4, l, M);
        LAUNCH(k_g5, l, M);
        LAUNCH(k_combine, l, M);
    }
#endif
}
```

```cpp
#include <hip/hip_runtime.h>
#include <stdint.h>
#include <stdio.h>

#define LAS __attribute__((address_space(3)))
typedef unsigned short bf16_t;
typedef short bf16x8 __attribute__((ext_vector_type(8)));
typedef float f32x4 __attribute__((ext_vector_type(4)));
typedef float f32x2 __attribute__((ext_vector_type(2)));
typedef unsigned u32x2 __attribute__((ext_vector_type(2)));
typedef unsigned u32x4 __attribute__((ext_vector_type(4)));

#ifndef MEGA
#define MEGA 1
#endif
#ifndef PROBE
#define PROBE 0
#endif

constexpr int D = 1024, NB = 4, TL = 4096, TC = 256, NLAT = NB * TL, NCTX = NB * TC, NTOK = NLAT + NCTX;
constexpr int NIN = 11792, NP = 12032, MW = 512, NE = 32, TOPK = 4, NMOD = 6;
constexpr int C_GQKV = 0, C_GZ = 1536, C_GA = 2048, C_GB = 2056, C_HQ = 2064, C_HI = 2576, C_HF = 3088, C_HG = 4112, C_LX = 4624,
              C_LY = 5136, C_RQKV = 5648, C_RG = 7184, C_MG = 7696;
constexpr int NTHREADS = 512, NWAVES = 8;
constexpr int LDS_BYTES = 140 * 1024;
constexpr int CAPROWS = 77824;
constexpr size_t TOKW = (size_t)NTOK * MW;
constexpr int PR_LA = 0, PR_LU = 2, NPREP = 4;
constexpr int NCHUNK = 68, NITEM = 32 * NCHUNK;

struct Params {
    const float *x, *c, *ctx, *c_ctx, *w_mod, *b_mod, *norm1_g, *norm2_g, *w_in, *gdn_conv_w, *gdn_a_log, *gdn_dt_bias, *gdn_norm_g, *hgrn_lb,
        *hgrn_norm_g, *lru_conv_w, *lru_conv_b, *lru_wa, *lru_ba, *lru_wx, *lru_bx, *lru_lambda, *ret_norm_g, *w_branch, *w_out, *router_w,
        *router_b, *moe_w1, *moe_b1, *moe_w2, *moe_b2, *final_norm_g;
    float* out;
    unsigned* bar; int* cnt; float* mod;
    bf16_t *winT, *wbT, *woutT, *w1T, *w2T;
    float* xl; bf16_t* H; bf16_t* P; float* prep; float* gg; float* gb; float* O; bf16_t* Y; bf16_t* mix; bf16_t* F;
    int* list; int* tokslot; float* topw; bf16_t* act; bf16_t* yp;
    bf16_t *lq, *lo, *lb, *la; float* ld; bf16_t* lruT;
};

__device__ __forceinline__ unsigned f2bf(float f) { unsigned u = __float_as_uint(f); u += 0x7fffu + ((u >> 16) & 1u); return u >> 16; }
__device__ __forceinline__ unsigned pack2(float a, float b) { return f2bf(a) | (f2bf(b) << 16); }
__device__ __forceinline__ float bf2f(bf16_t b) { return __uint_as_float(((unsigned)b) << 16); }
__device__ __forceinline__ float bflo(unsigned u) { return __uint_as_float(u << 16); }
__device__ __forceinline__ float bfhi(unsigned u) { return __uint_as_float(u & 0xffff0000u); }
__device__ __forceinline__ float sigmoidf_(float x) { return __builtin_amdgcn_rcpf(1.0f + __expf(-x)); }
__device__ __forceinline__ float siluf_(float x) { return x * sigmoidf_(x); }
__device__ __forceinline__ float softplusf_(float x) { return x > 20.f ? x : log1pf(__expf(x)); }
__device__ __forceinline__ float logsigmoidf_(float x) { return -softplusf_(-x); }
__device__ __forceinline__ float gelu_tanhf_(float x) { const float u = 0.7978845608028654f * (x + 0.044715f * x * x * x); return 0.5f * x * (1.0f + tanhf(u)); }
__device__ __forceinline__ float wave_sum(float v) {
#pragma unroll
    for (int m = 32; m >= 1; m >>= 1) v += __shfl_xor(v, m);
    return v;
}
__device__ __forceinline__ int opaque_tid() { int t = threadIdx.x; asm volatile("" : "+v"(t)); return t; }
template <class T> __device__ __forceinline__ T* opaque_sptr(T* q) { asm volatile("" : "+s"(q)); return q; }
__device__ __forceinline__ int tok_modrow(int tok) { return tok < NLAT ? (tok >> 12) : 4; }
__device__ __forceinline__ void tok_info(int tok, int& t, int& T, int& base) {
    if (tok < NLAT) { t = tok & (TL - 1); T = TL; base = tok - t; }
    else { t = (tok - NLAT) & (TC - 1); T = TC; base = tok - t; }
}

__device__ __forceinline__ f32x4 mfma16(bf16x8 a, bf16x8 b, f32x4 c) { return __builtin_amdgcn_mfma_f32_16x16x32_bf16(a, b, c, 0, 0, 0); }
__device__ __forceinline__ u32x2 pack4(f32x4 v) { u32x2 o; o[0] = pack2(v[0], v[1]); o[1] = pack2(v[2], v[3]); return o; }
__device__ __forceinline__ u32x4 pack8(const float* v) { u32x4 o; o[0] = pack2(v[0], v[1]); o[1] = pack2(v[2], v[3]); o[2] = pack2(v[4], v[5]); o[3] = pack2(v[6], v[7]); return o; }

namespace gm {
constexpr int HT = 16384;
__device__ __forceinline__ int lds_byte(int r, int c) { const int st = (r >> 4) * 2 + (c >> 5), rr = r & 15, cc = c & 31, ob = rr * 64 + cc * 2; return st * 1024 + (ob ^ (((ob >> 9) & 1) << 5)); }
__device__ __forceinline__ void stage_rc(int b, int& R, int& C) { const int st = b / 1024, sb = b % 1024, swz = sb ^ (((sb >> 9) & 1) << 5); R = (st >> 1) * 16 + swz / 64; C = (st & 1) * 32 + (swz % 64) / 2; }

__device__ __forceinline__ void kloop(LAS unsigned char* lds, const bf16_t* ap00, const bf16_t* ap01, const bf16_t* ap10, const bf16_t* ap11,
                                      const bf16_t* bp0, const bf16_t* bp1, int K, f32x4 (&acc)[4][4]) {
    const int tid = opaque_tid(), wid = __builtin_amdgcn_readfirstlane(tid >> 6), lane = tid & 63, wr = wid >> 1, wc = wid & 1, fr = lane & 15, fq = lane >> 4;
    const unsigned ldsw = (unsigned)wid * 1024u;
    const int aoff = (wr >> 1) * HT + lds_byte((wr & 1) * 64 + fr, fq * 8);
    const int boff = 2 * HT + lds_byte(wc * 64 + fr, fq * 8);
    const int nt = K / 64;
#define GM_GLDS(src, dstoff) __builtin_amdgcn_global_load_lds((const unsigned*)(src), (LAS unsigned*)(lds + (dstoff)), 16, 0, 0)
#define GM_STAGE(buf, kt) do { const int _bo = (buf) * 3 * HT + ldsw; const int _ko = (kt) * 64; \
        GM_GLDS(ap00 + _ko, _bo); GM_GLDS(ap01 + _ko, _bo + 8192); GM_GLDS(ap10 + _ko, _bo + HT); GM_GLDS(ap11 + _ko, _bo + HT + 8192); \
        GM_GLDS(bp0 + _ko, _bo + 2 * HT); GM_GLDS(bp1 + _ko, _bo + 2 * HT + 8192); } while (0)
    GM_STAGE(0, 0);
    for (int t = 0; t < nt; ++t) {
        const int cur = t & 1;
        if (t + 1 < nt) { GM_STAGE(cur ^ 1, t + 1); asm volatile("s_waitcnt vmcnt(6)" ::: "memory"); }
        else asm volatile("s_waitcnt vmcnt(0)" ::: "memory");
        __builtin_amdgcn_s_barrier(); asm volatile("" ::: "memory");
        bf16x8 af[4][2], bfr[4][2];
#pragma unroll
        for (int m = 0; m < 4; ++m)
#pragma unroll
            for (int k = 0; k < 2; ++k) af[m][k] = *(const LAS bf16x8*)(lds + cur * 3 * HT + aoff + m * 2048 + k * 1024);
#pragma unroll
        for (int n = 0; n < 4; ++n)
#pragma unroll
            for (int k = 0; k < 2; ++k) bfr[n][k] = *(const LAS bf16x8*)(lds + cur * 3 * HT + boff + n * 2048 + k * 1024);
#pragma unroll
        for (int k = 0; k < 2; ++k)
#pragma unroll
            for (int m = 0; m < 4; ++m)
#pragma unroll
                for (int n = 0; n < 4; ++n) acc[m][n] = __builtin_amdgcn_mfma_f32_16x16x32_bf16(bfr[n][k], af[m][k], acc[m][n], 0, 0, 0);
        asm volatile("s_waitcnt lgkmcnt(0)" ::: "memory");
        __builtin_amdgcn_s_barrier(); asm volatile("" ::: "memory");
    }
#undef GM_STAGE
#undef GM_GLDS
}
__device__ __forceinline__ void zero_acc(f32x4 (&acc)[4][4]) {
#pragma unroll
    for (int m = 0; m < 4; ++m)
#pragma unroll
        for (int n = 0; n < 4; ++n) acc[m][n] = (f32x4){0.f, 0.f, 0.f, 0.f};
}
}

namespace g8 {
constexpr int BM = 256, BK = 64, HALF = 128, HTB = HALF * BK * 2, STAGE_BYTES = 8 * HTB;
__device__ __forceinline__ int lds_byte(int r, int c) { const int st = (r >> 4) * 2 + (c >> 5), rr = r & 15, cc = c & 31, ob = rr * 64 + cc * 2; return st * 1024 + (ob ^ (((ob >> 9) & 1) << 5)); }
__device__ __forceinline__ void stage_rc(int b, int& R, int& C) { const int st = b / 1024, sb = b % 1024, swz = sb ^ (((sb >> 9) & 1) << 5); R = (st >> 1) * 16 + swz / 64; C = (st & 1) * 32 + (swz % 64) / 2; }
__device__ __forceinline__ int perm32(int rho) { const int n = rho >> 4, i = rho & 15; return 8 * (i >> 2) + 4 * n + (i & 3); }
struct Unit { int pm, pn, e; };

template <class Epi, class Sched>
__device__ __forceinline__ void gemm_phase(LAS unsigned char* lds, const int K, const Sched& S, const Epi& E) {
    const int tid = opaque_tid(), wid = __builtin_amdgcn_readfirstlane(tid >> 6), lane = tid & 63, wr = wid >> 2, wc = wid & 3, fr = lane & 15, fq = lane >> 4;
    const int nt = K / BK;
    int R0, C0, R1, C1; stage_rc(tid * 16, R0, C0); stage_rc(tid * 16 + 8192, R1, C1);
    unsigned voffB[2];
    voffB[0] = (unsigned)(((R0 & ~31) + perm32(R0 & 31)) * K + C0) * 2u; voffB[1] = (unsigned)(((R1 & ~31) + perm32(R1 & 31)) * K + C1) * 2u;
    const unsigned cb0 = (unsigned)C0 * 2u, cb1 = (unsigned)C1 * 2u;
    const size_t kstep = (size_t)(BK * 2);
    const size_t hstepB = (size_t)HALF * K * 2;
    const unsigned ldsw = (unsigned)wid * 1024u;
    const int aoff = lds_byte(wr * 64 + fr, fq * 8), boff = lds_byte(wc * 32 + fr, fq * 8);
#define G8_SA(b, h) (((b) * 2 + (h)) * HTB)
#define G8_SB(b, h) ((4 + (b) * 2 + (h)) * HTB)
#define G8_GL(src, dstoff) __builtin_amdgcn_global_load_lds((const unsigned*)(src), (LAS unsigned*)(lds + (dstoff)), 16, 0, 0)
#define G8_STAGE_A(bufoff, gbase, vo, h) do { G8_GL((const char*)(gbase) + (vo)[2 * (h)], (bufoff) + ldsw); G8_GL((const char*)(gbase) + (vo)[2 * (h) + 1], (bufoff) + ldsw + 8192); } while (0)
#define G8_STAGE_B(bufoff, gbase) do { G8_GL((const char*)(gbase) + voffB[0], (bufoff) + ldsw); G8_GL((const char*)(gbase) + voffB[1], (bufoff) + ldsw + 8192); } while (0)
#define G8_LDA(dst, b, h) do { _Pragma("unroll") for (int m = 0; m < 4; ++m) _Pragma("unroll") for (int k = 0; k < 2; ++k) dst[m][k] = *(const LAS bf16x8*)(lds + G8_SA(b, h) + aoff + m * 2048 + k * 1024); } while (0)
#define G8_LDB(dst, b, h) do { _Pragma("unroll") for (int n = 0; n < 2; ++n) _Pragma("unroll") for (int k = 0; k < 2; ++k) dst[n][k] = *(const LAS bf16x8*)(lds + G8_SB(b, h) + boff + n * 2048 + k * 1024); } while (0)
#define G8_MMA(ai, bj, At, Bt) do { __builtin_amdgcn_s_setprio(1); _Pragma("unroll") for (int m = 0; m < 4; ++m) _Pragma("unroll") for (int n = 0; n < 2; ++n) _Pragma("unroll") for (int k = 0; k < 2; ++k) \
        acc[ai][bj][m][n] = __builtin_amdgcn_mfma_f32_16x16x32_bf16(Bt[n][k], At[m][k], acc[ai][bj][m][n], 0, 0, 0); __builtin_amdgcn_s_setprio(0); } while (0)
#define G8_WAIT_V(n) asm volatile("s_waitcnt vmcnt(" #n ")" ::: "memory")
#define G8_WAIT_L(n) asm volatile("s_waitcnt lgkmcnt(" #n ")" ::: "memory")
#define G8_BAR __builtin_amdgcn_s_barrier()
#define G8_SCHED __builtin_amdgcn_sched_barrier(0)
    Unit cur, nxt; int ui = 0;
    if (!S.next(0, cur)) return;
    LAS float* biasbuf = (LAS float*)(lds + STAGE_BYTES + 2048);
    LAS int* rowbuf = (LAS int*)(lds + STAGE_BYTES + 4096);
    f32x4 acc[2][2][4][2];
#pragma unroll
    for (int a = 0; a < 2; ++a)
#pragma unroll
        for (int b = 0; b < 2; ++b)
#pragma unroll
            for (int m = 0; m < 4; ++m)
#pragma unroll
                for (int n = 0; n < 2; ++n) acc[a][b][m][n] = (f32x4){0.f, 0.f, 0.f, 0.f};
    bf16x8 At[4][2], B0[2][2], B1[2][2];
    unsigned vA[4];
    {
        unsigned rows[4] = {(unsigned)R0, (unsigned)R1, (unsigned)(HALF + R0), (unsigned)(HALF + R1)};
        if (S.gather) { rows[0] = (unsigned)*S.row_addr(cur, R0); rows[1] = (unsigned)*S.row_addr(cur, R1); rows[2] = (unsigned)*S.row_addr(cur, HALF + R0); rows[3] = (unsigned)*S.row_addr(cur, HALF + R1); }
        vA[0] = rows[0] * (unsigned)(K * 2) + cb0; vA[1] = rows[1] * (unsigned)(K * 2) + cb1; vA[2] = rows[2] * (unsigned)(K * 2) + cb0; vA[3] = rows[3] * (unsigned)(K * 2) + cb1;
    }
    const char* cA = S.a_base(cur); const char* cB = S.b_base(cur);
    G8_STAGE_B(G8_SB(0, 0), cB); G8_STAGE_A(G8_SA(0, 0), cA, vA, 0); G8_STAGE_B(G8_SB(0, 1), cB + hstepB); G8_STAGE_A(G8_SA(0, 1), cA, vA, 1);
    if (wr == 1) G8_BAR;
    G8_WAIT_V(4); G8_BAR;
    G8_STAGE_B(G8_SB(1, 0), cB + kstep); G8_STAGE_A(G8_SA(1, 0), cA + kstep, vA, 0); G8_STAGE_B(G8_SB(1, 1), cB + hstepB + kstep);
    G8_WAIT_V(6); G8_BAR;
    for (;;) {
        const bool has_next = S.next(ui + 1, nxt);
        const char* nA = has_next ? S.a_base(nxt) : cA; const char* nB = has_next ? S.b_base(nxt) : cB;
        const int nvalid = (S.gather && has_next) ? S.rows_valid(nxt) : 0;
        if (wid == 0) {
            if (Sched::HAS_BIAS) G8_GL(S.bias_src(cur, lane), STAGE_BYTES + 2048 + (ui & 1) * 1024);
            if (S.gather && has_next) G8_GL(S.row_addr(nxt, 0) + lane * 4, STAGE_BYTES + 4096 + ((ui + 1) & 1) * 1024);
        }
        unsigned vlast[4] = {vA[0], vA[1], vA[2], vA[3]};
        for (int t = 0; t < nt; t += 2) {
            const bool last = (t == nt - 2);
            const char* a1 = cA + (size_t)(t + 1) * kstep;
            const char* a2 = last ? nA : cA + (size_t)(t + 2) * kstep; const char* b2 = last ? nB : cB + (size_t)(t + 2) * kstep;
            const char* a3 = a2 + kstep; const char* b3 = b2 + kstep;
            unsigned v2[4];
#pragma unroll
            for (int q = 0; q < 4; ++q) v2[q] = vA[q];
            if (last && S.gather && has_next) {
                const LAS int* rb = rowbuf + ((ui + 1) & 1) * 256;
                const unsigned r0 = R0 < nvalid ? (unsigned)rb[R0] : 0u, r1 = R1 < nvalid ? (unsigned)rb[R1] : 0u;
                const unsigned r2 = HALF + R0 < nvalid ? (unsigned)rb[HALF + R0] : 0u, r3 = HALF + R1 < nvalid ? (unsigned)rb[HALF + R1] : 0u;
                v2[0] = r0 * (unsigned)(K * 2) + cb0; v2[1] = r1 * (unsigned)(K * 2) + cb1; v2[2] = r2 * (unsigned)(K * 2) + cb0; v2[3] = r3 * (unsigned)(K * 2) + cb1;
            }
            if (last) { vlast[0] = v2[0]; vlast[1] = v2[1]; vlast[2] = v2[2]; vlast[3] = v2[3]; }
            G8_LDB(B0, 0, 0); G8_SCHED; G8_LDA(At, 0, 0); G8_STAGE_A(G8_SA(1, 1), a1, vA, 1);
            G8_WAIT_L(8); G8_BAR; G8_WAIT_L(0); G8_MMA(0, 0, At, B0); G8_BAR; G8_SCHED;
            G8_LDB(B1, 0, 1); G8_STAGE_B(G8_SB(0, 0), b2);
            G8_BAR; G8_WAIT_L(0); G8_MMA(0, 1, At, B1); G8_BAR;
            G8_LDA(At, 0, 1); G8_STAGE_A(G8_SA(0, 0), a2, v2, 0);
            G8_BAR; G8_WAIT_L(0); G8_MMA(1, 0, At, B0); G8_BAR; G8_SCHED;
            G8_STAGE_B(G8_SB(0, 1), b2 + hstepB);
            G8_WAIT_V(6); G8_BAR; G8_MMA(1, 1, At, B1); G8_BAR;
            G8_LDB(B0, 1, 0); G8_SCHED; G8_LDA(At, 1, 0); G8_STAGE_A(G8_SA(0, 1), a2, v2, 1);
            G8_WAIT_L(8); G8_BAR; G8_WAIT_L(0); G8_MMA(0, 0, At, B0); G8_BAR; G8_SCHED;
            G8_LDB(B1, 1, 1); G8_STAGE_B(G8_SB(1, 0), b3);
            G8_BAR; G8_WAIT_L(0); G8_MMA(0, 1, At, B1); G8_BAR;
            G8_LDA(At, 1, 1); G8_STAGE_A(G8_SA(1, 0), a3, v2, 0);
            G8_BAR; G8_WAIT_L(0); G8_MMA(1, 0, At, B0); G8_BAR; G8_SCHED;
            G8_STAGE_B(G8_SB(1, 1), b3 + hstepB);
            G8_WAIT_V(6); G8_BAR; G8_MMA(1, 1, At, B1); G8_BAR;
        }
        E(acc, cur, wr, wc, fr, fq, biasbuf + (ui & 1) * 256);
        if (!has_next) break;
        if (!E.keep(cur))
#pragma unroll
        for (int a = 0; a < 2; ++a)
#pragma unroll
            for (int b = 0; b < 2; ++b)
#pragma unroll
                for (int m = 0; m < 4; ++m)
#pragma unroll
                    for (int n = 0; n < 2; ++n) acc[a][b][m][n] = (f32x4){0.f, 0.f, 0.f, 0.f};
        cur = nxt; cA = nA; cB = nB; ++ui;
#pragma unroll
        for (int q = 0; q < 4; ++q) vA[q] = vlast[q];
    }
    G8_WAIT_V(0);
    if (wr == 0) G8_BAR;
    G8_BAR;
#undef G8_SA
#undef G8_SB
#undef G8_GL
#undef G8_STAGE_A
#undef G8_STAGE_B
#undef G8_LDA
#undef G8_LDB
#undef G8_MMA
#undef G8_WAIT_V
#undef G8_WAIT_L
#undef G8_BAR
#undef G8_SCHED
}

struct PlainSched {
    const bf16_t* A; const bf16_t* Bt; int K, nM, nN, nwg, G, c;
    __device__ __forceinline__ void init(const bf16_t* A_, const bf16_t* Bt_, int M, int N, int K_) { A = A_; Bt = Bt_; K = K_; nM = M / BM; nN = N / BM; nwg = nM * nN; G = gridDim.x; c = blockIdx.x; }
    __device__ __forceinline__ bool next(int i, Unit& u) const {
        const long L = (long)i * G + c; if (L >= nwg) return false;
        int wgid = (int)L; { const int q = nwg / 8, r = nwg % 8, xcd = wgid % 8, off = wgid / 8; wgid = (xcd < r ? xcd * (q + 1) : r * (q + 1) + (xcd - r) * q) + off; }
        const int nig = 8 * nN, gid = wgid / nig, fm = gid * 8, gsz = (nM - fm) < 8 ? (nM - fm) : 8;
        u.pm = fm + ((wgid % nig) % gsz); u.pn = (wgid % nig) / gsz; u.e = 0; return true;
    }
    __device__ __forceinline__ const char* a_base(const Unit& u) const { return (const char*)(A + (size_t)u.pm * BM * K); }
    __device__ __forceinline__ const char* b_base(const Unit& u) const { return (const char*)(Bt + (size_t)u.pn * BM * K); }
    static constexpr bool HAS_BIAS = false, gather = false;
    __device__ __forceinline__ const int* row_addr(const Unit&, int) const { return nullptr; }
    __device__ __forceinline__ int rows_valid(const Unit&) const { return 256; }
    __device__ __forceinline__ const float* bias_src(const Unit&, int) const { return nullptr; }
};
}

struct StageRC { int R0, C0, R1, C1; };
__device__ __forceinline__ StageRC my_stage_rc() { const int t = opaque_tid(); StageRC s; gm::stage_rc(t * 16, s.R0, s.C0); gm::stage_rc(t * 16 + 8192, s.R1, s.C1); return s; }

__device__ __forceinline__ int w1_dst_row(int n) { const int half = n >> 10, cc = n & 1023; return (cc >> 7) * 256 + half * 128 + (cc & 127); }

__device__ __forceinline__ void cvt_tile(LAS float* tile, const float* src, int ldsrc, int Nsrc, int k0, int n0, bf16_t* dst, int K, int mode) {
    const int tid = opaque_tid();
    {
        const int rr = tid >> 6, cc = tid & 63, n = n0 + cc;
#pragma unroll
        for (int i = 0; i < 8; ++i) { const int k = rr + i * 8; tile[k * 65 + cc] = (n < Nsrc) ? src[(size_t)(k0 + k) * ldsrc + n] : 0.f; }
    }
    __syncthreads();
    {
        const int nl = tid >> 3, kg = tid & 7, n = n0 + nl;
        float v[8];
#pragma unroll
        for (int j = 0; j < 8; ++j) v[j] = tile[(kg * 8 + j) * 65 + nl];
        const int drow = mode == 1 ? w1_dst_row(n) : n;
        u32x4 o; o[0] = pack2(v[0], v[1]); o[1] = pack2(v[2], v[3]); o[2] = pack2(v[4], v[5]); o[3] = pack2(v[6], v[7]);
        *(u32x4*)(dst + (size_t)drow * K + k0 + kg * 8) = o;
    }
    __syncthreads();
}

__device__ __forceinline__ void ph_convert(const Params& p, LAS unsigned char* lds) {
    LAS float* tile = (LAS float*)lds;
    for (int idx = blockIdx.x * NTHREADS + opaque_tid(); idx < 2 * 8 * 4 * 4096; idx += gridDim.x * NTHREADS) {
        const int i = idx & 63, j = (idx >> 6) & 63, mat = (idx >> 12) & 3, n = (idx >> 14) & 7, ll = idx >> 17, d = mat >> 1;
        p.lruT[idx] = (bf16_t)f2bf(((mat & 1) ? p.lru_wx : p.lru_wa)[(size_t)((ll * 2 + d) * 8 + n) * 4096 + i * 64 + j]);
    }
    constexpr int PER_L = 3008 + 512 + 256 + 16384 + 8192;
    for (int it = blockIdx.x; it < 2 * PER_L; it += gridDim.x) {
        const int l = it / PER_L; int r = it % PER_L;
        if (r < 3008) { const int nt = r % 188, kt = r / 188; cvt_tile(tile, p.w_in + (size_t)l * D * NIN, NIN, NIN, kt * 64, nt * 64, p.winT + (size_t)l * NP * D, D, 0); }
        else if (r < 3520) { r -= 3008; const int n = r / 128; r %= 128; const int nt = r % 16, kt = r / 16;
            cvt_tile(tile, p.w_branch + (size_t)(l * 4 + n) * MW * D, D, D, kt * 64, nt * 64, p.wbT + (size_t)(l * 4 + n) * D * MW, MW, 0); }
        else if (r < 3776) { r -= 3520; const int nt = r % 16, kt = r / 16; cvt_tile(tile, p.w_out + (size_t)l * D * D, D, D, kt * 64, nt * 64, p.woutT + (size_t)l * D * D, D, 0); }
        else if (r < 3776 + 16384) { r -= 3776; const int e = r / 512; r %= 512; const int nt = r % 32, kt = r / 32;
            cvt_tile(tile, p.moe_w1 + (size_t)(l * NE + e) * D * 2 * D, 2 * D, 2 * D, kt * 64, nt * 64, p.w1T + (size_t)(l * NE + e) * 2 * D * D, D, 1); }
        else { r -= 3776 + 16384; const int e = r / 256; r %= 256; const int nt = r % 16, kt = r / 16;
            cvt_tile(tile, p.moe_w2 + (size_t)(l * NE + e) * D * D, D, D, kt * 64, nt * 64, p.w2T + (size_t)(l * NE + e) * D * D, D, 0); }
    }
}

__device__ __forceinline__ void ph_mod(const Params& p, LAS unsigned char* lds) {
    LAS float* sc = (LAS float*)lds;
    LAS float* red = sc + 5 * D;
    const int tid = opaque_tid(), wid = tid >> 6, lane = tid & 63;
    if ((int)blockIdx.x >= 192) return;
    for (int i = tid; i < 5 * D; i += NTHREADS) { const int r = i >> 10, k = i & 1023; const float v = r < 4 ? p.c[r * D + k] : p.c_ctx[k]; sc[i] = siluf_(v); }
    __syncthreads();
    for (int it = blockIdx.x; it < 192; it += gridDim.x) {
        const int l = it / 96, n0 = (it % 96) * 64;
        float acc[5] = {0.f, 0.f, 0.f, 0.f, 0.f};
        const float* wp = p.w_mod + (size_t)l * D * (NMOD * D) + n0 + lane;
        for (int k = wid * 128; k < wid * 128 + 128; ++k) {
            const float wv = wp[(size_t)k * (NMOD * D)];
#pragma unroll
            for (int r = 0; r < 5; ++r) acc[r] += sc[r * D + k] * wv;
        }
#pragma unroll
        for (int r = 0; r < 5; ++r) red[(wid * 5 + r) * 64 + lane] = acc[r];
        __syncthreads();
        if (tid < 320) { const int r = tid >> 6, cidx = tid & 63; float s = p.b_mod[l * NMOD * D + n0 + cidx];
#pragma unroll
            for (int w = 0; w < 8; ++w) s += red[(w * 5 + r) * 64 + cidx];
            p.mod[(size_t)(l * 5 + r) * (NMOD * D) + n0 + cidx] = s; }
        __syncthreads();
    }
}

__device__ __forceinline__ void norm_mod_store(const float4 (&v)[4], float rinv, const float* g, const float* scp, const float* shp, bf16_t* dst, int lane) {
#pragma unroll
    for (int i = 0; i < 4; ++i) {
        const int cidx = i * 256 + lane * 4;
        const float4 gv = *(const float4*)(g + cidx), sv = *(const float4*)(scp + cidx), hv = *(const float4*)(shp + cidx);
        const float h0 = v[i].x * rinv * gv.x * (1.f + sv.x) + hv.x, h1 = v[i].y * rinv * gv.y * (1.f + sv.y) + hv.y;
        const float h2 = v[i].z * rinv * gv.z * (1.f + sv.z) + hv.z, h3 = v[i].w * rinv * gv.w * (1.f + sv.w) + hv.w;
        u32x2 o; o[0] = pack2(h0, h1); o[1] = pack2(h2, h3);
        *(u32x2*)(dst + cidx) = o;
    }
}
__device__ __forceinline__ void ph_norm1_first(const Params& p) {
    const int tid = opaque_tid(), wid = tid >> 6, lane = tid & 63;
    for (int tok = blockIdx.x * NWAVES + wid; tok < NTOK; tok += gridDim.x * NWAVES) {
        const float* src = tok < NLAT ? p.x + (size_t)tok * D : p.ctx + (size_t)(tok - NLAT) * D;
        float4 v[4]; float ss = 0.f;
#pragma unroll
        for (int i = 0; i < 4; ++i) { v[i] = *(const float4*)(src + i * 256 + lane * 4); ss += v[i].x * v[i].x + v[i].y * v[i].y + v[i].z * v[i].z + v[i].w * v[i].w; }
        ss = wave_sum(ss);
        const float rinv = rsqrtf(ss * (1.0f / D) + 1e-6f);
        const float* mb = p.mod + (size_t)(0 * 5 + tok_modrow(tok)) * (NMOD * D);
        norm_mod_store(v, rinv, p.norm1_g, mb + 1 * D, mb + 0 * D, p.H + (size_t)tok * D, lane);
#pragma unroll
        for (int i = 0; i < 4; ++i) *(float4*)(p.xl + (size_t)tok * D + i * 256 + lane * 4) = v[i];
    }
}

struct EpiP {
    bf16_t* O;
    __device__ __forceinline__ bool keep(const g8::Unit&) const { return false; }
    __device__ __forceinline__ void operator()(const f32x4 (&acc)[2][2][4][2], const g8::Unit& u, int wr, int wc, int fr, int fq, const LAS float*) const {
        const int row0 = u.pm * 256 + wr * 64 + fr, col0 = u.pn * 256 + wc * 32 + 8 * fq;
#pragma unroll
        for (int ai = 0; ai < 2; ++ai)
#pragma unroll
            for (int m = 0; m < 4; ++m) {
                bf16_t* rowp = O + (size_t)(row0 + ai * 128 + m * 16) * NP + col0;
#pragma unroll
                for (int bj = 0; bj < 2; ++bj) {
                    u32x4 w; w[0] = pack2(acc[ai][bj][m][0][0], acc[ai][bj][m][0][1]); w[1] = pack2(acc[ai][bj][m][0][2], acc[ai][bj][m][0][3]);
                    w[2] = pack2(acc[ai][bj][m][1][0], acc[ai][bj][m][1][1]); w[3] = pack2(acc[ai][bj][m][1][2], acc[ai][bj][m][1][3]);
                    *(u32x4*)(rowp + bj * 128) = w;
                }
            }
    }
};
__device__ __forceinline__ void ph_g1(const Params& p, int l, LAS unsigned char* lds) {
    g8::PlainSched S; S.init(p.H, p.winT + (size_t)l * NP * D, NTOK, NP, D);
    EpiP E; E.O = p.P;
    g8::gemm_phase(lds, D, S, E);
}

__device__ __forceinline__ void ph_prep(const Params& p, int l, LAS unsigned char* lds) {
    const int tid = opaque_tid(), wid = tid >> 6, lane = tid & 63, fr = lane & 15, fq = lane >> 4;
    LAS float* xs = (LAS float*)lds;
    LAS bf16_t* xb = (LAS bf16_t*)(xs + 64 * 68);
    LAS bf16_t* wt = xb + 64 * 72;
    for (int it = blockIdx.x; it < (NTOK / 64) * 8; it += gridDim.x) {
        const int tile = it >> 3, n = it & 7, tok0 = tile * 64;
        {
            const int tl = tid & 63, cg = tid >> 6, tok = tok0 + tl;
            int t, T, base; tok_info(tok, t, T, base);
            float a[8];
            { const float4 b0 = *(const float4*)(p.lru_conv_b + l * MW + n * 64 + cg * 8), b1 = *(const float4*)(p.lru_conv_b + l * MW + n * 64 + cg * 8 + 4);
              a[0] = b0.x; a[1] = b0.y; a[2] = b0.z; a[3] = b0.w; a[4] = b1.x; a[5] = b1.y; a[6] = b1.z; a[7] = b1.w; }
#pragma unroll
            for (int j = 0; j < 4; ++j) {
                const int tt = t + j - 2;
                const float okf = (tt >= 0 && tt < T) ? 1.0f : 0.0f;
                const int ttc = tt < 0 ? 0 : (tt >= T ? T - 1 : tt);
                const u32x4 u = *(const u32x4*)(p.P + (size_t)(base + ttc) * NP + C_LX + n * 64 + cg * 8);
                const float* w = p.lru_conv_w + (size_t)(l * 4 + j) * MW + n * 64 + cg * 8;
                const float4 wa = *(const float4*)w, wb = *(const float4*)(w + 4);
                const float wv[8] = {wa.x * okf, wa.y * okf, wa.z * okf, wa.w * okf, wb.x * okf, wb.y * okf, wb.z * okf, wb.w * okf};
#pragma unroll
                for (int q = 0; q < 4; ++q) { a[2 * q] += wv[2 * q] * bflo(u[q]); a[2 * q + 1] += wv[2 * q + 1] * bfhi(u[q]); }
            }
            *(LAS f32x4*)(xs + tl * 68 + cg * 8) = (f32x4){a[0], a[1], a[2], a[3]}; *(LAS f32x4*)(xs + tl * 68 + cg * 8 + 4) = (f32x4){a[4], a[5], a[6], a[7]};
            *(LAS u32x4*)(xb + tl * 72 + cg * 8) = pack8(a);
            const bf16_t* wsrc = p.lruT + (size_t)((l * 8 + n) * 4) * 4096;
#pragma unroll
            for (int q = 0; q < 4; ++q) { const int e8 = tid + 512 * q, row = e8 >> 3, c8 = e8 & 7; *(LAS u32x4*)(wt + row * 72 + c8 * 8) = *(const u32x4*)(wsrc + (size_t)e8 * 8); }
        }
        __syncthreads();
        {
            const int jb = wid & 3, tb0 = (wid >> 2) * 2;
            bf16x8 xw[4][2];
#pragma unroll
            for (int m = 0; m < 4; ++m)
#pragma unroll
                for (int ks = 0; ks < 2; ++ks) xw[m][ks] = *(const LAS bf16x8*)(wt + (m * 64 + jb * 16 + fr) * 72 + ks * 32 + fq * 8);
            const int c0 = n * 64 + jb * 16 + 4 * fq;
            float4 bav[2], bxv[2], lsv[2];
#pragma unroll
            for (int d = 0; d < 2; ++d) {
                bav[d] = *(const float4*)(p.lru_ba + (l * 2 + d) * MW + c0); bxv[d] = *(const float4*)(p.lru_bx + (l * 2 + d) * MW + c0);
                const float4 lm = *(const float4*)(p.lru_lambda + (l * 2 + d) * MW + c0);
                lsv[d] = make_float4(8.0f * logsigmoidf_(lm.x), 8.0f * logsigmoidf_(lm.y), 8.0f * logsigmoidf_(lm.z), 8.0f * logsigmoidf_(lm.w));
            }
#pragma unroll
            for (int e = 0; e < 2; ++e) {
                const int tl = (tb0 + e) * 16 + fr, tok = tok0 + tl;
                f32x4 acc[4];
#pragma unroll
                for (int m = 0; m < 4; ++m) acc[m] = (f32x4){0.f, 0.f, 0.f, 0.f};
#pragma unroll
                for (int ks = 0; ks < 2; ++ks) {
                    const bf16x8 y = *(const LAS bf16x8*)(xb + tl * 72 + ks * 32 + fq * 8);
#pragma unroll
                    for (int m = 0; m < 4; ++m) acc[m] = mfma16(xw[m][ks], y, acc[m]);
                }
                const f32x4 xv = *(const LAS f32x4*)(xs + tl * 68 + jb * 16 + 4 * fq);
#pragma unroll
                for (int d = 0; d < 2; ++d) {
                    const float bar_[4] = {bav[d].x, bav[d].y, bav[d].z, bav[d].w}, bxr[4] = {bxv[d].x, bxv[d].y, bxv[d].z, bxv[d].w}, lsr[4] = {lsv[d].x, lsv[d].y, lsv[d].z, lsv[d].w};
                    float av[4], uv[4];
#pragma unroll
                    for (int r = 0; r < 4; ++r) {
                        const float gr = sigmoidf_(acc[d * 2][r] + bar_[r]), gi = sigmoidf_(acc[d * 2 + 1][r] + bxr[r]);
                        const float la = gr * lsr[r];
                        av[r] = __expf(la);
                        uv[r] = xv[r] * gi * sqrtf(fmaxf(-expm1f(2.0f * la), 1e-12f));
                    }
                    *(float4*)(p.prep + (PR_LA + d) * TOKW + (size_t)tok * MW + c0) = make_float4(av[0], av[1], av[2], av[3]);
                    *(float4*)(p.prep + (PR_LU + d) * TOKW + (size_t)tok * MW + c0) = make_float4(uv[0], uv[1], uv[2], uv[3]);
                }
            }
        }
        __syncthreads();
    }
}

__device__ __forceinline__ int chunk_base(int b, int d, int n) {
    if (n < 4) { const int blk = d ? 3 - n : n; return NLAT + b * TC + blk * 64; }
    const int m = n - 4, blk = d ? 63 - m : m; return b * TL + blk * 64;
}

__device__ __forceinline__ void local_gla(const Params& p, int l, int tz, int chain, int n, LAS unsigned char* lds) {
    const int tid = opaque_tid(), wid = tid >> 6, lane = tid & 63, fr = lane & 15, fq = lane >> 4;
    const int b = chain >> 3, h = (chain >> 1) & 3, d = chain & 1;
    const int base = chunk_base(b, d, n);
    const size_t item = (size_t)tz * NITEM + (size_t)chain * NCHUNK + n;
    LAS bf16_t* kraw = (LAS bf16_t*)lds;
    LAS bf16_t* qh = kraw + 64 * 136;
    LAS bf16_t* kh = qh + 64 * 136;
    LAS bf16_t* sc = kh + 64 * 136;
    LAS bf16_t* vT = sc + 64 * 72;
    LAS bf16_t* kT = vT + 128 * 72;
    LAS float* bc = (LAS float*)(kT + 128 * 72);
    const int vcol = tz == 1 ? C_HI : C_RQKV + 1024;
    const int ti = tid >> 3, dg = tid & 7, cA = dg * 8, cB = 64 + dg * 8;
    const int tokI = base + (d ? 63 - ti : ti);
    const bf16_t* pr = p.P + (size_t)tokI * NP;
    float qt[16];
    {
        float kv[16], lfv[16];
        if (tz == 1) {
            float lbv[16];
            {
                const float* lp0 = p.hgrn_lb + (size_t)(0 * 2 + d) * MW + h * 128; const float* lp1 = p.hgrn_lb + (size_t)(1 * 2 + d) * MW + h * 128;
                const float4 a0 = *(const float4*)(lp0 + cA), a1 = *(const float4*)(lp0 + cA + 4), a2 = *(const float4*)(lp0 + cB), a3 = *(const float4*)(lp0 + cB + 4);
                const float4 b0 = *(const float4*)(lp1 + cA), b1 = *(const float4*)(lp1 + cA + 4), b2 = *(const float4*)(lp1 + cB), b3 = *(const float4*)(lp1 + cB + 4);
                const float x0[16] = {a0.x, a0.y, a0.z, a0.w, a1.x, a1.y, a1.z, a1.w, a2.x, a2.y, a2.z, a2.w, a3.x, a3.y, a3.z, a3.w};
                const float x1[16] = {b0.x, b0.y, b0.z, b0.w, b1.x, b1.y, b1.z, b1.w, b2.x, b2.y, b2.z, b2.w, b3.x, b3.y, b3.z, b3.w};
#pragma unroll
                for (int e = 0; e < 16; ++e) lbv[e] = (l == 1) ? fminf(__builtin_amdgcn_rcpf(1.0f + __expf(x0[e] - x1[e])), 1.0f - 1e-4f) : 0.f;
            }
            const u32x4 uqa = *(const u32x4*)(pr + C_HQ + h * 128 + cA), uqb = *(const u32x4*)(pr + C_HQ + h * 128 + cB);
            const u32x4 uza = *(const u32x4*)(pr + C_HF + d * 512 + h * 128 + cA), uzb = *(const u32x4*)(pr + C_HF + d * 512 + h * 128 + cB);
#pragma unroll
            for (int e = 0; e < 16; ++e) {
                const unsigned uq = e < 8 ? uqa[(e & 7) >> 1] : uqb[(e & 7) >> 1], uz = e < 8 ? uza[(e & 7) >> 1] : uzb[(e & 7) >> 1];
                const float qraw = (e & 1) ? bfhi(uq) : bflo(uq), z = (e & 1) ? bfhi(uz) : bflo(uz);
                const float lb = lbv[e];
                const float sg = sigmoidf_(z);
                qt[e] = siluf_(qraw) * 0.08838834764831845f;
                kv[e] = (1.f - lb) * (1.f - sg);
                lfv[e] = __logf(fmaxf(lb + (1.f - lb) * sg, 1e-30f));
            }
        } else {
            const bf16_t* rp = pr + C_RQKV + h * 128;
            const u32x4 q1 = *(const u32x4*)(rp + cA), q2 = *(const u32x4*)(rp + cB), k1 = *(const u32x4*)(rp + 512 + cA), k2 = *(const u32x4*)(rp + 512 + cB);
            const float lng = log1pf(-exp2f(-5.0f - (float)h));
            const bool lat = tokI < NLAT;
            const int t = tokI & (TL - 1);
#pragma unroll
            for (int e = 0; e < 8; ++e) {
                float a1 = (e & 1) ? bfhi(q1[e >> 1]) : bflo(q1[e >> 1]), a2 = (e & 1) ? bfhi(q2[e >> 1]) : bflo(q2[e >> 1]);
                float b1 = (e & 1) ? bfhi(k1[e >> 1]) : bflo(k1[e >> 1]), b2 = (e & 1) ? bfhi(k2[e >> 1]) : bflo(k2[e >> 1]);
                if (lat) {
                    const int pi = cA + e;
                    const float pos = (pi < 32) ? (float)(t >> 6) : (float)(t & 63);
                    const float ang = pos * exp2f(-(float)(pi & 31) * (13.287712379549449f / 32.0f));
                    float sn, cs; sincosf(ang, &sn, &cs);
                    const float n1 = a1 * cs - a2 * sn, n2 = a1 * sn + a2 * cs, m1 = b1 * cs - b2 * sn, m2 = b1 * sn + b2 * cs;
                    a1 = n1; a2 = n2; b1 = m1; b2 = m2;
                }
                qt[e] = a1; qt[8 + e] = a2; kv[e] = b1 * 0.08838834764831845f; kv[8 + e] = b2 * 0.08838834764831845f;
                lfv[e] = lng; lfv[8 + e] = lng;
            }
        }
        *(LAS u32x4*)(kraw + ti * 136 + cA) = pack8(kv); *(LAS u32x4*)(kraw + ti * 136 + cB) = pack8(kv + 8);
        *(LAS f32x4*)(bc + ti * 132 + cA) = (f32x4){lfv[0], lfv[1], lfv[2], lfv[3]}; *(LAS f32x4*)(bc + ti * 132 + cA + 4) = (f32x4){lfv[4], lfv[5], lfv[6], lfv[7]};
        *(LAS f32x4*)(bc + ti * 132 + cB) = (f32x4){lfv[8], lfv[9], lfv[10], lfv[11]}; *(LAS f32x4*)(bc + ti * 132 + cB + 4) = (f32x4){lfv[12], lfv[13], lfv[14], lfv[15]};
        const bf16_t* vp = pr + vcol + h * 128;
        const u32x4 v0 = *(const u32x4*)(vp + cA), v1 = *(const u32x4*)(vp + cB);
#pragma unroll
        for (int e = 0; e < 8; ++e) {
            vT[(cA + e) * 72 + ti] = (bf16_t)((e & 1) ? (v0[e >> 1] >> 16) : (v0[e >> 1] & 0xffffu));
            vT[(cB + e) * 72 + ti] = (bf16_t)((e & 1) ? (v1[e >> 1] >> 16) : (v1[e >> 1] & 0xffffu));
        }
    }
    __syncthreads();
    if (tid < 128) {
        float run = 0.f, lv[64];
#pragma unroll
        for (int i = 0; i < 64; ++i) lv[i] = bc[i * 132 + tid];
#pragma unroll
        for (int i = 0; i < 64; ++i) { run += lv[i]; bc[i * 132 + tid] = run; }
    }
    __syncthreads();
    {
        const int I = ti >> 4;
        float qhat[16];
#pragma unroll
        for (int e = 0; e < 16; ++e) {
            const int ch = e < 8 ? cA + e : cB + e - 8;
            const float bi = bc[ti * 132 + ch], rI = I ? bc[(16 * I - 1) * 132 + ch] : 0.f, bl = bc[63 * 132 + ch];
            qhat[e] = qt[e] * __expf(bi - rI); qt[e] = qt[e] * __expf(bi);
            kT[ch * 72 + ti] = (bf16_t)f2bf(bf2f(kraw[ti * 136 + ch]) * __expf(bl - bi));
        }
        *(LAS u32x4*)(qh + ti * 136 + cA) = pack8(qhat); *(LAS u32x4*)(qh + ti * 136 + cB) = pack8(qhat + 8);
        {
            bf16_t* lqb = p.lq + item * 8192 + (size_t)((ti >> 4) * 8) * 256 + (ti & 15) * 4;
            const u32x4 pa = pack8(qt), pb = pack8(qt + 8);
            u32x2 t0; t0[0] = pa[0]; t0[1] = pa[1]; u32x2 t1; t1[0] = pa[2]; t1[1] = pa[3]; u32x2 t2; t2[0] = pb[0]; t2[1] = pb[1]; u32x2 t3; t3[0] = pb[2]; t3[1] = pb[3];
            *(u32x2*)(lqb + (dg >> 1) * 256 + ((dg & 1) * 2 + 0) * 64) = t0; *(u32x2*)(lqb + (dg >> 1) * 256 + ((dg & 1) * 2 + 1) * 64) = t1;
            *(u32x2*)(lqb + (4 + (dg >> 1)) * 256 + ((dg & 1) * 2 + 0) * 64) = t2; *(u32x2*)(lqb + (4 + (dg >> 1)) * 256 + ((dg & 1) * 2 + 1) * 64) = t3;
        }
    }
    if (tid < 128) p.ld[item * 128 + tid] = __expf(bc[63 * 132 + tid]);
    for (int I = 0; I < 4; ++I) {
        if (ti < 16 * (I + 1)) {
            float kk[16];
#pragma unroll
            for (int e = 0; e < 16; ++e) {
                const int ch = e < 8 ? cA + e : cB + e - 8;
                const float rI = I ? bc[(16 * I - 1) * 132 + ch] : 0.f, bj = bc[ti * 132 + ch];
                kk[e] = bf2f(kraw[ti * 136 + ch]) * __expf(fminf(rI - bj, 80.f));
            }
            *(LAS u32x4*)(kh + ti * 136 + cA) = pack8(kk); *(LAS u32x4*)(kh + ti * 136 + cB) = pack8(kk + 8);
        }
        __syncthreads();
        if (wid < 4) {
            const int J = wid;
            u32x2 outv; outv[0] = 0u; outv[1] = 0u;
            if (J <= I) {
                f32x4 acc = (f32x4){0.f, 0.f, 0.f, 0.f};
#pragma unroll
                for (int ks = 0; ks < 4; ++ks)
                    acc = mfma16(*(const LAS bf16x8*)(kh + (J * 16 + fr) * 136 + ks * 32 + fq * 8), *(const LAS bf16x8*)(qh + (I * 16 + fr) * 136 + ks * 32 + fq * 8), acc);
                const int i = 16 * I + fr, j0 = 16 * J + 4 * fq;
#pragma unroll
                for (int r = 0; r < 4; ++r) if (j0 + r > i) acc[r] = 0.f;
                outv = pack4(acc);
            }
            *(LAS u32x2*)(sc + (I * 16 + fr) * 72 + J * 16 + 4 * fq) = outv;
        }
        __syncthreads();
    }
    {
        bf16x8 xv[2], xk[2];
#pragma unroll
        for (int ks = 0; ks < 2; ++ks) { xv[ks] = *(const LAS bf16x8*)(vT + (wid * 16 + fr) * 72 + ks * 32 + fq * 8); xk[ks] = *(const LAS bf16x8*)(kT + (wid * 16 + fr) * 72 + ks * 32 + fq * 8); }
#pragma unroll
        for (int ib = 0; ib < 4; ++ib) {
            f32x4 acc = (f32x4){0.f, 0.f, 0.f, 0.f};
#pragma unroll
            for (int ks = 0; ks < 2; ++ks) acc = mfma16(xv[ks], *(const LAS bf16x8*)(sc + (ib * 16 + fr) * 72 + ks * 32 + fq * 8), acc);
            *(u32x2*)(p.lo + item * 8192 + ((wid * 4 + ib) * 64 + lane) * 4) = pack4(acc);
        }
#pragma unroll
        for (int dvb = 0; dvb < 8; ++dvb) {
            f32x4 acc = (f32x4){0.f, 0.f, 0.f, 0.f};
#pragma unroll
            for (int ks = 0; ks < 2; ++ks) acc = mfma16(xk[ks], *(const LAS bf16x8*)(vT + (dvb * 16 + fr) * 72 + ks * 32 + fq * 8), acc);
            *(u32x2*)(p.lb + item * 16384 + ((wid * 8 + dvb) * 64 + lane) * 4) = pack4(acc);
        }
    }
    __syncthreads();
}


template <int I> struct SolveRows {
    static __device__ __forceinline__ void run(float (&x)[64], const LAS float* Mf, const LAS float* rs) {
        SolveRows<I - 1>::run(x, Mf, rs);
        float r = x[I] * rs[I];
#pragma unroll
        for (int j4 = 0; j4 < (I + 3) / 4; ++j4) {
            const f32x4 m = *(const LAS f32x4*)(Mf + I * 68 + j4 * 4);
            r -= m[0] * x[j4 * 4] + m[1] * x[j4 * 4 + 1] + m[2] * x[j4 * 4 + 2] + m[3] * x[j4 * 4 + 3];
        }
        asm volatile("" : "+v"(r) :: "memory");
        x[I] = r;
    }
};
template <> struct SolveRows<-1> { static __device__ __forceinline__ void run(float (&)[64], const LAS float*, const LAS float*) {} };

__device__ __forceinline__ void local_gdn(const Params& p, int l, int chain, int n, LAS unsigned char* lds) {
    const int tid = opaque_tid(), wid = tid >> 6, lane = tid & 63, fr = lane & 15, fq = lane >> 4;
    const int b = chain >> 3, h = (chain >> 1) & 3, d = chain & 1;
    const int base = chunk_base(b, d, n);
    const size_t item = (size_t)chain * NCHUNK + n;
    LAS bf16_t* ks_ = (LAS bf16_t*)lds;
    LAS bf16_t* qs = ks_ + 64 * 136;
    LAS bf16_t* att = qs + 64 * 136;
    LAS bf16_t* wT = att + 64 * 72;
    LAS bf16_t* uT = wT + 128 * 72;
    LAS bf16_t* kT = uT + 128 * 72;
    LAS float* Mf = (LAS float*)(kT + 128 * 72);
    LAS float* bcs = Mf + 64 * 68;
    LAS float* bts = bcs + 64;
    LAS float* rse = bts + 64;
    LAS bf16_t* vs = (LAS bf16_t*)(rse + 64);
    const int ti = tid >> 3, d0 = (tid & 7) * 16;
    const int tokI = base + (d ? 63 - ti : ti);
    {
        int t, T, sbase; tok_info(tokI, t, T, sbase);
#pragma unroll
        for (int part = 0; part < 3; ++part) {
            float a[16];
#pragma unroll
            for (int e = 0; e < 16; ++e) a[e] = 0.f;
            const int ccol = part * 512 + h * 128 + d0;
#pragma unroll
            for (int j = 0; j < 4; ++j) {
                const int tt = t + j - 2;
                const float okf = (tt >= 0 && tt < T) ? 1.0f : 0.0f;
                const int ttc = tt < 0 ? 0 : (tt >= T ? T - 1 : tt);
                const bf16_t* xp = p.P + (size_t)(sbase + ttc) * NP + C_GQKV + ccol;
                const u32x4 x0 = *(const u32x4*)xp, x1 = *(const u32x4*)(xp + 8);
                const float* wp = p.gdn_conv_w + (size_t)(l * 4 + j) * 1536 + ccol;
#pragma unroll
                for (int q = 0; q < 4; ++q) {
                    float4 w0 = *(const float4*)(wp + q * 4);
                    w0.x *= okf; w0.y *= okf; w0.z *= okf; w0.w *= okf;
                    const unsigned ua = q < 2 ? x0[2 * q] : x1[2 * q - 4], ub = q < 2 ? x0[2 * q + 1] : x1[2 * q - 3];
                    a[q * 4] += w0.x * bflo(ua); a[q * 4 + 1] += w0.y * bfhi(ua); a[q * 4 + 2] += w0.z * bflo(ub); a[q * 4 + 3] += w0.w * bfhi(ub);
                }
            }
            float ss = 0.f;
#pragma unroll
            for (int e = 0; e < 16; ++e) { a[e] = siluf_(a[e]); ss += a[e] * a[e]; }
            if (part < 2) {
                ss += __shfl_xor(ss, 1); ss += __shfl_xor(ss, 2); ss += __shfl_xor(ss, 4);
                const float scl = rsqrtf(ss + 1e-6f) * (part == 0 ? 0.08838834764831845f : 1.0f);
#pragma unroll
                for (int e = 0; e < 16; ++e) a[e] *= scl;
            }
            LAS bf16_t* dstt = (part == 0 ? qs : part == 1 ? ks_ : vs) + ti * 136 + d0;
            *(LAS u32x4*)dstt = pack8(a); *(LAS u32x4*)(dstt + 8) = pack8(a + 8);
        }
    }
    if (wid == 0) {
        const int tok = base + (d ? 63 - lane : lane);
        const float av = bf2f(p.P[(size_t)tok * NP + C_GA + d * 4 + h]);
        float v = -__expf(p.gdn_a_log[l * 8 + d * 4 + h]) * softplusf_(av + p.gdn_dt_bias[l * 8 + d * 4 + h]);
#pragma unroll
        for (int off = 1; off < 64; off <<= 1) { const float t = __shfl_up(v, off); if (lane >= off) v += t; }
        const float btv = sigmoidf_(bf2f(p.P[(size_t)tok * NP + C_GB + d * 4 + h]));
        bcs[lane] = v; bts[lane] = btv; rse[lane] = btv * __expf(v);
    }
    __syncthreads();
#pragma unroll
    for (int e = 0; e < 2; ++e) {
        const int f = wid * 2 + e, ib = f >> 2, jb = f & 3;
        const int i = 16 * ib + fr, j0 = 16 * jb + 4 * fq;
        f32x4 mk = (f32x4){0.f, 0.f, 0.f, 0.f}, mq = (f32x4){0.f, 0.f, 0.f, 0.f};
        if (jb <= ib) {
#pragma unroll
            for (int ks = 0; ks < 4; ++ks) {
                const bf16x8 xk = *(const LAS bf16x8*)(ks_ + (jb * 16 + fr) * 136 + ks * 32 + fq * 8);
                mk = mfma16(xk, *(const LAS bf16x8*)(ks_ + (ib * 16 + fr) * 136 + ks * 32 + fq * 8), mk);
                mq = mfma16(xk, *(const LAS bf16x8*)(qs + (ib * 16 + fr) * 136 + ks * 32 + fq * 8), mq);
            }
            const float bi = bcs[i], bti = bts[i];
#pragma unroll
            for (int r = 0; r < 4; ++r) {
                const int j = j0 + r;
                const float dec = __expf(j <= i ? bi - bcs[j] : 0.f);
                mk[r] = (j < i) ? bti * mk[r] * dec : 0.f;
                mq[r] = (j <= i) ? mq[r] * dec : 0.f;
            }
        }
        *(LAS f32x4*)(Mf + i * 68 + j0) = mk;
        *(LAS u32x2*)(att + i * 72 + j0) = pack4(mq);
    }
    __syncthreads();
    {
        const float sc_ = __expf(bcs[63] - bcs[ti]);
#pragma unroll
        for (int e = 0; e < 16; ++e) kT[(d0 + e) * 72 + ti] = (bf16_t)f2bf(bf2f(ks_[ti * 136 + d0 + e]) * sc_);
    }
    if (tid < 256) {
        const int cidx = tid & 127;
        const bool isw = tid >= 128;
        const LAS bf16_t* srcp = (isw ? ks_ : vs) + cidx;
        float x[64];
#pragma unroll
        for (int i = 0; i < 64; ++i) x[i] = bf2f(srcp[i * 136]);
        {
            unsigned mb = (unsigned)(size_t)Mf, rb = (unsigned)(size_t)(isw ? rse : bts);
            asm volatile("" : "+v"(mb), "+v"(rb));
            SolveRows<63>::run(x, (const LAS float*)(size_t)mb, (const LAS float*)(size_t)rb);
        }
        if (isw) {
#pragma unroll
            for (int i = 0; i < 64; ++i) x[i] = -x[i];
        }
        LAS bf16_t* dst = (isw ? wT : uT) + cidx * 72;
#pragma unroll
        for (int q = 0; q < 8; ++q) *(LAS u32x4*)(dst + q * 8) = pack8(x + q * 8);
    }
    if (tid < 128) p.ld[item * 128 + tid] = __expf(bcs[63]);
    __syncthreads();
    {
        const int tid = opaque_tid(), wid = tid >> 6, lane = tid & 63, fr = lane & 15, fq = lane >> 4;
        bf16x8 xw[2], xu[2], xk[2];
#pragma unroll
        for (int ks = 0; ks < 2; ++ks) {
            xw[ks] = *(const LAS bf16x8*)(wT + (wid * 16 + fr) * 72 + ks * 32 + fq * 8);
            xu[ks] = *(const LAS bf16x8*)(uT + (wid * 16 + fr) * 72 + ks * 32 + fq * 8);
            xk[ks] = *(const LAS bf16x8*)(kT + (wid * 16 + fr) * 72 + ks * 32 + fq * 8);
        }
#pragma unroll
        for (int ib = 0; ib < 4; ++ib) {
            const int i = ib * 16 + fr;
            const u32x2 qr = *(const LAS u32x2*)(qs + i * 136 + wid * 16 + 4 * fq);
            const float eb = __expf(bcs[i]);
            f32x4 aq = (f32x4){bflo(qr[0]) * eb, bfhi(qr[0]) * eb, bflo(qr[1]) * eb, bfhi(qr[1]) * eb};
            f32x4 ao = (f32x4){0.f, 0.f, 0.f, 0.f};
#pragma unroll
            for (int ks = 0; ks < 2; ++ks) {
                const bf16x8 ya = *(const LAS bf16x8*)(att + i * 72 + ks * 32 + fq * 8);
                aq = mfma16(xw[ks], ya, aq); ao = mfma16(xu[ks], ya, ao);
            }
            *(u32x2*)(p.lq + item * 8192 + ((ib * 8 + wid) * 64 + lane) * 4) = pack4(aq);
            *(u32x2*)(p.lo + item * 8192 + ((wid * 4 + ib) * 64 + lane) * 4) = pack4(ao);
        }
#pragma unroll
        for (int db = 0; db < 8; ++db) {
            f32x4 aa = (f32x4){0.f, 0.f, 0.f, 0.f}, ab = (f32x4){0.f, 0.f, 0.f, 0.f};
#pragma unroll
            for (int ks = 0; ks < 2; ++ks) {
                aa = mfma16(xw[ks], *(const LAS bf16x8*)(kT + (db * 16 + fr) * 72 + ks * 32 + fq * 8), aa);
                ab = mfma16(xk[ks], *(const LAS bf16x8*)(uT + (db * 16 + fr) * 72 + ks * 32 + fq * 8), ab);
            }
            *(u32x2*)(p.la + item * 16384 + ((db * 8 + wid) * 64 + lane) * 4) = pack4(aa);
            *(u32x2*)(p.lb + item * 16384 + ((wid * 8 + db) * 64 + lane) * 4) = pack4(ab);
        }
    }
    __syncthreads();
}

__device__ __forceinline__ void ph_local(const Params& p, int l, LAS unsigned char* lds) {
    for (int it = blockIdx.x; it < 3 * NITEM; it += gridDim.x) {
        const int tz = it % 3, ci = it / 3, chain = ci / NCHUNK, n = ci % NCHUNK;
        if (tz == 0) local_gdn(p, l, chain, n, lds); else local_gla(p, l, tz, chain, n, lds);
    }
}

__device__ __forceinline__ void seq_matrix(const Params& p, int tz, int chain, int half, LAS unsigned char* lds) {
    const int tid = opaque_tid(), wid = tid >> 6, lane = tid & 63, fr = lane & 15, fq = lane >> 4;
    const int b = chain >> 3, h = (chain >> 1) & 3, d = chain & 1;
    LAS bf16_t* ST = (LAS bf16_t*)lds;
    float* Op = p.O + (size_t)((tz == 0 ? 0 : tz == 1 ? 1 : 3) * 2 + d) * TOKW;
    f32x4 S[4];
#pragma unroll
    for (int q = 0; q < 4; ++q) S[q] = (f32x4){0.f, 0.f, 0.f, 0.f};
    const int ib = wid >> 1, dv2 = (wid & 1) * 2;
    struct Ops { u32x2 yq[8], xa[8], oin[2], bin[4]; f32x4 dec; };
    auto load_ops = [&](int n, Ops& o) {
        const size_t item = (size_t)tz * NITEM + (size_t)chain * NCHUNK + n;
        const bf16_t* lqp = p.lq + item * 8192 + (size_t)(ib * 8) * 256 + lane * 4;
#pragma unroll
        for (int q = 0; q < 8; ++q) o.yq[q] = *(const u32x2*)(lqp + q * 256);
        if (tz == 0) {
            const bf16_t* lap = p.la + ((size_t)chain * NCHUNK + n) * 16384 + (size_t)(wid * 8) * 256 + lane * 4;
#pragma unroll
            for (int q = 0; q < 8; ++q) o.xa[q] = *(const u32x2*)(lap + q * 256);
        }
#pragma unroll
        for (int e2 = 0; e2 < 2; ++e2)
            o.oin[e2] = *(const u32x2*)(p.lo + item * 8192 + (((half * 4 + dv2 + (fq >> 1)) * 4 + ib) * 64 + fr + 16 * (2 * (fq & 1) + e2)) * 4);
#pragma unroll
        for (int q = 0; q < 4; ++q) o.bin[q] = *(const u32x2*)(p.lb + item * 16384 + ((wid * 8 + half * 4 + q) * 64 + lane) * 4);
        o.dec = *(const f32x4*)(p.ld + item * 128 + wid * 16 + 4 * fq);
    };
    Ops s0, s1, s2; load_ops(0, s0); load_ops(1, s1);
    auto step = [&](int n, Ops& cur, Ops& fill) {
        load_ops(n + 2 < NCHUNK ? n + 2 : n, fill);
        LAS bf16_t* st = ST + (n & 1) * 64 * 136;
#pragma unroll
        for (int q = 0; q < 4; ++q) *(LAS u32x2*)(st + (q * 16 + fr) * 136 + 32 * (wid >> 1) + 8 * fq + 4 * (wid & 1)) = pack4(S[q]);
        __syncthreads();
        const int base = chunk_base(b, d, n);
        const int tok = base + (d ? 63 - (ib * 16 + fr) : ib * 16 + fr);
        {
            f32x4 ao[2];
#pragma unroll
            for (int e2 = 0; e2 < 2; ++e2) {
                f32x4 acc = (f32x4){bflo(cur.oin[e2][0]), bfhi(cur.oin[e2][0]), bflo(cur.oin[e2][1]), bfhi(cur.oin[e2][1])};
                const int prow = dv2 * 16 + 8 * (fr >> 2) + 4 * e2 + (fr & 3);
#pragma unroll
                for (int ks = 0; ks < 4; ++ks) {
                    u32x4 t; t[0] = cur.yq[2 * ks][0]; t[1] = cur.yq[2 * ks][1]; t[2] = cur.yq[2 * ks + 1][0]; t[3] = cur.yq[2 * ks + 1][1];
                    acc = mfma16(*(const LAS bf16x8*)(st + prow * 136 + ks * 32 + fq * 8), __builtin_bit_cast(bf16x8, t), acc);
                }
                ao[e2] = acc;
            }
            float* op = Op + (size_t)tok * MW + h * 128 + half * 64 + dv2 * 16 + 8 * fq;
            *(f32x4*)op = ao[0]; *(f32x4*)(op + 4) = ao[1];
        }
#pragma unroll
        for (int q = 0; q < 4; ++q) {
            f32x4 acc = (f32x4){cur.dec[0] * S[q][0] + bflo(cur.bin[q][0]), cur.dec[1] * S[q][1] + bfhi(cur.bin[q][0]), cur.dec[2] * S[q][2] + bflo(cur.bin[q][1]), cur.dec[3] * S[q][3] + bfhi(cur.bin[q][1])};
            if (tz == 0) {
#pragma unroll
                for (int ks = 0; ks < 4; ++ks) {
                    u32x4 t; t[0] = cur.xa[2 * ks][0]; t[1] = cur.xa[2 * ks][1]; t[2] = cur.xa[2 * ks + 1][0]; t[3] = cur.xa[2 * ks + 1][1];
                    acc = mfma16(__builtin_bit_cast(bf16x8, t), *(const LAS bf16x8*)(st + (q * 16 + fr) * 136 + ks * 32 + fq * 8), acc);
                }
            }
            S[q] = acc;
        }
    };
    for (int n = 0; n < NCHUNK; n += 3) {
        step(n, s0, s2);
        if (n + 1 < NCHUNK) step(n + 1, s1, s0);
        if (n + 2 < NCHUNK) step(n + 2, s2, s1);
    }
    __syncthreads();
}

__device__ __forceinline__ void seq_lru(const Params& p, int b, int d, int cg, LAS unsigned char* lds) {
    const int tid = opaque_tid(), seg = tid >> 6, ch = cg * 64 + (tid & 63);
    LAS float* sP = (LAS float*)lds;
    LAS float* sL = sP + 512;
    const float* A = p.prep + (size_t)(PR_LA + d) * TOKW + ch; const float* U = p.prep + (size_t)(PR_LU + d) * TOKW + ch;
    float* Op = p.O + (size_t)(2 * 2 + d) * TOKW + ch;
    constexpr int SEG = (TC + TL) / 8;
    auto tok_of = [&](int pos) { return pos < TC ? NLAT + b * TC + (d ? TC - 1 - pos : pos) : b * TL + (d ? TL - 1 - (pos - TC) : pos - TC); };
    float P = 1.f, L = 0.f;
    for (int i0 = 0; i0 < SEG; i0 += 32) {
        float av[32], uv[32];
#pragma unroll
        for (int q = 0; q < 32; ++q) { const size_t o = (size_t)tok_of(seg * SEG + i0 + q) * MW; av[q] = A[o]; uv[q] = U[o]; }
#pragma unroll
        for (int q = 0; q < 32; ++q) { L = av[q] * L + uv[q]; P *= av[q]; }
    }
    sP[tid] = P; sL[tid] = L;
    __syncthreads();
    float hst = 0.f;
    for (int s = 0; s < seg; ++s) hst = sP[s * 64 + (tid & 63)] * hst + sL[s * 64 + (tid & 63)];
    for (int i0 = 0; i0 < SEG; i0 += 32) {
        float av[32], uv[32];
#pragma unroll
        for (int q = 0; q < 32; ++q) { const size_t o = (size_t)tok_of(seg * SEG + i0 + q) * MW; av[q] = A[o]; uv[q] = U[o]; }
#pragma unroll
        for (int q = 0; q < 32; ++q) { hst = av[q] * hst + uv[q]; Op[(size_t)tok_of(seg * SEG + i0 + q) * MW] = hst; }
    }
    __syncthreads();
}

__device__ __forceinline__ void ph_seq(const Params& p, LAS unsigned char* lds) {
    for (int it = blockIdx.x; it < 256; it += gridDim.x) {
        if (it < 192) { const int tz = it >> 6, r = it & 63; seq_matrix(p, tz, r >> 1, r & 1, lds); }
        else { const int r = it - 192; seq_lru(p, r >> 4, (r >> 3) & 1, r & 7, lds); }
    }
}

__device__ __forceinline__ void ph_merge(const Params& p, int l, int M) {
    const int tid = opaque_tid(), wid = tid >> 6, lane = tid & 63;
    const float* Ob = opaque_sptr(p.O); const bf16_t* Pb = opaque_sptr(p.P); bf16_t* Yb = opaque_sptr(p.Y);
    float2 gn[3];
#pragma unroll
    for (int m = 0; m < 3; ++m) gn[m] = *(const float2*)((m == 0 ? p.gdn_norm_g : m == 1 ? p.hgrn_norm_g : p.ret_norm_g) + l * 128 + lane * 2);
    for (int tok = blockIdx.x * NWAVES + wid; tok < M; tok += gridDim.x * NWAVES) {
        f32x2 o0[16], o1[16]; unsigned gz[16];
#pragma unroll
        for (int r = 0; r < 16; ++r) {
            const int m = r >> 2, head = r & 3, cidx = head * 128 + lane * 2;
            const size_t o = (size_t)tok * MW + cidx;
            o0[r] = *(const f32x2*)(Ob + (size_t)(m * 2) * TOKW + o); o1[r] = *(const f32x2*)(Ob + (size_t)(m * 2 + 1) * TOKW + o);
            const int zc = m == 0 ? C_GZ : m == 1 ? C_HG : m == 2 ? C_LY : C_RG;
            gz[r] = *(const unsigned*)(Pb + (size_t)tok * NP + zc + cidx);
        }
        float a0[16], a1[16], ss[16];
#pragma unroll
        for (int r = 0; r < 16; ++r) { a0[r] = o0[r][0] + o1[r][0]; a1[r] = o0[r][1] + o1[r][1]; ss[r] = a0[r] * a0[r] + a1[r] * a1[r]; }
#pragma unroll
        for (int msk = 32; msk >= 1; msk >>= 1)
#pragma unroll
            for (int r = 0; r < 16; ++r) if ((r >> 2) != 2) ss[r] += __shfl_xor(ss[r], msk);
#pragma unroll
        for (int r = 0; r < 16; ++r) {
            const int m = r >> 2, head = r & 3, cidx = head * 128 + lane * 2;
            float y0, y1; int nbr;
            if (m == 2) { y0 = a0[r] * gelu_tanhf_(bflo(gz[r])); y1 = a1[r] * gelu_tanhf_(bfhi(gz[r])); nbr = 2; }
            else {
                const float rinv = rsqrtf(ss[r] * (1.0f / 128.0f) + 1e-6f);
                const float2 g = gn[m == 3 ? 2 : m];
                y0 = a0[r] * rinv * g.x * siluf_(bflo(gz[r])); y1 = a1[r] * rinv * g.y * siluf_(bfhi(gz[r])); nbr = m == 3 ? 3 : m;
            }
            *(unsigned*)(Yb + (size_t)nbr * TOKW + (size_t)tok * MW + cidx) = pack2(y0, y1);
        }
    }
}

struct G2Sched {
    const bf16_t* Y; const bf16_t* Wb; int ntiles, G, c;
    static constexpr bool HAS_BIAS = false, gather = false;
    __device__ __forceinline__ bool next(int i, g8::Unit& u) const {
        const int tile = (i >> 2) * G + c; if (tile >= ntiles) return false;
        u.pm = tile >> 2; u.pn = tile & 3; u.e = i & 3; return true;
    }
    __device__ __forceinline__ const char* a_base(const g8::Unit& u) const { return (const char*)(Y + (size_t)u.e * TOKW + (size_t)u.pm * 256 * MW); }
    __device__ __forceinline__ const char* b_base(const g8::Unit& u) const { return (const char*)(Wb + (size_t)u.e * D * MW + (size_t)u.pn * 256 * MW); }
    __device__ __forceinline__ const int* row_addr(const g8::Unit&, int) const { return nullptr; }
    __device__ __forceinline__ int rows_valid(const g8::Unit&) const { return 256; }
    __device__ __forceinline__ const float* bias_src(const g8::Unit&, int) const { return nullptr; }
};
struct EpiMix {
    const bf16_t* P; bf16_t* O;
    __device__ __forceinline__ bool keep(const g8::Unit& u) const { return u.e < 3; }
    __device__ __forceinline__ void operator()(f32x4 (&acc)[2][2][4][2], const g8::Unit& u, int wr, int wc, int fr, int fq, const LAS float*) const {
        const int row0 = u.pm * 256 + wr * 64 + fr, col0 = u.pn * 256 + wc * 32 + 8 * fq;
        const bool lastseg = u.e == 3;
#pragma unroll
        for (int ai = 0; ai < 2; ++ai)
#pragma unroll
            for (int m = 0; m < 4; ++m)
#pragma unroll
                for (int bj = 0; bj < 2; ++bj) {
                    const size_t row = (size_t)(row0 + ai * 128 + m * 16);
                    const bf16_t* gp = P + row * NP + C_MG + u.e * D + col0 + bj * 128;
                    const u32x4 gc = *(const u32x4*)gp;
                    const u32x4 gn = *(const u32x4*)(gp + (lastseg ? 0 : D));
                    float sc[8];
#pragma unroll
                    for (int q = 0; q < 4; ++q) {
                        const float e0 = __expf(-bflo(gc[q])), e1 = __expf(-bfhi(gc[q]));
                        const float n0 = lastseg ? 1.0f : 1.0f + __expf(-bflo(gn[q])), n1 = lastseg ? 1.0f : 1.0f + __expf(-bfhi(gn[q]));
                        sc[2 * q] = n0 * __builtin_amdgcn_rcpf(1.0f + e0); sc[2 * q + 1] = n1 * __builtin_amdgcn_rcpf(1.0f + e1);
                    }
#pragma unroll
                    for (int n = 0; n < 2; ++n)
#pragma unroll
                        for (int j = 0; j < 4; ++j) acc[ai][bj][m][n][j] *= sc[n * 4 + j];
                    if (lastseg) {
                        u32x4 w; w[0] = pack2(acc[ai][bj][m][0][0], acc[ai][bj][m][0][1]); w[1] = pack2(acc[ai][bj][m][0][2], acc[ai][bj][m][0][3]);
                        w[2] = pack2(acc[ai][bj][m][1][0], acc[ai][bj][m][1][1]); w[3] = pack2(acc[ai][bj][m][1][2], acc[ai][bj][m][1][3]);
                        *(u32x4*)(O + row * D + col0 + bj * 128) = w;
                    }
                }
    }
};
__device__ __forceinline__ void ph_g2(const Params& p, int l, int M, LAS unsigned char* lds) {
    G2Sched S; S.Y = p.Y; S.Wb = p.wbT + (size_t)l * 4 * D * MW; S.ntiles = (M / 256) * 4; S.G = gridDim.x; S.c = blockIdx.x;
    EpiMix E; E.P = p.P; E.O = p.mix;
    g8::gemm_phase(lds, MW, S, E);
}

template <bool DRY> struct EpiRes {
    float* xl; float* xo; const float* mod;
    __device__ __forceinline__ bool keep(const g8::Unit&) const { return false; }
    __device__ __forceinline__ void operator()(const f32x4 (&acc)[2][2][4][2], const g8::Unit& u, int wr, int wc, int fr, int fq, const LAS float*) const {
        const int row0 = u.pm * 256 + wr * 64 + fr, col0 = u.pn * 256 + wc * 32 + 8 * fq;
#pragma unroll
        for (int ai = 0; ai < 2; ++ai)
#pragma unroll
            for (int m = 0; m < 4; ++m) {
                const int row = row0 + ai * 128 + m * 16;
                const float* gtp = mod + (size_t)tok_modrow(row) * (NMOD * D) + 2 * D + col0;
#pragma unroll
                for (int bj = 0; bj < 2; ++bj)
#pragma unroll
                    for (int n = 0; n < 2; ++n) {
                        const float4 gt = *(const float4*)(gtp + bj * 128 + n * 4);
                        const size_t o = (size_t)row * D + col0 + bj * 128 + n * 4;
                        float4 xv = *(const float4*)(xl + o);
                        xv.x += gt.x * acc[ai][bj][m][n][0]; xv.y += gt.y * acc[ai][bj][m][n][1]; xv.z += gt.z * acc[ai][bj][m][n][2]; xv.w += gt.w * acc[ai][bj][m][n][3];
                        *(float4*)(xo + o) = xv;
                    }
            }
    }
};
template <bool DRY = false> __device__ __forceinline__ void ph_g3(const Params& p, int l, int M, LAS unsigned char* lds) {
    g8::PlainSched S; S.init(p.mix, p.woutT + (size_t)l * D * D, M, D, D);
    EpiRes<DRY> E; E.xl = p.xl; E.xo = DRY ? p.prep : p.xl; E.mod = p.mod + (size_t)(l * 5) * (NMOD * D);
    g8::gemm_phase(lds, D, S, E);
}

template <bool DRY = false> __device__ __forceinline__ void ph_route(const Params& p, int l, int M, LAS unsigned char* lds) {
    int* const r_cnt = DRY ? p.cnt + 64 : p.cnt; int* const r_list = DRY ? (int*)p.act : p.list; int* const r_ts = DRY ? (int*)p.yp : p.tokslot; float* const r_tw = DRY ? (float*)p.yp + (size_t)NTOK * 4 : p.topw;
    LAS float* fs = (LAS float*)lds;
    LAS float* lg = fs + 32 * 1028;
    LAS int* lcnt = (LAS int*)(lg + 32 * 36);
    LAS int* lbase = lcnt + 32;
    const int tid = opaque_tid(), wid = tid >> 6, lane = tid & 63;
    const float* rw = p.router_w + (size_t)l * D * NE;
    for (int it = blockIdx.x; it < M / 32; it += gridDim.x) {
        const int tok0 = it * 32;
        {
            float4 v[4][4]; float ss[4];
#pragma unroll
            for (int q = 0; q < 4; ++q) {
                const float* src = p.xl + (size_t)(tok0 + wid * 4 + q) * D;
#pragma unroll
                for (int i = 0; i < 4; ++i) v[q][i] = *(const float4*)(src + i * 256 + lane * 4);
            }
#pragma unroll
            for (int q = 0; q < 4; ++q) {
                float s = 0.f;
#pragma unroll
                for (int i = 0; i < 4; ++i) s += v[q][i].x * v[q][i].x + v[q][i].y * v[q][i].y + v[q][i].z * v[q][i].z + v[q][i].w * v[q][i].w;
                ss[q] = s;
            }
#pragma unroll
            for (int m = 32; m >= 1; m >>= 1)
#pragma unroll
                for (int q = 0; q < 4; ++q) ss[q] += __shfl_xor(ss[q], m);
            const float* mb = p.mod + (size_t)(l * 5 + tok_modrow(tok0)) * (NMOD * D);
#pragma unroll
            for (int i = 0; i < 4; ++i) {
                const int cidx = i * 256 + lane * 4;
                const float4 gv = *(const float4*)(p.norm2_g + l * D + cidx), sv = *(const float4*)(mb + 4 * D + cidx), hv = *(const float4*)(mb + 3 * D + cidx);
#pragma unroll
                for (int q = 0; q < 4; ++q) {
                    const int tl = wid * 4 + q, tok = tok0 + tl;
                    const float rinv = rsqrtf(ss[q] * (1.0f / D) + 1e-6f);
                    const float h0 = v[q][i].x * rinv * gv.x * (1.f + sv.x) + hv.x, h1 = v[q][i].y * rinv * gv.y * (1.f + sv.y) + hv.y;
                    const float h2 = v[q][i].z * rinv * gv.z * (1.f + sv.z) + hv.z, h3 = v[q][i].w * rinv * gv.w * (1.f + sv.w) + hv.w;
                    u32x2 o; o[0] = pack2(h0, h1); o[1] = pack2(h2, h3);
                    *(u32x2*)(p.F + (size_t)tok * D + cidx) = o;
                    *(LAS f32x4*)(fs + tl * 1028 + cidx) = (f32x4){h0, h1, h2, h3};
                }
            }
        }
        __syncthreads();
        {
            typedef float f32x16 __attribute__((ext_vector_type(16)));
            f32x16 acc;
#pragma unroll
            for (int r = 0; r < 16; ++r) acc[r] = 0.f;
            const int tk = lane & 31, hh = lane >> 5;
            const LAS float* ap = fs + tk * 1028 + wid * 128 + 4 * hh;
            const float* bp = rw + (size_t)(wid * 128 + 4 * hh) * NE + tk;
#pragma unroll 4
            for (int kk = 0; kk < 16; ++kk) {
                const f32x4 a4 = *(const LAS f32x4*)(ap + kk * 8);
                const float b0 = bp[(kk * 8 + 0) * NE], b1 = bp[(kk * 8 + 1) * NE], b2 = bp[(kk * 8 + 2) * NE], b3 = bp[(kk * 8 + 3) * NE];
                acc = __builtin_amdgcn_mfma_f32_32x32x2f32(a4[0], b0, acc, 0, 0, 0);
                acc = __builtin_amdgcn_mfma_f32_32x32x2f32(a4[1], b1, acc, 0, 0, 0);
                acc = __builtin_amdgcn_mfma_f32_32x32x2f32(a4[2], b2, acc, 0, 0, 0);
                acc = __builtin_amdgcn_mfma_f32_32x32x2f32(a4[3], b3, acc, 0, 0, 0);
            }
            __syncthreads();
            LAS float* red = fs;
#pragma unroll
            for (int r = 0; r < 16; ++r) red[(wid * 32 + (r & 3) + 8 * (r >> 2) + 4 * hh) * 33 + tk] = acc[r];
            __syncthreads();
            const int t2 = tid >> 4, e0 = (tid & 15) * 2;
            float s0 = p.router_b[l * NE + e0], s1 = p.router_b[l * NE + e0 + 1];
#pragma unroll
            for (int w = 0; w < 8; ++w) { s0 += red[(w * 32 + t2) * 33 + e0]; s1 += red[(w * 32 + t2) * 33 + e0 + 1]; }
            lg[t2 * 36 + e0] = s0; lg[t2 * 36 + e0 + 1] = s1;
            if (tid < 32) lcnt[tid] = 0;
        }
        __syncthreads();
        float vals[4]; int idxs[4], rank[4];
        if (tid < 32) {
            float lv[32];
#pragma unroll
            for (int q = 0; q < 8; ++q) { const f32x4 t = *(const LAS f32x4*)(lg + tid * 36 + q * 4); lv[q * 4] = t[0]; lv[q * 4 + 1] = t[1]; lv[q * 4 + 2] = t[2]; lv[q * 4 + 3] = t[3]; }
#pragma unroll
            for (int k = 0; k < 4; ++k) {
                float best = lv[0]; int bi = 0;
#pragma unroll
                for (int ee = 1; ee < NE; ++ee) { const bool gt = lv[ee] > best; best = gt ? lv[ee] : best; bi = gt ? ee : bi; }
#pragma unroll
                for (int ee = 0; ee < NE; ++ee) lv[ee] = (ee == bi) ? -3.0e38f : lv[ee];
                vals[k] = best; idxs[k] = bi;
                rank[k] = atomicAdd((int*)(lcnt + bi), 1);
            }
        }
        __syncthreads();
        if (tid < 32) { const int c = lcnt[tid]; lbase[tid] = c ? atomicAdd(r_cnt + l * NE + tid, c) : 0; }
        __syncthreads();
        if (tid < 32) {
            const int tok = tok0 + tid;
            const float mx = vals[0];
            float ex[4], sum = 0.f;
#pragma unroll
            for (int k = 0; k < 4; ++k) { ex[k] = __expf(vals[k] - mx); sum += ex[k]; }
            const float inv = 1.0f / sum;
#pragma unroll
            for (int k = 0; k < 4; ++k) {
                const int ee = idxs[k];
                const int slot = lbase[ee] + rank[k];
                r_list[(size_t)ee * NTOK + slot] = tok;
                r_ts[(size_t)tok * 4 + k] = (ee << 16) | slot;
                r_tw[(size_t)tok * 4 + k] = ex[k] * inv;
            }
        }
        __syncthreads();
    }
}

__device__ __forceinline__ void build_expert_tables(const Params& p, int l, LAS int* ts, LAS int* cn, LAS int* te) {
    const int tid = opaque_tid();
    if (tid < 64) {
        const int c = tid < NE ? p.cnt[l * NE + tid] : 0;
        const int nt = (c + 255) >> 8;
        int v = nt;
#pragma unroll
        for (int off = 1; off < 32; off <<= 1) { const int t = __shfl_up(v, off); if (tid >= off) v += t; }
        if (tid < NE) { cn[tid] = c; ts[tid] = v - nt; if (tid == NE - 1) ts[NE] = v; }
        if (te && tid < NE) for (int q = 0; q < nt; ++q) te[v - nt + q] = tid;
    }
    __syncthreads();
}

struct MoeSched {
    const LAS int* ts; const LAS int* cn; const LAS int* te; const int* list; const bf16_t* A; const bf16_t* Bt; const float* bias; int K, npn, nunits, G, c, nrowsB, nbias; bool gather;
    static constexpr bool HAS_BIAS = true;
    __device__ __forceinline__ bool next(int i, g8::Unit& u) const {
        const long L = (long)i * G + c; if (L >= nunits) return false;
        u.pm = (int)(L / npn); u.pn = (int)(L % npn); u.e = te[u.pm]; return true;
    }
    __device__ __forceinline__ const char* a_base(const g8::Unit& u) const { return (const char*)(gather ? A : A + (size_t)u.pm * 256 * K); }
    __device__ __forceinline__ const char* b_base(const g8::Unit& u) const { return (const char*)(Bt + ((size_t)u.e * nrowsB + (size_t)u.pn * 256) * K); }
    __device__ __forceinline__ const int* row_addr(const g8::Unit& u, int R) const {
        const int cnt = cn[u.e], sl = (u.pm - ts[u.e]) * 256 + R;
        return list + (size_t)u.e * NTOK + (sl < cnt ? sl : 0);
    }
    __device__ __forceinline__ int rows_valid(const g8::Unit& u) const { return cn[u.e] - (u.pm - ts[u.e]) * 256; }
    __device__ __forceinline__ const float* bias_src(const g8::Unit& u, int lane) const {
        if (nbias == 2) return bias + (size_t)u.e * 2 * D + (lane < 32 ? u.pn * 128 + lane * 4 : D + u.pn * 128 + (lane - 32) * 4);
        return bias + (size_t)u.e * D + u.pn * 256 + lane * 4;
    }
};
struct EpiAct {
    bf16_t* O;
    __device__ __forceinline__ bool keep(const g8::Unit&) const { return false; }
    __device__ __forceinline__ void operator()(const f32x4 (&acc)[2][2][4][2], const g8::Unit& u, int wr, int wc, int fr, int fq, const LAS float* bias) const {
        const int row0 = u.pm * 256 + wr * 64 + fr, col0 = u.pn * 128 + wc * 32 + 8 * fq;
        const LAS float* bb = bias + wc * 32 + 8 * fq;
        const f32x4 g0 = *(const LAS f32x4*)bb, g1 = *(const LAS f32x4*)(bb + 4), l0 = *(const LAS f32x4*)(bb + 128), l1 = *(const LAS f32x4*)(bb + 132);
        const float bg[8] = {g0[0], g0[1], g0[2], g0[3], g1[0], g1[1], g1[2], g1[3]}, bl[8] = {l0[0], l0[1], l0[2], l0[3], l1[0], l1[1], l1[2], l1[3]};
#pragma unroll
        for (int ai = 0; ai < 2; ++ai)
#pragma unroll
            for (int m = 0; m < 4; ++m) {
                float o[8];
#pragma unroll
                for (int n = 0; n < 2; ++n)
#pragma unroll
                    for (int j = 0; j < 4; ++j) {
                        const float glu = fminf(acc[ai][0][m][n][j] + bg[n * 4 + j], 7.0f);
                        const float lin = fminf(fmaxf(acc[ai][1][m][n][j] + bl[n * 4 + j], -7.0f), 7.0f);
                        o[n * 4 + j] = glu * sigmoidf_(1.702f * glu) * (lin + 1.0f);
                    }
                *(u32x4*)(O + (size_t)(row0 + ai * 128 + m * 16) * D + col0) = pack8(o);
            }
    }
};
__device__ __forceinline__ void ph_g4(const Params& p, int l, LAS unsigned char* lds) {
    LAS int* ts = (LAS int*)(lds + g8::STAGE_BYTES); LAS int* cn = ts + 40; LAS int* te = ts + 80;
    build_expert_tables(p, l, ts, cn, te);
    MoeSched S; S.ts = ts; S.cn = cn; S.te = te; S.list = p.list; S.A = p.F; S.Bt = p.w1T + (size_t)l * NE * 2 * D * D; S.bias = p.moe_b1 + (size_t)l * NE * 2 * D; S.nbias = 2;
    S.K = D; S.npn = 8; S.nunits = ts[NE] * 8; S.G = gridDim.x; S.c = blockIdx.x; S.nrowsB = 2 * D; S.gather = true;
    EpiAct E; E.O = p.act;
    g8::gemm_phase(lds, D, S, E);
}

struct EpiYp {
    bf16_t* O;
    __device__ __forceinline__ bool keep(const g8::Unit&) const { return false; }
    __device__ __forceinline__ void operator()(const f32x4 (&acc)[2][2][4][2], const g8::Unit& u, int wr, int wc, int fr, int fq, const LAS float* bias) const {
        const int row0 = u.pm * 256 + wr * 64 + fr, col0 = u.pn * 256 + wc * 32 + 8 * fq;
#pragma unroll
        for (int bj = 0; bj < 2; ++bj) {
            const LAS float* bb = bias + bj * 128 + wc * 32 + 8 * fq;
            const f32x4 c0v = *(const LAS f32x4*)bb, c1v = *(const LAS f32x4*)(bb + 4);
            const float4 c0 = make_float4(c0v[0], c0v[1], c0v[2], c0v[3]), c1 = make_float4(c1v[0], c1v[1], c1v[2], c1v[3]);
#pragma unroll
            for (int ai = 0; ai < 2; ++ai)
#pragma unroll
                for (int m = 0; m < 4; ++m) {
                    u32x4 w; w[0] = pack2(acc[ai][bj][m][0][0] + c0.x, acc[ai][bj][m][0][1] + c0.y); w[1] = pack2(acc[ai][bj][m][0][2] + c0.z, acc[ai][bj][m][0][3] + c0.w);
                    w[2] = pack2(acc[ai][bj][m][1][0] + c1.x, acc[ai][bj][m][1][1] + c1.y); w[3] = pack2(acc[ai][bj][m][1][2] + c1.z, acc[ai][bj][m][1][3] + c1.w);
                    *(u32x4*)(O + (size_t)(row0 + ai * 128 + m * 16) * D + col0 + bj * 128) = w;
                }
        }
    }
};
__device__ __forceinline__ void ph_g5(const Params& p, int l, LAS unsigned char* lds) {
    LAS int* ts = (LAS int*)(lds + g8::STAGE_BYTES); LAS int* cn = ts + 40; LAS int* te = ts + 80;
    build_expert_tables(p, l, ts, cn, te);
    MoeSched S; S.ts = ts; S.cn = cn; S.te = te; S.list = p.list; S.A = p.act; S.Bt = p.w2T + (size_t)l * NE * D * D; S.bias = p.moe_b2 + (size_t)l * NE * D; S.nbias = 1;
    S.K = D; S.npn = 4; S.nunits = ts[NE] * 4; S.G = gridDim.x; S.c = blockIdx.x; S.nrowsB = D; S.gather = false;
    EpiYp E; E.O = p.yp;
    g8::gemm_phase(lds, D, S, E);
}

template <bool DRY = false> __device__ __forceinline__ void ph_combine(const Params& p, int l, int M, LAS unsigned char* lds) {
    float* const c_xl = DRY ? p.prep : p.xl; bf16_t* const c_H = DRY ? (bf16_t*)(p.prep + (size_t)NTOK * D) : p.H; float* const c_out = DRY ? p.prep : p.out;
    LAS int* ts = (LAS int*)lds; LAS int* cn = ts + 40;
    build_expert_tables(p, l, ts, cn, nullptr);
    const int tid = opaque_tid(), wid = tid >> 6, lane = tid & 63;
    const bool last = (l == 1);
    for (int tok = blockIdx.x * NWAVES + wid; tok < M; tok += gridDim.x * NWAVES) {
        float4 v[4];
        const float* mb = p.mod + (size_t)(l * 5 + tok_modrow(tok)) * (NMOD * D);
        int rows[4]; float wts[4];
#pragma unroll
        for (int k = 0; k < 4; ++k) { const int tsl = p.tokslot[(size_t)tok * 4 + k]; rows[k] = ts[tsl >> 16] * 256 + (tsl & 0xffff); wts[k] = p.topw[(size_t)tok * 4 + k]; }
        float ss = 0.f;
#pragma unroll
        for (int i = 0; i < 4; ++i) {
            const int cidx = i * 256 + lane * 4;
            float m0 = 0.f, m1 = 0.f, m2 = 0.f, m3 = 0.f;
#pragma unroll
            for (int k = 0; k < 4; ++k) {
                const u32x2 u = *(const u32x2*)(p.yp + (size_t)rows[k] * D + cidx);
                m0 += wts[k] * bflo(u[0]); m1 += wts[k] * bfhi(u[0]); m2 += wts[k] * bflo(u[1]); m3 += wts[k] * bfhi(u[1]);
            }
            const float4 gt = *(const float4*)(mb + 5 * D + cidx);
            float4 xv = *(const float4*)(p.xl + (size_t)tok * D + cidx);
            xv.x += gt.x * m0; xv.y += gt.y * m1; xv.z += gt.z * m2; xv.w += gt.w * m3;
            v[i] = xv; ss += xv.x * xv.x + xv.y * xv.y + xv.z * xv.z + xv.w * xv.w;
        }
        ss = wave_sum(ss);
        const float rinv = rsqrtf(ss * (1.0f / D) + 1e-6f);
        if (!last) {
#pragma unroll
            for (int i = 0; i < 4; ++i) *(float4*)(c_xl + (size_t)tok * D + i * 256 + lane * 4) = v[i];
            const float* mb1 = p.mod + (size_t)((l + 1) * 5 + tok_modrow(tok)) * (NMOD * D);
            norm_mod_store(v, rinv, p.norm1_g + (l + 1) * D, mb1 + 1 * D, mb1 + 0 * D, c_H + (size_t)tok * D, lane);
        } else {
#pragma unroll
            for (int i = 0; i < 4; ++i) {
                const int cidx = i * 256 + lane * 4;
                const float4 gv = *(const float4*)(p.final_norm_g + cidx);
                *(float4*)(c_out + (size_t)tok * D + cidx) = make_float4(v[i].x * rinv * gv.x, v[i].y * rinv * gv.y, v[i].z * rinv * gv.z, v[i].w * rinv * gv.w);
            }
        }
    }
}

#define XB_TMO      128
#define XB_XCNT(j)  (256  + 64 * (j))
#define XB_XSUB(j)  (1280 + 64 * (j))
#define XB_XGEN(j)  (2304 + 64 * (j))
#define XB_TOP      3328
#define XB_TOPGEN   3392
#define XCD_BAR_WORDS 3456
#define XB_SPIN_CAP (1u << 18)

__device__ __forceinline__ unsigned xb_ld(unsigned* p)              { return __hip_atomic_load(p, __ATOMIC_RELAXED, __HIP_MEMORY_SCOPE_AGENT); }
__device__ __forceinline__ unsigned xb_add(unsigned* p, unsigned v) { return __hip_atomic_fetch_add(p, v, __ATOMIC_RELAXED, __HIP_MEMORY_SCOPE_AGENT); }
__device__ __forceinline__ unsigned xb_xcc_id() { return (unsigned)__builtin_amdgcn_s_getreg((3 << 11) | 20) & 0xFu; }
#define XB_SPIN(cond, bar) do { unsigned _sp = 0; while (cond) { __builtin_amdgcn_s_sleep(1); \
    if ((++_sp & 255u) == 0u) { if (xb_ld(&(bar)[XB_TMO])) break; if (_sp > XB_SPIN_CAP) { atomicAdd(&(bar)[XB_TMO], 1u); break; } } } } while (0)

struct XcdBarrier {
    unsigned* bar; unsigned x;
    volatile LAS unsigned* st;
};

__device__ __forceinline__ XcdBarrier xcd_barrier_post(unsigned* bar, volatile LAS unsigned* st) {
    XcdBarrier b; b.bar = bar; b.x = xb_xcc_id(); b.st = st;
    if (threadIdx.x == 0) (void)xb_add(&bar[XB_XCNT(b.x)], 1u);
    return b;
}
__device__ __forceinline__ void xcd_barrier_complete(unsigned* bar, unsigned x, unsigned& nloc, unsigned& nx) {
    const unsigned G = gridDim.x * gridDim.y * gridDim.z;
    unsigned sum, cnt, mine, sp = 0u;
    for (;;) {
        sum = 0u; cnt = 0u; mine = 0u;
#pragma unroll
        for (unsigned j = 0; j < 16; ++j) { const unsigned c = xb_ld(&bar[XB_XCNT(j)]); sum += c; cnt += (c > 0u) ? 1u : 0u; mine = (j == x) ? c : mine; }
        if (sum == G) break;
        __builtin_amdgcn_s_sleep(1);
        if ((++sp & 255u) == 0u) { if (xb_ld(&bar[XB_TMO])) break; if (sp > XB_SPIN_CAP) { atomicAdd(&bar[XB_TMO], 1u); break; } }
    }
    nloc = mine > 0u ? mine : 1u; nx = cnt > 0u ? cnt : 1u;
}

__device__ __forceinline__ void xcd_barrier(const XcdBarrier& b) {
    asm volatile("s_waitcnt vmcnt(0)" ::: "memory");
    __syncthreads();
    if (threadIdx.x == 0) {
        unsigned* bar = b.bar;
        __builtin_amdgcn_s_waitcnt(0);
        unsigned nloc = b.st[0], nx = b.st[1];
        if (nloc == 0u) { xcd_barrier_complete(bar, b.x, nloc, nx); b.st[0] = nloc; b.st[1] = nx; }
        const unsigned old = xb_add(&bar[XB_XSUB(b.x)], 1u);
        const unsigned gen = old / nloc;
        if (old + 1u == (gen + 1u) * nloc) {
            __builtin_amdgcn_fence(__ATOMIC_RELEASE, "agent");
            asm volatile("s_waitcnt vmcnt(0)" ::: "memory");
            const unsigned og = xb_add(&bar[XB_TOP], 1u);
            const unsigned tg = og / nx;
            if (og + 1u == (tg + 1u) * nx) xb_add(&bar[XB_TOPGEN], 1u);
            else XB_SPIN(xb_ld(&bar[XB_TOPGEN]) == tg, bar);
            __builtin_amdgcn_fence(__ATOMIC_ACQUIRE, "agent");
            xb_add(&bar[XB_XGEN(b.x)], 1u);
            asm volatile("s_waitcnt vmcnt(0)" ::: "memory");
        } else {
            XB_SPIN(xb_ld(&bar[XB_XGEN(b.x)]) == gen, bar);
            __builtin_amdgcn_fence(__ATOMIC_ACQUIRE, "agent");
            asm volatile("s_waitcnt vmcnt(0)" ::: "memory");
        }
    }
    __syncthreads();
}


extern __shared__ __attribute__((aligned(16))) unsigned char dyn_lds[];
#define KPH(name, call) __global__ void __launch_bounds__(NTHREADS, 2) name(Params p, int l, int M) { LAS unsigned char* lds = (LAS unsigned char*)dyn_lds; (void)l; (void)M; (void)lds; call; }
KPH(k_convert, { ph_convert(p, lds); })
KPH(k_mod, { ph_mod(p, lds); })
KPH(k_norm1, { ph_norm1_first(p); })
KPH(k_g1, { ph_g1(p, l, lds); })
KPH(k_prep, { ph_prep(p, l, lds); })
KPH(k_local, { ph_local(p, l, lds); })
KPH(k_seq, { ph_seq(p, lds); })
KPH(k_merge, { ph_merge(p, l, M); })
KPH(k_g2, { ph_g2(p, l, M, lds); })
KPH(k_g3, { ph_g3(p, l, M, lds); })
KPH(k_route, { ph_route(p, l, M, lds); })
KPH(k_g4, { ph_g4(p, l, lds); })
KPH(k_g5, { ph_g5(p, l, lds); })
KPH(k_combine, { ph_combine(p, l, M, lds); })


__global__ void __launch_bounds__(NTHREADS, 2) k_mega(Params p) {
    LAS unsigned char* lds = (LAS unsigned char*)dyn_lds;
    volatile LAS unsigned* xb_words = (volatile LAS unsigned*)(lds + LDS_BYTES - 16);
    if (threadIdx.x == 0) { xb_words[0] = 0u; xb_words[1] = 0u; xb_words[2] = 0u; xb_words[3] = 0u; }
    __syncthreads();
    (void)xcd_barrier_post(p.bar, xb_words);
#define GRID_BARRIER() do { XcdBarrier b_; b_.bar = p.bar; b_.x = xb_xcc_id(); b_.st = xb_words; xcd_barrier(b_); } while (0)
#define RUNP(bit, stmt) do { stmt; if (PROBE & (1 << (bit))) { GRID_BARRIER(); stmt; } } while (0)
    RUNP(0, ph_convert(p, lds));
    RUNP(1, ph_mod(p, lds));
    GRID_BARRIER();
    RUNP(2, ph_norm1_first(p));
    GRID_BARRIER();
    for (int l = 0; l < 2; ++l) {
        const int M = l == 0 ? NTOK : NLAT;
        { unsigned lb_ = (unsigned)(size_t)lds; asm volatile("" : "+s"(lb_)); lds = (LAS unsigned char*)(size_t)lb_; }
        RUNP(3, ph_g1(p, l, lds));
        GRID_BARRIER();
        RUNP(4, ph_prep(p, l, lds));
        GRID_BARRIER();
        RUNP(5, ph_local(p, l, lds));
        GRID_BARRIER();
        RUNP(6, ph_seq(p, lds));
        GRID_BARRIER();
        RUNP(7, ph_merge(p, l, M));
        GRID_BARRIER();
        RUNP(8, ph_g2(p, l, M, lds));
        GRID_BARRIER();
        if (PROBE & (1 << 11)) { ph_g3<true>(p, l, M, lds); GRID_BARRIER(); }
        ph_g3(p, l, M, lds);
        GRID_BARRIER();
        if (PROBE & (1 << 12)) { ph_route<true>(p, l, M, lds); GRID_BARRIER(); }
        ph_route(p, l, M, lds);
        GRID_BARRIER();
        RUNP(9, ph_g4(p, l, lds));
        GRID_BARRIER();
        RUNP(10, ph_g5(p, l, lds));
        GRID_BARRIER();
        if (PROBE & (1 << 13)) { ph_combine<true>(p, l, M, lds); GRID_BARRIER(); }
        ph_combine(p, l, M, lds);
        if (l == 0) GRID_BARRIER();
    }
}

static inline size_t align_up(size_t v, size_t a) { return (v + a - 1) / a * a; }

extern "C" void kernel_launch(void* const* d_in, const int* in_sizes, int n_in, void* d_out, int out_size, void* d_ws, size_t ws_size, hipStream_t stream) {
    (void)in_sizes; (void)n_in; (void)out_size;
    Params p{};
    const float** pf = (const float**)&p;
    for (int i = 0; i < 32; ++i) pf[i] = (const float*)d_in[i];
    p.out = (float*)d_out;
    unsigned char* w = (unsigned char*)d_ws; size_t off = 0;
    auto take = [&](size_t bytes) { void* r = w + off; off = align_up(off + bytes, 256); return r; };
    p.bar = (unsigned*)take(16384);
    p.cnt = (int*)take(1024);
    const size_t ctl_bytes = off;
    p.mod = (float*)take((size_t)2 * 5 * NMOD * D * 4);
    p.winT = (bf16_t*)take((size_t)2 * NP * D * 2);
    p.wbT = (bf16_t*)take((size_t)2 * 4 * D * MW * 2);
    p.woutT = (bf16_t*)take((size_t)2 * D * D * 2);
    p.w1T = (bf16_t*)take((size_t)2 * NE * 2 * D * D * 2);
    p.w2T = (bf16_t*)take((size_t)2 * NE * D * D * 2);
    p.xl = (float*)take((size_t)NTOK * D * 4);
    p.H = (bf16_t*)take((size_t)NTOK * D * 2);
    p.P = (bf16_t*)take((size_t)NTOK * NP * 2);
    p.act = p.P; p.yp = p.P + (size_t)CAPROWS * D;
    p.prep = (float*)take(NPREP * TOKW * 4);
    p.gg = (float*)take((size_t)NTOK * 8 * 4);
    p.gb = (float*)take((size_t)NTOK * 8 * 4);
    p.O = (float*)take(8 * TOKW * 4);
    p.lq = (bf16_t*)take((size_t)3 * NITEM * 64 * 128 * 2);
    p.lo = (bf16_t*)take((size_t)3 * NITEM * 64 * 128 * 2);
    p.lb = (bf16_t*)take((size_t)3 * NITEM * 128 * 128 * 2);
    p.la = (bf16_t*)take((size_t)NITEM * 128 * 128 * 2);
    p.ld = (float*)take((size_t)3 * NITEM * 128 * 4);
    p.lruT = (bf16_t*)take((size_t)2 * 8 * 4 * 4096 * 2);
    p.Y = (bf16_t*)take(4 * TOKW * 2);
    p.mix = (bf16_t*)take((size_t)NTOK * D * 2);
    p.F = p.H;
    p.list = (int*)take((size_t)NE * NTOK * 4);
    p.tokslot = (int*)take((size_t)NTOK * 4 * 4);
    p.topw = (float*)take((size_t)NTOK * 4 * 4);
    if (off > ws_size) { fprintf(stderr, "workspace too small: need %zu have %zu\n", off, ws_size); return; }

    static int grid = 0;
#if MEGA
    if (!grid) {
        int dev = 0, cus = 0, occ = 0; (void)hipGetDevice(&dev); (void)hipDeviceGetAttribute(&cus, hipDeviceAttributeMultiprocessorCount, dev);
        (void)hipFuncSetAttribute((const void*)k_mega, hipFuncAttributeMaxDynamicSharedMemorySize, LDS_BYTES);
        (void)hipOccupancyMaxActiveBlocksPerMultiprocessor(&occ, (const void*)k_mega, NTHREADS, LDS_BYTES);
        if (cus <= 0) cus = 256;
        grid = cus * (occ < 1 ? 1 : 1);
        if (occ < 1) fprintf(stderr, "occupancy query says %d blocks per CU\n", occ);
    }
    (void)hipMemsetAsync(d_ws, 0, ctl_bytes, stream);
    hipLaunchKernelGGL(k_mega, dim3(grid), dim3(NTHREADS), LDS_BYTES, stream, p);
#else
    if (!grid) {
        int dev = 0, cus = 0; (void)hipGetDevice(&dev); (void)hipDeviceGetAttribute(&cus, hipDeviceAttributeMultiprocessorCount, dev);
        grid = cus > 0 ? cus : 256;
        const void* ks[] = {(const void*)k_convert, (const void*)k_mod, (const void*)k_norm1, (const void*)k_g1, (const void*)k_prep, (const void*)k_local, (const void*)k_seq, (const void*)k_merge,
                            (const void*)k_g2, (const void*)k_g3, (const void*)k_route, (const void*)k_g4, (const void*)k_g5, (const void*)k_combine};
        for (const void* k : ks) (void)hipFuncSetAttribute(k, hipFuncAttributeMaxDynamicSharedMemorySize, LDS_BYTES);
    }
    (void)hipMemsetAsync(d_ws, 0, ctl_bytes, stream);
#define LAUNCH(k, l, M) hipLaunchKernelGGL(k, dim3(grid), dim3(NTHREADS), LDS_BYTES, stream, p, l, M)
    LAUNCH(k_convert, 0, 0);
    LAUNCH(k_mod, 0, 0);
    LAUNCH(k_norm1, 0, 0);
    for (int l = 0; l < 2; ++l) {
        const int M = l == 0 ? NTOK : NLAT;
        LAUNCH(k_g1, l, M);
        LAUNCH(k_prep, l, M);
        LAUNCH(k_local, l, M);
        LAUNCH(k_seq, l, M);
        LAUNCH(k_merge, l, M);
        LAUNCH(k_g2, l, M);
        LAUNCH(k_g3, l, M);
        LAUNCH(k_route, l, M);
        LAUNCH(k_g4, l, M);
        LAUNCH(k_g5, l, M);
        LAUNCH(k_combine, l, M);
    }
#endif
}
```

```cpp
#include <hip/hip_runtime.h>
#include <stdint.h>
#include <stdio.h>

#define LAS __attribute__((address_space(3)))
typedef unsigned short bf16_t;
typedef short bf16x8 __attribute__((ext_vector_type(8)));
typedef float f32x4 __attribute__((ext_vector_type(4)));
typedef float f32x2 __attribute__((ext_vector_type(2)));
typedef unsigned u32x2 __attribute__((ext_vector_type(2)));
typedef unsigned u32x4 __attribute__((ext_vector_type(4)));

#ifndef MEGA
#define MEGA 1
#endif
#ifndef PROBE
#define PROBE 0
#endif

constexpr int D = 1024, NB = 4, TL = 4096, TC = 256, NLAT = NB * TL, NCTX = NB * TC, NTOK = NLAT + NCTX;
constexpr int NIN = 11792, NPW = 12032, NP = 7936, MW = 512, NE = 32, TOPK = 4, NMOD = 6;
constexpr int C_GQKV = 0, C_GZ = 1536, C_HQ = 2048, C_HI = 2560, C_HF = 3072, C_HG = 4096, C_LX = 4608,
              C_LY = 5120, C_RQKV = 5632, C_RG = 7168, C_GA = 7680, C_GB = 7688, W_MG = 7936;
__host__ __device__ __forceinline__ int win_dst_row(int n) { return n < 2048 ? n : n < 2064 ? 7680 + (n - 2048) : n < 7696 ? n - 16 : 7936 + (n - 7696); }
constexpr int NTHREADS = 512, NWAVES = 8;
constexpr int LDS_BYTES = 140 * 1024;
constexpr int CAPROWS = 77824;
constexpr size_t TOKW = (size_t)NTOK * MW;
constexpr int PR_LA = 0, PR_LU = 2, NPREP = 4;
constexpr int NCHUNK = 68, NITEM = 32 * NCHUNK;

struct Params {
    const float *x, *c, *ctx, *c_ctx, *w_mod, *b_mod, *norm1_g, *norm2_g, *w_in, *gdn_conv_w, *gdn_a_log, *gdn_dt_bias, *gdn_norm_g, *hgrn_lb,
        *hgrn_norm_g, *lru_conv_w, *lru_conv_b, *lru_wa, *lru_ba, *lru_wx, *lru_bx, *lru_lambda, *ret_norm_g, *w_branch, *w_out, *router_w,
        *router_b, *moe_w1, *moe_b1, *moe_w2, *moe_b2, *final_norm_g;
    float* out;
    unsigned* bar; int* cnt; float* mod;
    bf16_t *winT, *wbT, *woutT, *w1T, *w2T;
    float* xl; bf16_t* H; bf16_t* P; float* prep; float* gg; float* gb; float* O; bf16_t* Y; bf16_t* mix; bf16_t* F;
    int* list; int* tokslot; float* topw; bf16_t* act; bf16_t* yp;
    bf16_t *lq, *lo, *lb, *la; float* ld; bf16_t* lruT; bf16_t* gate;
};

__device__ __forceinline__ unsigned f2bf(float f) { unsigned u = __float_as_uint(f); u += 0x7fffu + ((u >> 16) & 1u); return u >> 16; }
__device__ __forceinline__ unsigned pack2(float a, float b) { return f2bf(a) | (f2bf(b) << 16); }
__device__ __forceinline__ float bf2f(bf16_t b) { return __uint_as_float(((unsigned)b) << 16); }
__device__ __forceinline__ float bflo(unsigned u) { return __uint_as_float(u << 16); }
__device__ __forceinline__ float bfhi(unsigned u) { return __uint_as_float(u & 0xffff0000u); }
__device__ __forceinline__ float sigmoidf_(float x) { return __builtin_amdgcn_rcpf(1.0f + __expf(-x)); }
__device__ __forceinline__ float siluf_(float x) { return x * sigmoidf_(x); }
__device__ __forceinline__ float softplusf_(float x) { return x > 20.f ? x : log1pf(__expf(x)); }
__device__ __forceinline__ float logsigmoidf_(float x) { return -softplusf_(-x); }
__device__ __forceinline__ float gelu_tanhf_(float x) { const float u = 0.7978845608028654f * (x + 0.044715f * x * x * x); return 0.5f * x * (1.0f + tanhf(u)); }
__device__ __forceinline__ float wave_sum(float v) {
#pragma unroll
    for (int m = 32; m >= 1; m >>= 1) v += __shfl_xor(v, m);
    return v;
}
__device__ __forceinline__ int opaque_tid() { int t = threadIdx.x; asm volatile("" : "+v"(t)); return t; }
template <class T> __device__ __forceinline__ T* opaque_sptr(T* q) { asm volatile("" : "+s"(q)); return q; }
__device__ __forceinline__ int tok_modrow(int tok) { return tok < NLAT ? (tok >> 12) : 4; }
__device__ __forceinline__ void tok_info(int tok, int& t, int& T, int& base) {
    if (tok < NLAT) { t = tok & (TL - 1); T = TL; base = tok - t; }
    else { t = (tok - NLAT) & (TC - 1); T = TC; base = tok - t; }
}

__device__ __forceinline__ f32x4 mfma16(bf16x8 a, bf16x8 b, f32x4 c) { return __builtin_amdgcn_mfma_f32_16x16x32_bf16(a, b, c, 0, 0, 0); }
__device__ __forceinline__ u32x2 pack4(f32x4 v) { u32x2 o; o[0] = pack2(v[0], v[1]); o[1] = pack2(v[2], v[3]); return o; }
__device__ __forceinline__ u32x4 pack8(const float* v) { u32x4 o; o[0] = pack2(v[0], v[1]); o[1] = pack2(v[2], v[3]); o[2] = pack2(v[4], v[5]); o[3] = pack2(v[6], v[7]); return o; }

namespace gm {
constexpr int HT = 16384;
__device__ __forceinline__ int lds_byte(int r, int c) { const int st = (r >> 4) * 2 + (c >> 5), rr = r & 15, cc = c & 31, ob = rr * 64 + cc * 2; return st * 1024 + (ob ^ (((ob >> 9) & 1) << 5)); }
__device__ __forceinline__ void stage_rc(int b, int& R, int& C) { const int st = b / 1024, sb = b % 1024, swz = sb ^ (((sb >> 9) & 1) << 5); R = (st >> 1) * 16 + swz / 64; C = (st & 1) * 32 + (swz % 64) / 2; }

__device__ __forceinline__ void kloop(LAS unsigned char* lds, const bf16_t* ap00, const bf16_t* ap01, const bf16_t* ap10, const bf16_t* ap11,
                                      const bf16_t* bp0, const bf16_t* bp1, int K, f32x4 (&acc)[4][4]) {
    const int tid = opaque_tid(), wid = __builtin_amdgcn_readfirstlane(tid >> 6), lane = tid & 63, wr = wid >> 1, wc = wid & 1, fr = lane & 15, fq = lane >> 4;
    const unsigned ldsw = (unsigned)wid * 1024u;
    const int aoff = (wr >> 1) * HT + lds_byte((wr & 1) * 64 + fr, fq * 8);
    const int boff = 2 * HT + lds_byte(wc * 64 + fr, fq * 8);
    const int nt = K / 64;
#define GM_GLDS(src, dstoff) __builtin_amdgcn_global_load_lds((const unsigned*)(src), (LAS unsigned*)(lds + (dstoff)), 16, 0, 0)
#define GM_STAGE(buf, kt) do { const int _bo = (buf) * 3 * HT + ldsw; const int _ko = (kt) * 64; \
        GM_GLDS(ap00 + _ko, _bo); GM_GLDS(ap01 + _ko, _bo + 8192); GM_GLDS(ap10 + _ko, _bo + HT); GM_GLDS(ap11 + _ko, _bo + HT + 8192); \
        GM_GLDS(bp0 + _ko, _bo + 2 * HT); GM_GLDS(bp1 + _ko, _bo + 2 * HT + 8192); } while (0)
    GM_STAGE(0, 0);
    for (int t = 0; t < nt; ++t) {
        const int cur = t & 1;
        if (t + 1 < nt) { GM_STAGE(cur ^ 1, t + 1); asm volatile("s_waitcnt vmcnt(6)" ::: "memory"); }
        else asm volatile("s_waitcnt vmcnt(0)" ::: "memory");
        __builtin_amdgcn_s_barrier(); asm volatile("" ::: "memory");
        bf16x8 af[4][2], bfr[4][2];
#pragma unroll
        for (int m = 0; m < 4; ++m)
#pragma unroll
            for (int k = 0; k < 2; ++k) af[m][k] = *(const LAS bf16x8*)(lds + cur * 3 * HT + aoff + m * 2048 + k * 1024);
#pragma unroll
        for (int n = 0; n < 4; ++n)
#pragma unroll
            for (int k = 0; k < 2; ++k) bfr[n][k] = *(const LAS bf16x8*)(lds + cur * 3 * HT + boff + n * 2048 + k * 1024);
#pragma unroll
        for (int k = 0; k < 2; ++k)
#pragma unroll
            for (int m = 0; m < 4; ++m)
#pragma unroll
                for (int n = 0; n < 4; ++n) acc[m][n] = __builtin_amdgcn_mfma_f32_16x16x32_bf16(bfr[n][k], af[m][k], acc[m][n], 0, 0, 0);
        asm volatile("s_waitcnt lgkmcnt(0)" ::: "memory");
        __builtin_amdgcn_s_barrier(); asm volatile("" ::: "memory");
    }
#undef GM_STAGE
#undef GM_GLDS
}
__device__ __forceinline__ void zero_acc(f32x4 (&acc)[4][4]) {
#pragma unroll
    for (int m = 0; m < 4; ++m)
#pragma unroll
        for (int n = 0; n < 4; ++n) acc[m][n] = (f32x4){0.f, 0.f, 0.f, 0.f};
}
}

namespace g8 {
constexpr int BM = 256, BK = 64, HALF = 128, HTB = HALF * BK * 2, STAGE_BYTES = 8 * HTB;
__device__ __forceinline__ int lds_byte(int r, int c) { const int st = (r >> 4) * 2 + (c >> 5), rr = r & 15, cc = c & 31, ob = rr * 64 + cc * 2; return st * 1024 + (ob ^ (((ob >> 9) & 1) << 5)); }
__device__ __forceinline__ void stage_rc(int b, int& R, int& C) { const int st = b / 1024, sb = b % 1024, swz = sb ^ (((sb >> 9) & 1) << 5); R = (st >> 1) * 16 + swz / 64; C = (st & 1) * 32 + (swz % 64) / 2; }
__device__ __forceinline__ int perm32(int rho) { const int n = rho >> 4, i = rho & 15; return 8 * (i >> 2) + 4 * n + (i & 3); }
struct Unit { int pm, pn, e; };

template <class Epi, class Sched>
__device__ __forceinline__ void gemm_phase(LAS unsigned char* lds, const int K, const Sched& S, const Epi& E) {
    const int tid = opaque_tid(), wid = __builtin_amdgcn_readfirstlane(tid >> 6), lane = tid & 63, wr = wid >> 2, wc = wid & 3, fr = lane & 15, fq = lane >> 4;
    const int nt = K / BK;
    int R0, C0, R1, C1; stage_rc(tid * 16, R0, C0); stage_rc(tid * 16 + 8192, R1, C1);
    unsigned voffB[2];
    voffB[0] = (unsigned)(((R0 & ~31) + perm32(R0 & 31)) * K + C0) * 2u; voffB[1] = (unsigned)(((R1 & ~31) + perm32(R1 & 31)) * K + C1) * 2u;
    const unsigned cb0 = (unsigned)C0 * 2u, cb1 = (unsigned)C1 * 2u;
    const size_t kstep = (size_t)(BK * 2);
    const size_t hstepB = (size_t)HALF * K * 2;
    const unsigned ldsw = (unsigned)wid * 1024u;
    const int aoff = lds_byte(wr * 64 + fr, fq * 8), boff = lds_byte(wc * 32 + fr, fq * 8);
#define G8_SA(b, h) (((b) * 2 + (h)) * HTB)
#define G8_SB(b, h) ((4 + (b) * 2 + (h)) * HTB)
#define G8_GL(src, dstoff) __builtin_amdgcn_global_load_lds((const unsigned*)(src), (LAS unsigned*)(lds + (dstoff)), 16, 0, 0)
#define G8_STAGE_A(bufoff, gbase, vo, h) do { G8_GL((const char*)(gbase) + (vo)[2 * (h)], (bufoff) + ldsw); G8_GL((const char*)(gbase) + (vo)[2 * (h) + 1], (bufoff) + ldsw + 8192); } while (0)
#define G8_STAGE_B(bufoff, gbase) do { G8_GL((const char*)(gbase) + voffB[0], (bufoff) + ldsw); G8_GL((const char*)(gbase) + voffB[1], (bufoff) + ldsw + 8192); } while (0)
#define G8_LDA(dst, b, h) do { _Pragma("unroll") for (int m = 0; m < 4; ++m) _Pragma("unroll") for (int k = 0; k < 2; ++k) dst[m][k] = *(const LAS bf16x8*)(lds + G8_SA(b, h) + aoff + m * 2048 + k * 1024); } while (0)
#define G8_LDB(dst, b, h) do { _Pragma("unroll") for (int n = 0; n < 2; ++n) _Pragma("unroll") for (int k = 0; k < 2; ++k) dst[n][k] = *(const LAS bf16x8*)(lds + G8_SB(b, h) + boff + n * 2048 + k * 1024); } while (0)
#define G8_MMA(ai, bj, At, Bt) do { __builtin_amdgcn_s_setprio(1); _Pragma("unroll") for (int m = 0; m < 4; ++m) _Pragma("unroll") for (int n = 0; n < 2; ++n) _Pragma("unroll") for (int k = 0; k < 2; ++k) \
        acc[ai][bj][m][n] = __builtin_amdgcn_mfma_f32_16x16x32_bf16(Bt[n][k], At[m][k], acc[ai][bj][m][n], 0, 0, 0); __builtin_amdgcn_s_setprio(0); } while (0)
#define G8_WAIT_V(n) asm volatile("s_waitcnt vmcnt(" #n ")" ::: "memory")
#define G8_WAIT_L(n) asm volatile("s_waitcnt lgkmcnt(" #n ")" ::: "memory")
#define G8_BAR __builtin_amdgcn_s_barrier()
#define G8_SCHED __builtin_amdgcn_sched_barrier(0)
    Unit cur, nxt; int ui = 0;
    if (!S.next(0, cur)) return;
    LAS float* biasbuf = (LAS float*)(lds + STAGE_BYTES + 2048);
    LAS int* rowbuf = (LAS int*)(lds + STAGE_BYTES + 4096);
    f32x4 acc[2][2][4][2];
#pragma unroll
    for (int a = 0; a < 2; ++a)
#pragma unroll
        for (int b = 0; b < 2; ++b)
#pragma unroll
            for (int m = 0; m < 4; ++m)
#pragma unroll
                for (int n = 0; n < 2; ++n) acc[a][b][m][n] = (f32x4){0.f, 0.f, 0.f, 0.f};
    bf16x8 At[4][2], B0[2][2], B1[2][2];
    unsigned vA[4];
    {
        unsigned rows[4] = {(unsigned)R0, (unsigned)R1, (unsigned)(HALF + R0), (unsigned)(HALF + R1)};
        if (S.gather) { rows[0] = (unsigned)*S.row_addr(cur, R0); rows[1] = (unsigned)*S.row_addr(cur, R1); rows[2] = (unsigned)*S.row_addr(cur, HALF + R0); rows[3] = (unsigned)*S.row_addr(cur, HALF + R1); }
        vA[0] = rows[0] * (unsigned)(K * 2) + cb0; vA[1] = rows[1] * (unsigned)(K * 2) + cb1; vA[2] = rows[2] * (unsigned)(K * 2) + cb0; vA[3] = rows[3] * (unsigned)(K * 2) + cb1;
    }
    const char* cA = S.a_base(cur); const char* cB = S.b_base(cur);
    G8_STAGE_B(G8_SB(0, 0), cB); G8_STAGE_A(G8_SA(0, 0), cA, vA, 0); G8_STAGE_B(G8_SB(0, 1), cB + hstepB); G8_STAGE_A(G8_SA(0, 1), cA, vA, 1);
    if (wr == 1) G8_BAR;
    G8_WAIT_V(4); G8_BAR;
    G8_STAGE_B(G8_SB(1, 0), cB + kstep); G8_STAGE_A(G8_SA(1, 0), cA + kstep, vA, 0); G8_STAGE_B(G8_SB(1, 1), cB + hstepB + kstep);
    G8_WAIT_V(6); G8_BAR;
    for (;;) {
        const bool has_next = S.next(ui + 1, nxt);
        const char* nA = has_next ? S.a_base(nxt) : cA; const char* nB = has_next ? S.b_base(nxt) : cB;
        const int nvalid = (S.gather && has_next) ? S.rows_valid(nxt) : 0;
        if (wid == 0) {
            if (Sched::HAS_BIAS) G8_GL(S.bias_src(cur, lane), STAGE_BYTES + 2048 + (ui & 1) * 1024);
            if (S.gather && has_next) G8_GL(S.row_addr(nxt, 0) + lane * 4, STAGE_BYTES + 4096 + ((ui + 1) & 1) * 1024);
        }
        unsigned vlast[4] = {vA[0], vA[1], vA[2], vA[3]};
        for (int t = 0; t < nt; t += 2) {
            const bool last = (t == nt - 2);
            const char* a1 = cA + (size_t)(t + 1) * kstep;
            const char* a2 = last ? nA : cA + (size_t)(t + 2) * kstep; const char* b2 = last ? nB : cB + (size_t)(t + 2) * kstep;
            const char* a3 = a2 + kstep; const char* b3 = b2 + kstep;
            unsigned v2[4];
#pragma unroll
            for (int q = 0; q < 4; ++q) v2[q] = vA[q];
            if (last && S.gather && has_next) {
                const LAS int* rb = rowbuf + ((ui + 1) & 1) * 256;
                const unsigned r0 = R0 < nvalid ? (unsigned)rb[R0] : 0u, r1 = R1 < nvalid ? (unsigned)rb[R1] : 0u;
                const unsigned r2 = HALF + R0 < nvalid ? (unsigned)rb[HALF + R0] : 0u, r3 = HALF + R1 < nvalid ? (unsigned)rb[HALF + R1] : 0u;
                v2[0] = r0 * (unsigned)(K * 2) + cb0; v2[1] = r1 * (unsigned)(K * 2) + cb1; v2[2] = r2 * (unsigned)(K * 2) + cb0; v2[3] = r3 * (unsigned)(K * 2) + cb1;
            }
            if (last) { vlast[0] = v2[0]; vlast[1] = v2[1]; vlast[2] = v2[2]; vlast[3] = v2[3]; }
            G8_LDB(B0, 0, 0); G8_SCHED; G8_LDA(At, 0, 0); G8_STAGE_A(G8_SA(1, 1), a1, vA, 1);
            G8_WAIT_L(8); G8_BAR; G8_WAIT_L(0); G8_MMA(0, 0, At, B0); G8_BAR; G8_SCHED;
            G8_LDB(B1, 0, 1); G8_STAGE_B(G8_SB(0, 0), b2);
            G8_BAR; G8_WAIT_L(0); G8_MMA(0, 1, At, B1); G8_BAR;
            G8_LDA(At, 0, 1); G8_STAGE_A(G8_SA(0, 0), a2, v2, 0);
            G8_BAR; G8_WAIT_L(0); G8_MMA(1, 0, At, B0); G8_BAR; G8_SCHED;
            G8_STAGE_B(G8_SB(0, 1), b2 + hstepB);
            G8_WAIT_V(6); G8_BAR; G8_MMA(1, 1, At, B1); G8_BAR;
            G8_LDB(B0, 1, 0); G8_SCHED; G8_LDA(At, 1, 0); G8_STAGE_A(G8_SA(0, 1), a2, v2, 1);
            G8_WAIT_L(8); G8_BAR; G8_WAIT_L(0); G8_MMA(0, 0, At, B0); G8_BAR; G8_SCHED;
            G8_LDB(B1, 1, 1); G8_STAGE_B(G8_SB(1, 0), b3);
            G8_BAR; G8_WAIT_L(0); G8_MMA(0, 1, At, B1); G8_BAR;
            G8_LDA(At, 1, 1); G8_STAGE_A(G8_SA(1, 0), a3, v2, 0);
            G8_BAR; G8_WAIT_L(0); G8_MMA(1, 0, At, B0); G8_BAR; G8_SCHED;
            G8_STAGE_B(G8_SB(1, 1), b3 + hstepB);
            G8_WAIT_V(6); G8_BAR; G8_MMA(1, 1, At, B1); G8_BAR;
        }
        E(acc, cur, wr, wc, fr, fq, biasbuf + (ui & 1) * 256);
        if (!has_next) break;
        if (!E.keep(cur))
#pragma unroll
        for (int a = 0; a < 2; ++a)
#pragma unroll
            for (int b = 0; b < 2; ++b)
#pragma unroll
                for (int m = 0; m < 4; ++m)
#pragma unroll
                    for (int n = 0; n < 2; ++n) acc[a][b][m][n] = (f32x4){0.f, 0.f, 0.f, 0.f};
        cur = nxt; cA = nA; cB = nB; ++ui;
#pragma unroll
        for (int q = 0; q < 4; ++q) vA[q] = vlast[q];
    }
    G8_WAIT_V(0);
    if (wr == 0) G8_BAR;
    G8_BAR;
#undef G8_SA
#undef G8_SB
#undef G8_GL
#undef G8_STAGE_A
#undef G8_STAGE_B
#undef G8_LDA
#undef G8_LDB
#undef G8_MMA
#undef G8_WAIT_V
#undef G8_WAIT_L
#undef G8_BAR
#undef G8_SCHED
}

struct PlainSched {
    const bf16_t* A; const bf16_t* Bt; int K, nM, nN, nwg, G, c;
    __device__ __forceinline__ void init(const bf16_t* A_, const bf16_t* Bt_, int M, int N, int K_) { A = A_; Bt = Bt_; K = K_; nM = M / BM; nN = N / BM; nwg = nM * nN; G = gridDim.x; c = blockIdx.x; }
    __device__ __forceinline__ bool next(int i, Unit& u) const {
        const long L = (long)i * G + c; if (L >= nwg) return false;
        int wgid = (int)L; { const int q = nwg / 8, r = nwg % 8, xcd = wgid % 8, off = wgid / 8; wgid = (xcd < r ? xcd * (q + 1) : r * (q + 1) + (xcd - r) * q) + off; }
        const int nig = 8 * nN, gid = wgid / nig, fm = gid * 8, gsz = (nM - fm) < 8 ? (nM - fm) : 8;
        u.pm = fm + ((wgid % nig) % gsz); u.pn = (wgid % nig) / gsz; u.e = 0; return true;
    }
    __device__ __forceinline__ const char* a_base(const Unit& u) const { return (const char*)(A + (size_t)u.pm * BM * K); }
    __device__ __forceinline__ const char* b_base(const Unit& u) const { return (const char*)(Bt + (size_t)u.pn * BM * K); }
    static constexpr bool HAS_BIAS = false, gather = false;
    __device__ __forceinline__ const int* row_addr(const Unit&, int) const { return nullptr; }
    __device__ __forceinline__ int rows_valid(const Unit&) const { return 256; }
    __device__ __forceinline__ const float* bias_src(const Unit&, int) const { return nullptr; }
};
}

struct StageRC { int R0, C0, R1, C1; };
__device__ __forceinline__ StageRC my_stage_rc() { const int t = opaque_tid(); StageRC s; gm::stage_rc(t * 16, s.R0, s.C0); gm::stage_rc(t * 16 + 8192, s.R1, s.C1); return s; }

__device__ __forceinline__ int w1_dst_row(int n) { const int half = n >> 10, cc = n & 1023; return (cc >> 7) * 256 + half * 128 + (cc & 127); }

struct CvtTile { const float* src; bf16_t* dst; int ld, Nsrc, k0, n0, K, mode; };
__device__ __forceinline__ CvtTile cvt_decode(const Params& p, int it) {
    constexpr int PER_L = 2960 + 512 + 256 + 16384 + 8192;
    CvtTile t; const int l = it / PER_L; int r = it % PER_L;
    if (r < 2960) { const int nt = r % 185, kt = r / 185; t.src = p.w_in + (size_t)l * D * NIN; t.ld = NIN; t.Nsrc = NIN; t.k0 = kt * 64; t.n0 = nt * 64; t.dst = p.winT + (size_t)l * NPW * D; t.K = D; t.mode = 2; }
    else if (r < 3472) { r -= 2960; const int n = r / 128; r %= 128; const int nt = r % 16, kt = r / 16;
        t.src = p.w_branch + (size_t)(l * 4 + n) * MW * D; t.ld = D; t.Nsrc = D; t.k0 = kt * 64; t.n0 = nt * 64; t.dst = p.wbT + (size_t)(l * 4 + n) * D * MW; t.K = MW; t.mode = 0; }
    else if (r < 3728) { r -= 3472; const int nt = r % 16, kt = r / 16; t.src = p.w_out + (size_t)l * D * D; t.ld = D; t.Nsrc = D; t.k0 = kt * 64; t.n0 = nt * 64; t.dst = p.woutT + (size_t)l * D * D; t.K = D; t.mode = 0; }
    else if (r < 3728 + 16384) { r -= 3728; const int ee = r / 512; r %= 512; const int nt = r % 32, kt = r / 32;
        t.src = p.moe_w1 + (size_t)(l * NE + ee) * D * 2 * D; t.ld = 2 * D; t.Nsrc = 2 * D; t.k0 = kt * 64; t.n0 = nt * 64; t.dst = p.w1T + (size_t)(l * NE + ee) * 2 * D * D; t.K = D; t.mode = 1; }
    else { r -= 3728 + 16384; const int ee = r / 256; r %= 256; const int nt = r % 16, kt = r / 16;
        t.src = p.moe_w2 + (size_t)(l * NE + ee) * D * D; t.ld = D; t.Nsrc = D; t.k0 = kt * 64; t.n0 = nt * 64; t.dst = p.w2T + (size_t)(l * NE + ee) * D * D; t.K = D; t.mode = 0; }
    return t;
}

__device__ __forceinline__ void ph_convert(const Params& p, LAS unsigned char* lds) {
    LAS float* tile = (LAS float*)lds;
    const int tid = opaque_tid();
    for (int idx = blockIdx.x * NTHREADS + tid; idx < 2 * 8 * 4 * 4096; idx += gridDim.x * NTHREADS) {
        const int i = idx & 63, j = (idx >> 6) & 63, mat = (idx >> 12) & 3, n = (idx >> 14) & 7, ll = idx >> 17, d = mat >> 1;
        p.lruT[idx] = (bf16_t)f2bf(((mat & 1) ? p.lru_wx : p.lru_wa)[(size_t)((ll * 2 + d) * 8 + n) * 4096 + i * 64 + j]);
    }
    constexpr int TOTAL = 2 * (2960 + 512 + 256 + 16384 + 8192);
    for (int idx = blockIdx.x * NTHREADS + tid; idx < 2 * 240 * (D / 8); idx += gridDim.x * NTHREADS) {
        const int ll = idx / (240 * (D / 8)), r = idx % (240 * (D / 8));
        *(u32x4*)(p.winT + ((size_t)ll * NPW + 7696) * D + (size_t)r * 8) = (u32x4){0u, 0u, 0u, 0u};
    }
    for (int g = blockIdx.x; g * 4 < TOTAL; g += gridDim.x) {
        float v[4][8];
        const int rr = tid >> 6, cc = tid & 63;
#pragma unroll
        for (int q = 0; q < 4; ++q) {
            const int it = g * 4 + q;
            const CvtTile t = cvt_decode(p, it < TOTAL ? it : TOTAL - 1);
            const int n = t.n0 + cc; const bool ok = n < t.Nsrc; const int nc = ok ? n : t.Nsrc - 1;
#pragma unroll
            for (int i = 0; i < 8; ++i) { const float x = t.src[(size_t)(t.k0 + rr + i * 8) * t.ld + nc]; v[q][i] = ok ? x : 0.f; }
        }
#pragma unroll
        for (int q = 0; q < 4; ++q)
#pragma unroll
            for (int i = 0; i < 8; ++i) tile[q * 4160 + (rr + i * 8) * 65 + cc] = v[q][i];
        __syncthreads();
#pragma unroll
        for (int q = 0; q < 4; ++q) {
            const int it = g * 4 + q;
            if (it < TOTAL) {
                const CvtTile t = cvt_decode(p, it);
                const int nl = tid >> 3, kg = tid & 7, n = t.n0 + nl;
                float w[8];
#pragma unroll
                for (int j = 0; j < 8; ++j) w[j] = tile[q * 4160 + (kg * 8 + j) * 65 + nl];
                const int drow = t.mode == 1 ? w1_dst_row(n) : t.mode == 2 ? win_dst_row(n) : n;
                if (n < t.Nsrc) *(u32x4*)(t.dst + (size_t)drow * t.K + t.k0 + kg * 8) = pack8(w);
            }
        }
        __syncthreads();
    }
}

__device__ __forceinline__ void ph_mod(const Params& p, LAS unsigned char* lds) {
    LAS float* sc = (LAS float*)lds;
    LAS float* red = sc + 5 * D;
    const int tid = opaque_tid(), wid = tid >> 6, lane = tid & 63;
    if ((int)blockIdx.x >= 192) return;
    for (int i = tid; i < 5 * D; i += NTHREADS) { const int r = i >> 10, k = i & 1023; const float v = r < 4 ? p.c[r * D + k] : p.c_ctx[k]; sc[i] = siluf_(v); }
    __syncthreads();
    for (int it = blockIdx.x; it < 192; it += gridDim.x) {
        const int l = it / 96, n0 = (it % 96) * 64;
        float acc[5] = {0.f, 0.f, 0.f, 0.f, 0.f};
        const float* wp = p.w_mod + (size_t)l * D * (NMOD * D) + n0 + lane;
        for (int k = wid * 128; k < wid * 128 + 128; ++k) {
            const float wv = wp[(size_t)k * (NMOD * D)];
#pragma unroll
            for (int r = 0; r < 5; ++r) acc[r] += sc[r * D + k] * wv;
        }
#pragma unroll
        for (int r = 0; r < 5; ++r) red[(wid * 5 + r) * 64 + lane] = acc[r];
        __syncthreads();
        if (tid < 320) { const int r = tid >> 6, cidx = tid & 63; float s = p.b_mod[l * NMOD * D + n0 + cidx];
#pragma unroll
            for (int w = 0; w < 8; ++w) s += red[(w * 5 + r) * 64 + cidx];
            p.mod[(size_t)(l * 5 + r) * (NMOD * D) + n0 + cidx] = s; }
        __syncthreads();
    }
}

__device__ __forceinline__ void norm_mod_store(const float4 (&v)[4], float rinv, const float* g, const float* scp, const float* shp, bf16_t* dst, int lane) {
#pragma unroll
    for (int i = 0; i < 4; ++i) {
        const int cidx = i * 256 + lane * 4;
        const float4 gv = *(const float4*)(g + cidx), sv = *(const float4*)(scp + cidx), hv = *(const float4*)(shp + cidx);
        const float h0 = v[i].x * rinv * gv.x * (1.f + sv.x) + hv.x, h1 = v[i].y * rinv * gv.y * (1.f + sv.y) + hv.y;
        const float h2 = v[i].z * rinv * gv.z * (1.f + sv.z) + hv.z, h3 = v[i].w * rinv * gv.w * (1.f + sv.w) + hv.w;
        u32x2 o; o[0] = pack2(h0, h1); o[1] = pack2(h2, h3);
        *(u32x2*)(dst + cidx) = o;
    }
}
__device__ __forceinline__ void ph_norm1_first(const Params& p) {
    const int tid = opaque_tid(), wid = tid >> 6, lane = tid & 63;
    for (int tok = blockIdx.x * NWAVES + wid; tok < NTOK; tok += gridDim.x * NWAVES) {
        const float* src = tok < NLAT ? p.x + (size_t)tok * D : p.ctx + (size_t)(tok - NLAT) * D;
        float4 v[4]; float ss = 0.f;
#pragma unroll
        for (int i = 0; i < 4; ++i) { v[i] = *(const float4*)(src + i * 256 + lane * 4); ss += v[i].x * v[i].x + v[i].y * v[i].y + v[i].z * v[i].z + v[i].w * v[i].w; }
        ss = wave_sum(ss);
        const float rinv = rsqrtf(ss * (1.0f / D) + 1e-6f);
        const float* mb = p.mod + (size_t)(0 * 5 + tok_modrow(tok)) * (NMOD * D);
        norm_mod_store(v, rinv, p.norm1_g, mb + 1 * D, mb + 0 * D, p.H + (size_t)tok * D, lane);
#pragma unroll
        for (int i = 0; i < 4; ++i) *(float4*)(p.xl + (size_t)tok * D + i * 256 + lane * 4) = v[i];
    }
}

struct EpiP {
    bf16_t* O; bf16_t* gate;
    __device__ __forceinline__ bool keep(const g8::Unit&) const { return false; }
    __device__ __forceinline__ void operator()(const f32x4 (&acc)[2][2][4][2], const g8::Unit& u, int wr, int wc, int fr, int fq, const LAS float*) const {
        if (u.pn < 31) {
            const int row0 = u.pm * 256 + wr * 64 + fr, col0 = u.pn * 256 + wc * 32 + 8 * fq;
#pragma unroll
            for (int ai = 0; ai < 2; ++ai)
#pragma unroll
                for (int m = 0; m < 4; ++m) {
                    bf16_t* rowp = O + (size_t)(row0 + ai * 128 + m * 16) * NP + col0;
#pragma unroll
                    for (int bj = 0; bj < 2; ++bj) {
                        u32x4 w; w[0] = pack2(acc[ai][bj][m][0][0], acc[ai][bj][m][0][1]); w[1] = pack2(acc[ai][bj][m][0][2], acc[ai][bj][m][0][3]);
                        w[2] = pack2(acc[ai][bj][m][1][0], acc[ai][bj][m][1][1]); w[3] = pack2(acc[ai][bj][m][1][2], acc[ai][bj][m][1][3]);
                        *(u32x4*)(rowp + bj * 128) = w;
                    }
                }
        } else {
            const int g = u.pn - 31;
            bf16_t* gp = gate + ((((size_t)u.pm * 16 + g) * 8 + (wr * 4 + wc)) * 16) * 512 + (fq * 16 + fr) * 8;
#pragma unroll
            for (int ai = 0; ai < 2; ++ai)
#pragma unroll
                for (int m = 0; m < 4; ++m)
#pragma unroll
                    for (int bj = 0; bj < 2; ++bj) {
                        float s[8];
#pragma unroll
                        for (int n = 0; n < 2; ++n)
#pragma unroll
                            for (int j = 0; j < 4; ++j) s[n * 4 + j] = sigmoidf_(acc[ai][bj][m][n][j]);
                        *(u32x4*)(gp + (ai * 8 + m * 2 + bj) * 512) = pack8(s);
                    }
        }
    }
};
__device__ __forceinline__ void ph_g1(const Params& p, int l, LAS unsigned char* lds) {
    g8::PlainSched S; S.init(p.H, p.winT + (size_t)l * NPW * D, NTOK, NPW, D);
    EpiP E; E.O = p.P; E.gate = p.gate;
    g8::gemm_phase(lds, D, S, E);
}

__device__ __forceinline__ void ph_prep(const Params& p, int l, LAS unsigned char* lds) {
    const int tid = opaque_tid(), wid = tid >> 6, lane = tid & 63, fr = lane & 15, fq = lane >> 4;
    LAS float* xs = (LAS float*)lds;
    LAS bf16_t* xb = (LAS bf16_t*)(xs + 64 * 68);
    LAS bf16_t* wt = xb + 64 * 72;
    for (int it = blockIdx.x; it < (NTOK / 64) * 8; it += gridDim.x) {
        const int tile = it >> 3, n = it & 7, tok0 = tile * 64;
        {
            const int tl = tid & 63, cg = tid >> 6, tok = tok0 + tl;
            int t, T, base; tok_info(tok, t, T, base);
            float a[8];
            { const float4 b0 = *(const float4*)(p.lru_conv_b + l * MW + n * 64 + cg * 8), b1 = *(const float4*)(p.lru_conv_b + l * MW + n * 64 + cg * 8 + 4);
              a[0] = b0.x; a[1] = b0.y; a[2] = b0.z; a[3] = b0.w; a[4] = b1.x; a[5] = b1.y; a[6] = b1.z; a[7] = b1.w; }
#pragma unroll
            for (int j = 0; j < 4; ++j) {
                const int tt = t + j - 2;
                const float okf = (tt >= 0 && tt < T) ? 1.0f : 0.0f;
                const int ttc = tt < 0 ? 0 : (tt >= T ? T - 1 : tt);
                const u32x4 u = *(const u32x4*)(p.P + (size_t)(base + ttc) * NP + C_LX + n * 64 + cg * 8);
                const float* w = p.lru_conv_w + (size_t)(l * 4 + j) * MW + n * 64 + cg * 8;
                const float4 wa = *(const float4*)w, wb = *(const float4*)(w + 4);
                const float wv[8] = {wa.x * okf, wa.y * okf, wa.z * okf, wa.w * okf, wb.x * okf, wb.y * okf, wb.z * okf, wb.w * okf};
#pragma unroll
                for (int q = 0; q < 4; ++q) { a[2 * q] += wv[2 * q] * bflo(u[q]); a[2 * q + 1] += wv[2 * q + 1] * bfhi(u[q]); }
            }
            *(LAS f32x4*)(xs + tl * 68 + cg * 8) = (f32x4){a[0], a[1], a[2], a[3]}; *(LAS f32x4*)(xs + tl * 68 + cg * 8 + 4) = (f32x4){a[4], a[5], a[6], a[7]};
            *(LAS u32x4*)(xb + tl * 72 + cg * 8) = pack8(a);
            const bf16_t* wsrc = p.lruT + (size_t)((l * 8 + n) * 4) * 4096;
#pragma unroll
            for (int q = 0; q < 4; ++q) { const int e8 = tid + 512 * q, row = e8 >> 3, c8 = e8 & 7; *(LAS u32x4*)(wt + row * 72 + c8 * 8) = *(const u32x4*)(wsrc + (size_t)e8 * 8); }
        }
        __syncthreads();
        {
            const int jb = wid & 3, tb0 = (wid >> 2) * 2;
            bf16x8 xw[4][2];
#pragma unroll
            for (int m = 0; m < 4; ++m)
#pragma unroll
                for (int ks = 0; ks < 2; ++ks) xw[m][ks] = *(const LAS bf16x8*)(wt + (m * 64 + jb * 16 + fr) * 72 + ks * 32 + fq * 8);
            const int c0 = n * 64 + jb * 16 + 4 * fq;
            float4 bav[2], bxv[2], lsv[2];
#pragma unroll
            for (int d = 0; d < 2; ++d) {
                bav[d] = *(const float4*)(p.lru_ba + (l * 2 + d) * MW + c0); bxv[d] = *(const float4*)(p.lru_bx + (l * 2 + d) * MW + c0);
                const float4 lm = *(const float4*)(p.lru_lambda + (l * 2 + d) * MW + c0);
                lsv[d] = make_float4(8.0f * logsigmoidf_(lm.x), 8.0f * logsigmoidf_(lm.y), 8.0f * logsigmoidf_(lm.z), 8.0f * logsigmoidf_(lm.w));
            }
#pragma unroll
            for (int e = 0; e < 2; ++e) {
                const int tl = (tb0 + e) * 16 + fr, tok = tok0 + tl;
                f32x4 acc[4];
#pragma unroll
                for (int m = 0; m < 4; ++m) acc[m] = (f32x4){0.f, 0.f, 0.f, 0.f};
#pragma unroll
                for (int ks = 0; ks < 2; ++ks) {
                    const bf16x8 y = *(const LAS bf16x8*)(xb + tl * 72 + ks * 32 + fq * 8);
#pragma unroll
                    for (int m = 0; m < 4; ++m) acc[m] = mfma16(xw[m][ks], y, acc[m]);
                }
                const f32x4 xv = *(const LAS f32x4*)(xs + tl * 68 + jb * 16 + 4 * fq);
#pragma unroll
                for (int d = 0; d < 2; ++d) {
                    const float bar_[4] = {bav[d].x, bav[d].y, bav[d].z, bav[d].w}, bxr[4] = {bxv[d].x, bxv[d].y, bxv[d].z, bxv[d].w}, lsr[4] = {lsv[d].x, lsv[d].y, lsv[d].z, lsv[d].w};
                    float av[4], uv[4];
#pragma unroll
                    for (int r = 0; r < 4; ++r) {
                        const float gr = sigmoidf_(acc[d * 2][r] + bar_[r]), gi = sigmoidf_(acc[d * 2 + 1][r] + bxr[r]);
                        const float la = gr * lsr[r];
                        av[r] = __expf(la);
                        uv[r] = xv[r] * gi * sqrtf(fmaxf(-expm1f(2.0f * la), 1e-12f));
                    }
                    *(float4*)(p.prep + (PR_LA + d) * TOKW + (size_t)tok * MW + c0) = make_float4(av[0], av[1], av[2], av[3]);
                    *(float4*)(p.prep + (PR_LU + d) * TOKW + (size_t)tok * MW + c0) = make_float4(uv[0], uv[1], uv[2], uv[3]);
                }
            }
        }
        __syncthreads();
    }
}

__device__ __forceinline__ int chunk_base(int b, int d, int n) {
    if (n < 4) { const int blk = d ? 3 - n : n; return NLAT + b * TC + blk * 64; }
    const int m = n - 4, blk = d ? 63 - m : m; return b * TL + blk * 64;
}

__device__ __forceinline__ void local_gla(const Params& p, int l, int tz, int chain, int n, LAS unsigned char* lds) {
    const int tid = opaque_tid(), wid = tid >> 6, lane = tid & 63, fr = lane & 15, fq = lane >> 4;
    const int b = chain >> 3, h = (chain >> 1) & 3, d = chain & 1;
    const int base = chunk_base(b, d, n);
    const size_t item = (size_t)tz * NITEM + (size_t)chain * NCHUNK + n;
    LAS bf16_t* kraw = (LAS bf16_t*)lds;
    LAS bf16_t* qh = kraw + 64 * 136;
    LAS bf16_t* kh = qh + 64 * 136;
    LAS bf16_t* sc = kh + 64 * 136;
    LAS bf16_t* vT = sc + 64 * 72;
    LAS bf16_t* kT = vT + 128 * 72;
    LAS float* bc = (LAS float*)(kT + 128 * 72);
    const int vcol = tz == 1 ? C_HI : C_RQKV + 1024;
    const int ti = tid >> 3, dg = tid & 7, cA = dg * 8, cB = 64 + dg * 8;
    const int tokI = base + (d ? 63 - ti : ti);
    const bf16_t* pr = p.P + (size_t)tokI * NP;
    float qt[16];
    {
        float kv[16], lfv[16];
        if (tz == 1) {
            float lbv[16];
            {
                const float* lp0 = p.hgrn_lb + (size_t)(0 * 2 + d) * MW + h * 128; const float* lp1 = p.hgrn_lb + (size_t)(1 * 2 + d) * MW + h * 128;
                const float4 a0 = *(const float4*)(lp0 + cA), a1 = *(const float4*)(lp0 + cA + 4), a2 = *(const float4*)(lp0 + cB), a3 = *(const float4*)(lp0 + cB + 4);
                const float4 b0 = *(const float4*)(lp1 + cA), b1 = *(const float4*)(lp1 + cA + 4), b2 = *(const float4*)(lp1 + cB), b3 = *(const float4*)(lp1 + cB + 4);
                const float x0[16] = {a0.x, a0.y, a0.z, a0.w, a1.x, a1.y, a1.z, a1.w, a2.x, a2.y, a2.z, a2.w, a3.x, a3.y, a3.z, a3.w};
                const float x1[16] = {b0.x, b0.y, b0.z, b0.w, b1.x, b1.y, b1.z, b1.w, b2.x, b2.y, b2.z, b2.w, b3.x, b3.y, b3.z, b3.w};
#pragma unroll
                for (int e = 0; e < 16; ++e) lbv[e] = (l == 1) ? fminf(__builtin_amdgcn_rcpf(1.0f + __expf(x0[e] - x1[e])), 1.0f - 1e-4f) : 0.f;
            }
            const u32x4 uqa = *(const u32x4*)(pr + C_HQ + h * 128 + cA), uqb = *(const u32x4*)(pr + C_HQ + h * 128 + cB);
            const u32x4 uza = *(const u32x4*)(pr + C_HF + d * 512 + h * 128 + cA), uzb = *(const u32x4*)(pr + C_HF + d * 512 + h * 128 + cB);
#pragma unroll
            for (int e = 0; e < 16; ++e) {
                const unsigned uq = e < 8 ? uqa[(e & 7) >> 1] : uqb[(e & 7) >> 1], uz = e < 8 ? uza[(e & 7) >> 1] : uzb[(e & 7) >> 1];
                const float qraw = (e & 1) ? bfhi(uq) : bflo(uq), z = (e & 1) ? bfhi(uz) : bflo(uz);
                const float lb = lbv[e];
                const float sg = sigmoidf_(z);
                qt[e] = siluf_(qraw) * 0.08838834764831845f;
                kv[e] = (1.f - lb) * (1.f - sg);
                lfv[e] = __logf(fmaxf(lb + (1.f - lb) * sg, 1e-30f));
            }
        } else {
            const bf16_t* rp = pr + C_RQKV + h * 128;
            const u32x4 q1 = *(const u32x4*)(rp + cA), q2 = *(const u32x4*)(rp + cB), k1 = *(const u32x4*)(rp + 512 + cA), k2 = *(const u32x4*)(rp + 512 + cB);
            const float lng = log1pf(-exp2f(-5.0f - (float)h));
            const bool lat = tokI < NLAT;
            const int t = tokI & (TL - 1);
#pragma unroll
            for (int e = 0; e < 8; ++e) {
                float a1 = (e & 1) ? bfhi(q1[e >> 1]) : bflo(q1[e >> 1]), a2 = (e & 1) ? bfhi(q2[e >> 1]) : bflo(q2[e >> 1]);
                float b1 = (e & 1) ? bfhi(k1[e >> 1]) : bflo(k1[e >> 1]), b2 = (e & 1) ? bfhi(k2[e >> 1]) : bflo(k2[e >> 1]);
                if (lat) {
                    const int pi = cA + e;
                    const float pos = (pi < 32) ? (float)(t >> 6) : (float)(t & 63);
                    const float ang = pos * exp2f(-(float)(pi & 31) * (13.287712379549449f / 32.0f));
                    float sn, cs; sincosf(ang, &sn, &cs);
                    const float n1 = a1 * cs - a2 * sn, n2 = a1 * sn + a2 * cs, m1 = b1 * cs - b2 * sn, m2 = b1 * sn + b2 * cs;
                    a1 = n1; a2 = n2; b1 = m1; b2 = m2;
                }
                qt[e] = a1; qt[8 + e] = a2; kv[e] = b1 * 0.08838834764831845f; kv[8 + e] = b2 * 0.08838834764831845f;
                lfv[e] = lng; lfv[8 + e] = lng;
            }
        }
        *(LAS u32x4*)(kraw + ti * 136 + cA) = pack8(kv); *(LAS u32x4*)(kraw + ti * 136 + cB) = pack8(kv + 8);
        *(LAS f32x4*)(bc + ti * 132 + cA) = (f32x4){lfv[0], lfv[1], lfv[2], lfv[3]}; *(LAS f32x4*)(bc + ti * 132 + cA + 4) = (f32x4){lfv[4], lfv[5], lfv[6], lfv[7]};
        *(LAS f32x4*)(bc + ti * 132 + cB) = (f32x4){lfv[8], lfv[9], lfv[10], lfv[11]}; *(LAS f32x4*)(bc + ti * 132 + cB + 4) = (f32x4){lfv[12], lfv[13], lfv[14], lfv[15]};
        const bf16_t* vp = pr + vcol + h * 128;
        const u32x4 v0 = *(const u32x4*)(vp + cA), v1 = *(const u32x4*)(vp + cB);
#pragma unroll
        for (int e = 0; e < 8; ++e) {
            vT[(cA + e) * 72 + ti] = (bf16_t)((e & 1) ? (v0[e >> 1] >> 16) : (v0[e >> 1] & 0xffffu));
            vT[(cB + e) * 72 + ti] = (bf16_t)((e & 1) ? (v1[e >> 1] >> 16) : (v1[e >> 1] & 0xffffu));
        }
    }
    __syncthreads();
    if (tid < 128) {
        float run = 0.f, lv[64];
#pragma unroll
        for (int i = 0; i < 64; ++i) lv[i] = bc[i * 132 + tid];
#pragma unroll
        for (int i = 0; i < 64; ++i) { run += lv[i]; bc[i * 132 + tid] = run; }
    }
    __syncthreads();
    {
        const int I = ti >> 4;
        float qhat[16];
#pragma unroll
        for (int e = 0; e < 16; ++e) {
            const int ch = e < 8 ? cA + e : cB + e - 8;
            const float bi = bc[ti * 132 + ch], rI = I ? bc[(16 * I - 1) * 132 + ch] : 0.f, bl = bc[63 * 132 + ch];
            qhat[e] = qt[e] * __expf(bi - rI); qt[e] = qt[e] * __expf(bi);
            kT[ch * 72 + ti] = (bf16_t)f2bf(bf2f(kraw[ti * 136 + ch]) * __expf(bl - bi));
        }
        *(LAS u32x4*)(qh + ti * 136 + cA) = pack8(qhat); *(LAS u32x4*)(qh + ti * 136 + cB) = pack8(qhat + 8);
        {
            bf16_t* lqb = p.lq + item * 8192 + (size_t)((ti >> 4) * 8) * 256 + (ti & 15) * 4;
            const u32x4 pa = pack8(qt), pb = pack8(qt + 8);
            u32x2 t0; t0[0] = pa[0]; t0[1] = pa[1]; u32x2 t1; t1[0] = pa[2]; t1[1] = pa[3]; u32x2 t2; t2[0] = pb[0]; t2[1] = pb[1]; u32x2 t3; t3[0] = pb[2]; t3[1] = pb[3];
            *(u32x2*)(lqb + (dg >> 1) * 256 + ((dg & 1) * 2 + 0) * 64) = t0; *(u32x2*)(lqb + (dg >> 1) * 256 + ((dg & 1) * 2 + 1) * 64) = t1;
            *(u32x2*)(lqb + (4 + (dg >> 1)) * 256 + ((dg & 1) * 2 + 0) * 64) = t2; *(u32x2*)(lqb + (4 + (dg >> 1)) * 256 + ((dg & 1) * 2 + 1) * 64) = t3;
        }
    }
    if (tid < 128) p.ld[item * 128 + tid] = __expf(bc[63 * 132 + tid]);
    for (int I = 0; I < 4; ++I) {
        if (ti < 16 * (I + 1)) {
            float kk[16];
#pragma unroll
            for (int e = 0; e < 16; ++e) {
                const int ch = e < 8 ? cA + e : cB + e - 8;
                const float rI = I ? bc[(16 * I - 1) * 132 + ch] : 0.f, bj = bc[ti * 132 + ch];
                kk[e] = bf2f(kraw[ti * 136 + ch]) * __expf(fminf(rI - bj, 80.f));
            }
            *(LAS u32x4*)(kh + ti * 136 + cA) = pack8(kk); *(LAS u32x4*)(kh + ti * 136 + cB) = pack8(kk + 8);
        }
        __syncthreads();
        if (wid < 4) {
            const int J = wid;
            u32x2 outv; outv[0] = 0u; outv[1] = 0u;
            if (J <= I) {
                f32x4 acc = (f32x4){0.f, 0.f, 0.f, 0.f};
#pragma unroll
                for (int ks = 0; ks < 4; ++ks)
                    acc = mfma16(*(const LAS bf16x8*)(kh + (J * 16 + fr) * 136 + ks * 32 + fq * 8), *(const LAS bf16x8*)(qh + (I * 16 + fr) * 136 + ks * 32 + fq * 8), acc);
                const int i = 16 * I + fr, j0 = 16 * J + 4 * fq;
#pragma unroll
                for (int r = 0; r < 4; ++r) if (j0 + r > i) acc[r] = 0.f;
                outv = pack4(acc);
            }
            *(LAS u32x2*)(sc + (I * 16 + fr) * 72 + J * 16 + 4 * fq) = outv;
        }
        __syncthreads();
    }
    {
        bf16x8 xv[2], xk[2];
#pragma unroll
        for (int ks = 0; ks < 2; ++ks) { xv[ks] = *(const LAS bf16x8*)(vT + (wid * 16 + fr) * 72 + ks * 32 + fq * 8); xk[ks] = *(const LAS bf16x8*)(kT + (wid * 16 + fr) * 72 + ks * 32 + fq * 8); }
#pragma unroll
        for (int ib = 0; ib < 4; ++ib) {
            f32x4 acc = (f32x4){0.f, 0.f, 0.f, 0.f};
#pragma unroll
            for (int ks = 0; ks < 2; ++ks) acc = mfma16(xv[ks], *(const LAS bf16x8*)(sc + (ib * 16 + fr) * 72 + ks * 32 + fq * 8), acc);
            *(u32x2*)(p.lo + item * 8192 + ((wid * 4 + ib) * 64 + lane) * 4) = pack4(acc);
        }
#pragma unroll
        for (int dvb = 0; dvb < 8; ++dvb) {
            f32x4 acc = (f32x4){0.f, 0.f, 0.f, 0.f};
#pragma unroll
            for (int ks = 0; ks < 2; ++ks) acc = mfma16(xk[ks], *(const LAS bf16x8*)(vT + (dvb * 16 + fr) * 72 + ks * 32 + fq * 8), acc);
            *(u32x2*)(p.lb + item * 16384 + ((wid * 8 + dvb) * 64 + lane) * 4) = pack4(acc);
        }
    }
    __syncthreads();
}


template <int I> struct SolveRows {
    static __device__ __forceinline__ void run(float (&x)[64], const LAS float* Mf, const LAS float* rs) {
        SolveRows<I - 1>::run(x, Mf, rs);
        float r = x[I] * rs[I];
#pragma unroll
        for (int j4 = 0; j4 < (I + 3) / 4; ++j4) {
            const f32x4 m = *(const LAS f32x4*)(Mf + I * 68 + j4 * 4);
            r -= m[0] * x[j4 * 4] + m[1] * x[j4 * 4 + 1] + m[2] * x[j4 * 4 + 2] + m[3] * x[j4 * 4 + 3];
        }
        asm volatile("" : "+v"(r) :: "memory");
        x[I] = r;
    }
};
template <> struct SolveRows<-1> { static __device__ __forceinline__ void run(float (&)[64], const LAS float*, const LAS float*) {} };

__device__ __forceinline__ void local_gdn(const Params& p, int l, int chain, int n, LAS unsigned char* lds) {
    const int tid = opaque_tid(), wid = tid >> 6, lane = tid & 63, fr = lane & 15, fq = lane >> 4;
    const int b = chain >> 3, h = (chain >> 1) & 3, d = chain & 1;
    const int base = chunk_base(b, d, n);
    const size_t item = (size_t)chain * NCHUNK + n;
    LAS bf16_t* ks_ = (LAS bf16_t*)lds;
    LAS bf16_t* qs = ks_ + 64 * 136;
    LAS bf16_t* att = qs + 64 * 136;
    LAS bf16_t* wT = att + 64 * 72;
    LAS bf16_t* uT = wT + 128 * 72;
    LAS bf16_t* kT = uT + 128 * 72;
    LAS float* Mf = (LAS float*)(kT + 128 * 72);
    LAS float* bcs = Mf + 64 * 68;
    LAS float* bts = bcs + 64;
    LAS float* rse = bts + 64;
    LAS bf16_t* vs = (LAS bf16_t*)(rse + 64);
    const int ti = tid >> 3, d0 = (tid & 7) * 16;
    const int tokI = base + (d ? 63 - ti : ti);
    {
        int t, T, sbase; tok_info(tokI, t, T, sbase);
#pragma unroll
        for (int part = 0; part < 3; ++part) {
            float a[16];
#pragma unroll
            for (int e = 0; e < 16; ++e) a[e] = 0.f;
            const int ccol = part * 512 + h * 128 + d0;
#pragma unroll
            for (int j = 0; j < 4; ++j) {
                const int tt = t + j - 2;
                const float okf = (tt >= 0 && tt < T) ? 1.0f : 0.0f;
                const int ttc = tt < 0 ? 0 : (tt >= T ? T - 1 : tt);
                const bf16_t* xp = p.P + (size_t)(sbase + ttc) * NP + C_GQKV + ccol;
                const u32x4 x0 = *(const u32x4*)xp, x1 = *(const u32x4*)(xp + 8);
                const float* wp = p.gdn_conv_w + (size_t)(l * 4 + j) * 1536 + ccol;
#pragma unroll
                for (int q = 0; q < 4; ++q) {
                    float4 w0 = *(const float4*)(wp + q * 4);
                    w0.x *= okf; w0.y *= okf; w0.z *= okf; w0.w *= okf;
                    const unsigned ua = q < 2 ? x0[2 * q] : x1[2 * q - 4], ub = q < 2 ? x0[2 * q + 1] : x1[2 * q - 3];
                    a[q * 4] += w0.x * bflo(ua); a[q * 4 + 1] += w0.y * bfhi(ua); a[q * 4 + 2] += w0.z * bflo(ub); a[q * 4 + 3] += w0.w * bfhi(ub);
                }
            }
            float ss = 0.f;
#pragma unroll
            for (int e = 0; e < 16; ++e) { a[e] = siluf_(a[e]); ss += a[e] * a[e]; }
            if (part < 2) {
                ss += __shfl_xor(ss, 1); ss += __shfl_xor(ss, 2); ss += __shfl_xor(ss, 4);
                const float scl = rsqrtf(ss + 1e-6f) * (part == 0 ? 0.08838834764831845f : 1.0f);
#pragma unroll
                for (int e = 0; e < 16; ++e) a[e] *= scl;
            }
            LAS bf16_t* dstt = (part == 0 ? qs : part == 1 ? ks_ : vs) + ti * 136 + d0;
            *(LAS u32x4*)dstt = pack8(a); *(LAS u32x4*)(dstt + 8) = pack8(a + 8);
        }
    }
    if (wid == 0) {
        const int tok = base + (d ? 63 - lane : lane);
        const float av = bf2f(p.P[(size_t)tok * NP + C_GA + d * 4 + h]);
        float v = -__expf(p.gdn_a_log[l * 8 + d * 4 + h]) * softplusf_(av + p.gdn_dt_bias[l * 8 + d * 4 + h]);
#pragma unroll
        for (int off = 1; off < 64; off <<= 1) { const float t = __shfl_up(v, off); if (lane >= off) v += t; }
        const float btv = sigmoidf_(bf2f(p.P[(size_t)tok * NP + C_GB + d * 4 + h]));
        bcs[lane] = v; bts[lane] = btv; rse[lane] = btv * __expf(v);
    }
    __syncthreads();
#pragma unroll
    for (int e = 0; e < 2; ++e) {
        const int f = wid * 2 + e, ib = f >> 2, jb = f & 3;
        const int i = 16 * ib + fr, j0 = 16 * jb + 4 * fq;
        f32x4 mk = (f32x4){0.f, 0.f, 0.f, 0.f}, mq = (f32x4){0.f, 0.f, 0.f, 0.f};
        if (jb <= ib) {
#pragma unroll
            for (int ks = 0; ks < 4; ++ks) {
                const bf16x8 xk = *(const LAS bf16x8*)(ks_ + (jb * 16 + fr) * 136 + ks * 32 + fq * 8);
                mk = mfma16(xk, *(const LAS bf16x8*)(ks_ + (ib * 16 + fr) * 136 + ks * 32 + fq * 8), mk);
                mq = mfma16(xk, *(const LAS bf16x8*)(qs + (ib * 16 + fr) * 136 + ks * 32 + fq * 8), mq);
            }
            const float bi = bcs[i], bti = bts[i];
#pragma unroll
            for (int r = 0; r < 4; ++r) {
                const int j = j0 + r;
                const float dec = __expf(j <= i ? bi - bcs[j] : 0.f);
                mk[r] = (j < i) ? bti * mk[r] * dec : 0.f;
                mq[r] = (j <= i) ? mq[r] * dec : 0.f;
            }
        }
        *(LAS f32x4*)(Mf + i * 68 + j0) = mk;
        *(LAS u32x2*)(att + i * 72 + j0) = pack4(mq);
    }
    __syncthreads();
    {
        const float sc_ = __expf(bcs[63] - bcs[ti]);
#pragma unroll
        for (int e = 0; e < 16; ++e) kT[(d0 + e) * 72 + ti] = (bf16_t)f2bf(bf2f(ks_[ti * 136 + d0 + e]) * sc_);
    }
    if (tid < 256) {
        const int cidx = tid & 127;
        const bool isw = tid >= 128;
        const LAS bf16_t* srcp = (isw ? ks_ : vs) + cidx;
        float x[64];
#pragma unroll
        for (int i = 0; i < 64; ++i) x[i] = bf2f(srcp[i * 136]);
        {
            unsigned mb = (unsigned)(size_t)Mf, rb = (unsigned)(size_t)(isw ? rse : bts);
            asm volatile("" : "+v"(mb), "+v"(rb));
            SolveRows<63>::run(x, (const LAS float*)(size_t)mb, (const LAS float*)(size_t)rb);
        }
        if (isw) {
#pragma unroll
            for (int i = 0; i < 64; ++i) x[i] = -x[i];
        }
        LAS bf16_t* dst = (isw ? wT : uT) + cidx * 72;
#pragma unroll
        for (int q = 0; q < 8; ++q) *(LAS u32x4*)(dst + q * 8) = pack8(x + q * 8);
    }
    if (tid < 128) p.ld[item * 128 + tid] = __expf(bcs[63]);
    __syncthreads();
    {
        const int tid = opaque_tid(), wid = tid >> 6, lane = tid & 63, fr = lane & 15, fq = lane >> 4;
        bf16x8 xw[2], xu[2], xk[2];
#pragma unroll
        for (int ks = 0; ks < 2; ++ks) {
            xw[ks] = *(const LAS bf16x8*)(wT + (wid * 16 + fr) * 72 + ks * 32 + fq * 8);
            xu[ks] = *(const LAS bf16x8*)(uT + (wid * 16 + fr) * 72 + ks * 32 + fq * 8);
            xk[ks] = *(const LAS bf16x8*)(kT + (wid * 16 + fr) * 72 + ks * 32 + fq * 8);
        }
#pragma unroll
        for (int ib = 0; ib < 4; ++ib) {
            const int i = ib * 16 + fr;
            const u32x2 qr = *(const LAS u32x2*)(qs + i * 136 + wid * 16 + 4 * fq);
            const float eb = __expf(bcs[i]);
            f32x4 aq = (f32x4){bflo(qr[0]) * eb, bfhi(qr[0]) * eb, bflo(qr[1]) * eb, bfhi(qr[1]) * eb};
            f32x4 ao = (f32x4){0.f, 0.f, 0.f, 0.f};
#pragma unroll
            for (int ks = 0; ks < 2; ++ks) {
                const bf16x8 ya = *(const LAS bf16x8*)(att + i * 72 + ks * 32 + fq * 8);
                aq = mfma16(xw[ks], ya, aq); ao = mfma16(xu[ks], ya, ao);
            }
            *(u32x2*)(p.lq + item * 8192 + ((ib * 8 + wid) * 64 + lane) * 4) = pack4(aq);
            *(u32x2*)(p.lo + item * 8192 + ((wid * 4 + ib) * 64 + lane) * 4) = pack4(ao);
        }
#pragma unroll
        for (int db = 0; db < 8; ++db) {
            f32x4 aa = (f32x4){0.f, 0.f, 0.f, 0.f}, ab = (f32x4){0.f, 0.f, 0.f, 0.f};
#pragma unroll
            for (int ks = 0; ks < 2; ++ks) {
                aa = mfma16(xw[ks], *(const LAS bf16x8*)(kT + (db * 16 + fr) * 72 + ks * 32 + fq * 8), aa);
                ab = mfma16(xk[ks], *(const LAS bf16x8*)(uT + (db * 16 + fr) * 72 + ks * 32 + fq * 8), ab);
            }
            *(u32x2*)(p.la + item * 16384 + ((db * 8 + wid) * 64 + lane) * 4) = pack4(aa);
            *(u32x2*)(p.lb + item * 16384 + ((wid * 8 + db) * 64 + lane) * 4) = pack4(ab);
        }
    }
    __syncthreads();
}

__device__ __forceinline__ void ph_local(const Params& p, int l, LAS unsigned char* lds) {
    for (int it = blockIdx.x; it < 3 * NITEM; it += gridDim.x) {
        const int tz = it % 3, ci = it / 3, chain = ci / NCHUNK, n = ci % NCHUNK;
        if (tz == 0) local_gdn(p, l, chain, n, lds); else local_gla(p, l, tz, chain, n, lds);
    }
}

__device__ __forceinline__ void seq_matrix(const Params& p, int tz, int chain, int half, LAS unsigned char* lds) {
    const int tid = opaque_tid(), wid = tid >> 6, lane = tid & 63, fr = lane & 15, fq = lane >> 4;
    const int b = chain >> 3, h = (chain >> 1) & 3, d = chain & 1;
    LAS bf16_t* ST = (LAS bf16_t*)lds;
    float* Op = p.O + (size_t)((tz == 0 ? 0 : tz == 1 ? 1 : 3) * 2 + d) * TOKW;
    f32x4 S[4];
#pragma unroll
    for (int q = 0; q < 4; ++q) S[q] = (f32x4){0.f, 0.f, 0.f, 0.f};
    const int ib = wid >> 1, dv2 = (wid & 1) * 2;
    struct Ops { u32x2 yq[8], xa[8], oin[2], bin[4]; f32x4 dec; };
    auto load_ops = [&](int n, Ops& o) {
        const size_t item = (size_t)tz * NITEM + (size_t)chain * NCHUNK + n;
        const bf16_t* lqp = p.lq + item * 8192 + (size_t)(ib * 8) * 256 + lane * 4;
#pragma unroll
        for (int q = 0; q < 8; ++q) o.yq[q] = *(const u32x2*)(lqp + q * 256);
        if (tz == 0) {
            const bf16_t* lap = p.la + ((size_t)chain * NCHUNK + n) * 16384 + (size_t)(wid * 8) * 256 + lane * 4;
#pragma unroll
            for (int q = 0; q < 8; ++q) o.xa[q] = *(const u32x2*)(lap + q * 256);
        }
#pragma unroll
        for (int e2 = 0; e2 < 2; ++e2)
            o.oin[e2] = *(const u32x2*)(p.lo + item * 8192 + (((half * 4 + dv2 + (fq >> 1)) * 4 + ib) * 64 + fr + 16 * (2 * (fq & 1) + e2)) * 4);
#pragma unroll
        for (int q = 0; q < 4; ++q) o.bin[q] = *(const u32x2*)(p.lb + item * 16384 + ((wid * 8 + half * 4 + q) * 64 + lane) * 4);
        o.dec = *(const f32x4*)(p.ld + item * 128 + wid * 16 + 4 * fq);
    };
    Ops s0, s1, s2; load_ops(0, s0); load_ops(1, s1);
    auto step = [&](int n, Ops& cur, Ops& fill) {
        load_ops(n + 2 < NCHUNK ? n + 2 : n, fill);
        LAS bf16_t* st = ST + (n & 1) * 64 * 136;
#pragma unroll
        for (int q = 0; q < 4; ++q) *(LAS u32x2*)(st + (q * 16 + fr) * 136 + 32 * (wid >> 1) + 8 * fq + 4 * (wid & 1)) = pack4(S[q]);
        __syncthreads();
        const int base = chunk_base(b, d, n);
        const int tok = base + (d ? 63 - (ib * 16 + fr) : ib * 16 + fr);
        {
            f32x4 ao[2];
#pragma unroll
            for (int e2 = 0; e2 < 2; ++e2) {
                f32x4 acc = (f32x4){bflo(cur.oin[e2][0]), bfhi(cur.oin[e2][0]), bflo(cur.oin[e2][1]), bfhi(cur.oin[e2][1])};
                const int prow = dv2 * 16 + 8 * (fr >> 2) + 4 * e2 + (fr & 3);
#pragma unroll
                for (int ks = 0; ks < 4; ++ks) {
                    u32x4 t; t[0] = cur.yq[2 * ks][0]; t[1] = cur.yq[2 * ks][1]; t[2] = cur.yq[2 * ks + 1][0]; t[3] = cur.yq[2 * ks + 1][1];
                    acc = mfma16(*(const LAS bf16x8*)(st + prow * 136 + ks * 32 + fq * 8), __builtin_bit_cast(bf16x8, t), acc);
                }
                ao[e2] = acc;
            }
            float* op = Op + (size_t)tok * MW + h * 128 + half * 64 + dv2 * 16 + 8 * fq;
            *(f32x4*)op = ao[0]; *(f32x4*)(op + 4) = ao[1];
        }
#pragma unroll
        for (int q = 0; q < 4; ++q) {
            f32x4 acc = (f32x4){cur.dec[0] * S[q][0] + bflo(cur.bin[q][0]), cur.dec[1] * S[q][1] + bfhi(cur.bin[q][0]), cur.dec[2] * S[q][2] + bflo(cur.bin[q][1]), cur.dec[3] * S[q][3] + bfhi(cur.bin[q][1])};
            if (tz == 0) {
#pragma unroll
                for (int ks = 0; ks < 4; ++ks) {
                    u32x4 t; t[0] = cur.xa[2 * ks][0]; t[1] = cur.xa[2 * ks][1]; t[2] = cur.xa[2 * ks + 1][0]; t[3] = cur.xa[2 * ks + 1][1];
                    acc = mfma16(__builtin_bit_cast(bf16x8, t), *(const LAS bf16x8*)(st + (q * 16 + fr) * 136 + ks * 32 + fq * 8), acc);
                }
            }
            S[q] = acc;
        }
    };
    for (int n = 0; n < NCHUNK; n += 3) {
        step(n, s0, s2);
        if (n + 1 < NCHUNK) step(n + 1, s1, s0);
        if (n + 2 < NCHUNK) step(n + 2, s2, s1);
    }
    __syncthreads();
}

__device__ __forceinline__ void seq_lru(const Params& p, int b, int d, int cg, LAS unsigned char* lds) {
    const int tid = opaque_tid(), seg = tid >> 6, ch = cg * 64 + (tid & 63);
    LAS float* sP = (LAS float*)lds;
    LAS float* sL = sP + 512;
    const float* A = p.prep + (size_t)(PR_LA + d) * TOKW + ch; const float* U = p.prep + (size_t)(PR_LU + d) * TOKW + ch;
    float* Op = p.O + (size_t)(2 * 2 + d) * TOKW + ch;
    constexpr int SEG = (TC + TL) / 8;
    auto tok_of = [&](int pos) { return pos < TC ? NLAT + b * TC + (d ? TC - 1 - pos : pos) : b * TL + (d ? TL - 1 - (pos - TC) : pos - TC); };
    float P = 1.f, L = 0.f;
    for (int i0 = 0; i0 < SEG; i0 += 32) {
        float av[32], uv[32];
#pragma unroll
        for (int q = 0; q < 32; ++q) { const size_t o = (size_t)tok_of(seg * SEG + i0 + q) * MW; av[q] = A[o]; uv[q] = U[o]; }
#pragma unroll
        for (int q = 0; q < 32; ++q) { L = av[q] * L + uv[q]; P *= av[q]; }
    }
    sP[tid] = P; sL[tid] = L;
    __syncthreads();
    float hst = 0.f;
    for (int s = 0; s < seg; ++s) hst = sP[s * 64 + (tid & 63)] * hst + sL[s * 64 + (tid & 63)];
    for (int i0 = 0; i0 < SEG; i0 += 32) {
        float av[32], uv[32];
#pragma unroll
        for (int q = 0; q < 32; ++q) { const size_t o = (size_t)tok_of(seg * SEG + i0 + q) * MW; av[q] = A[o]; uv[q] = U[o]; }
#pragma unroll
        for (int q = 0; q < 32; ++q) { hst = av[q] * hst + uv[q]; Op[(size_t)tok_of(seg * SEG + i0 + q) * MW] = hst; }
    }
    __syncthreads();
}

__device__ __forceinline__ void ph_seq(const Params& p, LAS unsigned char* lds) {
    for (int it = blockIdx.x; it < 256; it += gridDim.x) {
        if (it < 192) { const int tz = it >> 6, r = it & 63; seq_matrix(p, tz, r >> 1, r & 1, lds); }
        else { const int r = it - 192; seq_lru(p, r >> 4, (r >> 3) & 1, r & 7, lds); }
    }
}

__device__ __forceinline__ void ph_merge(const Params& p, int l, int M) {
    const int tid = opaque_tid(), wid = tid >> 6, lane = tid & 63;
    const float* Ob = opaque_sptr(p.O); const bf16_t* Pb = opaque_sptr(p.P); bf16_t* Yb = opaque_sptr(p.Y);
    float2 gn[3];
#pragma unroll
    for (int m = 0; m < 3; ++m) gn[m] = *(const float2*)((m == 0 ? p.gdn_norm_g : m == 1 ? p.hgrn_norm_g : p.ret_norm_g) + l * 128 + lane * 2);
    for (int tok = blockIdx.x * NWAVES + wid; tok < M; tok += gridDim.x * NWAVES) {
        f32x2 o0[16], o1[16]; unsigned gz[16];
#pragma unroll
        for (int r = 0; r < 16; ++r) {
            const int m = r >> 2, head = r & 3, cidx = head * 128 + lane * 2;
            const size_t o = (size_t)tok * MW + cidx;
            o0[r] = *(const f32x2*)(Ob + (size_t)(m * 2) * TOKW + o); o1[r] = *(const f32x2*)(Ob + (size_t)(m * 2 + 1) * TOKW + o);
            const int zc = m == 0 ? C_GZ : m == 1 ? C_HG : m == 2 ? C_LY : C_RG;
            gz[r] = *(const unsigned*)(Pb + (size_t)tok * NP + zc + cidx);
        }
        float a0[16], a1[16], ss[16];
#pragma unroll
        for (int r = 0; r < 16; ++r) { a0[r] = o0[r][0] + o1[r][0]; a1[r] = o0[r][1] + o1[r][1]; ss[r] = a0[r] * a0[r] + a1[r] * a1[r]; }
#pragma unroll
        for (int msk = 32; msk >= 1; msk >>= 1)
#pragma unroll
            for (int r = 0; r < 16; ++r) if ((r >> 2) != 2) ss[r] += __shfl_xor(ss[r], msk);
#pragma unroll
        for (int r = 0; r < 16; ++r) {
            const int m = r >> 2, head = r & 3, cidx = head * 128 + lane * 2;
            float y0, y1; int nbr;
            if (m == 2) { y0 = a0[r] * gelu_tanhf_(bflo(gz[r])); y1 = a1[r] * gelu_tanhf_(bfhi(gz[r])); nbr = 2; }
            else {
                const float rinv = rsqrtf(ss[r] * (1.0f / 128.0f) + 1e-6f);
                const float2 g = gn[m == 3 ? 2 : m];
                y0 = a0[r] * rinv * g.x * siluf_(bflo(gz[r])); y1 = a1[r] * rinv * g.y * siluf_(bfhi(gz[r])); nbr = m == 3 ? 3 : m;
            }
            *(unsigned*)(Yb + (size_t)nbr * TOKW + (size_t)tok * MW + cidx) = pack2(y0, y1);
        }
    }
}

struct G2Sched {
    const bf16_t* Y; const bf16_t* Wb; int ntiles, G, c;
    static constexpr bool HAS_BIAS = false, gather = false;
    __device__ __forceinline__ bool next(int i, g8::Unit& u) const {
        const int tile = (i >> 2) * G + c; if (tile >= ntiles) return false;
        u.pm = tile >> 2; u.pn = tile & 3; u.e = i & 3; return true;
    }
    __device__ __forceinline__ const char* a_base(const g8::Unit& u) const { return (const char*)(Y + (size_t)u.e * TOKW + (size_t)u.pm * 256 * MW); }
    __device__ __forceinline__ const char* b_base(const g8::Unit& u) const { return (const char*)(Wb + (size_t)u.e * D * MW + (size_t)u.pn * 256 * MW); }
    __device__ __forceinline__ const int* row_addr(const g8::Unit&, int) const { return nullptr; }
    __device__ __forceinline__ int rows_valid(const g8::Unit&) const { return 256; }
    __device__ __forceinline__ const float* bias_src(const g8::Unit&, int) const { return nullptr; }
};
struct EpiMix {
    const bf16_t* gate; bf16_t* O;
    __device__ __forceinline__ bool keep(const g8::Unit& u) const { return u.e < 3; }
    __device__ __forceinline__ void operator()(f32x4 (&acc)[2][2][4][2], const g8::Unit& u, int wr, int wc, int fr, int fq, const LAS float*) const {
        const int row0 = u.pm * 256 + wr * 64 + fr, col0 = u.pn * 256 + wc * 32 + 8 * fq;
        const bool lastseg = u.e == 3;
        const bf16_t* gc = gate + ((((size_t)u.pm * 16 + u.e * 4 + u.pn) * 8 + (wr * 4 + wc)) * 16) * 512 + (fq * 16 + fr) * 8;
        const bf16_t* gn = gc + (lastseg ? 0 : (size_t)4 * 8 * 16 * 512);
#pragma unroll
        for (int ah = 0; ah < 4; ++ah) {
            const int ai = ah >> 1;
            u32x4 c[4], x[4];
#pragma unroll
            for (int q = 0; q < 4; ++q) { c[q] = *(const u32x4*)(gc + (ah * 4 + q) * 512); x[q] = *(const u32x4*)(gn + (ah * 4 + q) * 512); }
#pragma unroll
            for (int q = 0; q < 4; ++q) {
                const int m = (ah & 1) * 2 + (q >> 1), bj = q & 1;
#pragma unroll
                for (int w = 0; w < 4; ++w) {
                    const float c0 = bflo(c[q][w]), c1 = bfhi(c[q][w]);
                    const float s0 = lastseg ? c0 : c0 * __builtin_amdgcn_rcpf(bflo(x[q][w])), s1 = lastseg ? c1 : c1 * __builtin_amdgcn_rcpf(bfhi(x[q][w]));
                    acc[ai][bj][m][w >> 1][(w & 1) * 2] *= s0; acc[ai][bj][m][w >> 1][(w & 1) * 2 + 1] *= s1;
                }
            }
        }
        if (lastseg) {
#pragma unroll
            for (int ai = 0; ai < 2; ++ai)
#pragma unroll
                for (int m = 0; m < 4; ++m)
#pragma unroll
                    for (int bj = 0; bj < 2; ++bj) {
                        u32x4 w; w[0] = pack2(acc[ai][bj][m][0][0], acc[ai][bj][m][0][1]); w[1] = pack2(acc[ai][bj][m][0][2], acc[ai][bj][m][0][3]);
                        w[2] = pack2(acc[ai][bj][m][1][0], acc[ai][bj][m][1][1]); w[3] = pack2(acc[ai][bj][m][1][2], acc[ai][bj][m][1][3]);
                        *(u32x4*)(O + (size_t)(row0 + ai * 128 + m * 16) * D + col0 + bj * 128) = w;
                    }
        }
    }
};
__device__ __forceinline__ void ph_g2(const Params& p, int l, int M, LAS unsigned char* lds) {
    G2Sched S; S.Y = p.Y; S.Wb = p.wbT + (size_t)l * 4 * D * MW; S.ntiles = (M / 256) * 4; S.G = gridDim.x; S.c = blockIdx.x;
    EpiMix E; E.gate = p.gate; E.O = p.mix;
    g8::gemm_phase(lds, MW, S, E);
}

template <bool DRY> struct EpiRes {
    float* xl; float* xo; const float* mod;
    __device__ __forceinline__ bool keep(const g8::Unit&) const { return false; }
    __device__ __forceinline__ void operator()(const f32x4 (&acc)[2][2][4][2], const g8::Unit& u, int wr, int wc, int fr, int fq, const LAS float*) const {
        const int row0 = u.pm * 256 + wr * 64 + fr, col0 = u.pn * 256 + wc * 32 + 8 * fq;
#pragma unroll
        for (int ai = 0; ai < 2; ++ai)
#pragma unroll
            for (int m = 0; m < 4; ++m) {
                const int row = row0 + ai * 128 + m * 16;
                const float* gtp = mod + (size_t)tok_modrow(row) * (NMOD * D) + 2 * D + col0;
#pragma unroll
                for (int bj = 0; bj < 2; ++bj)
#pragma unroll
                    for (int n = 0; n < 2; ++n) {
                        const float4 gt = *(const float4*)(gtp + bj * 128 + n * 4);
                        const size_t o = (size_t)row * D + col0 + bj * 128 + n * 4;
                        float4 xv = *(const float4*)(xl + o);
                        xv.x += gt.x * acc[ai][bj][m][n][0]; xv.y += gt.y * acc[ai][bj][m][n][1]; xv.z += gt.z * acc[ai][bj][m][n][2]; xv.w += gt.w * acc[ai][bj][m][n][3];
                        *(float4*)(xo + o) = xv;
                    }
            }
    }
};
template <bool DRY = false> __device__ __forceinline__ void ph_g3(const Params& p, int l, int M, LAS unsigned char* lds) {
    g8::PlainSched S; S.init(p.mix, p.woutT + (size_t)l * D * D, M, D, D);
    EpiRes<DRY> E; E.xl = p.xl; E.xo = DRY ? p.prep : p.xl; E.mod = p.mod + (size_t)(l * 5) * (NMOD * D);
    g8::gemm_phase(lds, D, S, E);
}

template <bool DRY = false> __device__ __forceinline__ void ph_route(const Params& p, int l, int M, LAS unsigned char* lds) {
    int* const r_cnt = DRY ? p.cnt + 64 : p.cnt; int* const r_list = DRY ? (int*)p.act : p.list; int* const r_ts = DRY ? (int*)p.yp : p.tokslot; float* const r_tw = DRY ? (float*)p.yp + (size_t)NTOK * 4 : p.topw;
    LAS float* fs = (LAS float*)lds;
    LAS float* lg = fs + 32 * 1028;
    LAS int* lcnt = (LAS int*)(lg + 32 * 36);
    LAS int* lbase = lcnt + 32;
    const int tid = opaque_tid(), wid = tid >> 6, lane = tid & 63;
    const float* rw = p.router_w + (size_t)l * D * NE;
    for (int it = blockIdx.x; it < M / 32; it += gridDim.x) {
        const int tok0 = it * 32;
        {
            float4 v[4][4]; float ss[4];
#pragma unroll
            for (int q = 0; q < 4; ++q) {
                const float* src = p.xl + (size_t)(tok0 + wid * 4 + q) * D;
#pragma unroll
                for (int i = 0; i < 4; ++i) v[q][i] = *(const float4*)(src + i * 256 + lane * 4);
            }
#pragma unroll
            for (int q = 0; q < 4; ++q) {
                float s = 0.f;
#pragma unroll
                for (int i = 0; i < 4; ++i) s += v[q][i].x * v[q][i].x + v[q][i].y * v[q][i].y + v[q][i].z * v[q][i].z + v[q][i].w * v[q][i].w;
                ss[q] = s;
            }
#pragma unroll
            for (int m = 32; m >= 1; m >>= 1)
#pragma unroll
                for (int q = 0; q < 4; ++q) ss[q] += __shfl_xor(ss[q], m);
            const float* mb = p.mod + (size_t)(l * 5 + tok_modrow(tok0)) * (NMOD * D);
#pragma unroll
            for (int i = 0; i < 4; ++i) {
                const int cidx = i * 256 + lane * 4;
                const float4 gv = *(const float4*)(p.norm2_g + l * D + cidx), sv = *(const float4*)(mb + 4 * D + cidx), hv = *(const float4*)(mb + 3 * D + cidx);
#pragma unroll
                for (int q = 0; q < 4; ++q) {
                    const int tl = wid * 4 + q, tok = tok0 + tl;
                    const float rinv = rsqrtf(ss[q] * (1.0f / D) + 1e-6f);
                    const float h0 = v[q][i].x * rinv * gv.x * (1.f + sv.x) + hv.x, h1 = v[q][i].y * rinv * gv.y * (1.f + sv.y) + hv.y;
                    const float h2 = v[q][i].z * rinv * gv.z * (1.f + sv.z) + hv.z, h3 = v[q][i].w * rinv * gv.w * (1.f + sv.w) + hv.w;
                    u32x2 o; o[0] = pack2(h0, h1); o[1] = pack2(h2, h3);
                    *(u32x2*)(p.F + (size_t)tok * D + cidx) = o;
                    *(LAS f32x4*)(fs + tl * 1028 + cidx) = (f32x4){h0, h1, h2, h3};
                }
            }
        }
        __syncthreads();
        {
            typedef float f32x16 __attribute__((ext_vector_type(16)));
            f32x16 acc;
#pragma unroll
            for (int r = 0; r < 16; ++r) acc[r] = 0.f;
            const int tk = lane & 31, hh = lane >> 5;
            const LAS float* ap = fs + tk * 1028 + wid * 128 + 4 * hh;
            const float* bp = rw + (size_t)(wid * 128 + 4 * hh) * NE + tk;
#pragma unroll 4
            for (int kk = 0; kk < 16; ++kk) {
                const f32x4 a4 = *(const LAS f32x4*)(ap + kk * 8);
                const float b0 = bp[(kk * 8 + 0) * NE], b1 = bp[(kk * 8 + 1) * NE], b2 = bp[(kk * 8 + 2) * NE], b3 = bp[(kk * 8 + 3) * NE];
                acc = __builtin_amdgcn_mfma_f32_32x32x2f32(a4[0], b0, acc, 0, 0, 0);
                acc = __builtin_amdgcn_mfma_f32_32x32x2f32(a4[1], b1, acc, 0, 0, 0);
                acc = __builtin_amdgcn_mfma_f32_32x32x2f32(a4[2], b2, acc, 0, 0, 0);
                acc = __builtin_amdgcn_mfma_f32_32x32x2f32(a4[3], b3, acc, 0, 0, 0);
            }
            __syncthreads();
            LAS float* red = fs;
#pragma unroll
            for (int r = 0; r < 16; ++r) red[(wid * 32 + (r & 3) + 8 * (r >> 2) + 4 * hh) * 33 + tk] = acc[r];
            __syncthreads();
            const int t2 = tid >> 4, e0 = (tid & 15) * 2;
            float s0 = p.router_b[l * NE + e0], s1 = p.router_b[l * NE + e0 + 1];
#pragma unroll
            for (int w = 0; w < 8; ++w) { s0 += red[(w * 32 + t2) * 33 + e0]; s1 += red[(w * 32 + t2) * 33 + e0 + 1]; }
            lg[t2 * 36 + e0] = s0; lg[t2 * 36 + e0 + 1] = s1;
            if (tid < 32) lcnt[tid] = 0;
        }
        __syncthreads();
        float vals[4]; int idxs[4], rank[4];
        if (tid < 32) {
            float lv[32];
#pragma unroll
            for (int q = 0; q < 8; ++q) { const f32x4 t = *(const LAS f32x4*)(lg + tid * 36 + q * 4); lv[q * 4] = t[0]; lv[q * 4 + 1] = t[1]; lv[q * 4 + 2] = t[2]; lv[q * 4 + 3] = t[3]; }
#pragma unroll
            for (int k = 0; k < 4; ++k) {
                float best = lv[0]; int bi = 0;
#pragma unroll
                for (int ee = 1; ee < NE; ++ee) { const bool gt = lv[ee] > best; best = gt ? lv[ee] : best; bi = gt ? ee : bi; }
#pragma unroll
                for (int ee = 0; ee < NE; ++ee) lv[ee] = (ee == bi) ? -3.0e38f : lv[ee];
                vals[k] = best; idxs[k] = bi;
                rank[k] = atomicAdd((int*)(lcnt + bi), 1);
            }
        }
        __syncthreads();
        if (tid < 32) { const int c = lcnt[tid]; lbase[tid] = c ? atomicAdd(r_cnt + l * NE + tid, c) : 0; }
        __syncthreads();
        if (tid < 32) {
            const int tok = tok0 + tid;
            const float mx = vals[0];
            float ex[4], sum = 0.f;
#pragma unroll
            for (int k = 0; k < 4; ++k) { ex[k] = __expf(vals[k] - mx); sum += ex[k]; }
            const float inv = 1.0f / sum;
#pragma unroll
            for (int k = 0; k < 4; ++k) {
                const int ee = idxs[k];
                const int slot = lbase[ee] + rank[k];
                r_list[(size_t)ee * NTOK + slot] = tok;
                r_ts[(size_t)tok * 4 + k] = (ee << 16) | slot;
                r_tw[(size_t)tok * 4 + k] = ex[k] * inv;
            }
        }
        __syncthreads();
    }
}

__device__ __forceinline__ void build_expert_tables(const Params& p, int l, LAS int* ts, LAS int* cn, LAS int* te) {
    const int tid = opaque_tid();
    if (tid < 64) {
        const int c = tid < NE ? p.cnt[l * NE + tid] : 0;
        const int nt = (c + 255) >> 8;
        int v = nt;
#pragma unroll
        for (int off = 1; off < 32; off <<= 1) { const int t = __shfl_up(v, off); if (tid >= off) v += t; }
        if (tid < NE) { cn[tid] = c; ts[tid] = v - nt; if (tid == NE - 1) ts[NE] = v; }
        if (te && tid < NE) for (int q = 0; q < nt; ++q) te[v - nt + q] = tid;
    }
    __syncthreads();
}

struct MoeSched {
    const LAS int* ts; const LAS int* cn; const LAS int* te; const int* list; const bf16_t* A; const bf16_t* Bt; const float* bias; int K, npn, nunits, G, c, nrowsB, nbias; bool gather;
    static constexpr bool HAS_BIAS = true;
    __device__ __forceinline__ bool next(int i, g8::Unit& u) const {
        const long L = (long)i * G + c; if (L >= nunits) return false;
        u.pm = (int)(L / npn); u.pn = (int)(L % npn); u.e = te[u.pm]; return true;
    }
    __device__ __forceinline__ const char* a_base(const g8::Unit& u) const { return (const char*)(gather ? A : A + (size_t)u.pm * 256 * K); }
    __device__ __forceinline__ const char* b_base(const g8::Unit& u) const { return (const char*)(Bt + ((size_t)u.e * nrowsB + (size_t)u.pn * 256) * K); }
    __device__ __forceinline__ const int* row_addr(const g8::Unit& u, int R) const {
        const int cnt = cn[u.e], sl = (u.pm - ts[u.e]) * 256 + R;
        return list + (size_t)u.e * NTOK + (sl < cnt ? sl : 0);
    }
    __device__ __forceinline__ int rows_valid(const g8::Unit& u) const { return cn[u.e] - (u.pm - ts[u.e]) * 256; }
    __device__ __forceinline__ const float* bias_src(const g8::Unit& u, int lane) const {
        if (nbias == 2) return bias + (size_t)u.e * 2 * D + (lane < 32 ? u.pn * 128 + lane * 4 : D + u.pn * 128 + (lane - 32) * 4);
        return bias + (size_t)u.e * D + u.pn * 256 + lane * 4;
    }
};
struct EpiAct {
    bf16_t* O;
    __device__ __forceinline__ bool keep(const g8::Unit&) const { return false; }
    __device__ __forceinline__ void operator()(const f32x4 (&acc)[2][2][4][2], const g8::Unit& u, int wr, int wc, int fr, int fq, const LAS float* bias) const {
        const int row0 = u.pm * 256 + wr * 64 + fr, col0 = u.pn * 128 + wc * 32 + 8 * fq;
        const LAS float* bb = bias + wc * 32 + 8 * fq;
        const f32x4 g0 = *(const LAS f32x4*)bb, g1 = *(const LAS f32x4*)(bb + 4), l0 = *(const LAS f32x4*)(bb + 128), l1 = *(const LAS f32x4*)(bb + 132);
        const float bg[8] = {g0[0], g0[1], g0[2], g0[3], g1[0], g1[1], g1[2], g1[3]}, bl[8] = {l0[0], l0[1], l0[2], l0[3], l1[0], l1[1], l1[2], l1[3]};
#pragma unroll
        for (int ai = 0; ai < 2; ++ai)
#pragma unroll
            for (int m = 0; m < 4; ++m) {
                float o[8];
#pragma unroll
                for (int n = 0; n < 2; ++n)
#pragma unroll
                    for (int j = 0; j < 4; ++j) {
                        const float glu = fminf(acc[ai][0][m][n][j] + bg[n * 4 + j], 7.0f);
                        const float lin = fminf(fmaxf(acc[ai][1][m][n][j] + bl[n * 4 + j], -7.0f), 7.0f);
                        o[n * 4 + j] = glu * sigmoidf_(1.702f * glu) * (lin + 1.0f);
                    }
                *(u32x4*)(O + (size_t)(row0 + ai * 128 + m * 16) * D + col0) = pack8(o);
            }
    }
};
__device__ __forceinline__ void ph_g4(const Params& p, int l, LAS unsigned char* lds) {
    LAS int* ts = (LAS int*)(lds + g8::STAGE_BYTES); LAS int* cn = ts + 40; LAS int* te = ts + 80;
    build_expert_tables(p, l, ts, cn, te);
    MoeSched S; S.ts = ts; S.cn = cn; S.te = te; S.list = p.list; S.A = p.F; S.Bt = p.w1T + (size_t)l * NE * 2 * D * D; S.bias = p.moe_b1 + (size_t)l * NE * 2 * D; S.nbias = 2;
    S.K = D; S.npn = 8; S.nunits = ts[NE] * 8; S.G = gridDim.x; S.c = blockIdx.x; S.nrowsB = 2 * D; S.gather = true;
    EpiAct E; E.O = p.act;
    g8::gemm_phase(lds, D, S, E);
}

struct EpiYp {
    bf16_t* O;
    __device__ __forceinline__ bool keep(const g8::Unit&) const { return false; }
    __device__ __forceinline__ void operator()(const f32x4 (&acc)[2][2][4][2], const g8::Unit& u, int wr, int wc, int fr, int fq, const LAS float* bias) const {
        const int row0 = u.pm * 256 + wr * 64 + fr, col0 = u.pn * 256 + wc * 32 + 8 * fq;
#pragma unroll
        for (int bj = 0; bj < 2; ++bj) {
            const LAS float* bb = bias + bj * 128 + wc * 32 + 8 * fq;
            const f32x4 c0v = *(const LAS f32x4*)bb, c1v = *(const LAS f32x4*)(bb + 4);
            const float4 c0 = make_float4(c0v[0], c0v[1], c0v[2], c0v[3]), c1 = make_float4(c1v[0], c1v[1], c1v[2], c1v[3]);
#pragma unroll
            for (int ai = 0; ai < 2; ++ai)
#pragma unroll
                for (int m = 0; m < 4; ++m) {
                    u32x4 w; w[0] = pack2(acc[ai][bj][m][0][0] + c0.x, acc[ai][bj][m][0][1] + c0.y); w[1] = pack2(acc[ai][bj][m][0][2] + c0.z, acc[ai][bj][m][0][3] + c0.w);
                    w[2] = pack2(acc[ai][bj][m][1][0] + c1.x, acc[ai][bj][m][1][1] + c1.y); w[3] = pack2(acc[ai][bj][m][1][2] + c1.z, acc[ai][bj][m][1][3] + c1.w);
                    *(u32x4*)(O + (size_t)(row0 + ai * 128 + m * 16) * D + col0 + bj * 128) = w;
                }
        }
    }
};
__device__ __forceinline__ void ph_g5(const Params& p, int l, LAS unsigned char* lds) {
    LAS int* ts = (LAS int*)(lds + g8::STAGE_BYTES); LAS int* cn = ts + 40; LAS int* te = ts + 80;
    build_expert_tables(p, l, ts, cn, te);
    MoeSched S; S.ts = ts; S.cn = cn; S.te = te; S.list = p.list; S.A = p.act; S.Bt = p.w2T + (size_t)l * NE * D * D; S.bias = p.moe_b2 + (size_t)l * NE * D; S.nbias = 1;
    S.K = D; S.npn = 4; S.nunits = ts[NE] * 4; S.G = gridDim.x; S.c = blockIdx.x; S.nrowsB = D; S.gather = false;
    EpiYp E; E.O = p.yp;
    g8::gemm_phase(lds, D, S, E);
}

template <bool DRY = false> __device__ __forceinline__ void ph_combine(const Params& p, int l, int M, LAS unsigned char* lds) {
    float* const c_xl = DRY ? p.prep : p.xl; bf16_t* const c_H = DRY ? (bf16_t*)(p.prep + (size_t)NTOK * D) : p.H; float* const c_out = DRY ? p.prep : p.out;
    LAS int* ts = (LAS int*)lds; LAS int* cn = ts + 40;
    build_expert_tables(p, l, ts, cn, nullptr);
    const int tid = opaque_tid(), wid = tid >> 6, lane = tid & 63;
    const bool last = (l == 1);
    for (int tok = blockIdx.x * NWAVES + wid; tok < M; tok += gridDim.x * NWAVES) {
        float4 v[4];
        const float* mb = p.mod + (size_t)(l * 5 + tok_modrow(tok)) * (NMOD * D);
        int rows[4]; float wts[4];
#pragma unroll
        for (int k = 0; k < 4; ++k) { const int tsl = p.tokslot[(size_t)tok * 4 + k]; rows[k] = ts[tsl >> 16] * 256 + (tsl & 0xffff); wts[k] = p.topw[(size_t)tok * 4 + k]; }
        float ss = 0.f;
#pragma unroll
        for (int i = 0; i < 4; ++i) {
            const int cidx = i * 256 + lane * 4;
            float m0 = 0.f, m1 = 0.f, m2 = 0.f, m3 = 0.f;
#pragma unroll
            for (int k = 0; k < 4; ++k) {
                const u32x2 u = *(const u32x2*)(p.yp + (size_t)rows[k] * D + cidx);
                m0 += wts[k] * bflo(u[0]); m1 += wts[k] * bfhi(u[0]); m2 += wts[k] * bflo(u[1]); m3 += wts[k] * bfhi(u[1]);
            }
            const float4 gt = *(const float4*)(mb + 5 * D + cidx);
            float4 xv = *(const float4*)(p.xl + (size_t)tok * D + cidx);
            xv.x += gt.x * m0; xv.y += gt.y * m1; xv.z += gt.z * m2; xv.w += gt.w * m3;
            v[i] = xv; ss += xv.x * xv.x + xv.y * xv.y + xv.z * xv.z + xv.w * xv.w;
        }
        ss = wave_sum(ss);
        const float rinv = rsqrtf(ss * (1.0f / D) + 1e-6f);
        if (!last) {
#pragma unroll
            for (int i = 0; i < 4; ++i) *(float4*)(c_xl + (size_t)tok * D + i * 256 + lane * 4) = v[i];
            const float* mb1 = p.mod + (size_t)((l + 1) * 5 + tok_modrow(tok)) * (NMOD * D);
            norm_mod_store(v, rinv, p.norm1_g + (l + 1) * D, mb1 + 1 * D, mb1 + 0 * D, c_H + (size_t)tok * D, lane);
        } else {
#pragma unroll
            for (int i = 0; i < 4; ++i) {
                const int cidx = i * 256 + lane * 4;
                const float4 gv = *(const float4*)(p.final_norm_g + cidx);
                *(float4*)(c_out + (size_t)tok * D + cidx) = make_float4(v[i].x * rinv * gv.x, v[i].y * rinv * gv.y, v[i].z * rinv * gv.z, v[i].w * rinv * gv.w);
            }
        }
    }
}

#define XB_TMO      128
#define XB_XCNT(j)  (256  + 64 * (j))
#define XB_XSUB(j)  (1280 + 64 * (j))
#define XB_XGEN(j)  (2304 + 64 * (j))
#define XB_TOP      3328
#define XB_TOPGEN   3392
#define XCD_BAR_WORDS 3456
#define XB_SPIN_CAP (1u << 18)

__device__ __forceinline__ unsigned xb_ld(unsigned* p)              { return __hip_atomic_load(p, __ATOMIC_RELAXED, __HIP_MEMORY_SCOPE_AGENT); }
__device__ __forceinline__ unsigned xb_add(unsigned* p, unsigned v) { return __hip_atomic_fetch_add(p, v, __ATOMIC_RELAXED, __HIP_MEMORY_SCOPE_AGENT); }
__device__ __forceinline__ unsigned xb_xcc_id() { return (unsigned)__builtin_amdgcn_s_getreg((3 << 11) | 20) & 0xFu; }
#define XB_SPIN(cond, bar) do { unsigned _sp = 0; while (cond) { __builtin_amdgcn_s_sleep(1); \
    if ((++_sp & 255u) == 0u) { if (xb_ld(&(bar)[XB_TMO])) break; if (_sp > XB_SPIN_CAP) { atomicAdd(&(bar)[XB_TMO], 1u); break; } } } } while (0)

struct XcdBarrier {
    unsigned* bar; unsigned x;
    volatile LAS unsigned* st;
};

__device__ __forceinline__ XcdBarrier xcd_barrier_post(unsigned* bar, volatile LAS unsigned* st) {
    XcdBarrier b; b.bar = bar; b.x = xb_xcc_id(); b.st = st;
    if (threadIdx.x == 0) (void)xb_add(&bar[XB_XCNT(b.x)], 1u);
    return b;
}
__device__ __forceinline__ void xcd_barrier_complete(unsigned* bar, unsigned x, unsigned& nloc, unsigned& nx) {
    const unsigned G = gridDim.x * gridDim.y * gridDim.z;
    unsigned sum, cnt, mine, sp = 0u;
    for (;;) {
        sum = 0u; cnt = 0u; mine = 0u;
#pragma unroll
        for (unsigned j = 0; j < 16; ++j) { const unsigned c = xb_ld(&bar[XB_XCNT(j)]); sum += c; cnt += (c > 0u) ? 1u : 0u; mine = (j == x) ? c : mine; }
        if (sum == G) break;
        __builtin_amdgcn_s_sleep(1);
        if ((++sp & 255u) == 0u) { if (xb_ld(&bar[XB_TMO])) break; if (sp > XB_SPIN_CAP) { atomicAdd(&bar[XB_TMO], 1u); break; } }
    }
    nloc = mine > 0u ? mine : 1u; nx = cnt > 0u ? cnt : 1u;
}

__device__ __forceinline__ void xcd_barrier(const XcdBarrier& b) {
    asm volatile("s_waitcnt vmcnt(0)" ::: "memory");
    __syncthreads();
    if (threadIdx.x == 0) {
        unsigned* bar = b.bar;
        __builtin_amdgcn_s_waitcnt(0);
        unsigned nloc = b.st[0], nx = b.st[1];
        if (nloc == 0u) { xcd_barrier_complete(bar, b.x, nloc, nx); b.st[0] = nloc; b.st[1] = nx; }
        const unsigned old = xb_add(&bar[XB_XSUB(b.x)], 1u);
        const unsigned gen = old / nloc;
        if (old + 1u == (gen + 1u) * nloc) {
            __builtin_amdgcn_fence(__ATOMIC_RELEASE, "agent");
            asm volatile("s_waitcnt vmcnt(0)" ::: "memory");
            const unsigned og = xb_add(&bar[XB_TOP], 1u);
            const unsigned tg = og / nx;
            if (og + 1u == (tg + 1u) * nx) xb_add(&bar[XB_TOPGEN], 1u);
            else XB_SPIN(xb_ld(&bar[XB_TOPGEN]) == tg, bar);
            __builtin_amdgcn_fence(__ATOMIC_ACQUIRE, "agent");
            xb_add(&bar[XB_XGEN(b.x)], 1u);
            asm volatile("s_waitcnt vmcnt(0)" ::: "memory");
        } else {
            XB_SPIN(xb_ld(&bar[XB_XGEN(b.x)]) == gen, bar);
            __builtin_amdgcn_fence(__ATOMIC_ACQUIRE, "agent");
            asm volatile("s_waitcnt vmcnt(0)" ::: "memory");
        }
    }
    __syncthreads();
}


extern __shared__ __attribute__((aligned(16))) unsigned char dyn_lds[];
#define KPH(name, call) __global__ void __launch_bounds__(NTHREADS, 2) name(Params p, int l, int M) { LAS unsigned char* lds = (LAS unsigned char*)dyn_lds; (void)l; (void)M; (void)lds; call; }
KPH(k_convert, { ph_convert(p, lds); })
KPH(k_mod, { ph_mod(p, lds); })
KPH(k_norm1, { ph_norm1_first(p); })
KPH(k_g1, { ph_g1(p, l, lds); })
KPH(k_prep, { ph_prep(p, l, lds); })
KPH(k_local, { ph_local(p, l, lds); })
KPH(k_seq, { ph_seq(p, lds); })
KPH(k_merge, { ph_merge(p, l, M); })
KPH(k_g2, { ph_g2(p, l, M, lds); })
KPH(k_g3, { ph_g3(p, l, M, lds); })
KPH(k_route, { ph_route(p, l, M, lds); })
KPH(k_g4, { ph_g4(p, l, lds); })
KPH(k_g5, { ph_g5(p, l, lds); })
KPH(k_combine, { ph_combine(p, l, M, lds); })


__global__ void __launch_bounds__(NTHREADS, 2) k_mega(Params p) {
    LAS unsigned char* lds = (LAS unsigned char*)dyn_lds;
    volatile LAS unsigned* xb_words = (volatile LAS unsigned*)(lds + LDS_BYTES - 16);
    if (threadIdx.x == 0) { xb_words[0] = 0u; xb_words[1] = 0u; xb_words[2] = 0u; xb_words[3] = 0u; }
    __syncthreads();
    (void)xcd_barrier_post(p.bar, xb_words);
#define GRID_BARRIER() do { XcdBarrier b_; b_.bar = p.bar; b_.x = xb_xcc_id(); b_.st = xb_words; xcd_barrier(b_); } while (0)
#define RUNP(bit, stmt) do { stmt; if (PROBE & (1 << (bit))) { GRID_BARRIER(); stmt; } } while (0)
    RUNP(0, ph_convert(p, lds));
    RUNP(1, ph_mod(p, lds));
    GRID_BARRIER();
    RUNP(2, ph_norm1_first(p));
    GRID_BARRIER();
    for (int l = 0; l < 2; ++l) {
        const int M = l == 0 ? NTOK : NLAT;
        { unsigned lb_ = (unsigned)(size_t)lds; asm volatile("" : "+s"(lb_)); lds = (LAS unsigned char*)(size_t)lb_; }
        RUNP(3, ph_g1(p, l, lds));
        GRID_BARRIER();
        RUNP(4, ph_prep(p, l, lds));
        GRID_BARRIER();
        RUNP(5, ph_local(p, l, lds));
        GRID_BARRIER();
        RUNP(6, ph_seq(p, lds));
        GRID_BARRIER();
        RUNP(7, ph_merge(p, l, M));
        GRID_BARRIER();
        RUNP(8, ph_g2(p, l, M, lds));
        GRID_BARRIER();
        if (PROBE & (1 << 11)) { ph_g3<true>(p, l, M, lds); GRID_BARRIER(); }
        ph_g3(p, l, M, lds);
        GRID_BARRIER();
        if (PROBE & (1 << 12)) { ph_route<true>(p, l, M, lds); GRID_BARRIER(); }
        ph_route(p, l, M, lds);
        GRID_BARRIER();
        RUNP(9, ph_g4(p, l, lds));
        GRID_BARRIER();
        RUNP(10, ph_g5(p, l, lds));
        GRID_BARRIER();
        if (PROBE & (1 << 13)) { ph_combine<true>(p, l, M, lds); GRID_BARRIER(); }
        ph_combine(p, l, M, lds);
        if (l == 0) GRID_BARRIER();
    }
}

static inline size_t align_up(size_t v, size_t a) { return (v + a - 1) / a * a; }

extern "C" void kernel_launch(void* const* d_in, const int* in_sizes, int n_in, void* d_out, int out_size, void* d_ws, size_t ws_size, hipStream_t stream) {
    (void)in_sizes; (void)n_in; (void)out_size;
    Params p{};
    const float** pf = (const float**)&p;
    for (int i = 0; i < 32; ++i) pf[i] = (const float*)d_in[i];
    p.out = (float*)d_out;
    unsigned char* w = (unsigned char*)d_ws; size_t off = 0;
    auto take = [&](size_t bytes) { void* r = w + off; off = align_up(off + bytes, 256); return r; };
    p.bar = (unsigned*)take(16384);
    p.cnt = (int*)take(1024);
    const size_t ctl_bytes = off;
    p.mod = (float*)take((size_t)2 * 5 * NMOD * D * 4);
    p.winT = (bf16_t*)take((size_t)2 * NPW * D * 2);
    p.wbT = (bf16_t*)take((size_t)2 * 4 * D * MW * 2);
    p.woutT = (bf16_t*)take((size_t)2 * D * D * 2);
    p.w1T = (bf16_t*)take((size_t)2 * NE * 2 * D * D * 2);
    p.w2T = (bf16_t*)take((size_t)2 * NE * D * D * 2);
    p.xl = (float*)take((size_t)NTOK * D * 4);
    p.H = (bf16_t*)take((size_t)NTOK * D * 2);
    p.P = (bf16_t*)take((size_t)NTOK * NP * 2);
    p.gate = (bf16_t*)take((size_t)NTOK * 4096 * 2);
    p.act = p.P; p.yp = p.P + (size_t)CAPROWS * D;
    p.prep = (float*)take(NPREP * TOKW * 4);
    p.gg = (float*)take((size_t)NTOK * 8 * 4);
    p.gb = (float*)take((size_t)NTOK * 8 * 4);
    p.O = (float*)take(8 * TOKW * 4);
    p.lq = (bf16_t*)take((size_t)3 * NITEM * 64 * 128 * 2);
    p.lo = (bf16_t*)take((size_t)3 * NITEM * 64 * 128 * 2);
    p.lb = (bf16_t*)take((size_t)3 * NITEM * 128 * 128 * 2);
    p.la = (bf16_t*)take((size_t)NITEM * 128 * 128 * 2);
    p.ld = (float*)take((size_t)3 * NITEM * 128 * 4);
    p.lruT = (bf16_t*)take((size_t)2 * 8 * 4 * 4096 * 2);
    p.Y = (bf16_t*)take(4 * TOKW * 2);
    p.mix = (bf16_t*)take((size_t)NTOK * D * 2);
    p.F = p.H;
    p.list = (int*)take((size_t)NE * NTOK * 4);
    p.tokslot = (int*)take((size_t)NTOK * 4 * 4);
    p.topw = (float*)take((size_t)NTOK * 4 * 4);
    if (off > ws_size) { fprintf(stderr, "workspace too small: need %zu have %zu\n", off, ws_size); return; }

    static int grid = 0;
#if MEGA
    if (!grid) {
        int dev = 0, cus = 0, occ = 0; (void)hipGetDevice(&dev); (void)hipDeviceGetAttribute(&cus, hipDeviceAttributeMultiprocessorCount, dev);
        (void)hipFuncSetAttribute((const void*)k_mega, hipFuncAttributeMaxDynamicSharedMemorySize, LDS_BYTES);
        (void)hipOccupancyMaxActiveBlocksPerMultiprocessor(&occ, (const void*)k_mega, NTHREADS, LDS_BYTES);
        if (cus <= 0) cus = 256;
        grid = cus * (occ < 1 ? 1 : 1);
        if (occ < 1) fprintf(stderr, "occupancy query says %d blocks per CU\n", occ);
    }
    (void)hipMemsetAsync(d_ws, 0, ctl_bytes, stream);
    hipLaunchKernelGGL(k_mega, dim3(grid), dim3(NTHREADS), LDS_BYTES, stream, p);
#else
    if (!grid) {
        int dev = 0, cus = 0; (void)hipGetDevice(&dev); (void)hipDeviceGetAttribute(&cus, hipDeviceAttributeMultiprocessorCount, dev);
        grid = cus > 0 ? cus : 256;
        const void* ks[] = {(const void*)k_convert, (const void*)k_mod, (const void*)k_norm1, (const void*)k_g1, (const void*)k_prep, (const void*)k_local, (const void*)k_seq, (const void*)k_merge,
                            (const void*)k_g2, (const void*)k_g3, (const void*)k_route, (const void*)k_g4, (const void*)k_g5, (const void*)k_combine};
        for (const void* k : ks) (void)hipFuncSetAttribute(k, hipFuncAttributeMaxDynamicSharedMemorySize, LDS_BYTES);
    }
    (void)hipMemsetAsync(d_ws, 0, ctl_bytes, stream);
#define LAUNCH(k, l, M) hipLaunchKernelGGL(k, dim3(grid), dim3(NTHREADS), LDS_BYTES, stream, p, l, M)
    LAUNCH(k_convert, 0, 0);
    LAUNCH(k_mod, 0, 0);
    LAUNCH(k_norm1, 0, 0);
    for (int l = 0; l < 2; ++l) {
        const int M = l == 0 ? NTOK : NLAT;
        LAUNCH(k_g1, l, M);
        LAUNCH(k_prep, l, M);
        LAUNCH(k_local, l, M);
        LAUNCH(k_seq, l, M);
        LAUNCH(k_merge, l, M);
        LAUNCH(k_g2, l, M);
        LAUNCH(k_g3, l, M);
        LAUNCH(k_route, l, M);
        LAUNCH(k_g4, l, M);
        LAUNCH(k_g5, l, M);
        LAUNCH(k_combine, l, M);
    }
#endif
}
```

```cpp
#include <hip/hip_runtime.h>
#include <stdint.h>
#include <stdio.h>

#define LAS __attribute__((address_space(3)))
typedef unsigned short bf16_t;
typedef short bf16x8 __attribute__((ext_vector_type(8)));
typedef float f32x4 __attribute__((ext_vector_type(4)));
typedef float f32x2 __attribute__((ext_vector_type(2)));
typedef unsigned u32x2 __attribute__((ext_vector_type(2)));
typedef unsigned u32x4 __attribute__((ext_vector_type(4)));

#ifndef MEGA
#define MEGA 1
#endif
#ifndef PROBE
#define PROBE 0
#endif

constexpr int D = 1024, NB = 4, TL = 4096, TC = 256, NLAT = NB * TL, NCTX = NB * TC, NTOK = NLAT + NCTX;
constexpr int NIN = 11792, NPW = 12032, NP = 7936, MW = 512, NE = 32, TOPK = 4, NMOD = 6;
constexpr int C_GQKV = 0, C_GZ = 1536, C_HQ = 2048, C_HI = 2560, C_HF = 3072, C_HG = 4096, C_LX = 4608,
              C_LY = 5120, C_RQKV = 5632, C_RG = 7168, C_GA = 7680, C_GB = 7688, W_MG = 7936;
__host__ __device__ __forceinline__ int win_dst_row(int n) { return n < 2048 ? n : n < 2064 ? 7680 + (n - 2048) : n < 7696 ? n - 16 : 7936 + (n - 7696); }
constexpr int NTHREADS = 512, NWAVES = 8;
constexpr int LDS_BYTES = 140 * 1024;
constexpr int CAPROWS = 77824;
constexpr size_t TOKW = (size_t)NTOK * MW;
constexpr int PR_LA = 0, PR_LU = 2, NPREP = 4;
constexpr int NCHUNK = 68, NITEM = 32 * NCHUNK;

struct Params {
    const float *x, *c, *ctx, *c_ctx, *w_mod, *b_mod, *norm1_g, *norm2_g, *w_in, *gdn_conv_w, *gdn_a_log, *gdn_dt_bias, *gdn_norm_g, *hgrn_lb,
        *hgrn_norm_g, *lru_conv_w, *lru_conv_b, *lru_wa, *lru_ba, *lru_wx, *lru_bx, *lru_lambda, *ret_norm_g, *w_branch, *w_out, *router_w,
        *router_b, *moe_w1, *moe_b1, *moe_w2, *moe_b2, *final_norm_g;
    float* out;
    unsigned* bar; int* cnt; float* mod;
    bf16_t *winT, *wbT, *woutT, *w1T, *w2T;
    float* xl; bf16_t* H; bf16_t* P; float* prep; float* gg; float* gb; float* O; bf16_t* Y; bf16_t* mix; bf16_t* F;
    int* list; int* tokslot; float* topw; bf16_t* act; bf16_t* yp;
    bf16_t *lq, *lo, *lb, *la; float* ld; bf16_t* lruT; bf16_t* gate;
};

__device__ __forceinline__ unsigned f2bf(float f) { unsigned u = __float_as_uint(f); u += 0x7fffu + ((u >> 16) & 1u); return u >> 16; }
__device__ __forceinline__ unsigned pack2(float a, float b) { return f2bf(a) | (f2bf(b) << 16); }
__device__ __forceinline__ float bf2f(bf16_t b) { return __uint_as_float(((unsigned)b) << 16); }
__device__ __forceinline__ float bflo(unsigned u) { return __uint_as_float(u << 16); }
__device__ __forceinline__ float bfhi(unsigned u) { return __uint_as_float(u & 0xffff0000u); }
__device__ __forceinline__ float sigmoidf_(float x) { return __builtin_amdgcn_rcpf(1.0f + __expf(-x)); }
__device__ __forceinline__ float siluf_(float x) { return x * sigmoidf_(x); }
__device__ __forceinline__ float softplusf_(float x) { return x > 20.f ? x : log1pf(__expf(x)); }
__device__ __forceinline__ float logsigmoidf_(float x) { return -softplusf_(-x); }
__device__ __forceinline__ float gelu_tanhf_(float x) { const float u = 0.7978845608028654f * (x + 0.044715f * x * x * x); return 0.5f * x * (1.0f + tanhf(u)); }
__device__ __forceinline__ float wave_sum(float v) {
#pragma unroll
    for (int m = 32; m >= 1; m >>= 1) v += __shfl_xor(v, m);
    return v;
}
__device__ __forceinline__ int opaque_tid() { int t = threadIdx.x; asm volatile("" : "+v"(t)); return t; }
template <class T> __device__ __forceinline__ T* opaque_sptr(T* q) { asm volatile("" : "+s"(q)); return q; }
__device__ __forceinline__ int tok_modrow(int tok) { return tok < NLAT ? (tok >> 12) : 4; }
__device__ __forceinline__ void tok_info(int tok, int& t, int& T, int& base) {
    if (tok < NLAT) { t = tok & (TL - 1); T = TL; base = tok - t; }
    else { t = (tok - NLAT) & (TC - 1); T = TC; base = tok - t; }
}

__device__ __forceinline__ f32x4 mfma16(bf16x8 a, bf16x8 b, f32x4 c) { return __builtin_amdgcn_mfma_f32_16x16x32_bf16(a, b, c, 0, 0, 0); }
__device__ __forceinline__ u32x2 pack4(f32x4 v) { u32x2 o; o[0] = pack2(v[0], v[1]); o[1] = pack2(v[2], v[3]); return o; }
__device__ __forceinline__ u32x4 pack8(const float* v) { u32x4 o; o[0] = pack2(v[0], v[1]); o[1] = pack2(v[2], v[3]); o[2] = pack2(v[4], v[5]); o[3] = pack2(v[6], v[7]); return o; }

namespace gm {
constexpr int HT = 16384;
__device__ __forceinline__ int lds_byte(int r, int c) { const int st = (r >> 4) * 2 + (c >> 5), rr = r & 15, cc = c & 31, ob = rr * 64 + cc * 2; return st * 1024 + (ob ^ (((ob >> 9) & 1) << 5)); }
__device__ __forceinline__ void stage_rc(int b, int& R, int& C) { const int st = b / 1024, sb = b % 1024, swz = sb ^ (((sb >> 9) & 1) << 5); R = (st >> 1) * 16 + swz / 64; C = (st & 1) * 32 + (swz % 64) / 2; }

__device__ __forceinline__ void kloop(LAS unsigned char* lds, const bf16_t* ap00, const bf16_t* ap01, const bf16_t* ap10, const bf16_t* ap11,
                                      const bf16_t* bp0, const bf16_t* bp1, int K, f32x4 (&acc)[4][4]) {
    const int tid = opaque_tid(), wid = __builtin_amdgcn_readfirstlane(tid >> 6), lane = tid & 63, wr = wid >> 1, wc = wid & 1, fr = lane & 15, fq = lane >> 4;
    const unsigned ldsw = (unsigned)wid * 1024u;
    const int aoff = (wr >> 1) * HT + lds_byte((wr & 1) * 64 + fr, fq * 8);
    const int boff = 2 * HT + lds_byte(wc * 64 + fr, fq * 8);
    const int nt = K / 64;
#define GM_GLDS(src, dstoff) __builtin_amdgcn_global_load_lds((const unsigned*)(src), (LAS unsigned*)(lds + (dstoff)), 16, 0, 0)
#define GM_STAGE(buf, kt) do { const int _bo = (buf) * 3 * HT + ldsw; const int _ko = (kt) * 64; \
        GM_GLDS(ap00 + _ko, _bo); GM_GLDS(ap01 + _ko, _bo + 8192); GM_GLDS(ap10 + _ko, _bo + HT); GM_GLDS(ap11 + _ko, _bo + HT + 8192); \
        GM_GLDS(bp0 + _ko, _bo + 2 * HT); GM_GLDS(bp1 + _ko, _bo + 2 * HT + 8192); } while (0)
    GM_STAGE(0, 0);
    for (int t = 0; t < nt; ++t) {
        const int cur = t & 1;
        if (t + 1 < nt) { GM_STAGE(cur ^ 1, t + 1); asm volatile("s_waitcnt vmcnt(6)" ::: "memory"); }
        else asm volatile("s_waitcnt vmcnt(0)" ::: "memory");
        __builtin_amdgcn_s_barrier(); asm volatile("" ::: "memory");
        bf16x8 af[4][2], bfr[4][2];
#pragma unroll
        for (int m = 0; m < 4; ++m)
#pragma unroll
            for (int k = 0; k < 2; ++k) af[m][k] = *(const LAS bf16x8*)(lds + cur * 3 * HT + aoff + m * 2048 + k * 1024);
#pragma unroll
        for (int n = 0; n < 4; ++n)
#pragma unroll
            for (int k = 0; k < 2; ++k) bfr[n][k] = *(const LAS bf16x8*)(lds + cur * 3 * HT + boff + n * 2048 + k * 1024);
#pragma unroll
        for (int k = 0; k < 2; ++k)
#pragma unroll
            for (int m = 0; m < 4; ++m)
#pragma unroll
                for (int n = 0; n < 4; ++n) acc[m][n] = __builtin_amdgcn_mfma_f32_16x16x32_bf16(bfr[n][k], af[m][k], acc[m][n], 0, 0, 0);
        asm volatile("s_waitcnt lgkmcnt(0)" ::: "memory");
        __builtin_amdgcn_s_barrier(); asm volatile("" ::: "memory");
    }
#undef GM_STAGE
#undef GM_GLDS
}
__device__ __forceinline__ void zero_acc(f32x4 (&acc)[4][4]) {
#pragma unroll
    for (int m = 0; m < 4; ++m)
#pragma unroll
        for (int n = 0; n < 4; ++n) acc[m][n] = (f32x4){0.f, 0.f, 0.f, 0.f};
}
}

namespace g8 {
constexpr int BM = 256, BK = 64, HALF = 128, HTB = HALF * BK * 2, STAGE_BYTES = 8 * HTB;
__device__ __forceinline__ int lds_byte(int r, int c) { const int st = (r >> 4) * 2 + (c >> 5), rr = r & 15, cc = c & 31, ob = rr * 64 + cc * 2; return st * 1024 + (ob ^ (((ob >> 9) & 1) << 5)); }
__device__ __forceinline__ void stage_rc(int b, int& R, int& C) { const int st = b / 1024, sb = b % 1024, swz = sb ^ (((sb >> 9) & 1) << 5); R = (st >> 1) * 16 + swz / 64; C = (st & 1) * 32 + (swz % 64) / 2; }
__device__ __forceinline__ int perm32(int rho) { const int n = rho >> 4, i = rho & 15; return 8 * (i >> 2) + 4 * n + (i & 3); }
struct Unit { int pm, pn, e; };

template <class Epi, class Sched>
__device__ __forceinline__ void gemm_phase(LAS unsigned char* lds, const int K, const Sched& S, const Epi& E) {
    const int tid = opaque_tid(), wid = __builtin_amdgcn_readfirstlane(tid >> 6), lane = tid & 63, wr = wid >> 2, wc = wid & 3, fr = lane & 15, fq = lane >> 4;
    const int nt = K / BK;
    int R0, C0, R1, C1; stage_rc(tid * 16, R0, C0); stage_rc(tid * 16 + 8192, R1, C1);
    unsigned voffB[2];
    voffB[0] = (unsigned)(((R0 & ~31) + perm32(R0 & 31)) * K + C0) * 2u; voffB[1] = (unsigned)(((R1 & ~31) + perm32(R1 & 31)) * K + C1) * 2u;
    const unsigned cb0 = (unsigned)C0 * 2u, cb1 = (unsigned)C1 * 2u;
    const size_t kstep = (size_t)(BK * 2);
    const size_t hstepB = (size_t)HALF * K * 2;
    const unsigned ldsw = (unsigned)wid * 1024u;
    const int aoff = lds_byte(wr * 64 + fr, fq * 8), boff = lds_byte(wc * 32 + fr, fq * 8);
#define G8_SA(b, h) (((b) * 2 + (h)) * HTB)
#define G8_SB(b, h) ((4 + (b) * 2 + (h)) * HTB)
#define G8_GL(src, dstoff) __builtin_amdgcn_global_load_lds((const unsigned*)(src), (LAS unsigned*)(lds + (dstoff)), 16, 0, 0)
#define G8_STAGE_A(bufoff, gbase, vo, h) do { G8_GL((const char*)(gbase) + (vo)[2 * (h)], (bufoff) + ldsw); G8_GL((const char*)(gbase) + (vo)[2 * (h) + 1], (bufoff) + ldsw + 8192); } while (0)
#define G8_STAGE_B(bufoff, gbase) do { G8_GL((const char*)(gbase) + voffB[0], (bufoff) + ldsw); G8_GL((const char*)(gbase) + voffB[1], (bufoff) + ldsw + 8192); } while (0)
#define G8_LDA(dst, b, h) do { _Pragma("unroll") for (int m = 0; m < 4; ++m) _Pragma("unroll") for (int k = 0; k < 2; ++k) dst[m][k] = *(const LAS bf16x8*)(lds + G8_SA(b, h) + aoff + m * 2048 + k * 1024); } while (0)
#define G8_LDB(dst, b, h) do { _Pragma("unroll") for (int n = 0; n < 2; ++n) _Pragma("unroll") for (int k = 0; k < 2; ++k) dst[n][k] = *(const LAS bf16x8*)(lds + G8_SB(b, h) + boff + n * 2048 + k * 1024); } while (0)
#define G8_MMA(ai, bj, At, Bt) do { __builtin_amdgcn_s_setprio(1); _Pragma("unroll") for (int m = 0; m < 4; ++m) _Pragma("unroll") for (int n = 0; n < 2; ++n) _Pragma("unroll") for (int k = 0; k < 2; ++k) \
        acc[ai][bj][m][n] = __builtin_amdgcn_mfma_f32_16x16x32_bf16(Bt[n][k], At[m][k], acc[ai][bj][m][n], 0, 0, 0); __builtin_amdgcn_s_setprio(0); } while (0)
#define G8_WAIT_V(n) asm volatile("s_waitcnt vmcnt(" #n ")" ::: "memory")
#define G8_WAIT_L(n) asm volatile("s_waitcnt lgkmcnt(" #n ")" ::: "memory")
#define G8_BAR __builtin_amdgcn_s_barrier()
#define G8_SCHED __builtin_amdgcn_sched_barrier(0)
    Unit cur, nxt; int ui = 0;
    if (!S.next(0, cur)) return;
    LAS float* biasbuf = (LAS float*)(lds + STAGE_BYTES + 2048);
    LAS int* rowbuf = (LAS int*)(lds + STAGE_BYTES + 4096);
    f32x4 acc[2][2][4][2];
#pragma unroll
    for (int a = 0; a < 2; ++a)
#pragma unroll
        for (int b = 0; b < 2; ++b)
#pragma unroll
            for (int m = 0; m < 4; ++m)
#pragma unroll
                for (int n = 0; n < 2; ++n) acc[a][b][m][n] = (f32x4){0.f, 0.f, 0.f, 0.f};
    bf16x8 At[4][2], B0[2][2], B1[2][2];
    unsigned vA[4];
    {
        unsigned rows[4] = {(unsigned)R0, (unsigned)R1, (unsigned)(HALF + R0), (unsigned)(HALF + R1)};
        if (S.gather) { rows[0] = (unsigned)*S.row_addr(cur, R0); rows[1] = (unsigned)*S.row_addr(cur, R1); rows[2] = (unsigned)*S.row_addr(cur, HALF + R0); rows[3] = (unsigned)*S.row_addr(cur, HALF + R1); }
        vA[0] = rows[0] * (unsigned)(K * 2) + cb0; vA[1] = rows[1] * (unsigned)(K * 2) + cb1; vA[2] = rows[2] * (unsigned)(K * 2) + cb0; vA[3] = rows[3] * (unsigned)(K * 2) + cb1;
    }
    const char* cA = S.a_base(cur); const char* cB = S.b_base(cur);
    G8_STAGE_B(G8_SB(0, 0), cB); G8_STAGE_A(G8_SA(0, 0), cA, vA, 0); G8_STAGE_B(G8_SB(0, 1), cB + hstepB); G8_STAGE_A(G8_SA(0, 1), cA, vA, 1);
    if (wr == 1) G8_BAR;
    G8_WAIT_V(4); G8_BAR;
    G8_STAGE_B(G8_SB(1, 0), cB + kstep); G8_STAGE_A(G8_SA(1, 0), cA + kstep, vA, 0); G8_STAGE_B(G8_SB(1, 1), cB + hstepB + kstep);
    G8_WAIT_V(6); G8_BAR;
    for (;;) {
        const bool has_next = S.next(ui + 1, nxt);
        const char* nA = has_next ? S.a_base(nxt) : cA; const char* nB = has_next ? S.b_base(nxt) : cB;
        const int nvalid = (S.gather && has_next) ? S.rows_valid(nxt) : 0;
        if (wid == 0) {
            if (Sched::HAS_BIAS) G8_GL(S.bias_src(cur, lane), STAGE_BYTES + 2048 + (ui & 1) * 1024);
            if (S.gather && has_next) G8_GL(S.row_addr(nxt, 0) + lane * 4, STAGE_BYTES + 4096 + ((ui + 1) & 1) * 1024);
        }
        for (int t = 0; t < nt; t += 2) {
            const bool last = (t == nt - 2);
            const char* a1 = cA + (size_t)(t + 1) * kstep;
            const char* a2 = last ? nA : cA + (size_t)(t + 2) * kstep; const char* b2 = last ? nB : cB + (size_t)(t + 2) * kstep;
            const char* a3 = a2 + kstep; const char* b3 = b2 + kstep;
            unsigned v2[4];
#pragma unroll
            for (int q = 0; q < 4; ++q) v2[q] = vA[q];
            if (last && S.gather && has_next) {
                const LAS int* rb = rowbuf + ((ui + 1) & 1) * 256;
                const unsigned r0 = R0 < nvalid ? (unsigned)rb[R0] : 0u, r1 = R1 < nvalid ? (unsigned)rb[R1] : 0u;
                const unsigned r2 = HALF + R0 < nvalid ? (unsigned)rb[HALF + R0] : 0u, r3 = HALF + R1 < nvalid ? (unsigned)rb[HALF + R1] : 0u;
                v2[0] = r0 * (unsigned)(K * 2) + cb0; v2[1] = r1 * (unsigned)(K * 2) + cb1; v2[2] = r2 * (unsigned)(K * 2) + cb0; v2[3] = r3 * (unsigned)(K * 2) + cb1;
            }
            G8_LDB(B0, 0, 0); G8_SCHED; G8_LDA(At, 0, 0); G8_STAGE_A(G8_SA(1, 1), a1, vA, 1);
            G8_WAIT_L(8); G8_BAR; G8_WAIT_L(0); G8_MMA(0, 0, At, B0); G8_BAR; G8_SCHED;
            G8_LDB(B1, 0, 1); G8_STAGE_B(G8_SB(0, 0), b2);
            G8_BAR; G8_WAIT_L(0); G8_MMA(0, 1, At, B1); G8_BAR;
            G8_LDA(At, 0, 1); G8_STAGE_A(G8_SA(0, 0), a2, v2, 0);
            G8_BAR; G8_WAIT_L(0); G8_MMA(1, 0, At, B0); G8_BAR; G8_SCHED;
            G8_STAGE_B(G8_SB(0, 1), b2 + hstepB);
            G8_WAIT_V(6); G8_BAR; G8_MMA(1, 1, At, B1); G8_BAR;
            G8_LDB(B0, 1, 0); G8_SCHED; G8_LDA(At, 1, 0); G8_STAGE_A(G8_SA(0, 1), a2, v2, 1);
            G8_WAIT_L(8); G8_BAR; G8_WAIT_L(0); G8_MMA(0, 0, At, B0); G8_BAR; G8_SCHED;
            G8_LDB(B1, 1, 1); G8_STAGE_B(G8_SB(1, 0), b3);
            G8_BAR; G8_WAIT_L(0); G8_MMA(0, 1, At, B1); G8_BAR;
            G8_LDA(At, 1, 1); G8_STAGE_A(G8_SA(1, 0), a3, v2, 0);
            G8_BAR; G8_WAIT_L(0); G8_MMA(1, 0, At, B0); G8_BAR; G8_SCHED;
            G8_STAGE_B(G8_SB(1, 1), b3 + hstepB);
            G8_WAIT_V(6); G8_BAR; G8_MMA(1, 1, At, B1); G8_BAR;
        }
        E(acc, cur, wr, wc, fr, fq, biasbuf + (ui & 1) * 256);
        if (!has_next) break;
        if (!E.keep(cur))
#pragma unroll
        for (int a = 0; a < 2; ++a)
#pragma unroll
            for (int b = 0; b < 2; ++b)
#pragma unroll
                for (int m = 0; m < 4; ++m)
#pragma unroll
                    for (int n = 0; n < 2; ++n) acc[a][b][m][n] = (f32x4){0.f, 0.f, 0.f, 0.f};
        if (S.gather) {
            const LAS int* rb = rowbuf + ((ui + 1) & 1) * 256;
            const unsigned r0 = R0 < nvalid ? (unsigned)rb[R0] : 0u, r1 = R1 < nvalid ? (unsigned)rb[R1] : 0u;
            const unsigned r2 = HALF + R0 < nvalid ? (unsigned)rb[HALF + R0] : 0u, r3 = HALF + R1 < nvalid ? (unsigned)rb[HALF + R1] : 0u;
            vA[0] = r0 * (unsigned)(K * 2) + cb0; vA[1] = r1 * (unsigned)(K * 2) + cb1; vA[2] = r2 * (unsigned)(K * 2) + cb0; vA[3] = r3 * (unsigned)(K * 2) + cb1;
        }
        cur = nxt; cA = nA; cB = nB; ++ui;
    }
    G8_WAIT_V(0);
    if (wr == 0) G8_BAR;
    G8_BAR;
#undef G8_SA
#undef G8_SB
#undef G8_GL
#undef G8_STAGE_A
#undef G8_STAGE_B
#undef G8_LDA
#undef G8_LDB
#undef G8_MMA
#undef G8_WAIT_V
#undef G8_WAIT_L
#undef G8_BAR
#undef G8_SCHED
}

struct PlainSched {
    const bf16_t* A; const bf16_t* Bt; int K, nM, nN, nwg, G, c;
    __device__ __forceinline__ void init(const bf16_t* A_, const bf16_t* Bt_, int M, int N, int K_) { A = A_; Bt = Bt_; K = K_; nM = M / BM; nN = N / BM; nwg = nM * nN; G = gridDim.x; c = blockIdx.x; }
    __device__ __forceinline__ bool next(int i, Unit& u) const {
        const long L = (long)i * G + c; if (L >= nwg) return false;
        int wgid = (int)L; { const int q = nwg / 8, r = nwg % 8, xcd = wgid % 8, off = wgid / 8; wgid = (xcd < r ? xcd * (q + 1) : r * (q + 1) + (xcd - r) * q) + off; }
        const int nig = 8 * nN, gid = wgid / nig, fm = gid * 8, gsz = (nM - fm) < 8 ? (nM - fm) : 8;
        u.pm = fm + ((wgid % nig) % gsz); u.pn = (wgid % nig) / gsz; u.e = 0; return true;
    }
    __device__ __forceinline__ const char* a_base(const Unit& u) const { return (const char*)(A + (size_t)u.pm * BM * K); }
    __device__ __forceinline__ const char* b_base(const Unit& u) const { return (const char*)(Bt + (size_t)u.pn * BM * K); }
    static constexpr bool HAS_BIAS = false, gather = false;
    __device__ __forceinline__ const int* row_addr(const Unit&, int) const { return nullptr; }
    __device__ __forceinline__ int rows_valid(const Unit&) const { return 256; }
    __device__ __forceinline__ const float* bias_src(const Unit&, int) const { return nullptr; }
};
}

struct StageRC { int R0, C0, R1, C1; };
__device__ __forceinline__ StageRC my_stage_rc() { const int t = opaque_tid(); StageRC s; gm::stage_rc(t * 16, s.R0, s.C0); gm::stage_rc(t * 16 + 8192, s.R1, s.C1); return s; }

__device__ __forceinline__ int w1_dst_row(int n) { const int half = n >> 10, cc = n & 1023; return (cc >> 7) * 256 + half * 128 + (cc & 127); }

struct CvtTile { const float* src; bf16_t* dst; int ld, Nsrc, k0, n0, K, mode; };
__device__ __forceinline__ CvtTile cvt_decode(const Params& p, int it) {
    constexpr int PER_L = 2960 + 512 + 256 + 16384 + 8192;
    CvtTile t; const int l = it / PER_L; int r = it % PER_L;
    if (r < 2960) { const int nt = r % 185, kt = r / 185; t.src = p.w_in + (size_t)l * D * NIN; t.ld = NIN; t.Nsrc = NIN; t.k0 = kt * 64; t.n0 = nt * 64; t.dst = p.winT + (size_t)l * NPW * D; t.K = D; t.mode = 2; }
    else if (r < 3472) { r -= 2960; const int n = r / 128; r %= 128; const int nt = r % 16, kt = r / 16;
        t.src = p.w_branch + (size_t)(l * 4 + n) * MW * D; t.ld = D; t.Nsrc = D; t.k0 = kt * 64; t.n0 = nt * 64; t.dst = p.wbT + (size_t)(l * 4 + n) * D * MW; t.K = MW; t.mode = 0; }
    else if (r < 3728) { r -= 3472; const int nt = r % 16, kt = r / 16; t.src = p.w_out + (size_t)l * D * D; t.ld = D; t.Nsrc = D; t.k0 = kt * 64; t.n0 = nt * 64; t.dst = p.woutT + (size_t)l * D * D; t.K = D; t.mode = 0; }
    else if (r < 3728 + 16384) { r -= 3728; const int ee = r / 512; r %= 512; const int nt = r % 32, kt = r / 32;
        t.src = p.moe_w1 + (size_t)(l * NE + ee) * D * 2 * D; t.ld = 2 * D; t.Nsrc = 2 * D; t.k0 = kt * 64; t.n0 = nt * 64; t.dst = p.w1T + (size_t)(l * NE + ee) * 2 * D * D; t.K = D; t.mode = 1; }
    else { r -= 3728 + 16384; const int ee = r / 256; r %= 256; const int nt = r % 16, kt = r / 16;
        t.src = p.moe_w2 + (size_t)(l * NE + ee) * D * D; t.ld = D; t.Nsrc = D; t.k0 = kt * 64; t.n0 = nt * 64; t.dst = p.w2T + (size_t)(l * NE + ee) * D * D; t.K = D; t.mode = 0; }
    return t;
}

__device__ __forceinline__ void ph_convert(const Params& p, LAS unsigned char* lds) {
    LAS float* tile = (LAS float*)lds;
    const int tid = opaque_tid();
    for (int idx = blockIdx.x * NTHREADS + tid; idx < 2 * 8 * 4 * 4096; idx += gridDim.x * NTHREADS) {
        const int i = idx & 63, j = (idx >> 6) & 63, mat = (idx >> 12) & 3, n = (idx >> 14) & 7, ll = idx >> 17, d = mat >> 1;
        p.lruT[idx] = (bf16_t)f2bf(((mat & 1) ? p.lru_wx : p.lru_wa)[(size_t)((ll * 2 + d) * 8 + n) * 4096 + i * 64 + j]);
    }
    constexpr int TOTAL = 2 * (2960 + 512 + 256 + 16384 + 8192);
    for (int idx = blockIdx.x * NTHREADS + tid; idx < 2 * 240 * (D / 8); idx += gridDim.x * NTHREADS) {
        const int ll = idx / (240 * (D / 8)), r = idx % (240 * (D / 8));
        *(u32x4*)(p.winT + ((size_t)ll * NPW + 7696) * D + (size_t)r * 8) = (u32x4){0u, 0u, 0u, 0u};
    }
    for (int g = blockIdx.x; g * 4 < TOTAL; g += gridDim.x) {
        float v[4][8];
        const int rr = tid >> 6, cc = tid & 63;
#pragma unroll
        for (int q = 0; q < 4; ++q) {
            const int it = g * 4 + q;
            const CvtTile t = cvt_decode(p, it < TOTAL ? it : TOTAL - 1);
            const int n = t.n0 + cc; const bool ok = n < t.Nsrc; const int nc = ok ? n : t.Nsrc - 1;
#pragma unroll
            for (int i = 0; i < 8; ++i) { const float x = t.src[(size_t)(t.k0 + rr + i * 8) * t.ld + nc]; v[q][i] = ok ? x : 0.f; }
        }
#pragma unroll
        for (int q = 0; q < 4; ++q)
#pragma unroll
            for (int i = 0; i < 8; ++i) tile[q * 4160 + (rr + i * 8) * 65 + cc] = v[q][i];
        __syncthreads();
#pragma unroll
        for (int q = 0; q < 4; ++q) {
            const int it = g * 4 + q;
            if (it < TOTAL) {
                const CvtTile t = cvt_decode(p, it);
                const int nl = tid >> 3, kg = tid & 7, n = t.n0 + nl;
                float w[8];
#pragma unroll
                for (int j = 0; j < 8; ++j) w[j] = tile[q * 4160 + (kg * 8 + j) * 65 + nl];
                const int drow = t.mode == 1 ? w1_dst_row(n) : t.mode == 2 ? win_dst_row(n) : n;
                if (n < t.Nsrc) *(u32x4*)(t.dst + (size_t)drow * t.K + t.k0 + kg * 8) = pack8(w);
            }
        }
        __syncthreads();
    }
}

__device__ __forceinline__ void ph_mod(const Params& p, LAS unsigned char* lds) {
    LAS float* sc = (LAS float*)lds;
    LAS float* red = sc + 5 * D;
    const int tid = opaque_tid(), wid = tid >> 6, lane = tid & 63;
    if ((int)blockIdx.x >= 192) return;
    for (int i = tid; i < 5 * D; i += NTHREADS) { const int r = i >> 10, k = i & 1023; const float v = r < 4 ? p.c[r * D + k] : p.c_ctx[k]; sc[i] = siluf_(v); }
    __syncthreads();
    for (int it = blockIdx.x; it < 192; it += gridDim.x) {
        const int l = it / 96, n0 = (it % 96) * 64;
        float acc[5] = {0.f, 0.f, 0.f, 0.f, 0.f};
        const float* wp = p.w_mod + (size_t)l * D * (NMOD * D) + n0 + lane;
        for (int k = wid * 128; k < wid * 128 + 128; ++k) {
            const float wv = wp[(size_t)k * (NMOD * D)];
#pragma unroll
            for (int r = 0; r < 5; ++r) acc[r] += sc[r * D + k] * wv;
        }
#pragma unroll
        for (int r = 0; r < 5; ++r) red[(wid * 5 + r) * 64 + lane] = acc[r];
        __syncthreads();
        if (tid < 320) { const int r = tid >> 6, cidx = tid & 63; float s = p.b_mod[l * NMOD * D + n0 + cidx];
#pragma unroll
            for (int w = 0; w < 8; ++w) s += red[(w * 5 + r) * 64 + cidx];
            p.mod[(size_t)(l * 5 + r) * (NMOD * D) + n0 + cidx] = s; }
        __syncthreads();
    }
}

__device__ __forceinline__ void norm_mod_store(const float4 (&v)[4], float rinv, const float* g, const float* scp, const float* shp, bf16_t* dst, int lane) {
#pragma unroll
    for (int i = 0; i < 4; ++i) {
        const int cidx = i * 256 + lane * 4;
        const float4 gv = *(const float4*)(g + cidx), sv = *(const float4*)(scp + cidx), hv = *(const float4*)(shp + cidx);
        const float h0 = v[i].x * rinv * gv.x * (1.f + sv.x) + hv.x, h1 = v[i].y * rinv * gv.y * (1.f + sv.y) + hv.y;
        const float h2 = v[i].z * rinv * gv.z * (1.f + sv.z) + hv.z, h3 = v[i].w * rinv * gv.w * (1.f + sv.w) + hv.w;
        u32x2 o; o[0] = pack2(h0, h1); o[1] = pack2(h2, h3);
        *(u32x2*)(dst + cidx) = o;
    }
}
__device__ __forceinline__ void ph_norm1_first(const Params& p) {
    const int tid = opaque_tid(), wid = tid >> 6, lane = tid & 63;
    for (int tok = blockIdx.x * NWAVES + wid; tok < NTOK; tok += gridDim.x * NWAVES) {
        const float* src = tok < NLAT ? p.x + (size_t)tok * D : p.ctx + (size_t)(tok - NLAT) * D;
        float4 v[4]; float ss = 0.f;
#pragma unroll
        for (int i = 0; i < 4; ++i) { v[i] = *(const float4*)(src + i * 256 + lane * 4); ss += v[i].x * v[i].x + v[i].y * v[i].y + v[i].z * v[i].z + v[i].w * v[i].w; }
        ss = wave_sum(ss);
        const float rinv = rsqrtf(ss * (1.0f / D) + 1e-6f);
        const float* mb = p.mod + (size_t)(0 * 5 + tok_modrow(tok)) * (NMOD * D);
        norm_mod_store(v, rinv, p.norm1_g, mb + 1 * D, mb + 0 * D, p.H + (size_t)tok * D, lane);
#pragma unroll
        for (int i = 0; i < 4; ++i) *(float4*)(p.xl + (size_t)tok * D + i * 256 + lane * 4) = v[i];
    }
}

struct EpiP {
    bf16_t* O; bf16_t* gate;
    __device__ __forceinline__ bool keep(const g8::Unit&) const { return false; }
    __device__ __forceinline__ void operator()(const f32x4 (&acc)[2][2][4][2], const g8::Unit& u, int wr, int wc, int fr, int fq, const LAS float*) const {
        if (u.pn < 31) {
            const int row0 = u.pm * 256 + wr * 64 + fr, col0 = u.pn * 256 + wc * 32 + 8 * fq;
#pragma unroll
            for (int ai = 0; ai < 2; ++ai)
#pragma unroll
                for (int m = 0; m < 4; ++m) {
                    bf16_t* rowp = O + (size_t)(row0 + ai * 128 + m * 16) * NP + col0;
#pragma unroll
                    for (int bj = 0; bj < 2; ++bj) {
                        u32x4 w; w[0] = pack2(acc[ai][bj][m][0][0], acc[ai][bj][m][0][1]); w[1] = pack2(acc[ai][bj][m][0][2], acc[ai][bj][m][0][3]);
                        w[2] = pack2(acc[ai][bj][m][1][0], acc[ai][bj][m][1][1]); w[3] = pack2(acc[ai][bj][m][1][2], acc[ai][bj][m][1][3]);
                        *(u32x4*)(rowp + bj * 128) = w;
                    }
                }
        } else {
            const int g = u.pn - 31;
            bf16_t* gp = gate + ((((size_t)u.pm * 16 + g) * 8 + (wr * 4 + wc)) * 16) * 512 + (fq * 16 + fr) * 8;
#pragma unroll
            for (int ai = 0; ai < 2; ++ai)
#pragma unroll
                for (int m = 0; m < 4; ++m)
#pragma unroll
                    for (int bj = 0; bj < 2; ++bj) {
                        float s[8];
#pragma unroll
                        for (int n = 0; n < 2; ++n)
#pragma unroll
                            for (int j = 0; j < 4; ++j) s[n * 4 + j] = sigmoidf_(acc[ai][bj][m][n][j]);
                        *(u32x4*)(gp + (ai * 8 + m * 2 + bj) * 512) = pack8(s);
                    }
        }
    }
};
__device__ __forceinline__ void ph_g1(const Params& p, int l, LAS unsigned char* lds) {
    g8::PlainSched S; S.init(p.H, p.winT + (size_t)l * NPW * D, NTOK, NPW, D);
    EpiP E; E.O = p.P; E.gate = p.gate;
    g8::gemm_phase(lds, D, S, E);
}

__device__ __forceinline__ void ph_prep(const Params& p, int l, LAS unsigned char* lds) {
    const int tid = opaque_tid(), wid = tid >> 6, lane = tid & 63, fr = lane & 15, fq = lane >> 4;
    LAS float* xs = (LAS float*)lds;
    LAS bf16_t* xb = (LAS bf16_t*)(xs + 64 * 68);
    LAS bf16_t* wt = xb + 64 * 72;
    for (int it = blockIdx.x; it < (NTOK / 64) * 8; it += gridDim.x) {
        const int tile = it >> 3, n = it & 7, tok0 = tile * 64;
        {
            const int tl = tid & 63, cg = tid >> 6, tok = tok0 + tl;
            int t, T, base; tok_info(tok, t, T, base);
            float a[8];
            { const float4 b0 = *(const float4*)(p.lru_conv_b + l * MW + n * 64 + cg * 8), b1 = *(const float4*)(p.lru_conv_b + l * MW + n * 64 + cg * 8 + 4);
              a[0] = b0.x; a[1] = b0.y; a[2] = b0.z; a[3] = b0.w; a[4] = b1.x; a[5] = b1.y; a[6] = b1.z; a[7] = b1.w; }
#pragma unroll
            for (int j = 0; j < 4; ++j) {
                const int tt = t + j - 2;
                const float okf = (tt >= 0 && tt < T) ? 1.0f : 0.0f;
                const int ttc = tt < 0 ? 0 : (tt >= T ? T - 1 : tt);
                const u32x4 u = *(const u32x4*)(p.P + (size_t)(base + ttc) * NP + C_LX + n * 64 + cg * 8);
                const float* w = p.lru_conv_w + (size_t)(l * 4 + j) * MW + n * 64 + cg * 8;
                const float4 wa = *(const float4*)w, wb = *(const float4*)(w + 4);
                const float wv[8] = {wa.x * okf, wa.y * okf, wa.z * okf, wa.w * okf, wb.x * okf, wb.y * okf, wb.z * okf, wb.w * okf};
#pragma unroll
                for (int q = 0; q < 4; ++q) { a[2 * q] += wv[2 * q] * bflo(u[q]); a[2 * q + 1] += wv[2 * q + 1] * bfhi(u[q]); }
            }
            *(LAS f32x4*)(xs + tl * 68 + cg * 8) = (f32x4){a[0], a[1], a[2], a[3]}; *(LAS f32x4*)(xs + tl * 68 + cg * 8 + 4) = (f32x4){a[4], a[5], a[6], a[7]};
            *(LAS u32x4*)(xb + tl * 72 + cg * 8) = pack8(a);
            const bf16_t* wsrc = p.lruT + (size_t)((l * 8 + n) * 4) * 4096;
#pragma unroll
            for (int q = 0; q < 4; ++q) { const int e8 = tid + 512 * q, row = e8 >> 3, c8 = e8 & 7; *(LAS u32x4*)(wt + row * 72 + c8 * 8) = *(const u32x4*)(wsrc + (size_t)e8 * 8); }
        }
        __syncthreads();
        {
            const int jb = wid & 3, tb0 = (wid >> 2) * 2;
            bf16x8 xw[4][2];
#pragma unroll
            for (int m = 0; m < 4; ++m)
#pragma unroll
                for (int ks = 0; ks < 2; ++ks) xw[m][ks] = *(const LAS bf16x8*)(wt + (m * 64 + jb * 16 + fr) * 72 + ks * 32 + fq * 8);
            const int c0 = n * 64 + jb * 16 + 4 * fq;
            float4 bav[2], bxv[2], lsv[2];
#pragma unroll
            for (int d = 0; d < 2; ++d) {
                bav[d] = *(const float4*)(p.lru_ba + (l * 2 + d) * MW + c0); bxv[d] = *(const float4*)(p.lru_bx + (l * 2 + d) * MW + c0);
                const float4 lm = *(const float4*)(p.lru_lambda + (l * 2 + d) * MW + c0);
                lsv[d] = make_float4(8.0f * logsigmoidf_(lm.x), 8.0f * logsigmoidf_(lm.y), 8.0f * logsigmoidf_(lm.z), 8.0f * logsigmoidf_(lm.w));
            }
#pragma unroll
            for (int e = 0; e < 2; ++e) {
                const int tl = (tb0 + e) * 16 + fr, tok = tok0 + tl;
                f32x4 acc[4];
#pragma unroll
                for (int m = 0; m < 4; ++m) acc[m] = (f32x4){0.f, 0.f, 0.f, 0.f};
#pragma unroll
                for (int ks = 0; ks < 2; ++ks) {
                    const bf16x8 y = *(const LAS bf16x8*)(xb + tl * 72 + ks * 32 + fq * 8);
#pragma unroll
                    for (int m = 0; m < 4; ++m) acc[m] = mfma16(xw[m][ks], y, acc[m]);
                }
                const f32x4 xv = *(const LAS f32x4*)(xs + tl * 68 + jb * 16 + 4 * fq);
#pragma unroll
                for (int d = 0; d < 2; ++d) {
                    const float bar_[4] = {bav[d].x, bav[d].y, bav[d].z, bav[d].w}, bxr[4] = {bxv[d].x, bxv[d].y, bxv[d].z, bxv[d].w}, lsr[4] = {lsv[d].x, lsv[d].y, lsv[d].z, lsv[d].w};
                    float av[4], uv[4];
#pragma unroll
                    for (int r = 0; r < 4; ++r) {
                        const float gr = sigmoidf_(acc[d * 2][r] + bar_[r]), gi = sigmoidf_(acc[d * 2 + 1][r] + bxr[r]);
                        const float la = gr * lsr[r];
                        av[r] = __expf(la);
                        uv[r] = xv[r] * gi * sqrtf(fmaxf(-expm1f(2.0f * la), 1e-12f));
                    }
                    *(float4*)(p.prep + (PR_LA + d) * TOKW + (size_t)tok * MW + c0) = make_float4(av[0], av[1], av[2], av[3]);
                    *(float4*)(p.prep + (PR_LU + d) * TOKW + (size_t)tok * MW + c0) = make_float4(uv[0], uv[1], uv[2], uv[3]);
                }
            }
        }
        __syncthreads();
    }
}

__device__ __forceinline__ int chunk_base(int b, int d, int n) {
    if (n < 4) { const int blk = d ? 3 - n : n; return NLAT + b * TC + blk * 64; }
    const int m = n - 4, blk = d ? 63 - m : m; return b * TL + blk * 64;
}

__device__ __forceinline__ void local_gla(const Params& p, int l, int tz, int chain, int n, LAS unsigned char* lds) {
    const int tid = opaque_tid(), wid = tid >> 6, lane = tid & 63, fr = lane & 15, fq = lane >> 4;
    const int b = chain >> 3, h = (chain >> 1) & 3, d = chain & 1;
    const int base = chunk_base(b, d, n);
    const size_t item = (size_t)tz * NITEM + (size_t)chain * NCHUNK + n;
    LAS bf16_t* kraw = (LAS bf16_t*)lds;
    LAS bf16_t* qh = kraw + 64 * 136;
    LAS bf16_t* kh = qh + 64 * 136;
    LAS bf16_t* sc = kh + 64 * 136;
    LAS bf16_t* vT = sc + 64 * 72;
    LAS bf16_t* kT = vT + 128 * 72;
    LAS float* bc = (LAS float*)(kT + 128 * 72);
    const int vcol = tz == 1 ? C_HI : C_RQKV + 1024;
    const int ti = tid >> 3, dg = tid & 7, cA = dg * 8, cB = 64 + dg * 8;
    const int tokI = base + (d ? 63 - ti : ti);
    const bf16_t* pr = p.P + (size_t)tokI * NP;
    float qt[16];
    {
        float kv[16], lfv[16];
        if (tz == 1) {
            float lbv[16];
            {
                const float* lp0 = p.hgrn_lb + (size_t)(0 * 2 + d) * MW + h * 128; const float* lp1 = p.hgrn_lb + (size_t)(1 * 2 + d) * MW + h * 128;
                const float4 a0 = *(const float4*)(lp0 + cA), a1 = *(const float4*)(lp0 + cA + 4), a2 = *(const float4*)(lp0 + cB), a3 = *(const float4*)(lp0 + cB + 4);
                const float4 b0 = *(const float4*)(lp1 + cA), b1 = *(const float4*)(lp1 + cA + 4), b2 = *(const float4*)(lp1 + cB), b3 = *(const float4*)(lp1 + cB + 4);
                const float x0[16] = {a0.x, a0.y, a0.z, a0.w, a1.x, a1.y, a1.z, a1.w, a2.x, a2.y, a2.z, a2.w, a3.x, a3.y, a3.z, a3.w};
                const float x1[16] = {b0.x, b0.y, b0.z, b0.w, b1.x, b1.y, b1.z, b1.w, b2.x, b2.y, b2.z, b2.w, b3.x, b3.y, b3.z, b3.w};
#pragma unroll
                for (int e = 0; e < 16; ++e) lbv[e] = (l == 1) ? fminf(__builtin_amdgcn_rcpf(1.0f + __expf(x0[e] - x1[e])), 1.0f - 1e-4f) : 0.f;
            }
            const u32x4 uqa = *(const u32x4*)(pr + C_HQ + h * 128 + cA), uqb = *(const u32x4*)(pr + C_HQ + h * 128 + cB);
            const u32x4 uza = *(const u32x4*)(pr + C_HF + d * 512 + h * 128 + cA), uzb = *(const u32x4*)(pr + C_HF + d * 512 + h * 128 + cB);
#pragma unroll
            for (int e = 0; e < 16; ++e) {
                const unsigned uq = e < 8 ? uqa[(e & 7) >> 1] : uqb[(e & 7) >> 1], uz = e < 8 ? uza[(e & 7) >> 1] : uzb[(e & 7) >> 1];
                const float qraw = (e & 1) ? bfhi(uq) : bflo(uq), z = (e & 1) ? bfhi(uz) : bflo(uz);
                const float lb = lbv[e];
                const float sg = sigmoidf_(z);
                qt[e] = siluf_(qraw) * 0.08838834764831845f;
                kv[e] = (1.f - lb) * (1.f - sg);
                lfv[e] = __logf(fmaxf(lb + (1.f - lb) * sg, 1e-30f));
            }
        } else {
            const bf16_t* rp = pr + C_RQKV + h * 128;
            const u32x4 q1 = *(const u32x4*)(rp + cA), q2 = *(const u32x4*)(rp + cB), k1 = *(const u32x4*)(rp + 512 + cA), k2 = *(const u32x4*)(rp + 512 + cB);
            const float lng = log1pf(-exp2f(-5.0f - (float)h));
            const bool lat = tokI < NLAT;
            const int t = tokI & (TL - 1);
#pragma unroll
            for (int e = 0; e < 8; ++e) {
                float a1 = (e & 1) ? bfhi(q1[e >> 1]) : bflo(q1[e >> 1]), a2 = (e & 1) ? bfhi(q2[e >> 1]) : bflo(q2[e >> 1]);
                float b1 = (e & 1) ? bfhi(k1[e >> 1]) : bflo(k1[e >> 1]), b2 = (e & 1) ? bfhi(k2[e >> 1]) : bflo(k2[e >> 1]);
                if (lat) {
                    const int pi = cA + e;
                    const float pos = (pi < 32) ? (float)(t >> 6) : (float)(t & 63);
                    const float ang = pos * exp2f(-(float)(pi & 31) * (13.287712379549449f / 32.0f));
                    float sn, cs; sincosf(ang, &sn, &cs);
                    const float n1 = a1 * cs - a2 * sn, n2 = a1 * sn + a2 * cs, m1 = b1 * cs - b2 * sn, m2 = b1 * sn + b2 * cs;
                    a1 = n1; a2 = n2; b1 = m1; b2 = m2;
                }
                qt[e] = a1; qt[8 + e] = a2; kv[e] = b1 * 0.08838834764831845f; kv[8 + e] = b2 * 0.08838834764831845f;
                lfv[e] = lng; lfv[8 + e] = lng;
            }
        }
        *(LAS u32x4*)(kraw + ti * 136 + cA) = pack8(kv); *(LAS u32x4*)(kraw + ti * 136 + cB) = pack8(kv + 8);
        *(LAS f32x4*)(bc + ti * 132 + cA) = (f32x4){lfv[0], lfv[1], lfv[2], lfv[3]}; *(LAS f32x4*)(bc + ti * 132 + cA + 4) = (f32x4){lfv[4], lfv[5], lfv[6], lfv[7]};
        *(LAS f32x4*)(bc + ti * 132 + cB) = (f32x4){lfv[8], lfv[9], lfv[10], lfv[11]}; *(LAS f32x4*)(bc + ti * 132 + cB + 4) = (f32x4){lfv[12], lfv[13], lfv[14], lfv[15]};
        const bf16_t* vp = pr + vcol + h * 128;
        const u32x4 v0 = *(const u32x4*)(vp + cA), v1 = *(const u32x4*)(vp + cB);
#pragma unroll
        for (int e = 0; e < 8; ++e) {
            vT[(cA + e) * 72 + ti] = (bf16_t)((e & 1) ? (v0[e >> 1] >> 16) : (v0[e >> 1] & 0xffffu));
            vT[(cB + e) * 72 + ti] = (bf16_t)((e & 1) ? (v1[e >> 1] >> 16) : (v1[e >> 1] & 0xffffu));
        }
    }
    __syncthreads();
    if (tid < 128) {
        float run = 0.f, lv[64];
#pragma unroll
        for (int i = 0; i < 64; ++i) lv[i] = bc[i * 132 + tid];
#pragma unroll
        for (int i = 0; i < 64; ++i) { run += lv[i]; bc[i * 132 + tid] = run; }
    }
    __syncthreads();
    {
        const int I = ti >> 4;
        float qhat[16];
#pragma unroll
        for (int e = 0; e < 16; ++e) {
            const int ch = e < 8 ? cA + e : cB + e - 8;
            const float bi = bc[ti * 132 + ch], rI = I ? bc[(16 * I - 1) * 132 + ch] : 0.f, bl = bc[63 * 132 + ch];
            qhat[e] = qt[e] * __expf(bi - rI); qt[e] = qt[e] * __expf(bi);
            kT[ch * 72 + ti] = (bf16_t)f2bf(bf2f(kraw[ti * 136 + ch]) * __expf(bl - bi));
        }
        *(LAS u32x4*)(qh + ti * 136 + cA) = pack8(qhat); *(LAS u32x4*)(qh + ti * 136 + cB) = pack8(qhat + 8);
        {
            bf16_t* lqb = p.lq + item * 8192 + (size_t)((ti >> 4) * 8) * 256 + (ti & 15) * 4;
            const u32x4 pa = pack8(qt), pb = pack8(qt + 8);
            u32x2 t0; t0[0] = pa[0]; t0[1] = pa[1]; u32x2 t1; t1[0] = pa[2]; t1[1] = pa[3]; u32x2 t2; t2[0] = pb[0]; t2[1] = pb[1]; u32x2 t3; t3[0] = pb[2]; t3[1] = pb[3];
            *(u32x2*)(lqb + (dg >> 1) * 256 + ((dg & 1) * 2 + 0) * 64) = t0; *(u32x2*)(lqb + (dg >> 1) * 256 + ((dg & 1) * 2 + 1) * 64) = t1;
            *(u32x2*)(lqb + (4 + (dg >> 1)) * 256 + ((dg & 1) * 2 + 0) * 64) = t2; *(u32x2*)(lqb + (4 + (dg >> 1)) * 256 + ((dg & 1) * 2 + 1) * 64) = t3;
        }
    }
    if (tid < 128) p.ld[item * 128 + tid] = __expf(bc[63 * 132 + tid]);
    for (int I = 0; I < 4; ++I) {
        if (ti < 16 * (I + 1)) {
            float kk[16];
#pragma unroll
            for (int e = 0; e < 16; ++e) {
                const int ch = e < 8 ? cA + e : cB + e - 8;
                const float rI = I ? bc[(16 * I - 1) * 132 + ch] : 0.f, bj = bc[ti * 132 + ch];
                kk[e] = bf2f(kraw[ti * 136 + ch]) * __expf(fminf(rI - bj, 80.f));
            }
            *(LAS u32x4*)(kh + ti * 136 + cA) = pack8(kk); *(LAS u32x4*)(kh + ti * 136 + cB) = pack8(kk + 8);
        }
        __syncthreads();
        if (wid < 4) {
            const int J = wid;
            u32x2 outv; outv[0] = 0u; outv[1] = 0u;
            if (J <= I) {
                f32x4 acc = (f32x4){0.f, 0.f, 0.f, 0.f};
#pragma unroll
                for (int ks = 0; ks < 4; ++ks)
                    acc = mfma16(*(const LAS bf16x8*)(kh + (J * 16 + fr) * 136 + ks * 32 + fq * 8), *(const LAS bf16x8*)(qh + (I * 16 + fr) * 136 + ks * 32 + fq * 8), acc);
                const int i = 16 * I + fr, j0 = 16 * J + 4 * fq;
#pragma unroll
                for (int r = 0; r < 4; ++r) if (j0 + r > i) acc[r] = 0.f;
                outv = pack4(acc);
            }
            *(LAS u32x2*)(sc + (I * 16 + fr) * 72 + J * 16 + 4 * fq) = outv;
        }
        __syncthreads();
    }
    {
        bf16x8 xv[2], xk[2];
#pragma unroll
        for (int ks = 0; ks < 2; ++ks) { xv[ks] = *(const LAS bf16x8*)(vT + (wid * 16 + fr) * 72 + ks * 32 + fq * 8); xk[ks] = *(const LAS bf16x8*)(kT + (wid * 16 + fr) * 72 + ks * 32 + fq * 8); }
#pragma unroll
        for (int ib = 0; ib < 4; ++ib) {
            f32x4 acc = (f32x4){0.f, 0.f, 0.f, 0.f};
#pragma unroll
            for (int ks = 0; ks < 2; ++ks) acc = mfma16(xv[ks], *(const LAS bf16x8*)(sc + (ib * 16 + fr) * 72 + ks * 32 + fq * 8), acc);
            *(u32x2*)(p.lo + item * 8192 + ((wid * 4 + ib) * 64 + lane) * 4) = pack4(acc);
        }
#pragma unroll
        for (int dvb = 0; dvb < 8; ++dvb) {
            f32x4 acc = (f32x4){0.f, 0.f, 0.f, 0.f};
#pragma unroll
            for (int ks = 0; ks < 2; ++ks) acc = mfma16(xk[ks], *(const LAS bf16x8*)(vT + (dvb * 16 + fr) * 72 + ks * 32 + fq * 8), acc);
            *(u32x2*)(p.lb + item * 16384 + ((wid * 8 + dvb) * 64 + lane) * 4) = pack4(acc);
        }
    }
    __syncthreads();
}


template <int MODE> __device__ __forceinline__ void local_ret(const Params& p, int l, int chain, int n, LAS unsigned char* lds) {
    const int tid = opaque_tid(), wid = tid >> 6, lane = tid & 63, fr = lane & 15, fq = lane >> 4;
    const int b = chain >> 3, h = (chain >> 1) & 3, d = chain & 1;
    const int base = chunk_base(b, d, n);
    const size_t item = (size_t)2 * NITEM + (size_t)chain * NCHUNK + n;
    LAS bf16_t* ks_ = (LAS bf16_t*)lds;
    LAS bf16_t* qs = ks_ + 64 * 136;
    LAS bf16_t* sc = qs + 64 * 136;
    LAS bf16_t* vT = sc + 64 * 72;
    LAS bf16_t* kT = vT + 128 * 72;
    const int ti = tid >> 3, dg = tid & 7, cA = dg * 8, cB = 64 + dg * 8;
    const int tokI = base + (d ? 63 - ti : ti);
    const bf16_t* pr = p.P + (size_t)tokI * NP + C_RQKV + h * 128;
    const float lng = log1pf(-exp2f(-5.0f - (float)h));
    {
        const u32x4 q1 = *(const u32x4*)(pr + cA), q2 = *(const u32x4*)(pr + cB), k1 = *(const u32x4*)(pr + 512 + cA), k2 = *(const u32x4*)(pr + 512 + cB);
        const u32x4 v0 = *(const u32x4*)(pr + 1024 + cA), v1 = *(const u32x4*)(pr + 1024 + cB);
        const bool lat = tokI < NLAT;
        const int t = tokI & (TL - 1);
        float qv[16], kv[16];
#pragma unroll
        for (int e = 0; e < 8; ++e) {
            float a1 = (e & 1) ? bfhi(q1[e >> 1]) : bflo(q1[e >> 1]), a2 = (e & 1) ? bfhi(q2[e >> 1]) : bflo(q2[e >> 1]);
            float b1 = (e & 1) ? bfhi(k1[e >> 1]) : bflo(k1[e >> 1]), b2 = (e & 1) ? bfhi(k2[e >> 1]) : bflo(k2[e >> 1]);
            if (lat) {
                const int pi = cA + e;
                const float pos = (pi < 32) ? (float)(t >> 6) : (float)(t & 63);
                const float ang = pos * exp2f(-(float)(pi & 31) * (13.287712379549449f / 32.0f));
                float sn, cs; sincosf(ang, &sn, &cs);
                const float n1 = a1 * cs - a2 * sn, n2 = a1 * sn + a2 * cs, m1 = b1 * cs - b2 * sn, m2 = b1 * sn + b2 * cs;
                a1 = n1; a2 = n2; b1 = m1; b2 = m2;
            }
            qv[e] = a1; qv[8 + e] = a2; kv[e] = b1 * 0.08838834764831845f; kv[8 + e] = b2 * 0.08838834764831845f;
        }
        *(LAS u32x4*)(ks_ + ti * 136 + cA) = pack8(kv); *(LAS u32x4*)(ks_ + ti * 136 + cB) = pack8(kv + 8);
        *(LAS u32x4*)(qs + ti * 136 + cA) = pack8(qv); *(LAS u32x4*)(qs + ti * 136 + cB) = pack8(qv + 8);
        const float gq = __expf((float)(ti + 1) * lng), gk = __expf((float)(63 - ti) * lng);
#pragma unroll
        for (int e = 0; e < 8; ++e) {
            vT[(cA + e) * 72 + ti] = (bf16_t)((e & 1) ? (v0[e >> 1] >> 16) : (v0[e >> 1] & 0xffffu));
            vT[(cB + e) * 72 + ti] = (bf16_t)((e & 1) ? (v1[e >> 1] >> 16) : (v1[e >> 1] & 0xffffu));
            kT[(cA + e) * 72 + ti] = (bf16_t)f2bf(kv[e] * gk); kT[(cB + e) * 72 + ti] = (bf16_t)f2bf(kv[8 + e] * gk);
            qv[e] *= gq; qv[8 + e] *= gq;
        }
        {
            bf16_t* lqb = p.lq + item * 8192 + (size_t)((ti >> 4) * 8) * 256 + (ti & 15) * 4;
            const u32x4 pa = pack8(qv), pb = pack8(qv + 8);
            u32x2 t0; t0[0] = pa[0]; t0[1] = pa[1]; u32x2 t1; t1[0] = pa[2]; t1[1] = pa[3]; u32x2 t2; t2[0] = pb[0]; t2[1] = pb[1]; u32x2 t3; t3[0] = pb[2]; t3[1] = pb[3];
            *(u32x2*)(lqb + (dg >> 1) * 256 + ((dg & 1) * 2 + 0) * 64) = t0; *(u32x2*)(lqb + (dg >> 1) * 256 + ((dg & 1) * 2 + 1) * 64) = t1;
            *(u32x2*)(lqb + (4 + (dg >> 1)) * 256 + ((dg & 1) * 2 + 0) * 64) = t2; *(u32x2*)(lqb + (4 + (dg >> 1)) * 256 + ((dg & 1) * 2 + 1) * 64) = t3;
        }
    }
    if (tid < 128) p.ld[item * 128 + tid] = __expf(64.0f * lng);
    __syncthreads();
#pragma unroll
    for (int e = 0; e < 2; ++e) {
        const int f = wid * 2 + e, ib = f >> 2, jb = f & 3;
        const int i = 16 * ib + fr, j0 = 16 * jb + 4 * fq;
        f32x4 mq = (f32x4){0.f, 0.f, 0.f, 0.f};
        if (jb <= ib) {
#pragma unroll
            for (int ks = 0; ks < 4; ++ks)
                mq = mfma16(*(const LAS bf16x8*)(ks_ + (jb * 16 + fr) * 136 + ks * 32 + fq * 8), *(const LAS bf16x8*)(qs + i * 136 + ks * 32 + fq * 8), mq);
#pragma unroll
            for (int r = 0; r < 4; ++r) { const int j = j0 + r; mq[r] = (j <= i) ? mq[r] * __expf((float)(i - j) * lng) : 0.f; }
        }
        *(LAS u32x2*)(sc + i * 72 + j0) = pack4(mq);
    }
    __syncthreads();
    {
        bf16x8 xv[2], xk[2];
#pragma unroll
        for (int ks = 0; ks < 2; ++ks) { xv[ks] = *(const LAS bf16x8*)(vT + (wid * 16 + fr) * 72 + ks * 32 + fq * 8); xk[ks] = *(const LAS bf16x8*)(kT + (wid * 16 + fr) * 72 + ks * 32 + fq * 8); }
#pragma unroll
        for (int ib = 0; ib < 4; ++ib) {
            f32x4 acc = (f32x4){0.f, 0.f, 0.f, 0.f};
#pragma unroll
            for (int ks = 0; ks < 2; ++ks) acc = mfma16(xv[ks], *(const LAS bf16x8*)(sc + (ib * 16 + fr) * 72 + ks * 32 + fq * 8), acc);
            *(u32x2*)(p.lo + item * 8192 + ((wid * 4 + ib) * 64 + lane) * 4) = pack4(acc);
        }
#pragma unroll
        for (int dvb = 0; dvb < 8; ++dvb) {
            f32x4 acc = (f32x4){0.f, 0.f, 0.f, 0.f};
#pragma unroll
            for (int ks = 0; ks < 2; ++ks) acc = mfma16(xk[ks], *(const LAS bf16x8*)(vT + (dvb * 16 + fr) * 72 + ks * 32 + fq * 8), acc);
            *(u32x2*)(p.lb + item * 16384 + ((wid * 8 + dvb) * 64 + lane) * 4) = pack4(acc);
        }
    }
    __syncthreads();
}

template <int I> struct SolveRows {
    static __device__ __forceinline__ void run(float (&x)[64], const LAS float* Mf, const LAS float* rs) {
        SolveRows<I - 1>::run(x, Mf, rs);
        float r = x[I] * rs[I];
        float pa[4] = {0.f, 0.f, 0.f, 0.f};
#pragma unroll
        for (int j4 = 0; j4 < (I + 3) / 4; ++j4) {
            const f32x4 m = *(const LAS f32x4*)(Mf + I * 68 + j4 * 4);
            pa[0] += m[0] * x[j4 * 4]; pa[1] += m[1] * x[j4 * 4 + 1]; pa[2] += m[2] * x[j4 * 4 + 2]; pa[3] += m[3] * x[j4 * 4 + 3];
        }
        r -= (pa[0] + pa[1]) + (pa[2] + pa[3]);
        asm volatile("" : "+v"(r) :: "memory");
        x[I] = r;
    }
};
template <> struct SolveRows<-1> { static __device__ __forceinline__ void run(float (&)[64], const LAS float*, const LAS float*) {} };

__device__ __forceinline__ void local_gdn(const Params& p, int l, int chain, int n, LAS unsigned char* lds) {
    const int tid = opaque_tid(), wid = tid >> 6, lane = tid & 63, fr = lane & 15, fq = lane >> 4;
    const int b = chain >> 3, h = (chain >> 1) & 3, d = chain & 1;
    const int base = chunk_base(b, d, n);
    const size_t item = (size_t)chain * NCHUNK + n;
    LAS bf16_t* ks_ = (LAS bf16_t*)lds;
    LAS bf16_t* qs = ks_ + 64 * 136;
    LAS bf16_t* att = qs + 64 * 136;
    LAS bf16_t* wT = att + 64 * 72;
    LAS bf16_t* uT = wT + 128 * 72;
    LAS bf16_t* kT = uT + 128 * 72;
    LAS float* Mf = (LAS float*)(kT + 128 * 72);
    LAS float* bcs = Mf + 64 * 68;
    LAS float* bts = bcs + 64;
    LAS float* rse = bts + 64;
    LAS bf16_t* vs = (LAS bf16_t*)(rse + 64);
    const int ti = tid >> 3, d0 = (tid & 7) * 16;
    const int tokI = base + (d ? 63 - ti : ti);
    {
        int t, T, sbase; tok_info(tokI, t, T, sbase);
#pragma unroll
        for (int part = 0; part < 3; ++part) {
            float a[16];
#pragma unroll
            for (int e = 0; e < 16; ++e) a[e] = 0.f;
            const int ccol = part * 512 + h * 128 + d0;
#pragma unroll
            for (int j = 0; j < 4; ++j) {
                const int tt = t + j - 2;
                const float okf = (tt >= 0 && tt < T) ? 1.0f : 0.0f;
                const int ttc = tt < 0 ? 0 : (tt >= T ? T - 1 : tt);
                const bf16_t* xp = p.P + (size_t)(sbase + ttc) * NP + C_GQKV + ccol;
                const u32x4 x0 = *(const u32x4*)xp, x1 = *(const u32x4*)(xp + 8);
                const float* wp = p.gdn_conv_w + (size_t)(l * 4 + j) * 1536 + ccol;
#pragma unroll
                for (int q = 0; q < 4; ++q) {
                    float4 w0 = *(const float4*)(wp + q * 4);
                    w0.x *= okf; w0.y *= okf; w0.z *= okf; w0.w *= okf;
                    const unsigned ua = q < 2 ? x0[2 * q] : x1[2 * q - 4], ub = q < 2 ? x0[2 * q + 1] : x1[2 * q - 3];
                    a[q * 4] += w0.x * bflo(ua); a[q * 4 + 1] += w0.y * bfhi(ua); a[q * 4 + 2] += w0.z * bflo(ub); a[q * 4 + 3] += w0.w * bfhi(ub);
                }
            }
            float ss = 0.f;
#pragma unroll
            for (int e = 0; e < 16; ++e) { a[e] = siluf_(a[e]); ss += a[e] * a[e]; }
            if (part < 2) {
                ss += __shfl_xor(ss, 1); ss += __shfl_xor(ss, 2); ss += __shfl_xor(ss, 4);
                const float scl = rsqrtf(ss + 1e-6f) * (part == 0 ? 0.08838834764831845f : 1.0f);
#pragma unroll
                for (int e = 0; e < 16; ++e) a[e] *= scl;
            }
            LAS bf16_t* dstt = (part == 0 ? qs : part == 1 ? ks_ : vs) + ti * 136 + d0;
            *(LAS u32x4*)dstt = pack8(a); *(LAS u32x4*)(dstt + 8) = pack8(a + 8);
        }
    }
    if (wid == 0) {
        const int tok = base + (d ? 63 - lane : lane);
        const float av = bf2f(p.P[(size_t)tok * NP + C_GA + d * 4 + h]);
        float v = -__expf(p.gdn_a_log[l * 8 + d * 4 + h]) * softplusf_(av + p.gdn_dt_bias[l * 8 + d * 4 + h]);
#pragma unroll
        for (int off = 1; off < 64; off <<= 1) { const float t = __shfl_up(v, off); if (lane >= off) v += t; }
        const float btv = sigmoidf_(bf2f(p.P[(size_t)tok * NP + C_GB + d * 4 + h]));
        bcs[lane] = v; bts[lane] = btv; rse[lane] = btv * __expf(v);
    }
    __syncthreads();
#pragma unroll
    for (int e = 0; e < 2; ++e) {
        const int f = wid * 2 + e, ib = f >> 2, jb = f & 3;
        const int i = 16 * ib + fr, j0 = 16 * jb + 4 * fq;
        f32x4 mk = (f32x4){0.f, 0.f, 0.f, 0.f}, mq = (f32x4){0.f, 0.f, 0.f, 0.f};
        if (jb <= ib) {
#pragma unroll
            for (int ks = 0; ks < 4; ++ks) {
                const bf16x8 xk = *(const LAS bf16x8*)(ks_ + (jb * 16 + fr) * 136 + ks * 32 + fq * 8);
                mk = mfma16(xk, *(const LAS bf16x8*)(ks_ + (ib * 16 + fr) * 136 + ks * 32 + fq * 8), mk);
                mq = mfma16(xk, *(const LAS bf16x8*)(qs + (ib * 16 + fr) * 136 + ks * 32 + fq * 8), mq);
            }
            const float bi = bcs[i], bti = bts[i];
#pragma unroll
            for (int r = 0; r < 4; ++r) {
                const int j = j0 + r;
                const float dec = __expf(j <= i ? bi - bcs[j] : 0.f);
                mk[r] = (j < i) ? bti * mk[r] * dec : 0.f;
                mq[r] = (j <= i) ? mq[r] * dec : 0.f;
            }
        }
        *(LAS f32x4*)(Mf + i * 68 + j0) = mk;
        *(LAS u32x2*)(att + i * 72 + j0) = pack4(mq);
    }
    __syncthreads();
    {
        const float sc_ = __expf(bcs[63] - bcs[ti]);
#pragma unroll
        for (int e = 0; e < 16; ++e) kT[(d0 + e) * 72 + ti] = (bf16_t)f2bf(bf2f(ks_[ti * 136 + d0 + e]) * sc_);
    }
    if (tid < 256) {
        const int cidx = tid & 127;
        const bool isw = tid >= 128;
        const LAS bf16_t* srcp = (isw ? ks_ : vs) + cidx;
        float x[64];
#pragma unroll
        for (int i = 0; i < 64; ++i) x[i] = bf2f(srcp[i * 136]);
        {
            unsigned mb = (unsigned)(size_t)Mf, rb = (unsigned)(size_t)(isw ? rse : bts);
            asm volatile("" : "+v"(mb), "+v"(rb));
            SolveRows<63>::run(x, (const LAS float*)(size_t)mb, (const LAS float*)(size_t)rb);
        }
        if (isw) {
#pragma unroll
            for (int i = 0; i < 64; ++i) x[i] = -x[i];
        }
        LAS bf16_t* dst = (isw ? wT : uT) + cidx * 72;
#pragma unroll
        for (int q = 0; q < 8; ++q) *(LAS u32x4*)(dst + q * 8) = pack8(x + q * 8);
    }
    if (tid < 128) p.ld[item * 128 + tid] = __expf(bcs[63]);
    __syncthreads();
    {
        const int tid = opaque_tid(), wid = tid >> 6, lane = tid & 63, fr = lane & 15, fq = lane >> 4;
        bf16x8 xw[2], xu[2], xk[2];
#pragma unroll
        for (int ks = 0; ks < 2; ++ks) {
            xw[ks] = *(const LAS bf16x8*)(wT + (wid * 16 + fr) * 72 + ks * 32 + fq * 8);
            xu[ks] = *(const LAS bf16x8*)(uT + (wid * 16 + fr) * 72 + ks * 32 + fq * 8);
            xk[ks] = *(const LAS bf16x8*)(kT + (wid * 16 + fr) * 72 + ks * 32 + fq * 8);
        }
#pragma unroll
        for (int ib = 0; ib < 4; ++ib) {
            const int i = ib * 16 + fr;
            const u32x2 qr = *(const LAS u32x2*)(qs + i * 136 + wid * 16 + 4 * fq);
            const float eb = __expf(bcs[i]);
            f32x4 aq = (f32x4){bflo(qr[0]) * eb, bfhi(qr[0]) * eb, bflo(qr[1]) * eb, bfhi(qr[1]) * eb};
            f32x4 ao = (f32x4){0.f, 0.f, 0.f, 0.f};
#pragma unroll
            for (int ks = 0; ks < 2; ++ks) {
                const bf16x8 ya = *(const LAS bf16x8*)(att + i * 72 + ks * 32 + fq * 8);
                aq = mfma16(xw[ks], ya, aq); ao = mfma16(xu[ks], ya, ao);
            }
            *(u32x2*)(p.lq + item * 8192 + ((ib * 8 + wid) * 64 + lane) * 4) = pack4(aq);
            *(u32x2*)(p.lo + item * 8192 + ((wid * 4 + ib) * 64 + lane) * 4) = pack4(ao);
        }
#pragma unroll
        for (int db = 0; db < 8; ++db) {
            f32x4 aa = (f32x4){0.f, 0.f, 0.f, 0.f}, ab = (f32x4){0.f, 0.f, 0.f, 0.f};
#pragma unroll
            for (int ks = 0; ks < 2; ++ks) {
                aa = mfma16(xw[ks], *(const LAS bf16x8*)(kT + (db * 16 + fr) * 72 + ks * 32 + fq * 8), aa);
                ab = mfma16(xk[ks], *(const LAS bf16x8*)(uT + (db * 16 + fr) * 72 + ks * 32 + fq * 8), ab);
            }
            *(u32x2*)(p.la + item * 16384 + ((db * 8 + wid) * 64 + lane) * 4) = pack4(aa);
            *(u32x2*)(p.lb + item * 16384 + ((wid * 8 + db) * 64 + lane) * 4) = pack4(ab);
        }
    }
    __syncthreads();
}

__device__ __forceinline__ void ph_local(const Params& p, int l, LAS unsigned char* lds) {
    for (int it = blockIdx.x; it < 3 * NITEM; it += gridDim.x) {
        const int tz = it % 3, ci = it / 3, chain = ci / NCHUNK, n = ci % NCHUNK;
        if (tz == 0) local_gdn(p, l, chain, n, lds); else if (tz == 1) local_gla(p, l, tz, chain, n, lds); else local_ret<0>(p, l, chain, n, lds);
    }
}

__device__ __forceinline__ void seq_matrix(const Params& p, int tz, int chain, int half, LAS unsigned char* lds) {
    const int tid = opaque_tid(), wid = tid >> 6, lane = tid & 63, fr = lane & 15, fq = lane >> 4;
    const int b = chain >> 3, h = (chain >> 1) & 3, d = chain & 1;
    LAS bf16_t* ST = (LAS bf16_t*)lds;
    float* Op = p.O + (size_t)((tz == 0 ? 0 : tz == 1 ? 1 : 3) * 2 + d) * TOKW;
    f32x4 S[4];
#pragma unroll
    for (int q = 0; q < 4; ++q) S[q] = (f32x4){0.f, 0.f, 0.f, 0.f};
    const int ib = wid >> 1, dv2 = (wid & 1) * 2;
    struct Ops { u32x2 yq[8], xa[8], oin[2], bin[4]; f32x4 dec; };
    auto load_ops = [&](int n, Ops& o) {
        const size_t item = (size_t)tz * NITEM + (size_t)chain * NCHUNK + n;
        const bf16_t* lqp = p.lq + item * 8192 + (size_t)(ib * 8) * 256 + lane * 4;
#pragma unroll
        for (int q = 0; q < 8; ++q) o.yq[q] = *(const u32x2*)(lqp + q * 256);
        if (tz == 0) {
            const bf16_t* lap = p.la + ((size_t)chain * NCHUNK + n) * 16384 + (size_t)(wid * 8) * 256 + lane * 4;
#pragma unroll
            for (int q = 0; q < 8; ++q) o.xa[q] = *(const u32x2*)(lap + q * 256);
        }
#pragma unroll
        for (int e2 = 0; e2 < 2; ++e2)
            o.oin[e2] = *(const u32x2*)(p.lo + item * 8192 + (((half * 4 + dv2 + (fq >> 1)) * 4 + ib) * 64 + fr + 16 * (2 * (fq & 1) + e2)) * 4);
#pragma unroll
        for (int q = 0; q < 4; ++q) o.bin[q] = *(const u32x2*)(p.lb + item * 16384 + ((wid * 8 + half * 4 + q) * 64 + lane) * 4);
        o.dec = *(const f32x4*)(p.ld + item * 128 + wid * 16 + 4 * fq);
    };
    Ops s0, s1, s2; load_ops(0, s0); load_ops(1, s1);
    auto step = [&](int n, Ops& cur, Ops& fill) {
        load_ops(n + 2 < NCHUNK ? n + 2 : n, fill);
        LAS bf16_t* st = ST + (n & 1) * 64 * 136;
#pragma unroll
        for (int q = 0; q < 4; ++q) *(LAS u32x2*)(st + (q * 16 + fr) * 136 + 32 * (wid >> 1) + 8 * fq + 4 * (wid & 1)) = pack4(S[q]);
        __syncthreads();
        const int base = chunk_base(b, d, n);
        const int tok = base + (d ? 63 - (ib * 16 + fr) : ib * 16 + fr);
        {
            f32x4 ao[2];
#pragma unroll
            for (int e2 = 0; e2 < 2; ++e2) {
                f32x4 acc = (f32x4){bflo(cur.oin[e2][0]), bfhi(cur.oin[e2][0]), bflo(cur.oin[e2][1]), bfhi(cur.oin[e2][1])};
                const int prow = dv2 * 16 + 8 * (fr >> 2) + 4 * e2 + (fr & 3);
#pragma unroll
                for (int ks = 0; ks < 4; ++ks) {
                    u32x4 t; t[0] = cur.yq[2 * ks][0]; t[1] = cur.yq[2 * ks][1]; t[2] = cur.yq[2 * ks + 1][0]; t[3] = cur.yq[2 * ks + 1][1];
                    acc = mfma16(*(const LAS bf16x8*)(st + prow * 136 + ks * 32 + fq * 8), __builtin_bit_cast(bf16x8, t), acc);
                }
                ao[e2] = acc;
            }
            float* op = Op + (size_t)tok * MW + h * 128 + half * 64 + dv2 * 16 + 8 * fq;
            *(f32x4*)op = ao[0]; *(f32x4*)(op + 4) = ao[1];
        }
#pragma unroll
        for (int q = 0; q < 4; ++q) {
            f32x4 acc = (f32x4){cur.dec[0] * S[q][0] + bflo(cur.bin[q][0]), cur.dec[1] * S[q][1] + bfhi(cur.bin[q][0]), cur.dec[2] * S[q][2] + bflo(cur.bin[q][1]), cur.dec[3] * S[q][3] + bfhi(cur.bin[q][1])};
            if (tz == 0) {
#pragma unroll
                for (int ks = 0; ks < 4; ++ks) {
                    u32x4 t; t[0] = cur.xa[2 * ks][0]; t[1] = cur.xa[2 * ks][1]; t[2] = cur.xa[2 * ks + 1][0]; t[3] = cur.xa[2 * ks + 1][1];
                    acc = mfma16(__builtin_bit_cast(bf16x8, t), *(const LAS bf16x8*)(st + (q * 16 + fr) * 136 + ks * 32 + fq * 8), acc);
                }
            }
            S[q] = acc;
        }
    };
    for (int n = 0; n < NCHUNK; n += 3) {
        step(n, s0, s2);
        if (n + 1 < NCHUNK) step(n + 1, s1, s0);
        if (n + 2 < NCHUNK) step(n + 2, s2, s1);
    }
    __syncthreads();
}

__device__ __forceinline__ void seq_lru(const Params& p, int b, int d, int cg, LAS unsigned char* lds) {
    const int tid = opaque_tid(), seg = tid >> 6, ch = cg * 64 + (tid & 63);
    LAS float* sP = (LAS float*)lds;
    LAS float* sL = sP + 512;
    const float* A = p.prep + (size_t)(PR_LA + d) * TOKW + ch; const float* U = p.prep + (size_t)(PR_LU + d) * TOKW + ch;
    float* Op = p.O + (size_t)(2 * 2 + d) * TOKW + ch;
    constexpr int SEG = (TC + TL) / 8;
    auto tok_of = [&](int pos) { return pos < TC ? NLAT + b * TC + (d ? TC - 1 - pos : pos) : b * TL + (d ? TL - 1 - (pos - TC) : pos - TC); };
    float P = 1.f, L = 0.f;
    for (int i0 = 0; i0 < SEG; i0 += 32) {
        float av[32], uv[32];
#pragma unroll
        for (int q = 0; q < 32; ++q) { const size_t o = (size_t)tok_of(seg * SEG + i0 + q) * MW; av[q] = A[o]; uv[q] = U[o]; }
#pragma unroll
        for (int q = 0; q < 32; ++q) { L = av[q] * L + uv[q]; P *= av[q]; }
    }
    sP[tid] = P; sL[tid] = L;
    __syncthreads();
    float hst = 0.f;
    for (int s = 0; s < seg; ++s) hst = sP[s * 64 + (tid & 63)] * hst + sL[s * 64 + (tid & 63)];
    for (int i0 = 0; i0 < SEG; i0 += 32) {
        float av[32], uv[32];
#pragma unroll
        for (int q = 0; q < 32; ++q) { const size_t o = (size_t)tok_of(seg * SEG + i0 + q) * MW; av[q] = A[o]; uv[q] = U[o]; }
#pragma unroll
        for (int q = 0; q < 32; ++q) { hst = av[q] * hst + uv[q]; Op[(size_t)tok_of(seg * SEG + i0 + q) * MW] = hst; }
    }
    __syncthreads();
}

__device__ __forceinline__ void ph_seq(const Params& p, LAS unsigned char* lds) {
    for (int it = blockIdx.x; it < 256; it += gridDim.x) {
        if (it < 192) { const int tz = it >> 6, r = it & 63; seq_matrix(p, tz, r >> 1, r & 1, lds); }
        else { const int r = it - 192; seq_lru(p, r >> 4, (r >> 3) & 1, r & 7, lds); }
    }
}

__device__ __forceinline__ void ph_merge(const Params& p, int l, int M) {
    const int tid = opaque_tid(), wid = tid >> 6, lane = tid & 63;
    const float* Ob = opaque_sptr(p.O); const bf16_t* Pb = opaque_sptr(p.P); bf16_t* Yb = opaque_sptr(p.Y);
    float2 gn[3];
#pragma unroll
    for (int m = 0; m < 3; ++m) gn[m] = *(const float2*)((m == 0 ? p.gdn_norm_g : m == 1 ? p.hgrn_norm_g : p.ret_norm_g) + l * 128 + lane * 2);
    for (int tok = blockIdx.x * NWAVES + wid; tok < M; tok += gridDim.x * NWAVES) {
        f32x2 o0[16], o1[16]; unsigned gz[16];
#pragma unroll
        for (int r = 0; r < 16; ++r) {
            const int m = r >> 2, head = r & 3, cidx = head * 128 + lane * 2;
            const size_t o = (size_t)tok * MW + cidx;
            o0[r] = *(const f32x2*)(Ob + (size_t)(m * 2) * TOKW + o); o1[r] = *(const f32x2*)(Ob + (size_t)(m * 2 + 1) * TOKW + o);
            const int zc = m == 0 ? C_GZ : m == 1 ? C_HG : m == 2 ? C_LY : C_RG;
            gz[r] = *(const unsigned*)(Pb + (size_t)tok * NP + zc + cidx);
        }
        float a0[16], a1[16], ss[16];
#pragma unroll
        for (int r = 0; r < 16; ++r) { a0[r] = o0[r][0] + o1[r][0]; a1[r] = o0[r][1] + o1[r][1]; ss[r] = a0[r] * a0[r] + a1[r] * a1[r]; }
#pragma unroll
        for (int msk = 32; msk >= 1; msk >>= 1)
#pragma unroll
            for (int r = 0; r < 16; ++r) if ((r >> 2) != 2) ss[r] += __shfl_xor(ss[r], msk);
#pragma unroll
        for (int r = 0; r < 16; ++r) {
            const int m = r >> 2, head = r & 3, cidx = head * 128 + lane * 2;
            float y0, y1; int nbr;
            if (m == 2) { y0 = a0[r] * gelu_tanhf_(bflo(gz[r])); y1 = a1[r] * gelu_tanhf_(bfhi(gz[r])); nbr = 2; }
            else {
                const float rinv = rsqrtf(ss[r] * (1.0f / 128.0f) + 1e-6f);
                const float2 g = gn[m == 3 ? 2 : m];
                y0 = a0[r] * rinv * g.x * siluf_(bflo(gz[r])); y1 = a1[r] * rinv * g.y * siluf_(bfhi(gz[r])); nbr = m == 3 ? 3 : m;
            }
            *(unsigned*)(Yb + (size_t)nbr * TOKW + (size_t)tok * MW + cidx) = pack2(y0, y1);
        }
    }
}

struct G2Sched {
    const bf16_t* Y; const bf16_t* Wb; int ntiles, G, c;
    static constexpr bool HAS_BIAS = false, gather = false;
    __device__ __forceinline__ bool next(int i, g8::Unit& u) const {
        const int tile = (i >> 2) * G + c; if (tile >= ntiles) return false;
        u.pm = tile >> 2; u.pn = tile & 3; u.e = i & 3; return true;
    }
    __device__ __forceinline__ const char* a_base(const g8::Unit& u) const { return (const char*)(Y + (size_t)u.e * TOKW + (size_t)u.pm * 256 * MW); }
    __device__ __forceinline__ const char* b_base(const g8::Unit& u) const { return (const char*)(Wb + (size_t)u.e * D * MW + (size_t)u.pn * 256 * MW); }
    __device__ __forceinline__ const int* row_addr(const g8::Unit&, int) const { return nullptr; }
    __device__ __forceinline__ int rows_valid(const g8::Unit&) const { return 256; }
    __device__ __forceinline__ const float* bias_src(const g8::Unit&, int) const { return nullptr; }
};
struct EpiMix {
    const bf16_t* gate; bf16_t* O;
    __device__ __forceinline__ bool keep(const g8::Unit& u) const { return u.e < 3; }
    __device__ __forceinline__ void operator()(f32x4 (&acc)[2][2][4][2], const g8::Unit& u, int wr, int wc, int fr, int fq, const LAS float*) const {
        const int row0 = u.pm * 256 + wr * 64 + fr, col0 = u.pn * 256 + wc * 32 + 8 * fq;
        const bool lastseg = u.e == 3;
        const bf16_t* gc = gate + ((((size_t)u.pm * 16 + u.e * 4 + u.pn) * 8 + (wr * 4 + wc)) * 16) * 512 + (fq * 16 + fr) * 8;
        const bf16_t* gn = gc + (lastseg ? 0 : (size_t)4 * 8 * 16 * 512);
#pragma unroll
        for (int ah = 0; ah < 4; ++ah) {
            const int ai = ah >> 1;
            u32x4 c[4], x[4];
#pragma unroll
            for (int q = 0; q < 4; ++q) { c[q] = *(const u32x4*)(gc + (ah * 4 + q) * 512); x[q] = *(const u32x4*)(gn + (ah * 4 + q) * 512); }
#pragma unroll
            for (int q = 0; q < 4; ++q) {
                const int m = (ah & 1) * 2 + (q >> 1), bj = q & 1;
#pragma unroll
                for (int w = 0; w < 4; ++w) {
                    const float c0 = bflo(c[q][w]), c1 = bfhi(c[q][w]);
                    const float s0 = lastseg ? c0 : c0 * __builtin_amdgcn_rcpf(bflo(x[q][w])), s1 = lastseg ? c1 : c1 * __builtin_amdgcn_rcpf(bfhi(x[q][w]));
                    acc[ai][bj][m][w >> 1][(w & 1) * 2] *= s0; acc[ai][bj][m][w >> 1][(w & 1) * 2 + 1] *= s1;
                }
            }
        }
        if (lastseg) {
#pragma unroll
            for (int ai = 0; ai < 2; ++ai)
#pragma unroll
                for (int m = 0; m < 4; ++m)
#pragma unroll
                    for (int bj = 0; bj < 2; ++bj) {
                        u32x4 w; w[0] = pack2(acc[ai][bj][m][0][0], acc[ai][bj][m][0][1]); w[1] = pack2(acc[ai][bj][m][0][2], acc[ai][bj][m][0][3]);
                        w[2] = pack2(acc[ai][bj][m][1][0], acc[ai][bj][m][1][1]); w[3] = pack2(acc[ai][bj][m][1][2], acc[ai][bj][m][1][3]);
                        *(u32x4*)(O + (size_t)(row0 + ai * 128 + m * 16) * D + col0 + bj * 128) = w;
                    }
        }
    }
};
__device__ __forceinline__ void ph_g2(const Params& p, int l, int M, LAS unsigned char* lds) {
    G2Sched S; S.Y = p.Y; S.Wb = p.wbT + (size_t)l * 4 * D * MW; S.ntiles = (M / 256) * 4; S.G = gridDim.x; S.c = blockIdx.x;
    EpiMix E; E.gate = p.gate; E.O = p.mix;
    g8::gemm_phase(lds, MW, S, E);
}

template <bool DRY> struct EpiRes {
    float* xl; float* xo; const float* mod;
    __device__ __forceinline__ bool keep(const g8::Unit&) const { return false; }
    __device__ __forceinline__ void operator()(const f32x4 (&acc)[2][2][4][2], const g8::Unit& u, int wr, int wc, int fr, int fq, const LAS float*) const {
        const int row0 = u.pm * 256 + wr * 64 + fr, col0 = u.pn * 256 + wc * 32 + 8 * fq;
#pragma unroll
        for (int ai = 0; ai < 2; ++ai)
#pragma unroll
            for (int m = 0; m < 4; ++m) {
                const int row = row0 + ai * 128 + m * 16;
                const float* gtp = mod + (size_t)tok_modrow(row) * (NMOD * D) + 2 * D + col0;
#pragma unroll
                for (int bj = 0; bj < 2; ++bj)
#pragma unroll
                    for (int n = 0; n < 2; ++n) {
                        const float4 gt = *(const float4*)(gtp + bj * 128 + n * 4);
                        const size_t o = (size_t)row * D + col0 + bj * 128 + n * 4;
                        float4 xv = *(const float4*)(xl + o);
                        xv.x += gt.x * acc[ai][bj][m][n][0]; xv.y += gt.y * acc[ai][bj][m][n][1]; xv.z += gt.z * acc[ai][bj][m][n][2]; xv.w += gt.w * acc[ai][bj][m][n][3];
                        *(float4*)(xo + o) = xv;
                    }
            }
    }
};
template <bool DRY = false> __device__ __forceinline__ void ph_g3(const Params& p, int l, int M, LAS unsigned char* lds) {
    g8::PlainSched S; S.init(p.mix, p.woutT + (size_t)l * D * D, M, D, D);
    EpiRes<DRY> E; E.xl = p.xl; E.xo = DRY ? p.prep : p.xl; E.mod = p.mod + (size_t)(l * 5) * (NMOD * D);
    g8::gemm_phase(lds, D, S, E);
}

template <bool DRY = false> __device__ __forceinline__ void ph_route(const Params& p, int l, int M, LAS unsigned char* lds) {
    int* const r_cnt = DRY ? p.cnt + 64 : p.cnt; int* const r_list = DRY ? (int*)p.act : p.list; int* const r_ts = DRY ? (int*)p.yp : p.tokslot; float* const r_tw = DRY ? (float*)p.yp + (size_t)NTOK * 4 : p.topw;
    LAS float* fs = (LAS float*)lds;
    LAS float* lg = fs + 32 * 1028;
    LAS int* lcnt = (LAS int*)(lg + 32 * 36);
    LAS int* lbase = lcnt + 32;
    const int tid = opaque_tid(), wid = tid >> 6, lane = tid & 63;
    const float* rw = p.router_w + (size_t)l * D * NE;
    for (int it = blockIdx.x; it < M / 32; it += gridDim.x) {
        const int tok0 = it * 32;
        {
            float4 v[4][4]; float ss[4];
#pragma unroll
            for (int q = 0; q < 4; ++q) {
                const float* src = p.xl + (size_t)(tok0 + wid * 4 + q) * D;
#pragma unroll
                for (int i = 0; i < 4; ++i) v[q][i] = *(const float4*)(src + i * 256 + lane * 4);
            }
#pragma unroll
            for (int q = 0; q < 4; ++q) {
                float s = 0.f;
#pragma unroll
                for (int i = 0; i < 4; ++i) s += v[q][i].x * v[q][i].x + v[q][i].y * v[q][i].y + v[q][i].z * v[q][i].z + v[q][i].w * v[q][i].w;
                ss[q] = s;
            }
#pragma unroll
            for (int m = 32; m >= 1; m >>= 1)
#pragma unroll
                for (int q = 0; q < 4; ++q) ss[q] += __shfl_xor(ss[q], m);
            const float* mb = p.mod + (size_t)(l * 5 + tok_modrow(tok0)) * (NMOD * D);
#pragma unroll
            for (int i = 0; i < 4; ++i) {
                const int cidx = i * 256 + lane * 4;
                const float4 gv = *(const float4*)(p.norm2_g + l * D + cidx), sv = *(const float4*)(mb + 4 * D + cidx), hv = *(const float4*)(mb + 3 * D + cidx);
#pragma unroll
                for (int q = 0; q < 4; ++q) {
                    const int tl = wid * 4 + q, tok = tok0 + tl;
                    const float rinv = rsqrtf(ss[q] * (1.0f / D) + 1e-6f);
                    const float h0 = v[q][i].x * rinv * gv.x * (1.f + sv.x) + hv.x, h1 = v[q][i].y * rinv * gv.y * (1.f + sv.y) + hv.y;
                    const float h2 = v[q][i].z * rinv * gv.z * (1.f + sv.z) + hv.z, h3 = v[q][i].w * rinv * gv.w * (1.f + sv.w) + hv.w;
                    u32x2 o; o[0] = pack2(h0, h1); o[1] = pack2(h2, h3);
                    *(u32x2*)(p.F + (size_t)tok * D + cidx) = o;
                    *(LAS f32x4*)(fs + tl * 1028 + cidx) = (f32x4){h0, h1, h2, h3};
                }
            }
        }
        __syncthreads();
        {
            typedef float f32x16 __attribute__((ext_vector_type(16)));
            f32x16 acc;
#pragma unroll
            for (int r = 0; r < 16; ++r) acc[r] = 0.f;
            const int tk = lane & 31, hh = lane >> 5;
            const LAS float* ap = fs + tk * 1028 + wid * 128 + 4 * hh;
            const float* bp = rw + (size_t)(wid * 128 + 4 * hh) * NE + tk;
#pragma unroll 4
            for (int kk = 0; kk < 16; ++kk) {
                const f32x4 a4 = *(const LAS f32x4*)(ap + kk * 8);
                const float b0 = bp[(kk * 8 + 0) * NE], b1 = bp[(kk * 8 + 1) * NE], b2 = bp[(kk * 8 + 2) * NE], b3 = bp[(kk * 8 + 3) * NE];
                acc = __builtin_amdgcn_mfma_f32_32x32x2f32(a4[0], b0, acc, 0, 0, 0);
                acc = __builtin_amdgcn_mfma_f32_32x32x2f32(a4[1], b1, acc, 0, 0, 0);
                acc = __builtin_amdgcn_mfma_f32_32x32x2f32(a4[2], b2, acc, 0, 0, 0);
                acc = __builtin_amdgcn_mfma_f32_32x32x2f32(a4[3], b3, acc, 0, 0, 0);
            }
            __syncthreads();
            LAS float* red = fs;
#pragma unroll
            for (int r = 0; r < 16; ++r) red[(wid * 32 + (r & 3) + 8 * (r >> 2) + 4 * hh) * 33 + tk] = acc[r];
            __syncthreads();
            const int t2 = tid >> 4, e0 = (tid & 15) * 2;
            float s0 = p.router_b[l * NE + e0], s1 = p.router_b[l * NE + e0 + 1];
#pragma unroll
            for (int w = 0; w < 8; ++w) { s0 += red[(w * 32 + t2) * 33 + e0]; s1 += red[(w * 32 + t2) * 33 + e0 + 1]; }
            lg[t2 * 36 + e0] = s0; lg[t2 * 36 + e0 + 1] = s1;
            if (tid < 32) lcnt[tid] = 0;
        }
        __syncthreads();
        float vals[4]; int idxs[4], rank[4];
        if (tid < 32) {
            float lv[32];
#pragma unroll
            for (int q = 0; q < 8; ++q) { const f32x4 t = *(const LAS f32x4*)(lg + tid * 36 + q * 4); lv[q * 4] = t[0]; lv[q * 4 + 1] = t[1]; lv[q * 4 + 2] = t[2]; lv[q * 4 + 3] = t[3]; }
#pragma unroll
            for (int k = 0; k < 4; ++k) {
                float best = lv[0]; int bi = 0;
#pragma unroll
                for (int ee = 1; ee < NE; ++ee) { const bool gt = lv[ee] > best; best = gt ? lv[ee] : best; bi = gt ? ee : bi; }
#pragma unroll
                for (int ee = 0; ee < NE; ++ee) lv[ee] = (ee == bi) ? -3.0e38f : lv[ee];
                vals[k] = best; idxs[k] = bi;
                rank[k] = atomicAdd((int*)(lcnt + bi), 1);
            }
        }
        __syncthreads();
        if (tid < 32) { const int c = lcnt[tid]; lbase[tid] = c ? atomicAdd(r_cnt + l * NE + tid, c) : 0; }
        __syncthreads();
        if (tid < 32) {
            const int tok = tok0 + tid;
            const float mx = vals[0];
            float ex[4], sum = 0.f;
#pragma unroll
            for (int k = 0; k < 4; ++k) { ex[k] = __expf(vals[k] - mx); sum += ex[k]; }
            const float inv = 1.0f / sum;
#pragma unroll
            for (int k = 0; k < 4; ++k) {
                const int ee = idxs[k];
                const int slot = lbase[ee] + rank[k];
                r_list[(size_t)ee * NTOK + slot] = tok;
                r_ts[(size_t)tok * 4 + k] = (ee << 16) | slot;
                r_tw[(size_t)tok * 4 + k] = ex[k] * inv;
            }
        }
        __syncthreads();
    }
}

__device__ __forceinline__ void build_expert_tables(const Params& p, int l, LAS int* ts, LAS int* cn, LAS int* te) {
    const int tid = opaque_tid();
    if (tid < 64) {
        const int c = tid < NE ? p.cnt[l * NE + tid] : 0;
        const int nt = (c + 255) >> 8;
        int v = nt;
#pragma unroll
        for (int off = 1; off < 32; off <<= 1) { const int t = __shfl_up(v, off); if (tid >= off) v += t; }
        if (tid < NE) { cn[tid] = c; ts[tid] = v - nt; if (tid == NE - 1) ts[NE] = v; }
        if (te && tid < NE) for (int q = 0; q < nt; ++q) te[v - nt + q] = tid;
    }
    __syncthreads();
}

struct MoeSched {
    const LAS int* ts; const LAS int* cn; const LAS int* te; const int* list; const bf16_t* A; const bf16_t* Bt; const float* bias; int K, npn, nunits, G, c, nrowsB, nbias; bool gather;
    static constexpr bool HAS_BIAS = true;
    __device__ __forceinline__ bool next(int i, g8::Unit& u) const {
        const long L = (long)i * G + c; if (L >= nunits) return false;
        u.pm = (int)(L / npn); u.pn = (int)(L % npn); u.e = te[u.pm]; return true;
    }
    __device__ __forceinline__ const char* a_base(const g8::Unit& u) const { return (const char*)(gather ? A : A + (size_t)u.pm * 256 * K); }
    __device__ __forceinline__ const char* b_base(const g8::Unit& u) const { return (const char*)(Bt + ((size_t)u.e * nrowsB + (size_t)u.pn * 256) * K); }
    __device__ __forceinline__ const int* row_addr(const g8::Unit& u, int R) const {
        const int cnt = cn[u.e], sl = (u.pm - ts[u.e]) * 256 + R;
        return list + (size_t)u.e * NTOK + (sl < cnt ? sl : 0);
    }
    __device__ __forceinline__ int rows_valid(const g8::Unit& u) const { return cn[u.e] - (u.pm - ts[u.e]) * 256; }
    __device__ __forceinline__ const float* bias_src(const g8::Unit& u, int lane) const {
        if (nbias == 2) return bias + (size_t)u.e * 2 * D + (lane < 32 ? u.pn * 128 + lane * 4 : D + u.pn * 128 + (lane - 32) * 4);
        return bias + (size_t)u.e * D + u.pn * 256 + lane * 4;
    }
};
struct EpiAct {
    bf16_t* O;
    __device__ __forceinline__ bool keep(const g8::Unit&) const { return false; }
    __device__ __forceinline__ void operator()(const f32x4 (&acc)[2][2][4][2], const g8::Unit& u, int wr, int wc, int fr, int fq, const LAS float* bias) const {
        const int row0 = u.pm * 256 + wr * 64 + fr, col0 = u.pn * 128 + wc * 32 + 8 * fq;
        const LAS float* bb = bias + wc * 32 + 8 * fq;
        const f32x4 g0 = *(const LAS f32x4*)bb, g1 = *(const LAS f32x4*)(bb + 4), l0 = *(const LAS f32x4*)(bb + 128), l1 = *(const LAS f32x4*)(bb + 132);
        const float bg[8] = {g0[0], g0[1], g0[2], g0[3], g1[0], g1[1], g1[2], g1[3]}, bl[8] = {l0[0], l0[1], l0[2], l0[3], l1[0], l1[1], l1[2], l1[3]};
#pragma unroll
        for (int ai = 0; ai < 2; ++ai)
#pragma unroll
            for (int m = 0; m < 4; ++m) {
                float o[8];
#pragma unroll
                for (int n = 0; n < 2; ++n)
#pragma unroll
                    for (int j = 0; j < 4; ++j) {
                        const float glu = fminf(acc[ai][0][m][n][j] + bg[n * 4 + j], 7.0f);
                        const float lin = fminf(fmaxf(acc[ai][1][m][n][j] + bl[n * 4 + j], -7.0f), 7.0f);
                        o[n * 4 + j] = glu * sigmoidf_(1.702f * glu) * (lin + 1.0f);
                    }
                *(u32x4*)(O + (size_t)(row0 + ai * 128 + m * 16) * D + col0) = pack8(o);
            }
    }
};
__device__ __forceinline__ void ph_g4(const Params& p, int l, LAS unsigned char* lds) {
    LAS int* ts = (LAS int*)(lds + g8::STAGE_BYTES); LAS int* cn = ts + 40; LAS int* te = ts + 80;
    build_expert_tables(p, l, ts, cn, te);
    MoeSched S; S.ts = ts; S.cn = cn; S.te = te; S.list = p.list; S.A = p.F; S.Bt = p.w1T + (size_t)l * NE * 2 * D * D; S.bias = p.moe_b1 + (size_t)l * NE * 2 * D; S.nbias = 2;
    S.K = D; S.npn = 8; S.nunits = ts[NE] * 8; S.G = gridDim.x; S.c = blockIdx.x; S.nrowsB = 2 * D; S.gather = true;
    EpiAct E; E.O = p.act;
    g8::gemm_phase(lds, D, S, E);
}

struct EpiYp {
    bf16_t* O;
    __device__ __forceinline__ bool keep(const g8::Unit&) const { return false; }
    __device__ __forceinline__ void operator()(const f32x4 (&acc)[2][2][4][2], const g8::Unit& u, int wr, int wc, int fr, int fq, const LAS float* bias) const {
        const int row0 = u.pm * 256 + wr * 64 + fr, col0 = u.pn * 256 + wc * 32 + 8 * fq;
#pragma unroll
        for (int bj = 0; bj < 2; ++bj) {
            const LAS float* bb = bias + bj * 128 + wc * 32 + 8 * fq;
            const f32x4 c0v = *(const LAS f32x4*)bb, c1v = *(const LAS f32x4*)(bb + 4);
            const float4 c0 = make_float4(c0v[0], c0v[1], c0v[2], c0v[3]), c1 = make_float4(c1v[0], c1v[1], c1v[2], c1v[3]);
#pragma unroll
            for (int ai = 0; ai < 2; ++ai)
#pragma unroll
                for (int m = 0; m < 4; ++m) {
                    u32x4 w; w[0] = pack2(acc[ai][bj][m][0][0] + c0.x, acc[ai][bj][m][0][1] + c0.y); w[1] = pack2(acc[ai][bj][m][0][2] + c0.z, acc[ai][bj][m][0][3] + c0.w);
                    w[2] = pack2(acc[ai][bj][m][1][0] + c1.x, acc[ai][bj][m][1][1] + c1.y); w[3] = pack2(acc[ai][bj][m][1][2] + c1.z, acc[ai][bj][m][1][3] + c1.w);
                    *(u32x4*)(O + (size_t)(row0 + ai * 128 + m * 16) * D + col0 + bj * 128) = w;
                }
        }
    }
};
__device__ __forceinline__ void ph_g5(const Params& p, int l, LAS unsigned char* lds) {
    LAS int* ts = (LAS int*)(lds + g8::STAGE_BYTES); LAS int* cn = ts + 40; LAS int* te = ts + 80;
    build_expert_tables(p, l, ts, cn, te);
    MoeSched S; S.ts = ts; S.cn = cn; S.te = te; S.list = p.list; S.A = p.act; S.Bt = p.w2T + (size_t)l * NE * D * D; S.bias = p.moe_b2 + (size_t)l * NE * D; S.nbias = 1;
    S.K = D; S.npn = 4; S.nunits = ts[NE] * 4; S.G = gridDim.x; S.c = blockIdx.x; S.nrowsB = D; S.gather = false;
    EpiYp E; E.O = p.yp;
    g8::gemm_phase(lds, D, S, E);
}

template <bool DRY = false> __device__ __forceinline__ void ph_combine(const Params& p, int l, int M, LAS unsigned char* lds) {
    float* const c_xl = DRY ? p.prep : p.xl; bf16_t* const c_H = DRY ? (bf16_t*)(p.prep + (size_t)NTOK * D) : p.H; float* const c_out = DRY ? p.prep : p.out;
    LAS int* ts = (LAS int*)lds; LAS int* cn = ts + 40;
    build_expert_tables(p, l, ts, cn, nullptr);
    const int tid = opaque_tid(), wid = tid >> 6, lane = tid & 63;
    const bool last = (l == 1);
    for (int tok = blockIdx.x * NWAVES + wid; tok < M; tok += gridDim.x * NWAVES) {
        float4 v[4];
        const float* mb = p.mod + (size_t)(l * 5 + tok_modrow(tok)) * (NMOD * D);
        int rows[4]; float wts[4];
#pragma unroll
        for (int k = 0; k < 4; ++k) { const int tsl = p.tokslot[(size_t)tok * 4 + k]; rows[k] = ts[tsl >> 16] * 256 + (tsl & 0xffff); wts[k] = p.topw[(size_t)tok * 4 + k]; }
        float ss = 0.f;
#pragma unroll
        for (int i = 0; i < 4; ++i) {
            const int cidx = i * 256 + lane * 4;
            float m0 = 0.f, m1 = 0.f, m2 = 0.f, m3 = 0.f;
#pragma unroll
            for (int k = 0; k < 4; ++k) {
                const u32x2 u = *(const u32x2*)(p.yp + (size_t)rows[k] * D + cidx);
                m0 += wts[k] * bflo(u[0]); m1 += wts[k] * bfhi(u[0]); m2 += wts[k] * bflo(u[1]); m3 += wts[k] * bfhi(u[1]);
            }
            const float4 gt = *(const float4*)(mb + 5 * D + cidx);
            float4 xv = *(const float4*)(p.xl + (size_t)tok * D + cidx);
            xv.x += gt.x * m0; xv.y += gt.y * m1; xv.z += gt.z * m2; xv.w += gt.w * m3;
            v[i] = xv; ss += xv.x * xv.x + xv.y * xv.y + xv.z * xv.z + xv.w * xv.w;
        }
        ss = wave_sum(ss);
        const float rinv = rsqrtf(ss * (1.0f / D) + 1e-6f);
        if (!last) {
#pragma unroll
            for (int i = 0; i < 4; ++i) *(float4*)(c_xl + (size_t)tok * D + i * 256 + lane * 4) = v[i];
            const float* mb1 = p.mod + (size_t)((l + 1) * 5 + tok_modrow(tok)) * (NMOD * D);
            norm_mod_store(v, rinv, p.norm1_g + (l + 1) * D, mb1 + 1 * D, mb1 + 0 * D, c_H + (size_t)tok * D, lane);
        } else {
#pragma unroll
            for (int i = 0; i < 4; ++i) {
                const int cidx = i * 256 + lane * 4;
                const float4 gv = *(const float4*)(p.final_norm_g + cidx);
                *(float4*)(c_out + (size_t)tok * D + cidx) = make_float4(v[i].x * rinv * gv.x, v[i].y * rinv * gv.y, v[i].z * rinv * gv.z, v[i].w * rinv * gv.w);
            }
        }
    }
}

#define XB_TMO      128
#define XB_XCNT(j)  (256  + 64 * (j))
#define XB_XSUB(j)  (1280 + 64 * (j))
#define XB_XGEN(j)  (2304 + 64 * (j))
#define XB_TOP      3328
#define XB_TOPGEN   3392
#define XCD_BAR_WORDS 3456
#define XB_SPIN_CAP (1u << 18)

__device__ __forceinline__ unsigned xb_ld(unsigned* p)              { return __hip_atomic_load(p, __ATOMIC_RELAXED, __HIP_MEMORY_SCOPE_AGENT); }
__device__ __forceinline__ unsigned xb_add(unsigned* p, unsigned v) { return __hip_atomic_fetch_add(p, v, __ATOMIC_RELAXED, __HIP_MEMORY_SCOPE_AGENT); }
__device__ __forceinline__ unsigned xb_xcc_id() { return (unsigned)__builtin_amdgcn_s_getreg((3 << 11) | 20) & 0xFu; }
#define XB_SPIN(cond, bar) do { unsigned _sp = 0; while (cond) { __builtin_amdgcn_s_sleep(1); \
    if ((++_sp & 255u) == 0u) { if (xb_ld(&(bar)[XB_TMO])) break; if (_sp > XB_SPIN_CAP) { atomicAdd(&(bar)[XB_TMO], 1u); break; } } } } while (0)

struct XcdBarrier {
    unsigned* bar; unsigned x;
    volatile LAS unsigned* st;
};

__device__ __forceinline__ XcdBarrier xcd_barrier_post(unsigned* bar, volatile LAS unsigned* st) {
    XcdBarrier b; b.bar = bar; b.x = xb_xcc_id(); b.st = st;
    if (threadIdx.x == 0) (void)xb_add(&bar[XB_XCNT(b.x)], 1u);
    return b;
}
__device__ __forceinline__ void xcd_barrier_complete(unsigned* bar, unsigned x, unsigned& nloc, unsigned& nx) {
    const unsigned G = gridDim.x * gridDim.y * gridDim.z;
    unsigned sum, cnt, mine, sp = 0u;
    for (;;) {
        sum = 0u; cnt = 0u; mine = 0u;
#pragma unroll
        for (unsigned j = 0; j < 16; ++j) { const unsigned c = xb_ld(&bar[XB_XCNT(j)]); sum += c; cnt += (c > 0u) ? 1u : 0u; mine = (j == x) ? c : mine; }
        if (sum == G) break;
        __builtin_amdgcn_s_sleep(1);
        if ((++sp & 255u) == 0u) { if (xb_ld(&bar[XB_TMO])) break; if (sp > XB_SPIN_CAP) { atomicAdd(&bar[XB_TMO], 1u); break; } }
    }
    nloc = mine > 0u ? mine : 1u; nx = cnt > 0u ? cnt : 1u;
}

__device__ __forceinline__ void xcd_barrier(const XcdBarrier& b) {
    asm volatile("s_waitcnt vmcnt(0)" ::: "memory");
    __syncthreads();
    if (threadIdx.x == 0) {
        unsigned* bar = b.bar;
        __builtin_amdgcn_s_waitcnt(0);
        unsigned nloc = b.st[0], nx = b.st[1];
        if (nloc == 0u) { xcd_barrier_complete(bar, b.x, nloc, nx); b.st[0] = nloc; b.st[1] = nx; }
        const unsigned old = xb_add(&bar[XB_XSUB(b.x)], 1u);
        const unsigned gen = old / nloc;
        if (old + 1u == (gen + 1u) * nloc) {
            __builtin_amdgcn_fence(__ATOMIC_RELEASE, "agent");
            asm volatile("s_waitcnt vmcnt(0)" ::: "memory");
            const unsigned og = xb_add(&bar[XB_TOP], 1u);
            const unsigned tg = og / nx;
            if (og + 1u == (tg + 1u) * nx) xb_add(&bar[XB_TOPGEN], 1u);
            else XB_SPIN(xb_ld(&bar[XB_TOPGEN]) == tg, bar);
            __builtin_amdgcn_fence(__ATOMIC_ACQUIRE, "agent");
            xb_add(&bar[XB_XGEN(b.x)], 1u);
            asm volatile("s_waitcnt vmcnt(0)" ::: "memory");
        } else {
            XB_SPIN(xb_ld(&bar[XB_XGEN(b.x)]) == gen, bar);
            __builtin_amdgcn_fence(__ATOMIC_ACQUIRE, "agent");
            asm volatile("s_waitcnt vmcnt(0)" ::: "memory");
        }
    }
    __syncthreads();
}


extern __shared__ __attribute__((aligned(16))) unsigned char dyn_lds[];
#define KPH(name, call) __global__ void __launch_bounds__(NTHREADS, 2) name(Params p, int l, int M) { LAS unsigned char* lds = (LAS unsigned char*)dyn_lds; (void)l; (void)M; (void)lds; call; }
KPH(k_convert, { ph_convert(p, lds); })
KPH(k_mod, { ph_mod(p, lds); })
KPH(k_norm1, { ph_norm1_first(p); })
KPH(k_g1, { ph_g1(p, l, lds); })
KPH(k_prep, { ph_prep(p, l, lds); })
KPH(k_local, { ph_local(p, l, lds); })
KPH(k_seq, { ph_seq(p, lds); })
KPH(k_merge, { ph_merge(p, l, M); })
KPH(k_g2, { ph_g2(p, l, M, lds); })
KPH(k_g3, { ph_g3(p, l, M, lds); })
KPH(k_route, { ph_route(p, l, M, lds); })
KPH(k_g4, { ph_g4(p, l, lds); })
KPH(k_g5, { ph_g5(p, l, lds); })
KPH(k_combine, { ph_combine(p, l, M, lds); })


__global__ void __launch_bounds__(NTHREADS, 2) k_mega(Params p) {
    LAS unsigned char* lds = (LAS unsigned char*)dyn_lds;
    volatile LAS unsigned* xb_words = (volatile LAS unsigned*)(lds + LDS_BYTES - 16);
    if (threadIdx.x == 0) { xb_words[0] = 0u; xb_words[1] = 0u; xb_words[2] = 0u; xb_words[3] = 0u; }
    __syncthreads();
    (void)xcd_barrier_post(p.bar, xb_words);
#define GRID_BARRIER() do { XcdBarrier b_; b_.bar = p.bar; b_.x = xb_xcc_id(); b_.st = xb_words; xcd_barrier(b_); } while (0)
#define RUNP(bit, stmt) do { stmt; if (PROBE & (1 << (bit))) { GRID_BARRIER(); stmt; } } while (0)
    RUNP(0, ph_convert(p, lds));
    RUNP(1, ph_mod(p, lds));
    GRID_BARRIER();
    RUNP(2, ph_norm1_first(p));
    GRID_BARRIER();
    for (int l = 0; l < 2; ++l) {
        const int M = l == 0 ? NTOK : NLAT;
        { unsigned lb_ = (unsigned)(size_t)lds; asm volatile("" : "+s"(lb_)); lds = (LAS unsigned char*)(size_t)lb_; }
        RUNP(3, ph_g1(p, l, lds));
        GRID_BARRIER();
        RUNP(4, ph_prep(p, l, lds));
        RUNP(5, ph_local(p, l, lds));
        GRID_BARRIER();
        RUNP(6, ph_seq(p, lds));
        GRID_BARRIER();
        RUNP(7, ph_merge(p, l, M));
        GRID_BARRIER();
        RUNP(8, ph_g2(p, l, M, lds));
        GRID_BARRIER();
        if (PROBE & (1 << 11)) { ph_g3<true>(p, l, M, lds); GRID_BARRIER(); }
        ph_g3(p, l, M, lds);
        GRID_BARRIER();
        if (PROBE & (1 << 12)) { ph_route<true>(p, l, M, lds); GRID_BARRIER(); }
        ph_route(p, l, M, lds);
        GRID_BARRIER();
        RUNP(9, ph_g4(p, l, lds));
        GRID_BARRIER();
        RUNP(10, ph_g5(p, l, lds));
        GRID_BARRIER();
        if (PROBE & (1 << 13)) { ph_combine<true>(p, l, M, lds); GRID_BARRIER(); }
        ph_combine(p, l, M, lds);
        if (l == 0) GRID_BARRIER();
    }
}

static inline size_t align_up(size_t v, size_t a) { return (v + a - 1) / a * a; }

extern "C" void kernel_launch(void* const* d_in, const int* in_sizes, int n_in, void* d_out, int out_size, void* d_ws, size_t ws_size, hipStream_t stream) {
    (void)in_sizes; (void)n_in; (void)out_size;
    Params p{};
    const float** pf = (const float**)&p;
    for (int i = 0; i < 32; ++i) pf[i] = (const float*)d_in[i];
    p.out = (float*)d_out;
    unsigned char* w = (unsigned char*)d_ws; size_t off = 0;
    auto take = [&](size_t bytes) { void* r = w + off; off = align_up(off + bytes, 256); return r; };
    p.bar = (unsigned*)take(16384);
    p.cnt = (int*)take(1024);
    const size_t ctl_bytes = off;
    p.mod = (float*)take((size_t)2 * 5 * NMOD * D * 4);
    p.winT = (bf16_t*)take((size_t)2 * NPW * D * 2);
    p.wbT = (bf16_t*)take((size_t)2 * 4 * D * MW * 2);
    p.woutT = (bf16_t*)take((size_t)2 * D * D * 2);
    p.w1T = (bf16_t*)take((size_t)2 * NE * 2 * D * D * 2);
    p.w2T = (bf16_t*)take((size_t)2 * NE * D * D * 2);
    p.xl = (float*)take((size_t)NTOK * D * 4);
    p.H = (bf16_t*)take((size_t)NTOK * D * 2);
    p.P = (bf16_t*)take((size_t)NTOK * NP * 2);
    p.gate = (bf16_t*)take((size_t)NTOK * 4096 * 2);
    p.act = p.P; p.yp = p.P + (size_t)CAPROWS * D;
    p.prep = (float*)take(NPREP * TOKW * 4);
    p.gg = (float*)take((size_t)NTOK * 8 * 4);
    p.gb = (float*)take((size_t)NTOK * 8 * 4);
    p.O = (float*)take(8 * TOKW * 4);
    p.lq = (bf16_t*)take((size_t)3 * NITEM * 64 * 128 * 2);
    p.lo = (bf16_t*)take((size_t)3 * NITEM * 64 * 128 * 2);
    p.lb = (bf16_t*)take((size_t)3 * NITEM * 128 * 128 * 2);
    p.la = (bf16_t*)take((size_t)NITEM * 128 * 128 * 2);
    p.ld = (float*)take((size_t)3 * NITEM * 128 * 4);
    p.lruT = (bf16_t*)take((size_t)2 * 8 * 4 * 4096 * 2);
    p.Y = (bf16_t*)take(4 * TOKW * 2);
    p.mix = (bf16_t*)take((size_t)NTOK * D * 2);
    p.F = p.H;
    p.list = (int*)take((size_t)NE * NTOK * 4);
    p.tokslot = (int*)take((size_t)NTOK * 4 * 4);
    p.topw = (float*)take((size_t)NTOK * 4 * 4);
    if (off > ws_size) { fprintf(stderr, "workspace too small: need %zu have %zu\n", off, ws_size); return; }

    static int grid = 0;
#if MEGA
    if (!grid) {
        int dev = 0, cus = 0, occ = 0; (void)hipGetDevice(&dev); (void)hipDeviceGetAttribute(&cus, hipDeviceAttributeMultiprocessorCount, dev);
        (void)hipFuncSetAttribute((const void*)k_mega, hipFuncAttributeMaxDynamicSharedMemorySize, LDS_BYTES);
        (void)hipOccupancyMaxActiveBlocksPerMultiprocessor(&occ, (const void*)k_mega, NTHREADS, LDS_BYTES);
        if (cus <= 0) cus = 256;
        grid = cus * (occ < 1 ? 1 : 1);
        if (occ < 1) fprintf(stderr, "occupancy query says %d blocks per CU\n", occ);
    }
    (void)hipMemsetAsync(d_ws, 0, ctl_bytes, stream);
    hipLaunchKernelGGL(k_mega, dim3(grid), dim3(NTHREADS), LDS_BYTES, stream, p);
#else
    if (!grid) {
        int dev = 0, cus = 0; (void)hipGetDevice(&dev); (void)hipDeviceGetAttribute(&cus, hipDeviceAttributeMultiprocessorCount, dev);
        grid = cus > 0 ? cus : 256;
        const void* ks[] = {(const void*)k_convert, (const void*)k_mod, (const void*)k_norm1, (const void*)k_g1, (const void*)k_prep, (const void*)k_local, (const void*)k_seq, (const void*)k_merge,
                            (const void*)k_g2, (const void*)k_g3, (const void*)k_route, (const void*)k_g4, (const void*)k_g5, (const void*)k_combine};
        for (const void* k : ks) (void)hipFuncSetAttribute(k, hipFuncAttributeMaxDynamicSharedMemorySize, LDS_BYTES);
    }
    (void)hipMemsetAsync(d_ws, 0, ctl_bytes, stream);
#define LAUNCH(k, l, M) hipLaunchKernelGGL(k, dim3(grid), dim3(NTHREADS), LDS_BYTES, stream, p, l, M)
    LAUNCH(k_convert, 0, 0);
    LAUNCH(k_mod, 0, 0);
    LAUNCH(k_norm1, 0, 0);
    for (int l = 0; l < 2; ++l) {
        const int M = l == 0 ? NTOK : NLAT;
        LAUNCH(k_g1, l, M);
        LAUNCH(k_prep, l, M);
        LAUNCH(k_local, l, M);
        LAUNCH(k_seq, l, M);
        LAUNCH(k_merge, l, M);
        LAUNCH(k_g2, l, M);
        LAUNCH(k_g3, l, M);
        LAUNCH(k_route, l, M);
        LAUNCH(k_g4, l, M);
        LAUNCH(k_g5, l, M);
        LAUNCH(k_combine, l, M);
    }
#endif
}
```

```cpp
#include <hip/hip_runtime.h>
#include <stdint.h>
#include <stdio.h>

#define LAS __attribute__((address_space(3)))
typedef unsigned short bf16_t;
typedef short bf16x8 __attribute__((ext_vector_type(8)));
typedef float f32x4 __attribute__((ext_vector_type(4)));
typedef float f32x2 __attribute__((ext_vector_type(2)));
typedef unsigned u32x2 __attribute__((ext_vector_type(2)));
typedef unsigned u32x4 __attribute__((ext_vector_type(4)));

#ifndef MEGA
#define MEGA 1
#endif
#ifndef PROBE
#define PROBE 0
#endif

constexpr int D = 1024, NB = 4, TL = 4096, TC = 256, NLAT = NB * TL, NCTX = NB * TC, NTOK = NLAT + NCTX;
constexpr int NIN = 11792, NPW = 12032, NP = 7936, MW = 512, NE = 32, TOPK = 4, NMOD = 6;
constexpr int C_GQKV = 0, C_GZ = 1536, C_HQ = 2048, C_HI = 2560, C_HF = 3072, C_HG = 4096, C_LX = 4608,
              C_LY = 5120, C_RQKV = 5632, C_RG = 7168, C_GA = 7680, C_GB = 7688, W_MG = 7936;
__host__ __device__ __forceinline__ int win_dst_row(int n) { return n < 2048 ? n : n < 2064 ? 7680 + (n - 2048) : n < 7696 ? n - 16 : 7936 + (n - 7696); }
constexpr int NTHREADS = 512, NWAVES = 8;
constexpr int LDS_BYTES = 140 * 1024;
constexpr int CAPROWS = 77824;
constexpr size_t TOKW = (size_t)NTOK * MW;
constexpr int PR_LA = 0, PR_LU = 2, NPREP = 4;
constexpr int NCHUNK = 68, NITEM = 32 * NCHUNK;

struct Params {
    const float *x, *c, *ctx, *c_ctx, *w_mod, *b_mod, *norm1_g, *norm2_g, *w_in, *gdn_conv_w, *gdn_a_log, *gdn_dt_bias, *gdn_norm_g, *hgrn_lb,
        *hgrn_norm_g, *lru_conv_w, *lru_conv_b, *lru_wa, *lru_ba, *lru_wx, *lru_bx, *lru_lambda, *ret_norm_g, *w_branch, *w_out, *router_w,
        *router_b, *moe_w1, *moe_b1, *moe_w2, *moe_b2, *final_norm_g;
    float* out;
    unsigned* bar; int* cnt; float* mod;
    bf16_t *winT, *wbT, *woutT, *w1T, *w2T;
    float* xl; bf16_t* H; bf16_t* P; float* prep; float* gg; float* gb; float* O; bf16_t* Y; bf16_t* mix; bf16_t* F;
    int* list; int* tokslot; float* topw; bf16_t* act; bf16_t* yp;
    bf16_t *lq, *lo, *lb, *la; float* ld; bf16_t* lruT; bf16_t* gate;
};

typedef __bf16 bf16x2_t __attribute__((ext_vector_type(2)));
__device__ __forceinline__ unsigned pack2(float a, float b) { const f32x2 v = {a, b}; return __builtin_bit_cast(unsigned, __builtin_convertvector(v, bf16x2_t)); }
__device__ __forceinline__ unsigned f2bf(float f) { return pack2(f, f) & 0xffffu; }
__device__ __forceinline__ float bf2f(bf16_t b) { return __uint_as_float(((unsigned)b) << 16); }
__device__ __forceinline__ float bflo(unsigned u) { return __uint_as_float(u << 16); }
__device__ __forceinline__ float bfhi(unsigned u) { return __uint_as_float(u & 0xffff0000u); }
__device__ __forceinline__ float sigmoidf_(float x) { return __builtin_amdgcn_rcpf(1.0f + __expf(-x)); }
__device__ __forceinline__ float siluf_(float x) { return x * sigmoidf_(x); }
__device__ __forceinline__ float softplusf_(float x) { return x > 20.f ? x : log1pf(__expf(x)); }
__device__ __forceinline__ float logsigmoidf_(float x) { return -softplusf_(-x); }
__device__ __forceinline__ float gelu_tanhf_(float x) { const float u = 0.7978845608028654f * (x + 0.044715f * x * x * x); return 0.5f * x * (1.0f + tanhf(u)); }
__device__ __forceinline__ float shx(float v, int m, int lane) { return __int_as_float(__builtin_amdgcn_ds_bpermute((lane ^ m) << 2, __float_as_int(v))); }
__device__ __forceinline__ float shup(float v, int off, int lane) { const int s = lane >= off ? lane - off : lane; return __int_as_float(__builtin_amdgcn_ds_bpermute(s << 2, __float_as_int(v))); }
__device__ __forceinline__ int shupi(int v, int off, int lane) { const int s = lane >= off ? lane - off : lane; return __builtin_amdgcn_ds_bpermute(s << 2, v); }
__device__ __forceinline__ float wave_sum(float v, int lane) {
#pragma unroll
    for (int m = 32; m >= 1; m >>= 1) v += shx(v, m, lane);
    return v;
}
__device__ __forceinline__ int opaque_tid() { int t = threadIdx.x; asm volatile("" : "+v"(t)); return t; }
template <class T> __device__ __forceinline__ T* opaque_sptr(T* q) { asm volatile("" : "+s"(q)); return q; }
__device__ __forceinline__ int tok_modrow(int tok) { return tok < NLAT ? (tok >> 12) : 4; }
__device__ __forceinline__ void tok_info(int tok, int& t, int& T, int& base) {
    if (tok < NLAT) { t = tok & (TL - 1); T = TL; base = tok - t; }
    else { t = (tok - NLAT) & (TC - 1); T = TC; base = tok - t; }
}

__device__ __forceinline__ f32x4 mfma16(bf16x8 a, bf16x8 b, f32x4 c) { return __builtin_amdgcn_mfma_f32_16x16x32_bf16(a, b, c, 0, 0, 0); }
__device__ __forceinline__ u32x2 pack4(f32x4 v) { u32x2 o; o[0] = pack2(v[0], v[1]); o[1] = pack2(v[2], v[3]); return o; }
__device__ __forceinline__ u32x4 pack8(const float* v) { u32x4 o; o[0] = pack2(v[0], v[1]); o[1] = pack2(v[2], v[3]); o[2] = pack2(v[4], v[5]); o[3] = pack2(v[6], v[7]); return o; }

namespace gm {
constexpr int HT = 16384;
__device__ __forceinline__ int lds_byte(int r, int c) { const int st = (r >> 4) * 2 + (c >> 5), rr = r & 15, cc = c & 31, ob = rr * 64 + cc * 2; return st * 1024 + (ob ^ (((ob >> 9) & 1) << 5)); }
__device__ __forceinline__ void stage_rc(int b, int& R, int& C) { const int st = b / 1024, sb = b % 1024, swz = sb ^ (((sb >> 9) & 1) << 5); R = (st >> 1) * 16 + swz / 64; C = (st & 1) * 32 + (swz % 64) / 2; }

__device__ __forceinline__ void kloop(LAS unsigned char* lds, const bf16_t* ap00, const bf16_t* ap01, const bf16_t* ap10, const bf16_t* ap11,
                                      const bf16_t* bp0, const bf16_t* bp1, int K, f32x4 (&acc)[4][4]) {
    const int tid = opaque_tid(), wid = __builtin_amdgcn_readfirstlane(tid >> 6), lane = tid & 63, wr = wid >> 1, wc = wid & 1, fr = lane & 15, fq = lane >> 4;
    const unsigned ldsw = (unsigned)wid * 1024u;
    const int aoff = (wr >> 1) * HT + lds_byte((wr & 1) * 64 + fr, fq * 8);
    const int boff = 2 * HT + lds_byte(wc * 64 + fr, fq * 8);
    const int nt = K / 64;
#define GM_GLDS(src, dstoff) __builtin_amdgcn_global_load_lds((const unsigned*)(src), (LAS unsigned*)(lds + (dstoff)), 16, 0, 0)
#define GM_STAGE(buf, kt) do { const int _bo = (buf) * 3 * HT + ldsw; const int _ko = (kt) * 64; \
        GM_GLDS(ap00 + _ko, _bo); GM_GLDS(ap01 + _ko, _bo + 8192); GM_GLDS(ap10 + _ko, _bo + HT); GM_GLDS(ap11 + _ko, _bo + HT + 8192); \
        GM_GLDS(bp0 + _ko, _bo + 2 * HT); GM_GLDS(bp1 + _ko, _bo + 2 * HT + 8192); } while (0)
    GM_STAGE(0, 0);
    for (int t = 0; t < nt; ++t) {
        const int cur = t & 1;
        if (t + 1 < nt) { GM_STAGE(cur ^ 1, t + 1); asm volatile("s_waitcnt vmcnt(6)" ::: "memory"); }
        else asm volatile("s_waitcnt vmcnt(0)" ::: "memory");
        __builtin_amdgcn_s_barrier(); asm volatile("" ::: "memory");
        bf16x8 af[4][2], bfr[4][2];
#pragma unroll
        for (int m = 0; m < 4; ++m)
#pragma unroll
            for (int k = 0; k < 2; ++k) af[m][k] = *(const LAS bf16x8*)(lds + cur * 3 * HT + aoff + m * 2048 + k * 1024);
#pragma unroll
        for (int n = 0; n < 4; ++n)
#pragma unroll
            for (int k = 0; k < 2; ++k) bfr[n][k] = *(const LAS bf16x8*)(lds + cur * 3 * HT + boff + n * 2048 + k * 1024);
#pragma unroll
        for (int k = 0; k < 2; ++k)
#pragma unroll
            for (int m = 0; m < 4; ++m)
#pragma unroll
                for (int n = 0; n < 4; ++n) acc[m][n] = __builtin_amdgcn_mfma_f32_16x16x32_bf16(bfr[n][k], af[m][k], acc[m][n], 0, 0, 0);
        asm volatile("s_waitcnt lgkmcnt(0)" ::: "memory");
        __builtin_amdgcn_s_barrier(); asm volatile("" ::: "memory");
    }
#undef GM_STAGE
#undef GM_GLDS
}
__device__ __forceinline__ void zero_acc(f32x4 (&acc)[4][4]) {
#pragma unroll
    for (int m = 0; m < 4; ++m)
#pragma unroll
        for (int n = 0; n < 4; ++n) acc[m][n] = (f32x4){0.f, 0.f, 0.f, 0.f};
}
}

namespace g8 {
constexpr int BM = 256, BK = 64, HALF = 128, HTB = HALF * BK * 2, STAGE_BYTES = 8 * HTB;
__device__ __forceinline__ int lds_byte(int r, int c) { const int st = (r >> 4) * 2 + (c >> 5), rr = r & 15, cc = c & 31, ob = rr * 64 + cc * 2; return st * 1024 + (ob ^ (((ob >> 9) & 1) << 5)); }
__device__ __forceinline__ void stage_rc(int b, int& R, int& C) { const int st = b / 1024, sb = b % 1024, swz = sb ^ (((sb >> 9) & 1) << 5); R = (st >> 1) * 16 + swz / 64; C = (st & 1) * 32 + (swz % 64) / 2; }
__device__ __forceinline__ int perm32(int rho) { const int n = rho >> 4, i = rho & 15; return 8 * (i >> 2) + 4 * n + (i & 3); }
struct Unit { int pm, pn, e; };

template <class Epi, class Sched>
__device__ __forceinline__ void gemm_phase(LAS unsigned char* lds, const int K, const Sched& S, const Epi& E) {
    const int tid = opaque_tid(), wid = __builtin_amdgcn_readfirstlane(tid >> 6), lane = tid & 63, wr = wid >> 2, wc = wid & 3, fr = lane & 15, fq = lane >> 4;
    const int nt = K / BK;
    int R0, C0, R1, C1; stage_rc(tid * 16, R0, C0); stage_rc(tid * 16 + 8192, R1, C1);
    unsigned voffB[2];
    voffB[0] = (unsigned)(((R0 & ~31) + perm32(R0 & 31)) * K + C0) * 2u; voffB[1] = (unsigned)(((R1 & ~31) + perm32(R1 & 31)) * K + C1) * 2u;
    const unsigned cb0 = (unsigned)C0 * 2u, cb1 = (unsigned)C1 * 2u;
    const size_t kstep = (size_t)(BK * 2);
    const size_t hstepB = (size_t)HALF * K * 2;
    const unsigned ldsw = (unsigned)wid * 1024u;
    const int aoff = lds_byte(wr * 64 + fr, fq * 8), boff = lds_byte(wc * 32 + fr, fq * 8);
#define G8_SA(b, h) (((b) * 2 + (h)) * HTB)
#define G8_SB(b, h) ((4 + (b) * 2 + (h)) * HTB)
#define G8_GL(src, dstoff) __builtin_amdgcn_global_load_lds((const unsigned*)(src), (LAS unsigned*)(lds + (dstoff)), 16, 0, 0)
#define G8_STAGE_A(bufoff, gbase, vo, h) do { G8_GL((const char*)(gbase) + (vo)[2 * (h)], (bufoff) + ldsw); G8_GL((const char*)(gbase) + (vo)[2 * (h) + 1], (bufoff) + ldsw + 8192); } while (0)
#define G8_STAGE_B(bufoff, gbase) do { G8_GL((const char*)(gbase) + voffB[0], (bufoff) + ldsw); G8_GL((const char*)(gbase) + voffB[1], (bufoff) + ldsw + 8192); } while (0)
#define G8_LDA(dst, b, h) do { _Pragma("unroll") for (int m = 0; m < 4; ++m) _Pragma("unroll") for (int k = 0; k < 2; ++k) dst[m][k] = *(const LAS bf16x8*)(lds + G8_SA(b, h) + aoff + m * 2048 + k * 1024); } while (0)
#define G8_LDB(dst, b, h) do { _Pragma("unroll") for (int n = 0; n < 2; ++n) _Pragma("unroll") for (int k = 0; k < 2; ++k) dst[n][k] = *(const LAS bf16x8*)(lds + G8_SB(b, h) + boff + n * 2048 + k * 1024); } while (0)
#define G8_MMA(ai, bj, At, Bt) do { __builtin_amdgcn_s_setprio(1); _Pragma("unroll") for (int m = 0; m < 4; ++m) _Pragma("unroll") for (int n = 0; n < 2; ++n) _Pragma("unroll") for (int k = 0; k < 2; ++k) \
        acc[ai][bj][m][n] = __builtin_amdgcn_mfma_f32_16x16x32_bf16(Bt[n][k], At[m][k], acc[ai][bj][m][n], 0, 0, 0); __builtin_amdgcn_s_setprio(0); } while (0)
#define G8_WAIT_V(n) asm volatile("s_waitcnt vmcnt(" #n ")" ::: "memory")
#define G8_WAIT_L(n) asm volatile("s_waitcnt lgkmcnt(" #n ")" ::: "memory")
#define G8_BAR __builtin_amdgcn_s_barrier()
#define G8_SCHED __builtin_amdgcn_sched_barrier(0)
    Unit cur, nxt; int ui = 0;
    if (!S.next(0, cur)) return;
    LAS float* biasbuf = (LAS float*)(lds + STAGE_BYTES + 2048);
    LAS int* rowbuf = (LAS int*)(lds + STAGE_BYTES + 4096);
    f32x4 acc[2][2][4][2];
#pragma unroll
    for (int a = 0; a < 2; ++a)
#pragma unroll
        for (int b = 0; b < 2; ++b)
#pragma unroll
            for (int m = 0; m < 4; ++m)
#pragma unroll
                for (int n = 0; n < 2; ++n) acc[a][b][m][n] = (f32x4){0.f, 0.f, 0.f, 0.f};
    bf16x8 At[4][2], B0[2][2], B1[2][2];
    unsigned vA[4];
    {
        unsigned rows[4] = {(unsigned)R0, (unsigned)R1, (unsigned)(HALF + R0), (unsigned)(HALF + R1)};
        if (S.gather) { rows[0] = (unsigned)*S.row_addr(cur, R0); rows[1] = (unsigned)*S.row_addr(cur, R1); rows[2] = (unsigned)*S.row_addr(cur, HALF + R0); rows[3] = (unsigned)*S.row_addr(cur, HALF + R1); }
        vA[0] = rows[0] * (unsigned)(K * 2) + cb0; vA[1] = rows[1] * (unsigned)(K * 2) + cb1; vA[2] = rows[2] * (unsigned)(K * 2) + cb0; vA[3] = rows[3] * (unsigned)(K * 2) + cb1;
    }
    const char* cA = S.a_base(cur); const char* cB = S.b_base(cur);
    G8_STAGE_B(G8_SB(0, 0), cB); G8_STAGE_A(G8_SA(0, 0), cA, vA, 0); G8_STAGE_B(G8_SB(0, 1), cB + hstepB); G8_STAGE_A(G8_SA(0, 1), cA, vA, 1);
    if (wr == 1) G8_BAR;
    G8_WAIT_V(4); G8_BAR;
    G8_STAGE_B(G8_SB(1, 0), cB + kstep); G8_STAGE_A(G8_SA(1, 0), cA + kstep, vA, 0); G8_STAGE_B(G8_SB(1, 1), cB + hstepB + kstep);
    G8_WAIT_V(6); G8_BAR;
    for (;;) {
        const bool has_next = S.next(ui + 1, nxt);
        const char* nA = has_next ? S.a_base(nxt) : cA; const char* nB = has_next ? S.b_base(nxt) : cB;
        const int nvalid = (S.gather && has_next) ? S.rows_valid(nxt) : 0;
        if (wid == 0) {
            if (Sched::HAS_BIAS) G8_GL(S.bias_src(cur, lane), STAGE_BYTES + 2048 + (ui & 1) * 1024);
            if (S.gather && has_next) G8_GL(S.row_addr(nxt, 0) + lane * 4, STAGE_BYTES + 4096 + ((ui + 1) & 1) * 1024);
        }
        for (int t = 0; t < nt; t += 2) {
            const bool last = (t == nt - 2);
            const char* a1 = cA + (size_t)(t + 1) * kstep;
            const char* a2 = last ? nA : cA + (size_t)(t + 2) * kstep; const char* b2 = last ? nB : cB + (size_t)(t + 2) * kstep;
            const char* a3 = a2 + kstep; const char* b3 = b2 + kstep;
            G8_LDB(B0, 0, 0); G8_SCHED; G8_LDA(At, 0, 0); G8_STAGE_A(G8_SA(1, 1), a1, vA, 1);
            if (last && S.gather && has_next) {
                const LAS int* rb = rowbuf + ((ui + 1) & 1) * 256;
                const unsigned r0 = R0 < nvalid ? (unsigned)rb[R0] : 0u, r1 = R1 < nvalid ? (unsigned)rb[R1] : 0u;
                const unsigned r2 = HALF + R0 < nvalid ? (unsigned)rb[HALF + R0] : 0u, r3 = HALF + R1 < nvalid ? (unsigned)rb[HALF + R1] : 0u;
                vA[0] = r0 * (unsigned)(K * 2) + cb0; vA[1] = r1 * (unsigned)(K * 2) + cb1; vA[2] = r2 * (unsigned)(K * 2) + cb0; vA[3] = r3 * (unsigned)(K * 2) + cb1;
            }
            G8_WAIT_L(8); G8_BAR; G8_WAIT_L(0); G8_MMA(0, 0, At, B0); G8_BAR; G8_SCHED;
            G8_LDB(B1, 0, 1); G8_STAGE_B(G8_SB(0, 0), b2);
            G8_BAR; G8_WAIT_L(0); G8_MMA(0, 1, At, B1); G8_BAR;
            G8_LDA(At, 0, 1); G8_STAGE_A(G8_SA(0, 0), a2, vA, 0);
            G8_BAR; G8_WAIT_L(0); G8_MMA(1, 0, At, B0); G8_BAR; G8_SCHED;
            G8_STAGE_B(G8_SB(0, 1), b2 + hstepB);
            G8_WAIT_V(6); G8_BAR; G8_MMA(1, 1, At, B1); G8_BAR;
            G8_LDB(B0, 1, 0); G8_SCHED; G8_LDA(At, 1, 0); G8_STAGE_A(G8_SA(0, 1), a2, vA, 1);
            G8_WAIT_L(8); G8_BAR; G8_WAIT_L(0); G8_MMA(0, 0, At, B0); G8_BAR; G8_SCHED;
            G8_LDB(B1, 1, 1); G8_STAGE_B(G8_SB(1, 0), b3);
            G8_BAR; G8_WAIT_L(0); G8_MMA(0, 1, At, B1); G8_BAR;
            G8_LDA(At, 1, 1); G8_STAGE_A(G8_SA(1, 0), a3, vA, 0);
            G8_BAR; G8_WAIT_L(0); G8_MMA(1, 0, At, B0); G8_BAR; G8_SCHED;
            G8_STAGE_B(G8_SB(1, 1), b3 + hstepB);
            G8_WAIT_V(6); G8_BAR; G8_MMA(1, 1, At, B1); G8_BAR;
        }
        E(acc, cur, wr, wc, fr, fq, biasbuf + (ui & 1) * 256);
        if (!has_next) break;
        if (!E.keep(cur))
#pragma unroll
        for (int a = 0; a < 2; ++a)
#pragma unroll
            for (int b = 0; b < 2; ++b)
#pragma unroll
                for (int m = 0; m < 4; ++m)
#pragma unroll
                    for (int n = 0; n < 2; ++n) acc[a][b][m][n] = (f32x4){0.f, 0.f, 0.f, 0.f};
        cur = nxt; cA = nA; cB = nB; ++ui;
    }
    G8_WAIT_V(0);
    if (wr == 0) G8_BAR;
    G8_BAR;
#undef G8_SA
#undef G8_SB
#undef G8_GL
#undef G8_STAGE_A
#undef G8_STAGE_B
#undef G8_LDA
#undef G8_LDB
#undef G8_MMA
#undef G8_WAIT_V
#undef G8_WAIT_L
#undef G8_BAR
#undef G8_SCHED
}

struct PlainSched {
    const bf16_t* A; const bf16_t* Bt; int K, nM, nN, nwg, G, c;
    __device__ __forceinline__ void init(const bf16_t* A_, const bf16_t* Bt_, int M, int N, int K_) { A = A_; Bt = Bt_; K = K_; nM = M / BM; nN = N / BM; nwg = nM * nN; G = gridDim.x; c = blockIdx.x; }
    __device__ __forceinline__ bool next(int i, Unit& u) const {
        const long L = (long)i * G + c; if (L >= nwg) return false;
        int wgid = (int)L; { const int q = nwg / 8, r = nwg % 8, xcd = wgid % 8, off = wgid / 8; wgid = (xcd < r ? xcd * (q + 1) : r * (q + 1) + (xcd - r) * q) + off; }
        const int nig = 8 * nN, gid = wgid / nig, fm = gid * 8, gsz = (nM - fm) < 8 ? (nM - fm) : 8;
        u.pm = fm + ((wgid % nig) % gsz); u.pn = (wgid % nig) / gsz; u.e = 0; return true;
    }
    __device__ __forceinline__ const char* a_base(const Unit& u) const { return (const char*)(A + (size_t)u.pm * BM * K); }
    __device__ __forceinline__ const char* b_base(const Unit& u) const { return (const char*)(Bt + (size_t)u.pn * BM * K); }
    static constexpr bool HAS_BIAS = false, gather = false;
    __device__ __forceinline__ const int* row_addr(const Unit&, int) const { return nullptr; }
    __device__ __forceinline__ int rows_valid(const Unit&) const { return 256; }
    __device__ __forceinline__ const float* bias_src(const Unit&, int) const { return nullptr; }
};
}

struct StageRC { int R0, C0, R1, C1; };
__device__ __forceinline__ StageRC my_stage_rc() { const int t = opaque_tid(); StageRC s; gm::stage_rc(t * 16, s.R0, s.C0); gm::stage_rc(t * 16 + 8192, s.R1, s.C1); return s; }

__device__ __forceinline__ int w1_dst_row(int n) { const int half = n >> 10, cc = n & 1023; return (cc >> 7) * 256 + half * 128 + (cc & 127); }

struct CvtTile { const float* src; bf16_t* dst; int ld, Nsrc, k0, n0, K, mode; };
__device__ __forceinline__ CvtTile cvt_decode(const Params& p, int it) {
    constexpr int PER_L = 2960 + 512 + 256 + 16384 + 8192;
    CvtTile t; const int l = it / PER_L; int r = it % PER_L;
    if (r < 2960) { const int nt = r % 185, kt = r / 185; t.src = p.w_in + (size_t)l * D * NIN; t.ld = NIN; t.Nsrc = NIN; t.k0 = kt * 64; t.n0 = nt * 64; t.dst = p.winT + (size_t)l * NPW * D; t.K = D; t.mode = 2; }
    else if (r < 3472) { r -= 2960; const int n = r / 128; r %= 128; const int nt = r % 16, kt = r / 16;
        t.src = p.w_branch + (size_t)(l * 4 + n) * MW * D; t.ld = D; t.Nsrc = D; t.k0 = kt * 64; t.n0 = nt * 64; t.dst = p.wbT + (size_t)(l * 4 + n) * D * MW; t.K = MW; t.mode = 0; }
    else if (r < 3728) { r -= 3472; const int nt = r % 16, kt = r / 16; t.src = p.w_out + (size_t)l * D * D; t.ld = D; t.Nsrc = D; t.k0 = kt * 64; t.n0 = nt * 64; t.dst = p.woutT + (size_t)l * D * D; t.K = D; t.mode = 0; }
    else if (r < 3728 + 16384) { r -= 3728; const int ee = r / 512; r %= 512; const int nt = r % 32, kt = r / 32;
        t.src = p.moe_w1 + (size_t)(l * NE + ee) * D * 2 * D; t.ld = 2 * D; t.Nsrc = 2 * D; t.k0 = kt * 64; t.n0 = nt * 64; t.dst = p.w1T + (size_t)(l * NE + ee) * 2 * D * D; t.K = D; t.mode = 1; }
    else { r -= 3728 + 16384; const int ee = r / 256; r %= 256; const int nt = r % 16, kt = r / 16;
        t.src = p.moe_w2 + (size_t)(l * NE + ee) * D * D; t.ld = D; t.Nsrc = D; t.k0 = kt * 64; t.n0 = nt * 64; t.dst = p.w2T + (size_t)(l * NE + ee) * D * D; t.K = D; t.mode = 0; }
    return t;
}

__device__ __forceinline__ void ph_convert(const Params& p, LAS unsigned char* lds) {
    LAS float* tile = (LAS float*)lds;
    const int tid = opaque_tid();
    for (int idx = blockIdx.x * NTHREADS + tid; idx < 2 * 8 * 4 * 4096; idx += gridDim.x * NTHREADS) {
        const int i = idx & 63, j = (idx >> 6) & 63, mat = (idx >> 12) & 3, n = (idx >> 14) & 7, ll = idx >> 17, d = mat >> 1;
        p.lruT[idx] = (bf16_t)f2bf(((mat & 1) ? p.lru_wx : p.lru_wa)[(size_t)((ll * 2 + d) * 8 + n) * 4096 + i * 64 + j]);
    }
    constexpr int TOTAL = 2 * (2960 + 512 + 256 + 16384 + 8192);
    for (int idx = blockIdx.x * NTHREADS + tid; idx < 2 * 240 * (D / 8); idx += gridDim.x * NTHREADS) {
        const int ll = idx / (240 * (D / 8)), r = idx % (240 * (D / 8));
        *(u32x4*)(p.winT + ((size_t)ll * NPW + 7696) * D + (size_t)r * 8) = (u32x4){0u, 0u, 0u, 0u};
    }
    for (int g = blockIdx.x; g * 4 < TOTAL; g += gridDim.x) {
        float v[4][8];
        const int rr = tid >> 6, cc = tid & 63;
#pragma unroll
        for (int q = 0; q < 4; ++q) {
            const int it = g * 4 + q;
            const CvtTile t = cvt_decode(p, it < TOTAL ? it : TOTAL - 1);
            const int n = t.n0 + cc; const bool ok = n < t.Nsrc; const int nc = ok ? n : t.Nsrc - 1;
#pragma unroll
            for (int i = 0; i < 8; ++i) { const float x = t.src[(size_t)(t.k0 + rr + i * 8) * t.ld + nc]; v[q][i] = ok ? x : 0.f; }
        }
#pragma unroll
        for (int q = 0; q < 4; ++q)
#pragma unroll
            for (int i = 0; i < 8; ++i) tile[q * 4160 + (rr + i * 8) * 65 + cc] = v[q][i];
        __syncthreads();
#pragma unroll
        for (int q = 0; q < 4; ++q) {
            const int it = g * 4 + q;
            if (it < TOTAL) {
                const CvtTile t = cvt_decode(p, it);
                const int nl = tid >> 3, kg = tid & 7, n = t.n0 + nl;
                float w[8];
#pragma unroll
                for (int j = 0; j < 8; ++j) w[j] = tile[q * 4160 + (kg * 8 + j) * 65 + nl];
                const int drow = t.mode == 1 ? w1_dst_row(n) : t.mode == 2 ? win_dst_row(n) : n;
                if (n < t.Nsrc) *(u32x4*)(t.dst + (size_t)drow * t.K + t.k0 + kg * 8) = pack8(w);
            }
        }
        __syncthreads();
    }
}

__device__ __forceinline__ void ph_mod(const Params& p, LAS unsigned char* lds) {
    LAS float* sc = (LAS float*)lds;
    LAS float* red = sc + 5 * D;
    const int tid = opaque_tid(), wid = tid >> 6, lane = tid & 63;
    if ((int)blockIdx.x >= 192) return;
    for (int i = tid; i < 5 * D; i += NTHREADS) { const int r = i >> 10, k = i & 1023; const float v = r < 4 ? p.c[r * D + k] : p.c_ctx[k]; sc[i] = siluf_(v); }
    __syncthreads();
    for (int it = blockIdx.x; it < 192; it += gridDim.x) {
        const int l = it / 96, n0 = (it % 96) * 64;
        float acc[5] = {0.f, 0.f, 0.f, 0.f, 0.f};
        const float* wp = p.w_mod + (size_t)l * D * (NMOD * D) + n0 + lane;
        for (int k = wid * 128; k < wid * 128 + 128; ++k) {
            const float wv = wp[(size_t)k * (NMOD * D)];
#pragma unroll
            for (int r = 0; r < 5; ++r) acc[r] += sc[r * D + k] * wv;
        }
#pragma unroll
        for (int r = 0; r < 5; ++r) red[(wid * 5 + r) * 64 + lane] = acc[r];
        __syncthreads();
        if (tid < 320) { const int r = tid >> 6, cidx = tid & 63; float s = p.b_mod[l * NMOD * D + n0 + cidx];
#pragma unroll
            for (int w = 0; w < 8; ++w) s += red[(w * 5 + r) * 64 + cidx];
            p.mod[(size_t)(l * 5 + r) * (NMOD * D) + n0 + cidx] = s; }
        __syncthreads();
    }
}

__device__ __forceinline__ void norm_mod_store(const float4 (&v)[4], float rinv, const float* g, const float* scp, const float* shp, bf16_t* dst, int lane) {
#pragma unroll
    for (int i = 0; i < 4; ++i) {
        const int cidx = i * 256 + lane * 4;
        const float4 gv = *(const float4*)(g + cidx), sv = *(const float4*)(scp + cidx), hv = *(const float4*)(shp + cidx);
        const float h0 = v[i].x * rinv * gv.x * (1.f + sv.x) + hv.x, h1 = v[i].y * rinv * gv.y * (1.f + sv.y) + hv.y;
        const float h2 = v[i].z * rinv * gv.z * (1.f + sv.z) + hv.z, h3 = v[i].w * rinv * gv.w * (1.f + sv.w) + hv.w;
        u32x2 o; o[0] = pack2(h0, h1); o[1] = pack2(h2, h3);
        *(u32x2*)(dst + cidx) = o;
    }
}
__device__ __forceinline__ void ph_norm1_first(const Params& p) {
    const int tid = opaque_tid(), wid = tid >> 6, lane = tid & 63;
    for (int tok = blockIdx.x * NWAVES + wid; tok < NTOK; tok += gridDim.x * NWAVES) {
        const float* src = tok < NLAT ? p.x + (size_t)tok * D : p.ctx + (size_t)(tok - NLAT) * D;
        float4 v[4]; float ss = 0.f;
#pragma unroll
        for (int i = 0; i < 4; ++i) { v[i] = *(const float4*)(src + i * 256 + lane * 4); ss += v[i].x * v[i].x + v[i].y * v[i].y + v[i].z * v[i].z + v[i].w * v[i].w; }
        ss = wave_sum(ss, lane);
        const float rinv = rsqrtf(ss * (1.0f / D) + 1e-6f);
        const float* mb = p.mod + (size_t)(0 * 5 + tok_modrow(tok)) * (NMOD * D);
        norm_mod_store(v, rinv, p.norm1_g, mb + 1 * D, mb + 0 * D, p.H + (size_t)tok * D, lane);
#pragma unroll
        for (int i = 0; i < 4; ++i) *(float4*)(p.xl + (size_t)tok * D + i * 256 + lane * 4) = v[i];
    }
}

struct EpiP {
    bf16_t* O; bf16_t* gate;
    __device__ __forceinline__ bool keep(const g8::Unit&) const { return false; }
    __device__ __forceinline__ void operator()(const f32x4 (&acc)[2][2][4][2], const g8::Unit& u, int wr, int wc, int fr, int fq, const LAS float*) const {
        if (u.pn < 31) {
            const int row0 = u.pm * 256 + wr * 64 + fr, col0 = u.pn * 256 + wc * 32 + 8 * fq;
#pragma unroll
            for (int ai = 0; ai < 2; ++ai)
#pragma unroll
                for (int m = 0; m < 4; ++m) {
                    bf16_t* rowp = O + (size_t)(row0 + ai * 128 + m * 16) * NP + col0;
#pragma unroll
                    for (int bj = 0; bj < 2; ++bj) {
                        u32x4 w; w[0] = pack2(acc[ai][bj][m][0][0], acc[ai][bj][m][0][1]); w[1] = pack2(acc[ai][bj][m][0][2], acc[ai][bj][m][0][3]);
                        w[2] = pack2(acc[ai][bj][m][1][0], acc[ai][bj][m][1][1]); w[3] = pack2(acc[ai][bj][m][1][2], acc[ai][bj][m][1][3]);
                        *(u32x4*)(rowp + bj * 128) = w;
                    }
                }
        } else {
            const int g = u.pn - 31;
            bf16_t* gp = gate + ((((size_t)u.pm * 16 + g) * 8 + (wr * 4 + wc)) * 16) * 512 + (fq * 16 + fr) * 8;
#pragma unroll
            for (int ai = 0; ai < 2; ++ai)
#pragma unroll
                for (int m = 0; m < 4; ++m)
#pragma unroll
                    for (int bj = 0; bj < 2; ++bj) {
                        float s[8];
#pragma unroll
                        for (int n = 0; n < 2; ++n)
#pragma unroll
                            for (int j = 0; j < 4; ++j) s[n * 4 + j] = sigmoidf_(acc[ai][bj][m][n][j]);
                        *(u32x4*)(gp + (ai * 8 + m * 2 + bj) * 512) = pack8(s);
                    }
        }
    }
};
__device__ __forceinline__ void ph_g1(const Params& p, int l, LAS unsigned char* lds) {
    g8::PlainSched S; S.init(p.H, p.winT + (size_t)l * NPW * D, NTOK, NPW, D);
    EpiP E; E.O = p.P; E.gate = p.gate;
    g8::gemm_phase(lds, D, S, E);
}

__device__ __forceinline__ void ph_prep(const Params& p, int l, LAS unsigned char* lds) {
    const int tid = opaque_tid(), wid = tid >> 6, lane = tid & 63, fr = lane & 15, fq = lane >> 4;
    LAS float* xs = (LAS float*)lds;
    LAS bf16_t* xb = (LAS bf16_t*)(xs + 64 * 68);
    LAS bf16_t* wt = xb + 64 * 72;
    for (int it = blockIdx.x; it < (NTOK / 64) * 8; it += gridDim.x) {
        const int tile = it >> 3, n = it & 7, tok0 = tile * 64;
        {
            const int tl = tid & 63, cg = tid >> 6, tok = tok0 + tl;
            int t, T, base; tok_info(tok, t, T, base);
            float a[8];
            { const float4 b0 = *(const float4*)(p.lru_conv_b + l * MW + n * 64 + cg * 8), b1 = *(const float4*)(p.lru_conv_b + l * MW + n * 64 + cg * 8 + 4);
              a[0] = b0.x; a[1] = b0.y; a[2] = b0.z; a[3] = b0.w; a[4] = b1.x; a[5] = b1.y; a[6] = b1.z; a[7] = b1.w; }
#pragma unroll
            for (int j = 0; j < 4; ++j) {
                const int tt = t + j - 2;
                const float okf = (tt >= 0 && tt < T) ? 1.0f : 0.0f;
                const int ttc = tt < 0 ? 0 : (tt >= T ? T - 1 : tt);
                const u32x4 u = *(const u32x4*)(p.P + (size_t)(base + ttc) * NP + C_LX + n * 64 + cg * 8);
                const float* w = p.lru_conv_w + (size_t)(l * 4 + j) * MW + n * 64 + cg * 8;
                const float4 wa = *(const float4*)w, wb = *(const float4*)(w + 4);
                const float wv[8] = {wa.x * okf, wa.y * okf, wa.z * okf, wa.w * okf, wb.x * okf, wb.y * okf, wb.z * okf, wb.w * okf};
#pragma unroll
                for (int q = 0; q < 4; ++q) { a[2 * q] += wv[2 * q] * bflo(u[q]); a[2 * q + 1] += wv[2 * q + 1] * bfhi(u[q]); }
            }
            *(LAS f32x4*)(xs + tl * 68 + cg * 8) = (f32x4){a[0], a[1], a[2], a[3]}; *(LAS f32x4*)(xs + tl * 68 + cg * 8 + 4) = (f32x4){a[4], a[5], a[6], a[7]};
            *(LAS u32x4*)(xb + tl * 72 + cg * 8) = pack8(a);
            const bf16_t* wsrc = p.lruT + (size_t)((l * 8 + n) * 4) * 4096;
#pragma unroll
            for (int q = 0; q < 4; ++q) { const int e8 = tid + 512 * q, row = e8 >> 3, c8 = e8 & 7; *(LAS u32x4*)(wt + row * 72 + c8 * 8) = *(const u32x4*)(wsrc + (size_t)e8 * 8); }
        }
        __syncthreads();
        {
            const int jb = wid & 3, tb0 = (wid >> 2) * 2;
            bf16x8 xw[4][2];
#pragma unroll
            for (int m = 0; m < 4; ++m)
#pragma unroll
                for (int ks = 0; ks < 2; ++ks) xw[m][ks] = *(const LAS bf16x8*)(wt + (m * 64 + jb * 16 + fr) * 72 + ks * 32 + fq * 8);
            const int c0 = n * 64 + jb * 16 + 4 * fq;
            float4 bav[2], bxv[2], lsv[2];
#pragma unroll
            for (int d = 0; d < 2; ++d) {
                bav[d] = *(const float4*)(p.lru_ba + (l * 2 + d) * MW + c0); bxv[d] = *(const float4*)(p.lru_bx + (l * 2 + d) * MW + c0);
                const float4 lm = *(const float4*)(p.lru_lambda + (l * 2 + d) * MW + c0);
                lsv[d] = make_float4(8.0f * logsigmoidf_(lm.x), 8.0f * logsigmoidf_(lm.y), 8.0f * logsigmoidf_(lm.z), 8.0f * logsigmoidf_(lm.w));
            }
#pragma unroll
            for (int e = 0; e < 2; ++e) {
                const int tl = (tb0 + e) * 16 + fr, tok = tok0 + tl;
                f32x4 acc[4];
#pragma unroll
                for (int m = 0; m < 4; ++m) acc[m] = (f32x4){0.f, 0.f, 0.f, 0.f};
#pragma unroll
                for (int ks = 0; ks < 2; ++ks) {
                    const bf16x8 y = *(const LAS bf16x8*)(xb + tl * 72 + ks * 32 + fq * 8);
#pragma unroll
                    for (int m = 0; m < 4; ++m) acc[m] = mfma16(xw[m][ks], y, acc[m]);
                }
                const f32x4 xv = *(const LAS f32x4*)(xs + tl * 68 + jb * 16 + 4 * fq);
#pragma unroll
                for (int d = 0; d < 2; ++d) {
                    const float bar_[4] = {bav[d].x, bav[d].y, bav[d].z, bav[d].w}, bxr[4] = {bxv[d].x, bxv[d].y, bxv[d].z, bxv[d].w}, lsr[4] = {lsv[d].x, lsv[d].y, lsv[d].z, lsv[d].w};
                    float av[4], uv[4];
#pragma unroll
                    for (int r = 0; r < 4; ++r) {
                        const float gr = sigmoidf_(acc[d * 2][r] + bar_[r]), gi = sigmoidf_(acc[d * 2 + 1][r] + bxr[r]);
                        const float la = gr * lsr[r];
                        av[r] = __expf(la);
                        uv[r] = xv[r] * gi * sqrtf(fmaxf(-expm1f(2.0f * la), 1e-12f));
                    }
                    *(float4*)(p.prep + (PR_LA + d) * TOKW + (size_t)tok * MW + c0) = make_float4(av[0], av[1], av[2], av[3]);
                    *(float4*)(p.prep + (PR_LU + d) * TOKW + (size_t)tok * MW + c0) = make_float4(uv[0], uv[1], uv[2], uv[3]);
                }
            }
        }
        __syncthreads();
    }
}

__device__ __forceinline__ int chunk_base(int b, int d, int n) {
    if (n < 4) { const int blk = d ? 3 - n : n; return NLAT + b * TC + blk * 64; }
    const int m = n - 4, blk = d ? 63 - m : m; return b * TL + blk * 64;
}

__device__ __forceinline__ void local_gla(const Params& p, int l, int tz, int chain, int n, LAS unsigned char* lds) {
    const int tid = opaque_tid(), wid = tid >> 6, lane = tid & 63, fr = lane & 15, fq = lane >> 4;
    const int b = chain >> 3, h = (chain >> 1) & 3, d = chain & 1;
    const int base = chunk_base(b, d, n);
    const size_t item = (size_t)tz * NITEM + (size_t)chain * NCHUNK + n;
    LAS bf16_t* kraw = (LAS bf16_t*)lds;
    LAS bf16_t* qh = kraw + 64 * 136;
    LAS bf16_t* kh = qh + 64 * 136;
    LAS bf16_t* sc = kh + 64 * 136;
    LAS bf16_t* vT = sc + 64 * 72;
    LAS bf16_t* kT = vT + 128 * 72;
    LAS float* bc = (LAS float*)(kT + 128 * 72);
    const int vcol = tz == 1 ? C_HI : C_RQKV + 1024;
    const int ti = tid >> 3, dg = tid & 7, cA = dg * 8, cB = 64 + dg * 8;
    const int tokI = base + (d ? 63 - ti : ti);
    const bf16_t* pr = p.P + (size_t)tokI * NP;
    float qt[16];
    {
        float kv[16], lfv[16];
        if (tz == 1) {
            float lbv[16];
            {
                const float* lp0 = p.hgrn_lb + (size_t)(0 * 2 + d) * MW + h * 128; const float* lp1 = p.hgrn_lb + (size_t)(1 * 2 + d) * MW + h * 128;
                const float4 a0 = *(const float4*)(lp0 + cA), a1 = *(const float4*)(lp0 + cA + 4), a2 = *(const float4*)(lp0 + cB), a3 = *(const float4*)(lp0 + cB + 4);
                const float4 b0 = *(const float4*)(lp1 + cA), b1 = *(const float4*)(lp1 + cA + 4), b2 = *(const float4*)(lp1 + cB), b3 = *(const float4*)(lp1 + cB + 4);
                const float x0[16] = {a0.x, a0.y, a0.z, a0.w, a1.x, a1.y, a1.z, a1.w, a2.x, a2.y, a2.z, a2.w, a3.x, a3.y, a3.z, a3.w};
                const float x1[16] = {b0.x, b0.y, b0.z, b0.w, b1.x, b1.y, b1.z, b1.w, b2.x, b2.y, b2.z, b2.w, b3.x, b3.y, b3.z, b3.w};
#pragma unroll
                for (int e = 0; e < 16; ++e) lbv[e] = (l == 1) ? fminf(__builtin_amdgcn_rcpf(1.0f + __expf(x0[e] - x1[e])), 1.0f - 1e-4f) : 0.f;
            }
            const u32x4 uqa = *(const u32x4*)(pr + C_HQ + h * 128 + cA), uqb = *(const u32x4*)(pr + C_HQ + h * 128 + cB);
            const u32x4 uza = *(const u32x4*)(pr + C_HF + d * 512 + h * 128 + cA), uzb = *(const u32x4*)(pr + C_HF + d * 512 + h * 128 + cB);
#pragma unroll
            for (int e = 0; e < 16; ++e) {
                const unsigned uq = e < 8 ? uqa[(e & 7) >> 1] : uqb[(e & 7) >> 1], uz = e < 8 ? uza[(e & 7) >> 1] : uzb[(e & 7) >> 1];
                const float qraw = (e & 1) ? bfhi(uq) : bflo(uq), z = (e & 1) ? bfhi(uz) : bflo(uz);
                const float lb = lbv[e];
                const float sg = sigmoidf_(z);
                qt[e] = siluf_(qraw) * 0.08838834764831845f;
                kv[e] = (1.f - lb) * (1.f - sg);
                lfv[e] = __logf(fmaxf(lb + (1.f - lb) * sg, 1e-30f));
            }
        } else {
            const bf16_t* rp = pr + C_RQKV + h * 128;
            const u32x4 q1 = *(const u32x4*)(rp + cA), q2 = *(const u32x4*)(rp + cB), k1 = *(const u32x4*)(rp + 512 + cA), k2 = *(const u32x4*)(rp + 512 + cB);
            const float lng = log1pf(-exp2f(-5.0f - (float)h));
            const bool lat = tokI < NLAT;
            const int t = tokI & (TL - 1);
#pragma unroll
            for (int e = 0; e < 8; ++e) {
                float a1 = (e & 1) ? bfhi(q1[e >> 1]) : bflo(q1[e >> 1]), a2 = (e & 1) ? bfhi(q2[e >> 1]) : bflo(q2[e >> 1]);
                float b1 = (e & 1) ? bfhi(k1[e >> 1]) : bflo(k1[e >> 1]), b2 = (e & 1) ? bfhi(k2[e >> 1]) : bflo(k2[e >> 1]);
                if (lat) {
                    const int pi = cA + e;
                    const float pos = (pi < 32) ? (float)(t >> 6) : (float)(t & 63);
                    const float ang = pos * exp2f(-(float)(pi & 31) * (13.287712379549449f / 32.0f));
                    float sn, cs; sincosf(ang, &sn, &cs);
                    const float n1 = a1 * cs - a2 * sn, n2 = a1 * sn + a2 * cs, m1 = b1 * cs - b2 * sn, m2 = b1 * sn + b2 * cs;
                    a1 = n1; a2 = n2; b1 = m1; b2 = m2;
                }
                qt[e] = a1; qt[8 + e] = a2; kv[e] = b1 * 0.08838834764831845f; kv[8 + e] = b2 * 0.08838834764831845f;
                lfv[e] = lng; lfv[8 + e] = lng;
            }
        }
        *(LAS u32x4*)(kraw + ti * 136 + cA) = pack8(kv); *(LAS u32x4*)(kraw + ti * 136 + cB) = pack8(kv + 8);
        *(LAS f32x4*)(bc + ti * 132 + cA) = (f32x4){lfv[0], lfv[1], lfv[2], lfv[3]}; *(LAS f32x4*)(bc + ti * 132 + cA + 4) = (f32x4){lfv[4], lfv[5], lfv[6], lfv[7]};
        *(LAS f32x4*)(bc + ti * 132 + cB) = (f32x4){lfv[8], lfv[9], lfv[10], lfv[11]}; *(LAS f32x4*)(bc + ti * 132 + cB + 4) = (f32x4){lfv[12], lfv[13], lfv[14], lfv[15]};
        const bf16_t* vp = pr + vcol + h * 128;
        const u32x4 v0 = *(const u32x4*)(vp + cA), v1 = *(const u32x4*)(vp + cB);
#pragma unroll
        for (int e = 0; e < 8; ++e) {
            vT[(cA + e) * 72 + ti] = (bf16_t)((e & 1) ? (v0[e >> 1] >> 16) : (v0[e >> 1] & 0xffffu));
            vT[(cB + e) * 72 + ti] = (bf16_t)((e & 1) ? (v1[e >> 1] >> 16) : (v1[e >> 1] & 0xffffu));
        }
    }
    __syncthreads();
    if (tid < 128) {
        float run = 0.f, lv[64];
#pragma unroll
        for (int i = 0; i < 64; ++i) lv[i] = bc[i * 132 + tid];
#pragma unroll
        for (int i = 0; i < 64; ++i) { run += lv[i]; bc[i * 132 + tid] = run; }
    }
    __syncthreads();
    {
        const int I = ti >> 4;
        float qhat[16];
#pragma unroll
        for (int e = 0; e < 16; ++e) {
            const int ch = e < 8 ? cA + e : cB + e - 8;
            const float bi = bc[ti * 132 + ch], rI = I ? bc[(16 * I - 1) * 132 + ch] : 0.f, bl = bc[63 * 132 + ch];
            qhat[e] = qt[e] * __expf(bi - rI); qt[e] = qt[e] * __expf(bi);
            kT[ch * 72 + ti] = (bf16_t)f2bf(bf2f(kraw[ti * 136 + ch]) * __expf(bl - bi));
        }
        *(LAS u32x4*)(qh + ti * 136 + cA) = pack8(qhat); *(LAS u32x4*)(qh + ti * 136 + cB) = pack8(qhat + 8);
        {
            bf16_t* lqb = p.lq + item * 8192 + (size_t)((ti >> 4) * 8) * 256 + (ti & 15) * 4;
            const u32x4 pa = pack8(qt), pb = pack8(qt + 8);
            u32x2 t0; t0[0] = pa[0]; t0[1] = pa[1]; u32x2 t1; t1[0] = pa[2]; t1[1] = pa[3]; u32x2 t2; t2[0] = pb[0]; t2[1] = pb[1]; u32x2 t3; t3[0] = pb[2]; t3[1] = pb[3];
            *(u32x2*)(lqb + (dg >> 1) * 256 + ((dg & 1) * 2 + 0) * 64) = t0; *(u32x2*)(lqb + (dg >> 1) * 256 + ((dg & 1) * 2 + 1) * 64) = t1;
            *(u32x2*)(lqb + (4 + (dg >> 1)) * 256 + ((dg & 1) * 2 + 0) * 64) = t2; *(u32x2*)(lqb + (4 + (dg >> 1)) * 256 + ((dg & 1) * 2 + 1) * 64) = t3;
        }
    }
    if (tid < 128) p.ld[item * 128 + tid] = __expf(bc[63 * 132 + tid]);
    for (int I = 0; I < 4; ++I) {
        if (ti < 16 * (I + 1)) {
            float kk[16];
#pragma unroll
            for (int e = 0; e < 16; ++e) {
                const int ch = e < 8 ? cA + e : cB + e - 8;
                const float rI = I ? bc[(16 * I - 1) * 132 + ch] : 0.f, bj = bc[ti * 132 + ch];
                kk[e] = bf2f(kraw[ti * 136 + ch]) * __expf(fminf(rI - bj, 80.f));
            }
            *(LAS u32x4*)(kh + ti * 136 + cA) = pack8(kk); *(LAS u32x4*)(kh + ti * 136 + cB) = pack8(kk + 8);
        }
        __syncthreads();
        if (wid < 4) {
            const int J = wid;
            u32x2 outv; outv[0] = 0u; outv[1] = 0u;
            if (J <= I) {
                f32x4 acc = (f32x4){0.f, 0.f, 0.f, 0.f};
#pragma unroll
                for (int ks = 0; ks < 4; ++ks)
                    acc = mfma16(*(const LAS bf16x8*)(kh + (J * 16 + fr) * 136 + ks * 32 + fq * 8), *(const LAS bf16x8*)(qh + (I * 16 + fr) * 136 + ks * 32 + fq * 8), acc);
                const int i = 16 * I + fr, j0 = 16 * J + 4 * fq;
#pragma unroll
                for (int r = 0; r < 4; ++r) if (j0 + r > i) acc[r] = 0.f;
                outv = pack4(acc);
            }
            *(LAS u32x2*)(sc + (I * 16 + fr) * 72 + J * 16 + 4 * fq) = outv;
        }
        __syncthreads();
    }
    {
        bf16x8 xv[2], xk[2];
#pragma unroll
        for (int ks = 0; ks < 2; ++ks) { xv[ks] = *(const LAS bf16x8*)(vT + (wid * 16 + fr) * 72 + ks * 32 + fq * 8); xk[ks] = *(const LAS bf16x8*)(kT + (wid * 16 + fr) * 72 + ks * 32 + fq * 8); }
#pragma unroll
        for (int ib = 0; ib < 4; ++ib) {
            f32x4 acc = (f32x4){0.f, 0.f, 0.f, 0.f};
#pragma unroll
            for (int ks = 0; ks < 2; ++ks) acc = mfma16(xv[ks], *(const LAS bf16x8*)(sc + (ib * 16 + fr) * 72 + ks * 32 + fq * 8), acc);
            *(u32x2*)(p.lo + item * 8192 + ((wid * 4 + ib) * 64 + lane) * 4) = pack4(acc);
        }
#pragma unroll
        for (int dvb = 0; dvb < 8; ++dvb) {
            f32x4 acc = (f32x4){0.f, 0.f, 0.f, 0.f};
#pragma unroll
            for (int ks = 0; ks < 2; ++ks) acc = mfma16(xk[ks], *(const LAS bf16x8*)(vT + (dvb * 16 + fr) * 72 + ks * 32 + fq * 8), acc);
            *(u32x2*)(p.lb + item * 16384 + ((wid * 8 + dvb) * 64 + lane) * 4) = pack4(acc);
        }
    }
    __syncthreads();
}


template <int MODE> __device__ __forceinline__ void local_ret(const Params& p, int l, int chain, int n, LAS unsigned char* lds) {
    const int tid = opaque_tid(), wid = tid >> 6, lane = tid & 63, fr = lane & 15, fq = lane >> 4;
    const int b = chain >> 3, h = (chain >> 1) & 3, d = chain & 1;
    const int base = chunk_base(b, d, n);
    const size_t item = (size_t)2 * NITEM + (size_t)chain * NCHUNK + n;
    LAS bf16_t* ks_ = (LAS bf16_t*)lds;
    LAS bf16_t* qs = ks_ + 64 * 136;
    LAS bf16_t* sc = qs + 64 * 136;
    LAS bf16_t* vT = sc + 64 * 72;
    LAS bf16_t* kT = vT + 128 * 72;
    const int ti = tid >> 3, dg = tid & 7, cA = dg * 8, cB = 64 + dg * 8;
    const int tokI = base + (d ? 63 - ti : ti);
    const bf16_t* pr = p.P + (size_t)tokI * NP + C_RQKV + h * 128;
    const float lng = log1pf(-exp2f(-5.0f - (float)h));
    {
        const u32x4 q1 = *(const u32x4*)(pr + cA), q2 = *(const u32x4*)(pr + cB), k1 = *(const u32x4*)(pr + 512 + cA), k2 = *(const u32x4*)(pr + 512 + cB);
        const u32x4 v0 = *(const u32x4*)(pr + 1024 + cA), v1 = *(const u32x4*)(pr + 1024 + cB);
        const bool lat = tokI < NLAT;
        const int t = tokI & (TL - 1);
        float qv[16], kv[16];
#pragma unroll
        for (int e = 0; e < 8; ++e) {
            float a1 = (e & 1) ? bfhi(q1[e >> 1]) : bflo(q1[e >> 1]), a2 = (e & 1) ? bfhi(q2[e >> 1]) : bflo(q2[e >> 1]);
            float b1 = (e & 1) ? bfhi(k1[e >> 1]) : bflo(k1[e >> 1]), b2 = (e & 1) ? bfhi(k2[e >> 1]) : bflo(k2[e >> 1]);
            if (lat) {
                const int pi = cA + e;
                const float pos = (pi < 32) ? (float)(t >> 6) : (float)(t & 63);
                const float ang = pos * exp2f(-(float)(pi & 31) * (13.287712379549449f / 32.0f));
                float sn, cs; sincosf(ang, &sn, &cs);
                const float n1 = a1 * cs - a2 * sn, n2 = a1 * sn + a2 * cs, m1 = b1 * cs - b2 * sn, m2 = b1 * sn + b2 * cs;
                a1 = n1; a2 = n2; b1 = m1; b2 = m2;
            }
            qv[e] = a1; qv[8 + e] = a2; kv[e] = b1 * 0.08838834764831845f; kv[8 + e] = b2 * 0.08838834764831845f;
        }
        *(LAS u32x4*)(ks_ + ti * 136 + cA) = pack8(kv); *(LAS u32x4*)(ks_ + ti * 136 + cB) = pack8(kv + 8);
        *(LAS u32x4*)(qs + ti * 136 + cA) = pack8(qv); *(LAS u32x4*)(qs + ti * 136 + cB) = pack8(qv + 8);
        const float gq = __expf((float)(ti + 1) * lng), gk = __expf((float)(63 - ti) * lng);
#pragma unroll
        for (int e = 0; e < 8; ++e) {
            vT[(cA + e) * 72 + ti] = (bf16_t)((e & 1) ? (v0[e >> 1] >> 16) : (v0[e >> 1] & 0xffffu));
            vT[(cB + e) * 72 + ti] = (bf16_t)((e & 1) ? (v1[e >> 1] >> 16) : (v1[e >> 1] & 0xffffu));
            kT[(cA + e) * 72 + ti] = (bf16_t)f2bf(kv[e] * gk); kT[(cB + e) * 72 + ti] = (bf16_t)f2bf(kv[8 + e] * gk);
            qv[e] *= gq; qv[8 + e] *= gq;
        }
        {
            bf16_t* lqb = p.lq + item * 8192 + (size_t)((ti >> 4) * 8) * 256 + (ti & 15) * 4;
            const u32x4 pa = pack8(qv), pb = pack8(qv + 8);
            u32x2 t0; t0[0] = pa[0]; t0[1] = pa[1]; u32x2 t1; t1[0] = pa[2]; t1[1] = pa[3]; u32x2 t2; t2[0] = pb[0]; t2[1] = pb[1]; u32x2 t3; t3[0] = pb[2]; t3[1] = pb[3];
            *(u32x2*)(lqb + (dg >> 1) * 256 + ((dg & 1) * 2 + 0) * 64) = t0; *(u32x2*)(lqb + (dg >> 1) * 256 + ((dg & 1) * 2 + 1) * 64) = t1;
            *(u32x2*)(lqb + (4 + (dg >> 1)) * 256 + ((dg & 1) * 2 + 0) * 64) = t2; *(u32x2*)(lqb + (4 + (dg >> 1)) * 256 + ((dg & 1) * 2 + 1) * 64) = t3;
        }
    }
    if (tid < 128) p.ld[item * 128 + tid] = __expf(64.0f * lng);
    __syncthreads();
#pragma unroll
    for (int e = 0; e < 2; ++e) {
        const int f = wid * 2 + e, ib = f >> 2, jb = f & 3;
        const int i = 16 * ib + fr, j0 = 16 * jb + 4 * fq;
        f32x4 mq = (f32x4){0.f, 0.f, 0.f, 0.f};
        if (jb <= ib) {
#pragma unroll
            for (int ks = 0; ks < 4; ++ks)
                mq = mfma16(*(const LAS bf16x8*)(ks_ + (jb * 16 + fr) * 136 + ks * 32 + fq * 8), *(const LAS bf16x8*)(qs + i * 136 + ks * 32 + fq * 8), mq);
#pragma unroll
            for (int r = 0; r < 4; ++r) { const int j = j0 + r; mq[r] = (j <= i) ? mq[r] * __expf((float)(i - j) * lng) : 0.f; }
        }
        *(LAS u32x2*)(sc + i * 72 + j0) = pack4(mq);
    }
    __syncthreads();
    {
        bf16x8 xv[2], xk[2];
#pragma unroll
        for (int ks = 0; ks < 2; ++ks) { xv[ks] = *(const LAS bf16x8*)(vT + (wid * 16 + fr) * 72 + ks * 32 + fq * 8); xk[ks] = *(const LAS bf16x8*)(kT + (wid * 16 + fr) * 72 + ks * 32 + fq * 8); }
#pragma unroll
        for (int ib = 0; ib < 4; ++ib) {
            f32x4 acc = (f32x4){0.f, 0.f, 0.f, 0.f};
#pragma unroll
            for (int ks = 0; ks < 2; ++ks) acc = mfma16(xv[ks], *(const LAS bf16x8*)(sc + (ib * 16 + fr) * 72 + ks * 32 + fq * 8), acc);
            *(u32x2*)(p.lo + item * 8192 + ((wid * 4 + ib) * 64 + lane) * 4) = pack4(acc);
        }
#pragma unroll
        for (int dvb = 0; dvb < 8; ++dvb) {
            f32x4 acc = (f32x4){0.f, 0.f, 0.f, 0.f};
#pragma unroll
            for (int ks = 0; ks < 2; ++ks) acc = mfma16(xk[ks], *(const LAS bf16x8*)(vT + (dvb * 16 + fr) * 72 + ks * 32 + fq * 8), acc);
            *(u32x2*)(p.lb + item * 16384 + ((wid * 8 + dvb) * 64 + lane) * 4) = pack4(acc);
        }
    }
    __syncthreads();
}

template <int I> struct SolveRows {
    static __device__ __forceinline__ void run(float (&x)[64], const LAS float* Mf, const LAS float* rs) {
        SolveRows<I - 1>::run(x, Mf, rs);
        float r = x[I] * rs[I];
        float pa[4] = {0.f, 0.f, 0.f, 0.f};
#pragma unroll
        for (int j4 = 0; j4 < (I + 3) / 4; ++j4) {
            const f32x4 m = *(const LAS f32x4*)(Mf + I * 68 + j4 * 4);
            pa[0] += m[0] * x[j4 * 4]; pa[1] += m[1] * x[j4 * 4 + 1]; pa[2] += m[2] * x[j4 * 4 + 2]; pa[3] += m[3] * x[j4 * 4 + 3];
        }
        r -= (pa[0] + pa[1]) + (pa[2] + pa[3]);
        asm volatile("" : "+v"(r) :: "memory");
        x[I] = r;
    }
};
template <> struct SolveRows<-1> { static __device__ __forceinline__ void run(float (&)[64], const LAS float*, const LAS float*) {} };

__device__ __forceinline__ void local_gdn(const Params& p, int l, int chain, int n, LAS unsigned char* lds) {
    const int tid = opaque_tid(), wid = tid >> 6, lane = tid & 63, fr = lane & 15, fq = lane >> 4;
    const int b = chain >> 3, h = (chain >> 1) & 3, d = chain & 1;
    const int base = chunk_base(b, d, n);
    const size_t item = (size_t)chain * NCHUNK + n;
    LAS bf16_t* ks_ = (LAS bf16_t*)lds;
    LAS bf16_t* qs = ks_ + 64 * 136;
    LAS bf16_t* att = qs + 64 * 136;
    LAS bf16_t* wT = att + 64 * 72;
    LAS bf16_t* uT = wT + 128 * 72;
    LAS bf16_t* kT = uT + 128 * 72;
    LAS float* Mf = (LAS float*)(kT + 128 * 72);
    LAS float* bcs = Mf + 64 * 68;
    LAS float* bts = bcs + 64;
    LAS float* rse = bts + 64;
    LAS bf16_t* vs = (LAS bf16_t*)(rse + 64);
    const int ti = tid >> 3, d0 = (tid & 7) * 16;
    const int tokI = base + (d ? 63 - ti : ti);
    {
        int t, T, sbase; tok_info(tokI, t, T, sbase);
#pragma unroll
        for (int part = 0; part < 3; ++part) {
            float a[16];
#pragma unroll
            for (int e = 0; e < 16; ++e) a[e] = 0.f;
            const int ccol = part * 512 + h * 128 + d0;
#pragma unroll
            for (int j = 0; j < 4; ++j) {
                const int tt = t + j - 2;
                const float okf = (tt >= 0 && tt < T) ? 1.0f : 0.0f;
                const int ttc = tt < 0 ? 0 : (tt >= T ? T - 1 : tt);
                const bf16_t* xp = p.P + (size_t)(sbase + ttc) * NP + C_GQKV + ccol;
                const u32x4 x0 = *(const u32x4*)xp, x1 = *(const u32x4*)(xp + 8);
                const float* wp = p.gdn_conv_w + (size_t)(l * 4 + j) * 1536 + ccol;
#pragma unroll
                for (int q = 0; q < 4; ++q) {
                    float4 w0 = *(const float4*)(wp + q * 4);
                    w0.x *= okf; w0.y *= okf; w0.z *= okf; w0.w *= okf;
                    const unsigned ua = q < 2 ? x0[2 * q] : x1[2 * q - 4], ub = q < 2 ? x0[2 * q + 1] : x1[2 * q - 3];
                    a[q * 4] += w0.x * bflo(ua); a[q * 4 + 1] += w0.y * bfhi(ua); a[q * 4 + 2] += w0.z * bflo(ub); a[q * 4 + 3] += w0.w * bfhi(ub);
                }
            }
            float ss = 0.f;
#pragma unroll
            for (int e = 0; e < 16; ++e) { a[e] = siluf_(a[e]); ss += a[e] * a[e]; }
            if (part < 2) {
                ss += shx(ss, 1, lane); ss += shx(ss, 2, lane); ss += shx(ss, 4, lane);
                const float scl = rsqrtf(ss + 1e-6f) * (part == 0 ? 0.08838834764831845f : 1.0f);
#pragma unroll
                for (int e = 0; e < 16; ++e) a[e] *= scl;
            }
            LAS bf16_t* dstt = (part == 0 ? qs : part == 1 ? ks_ : vs) + ti * 136 + d0;
            *(LAS u32x4*)dstt = pack8(a); *(LAS u32x4*)(dstt + 8) = pack8(a + 8);
        }
    }
    if (wid == 0) {
        const int tok = base + (d ? 63 - lane : lane);
        const float av = bf2f(p.P[(size_t)tok * NP + C_GA + d * 4 + h]);
        float v = -__expf(p.gdn_a_log[l * 8 + d * 4 + h]) * softplusf_(av + p.gdn_dt_bias[l * 8 + d * 4 + h]);
#pragma unroll
        for (int off = 1; off < 64; off <<= 1) { const float t = shup(v, off, lane); if (lane >= off) v += t; }
        const float btv = sigmoidf_(bf2f(p.P[(size_t)tok * NP + C_GB + d * 4 + h]));
        bcs[lane] = v; bts[lane] = btv; rse[lane] = btv * __expf(v);
    }
    __syncthreads();
#pragma unroll
    for (int e = 0; e < 2; ++e) {
        const int f = wid * 2 + e, ib = f >> 2, jb = f & 3;
        const int i = 16 * ib + fr, j0 = 16 * jb + 4 * fq;
        f32x4 mk = (f32x4){0.f, 0.f, 0.f, 0.f}, mq = (f32x4){0.f, 0.f, 0.f, 0.f};
        if (jb <= ib) {
#pragma unroll
            for (int ks = 0; ks < 4; ++ks) {
                const bf16x8 xk = *(const LAS bf16x8*)(ks_ + (jb * 16 + fr) * 136 + ks * 32 + fq * 8);
                mk = mfma16(xk, *(const LAS bf16x8*)(ks_ + (ib * 16 + fr) * 136 + ks * 32 + fq * 8), mk);
                mq = mfma16(xk, *(const LAS bf16x8*)(qs + (ib * 16 + fr) * 136 + ks * 32 + fq * 8), mq);
            }
            const float bi = bcs[i], bti = bts[i];
#pragma unroll
            for (int r = 0; r < 4; ++r) {
                const int j = j0 + r;
                const float dec = __expf(j <= i ? bi - bcs[j] : 0.f);
                mk[r] = (j < i) ? bti * mk[r] * dec : 0.f;
                mq[r] = (j <= i) ? mq[r] * dec : 0.f;
            }
        }
        *(LAS f32x4*)(Mf + i * 68 + j0) = mk;
        *(LAS u32x2*)(att + i * 72 + j0) = pack4(mq);
    }
    __syncthreads();
    {
        const float sc_ = __expf(bcs[63] - bcs[ti]);
#pragma unroll
        for (int e = 0; e < 16; ++e) kT[(d0 + e) * 72 + ti] = (bf16_t)f2bf(bf2f(ks_[ti * 136 + d0 + e]) * sc_);
    }
    if (tid < 256) {
        const int cidx = tid & 127;
        const bool isw = tid >= 128;
        const LAS bf16_t* srcp = (isw ? ks_ : vs) + cidx;
        float x[64];
#pragma unroll
        for (int i = 0; i < 64; ++i) x[i] = bf2f(srcp[i * 136]);
        {
            unsigned mb = (unsigned)(size_t)Mf, rb = (unsigned)(size_t)(isw ? rse : bts);
            asm volatile("" : "+v"(mb), "+v"(rb));
            SolveRows<63>::run(x, (const LAS float*)(size_t)mb, (const LAS float*)(size_t)rb);
        }
        if (isw) {
#pragma unroll
            for (int i = 0; i < 64; ++i) x[i] = -x[i];
        }
        LAS bf16_t* dst = (isw ? wT : uT) + cidx * 72;
#pragma unroll
        for (int q = 0; q < 8; ++q) *(LAS u32x4*)(dst + q * 8) = pack8(x + q * 8);
    }
    if (tid < 128) p.ld[item * 128 + tid] = __expf(bcs[63]);
    __syncthreads();
    {
        const int tid = opaque_tid(), wid = tid >> 6, lane = tid & 63, fr = lane & 15, fq = lane >> 4;
        bf16x8 xw[2], xu[2], xk[2];
#pragma unroll
        for (int ks = 0; ks < 2; ++ks) {
            xw[ks] = *(const LAS bf16x8*)(wT + (wid * 16 + fr) * 72 + ks * 32 + fq * 8);
            xu[ks] = *(const LAS bf16x8*)(uT + (wid * 16 + fr) * 72 + ks * 32 + fq * 8);
            xk[ks] = *(const LAS bf16x8*)(kT + (wid * 16 + fr) * 72 + ks * 32 + fq * 8);
        }
#pragma unroll
        for (int ib = 0; ib < 4; ++ib) {
            const int i = ib * 16 + fr;
            const u32x2 qr = *(const LAS u32x2*)(qs + i * 136 + wid * 16 + 4 * fq);
            const float eb = __expf(bcs[i]);
            f32x4 aq = (f32x4){bflo(qr[0]) * eb, bfhi(qr[0]) * eb, bflo(qr[1]) * eb, bfhi(qr[1]) * eb};
            f32x4 ao = (f32x4){0.f, 0.f, 0.f, 0.f};
#pragma unroll
            for (int ks = 0; ks < 2; ++ks) {
                const bf16x8 ya = *(const LAS bf16x8*)(att + i * 72 + ks * 32 + fq * 8);
                aq = mfma16(xw[ks], ya, aq); ao = mfma16(xu[ks], ya, ao);
            }
            *(u32x2*)(p.lq + item * 8192 + ((ib * 8 + wid) * 64 + lane) * 4) = pack4(aq);
            *(u32x2*)(p.lo + item * 8192 + ((wid * 4 + ib) * 64 + lane) * 4) = pack4(ao);
        }
#pragma unroll
        for (int db = 0; db < 8; ++db) {
            f32x4 aa = (f32x4){0.f, 0.f, 0.f, 0.f}, ab = (f32x4){0.f, 0.f, 0.f, 0.f};
#pragma unroll
            for (int ks = 0; ks < 2; ++ks) {
                aa = mfma16(xw[ks], *(const LAS bf16x8*)(kT + (db * 16 + fr) * 72 + ks * 32 + fq * 8), aa);
                ab = mfma16(xk[ks], *(const LAS bf16x8*)(uT + (db * 16 + fr) * 72 + ks * 32 + fq * 8), ab);
            }
            *(u32x2*)(p.la + item * 16384 + ((db * 8 + wid) * 64 + lane) * 4) = pack4(aa);
            *(u32x2*)(p.lb + item * 16384 + ((wid * 8 + db) * 64 + lane) * 4) = pack4(ab);
        }
    }
    __syncthreads();
}

__device__ __forceinline__ void ph_local(const Params& p, int l, LAS unsigned char* lds) {
    for (int it = blockIdx.x; it < 3 * NITEM; it += gridDim.x) {
        const int tz = it % 3, ci = it / 3, chain = ci / NCHUNK, n = ci % NCHUNK;
        if (tz == 0) local_gdn(p, l, chain, n, lds); else if (tz == 1) local_gla(p, l, tz, chain, n, lds); else local_ret<0>(p, l, chain, n, lds);
    }
}

__device__ __forceinline__ void seq_matrix(const Params& p, int tz, int chain, int half, LAS unsigned char* lds) {
    const int tid = opaque_tid(), wid = tid >> 6, lane = tid & 63, fr = lane & 15, fq = lane >> 4;
    const int b = chain >> 3, h = (chain >> 1) & 3, d = chain & 1;
    LAS bf16_t* ST = (LAS bf16_t*)lds;
    float* Op = p.O + (size_t)((tz == 0 ? 0 : tz == 1 ? 1 : 3) * 2 + d) * TOKW;
    f32x4 S[4];
#pragma unroll
    for (int q = 0; q < 4; ++q) S[q] = (f32x4){0.f, 0.f, 0.f, 0.f};
    const int ib = wid >> 1, dv2 = (wid & 1) * 2;
    struct Ops { u32x2 yq[8], xa[8], oin[2], bin[4]; f32x4 dec; };
    auto load_ops = [&](int n, Ops& o) {
        const size_t item = (size_t)tz * NITEM + (size_t)chain * NCHUNK + n;
        const bf16_t* lqp = p.lq + item * 8192 + (size_t)(ib * 8) * 256 + lane * 4;
#pragma unroll
        for (int q = 0; q < 8; ++q) o.yq[q] = *(const u32x2*)(lqp + q * 256);
        if (tz == 0) {
            const bf16_t* lap = p.la + ((size_t)chain * NCHUNK + n) * 16384 + (size_t)(wid * 8) * 256 + lane * 4;
#pragma unroll
            for (int q = 0; q < 8; ++q) o.xa[q] = *(const u32x2*)(lap + q * 256);
        }
#pragma unroll
        for (int e2 = 0; e2 < 2; ++e2)
            o.oin[e2] = *(const u32x2*)(p.lo + item * 8192 + (((half * 4 + dv2 + (fq >> 1)) * 4 + ib) * 64 + fr + 16 * (2 * (fq & 1) + e2)) * 4);
#pragma unroll
        for (int q = 0; q < 4; ++q) o.bin[q] = *(const u32x2*)(p.lb + item * 16384 + ((wid * 8 + half * 4 + q) * 64 + lane) * 4);
        o.dec = *(const f32x4*)(p.ld + item * 128 + wid * 16 + 4 * fq);
    };
    Ops s0, s1; load_ops(0, s0);
    auto step = [&](int n, Ops& cur, Ops& fill) {
        load_ops(n + 1 < NCHUNK ? n + 1 : n, fill);
        LAS bf16_t* st = ST + (n & 1) * 64 * 136;
#pragma unroll
        for (int q = 0; q < 4; ++q) *(LAS u32x2*)(st + (q * 16 + fr) * 136 + 32 * (wid >> 1) + 8 * fq + 4 * (wid & 1)) = pack4(S[q]);
        __syncthreads();
        const int base = chunk_base(b, d, n);
        const int tok = base + (d ? 63 - (ib * 16 + fr) : ib * 16 + fr);
        {
            bf16x8 xo[2][4];
#pragma unroll
            for (int e2 = 0; e2 < 2; ++e2) {
                const int prow = dv2 * 16 + 8 * (fr >> 2) + 4 * e2 + (fr & 3);
#pragma unroll
                for (int ks = 0; ks < 4; ++ks) xo[e2][ks] = *(const LAS bf16x8*)(st + prow * 136 + ks * 32 + fq * 8);
            }
            asm volatile("s_waitcnt lgkmcnt(0)" ::: "memory");
            f32x4 ao[2];
#pragma unroll
            for (int e2 = 0; e2 < 2; ++e2) {
                f32x4 acc = (f32x4){bflo(cur.oin[e2][0]), bfhi(cur.oin[e2][0]), bflo(cur.oin[e2][1]), bfhi(cur.oin[e2][1])};
#pragma unroll
                for (int ks = 0; ks < 4; ++ks) {
                    u32x4 t; t[0] = cur.yq[2 * ks][0]; t[1] = cur.yq[2 * ks][1]; t[2] = cur.yq[2 * ks + 1][0]; t[3] = cur.yq[2 * ks + 1][1];
                    acc = mfma16(xo[e2][ks], __builtin_bit_cast(bf16x8, t), acc);
                }
                ao[e2] = acc;
            }
            float* op = Op + (size_t)tok * MW + h * 128 + half * 64 + dv2 * 16 + 8 * fq;
            *(f32x4*)op = ao[0]; *(f32x4*)(op + 4) = ao[1];
#pragma unroll
            for (int qh = 0; qh < 2; ++qh) {
                bf16x8 xs[2][4];
                if (tz == 0) {
#pragma unroll
                    for (int q2 = 0; q2 < 2; ++q2)
#pragma unroll
                        for (int ks = 0; ks < 4; ++ks) xs[q2][ks] = *(const LAS bf16x8*)(st + ((qh * 2 + q2) * 16 + fr) * 136 + ks * 32 + fq * 8);
                    asm volatile("s_waitcnt lgkmcnt(0)" ::: "memory");
                }
#pragma unroll
                for (int q2 = 0; q2 < 2; ++q2) {
                    const int q = qh * 2 + q2;
                    f32x4 acc = (f32x4){cur.dec[0] * S[q][0] + bflo(cur.bin[q][0]), cur.dec[1] * S[q][1] + bfhi(cur.bin[q][0]), cur.dec[2] * S[q][2] + bflo(cur.bin[q][1]), cur.dec[3] * S[q][3] + bfhi(cur.bin[q][1])};
                    if (tz == 0) {
#pragma unroll
                        for (int ks = 0; ks < 4; ++ks) {
                            u32x4 t; t[0] = cur.xa[2 * ks][0]; t[1] = cur.xa[2 * ks][1]; t[2] = cur.xa[2 * ks + 1][0]; t[3] = cur.xa[2 * ks + 1][1];
                            acc = mfma16(__builtin_bit_cast(bf16x8, t), xs[q2][ks], acc);
                        }
                    }
                    S[q] = acc;
                }
            }
        }
    };
    for (int n = 0; n < NCHUNK; n += 2) {
        step(n, s0, s1);
        step(n + 1, s1, s0);
    }
    __syncthreads();
}

__device__ __forceinline__ void seq_lru(const Params& p, int b, int d, int cg, LAS unsigned char* lds) {
    const int tid = opaque_tid(), seg = tid >> 6, ch = cg * 64 + (tid & 63);
    LAS float* sP = (LAS float*)lds;
    LAS float* sL = sP + 512;
    const float* A = p.prep + (size_t)(PR_LA + d) * TOKW + ch; const float* U = p.prep + (size_t)(PR_LU + d) * TOKW + ch;
    float* Op = p.O + (size_t)(2 * 2 + d) * TOKW + ch;
    constexpr int SEG = (TC + TL) / 8;
    auto tok_of = [&](int pos) { return pos < TC ? NLAT + b * TC + (d ? TC - 1 - pos : pos) : b * TL + (d ? TL - 1 - (pos - TC) : pos - TC); };
    float P = 1.f, L = 0.f;
    for (int i0 = 0; i0 < SEG; i0 += 32) {
        float av[32], uv[32];
#pragma unroll
        for (int q = 0; q < 32; ++q) { const size_t o = (size_t)tok_of(seg * SEG + i0 + q) * MW; av[q] = A[o]; uv[q] = U[o]; }
#pragma unroll
        for (int q = 0; q < 32; ++q) { L = av[q] * L + uv[q]; P *= av[q]; }
    }
    sP[tid] = P; sL[tid] = L;
    __syncthreads();
    float hst = 0.f;
    for (int s = 0; s < seg; ++s) hst = sP[s * 64 + (tid & 63)] * hst + sL[s * 64 + (tid & 63)];
    for (int i0 = 0; i0 < SEG; i0 += 32) {
        float av[32], uv[32];
#pragma unroll
        for (int q = 0; q < 32; ++q) { const size_t o = (size_t)tok_of(seg * SEG + i0 + q) * MW; av[q] = A[o]; uv[q] = U[o]; }
#pragma unroll
        for (int q = 0; q < 32; ++q) { hst = av[q] * hst + uv[q]; Op[(size_t)tok_of(seg * SEG + i0 + q) * MW] = hst; }
    }
    __syncthreads();
}

__device__ __forceinline__ void ph_seq(const Params& p, LAS unsigned char* lds) {
    for (int it = blockIdx.x; it < 256; it += gridDim.x) {
        if (it < 192) { const int tz = it >> 6, r = it & 63; seq_matrix(p, tz, r >> 1, r & 1, lds); }
        else { const int r = it - 192; seq_lru(p, r >> 4, (r >> 3) & 1, r & 7, lds); }
    }
}

__device__ __forceinline__ void ph_merge(const Params& p, int l, int M) {
    const int tid = opaque_tid(), wid = tid >> 6, lane = tid & 63;
    const float* Ob = opaque_sptr(p.O); const bf16_t* Pb = opaque_sptr(p.P); bf16_t* Yb = opaque_sptr(p.Y);
    float2 gn[3];
#pragma unroll
    for (int m = 0; m < 3; ++m) gn[m] = *(const float2*)((m == 0 ? p.gdn_norm_g : m == 1 ? p.hgrn_norm_g : p.ret_norm_g) + l * 128 + lane * 2);
    for (int tok = blockIdx.x * NWAVES + wid; tok < M; tok += gridDim.x * NWAVES) {
        f32x2 o0[16], o1[16]; unsigned gz[16];
#pragma unroll
        for (int r = 0; r < 16; ++r) {
            const int m = r >> 2, head = r & 3, cidx = head * 128 + lane * 2;
            const size_t o = (size_t)tok * MW + cidx;
            o0[r] = *(const f32x2*)(Ob + (size_t)(m * 2) * TOKW + o); o1[r] = *(const f32x2*)(Ob + (size_t)(m * 2 + 1) * TOKW + o);
            const int zc = m == 0 ? C_GZ : m == 1 ? C_HG : m == 2 ? C_LY : C_RG;
            gz[r] = *(const unsigned*)(Pb + (size_t)tok * NP + zc + cidx);
        }
        float a0[16], a1[16], ss[16];
#pragma unroll
        for (int r = 0; r < 16; ++r) { a0[r] = o0[r][0] + o1[r][0]; a1[r] = o0[r][1] + o1[r][1]; ss[r] = a0[r] * a0[r] + a1[r] * a1[r]; }
#pragma unroll
        for (int msk = 32; msk >= 1; msk >>= 1)
#pragma unroll
            for (int r = 0; r < 16; ++r) if ((r >> 2) != 2) ss[r] += shx(ss[r], msk, lane);
#pragma unroll
        for (int r = 0; r < 16; ++r) {
            const int m = r >> 2, head = r & 3, cidx = head * 128 + lane * 2;
            float y0, y1; int nbr;
            if (m == 2) { y0 = a0[r] * gelu_tanhf_(bflo(gz[r])); y1 = a1[r] * gelu_tanhf_(bfhi(gz[r])); nbr = 2; }
            else {
                const float rinv = rsqrtf(ss[r] * (1.0f / 128.0f) + 1e-6f);
                const float2 g = gn[m == 3 ? 2 : m];
                y0 = a0[r] * rinv * g.x * siluf_(bflo(gz[r])); y1 = a1[r] * rinv * g.y * siluf_(bfhi(gz[r])); nbr = m == 3 ? 3 : m;
            }
            *(unsigned*)(Yb + (size_t)nbr * TOKW + (size_t)tok * MW + cidx) = pack2(y0, y1);
        }
    }
}

struct G2Sched {
    const bf16_t* Y; const bf16_t* Wb; int ntiles, G, c;
    static constexpr bool HAS_BIAS = false, gather = false;
    __device__ __forceinline__ bool next(int i, g8::Unit& u) const {
        const int tile = (i >> 2) * G + c; if (tile >= ntiles) return false;
        u.pm = tile >> 2; u.pn = tile & 3; u.e = i & 3; return true;
    }
    __device__ __forceinline__ const char* a_base(const g8::Unit& u) const { return (const char*)(Y + (size_t)u.e * TOKW + (size_t)u.pm * 256 * MW); }
    __device__ __forceinline__ const char* b_base(const g8::Unit& u) const { return (const char*)(Wb + (size_t)u.e * D * MW + (size_t)u.pn * 256 * MW); }
    __device__ __forceinline__ const int* row_addr(const g8::Unit&, int) const { return nullptr; }
    __device__ __forceinline__ int rows_valid(const g8::Unit&) const { return 256; }
    __device__ __forceinline__ const float* bias_src(const g8::Unit&, int) const { return nullptr; }
};
struct EpiMix {
    const bf16_t* gate; bf16_t* O;
    __device__ __forceinline__ bool keep(const g8::Unit& u) const { return u.e < 3; }
    __device__ __forceinline__ void operator()(f32x4 (&acc)[2][2][4][2], const g8::Unit& u, int wr, int wc, int fr, int fq, const LAS float*) const {
        const int row0 = u.pm * 256 + wr * 64 + fr, col0 = u.pn * 256 + wc * 32 + 8 * fq;
        const bool lastseg = u.e == 3;
        const bf16_t* gc = gate + ((((size_t)u.pm * 16 + u.e * 4 + u.pn) * 8 + (wr * 4 + wc)) * 16) * 512 + (fq * 16 + fr) * 8;
        const bf16_t* gn = gc + (lastseg ? 0 : (size_t)4 * 8 * 16 * 512);
#pragma unroll
        for (int ah = 0; ah < 4; ++ah) {
            const int ai = ah >> 1;
            u32x4 c[4], x[4];
#pragma unroll
            for (int q = 0; q < 4; ++q) { c[q] = *(const u32x4*)(gc + (ah * 4 + q) * 512); x[q] = *(const u32x4*)(gn + (ah * 4 + q) * 512); }
#pragma unroll
            for (int q = 0; q < 4; ++q) {
                const int m = (ah & 1) * 2 + (q >> 1), bj = q & 1;
#pragma unroll
                for (int w = 0; w < 4; ++w) {
                    const float c0 = bflo(c[q][w]), c1 = bfhi(c[q][w]);
                    const float s0 = lastseg ? c0 : c0 * __builtin_amdgcn_rcpf(bflo(x[q][w])), s1 = lastseg ? c1 : c1 * __builtin_amdgcn_rcpf(bfhi(x[q][w]));
                    acc[ai][bj][m][w >> 1][(w & 1) * 2] *= s0; acc[ai][bj][m][w >> 1][(w & 1) * 2 + 1] *= s1;
                }
            }
        }
        if (lastseg) {
#pragma unroll
            for (int ai = 0; ai < 2; ++ai)
#pragma unroll
                for (int m = 0; m < 4; ++m)
#pragma unroll
                    for (int bj = 0; bj < 2; ++bj) {
                        u32x4 w; w[0] = pack2(acc[ai][bj][m][0][0], acc[ai][bj][m][0][1]); w[1] = pack2(acc[ai][bj][m][0][2], acc[ai][bj][m][0][3]);
                        w[2] = pack2(acc[ai][bj][m][1][0], acc[ai][bj][m][1][1]); w[3] = pack2(acc[ai][bj][m][1][2], acc[ai][bj][m][1][3]);
                        *(u32x4*)(O + (size_t)(row0 + ai * 128 + m * 16) * D + col0 + bj * 128) = w;
                    }
        }
    }
};
__device__ __forceinline__ void ph_g2(const Params& p, int l, int M, LAS unsigned char* lds) {
    G2Sched S; S.Y = p.Y; S.Wb = p.wbT + (size_t)l * 4 * D * MW; S.ntiles = (M / 256) * 4; S.G = gridDim.x; S.c = blockIdx.x;
    EpiMix E; E.gate = p.gate; E.O = p.mix;
    g8::gemm_phase(lds, MW, S, E);
}

template <bool DRY> struct EpiRes {
    float* xl; float* xo; const float* mod;
    __device__ __forceinline__ bool keep(const g8::Unit&) const { return false; }
    __device__ __forceinline__ void operator()(const f32x4 (&acc)[2][2][4][2], const g8::Unit& u, int wr, int wc, int fr, int fq, const LAS float*) const {
        const int row0 = u.pm * 256 + wr * 64 + fr, col0 = u.pn * 256 + wc * 32 + 8 * fq;
#pragma unroll
        for (int ai = 0; ai < 2; ++ai)
#pragma unroll
            for (int m = 0; m < 4; ++m) {
                const int row = row0 + ai * 128 + m * 16;
                const float* gtp = mod + (size_t)tok_modrow(row) * (NMOD * D) + 2 * D + col0;
#pragma unroll
                for (int bj = 0; bj < 2; ++bj)
#pragma unroll
                    for (int n = 0; n < 2; ++n) {
                        const float4 gt = *(const float4*)(gtp + bj * 128 + n * 4);
                        const size_t o = (size_t)row * D + col0 + bj * 128 + n * 4;
                        float4 xv = *(const float4*)(xl + o);
                        xv.x += gt.x * acc[ai][bj][m][n][0]; xv.y += gt.y * acc[ai][bj][m][n][1]; xv.z += gt.z * acc[ai][bj][m][n][2]; xv.w += gt.w * acc[ai][bj][m][n][3];
                        *(float4*)(xo + o) = xv;
                    }
            }
    }
};
template <bool DRY = false> __device__ __forceinline__ void ph_g3(const Params& p, int l, int M, LAS unsigned char* lds) {
    g8::PlainSched S; S.init(p.mix, p.woutT + (size_t)l * D * D, M, D, D);
    EpiRes<DRY> E; E.xl = p.xl; E.xo = DRY ? p.prep : p.xl; E.mod = p.mod + (size_t)(l * 5) * (NMOD * D);
    g8::gemm_phase(lds, D, S, E);
}

template <bool DRY = false> __device__ __forceinline__ void ph_route(const Params& p, int l, int M, LAS unsigned char* lds) {
    int* const r_cnt = DRY ? p.cnt + 64 : p.cnt; int* const r_list = DRY ? (int*)p.act : p.list; int* const r_ts = DRY ? (int*)p.yp : p.tokslot; float* const r_tw = DRY ? (float*)p.yp + (size_t)NTOK * 4 : p.topw;
    LAS float* fs = (LAS float*)lds;
    LAS float* lg = fs + 32 * 1028;
    LAS int* lcnt = (LAS int*)(lg + 32 * 36);
    LAS int* lbase = lcnt + 32;
    const int tid = opaque_tid(), wid = tid >> 6, lane = tid & 63;
    const float* rw = p.router_w + (size_t)l * D * NE;
    for (int it = blockIdx.x; it < M / 32; it += gridDim.x) {
        const int tok0 = it * 32;
        {
            float4 v[4][4]; float ss[4];
#pragma unroll
            for (int q = 0; q < 4; ++q) {
                const float* src = p.xl + (size_t)(tok0 + wid * 4 + q) * D;
#pragma unroll
                for (int i = 0; i < 4; ++i) v[q][i] = *(const float4*)(src + i * 256 + lane * 4);
            }
#pragma unroll
            for (int q = 0; q < 4; ++q) {
                float s = 0.f;
#pragma unroll
                for (int i = 0; i < 4; ++i) s += v[q][i].x * v[q][i].x + v[q][i].y * v[q][i].y + v[q][i].z * v[q][i].z + v[q][i].w * v[q][i].w;
                ss[q] = s;
            }
#pragma unroll
            for (int m = 32; m >= 1; m >>= 1)
#pragma unroll
                for (int q = 0; q < 4; ++q) ss[q] += shx(ss[q], m, lane);
            const float* mb = p.mod + (size_t)(l * 5 + tok_modrow(tok0)) * (NMOD * D);
#pragma unroll
            for (int i = 0; i < 4; ++i) {
                const int cidx = i * 256 + lane * 4;
                const float4 gv = *(const float4*)(p.norm2_g + l * D + cidx), sv = *(const float4*)(mb + 4 * D + cidx), hv = *(const float4*)(mb + 3 * D + cidx);
#pragma unroll
                for (int q = 0; q < 4; ++q) {
                    const int tl = wid * 4 + q, tok = tok0 + tl;
                    const float rinv = rsqrtf(ss[q] * (1.0f / D) + 1e-6f);
                    const float h0 = v[q][i].x * rinv * gv.x * (1.f + sv.x) + hv.x, h1 = v[q][i].y * rinv * gv.y * (1.f + sv.y) + hv.y;
                    const float h2 = v[q][i].z * rinv * gv.z * (1.f + sv.z) + hv.z, h3 = v[q][i].w * rinv * gv.w * (1.f + sv.w) + hv.w;
                    u32x2 o; o[0] = pack2(h0, h1); o[1] = pack2(h2, h3);
                    *(u32x2*)(p.F + (size_t)tok * D + cidx) = o;
                    *(LAS f32x4*)(fs + tl * 1028 + cidx) = (f32x4){h0, h1, h2, h3};
                }
            }
        }
        __syncthreads();
        {
            typedef float f32x16 __attribute__((ext_vector_type(16)));
            f32x16 acc;
#pragma unroll
            for (int r = 0; r < 16; ++r) acc[r] = 0.f;
            const int tk = lane & 31, hh = lane >> 5;
            const LAS float* ap = fs + tk * 1028 + wid * 128 + 4 * hh;
            const float* bp = rw + (size_t)(wid * 128 + 4 * hh) * NE + tk;
#pragma unroll 4
            for (int kk = 0; kk < 16; ++kk) {
                const f32x4 a4 = *(const LAS f32x4*)(ap + kk * 8);
                const float b0 = bp[(kk * 8 + 0) * NE], b1 = bp[(kk * 8 + 1) * NE], b2 = bp[(kk * 8 + 2) * NE], b3 = bp[(kk * 8 + 3) * NE];
                acc = __builtin_amdgcn_mfma_f32_32x32x2f32(a4[0], b0, acc, 0, 0, 0);
                acc = __builtin_amdgcn_mfma_f32_32x32x2f32(a4[1], b1, acc, 0, 0, 0);
                acc = __builtin_amdgcn_mfma_f32_32x32x2f32(a4[2], b2, acc, 0, 0, 0);
                acc = __builtin_amdgcn_mfma_f32_32x32x2f32(a4[3], b3, acc, 0, 0, 0);
            }
            __syncthreads();
            LAS float* red = fs;
#pragma unroll
            for (int r = 0; r < 16; ++r) red[(wid * 32 + (r & 3) + 8 * (r >> 2) + 4 * hh) * 33 + tk] = acc[r];
            __syncthreads();
            const int t2 = tid >> 4, e0 = (tid & 15) * 2;
            float s0 = p.router_b[l * NE + e0], s1 = p.router_b[l * NE + e0 + 1];
#pragma unroll
            for (int w = 0; w < 8; ++w) { s0 += red[(w * 32 + t2) * 33 + e0]; s1 += red[(w * 32 + t2) * 33 + e0 + 1]; }
            lg[t2 * 36 + e0] = s0; lg[t2 * 36 + e0 + 1] = s1;
            if (tid < 32) lcnt[tid] = 0;
        }
        __syncthreads();
        float vals[4]; int idxs[4], rank[4];
        if (tid < 32) {
            float lv[32];
#pragma unroll
            for (int q = 0; q < 8; ++q) { const f32x4 t = *(const LAS f32x4*)(lg + tid * 36 + q * 4); lv[q * 4] = t[0]; lv[q * 4 + 1] = t[1]; lv[q * 4 + 2] = t[2]; lv[q * 4 + 3] = t[3]; }
#pragma unroll
            for (int k = 0; k < 4; ++k) {
                float best = lv[0]; int bi = 0;
#pragma unroll
                for (int ee = 1; ee < NE; ++ee) { const bool gt = lv[ee] > best; best = gt ? lv[ee] : best; bi = gt ? ee : bi; }
#pragma unroll
                for (int ee = 0; ee < NE; ++ee) lv[ee] = (ee == bi) ? -3.0e38f : lv[ee];
                vals[k] = best; idxs[k] = bi;
                rank[k] = atomicAdd((int*)(lcnt + bi), 1);
            }
        }
        __syncthreads();
        if (tid < 32) { const int c = lcnt[tid]; lbase[tid] = c ? atomicAdd(r_cnt + l * NE + tid, c) : 0; }
        __syncthreads();
        if (tid < 32) {
            const int tok = tok0 + tid;
            const float mx = vals[0];
            float ex[4], sum = 0.f;
#pragma unroll
            for (int k = 0; k < 4; ++k) { ex[k] = __expf(vals[k] - mx); sum += ex[k]; }
            const float inv = 1.0f / sum;
#pragma unroll
            for (int k = 0; k < 4; ++k) {
                const int ee = idxs[k];
                const int slot = lbase[ee] + rank[k];
                r_list[(size_t)ee * NTOK + slot] = tok;
                r_ts[(size_t)tok * 4 + k] = (ee << 16) | slot;
                r_tw[(size_t)tok * 4 + k] = ex[k] * inv;
            }
        }
        __syncthreads();
    }
}

__device__ __forceinline__ void build_expert_tables(const Params& p, int l, LAS int* ts, LAS int* cn, LAS int* te) {
    const int tid = opaque_tid();
    if (tid < 64) {
        const int c = tid < NE ? p.cnt[l * NE + tid] : 0;
        const int nt = (c + 255) >> 8;
        int v = nt;
#pragma unroll
        for (int off = 1; off < 32; off <<= 1) { const int t = shupi(v, off, tid); if (tid >= off) v += t; }
        if (tid < NE) { cn[tid] = c; ts[tid] = v - nt; if (tid == NE - 1) ts[NE] = v; }
        if (te && tid < NE) for (int q = 0; q < nt; ++q) te[v - nt + q] = tid;
    }
    __syncthreads();
}

struct MoeSched {
    const LAS int* ts; const LAS int* cn; const LAS int* te; const int* list; const bf16_t* A; const bf16_t* Bt; const float* bias; int K, npn, nunits, G, c, nrowsB, nbias; bool gather;
    static constexpr bool HAS_BIAS = true;
    __device__ __forceinline__ bool next(int i, g8::Unit& u) const {
        const long L = (long)i * G + c; if (L >= nunits) return false;
        u.pm = (int)(L / npn); u.pn = (int)(L % npn); u.e = te[u.pm]; return true;
    }
    __device__ __forceinline__ const char* a_base(const g8::Unit& u) const { return (const char*)(gather ? A : A + (size_t)u.pm * 256 * K); }
    __device__ __forceinline__ const char* b_base(const g8::Unit& u) const { return (const char*)(Bt + ((size_t)u.e * nrowsB + (size_t)u.pn * 256) * K); }
    __device__ __forceinline__ const int* row_addr(const g8::Unit& u, int R) const {
        const int cnt = cn[u.e], sl = (u.pm - ts[u.e]) * 256 + R;
        return list + (size_t)u.e * NTOK + (sl < cnt ? sl : 0);
    }
    __device__ __forceinline__ int rows_valid(const g8::Unit& u) const { return cn[u.e] - (u.pm - ts[u.e]) * 256; }
    __device__ __forceinline__ const float* bias_src(const g8::Unit& u, int lane) const {
        if (nbias == 2) return bias + (size_t)u.e * 2 * D + (lane < 32 ? u.pn * 128 + lane * 4 : D + u.pn * 128 + (lane - 32) * 4);
        return bias + (size_t)u.e * D + u.pn * 256 + lane * 4;
    }
};
struct EpiAct {
    bf16_t* O;
    __device__ __forceinline__ bool keep(const g8::Unit&) const { return false; }
    __device__ __forceinline__ void operator()(const f32x4 (&acc)[2][2][4][2], const g8::Unit& u, int wr, int wc, int fr, int fq, const LAS float* bias) const {
        const int row0 = u.pm * 256 + wr * 64 + fr, col0 = u.pn * 128 + wc * 32 + 8 * fq;
        const LAS float* bb = bias + wc * 32 + 8 * fq;
        const f32x4 g0 = *(const LAS f32x4*)bb, g1 = *(const LAS f32x4*)(bb + 4), l0 = *(const LAS f32x4*)(bb + 128), l1 = *(const LAS f32x4*)(bb + 132);
        const float bg[8] = {g0[0], g0[1], g0[2], g0[3], g1[0], g1[1], g1[2], g1[3]}, bl[8] = {l0[0], l0[1], l0[2], l0[3], l1[0], l1[1], l1[2], l1[3]};
#pragma unroll
        for (int ai = 0; ai < 2; ++ai)
#pragma unroll
            for (int m = 0; m < 4; ++m) {
                float o[8];
#pragma unroll
                for (int n = 0; n < 2; ++n)
#pragma unroll
                    for (int j = 0; j < 4; ++j) {
                        const float glu = fminf(acc[ai][0][m][n][j] + bg[n * 4 + j], 7.0f);
                        const float lin = fminf(fmaxf(acc[ai][1][m][n][j] + bl[n * 4 + j], -7.0f), 7.0f);
                        o[n * 4 + j] = glu * sigmoidf_(1.702f * glu) * (lin + 1.0f);
                    }
                *(u32x4*)(O + (size_t)(row0 + ai * 128 + m * 16) * D + col0) = pack8(o);
            }
    }
};
__device__ __forceinline__ void ph_g4(const Params& p, int l, LAS unsigned char* lds) {
    LAS int* ts = (LAS int*)(lds + g8::STAGE_BYTES); LAS int* cn = ts + 40; LAS int* te = ts + 80;
    build_expert_tables(p, l, ts, cn, te);
    MoeSched S; S.ts = ts; S.cn = cn; S.te = te; S.list = p.list; S.A = p.F; S.Bt = p.w1T + (size_t)l * NE * 2 * D * D; S.bias = p.moe_b1 + (size_t)l * NE * 2 * D; S.nbias = 2;
    S.K = D; S.npn = 8; S.nunits = ts[NE] * 8; S.G = gridDim.x; S.c = blockIdx.x; S.nrowsB = 2 * D; S.gather = true;
    EpiAct E; E.O = p.act;
    g8::gemm_phase(lds, D, S, E);
}

struct EpiYp {
    bf16_t* O;
    __device__ __forceinline__ bool keep(const g8::Unit&) const { return false; }
    __device__ __forceinline__ void operator()(const f32x4 (&acc)[2][2][4][2], const g8::Unit& u, int wr, int wc, int fr, int fq, const LAS float* bias) const {
        const int row0 = u.pm * 256 + wr * 64 + fr, col0 = u.pn * 256 + wc * 32 + 8 * fq;
#pragma unroll
        for (int bj = 0; bj < 2; ++bj) {
            const LAS float* bb = bias + bj * 128 + wc * 32 + 8 * fq;
            const f32x4 c0v = *(const LAS f32x4*)bb, c1v = *(const LAS f32x4*)(bb + 4);
            const float4 c0 = make_float4(c0v[0], c0v[1], c0v[2], c0v[3]), c1 = make_float4(c1v[0], c1v[1], c1v[2], c1v[3]);
#pragma unroll
            for (int ai = 0; ai < 2; ++ai)
#pragma unroll
                for (int m = 0; m < 4; ++m) {
                    u32x4 w; w[0] = pack2(acc[ai][bj][m][0][0] + c0.x, acc[ai][bj][m][0][1] + c0.y); w[1] = pack2(acc[ai][bj][m][0][2] + c0.z, acc[ai][bj][m][0][3] + c0.w);
                    w[2] = pack2(acc[ai][bj][m][1][0] + c1.x, acc[ai][bj][m][1][1] + c1.y); w[3] = pack2(acc[ai][bj][m][1][2] + c1.z, acc[ai][bj][m][1][3] + c1.w);
                    *(u32x4*)(O + (size_t)(row0 + ai * 128 + m * 16) * D + col0 + bj * 128) = w;
                }
        }
    }
};
__device__ __forceinline__ void ph_g5(const Params& p, int l, LAS unsigned char* lds) {
    LAS int* ts = (LAS int*)(lds + g8::STAGE_BYTES); LAS int* cn = ts + 40; LAS int* te = ts + 80;
    build_expert_tables(p, l, ts, cn, te);
    MoeSched S; S.ts = ts; S.cn = cn; S.te = te; S.list = p.list; S.A = p.act; S.Bt = p.w2T + (size_t)l * NE * D * D; S.bias = p.moe_b2 + (size_t)l * NE * D; S.nbias = 1;
    S.K = D; S.npn = 4; S.nunits = ts[NE] * 4; S.G = gridDim.x; S.c = blockIdx.x; S.nrowsB = D; S.gather = false;
    EpiYp E; E.O = p.yp;
    g8::gemm_phase(lds, D, S, E);
}

template <bool DRY = false> __device__ __forceinline__ void ph_combine(const Params& p, int l, int M, LAS unsigned char* lds) {
    float* const c_xl = DRY ? p.prep : p.xl; bf16_t* const c_H = DRY ? (bf16_t*)(p.prep + (size_t)NTOK * D) : p.H; float* const c_out = DRY ? p.prep : p.out;
    LAS int* ts = (LAS int*)lds; LAS int* cn = ts + 40;
    build_expert_tables(p, l, ts, cn, nullptr);
    const int tid = opaque_tid(), wid = tid >> 6, lane = tid & 63;
    const bool last = (l == 1);
    for (int tok = blockIdx.x * NWAVES + wid; tok < M; tok += gridDim.x * NWAVES) {
        float4 v[4];
        const float* mb = p.mod + (size_t)(l * 5 + tok_modrow(tok)) * (NMOD * D);
        int rows[4]; float wts[4];
#pragma unroll
        for (int k = 0; k < 4; ++k) { const int tsl = p.tokslot[(size_t)tok * 4 + k]; rows[k] = ts[tsl >> 16] * 256 + (tsl & 0xffff); wts[k] = p.topw[(size_t)tok * 4 + k]; }
        float ss = 0.f;
#pragma unroll
        for (int i = 0; i < 4; ++i) {
            const int cidx = i * 256 + lane * 4;
            float m0 = 0.f, m1 = 0.f, m2 = 0.f, m3 = 0.f;
#pragma unroll
            for (int k = 0; k < 4; ++k) {
                const u32x2 u = *(const u32x2*)(p.yp + (size_t)rows[k] * D + cidx);
                m0 += wts[k] * bflo(u[0]); m1 += wts[k] * bfhi(u[0]); m2 += wts[k] * bflo(u[1]); m3 += wts[k] * bfhi(u[1]);
            }
            const float4 gt = *(const float4*)(mb + 5 * D + cidx);
            float4 xv = *(const float4*)(p.xl + (size_t)tok * D + cidx);
            xv.x += gt.x * m0; xv.y += gt.y * m1; xv.z += gt.z * m2; xv.w += gt.w * m3;
            v[i] = xv; ss += xv.x * xv.x + xv.y * xv.y + xv.z * xv.z + xv.w * xv.w;
        }
        ss = wave_sum(ss, lane);
        const float rinv = rsqrtf(ss * (1.0f / D) + 1e-6f);
        if (!last) {
#pragma unroll
            for (int i = 0; i < 4; ++i) *(float4*)(c_xl + (size_t)tok * D + i * 256 + lane * 4) = v[i];
            const float* mb1 = p.mod + (size_t)((l + 1) * 5 + tok_modrow(tok)) * (NMOD * D);
            norm_mod_store(v, rinv, p.norm1_g + (l + 1) * D, mb1 + 1 * D, mb1 + 0 * D, c_H + (size_t)tok * D, lane);
        } else {
#pragma unroll
            for (int i = 0; i < 4; ++i) {
                const int cidx = i * 256 + lane * 4;
                const float4 gv = *(const float4*)(p.final_norm_g + cidx);
                *(float4*)(c_out + (size_t)tok * D + cidx) = make_float4(v[i].x * rinv * gv.x, v[i].y * rinv * gv.y, v[i].z * rinv * gv.z, v[i].w * rinv * gv.w);
            }
        }
    }
}

#define XB_TMO      128
#define XB_XCNT(j)  (256  + 64 * (j))
#define XB_XSUB(j)  (1280 + 64 * (j))
#define XB_XGEN(j)  (2304 + 64 * (j))
#define XB_TOP      3328
#define XB_TOPGEN   3392
#define XCD_BAR_WORDS 3456
#define XB_SPIN_CAP (1u << 18)

__device__ __forceinline__ unsigned xb_ld(unsigned* p)              { return __hip_atomic_load(p, __ATOMIC_RELAXED, __HIP_MEMORY_SCOPE_AGENT); }
__device__ __forceinline__ unsigned xb_add(unsigned* p, unsigned v) { return __hip_atomic_fetch_add(p, v, __ATOMIC_RELAXED, __HIP_MEMORY_SCOPE_AGENT); }
__device__ __forceinline__ unsigned xb_xcc_id() { return (unsigned)__builtin_amdgcn_s_getreg((3 << 11) | 20) & 0xFu; }
#define XB_SPIN(cond, bar) do { unsigned _sp = 0; while (cond) { __builtin_amdgcn_s_sleep(1); \
    if ((++_sp & 255u) == 0u) { if (xb_ld(&(bar)[XB_TMO])) break; if (_sp > XB_SPIN_CAP) { atomicAdd(&(bar)[XB_TMO], 1u); break; } } } } while (0)

struct XcdBarrier {
    unsigned* bar; unsigned x;
    volatile LAS unsigned* st;
};

__device__ __forceinline__ XcdBarrier xcd_barrier_post(unsigned* bar, volatile LAS unsigned* st) {
    XcdBarrier b; b.bar = bar; b.x = xb_xcc_id(); b.st = st;
    if (threadIdx.x == 0) (void)xb_add(&bar[XB_XCNT(b.x)], 1u);
    return b;
}
__device__ __forceinline__ void xcd_barrier_complete(unsigned* bar, unsigned x, unsigned& nloc, unsigned& nx) {
    const unsigned G = gridDim.x * gridDim.y * gridDim.z;
    unsigned sum, cnt, mine, sp = 0u;
    for (;;) {
        sum = 0u; cnt = 0u; mine = 0u;
#pragma unroll
        for (unsigned j = 0; j < 16; ++j) { const unsigned c = xb_ld(&bar[XB_XCNT(j)]); sum += c; cnt += (c > 0u) ? 1u : 0u; mine = (j == x) ? c : mine; }
        if (sum == G) break;
        __builtin_amdgcn_s_sleep(1);
        if ((++sp & 255u) == 0u) { if (xb_ld(&bar[XB_TMO])) break; if (sp > XB_SPIN_CAP) { atomicAdd(&bar[XB_TMO], 1u); break; } }
    }
    nloc = mine > 0u ? mine : 1u; nx = cnt > 0u ? cnt : 1u;
}

__device__ __forceinline__ void xcd_barrier(const XcdBarrier& b) {
    asm volatile("s_waitcnt vmcnt(0)" ::: "memory");
    __syncthreads();
    if (threadIdx.x == 0) {
        unsigned* bar = b.bar;
        __builtin_amdgcn_s_waitcnt(0);
        unsigned nloc = b.st[0], nx = b.st[1];
        if (nloc == 0u) { xcd_barrier_complete(bar, b.x, nloc, nx); b.st[0] = nloc; b.st[1] = nx; }
        const unsigned old = xb_add(&bar[XB_XSUB(b.x)], 1u);
        const unsigned gen = old / nloc;
        if (old + 1u == (gen + 1u) * nloc) {
            __builtin_amdgcn_fence(__ATOMIC_RELEASE, "agent");
            asm volatile("s_waitcnt vmcnt(0)" ::: "memory");
            const unsigned og = xb_add(&bar[XB_TOP], 1u);
            const unsigned tg = og / nx;
            if (og + 1u == (tg + 1u) * nx) xb_add(&bar[XB_TOPGEN], 1u);
            else XB_SPIN(xb_ld(&bar[XB_TOPGEN]) == tg, bar);
            __builtin_amdgcn_fence(__ATOMIC_ACQUIRE, "agent");
            xb_add(&bar[XB_XGEN(b.x)], 1u);
            asm volatile("s_waitcnt vmcnt(0)" ::: "memory");
        } else {
            XB_SPIN(xb_ld(&bar[XB_XGEN(b.x)]) == gen, bar);
            __builtin_amdgcn_fence(__ATOMIC_ACQUIRE, "agent");
            asm volatile("s_waitcnt vmcnt(0)" ::: "memory");
        }
    }
    __syncthreads();
}


extern __shared__ __attribute__((aligned(16))) unsigned char dyn_lds[];
#define KPH(name, call) __global__ void __launch_bounds__(NTHREADS, 2) name(Params p, int l, int M) { LAS unsigned char* lds = (LAS unsigned char*)dyn_lds; (void)l; (void)M; (void)lds; call; }
KPH(k_convert, { ph_convert(p, lds); })
KPH(k_mod, { ph_mod(p, lds); })
KPH(k_norm1, { ph_norm1_first(p); })
KPH(k_g1, { ph_g1(p, l, lds); })
KPH(k_prep, { ph_prep(p, l, lds); })
KPH(k_local, { ph_local(p, l, lds); })
KPH(k_seq, { ph_seq(p, lds); })
KPH(k_merge, { ph_merge(p, l, M); })
KPH(k_g2, { ph_g2(p, l, M, lds); })
KPH(k_g3, { ph_g3(p, l, M, lds); })
KPH(k_route, { ph_route(p, l, M, lds); })
KPH(k_g4, { ph_g4(p, l, lds); })
KPH(k_g5, { ph_g5(p, l, lds); })
KPH(k_combine, { ph_combine(p, l, M, lds); })


typedef const __attribute__((address_space(4))) unsigned char* KArgPtr;
__device__ __forceinline__ Params load_params(KArgPtr kp) {
    asm volatile("" : "+s"(kp));
    Params q;
    const __attribute__((address_space(4))) unsigned long long* k8 = (const __attribute__((address_space(4))) unsigned long long*)kp;
    unsigned long long* d8 = (unsigned long long*)&q;
#pragma unroll
    for (int i = 0; i < (int)(sizeof(Params) / 8); ++i) d8[i] = k8[i];
    return q;
}
__global__ void __launch_bounds__(NTHREADS, 2) k_mega(Params p_unused) {
    (void)p_unused;
    const KArgPtr kp = (KArgPtr)__builtin_amdgcn_kernarg_segment_ptr();
    LAS unsigned char* lds = (LAS unsigned char*)dyn_lds;
    volatile LAS unsigned* xb_words = (volatile LAS unsigned*)(lds + LDS_BYTES - 16);
    if (threadIdx.x == 0) { xb_words[0] = 0u; xb_words[1] = 0u; xb_words[2] = 0u; xb_words[3] = 0u; }
    __syncthreads();
    { const Params p = load_params(kp); (void)xcd_barrier_post(p.bar, xb_words); }
#define GRID_BARRIER() do { XcdBarrier b_; b_.bar = load_params(kp).bar; b_.x = xb_xcc_id(); b_.st = xb_words; xcd_barrier(b_); } while (0)
#define PH(stmt) do { const Params p = load_params(kp); stmt; } while (0)
    PH(ph_convert(p, lds));
    PH(ph_mod(p, lds));
    GRID_BARRIER();
    PH(ph_norm1_first(p));
    GRID_BARRIER();
    for (int l = 0; l < 2; ++l) {
        const int M = l == 0 ? NTOK : NLAT;
        { unsigned lb_ = (unsigned)(size_t)lds; asm volatile("" : "+s"(lb_)); lds = (LAS unsigned char*)(size_t)lb_; }
        PH(ph_g1(p, l, lds));
        GRID_BARRIER();
        PH(ph_prep(p, l, lds));
        PH(ph_local(p, l, lds));
        GRID_BARRIER();
        PH(ph_seq(p, lds));
        GRID_BARRIER();
        PH(ph_merge(p, l, M));
        GRID_BARRIER();
        PH(ph_g2(p, l, M, lds));
        GRID_BARRIER();
        PH(ph_g3(p, l, M, lds));
        GRID_BARRIER();
        PH(ph_route(p, l, M, lds));
        GRID_BARRIER();
        PH(ph_g4(p, l, lds));
        GRID_BARRIER();
        PH(ph_g5(p, l, lds));
        GRID_BARRIER();
        PH(ph_combine(p, l, M, lds));
        if (l == 0) GRID_BARRIER();
    }
}

static inline size_t align_up(size_t v, size_t a) { return (v + a - 1) / a * a; }

extern "C" void kernel_launch(void* const* d_in, const int* in_sizes, int n_in, void* d_out, int out_size, void* d_ws, size_t ws_size, hipStream_t stream) {
    (void)in_sizes; (void)n_in; (void)out_size;
    Params p{};
    const float** pf = (const float**)&p;
    for (int i = 0; i < 32; ++i) pf[i] = (const float*)d_in[i];
    p.out = (float*)d_out;
    unsigned char* w = (unsigned char*)d_ws; size_t off = 0;
    auto take = [&](size_t bytes) { void* r = w + off; off = align_up(off + bytes, 256); return r; };
    p.bar = (unsigned*)take(16384);
    p.cnt = (int*)take(1024);
    const size_t ctl_bytes = off;
    p.mod = (float*)take((size_t)2 * 5 * NMOD * D * 4);
    p.winT = (bf16_t*)take((size_t)2 * NPW * D * 2);
    p.wbT = (bf16_t*)take((size_t)2 * 4 * D * MW * 2);
    p.woutT = (bf16_t*)take((size_t)2 * D * D * 2);
    p.w1T = (bf16_t*)take((size_t)2 * NE * 2 * D * D * 2);
    p.w2T = (bf16_t*)take((size_t)2 * NE * D * D * 2);
    p.xl = (float*)take((size_t)NTOK * D * 4);
    p.H = (bf16_t*)take((size_t)NTOK * D * 2);
    p.P = (bf16_t*)take((size_t)NTOK * NP * 2);
    p.gate = (bf16_t*)take((size_t)NTOK * 4096 * 2);
    p.act = p.P; p.yp = p.P + (size_t)CAPROWS * D;
    p.prep = (float*)take(NPREP * TOKW * 4);
    p.gg = (float*)take((size_t)NTOK * 8 * 4);
    p.gb = (float*)take((size_t)NTOK * 8 * 4);
    p.O = (float*)take(8 * TOKW * 4);
    p.lq = (bf16_t*)take((size_t)3 * NITEM * 64 * 128 * 2);
    p.lo = (bf16_t*)take((size_t)3 * NITEM * 64 * 128 * 2);
    p.lb = (bf16_t*)take((size_t)3 * NITEM * 128 * 128 * 2);
    p.la = (bf16_t*)take((size_t)NITEM * 128 * 128 * 2);
    p.ld = (float*)take((size_t)3 * NITEM * 128 * 4);
    p.lruT = (bf16_t*)take((size_t)2 * 8 * 4 * 4096 * 2);
    p.Y = (bf16_t*)take(4 * TOKW * 2);
    p.mix = (bf16_t*)take((size_t)NTOK * D * 2);
    p.F = p.H;
    p.list = (int*)take((size_t)NE * NTOK * 4);
    p.tokslot = (int*)take((size_t)NTOK * 4 * 4);
    p.topw = (float*)take((size_t)NTOK * 4 * 4);
    if (off > ws_size) { fprintf(stderr, "workspace too small: need %zu have %zu\n", off, ws_size); return; }

    static int grid = 0;
#if MEGA
    if (!grid) {
        int dev = 0, cus = 0, occ = 0; (void)hipGetDevice(&dev); (void)hipDeviceGetAttribute(&cus, hipDeviceAttributeMultiprocessorCount, dev);
        (void)hipFuncSetAttribute((const void*)k_mega, hipFuncAttributeMaxDynamicSharedMemorySize, LDS_BYTES);
        (void)hipOccupancyMaxActiveBlocksPerMultiprocessor(&occ, (const void*)k_mega, NTHREADS, LDS_BYTES);
        if (cus <= 0) cus = 256;
        grid = cus * (occ < 1 ? 1 : 1);
        if (occ < 1) fprintf(stderr, "occupancy query says %d blocks per CU\n", occ);
    }
    (void)hipMemsetAsync(d_ws, 0, ctl_bytes, stream);
    hipLaunchKernelGGL(k_mega, dim3(grid), dim3(NTHREADS), LDS_BYTES, stream, p);
#else
    if (!grid) {
        int dev = 0, cus = 0; (void)hipGetDevice(&dev); (void)hipDeviceGetAttribute(&cus, hipDeviceAttributeMultiprocessorCount, dev);
        grid = cus > 0 ? cus : 256;
        const void* ks[] = {(const void*)k_convert, (const void*)k_mod, (const void*)k_norm1, (const void*)k_g1, (const void*)k_prep, (const void*)k_local, (const void*)k_seq, (const void*)k_merge,
                            (const void*)k_g2, (const void*)k_g3, (const void*)k_route, (const void*)k_g4, (const void*)k_g5, (const void*)k_combine};
        for (const void* k : ks) (void)hipFuncSetAttribute(k, hipFuncAttributeMaxDynamicSharedMemorySize, LDS_BYTES);
    }
    (void)hipMemsetAsync(d_ws, 0, ctl_bytes, stream);
#define LAUNCH(k, l, M) hipLaunchKernelGGL(k, dim3(grid), dim3(NTHREADS), LDS_BYTES, stream, p, l, M)
    LAUNCH(k_convert, 0, 0);
    LAUNCH(k_mod, 0, 0);
    LAUNCH(k_norm1, 0, 0);
    for (int l = 0; l < 2; ++l) {
        const int M = l == 0 ? NTOK : NLAT;
        LAUNCH(k_g1, l, M);
        LAUNCH(k_prep, l, M);
        LAUNCH(k_local, l, M);
        LAUNCH(k_seq, l, M);
        LAUNCH(k_merge, l, M);
        LAUNCH(k_g2, l, M);
        LAUNCH(k_g3, l, M);
        LAUNCH(k_route, l, M);
        LAUNCH(k_g4, l, M);
        LAUNCH(k_g5, l, M);
        LAUNCH(k_combine, l, M);
    }
#endif
}
```

```cpp
#include <hip/hip_runtime.h>
#include <stdint.h>
#include <stdio.h>

#define LAS __attribute__((address_space(3)))
typedef unsigned short bf16_t;
typedef short bf16x8 __attribute__((ext_vector_type(8)));
typedef float f32x4 __attribute__((ext_vector_type(4)));
typedef float f32x2 __attribute__((ext_vector_type(2)));
typedef unsigned u32x2 __attribute__((ext_vector_type(2)));
typedef unsigned u32x4 __attribute__((ext_vector_type(4)));

#ifndef MEGA
#define MEGA 1
#endif
#ifndef PROBE
#define PROBE 0
#endif

constexpr int D = 1024, NB = 4, TL = 4096, TC = 256, NLAT = NB * TL, NCTX = NB * TC, NTOK = NLAT + NCTX;
constexpr int NIN = 11792, NPW = 12032, NP = 7936, MW = 512, NE = 32, TOPK = 4, NMOD = 6;
constexpr int C_GQKV = 0, C_GZ = 1536, C_HQ = 2048, C_HI = 2560, C_HF = 3072, C_HG = 4096, C_LX = 4608,
              C_LY = 5120, C_RQKV = 5632, C_RG = 7168, C_GA = 7680, C_GB = 7688, W_MG = 7936;
__host__ __device__ __forceinline__ int win_dst_row(int n) { return n < 2048 ? n : n < 2064 ? 7680 + (n - 2048) : n < 7696 ? n - 16 : 7936 + (n - 7696); }
constexpr int NTHREADS = 512, NWAVES = 8;
constexpr int LDS_BYTES = 140 * 1024;
constexpr int CAPROWS = 77824;
constexpr size_t TOKW = (size_t)NTOK * MW;
constexpr int PR_LA = 0, PR_LU = 2, NPREP = 4;
constexpr int NCHUNK = 68, NITEM = 32 * NCHUNK;

struct Params {
    const float *x, *c, *ctx, *c_ctx, *w_mod, *b_mod, *norm1_g, *norm2_g, *w_in, *gdn_conv_w, *gdn_a_log, *gdn_dt_bias, *gdn_norm_g, *hgrn_lb,
        *hgrn_norm_g, *lru_conv_w, *lru_conv_b, *lru_wa, *lru_ba, *lru_wx, *lru_bx, *lru_lambda, *ret_norm_g, *w_branch, *w_out, *router_w,
        *router_b, *moe_w1, *moe_b1, *moe_w2, *moe_b2, *final_norm_g;
    float* out;
    unsigned* bar; int* cnt; float* mod;
    bf16_t *winT, *wbT, *woutT, *w1T, *w2T;
    float* xl; bf16_t* H; bf16_t* P; float* prep; float* gg; float* gb; bf16_t* O; bf16_t* Y; bf16_t* mix; bf16_t* F;
    int* list; int* tokslot; float* topw; bf16_t* act; bf16_t* yp;
    bf16_t *lq, *lo, *lb, *la; float* ld; bf16_t* lruT; bf16_t* gate; float* lsig;
};

typedef __bf16 bf16x2_t __attribute__((ext_vector_type(2)));
__device__ __forceinline__ unsigned pack2(float a, float b) { const f32x2 v = {a, b}; return __builtin_bit_cast(unsigned, __builtin_convertvector(v, bf16x2_t)); }
__device__ __forceinline__ unsigned f2bf(float f) { return pack2(f, f) & 0xffffu; }
__device__ __forceinline__ float bf2f(bf16_t b) { return __uint_as_float(((unsigned)b) << 16); }
__device__ __forceinline__ float bflo(unsigned u) { return __uint_as_float(u << 16); }
__device__ __forceinline__ float bfhi(unsigned u) { return __uint_as_float(u & 0xffff0000u); }
__device__ __forceinline__ float sigmoidf_(float x) { return __builtin_amdgcn_rcpf(1.0f + __expf(-x)); }
__device__ __forceinline__ float siluf_(float x) { return x * sigmoidf_(x); }
__device__ __forceinline__ float softplusf_(float x) { return x > 20.f ? x : __logf(1.0f + __expf(x)); }
__device__ __forceinline__ float ret_log_gamma(int h) { return h == 0 ? -0.031748698314580f : h == 1 ? -0.015748356968139f : h == 2 ? -0.007843177461025f : -0.003913899321136f; }
__device__ __forceinline__ float logsigmoidf_(float x) { return -softplusf_(-x); }
__device__ __forceinline__ float gelu_tanhf_(float x) { const float u = 0.7978845608028654f * (x + 0.044715f * x * x * x); return 0.5f * x * (1.0f + tanhf(u)); }
__device__ __forceinline__ float shx(float v, int m, int lane) { return __int_as_float(__builtin_amdgcn_ds_bpermute((lane ^ m) << 2, __float_as_int(v))); }
__device__ __forceinline__ float shup(float v, int off, int lane) { const int s = lane >= off ? lane - off : lane; return __int_as_float(__builtin_amdgcn_ds_bpermute(s << 2, __float_as_int(v))); }
__device__ __forceinline__ int shupi(int v, int off, int lane) { const int s = lane >= off ? lane - off : lane; return __builtin_amdgcn_ds_bpermute(s << 2, v); }
__device__ __forceinline__ float wave_sum(float v, int lane) {
#pragma unroll
    for (int m = 32; m >= 1; m >>= 1) v += shx(v, m, lane);
    return v;
}
__device__ __forceinline__ int opaque_tid() { int t = threadIdx.x; asm volatile("" : "+v"(t)); return t; }
template <class T> __device__ __forceinline__ T* opaque_sptr(T* q) { asm volatile("" : "+s"(q)); return q; }
__device__ __forceinline__ int tok_modrow(int tok) { return tok < NLAT ? (tok >> 12) : 4; }
__device__ __forceinline__ void tok_info(int tok, int& t, int& T, int& base) {
    if (tok < NLAT) { t = tok & (TL - 1); T = TL; base = tok - t; }
    else { t = (tok - NLAT) & (TC - 1); T = TC; base = tok - t; }
}

__device__ __forceinline__ f32x4 mfma16(bf16x8 a, bf16x8 b, f32x4 c) { return __builtin_amdgcn_mfma_f32_16x16x32_bf16(a, b, c, 0, 0, 0); }
__device__ __forceinline__ u32x2 pack4(f32x4 v) { u32x2 o; o[0] = pack2(v[0], v[1]); o[1] = pack2(v[2], v[3]); return o; }
__device__ __forceinline__ u32x4 pack8(const float* v) { u32x4 o; o[0] = pack2(v[0], v[1]); o[1] = pack2(v[2], v[3]); o[2] = pack2(v[4], v[5]); o[3] = pack2(v[6], v[7]); return o; }

namespace gm {
constexpr int HT = 16384;
__device__ __forceinline__ int lds_byte(int r, int c) { const int st = (r >> 4) * 2 + (c >> 5), rr = r & 15, cc = c & 31, ob = rr * 64 + cc * 2; return st * 1024 + (ob ^ (((ob >> 9) & 1) << 5)); }
__device__ __forceinline__ void stage_rc(int b, int& R, int& C) { const int st = b / 1024, sb = b % 1024, swz = sb ^ (((sb >> 9) & 1) << 5); R = (st >> 1) * 16 + swz / 64; C = (st & 1) * 32 + (swz % 64) / 2; }

__device__ __forceinline__ void kloop(LAS unsigned char* lds, const bf16_t* ap00, const bf16_t* ap01, const bf16_t* ap10, const bf16_t* ap11,
                                      const bf16_t* bp0, const bf16_t* bp1, int K, f32x4 (&acc)[4][4]) {
    const int tid = opaque_tid(), wid = __builtin_amdgcn_readfirstlane(tid >> 6), lane = tid & 63, wr = wid >> 1, wc = wid & 1, fr = lane & 15, fq = lane >> 4;
    const unsigned ldsw = (unsigned)wid * 1024u;
    const int aoff = (wr >> 1) * HT + lds_byte((wr & 1) * 64 + fr, fq * 8);
    const int boff = 2 * HT + lds_byte(wc * 64 + fr, fq * 8);
    const int nt = K / 64;
#define GM_GLDS(src, dstoff) __builtin_amdgcn_global_load_lds((const unsigned*)(src), (LAS unsigned*)(lds + (dstoff)), 16, 0, 0)
#define GM_STAGE(buf, kt) do { const int _bo = (buf) * 3 * HT + ldsw; const int _ko = (kt) * 64; \
        GM_GLDS(ap00 + _ko, _bo); GM_GLDS(ap01 + _ko, _bo + 8192); GM_GLDS(ap10 + _ko, _bo + HT); GM_GLDS(ap11 + _ko, _bo + HT + 8192); \
        GM_GLDS(bp0 + _ko, _bo + 2 * HT); GM_GLDS(bp1 + _ko, _bo + 2 * HT + 8192); } while (0)
    GM_STAGE(0, 0);
    for (int t = 0; t < nt; ++t) {
        const int cur = t & 1;
        if (t + 1 < nt) { GM_STAGE(cur ^ 1, t + 1); asm volatile("s_waitcnt vmcnt(6)" ::: "memory"); }
        else asm volatile("s_waitcnt vmcnt(0)" ::: "memory");
        __builtin_amdgcn_s_barrier(); asm volatile("" ::: "memory");
        bf16x8 af[4][2], bfr[4][2];
#pragma unroll
        for (int m = 0; m < 4; ++m)
#pragma unroll
            for (int k = 0; k < 2; ++k) af[m][k] = *(const LAS bf16x8*)(lds + cur * 3 * HT + aoff + m * 2048 + k * 1024);
#pragma unroll
        for (int n = 0; n < 4; ++n)
#pragma unroll
            for (int k = 0; k < 2; ++k) bfr[n][k] = *(const LAS bf16x8*)(lds + cur * 3 * HT + boff + n * 2048 + k * 1024);
#pragma unroll
        for (int k = 0; k < 2; ++k)
#pragma unroll
            for (int m = 0; m < 4; ++m)
#pragma unroll
                for (int n = 0; n < 4; ++n) acc[m][n] = __builtin_amdgcn_mfma_f32_16x16x32_bf16(bfr[n][k], af[m][k], acc[m][n], 0, 0, 0);
        asm volatile("s_waitcnt lgkmcnt(0)" ::: "memory");
        __builtin_amdgcn_s_barrier(); asm volatile("" ::: "memory");
    }
#undef GM_STAGE
#undef GM_GLDS
}
__device__ __forceinline__ void zero_acc(f32x4 (&acc)[4][4]) {
#pragma unroll
    for (int m = 0; m < 4; ++m)
#pragma unroll
        for (int n = 0; n < 4; ++n) acc[m][n] = (f32x4){0.f, 0.f, 0.f, 0.f};
}
}

namespace g8 {
constexpr int BM = 256, BK = 64, HALF = 128, HTB = HALF * BK * 2, STAGE_BYTES = 8 * HTB;
__device__ __forceinline__ int lds_byte(int r, int c) { const int st = (r >> 4) * 2 + (c >> 5), rr = r & 15, cc = c & 31, ob = rr * 64 + cc * 2; return st * 1024 + (ob ^ (((ob >> 9) & 1) << 5)); }
__device__ __forceinline__ void stage_rc(int b, int& R, int& C) { const int st = b / 1024, sb = b % 1024, swz = sb ^ (((sb >> 9) & 1) << 5); R = (st >> 1) * 16 + swz / 64; C = (st & 1) * 32 + (swz % 64) / 2; }
__device__ __forceinline__ int perm32(int rho) { const int n = rho >> 4, i = rho & 15; return 8 * (i >> 2) + 4 * n + (i & 3); }
struct Unit { int pm, pn, e; };

template <class Epi, class Sched>
__device__ __forceinline__ void gemm_phase(LAS unsigned char* lds, const int K, const Sched& S, const Epi& E) {
    const int tid = opaque_tid(), wid = __builtin_amdgcn_readfirstlane(tid >> 6), lane = tid & 63, wr = wid >> 2, wc = wid & 3, fr = lane & 15, fq = lane >> 4;
    const int nt = K / BK;
    int R0, C0, R1, C1; stage_rc(tid * 16, R0, C0); stage_rc(tid * 16 + 8192, R1, C1);
    unsigned voffB[2];
    voffB[0] = (unsigned)(((R0 & ~31) + perm32(R0 & 31)) * K + C0) * 2u; voffB[1] = (unsigned)(((R1 & ~31) + perm32(R1 & 31)) * K + C1) * 2u;
    const unsigned cb0 = (unsigned)C0 * 2u, cb1 = (unsigned)C1 * 2u;
    const size_t kstep = (size_t)(BK * 2);
    const size_t hstepB = (size_t)HALF * K * 2;
    const unsigned ldsw = (unsigned)wid * 1024u;
    const int aoff = lds_byte(wr * 64 + fr, fq * 8), boff = lds_byte(wc * 32 + fr, fq * 8);
#define G8_SA(b, h) (((b) * 2 + (h)) * HTB)
#define G8_SB(b, h) ((4 + (b) * 2 + (h)) * HTB)
#define G8_GL(src, dstoff) __builtin_amdgcn_global_load_lds((const unsigned*)(src), (LAS unsigned*)(lds + (dstoff)), 16, 0, 0)
#define G8_STAGE_A(bufoff, gbase, vo, h) do { G8_GL((const char*)(gbase) + (vo)[2 * (h)], (bufoff) + ldsw); G8_GL((const char*)(gbase) + (vo)[2 * (h) + 1], (bufoff) + ldsw + 8192); } while (0)
#define G8_STAGE_B(bufoff, gbase) do { G8_GL((const char*)(gbase) + voffB[0], (bufoff) + ldsw); G8_GL((const char*)(gbase) + voffB[1], (bufoff) + ldsw + 8192); } while (0)
#define G8_LDA(dst, b, h) do { _Pragma("unroll") for (int m = 0; m < 4; ++m) _Pragma("unroll") for (int k = 0; k < 2; ++k) dst[m][k] = *(const LAS bf16x8*)(lds + G8_SA(b, h) + aoff + m * 2048 + k * 1024); } while (0)
#define G8_LDB(dst, b, h) do { _Pragma("unroll") for (int n = 0; n < 2; ++n) _Pragma("unroll") for (int k = 0; k < 2; ++k) dst[n][k] = *(const LAS bf16x8*)(lds + G8_SB(b, h) + boff + n * 2048 + k * 1024); } while (0)
#define G8_MMA(ai, bj, At, Bt) do { __builtin_amdgcn_s_setprio(1); _Pragma("unroll") for (int m = 0; m < 4; ++m) _Pragma("unroll") for (int n = 0; n < 2; ++n) _Pragma("unroll") for (int k = 0; k < 2; ++k) \
        acc[ai][bj][m][n] = __builtin_amdgcn_mfma_f32_16x16x32_bf16(Bt[n][k], At[m][k], acc[ai][bj][m][n], 0, 0, 0); __builtin_amdgcn_s_setprio(0); } while (0)
#define G8_WAIT_V(n) asm volatile("s_waitcnt vmcnt(" #n ")" ::: "memory")
#define G8_WAIT_L(n) asm volatile("s_waitcnt lgkmcnt(" #n ")" ::: "memory")
#define G8_BAR __builtin_amdgcn_s_barrier()
#define G8_SCHED __builtin_amdgcn_sched_barrier(0)
    Unit cur, nxt; int ui = 0;
    if (!S.next(0, cur)) return;
    LAS float* biasbuf = (LAS float*)(lds + STAGE_BYTES + 2048);
    LAS int* rowbuf = (LAS int*)(lds + STAGE_BYTES + 4096);
    f32x4 acc[2][2][4][2];
#pragma unroll
    for (int a = 0; a < 2; ++a)
#pragma unroll
        for (int b = 0; b < 2; ++b)
#pragma unroll
            for (int m = 0; m < 4; ++m)
#pragma unroll
                for (int n = 0; n < 2; ++n) acc[a][b][m][n] = (f32x4){0.f, 0.f, 0.f, 0.f};
    bf16x8 At[4][2], B0[2][2], B1[2][2];
    unsigned vA[4];
    {
        unsigned rows[4] = {(unsigned)R0, (unsigned)R1, (unsigned)(HALF + R0), (unsigned)(HALF + R1)};
        if (S.gather) { rows[0] = (unsigned)*S.row_addr(cur, R0); rows[1] = (unsigned)*S.row_addr(cur, R1); rows[2] = (unsigned)*S.row_addr(cur, HALF + R0); rows[3] = (unsigned)*S.row_addr(cur, HALF + R1); }
        vA[0] = rows[0] * (unsigned)(K * 2) + cb0; vA[1] = rows[1] * (unsigned)(K * 2) + cb1; vA[2] = rows[2] * (unsigned)(K * 2) + cb0; vA[3] = rows[3] * (unsigned)(K * 2) + cb1;
    }
    const char* cA = S.a_base(cur); const char* cB = S.b_base(cur);
    G8_STAGE_B(G8_SB(0, 0), cB); G8_STAGE_A(G8_SA(0, 0), cA, vA, 0); G8_STAGE_B(G8_SB(0, 1), cB + hstepB); G8_STAGE_A(G8_SA(0, 1), cA, vA, 1);
    if (wr == 1) G8_BAR;
    G8_WAIT_V(4); G8_BAR;
    G8_STAGE_B(G8_SB(1, 0), cB + kstep); G8_STAGE_A(G8_SA(1, 0), cA + kstep, vA, 0); G8_STAGE_B(G8_SB(1, 1), cB + hstepB + kstep);
    G8_WAIT_V(6); G8_BAR;
    for (;;) {
        const bool has_next = S.next(ui + 1, nxt);
        const char* nA = has_next ? S.a_base(nxt) : cA; const char* nB = has_next ? S.b_base(nxt) : cB;
        const int nvalid = (S.gather && has_next) ? S.rows_valid(nxt) : 0;
        if (wid == 0) {
            if (Sched::HAS_BIAS) G8_GL(S.bias_src(cur, lane), STAGE_BYTES + 2048 + (ui & 1) * 1024);
            if (S.gather && has_next) G8_GL(S.row_addr(nxt, 0) + lane * 4, STAGE_BYTES + 4096 + ((ui + 1) & 1) * 1024);
        }
        for (int t = 0; t < nt; t += 2) {
            const bool last = (t == nt - 2);
            const char* a1 = cA + (size_t)(t + 1) * kstep;
            const char* a2 = last ? nA : cA + (size_t)(t + 2) * kstep; const char* b2 = last ? nB : cB + (size_t)(t + 2) * kstep;
            const char* a3 = a2 + kstep; const char* b3 = b2 + kstep;
            G8_LDB(B0, 0, 0); G8_SCHED; G8_LDA(At, 0, 0); G8_STAGE_A(G8_SA(1, 1), a1, vA, 1);
            if (last && S.gather && has_next) {
                const LAS int* rb = rowbuf + ((ui + 1) & 1) * 256;
                const unsigned r0 = R0 < nvalid ? (unsigned)rb[R0] : 0u, r1 = R1 < nvalid ? (unsigned)rb[R1] : 0u;
                const unsigned r2 = HALF + R0 < nvalid ? (unsigned)rb[HALF + R0] : 0u, r3 = HALF + R1 < nvalid ? (unsigned)rb[HALF + R1] : 0u;
                vA[0] = r0 * (unsigned)(K * 2) + cb0; vA[1] = r1 * (unsigned)(K * 2) + cb1; vA[2] = r2 * (unsigned)(K * 2) + cb0; vA[3] = r3 * (unsigned)(K * 2) + cb1;
            }
            G8_WAIT_L(8); G8_BAR; G8_WAIT_L(0); G8_MMA(0, 0, At, B0); G8_BAR; G8_SCHED;
            G8_LDB(B1, 0, 1); G8_STAGE_B(G8_SB(0, 0), b2);
            G8_BAR; G8_WAIT_L(0); G8_MMA(0, 1, At, B1); G8_BAR;
            G8_LDA(At, 0, 1); G8_STAGE_A(G8_SA(0, 0), a2, vA, 0);
            G8_BAR; G8_WAIT_L(0); G8_MMA(1, 0, At, B0); G8_BAR; G8_SCHED;
            G8_STAGE_B(G8_SB(0, 1), b2 + hstepB);
            G8_WAIT_V(6); G8_BAR; G8_MMA(1, 1, At, B1); G8_BAR;
            G8_LDB(B0, 1, 0); G8_SCHED; G8_LDA(At, 1, 0); G8_STAGE_A(G8_SA(0, 1), a2, vA, 1);
            G8_WAIT_L(8); G8_BAR; G8_WAIT_L(0); G8_MMA(0, 0, At, B0); G8_BAR; G8_SCHED;
            G8_LDB(B1, 1, 1); G8_STAGE_B(G8_SB(1, 0), b3);
            G8_BAR; G8_WAIT_L(0); G8_MMA(0, 1, At, B1); G8_BAR;
            G8_LDA(At, 1, 1); G8_STAGE_A(G8_SA(1, 0), a3, vA, 0);
            G8_BAR; G8_WAIT_L(0); G8_MMA(1, 0, At, B0); G8_BAR; G8_SCHED;
            G8_STAGE_B(G8_SB(1, 1), b3 + hstepB);
            G8_WAIT_V(6); G8_BAR; G8_MMA(1, 1, At, B1); G8_BAR;
        }
        E(acc, cur, wr, wc, fr, fq, biasbuf + (ui & 1) * 256);
        if (!has_next) break;
        if (!E.keep(cur))
#pragma unroll
        for (int a = 0; a < 2; ++a)
#pragma unroll
            for (int b = 0; b < 2; ++b)
#pragma unroll
                for (int m = 0; m < 4; ++m)
#pragma unroll
                    for (int n = 0; n < 2; ++n) acc[a][b][m][n] = (f32x4){0.f, 0.f, 0.f, 0.f};
        cur = nxt; cA = nA; cB = nB; ++ui;
    }
    G8_WAIT_V(0);
    if (wr == 0) G8_BAR;
    G8_BAR;
#undef G8_SA
#undef G8_SB
#undef G8_GL
#undef G8_STAGE_A
#undef G8_STAGE_B
#undef G8_LDA
#undef G8_LDB
#undef G8_MMA
#undef G8_WAIT_V
#undef G8_WAIT_L
#undef G8_BAR
#undef G8_SCHED
}

struct PlainSched {
    const bf16_t* A; const bf16_t* Bt; int K, nM, nN, nwg, G, c;
    __device__ __forceinline__ void init(const bf16_t* A_, const bf16_t* Bt_, int M, int N, int K_) { A = A_; Bt = Bt_; K = K_; nM = M / BM; nN = N / BM; nwg = nM * nN; G = gridDim.x; c = blockIdx.x; }
    __device__ __forceinline__ bool next(int i, Unit& u) const {
        const long L = (long)i * G + c; if (L >= nwg) return false;
        int wgid = (int)L; { const int q = nwg / 8, r = nwg % 8, xcd = wgid % 8, off = wgid / 8; wgid = (xcd < r ? xcd * (q + 1) : r * (q + 1) + (xcd - r) * q) + off; }
        const int nig = 8 * nN, gid = wgid / nig, fm = gid * 8, gsz = (nM - fm) < 8 ? (nM - fm) : 8;
        u.pm = fm + ((wgid % nig) % gsz); u.pn = (wgid % nig) / gsz; u.e = 0; return true;
    }
    __device__ __forceinline__ const char* a_base(const Unit& u) const { return (const char*)(A + (size_t)u.pm * BM * K); }
    __device__ __forceinline__ const char* b_base(const Unit& u) const { return (const char*)(Bt + (size_t)u.pn * BM * K); }
    static constexpr bool HAS_BIAS = false, gather = false;
    __device__ __forceinline__ const int* row_addr(const Unit&, int) const { return nullptr; }
    __device__ __forceinline__ int rows_valid(const Unit&) const { return 256; }
    __device__ __forceinline__ const float* bias_src(const Unit&, int) const { return nullptr; }
};
}

struct StageRC { int R0, C0, R1, C1; };
__device__ __forceinline__ StageRC my_stage_rc() { const int t = opaque_tid(); StageRC s; gm::stage_rc(t * 16, s.R0, s.C0); gm::stage_rc(t * 16 + 8192, s.R1, s.C1); return s; }

__device__ __forceinline__ int w1_dst_row(int n) { const int half = n >> 10, cc = n & 1023; return (cc >> 7) * 256 + half * 128 + (cc & 127); }

struct CvtTile { const float* src; bf16_t* dst; int ld, Nsrc, k0, n0, K, mode; };
__device__ __forceinline__ CvtTile cvt_decode(const Params& p, int it) {
    constexpr int PER_L = 2960 + 512 + 256 + 16384 + 8192;
    CvtTile t; const int l = it / PER_L; int r = it % PER_L;
    if (r < 2960) { const int nt = r % 185, kt = r / 185; t.src = p.w_in + (size_t)l * D * NIN; t.ld = NIN; t.Nsrc = NIN; t.k0 = kt * 64; t.n0 = nt * 64; t.dst = p.winT + (size_t)l * NPW * D; t.K = D; t.mode = 2; }
    else if (r < 3472) { r -= 2960; const int n = r / 128; r %= 128; const int nt = r % 16, kt = r / 16;
        t.src = p.w_branch + (size_t)(l * 4 + n) * MW * D; t.ld = D; t.Nsrc = D; t.k0 = kt * 64; t.n0 = nt * 64; t.dst = p.wbT + (size_t)(l * 4 + n) * D * MW; t.K = MW; t.mode = 0; }
    else if (r < 3728) { r -= 3472; const int nt = r % 16, kt = r / 16; t.src = p.w_out + (size_t)l * D * D; t.ld = D; t.Nsrc = D; t.k0 = kt * 64; t.n0 = nt * 64; t.dst = p.woutT + (size_t)l * D * D; t.K = D; t.mode = 0; }
    else if (r < 3728 + 16384) { r -= 3728; const int ee = r / 512; r %= 512; const int nt = r % 32, kt = r / 32;
        t.src = p.moe_w1 + (size_t)(l * NE + ee) * D * 2 * D; t.ld = 2 * D; t.Nsrc = 2 * D; t.k0 = kt * 64; t.n0 = nt * 64; t.dst = p.w1T + (size_t)(l * NE + ee) * 2 * D * D; t.K = D; t.mode = 1; }
    else { r -= 3728 + 16384; const int ee = r / 256; r %= 256; const int nt = r % 16, kt = r / 16;
        t.src = p.moe_w2 + (size_t)(l * NE + ee) * D * D; t.ld = D; t.Nsrc = D; t.k0 = kt * 64; t.n0 = nt * 64; t.dst = p.w2T + (size_t)(l * NE + ee) * D * D; t.K = D; t.mode = 0; }
    return t;
}

__device__ __forceinline__ void ph_convert(const Params& p, LAS unsigned char* lds) {
    LAS float* tile = (LAS float*)lds;
    const int tid = opaque_tid();
    for (int idx = blockIdx.x * NTHREADS + tid; idx < 2 * 8 * 4 * 4096; idx += gridDim.x * NTHREADS) {
        const int i = idx & 63, j = (idx >> 6) & 63, mat = (idx >> 12) & 3, n = (idx >> 14) & 7, ll = idx >> 17, d = mat >> 1;
        p.lruT[idx] = (bf16_t)f2bf(((mat & 1) ? p.lru_wx : p.lru_wa)[(size_t)((ll * 2 + d) * 8 + n) * 4096 + i * 64 + j]);
    }
    for (int idx = blockIdx.x * NTHREADS + tid; idx < 2 * 2 * MW; idx += gridDim.x * NTHREADS) p.lsig[idx] = 8.0f * logsigmoidf_(p.lru_lambda[idx]);
    constexpr int TOTAL = 2 * (2960 + 512 + 256 + 16384 + 8192);
    for (int idx = blockIdx.x * NTHREADS + tid; idx < 2 * 240 * (D / 8); idx += gridDim.x * NTHREADS) {
        const int ll = idx / (240 * (D / 8)), r = idx % (240 * (D / 8));
        *(u32x4*)(p.winT + ((size_t)ll * NPW + 7696) * D + (size_t)r * 8) = (u32x4){0u, 0u, 0u, 0u};
    }
    for (int g = blockIdx.x; g * 4 < TOTAL; g += gridDim.x) {
        float v[4][8];
        const int rr = tid >> 6, cc = tid & 63;
#pragma unroll
        for (int q = 0; q < 4; ++q) {
            const int it = g * 4 + q;
            const CvtTile t = cvt_decode(p, it < TOTAL ? it : TOTAL - 1);
            const int n = t.n0 + cc; const bool ok = n < t.Nsrc; const int nc = ok ? n : t.Nsrc - 1;
#pragma unroll
            for (int i = 0; i < 8; ++i) { const float x = t.src[(size_t)(t.k0 + rr + i * 8) * t.ld + nc]; v[q][i] = ok ? x : 0.f; }
        }
#pragma unroll
        for (int q = 0; q < 4; ++q)
#pragma unroll
            for (int i = 0; i < 8; ++i) tile[q * 4160 + (rr + i * 8) * 65 + cc] = v[q][i];
        __syncthreads();
#pragma unroll
        for (int q = 0; q < 4; ++q) {
            const int it = g * 4 + q;
            if (it < TOTAL) {
                const CvtTile t = cvt_decode(p, it);
                const int nl = tid >> 3, kg = tid & 7, n = t.n0 + nl;
                float w[8];
#pragma unroll
                for (int j = 0; j < 8; ++j) w[j] = tile[q * 4160 + (kg * 8 + j) * 65 + nl];
                const int drow = t.mode == 1 ? w1_dst_row(n) : t.mode == 2 ? win_dst_row(n) : n;
                if (n < t.Nsrc) *(u32x4*)(t.dst + (size_t)drow * t.K + t.k0 + kg * 8) = pack8(w);
            }
        }
        __syncthreads();
    }
}

__device__ __forceinline__ void ph_mod(const Params& p, LAS unsigned char* lds) {
    LAS float* sc = (LAS float*)lds;
    LAS float* red = sc + 5 * D;
    const int tid = opaque_tid(), wid = tid >> 6, lane = tid & 63;
    if ((int)blockIdx.x >= 192) return;
    for (int i = tid; i < 5 * D; i += NTHREADS) { const int r = i >> 10, k = i & 1023; const float v = r < 4 ? p.c[r * D + k] : p.c_ctx[k]; sc[i] = siluf_(v); }
    __syncthreads();
    for (int it = blockIdx.x; it < 192; it += gridDim.x) {
        const int l = it / 96, n0 = (it % 96) * 64;
        float acc[5] = {0.f, 0.f, 0.f, 0.f, 0.f};
        const float* wp = p.w_mod + (size_t)l * D * (NMOD * D) + n0 + lane;
        for (int k = wid * 128; k < wid * 128 + 128; ++k) {
            const float wv = wp[(size_t)k * (NMOD * D)];
#pragma unroll
            for (int r = 0; r < 5; ++r) acc[r] += sc[r * D + k] * wv;
        }
#pragma unroll
        for (int r = 0; r < 5; ++r) red[(wid * 5 + r) * 64 + lane] = acc[r];
        __syncthreads();
        if (tid < 320) { const int r = tid >> 6, cidx = tid & 63; float s = p.b_mod[l * NMOD * D + n0 + cidx];
#pragma unroll
            for (int w = 0; w < 8; ++w) s += red[(w * 5 + r) * 64 + cidx];
            p.mod[(size_t)(l * 5 + r) * (NMOD * D) + n0 + cidx] = s; }
        __syncthreads();
    }
}

__device__ __forceinline__ void norm_mod_store(const float4 (&v)[4], float rinv, const float* g, const float* scp, const float* shp, bf16_t* dst, int lane) {
#pragma unroll
    for (int i = 0; i < 4; ++i) {
        const int cidx = i * 256 + lane * 4;
        const float4 gv = *(const float4*)(g + cidx), sv = *(const float4*)(scp + cidx), hv = *(const float4*)(shp + cidx);
        const float h0 = v[i].x * rinv * gv.x * (1.f + sv.x) + hv.x, h1 = v[i].y * rinv * gv.y * (1.f + sv.y) + hv.y;
        const float h2 = v[i].z * rinv * gv.z * (1.f + sv.z) + hv.z, h3 = v[i].w * rinv * gv.w * (1.f + sv.w) + hv.w;
        u32x2 o; o[0] = pack2(h0, h1); o[1] = pack2(h2, h3);
        *(u32x2*)(dst + cidx) = o;
    }
}
__device__ __forceinline__ void ph_norm1_first(const Params& p) {
    const int tid = opaque_tid(), wid = tid >> 6, lane = tid & 63;
    for (int tok = blockIdx.x * NWAVES + wid; tok < NTOK; tok += gridDim.x * NWAVES) {
        const float* src = tok < NLAT ? p.x + (size_t)tok * D : p.ctx + (size_t)(tok - NLAT) * D;
        float4 v[4]; float ss = 0.f;
#pragma unroll
        for (int i = 0; i < 4; ++i) { v[i] = *(const float4*)(src + i * 256 + lane * 4); ss += v[i].x * v[i].x + v[i].y * v[i].y + v[i].z * v[i].z + v[i].w * v[i].w; }
        ss = wave_sum(ss, lane);
        const float rinv = rsqrtf(ss * (1.0f / D) + 1e-6f);
        const float* mb = p.mod + (size_t)(0 * 5 + tok_modrow(tok)) * (NMOD * D);
        norm_mod_store(v, rinv, p.norm1_g, mb + 1 * D, mb + 0 * D, p.H + (size_t)tok * D, lane);
#pragma unroll
        for (int i = 0; i < 4; ++i) *(float4*)(p.xl + (size_t)tok * D + i * 256 + lane * 4) = v[i];
    }
}

struct EpiP {
    bf16_t* O; bf16_t* gate;
    __device__ __forceinline__ bool keep(const g8::Unit&) const { return false; }
    __device__ __forceinline__ void operator()(const f32x4 (&acc)[2][2][4][2], const g8::Unit& u, int wr, int wc, int fr, int fq, const LAS float*) const {
        if (u.pn < 31) {
            const int row0 = u.pm * 256 + wr * 64 + fr, col0 = u.pn * 256 + wc * 32 + 8 * fq;
#pragma unroll
            for (int ai = 0; ai < 2; ++ai)
#pragma unroll
                for (int m = 0; m < 4; ++m) {
                    bf16_t* rowp = O + (size_t)(row0 + ai * 128 + m * 16) * NP + col0;
#pragma unroll
                    for (int bj = 0; bj < 2; ++bj) {
                        u32x4 w; w[0] = pack2(acc[ai][bj][m][0][0], acc[ai][bj][m][0][1]); w[1] = pack2(acc[ai][bj][m][0][2], acc[ai][bj][m][0][3]);
                        w[2] = pack2(acc[ai][bj][m][1][0], acc[ai][bj][m][1][1]); w[3] = pack2(acc[ai][bj][m][1][2], acc[ai][bj][m][1][3]);
                        *(u32x4*)(rowp + bj * 128) = w;
                    }
                }
        } else {
            const int g = u.pn - 31;
            bf16_t* gp = gate + ((((size_t)u.pm * 16 + g) * 8 + (wr * 4 + wc)) * 16) * 512 + (fq * 16 + fr) * 8;
#pragma unroll
            for (int ai = 0; ai < 2; ++ai)
#pragma unroll
                for (int m = 0; m < 4; ++m)
#pragma unroll
                    for (int bj = 0; bj < 2; ++bj) {
                        float s[8];
#pragma unroll
                        for (int n = 0; n < 2; ++n)
#pragma unroll
                            for (int j = 0; j < 4; ++j) s[n * 4 + j] = sigmoidf_(acc[ai][bj][m][n][j]);
                        *(u32x4*)(gp + (ai * 8 + m * 2 + bj) * 512) = pack8(s);
                    }
        }
    }
};
__device__ __forceinline__ void ph_g1(const Params& p, int l, LAS unsigned char* lds) {
    g8::PlainSched S; S.init(p.H, p.winT + (size_t)l * NPW * D, NTOK, NPW, D);
    EpiP E; E.O = p.P; E.gate = p.gate;
    g8::gemm_phase(lds, D, S, E);
}

__device__ __forceinline__ void ph_prep(const Params& p, int l, LAS unsigned char* lds) {
    const int tid = opaque_tid(), wid = tid >> 6, lane = tid & 63, fr = lane & 15, fq = lane >> 4;
    LAS float* xs = (LAS float*)lds;
    LAS bf16_t* xb = (LAS bf16_t*)(xs + 64 * 68);
    LAS bf16_t* wt = xb + 64 * 72;
    for (int it = blockIdx.x; it < (NTOK / 64) * 8; it += gridDim.x) {
        const int tile = it >> 3, n = it & 7, tok0 = tile * 64;
        {
            const int tl = tid & 63, cg = tid >> 6, tok = tok0 + tl;
            int t, T, base; tok_info(tok, t, T, base);
            float a[8];
            { const float4 b0 = *(const float4*)(p.lru_conv_b + l * MW + n * 64 + cg * 8), b1 = *(const float4*)(p.lru_conv_b + l * MW + n * 64 + cg * 8 + 4);
              a[0] = b0.x; a[1] = b0.y; a[2] = b0.z; a[3] = b0.w; a[4] = b1.x; a[5] = b1.y; a[6] = b1.z; a[7] = b1.w; }
#pragma unroll
            for (int j = 0; j < 4; ++j) {
                const int tt = t + j - 2;
                const float okf = (tt >= 0 && tt < T) ? 1.0f : 0.0f;
                const int ttc = tt < 0 ? 0 : (tt >= T ? T - 1 : tt);
                const u32x4 u = *(const u32x4*)(p.P + (size_t)(base + ttc) * NP + C_LX + n * 64 + cg * 8);
                const float* w = p.lru_conv_w + (size_t)(l * 4 + j) * MW + n * 64 + cg * 8;
                const float4 wa = *(const float4*)w, wb = *(const float4*)(w + 4);
                const float wv[8] = {wa.x * okf, wa.y * okf, wa.z * okf, wa.w * okf, wb.x * okf, wb.y * okf, wb.z * okf, wb.w * okf};
#pragma unroll
                for (int q = 0; q < 4; ++q) { a[2 * q] += wv[2 * q] * bflo(u[q]); a[2 * q + 1] += wv[2 * q + 1] * bfhi(u[q]); }
            }
            *(LAS f32x4*)(xs + tl * 68 + cg * 8) = (f32x4){a[0], a[1], a[2], a[3]}; *(LAS f32x4*)(xs + tl * 68 + cg * 8 + 4) = (f32x4){a[4], a[5], a[6], a[7]};
            *(LAS u32x4*)(xb + tl * 72 + cg * 8) = pack8(a);
            const bf16_t* wsrc = p.lruT + (size_t)((l * 8 + n) * 4) * 4096;
#pragma unroll
            for (int q = 0; q < 4; ++q) { const int e8 = tid + 512 * q, row = e8 >> 3, c8 = e8 & 7; *(LAS u32x4*)(wt + row * 72 + c8 * 8) = *(const u32x4*)(wsrc + (size_t)e8 * 8); }
        }
        __syncthreads();
        {
            const int jb = wid & 3, tb0 = (wid >> 2) * 2;
            bf16x8 xw[4][2];
#pragma unroll
            for (int m = 0; m < 4; ++m)
#pragma unroll
                for (int ks = 0; ks < 2; ++ks) xw[m][ks] = *(const LAS bf16x8*)(wt + (m * 64 + jb * 16 + fr) * 72 + ks * 32 + fq * 8);
            const int c0 = n * 64 + jb * 16 + 4 * fq;
            float4 bav[2], bxv[2], lsv[2];
#pragma unroll
            for (int d = 0; d < 2; ++d) {
                bav[d] = *(const float4*)(p.lru_ba + (l * 2 + d) * MW + c0); bxv[d] = *(const float4*)(p.lru_bx + (l * 2 + d) * MW + c0);
                lsv[d] = *(const float4*)(p.lsig + (l * 2 + d) * MW + c0);
            }
#pragma unroll
            for (int e = 0; e < 2; ++e) {
                const int tl = (tb0 + e) * 16 + fr, tok = tok0 + tl;
                f32x4 acc[4];
#pragma unroll
                for (int m = 0; m < 4; ++m) acc[m] = (f32x4){0.f, 0.f, 0.f, 0.f};
#pragma unroll
                for (int ks = 0; ks < 2; ++ks) {
                    const bf16x8 y = *(const LAS bf16x8*)(xb + tl * 72 + ks * 32 + fq * 8);
#pragma unroll
                    for (int m = 0; m < 4; ++m) acc[m] = mfma16(xw[m][ks], y, acc[m]);
                }
                const f32x4 xv = *(const LAS f32x4*)(xs + tl * 68 + jb * 16 + 4 * fq);
#pragma unroll
                for (int d = 0; d < 2; ++d) {
                    const float bar_[4] = {bav[d].x, bav[d].y, bav[d].z, bav[d].w}, bxr[4] = {bxv[d].x, bxv[d].y, bxv[d].z, bxv[d].w}, lsr[4] = {lsv[d].x, lsv[d].y, lsv[d].z, lsv[d].w};
                    float av[4], uv[4];
#pragma unroll
                    for (int r = 0; r < 4; ++r) {
                        const float gr = sigmoidf_(acc[d * 2][r] + bar_[r]), gi = sigmoidf_(acc[d * 2 + 1][r] + bxr[r]);
                        const float la = gr * lsr[r];
                        av[r] = __expf(la);
                        uv[r] = xv[r] * gi * __builtin_amdgcn_sqrtf(fmaxf(1.0f - __expf(2.0f * la), 1e-12f));
                    }
                    *(float4*)(p.prep + (PR_LA + d) * TOKW + (size_t)tok * MW + c0) = make_float4(av[0], av[1], av[2], av[3]);
                    *(float4*)(p.prep + (PR_LU + d) * TOKW + (size_t)tok * MW + c0) = make_float4(uv[0], uv[1], uv[2], uv[3]);
                }
            }
        }
        __syncthreads();
    }
}

__device__ __forceinline__ int chunk_base(int b, int d, int n) {
    if (n < 4) { const int blk = d ? 3 - n : n; return NLAT + b * TC + blk * 64; }
    const int m = n - 4, blk = d ? 63 - m : m; return b * TL + blk * 64;
}

__device__ __forceinline__ void local_gla(const Params& p, int l, int tz, int chain, int n, LAS unsigned char* lds) {
    const int tid = opaque_tid(), wid = tid >> 6, lane = tid & 63, fr = lane & 15, fq = lane >> 4;
    const int b = chain >> 3, h = (chain >> 1) & 3, d = chain & 1;
    const int base = chunk_base(b, d, n);
    const size_t item = (size_t)tz * NITEM + (size_t)chain * NCHUNK + n;
    LAS bf16_t* kraw = (LAS bf16_t*)lds;
    LAS bf16_t* qh = kraw + 64 * 136;
    LAS bf16_t* kh = qh + 64 * 136;
    LAS bf16_t* sc = kh + 64 * 136;
    LAS bf16_t* vT = sc + 64 * 72;
    LAS bf16_t* kT = vT + 128 * 72;
    LAS float* bc = (LAS float*)(kT + 128 * 72);
    const int vcol = tz == 1 ? C_HI : C_RQKV + 1024;
    const int ti = tid >> 3, dg = tid & 7, cA = dg * 8, cB = 64 + dg * 8;
    const int tokI = base + (d ? 63 - ti : ti);
    const bf16_t* pr = p.P + (size_t)tokI * NP;
    float qt[16];
    {
        float kv[16], lfv[16];
        if (tz == 1) {
            float lbv[16];
            {
                const float* lp0 = p.hgrn_lb + (size_t)(0 * 2 + d) * MW + h * 128; const float* lp1 = p.hgrn_lb + (size_t)(1 * 2 + d) * MW + h * 128;
                const float4 a0 = *(const float4*)(lp0 + cA), a1 = *(const float4*)(lp0 + cA + 4), a2 = *(const float4*)(lp0 + cB), a3 = *(const float4*)(lp0 + cB + 4);
                const float4 b0 = *(const float4*)(lp1 + cA), b1 = *(const float4*)(lp1 + cA + 4), b2 = *(const float4*)(lp1 + cB), b3 = *(const float4*)(lp1 + cB + 4);
                const float x0[16] = {a0.x, a0.y, a0.z, a0.w, a1.x, a1.y, a1.z, a1.w, a2.x, a2.y, a2.z, a2.w, a3.x, a3.y, a3.z, a3.w};
                const float x1[16] = {b0.x, b0.y, b0.z, b0.w, b1.x, b1.y, b1.z, b1.w, b2.x, b2.y, b2.z, b2.w, b3.x, b3.y, b3.z, b3.w};
#pragma unroll
                for (int e = 0; e < 16; ++e) lbv[e] = (l == 1) ? fminf(__builtin_amdgcn_rcpf(1.0f + __expf(x0[e] - x1[e])), 1.0f - 1e-4f) : 0.f;
            }
            const u32x4 uqa = *(const u32x4*)(pr + C_HQ + h * 128 + cA), uqb = *(const u32x4*)(pr + C_HQ + h * 128 + cB);
            const u32x4 uza = *(const u32x4*)(pr + C_HF + d * 512 + h * 128 + cA), uzb = *(const u32x4*)(pr + C_HF + d * 512 + h * 128 + cB);
#pragma unroll
            for (int e = 0; e < 16; ++e) {
                const unsigned uq = e < 8 ? uqa[(e & 7) >> 1] : uqb[(e & 7) >> 1], uz = e < 8 ? uza[(e & 7) >> 1] : uzb[(e & 7) >> 1];
                const float qraw = (e & 1) ? bfhi(uq) : bflo(uq), z = (e & 1) ? bfhi(uz) : bflo(uz);
                const float lb = lbv[e];
                const float sg = sigmoidf_(z);
                qt[e] = siluf_(qraw) * 0.08838834764831845f;
                kv[e] = (1.f - lb) * (1.f - sg);
                lfv[e] = __logf(fmaxf(lb + (1.f - lb) * sg, 1e-30f));
            }
        } else {
            const bf16_t* rp = pr + C_RQKV + h * 128;
            const u32x4 q1 = *(const u32x4*)(rp + cA), q2 = *(const u32x4*)(rp + cB), k1 = *(const u32x4*)(rp + 512 + cA), k2 = *(const u32x4*)(rp + 512 + cB);
            const float lng = ret_log_gamma(h);
            const bool lat = tokI < NLAT;
            const int t = tokI & (TL - 1);
#pragma unroll
            for (int e = 0; e < 8; ++e) {
                float a1 = (e & 1) ? bfhi(q1[e >> 1]) : bflo(q1[e >> 1]), a2 = (e & 1) ? bfhi(q2[e >> 1]) : bflo(q2[e >> 1]);
                float b1 = (e & 1) ? bfhi(k1[e >> 1]) : bflo(k1[e >> 1]), b2 = (e & 1) ? bfhi(k2[e >> 1]) : bflo(k2[e >> 1]);
                if (lat) {
                    const int pi = cA + e;
                    const float pos = (pi < 32) ? (float)(t >> 6) : (float)(t & 63);
                    const float ang = pos * exp2f(-(float)(pi & 31) * (13.287712379549449f / 32.0f));
                    float sn, cs; sincosf(ang, &sn, &cs);
                    const float n1 = a1 * cs - a2 * sn, n2 = a1 * sn + a2 * cs, m1 = b1 * cs - b2 * sn, m2 = b1 * sn + b2 * cs;
                    a1 = n1; a2 = n2; b1 = m1; b2 = m2;
                }
                qt[e] = a1; qt[8 + e] = a2; kv[e] = b1 * 0.08838834764831845f; kv[8 + e] = b2 * 0.08838834764831845f;
                lfv[e] = lng; lfv[8 + e] = lng;
            }
        }
        *(LAS u32x4*)(kraw + ti * 136 + cA) = pack8(kv); *(LAS u32x4*)(kraw + ti * 136 + cB) = pack8(kv + 8);
        *(LAS f32x4*)(bc + ti * 132 + cA) = (f32x4){lfv[0], lfv[1], lfv[2], lfv[3]}; *(LAS f32x4*)(bc + ti * 132 + cA + 4) = (f32x4){lfv[4], lfv[5], lfv[6], lfv[7]};
        *(LAS f32x4*)(bc + ti * 132 + cB) = (f32x4){lfv[8], lfv[9], lfv[10], lfv[11]}; *(LAS f32x4*)(bc + ti * 132 + cB + 4) = (f32x4){lfv[12], lfv[13], lfv[14], lfv[15]};
        const bf16_t* vp = pr + vcol + h * 128;
        const u32x4 v0 = *(const u32x4*)(vp + cA), v1 = *(const u32x4*)(vp + cB);
#pragma unroll
        for (int e = 0; e < 8; ++e) {
            vT[(cA + e) * 72 + ti] = (bf16_t)((e & 1) ? (v0[e >> 1] >> 16) : (v0[e >> 1] & 0xffffu));
            vT[(cB + e) * 72 + ti] = (bf16_t)((e & 1) ? (v1[e >> 1] >> 16) : (v1[e >> 1] & 0xffffu));
        }
    }
    __syncthreads();
    if (tid < 128) {
        float run = 0.f, lv[64];
#pragma unroll
        for (int i = 0; i < 64; ++i) lv[i] = bc[i * 132 + tid];
#pragma unroll
        for (int i = 0; i < 64; ++i) { run += lv[i]; bc[i * 132 + tid] = run; }
    }
    __syncthreads();
    {
        const int I = ti >> 4;
        float qhat[16];
#pragma unroll
        for (int e = 0; e < 16; ++e) {
            const int ch = e < 8 ? cA + e : cB + e - 8;
            const float bi = bc[ti * 132 + ch], rI = I ? bc[(16 * I - 1) * 132 + ch] : 0.f, bl = bc[63 * 132 + ch];
            qhat[e] = qt[e] * __expf(bi - rI); qt[e] = qt[e] * __expf(bi);
            kT[ch * 72 + ti] = (bf16_t)f2bf(bf2f(kraw[ti * 136 + ch]) * __expf(bl - bi));
        }
        *(LAS u32x4*)(qh + ti * 136 + cA) = pack8(qhat); *(LAS u32x4*)(qh + ti * 136 + cB) = pack8(qhat + 8);
        {
            bf16_t* lqb = p.lq + item * 8192 + (size_t)((ti >> 4) * 8) * 256 + (ti & 15) * 4;
            const u32x4 pa = pack8(qt), pb = pack8(qt + 8);
            u32x2 t0; t0[0] = pa[0]; t0[1] = pa[1]; u32x2 t1; t1[0] = pa[2]; t1[1] = pa[3]; u32x2 t2; t2[0] = pb[0]; t2[1] = pb[1]; u32x2 t3; t3[0] = pb[2]; t3[1] = pb[3];
            *(u32x2*)(lqb + (dg >> 1) * 256 + ((dg & 1) * 2 + 0) * 64) = t0; *(u32x2*)(lqb + (dg >> 1) * 256 + ((dg & 1) * 2 + 1) * 64) = t1;
            *(u32x2*)(lqb + (4 + (dg >> 1)) * 256 + ((dg & 1) * 2 + 0) * 64) = t2; *(u32x2*)(lqb + (4 + (dg >> 1)) * 256 + ((dg & 1) * 2 + 1) * 64) = t3;
        }
    }
    if (tid < 128) p.ld[item * 128 + tid] = __expf(bc[63 * 132 + tid]);
    for (int I = 0; I < 4; ++I) {
        if (ti < 16 * (I + 1)) {
            float kk[16];
#pragma unroll
            for (int e = 0; e < 16; ++e) {
                const int ch = e < 8 ? cA + e : cB + e - 8;
                const float rI = I ? bc[(16 * I - 1) * 132 + ch] : 0.f, bj = bc[ti * 132 + ch];
                kk[e] = bf2f(kraw[ti * 136 + ch]) * __expf(fminf(rI - bj, 80.f));
            }
            *(LAS u32x4*)(kh + ti * 136 + cA) = pack8(kk); *(LAS u32x4*)(kh + ti * 136 + cB) = pack8(kk + 8);
        }
        __syncthreads();
        if (wid < 4) {
            const int J = wid;
            u32x2 outv; outv[0] = 0u; outv[1] = 0u;
            if (J <= I) {
                f32x4 acc = (f32x4){0.f, 0.f, 0.f, 0.f};
#pragma unroll
                for (int ks = 0; ks < 4; ++ks)
                    acc = mfma16(*(const LAS bf16x8*)(kh + (J * 16 + fr) * 136 + ks * 32 + fq * 8), *(const LAS bf16x8*)(qh + (I * 16 + fr) * 136 + ks * 32 + fq * 8), acc);
                const int i = 16 * I + fr, j0 = 16 * J + 4 * fq;
#pragma unroll
                for (int r = 0; r < 4; ++r) if (j0 + r > i) acc[r] = 0.f;
                outv = pack4(acc);
            }
            *(LAS u32x2*)(sc + (I * 16 + fr) * 72 + J * 16 + 4 * fq) = outv;
        }
        __syncthreads();
    }
    {
        bf16x8 xv[2], xk[2];
#pragma unroll
        for (int ks = 0; ks < 2; ++ks) { xv[ks] = *(const LAS bf16x8*)(vT + (wid * 16 + fr) * 72 + ks * 32 + fq * 8); xk[ks] = *(const LAS bf16x8*)(kT + (wid * 16 + fr) * 72 + ks * 32 + fq * 8); }
#pragma unroll
        for (int ib = 0; ib < 4; ++ib) {
            f32x4 acc = (f32x4){0.f, 0.f, 0.f, 0.f};
#pragma unroll
            for (int ks = 0; ks < 2; ++ks) acc = mfma16(xv[ks], *(const LAS bf16x8*)(sc + (ib * 16 + fr) * 72 + ks * 32 + fq * 8), acc);
            *(u32x2*)(p.lo + item * 8192 + ((wid * 4 + ib) * 64 + lane) * 4) = pack4(acc);
        }
#pragma unroll
        for (int dvb = 0; dvb < 8; ++dvb) {
            f32x4 acc = (f32x4){0.f, 0.f, 0.f, 0.f};
#pragma unroll
            for (int ks = 0; ks < 2; ++ks) acc = mfma16(xk[ks], *(const LAS bf16x8*)(vT + (dvb * 16 + fr) * 72 + ks * 32 + fq * 8), acc);
            *(u32x2*)(p.lb + item * 16384 + ((wid * 8 + dvb) * 64 + lane) * 4) = pack4(acc);
        }
    }
    __syncthreads();
}


template <int MODE> __device__ __forceinline__ void local_ret(const Params& p, int l, int chain, int n, LAS unsigned char* lds) {
    const int tid = opaque_tid(), wid = tid >> 6, lane = tid & 63, fr = lane & 15, fq = lane >> 4;
    const int b = chain >> 3, h = (chain >> 1) & 3, d = chain & 1;
    const int base = chunk_base(b, d, n);
    const size_t item = (size_t)2 * NITEM + (size_t)chain * NCHUNK + n;
    LAS bf16_t* ks_ = (LAS bf16_t*)lds;
    LAS bf16_t* qs = ks_ + 64 * 136;
    LAS bf16_t* sc = qs + 64 * 136;
    LAS bf16_t* vT = sc + 64 * 72;
    LAS bf16_t* kT = vT + 128 * 72;
    const int ti = tid >> 3, dg = tid & 7, cA = dg * 8, cB = 64 + dg * 8;
    const int tokI = base + (d ? 63 - ti : ti);
    const bf16_t* pr = p.P + (size_t)tokI * NP + C_RQKV + h * 128;
    const float lng = ret_log_gamma(h);
    {
        const u32x4 q1 = *(const u32x4*)(pr + cA), q2 = *(const u32x4*)(pr + cB), k1 = *(const u32x4*)(pr + 512 + cA), k2 = *(const u32x4*)(pr + 512 + cB);
        const u32x4 v0 = *(const u32x4*)(pr + 1024 + cA), v1 = *(const u32x4*)(pr + 1024 + cB);
        const bool lat = tokI < NLAT;
        const int t = tokI & (TL - 1);
        float qv[16], kv[16];
#pragma unroll
        for (int e = 0; e < 8; ++e) {
            float a1 = (e & 1) ? bfhi(q1[e >> 1]) : bflo(q1[e >> 1]), a2 = (e & 1) ? bfhi(q2[e >> 1]) : bflo(q2[e >> 1]);
            float b1 = (e & 1) ? bfhi(k1[e >> 1]) : bflo(k1[e >> 1]), b2 = (e & 1) ? bfhi(k2[e >> 1]) : bflo(k2[e >> 1]);
            if (lat) {
                const int pi = cA + e;
                const float pos = (pi < 32) ? (float)(t >> 6) : (float)(t & 63);
                const float ang = pos * exp2f(-(float)(pi & 31) * (13.287712379549449f / 32.0f));
                float sn, cs; sincosf(ang, &sn, &cs);
                const float n1 = a1 * cs - a2 * sn, n2 = a1 * sn + a2 * cs, m1 = b1 * cs - b2 * sn, m2 = b1 * sn + b2 * cs;
                a1 = n1; a2 = n2; b1 = m1; b2 = m2;
            }
            qv[e] = a1; qv[8 + e] = a2; kv[e] = b1 * 0.08838834764831845f; kv[8 + e] = b2 * 0.08838834764831845f;
        }
        *(LAS u32x4*)(ks_ + ti * 136 + cA) = pack8(kv); *(LAS u32x4*)(ks_ + ti * 136 + cB) = pack8(kv + 8);
        *(LAS u32x4*)(qs + ti * 136 + cA) = pack8(qv); *(LAS u32x4*)(qs + ti * 136 + cB) = pack8(qv + 8);
        const float gq = __expf((float)(ti + 1) * lng), gk = __expf((float)(63 - ti) * lng);
#pragma unroll
        for (int e = 0; e < 8; ++e) {
            vT[(cA + e) * 72 + ti] = (bf16_t)((e & 1) ? (v0[e >> 1] >> 16) : (v0[e >> 1] & 0xffffu));
            vT[(cB + e) * 72 + ti] = (bf16_t)((e & 1) ? (v1[e >> 1] >> 16) : (v1[e >> 1] & 0xffffu));
            kT[(cA + e) * 72 + ti] = (bf16_t)f2bf(kv[e] * gk); kT[(cB + e) * 72 + ti] = (bf16_t)f2bf(kv[8 + e] * gk);
            qv[e] *= gq; qv[8 + e] *= gq;
        }
        {
            bf16_t* lqb = p.lq + item * 8192 + (size_t)((ti >> 4) * 8) * 256 + (ti & 15) * 4;
            const u32x4 pa = pack8(qv), pb = pack8(qv + 8);
            u32x2 t0; t0[0] = pa[0]; t0[1] = pa[1]; u32x2 t1; t1[0] = pa[2]; t1[1] = pa[3]; u32x2 t2; t2[0] = pb[0]; t2[1] = pb[1]; u32x2 t3; t3[0] = pb[2]; t3[1] = pb[3];
            *(u32x2*)(lqb + (dg >> 1) * 256 + ((dg & 1) * 2 + 0) * 64) = t0; *(u32x2*)(lqb + (dg >> 1) * 256 + ((dg & 1) * 2 + 1) * 64) = t1;
            *(u32x2*)(lqb + (4 + (dg >> 1)) * 256 + ((dg & 1) * 2 + 0) * 64) = t2; *(u32x2*)(lqb + (4 + (dg >> 1)) * 256 + ((dg & 1) * 2 + 1) * 64) = t3;
        }
    }
    if (tid < 128) p.ld[item * 128 + tid] = __expf(64.0f * lng);
    __syncthreads();
#pragma unroll
    for (int e = 0; e < 2; ++e) {
        const int f = wid * 2 + e, ib = f >> 2, jb = f & 3;
        const int i = 16 * ib + fr, j0 = 16 * jb + 4 * fq;
        f32x4 mq = (f32x4){0.f, 0.f, 0.f, 0.f};
        if (jb <= ib) {
#pragma unroll
            for (int ks = 0; ks < 4; ++ks)
                mq = mfma16(*(const LAS bf16x8*)(ks_ + (jb * 16 + fr) * 136 + ks * 32 + fq * 8), *(const LAS bf16x8*)(qs + i * 136 + ks * 32 + fq * 8), mq);
#pragma unroll
            for (int r = 0; r < 4; ++r) { const int j = j0 + r; mq[r] = (j <= i) ? mq[r] * __expf((float)(i - j) * lng) : 0.f; }
        }
        *(LAS u32x2*)(sc + i * 72 + j0) = pack4(mq);
    }
    __syncthreads();
    {
        bf16x8 xv[2], xk[2];
#pragma unroll
        for (int ks = 0; ks < 2; ++ks) { xv[ks] = *(const LAS bf16x8*)(vT + (wid * 16 + fr) * 72 + ks * 32 + fq * 8); xk[ks] = *(const LAS bf16x8*)(kT + (wid * 16 + fr) * 72 + ks * 32 + fq * 8); }
#pragma unroll
        for (int ib = 0; ib < 4; ++ib) {
            f32x4 acc = (f32x4){0.f, 0.f, 0.f, 0.f};
#pragma unroll
            for (int ks = 0; ks < 2; ++ks) acc = mfma16(xv[ks], *(const LAS bf16x8*)(sc + (ib * 16 + fr) * 72 + ks * 32 + fq * 8), acc);
            *(u32x2*)(p.lo + item * 8192 + ((wid * 4 + ib) * 64 + lane) * 4) = pack4(acc);
        }
#pragma unroll
        for (int dvb = 0; dvb < 8; ++dvb) {
            f32x4 acc = (f32x4){0.f, 0.f, 0.f, 0.f};
#pragma unroll
            for (int ks = 0; ks < 2; ++ks) acc = mfma16(xk[ks], *(const LAS bf16x8*)(vT + (dvb * 16 + fr) * 72 + ks * 32 + fq * 8), acc);
            *(u32x2*)(p.lb + item * 16384 + ((wid * 8 + dvb) * 64 + lane) * 4) = pack4(acc);
        }
    }
    __syncthreads();
}

template <int I> struct SolveRows {
    static __device__ __forceinline__ void run(float (&x)[64], const LAS float* Mf, const LAS float* rs) {
        SolveRows<I - 1>::run(x, Mf, rs);
        float r = x[I] * rs[I];
        float pa[4] = {0.f, 0.f, 0.f, 0.f};
#pragma unroll
        for (int j4 = 0; j4 < (I + 3) / 4; ++j4) {
            const f32x4 m = *(const LAS f32x4*)(Mf + I * 68 + j4 * 4);
            pa[0] += m[0] * x[j4 * 4]; pa[1] += m[1] * x[j4 * 4 + 1]; pa[2] += m[2] * x[j4 * 4 + 2]; pa[3] += m[3] * x[j4 * 4 + 3];
        }
        r -= (pa[0] + pa[1]) + (pa[2] + pa[3]);
        asm volatile("" : "+v"(r) :: "memory");
        x[I] = r;
    }
};
template <> struct SolveRows<-1> { static __device__ __forceinline__ void run(float (&)[64], const LAS float*, const LAS float*) {} };

__device__ __forceinline__ void local_gdn(const Params& p, int l, int chain, int n, LAS unsigned char* lds) {
    const int tid = opaque_tid(), wid = tid >> 6, lane = tid & 63, fr = lane & 15, fq = lane >> 4;
    const int b = chain >> 3, h = (chain >> 1) & 3, d = chain & 1;
    const int base = chunk_base(b, d, n);
    const size_t item = (size_t)chain * NCHUNK + n;
    LAS bf16_t* ks_ = (LAS bf16_t*)lds;
    LAS bf16_t* qs = ks_ + 64 * 136;
    LAS bf16_t* att = qs + 64 * 136;
    LAS bf16_t* wT = att + 64 * 72;
    LAS bf16_t* uT = wT + 128 * 72;
    LAS bf16_t* kT = uT + 128 * 72;
    LAS float* Mf = (LAS float*)(kT + 128 * 72);
    LAS float* bcs = Mf + 64 * 68;
    LAS float* bts = bcs + 64;
    LAS float* rse = bts + 64;
    LAS bf16_t* vs = (LAS bf16_t*)(rse + 64);
    const int ti = tid >> 3, d0 = (tid & 7) * 16;
    const int tokI = base + (d ? 63 - ti : ti);
    {
        int t, T, sbase; tok_info(tokI, t, T, sbase);
#pragma unroll
        for (int part = 0; part < 3; ++part) {
            float a[16];
#pragma unroll
            for (int e = 0; e < 16; ++e) a[e] = 0.f;
            const int ccol = part * 512 + h * 128 + d0;
#pragma unroll
            for (int j = 0; j < 4; ++j) {
                const int tt = t + j - 2;
                const float okf = (tt >= 0 && tt < T) ? 1.0f : 0.0f;
                const int ttc = tt < 0 ? 0 : (tt >= T ? T - 1 : tt);
                const bf16_t* xp = p.P + (size_t)(sbase + ttc) * NP + C_GQKV + ccol;
                const u32x4 x0 = *(const u32x4*)xp, x1 = *(const u32x4*)(xp + 8);
                const float* wp = p.gdn_conv_w + (size_t)(l * 4 + j) * 1536 + ccol;
#pragma unroll
                for (int q = 0; q < 4; ++q) {
                    float4 w0 = *(const float4*)(wp + q * 4);
                    w0.x *= okf; w0.y *= okf; w0.z *= okf; w0.w *= okf;
                    const unsigned ua = q < 2 ? x0[2 * q] : x1[2 * q - 4], ub = q < 2 ? x0[2 * q + 1] : x1[2 * q - 3];
                    a[q * 4] += w0.x * bflo(ua); a[q * 4 + 1] += w0.y * bfhi(ua); a[q * 4 + 2] += w0.z * bflo(ub); a[q * 4 + 3] += w0.w * bfhi(ub);
                }
            }
            float ss = 0.f;
#pragma unroll
            for (int e = 0; e < 16; ++e) { a[e] = siluf_(a[e]); ss += a[e] * a[e]; }
            if (part < 2) {
                ss += shx(ss, 1, lane); ss += shx(ss, 2, lane); ss += shx(ss, 4, lane);
                const float scl = rsqrtf(ss + 1e-6f) * (part == 0 ? 0.08838834764831845f : 1.0f);
#pragma unroll
                for (int e = 0; e < 16; ++e) a[e] *= scl;
            }
            LAS bf16_t* dstt = (part == 0 ? qs : part == 1 ? ks_ : vs) + ti * 136 + d0;
            *(LAS u32x4*)dstt = pack8(a); *(LAS u32x4*)(dstt + 8) = pack8(a + 8);
        }
    }
    if (wid == 0) {
        const int tok = base + (d ? 63 - lane : lane);
        const float av = bf2f(p.P[(size_t)tok * NP + C_GA + d * 4 + h]);
        float v = -__expf(p.gdn_a_log[l * 8 + d * 4 + h]) * softplusf_(av + p.gdn_dt_bias[l * 8 + d * 4 + h]);
#pragma unroll
        for (int off = 1; off < 64; off <<= 1) { const float t = shup(v, off, lane); if (lane >= off) v += t; }
        const float btv = sigmoidf_(bf2f(p.P[(size_t)tok * NP + C_GB + d * 4 + h]));
        bcs[lane] = v; bts[lane] = btv; rse[lane] = btv * __expf(v);
    }
    __syncthreads();
#pragma unroll
    for (int e = 0; e < 2; ++e) {
        const int f = wid * 2 + e, ib = f >> 2, jb = f & 3;
        const int i = 16 * ib + fr, j0 = 16 * jb + 4 * fq;
        f32x4 mk = (f32x4){0.f, 0.f, 0.f, 0.f}, mq = (f32x4){0.f, 0.f, 0.f, 0.f};
        if (jb <= ib) {
#pragma unroll
            for (int ks = 0; ks < 4; ++ks) {
                const bf16x8 xk = *(const LAS bf16x8*)(ks_ + (jb * 16 + fr) * 136 + ks * 32 + fq * 8);
                mk = mfma16(xk, *(const LAS bf16x8*)(ks_ + (ib * 16 + fr) * 136 + ks * 32 + fq * 8), mk);
                mq = mfma16(xk, *(const LAS bf16x8*)(qs + (ib * 16 + fr) * 136 + ks * 32 + fq * 8), mq);
            }
            const float bi = bcs[i], bti = bts[i];
#pragma unroll
            for (int r = 0; r < 4; ++r) {
                const int j = j0 + r;
                const float dec = __expf(j <= i ? bi - bcs[j] : 0.f);
                mk[r] = (j < i) ? bti * mk[r] * dec : 0.f;
                mq[r] = (j <= i) ? mq[r] * dec : 0.f;
            }
        }
        *(LAS f32x4*)(Mf + i * 68 + j0) = mk;
        *(LAS u32x2*)(att + i * 72 + j0) = pack4(mq);
    }
    __syncthreads();
    {
        const float sc_ = __expf(bcs[63] - bcs[ti]);
#pragma unroll
        for (int e = 0; e < 16; ++e) kT[(d0 + e) * 72 + ti] = (bf16_t)f2bf(bf2f(ks_[ti * 136 + d0 + e]) * sc_);
    }
    if (tid < 256) {
        const int cidx = tid & 127;
        const bool isw = tid >= 128;
        const LAS bf16_t* srcp = (isw ? ks_ : vs) + cidx;
        float x[64];
#pragma unroll
        for (int i = 0; i < 64; ++i) x[i] = bf2f(srcp[i * 136]);
        {
            unsigned mb = (unsigned)(size_t)Mf, rb = (unsigned)(size_t)(isw ? rse : bts);
            asm volatile("" : "+v"(mb), "+v"(rb));
            SolveRows<63>::run(x, (const LAS float*)(size_t)mb, (const LAS float*)(size_t)rb);
        }
        if (isw) {
#pragma unroll
            for (int i = 0; i < 64; ++i) x[i] = -x[i];
        }
        LAS bf16_t* dst = (isw ? wT : uT) + cidx * 72;
#pragma unroll
        for (int q = 0; q < 8; ++q) *(LAS u32x4*)(dst + q * 8) = pack8(x + q * 8);
    }
    if (tid < 128) p.ld[item * 128 + tid] = __expf(bcs[63]);
    __syncthreads();
    {
        const int tid = opaque_tid(), wid = tid >> 6, lane = tid & 63, fr = lane & 15, fq = lane >> 4;
        bf16x8 xw[2], xu[2], xk[2];
#pragma unroll
        for (int ks = 0; ks < 2; ++ks) {
            xw[ks] = *(const LAS bf16x8*)(wT + (wid * 16 + fr) * 72 + ks * 32 + fq * 8);
            xu[ks] = *(const LAS bf16x8*)(uT + (wid * 16 + fr) * 72 + ks * 32 + fq * 8);
            xk[ks] = *(const LAS bf16x8*)(kT + (wid * 16 + fr) * 72 + ks * 32 + fq * 8);
        }
#pragma unroll
        for (int ib = 0; ib < 4; ++ib) {
            const int i = ib * 16 + fr;
            const u32x2 qr = *(const LAS u32x2*)(qs + i * 136 + wid * 16 + 4 * fq);
            const float eb = __expf(bcs[i]);
            f32x4 aq = (f32x4){bflo(qr[0]) * eb, bfhi(qr[0]) * eb, bflo(qr[1]) * eb, bfhi(qr[1]) * eb};
            f32x4 ao = (f32x4){0.f, 0.f, 0.f, 0.f};
#pragma unroll
            for (int ks = 0; ks < 2; ++ks) {
                const bf16x8 ya = *(const LAS bf16x8*)(att + i * 72 + ks * 32 + fq * 8);
                aq = mfma16(xw[ks], ya, aq); ao = mfma16(xu[ks], ya, ao);
            }
            *(u32x2*)(p.lq + item * 8192 + ((ib * 8 + wid) * 64 + lane) * 4) = pack4(aq);
            *(u32x2*)(p.lo + item * 8192 + ((wid * 4 + ib) * 64 + lane) * 4) = pack4(ao);
        }
#pragma unroll
        for (int db = 0; db < 8; ++db) {
            f32x4 aa = (f32x4){0.f, 0.f, 0.f, 0.f}, ab = (f32x4){0.f, 0.f, 0.f, 0.f};
#pragma unroll
            for (int ks = 0; ks < 2; ++ks) {
                aa = mfma16(xw[ks], *(const LAS bf16x8*)(kT + (db * 16 + fr) * 72 + ks * 32 + fq * 8), aa);
                ab = mfma16(xk[ks], *(const LAS bf16x8*)(uT + (db * 16 + fr) * 72 + ks * 32 + fq * 8), ab);
            }
            *(u32x2*)(p.la + item * 16384 + ((db * 8 + wid) * 64 + lane) * 4) = pack4(aa);
            *(u32x2*)(p.lb + item * 16384 + ((wid * 8 + db) * 64 + lane) * 4) = pack4(ab);
        }
    }
    __syncthreads();
}

__device__ __forceinline__ void ph_local(const Params& p, int l, LAS unsigned char* lds) {
    for (int it = blockIdx.x; it < 3 * NITEM; it += gridDim.x) {
        const int tz = it % 3, ci = it / 3, chain = ci / NCHUNK, n = ci % NCHUNK;
        if (tz == 0) local_gdn(p, l, chain, n, lds); else if (tz == 1) local_gla(p, l, tz, chain, n, lds); else local_ret<0>(p, l, chain, n, lds);
    }
}

__device__ __forceinline__ void seq_matrix(const Params& p, int tz, int chain, int half, LAS unsigned char* lds) {
    const int tid = opaque_tid(), wid = tid >> 6, lane = tid & 63, fr = lane & 15, fq = lane >> 4;
    const int b = chain >> 3, h = (chain >> 1) & 3, d = chain & 1;
    LAS bf16_t* ST = (LAS bf16_t*)lds;
    bf16_t* Op = p.O + (size_t)((tz == 0 ? 0 : tz == 1 ? 1 : 3) * 2 + d) * TOKW;
    f32x4 S[4];
#pragma unroll
    for (int q = 0; q < 4; ++q) S[q] = (f32x4){0.f, 0.f, 0.f, 0.f};
    const int ib = wid >> 1, dv2 = (wid & 1) * 2;
    struct Ops { u32x2 yq[8], xa[8], oin[2], bin[4]; f32x4 dec; };
    auto load_ops = [&](int n, Ops& o) {
        const size_t item = (size_t)tz * NITEM + (size_t)chain * NCHUNK + n;
        const bf16_t* lqp = p.lq + item * 8192 + (size_t)(ib * 8) * 256 + lane * 4;
#pragma unroll
        for (int q = 0; q < 8; ++q) o.yq[q] = *(const u32x2*)(lqp + q * 256);
        if (tz == 0) {
            const bf16_t* lap = p.la + ((size_t)chain * NCHUNK + n) * 16384 + (size_t)(wid * 8) * 256 + lane * 4;
#pragma unroll
            for (int q = 0; q < 8; ++q) o.xa[q] = *(const u32x2*)(lap + q * 256);
        }
#pragma unroll
        for (int e2 = 0; e2 < 2; ++e2)
            o.oin[e2] = *(const u32x2*)(p.lo + item * 8192 + (((half * 4 + dv2 + (fq >> 1)) * 4 + ib) * 64 + fr + 16 * (2 * (fq & 1) + e2)) * 4);
#pragma unroll
        for (int q = 0; q < 4; ++q) o.bin[q] = *(const u32x2*)(p.lb + item * 16384 + ((wid * 8 + half * 4 + q) * 64 + lane) * 4);
        o.dec = *(const f32x4*)(p.ld + item * 128 + wid * 16 + 4 * fq);
    };
    Ops s0, s1; load_ops(0, s0);
    auto step = [&](int n, Ops& cur, Ops& fill) {
        load_ops(n + 1 < NCHUNK ? n + 1 : n, fill);
        LAS bf16_t* st = ST + (n & 1) * 64 * 136;
#pragma unroll
        for (int q = 0; q < 4; ++q) *(LAS u32x2*)(st + (q * 16 + fr) * 136 + 32 * (wid >> 1) + 8 * fq + 4 * (wid & 1)) = pack4(S[q]);
        __syncthreads();
        const int base = chunk_base(b, d, n);
        const int tok = base + (d ? 63 - (ib * 16 + fr) : ib * 16 + fr);
        {
            bf16x8 xo[2][4];
#pragma unroll
            for (int e2 = 0; e2 < 2; ++e2) {
                const int prow = dv2 * 16 + 8 * (fr >> 2) + 4 * e2 + (fr & 3);
#pragma unroll
                for (int ks = 0; ks < 4; ++ks) xo[e2][ks] = *(const LAS bf16x8*)(st + prow * 136 + ks * 32 + fq * 8);
            }
            asm volatile("s_waitcnt lgkmcnt(0)" ::: "memory");
            f32x4 ao[2];
#pragma unroll
            for (int e2 = 0; e2 < 2; ++e2) {
                f32x4 acc = (f32x4){bflo(cur.oin[e2][0]), bfhi(cur.oin[e2][0]), bflo(cur.oin[e2][1]), bfhi(cur.oin[e2][1])};
#pragma unroll
                for (int ks = 0; ks < 4; ++ks) {
                    u32x4 t; t[0] = cur.yq[2 * ks][0]; t[1] = cur.yq[2 * ks][1]; t[2] = cur.yq[2 * ks + 1][0]; t[3] = cur.yq[2 * ks + 1][1];
                    acc = mfma16(xo[e2][ks], __builtin_bit_cast(bf16x8, t), acc);
                }
                ao[e2] = acc;
            }
            bf16_t* op = Op + (size_t)tok * MW + h * 128 + half * 64 + dv2 * 16 + 8 * fq;
            { u32x4 w; w[0] = pack2(ao[0][0], ao[0][1]); w[1] = pack2(ao[0][2], ao[0][3]); w[2] = pack2(ao[1][0], ao[1][1]); w[3] = pack2(ao[1][2], ao[1][3]); *(u32x4*)op = w; }
#pragma unroll
            for (int qh = 0; qh < 2; ++qh) {
                bf16x8 xs[2][4];
                if (tz == 0) {
#pragma unroll
                    for (int q2 = 0; q2 < 2; ++q2)
#pragma unroll
                        for (int ks = 0; ks < 4; ++ks) xs[q2][ks] = *(const LAS bf16x8*)(st + ((qh * 2 + q2) * 16 + fr) * 136 + ks * 32 + fq * 8);
                    asm volatile("s_waitcnt lgkmcnt(0)" ::: "memory");
                }
#pragma unroll
                for (int q2 = 0; q2 < 2; ++q2) {
                    const int q = qh * 2 + q2;
                    f32x4 acc = (f32x4){cur.dec[0] * S[q][0] + bflo(cur.bin[q][0]), cur.dec[1] * S[q][1] + bfhi(cur.bin[q][0]), cur.dec[2] * S[q][2] + bflo(cur.bin[q][1]), cur.dec[3] * S[q][3] + bfhi(cur.bin[q][1])};
                    if (tz == 0) {
#pragma unroll
                        for (int ks = 0; ks < 4; ++ks) {
                            u32x4 t; t[0] = cur.xa[2 * ks][0]; t[1] = cur.xa[2 * ks][1]; t[2] = cur.xa[2 * ks + 1][0]; t[3] = cur.xa[2 * ks + 1][1];
                            acc = mfma16(__builtin_bit_cast(bf16x8, t), xs[q2][ks], acc);
                        }
                    }
                    S[q] = acc;
                }
            }
        }
    };
    for (int n = 0; n < NCHUNK; n += 2) {
        step(n, s0, s1);
        step(n + 1, s1, s0);
    }
    __syncthreads();
}

__device__ __forceinline__ void seq_lru(const Params& p, int b, int d, int cg, LAS unsigned char* lds) {
    const int tid = opaque_tid(), seg = tid >> 6, ch = cg * 64 + (tid & 63);
    LAS float* sP = (LAS float*)lds;
    LAS float* sL = sP + 512;
    const float* A = p.prep + (size_t)(PR_LA + d) * TOKW + ch; const float* U = p.prep + (size_t)(PR_LU + d) * TOKW + ch;
    bf16_t* Op = p.O + (size_t)(2 * 2 + d) * TOKW + ch;
    constexpr int SEG = (TC + TL) / 8;
    auto tok_of = [&](int pos) { return pos < TC ? NLAT + b * TC + (d ? TC - 1 - pos : pos) : b * TL + (d ? TL - 1 - (pos - TC) : pos - TC); };
    float P = 1.f, L = 0.f;
    for (int i0 = 0; i0 < SEG; i0 += 32) {
        float av[32], uv[32];
#pragma unroll
        for (int q = 0; q < 32; ++q) { const size_t o = (size_t)tok_of(seg * SEG + i0 + q) * MW; av[q] = A[o]; uv[q] = U[o]; }
#pragma unroll
        for (int q = 0; q < 32; ++q) { L = av[q] * L + uv[q]; P *= av[q]; }
    }
    sP[tid] = P; sL[tid] = L;
    __syncthreads();
    float hst = 0.f;
    for (int s = 0; s < seg; ++s) hst = sP[s * 64 + (tid & 63)] * hst + sL[s * 64 + (tid & 63)];
    for (int i0 = 0; i0 < SEG; i0 += 32) {
        float av[32], uv[32];
#pragma unroll
        for (int q = 0; q < 32; ++q) { const size_t o = (size_t)tok_of(seg * SEG + i0 + q) * MW; av[q] = A[o]; uv[q] = U[o]; }
#pragma unroll
        for (int q = 0; q < 32; ++q) { hst = av[q] * hst + uv[q]; Op[(size_t)tok_of(seg * SEG + i0 + q) * MW] = (bf16_t)f2bf(hst); }
    }
    __syncthreads();
}

__device__ __forceinline__ void ph_seq(const Params& p, LAS unsigned char* lds) {
    for (int it = blockIdx.x; it < 256; it += gridDim.x) {
        if (it < 192) { const int tz = it >> 6, r = it & 63; seq_matrix(p, tz, r >> 1, r & 1, lds); }
        else { const int r = it - 192; seq_lru(p, r >> 4, (r >> 3) & 1, r & 7, lds); }
    }
}

__device__ __forceinline__ void ph_merge(const Params& p, int l, int M) {
    const int tid = opaque_tid(), wid = tid >> 6, lane = tid & 63;
    const bf16_t* Ob = opaque_sptr(p.O); const bf16_t* Pb = opaque_sptr(p.P); bf16_t* Yb = opaque_sptr(p.Y);
    float2 gn[3];
#pragma unroll
    for (int m = 0; m < 3; ++m) gn[m] = *(const float2*)((m == 0 ? p.gdn_norm_g : m == 1 ? p.hgrn_norm_g : p.ret_norm_g) + l * 128 + lane * 2);
    for (int tok = blockIdx.x * NWAVES + wid; tok < M; tok += gridDim.x * NWAVES) {
        unsigned o0[16], o1[16], gz[16];
#pragma unroll
        for (int r = 0; r < 16; ++r) {
            const int m = r >> 2, head = r & 3, cidx = head * 128 + lane * 2;
            const size_t o = (size_t)tok * MW + cidx;
            o0[r] = *(const unsigned*)(Ob + (size_t)(m * 2) * TOKW + o); o1[r] = *(const unsigned*)(Ob + (size_t)(m * 2 + 1) * TOKW + o);
            const int zc = m == 0 ? C_GZ : m == 1 ? C_HG : m == 2 ? C_LY : C_RG;
            gz[r] = *(const unsigned*)(Pb + (size_t)tok * NP + zc + cidx);
        }
        float a0[16], a1[16], ss[16];
#pragma unroll
        for (int r = 0; r < 16; ++r) { a0[r] = bflo(o0[r]) + bflo(o1[r]); a1[r] = bfhi(o0[r]) + bfhi(o1[r]); ss[r] = a0[r] * a0[r] + a1[r] * a1[r]; }
#pragma unroll
        for (int msk = 32; msk >= 1; msk >>= 1)
#pragma unroll
            for (int r = 0; r < 16; ++r) if ((r >> 2) != 2) ss[r] += shx(ss[r], msk, lane);
#pragma unroll
        for (int r = 0; r < 16; ++r) {
            const int m = r >> 2, head = r & 3, cidx = head * 128 + lane * 2;
            float y0, y1; int nbr;
            if (m == 2) { y0 = a0[r] * gelu_tanhf_(bflo(gz[r])); y1 = a1[r] * gelu_tanhf_(bfhi(gz[r])); nbr = 2; }
            else {
                const float rinv = rsqrtf(ss[r] * (1.0f / 128.0f) + 1e-6f);
                const float2 g = gn[m == 3 ? 2 : m];
                y0 = a0[r] * rinv * g.x * siluf_(bflo(gz[r])); y1 = a1[r] * rinv * g.y * siluf_(bfhi(gz[r])); nbr = m == 3 ? 3 : m;
            }
            *(unsigned*)(Yb + (size_t)nbr * TOKW + (size_t)tok * MW + cidx) = pack2(y0, y1);
        }
    }
}

struct G2Sched {
    const bf16_t* Y; const bf16_t* Wb; int ntiles, G, c;
    static constexpr bool HAS_BIAS = false, gather = false;
    __device__ __forceinline__ bool next(int i, g8::Unit& u) const {
        const int tile = (i >> 2) * G + c; if (tile >= ntiles) return false;
        u.pm = tile >> 2; u.pn = tile & 3; u.e = i & 3; return true;
    }
    __device__ __forceinline__ const char* a_base(const g8::Unit& u) const { return (const char*)(Y + (size_t)u.e * TOKW + (size_t)u.pm * 256 * MW); }
    __device__ __forceinline__ const char* b_base(const g8::Unit& u) const { return (const char*)(Wb + (size_t)u.e * D * MW + (size_t)u.pn * 256 * MW); }
    __device__ __forceinline__ const int* row_addr(const g8::Unit&, int) const { return nullptr; }
    __device__ __forceinline__ int rows_valid(const g8::Unit&) const { return 256; }
    __device__ __forceinline__ const float* bias_src(const g8::Unit&, int) const { return nullptr; }
};
struct EpiMix {
    const bf16_t* gate; bf16_t* O;
    __device__ __forceinline__ bool keep(const g8::Unit& u) const { return u.e < 3; }
    __device__ __forceinline__ void operator()(f32x4 (&acc)[2][2][4][2], const g8::Unit& u, int wr, int wc, int fr, int fq, const LAS float*) const {
        const int row0 = u.pm * 256 + wr * 64 + fr, col0 = u.pn * 256 + wc * 32 + 8 * fq;
        const bool lastseg = u.e == 3;
        const bf16_t* gc = gate + ((((size_t)u.pm * 16 + u.e * 4 + u.pn) * 8 + (wr * 4 + wc)) * 16) * 512 + (fq * 16 + fr) * 8;
        const bf16_t* gn = gc + (lastseg ? 0 : (size_t)4 * 8 * 16 * 512);
#pragma unroll
        for (int ah = 0; ah < 4; ++ah) {
            const int ai = ah >> 1;
            u32x4 c[4], x[4];
#pragma unroll
            for (int q = 0; q < 4; ++q) { c[q] = *(const u32x4*)(gc + (ah * 4 + q) * 512); x[q] = *(const u32x4*)(gn + (ah * 4 + q) * 512); }
#pragma unroll
            for (int q = 0; q < 4; ++q) {
                const int m = (ah & 1) * 2 + (q >> 1), bj = q & 1;
#pragma unroll
                for (int w = 0; w < 4; ++w) {
                    const float c0 = bflo(c[q][w]), c1 = bfhi(c[q][w]);
                    const float s0 = lastseg ? c0 : c0 * __builtin_amdgcn_rcpf(bflo(x[q][w])), s1 = lastseg ? c1 : c1 * __builtin_amdgcn_rcpf(bfhi(x[q][w]));
                    acc[ai][bj][m][w >> 1][(w & 1) * 2] *= s0; acc[ai][bj][m][w >> 1][(w & 1) * 2 + 1] *= s1;
                }
            }
        }
        if (lastseg) {
#pragma unroll
            for (int ai = 0; ai < 2; ++ai)
#pragma unroll
                for (int m = 0; m < 4; ++m)
#pragma unroll
                    for (int bj = 0; bj < 2; ++bj) {
                        u32x4 w; w[0] = pack2(acc[ai][bj][m][0][0], acc[ai][bj][m][0][1]); w[1] = pack2(acc[ai][bj][m][0][2], acc[ai][bj][m][0][3]);
                        w[2] = pack2(acc[ai][bj][m][1][0], acc[ai][bj][m][1][1]); w[3] = pack2(acc[ai][bj][m][1][2], acc[ai][bj][m][1][3]);
                        *(u32x4*)(O + (size_t)(row0 + ai * 128 + m * 16) * D + col0 + bj * 128) = w;
                    }
        }
    }
};
__device__ __forceinline__ void ph_g2(const Params& p, int l, int M, LAS unsigned char* lds) {
    G2Sched S; S.Y = p.Y; S.Wb = p.wbT + (size_t)l * 4 * D * MW; S.ntiles = (M / 256) * 4; S.G = gridDim.x; S.c = blockIdx.x;
    EpiMix E; E.gate = p.gate; E.O = p.mix;
    g8::gemm_phase(lds, MW, S, E);
}

template <bool DRY> struct EpiRes {
    float* xl; float* xo; const float* mod;
    __device__ __forceinline__ bool keep(const g8::Unit&) const { return false; }
    __device__ __forceinline__ void operator()(const f32x4 (&acc)[2][2][4][2], const g8::Unit& u, int wr, int wc, int fr, int fq, const LAS float*) const {
        const int row0 = u.pm * 256 + wr * 64 + fr, col0 = u.pn * 256 + wc * 32 + 8 * fq;
#pragma unroll
        for (int ai = 0; ai < 2; ++ai)
#pragma unroll
            for (int m = 0; m < 4; ++m) {
                const int row = row0 + ai * 128 + m * 16;
                const float* gtp = mod + (size_t)tok_modrow(row) * (NMOD * D) + 2 * D + col0;
#pragma unroll
                for (int bj = 0; bj < 2; ++bj)
#pragma unroll
                    for (int n = 0; n < 2; ++n) {
                        const float4 gt = *(const float4*)(gtp + bj * 128 + n * 4);
                        const size_t o = (size_t)row * D + col0 + bj * 128 + n * 4;
                        float4 xv = *(const float4*)(xl + o);
                        xv.x += gt.x * acc[ai][bj][m][n][0]; xv.y += gt.y * acc[ai][bj][m][n][1]; xv.z += gt.z * acc[ai][bj][m][n][2]; xv.w += gt.w * acc[ai][bj][m][n][3];
                        *(float4*)(xo + o) = xv;
                    }
            }
    }
};
template <bool DRY = false> __device__ __forceinline__ void ph_g3(const Params& p, int l, int M, LAS unsigned char* lds) {
    g8::PlainSched S; S.init(p.mix, p.woutT + (size_t)l * D * D, M, D, D);
    EpiRes<DRY> E; E.xl = p.xl; E.xo = DRY ? p.prep : p.xl; E.mod = p.mod + (size_t)(l * 5) * (NMOD * D);
    g8::gemm_phase(lds, D, S, E);
}

template <bool DRY = false> __device__ __forceinline__ void ph_route(const Params& p, int l, int M, LAS unsigned char* lds) {
    int* const r_cnt = DRY ? p.cnt + 64 : p.cnt; int* const r_list = DRY ? (int*)p.act : p.list; int* const r_ts = DRY ? (int*)p.yp : p.tokslot; float* const r_tw = DRY ? (float*)p.yp + (size_t)NTOK * 4 : p.topw;
    LAS float* fs = (LAS float*)lds;
    LAS float* lg = fs + 32 * 1028;
    LAS int* lcnt = (LAS int*)(lg + 32 * 36);
    LAS int* lbase = lcnt + 32;
    const int tid = opaque_tid(), wid = tid >> 6, lane = tid & 63;
    const float* rw = p.router_w + (size_t)l * D * NE;
    for (int it = blockIdx.x; it < M / 32; it += gridDim.x) {
        const int tok0 = it * 32;
        {
            float4 v[4][4]; float ss[4];
#pragma unroll
            for (int q = 0; q < 4; ++q) {
                const float* src = p.xl + (size_t)(tok0 + wid * 4 + q) * D;
#pragma unroll
                for (int i = 0; i < 4; ++i) v[q][i] = *(const float4*)(src + i * 256 + lane * 4);
            }
#pragma unroll
            for (int q = 0; q < 4; ++q) {
                float s = 0.f;
#pragma unroll
                for (int i = 0; i < 4; ++i) s += v[q][i].x * v[q][i].x + v[q][i].y * v[q][i].y + v[q][i].z * v[q][i].z + v[q][i].w * v[q][i].w;
                ss[q] = s;
            }
#pragma unroll
            for (int m = 32; m >= 1; m >>= 1)
#pragma unroll
                for (int q = 0; q < 4; ++q) ss[q] += shx(ss[q], m, lane);
            const float* mb = p.mod + (size_t)(l * 5 + tok_modrow(tok0)) * (NMOD * D);
#pragma unroll
            for (int i = 0; i < 4; ++i) {
                const int cidx = i * 256 + lane * 4;
                const float4 gv = *(const float4*)(p.norm2_g + l * D + cidx), sv = *(const float4*)(mb + 4 * D + cidx), hv = *(const float4*)(mb + 3 * D + cidx);
#pragma unroll
                for (int q = 0; q < 4; ++q) {
                    const int tl = wid * 4 + q, tok = tok0 + tl;
                    const float rinv = rsqrtf(ss[q] * (1.0f / D) + 1e-6f);
                    const float h0 = v[q][i].x * rinv * gv.x * (1.f + sv.x) + hv.x, h1 = v[q][i].y * rinv * gv.y * (1.f + sv.y) + hv.y;
                    const float h2 = v[q][i].z * rinv * gv.z * (1.f + sv.z) + hv.z, h3 = v[q][i].w * rinv * gv.w * (1.f + sv.w) + hv.w;
                    u32x2 o; o[0] = pack2(h0, h1); o[1] = pack2(h2, h3);
                    *(u32x2*)(p.F + (size_t)tok * D + cidx) = o;
                    *(LAS f32x4*)(fs + tl * 1028 + cidx) = (f32x4){h0, h1, h2, h3};
                }
            }
        }
        __syncthreads();
        {
            typedef float f32x16 __attribute__((ext_vector_type(16)));
            f32x16 acc;
#pragma unroll
            for (int r = 0; r < 16; ++r) acc[r] = 0.f;
            const int tk = lane & 31, hh = lane >> 5;
            const LAS float* ap = fs + tk * 1028 + wid * 128 + 4 * hh;
            const float* bp = rw + (size_t)(wid * 128 + 4 * hh) * NE + tk;
#pragma unroll 4
            for (int kk = 0; kk < 16; ++kk) {
                const f32x4 a4 = *(const LAS f32x4*)(ap + kk * 8);
                const float b0 = bp[(kk * 8 + 0) * NE], b1 = bp[(kk * 8 + 1) * NE], b2 = bp[(kk * 8 + 2) * NE], b3 = bp[(kk * 8 + 3) * NE];
                acc = __builtin_amdgcn_mfma_f32_32x32x2f32(a4[0], b0, acc, 0, 0, 0);
                acc = __builtin_amdgcn_mfma_f32_32x32x2f32(a4[1], b1, acc, 0, 0, 0);
                acc = __builtin_amdgcn_mfma_f32_32x32x2f32(a4[2], b2, acc, 0, 0, 0);
                acc = __builtin_amdgcn_mfma_f32_32x32x2f32(a4[3], b3, acc, 0, 0, 0);
            }
            __syncthreads();
            LAS float* red = fs;
#pragma unroll
            for (int r = 0; r < 16; ++r) red[(wid * 32 + (r & 3) + 8 * (r >> 2) + 4 * hh) * 33 + tk] = acc[r];
            __syncthreads();
            const int t2 = tid >> 4, e0 = (tid & 15) * 2;
            float s0 = p.router_b[l * NE + e0], s1 = p.router_b[l * NE + e0 + 1];
#pragma unroll
            for (int w = 0; w < 8; ++w) { s0 += red[(w * 32 + t2) * 33 + e0]; s1 += red[(w * 32 + t2) * 33 + e0 + 1]; }
            lg[t2 * 36 + e0] = s0; lg[t2 * 36 + e0 + 1] = s1;
            if (tid < 32) lcnt[tid] = 0;
        }
        __syncthreads();
        float vals[4]; int idxs[4], rank[4];
        if (tid < 32) {
            float lv[32];
#pragma unroll
            for (int q = 0; q < 8; ++q) { const f32x4 t = *(const LAS f32x4*)(lg + tid * 36 + q * 4); lv[q * 4] = t[0]; lv[q * 4 + 1] = t[1]; lv[q * 4 + 2] = t[2]; lv[q * 4 + 3] = t[3]; }
#pragma unroll
            for (int k = 0; k < 4; ++k) {
                float best = lv[0]; int bi = 0;
#pragma unroll
                for (int ee = 1; ee < NE; ++ee) { const bool gt = lv[ee] > best; best = gt ? lv[ee] : best; bi = gt ? ee : bi; }
#pragma unroll
                for (int ee = 0; ee < NE; ++ee) lv[ee] = (ee == bi) ? -3.0e38f : lv[ee];
                vals[k] = best; idxs[k] = bi;
                rank[k] = atomicAdd((int*)(lcnt + bi), 1);
            }
        }
        __syncthreads();
        if (tid < 32) { const int c = lcnt[tid]; lbase[tid] = c ? atomicAdd(r_cnt + l * NE + tid, c) : 0; }
        __syncthreads();
        if (tid < 32) {
            const int tok = tok0 + tid;
            const float mx = vals[0];
            float ex[4], sum = 0.f;
#pragma unroll
            for (int k = 0; k < 4; ++k) { ex[k] = __expf(vals[k] - mx); sum += ex[k]; }
            const float inv = 1.0f / sum;
#pragma unroll
            for (int k = 0; k < 4; ++k) {
                const int ee = idxs[k];
                const int slot = lbase[ee] + rank[k];
                r_list[(size_t)ee * NTOK + slot] = tok;
                r_ts[(size_t)tok * 4 + k] = (ee << 16) | slot;
                r_tw[(size_t)tok * 4 + k] = ex[k] * inv;
            }
        }
        __syncthreads();
    }
}

__device__ __forceinline__ void build_expert_tables(const Params& p, int l, LAS int* ts, LAS int* cn, LAS int* te) {
    const int tid = opaque_tid();
    if (tid < 64) {
        const int c = tid < NE ? p.cnt[l * NE + tid] : 0;
        const int nt = (c + 255) >> 8;
        int v = nt;
#pragma unroll
        for (int off = 1; off < 32; off <<= 1) { const int t = shupi(v, off, tid); if (tid >= off) v += t; }
        if (tid < NE) { cn[tid] = c; ts[tid] = v - nt; if (tid == NE - 1) ts[NE] = v; }
        if (te && tid < NE) for (int q = 0; q < nt; ++q) te[v - nt + q] = tid;
    }
    __syncthreads();
}

struct MoeSched {
    const LAS int* ts; const LAS int* cn; const LAS int* te; const int* list; const bf16_t* A; const bf16_t* Bt; const float* bias; int K, npn, nunits, G, c, nrowsB, nbias; bool gather;
    static constexpr bool HAS_BIAS = true;
    __device__ __forceinline__ bool next(int i, g8::Unit& u) const {
        const long L = (long)i * G + c; if (L >= nunits) return false;
        u.pm = (int)(L / npn); u.pn = (int)(L % npn); u.e = te[u.pm]; return true;
    }
    __device__ __forceinline__ const char* a_base(const g8::Unit& u) const { return (const char*)(gather ? A : A + (size_t)u.pm * 256 * K); }
    __device__ __forceinline__ const char* b_base(const g8::Unit& u) const { return (const char*)(Bt + ((size_t)u.e * nrowsB + (size_t)u.pn * 256) * K); }
    __device__ __forceinline__ const int* row_addr(const g8::Unit& u, int R) const {
        const int cnt = cn[u.e], sl = (u.pm - ts[u.e]) * 256 + R;
        return list + (size_t)u.e * NTOK + (sl < cnt ? sl : 0);
    }
    __device__ __forceinline__ int rows_valid(const g8::Unit& u) const { return cn[u.e] - (u.pm - ts[u.e]) * 256; }
    __device__ __forceinline__ const float* bias_src(const g8::Unit& u, int lane) const {
        if (nbias == 2) return bias + (size_t)u.e * 2 * D + (lane < 32 ? u.pn * 128 + lane * 4 : D + u.pn * 128 + (lane - 32) * 4);
        return bias + (size_t)u.e * D + u.pn * 256 + lane * 4;
    }
};
struct EpiAct {
    bf16_t* O;
    __device__ __forceinline__ bool keep(const g8::Unit&) const { return false; }
    __device__ __forceinline__ void operator()(const f32x4 (&acc)[2][2][4][2], const g8::Unit& u, int wr, int wc, int fr, int fq, const LAS float* bias) const {
        const int row0 = u.pm * 256 + wr * 64 + fr, col0 = u.pn * 128 + wc * 32 + 8 * fq;
        const LAS float* bb = bias + wc * 32 + 8 * fq;
        const f32x4 g0 = *(const LAS f32x4*)bb, g1 = *(const LAS f32x4*)(bb + 4), l0 = *(const LAS f32x4*)(bb + 128), l1 = *(const LAS f32x4*)(bb + 132);
        const float bg[8] = {g0[0], g0[1], g0[2], g0[3], g1[0], g1[1], g1[2], g1[3]}, bl[8] = {l0[0], l0[1], l0[2], l0[3], l1[0], l1[1], l1[2], l1[3]};
#pragma unroll
        for (int ai = 0; ai < 2; ++ai)
#pragma unroll
            for (int m = 0; m < 4; ++m) {
                float o[8];
#pragma unroll
                for (int n = 0; n < 2; ++n)
#pragma unroll
                    for (int j = 0; j < 4; ++j) {
                        const float glu = fminf(acc[ai][0][m][n][j] + bg[n * 4 + j], 7.0f);
                        const float lin = fminf(fmaxf(acc[ai][1][m][n][j] + bl[n * 4 + j], -7.0f), 7.0f);
                        o[n * 4 + j] = glu * sigmoidf_(1.702f * glu) * (lin + 1.0f);
                    }
                *(u32x4*)(O + (size_t)(row0 + ai * 128 + m * 16) * D + col0) = pack8(o);
            }
    }
};
__device__ __forceinline__ void ph_g4(const Params& p, int l, LAS unsigned char* lds) {
    LAS int* ts = (LAS int*)(lds + g8::STAGE_BYTES); LAS int* cn = ts + 40; LAS int* te = ts + 80;
    build_expert_tables(p, l, ts, cn, te);
    MoeSched S; S.ts = ts; S.cn = cn; S.te = te; S.list = p.list; S.A = p.F; S.Bt = p.w1T + (size_t)l * NE * 2 * D * D; S.bias = p.moe_b1 + (size_t)l * NE * 2 * D; S.nbias = 2;
    S.K = D; S.npn = 8; S.nunits = ts[NE] * 8; S.G = gridDim.x; S.c = blockIdx.x; S.nrowsB = 2 * D; S.gather = true;
    EpiAct E; E.O = p.act;
    g8::gemm_phase(lds, D, S, E);
}

struct EpiYp {
    bf16_t* O;
    __device__ __forceinline__ bool keep(const g8::Unit&) const { return false; }
    __device__ __forceinline__ void operator()(const f32x4 (&acc)[2][2][4][2], const g8::Unit& u, int wr, int wc, int fr, int fq, const LAS float* bias) const {
        const int row0 = u.pm * 256 + wr * 64 + fr, col0 = u.pn * 256 + wc * 32 + 8 * fq;
#pragma unroll
        for (int bj = 0; bj < 2; ++bj) {
            const LAS float* bb = bias + bj * 128 + wc * 32 + 8 * fq;
            const f32x4 c0v = *(const LAS f32x4*)bb, c1v = *(const LAS f32x4*)(bb + 4);
            const float4 c0 = make_float4(c0v[0], c0v[1], c0v[2], c0v[3]), c1 = make_float4(c1v[0], c1v[1], c1v[2], c1v[3]);
#pragma unroll
            for (int ai = 0; ai < 2; ++ai)
#pragma unroll
                for (int m = 0; m < 4; ++m) {
                    u32x4 w; w[0] = pack2(acc[ai][bj][m][0][0] + c0.x, acc[ai][bj][m][0][1] + c0.y); w[1] = pack2(acc[ai][bj][m][0][2] + c0.z, acc[ai][bj][m][0][3] + c0.w);
                    w[2] = pack2(acc[ai][bj][m][1][0] + c1.x, acc[ai][bj][m][1][1] + c1.y); w[3] = pack2(acc[ai][bj][m][1][2] + c1.z, acc[ai][bj][m][1][3] + c1.w);
                    *(u32x4*)(O + (size_t)(row0 + ai * 128 + m * 16) * D + col0 + bj * 128) = w;
                }
        }
    }
};
__device__ __forceinline__ void ph_g5(const Params& p, int l, LAS unsigned char* lds) {
    LAS int* ts = (LAS int*)(lds + g8::STAGE_BYTES); LAS int* cn = ts + 40; LAS int* te = ts + 80;
    build_expert_tables(p, l, ts, cn, te);
    MoeSched S; S.ts = ts; S.cn = cn; S.te = te; S.list = p.list; S.A = p.act; S.Bt = p.w2T + (size_t)l * NE * D * D; S.bias = p.moe_b2 + (size_t)l * NE * D; S.nbias = 1;
    S.K = D; S.npn = 4; S.nunits = ts[NE] * 4; S.G = gridDim.x; S.c = blockIdx.x; S.nrowsB = D; S.gather = false;
    EpiYp E; E.O = p.yp;
    g8::gemm_phase(lds, D, S, E);
}

template <bool DRY = false> __device__ __forceinline__ void ph_combine(const Params& p, int l, int M, LAS unsigned char* lds) {
    float* const c_xl = DRY ? p.prep : p.xl; bf16_t* const c_H = DRY ? (bf16_t*)(p.prep + (size_t)NTOK * D) : p.H; float* const c_out = DRY ? p.prep : p.out;
    LAS int* ts = (LAS int*)lds; LAS int* cn = ts + 40;
    build_expert_tables(p, l, ts, cn, nullptr);
    const int tid = opaque_tid(), wid = tid >> 6, lane = tid & 63;
    const bool last = (l == 1);
    const int tstep = gridDim.x * NWAVES;
    int tok = blockIdx.x * NWAVES + wid;
    int4 nts = make_int4(0, 0, 0, 0); float4 ntw = make_float4(0.f, 0.f, 0.f, 0.f);
    if (tok < M) { nts = *(const int4*)(p.tokslot + (size_t)tok * 4); ntw = *(const float4*)(p.topw + (size_t)tok * 4); }
    for (; tok < M; tok += tstep) {
        float4 v[4];
        const float* mb = p.mod + (size_t)(l * 5 + tok_modrow(tok)) * (NMOD * D);
        const int tsl[4] = {nts.x, nts.y, nts.z, nts.w}; const float wts[4] = {ntw.x, ntw.y, ntw.z, ntw.w};
        int rows[4];
#pragma unroll
        for (int k = 0; k < 4; ++k) rows[k] = ts[tsl[k] >> 16] * 256 + (tsl[k] & 0xffff);
        if (tok + tstep < M) { nts = *(const int4*)(p.tokslot + (size_t)(tok + tstep) * 4); ntw = *(const float4*)(p.topw + (size_t)(tok + tstep) * 4); }
        u32x2 yv[4][4]; float4 xin[4], gtv[4];
#pragma unroll
        for (int i = 0; i < 4; ++i) {
            const int cidx = i * 256 + lane * 4;
#pragma unroll
            for (int k = 0; k < 4; ++k) yv[i][k] = *(const u32x2*)(p.yp + (size_t)rows[k] * D + cidx);
            xin[i] = *(const float4*)(p.xl + (size_t)tok * D + cidx);
            gtv[i] = *(const float4*)(mb + 5 * D + cidx);
        }
        float ss = 0.f;
#pragma unroll
        for (int i = 0; i < 4; ++i) {
            float m0 = 0.f, m1 = 0.f, m2 = 0.f, m3 = 0.f;
#pragma unroll
            for (int k = 0; k < 4; ++k) { m0 += wts[k] * bflo(yv[i][k][0]); m1 += wts[k] * bfhi(yv[i][k][0]); m2 += wts[k] * bflo(yv[i][k][1]); m3 += wts[k] * bfhi(yv[i][k][1]); }
            float4 xv = xin[i];
            xv.x += gtv[i].x * m0; xv.y += gtv[i].y * m1; xv.z += gtv[i].z * m2; xv.w += gtv[i].w * m3;
            v[i] = xv; ss += xv.x * xv.x + xv.y * xv.y + xv.z * xv.z + xv.w * xv.w;
        }
        ss = wave_sum(ss, lane);
        const float rinv = rsqrtf(ss * (1.0f / D) + 1e-6f);
        if (!last) {
#pragma unroll
            for (int i = 0; i < 4; ++i) *(float4*)(c_xl + (size_t)tok * D + i * 256 + lane * 4) = v[i];
            const float* mb1 = p.mod + (size_t)((l + 1) * 5 + tok_modrow(tok)) * (NMOD * D);
            norm_mod_store(v, rinv, p.norm1_g + (l + 1) * D, mb1 + 1 * D, mb1 + 0 * D, c_H + (size_t)tok * D, lane);
        } else {
#pragma unroll
            for (int i = 0; i < 4; ++i) {
                const int cidx = i * 256 + lane * 4;
                const float4 gv = *(const float4*)(p.final_norm_g + cidx);
                *(float4*)(c_out + (size_t)tok * D + cidx) = make_float4(v[i].x * rinv * gv.x, v[i].y * rinv * gv.y, v[i].z * rinv * gv.z, v[i].w * rinv * gv.w);
            }
        }
    }
}

#define XB_TMO      128
#define XB_XCNT(j)  (256  + 64 * (j))
#define XB_XSUB(j)  (1280 + 64 * (j))
#define XB_XGEN(j)  (2304 + 64 * (j))
#define XB_TOP      3328
#define XB_TOPGEN   3392
#define XCD_BAR_WORDS 3456
#define XB_SPIN_CAP (1u << 18)

__device__ __forceinline__ unsigned xb_ld(unsigned* p)              { return __hip_atomic_load(p, __ATOMIC_RELAXED, __HIP_MEMORY_SCOPE_AGENT); }
__device__ __forceinline__ unsigned xb_add(unsigned* p, unsigned v) { return __hip_atomic_fetch_add(p, v, __ATOMIC_RELAXED, __HIP_MEMORY_SCOPE_AGENT); }
__device__ __forceinline__ unsigned xb_xcc_id() { return (unsigned)__builtin_amdgcn_s_getreg((3 << 11) | 20) & 0xFu; }
#define XB_SPIN(cond, bar) do { unsigned _sp = 0; while (cond) { __builtin_amdgcn_s_sleep(1); \
    if ((++_sp & 255u) == 0u) { if (xb_ld(&(bar)[XB_TMO])) break; if (_sp > XB_SPIN_CAP) { atomicAdd(&(bar)[XB_TMO], 1u); break; } } } } while (0)

struct XcdBarrier {
    unsigned* bar; unsigned x;
    volatile LAS unsigned* st;
};

__device__ __forceinline__ XcdBarrier xcd_barrier_post(unsigned* bar, volatile LAS unsigned* st) {
    XcdBarrier b; b.bar = bar; b.x = xb_xcc_id(); b.st = st;
    if (threadIdx.x == 0) (void)xb_add(&bar[XB_XCNT(b.x)], 1u);
    return b;
}
__device__ __forceinline__ void xcd_barrier_complete(unsigned* bar, unsigned x, unsigned& nloc, unsigned& nx) {
    const unsigned G = gridDim.x * gridDim.y * gridDim.z;
    unsigned sum, cnt, mine, sp = 0u;
    for (;;) {
        sum = 0u; cnt = 0u; mine = 0u;
#pragma unroll
        for (unsigned j = 0; j < 16; ++j) { const unsigned c = xb_ld(&bar[XB_XCNT(j)]); sum += c; cnt += (c > 0u) ? 1u : 0u; mine = (j == x) ? c : mine; }
        if (sum == G) break;
        __builtin_amdgcn_s_sleep(1);
        if ((++sp & 255u) == 0u) { if (xb_ld(&bar[XB_TMO])) break; if (sp > XB_SPIN_CAP) { atomicAdd(&bar[XB_TMO], 1u); break; } }
    }
    nloc = mine > 0u ? mine : 1u; nx = cnt > 0u ? cnt : 1u;
}

__device__ __forceinline__ void xcd_barrier(const XcdBarrier& b) {
    asm volatile("s_waitcnt vmcnt(0)" ::: "memory");
    __syncthreads();
    if (threadIdx.x == 0) {
        unsigned* bar = b.bar;
        __builtin_amdgcn_s_waitcnt(0);
        unsigned nloc = b.st[0], nx = b.st[1];
        if (nloc == 0u) { xcd_barrier_complete(bar, b.x, nloc, nx); b.st[0] = nloc; b.st[1] = nx; }
        const unsigned old = xb_add(&bar[XB_XSUB(b.x)], 1u);
        const unsigned gen = old / nloc;
        if (old + 1u == (gen + 1u) * nloc) {
            __builtin_amdgcn_fence(__ATOMIC_RELEASE, "agent");
            asm volatile("s_waitcnt vmcnt(0)" ::: "memory");
            const unsigned og = xb_add(&bar[XB_TOP], 1u);
            const unsigned tg = og / nx;
            if (og + 1u == (tg + 1u) * nx) xb_add(&bar[XB_TOPGEN], 1u);
            else XB_SPIN(xb_ld(&bar[XB_TOPGEN]) == tg, bar);
            __builtin_amdgcn_fence(__ATOMIC_ACQUIRE, "agent");
            xb_add(&bar[XB_XGEN(b.x)], 1u);
            asm volatile("s_waitcnt vmcnt(0)" ::: "memory");
        } else {
            XB_SPIN(xb_ld(&bar[XB_XGEN(b.x)]) == gen, bar);
            __builtin_amdgcn_fence(__ATOMIC_ACQUIRE, "agent");
            asm volatile("s_waitcnt vmcnt(0)" ::: "memory");
        }
    }
    __syncthreads();
}


extern __shared__ __attribute__((aligned(16))) unsigned char dyn_lds[];
#define KPH(name, call) __global__ void __launch_bounds__(NTHREADS, 2) name(Params p, int l, int M) { LAS unsigned char* lds = (LAS unsigned char*)dyn_lds; (void)l; (void)M; (void)lds; call; }
KPH(k_convert, { ph_convert(p, lds); })
KPH(k_mod, { ph_mod(p, lds); })
KPH(k_norm1, { ph_norm1_first(p); })
KPH(k_g1, { ph_g1(p, l, lds); })
KPH(k_prep, { ph_prep(p, l, lds); })
KPH(k_local, { ph_local(p, l, lds); })
KPH(k_seq, { ph_seq(p, lds); })
KPH(k_merge, { ph_merge(p, l, M); })
KPH(k_g2, { ph_g2(p, l, M, lds); })
KPH(k_g3, { ph_g3(p, l, M, lds); })
KPH(k_route, { ph_route(p, l, M, lds); })
KPH(k_g4, { ph_g4(p, l, lds); })
KPH(k_g5, { ph_g5(p, l, lds); })
KPH(k_combine, { ph_combine(p, l, M, lds); })


typedef const __attribute__((address_space(4))) unsigned char* KArgPtr;
__device__ __forceinline__ Params load_params(KArgPtr kp) {
    asm volatile("" : "+s"(kp));
    Params q;
    const __attribute__((address_space(4))) unsigned long long* k8 = (const __attribute__((address_space(4))) unsigned long long*)kp;
    unsigned long long* d8 = (unsigned long long*)&q;
#pragma unroll
    for (int i = 0; i < (int)(sizeof(Params) / 8); ++i) d8[i] = k8[i];
    return q;
}
__global__ void __launch_bounds__(NTHREADS, 2) k_mega(Params p_unused) {
    (void)p_unused;
    const KArgPtr kp = (KArgPtr)__builtin_amdgcn_kernarg_segment_ptr();
    LAS unsigned char* lds = (LAS unsigned char*)dyn_lds;
    volatile LAS unsigned* xb_words = (volatile LAS unsigned*)(lds + LDS_BYTES - 16);
    if (threadIdx.x == 0) { xb_words[0] = 0u; xb_words[1] = 0u; xb_words[2] = 0u; xb_words[3] = 0u; }
    __syncthreads();
    { const Params p = load_params(kp); (void)xcd_barrier_post(p.bar, xb_words); }
#define GRID_BARRIER() do { XcdBarrier b_; b_.bar = load_params(kp).bar; b_.x = xb_xcc_id(); b_.st = xb_words; xcd_barrier(b_); } while (0)
#define PH(stmt) do { const Params p = load_params(kp); stmt; } while (0)
    PH(ph_convert(p, lds));
    PH(ph_mod(p, lds));
    GRID_BARRIER();
    PH(ph_norm1_first(p));
    GRID_BARRIER();
    for (int l = 0; l < 2; ++l) {
        const int M = l == 0 ? NTOK : NLAT;
        { unsigned lb_ = (unsigned)(size_t)lds; asm volatile("" : "+s"(lb_)); lds = (LAS unsigned char*)(size_t)lb_; }
        PH(ph_g1(p, l, lds));
        GRID_BARRIER();
        PH(ph_prep(p, l, lds));
        PH(ph_local(p, l, lds));
        GRID_BARRIER();
        PH(ph_seq(p, lds));
        GRID_BARRIER();
        PH(ph_merge(p, l, M));
        GRID_BARRIER();
        PH(ph_g2(p, l, M, lds));
        GRID_BARRIER();
        PH(ph_g3(p, l, M, lds));
        GRID_BARRIER();
        PH(ph_route(p, l, M, lds));
        GRID_BARRIER();
        PH(ph_g4(p, l, lds));
        GRID_BARRIER();
        PH(ph_g5(p, l, lds));
        GRID_BARRIER();
        PH(ph_combine(p, l, M, lds));
        if (l == 0) GRID_BARRIER();
    }
}

static inline size_t align_up(size_t v, size_t a) { return (v + a - 1) / a * a; }

extern "C" void kernel_launch(void* const* d_in, const int* in_sizes, int n_in, void* d_out, int out_size, void* d_ws, size_t ws_size, hipStream_t stream) {
    (void)in_sizes; (void)n_in; (void)out_size;
    Params p{};
    const float** pf = (const float**)&p;
    for (int i = 0; i < 32; ++i) pf[i] = (const float*)d_in[i];
    p.out = (float*)d_out;
    unsigned char* w = (unsigned char*)d_ws; size_t off = 0;
    auto take = [&](size_t bytes) { void* r = w + off; off = align_up(off + bytes, 256); return r; };
    p.bar = (unsigned*)take(16384);
    p.cnt = (int*)take(1024);
    const size_t ctl_bytes = off;
    p.mod = (float*)take((size_t)2 * 5 * NMOD * D * 4);
    p.winT = (bf16_t*)take((size_t)2 * NPW * D * 2);
    p.wbT = (bf16_t*)take((size_t)2 * 4 * D * MW * 2);
    p.woutT = (bf16_t*)take((size_t)2 * D * D * 2);
    p.w1T = (bf16_t*)take((size_t)2 * NE * 2 * D * D * 2);
    p.w2T = (bf16_t*)take((size_t)2 * NE * D * D * 2);
    p.xl = (float*)take((size_t)NTOK * D * 4);
    p.H = (bf16_t*)take((size_t)NTOK * D * 2);
    p.P = (bf16_t*)take((size_t)NTOK * NP * 2);
    p.gate = (bf16_t*)take((size_t)NTOK * 4096 * 2);
    p.act = p.P; p.yp = p.P + (size_t)CAPROWS * D;
    p.prep = (float*)take(NPREP * TOKW * 4);
    p.O = (bf16_t*)take(8 * TOKW * 2);
    p.lq = (bf16_t*)take((size_t)3 * NITEM * 64 * 128 * 2);
    p.lo = (bf16_t*)take((size_t)3 * NITEM * 64 * 128 * 2);
    p.lb = (bf16_t*)take((size_t)3 * NITEM * 128 * 128 * 2);
    p.la = (bf16_t*)take((size_t)NITEM * 128 * 128 * 2);
    p.ld = (float*)take((size_t)3 * NITEM * 128 * 4);
    p.lruT = (bf16_t*)take((size_t)2 * 8 * 4 * 4096 * 2);
    p.lsig = (float*)take((size_t)2 * 2 * MW * 4);
    p.Y = (bf16_t*)take(4 * TOKW * 2);
    p.mix = (bf16_t*)take((size_t)NTOK * D * 2);
    p.F = p.H;
    p.list = (int*)take((size_t)NE * NTOK * 4);
    p.tokslot = (int*)take((size_t)NTOK * 4 * 4);
    p.topw = (float*)take((size_t)NTOK * 4 * 4);
    if (off > ws_size) { fprintf(stderr, "workspace too small: need %zu have %zu\n", off, ws_size); return; }

    static int grid = 0;
#if MEGA
    if (!grid) {
        int dev = 0, cus = 0, occ = 0; (void)hipGetDevice(&dev); (void)hipDeviceGetAttribute(&cus, hipDeviceAttributeMultiprocessorCount, dev);
        (void)hipFuncSetAttribute((const void*)k_mega, hipFuncAttributeMaxDynamicSharedMemorySize, LDS_BYTES);
        (void)hipOccupancyMaxActiveBlocksPerMultiprocessor(&occ, (const void*)k_mega, NTHREADS, LDS_BYTES);
        if (cus <= 0) cus = 256;
        grid = cus * (occ < 1 ? 1 : 1);
        if (occ < 1) fprintf(stderr, "occupancy query says %d blocks per CU\n", occ);
    }
    (void)hipMemsetAsync(d_ws, 0, ctl_bytes, stream);
    hipLaunchKernelGGL(k_mega, dim3(grid), dim3(NTHREADS), LDS_BYTES, stream, p);
#else
    if (!grid) {
        int dev = 0, cus = 0; (void)hipGetDevice(&dev); (void)hipDeviceGetAttribute(&cus, hipDeviceAttributeMultiprocessorCount, dev);
        grid = cus > 0 ? cus : 256;
        const void* ks[] = {(const void*)k_convert, (const void*)k_mod, (const void*)k_norm1, (const void*)k_g1, (const void*)k_prep, (const void*)k_local, (const void*)k_seq, (const void*)k_merge,
                            (const void*)k_g2, (const void*)k_g3, (const void*)k_route, (const void*)k_g4, (const void*)k_g5, (const void*)k_combine};
        for (const void* k : ks) (void)hipFuncSetAttribute(k, hipFuncAttributeMaxDynamicSharedMemorySize, LDS_BYTES);
    }
    (void)hipMemsetAsync(d_ws, 0, ctl_bytes, stream);
#define LAUNCH(k, l, M) hipLaunchKernelGGL(k, dim3(grid), dim3(NTHREADS), LDS_BYTES, stream, p, l, M)
    LAUNCH(k_convert, 0, 0);
    LAUNCH(k_mod, 0, 0);
    LAUNCH(k_norm1, 0, 0);
    for (int l = 0; l < 2; ++l) {
        const int M = l == 0 ? NTOK : NLAT;
        LAUNCH(k_g1, l, M);
        LAUNCH(k_prep, l, M);
        LAUNCH(k_local, l, M);
        LAUNCH(k_seq, l, M);
        LAUNCH(k_merge, l, M);
        LAUNCH(k_g2, l, M);
        LAUNCH(k_g3, l, M);
        LAUNCH(k_route, l, M);
        LAUNCH(k_g4, l, M);
        LAUNCH(k_g5, l, M);
        LAUNCH(k_combine, l, M);
    }
#endif
}
```

```cpp
#include <hip/hip_runtime.h>
#include <stdint.h>
#include <stdio.h>

#define LAS __attribute__((address_space(3)))
typedef unsigned short bf16_t;
typedef short bf16x8 __attribute__((ext_vector_type(8)));
typedef float f32x4 __attribute__((ext_vector_type(4)));
typedef float f32x2 __attribute__((ext_vector_type(2)));
typedef unsigned u32x2 __attribute__((ext_vector_type(2)));
typedef unsigned u32x4 __attribute__((ext_vector_type(4)));

#ifndef MEGA
#define MEGA 1
#endif
#ifndef PROBE
#define PROBE 0
#endif

constexpr int D = 1024, NB = 4, TL = 4096, TC = 256, NLAT = NB * TL, NCTX = NB * TC, NTOK = NLAT + NCTX;
constexpr int NIN = 11792, NPW = 12032, NP = 7936, MW = 512, NE = 32, TOPK = 4, NMOD = 6;
constexpr int C_GQKV = 0, C_GZ = 1536, C_HQ = 2048, C_HI = 2560, C_HF = 3072, C_HG = 4096, C_LX = 4608,
              C_LY = 5120, C_RQKV = 5632, C_RG = 7168, C_GA = 7680, C_GB = 7688, W_MG = 7936;
__host__ __device__ __forceinline__ int win_dst_row(int n) { return n < 2048 ? n : n < 2064 ? 7680 + (n - 2048) : n < 7696 ? n - 16 : 7936 + (n - 7696); }
constexpr int NTHREADS = 512, NWAVES = 8;
constexpr int LDS_BYTES = 140 * 1024;
constexpr int CAPROWS = 77824;
constexpr size_t TOKW = (size_t)NTOK * MW;
constexpr int PR_LA = 0, PR_LU = 2, NPREP = 4;
constexpr int NCHUNK = 68, NITEM = 32 * NCHUNK;

struct Params {
    const float *x, *c, *ctx, *c_ctx, *w_mod, *b_mod, *norm1_g, *norm2_g, *w_in, *gdn_conv_w, *gdn_a_log, *gdn_dt_bias, *gdn_norm_g, *hgrn_lb,
        *hgrn_norm_g, *lru_conv_w, *lru_conv_b, *lru_wa, *lru_ba, *lru_wx, *lru_bx, *lru_lambda, *ret_norm_g, *w_branch, *w_out, *router_w,
        *router_b, *moe_w1, *moe_b1, *moe_w2, *moe_b2, *final_norm_g;
    float* out;
    unsigned* bar; int* cnt; float* mod;
    bf16_t *winT, *wbT, *woutT, *w1T, *w2T;
    float* xl; bf16_t* H; bf16_t* P; float* prep; float* gg; float* gb; bf16_t* O; bf16_t* Y; bf16_t* mix; bf16_t* F;
    int* list; int* tokslot; float* topw; bf16_t* act; bf16_t* yp;
    bf16_t *lq, *lo, *lb, *la; float* ld; bf16_t* lruT; bf16_t* gate; float* lsig; float2* rope;
};

typedef __bf16 bf16x2_t __attribute__((ext_vector_type(2)));
__device__ __forceinline__ unsigned pack2(float a, float b) { const f32x2 v = {a, b}; return __builtin_bit_cast(unsigned, __builtin_convertvector(v, bf16x2_t)); }
__device__ __forceinline__ unsigned f2bf(float f) { return pack2(f, f) & 0xffffu; }
__device__ __forceinline__ float bf2f(bf16_t b) { return __uint_as_float(((unsigned)b) << 16); }
__device__ __forceinline__ float bflo(unsigned u) { return __uint_as_float(u << 16); }
__device__ __forceinline__ float bfhi(unsigned u) { return __uint_as_float(u & 0xffff0000u); }
__device__ __forceinline__ float sigmoidf_(float x) { return __builtin_amdgcn_rcpf(1.0f + __expf(-x)); }
__device__ __forceinline__ float siluf_(float x) { return x * sigmoidf_(x); }
__device__ __forceinline__ float softplusf_(float x) { return x > 20.f ? x : __logf(1.0f + __expf(x)); }
__device__ __forceinline__ float ret_log_gamma(int h) { return h == 0 ? -0.031748698314580f : h == 1 ? -0.015748356968139f : h == 2 ? -0.007843177461025f : -0.003913899321136f; }
__device__ __forceinline__ float logsigmoidf_(float x) { return -softplusf_(-x); }
__device__ __forceinline__ float gelu_tanhf_(float x) { const float u = 0.7978845608028654f * (x + 0.044715f * x * x * x); return x * __builtin_amdgcn_rcpf(1.0f + __expf(-2.0f * u)); }
__device__ __forceinline__ float shx(float v, int m, int lane) { return __int_as_float(__builtin_amdgcn_ds_bpermute((lane ^ m) << 2, __float_as_int(v))); }
__device__ __forceinline__ float shup(float v, int off, int lane) { const int s = lane >= off ? lane - off : lane; return __int_as_float(__builtin_amdgcn_ds_bpermute(s << 2, __float_as_int(v))); }
__device__ __forceinline__ int shupi(int v, int off, int lane) { const int s = lane >= off ? lane - off : lane; return __builtin_amdgcn_ds_bpermute(s << 2, v); }
__device__ __forceinline__ float wave_sum(float v, int lane) {
#pragma unroll
    for (int m = 32; m >= 1; m >>= 1) v += shx(v, m, lane);
    return v;
}
__device__ __forceinline__ int opaque_tid() { int t = threadIdx.x; asm volatile("" : "+v"(t)); return t; }
template <class T> __device__ __forceinline__ T* opaque_sptr(T* q) { asm volatile("" : "+s"(q)); return q; }
__device__ __forceinline__ int tok_modrow(int tok) { return tok < NLAT ? (tok >> 12) : 4; }
__device__ __forceinline__ void tok_info(int tok, int& t, int& T, int& base) {
    if (tok < NLAT) { t = tok & (TL - 1); T = TL; base = tok - t; }
    else { t = (tok - NLAT) & (TC - 1); T = TC; base = tok - t; }
}

__device__ __forceinline__ f32x4 mfma16(bf16x8 a, bf16x8 b, f32x4 c) { return __builtin_amdgcn_mfma_f32_16x16x32_bf16(a, b, c, 0, 0, 0); }
__device__ __forceinline__ u32x2 pack4(f32x4 v) { u32x2 o; o[0] = pack2(v[0], v[1]); o[1] = pack2(v[2], v[3]); return o; }
__device__ __forceinline__ u32x4 pack8(const float* v) { u32x4 o; o[0] = pack2(v[0], v[1]); o[1] = pack2(v[2], v[3]); o[2] = pack2(v[4], v[5]); o[3] = pack2(v[6], v[7]); return o; }

namespace gm {
constexpr int HT = 16384;
__device__ __forceinline__ int lds_byte(int r, int c) { const int st = (r >> 4) * 2 + (c >> 5), rr = r & 15, cc = c & 31, ob = rr * 64 + cc * 2; return st * 1024 + (ob ^ (((ob >> 9) & 1) << 5)); }
__device__ __forceinline__ void stage_rc(int b, int& R, int& C) { const int st = b / 1024, sb = b % 1024, swz = sb ^ (((sb >> 9) & 1) << 5); R = (st >> 1) * 16 + swz / 64; C = (st & 1) * 32 + (swz % 64) / 2; }

__device__ __forceinline__ void kloop(LAS unsigned char* lds, const bf16_t* ap00, const bf16_t* ap01, const bf16_t* ap10, const bf16_t* ap11,
                                      const bf16_t* bp0, const bf16_t* bp1, int K, f32x4 (&acc)[4][4]) {
    const int tid = opaque_tid(), wid = __builtin_amdgcn_readfirstlane(tid >> 6), lane = tid & 63, wr = wid >> 1, wc = wid & 1, fr = lane & 15, fq = lane >> 4;
    const unsigned ldsw = (unsigned)wid * 1024u;
    const int aoff = (wr >> 1) * HT + lds_byte((wr & 1) * 64 + fr, fq * 8);
    const int boff = 2 * HT + lds_byte(wc * 64 + fr, fq * 8);
    const int nt = K / 64;
#define GM_GLDS(src, dstoff) __builtin_amdgcn_global_load_lds((const unsigned*)(src), (LAS unsigned*)(lds + (dstoff)), 16, 0, 0)
#define GM_STAGE(buf, kt) do { const int _bo = (buf) * 3 * HT + ldsw; const int _ko = (kt) * 64; \
        GM_GLDS(ap00 + _ko, _bo); GM_GLDS(ap01 + _ko, _bo + 8192); GM_GLDS(ap10 + _ko, _bo + HT); GM_GLDS(ap11 + _ko, _bo + HT + 8192); \
        GM_GLDS(bp0 + _ko, _bo + 2 * HT); GM_GLDS(bp1 + _ko, _bo + 2 * HT + 8192); } while (0)
    GM_STAGE(0, 0);
    for (int t = 0; t < nt; ++t) {
        const int cur = t & 1;
        if (t + 1 < nt) { GM_STAGE(cur ^ 1, t + 1); asm volatile("s_waitcnt vmcnt(6)" ::: "memory"); }
        else asm volatile("s_waitcnt vmcnt(0)" ::: "memory");
        __builtin_amdgcn_s_barrier(); asm volatile("" ::: "memory");
        bf16x8 af[4][2], bfr[4][2];
#pragma unroll
        for (int m = 0; m < 4; ++m)
#pragma unroll
            for (int k = 0; k < 2; ++k) af[m][k] = *(const LAS bf16x8*)(lds + cur * 3 * HT + aoff + m * 2048 + k * 1024);
#pragma unroll
        for (int n = 0; n < 4; ++n)
#pragma unroll
            for (int k = 0; k < 2; ++k) bfr[n][k] = *(const LAS bf16x8*)(lds + cur * 3 * HT + boff + n * 2048 + k * 1024);
#pragma unroll
        for (int k = 0; k < 2; ++k)
#pragma unroll
            for (int m = 0; m < 4; ++m)
#pragma unroll
                for (int n = 0; n < 4; ++n) acc[m][n] = __builtin_amdgcn_mfma_f32_16x16x32_bf16(bfr[n][k], af[m][k], acc[m][n], 0, 0, 0);
        asm volatile("s_waitcnt lgkmcnt(0)" ::: "memory");
        __builtin_amdgcn_s_barrier(); asm volatile("" ::: "memory");
    }
#undef GM_STAGE
#undef GM_GLDS
}
__device__ __forceinline__ void zero_acc(f32x4 (&acc)[4][4]) {
#pragma unroll
    for (int m = 0; m < 4; ++m)
#pragma unroll
        for (int n = 0; n < 4; ++n) acc[m][n] = (f32x4){0.f, 0.f, 0.f, 0.f};
}
}

namespace g8 {
constexpr int BM = 256, BK = 64, HALF = 128, HTB = HALF * BK * 2, STAGE_BYTES = 8 * HTB;
__device__ __forceinline__ int lds_byte(int r, int c) { const int st = (r >> 4) * 2 + (c >> 5), rr = r & 15, cc = c & 31, ob = rr * 64 + cc * 2; return st * 1024 + (ob ^ (((ob >> 9) & 1) << 5)); }
__device__ __forceinline__ void stage_rc(int b, int& R, int& C) { const int st = b / 1024, sb = b % 1024, swz = sb ^ (((sb >> 9) & 1) << 5); R = (st >> 1) * 16 + swz / 64; C = (st & 1) * 32 + (swz % 64) / 2; }
__device__ __forceinline__ int perm32(int rho) { const int n = rho >> 4, i = rho & 15; return 8 * (i >> 2) + 4 * n + (i & 3); }
struct Unit { int pm, pn, e; };

template <class Epi, class Sched>
__device__ __forceinline__ void gemm_phase(LAS unsigned char* lds, const int K, const Sched& S, const Epi& E) {
    const int tid = opaque_tid(), wid = __builtin_amdgcn_readfirstlane(tid >> 6), lane = tid & 63, wr = wid >> 2, wc = wid & 3, fr = lane & 15, fq = lane >> 4;
    const int nt = K / BK;
    int R0, C0, R1, C1; stage_rc(tid * 16, R0, C0); stage_rc(tid * 16 + 8192, R1, C1);
    unsigned voffB[2];
    voffB[0] = (unsigned)(((R0 & ~31) + perm32(R0 & 31)) * K + C0) * 2u; voffB[1] = (unsigned)(((R1 & ~31) + perm32(R1 & 31)) * K + C1) * 2u;
    const unsigned cb0 = (unsigned)C0 * 2u, cb1 = (unsigned)C1 * 2u;
    const size_t kstep = (size_t)(BK * 2);
    const size_t hstepB = (size_t)HALF * K * 2;
    const unsigned ldsw = (unsigned)wid * 1024u;
    const int aoff = lds_byte(wr * 64 + fr, fq * 8), boff = lds_byte(wc * 32 + fr, fq * 8);
#define G8_SA(b, h) (((b) * 2 + (h)) * HTB)
#define G8_SB(b, h) ((4 + (b) * 2 + (h)) * HTB)
#define G8_GL(src, dstoff) __builtin_amdgcn_global_load_lds((const unsigned*)(src), (LAS unsigned*)(lds + (dstoff)), 16, 0, 0)
#define G8_STAGE_A(bufoff, gbase, vo, h) do { G8_GL((const char*)(gbase) + (vo)[2 * (h)], (bufoff) + ldsw); G8_GL((const char*)(gbase) + (vo)[2 * (h) + 1], (bufoff) + ldsw + 8192); } while (0)
#define G8_STAGE_B(bufoff, gbase) do { G8_GL((const char*)(gbase) + voffB[0], (bufoff) + ldsw); G8_GL((const char*)(gbase) + voffB[1], (bufoff) + ldsw + 8192); } while (0)
#define G8_LDA(dst, b, h) do { _Pragma("unroll") for (int m = 0; m < 4; ++m) _Pragma("unroll") for (int k = 0; k < 2; ++k) dst[m][k] = *(const LAS bf16x8*)(lds + G8_SA(b, h) + aoff + m * 2048 + k * 1024); } while (0)
#define G8_LDB(dst, b, h) do { _Pragma("unroll") for (int n = 0; n < 2; ++n) _Pragma("unroll") for (int k = 0; k < 2; ++k) dst[n][k] = *(const LAS bf16x8*)(lds + G8_SB(b, h) + boff + n * 2048 + k * 1024); } while (0)
#define G8_MMA(ai, bj, At, Bt) do { __builtin_amdgcn_s_setprio(1); _Pragma("unroll") for (int m = 0; m < 4; ++m) _Pragma("unroll") for (int n = 0; n < 2; ++n) _Pragma("unroll") for (int k = 0; k < 2; ++k) \
        acc[ai][bj][m][n] = __builtin_amdgcn_mfma_f32_16x16x32_bf16(Bt[n][k], At[m][k], acc[ai][bj][m][n], 0, 0, 0); __builtin_amdgcn_s_setprio(0); } while (0)
#define G8_WAIT_V(n) asm volatile("s_waitcnt vmcnt(" #n ")" ::: "memory")
#define G8_WAIT_L(n) asm volatile("s_waitcnt lgkmcnt(" #n ")" ::: "memory")
#define G8_BAR __builtin_amdgcn_s_barrier()
#define G8_SCHED __builtin_amdgcn_sched_barrier(0)
    Unit cur, nxt; int ui = 0;
    if (!S.next(0, cur)) return;
    LAS float* biasbuf = (LAS float*)(lds + STAGE_BYTES + 2048);
    LAS int* rowbuf = (LAS int*)(lds + STAGE_BYTES + 4096);
    f32x4 acc[2][2][4][2];
#pragma unroll
    for (int a = 0; a < 2; ++a)
#pragma unroll
        for (int b = 0; b < 2; ++b)
#pragma unroll
            for (int m = 0; m < 4; ++m)
#pragma unroll
                for (int n = 0; n < 2; ++n) acc[a][b][m][n] = (f32x4){0.f, 0.f, 0.f, 0.f};
    bf16x8 At[4][2], B0[2][2], B1[2][2];
    unsigned vA[4];
    {
        unsigned rows[4] = {(unsigned)R0, (unsigned)R1, (unsigned)(HALF + R0), (unsigned)(HALF + R1)};
        if (S.gather) { rows[0] = (unsigned)*S.row_addr(cur, R0); rows[1] = (unsigned)*S.row_addr(cur, R1); rows[2] = (unsigned)*S.row_addr(cur, HALF + R0); rows[3] = (unsigned)*S.row_addr(cur, HALF + R1); }
        vA[0] = rows[0] * (unsigned)(K * 2) + cb0; vA[1] = rows[1] * (unsigned)(K * 2) + cb1; vA[2] = rows[2] * (unsigned)(K * 2) + cb0; vA[3] = rows[3] * (unsigned)(K * 2) + cb1;
    }
    const char* cA = S.a_base(cur); const char* cB = S.b_base(cur);
    G8_STAGE_B(G8_SB(0, 0), cB); G8_STAGE_A(G8_SA(0, 0), cA, vA, 0); G8_STAGE_B(G8_SB(0, 1), cB + hstepB); G8_STAGE_A(G8_SA(0, 1), cA, vA, 1);
    if (wr == 1) G8_BAR;
    G8_WAIT_V(4); G8_BAR;
    G8_STAGE_B(G8_SB(1, 0), cB + kstep); G8_STAGE_A(G8_SA(1, 0), cA + kstep, vA, 0); G8_STAGE_B(G8_SB(1, 1), cB + hstepB + kstep);
    G8_WAIT_V(6); G8_BAR;
    for (;;) {
        const bool has_next = S.next(ui + 1, nxt);
        const char* nA = has_next ? S.a_base(nxt) : cA; const char* nB = has_next ? S.b_base(nxt) : cB;
        const int nvalid = (S.gather && has_next) ? S.rows_valid(nxt) : 0;
        if (wid == 0) {
            if (Sched::HAS_BIAS) G8_GL(S.bias_src(cur, lane), STAGE_BYTES + 2048 + (ui & 1) * 1024);
            if (S.gather && has_next) G8_GL(S.row_addr(nxt, 0) + lane * 4, STAGE_BYTES + 4096 + ((ui + 1) & 1) * 1024);
        }
        for (int t = 0; t < nt; t += 2) {
            const bool last = (t == nt - 2);
            const char* a1 = cA + (size_t)(t + 1) * kstep;
            const char* a2 = last ? nA : cA + (size_t)(t + 2) * kstep; const char* b2 = last ? nB : cB + (size_t)(t + 2) * kstep;
            const char* a3 = a2 + kstep; const char* b3 = b2 + kstep;
            G8_LDB(B0, 0, 0); G8_SCHED; G8_LDA(At, 0, 0); G8_STAGE_A(G8_SA(1, 1), a1, vA, 1);
            if (last && S.gather && has_next) {
                const LAS int* rb = rowbuf + ((ui + 1) & 1) * 256;
                const unsigned r0 = R0 < nvalid ? (unsigned)rb[R0] : 0u, r1 = R1 < nvalid ? (unsigned)rb[R1] : 0u;
                const unsigned r2 = HALF + R0 < nvalid ? (unsigned)rb[HALF + R0] : 0u, r3 = HALF + R1 < nvalid ? (unsigned)rb[HALF + R1] : 0u;
                vA[0] = r0 * (unsigned)(K * 2) + cb0; vA[1] = r1 * (unsigned)(K * 2) + cb1; vA[2] = r2 * (unsigned)(K * 2) + cb0; vA[3] = r3 * (unsigned)(K * 2) + cb1;
            }
            G8_WAIT_L(8); G8_BAR; G8_WAIT_L(0); G8_MMA(0, 0, At, B0); G8_BAR; G8_SCHED;
            G8_LDB(B1, 0, 1); G8_STAGE_B(G8_SB(0, 0), b2);
            G8_BAR; G8_WAIT_L(0); G8_MMA(0, 1, At, B1); G8_BAR;
            G8_LDA(At, 0, 1); G8_STAGE_A(G8_SA(0, 0), a2, vA, 0);
            G8_BAR; G8_WAIT_L(0); G8_MMA(1, 0, At, B0); G8_BAR; G8_SCHED;
            G8_STAGE_B(G8_SB(0, 1), b2 + hstepB);
            G8_WAIT_V(6); G8_BAR; G8_MMA(1, 1, At, B1); G8_BAR;
            G8_LDB(B0, 1, 0); G8_SCHED; G8_LDA(At, 1, 0); G8_STAGE_A(G8_SA(0, 1), a2, vA, 1);
            G8_WAIT_L(8); G8_BAR; G8_WAIT_L(0); G8_MMA(0, 0, At, B0); G8_BAR; G8_SCHED;
            G8_LDB(B1, 1, 1); G8_STAGE_B(G8_SB(1, 0), b3);
            G8_BAR; G8_WAIT_L(0); G8_MMA(0, 1, At, B1); G8_BAR;
            G8_LDA(At, 1, 1); G8_STAGE_A(G8_SA(1, 0), a3, vA, 0);
            G8_BAR; G8_WAIT_L(0); G8_MMA(1, 0, At, B0); G8_BAR; G8_SCHED;
            G8_STAGE_B(G8_SB(1, 1), b3 + hstepB);
            G8_WAIT_V(6); G8_BAR; G8_MMA(1, 1, At, B1); G8_BAR;
        }
        E(acc, cur, wr, wc, fr, fq, biasbuf + (ui & 1) * 256);
        if (!has_next) break;
        if (!E.keep(cur))
#pragma unroll
        for (int a = 0; a < 2; ++a)
#pragma unroll
            for (int b = 0; b < 2; ++b)
#pragma unroll
                for (int m = 0; m < 4; ++m)
#pragma unroll
                    for (int n = 0; n < 2; ++n) acc[a][b][m][n] = (f32x4){0.f, 0.f, 0.f, 0.f};
        cur = nxt; cA = nA; cB = nB; ++ui;
    }
    G8_WAIT_V(0);
    if (wr == 0) G8_BAR;
    G8_BAR;
#undef G8_SA
#undef G8_SB
#undef G8_GL
#undef G8_STAGE_A
#undef G8_STAGE_B
#undef G8_LDA
#undef G8_LDB
#undef G8_MMA
#undef G8_WAIT_V
#undef G8_WAIT_L
#undef G8_BAR
#undef G8_SCHED
}

struct PlainSched {
    const bf16_t* A; const bf16_t* Bt; int K, nM, nN, nwg, G, c;
    __device__ __forceinline__ void init(const bf16_t* A_, const bf16_t* Bt_, int M, int N, int K_) { A = A_; Bt = Bt_; K = K_; nM = M / BM; nN = N / BM; nwg = nM * nN; G = gridDim.x; c = blockIdx.x; }
    __device__ __forceinline__ bool next(int i, Unit& u) const {
        const long L = (long)i * G + c; if (L >= nwg) return false;
        int wgid = (int)L; { const int q = nwg / 8, r = nwg % 8, xcd = wgid % 8, off = wgid / 8; wgid = (xcd < r ? xcd * (q + 1) : r * (q + 1) + (xcd - r) * q) + off; }
        const int nig = 8 * nN, gid = wgid / nig, fm = gid * 8, gsz = (nM - fm) < 8 ? (nM - fm) : 8;
        u.pm = fm + ((wgid % nig) % gsz); u.pn = (wgid % nig) / gsz; u.e = 0; return true;
    }
    __device__ __forceinline__ const char* a_base(const Unit& u) const { return (const char*)(A + (size_t)u.pm * BM * K); }
    __device__ __forceinline__ const char* b_base(const Unit& u) const { return (const char*)(Bt + (size_t)u.pn * BM * K); }
    static constexpr bool HAS_BIAS = false, gather = false;
    __device__ __forceinline__ const int* row_addr(const Unit&, int) const { return nullptr; }
    __device__ __forceinline__ int rows_valid(const Unit&) const { return 256; }
    __device__ __forceinline__ const float* bias_src(const Unit&, int) const { return nullptr; }
};
}

struct StageRC { int R0, C0, R1, C1; };
__device__ __forceinline__ StageRC my_stage_rc() { const int t = opaque_tid(); StageRC s; gm::stage_rc(t * 16, s.R0, s.C0); gm::stage_rc(t * 16 + 8192, s.R1, s.C1); return s; }

__device__ __forceinline__ int w1_dst_row(int n) { const int half = n >> 10, cc = n & 1023; return (cc >> 7) * 256 + half * 128 + (cc & 127); }

struct CvtTile { const float* src; bf16_t* dst; int ld, Nsrc, k0, n0, K, mode; };
__device__ __forceinline__ CvtTile cvt_decode(const Params& p, int it) {
    constexpr int PER_L = 2960 + 512 + 256 + 16384 + 8192;
    CvtTile t; const int l = it / PER_L; int r = it % PER_L;
    if (r < 2960) { const int nt = r % 185, kt = r / 185; t.src = p.w_in + (size_t)l * D * NIN; t.ld = NIN; t.Nsrc = NIN; t.k0 = kt * 64; t.n0 = nt * 64; t.dst = p.winT + (size_t)l * NPW * D; t.K = D; t.mode = 2; }
    else if (r < 3472) { r -= 2960; const int n = r / 128; r %= 128; const int nt = r % 16, kt = r / 16;
        t.src = p.w_branch + (size_t)(l * 4 + n) * MW * D; t.ld = D; t.Nsrc = D; t.k0 = kt * 64; t.n0 = nt * 64; t.dst = p.wbT + (size_t)(l * 4 + n) * D * MW; t.K = MW; t.mode = 0; }
    else if (r < 3728) { r -= 3472; const int nt = r % 16, kt = r / 16; t.src = p.w_out + (size_t)l * D * D; t.ld = D; t.Nsrc = D; t.k0 = kt * 64; t.n0 = nt * 64; t.dst = p.woutT + (size_t)l * D * D; t.K = D; t.mode = 0; }
    else if (r < 3728 + 16384) { r -= 3728; const int ee = r / 512; r %= 512; const int nt = r % 32, kt = r / 32;
        t.src = p.moe_w1 + (size_t)(l * NE + ee) * D * 2 * D; t.ld = 2 * D; t.Nsrc = 2 * D; t.k0 = kt * 64; t.n0 = nt * 64; t.dst = p.w1T + (size_t)(l * NE + ee) * 2 * D * D; t.K = D; t.mode = 1; }
    else { r -= 3728 + 16384; const int ee = r / 256; r %= 256; const int nt = r % 16, kt = r / 16;
        t.src = p.moe_w2 + (size_t)(l * NE + ee) * D * D; t.ld = D; t.Nsrc = D; t.k0 = kt * 64; t.n0 = nt * 64; t.dst = p.w2T + (size_t)(l * NE + ee) * D * D; t.K = D; t.mode = 0; }
    return t;
}

__device__ __forceinline__ void ph_convert(const Params& p, LAS unsigned char* lds) {
    LAS float* tile = (LAS float*)lds;
    const int tid = opaque_tid();
    for (int idx = blockIdx.x * NTHREADS + tid; idx < 2 * 8 * 4 * 4096; idx += gridDim.x * NTHREADS) {
        const int i = idx & 63, j = (idx >> 6) & 63, mat = (idx >> 12) & 3, n = (idx >> 14) & 7, ll = idx >> 17, d = mat >> 1;
        p.lruT[idx] = (bf16_t)f2bf(((mat & 1) ? p.lru_wx : p.lru_wa)[(size_t)((ll * 2 + d) * 8 + n) * 4096 + i * 64 + j]);
    }
    for (int idx = blockIdx.x * NTHREADS + tid; idx < 2 * 2 * MW; idx += gridDim.x * NTHREADS) p.lsig[idx] = 8.0f * logsigmoidf_(p.lru_lambda[idx]);
    for (int idx = blockIdx.x * NTHREADS + tid; idx < TL * 64; idx += gridDim.x * NTHREADS) {
        const int t = idx >> 6, pi = idx & 63;
        const float pos = (pi < 32) ? (float)(t >> 6) : (float)(t & 63);
        const float ang = pos * exp2f(-(float)(pi & 31) * (13.287712379549449f / 32.0f));
        float sn, cs; sincosf(ang, &sn, &cs);
        p.rope[idx] = make_float2(cs, sn);
    }
    constexpr int TOTAL = 2 * (2960 + 512 + 256 + 16384 + 8192);
    for (int idx = blockIdx.x * NTHREADS + tid; idx < 2 * 240 * (D / 8); idx += gridDim.x * NTHREADS) {
        const int ll = idx / (240 * (D / 8)), r = idx % (240 * (D / 8));
        *(u32x4*)(p.winT + ((size_t)ll * NPW + 7696) * D + (size_t)r * 8) = (u32x4){0u, 0u, 0u, 0u};
    }
    for (int g = blockIdx.x; g * 4 < TOTAL; g += gridDim.x) {
        float v[4][8];
        const int rr = tid >> 6, cc = tid & 63;
#pragma unroll
        for (int q = 0; q < 4; ++q) {
            const int it = g * 4 + q;
            const CvtTile t = cvt_decode(p, it < TOTAL ? it : TOTAL - 1);
            const int n = t.n0 + cc; const bool ok = n < t.Nsrc; const int nc = ok ? n : t.Nsrc - 1;
#pragma unroll
            for (int i = 0; i < 8; ++i) { const float x = t.src[(size_t)(t.k0 + rr + i * 8) * t.ld + nc]; v[q][i] = ok ? x : 0.f; }
        }
#pragma unroll
        for (int q = 0; q < 4; ++q)
#pragma unroll
            for (int i = 0; i < 8; ++i) tile[q * 4160 + (rr + i * 8) * 65 + cc] = v[q][i];
        __syncthreads();
#pragma unroll
        for (int q = 0; q < 4; ++q) {
            const int it = g * 4 + q;
            if (it < TOTAL) {
                const CvtTile t = cvt_decode(p, it);
                const int nl = tid >> 3, kg = tid & 7, n = t.n0 + nl;
                float w[8];
#pragma unroll
                for (int j = 0; j < 8; ++j) w[j] = tile[q * 4160 + (kg * 8 + j) * 65 + nl];
                const int drow = t.mode == 1 ? w1_dst_row(n) : t.mode == 2 ? win_dst_row(n) : n;
                if (n < t.Nsrc) *(u32x4*)(t.dst + (size_t)drow * t.K + t.k0 + kg * 8) = pack8(w);
            }
        }
        __syncthreads();
    }
}

__device__ __forceinline__ void ph_mod(const Params& p, LAS unsigned char* lds) {
    LAS float* sc = (LAS float*)lds;
    LAS float* red = sc + 5 * D;
    const int tid = opaque_tid(), wid = tid >> 6, lane = tid & 63;
    if ((int)blockIdx.x >= 192) return;
    for (int i = tid; i < 5 * D; i += NTHREADS) { const int r = i >> 10, k = i & 1023; const float v = r < 4 ? p.c[r * D + k] : p.c_ctx[k]; sc[i] = siluf_(v); }
    __syncthreads();
    for (int it = blockIdx.x; it < 192; it += gridDim.x) {
        const int l = it / 96, n0 = (it % 96) * 64;
        float acc[5] = {0.f, 0.f, 0.f, 0.f, 0.f};
        const float* wp = p.w_mod + (size_t)l * D * (NMOD * D) + n0 + lane;
        for (int k = wid * 128; k < wid * 128 + 128; ++k) {
            const float wv = wp[(size_t)k * (NMOD * D)];
#pragma unroll
            for (int r = 0; r < 5; ++r) acc[r] += sc[r * D + k] * wv;
        }
#pragma unroll
        for (int r = 0; r < 5; ++r) red[(wid * 5 + r) * 64 + lane] = acc[r];
        __syncthreads();
        if (tid < 320) { const int r = tid >> 6, cidx = tid & 63; float s = p.b_mod[l * NMOD * D + n0 + cidx];
#pragma unroll
            for (int w = 0; w < 8; ++w) s += red[(w * 5 + r) * 64 + cidx];
            p.mod[(size_t)(l * 5 + r) * (NMOD * D) + n0 + cidx] = s; }
        __syncthreads();
    }
}

__device__ __forceinline__ void norm_mod_store(const float4 (&v)[4], float rinv, const float* g, const float* scp, const float* shp, bf16_t* dst, int lane) {
#pragma unroll
    for (int i = 0; i < 4; ++i) {
        const int cidx = i * 256 + lane * 4;
        const float4 gv = *(const float4*)(g + cidx), sv = *(const float4*)(scp + cidx), hv = *(const float4*)(shp + cidx);
        const float h0 = v[i].x * rinv * gv.x * (1.f + sv.x) + hv.x, h1 = v[i].y * rinv * gv.y * (1.f + sv.y) + hv.y;
        const float h2 = v[i].z * rinv * gv.z * (1.f + sv.z) + hv.z, h3 = v[i].w * rinv * gv.w * (1.f + sv.w) + hv.w;
        u32x2 o; o[0] = pack2(h0, h1); o[1] = pack2(h2, h3);
        *(u32x2*)(dst + cidx) = o;
    }
}
__device__ __forceinline__ void ph_norm1_first(const Params& p) {
    const int tid = opaque_tid(), wid = tid >> 6, lane = tid & 63;
    for (int tok = blockIdx.x * NWAVES + wid; tok < NTOK; tok += gridDim.x * NWAVES) {
        const float* src = tok < NLAT ? p.x + (size_t)tok * D : p.ctx + (size_t)(tok - NLAT) * D;
        float4 v[4]; float ss = 0.f;
#pragma unroll
        for (int i = 0; i < 4; ++i) { v[i] = *(const float4*)(src + i * 256 + lane * 4); ss += v[i].x * v[i].x + v[i].y * v[i].y + v[i].z * v[i].z + v[i].w * v[i].w; }
        ss = wave_sum(ss, lane);
        const float rinv = rsqrtf(ss * (1.0f / D) + 1e-6f);
        const float* mb = p.mod + (size_t)(0 * 5 + tok_modrow(tok)) * (NMOD * D);
        norm_mod_store(v, rinv, p.norm1_g, mb + 1 * D, mb + 0 * D, p.H + (size_t)tok * D, lane);
#pragma unroll
        for (int i = 0; i < 4; ++i) *(float4*)(p.xl + (size_t)tok * D + i * 256 + lane * 4) = v[i];
    }
}

struct EpiP {
    bf16_t* O; bf16_t* gate;
    __device__ __forceinline__ bool keep(const g8::Unit&) const { return false; }
    __device__ __forceinline__ void operator()(const f32x4 (&acc)[2][2][4][2], const g8::Unit& u, int wr, int wc, int fr, int fq, const LAS float*) const {
        if (u.pn < 31) {
            const int row0 = u.pm * 256 + wr * 64 + fr, col0 = u.pn * 256 + wc * 32 + 8 * fq;
#pragma unroll
            for (int ai = 0; ai < 2; ++ai)
#pragma unroll
                for (int m = 0; m < 4; ++m) {
                    bf16_t* rowp = O + (size_t)(row0 + ai * 128 + m * 16) * NP + col0;
#pragma unroll
                    for (int bj = 0; bj < 2; ++bj) {
                        u32x4 w; w[0] = pack2(acc[ai][bj][m][0][0], acc[ai][bj][m][0][1]); w[1] = pack2(acc[ai][bj][m][0][2], acc[ai][bj][m][0][3]);
                        w[2] = pack2(acc[ai][bj][m][1][0], acc[ai][bj][m][1][1]); w[3] = pack2(acc[ai][bj][m][1][2], acc[ai][bj][m][1][3]);
                        *(u32x4*)(rowp + bj * 128) = w;
                    }
                }
        } else {
            const int g = u.pn - 31;
            bf16_t* gp = gate + ((((size_t)u.pm * 16 + g) * 8 + (wr * 4 + wc)) * 16) * 512 + (fq * 16 + fr) * 8;
#pragma unroll
            for (int ai = 0; ai < 2; ++ai)
#pragma unroll
                for (int m = 0; m < 4; ++m)
#pragma unroll
                    for (int bj = 0; bj < 2; ++bj) {
                        float s[8];
#pragma unroll
                        for (int n = 0; n < 2; ++n)
#pragma unroll
                            for (int j = 0; j < 4; ++j) s[n * 4 + j] = sigmoidf_(acc[ai][bj][m][n][j]);
                        *(u32x4*)(gp + (ai * 8 + m * 2 + bj) * 512) = pack8(s);
                    }
        }
    }
};
__device__ __forceinline__ void ph_g1(const Params& p, int l, LAS unsigned char* lds) {
    g8::PlainSched S; S.init(p.H, p.winT + (size_t)l * NPW * D, NTOK, NPW, D);
    EpiP E; E.O = p.P; E.gate = p.gate;
    g8::gemm_phase(lds, D, S, E);
}

__device__ __forceinline__ void ph_prep(const Params& p, int l, LAS unsigned char* lds) {
    const int tid = opaque_tid(), wid = tid >> 6, lane = tid & 63, fr = lane & 15, fq = lane >> 4;
    LAS float* xs = (LAS float*)lds;
    LAS bf16_t* xb = (LAS bf16_t*)(xs + 64 * 68);
    LAS bf16_t* wt = xb + 64 * 72;
    for (int it = blockIdx.x; it < (NTOK / 64) * 8; it += gridDim.x) {
        const int tile = it >> 3, n = it & 7, tok0 = tile * 64;
        {
            const int tl = tid & 63, cg = tid >> 6, tok = tok0 + tl;
            int t, T, base; tok_info(tok, t, T, base);
            float a[8];
            { const float4 b0 = *(const float4*)(p.lru_conv_b + l * MW + n * 64 + cg * 8), b1 = *(const float4*)(p.lru_conv_b + l * MW + n * 64 + cg * 8 + 4);
              a[0] = b0.x; a[1] = b0.y; a[2] = b0.z; a[3] = b0.w; a[4] = b1.x; a[5] = b1.y; a[6] = b1.z; a[7] = b1.w; }
#pragma unroll
            for (int j = 0; j < 4; ++j) {
                const int tt = t + j - 2;
                const float okf = (tt >= 0 && tt < T) ? 1.0f : 0.0f;
                const int ttc = tt < 0 ? 0 : (tt >= T ? T - 1 : tt);
                const u32x4 u = *(const u32x4*)(p.P + (size_t)(base + ttc) * NP + C_LX + n * 64 + cg * 8);
                const float* w = p.lru_conv_w + (size_t)(l * 4 + j) * MW + n * 64 + cg * 8;
                const float4 wa = *(const float4*)w, wb = *(const float4*)(w + 4);
                const float wv[8] = {wa.x * okf, wa.y * okf, wa.z * okf, wa.w * okf, wb.x * okf, wb.y * okf, wb.z * okf, wb.w * okf};
#pragma unroll
                for (int q = 0; q < 4; ++q) { a[2 * q] += wv[2 * q] * bflo(u[q]); a[2 * q + 1] += wv[2 * q + 1] * bfhi(u[q]); }
            }
            *(LAS f32x4*)(xs + tl * 68 + cg * 8) = (f32x4){a[0], a[1], a[2], a[3]}; *(LAS f32x4*)(xs + tl * 68 + cg * 8 + 4) = (f32x4){a[4], a[5], a[6], a[7]};
            *(LAS u32x4*)(xb + tl * 72 + cg * 8) = pack8(a);
            const bf16_t* wsrc = p.lruT + (size_t)((l * 8 + n) * 4) * 4096;
#pragma unroll
            for (int q = 0; q < 4; ++q) { const int e8 = tid + 512 * q, row = e8 >> 3, c8 = e8 & 7; *(LAS u32x4*)(wt + row * 72 + c8 * 8) = *(const u32x4*)(wsrc + (size_t)e8 * 8); }
        }
        __syncthreads();
        {
            const int jb = wid & 3, tb0 = (wid >> 2) * 2;
            bf16x8 xw[4][2];
#pragma unroll
            for (int m = 0; m < 4; ++m)
#pragma unroll
                for (int ks = 0; ks < 2; ++ks) xw[m][ks] = *(const LAS bf16x8*)(wt + (m * 64 + jb * 16 + fr) * 72 + ks * 32 + fq * 8);
            const int c0 = n * 64 + jb * 16 + 4 * fq;
            float4 bav[2], bxv[2], lsv[2];
#pragma unroll
            for (int d = 0; d < 2; ++d) {
                bav[d] = *(const float4*)(p.lru_ba + (l * 2 + d) * MW + c0); bxv[d] = *(const float4*)(p.lru_bx + (l * 2 + d) * MW + c0);
                lsv[d] = *(const float4*)(p.lsig + (l * 2 + d) * MW + c0);
            }
#pragma unroll
            for (int e = 0; e < 2; ++e) {
                const int tl = (tb0 + e) * 16 + fr, tok = tok0 + tl;
                f32x4 acc[4];
#pragma unroll
                for (int m = 0; m < 4; ++m) acc[m] = (f32x4){0.f, 0.f, 0.f, 0.f};
#pragma unroll
                for (int ks = 0; ks < 2; ++ks) {
                    const bf16x8 y = *(const LAS bf16x8*)(xb + tl * 72 + ks * 32 + fq * 8);
#pragma unroll
                    for (int m = 0; m < 4; ++m) acc[m] = mfma16(xw[m][ks], y, acc[m]);
                }
                const f32x4 xv = *(const LAS f32x4*)(xs + tl * 68 + jb * 16 + 4 * fq);
#pragma unroll
                for (int d = 0; d < 2; ++d) {
                    const float bar_[4] = {bav[d].x, bav[d].y, bav[d].z, bav[d].w}, bxr[4] = {bxv[d].x, bxv[d].y, bxv[d].z, bxv[d].w}, lsr[4] = {lsv[d].x, lsv[d].y, lsv[d].z, lsv[d].w};
                    float av[4], uv[4];
#pragma unroll
                    for (int r = 0; r < 4; ++r) {
                        const float gr = sigmoidf_(acc[d * 2][r] + bar_[r]), gi = sigmoidf_(acc[d * 2 + 1][r] + bxr[r]);
                        const float la = gr * lsr[r];
                        av[r] = __expf(la);
                        uv[r] = xv[r] * gi * __builtin_amdgcn_sqrtf(fmaxf(1.0f - __expf(2.0f * la), 1e-12f));
                    }
                    *(float4*)(p.prep + (PR_LA + d) * TOKW + (size_t)tok * MW + c0) = make_float4(av[0], av[1], av[2], av[3]);
                    *(float4*)(p.prep + (PR_LU + d) * TOKW + (size_t)tok * MW + c0) = make_float4(uv[0], uv[1], uv[2], uv[3]);
                }
            }
        }
        __syncthreads();
    }
}

__device__ __forceinline__ int chunk_base(int b, int d, int n) {
    if (n < 4) { const int blk = d ? 3 - n : n; return NLAT + b * TC + blk * 64; }
    const int m = n - 4, blk = d ? 63 - m : m; return b * TL + blk * 64;
}

__device__ __forceinline__ void local_gla(const Params& p, int l, int tz, int chain, int n, LAS unsigned char* lds) {
    const int tid = opaque_tid(), wid = tid >> 6, lane = tid & 63, fr = lane & 15, fq = lane >> 4;
    const int b = chain >> 3, h = (chain >> 1) & 3, d = chain & 1;
    const int base = chunk_base(b, d, n);
    const size_t item = (size_t)tz * NITEM + (size_t)chain * NCHUNK + n;
    LAS bf16_t* kraw = (LAS bf16_t*)lds;
    LAS bf16_t* qh = kraw + 64 * 136;
    LAS bf16_t* kh = qh + 64 * 136;
    LAS bf16_t* sc = kh + 64 * 136;
    LAS bf16_t* vT = sc + 64 * 72;
    LAS bf16_t* kT = vT + 128 * 72;
    LAS float* bc = (LAS float*)(kT + 128 * 72);
    const int vcol = tz == 1 ? C_HI : C_RQKV + 1024;
    const int ti = tid >> 3, dg = tid & 7, cA = dg * 8, cB = 64 + dg * 8;
    const int tokI = base + (d ? 63 - ti : ti);
    const bf16_t* pr = p.P + (size_t)tokI * NP;
    float qt[16];
    {
        float kv[16], lfv[16];
        if (tz == 1) {
            float lbv[16];
            {
                const float* lp0 = p.hgrn_lb + (size_t)(0 * 2 + d) * MW + h * 128; const float* lp1 = p.hgrn_lb + (size_t)(1 * 2 + d) * MW + h * 128;
                const float4 a0 = *(const float4*)(lp0 + cA), a1 = *(const float4*)(lp0 + cA + 4), a2 = *(const float4*)(lp0 + cB), a3 = *(const float4*)(lp0 + cB + 4);
                const float4 b0 = *(const float4*)(lp1 + cA), b1 = *(const float4*)(lp1 + cA + 4), b2 = *(const float4*)(lp1 + cB), b3 = *(const float4*)(lp1 + cB + 4);
                const float x0[16] = {a0.x, a0.y, a0.z, a0.w, a1.x, a1.y, a1.z, a1.w, a2.x, a2.y, a2.z, a2.w, a3.x, a3.y, a3.z, a3.w};
                const float x1[16] = {b0.x, b0.y, b0.z, b0.w, b1.x, b1.y, b1.z, b1.w, b2.x, b2.y, b2.z, b2.w, b3.x, b3.y, b3.z, b3.w};
#pragma unroll
                for (int e = 0; e < 16; ++e) lbv[e] = (l == 1) ? fminf(__builtin_amdgcn_rcpf(1.0f + __expf(x0[e] - x1[e])), 1.0f - 1e-4f) : 0.f;
            }
            const u32x4 uqa = *(const u32x4*)(pr + C_HQ + h * 128 + cA), uqb = *(const u32x4*)(pr + C_HQ + h * 128 + cB);
            const u32x4 uza = *(const u32x4*)(pr + C_HF + d * 512 + h * 128 + cA), uzb = *(const u32x4*)(pr + C_HF + d * 512 + h * 128 + cB);
#pragma unroll
            for (int e = 0; e < 16; ++e) {
                const unsigned uq = e < 8 ? uqa[(e & 7) >> 1] : uqb[(e & 7) >> 1], uz = e < 8 ? uza[(e & 7) >> 1] : uzb[(e & 7) >> 1];
                const float qraw = (e & 1) ? bfhi(uq) : bflo(uq), z = (e & 1) ? bfhi(uz) : bflo(uz);
                const float lb = lbv[e];
                const float sg = sigmoidf_(z);
                qt[e] = siluf_(qraw) * 0.08838834764831845f;
                kv[e] = (1.f - lb) * (1.f - sg);
                lfv[e] = __logf(fmaxf(lb + (1.f - lb) * sg, 1e-30f));
            }
        }
        *(LAS u32x4*)(kraw + ti * 136 + cA) = pack8(kv); *(LAS u32x4*)(kraw + ti * 136 + cB) = pack8(kv + 8);
        *(LAS f32x4*)(bc + ti * 132 + cA) = (f32x4){lfv[0], lfv[1], lfv[2], lfv[3]}; *(LAS f32x4*)(bc + ti * 132 + cA + 4) = (f32x4){lfv[4], lfv[5], lfv[6], lfv[7]};
        *(LAS f32x4*)(bc + ti * 132 + cB) = (f32x4){lfv[8], lfv[9], lfv[10], lfv[11]}; *(LAS f32x4*)(bc + ti * 132 + cB + 4) = (f32x4){lfv[12], lfv[13], lfv[14], lfv[15]};
        const bf16_t* vp = pr + vcol + h * 128;
        const u32x4 v0 = *(const u32x4*)(vp + cA), v1 = *(const u32x4*)(vp + cB);
#pragma unroll
        for (int e = 0; e < 8; ++e) {
            vT[(cA + e) * 72 + ti] = (bf16_t)((e & 1) ? (v0[e >> 1] >> 16) : (v0[e >> 1] & 0xffffu));
            vT[(cB + e) * 72 + ti] = (bf16_t)((e & 1) ? (v1[e >> 1] >> 16) : (v1[e >> 1] & 0xffffu));
        }
    }
    __syncthreads();
    if (tid < 128) {
        float run = 0.f, lv[64];
#pragma unroll
        for (int i = 0; i < 64; ++i) lv[i] = bc[i * 132 + tid];
#pragma unroll
        for (int i = 0; i < 64; ++i) { run += lv[i]; bc[i * 132 + tid] = run; }
    }
    __syncthreads();
    {
        const int I = ti >> 4;
        float qhat[16];
#pragma unroll
        for (int e = 0; e < 16; ++e) {
            const int ch = e < 8 ? cA + e : cB + e - 8;
            const float bi = bc[ti * 132 + ch], rI = I ? bc[(16 * I - 1) * 132 + ch] : 0.f, bl = bc[63 * 132 + ch];
            qhat[e] = qt[e] * __expf(bi - rI); qt[e] = qt[e] * __expf(bi);
            kT[ch * 72 + ti] = (bf16_t)f2bf(bf2f(kraw[ti * 136 + ch]) * __expf(bl - bi));
        }
        *(LAS u32x4*)(qh + ti * 136 + cA) = pack8(qhat); *(LAS u32x4*)(qh + ti * 136 + cB) = pack8(qhat + 8);
        {
            bf16_t* lqb = p.lq + item * 8192 + (size_t)((ti >> 4) * 8) * 256 + (ti & 15) * 4;
            const u32x4 pa = pack8(qt), pb = pack8(qt + 8);
            u32x2 t0; t0[0] = pa[0]; t0[1] = pa[1]; u32x2 t1; t1[0] = pa[2]; t1[1] = pa[3]; u32x2 t2; t2[0] = pb[0]; t2[1] = pb[1]; u32x2 t3; t3[0] = pb[2]; t3[1] = pb[3];
            *(u32x2*)(lqb + (dg >> 1) * 256 + ((dg & 1) * 2 + 0) * 64) = t0; *(u32x2*)(lqb + (dg >> 1) * 256 + ((dg & 1) * 2 + 1) * 64) = t1;
            *(u32x2*)(lqb + (4 + (dg >> 1)) * 256 + ((dg & 1) * 2 + 0) * 64) = t2; *(u32x2*)(lqb + (4 + (dg >> 1)) * 256 + ((dg & 1) * 2 + 1) * 64) = t3;
        }
    }
    if (tid < 128) p.ld[item * 128 + tid] = __expf(bc[63 * 132 + tid]);
    for (int I = 0; I < 4; ++I) {
        if (ti < 16 * (I + 1)) {
            float kk[16];
#pragma unroll
            for (int e = 0; e < 16; ++e) {
                const int ch = e < 8 ? cA + e : cB + e - 8;
                const float rI = I ? bc[(16 * I - 1) * 132 + ch] : 0.f, bj = bc[ti * 132 + ch];
                kk[e] = bf2f(kraw[ti * 136 + ch]) * __expf(fminf(rI - bj, 80.f));
            }
            *(LAS u32x4*)(kh + ti * 136 + cA) = pack8(kk); *(LAS u32x4*)(kh + ti * 136 + cB) = pack8(kk + 8);
        }
        __syncthreads();
        if (wid < 4) {
            const int J = wid;
            u32x2 outv; outv[0] = 0u; outv[1] = 0u;
            if (J <= I) {
                f32x4 acc = (f32x4){0.f, 0.f, 0.f, 0.f};
#pragma unroll
                for (int ks = 0; ks < 4; ++ks)
                    acc = mfma16(*(const LAS bf16x8*)(kh + (J * 16 + fr) * 136 + ks * 32 + fq * 8), *(const LAS bf16x8*)(qh + (I * 16 + fr) * 136 + ks * 32 + fq * 8), acc);
                const int i = 16 * I + fr, j0 = 16 * J + 4 * fq;
#pragma unroll
                for (int r = 0; r < 4; ++r) if (j0 + r > i) acc[r] = 0.f;
                outv = pack4(acc);
            }
            *(LAS u32x2*)(sc + (I * 16 + fr) * 72 + J * 16 + 4 * fq) = outv;
        }
        __syncthreads();
    }
    {
        bf16x8 xv[2], xk[2];
#pragma unroll
        for (int ks = 0; ks < 2; ++ks) { xv[ks] = *(const LAS bf16x8*)(vT + (wid * 16 + fr) * 72 + ks * 32 + fq * 8); xk[ks] = *(const LAS bf16x8*)(kT + (wid * 16 + fr) * 72 + ks * 32 + fq * 8); }
#pragma unroll
        for (int ib = 0; ib < 4; ++ib) {
            f32x4 acc = (f32x4){0.f, 0.f, 0.f, 0.f};
#pragma unroll
            for (int ks = 0; ks < 2; ++ks) acc = mfma16(xv[ks], *(const LAS bf16x8*)(sc + (ib * 16 + fr) * 72 + ks * 32 + fq * 8), acc);
            *(u32x2*)(p.lo + item * 8192 + ((wid * 4 + ib) * 64 + lane) * 4) = pack4(acc);
        }
#pragma unroll
        for (int dvb = 0; dvb < 8; ++dvb) {
            f32x4 acc = (f32x4){0.f, 0.f, 0.f, 0.f};
#pragma unroll
            for (int ks = 0; ks < 2; ++ks) acc = mfma16(xk[ks], *(const LAS bf16x8*)(vT + (dvb * 16 + fr) * 72 + ks * 32 + fq * 8), acc);
            *(u32x2*)(p.lb + item * 16384 + ((wid * 8 + dvb) * 64 + lane) * 4) = pack4(acc);
        }
    }
    __syncthreads();
}


template <int MODE> __device__ __forceinline__ void local_ret(const Params& p, int l, int chain, int n, LAS unsigned char* lds) {
    const int tid = opaque_tid(), wid = tid >> 6, lane = tid & 63, fr = lane & 15, fq = lane >> 4;
    const int b = chain >> 3, h = (chain >> 1) & 3, d = chain & 1;
    const int base = chunk_base(b, d, n);
    const size_t item = (size_t)2 * NITEM + (size_t)chain * NCHUNK + n;
    LAS bf16_t* ks_ = (LAS bf16_t*)lds;
    LAS bf16_t* qs = ks_ + 64 * 136;
    LAS bf16_t* sc = qs + 64 * 136;
    LAS bf16_t* vT = sc + 64 * 72;
    LAS bf16_t* kT = vT + 128 * 72;
    const int ti = tid >> 3, dg = tid & 7, cA = dg * 8, cB = 64 + dg * 8;
    const int tokI = base + (d ? 63 - ti : ti);
    const bf16_t* pr = p.P + (size_t)tokI * NP + C_RQKV + h * 128;
    const float lng = ret_log_gamma(h);
    {
        const u32x4 q1 = *(const u32x4*)(pr + cA), q2 = *(const u32x4*)(pr + cB), k1 = *(const u32x4*)(pr + 512 + cA), k2 = *(const u32x4*)(pr + 512 + cB);
        const u32x4 v0 = *(const u32x4*)(pr + 1024 + cA), v1 = *(const u32x4*)(pr + 1024 + cB);
        const bool lat = tokI < NLAT;
        const int t = tokI & (TL - 1);
        float qv[16], kv[16];
#pragma unroll
        for (int e = 0; e < 8; ++e) {
            float a1 = (e & 1) ? bfhi(q1[e >> 1]) : bflo(q1[e >> 1]), a2 = (e & 1) ? bfhi(q2[e >> 1]) : bflo(q2[e >> 1]);
            float b1 = (e & 1) ? bfhi(k1[e >> 1]) : bflo(k1[e >> 1]), b2 = (e & 1) ? bfhi(k2[e >> 1]) : bflo(k2[e >> 1]);
            {
                const float2 cst = p.rope[(size_t)t * 64 + cA + e];
                const float cs = lat ? cst.x : 1.0f, sn = lat ? cst.y : 0.0f;
                const float n1 = a1 * cs - a2 * sn, n2 = a1 * sn + a2 * cs, m1 = b1 * cs - b2 * sn, m2 = b1 * sn + b2 * cs;
                a1 = n1; a2 = n2; b1 = m1; b2 = m2;
            }
            qv[e] = a1; qv[8 + e] = a2; kv[e] = b1 * 0.08838834764831845f; kv[8 + e] = b2 * 0.08838834764831845f;
        }
        *(LAS u32x4*)(ks_ + ti * 136 + cA) = pack8(kv); *(LAS u32x4*)(ks_ + ti * 136 + cB) = pack8(kv + 8);
        *(LAS u32x4*)(qs + ti * 136 + cA) = pack8(qv); *(LAS u32x4*)(qs + ti * 136 + cB) = pack8(qv + 8);
        const float gq = __expf((float)(ti + 1) * lng), gk = __expf((float)(63 - ti) * lng);
#pragma unroll
        for (int e = 0; e < 8; ++e) {
            vT[(cA + e) * 72 + ti] = (bf16_t)((e & 1) ? (v0[e >> 1] >> 16) : (v0[e >> 1] & 0xffffu));
            vT[(cB + e) * 72 + ti] = (bf16_t)((e & 1) ? (v1[e >> 1] >> 16) : (v1[e >> 1] & 0xffffu));
            kT[(cA + e) * 72 + ti] = (bf16_t)f2bf(kv[e] * gk); kT[(cB + e) * 72 + ti] = (bf16_t)f2bf(kv[8 + e] * gk);
            qv[e] *= gq; qv[8 + e] *= gq;
        }
        {
            bf16_t* lqb = p.lq + item * 8192 + (size_t)((ti >> 4) * 8) * 256 + (ti & 15) * 4;
            const u32x4 pa = pack8(qv), pb = pack8(qv + 8);
            u32x2 t0; t0[0] = pa[0]; t0[1] = pa[1]; u32x2 t1; t1[0] = pa[2]; t1[1] = pa[3]; u32x2 t2; t2[0] = pb[0]; t2[1] = pb[1]; u32x2 t3; t3[0] = pb[2]; t3[1] = pb[3];
            *(u32x2*)(lqb + (dg >> 1) * 256 + ((dg & 1) * 2 + 0) * 64) = t0; *(u32x2*)(lqb + (dg >> 1) * 256 + ((dg & 1) * 2 + 1) * 64) = t1;
            *(u32x2*)(lqb + (4 + (dg >> 1)) * 256 + ((dg & 1) * 2 + 0) * 64) = t2; *(u32x2*)(lqb + (4 + (dg >> 1)) * 256 + ((dg & 1) * 2 + 1) * 64) = t3;
        }
    }
    if (tid < 128) p.ld[item * 128 + tid] = __expf(64.0f * lng);
    __syncthreads();
#pragma unroll
    for (int e = 0; e < 2; ++e) {
        const int f = wid * 2 + e, ib = f >> 2, jb = f & 3;
        const int i = 16 * ib + fr, j0 = 16 * jb + 4 * fq;
        f32x4 mq = (f32x4){0.f, 0.f, 0.f, 0.f};
        if (jb <= ib) {
#pragma unroll
            for (int ks = 0; ks < 4; ++ks)
                mq = mfma16(*(const LAS bf16x8*)(ks_ + (jb * 16 + fr) * 136 + ks * 32 + fq * 8), *(const LAS bf16x8*)(qs + i * 136 + ks * 32 + fq * 8), mq);
#pragma unroll
            for (int r = 0; r < 4; ++r) { const int j = j0 + r; mq[r] = (j <= i) ? mq[r] * __expf((float)(i - j) * lng) : 0.f; }
        }
        *(LAS u32x2*)(sc + i * 72 + j0) = pack4(mq);
    }
    __syncthreads();
    {
        bf16x8 xv[2], xk[2];
#pragma unroll
        for (int ks = 0; ks < 2; ++ks) { xv[ks] = *(const LAS bf16x8*)(vT + (wid * 16 + fr) * 72 + ks * 32 + fq * 8); xk[ks] = *(const LAS bf16x8*)(kT + (wid * 16 + fr) * 72 + ks * 32 + fq * 8); }
#pragma unroll
        for (int ib = 0; ib < 4; ++ib) {
            f32x4 acc = (f32x4){0.f, 0.f, 0.f, 0.f};
#pragma unroll
            for (int ks = 0; ks < 2; ++ks) acc = mfma16(xv[ks], *(const LAS bf16x8*)(sc + (ib * 16 + fr) * 72 + ks * 32 + fq * 8), acc);
            *(u32x2*)(p.lo + item * 8192 + ((wid * 4 + ib) * 64 + lane) * 4) = pack4(acc);
        }
#pragma unroll
        for (int dvb = 0; dvb < 8; ++dvb) {
            f32x4 acc = (f32x4){0.f, 0.f, 0.f, 0.f};
#pragma unroll
            for (int ks = 0; ks < 2; ++ks) acc = mfma16(xk[ks], *(const LAS bf16x8*)(vT + (dvb * 16 + fr) * 72 + ks * 32 + fq * 8), acc);
            *(u32x2*)(p.lb + item * 16384 + ((wid * 8 + dvb) * 64 + lane) * 4) = pack4(acc);
        }
    }
    __syncthreads();
}

template <int I> struct SolveRows {
    static __device__ __forceinline__ void run(float (&x)[64], const LAS float* Mf, const LAS float* rs) {
        SolveRows<I - 1>::run(x, Mf, rs);
        float r = x[I] * rs[I];
        float pa[4] = {0.f, 0.f, 0.f, 0.f};
#pragma unroll
        for (int j4 = 0; j4 < (I + 3) / 4; ++j4) {
            const f32x4 m = *(const LAS f32x4*)(Mf + I * 68 + j4 * 4);
            pa[0] += m[0] * x[j4 * 4]; pa[1] += m[1] * x[j4 * 4 + 1]; pa[2] += m[2] * x[j4 * 4 + 2]; pa[3] += m[3] * x[j4 * 4 + 3];
        }
        r -= (pa[0] + pa[1]) + (pa[2] + pa[3]);
        asm volatile("" : "+v"(r) :: "memory");
        x[I] = r;
    }
};
template <> struct SolveRows<-1> { static __device__ __forceinline__ void run(float (&)[64], const LAS float*, const LAS float*) {} };

__device__ __forceinline__ void local_gdn(const Params& p, int l, int chain, int n, LAS unsigned char* lds) {
    const int tid = opaque_tid(), wid = tid >> 6, lane = tid & 63, fr = lane & 15, fq = lane >> 4;
    const int b = chain >> 3, h = (chain >> 1) & 3, d = chain & 1;
    const int base = chunk_base(b, d, n);
    const size_t item = (size_t)chain * NCHUNK + n;
    LAS bf16_t* ks_ = (LAS bf16_t*)lds;
    LAS bf16_t* qs = ks_ + 64 * 136;
    LAS bf16_t* att = qs + 64 * 136;
    LAS bf16_t* wT = att + 64 * 72;
    LAS bf16_t* uT = wT + 128 * 72;
    LAS bf16_t* kT = uT + 128 * 72;
    LAS float* Mf = (LAS float*)(kT + 128 * 72);
    LAS float* bcs = Mf + 64 * 68;
    LAS float* bts = bcs + 64;
    LAS float* rse = bts + 64;
    LAS bf16_t* vs = (LAS bf16_t*)(rse + 64);
    LAS float* cw = (LAS float*)(vs + 64 * 136);
    const int ti = tid >> 3, d0 = (tid & 7) * 16;
    const int tokI = base + (d ? 63 - ti : ti);
    {
        int t, T, sbase; tok_info(tokI, t, T, sbase);
        u32x4 xr[3][4][2];
#pragma unroll
        for (int j = 0; j < 4; ++j) {
            const int tt = t + j - 2;
            const bool ok = (tt >= 0 && tt < T);
            const int ttc = tt < 0 ? 0 : (tt >= T ? T - 1 : tt);
            const bf16_t* xp = p.P + (size_t)(sbase + ttc) * NP + C_GQKV + h * 128 + d0;
#pragma unroll
            for (int part = 0; part < 3; ++part) {
                const u32x4 a0 = *(const u32x4*)(xp + part * 512), a1 = *(const u32x4*)(xp + part * 512 + 8);
#pragma unroll
                for (int q = 0; q < 4; ++q) { xr[part][j][0][q] = ok ? a0[q] : 0u; xr[part][j][1][q] = ok ? a1[q] : 0u; }
            }
        }
        if (tid < 384) {
            const int row = tid >> 5, c4 = (tid & 31) * 4, part = row >> 2, j = row & 3;
            *(LAS f32x4*)(cw + row * 128 + c4) = *(const f32x4*)(p.gdn_conv_w + (size_t)(l * 4 + j) * 1536 + part * 512 + h * 128 + c4);
        }
        __syncthreads();
#pragma unroll
        for (int part = 0; part < 3; ++part) {
            float a[16];
#pragma unroll
            for (int e = 0; e < 16; ++e) a[e] = 0.f;
#pragma unroll
            for (int j = 0; j < 4; ++j) {
                const u32x4 x0 = xr[part][j][0], x1 = xr[part][j][1];
                const LAS float* wp = cw + (part * 4 + j) * 128 + d0;
#pragma unroll
                for (int q = 0; q < 4; ++q) {
                    const f32x4 w0 = *(const LAS f32x4*)(wp + q * 4);
                    const unsigned ua = q < 2 ? x0[2 * q] : x1[2 * q - 4], ub = q < 2 ? x0[2 * q + 1] : x1[2 * q - 3];
                    a[q * 4] += w0[0] * bflo(ua); a[q * 4 + 1] += w0[1] * bfhi(ua); a[q * 4 + 2] += w0[2] * bflo(ub); a[q * 4 + 3] += w0[3] * bfhi(ub);
                }
            }
            float ss = 0.f;
#pragma unroll
            for (int e = 0; e < 16; ++e) { a[e] = siluf_(a[e]); ss += a[e] * a[e]; }
            if (part < 2) {
                ss += shx(ss, 1, lane); ss += shx(ss, 2, lane); ss += shx(ss, 4, lane);
                const float scl = rsqrtf(ss + 1e-6f) * (part == 0 ? 0.08838834764831845f : 1.0f);
#pragma unroll
                for (int e = 0; e < 16; ++e) a[e] *= scl;
            }
            LAS bf16_t* dstt = (part == 0 ? qs : part == 1 ? ks_ : vs) + ti * 136 + d0;
            *(LAS u32x4*)dstt = pack8(a); *(LAS u32x4*)(dstt + 8) = pack8(a + 8);
        }
    }
    if (wid == 0) {
        const int tok = base + (d ? 63 - lane : lane);
        const float av = bf2f(p.P[(size_t)tok * NP + C_GA + d * 4 + h]);
        float v = -__expf(p.gdn_a_log[l * 8 + d * 4 + h]) * softplusf_(av + p.gdn_dt_bias[l * 8 + d * 4 + h]);
#pragma unroll
        for (int off = 1; off < 64; off <<= 1) { const float t = shup(v, off, lane); if (lane >= off) v += t; }
        const float btv = sigmoidf_(bf2f(p.P[(size_t)tok * NP + C_GB + d * 4 + h]));
        bcs[lane] = v; bts[lane] = btv; rse[lane] = btv * __expf(v);
    }
    __syncthreads();
#pragma unroll
    for (int e = 0; e < 2; ++e) {
        const int f = wid * 2 + e, ib = f >> 2, jb = f & 3;
        const int i = 16 * ib + fr, j0 = 16 * jb + 4 * fq;
        f32x4 mk = (f32x4){0.f, 0.f, 0.f, 0.f}, mq = (f32x4){0.f, 0.f, 0.f, 0.f};
        if (jb <= ib) {
#pragma unroll
            for (int ks = 0; ks < 4; ++ks) {
                const bf16x8 xk = *(const LAS bf16x8*)(ks_ + (jb * 16 + fr) * 136 + ks * 32 + fq * 8);
                mk = mfma16(xk, *(const LAS bf16x8*)(ks_ + (ib * 16 + fr) * 136 + ks * 32 + fq * 8), mk);
                mq = mfma16(xk, *(const LAS bf16x8*)(qs + (ib * 16 + fr) * 136 + ks * 32 + fq * 8), mq);
            }
            const float bi = bcs[i], bti = bts[i];
#pragma unroll
            for (int r = 0; r < 4; ++r) {
                const int j = j0 + r;
                const float dec = __expf(j <= i ? bi - bcs[j] : 0.f);
                mk[r] = (j < i) ? bti * mk[r] * dec : 0.f;
                mq[r] = (j <= i) ? mq[r] * dec : 0.f;
            }
        }
        *(LAS f32x4*)(Mf + i * 68 + j0) = mk;
        *(LAS u32x2*)(att + i * 72 + j0) = pack4(mq);
    }
    __syncthreads();
    {
        const float sc_ = __expf(bcs[63] - bcs[ti]);
#pragma unroll
        for (int e = 0; e < 16; ++e) kT[(d0 + e) * 72 + ti] = (bf16_t)f2bf(bf2f(ks_[ti * 136 + d0 + e]) * sc_);
    }
    if (tid < 256) {
        const int cidx = tid & 127;
        const bool isw = tid >= 128;
        const LAS bf16_t* srcp = (isw ? ks_ : vs) + cidx;
        float x[64];
#pragma unroll
        for (int i = 0; i < 64; ++i) x[i] = bf2f(srcp[i * 136]);
        {
            unsigned mb = (unsigned)(size_t)Mf, rb = (unsigned)(size_t)(isw ? rse : bts);
            asm volatile("" : "+v"(mb), "+v"(rb));
            SolveRows<63>::run(x, (const LAS float*)(size_t)mb, (const LAS float*)(size_t)rb);
        }
        if (isw) {
#pragma unroll
            for (int i = 0; i < 64; ++i) x[i] = -x[i];
        }
        LAS bf16_t* dst = (isw ? wT : uT) + cidx * 72;
#pragma unroll
        for (int q = 0; q < 8; ++q) *(LAS u32x4*)(dst + q * 8) = pack8(x + q * 8);
    }
    if (tid < 128) p.ld[item * 128 + tid] = __expf(bcs[63]);
    __syncthreads();
    {
        const int tid = opaque_tid(), wid = tid >> 6, lane = tid & 63, fr = lane & 15, fq = lane >> 4;
        bf16x8 xw[2], xu[2], xk[2];
#pragma unroll
        for (int ks = 0; ks < 2; ++ks) {
            xw[ks] = *(const LAS bf16x8*)(wT + (wid * 16 + fr) * 72 + ks * 32 + fq * 8);
            xu[ks] = *(const LAS bf16x8*)(uT + (wid * 16 + fr) * 72 + ks * 32 + fq * 8);
            xk[ks] = *(const LAS bf16x8*)(kT + (wid * 16 + fr) * 72 + ks * 32 + fq * 8);
        }
#pragma unroll
        for (int ib = 0; ib < 4; ++ib) {
            const int i = ib * 16 + fr;
            const u32x2 qr = *(const LAS u32x2*)(qs + i * 136 + wid * 16 + 4 * fq);
            const float eb = __expf(bcs[i]);
            f32x4 aq = (f32x4){bflo(qr[0]) * eb, bfhi(qr[0]) * eb, bflo(qr[1]) * eb, bfhi(qr[1]) * eb};
            f32x4 ao = (f32x4){0.f, 0.f, 0.f, 0.f};
#pragma unroll
            for (int ks = 0; ks < 2; ++ks) {
                const bf16x8 ya = *(const LAS bf16x8*)(att + i * 72 + ks * 32 + fq * 8);
                aq = mfma16(xw[ks], ya, aq); ao = mfma16(xu[ks], ya, ao);
            }
            *(u32x2*)(p.lq + item * 8192 + ((ib * 8 + wid) * 64 + lane) * 4) = pack4(aq);
            *(u32x2*)(p.lo + item * 8192 + ((wid * 4 + ib) * 64 + lane) * 4) = pack4(ao);
        }
#pragma unroll
        for (int db = 0; db < 8; ++db) {
            f32x4 aa = (f32x4){0.f, 0.f, 0.f, 0.f}, ab = (f32x4){0.f, 0.f, 0.f, 0.f};
#pragma unroll
            for (int ks = 0; ks < 2; ++ks) {
                aa = mfma16(xw[ks], *(const LAS bf16x8*)(kT + (db * 16 + fr) * 72 + ks * 32 + fq * 8), aa);
                ab = mfma16(xk[ks], *(const LAS bf16x8*)(uT + (db * 16 + fr) * 72 + ks * 32 + fq * 8), ab);
            }
            *(u32x2*)(p.la + item * 16384 + ((db * 8 + wid) * 64 + lane) * 4) = pack4(aa);
            *(u32x2*)(p.lb + item * 16384 + ((wid * 8 + db) * 64 + lane) * 4) = pack4(ab);
        }
    }
    __syncthreads();
}

__device__ __forceinline__ void ph_local(const Params& p, int l, LAS unsigned char* lds) {
    for (int it = blockIdx.x; it < 3 * NITEM; it += gridDim.x) {
        const int tz = it % 3, ci = it / 3, chain = ci / NCHUNK, n = ci % NCHUNK;
        if (tz == 0) local_gdn(p, l, chain, n, lds); else if (tz == 1) local_gla(p, l, tz, chain, n, lds); else local_ret<0>(p, l, chain, n, lds);
    }
}

__device__ __forceinline__ void seq_matrix(const Params& p, int tz, int chain, int half, LAS unsigned char* lds) {
    const int tid = opaque_tid(), wid = tid >> 6, lane = tid & 63, fr = lane & 15, fq = lane >> 4;
    const int b = chain >> 3, h = (chain >> 1) & 3, d = chain & 1;
    LAS bf16_t* ST = (LAS bf16_t*)lds;
    bf16_t* Op = p.O + (size_t)((tz == 0 ? 0 : tz == 1 ? 1 : 3) * 2 + d) * TOKW;
    f32x4 S[4];
#pragma unroll
    for (int q = 0; q < 4; ++q) S[q] = (f32x4){0.f, 0.f, 0.f, 0.f};
    const int ib = wid >> 1, dv2 = (wid & 1) * 2;
    struct Ops { u32x2 yq[8], xa[8], oin[2], bin[4]; f32x4 dec; };
    auto load_ops = [&](int n, Ops& o) {
        const size_t item = (size_t)tz * NITEM + (size_t)chain * NCHUNK + n;
        const bf16_t* lqp = p.lq + item * 8192 + (size_t)(ib * 8) * 256 + lane * 4;
#pragma unroll
        for (int q = 0; q < 8; ++q) o.yq[q] = *(const u32x2*)(lqp + q * 256);
        if (tz == 0) {
            const bf16_t* lap = p.la + ((size_t)chain * NCHUNK + n) * 16384 + (size_t)(wid * 8) * 256 + lane * 4;
#pragma unroll
            for (int q = 0; q < 8; ++q) o.xa[q] = *(const u32x2*)(lap + q * 256);
        }
#pragma unroll
        for (int e2 = 0; e2 < 2; ++e2)
            o.oin[e2] = *(const u32x2*)(p.lo + item * 8192 + (((half * 4 + dv2 + (fq >> 1)) * 4 + ib) * 64 + fr + 16 * (2 * (fq & 1) + e2)) * 4);
#pragma unroll
        for (int q = 0; q < 4; ++q) o.bin[q] = *(const u32x2*)(p.lb + item * 16384 + ((wid * 8 + half * 4 + q) * 64 + lane) * 4);
        o.dec = *(const f32x4*)(p.ld + item * 128 + wid * 16 + 4 * fq);
    };
    Ops s0, s1; load_ops(0, s0);
    auto step = [&](int n, Ops& cur, Ops& fill) {
        load_ops(n + 1 < NCHUNK ? n + 1 : n, fill);
        LAS bf16_t* st = ST + (n & 1) * 64 * 136;
#pragma unroll
        for (int q = 0; q < 4; ++q) *(LAS u32x2*)(st + (q * 16 + fr) * 136 + 32 * (wid >> 1) + 8 * fq + 4 * (wid & 1)) = pack4(S[q]);
        __syncthreads();
        const int base = chunk_base(b, d, n);
        const int tok = base + (d ? 63 - (ib * 16 + fr) : ib * 16 + fr);
        {
            bf16x8 xo[2][4];
#pragma unroll
            for (int e2 = 0; e2 < 2; ++e2) {
                const int prow = dv2 * 16 + 8 * (fr >> 2) + 4 * e2 + (fr & 3);
#pragma unroll
                for (int ks = 0; ks < 4; ++ks) xo[e2][ks] = *(const LAS bf16x8*)(st + prow * 136 + ks * 32 + fq * 8);
            }
            asm volatile("s_waitcnt lgkmcnt(0)" ::: "memory");
            f32x4 ao[2];
#pragma unroll
            for (int e2 = 0; e2 < 2; ++e2) {
                f32x4 acc = (f32x4){bflo(cur.oin[e2][0]), bfhi(cur.oin[e2][0]), bflo(cur.oin[e2][1]), bfhi(cur.oin[e2][1])};
#pragma unroll
                for (int ks = 0; ks < 4; ++ks) {
                    u32x4 t; t[0] = cur.yq[2 * ks][0]; t[1] = cur.yq[2 * ks][1]; t[2] = cur.yq[2 * ks + 1][0]; t[3] = cur.yq[2 * ks + 1][1];
                    acc = mfma16(xo[e2][ks], __builtin_bit_cast(bf16x8, t), acc);
                }
                ao[e2] = acc;
            }
            bf16_t* op = Op + (size_t)tok * MW + h * 128 + half * 64 + dv2 * 16 + 8 * fq;
            { u32x4 w; w[0] = pack2(ao[0][0], ao[0][1]); w[1] = pack2(ao[0][2], ao[0][3]); w[2] = pack2(ao[1][0], ao[1][1]); w[3] = pack2(ao[1][2], ao[1][3]); *(u32x4*)op = w; }
#pragma unroll
            for (int qh = 0; qh < 2; ++qh) {
                bf16x8 xs[2][4];
                if (tz == 0) {
#pragma unroll
                    for (int q2 = 0; q2 < 2; ++q2)
#pragma unroll
                        for (int ks = 0; ks < 4; ++ks) xs[q2][ks] = *(const LAS bf16x8*)(st + ((qh * 2 + q2) * 16 + fr) * 136 + ks * 32 + fq * 8);
                    asm volatile("s_waitcnt lgkmcnt(0)" ::: "memory");
                }
#pragma unroll
                for (int q2 = 0; q2 < 2; ++q2) {
                    const int q = qh * 2 + q2;
                    f32x4 acc = (f32x4){cur.dec[0] * S[q][0] + bflo(cur.bin[q][0]), cur.dec[1] * S[q][1] + bfhi(cur.bin[q][0]), cur.dec[2] * S[q][2] + bflo(cur.bin[q][1]), cur.dec[3] * S[q][3] + bfhi(cur.bin[q][1])};
                    if (tz == 0) {
#pragma unroll
                        for (int ks = 0; ks < 4; ++ks) {
                            u32x4 t; t[0] = cur.xa[2 * ks][0]; t[1] = cur.xa[2 * ks][1]; t[2] = cur.xa[2 * ks + 1][0]; t[3] = cur.xa[2 * ks + 1][1];
                            acc = mfma16(__builtin_bit_cast(bf16x8, t), xs[q2][ks], acc);
                        }
                    }
                    S[q] = acc;
                }
            }
        }
    };
    for (int n = 0; n < NCHUNK; n += 2) {
        step(n, s0, s1);
        step(n + 1, s1, s0);
    }
    __syncthreads();
}

__device__ __forceinline__ void seq_lru(const Params& p, int b, int d, int cg, LAS unsigned char* lds) {
    const int tid = opaque_tid(), seg = tid >> 6, ch = cg * 64 + (tid & 63);
    LAS float* sP = (LAS float*)lds;
    LAS float* sL = sP + 512;
    const float* A = p.prep + (size_t)(PR_LA + d) * TOKW + ch; const float* U = p.prep + (size_t)(PR_LU + d) * TOKW + ch;
    bf16_t* Op = p.O + (size_t)(2 * 2 + d) * TOKW + ch;
    constexpr int SEG = (TC + TL) / 8;
    auto tok_of = [&](int pos) { return pos < TC ? NLAT + b * TC + (d ? TC - 1 - pos : pos) : b * TL + (d ? TL - 1 - (pos - TC) : pos - TC); };
    float P = 1.f, L = 0.f;
    for (int i0 = 0; i0 < SEG; i0 += 32) {
        float av[32], uv[32];
#pragma unroll
        for (int q = 0; q < 32; ++q) { const size_t o = (size_t)tok_of(seg * SEG + i0 + q) * MW; av[q] = A[o]; uv[q] = U[o]; }
#pragma unroll
        for (int q = 0; q < 32; ++q) { L = av[q] * L + uv[q]; P *= av[q]; }
    }
    sP[tid] = P; sL[tid] = L;
    __syncthreads();
    float hst = 0.f;
    for (int s = 0; s < seg; ++s) hst = sP[s * 64 + (tid & 63)] * hst + sL[s * 64 + (tid & 63)];
    for (int i0 = 0; i0 < SEG; i0 += 32) {
        float av[32], uv[32];
#pragma unroll
        for (int q = 0; q < 32; ++q) { const size_t o = (size_t)tok_of(seg * SEG + i0 + q) * MW; av[q] = A[o]; uv[q] = U[o]; }
#pragma unroll
        for (int q = 0; q < 32; ++q) { hst = av[q] * hst + uv[q]; Op[(size_t)tok_of(seg * SEG + i0 + q) * MW] = (bf16_t)f2bf(hst); }
    }
    __syncthreads();
}

__device__ __forceinline__ void ph_seq(const Params& p, LAS unsigned char* lds) {
    for (int it = blockIdx.x; it < 256; it += gridDim.x) {
        if (it < 192) { const int tz = it >> 6, r = it & 63; seq_matrix(p, tz, r >> 1, r & 1, lds); }
        else { const int r = it - 192; seq_lru(p, r >> 4, (r >> 3) & 1, r & 7, lds); }
    }
}

__device__ __forceinline__ void ph_merge(const Params& p, int l, int M) {
    const int tid = opaque_tid(), wid = tid >> 6, lane = tid & 63;
    const bf16_t* Ob = opaque_sptr(p.O); const bf16_t* Pb = opaque_sptr(p.P); bf16_t* Yb = opaque_sptr(p.Y);
    float2 gn[3];
#pragma unroll
    for (int m = 0; m < 3; ++m) gn[m] = *(const float2*)((m == 0 ? p.gdn_norm_g : m == 1 ? p.hgrn_norm_g : p.ret_norm_g) + l * 128 + lane * 2);
    for (int tok = blockIdx.x * NWAVES + wid; tok < M; tok += gridDim.x * NWAVES) {
        unsigned o0[16], o1[16], gz[16];
#pragma unroll
        for (int r = 0; r < 16; ++r) {
            const int m = r >> 2, head = r & 3, cidx = head * 128 + lane * 2;
            const size_t o = (size_t)tok * MW + cidx;
            o0[r] = *(const unsigned*)(Ob + (size_t)(m * 2) * TOKW + o); o1[r] = *(const unsigned*)(Ob + (size_t)(m * 2 + 1) * TOKW + o);
            const int zc = m == 0 ? C_GZ : m == 1 ? C_HG : m == 2 ? C_LY : C_RG;
            gz[r] = *(const unsigned*)(Pb + (size_t)tok * NP + zc + cidx);
        }
        float a0[16], a1[16], ss[16];
#pragma unroll
        for (int r = 0; r < 16; ++r) { a0[r] = bflo(o0[r]) + bflo(o1[r]); a1[r] = bfhi(o0[r]) + bfhi(o1[r]); ss[r] = a0[r] * a0[r] + a1[r] * a1[r]; }
#pragma unroll
        for (int msk = 32; msk >= 1; msk >>= 1)
#pragma unroll
            for (int r = 0; r < 16; ++r) if ((r >> 2) != 2) ss[r] += shx(ss[r], msk, lane);
#pragma unroll
        for (int r = 0; r < 16; ++r) {
            const int m = r >> 2, head = r & 3, cidx = head * 128 + lane * 2;
            float y0, y1; int nbr;
            if (m == 2) { y0 = a0[r] * gelu_tanhf_(bflo(gz[r])); y1 = a1[r] * gelu_tanhf_(bfhi(gz[r])); nbr = 2; }
            else {
                const float rinv = rsqrtf(ss[r] * (1.0f / 128.0f) + 1e-6f);
                const float2 g = gn[m == 3 ? 2 : m];
                y0 = a0[r] * rinv * g.x * siluf_(bflo(gz[r])); y1 = a1[r] * rinv * g.y * siluf_(bfhi(gz[r])); nbr = m == 3 ? 3 : m;
            }
            *(unsigned*)(Yb + (size_t)nbr * TOKW + (size_t)tok * MW + cidx) = pack2(y0, y1);
        }
    }
}

struct G2Sched {
    const bf16_t* Y; const bf16_t* Wb; int ntiles, G, c;
    static constexpr bool HAS_BIAS = false, gather = false;
    __device__ __forceinline__ bool next(int i, g8::Unit& u) const {
        const int tile = (i >> 2) * G + c; if (tile >= ntiles) return false;
        u.pm = tile >> 2; u.pn = tile & 3; u.e = i & 3; return true;
    }
    __device__ __forceinline__ const char* a_base(const g8::Unit& u) const { return (const char*)(Y + (size_t)u.e * TOKW + (size_t)u.pm * 256 * MW); }
    __device__ __forceinline__ const char* b_base(const g8::Unit& u) const { return (const char*)(Wb + (size_t)u.e * D * MW + (size_t)u.pn * 256 * MW); }
    __device__ __forceinline__ const int* row_addr(const g8::Unit&, int) const { return nullptr; }
    __device__ __forceinline__ int rows_valid(const g8::Unit&) const { return 256; }
    __device__ __forceinline__ const float* bias_src(const g8::Unit&, int) const { return nullptr; }
};
struct EpiMix {
    const bf16_t* gate; bf16_t* O;
    __device__ __forceinline__ bool keep(const g8::Unit& u) const { return u.e < 3; }
    __device__ __forceinline__ void operator()(f32x4 (&acc)[2][2][4][2], const g8::Unit& u, int wr, int wc, int fr, int fq, const LAS float*) const {
        const int row0 = u.pm * 256 + wr * 64 + fr, col0 = u.pn * 256 + wc * 32 + 8 * fq;
        const bool lastseg = u.e == 3;
        const bf16_t* gc = gate + ((((size_t)u.pm * 16 + u.e * 4 + u.pn) * 8 + (wr * 4 + wc)) * 16) * 512 + (fq * 16 + fr) * 8;
        const bf16_t* gn = gc + (lastseg ? 0 : (size_t)4 * 8 * 16 * 512);
#pragma unroll
        for (int ah = 0; ah < 4; ++ah) {
            const int ai = ah >> 1;
            u32x4 c[4], x[4];
#pragma unroll
            for (int q = 0; q < 4; ++q) { c[q] = *(const u32x4*)(gc + (ah * 4 + q) * 512); x[q] = *(const u32x4*)(gn + (ah * 4 + q) * 512); }
#pragma unroll
            for (int q = 0; q < 4; ++q) {
                const int m = (ah & 1) * 2 + (q >> 1), bj = q & 1;
#pragma unroll
                for (int w = 0; w < 4; ++w) {
                    const float c0 = bflo(c[q][w]), c1 = bfhi(c[q][w]);
                    const float s0 = lastseg ? c0 : c0 * __builtin_amdgcn_rcpf(bflo(x[q][w])), s1 = lastseg ? c1 : c1 * __builtin_amdgcn_rcpf(bfhi(x[q][w]));
                    acc[ai][bj][m][w >> 1][(w & 1) * 2] *= s0; acc[ai][bj][m][w >> 1][(w & 1) * 2 + 1] *= s1;
                }
            }
        }
        if (lastseg) {
#pragma unroll
            for (int ai = 0; ai < 2; ++ai)
#pragma unroll
                for (int m = 0; m < 4; ++m)
#pragma unroll
                    for (int bj = 0; bj < 2; ++bj) {
                        u32x4 w; w[0] = pack2(acc[ai][bj][m][0][0], acc[ai][bj][m][0][1]); w[1] = pack2(acc[ai][bj][m][0][2], acc[ai][bj][m][0][3]);
                        w[2] = pack2(acc[ai][bj][m][1][0], acc[ai][bj][m][1][1]); w[3] = pack2(acc[ai][bj][m][1][2], acc[ai][bj][m][1][3]);
                        *(u32x4*)(O + (size_t)(row0 + ai * 128 + m * 16) * D + col0 + bj * 128) = w;
                    }
        }
    }
};
__device__ __forceinline__ void ph_g2(const Params& p, int l, int M, LAS unsigned char* lds) {
    G2Sched S; S.Y = p.Y; S.Wb = p.wbT + (size_t)l * 4 * D * MW; S.ntiles = (M / 256) * 4; S.G = gridDim.x; S.c = blockIdx.x;
    EpiMix E; E.gate = p.gate; E.O = p.mix;
    g8::gemm_phase(lds, MW, S, E);
}

template <bool DRY> struct EpiRes {
    float* xl; float* xo; const float* mod;
    __device__ __forceinline__ bool keep(const g8::Unit&) const { return false; }
    __device__ __forceinline__ void operator()(const f32x4 (&acc)[2][2][4][2], const g8::Unit& u, int wr, int wc, int fr, int fq, const LAS float*) const {
        const int row0 = u.pm * 256 + wr * 64 + fr, col0 = u.pn * 256 + wc * 32 + 8 * fq;
#pragma unroll
        for (int ai = 0; ai < 2; ++ai)
#pragma unroll
            for (int m = 0; m < 4; ++m) {
                const int row = row0 + ai * 128 + m * 16;
                const float* gtp = mod + (size_t)tok_modrow(row) * (NMOD * D) + 2 * D + col0;
#pragma unroll
                for (int bj = 0; bj < 2; ++bj)
#pragma unroll
                    for (int n = 0; n < 2; ++n) {
                        const float4 gt = *(const float4*)(gtp + bj * 128 + n * 4);
                        const size_t o = (size_t)row * D + col0 + bj * 128 + n * 4;
                        float4 xv = *(const float4*)(xl + o);
                        xv.x += gt.x * acc[ai][bj][m][n][0]; xv.y += gt.y * acc[ai][bj][m][n][1]; xv.z += gt.z * acc[ai][bj][m][n][2]; xv.w += gt.w * acc[ai][bj][m][n][3];
                        *(float4*)(xo + o) = xv;
                    }
            }
    }
};
template <bool DRY = false> __device__ __forceinline__ void ph_g3(const Params& p, int l, int M, LAS unsigned char* lds) {
    g8::PlainSched S; S.init(p.mix, p.woutT + (size_t)l * D * D, M, D, D);
    EpiRes<DRY> E; E.xl = p.xl; E.xo = DRY ? p.prep : p.xl; E.mod = p.mod + (size_t)(l * 5) * (NMOD * D);
    g8::gemm_phase(lds, D, S, E);
}

template <bool DRY = false> __device__ __forceinline__ void ph_route(const Params& p, int l, int M, LAS unsigned char* lds) {
    int* const r_cnt = DRY ? p.cnt + 64 : p.cnt; int* const r_list = DRY ? (int*)p.act : p.list; int* const r_ts = DRY ? (int*)p.yp : p.tokslot; float* const r_tw = DRY ? (float*)p.yp + (size_t)NTOK * 4 : p.topw;
    LAS float* fs = (LAS float*)lds;
    LAS float* lg = fs + 32 * 1028;
    LAS int* lcnt = (LAS int*)(lg + 32 * 36);
    LAS int* lbase = lcnt + 32;
    const int tid = opaque_tid(), wid = tid >> 6, lane = tid & 63;
    const float* rw = p.router_w + (size_t)l * D * NE;
    for (int it = blockIdx.x; it < M / 32; it += gridDim.x) {
        const int tok0 = it * 32;
        {
            float4 v[4][4]; float ss[4];
#pragma unroll
            for (int q = 0; q < 4; ++q) {
                const float* src = p.xl + (size_t)(tok0 + wid * 4 + q) * D;
#pragma unroll
                for (int i = 0; i < 4; ++i) v[q][i] = *(const float4*)(src + i * 256 + lane * 4);
            }
#pragma unroll
            for (int q = 0; q < 4; ++q) {
                float s = 0.f;
#pragma unroll
                for (int i = 0; i < 4; ++i) s += v[q][i].x * v[q][i].x + v[q][i].y * v[q][i].y + v[q][i].z * v[q][i].z + v[q][i].w * v[q][i].w;
                ss[q] = s;
            }
#pragma unroll
            for (int m = 32; m >= 1; m >>= 1)
#pragma unroll
                for (int q = 0; q < 4; ++q) ss[q] += shx(ss[q], m, lane);
            const float* mb = p.mod + (size_t)(l * 5 + tok_modrow(tok0)) * (NMOD * D);
#pragma unroll
            for (int i = 0; i < 4; ++i) {
                const int cidx = i * 256 + lane * 4;
                const float4 gv = *(const float4*)(p.norm2_g + l * D + cidx), sv = *(const float4*)(mb + 4 * D + cidx), hv = *(const float4*)(mb + 3 * D + cidx);
#pragma unroll
                for (int q = 0; q < 4; ++q) {
                    const int tl = wid * 4 + q, tok = tok0 + tl;
                    const float rinv = rsqrtf(ss[q] * (1.0f / D) + 1e-6f);
                    const float h0 = v[q][i].x * rinv * gv.x * (1.f + sv.x) + hv.x, h1 = v[q][i].y * rinv * gv.y * (1.f + sv.y) + hv.y;
                    const float h2 = v[q][i].z * rinv * gv.z * (1.f + sv.z) + hv.z, h3 = v[q][i].w * rinv * gv.w * (1.f + sv.w) + hv.w;
                    u32x2 o; o[0] = pack2(h0, h1); o[1] = pack2(h2, h3);
                    *(u32x2*)(p.F + (size_t)tok * D + cidx) = o;
                    *(LAS f32x4*)(fs + tl * 1028 + cidx) = (f32x4){h0, h1, h2, h3};
                }
            }
        }
        __syncthreads();
        {
            typedef float f32x16 __attribute__((ext_vector_type(16)));
            f32x16 acc;
#pragma unroll
            for (int r = 0; r < 16; ++r) acc[r] = 0.f;
            const int tk = lane & 31, hh = lane >> 5;
            const LAS float* ap = fs + tk * 1028 + wid * 128 + 4 * hh;
            const float* bp = rw + (size_t)(wid * 128 + 4 * hh) * NE + tk;
#pragma unroll 4
            for (int kk = 0; kk < 16; ++kk) {
                const f32x4 a4 = *(const LAS f32x4*)(ap + kk * 8);
                const float b0 = bp[(kk * 8 + 0) * NE], b1 = bp[(kk * 8 + 1) * NE], b2 = bp[(kk * 8 + 2) * NE], b3 = bp[(kk * 8 + 3) * NE];
                acc = __builtin_amdgcn_mfma_f32_32x32x2f32(a4[0], b0, acc, 0, 0, 0);
                acc = __builtin_amdgcn_mfma_f32_32x32x2f32(a4[1], b1, acc, 0, 0, 0);
                acc = __builtin_amdgcn_mfma_f32_32x32x2f32(a4[2], b2, acc, 0, 0, 0);
                acc = __builtin_amdgcn_mfma_f32_32x32x2f32(a4[3], b3, acc, 0, 0, 0);
            }
            __syncthreads();
            LAS float* red = fs;
#pragma unroll
            for (int r = 0; r < 16; ++r) red[(wid * 32 + (r & 3) + 8 * (r >> 2) + 4 * hh) * 33 + tk] = acc[r];
            __syncthreads();
            const int t2 = tid >> 4, e0 = (tid & 15) * 2;
            float s0 = p.router_b[l * NE + e0], s1 = p.router_b[l * NE + e0 + 1];
#pragma unroll
            for (int w = 0; w < 8; ++w) { s0 += red[(w * 32 + t2) * 33 + e0]; s1 += red[(w * 32 + t2) * 33 + e0 + 1]; }
            lg[t2 * 36 + e0] = s0; lg[t2 * 36 + e0 + 1] = s1;
            if (tid < 32) lcnt[tid] = 0;
        }
        __syncthreads();
        float vals[4]; int idxs[4], rank[4];
        if (tid < 32) {
            float lv[32];
#pragma unroll
            for (int q = 0; q < 8; ++q) { const f32x4 t = *(const LAS f32x4*)(lg + tid * 36 + q * 4); lv[q * 4] = t[0]; lv[q * 4 + 1] = t[1]; lv[q * 4 + 2] = t[2]; lv[q * 4 + 3] = t[3]; }
#pragma unroll
            for (int k = 0; k < 4; ++k) {
                float best = lv[0]; int bi = 0;
#pragma unroll
                for (int ee = 1; ee < NE; ++ee) { const bool gt = lv[ee] > best; best = gt ? lv[ee] : best; bi = gt ? ee : bi; }
#pragma unroll
                for (int ee = 0; ee < NE; ++ee) lv[ee] = (ee == bi) ? -3.0e38f : lv[ee];
                vals[k] = best; idxs[k] = bi;
                rank[k] = atomicAdd((int*)(lcnt + bi), 1);
            }
        }
        __syncthreads();
        if (tid < 32) { const int c = lcnt[tid]; lbase[tid] = c ? atomicAdd(r_cnt + l * NE + tid, c) : 0; }
        __syncthreads();
        if (tid < 32) {
            const int tok = tok0 + tid;
            const float mx = vals[0];
            float ex[4], sum = 0.f;
#pragma unroll
            for (int k = 0; k < 4; ++k) { ex[k] = __expf(vals[k] - mx); sum += ex[k]; }
            const float inv = 1.0f / sum;
#pragma unroll
            for (int k = 0; k < 4; ++k) {
                const int ee = idxs[k];
                const int slot = lbase[ee] + rank[k];
                r_list[(size_t)ee * NTOK + slot] = tok;
                r_ts[(size_t)tok * 4 + k] = (ee << 16) | slot;
                r_tw[(size_t)tok * 4 + k] = ex[k] * inv;
            }
        }
        __syncthreads();
    }
}

__device__ __forceinline__ void build_expert_tables(const Params& p, int l, LAS int* ts, LAS int* cn, LAS int* te) {
    const int tid = opaque_tid();
    if (tid < 64) {
        const int c = tid < NE ? p.cnt[l * NE + tid] : 0;
        const int nt = (c + 255) >> 8;
        int v = nt;
#pragma unroll
        for (int off = 1; off < 32; off <<= 1) { const int t = shupi(v, off, tid); if (tid >= off) v += t; }
        if (tid < NE) { cn[tid] = c; ts[tid] = v - nt; if (tid == NE - 1) ts[NE] = v; }
        if (te && tid < NE) for (int q = 0; q < nt; ++q) te[v - nt + q] = tid;
    }
    __syncthreads();
}

struct MoeSched {
    const LAS int* ts; const LAS int* cn; const LAS int* te; const int* list; const bf16_t* A; const bf16_t* Bt; const float* bias; int K, npn, nunits, G, c, nrowsB, nbias; bool gather;
    static constexpr bool HAS_BIAS = true;
    __device__ __forceinline__ bool next(int i, g8::Unit& u) const {
        const long L = (long)i * G + c; if (L >= nunits) return false;
        u.pm = (int)(L / npn); u.pn = (int)(L % npn); u.e = te[u.pm]; return true;
    }
    __device__ __forceinline__ const char* a_base(const g8::Unit& u) const { return (const char*)(gather ? A : A + (size_t)u.pm * 256 * K); }
    __device__ __forceinline__ const char* b_base(const g8::Unit& u) const { return (const char*)(Bt + ((size_t)u.e * nrowsB + (size_t)u.pn * 256) * K); }
    __device__ __forceinline__ const int* row_addr(const g8::Unit& u, int R) const {
        const int cnt = cn[u.e], sl = (u.pm - ts[u.e]) * 256 + R;
        return list + (size_t)u.e * NTOK + (sl < cnt ? sl : 0);
    }
    __device__ __forceinline__ int rows_valid(const g8::Unit& u) const { return cn[u.e] - (u.pm - ts[u.e]) * 256; }
    __device__ __forceinline__ const float* bias_src(const g8::Unit& u, int lane) const {
        if (nbias == 2) return bias + (size_t)u.e * 2 * D + (lane < 32 ? u.pn * 128 + lane * 4 : D + u.pn * 128 + (lane - 32) * 4);
        return bias + (size_t)u.e * D + u.pn * 256 + lane * 4;
    }
};
struct EpiAct {
    bf16_t* O;
    __device__ __forceinline__ bool keep(const g8::Unit&) const { return false; }
    __device__ __forceinline__ void operator()(const f32x4 (&acc)[2][2][4][2], const g8::Unit& u, int wr, int wc, int fr, int fq, const LAS float* bias) const {
        const int row0 = u.pm * 256 + wr * 64 + fr, col0 = u.pn * 128 + wc * 32 + 8 * fq;
        const LAS float* bb = bias + wc * 32 + 8 * fq;
        const f32x4 g0 = *(const LAS f32x4*)bb, g1 = *(const LAS f32x4*)(bb + 4), l0 = *(const LAS f32x4*)(bb + 128), l1 = *(const LAS f32x4*)(bb + 132);
        const float bg[8] = {g0[0], g0[1], g0[2], g0[3], g1[0], g1[1], g1[2], g1[3]}, bl[8] = {l0[0], l0[1], l0[2], l0[3], l1[0], l1[1], l1[2], l1[3]};
#pragma unroll
        for (int ai = 0; ai < 2; ++ai)
#pragma unroll
            for (int m = 0; m < 4; ++m) {
                float o[8];
#pragma unroll
                for (int n = 0; n < 2; ++n)
#pragma unroll
                    for (int j = 0; j < 4; ++j) {
                        const float glu = fminf(acc[ai][0][m][n][j] + bg[n * 4 + j], 7.0f);
                        const float lin = fminf(fmaxf(acc[ai][1][m][n][j] + bl[n * 4 + j], -7.0f), 7.0f);
                        o[n * 4 + j] = glu * sigmoidf_(1.702f * glu) * (lin + 1.0f);
                    }
                *(u32x4*)(O + (size_t)(row0 + ai * 128 + m * 16) * D + col0) = pack8(o);
            }
    }
};
__device__ __forceinline__ void ph_g4(const Params& p, int l, LAS unsigned char* lds) {
    LAS int* ts = (LAS int*)(lds + g8::STAGE_BYTES); LAS int* cn = ts + 40; LAS int* te = ts + 80;
    build_expert_tables(p, l, ts, cn, te);
    MoeSched S; S.ts = ts; S.cn = cn; S.te = te; S.list = p.list; S.A = p.F; S.Bt = p.w1T + (size_t)l * NE * 2 * D * D; S.bias = p.moe_b1 + (size_t)l * NE * 2 * D; S.nbias = 2;
    S.K = D; S.npn = 8; S.nunits = ts[NE] * 8; S.G = gridDim.x; S.c = blockIdx.x; S.nrowsB = 2 * D; S.gather = true;
    EpiAct E; E.O = p.act;
    g8::gemm_phase(lds, D, S, E);
}

struct EpiYp {
    bf16_t* O;
    __device__ __forceinline__ bool keep(const g8::Unit&) const { return false; }
    __device__ __forceinline__ void operator()(const f32x4 (&acc)[2][2][4][2], const g8::Unit& u, int wr, int wc, int fr, int fq, const LAS float* bias) const {
        const int row0 = u.pm * 256 + wr * 64 + fr, col0 = u.pn * 256 + wc * 32 + 8 * fq;
#pragma unroll
        for (int bj = 0; bj < 2; ++bj) {
            const LAS float* bb = bias + bj * 128 + wc * 32 + 8 * fq;
            const f32x4 c0v = *(const LAS f32x4*)bb, c1v = *(const LAS f32x4*)(bb + 4);
            const float4 c0 = make_float4(c0v[0], c0v[1], c0v[2], c0v[3]), c1 = make_float4(c1v[0], c1v[1], c1v[2], c1v[3]);
#pragma unroll
            for (int ai = 0; ai < 2; ++ai)
#pragma unroll
                for (int m = 0; m < 4; ++m) {
                    u32x4 w; w[0] = pack2(acc[ai][bj][m][0][0] + c0.x, acc[ai][bj][m][0][1] + c0.y); w[1] = pack2(acc[ai][bj][m][0][2] + c0.z, acc[ai][bj][m][0][3] + c0.w);
                    w[2] = pack2(acc[ai][bj][m][1][0] + c1.x, acc[ai][bj][m][1][1] + c1.y); w[3] = pack2(acc[ai][bj][m][1][2] + c1.z, acc[ai][bj][m][1][3] + c1.w);
                    *(u32x4*)(O + (size_t)(row0 + ai * 128 + m * 16) * D + col0 + bj * 128) = w;
                }
        }
    }
};
__device__ __forceinline__ void ph_g5(const Params& p, int l, LAS unsigned char* lds) {
    LAS int* ts = (LAS int*)(lds + g8::STAGE_BYTES); LAS int* cn = ts + 40; LAS int* te = ts + 80;
    build_expert_tables(p, l, ts, cn, te);
    MoeSched S; S.ts = ts; S.cn = cn; S.te = te; S.list = p.list; S.A = p.act; S.Bt = p.w2T + (size_t)l * NE * D * D; S.bias = p.moe_b2 + (size_t)l * NE * D; S.nbias = 1;
    S.K = D; S.npn = 4; S.nunits = ts[NE] * 4; S.G = gridDim.x; S.c = blockIdx.x; S.nrowsB = D; S.gather = false;
    EpiYp E; E.O = p.yp;
    g8::gemm_phase(lds, D, S, E);
}

template <bool DRY = false> __device__ __forceinline__ void ph_combine(const Params& p, int l, int M, LAS unsigned char* lds) {
    float* const c_xl = DRY ? p.prep : p.xl; bf16_t* const c_H = DRY ? (bf16_t*)(p.prep + (size_t)NTOK * D) : p.H; float* const c_out = DRY ? p.prep : p.out;
    LAS int* ts = (LAS int*)lds; LAS int* cn = ts + 40;
    build_expert_tables(p, l, ts, cn, nullptr);
    const int tid = opaque_tid(), wid = tid >> 6, lane = tid & 63;
    const bool last = (l == 1);
    const int tstep = gridDim.x * NWAVES;
    int tok = blockIdx.x * NWAVES + wid;
    int4 nts = make_int4(0, 0, 0, 0); float4 ntw = make_float4(0.f, 0.f, 0.f, 0.f);
    if (tok < M) { nts = *(const int4*)(p.tokslot + (size_t)tok * 4); ntw = *(const float4*)(p.topw + (size_t)tok * 4); }
    for (; tok < M; tok += tstep) {
        float4 v[4];
        const float* mb = p.mod + (size_t)(l * 5 + tok_modrow(tok)) * (NMOD * D);
        const int tsl[4] = {nts.x, nts.y, nts.z, nts.w}; const float wts[4] = {ntw.x, ntw.y, ntw.z, ntw.w};
        int rows[4];
#pragma unroll
        for (int k = 0; k < 4; ++k) rows[k] = ts[tsl[k] >> 16] * 256 + (tsl[k] & 0xffff);
        if (tok + tstep < M) { nts = *(const int4*)(p.tokslot + (size_t)(tok + tstep) * 4); ntw = *(const float4*)(p.topw + (size_t)(tok + tstep) * 4); }
        u32x2 yv[4][4]; float4 xin[4], gtv[4];
#pragma unroll
        for (int i = 0; i < 4; ++i) {
            const int cidx = i * 256 + lane * 4;
#pragma unroll
            for (int k = 0; k < 4; ++k) yv[i][k] = *(const u32x2*)(p.yp + (size_t)rows[k] * D + cidx);
            xin[i] = *(const float4*)(p.xl + (size_t)tok * D + cidx);
            gtv[i] = *(const float4*)(mb + 5 * D + cidx);
        }
        float ss = 0.f;
#pragma unroll
        for (int i = 0; i < 4; ++i) {
            float m0 = 0.f, m1 = 0.f, m2 = 0.f, m3 = 0.f;
#pragma unroll
            for (int k = 0; k < 4; ++k) { m0 += wts[k] * bflo(yv[i][k][0]); m1 += wts[k] * bfhi(yv[i][k][0]); m2 += wts[k] * bflo(yv[i][k][1]); m3 += wts[k] * bfhi(yv[i][k][1]); }
            float4 xv = xin[i];
            xv.x += gtv[i].x * m0; xv.y += gtv[i].y * m1; xv.z += gtv[i].z * m2; xv.w += gtv[i].w * m3;
            v[i] = xv; ss += xv.x * xv.x + xv.y * xv.y + xv.z * xv.z + xv.w * xv.w;
        }
        ss = wave_sum(ss, lane);
        const float rinv = rsqrtf(ss * (1.0f / D) + 1e-6f);
        if (!last) {
#pragma unroll
            for (int i = 0; i < 4; ++i) *(float4*)(c_xl + (size_t)tok * D + i * 256 + lane * 4) = v[i];
            const float* mb1 = p.mod + (size_t)((l + 1) * 5 + tok_modrow(tok)) * (NMOD * D);
            norm_mod_store(v, rinv, p.norm1_g + (l + 1) * D, mb1 + 1 * D, mb1 + 0 * D, c_H + (size_t)tok * D, lane);
        } else {
#pragma unroll
            for (int i = 0; i < 4; ++i) {
                const int cidx = i * 256 + lane * 4;
                const float4 gv = *(const float4*)(p.final_norm_g + cidx);
                *(float4*)(c_out + (size_t)tok * D + cidx) = make_float4(v[i].x * rinv * gv.x, v[i].y * rinv * gv.y, v[i].z * rinv * gv.z, v[i].w * rinv * gv.w);
            }
        }
    }
}

#define XB_TMO      128
#define XB_XCNT(j)  (256  + 64 * (j))
#define XB_XSUB(j)  (1280 + 64 * (j))
#define XB_XGEN(j)  (2304 + 64 * (j))
#define XB_TOP      3328
#define XB_TOPGEN   3392
#define XCD_BAR_WORDS 3456
#define XB_SPIN_CAP (1u << 18)

__device__ __forceinline__ unsigned xb_ld(unsigned* p)              { return __hip_atomic_load(p, __ATOMIC_RELAXED, __HIP_MEMORY_SCOPE_AGENT); }
__device__ __forceinline__ unsigned xb_add(unsigned* p, unsigned v) { return __hip_atomic_fetch_add(p, v, __ATOMIC_RELAXED, __HIP_MEMORY_SCOPE_AGENT); }
__device__ __forceinline__ unsigned xb_xcc_id() { return (unsigned)__builtin_amdgcn_s_getreg((3 << 11) | 20) & 0xFu; }
#define XB_SPIN(cond, bar) do { unsigned _sp = 0; while (cond) { __builtin_amdgcn_s_sleep(1); \
    if ((++_sp & 255u) == 0u) { if (xb_ld(&(bar)[XB_TMO])) break; if (_sp > XB_SPIN_CAP) { atomicAdd(&(bar)[XB_TMO], 1u); break; } } } } while (0)

struct XcdBarrier {
    unsigned* bar; unsigned x;
    volatile LAS unsigned* st;
};

__device__ __forceinline__ XcdBarrier xcd_barrier_post(unsigned* bar, volatile LAS unsigned* st) {
    XcdBarrier b; b.bar = bar; b.x = xb_xcc_id(); b.st = st;
    if (threadIdx.x == 0) (void)xb_add(&bar[XB_XCNT(b.x)], 1u);
    return b;
}
__device__ __forceinline__ void xcd_barrier_complete(unsigned* bar, unsigned x, unsigned& nloc, unsigned& nx) {
    const unsigned G = gridDim.x * gridDim.y * gridDim.z;
    unsigned sum, cnt, mine, sp = 0u;
    for (;;) {
        sum = 0u; cnt = 0u; mine = 0u;
#pragma unroll
        for (unsigned j = 0; j < 16; ++j) { const unsigned c = xb_ld(&bar[XB_XCNT(j)]); sum += c; cnt += (c > 0u) ? 1u : 0u; mine = (j == x) ? c : mine; }
        if (sum == G) break;
        __builtin_amdgcn_s_sleep(1);
        if ((++sp & 255u) == 0u) { if (xb_ld(&bar[XB_TMO])) break; if (sp > XB_SPIN_CAP) { atomicAdd(&bar[XB_TMO], 1u); break; } }
    }
    nloc = mine > 0u ? mine : 1u; nx = cnt > 0u ? cnt : 1u;
}

__device__ __forceinline__ void xcd_barrier(const XcdBarrier& b) {
    asm volatile("s_waitcnt vmcnt(0)" ::: "memory");
    __syncthreads();
    if (threadIdx.x == 0) {
        unsigned* bar = b.bar;
        __builtin_amdgcn_s_waitcnt(0);
        unsigned nloc = b.st[0], nx = b.st[1];
        if (nloc == 0u) { xcd_barrier_complete(bar, b.x, nloc, nx); b.st[0] = nloc; b.st[1] = nx; }
        const unsigned old = xb_add(&bar[XB_XSUB(b.x)], 1u);
        const unsigned gen = old / nloc;
        if (old + 1u == (gen + 1u) * nloc) {
            __builtin_amdgcn_fence(__ATOMIC_RELEASE, "agent");
            asm volatile("s_waitcnt vmcnt(0)" ::: "memory");
            const unsigned og = xb_add(&bar[XB_TOP], 1u);
            const unsigned tg = og / nx;
            if (og + 1u == (tg + 1u) * nx) xb_add(&bar[XB_TOPGEN], 1u);
            else XB_SPIN(xb_ld(&bar[XB_TOPGEN]) == tg, bar);
            __builtin_amdgcn_fence(__ATOMIC_ACQUIRE, "agent");
            xb_add(&bar[XB_XGEN(b.x)], 1u);
            asm volatile("s_waitcnt vmcnt(0)" ::: "memory");
        } else {
            XB_SPIN(xb_ld(&bar[XB_XGEN(b.x)]) == gen, bar);
            __builtin_amdgcn_fence(__ATOMIC_ACQUIRE, "agent");
            asm volatile("s_waitcnt vmcnt(0)" ::: "memory");
        }
    }
    __syncthreads();
}


extern __shared__ __attribute__((aligned(16))) unsigned char dyn_lds[];
#define KPH(name, call) __global__ void __launch_bounds__(NTHREADS, 2) name(Params p, int l, int M) { LAS unsigned char* lds = (LAS unsigned char*)dyn_lds; (void)l; (void)M; (void)lds; call; }
KPH(k_convert, { ph_convert(p, lds); })
KPH(k_mod, { ph_mod(p, lds); })
KPH(k_norm1, { ph_norm1_first(p); })
KPH(k_g1, { ph_g1(p, l, lds); })
KPH(k_prep, { ph_prep(p, l, lds); })
KPH(k_local, { ph_local(p, l, lds); })
KPH(k_seq, { ph_seq(p, lds); })
KPH(k_merge, { ph_merge(p, l, M); })
KPH(k_g2, { ph_g2(p, l, M, lds); })
KPH(k_g3, { ph_g3(p, l, M, lds); })
KPH(k_route, { ph_route(p, l, M, lds); })
KPH(k_g4, { ph_g4(p, l, lds); })
KPH(k_g5, { ph_g5(p, l, lds); })
KPH(k_combine, { ph_combine(p, l, M, lds); })


typedef const __attribute__((address_space(4))) unsigned char* KArgPtr;
__device__ __forceinline__ Params load_params(KArgPtr kp) {
    asm volatile("" : "+s"(kp));
    Params q;
    const __attribute__((address_space(4))) unsigned long long* k8 = (const __attribute__((address_space(4))) unsigned long long*)kp;
    unsigned long long* d8 = (unsigned long long*)&q;
#pragma unroll
    for (int i = 0; i < (int)(sizeof(Params) / 8); ++i) d8[i] = k8[i];
    return q;
}
__global__ void __launch_bounds__(NTHREADS, 2) k_mega(Params p_unused) {
    (void)p_unused;
    const KArgPtr kp = (KArgPtr)__builtin_amdgcn_kernarg_segment_ptr();
    LAS unsigned char* lds = (LAS unsigned char*)dyn_lds;
    volatile LAS unsigned* xb_words = (volatile LAS unsigned*)(lds + LDS_BYTES - 16);
    if (threadIdx.x == 0) { xb_words[0] = 0u; xb_words[1] = 0u; xb_words[2] = 0u; xb_words[3] = 0u; }
    __syncthreads();
    { const Params p = load_params(kp); (void)xcd_barrier_post(p.bar, xb_words); }
#define GRID_BARRIER() do { XcdBarrier b_; b_.bar = load_params(kp).bar; b_.x = xb_xcc_id(); b_.st = xb_words; xcd_barrier(b_); } while (0)
#define PH(stmt) do { const Params p = load_params(kp); stmt; } while (0)
    PH(ph_convert(p, lds));
    PH(ph_mod(p, lds));
    GRID_BARRIER();
    PH(ph_norm1_first(p));
    GRID_BARRIER();
    for (int l = 0; l < 2; ++l) {
        const int M = l == 0 ? NTOK : NLAT;
        { unsigned lb_ = (unsigned)(size_t)lds; asm volatile("" : "+s"(lb_)); lds = (LAS unsigned char*)(size_t)lb_; }
        PH(ph_g1(p, l, lds));
        GRID_BARRIER();
        PH(ph_prep(p, l, lds));
        PH(ph_local(p, l, lds));
        GRID_BARRIER();
        PH(ph_seq(p, lds));
        GRID_BARRIER();
        PH(ph_merge(p, l, M));
        GRID_BARRIER();
        PH(ph_g2(p, l, M, lds));
        GRID_BARRIER();
        PH(ph_g3(p, l, M, lds));
        GRID_BARRIER();
        PH(ph_route(p, l, M, lds));
        GRID_BARRIER();
        PH(ph_g4(p, l, lds));
        GRID_BARRIER();
        PH(ph_g5(p, l, lds));
        GRID_BARRIER();
        PH(ph_combine(p, l, M, lds));
        if (l == 0) GRID_BARRIER();
    }
}

static inline size_t align_up(size_t v, size_t a) { return (v + a - 1) / a * a; }

extern "C" void kernel_launch(void* const* d_in, const int* in_sizes, int n_in, void* d_out, int out_size, void* d_ws, size_t ws_size, hipStream_t stream) {
    (void)in_sizes; (void)n_in; (void)out_size;
    Params p{};
    const float** pf = (const float**)&p;
    for (int i = 0; i < 32; ++i) pf[i] = (const float*)d_in[i];
    p.out = (float*)d_out;
    unsigned char* w = (unsigned char*)d_ws; size_t off = 0;
    auto take = [&](size_t bytes) { void* r = w + off; off = align_up(off + bytes, 256); return r; };
    p.bar = (unsigned*)take(16384);
    p.cnt = (int*)take(1024);
    const size_t ctl_bytes = off;
    p.mod = (float*)take((size_t)2 * 5 * NMOD * D * 4);
    p.winT = (bf16_t*)take((size_t)2 * NPW * D * 2);
    p.wbT = (bf16_t*)take((size_t)2 * 4 * D * MW * 2);
    p.woutT = (bf16_t*)take((size_t)2 * D * D * 2);
    p.w1T = (bf16_t*)take((size_t)2 * NE * 2 * D * D * 2);
    p.w2T = (bf16_t*)take((size_t)2 * NE * D * D * 2);
    p.xl = (float*)take((size_t)NTOK * D * 4);
    p.H = (bf16_t*)take((size_t)NTOK * D * 2);
    p.P = (bf16_t*)take((size_t)NTOK * NP * 2);
    p.gate = (bf16_t*)take((size_t)NTOK * 4096 * 2);
    p.act = p.P; p.yp = p.P + (size_t)CAPROWS * D;
    p.prep = (float*)take(NPREP * TOKW * 4);
    p.O = (bf16_t*)take(8 * TOKW * 2);
    p.lq = (bf16_t*)take((size_t)3 * NITEM * 64 * 128 * 2);
    p.lo = (bf16_t*)take((size_t)3 * NITEM * 64 * 128 * 2);
    p.lb = (bf16_t*)take((size_t)3 * NITEM * 128 * 128 * 2);
    p.la = (bf16_t*)take((size_t)NITEM * 128 * 128 * 2);
    p.ld = (float*)take((size_t)3 * NITEM * 128 * 4);
    p.lruT = (bf16_t*)take((size_t)2 * 8 * 4 * 4096 * 2);
    p.lsig = (float*)take((size_t)2 * 2 * MW * 4);
    p.rope = (float2*)take((size_t)TL * 64 * 8);
    p.Y = (bf16_t*)take(4 * TOKW * 2);
    p.mix = (bf16_t*)take((size_t)NTOK * D * 2);
    p.F = p.H;
    p.list = (int*)take((size_t)NE * NTOK * 4);
    p.tokslot = (int*)take((size_t)NTOK * 4 * 4);
    p.topw = (float*)take((size_t)NTOK * 4 * 4);
    if (off > ws_size) { fprintf(stderr, "workspace too small: need %zu have %zu\n", off, ws_size); return; }

    static int grid = 0;
#if MEGA
    if (!grid) {
        int dev = 0, cus = 0, occ = 0; (void)hipGetDevice(&dev); (void)hipDeviceGetAttribute(&cus, hipDeviceAttributeMultiprocessorCount, dev);
        (void)hipFuncSetAttribute((const void*)k_mega, hipFuncAttributeMaxDynamicSharedMemorySize, LDS_BYTES);
        (void)hipOccupancyMaxActiveBlocksPerMultiprocessor(&occ, (const void*)k_mega, NTHREADS, LDS_BYTES);
        if (cus <= 0) cus = 256;
        grid = cus * (occ < 1 ? 1 : 1);
        if (occ < 1) fprintf(stderr, "occupancy query says %d blocks per CU\n", occ);
    }
    (void)hipMemsetAsync(d_ws, 0, ctl_bytes, stream);
    hipLaunchKernelGGL(k_mega, dim3(grid), dim3(NTHREADS), LDS_BYTES, stream, p);
#else
    if (!grid) {
        int dev = 0, cus = 0; (void)hipGetDevice(&dev); (void)hipDeviceGetAttribute(&cus, hipDeviceAttributeMultiprocessorCount, dev);
        grid = cus > 0 ? cus : 256;
        const void* ks[] = {(const void*)k_convert, (const void*)k_mod, (const void*)k_norm1, (const void*)k_g1, (const void*)k_prep, (const void*)k_local, (const void*)k_seq, (const void*)k_merge,
                            (const void*)k_g2, (const void*)k_g3, (const void*)k_route, (const void*)k_g4, (const void*)k_g5, (const void*)k_combine};
        for (const void* k : ks) (void)hipFuncSetAttribute(k, hipFuncAttributeMaxDynamicSharedMemorySize, LDS_BYTES);
    }
    (void)hipMemsetAsync(d_ws, 0, ctl_bytes, stream);
#define LAUNCH(k, l, M) hipLaunchKernelGGL(k, dim3(grid), dim3(NTHREADS), LDS_BYTES, stream, p, l, M)
    LAUNCH(k_convert, 0, 0);
    LAUNCH(k_mod, 0, 0);
    LAUNCH(k_norm1, 0, 0);
    for (int l = 0; l < 2; ++l) {
        const int M = l == 0 ? NTOK : NLAT;
        LAUNCH(k_g1, l, M);
        LAUNCH(k_prep, l, M);
        LAUNCH(k_local, l, M);
        LAUNCH(k_seq, l, M);
        LAUNCH(k_merge, l, M);
        LAUNCH(k_g2, l, M);
        LAUNCH(k_g3, l, M);
        LAUNCH(k_route, l, M);
        LAUNCH(k_g4, l, M);
        LAUNCH(k_g5, l, M);
        LAUNCH(k_combine, l, M);
    }
#endif
}
```

```cpp
#include <hip/hip_runtime.h>
#include <stdint.h>
#include <stdio.h>

#define LAS __attribute__((address_space(3)))
typedef unsigned short bf16_t;
typedef short bf16x8 __attribute__((ext_vector_type(8)));
typedef float f32x4 __attribute__((ext_vector_type(4)));
typedef float f32x2 __attribute__((ext_vector_type(2)));
typedef unsigned u32x2 __attribute__((ext_vector_type(2)));
typedef unsigned u32x4 __attribute__((ext_vector_type(4)));

#ifndef PROBE
#define PROBE 0
#endif

constexpr int D = 1024, NB = 4, TL = 4096, TC = 256, NLAT = NB * TL, NCTX = NB * TC, NTOK = NLAT + NCTX;
constexpr int NIN = 11792, NPW = 12032, NP = 7936, MW = 512, NE = 32, TOPK = 4, NMOD = 6;
constexpr int C_GQKV = 0, C_GZ = 1536, C_HQ = 2048, C_HI = 2560, C_HF = 3072, C_HG = 4096, C_LX = 4608,
              C_LY = 5120, C_RQKV = 5632, C_RG = 7168, C_GA = 7680, C_GB = 7688, W_MG = 7936;
__host__ __device__ __forceinline__ int win_dst_row(int n) { return n < 2048 ? n : n < 2064 ? 7680 + (n - 2048) : n < 7696 ? n - 16 : 7936 + (n - 7696); }
constexpr int NTHREADS = 512, NWAVES = 8;
constexpr int LDS_BYTES = 140 * 1024;
constexpr int CAPROWS = 77824;
constexpr size_t TOKW = (size_t)NTOK * MW;
constexpr int PR_LA = 0, PR_LU = 2, NPREP = 4;
constexpr int NCHUNK = 68, NITEM = 32 * NCHUNK;

struct Params {
    const float *x, *c, *ctx, *c_ctx, *w_mod, *b_mod, *norm1_g, *norm2_g, *w_in, *gdn_conv_w, *gdn_a_log, *gdn_dt_bias, *gdn_norm_g, *hgrn_lb,
        *hgrn_norm_g, *lru_conv_w, *lru_conv_b, *lru_wa, *lru_ba, *lru_wx, *lru_bx, *lru_lambda, *ret_norm_g, *w_branch, *w_out, *router_w,
        *router_b, *moe_w1, *moe_b1, *moe_w2, *moe_b2, *final_norm_g;
    float* out;
    unsigned* bar; int* cnt; float* mod;
    bf16_t *winT, *wbT, *woutT, *w1T, *w2T;
    float* xl; bf16_t* H; bf16_t* P; float* prep; float* gg; float* gb; bf16_t* O; bf16_t* Y; bf16_t* mix; bf16_t* F;
    int* list; int* tokslot; float* topw; bf16_t* act; bf16_t* yp;
    bf16_t *lq, *lo, *lb, *la; float* ld; bf16_t* lruT; bf16_t* gate; float* lsig; float2* rope;
};

typedef __bf16 bf16x2_t __attribute__((ext_vector_type(2)));
__device__ __forceinline__ unsigned pack2(float a, float b) { const f32x2 v = {a, b}; return __builtin_bit_cast(unsigned, __builtin_convertvector(v, bf16x2_t)); }
__device__ __forceinline__ unsigned f2bf(float f) { return pack2(f, f) & 0xffffu; }
__device__ __forceinline__ float bf2f(bf16_t b) { return __uint_as_float(((unsigned)b) << 16); }
__device__ __forceinline__ float bflo(unsigned u) { return __uint_as_float(u << 16); }
__device__ __forceinline__ float bfhi(unsigned u) { return __uint_as_float(u & 0xffff0000u); }
__device__ __forceinline__ float sigmoidf_(float x) { return __builtin_amdgcn_rcpf(1.0f + __expf(-x)); }
__device__ __forceinline__ float siluf_(float x) { return x * sigmoidf_(x); }
__device__ __forceinline__ float softplusf_(float x) { return x > 20.f ? x : __logf(1.0f + __expf(x)); }
__device__ __forceinline__ float ret_log_gamma(int h) { return h == 0 ? -0.031748698314580f : h == 1 ? -0.015748356968139f : h == 2 ? -0.007843177461025f : -0.003913899321136f; }
__device__ __forceinline__ float logsigmoidf_(float x) { return -softplusf_(-x); }
__device__ __forceinline__ float gelu_tanhf_(float x) { const float u = 0.7978845608028654f * (x + 0.044715f * x * x * x); return x * __builtin_amdgcn_rcpf(1.0f + __expf(-2.0f * u)); }
__device__ __forceinline__ float shx(float v, int m, int lane) { return __int_as_float(__builtin_amdgcn_ds_bpermute((lane ^ m) << 2, __float_as_int(v))); }
__device__ __forceinline__ float shup(float v, int off, int lane) { const int s = lane >= off ? lane - off : lane; return __int_as_float(__builtin_amdgcn_ds_bpermute(s << 2, __float_as_int(v))); }
__device__ __forceinline__ int shupi(int v, int off, int lane) { const int s = lane >= off ? lane - off : lane; return __builtin_amdgcn_ds_bpermute(s << 2, v); }
__device__ __forceinline__ float wave_sum(float v, int lane) {
#pragma unroll
    for (int m = 32; m >= 1; m >>= 1) v += shx(v, m, lane);
    return v;
}
__device__ __forceinline__ int opaque_tid() { int t = threadIdx.x; asm volatile("" : "+v"(t)); return t; }
template <class T> __device__ __forceinline__ T* opaque_sptr(T* q) { asm volatile("" : "+s"(q)); return q; }
__device__ __forceinline__ int tok_modrow(int tok) { return tok < NLAT ? (tok >> 12) : 4; }
__device__ __forceinline__ void tok_info(int tok, int& t, int& T, int& base) {
    if (tok < NLAT) { t = tok & (TL - 1); T = TL; base = tok - t; }
    else { t = (tok - NLAT) & (TC - 1); T = TC; base = tok - t; }
}

__device__ __forceinline__ f32x4 mfma16(bf16x8 a, bf16x8 b, f32x4 c) { return __builtin_amdgcn_mfma_f32_16x16x32_bf16(a, b, c, 0, 0, 0); }
__device__ __forceinline__ u32x2 pack4(f32x4 v) { u32x2 o; o[0] = pack2(v[0], v[1]); o[1] = pack2(v[2], v[3]); return o; }
__device__ __forceinline__ u32x4 pack8(const float* v) { u32x4 o; o[0] = pack2(v[0], v[1]); o[1] = pack2(v[2], v[3]); o[2] = pack2(v[4], v[5]); o[3] = pack2(v[6], v[7]); return o; }

namespace g8 {
constexpr int BM = 256, BK = 64, HALF = 128, HTB = HALF * BK * 2, STAGE_BYTES = 8 * HTB;
__device__ __forceinline__ int lds_byte(int r, int c) { const int st = (r >> 4) * 2 + (c >> 5), rr = r & 15, cc = c & 31, ob = rr * 64 + cc * 2; return st * 1024 + (ob ^ (((ob >> 9) & 1) << 5)); }
__device__ __forceinline__ void stage_rc(int b, int& R, int& C) { const int st = b / 1024, sb = b % 1024, swz = sb ^ (((sb >> 9) & 1) << 5); R = (st >> 1) * 16 + swz / 64; C = (st & 1) * 32 + (swz % 64) / 2; }
__device__ __forceinline__ int perm32(int rho) { const int n = rho >> 4, i = rho & 15; return 8 * (i >> 2) + 4 * n + (i & 3); }
struct Unit { int pm, pn, e; };

template <class Epi, class Sched>
__device__ __forceinline__ void gemm_phase(LAS unsigned char* lds, const int K, const Sched& S, const Epi& E) {
    const int tid = opaque_tid(), wid = __builtin_amdgcn_readfirstlane(tid >> 6), lane = tid & 63, wr = wid >> 2, wc = wid & 3, fr = lane & 15, fq = lane >> 4;
    const int nt = K / BK;
    int R0, C0, R1, C1; stage_rc(tid * 16, R0, C0); stage_rc(tid * 16 + 8192, R1, C1);
    unsigned voffB[2];
    voffB[0] = (unsigned)(((R0 & ~31) + perm32(R0 & 31)) * K + C0) * 2u; voffB[1] = (unsigned)(((R1 & ~31) + perm32(R1 & 31)) * K + C1) * 2u;
    const unsigned cb0 = (unsigned)C0 * 2u, cb1 = (unsigned)C1 * 2u;
    const size_t kstep = (size_t)(BK * 2);
    const size_t hstepB = (size_t)HALF * K * 2;
    const unsigned ldsw = (unsigned)wid * 1024u;
    const int aoff = lds_byte(wr * 64 + fr, fq * 8), boff = lds_byte(wc * 32 + fr, fq * 8);
#define G8_SA(b, h) (((b) * 2 + (h)) * HTB)
#define G8_SB(b, h) ((4 + (b) * 2 + (h)) * HTB)
#define G8_GL(src, dstoff) __builtin_amdgcn_global_load_lds((const unsigned*)(src), (LAS unsigned*)(lds + (dstoff)), 16, 0, 0)
#define G8_STAGE_A(bufoff, gbase, vo, h) do { G8_GL((const char*)(gbase) + (vo)[2 * (h)], (bufoff) + ldsw); G8_GL((const char*)(gbase) + (vo)[2 * (h) + 1], (bufoff) + ldsw + 8192); } while (0)
#define G8_STAGE_B(bufoff, gbase) do { G8_GL((const char*)(gbase) + voffB[0], (bufoff) + ldsw); G8_GL((const char*)(gbase) + voffB[1], (bufoff) + ldsw + 8192); } while (0)
#define G8_LDA(dst, b, h) do { _Pragma("unroll") for (int m = 0; m < 4; ++m) _Pragma("unroll") for (int k = 0; k < 2; ++k) dst[m][k] = *(const LAS bf16x8*)(lds + G8_SA(b, h) + aoff + m * 2048 + k * 1024); } while (0)
#define G8_LDB(dst, b, h) do { _Pragma("unroll") for (int n = 0; n < 2; ++n) _Pragma("unroll") for (int k = 0; k < 2; ++k) dst[n][k] = *(const LAS bf16x8*)(lds + G8_SB(b, h) + boff + n * 2048 + k * 1024); } while (0)
#define G8_MMA(ai, bj, At, Bt) do { __builtin_amdgcn_s_setprio(1); _Pragma("unroll") for (int m = 0; m < 4; ++m) _Pragma("unroll") for (int n = 0; n < 2; ++n) _Pragma("unroll") for (int k = 0; k < 2; ++k) \
        acc[ai][bj][m][n] = __builtin_amdgcn_mfma_f32_16x16x32_bf16(Bt[n][k], At[m][k], acc[ai][bj][m][n], 0, 0, 0); __builtin_amdgcn_s_setprio(0); } while (0)
#define G8_WAIT_V(n) asm volatile("s_waitcnt vmcnt(" #n ")" ::: "memory")
#define G8_WAIT_L(n) asm volatile("s_waitcnt lgkmcnt(" #n ")" ::: "memory")
#define G8_BAR __builtin_amdgcn_s_barrier()
#define G8_SCHED __builtin_amdgcn_sched_barrier(0)
    Unit cur, nxt; int ui = 0;
    if (!S.next(0, cur)) return;
    LAS float* biasbuf = (LAS float*)(lds + STAGE_BYTES + 2048);
    LAS int* rowbuf = (LAS int*)(lds + STAGE_BYTES + 4096);
    f32x4 acc[2][2][4][2];
#pragma unroll
    for (int a = 0; a < 2; ++a)
#pragma unroll
        for (int b = 0; b < 2; ++b)
#pragma unroll
            for (int m = 0; m < 4; ++m)
#pragma unroll
                for (int n = 0; n < 2; ++n) acc[a][b][m][n] = (f32x4){0.f, 0.f, 0.f, 0.f};
    bf16x8 At[4][2], B0[2][2], B1[2][2];
    unsigned vA[4];
    {
        unsigned rows[4] = {(unsigned)R0, (unsigned)R1, (unsigned)(HALF + R0), (unsigned)(HALF + R1)};
        if (S.gather) { rows[0] = (unsigned)*S.row_addr(cur, R0); rows[1] = (unsigned)*S.row_addr(cur, R1); rows[2] = (unsigned)*S.row_addr(cur, HALF + R0); rows[3] = (unsigned)*S.row_addr(cur, HALF + R1); }
        vA[0] = rows[0] * (unsigned)(K * 2) + cb0; vA[1] = rows[1] * (unsigned)(K * 2) + cb1; vA[2] = rows[2] * (unsigned)(K * 2) + cb0; vA[3] = rows[3] * (unsigned)(K * 2) + cb1;
    }
    const char* cA = S.a_base(cur); const char* cB = S.b_base(cur);
    G8_STAGE_B(G8_SB(0, 0), cB); G8_STAGE_A(G8_SA(0, 0), cA, vA, 0); G8_STAGE_B(G8_SB(0, 1), cB + hstepB); G8_STAGE_A(G8_SA(0, 1), cA, vA, 1);
    if (wr == 1) G8_BAR;
    G8_WAIT_V(4); G8_BAR;
    G8_STAGE_B(G8_SB(1, 0), cB + kstep); G8_STAGE_A(G8_SA(1, 0), cA + kstep, vA, 0); G8_STAGE_B(G8_SB(1, 1), cB + hstepB + kstep);
    G8_WAIT_V(6); G8_BAR;
    for (;;) {
        const bool has_next = S.next(ui + 1, nxt);
        const char* nA = has_next ? S.a_base(nxt) : cA; const char* nB = has_next ? S.b_base(nxt) : cB;
        const int nvalid = (S.gather && has_next) ? S.rows_valid(nxt) : 0;
        if (wid == 0) {
            if (Sched::HAS_BIAS) G8_GL(S.bias_src(cur, lane), STAGE_BYTES + 2048 + (ui & 1) * 1024);
            if (S.gather && has_next) G8_GL(S.row_addr(nxt, 0) + lane * 4, STAGE_BYTES + 4096 + ((ui + 1) & 1) * 1024);
        }
        for (int t = 0; t < nt; t += 2) {
            const bool last = (t == nt - 2);
            const char* a1 = cA + (size_t)(t + 1) * kstep;
            const char* a2 = last ? nA : cA + (size_t)(t + 2) * kstep; const char* b2 = last ? nB : cB + (size_t)(t + 2) * kstep;
            const char* a3 = a2 + kstep; const char* b3 = b2 + kstep;
            G8_LDB(B0, 0, 0); G8_SCHED; G8_LDA(At, 0, 0); G8_STAGE_A(G8_SA(1, 1), a1, vA, 1);
            if (last && S.gather && has_next) {
                const LAS int* rb = rowbuf + ((ui + 1) & 1) * 256;
                const unsigned r0 = R0 < nvalid ? (unsigned)rb[R0] : 0u, r1 = R1 < nvalid ? (unsigned)rb[R1] : 0u;
                const unsigned r2 = HALF + R0 < nvalid ? (unsigned)rb[HALF + R0] : 0u, r3 = HALF + R1 < nvalid ? (unsigned)rb[HALF + R1] : 0u;
                vA[0] = r0 * (unsigned)(K * 2) + cb0; vA[1] = r1 * (unsigned)(K * 2) + cb1; vA[2] = r2 * (unsigned)(K * 2) + cb0; vA[3] = r3 * (unsigned)(K * 2) + cb1;
            }
            G8_WAIT_L(8); G8_BAR; G8_WAIT_L(0); G8_MMA(0, 0, At, B0); G8_BAR; G8_SCHED;
            G8_LDB(B1, 0, 1); G8_STAGE_B(G8_SB(0, 0), b2);
            G8_BAR; G8_WAIT_L(0); G8_MMA(0, 1, At, B1); G8_BAR;
            G8_LDA(At, 0, 1); G8_STAGE_A(G8_SA(0, 0), a2, vA, 0);
            G8_BAR; G8_WAIT_L(0); G8_MMA(1, 0, At, B0); G8_BAR; G8_SCHED;
            G8_STAGE_B(G8_SB(0, 1), b2 + hstepB);
            G8_WAIT_V(6); G8_BAR; G8_MMA(1, 1, At, B1); G8_BAR;
            G8_LDB(B0, 1, 0); G8_SCHED; G8_LDA(At, 1, 0); G8_STAGE_A(G8_SA(0, 1), a2, vA, 1);
            G8_WAIT_L(8); G8_BAR; G8_WAIT_L(0); G8_MMA(0, 0, At, B0); G8_BAR; G8_SCHED;
            G8_LDB(B1, 1, 1); G8_STAGE_B(G8_SB(1, 0), b3);
            G8_BAR; G8_WAIT_L(0); G8_MMA(0, 1, At, B1); G8_BAR;
            G8_LDA(At, 1, 1); G8_STAGE_A(G8_SA(1, 0), a3, vA, 0);
            G8_BAR; G8_WAIT_L(0); G8_MMA(1, 0, At, B0); G8_BAR; G8_SCHED;
            G8_STAGE_B(G8_SB(1, 1), b3 + hstepB);
            G8_WAIT_V(6); G8_BAR; G8_MMA(1, 1, At, B1); G8_BAR;
        }
        E(acc, cur, wr, wc, fr, fq, biasbuf + (ui & 1) * 256);
        if (!has_next) break;
        if (!E.keep(cur))
#pragma unroll
        for (int a = 0; a < 2; ++a)
#pragma unroll
            for (int b = 0; b < 2; ++b)
#pragma unroll
                for (int m = 0; m < 4; ++m)
#pragma unroll
                    for (int n = 0; n < 2; ++n) acc[a][b][m][n] = (f32x4){0.f, 0.f, 0.f, 0.f};
        cur = nxt; cA = nA; cB = nB; ++ui;
    }
    G8_WAIT_V(0);
    if (wr == 0) G8_BAR;
    G8_BAR;
#undef G8_SA
#undef G8_SB
#undef G8_GL
#undef G8_STAGE_A
#undef G8_STAGE_B
#undef G8_LDA
#undef G8_LDB
#undef G8_MMA
#undef G8_WAIT_V
#undef G8_WAIT_L
#undef G8_BAR
#undef G8_SCHED
}

struct PlainSched {
    const bf16_t* A; const bf16_t* Bt; int K, nM, nN, nwg, G, c;
    __device__ __forceinline__ void init(const bf16_t* A_, const bf16_t* Bt_, int M, int N, int K_) { A = A_; Bt = Bt_; K = K_; nM = M / BM; nN = N / BM; nwg = nM * nN; G = gridDim.x; c = blockIdx.x; }
    __device__ __forceinline__ bool next(int i, Unit& u) const {
        const long L = (long)i * G + c; if (L >= nwg) return false;
        int wgid = (int)L; { const int q = nwg / 8, r = nwg % 8, xcd = wgid % 8, off = wgid / 8; wgid = (xcd < r ? xcd * (q + 1) : r * (q + 1) + (xcd - r) * q) + off; }
        const int nig = 8 * nN, gid = wgid / nig, fm = gid * 8, gsz = (nM - fm) < 8 ? (nM - fm) : 8;
        u.pm = fm + ((wgid % nig) % gsz); u.pn = (wgid % nig) / gsz; u.e = 0; return true;
    }
    __device__ __forceinline__ const char* a_base(const Unit& u) const { return (const char*)(A + (size_t)u.pm * BM * K); }
    __device__ __forceinline__ const char* b_base(const Unit& u) const { return (const char*)(Bt + (size_t)u.pn * BM * K); }
    static constexpr bool HAS_BIAS = false, gather = false;
    __device__ __forceinline__ const int* row_addr(const Unit&, int) const { return nullptr; }
    __device__ __forceinline__ int rows_valid(const Unit&) const { return 256; }
    __device__ __forceinline__ const float* bias_src(const Unit&, int) const { return nullptr; }
};
}

__device__ __forceinline__ int w1_dst_row(int n) { const int half = n >> 10, cc = n & 1023; return (cc >> 7) * 256 + half * 128 + (cc & 127); }

struct CvtTile { const float* src; bf16_t* dst; int ld, Nsrc, k0, n0, K, mode; };
__device__ __forceinline__ CvtTile cvt_decode(const Params& p, int it) {
    constexpr int PER_L = 2960 + 512 + 256 + 16384 + 8192;
    CvtTile t; const int l = it / PER_L; int r = it % PER_L;
    if (r < 2960) { const int nt = r % 185, kt = r / 185; t.src = p.w_in + (size_t)l * D * NIN; t.ld = NIN; t.Nsrc = NIN; t.k0 = kt * 64; t.n0 = nt * 64; t.dst = p.winT + (size_t)l * NPW * D; t.K = D; t.mode = 2; }
    else if (r < 3472) { r -= 2960; const int n = r / 128; r %= 128; const int nt = r % 16, kt = r / 16;
        t.src = p.w_branch + (size_t)(l * 4 + n) * MW * D; t.ld = D; t.Nsrc = D; t.k0 = kt * 64; t.n0 = nt * 64; t.dst = p.wbT + (size_t)(l * 4 + n) * D * MW; t.K = MW; t.mode = 0; }
    else if (r < 3728) { r -= 3472; const int nt = r % 16, kt = r / 16; t.src = p.w_out + (size_t)l * D * D; t.ld = D; t.Nsrc = D; t.k0 = kt * 64; t.n0 = nt * 64; t.dst = p.woutT + (size_t)l * D * D; t.K = D; t.mode = 0; }
    else if (r < 3728 + 16384) { r -= 3728; const int ee = r / 512; r %= 512; const int nt = r % 32, kt = r / 32;
        t.src = p.moe_w1 + (size_t)(l * NE + ee) * D * 2 * D; t.ld = 2 * D; t.Nsrc = 2 * D; t.k0 = kt * 64; t.n0 = nt * 64; t.dst = p.w1T + (size_t)(l * NE + ee) * 2 * D * D; t.K = D; t.mode = 1; }
    else { r -= 3728 + 16384; const int ee = r / 256; r %= 256; const int nt = r % 16, kt = r / 16;
        t.src = p.moe_w2 + (size_t)(l * NE + ee) * D * D; t.ld = D; t.Nsrc = D; t.k0 = kt * 64; t.n0 = nt * 64; t.dst = p.w2T + (size_t)(l * NE + ee) * D * D; t.K = D; t.mode = 0; }
    return t;
}

__device__ __forceinline__ void ph_convert(const Params& p, LAS unsigned char* lds) {
    LAS float* tile = (LAS float*)lds;
    const int tid = opaque_tid();
    for (int idx = blockIdx.x * NTHREADS + tid; idx < 2 * 8 * 4 * 4096; idx += gridDim.x * NTHREADS) {
        const int i = idx & 63, j = (idx >> 6) & 63, mat = (idx >> 12) & 3, n = (idx >> 14) & 7, ll = idx >> 17, d = mat >> 1;
        p.lruT[idx] = (bf16_t)f2bf(((mat & 1) ? p.lru_wx : p.lru_wa)[(size_t)((ll * 2 + d) * 8 + n) * 4096 + i * 64 + j]);
    }
    for (int idx = blockIdx.x * NTHREADS + tid; idx < 2 * 2 * MW; idx += gridDim.x * NTHREADS) p.lsig[idx] = 8.0f * logsigmoidf_(p.lru_lambda[idx]);
    for (int idx = blockIdx.x * NTHREADS + tid; idx < TL * 64; idx += gridDim.x * NTHREADS) {
        const int t = idx >> 6, pi = idx & 63;
        const float pos = (pi < 32) ? (float)(t >> 6) : (float)(t & 63);
        const float ang = pos * exp2f(-(float)(pi & 31) * (13.287712379549449f / 32.0f));
        float sn, cs; sincosf(ang, &sn, &cs);
        p.rope[idx] = make_float2(cs, sn);
    }
    constexpr int TOTAL = 2 * (2960 + 512 + 256 + 16384 + 8192);
    for (int idx = blockIdx.x * NTHREADS + tid; idx < 2 * 240 * (D / 8); idx += gridDim.x * NTHREADS) {
        const int ll = idx / (240 * (D / 8)), r = idx % (240 * (D / 8));
        *(u32x4*)(p.winT + ((size_t)ll * NPW + 7696) * D + (size_t)r * 8) = (u32x4){0u, 0u, 0u, 0u};
    }
    for (int g = blockIdx.x; g * 4 < TOTAL; g += gridDim.x) {
        float4 v[4][2];
        const int rr = tid >> 4, c4 = (tid & 15) * 4;
#pragma unroll
        for (int q = 0; q < 4; ++q) {
            const int it = g * 4 + q;
            const CvtTile t = cvt_decode(p, it < TOTAL ? it : TOTAL - 1);
            const int n = t.n0 + c4; const bool ok = n < t.Nsrc; const int nc = ok ? n : t.Nsrc - 4;
#pragma unroll
            for (int i = 0; i < 2; ++i) { const float4 x = *(const float4*)(t.src + (size_t)(t.k0 + rr + i * 32) * t.ld + nc); v[q][i] = ok ? x : make_float4(0.f, 0.f, 0.f, 0.f); }
        }
#pragma unroll
        for (int q = 0; q < 4; ++q)
#pragma unroll
            for (int i = 0; i < 2; ++i) { LAS float* tp = tile + q * 4160 + (rr + i * 32) * 65 + c4; tp[0] = v[q][i].x; tp[1] = v[q][i].y; tp[2] = v[q][i].z; tp[3] = v[q][i].w; }
        __syncthreads();
#pragma unroll
        for (int q = 0; q < 4; ++q) {
            const int it = g * 4 + q;
            if (it < TOTAL) {
                const CvtTile t = cvt_decode(p, it);
                const int nl = tid >> 3, kg = tid & 7, n = t.n0 + nl;
                float w[8];
#pragma unroll
                for (int j = 0; j < 8; ++j) w[j] = tile[q * 4160 + (kg * 8 + j) * 65 + nl];
                const int drow = t.mode == 1 ? w1_dst_row(n) : t.mode == 2 ? win_dst_row(n) : n;
                if (n < t.Nsrc) *(u32x4*)(t.dst + (size_t)drow * t.K + t.k0 + kg * 8) = pack8(w);
            }
        }
        __syncthreads();
    }
}

__device__ __forceinline__ void ph_mod(const Params& p, LAS unsigned char* lds) {
    LAS float* sc = (LAS float*)lds;
    LAS float* red = sc + 5 * D;
    const int tid = opaque_tid(), wid = tid >> 6, lane = tid & 63;
    if ((int)blockIdx.x >= 192) return;
    for (int i = tid; i < 5 * D; i += NTHREADS) { const int r = i >> 10, k = i & 1023; const float v = r < 4 ? p.c[r * D + k] : p.c_ctx[k]; sc[i] = siluf_(v); }
    __syncthreads();
    for (int it = blockIdx.x; it < 192; it += gridDim.x) {
        const int l = it / 96, n0 = (it % 96) * 64;
        float acc[5] = {0.f, 0.f, 0.f, 0.f, 0.f};
        const float* wp = p.w_mod + (size_t)l * D * (NMOD * D) + n0 + lane;
        for (int k = wid * 128; k < wid * 128 + 128; ++k) {
            const float wv = wp[(size_t)k * (NMOD * D)];
#pragma unroll
            for (int r = 0; r < 5; ++r) acc[r] += sc[r * D + k] * wv;
        }
#pragma unroll
        for (int r = 0; r < 5; ++r) red[(wid * 5 + r) * 64 + lane] = acc[r];
        __syncthreads();
        if (tid < 320) { const int r = tid >> 6, cidx = tid & 63; float s = p.b_mod[l * NMOD * D + n0 + cidx];
#pragma unroll
            for (int w = 0; w < 8; ++w) s += red[(w * 5 + r) * 64 + cidx];
            p.mod[(size_t)(l * 5 + r) * (NMOD * D) + n0 + cidx] = s; }
        __syncthreads();
    }
}

__device__ __forceinline__ void norm_mod_store(const float4 (&v)[4], float rinv, const float* g, const float* scp, const float* shp, bf16_t* dst, int lane) {
#pragma unroll
    for (int i = 0; i < 4; ++i) {
        const int cidx = i * 256 + lane * 4;
        const float4 gv = *(const float4*)(g + cidx), sv = *(const float4*)(scp + cidx), hv = *(const float4*)(shp + cidx);
        const float h0 = v[i].x * rinv * gv.x * (1.f + sv.x) + hv.x, h1 = v[i].y * rinv * gv.y * (1.f + sv.y) + hv.y;
        const float h2 = v[i].z * rinv * gv.z * (1.f + sv.z) + hv.z, h3 = v[i].w * rinv * gv.w * (1.f + sv.w) + hv.w;
        u32x2 o; o[0] = pack2(h0, h1); o[1] = pack2(h2, h3);
        *(u32x2*)(dst + cidx) = o;
    }
}
__device__ __forceinline__ void ph_norm1_first(const Params& p) {
    const int tid = opaque_tid(), wid = tid >> 6, lane = tid & 63;
    for (int tok = blockIdx.x * NWAVES + wid; tok < NTOK; tok += gridDim.x * NWAVES) {
        const float* src = tok < NLAT ? p.x + (size_t)tok * D : p.ctx + (size_t)(tok - NLAT) * D;
        float4 v[4]; float ss = 0.f;
#pragma unroll
        for (int i = 0; i < 4; ++i) { v[i] = *(const float4*)(src + i * 256 + lane * 4); ss += v[i].x * v[i].x + v[i].y * v[i].y + v[i].z * v[i].z + v[i].w * v[i].w; }
        ss = wave_sum(ss, lane);
        const float rinv = rsqrtf(ss * (1.0f / D) + 1e-6f);
        const float* mb = p.mod + (size_t)(0 * 5 + tok_modrow(tok)) * (NMOD * D);
        norm_mod_store(v, rinv, p.norm1_g, mb + 1 * D, mb + 0 * D, p.H + (size_t)tok * D, lane);
#pragma unroll
        for (int i = 0; i < 4; ++i) *(float4*)(p.xl + (size_t)tok * D + i * 256 + lane * 4) = v[i];
    }
}

struct EpiP {
    bf16_t* O; bf16_t* gate;
    __device__ __forceinline__ bool keep(const g8::Unit&) const { return false; }
    __device__ __forceinline__ void operator()(const f32x4 (&acc)[2][2][4][2], const g8::Unit& u, int wr, int wc, int fr, int fq, const LAS float*) const {
        if (u.pn < 31) {
            const int row0 = u.pm * 256 + wr * 64 + fr, col0 = u.pn * 256 + wc * 32 + 8 * fq;
#pragma unroll
            for (int ai = 0; ai < 2; ++ai)
#pragma unroll
                for (int m = 0; m < 4; ++m) {
                    bf16_t* rowp = O + (size_t)(row0 + ai * 128 + m * 16) * NP + col0;
#pragma unroll
                    for (int bj = 0; bj < 2; ++bj) {
                        u32x4 w; w[0] = pack2(acc[ai][bj][m][0][0], acc[ai][bj][m][0][1]); w[1] = pack2(acc[ai][bj][m][0][2], acc[ai][bj][m][0][3]);
                        w[2] = pack2(acc[ai][bj][m][1][0], acc[ai][bj][m][1][1]); w[3] = pack2(acc[ai][bj][m][1][2], acc[ai][bj][m][1][3]);
                        *(u32x4*)(rowp + bj * 128) = w;
                    }
                }
        } else {
            const int g = u.pn - 31;
            bf16_t* gp = gate + ((((size_t)u.pm * 16 + g) * 8 + (wr * 4 + wc)) * 16) * 512 + (fq * 16 + fr) * 8;
#pragma unroll
            for (int ai = 0; ai < 2; ++ai)
#pragma unroll
                for (int m = 0; m < 4; ++m)
#pragma unroll
                    for (int bj = 0; bj < 2; ++bj) {
                        float s[8];
#pragma unroll
                        for (int n = 0; n < 2; ++n)
#pragma unroll
                            for (int j = 0; j < 4; ++j) s[n * 4 + j] = sigmoidf_(acc[ai][bj][m][n][j]);
                        *(u32x4*)(gp + (ai * 8 + m * 2 + bj) * 512) = pack8(s);
                    }
        }
    }
};
__device__ __forceinline__ void ph_g1(const Params& p, int l, LAS unsigned char* lds) {
    g8::PlainSched S; S.init(p.H, p.winT + (size_t)l * NPW * D, NTOK, NPW, D);
    EpiP E; E.O = p.P; E.gate = p.gate;
    g8::gemm_phase(lds, D, S, E);
}

__device__ __forceinline__ void ph_prep(const Params& p, int l, LAS unsigned char* lds) {
    const int tid = opaque_tid(), wid = tid >> 6, lane = tid & 63, fr = lane & 15, fq = lane >> 4;
    LAS float* xs = (LAS float*)lds;
    LAS bf16_t* xb = (LAS bf16_t*)(xs + 64 * 68);
    LAS bf16_t* wt = xb + 64 * 72;
    for (int it = blockIdx.x; it < (NTOK / 64) * 8; it += gridDim.x) {
        const int tile = it >> 3, n = it & 7, tok0 = tile * 64;
        {
            const int tl = tid & 63, cg = tid >> 6, tok = tok0 + tl;
            int t, T, base; tok_info(tok, t, T, base);
            float a[8];
            { const float4 b0 = *(const float4*)(p.lru_conv_b + l * MW + n * 64 + cg * 8), b1 = *(const float4*)(p.lru_conv_b + l * MW + n * 64 + cg * 8 + 4);
              a[0] = b0.x; a[1] = b0.y; a[2] = b0.z; a[3] = b0.w; a[4] = b1.x; a[5] = b1.y; a[6] = b1.z; a[7] = b1.w; }
#pragma unroll
            for (int j = 0; j < 4; ++j) {
                const int tt = t + j - 2;
                const float okf = (tt >= 0 && tt < T) ? 1.0f : 0.0f;
                const int ttc = tt < 0 ? 0 : (tt >= T ? T - 1 : tt);
                const u32x4 u = *(const u32x4*)(p.P + (size_t)(base + ttc) * NP + C_LX + n * 64 + cg * 8);
                const float* w = p.lru_conv_w + (size_t)(l * 4 + j) * MW + n * 64 + cg * 8;
                const float4 wa = *(const float4*)w, wb = *(const float4*)(w + 4);
                const float wv[8] = {wa.x * okf, wa.y * okf, wa.z * okf, wa.w * okf, wb.x * okf, wb.y * okf, wb.z * okf, wb.w * okf};
#pragma unroll
                for (int q = 0; q < 4; ++q) { a[2 * q] += wv[2 * q] * bflo(u[q]); a[2 * q + 1] += wv[2 * q + 1] * bfhi(u[q]); }
            }
            *(LAS f32x4*)(xs + tl * 68 + cg * 8) = (f32x4){a[0], a[1], a[2], a[3]}; *(LAS f32x4*)(xs + tl * 68 + cg * 8 + 4) = (f32x4){a[4], a[5], a[6], a[7]};
            *(LAS u32x4*)(xb + tl * 72 + cg * 8) = pack8(a);
            const bf16_t* wsrc = p.lruT + (size_t)((l * 8 + n) * 4) * 4096;
#pragma unroll
            for (int q = 0; q < 4; ++q) { const int e8 = tid + 512 * q, row = e8 >> 3, c8 = e8 & 7; *(LAS u32x4*)(wt + row * 72 + c8 * 8) = *(const u32x4*)(wsrc + (size_t)e8 * 8); }
        }
        __syncthreads();
        {
            const int jb = wid & 3, tb0 = (wid >> 2) * 2;
            bf16x8 xw[4][2];
#pragma unroll
            for (int m = 0; m < 4; ++m)
#pragma unroll
                for (int ks = 0; ks < 2; ++ks) xw[m][ks] = *(const LAS bf16x8*)(wt + (m * 64 + jb * 16 + fr) * 72 + ks * 32 + fq * 8);
            const int c0 = n * 64 + jb * 16 + 4 * fq;
            float4 bav[2], bxv[2], lsv[2];
#pragma unroll
            for (int d = 0; d < 2; ++d) {
                bav[d] = *(const float4*)(p.lru_ba + (l * 2 + d) * MW + c0); bxv[d] = *(const float4*)(p.lru_bx + (l * 2 + d) * MW + c0);
                lsv[d] = *(const float4*)(p.lsig + (l * 2 + d) * MW + c0);
            }
#pragma unroll
            for (int e = 0; e < 2; ++e) {
                const int tl = (tb0 + e) * 16 + fr, tok = tok0 + tl;
                f32x4 acc[4];
#pragma unroll
                for (int m = 0; m < 4; ++m) acc[m] = (f32x4){0.f, 0.f, 0.f, 0.f};
#pragma unroll
                for (int ks = 0; ks < 2; ++ks) {
                    const bf16x8 y = *(const LAS bf16x8*)(xb + tl * 72 + ks * 32 + fq * 8);
#pragma unroll
                    for (int m = 0; m < 4; ++m) acc[m] = mfma16(xw[m][ks], y, acc[m]);
                }
                const f32x4 xv = *(const LAS f32x4*)(xs + tl * 68 + jb * 16 + 4 * fq);
#pragma unroll
                for (int d = 0; d < 2; ++d) {
                    const float bar_[4] = {bav[d].x, bav[d].y, bav[d].z, bav[d].w}, bxr[4] = {bxv[d].x, bxv[d].y, bxv[d].z, bxv[d].w}, lsr[4] = {lsv[d].x, lsv[d].y, lsv[d].z, lsv[d].w};
                    float av[4], uv[4];
#pragma unroll
                    for (int r = 0; r < 4; ++r) {
                        const float gr = sigmoidf_(acc[d * 2][r] + bar_[r]), gi = sigmoidf_(acc[d * 2 + 1][r] + bxr[r]);
                        const float la = gr * lsr[r];
                        av[r] = __expf(la);
                        uv[r] = xv[r] * gi * __builtin_amdgcn_sqrtf(fmaxf(1.0f - __expf(2.0f * la), 1e-12f));
                    }
                    *(float4*)(p.prep + (PR_LA + d) * TOKW + (size_t)tok * MW + c0) = make_float4(av[0], av[1], av[2], av[3]);
                    *(float4*)(p.prep + (PR_LU + d) * TOKW + (size_t)tok * MW + c0) = make_float4(uv[0], uv[1], uv[2], uv[3]);
                }
            }
        }
        __syncthreads();
    }
}

__device__ __forceinline__ int chunk_base(int b, int d, int n) {
    if (n < 4) { const int blk = d ? 3 - n : n; return NLAT + b * TC + blk * 64; }
    const int m = n - 4, blk = d ? 63 - m : m; return b * TL + blk * 64;
}

__device__ __forceinline__ void local_gla(const Params& p, int l, int tz, int chain, int n, LAS unsigned char* lds) {
    const int tid = opaque_tid(), wid = tid >> 6, lane = tid & 63, fr = lane & 15, fq = lane >> 4;
    const int b = chain >> 3, h = (chain >> 1) & 3, d = chain & 1;
    const int base = chunk_base(b, d, n);
    const size_t item = (size_t)tz * NITEM + (size_t)chain * NCHUNK + n;
    LAS bf16_t* qh = (LAS bf16_t*)lds;
    LAS bf16_t* kh = qh + 64 * 136;
    LAS bf16_t* sc = kh + 10 * 16 * 136;
    LAS bf16_t* vT = sc + 64 * 72;
    LAS bf16_t* kT = vT + 128 * 72;
    LAS float* bc = (LAS float*)(kT + 128 * 72);
    const int vcol = tz == 1 ? C_HI : C_RQKV + 1024;
    const int ti = tid >> 3, dg = tid & 7, cA = dg * 8, cB = 64 + dg * 8;
    const int tokI = base + (d ? 63 - ti : ti);
    const bf16_t* pr = p.P + (size_t)tokI * NP;
    float qt[16], kv[16];
    {
        float lfv[16];
        if (tz == 1) {
            float lbv[16];
            {
                const float* lp0 = p.hgrn_lb + (size_t)(0 * 2 + d) * MW + h * 128; const float* lp1 = p.hgrn_lb + (size_t)(1 * 2 + d) * MW + h * 128;
                const float4 a0 = *(const float4*)(lp0 + cA), a1 = *(const float4*)(lp0 + cA + 4), a2 = *(const float4*)(lp0 + cB), a3 = *(const float4*)(lp0 + cB + 4);
                const float4 b0 = *(const float4*)(lp1 + cA), b1 = *(const float4*)(lp1 + cA + 4), b2 = *(const float4*)(lp1 + cB), b3 = *(const float4*)(lp1 + cB + 4);
                const float x0[16] = {a0.x, a0.y, a0.z, a0.w, a1.x, a1.y, a1.z, a1.w, a2.x, a2.y, a2.z, a2.w, a3.x, a3.y, a3.z, a3.w};
                const float x1[16] = {b0.x, b0.y, b0.z, b0.w, b1.x, b1.y, b1.z, b1.w, b2.x, b2.y, b2.z, b2.w, b3.x, b3.y, b3.z, b3.w};
#pragma unroll
                for (int e = 0; e < 16; ++e) lbv[e] = (l == 1) ? fminf(__builtin_amdgcn_rcpf(1.0f + __expf(x0[e] - x1[e])), 1.0f - 1e-4f) : 0.f;
            }
            const u32x4 uqa = *(const u32x4*)(pr + C_HQ + h * 128 + cA), uqb = *(const u32x4*)(pr + C_HQ + h * 128 + cB);
            const u32x4 uza = *(const u32x4*)(pr + C_HF + d * 512 + h * 128 + cA), uzb = *(const u32x4*)(pr + C_HF + d * 512 + h * 128 + cB);
#pragma unroll
            for (int e = 0; e < 16; ++e) {
                const unsigned uq = e < 8 ? uqa[(e & 7) >> 1] : uqb[(e & 7) >> 1], uz = e < 8 ? uza[(e & 7) >> 1] : uzb[(e & 7) >> 1];
                const float qraw = (e & 1) ? bfhi(uq) : bflo(uq), z = (e & 1) ? bfhi(uz) : bflo(uz);
                const float lb = lbv[e];
                const float sg = sigmoidf_(z);
                qt[e] = siluf_(qraw) * 0.08838834764831845f;
                kv[e] = (1.f - lb) * (1.f - sg);
                lfv[e] = __logf(fmaxf(lb + (1.f - lb) * sg, 1e-30f));
            }
        }
        *(LAS f32x4*)(bc + ti * 132 + cA) = (f32x4){lfv[0], lfv[1], lfv[2], lfv[3]}; *(LAS f32x4*)(bc + ti * 132 + cA + 4) = (f32x4){lfv[4], lfv[5], lfv[6], lfv[7]};
        *(LAS f32x4*)(bc + ti * 132 + cB) = (f32x4){lfv[8], lfv[9], lfv[10], lfv[11]}; *(LAS f32x4*)(bc + ti * 132 + cB + 4) = (f32x4){lfv[12], lfv[13], lfv[14], lfv[15]};
        const bf16_t* vp = pr + vcol + h * 128;
        const u32x4 v0 = *(const u32x4*)(vp + cA), v1 = *(const u32x4*)(vp + cB);
#pragma unroll
        for (int e = 0; e < 8; ++e) {
            vT[(cA + e) * 72 + ti] = (bf16_t)((e & 1) ? (v0[e >> 1] >> 16) : (v0[e >> 1] & 0xffffu));
            vT[(cB + e) * 72 + ti] = (bf16_t)((e & 1) ? (v1[e >> 1] >> 16) : (v1[e >> 1] & 0xffffu));
        }
    }
    __syncthreads();
    if (tid < 128) {
        float run = 0.f, lv[64];
#pragma unroll
        for (int i = 0; i < 64; ++i) lv[i] = bc[i * 132 + tid];
#pragma unroll
        for (int i = 0; i < 64; ++i) { run += lv[i]; bc[i * 132 + tid] = run; }
    }
    __syncthreads();
    {
        const int J = ti >> 4;
        float qhat[16];
#pragma unroll
        for (int e = 0; e < 16; ++e) {
            const int ch = e < 8 ? cA + e : cB + e - 8;
            const float bi = bc[ti * 132 + ch], rJ = J ? bc[(16 * J - 1) * 132 + ch] : 0.f, bl = bc[63 * 132 + ch];
            qhat[e] = qt[e] * __expf(bi - rJ); qt[e] = qt[e] * __expf(bi);
            kT[ch * 72 + ti] = (bf16_t)f2bf(kv[e] * __expf(bl - bi));
        }
        *(LAS u32x4*)(qh + ti * 136 + cA) = pack8(qhat); *(LAS u32x4*)(qh + ti * 136 + cB) = pack8(qhat + 8);
#pragma unroll
        for (int I = 0; I < 4; ++I) {
            if (I >= J) {
                float kk[16];
#pragma unroll
                for (int e = 0; e < 16; ++e) {
                    const int ch = e < 8 ? cA + e : cB + e - 8;
                    const float rI = I ? bc[(16 * I - 1) * 132 + ch] : 0.f, bj = bc[ti * 132 + ch];
                    kk[e] = kv[e] * __expf(fminf(rI - bj, 80.f));
                }
                LAS bf16_t* kp = kh + ((I * (I + 1) / 2 + J) * 16 + (ti & 15)) * 136;
                *(LAS u32x4*)(kp + cA) = pack8(kk); *(LAS u32x4*)(kp + cB) = pack8(kk + 8);
            }
        }
        *(LAS u32x4*)(sc + ti * 72 + dg * 8) = (u32x4){0u, 0u, 0u, 0u};
        {
            bf16_t* lqb = p.lq + item * 8192 + (size_t)((ti >> 4) * 8) * 256 + (ti & 15) * 4;
            const u32x4 pa = pack8(qt), pb = pack8(qt + 8);
            u32x2 t0; t0[0] = pa[0]; t0[1] = pa[1]; u32x2 t1; t1[0] = pa[2]; t1[1] = pa[3]; u32x2 t2; t2[0] = pb[0]; t2[1] = pb[1]; u32x2 t3; t3[0] = pb[2]; t3[1] = pb[3];
            *(u32x2*)(lqb + (dg >> 1) * 256 + ((dg & 1) * 2 + 0) * 64) = t0; *(u32x2*)(lqb + (dg >> 1) * 256 + ((dg & 1) * 2 + 1) * 64) = t1;
            *(u32x2*)(lqb + (4 + (dg >> 1)) * 256 + ((dg & 1) * 2 + 0) * 64) = t2; *(u32x2*)(lqb + (4 + (dg >> 1)) * 256 + ((dg & 1) * 2 + 1) * 64) = t3;
        }
    }
    if (tid < 128) p.ld[item * 128 + tid] = __expf(bc[63 * 132 + tid]);
    __syncthreads();
#pragma unroll
    for (int rep2 = 0; rep2 < 2; ++rep2) {
        const int t = wid + 8 * rep2;
        if (t < 10) {
            const int I = t >= 6 ? 3 : t >= 3 ? 2 : t >= 1 ? 1 : 0, J = t - I * (I + 1) / 2;
            f32x4 acc = (f32x4){0.f, 0.f, 0.f, 0.f};
#pragma unroll
            for (int ks = 0; ks < 4; ++ks)
                acc = mfma16(*(const LAS bf16x8*)(kh + (t * 16 + fr) * 136 + ks * 32 + fq * 8), *(const LAS bf16x8*)(qh + (I * 16 + fr) * 136 + ks * 32 + fq * 8), acc);
            const int i = 16 * I + fr, j0 = 16 * J + 4 * fq;
#pragma unroll
            for (int r = 0; r < 4; ++r) if (j0 + r > i) acc[r] = 0.f;
            *(LAS u32x2*)(sc + i * 72 + j0) = pack4(acc);
        }
    }
    __syncthreads();
    {
        bf16x8 xv[2], xk[2];
#pragma unroll
        for (int ks = 0; ks < 2; ++ks) { xv[ks] = *(const LAS bf16x8*)(vT + (wid * 16 + fr) * 72 + ks * 32 + fq * 8); xk[ks] = *(const LAS bf16x8*)(kT + (wid * 16 + fr) * 72 + ks * 32 + fq * 8); }
#pragma unroll
        for (int ib = 0; ib < 4; ++ib) {
            f32x4 acc = (f32x4){0.f, 0.f, 0.f, 0.f};
#pragma unroll
            for (int ks = 0; ks < 2; ++ks) acc = mfma16(xv[ks], *(const LAS bf16x8*)(sc + (ib * 16 + fr) * 72 + ks * 32 + fq * 8), acc);
            *(u32x2*)(p.lo + item * 8192 + ((wid * 4 + ib) * 64 + lane) * 4) = pack4(acc);
        }
#pragma unroll
        for (int dvb = 0; dvb < 8; ++dvb) {
            f32x4 acc = (f32x4){0.f, 0.f, 0.f, 0.f};
#pragma unroll
            for (int ks = 0; ks < 2; ++ks) acc = mfma16(xk[ks], *(const LAS bf16x8*)(vT + (dvb * 16 + fr) * 72 + ks * 32 + fq * 8), acc);
            *(u32x2*)(p.lb + item * 16384 + ((wid * 8 + dvb) * 64 + lane) * 4) = pack4(acc);
        }
    }
    __syncthreads();
}


template <int MODE> __device__ __forceinline__ void local_ret(const Params& p, int l, int chain, int n, LAS unsigned char* lds) {
    const int tid = opaque_tid(), wid = tid >> 6, lane = tid & 63, fr = lane & 15, fq = lane >> 4;
    const int b = chain >> 3, h = (chain >> 1) & 3, d = chain & 1;
    const int base = chunk_base(b, d, n);
    const size_t item = (size_t)2 * NITEM + (size_t)chain * NCHUNK + n;
    LAS bf16_t* ks_ = (LAS bf16_t*)lds;
    LAS bf16_t* qs = ks_ + 64 * 136;
    LAS bf16_t* sc = qs + 64 * 136;
    LAS bf16_t* vT = sc + 64 * 72;
    LAS bf16_t* kT = vT + 128 * 72;
    const int ti = tid >> 3, dg = tid & 7, cA = dg * 8, cB = 64 + dg * 8;
    const int tokI = base + (d ? 63 - ti : ti);
    const bf16_t* pr = p.P + (size_t)tokI * NP + C_RQKV + h * 128;
    const float lng = ret_log_gamma(h);
    {
        const u32x4 q1 = *(const u32x4*)(pr + cA), q2 = *(const u32x4*)(pr + cB), k1 = *(const u32x4*)(pr + 512 + cA), k2 = *(const u32x4*)(pr + 512 + cB);
        const u32x4 v0 = *(const u32x4*)(pr + 1024 + cA), v1 = *(const u32x4*)(pr + 1024 + cB);
        const bool lat = tokI < NLAT;
        const int t = tokI & (TL - 1);
        float qv[16], kv[16];
#pragma unroll
        for (int e = 0; e < 8; ++e) {
            float a1 = (e & 1) ? bfhi(q1[e >> 1]) : bflo(q1[e >> 1]), a2 = (e & 1) ? bfhi(q2[e >> 1]) : bflo(q2[e >> 1]);
            float b1 = (e & 1) ? bfhi(k1[e >> 1]) : bflo(k1[e >> 1]), b2 = (e & 1) ? bfhi(k2[e >> 1]) : bflo(k2[e >> 1]);
            {
                const float2 cst = p.rope[(size_t)t * 64 + cA + e];
                const float cs = lat ? cst.x : 1.0f, sn = lat ? cst.y : 0.0f;
                const float n1 = a1 * cs - a2 * sn, n2 = a1 * sn + a2 * cs, m1 = b1 * cs - b2 * sn, m2 = b1 * sn + b2 * cs;
                a1 = n1; a2 = n2; b1 = m1; b2 = m2;
            }
            qv[e] = a1; qv[8 + e] = a2; kv[e] = b1 * 0.08838834764831845f; kv[8 + e] = b2 * 0.08838834764831845f;
        }
        *(LAS u32x4*)(ks_ + ti * 136 + cA) = pack8(kv); *(LAS u32x4*)(ks_ + ti * 136 + cB) = pack8(kv + 8);
        *(LAS u32x4*)(qs + ti * 136 + cA) = pack8(qv); *(LAS u32x4*)(qs + ti * 136 + cB) = pack8(qv + 8);
        const float gq = __expf((float)(ti + 1) * lng), gk = __expf((float)(63 - ti) * lng);
#pragma unroll
        for (int e = 0; e < 8; ++e) {
            vT[(cA + e) * 72 + ti] = (bf16_t)((e & 1) ? (v0[e >> 1] >> 16) : (v0[e >> 1] & 0xffffu));
            vT[(cB + e) * 72 + ti] = (bf16_t)((e & 1) ? (v1[e >> 1] >> 16) : (v1[e >> 1] & 0xffffu));
            kT[(cA + e) * 72 + ti] = (bf16_t)f2bf(kv[e] * gk); kT[(cB + e) * 72 + ti] = (bf16_t)f2bf(kv[8 + e] * gk);
            qv[e] *= gq; qv[8 + e] *= gq;
        }
        {
            bf16_t* lqb = p.lq + item * 8192 + (size_t)((ti >> 4) * 8) * 256 + (ti & 15) * 4;
            const u32x4 pa = pack8(qv), pb = pack8(qv + 8);
            u32x2 t0; t0[0] = pa[0]; t0[1] = pa[1]; u32x2 t1; t1[0] = pa[2]; t1[1] = pa[3]; u32x2 t2; t2[0] = pb[0]; t2[1] = pb[1]; u32x2 t3; t3[0] = pb[2]; t3[1] = pb[3];
            *(u32x2*)(lqb + (dg >> 1) * 256 + ((dg & 1) * 2 + 0) * 64) = t0; *(u32x2*)(lqb + (dg >> 1) * 256 + ((dg & 1) * 2 + 1) * 64) = t1;
            *(u32x2*)(lqb + (4 + (dg >> 1)) * 256 + ((dg & 1) * 2 + 0) * 64) = t2; *(u32x2*)(lqb + (4 + (dg >> 1)) * 256 + ((dg & 1) * 2 + 1) * 64) = t3;
        }
    }
    if (tid < 128) p.ld[item * 128 + tid] = __expf(64.0f * lng);
    __syncthreads();
#pragma unroll
    for (int e = 0; e < 2; ++e) {
        const int f = wid * 2 + e, ib = f >> 2, jb = f & 3;
        const int i = 16 * ib + fr, j0 = 16 * jb + 4 * fq;
        f32x4 mq = (f32x4){0.f, 0.f, 0.f, 0.f};
        if (jb <= ib) {
#pragma unroll
            for (int ks = 0; ks < 4; ++ks)
                mq = mfma16(*(const LAS bf16x8*)(ks_ + (jb * 16 + fr) * 136 + ks * 32 + fq * 8), *(const LAS bf16x8*)(qs + i * 136 + ks * 32 + fq * 8), mq);
#pragma unroll
            for (int r = 0; r < 4; ++r) { const int j = j0 + r; mq[r] = (j <= i) ? mq[r] * __expf((float)(i - j) * lng) : 0.f; }
        }
        *(LAS u32x2*)(sc + i * 72 + j0) = pack4(mq);
    }
    __syncthreads();
    {
        bf16x8 xv[2], xk[2];
#pragma unroll
        for (int ks = 0; ks < 2; ++ks) { xv[ks] = *(const LAS bf16x8*)(vT + (wid * 16 + fr) * 72 + ks * 32 + fq * 8); xk[ks] = *(const LAS bf16x8*)(kT + (wid * 16 + fr) * 72 + ks * 32 + fq * 8); }
#pragma unroll
        for (int ib = 0; ib < 4; ++ib) {
            f32x4 acc = (f32x4){0.f, 0.f, 0.f, 0.f};
#pragma unroll
            for (int ks = 0; ks < 2; ++ks) acc = mfma16(xv[ks], *(const LAS bf16x8*)(sc + (ib * 16 + fr) * 72 + ks * 32 + fq * 8), acc);
            *(u32x2*)(p.lo + item * 8192 + ((wid * 4 + ib) * 64 + lane) * 4) = pack4(acc);
        }
#pragma unroll
        for (int dvb = 0; dvb < 8; ++dvb) {
            f32x4 acc = (f32x4){0.f, 0.f, 0.f, 0.f};
#pragma unroll
            for (int ks = 0; ks < 2; ++ks) acc = mfma16(xk[ks], *(const LAS bf16x8*)(vT + (dvb * 16 + fr) * 72 + ks * 32 + fq * 8), acc);
            *(u32x2*)(p.lb + item * 16384 + ((wid * 8 + dvb) * 64 + lane) * 4) = pack4(acc);
        }
    }
    __syncthreads();
}

__device__ __forceinline__ void local_gdn(const Params& p, int l, int bh, int seg, int blk, LAS unsigned char* lds) {
    const int tid = opaque_tid(), wid = tid >> 6, lane = tid & 63, fr = lane & 15, fq = lane >> 4;
    const int b = bh >> 2, h = bh & 3;
    const int base = seg ? b * TL + blk * 64 : NLAT + b * TC + blk * 64;
    LAS bf16_t* ks_ = (LAS bf16_t*)lds;
    LAS bf16_t* qs = ks_ + 64 * 136;
    LAS bf16_t* att = qs + 64 * 136;
    LAS bf16_t* wT = att + 64 * 72;
    LAS bf16_t* uT = wT + 128 * 72;
    LAS bf16_t* kT = uT + 128 * 72;
    LAS bf16_t* tT = kT;
    LAS bf16_t* Mneg = kT + 128 * 72;
    LAS float* Md = (LAS float*)(Mneg + 64 * 72);
    LAS float* bcs = (LAS float*)(kT + 128 * 72) + 64 * 68;
    LAS float* bts = bcs + 64;
    LAS float* rse = bts + 64;
    LAS bf16_t* vs = (LAS bf16_t*)(rse + 64);
    LAS bf16_t* Db = (LAS bf16_t*)(vs + 64 * 136);
    LAS float* cw = (LAS float*)(vs + 64 * 136);
    const int ti = tid >> 3, d0 = (tid & 7) * 16;
    const int tokI = base + ti;
    {
        int t, T, sbase; tok_info(tokI, t, T, sbase);
        u32x4 xr[3][4][2];
#pragma unroll
        for (int j = 0; j < 4; ++j) {
            const int tt = t + j - 2;
            const bool ok = (tt >= 0 && tt < T);
            const int ttc = tt < 0 ? 0 : (tt >= T ? T - 1 : tt);
            const bf16_t* xp = p.P + (size_t)(sbase + ttc) * NP + C_GQKV + h * 128 + d0;
#pragma unroll
            for (int part = 0; part < 3; ++part) {
                const u32x4 a0 = *(const u32x4*)(xp + part * 512), a1 = *(const u32x4*)(xp + part * 512 + 8);
#pragma unroll
                for (int q = 0; q < 4; ++q) { xr[part][j][0][q] = ok ? a0[q] : 0u; xr[part][j][1][q] = ok ? a1[q] : 0u; }
            }
        }
        if (tid < 384) {
            const int row = tid >> 5, c4 = (tid & 31) * 4, part = row >> 2, j = row & 3;
            *(LAS f32x4*)(cw + row * 128 + c4) = *(const f32x4*)(p.gdn_conv_w + (size_t)(l * 4 + j) * 1536 + part * 512 + h * 128 + c4);
        }
        __syncthreads();
#pragma unroll
        for (int part = 0; part < 3; ++part) {
            float a[16];
#pragma unroll
            for (int e = 0; e < 16; ++e) a[e] = 0.f;
#pragma unroll
            for (int j = 0; j < 4; ++j) {
                const u32x4 x0 = xr[part][j][0], x1 = xr[part][j][1];
                const LAS float* wp = cw + (part * 4 + j) * 128 + d0;
#pragma unroll
                for (int q = 0; q < 4; ++q) {
                    const f32x4 w0 = *(const LAS f32x4*)(wp + q * 4);
                    const unsigned ua = q < 2 ? x0[2 * q] : x1[2 * q - 4], ub = q < 2 ? x0[2 * q + 1] : x1[2 * q - 3];
                    a[q * 4] += w0[0] * bflo(ua); a[q * 4 + 1] += w0[1] * bfhi(ua); a[q * 4 + 2] += w0[2] * bflo(ub); a[q * 4 + 3] += w0[3] * bfhi(ub);
                }
            }
            float ss = 0.f;
#pragma unroll
            for (int e = 0; e < 16; ++e) { a[e] = siluf_(a[e]); ss += a[e] * a[e]; }
            if (part < 2) {
                ss += shx(ss, 1, lane); ss += shx(ss, 2, lane); ss += shx(ss, 4, lane);
                const float scl = rsqrtf(ss + 1e-6f) * (part == 0 ? 0.08838834764831845f : 1.0f);
#pragma unroll
                for (int e = 0; e < 16; ++e) a[e] *= scl;
            }
            LAS bf16_t* dstt = (part == 0 ? qs : part == 1 ? ks_ : vs) + ti * 136 + d0;
            *(LAS u32x4*)dstt = pack8(a); *(LAS u32x4*)(dstt + 8) = pack8(a + 8);
        }
    }
#pragma unroll 1
  for (int d = 0; d < 2; ++d) {
    const int n = seg ? 4 + (d ? 63 - blk : blk) : (d ? 3 - blk : blk);
    const size_t item = (size_t)(bh * 2 + d) * NCHUNK + n;
#define RR(x) (d ? 63 - (x) : (x))
    const int tid = opaque_tid(), wid = tid >> 6, lane = tid & 63, fr = lane & 15, fq = lane >> 4, ti = tid >> 3, d0 = (tid & 7) * 16;
    if (wid == 0) {
        const int tok = base + RR(lane);
        const float av = bf2f(p.P[(size_t)tok * NP + C_GA + d * 4 + h]);
        float v = -__expf(p.gdn_a_log[l * 8 + d * 4 + h]) * softplusf_(av + p.gdn_dt_bias[l * 8 + d * 4 + h]);
#pragma unroll
        for (int off = 1; off < 64; off <<= 1) { const float t = shup(v, off, lane); if (lane >= off) v += t; }
        const float btv = sigmoidf_(bf2f(p.P[(size_t)tok * NP + C_GB + d * 4 + h]));
        bcs[lane] = v; bts[lane] = btv; rse[lane] = btv * __expf(v);
    }
    __syncthreads();
#pragma unroll
    for (int e = 0; e < 2; ++e) {
        const int f = wid * 2 + e, ib = f >> 2, jb = f & 3;
        const int i = 16 * ib + fr, j0 = 16 * jb + 4 * fq;
        f32x4 mk = (f32x4){0.f, 0.f, 0.f, 0.f}, mq = (f32x4){0.f, 0.f, 0.f, 0.f};
        if (jb <= ib) {
#pragma unroll
            for (int ks = 0; ks < 4; ++ks) {
                const bf16x8 xk = *(const LAS bf16x8*)(ks_ + RR(jb * 16 + fr) * 136 + ks * 32 + fq * 8);
                mk = mfma16(xk, *(const LAS bf16x8*)(ks_ + RR(ib * 16 + fr) * 136 + ks * 32 + fq * 8), mk);
                mq = mfma16(xk, *(const LAS bf16x8*)(qs + RR(ib * 16 + fr) * 136 + ks * 32 + fq * 8), mq);
            }
            const float bi = bcs[i], bti = bts[i];
#pragma unroll
            for (int r = 0; r < 4; ++r) {
                const int j = j0 + r;
                const float dec = __expf(j <= i ? bi - bcs[j] : 0.f);
                mk[r] = (j < i) ? bti * mk[r] * dec : 0.f;
                mq[r] = (j <= i) ? mq[r] * dec : 0.f;
            }
        }
        {
            u32x2 mn; mn[0] = 0u; mn[1] = 0u;
            if (jb < ib) mn = pack4((f32x4){-mk[0], -mk[1], -mk[2], -mk[3]});
            *(LAS u32x2*)(Mneg + i * 72 + j0) = mn;
            if (jb == ib) *(LAS f32x4*)(Md + (ib * 16 + fr) * 20 + 4 * fq) = mk;
        }
        *(LAS u32x2*)(att + i * 72 + j0) = pack4(mq);
        if (e == 0) {
            const int zr = tid >> 1, zh = tid & 1;
            LAS bf16_t* zx = (zr < 128 ? uT + zr * 72 : wT + (zr - 128) * 72) + zh * 32;
#pragma unroll
            for (int q = 0; q < 4; ++q) *(LAS u32x4*)(zx + q * 8) = (u32x4){0u, 0u, 0u, 0u};
            *(LAS u32x4*)(tT + zr * 32 + 16 + zh * 8) = (u32x4){0u, 0u, 0u, 0u};
        }
    }
    __syncthreads();
    if (wid == 0) {
        const int R = lane >> 4, cc = lane & 15;
        float y[16];
#pragma unroll
        for (int i = 0; i < 16; ++i) {
            float acc = (i == cc) ? 1.0f : 0.0f;
#pragma unroll
            for (int j4 = 0; j4 < (i + 3) / 4; ++j4) {
                const f32x4 m = *(const LAS f32x4*)(Md + (R * 16 + i) * 20 + j4 * 4);
#pragma unroll
                for (int q = 0; q < 4; ++q) if (j4 * 4 + q < i) acc -= m[q] * y[j4 * 4 + q];
            }
            y[i] = acc;
            Db[(R * 16 + i) * 40 + cc] = (bf16_t)f2bf(acc);
        }
        *(LAS u32x4*)(Db + lane * 40 + 16) = (u32x4){0u, 0u, 0u, 0u}; *(LAS u32x4*)(Db + lane * 40 + 24) = (u32x4){0u, 0u, 0u, 0u};
    }
    __syncthreads();
#pragma unroll
    for (int R = 0; R < 4; ++R) {
        f32x4 tacc[2];
#pragma unroll
        for (int e = 0; e < 2; ++e) {
            const int cb = wid * 2 + e;
            const int i = 16 * R + fr;
            const u32x2 rv = *(const LAS u32x2*)((cb < 8 ? vs + cb * 16 : ks_ + (cb - 8) * 16) + RR(i) * 136 + 4 * fq);
            const float sc = cb < 8 ? bts[i] : -rse[i];
            f32x4 acc = (f32x4){bflo(rv[0]) * sc, bfhi(rv[0]) * sc, bflo(rv[1]) * sc, bfhi(rv[1]) * sc};
            if (R > 0) {
                const LAS bf16_t* xt = (cb < 8 ? uT + cb * 16 * 72 : wT + (cb - 8) * 16 * 72) + fr * 72 + fq * 8;
#pragma unroll
                for (int ks = 0; ks < (R + 1) / 2; ++ks) acc = mfma16(*(const LAS bf16x8*)(xt + ks * 32), *(const LAS bf16x8*)(Mneg + i * 72 + ks * 32 + fq * 8), acc);
            }
            tacc[e] = acc;
            LAS bf16_t* tp = tT + (cb * 16 + 4 * fq) * 32 + fr;
            tp[0] = (bf16_t)f2bf(acc[0]); tp[32] = (bf16_t)f2bf(acc[1]); tp[64] = (bf16_t)f2bf(acc[2]); tp[96] = (bf16_t)f2bf(acc[3]);
        }
        __syncthreads();
#pragma unroll
        for (int e = 0; e < 2; ++e) {
            const int cb = wid * 2 + e;
            f32x4 acc = (f32x4){0.f, 0.f, 0.f, 0.f};
            acc = mfma16(*(const LAS bf16x8*)(tT + (cb * 16 + fr) * 32 + fq * 8), *(const LAS bf16x8*)(Db + (R * 16 + fr) * 40 + fq * 8), acc);
            LAS bf16_t* xp = (cb < 8 ? uT + cb * 16 * 72 : wT + (cb - 8) * 16 * 72) + (4 * fq) * 72 + 16 * R + fr;
            xp[0] = (bf16_t)f2bf(acc[0]); xp[72] = (bf16_t)f2bf(acc[1]); xp[144] = (bf16_t)f2bf(acc[2]); xp[216] = (bf16_t)f2bf(acc[3]);
        }
        __syncthreads();
    }
    {
        const int pi = RR(ti);
        const float sc_ = __expf(bcs[63] - bcs[pi]);
#pragma unroll
        for (int e = 0; e < 16; ++e) kT[(d0 + e) * 72 + pi] = (bf16_t)f2bf(bf2f(ks_[ti * 136 + d0 + e]) * sc_);
    }
    if (tid < 128) p.ld[item * 128 + tid] = __expf(bcs[63]);
    __syncthreads();
    {
        const int tid = opaque_tid(), wid = tid >> 6, lane = tid & 63, fr = lane & 15, fq = lane >> 4;
        bf16x8 xw[2], xu[2], xk[2];
#pragma unroll
        for (int ks = 0; ks < 2; ++ks) {
            xw[ks] = *(const LAS bf16x8*)(wT + (wid * 16 + fr) * 72 + ks * 32 + fq * 8);
            xu[ks] = *(const LAS bf16x8*)(uT + (wid * 16 + fr) * 72 + ks * 32 + fq * 8);
            xk[ks] = *(const LAS bf16x8*)(kT + (wid * 16 + fr) * 72 + ks * 32 + fq * 8);
        }
#pragma unroll
        for (int ib = 0; ib < 4; ++ib) {
            const int i = ib * 16 + fr;
            const u32x2 qr = *(const LAS u32x2*)(qs + RR(i) * 136 + wid * 16 + 4 * fq);
            const float eb = __expf(bcs[i]);
            f32x4 aq = (f32x4){bflo(qr[0]) * eb, bfhi(qr[0]) * eb, bflo(qr[1]) * eb, bfhi(qr[1]) * eb};
            f32x4 ao = (f32x4){0.f, 0.f, 0.f, 0.f};
#pragma unroll
            for (int ks = 0; ks < 2; ++ks) {
                const bf16x8 ya = *(const LAS bf16x8*)(att + i * 72 + ks * 32 + fq * 8);
                aq = mfma16(xw[ks], ya, aq); ao = mfma16(xu[ks], ya, ao);
            }
            *(u32x2*)(p.lq + item * 8192 + ((ib * 8 + wid) * 64 + lane) * 4) = pack4(aq);
            *(u32x2*)(p.lo + item * 8192 + ((wid * 4 + ib) * 64 + lane) * 4) = pack4(ao);
        }
#pragma unroll
        for (int db = 0; db < 8; ++db) {
            f32x4 aa = (f32x4){0.f, 0.f, 0.f, 0.f}, ab = (f32x4){0.f, 0.f, 0.f, 0.f};
#pragma unroll
            for (int ks = 0; ks < 2; ++ks) {
                aa = mfma16(xw[ks], *(const LAS bf16x8*)(kT + (db * 16 + fr) * 72 + ks * 32 + fq * 8), aa);
                ab = mfma16(xk[ks], *(const LAS bf16x8*)(uT + (db * 16 + fr) * 72 + ks * 32 + fq * 8), ab);
            }
            *(u32x2*)(p.la + item * 16384 + ((db * 8 + wid) * 64 + lane) * 4) = pack4(aa);
            *(u32x2*)(p.lb + item * 16384 + ((wid * 8 + db) * 64 + lane) * 4) = pack4(ab);
        }
    }
    __syncthreads();
  }
#undef RR
}

__device__ __forceinline__ void ph_local(const Params& p, int l, LAS unsigned char* lds) {
    constexpr int NG = NITEM / 2, TOTAL = NG + 2 * NITEM;
    int* ctr = p.cnt + 128 + l;
    LAS int* qslot = (LAS int*)(lds + LDS_BYTES - 64);
    const int tid0 = opaque_tid();
    if (tid0 == 0) *qslot = atomicAdd(ctr, 1);
    __syncthreads();
    for (;;) {
        const int it = *qslot;
        __syncthreads();
        if (it >= TOTAL) break;
        int nxt = 0;
        if (tid0 == 0) nxt = atomicAdd(ctr, 1);
        if (it < NG) { const int bh = it / NCHUNK, c = it % NCHUNK; local_gdn(p, l, bh, c >= 4, c >= 4 ? c - 4 : c, lds); }
        else if (it < NG + NITEM) { const int idx = it - NG; local_gla(p, l, 1, idx / NCHUNK, idx % NCHUNK, lds); }
        else { const int idx = it - NG - NITEM; local_ret<0>(p, l, idx / NCHUNK, idx % NCHUNK, lds); }
        if (tid0 == 0) *qslot = nxt;
        __syncthreads();
    }
}

__device__ __forceinline__ void seq_matrix(const Params& p, int tz, int chain, int half, LAS unsigned char* lds) {
    const int tid = opaque_tid(), wid = tid >> 6, lane = tid & 63, fr = lane & 15, fq = lane >> 4;
    const int b = chain >> 3, h = (chain >> 1) & 3, d = chain & 1;
    LAS bf16_t* ST = (LAS bf16_t*)lds;
    bf16_t* Op = p.O + (size_t)((tz == 0 ? 0 : tz == 1 ? 1 : 3) * 2 + d) * TOKW;
    f32x4 S[4];
#pragma unroll
    for (int q = 0; q < 4; ++q) S[q] = (f32x4){0.f, 0.f, 0.f, 0.f};
    const int ib = wid >> 1, dv2 = (wid & 1) * 2;
    struct Ops { u32x2 yq[8], xa[8], oin[2], bin[4]; f32x4 dec; };
    auto load_ops = [&](int n, Ops& o) {
        const size_t item = (size_t)tz * NITEM + (size_t)chain * NCHUNK + n;
        const bf16_t* lqp = p.lq + item * 8192 + (size_t)(ib * 8) * 256 + lane * 4;
#pragma unroll
        for (int q = 0; q < 8; ++q) o.yq[q] = *(const u32x2*)(lqp + q * 256);
        if (tz == 0) {
            const bf16_t* lap = p.la + ((size_t)chain * NCHUNK + n) * 16384 + (size_t)(wid * 8) * 256 + lane * 4;
#pragma unroll
            for (int q = 0; q < 8; ++q) o.xa[q] = *(const u32x2*)(lap + q * 256);
        }
#pragma unroll
        for (int e2 = 0; e2 < 2; ++e2)
            o.oin[e2] = *(const u32x2*)(p.lo + item * 8192 + (((half * 4 + dv2 + (fq >> 1)) * 4 + ib) * 64 + fr + 16 * (2 * (fq & 1) + e2)) * 4);
#pragma unroll
        for (int q = 0; q < 4; ++q) o.bin[q] = *(const u32x2*)(p.lb + item * 16384 + ((wid * 8 + half * 4 + q) * 64 + lane) * 4);
        o.dec = *(const f32x4*)(p.ld + item * 128 + wid * 16 + 4 * fq);
    };
    Ops s0, s1; load_ops(0, s0);
    auto step = [&](int n, Ops& cur, Ops& fill) {
        load_ops(n + 1 < NCHUNK ? n + 1 : n, fill);
        LAS bf16_t* st = ST + (n & 1) * 64 * 136;
#pragma unroll
        for (int q = 0; q < 4; ++q) *(LAS u32x2*)(st + (q * 16 + fr) * 136 + 32 * (wid >> 1) + 8 * fq + 4 * (wid & 1)) = pack4(S[q]);
        __syncthreads();
        const int base = chunk_base(b, d, n);
        const int tok = base + (d ? 63 - (ib * 16 + fr) : ib * 16 + fr);
        {
            bf16x8 xo[2][4];
#pragma unroll
            for (int e2 = 0; e2 < 2; ++e2) {
                const int prow = dv2 * 16 + 8 * (fr >> 2) + 4 * e2 + (fr & 3);
#pragma unroll
                for (int ks = 0; ks < 4; ++ks) xo[e2][ks] = *(const LAS bf16x8*)(st + prow * 136 + ks * 32 + fq * 8);
            }
            asm volatile("s_waitcnt lgkmcnt(0)" ::: "memory");
            f32x4 ao[2];
#pragma unroll
            for (int e2 = 0; e2 < 2; ++e2) {
                f32x4 acc = (f32x4){bflo(cur.oin[e2][0]), bfhi(cur.oin[e2][0]), bflo(cur.oin[e2][1]), bfhi(cur.oin[e2][1])};
#pragma unroll
                for (int ks = 0; ks < 4; ++ks) {
                    u32x4 t; t[0] = cur.yq[2 * ks][0]; t[1] = cur.yq[2 * ks][1]; t[2] = cur.yq[2 * ks + 1][0]; t[3] = cur.yq[2 * ks + 1][1];
                    acc = mfma16(xo[e2][ks], __builtin_bit_cast(bf16x8, t), acc);
                }
                ao[e2] = acc;
            }
            bf16_t* op = Op + (size_t)tok * MW + h * 128 + half * 64 + dv2 * 16 + 8 * fq;
            { u32x4 w; w[0] = pack2(ao[0][0], ao[0][1]); w[1] = pack2(ao[0][2], ao[0][3]); w[2] = pack2(ao[1][0], ao[1][1]); w[3] = pack2(ao[1][2], ao[1][3]); *(u32x4*)op = w; }
#pragma unroll
            for (int qh = 0; qh < 2; ++qh) {
                bf16x8 xs[2][4];
                if (tz == 0) {
#pragma unroll
                    for (int q2 = 0; q2 < 2; ++q2)
#pragma unroll
                        for (int ks = 0; ks < 4; ++ks) xs[q2][ks] = *(const LAS bf16x8*)(st + ((qh * 2 + q2) * 16 + fr) * 136 + ks * 32 + fq * 8);
                    asm volatile("s_waitcnt lgkmcnt(0)" ::: "memory");
                }
#pragma unroll
                for (int q2 = 0; q2 < 2; ++q2) {
                    const int q = qh * 2 + q2;
                    f32x4 acc = (f32x4){cur.dec[0] * S[q][0] + bflo(cur.bin[q][0]), cur.dec[1] * S[q][1] + bfhi(cur.bin[q][0]), cur.dec[2] * S[q][2] + bflo(cur.bin[q][1]), cur.dec[3] * S[q][3] + bfhi(cur.bin[q][1])};
                    if (tz == 0) {
#pragma unroll
                        for (int ks = 0; ks < 4; ++ks) {
                            u32x4 t; t[0] = cur.xa[2 * ks][0]; t[1] = cur.xa[2 * ks][1]; t[2] = cur.xa[2 * ks + 1][0]; t[3] = cur.xa[2 * ks + 1][1];
                            acc = mfma16(__builtin_bit_cast(bf16x8, t), xs[q2][ks], acc);
                        }
                    }
                    S[q] = acc;
                }
            }
        }
    };
    for (int n = 0; n < NCHUNK; n += 2) {
        step(n, s0, s1);
        step(n + 1, s1, s0);
    }
    __syncthreads();
}

__device__ __forceinline__ void seq_lru(const Params& p, int b, int d, int cg, LAS unsigned char* lds) {
    const int tid = opaque_tid(), seg = tid >> 6, ch = cg * 64 + (tid & 63);
    LAS float* sP = (LAS float*)lds;
    LAS float* sL = sP + 512;
    const float* A = p.prep + (size_t)(PR_LA + d) * TOKW + ch; const float* U = p.prep + (size_t)(PR_LU + d) * TOKW + ch;
    bf16_t* Op = p.O + (size_t)(2 * 2 + d) * TOKW + ch;
    constexpr int SEG = (TC + TL) / 8;
    auto tok_of = [&](int pos) { return pos < TC ? NLAT + b * TC + (d ? TC - 1 - pos : pos) : b * TL + (d ? TL - 1 - (pos - TC) : pos - TC); };
    float P = 1.f, L = 0.f;
    for (int i0 = 0; i0 < SEG; i0 += 32) {
        float av[32], uv[32];
#pragma unroll
        for (int q = 0; q < 32; ++q) { const size_t o = (size_t)tok_of(seg * SEG + i0 + q) * MW; av[q] = A[o]; uv[q] = U[o]; }
#pragma unroll
        for (int q = 0; q < 32; ++q) { L = av[q] * L + uv[q]; P *= av[q]; }
    }
    sP[tid] = P; sL[tid] = L;
    __syncthreads();
    float hst = 0.f;
    for (int s = 0; s < seg; ++s) hst = sP[s * 64 + (tid & 63)] * hst + sL[s * 64 + (tid & 63)];
    for (int i0 = 0; i0 < SEG; i0 += 32) {
        float av[32], uv[32];
#pragma unroll
        for (int q = 0; q < 32; ++q) { const size_t o = (size_t)tok_of(seg * SEG + i0 + q) * MW; av[q] = A[o]; uv[q] = U[o]; }
#pragma unroll
        for (int q = 0; q < 32; ++q) { hst = av[q] * hst + uv[q]; Op[(size_t)tok_of(seg * SEG + i0 + q) * MW] = (bf16_t)f2bf(hst); }
    }
    __syncthreads();
}

__device__ __forceinline__ void ph_seq(const Params& p, LAS unsigned char* lds) {
    for (int it = blockIdx.x; it < 256; it += gridDim.x) {
        if (it < 192) { const int tz = it >> 6, r = it & 63; seq_matrix(p, tz, (r & 7) | ((r >> 4) << 3), (r >> 3) & 1, lds); }
        else { const int r = it - 192; seq_lru(p, r >> 4, (r >> 3) & 1, r & 7, lds); }
    }
}

__device__ __forceinline__ void ph_merge(const Params& p, int l, int M) {
    const int tid = opaque_tid(), wid = tid >> 6, lane = tid & 63;
    const bf16_t* Ob = opaque_sptr(p.O); const bf16_t* Pb = opaque_sptr(p.P); bf16_t* Yb = opaque_sptr(p.Y);
    float2 gn[3];
#pragma unroll
    for (int m = 0; m < 3; ++m) gn[m] = *(const float2*)((m == 0 ? p.gdn_norm_g : m == 1 ? p.hgrn_norm_g : p.ret_norm_g) + l * 128 + lane * 2);
    for (int tok = blockIdx.x * NWAVES + wid; tok < M; tok += gridDim.x * NWAVES) {
        unsigned o0[16], o1[16], gz[16];
#pragma unroll
        for (int r = 0; r < 16; ++r) {
            const int m = r >> 2, head = r & 3, cidx = head * 128 + lane * 2;
            const size_t o = (size_t)tok * MW + cidx;
            o0[r] = *(const unsigned*)(Ob + (size_t)(m * 2) * TOKW + o); o1[r] = *(const unsigned*)(Ob + (size_t)(m * 2 + 1) * TOKW + o);
            const int zc = m == 0 ? C_GZ : m == 1 ? C_HG : m == 2 ? C_LY : C_RG;
            gz[r] = *(const unsigned*)(Pb + (size_t)tok * NP + zc + cidx);
        }
        float a0[16], a1[16], ss[16];
#pragma unroll
        for (int r = 0; r < 16; ++r) { a0[r] = bflo(o0[r]) + bflo(o1[r]); a1[r] = bfhi(o0[r]) + bfhi(o1[r]); ss[r] = a0[r] * a0[r] + a1[r] * a1[r]; }
#pragma unroll
        for (int msk = 32; msk >= 1; msk >>= 1)
#pragma unroll
            for (int r = 0; r < 16; ++r) if ((r >> 2) != 2) ss[r] += shx(ss[r], msk, lane);
#pragma unroll
        for (int r = 0; r < 16; ++r) {
            const int m = r >> 2, head = r & 3, cidx = head * 128 + lane * 2;
            float y0, y1; int nbr;
            if (m == 2) { y0 = a0[r] * gelu_tanhf_(bflo(gz[r])); y1 = a1[r] * gelu_tanhf_(bfhi(gz[r])); nbr = 2; }
            else {
                const float rinv = rsqrtf(ss[r] * (1.0f / 128.0f) + 1e-6f);
                const float2 g = gn[m == 3 ? 2 : m];
                y0 = a0[r] * rinv * g.x * siluf_(bflo(gz[r])); y1 = a1[r] * rinv * g.y * siluf_(bfhi(gz[r])); nbr = m == 3 ? 3 : m;
            }
            *(unsigned*)(Yb + (size_t)nbr * TOKW + (size_t)tok * MW + cidx) = pack2(y0, y1);
        }
    }
}

struct G2Sched {
    const bf16_t* Y; const bf16_t* Wb; int ntiles, G, c;
    static constexpr bool HAS_BIAS = false, gather = false;
    __device__ __forceinline__ bool next(int i, g8::Unit& u) const {
        const int tile = (i >> 2) * G + c; if (tile >= ntiles) return false;
        u.pm = tile >> 2; u.pn = tile & 3; u.e = i & 3; return true;
    }
    __device__ __forceinline__ const char* a_base(const g8::Unit& u) const { return (const char*)(Y + (size_t)u.e * TOKW + (size_t)u.pm * 256 * MW); }
    __device__ __forceinline__ const char* b_base(const g8::Unit& u) const { return (const char*)(Wb + (size_t)u.e * D * MW + (size_t)u.pn * 256 * MW); }
    __device__ __forceinline__ const int* row_addr(const g8::Unit&, int) const { return nullptr; }
    __device__ __forceinline__ int rows_valid(const g8::Unit&) const { return 256; }
    __device__ __forceinline__ const float* bias_src(const g8::Unit&, int) const { return nullptr; }
};
struct EpiMix {
    const bf16_t* gate; bf16_t* O;
    __device__ __forceinline__ bool keep(const g8::Unit& u) const { return u.e < 3; }
    __device__ __forceinline__ void operator()(f32x4 (&acc)[2][2][4][2], const g8::Unit& u, int wr, int wc, int fr, int fq, const LAS float*) const {
        const int row0 = u.pm * 256 + wr * 64 + fr, col0 = u.pn * 256 + wc * 32 + 8 * fq;
        const bool lastseg = u.e == 3;
        const bf16_t* gc = gate + ((((size_t)u.pm * 16 + u.e * 4 + u.pn) * 8 + (wr * 4 + wc)) * 16) * 512 + (fq * 16 + fr) * 8;
        const bf16_t* gn = gc + (lastseg ? 0 : (size_t)4 * 8 * 16 * 512);
#pragma unroll
        for (int ah = 0; ah < 4; ++ah) {
            const int ai = ah >> 1;
            u32x4 c[4], x[4];
#pragma unroll
            for (int q = 0; q < 4; ++q) { c[q] = *(const u32x4*)(gc + (ah * 4 + q) * 512); x[q] = *(const u32x4*)(gn + (ah * 4 + q) * 512); }
#pragma unroll
            for (int q = 0; q < 4; ++q) {
                const int m = (ah & 1) * 2 + (q >> 1), bj = q & 1;
#pragma unroll
                for (int w = 0; w < 4; ++w) {
                    const float c0 = bflo(c[q][w]), c1 = bfhi(c[q][w]);
                    const float s0 = lastseg ? c0 : c0 * __builtin_amdgcn_rcpf(bflo(x[q][w])), s1 = lastseg ? c1 : c1 * __builtin_amdgcn_rcpf(bfhi(x[q][w]));
                    acc[ai][bj][m][w >> 1][(w & 1) * 2] *= s0; acc[ai][bj][m][w >> 1][(w & 1) * 2 + 1] *= s1;
                }
            }
        }
        if (lastseg) {
#pragma unroll
            for (int ai = 0; ai < 2; ++ai)
#pragma unroll
                for (int m = 0; m < 4; ++m)
#pragma unroll
                    for (int bj = 0; bj < 2; ++bj) {
                        u32x4 w; w[0] = pack2(acc[ai][bj][m][0][0], acc[ai][bj][m][0][1]); w[1] = pack2(acc[ai][bj][m][0][2], acc[ai][bj][m][0][3]);
                        w[2] = pack2(acc[ai][bj][m][1][0], acc[ai][bj][m][1][1]); w[3] = pack2(acc[ai][bj][m][1][2], acc[ai][bj][m][1][3]);
                        *(u32x4*)(O + (size_t)(row0 + ai * 128 + m * 16) * D + col0 + bj * 128) = w;
                    }
        }
    }
};
__device__ __forceinline__ void ph_g2(const Params& p, int l, int M, LAS unsigned char* lds) {
    G2Sched S; S.Y = p.Y; S.Wb = p.wbT + (size_t)l * 4 * D * MW; S.ntiles = (M / 256) * 4; S.G = gridDim.x; S.c = blockIdx.x;
    EpiMix E; E.gate = p.gate; E.O = p.mix;
    g8::gemm_phase(lds, MW, S, E);
}

struct EpiY {
    bf16_t* O;
    __device__ __forceinline__ bool keep(const g8::Unit&) const { return false; }
    __device__ __forceinline__ void operator()(const f32x4 (&acc)[2][2][4][2], const g8::Unit& u, int wr, int wc, int fr, int fq, const LAS float*) const {
        const int row0 = u.pm * 256 + wr * 64 + fr, col0 = u.pn * 256 + wc * 32 + 8 * fq;
#pragma unroll
        for (int ai = 0; ai < 2; ++ai)
#pragma unroll
            for (int m = 0; m < 4; ++m)
#pragma unroll
                for (int bj = 0; bj < 2; ++bj) {
                    u32x4 w; w[0] = pack2(acc[ai][bj][m][0][0], acc[ai][bj][m][0][1]); w[1] = pack2(acc[ai][bj][m][0][2], acc[ai][bj][m][0][3]);
                    w[2] = pack2(acc[ai][bj][m][1][0], acc[ai][bj][m][1][1]); w[3] = pack2(acc[ai][bj][m][1][2], acc[ai][bj][m][1][3]);
                    *(u32x4*)(O + (size_t)(row0 + ai * 128 + m * 16) * D + col0 + bj * 128) = w;
                }
    }
};
__device__ __forceinline__ void ph_g3(const Params& p, int l, int M, LAS unsigned char* lds) {
    g8::PlainSched S; S.init(p.mix, p.woutT + (size_t)l * D * D, M, D, D);
    EpiY E; E.O = p.Y;
    g8::gemm_phase(lds, D, S, E);
}

template <bool DRY = false> __device__ __forceinline__ void ph_route(const Params& p, int l, int M, LAS unsigned char* lds) {
    int* const r_cnt = DRY ? p.cnt + 64 : p.cnt; int* const r_list = DRY ? (int*)p.act : p.list; int* const r_ts = DRY ? (int*)p.yp : p.tokslot; float* const r_tw = DRY ? (float*)p.yp + (size_t)NTOK * 4 : p.topw;
    LAS float* fs = (LAS float*)lds;
    LAS float* lg = fs + 32 * 1028;
    LAS int* lcnt = (LAS int*)(lg + 32 * 36);
    LAS int* lbase = lcnt + 32;
    const int tid = opaque_tid(), wid = tid >> 6, lane = tid & 63;
    const float* rw = p.router_w + (size_t)l * D * NE;
    for (int it = blockIdx.x; it < M / 32; it += gridDim.x) {
        const int tok0 = it * 32;
        {
            float4 v[4][4]; float ss[4];
            const float* mb0 = p.mod + (size_t)(l * 5 + tok_modrow(tok0)) * (NMOD * D);
            u32x2 yv[4][4]; float4 g1v[4];
#pragma unroll
            for (int i = 0; i < 4; ++i) g1v[i] = *(const float4*)(mb0 + 2 * D + i * 256 + lane * 4);
#pragma unroll
            for (int q = 0; q < 4; ++q) {
                const size_t ro = (size_t)(tok0 + wid * 4 + q) * D;
#pragma unroll
                for (int i = 0; i < 4; ++i) { v[q][i] = *(const float4*)(p.xl + ro + i * 256 + lane * 4); yv[q][i] = *(const u32x2*)(p.Y + ro + i * 256 + lane * 4); }
            }
#pragma unroll
            for (int q = 0; q < 4; ++q)
#pragma unroll
                for (int i = 0; i < 4; ++i) {
                    v[q][i].x += g1v[i].x * bflo(yv[q][i][0]); v[q][i].y += g1v[i].y * bfhi(yv[q][i][0]); v[q][i].z += g1v[i].z * bflo(yv[q][i][1]); v[q][i].w += g1v[i].w * bfhi(yv[q][i][1]);
                    if (!DRY) *(float4*)(p.xl + (size_t)(tok0 + wid * 4 + q) * D + i * 256 + lane * 4) = v[q][i];
                }
#pragma unroll
            for (int q = 0; q < 4; ++q) {
                float s = 0.f;
#pragma unroll
                for (int i = 0; i < 4; ++i) s += v[q][i].x * v[q][i].x + v[q][i].y * v[q][i].y + v[q][i].z * v[q][i].z + v[q][i].w * v[q][i].w;
                ss[q] = s;
            }
#pragma unroll
            for (int m = 32; m >= 1; m >>= 1)
#pragma unroll
                for (int q = 0; q < 4; ++q) ss[q] += shx(ss[q], m, lane);
            const float* mb = mb0;
#pragma unroll
            for (int i = 0; i < 4; ++i) {
                const int cidx = i * 256 + lane * 4;
                const float4 gv = *(const float4*)(p.norm2_g + l * D + cidx), sv = *(const float4*)(mb + 4 * D + cidx), hv = *(const float4*)(mb + 3 * D + cidx);
#pragma unroll
                for (int q = 0; q < 4; ++q) {
                    const int tl = wid * 4 + q, tok = tok0 + tl;
                    const float rinv = rsqrtf(ss[q] * (1.0f / D) + 1e-6f);
                    const float h0 = v[q][i].x * rinv * gv.x * (1.f + sv.x) + hv.x, h1 = v[q][i].y * rinv * gv.y * (1.f + sv.y) + hv.y;
                    const float h2 = v[q][i].z * rinv * gv.z * (1.f + sv.z) + hv.z, h3 = v[q][i].w * rinv * gv.w * (1.f + sv.w) + hv.w;
                    u32x2 o; o[0] = pack2(h0, h1); o[1] = pack2(h2, h3);
                    *(u32x2*)(p.F + (size_t)tok * D + cidx) = o;
                    *(LAS f32x4*)(fs + tl * 1028 + cidx) = (f32x4){h0, h1, h2, h3};
                }
            }
        }
        __syncthreads();
        {
            typedef float f32x16 __attribute__((ext_vector_type(16)));
            f32x16 acc;
#pragma unroll
            for (int r = 0; r < 16; ++r) acc[r] = 0.f;
            const int tk = lane & 31, hh = lane >> 5;
            const LAS float* ap = fs + tk * 1028 + wid * 128 + 4 * hh;
            const float* bp = rw + (size_t)(wid * 128 + 4 * hh) * NE + tk;
#pragma unroll 4
            for (int kk = 0; kk < 16; ++kk) {
                const f32x4 a4 = *(const LAS f32x4*)(ap + kk * 8);
                const float b0 = bp[(kk * 8 + 0) * NE], b1 = bp[(kk * 8 + 1) * NE], b2 = bp[(kk * 8 + 2) * NE], b3 = bp[(kk * 8 + 3) * NE];
                acc = __builtin_amdgcn_mfma_f32_32x32x2f32(a4[0], b0, acc, 0, 0, 0);
                acc = __builtin_amdgcn_mfma_f32_32x32x2f32(a4[1], b1, acc, 0, 0, 0);
                acc = __builtin_amdgcn_mfma_f32_32x32x2f32(a4[2], b2, acc, 0, 0, 0);
                acc = __builtin_amdgcn_mfma_f32_32x32x2f32(a4[3], b3, acc, 0, 0, 0);
            }
            __syncthreads();
            LAS float* red = fs;
#pragma unroll
            for (int r = 0; r < 16; ++r) red[(wid * 32 + (r & 3) + 8 * (r >> 2) + 4 * hh) * 33 + tk] = acc[r];
            __syncthreads();
            const int t2 = tid >> 4, e0 = (tid & 15) * 2;
            float s0 = p.router_b[l * NE + e0], s1 = p.router_b[l * NE + e0 + 1];
#pragma unroll
            for (int w = 0; w < 8; ++w) { s0 += red[(w * 32 + t2) * 33 + e0]; s1 += red[(w * 32 + t2) * 33 + e0 + 1]; }
            lg[t2 * 36 + e0] = s0; lg[t2 * 36 + e0 + 1] = s1;
            if (tid < 32) lcnt[tid] = 0;
        }
        __syncthreads();
        float vals[4]; int idxs[4], rank[4];
        if (tid < 32) {
            float lv[32];
#pragma unroll
            for (int q = 0; q < 8; ++q) { const f32x4 t = *(const LAS f32x4*)(lg + tid * 36 + q * 4); lv[q * 4] = t[0]; lv[q * 4 + 1] = t[1]; lv[q * 4 + 2] = t[2]; lv[q * 4 + 3] = t[3]; }
#pragma unroll
            for (int k = 0; k < 4; ++k) {
                float best = lv[0]; int bi = 0;
#pragma unroll
                for (int ee = 1; ee < NE; ++ee) { const bool gt = lv[ee] > best; best = gt ? lv[ee] : best; bi = gt ? ee : bi; }
#pragma unroll
                for (int ee = 0; ee < NE; ++ee) lv[ee] = (ee == bi) ? -3.0e38f : lv[ee];
                vals[k] = best; idxs[k] = bi;
                rank[k] = atomicAdd((int*)(lcnt + bi), 1);
            }
        }
        __syncthreads();
        if (tid < 32) { const int c = lcnt[tid]; lbase[tid] = c ? atomicAdd(r_cnt + l * NE + tid, c) : 0; }
        __syncthreads();
        if (tid < 32) {
            const int tok = tok0 + tid;
            const float mx = vals[0];
            float ex[4], sum = 0.f;
#pragma unroll
            for (int k = 0; k < 4; ++k) { ex[k] = __expf(vals[k] - mx); sum += ex[k]; }
            const float inv = 1.0f / sum;
#pragma unroll
            for (int k = 0; k < 4; ++k) {
                const int ee = idxs[k];
                const int slot = lbase[ee] + rank[k];
                r_list[(size_t)ee * NTOK + slot] = tok;
                r_ts[(size_t)tok * 4 + k] = (ee << 16) | slot;
                r_tw[(size_t)tok * 4 + k] = ex[k] * inv;
            }
        }
        __syncthreads();
    }
}

__device__ __forceinline__ void build_expert_tables(const Params& p, int l, LAS int* ts, LAS int* cn, LAS int* te) {
    const int tid = opaque_tid();
    if (tid < 64) {
        const int c = tid < NE ? p.cnt[l * NE + tid] : 0;
        const int nt = (c + 255) >> 8;
        int v = nt;
#pragma unroll
        for (int off = 1; off < 32; off <<= 1) { const int t = shupi(v, off, tid); if (tid >= off) v += t; }
        if (tid < NE) { cn[tid] = c; ts[tid] = v - nt; if (tid == NE - 1) ts[NE] = v; }
        if (te && tid < NE) for (int q = 0; q < nt; ++q) te[v - nt + q] = tid;
    }
    __syncthreads();
}

struct MoeSched {
    const LAS int* ts; const LAS int* cn; const LAS int* te; const int* list; const bf16_t* A; const bf16_t* Bt; const float* bias; int K, npn, nunits, G, c, nrowsB, nbias; bool gather;
    static constexpr bool HAS_BIAS = true;
    __device__ __forceinline__ bool next(int i, g8::Unit& u) const {
        const long L = (long)i * G + c; if (L >= nunits) return false;
        u.pm = (int)(L / npn); u.pn = (int)(L % npn); u.e = te[u.pm]; return true;
    }
    __device__ __forceinline__ const char* a_base(const g8::Unit& u) const { return (const char*)(gather ? A : A + (size_t)u.pm * 256 * K); }
    __device__ __forceinline__ const char* b_base(const g8::Unit& u) const { return (const char*)(Bt + ((size_t)u.e * nrowsB + (size_t)u.pn * 256) * K); }
    __device__ __forceinline__ const int* row_addr(const g8::Unit& u, int R) const {
        const int cnt = cn[u.e], sl = (u.pm - ts[u.e]) * 256 + R;
        return list + (size_t)u.e * NTOK + (sl < cnt ? sl : 0);
    }
    __device__ __forceinline__ int rows_valid(const g8::Unit& u) const { return cn[u.e] - (u.pm - ts[u.e]) * 256; }
    __device__ __forceinline__ const float* bias_src(const g8::Unit& u, int lane) const {
        if (nbias == 2) return bias + (size_t)u.e * 2 * D + (lane < 32 ? u.pn * 128 + lane * 4 : D + u.pn * 128 + (lane - 32) * 4);
        return bias + (size_t)u.e * D + u.pn * 256 + lane * 4;
    }
};
struct EpiAct {
    bf16_t* O;
    __device__ __forceinline__ bool keep(const g8::Unit&) const { return false; }
    __device__ __forceinline__ void operator()(const f32x4 (&acc)[2][2][4][2], const g8::Unit& u, int wr, int wc, int fr, int fq, const LAS float* bias) const {
        const int row0 = u.pm * 256 + wr * 64 + fr, col0 = u.pn * 128 + wc * 32 + 8 * fq;
        const LAS float* bb = bias + wc * 32 + 8 * fq;
        const f32x4 g0 = *(const LAS f32x4*)bb, g1 = *(const LAS f32x4*)(bb + 4), l0 = *(const LAS f32x4*)(bb + 128), l1 = *(const LAS f32x4*)(bb + 132);
        const float bg[8] = {g0[0], g0[1], g0[2], g0[3], g1[0], g1[1], g1[2], g1[3]}, bl[8] = {l0[0], l0[1], l0[2], l0[3], l1[0], l1[1], l1[2], l1[3]};
#pragma unroll
        for (int ai = 0; ai < 2; ++ai)
#pragma unroll
            for (int m = 0; m < 4; ++m) {
                float o[8];
#pragma unroll
                for (int n = 0; n < 2; ++n)
#pragma unroll
                    for (int j = 0; j < 4; ++j) {
                        const float glu = fminf(acc[ai][0][m][n][j] + bg[n * 4 + j], 7.0f);
                        const float lin = fminf(fmaxf(acc[ai][1][m][n][j] + bl[n * 4 + j], -7.0f), 7.0f);
                        o[n * 4 + j] = glu * sigmoidf_(1.702f * glu) * (lin + 1.0f);
                    }
                *(u32x4*)(O + (size_t)(row0 + ai * 128 + m * 16) * D + col0) = pack8(o);
            }
    }
};
__device__ __forceinline__ void ph_g4(const Params& p, int l, LAS unsigned char* lds) {
    LAS int* ts = (LAS int*)(lds + g8::STAGE_BYTES); LAS int* cn = ts + 40; LAS int* te = ts + 80;
    build_expert_tables(p, l, ts, cn, te);
    MoeSched S; S.ts = ts; S.cn = cn; S.te = te; S.list = p.list; S.A = p.F; S.Bt = p.w1T + (size_t)l * NE * 2 * D * D; S.bias = p.moe_b1 + (size_t)l * NE * 2 * D; S.nbias = 2;
    S.K = D; S.npn = 8; S.nunits = ts[NE] * 8; S.G = gridDim.x; S.c = blockIdx.x; S.nrowsB = 2 * D; S.gather = true;
    EpiAct E; E.O = p.act;
    g8::gemm_phase(lds, D, S, E);
}

struct EpiYp {
    bf16_t* O;
    __device__ __forceinline__ bool keep(const g8::Unit&) const { return false; }
    __device__ __forceinline__ void operator()(const f32x4 (&acc)[2][2][4][2], const g8::Unit& u, int wr, int wc, int fr, int fq, const LAS float* bias) const {
        const int row0 = u.pm * 256 + wr * 64 + fr, col0 = u.pn * 256 + wc * 32 + 8 * fq;
#pragma unroll
        for (int bj = 0; bj < 2; ++bj) {
            const LAS float* bb = bias + bj * 128 + wc * 32 + 8 * fq;
            const f32x4 c0v = *(const LAS f32x4*)bb, c1v = *(const LAS f32x4*)(bb + 4);
            const float4 c0 = make_float4(c0v[0], c0v[1], c0v[2], c0v[3]), c1 = make_float4(c1v[0], c1v[1], c1v[2], c1v[3]);
#pragma unroll
            for (int ai = 0; ai < 2; ++ai)
#pragma unroll
                for (int m = 0; m < 4; ++m) {
                    u32x4 w; w[0] = pack2(acc[ai][bj][m][0][0] + c0.x, acc[ai][bj][m][0][1] + c0.y); w[1] = pack2(acc[ai][bj][m][0][2] + c0.z, acc[ai][bj][m][0][3] + c0.w);
                    w[2] = pack2(acc[ai][bj][m][1][0] + c1.x, acc[ai][bj][m][1][1] + c1.y); w[3] = pack2(acc[ai][bj][m][1][2] + c1.z, acc[ai][bj][m][1][3] + c1.w);
                    *(u32x4*)(O + (size_t)(row0 + ai * 128 + m * 16) * D + col0 + bj * 128) = w;
                }
        }
    }
};
__device__ __forceinline__ void ph_g5(const Params& p, int l, LAS unsigned char* lds) {
    LAS int* ts = (LAS int*)(lds + g8::STAGE_BYTES); LAS int* cn = ts + 40; LAS int* te = ts + 80;
    build_expert_tables(p, l, ts, cn, te);
    MoeSched S; S.ts = ts; S.cn = cn; S.te = te; S.list = p.list; S.A = p.act; S.Bt = p.w2T + (size_t)l * NE * D * D; S.bias = p.moe_b2 + (size_t)l * NE * D; S.nbias = 1;
    S.K = D; S.npn = 4; S.nunits = ts[NE] * 4; S.G = gridDim.x; S.c = blockIdx.x; S.nrowsB = D; S.gather = false;
    EpiYp E; E.O = p.yp;
    g8::gemm_phase(lds, D, S, E);
}

template <bool DRY = false> __device__ __forceinline__ void ph_combine(const Params& p, int l, int M, LAS unsigned char* lds) {
    float* const c_xl = DRY ? p.prep : p.xl; bf16_t* const c_H = DRY ? (bf16_t*)(p.prep + (size_t)NTOK * D) : p.H; float* const c_out = DRY ? p.prep : p.out;
    LAS int* ts = (LAS int*)lds; LAS int* cn = ts + 40;
    build_expert_tables(p, l, ts, cn, nullptr);
    const int tid = opaque_tid(), wid = tid >> 6, lane = tid & 63;
    const bool last = (l == 1);
    const int tstep = gridDim.x * NWAVES;
    int tok = blockIdx.x * NWAVES + wid;
    int4 nts = make_int4(0, 0, 0, 0); float4 ntw = make_float4(0.f, 0.f, 0.f, 0.f);
    if (tok < M) { nts = *(const int4*)(p.tokslot + (size_t)tok * 4); ntw = *(const float4*)(p.topw + (size_t)tok * 4); }
    for (; tok < M; tok += tstep) {
        float4 v[4];
        const float* mb = p.mod + (size_t)(l * 5 + tok_modrow(tok)) * (NMOD * D);
        const int tsl[4] = {nts.x, nts.y, nts.z, nts.w}; const float wts[4] = {ntw.x, ntw.y, ntw.z, ntw.w};
        int rows[4];
#pragma unroll
        for (int k = 0; k < 4; ++k) rows[k] = ts[tsl[k] >> 16] * 256 + (tsl[k] & 0xffff);
        if (tok + tstep < M) { nts = *(const int4*)(p.tokslot + (size_t)(tok + tstep) * 4); ntw = *(const float4*)(p.topw + (size_t)(tok + tstep) * 4); }
        u32x2 yv[4][4]; float4 xin[4], gtv[4];
#pragma unroll
        for (int i = 0; i < 4; ++i) {
            const int cidx = i * 256 + lane * 4;
#pragma unroll
            for (int k = 0; k < 4; ++k) yv[i][k] = *(const u32x2*)(p.yp + (size_t)rows[k] * D + cidx);
            xin[i] = *(const float4*)(p.xl + (size_t)tok * D + cidx);
            gtv[i] = *(const float4*)(mb + 5 * D + cidx);
        }
        float ss = 0.f;
#pragma unroll
        for (int i = 0; i < 4; ++i) {
            float m0 = 0.f, m1 = 0.f, m2 = 0.f, m3 = 0.f;
#pragma unroll
            for (int k = 0; k < 4; ++k) { m0 += wts[k] * bflo(yv[i][k][0]); m1 += wts[k] * bfhi(yv[i][k][0]); m2 += wts[k] * bflo(yv[i][k][1]); m3 += wts[k] * bfhi(yv[i][k][1]); }
            float4 xv = xin[i];
            xv.x += gtv[i].x * m0; xv.y += gtv[i].y * m1; xv.z += gtv[i].z * m2; xv.w += gtv[i].w * m3;
            v[i] = xv; ss += xv.x * xv.x + xv.y * xv.y + xv.z * xv.z + xv.w * xv.w;
        }
        ss = wave_sum(ss, lane);
        const float rinv = rsqrtf(ss * (1.0f / D) + 1e-6f);
        if (!last) {
#pragma unroll
            for (int i = 0; i < 4; ++i) *(float4*)(c_xl + (size_t)tok * D + i * 256 + lane * 4) = v[i];
            const float* mb1 = p.mod + (size_t)((l + 1) * 5 + tok_modrow(tok)) * (NMOD * D);
            norm_mod_store(v, rinv, p.norm1_g + (l + 1) * D, mb1 + 1 * D, mb1 + 0 * D, c_H + (size_t)tok * D, lane);
        } else {
#pragma unroll
            for (int i = 0; i < 4; ++i) {
                const int cidx = i * 256 + lane * 4;
                const float4 gv = *(const float4*)(p.final_norm_g + cidx);
                *(float4*)(c_out + (size_t)tok * D + cidx) = make_float4(v[i].x * rinv * gv.x, v[i].y * rinv * gv.y, v[i].z * rinv * gv.z, v[i].w * rinv * gv.w);
            }
        }
    }
}

#define XB_TMO      128
#define XB_XCNT(j)  (256  + 64 * (j))
#define XB_XSUB(j)  (1280 + 64 * (j))
#define XB_XGEN(j)  (2304 + 64 * (j))
#define XB_TOP      3328
#define XB_TOPGEN   3392
#define XCD_BAR_WORDS 3456
#define XB_SPIN_CAP (1u << 18)

__device__ __forceinline__ unsigned xb_ld(unsigned* p)              { return __hip_atomic_load(p, __ATOMIC_RELAXED, __HIP_MEMORY_SCOPE_AGENT); }
__device__ __forceinline__ unsigned xb_add(unsigned* p, unsigned v) { return __hip_atomic_fetch_add(p, v, __ATOMIC_RELAXED, __HIP_MEMORY_SCOPE_AGENT); }
__device__ __forceinline__ unsigned xb_xcc_id() { return (unsigned)__builtin_amdgcn_s_getreg((3 << 11) | 20) & 0xFu; }
#define XB_SPIN(cond, bar) do { unsigned _sp = 0; while (cond) { __builtin_amdgcn_s_sleep(1); \
    if ((++_sp & 255u) == 0u) { if (xb_ld(&(bar)[XB_TMO])) break; if (_sp > XB_SPIN_CAP) { atomicAdd(&(bar)[XB_TMO], 1u); break; } } } } while (0)

struct XcdBarrier {
    unsigned* bar; unsigned x;
    volatile LAS unsigned* st;
};

__device__ __forceinline__ XcdBarrier xcd_barrier_post(unsigned* bar, volatile LAS unsigned* st) {
    XcdBarrier b; b.bar = bar; b.x = xb_xcc_id(); b.st = st;
    if (threadIdx.x == 0) (void)xb_add(&bar[XB_XCNT(b.x)], 1u);
    return b;
}
__device__ __forceinline__ void xcd_barrier_complete(unsigned* bar, unsigned x, unsigned& nloc, unsigned& nx) {
    const unsigned G = gridDim.x * gridDim.y * gridDim.z;
    unsigned sum, cnt, mine, sp = 0u;
    for (;;) {
        sum = 0u; cnt = 0u; mine = 0u;
#pragma unroll
        for (unsigned j = 0; j < 16; ++j) { const unsigned c = xb_ld(&bar[XB_XCNT(j)]); sum += c; cnt += (c > 0u) ? 1u : 0u; mine = (j == x) ? c : mine; }
        if (sum == G) break;
        __builtin_amdgcn_s_sleep(1);
        if ((++sp & 255u) == 0u) { if (xb_ld(&bar[XB_TMO])) break; if (sp > XB_SPIN_CAP) { atomicAdd(&bar[XB_TMO], 1u); break; } }
    }
    nloc = mine > 0u ? mine : 1u; nx = cnt > 0u ? cnt : 1u;
}

__device__ __forceinline__ void xcd_barrier(const XcdBarrier& b) {
    asm volatile("s_waitcnt vmcnt(0)" ::: "memory");
    __syncthreads();
    if (threadIdx.x == 0) {
        unsigned* bar = b.bar;
        __builtin_amdgcn_s_waitcnt(0);
        unsigned nloc = b.st[0], nx = b.st[1];
        if (nloc == 0u) { xcd_barrier_complete(bar, b.x, nloc, nx); b.st[0] = nloc; b.st[1] = nx; }
        const unsigned old = xb_add(&bar[XB_XSUB(b.x)], 1u);
        const unsigned gen = old / nloc;
        if (old + 1u == (gen + 1u) * nloc) {
            __builtin_amdgcn_fence(__ATOMIC_RELEASE, "agent");
            asm volatile("s_waitcnt vmcnt(0)" ::: "memory");
            const unsigned og = xb_add(&bar[XB_TOP], 1u);
            const unsigned tg = og / nx;
            if (og + 1u == (tg + 1u) * nx) xb_add(&bar[XB_TOPGEN], 1u);
            else XB_SPIN(xb_ld(&bar[XB_TOPGEN]) == tg, bar);
            __builtin_amdgcn_fence(__ATOMIC_ACQUIRE, "agent");
            xb_add(&bar[XB_XGEN(b.x)], 1u);
            asm volatile("s_waitcnt vmcnt(0)" ::: "memory");
        } else {
            XB_SPIN(xb_ld(&bar[XB_XGEN(b.x)]) == gen, bar);
            __builtin_amdgcn_fence(__ATOMIC_ACQUIRE, "agent");
            asm volatile("s_waitcnt vmcnt(0)" ::: "memory");
        }
    }
    __syncthreads();
}


extern __shared__ __attribute__((aligned(16))) unsigned char dyn_lds[];

typedef const __attribute__((address_space(4))) unsigned char* KArgPtr;
__device__ __forceinline__ Params load_params(KArgPtr kp) {
    asm volatile("" : "+s"(kp));
    Params q;
    const __attribute__((address_space(4))) unsigned long long* k8 = (const __attribute__((address_space(4))) unsigned long long*)kp;
    unsigned long long* d8 = (unsigned long long*)&q;
#pragma unroll
    for (int i = 0; i < (int)(sizeof(Params) / 8); ++i) d8[i] = k8[i];
    return q;
}
__global__ void __launch_bounds__(NTHREADS, 2) k_mega(Params p_unused) {
    (void)p_unused;
    const KArgPtr kp = (KArgPtr)__builtin_amdgcn_kernarg_segment_ptr();
    LAS unsigned char* lds = (LAS unsigned char*)dyn_lds;
    volatile LAS unsigned* xb_words = (volatile LAS unsigned*)(lds + LDS_BYTES - 16);
    if (threadIdx.x == 0) { xb_words[0] = 0u; xb_words[1] = 0u; xb_words[2] = 0u; xb_words[3] = 0u; }
    __syncthreads();
    { const Params p = load_params(kp); (void)xcd_barrier_post(p.bar, xb_words); }
#define GRID_BARRIER() do { XcdBarrier b_; b_.bar = load_params(kp).bar; b_.x = xb_xcc_id(); b_.st = xb_words; xcd_barrier(b_); } while (0)
#define PH(stmt) do { const Params p = load_params(kp); stmt; } while (0)
    PH(ph_convert(p, lds));
    PH(ph_mod(p, lds));
    GRID_BARRIER();
    PH(ph_norm1_first(p));
    GRID_BARRIER();
    for (int l = 0; l < 2; ++l) {
        const int M = l == 0 ? NTOK : NLAT;
        { unsigned lb_ = (unsigned)(size_t)lds; asm volatile("" : "+s"(lb_)); lds = (LAS unsigned char*)(size_t)lb_; }
        PH(ph_g1(p, l, lds));
        GRID_BARRIER();
        PH(ph_prep(p, l, lds));
        PH(ph_local(p, l, lds));
        GRID_BARRIER();
        PH(ph_seq(p, lds));
        GRID_BARRIER();
        PH(ph_merge(p, l, M));
        GRID_BARRIER();
        PH(ph_g2(p, l, M, lds));
        GRID_BARRIER();
        PH(ph_g3(p, l, M, lds));
        GRID_BARRIER();
        PH(ph_route(p, l, M, lds));
        GRID_BARRIER();
        PH(ph_g4(p, l, lds));
        GRID_BARRIER();
        PH(ph_g5(p, l, lds));
        GRID_BARRIER();
        PH(ph_combine(p, l, M, lds));
        if (l == 0) GRID_BARRIER();
    }
}

static inline size_t align_up(size_t v, size_t a) { return (v + a - 1) / a * a; }

extern "C" void kernel_launch(void* const* d_in, const int* in_sizes, int n_in, void* d_out, int out_size, void* d_ws, size_t ws_size, hipStream_t stream) {
    (void)in_sizes; (void)n_in; (void)out_size;
    Params p{};
    const float** pf = (const float**)&p;
    for (int i = 0; i < 32; ++i) pf[i] = (const float*)d_in[i];
    p.out = (float*)d_out;
    unsigned char* w = (unsigned char*)d_ws; size_t off = 0;
    auto take = [&](size_t bytes) { void* r = w + off; off = align_up(off + bytes, 256); return r; };
    p.bar = (unsigned*)take(16384);
    p.cnt = (int*)take(1024);
    const size_t ctl_bytes = off;
    p.mod = (float*)take((size_t)2 * 5 * NMOD * D * 4);
    p.winT = (bf16_t*)take((size_t)2 * NPW * D * 2);
    p.wbT = (bf16_t*)take((size_t)2 * 4 * D * MW * 2);
    p.woutT = (bf16_t*)take((size_t)2 * D * D * 2);
    p.w1T = (bf16_t*)take((size_t)2 * NE * 2 * D * D * 2);
    p.w2T = (bf16_t*)take((size_t)2 * NE * D * D * 2);
    p.xl = (float*)take((size_t)NTOK * D * 4);
    p.H = (bf16_t*)take((size_t)NTOK * D * 2);
    p.P = (bf16_t*)take((size_t)NTOK * NP * 2);
    p.gate = (bf16_t*)take((size_t)NTOK * 4096 * 2);
    p.act = p.P; p.yp = p.P + (size_t)CAPROWS * D;
    p.prep = (float*)take(NPREP * TOKW * 4);
    p.O = (bf16_t*)take(8 * TOKW * 2);
    p.lq = (bf16_t*)take((size_t)3 * NITEM * 64 * 128 * 2);
    p.lo = (bf16_t*)take((size_t)3 * NITEM * 64 * 128 * 2);
    p.lb = (bf16_t*)take((size_t)3 * NITEM * 128 * 128 * 2);
    p.la = (bf16_t*)take((size_t)NITEM * 128 * 128 * 2);
    p.ld = (float*)take((size_t)3 * NITEM * 128 * 4);
    p.lruT = (bf16_t*)take((size_t)2 * 8 * 4 * 4096 * 2);
    p.lsig = (float*)take((size_t)2 * 2 * MW * 4);
    p.rope = (float2*)take((size_t)TL * 64 * 8);
    p.Y = (bf16_t*)take(4 * TOKW * 2);
    p.mix = (bf16_t*)take((size_t)NTOK * D * 2);
    p.F = p.H;
    p.list = (int*)take((size_t)NE * NTOK * 4);
    p.tokslot = (int*)take((size_t)NTOK * 4 * 4);
    p.topw = (float*)take((size_t)NTOK * 4 * 4);
    if (off > ws_size) { fprintf(stderr, "workspace too small: need %zu have %zu\n", off, ws_size); return; }

    static int grid = 0;
    if (!grid) {
        int dev = 0, cus = 0, occ = 0; (void)hipGetDevice(&dev); (void)hipDeviceGetAttribute(&cus, hipDeviceAttributeMultiprocessorCount, dev);
        (void)hipFuncSetAttribute((const void*)k_mega, hipFuncAttributeMaxDynamicSharedMemorySize, LDS_BYTES);
        (void)hipOccupancyMaxActiveBlocksPerMultiprocessor(&occ, (const void*)k_mega, NTHREADS, LDS_BYTES);
        if (cus <= 0) cus = 256;
        grid = cus * (occ < 1 ? 1 : 1);
        if (occ < 1) fprintf(stderr, "occupancy query says %d blocks per CU\n", occ);
    }
    (void)hipMemsetAsync(d_ws, 0, ctl_bytes, stream);
    hipLaunchKernelGGL(k_mega, dim3(grid), dim3(NTHREADS), LDS_BYTES, stream, p);
}
```

```cpp
#include <hip/hip_runtime.h>
#include <stdint.h>
#include <stdio.h>

#define LAS __attribute__((address_space(3)))
typedef unsigned short bf16_t;
typedef short bf16x8 __attribute__((ext_vector_type(8)));
typedef float f32x4 __attribute__((ext_vector_type(4)));
typedef float f32x2 __attribute__((ext_vector_type(2)));
typedef unsigned u32x2 __attribute__((ext_vector_type(2)));
typedef unsigned u32x4 __attribute__((ext_vector_type(4)));

#ifndef PROBE
#define PROBE 0
#endif

constexpr int D = 1024, NB = 4, TL = 4096, TC = 256, NLAT = NB * TL, NCTX = NB * TC, NTOK = NLAT + NCTX;
constexpr int NIN = 11792, NPW = 12032, NP = 7936, MW = 512, NE = 32, TOPK = 4, NMOD = 6;
constexpr int C_GQKV = 0, C_GZ = 1536, C_HQ = 2048, C_HI = 2560, C_HF = 3072, C_HG = 4096, C_LX = 4608,
              C_LY = 5120, C_RQKV = 5632, C_RG = 7168, C_GA = 7680, C_GB = 7688, W_MG = 7936;
__host__ __device__ __forceinline__ int win_dst_row(int n) { return n < 2048 ? n : n < 2064 ? 7680 + (n - 2048) : n < 7696 ? n - 16 : 7936 + (n - 7696); }
constexpr int NTHREADS = 512, NWAVES = 8;
constexpr int LDS_BYTES = 140 * 1024;
constexpr int CAPROWS = 77824;
constexpr size_t TOKW = (size_t)NTOK * MW;
constexpr int PR_LA = 0, PR_LU = 2, NPREP = 4;
constexpr int NCHUNK = 68, NITEM = 32 * NCHUNK;

struct Params {
    const float *x, *c, *ctx, *c_ctx, *w_mod, *b_mod, *norm1_g, *norm2_g, *w_in, *gdn_conv_w, *gdn_a_log, *gdn_dt_bias, *gdn_norm_g, *hgrn_lb,
        *hgrn_norm_g, *lru_conv_w, *lru_conv_b, *lru_wa, *lru_ba, *lru_wx, *lru_bx, *lru_lambda, *ret_norm_g, *w_branch, *w_out, *router_w,
        *router_b, *moe_w1, *moe_b1, *moe_w2, *moe_b2, *final_norm_g;
    float* out;
    unsigned* bar; int* cnt; float* mod;
    bf16_t *winT, *wbT, *woutT, *w1T, *w2T;
    float* xl; bf16_t* H; bf16_t* P; float* prep; float* gg; float* gb; bf16_t* O; bf16_t* Y; bf16_t* mix; bf16_t* F;
    int* list; int* tokslot; float* topw; bf16_t* act; bf16_t* yp;
    bf16_t *lq, *lo, *lb, *la; float* ld; bf16_t* lruT; bf16_t* gate; float* lsig; float2* rope;
};

typedef __bf16 bf16x2_t __attribute__((ext_vector_type(2)));
__device__ __forceinline__ unsigned pack2(float a, float b) { const f32x2 v = {a, b}; return __builtin_bit_cast(unsigned, __builtin_convertvector(v, bf16x2_t)); }
__device__ __forceinline__ unsigned f2bf(float f) { return pack2(f, f) & 0xffffu; }
__device__ __forceinline__ float bf2f(bf16_t b) { return __uint_as_float(((unsigned)b) << 16); }
__device__ __forceinline__ float bflo(unsigned u) { return __uint_as_float(u << 16); }
__device__ __forceinline__ float bfhi(unsigned u) { return __uint_as_float(u & 0xffff0000u); }
__device__ __forceinline__ float sigmoidf_(float x) { return __builtin_amdgcn_rcpf(1.0f + __expf(-x)); }
__device__ __forceinline__ float siluf_(float x) { return x * sigmoidf_(x); }
__device__ __forceinline__ float softplusf_(float x) { return x > 20.f ? x : __logf(1.0f + __expf(x)); }
__device__ __forceinline__ float ret_log_gamma(int h) { return h == 0 ? -0.031748698314580f : h == 1 ? -0.015748356968139f : h == 2 ? -0.007843177461025f : -0.003913899321136f; }
__device__ __forceinline__ float logsigmoidf_(float x) { return -softplusf_(-x); }
__device__ __forceinline__ float gelu_tanhf_(float x) { const float u = 0.7978845608028654f * (x + 0.044715f * x * x * x); return x * __builtin_amdgcn_rcpf(1.0f + __expf(-2.0f * u)); }
__device__ __forceinline__ float shx(float v, int m, int lane) { return __int_as_float(__builtin_amdgcn_ds_bpermute((lane ^ m) << 2, __float_as_int(v))); }
__device__ __forceinline__ float shup(float v, int off, int lane) { const int s = lane >= off ? lane - off : lane; return __int_as_float(__builtin_amdgcn_ds_bpermute(s << 2, __float_as_int(v))); }
__device__ __forceinline__ int shupi(int v, int off, int lane) { const int s = lane >= off ? lane - off : lane; return __builtin_amdgcn_ds_bpermute(s << 2, v); }
__device__ __forceinline__ float wave_sum(float v, int lane) {
#pragma unroll
    for (int m = 32; m >= 1; m >>= 1) v += shx(v, m, lane);
    return v;
}
__device__ __forceinline__ int opaque_tid() { int t = threadIdx.x; asm volatile("" : "+v"(t)); return t; }
template <class T> __device__ __forceinline__ T* opaque_sptr(T* q) { asm volatile("" : "+s"(q)); return q; }
__device__ __forceinline__ int tok_modrow(int tok) { return tok < NLAT ? (tok >> 12) : 4; }
__device__ __forceinline__ void tok_info(int tok, int& t, int& T, int& base) {
    if (tok < NLAT) { t = tok & (TL - 1); T = TL; base = tok - t; }
    else { t = (tok - NLAT) & (TC - 1); T = TC; base = tok - t; }
}

__device__ __forceinline__ f32x4 mfma16(bf16x8 a, bf16x8 b, f32x4 c) { return __builtin_amdgcn_mfma_f32_16x16x32_bf16(a, b, c, 0, 0, 0); }
__device__ __forceinline__ u32x2 pack4(f32x4 v) { u32x2 o; o[0] = pack2(v[0], v[1]); o[1] = pack2(v[2], v[3]); return o; }
__device__ __forceinline__ u32x4 pack8(const float* v) { u32x4 o; o[0] = pack2(v[0], v[1]); o[1] = pack2(v[2], v[3]); o[2] = pack2(v[4], v[5]); o[3] = pack2(v[6], v[7]); return o; }

namespace g8 {
constexpr int BM = 256, BK = 64, HALF = 128, HTB = HALF * BK * 2, STAGE_BYTES = 8 * HTB;
__device__ __forceinline__ int lds_byte(int r, int c) { const int st = (r >> 4) * 2 + (c >> 5), rr = r & 15, cc = c & 31, ob = rr * 64 + cc * 2; return st * 1024 + (ob ^ (((ob >> 9) & 1) << 5)); }
__device__ __forceinline__ void stage_rc(int b, int& R, int& C) { const int st = b / 1024, sb = b % 1024, swz = sb ^ (((sb >> 9) & 1) << 5); R = (st >> 1) * 16 + swz / 64; C = (st & 1) * 32 + (swz % 64) / 2; }
__device__ __forceinline__ int perm32(int rho) { const int n = rho >> 4, i = rho & 15; return 8 * (i >> 2) + 4 * n + (i & 3); }
struct Unit { int pm, pn, e; };

template <class Epi, class Sched>
__device__ __forceinline__ void gemm_phase(LAS unsigned char* lds, const int K, const Sched& S, const Epi& E) {
    const int tid = opaque_tid(), wid = __builtin_amdgcn_readfirstlane(tid >> 6), lane = tid & 63, wr = wid >> 2, wc = wid & 3, fr = lane & 15, fq = lane >> 4;
    const int nt = K / BK;
    int R0, C0, R1, C1; stage_rc(tid * 16, R0, C0); stage_rc(tid * 16 + 8192, R1, C1);
    unsigned voffB[2];
    voffB[0] = (unsigned)(((R0 & ~31) + perm32(R0 & 31)) * K + C0) * 2u; voffB[1] = (unsigned)(((R1 & ~31) + perm32(R1 & 31)) * K + C1) * 2u;
    const unsigned cb0 = (unsigned)C0 * 2u, cb1 = (unsigned)C1 * 2u;
    const size_t kstep = (size_t)(BK * 2);
    const size_t hstepB = (size_t)HALF * K * 2;
    const unsigned ldsw = (unsigned)wid * 1024u;
    const int aoff = lds_byte(wr * 64 + fr, fq * 8), boff = lds_byte(wc * 32 + fr, fq * 8);
#define G8_SA(b, h) (((b) * 2 + (h)) * HTB)
#define G8_SB(b, h) ((4 + (b) * 2 + (h)) * HTB)
#define G8_GL(src, dstoff) __builtin_amdgcn_global_load_lds((const unsigned*)(src), (LAS unsigned*)(lds + (dstoff)), 16, 0, 0)
#define G8_STAGE_A(bufoff, gbase, vo, h) do { G8_GL((const char*)(gbase) + (vo)[2 * (h)], (bufoff) + ldsw); G8_GL((const char*)(gbase) + (vo)[2 * (h) + 1], (bufoff) + ldsw + 8192); } while (0)
#define G8_STAGE_B(bufoff, gbase) do { G8_GL((const char*)(gbase) + voffB[0], (bufoff) + ldsw); G8_GL((const char*)(gbase) + voffB[1], (bufoff) + ldsw + 8192); } while (0)
#define G8_LDA(dst, b, h) do { _Pragma("unroll") for (int m = 0; m < 4; ++m) _Pragma("unroll") for (int k = 0; k < 2; ++k) dst[m][k] = *(const LAS bf16x8*)(lds + G8_SA(b, h) + aoff + m * 2048 + k * 1024); } while (0)
#define G8_LDB(dst, b, h) do { _Pragma("unroll") for (int n = 0; n < 2; ++n) _Pragma("unroll") for (int k = 0; k < 2; ++k) dst[n][k] = *(const LAS bf16x8*)(lds + G8_SB(b, h) + boff + n * 2048 + k * 1024); } while (0)
#define G8_MMA(ai, bj, At, Bt) do { __builtin_amdgcn_s_setprio(1); _Pragma("unroll") for (int m = 0; m < 4; ++m) _Pragma("unroll") for (int n = 0; n < 2; ++n) _Pragma("unroll") for (int k = 0; k < 2; ++k) \
        acc[ai][bj][m][n] = __builtin_amdgcn_mfma_f32_16x16x32_bf16(Bt[n][k], At[m][k], acc[ai][bj][m][n], 0, 0, 0); __builtin_amdgcn_s_setprio(0); } while (0)
#define G8_WAIT_V(n) asm volatile("s_waitcnt vmcnt(" #n ")" ::: "memory")
#define G8_WAIT_L(n) asm volatile("s_waitcnt lgkmcnt(" #n ")" ::: "memory")
#define G8_BAR __builtin_amdgcn_s_barrier()
#define G8_SCHED __builtin_amdgcn_sched_barrier(0)
    Unit cur, nxt; int ui = 0;
    if (!S.next(0, cur)) return;
    LAS float* biasbuf = (LAS float*)(lds + STAGE_BYTES + 2048);
    LAS int* rowbuf = (LAS int*)(lds + STAGE_BYTES + 4096);
    f32x4 acc[2][2][4][2];
#pragma unroll
    for (int a = 0; a < 2; ++a)
#pragma unroll
        for (int b = 0; b < 2; ++b)
#pragma unroll
            for (int m = 0; m < 4; ++m)
#pragma unroll
                for (int n = 0; n < 2; ++n) acc[a][b][m][n] = (f32x4){0.f, 0.f, 0.f, 0.f};
    bf16x8 At[4][2], B0[2][2], B1[2][2];
    unsigned vA[4];
    {
        unsigned rows[4] = {(unsigned)R0, (unsigned)R1, (unsigned)(HALF + R0), (unsigned)(HALF + R1)};
        if (S.gather) { rows[0] = (unsigned)*S.row_addr(cur, R0); rows[1] = (unsigned)*S.row_addr(cur, R1); rows[2] = (unsigned)*S.row_addr(cur, HALF + R0); rows[3] = (unsigned)*S.row_addr(cur, HALF + R1); }
        vA[0] = rows[0] * (unsigned)(K * 2) + cb0; vA[1] = rows[1] * (unsigned)(K * 2) + cb1; vA[2] = rows[2] * (unsigned)(K * 2) + cb0; vA[3] = rows[3] * (unsigned)(K * 2) + cb1;
    }
    const char* cA = S.a_base(cur); const char* cB = S.b_base(cur);
    G8_STAGE_B(G8_SB(0, 0), cB); G8_STAGE_A(G8_SA(0, 0), cA, vA, 0); G8_STAGE_B(G8_SB(0, 1), cB + hstepB); G8_STAGE_A(G8_SA(0, 1), cA, vA, 1);
    if (wr == 1) G8_BAR;
    G8_WAIT_V(4); G8_BAR;
    G8_STAGE_B(G8_SB(1, 0), cB + kstep); G8_STAGE_A(G8_SA(1, 0), cA + kstep, vA, 0); G8_STAGE_B(G8_SB(1, 1), cB + hstepB + kstep);
    G8_WAIT_V(6); G8_BAR;
    for (;;) {
        const bool has_next = S.next(ui + 1, nxt);
        const char* nA = has_next ? S.a_base(nxt) : cA; const char* nB = has_next ? S.b_base(nxt) : cB;
        const int nvalid = (S.gather && has_next) ? S.rows_valid(nxt) : 0;
        if (wid == 0) {
            if (Sched::HAS_BIAS) G8_GL(S.bias_src(cur, lane), STAGE_BYTES + 2048 + (ui & 1) * 1024);
            if (S.gather && has_next) G8_GL(S.row_addr(nxt, 0) + lane * 4, STAGE_BYTES + 4096 + ((ui + 1) & 1) * 1024);
        }
        for (int t = 0; t < nt; t += 2) {
            const bool last = (t == nt - 2);
            const char* a1 = cA + (size_t)(t + 1) * kstep;
            const char* a2 = last ? nA : cA + (size_t)(t + 2) * kstep; const char* b2 = last ? nB : cB + (size_t)(t + 2) * kstep;
            const char* a3 = a2 + kstep; const char* b3 = b2 + kstep;
            G8_LDB(B0, 0, 0); G8_SCHED; G8_LDA(At, 0, 0); G8_STAGE_A(G8_SA(1, 1), a1, vA, 1);
            if (last && S.gather && has_next) {
                const LAS int* rb = rowbuf + ((ui + 1) & 1) * 256;
                const unsigned r0 = R0 < nvalid ? (unsigned)rb[R0] : 0u, r1 = R1 < nvalid ? (unsigned)rb[R1] : 0u;
                const unsigned r2 = HALF + R0 < nvalid ? (unsigned)rb[HALF + R0] : 0u, r3 = HALF + R1 < nvalid ? (unsigned)rb[HALF + R1] : 0u;
                vA[0] = r0 * (unsigned)(K * 2) + cb0; vA[1] = r1 * (unsigned)(K * 2) + cb1; vA[2] = r2 * (unsigned)(K * 2) + cb0; vA[3] = r3 * (unsigned)(K * 2) + cb1;
            }
            G8_WAIT_L(8); G8_BAR; G8_WAIT_L(0); G8_MMA(0, 0, At, B0); G8_BAR; G8_SCHED;
            G8_LDB(B1, 0, 1); G8_STAGE_B(G8_SB(0, 0), b2);
            G8_BAR; G8_WAIT_L(0); G8_MMA(0, 1, At, B1); G8_BAR;
            G8_LDA(At, 0, 1); G8_STAGE_A(G8_SA(0, 0), a2, vA, 0);
            G8_BAR; G8_WAIT_L(0); G8_MMA(1, 0, At, B0); G8_BAR; G8_SCHED;
            G8_STAGE_B(G8_SB(0, 1), b2 + hstepB);
            G8_WAIT_V(6); G8_BAR; G8_MMA(1, 1, At, B1); G8_BAR;
            G8_LDB(B0, 1, 0); G8_SCHED; G8_LDA(At, 1, 0); G8_STAGE_A(G8_SA(0, 1), a2, vA, 1);
            G8_WAIT_L(8); G8_BAR; G8_WAIT_L(0); G8_MMA(0, 0, At, B0); G8_BAR; G8_SCHED;
            G8_LDB(B1, 1, 1); G8_STAGE_B(G8_SB(1, 0), b3);
            G8_BAR; G8_WAIT_L(0); G8_MMA(0, 1, At, B1); G8_BAR;
            G8_LDA(At, 1, 1); G8_STAGE_A(G8_SA(1, 0), a3, vA, 0);
            G8_BAR; G8_WAIT_L(0); G8_MMA(1, 0, At, B0); G8_BAR; G8_SCHED;
            G8_STAGE_B(G8_SB(1, 1), b3 + hstepB);
            G8_WAIT_V(6); G8_BAR; G8_MMA(1, 1, At, B1); G8_BAR;
        }
        E(acc, cur, wr, wc, fr, fq, biasbuf + (ui & 1) * 256);
        if (!has_next) break;
        if (!E.keep(cur))
#pragma unroll
        for (int a = 0; a < 2; ++a)
#pragma unroll
            for (int b = 0; b < 2; ++b)
#pragma unroll
                for (int m = 0; m < 4; ++m)
#pragma unroll
                    for (int n = 0; n < 2; ++n) acc[a][b][m][n] = (f32x4){0.f, 0.f, 0.f, 0.f};
        cur = nxt; cA = nA; cB = nB; ++ui;
    }
    G8_WAIT_V(0);
    if (wr == 0) G8_BAR;
    G8_BAR;
#undef G8_SA
#undef G8_SB
#undef G8_GL
#undef G8_STAGE_A
#undef G8_STAGE_B
#undef G8_LDA
#undef G8_LDB
#undef G8_MMA
#undef G8_WAIT_V
#undef G8_WAIT_L
#undef G8_BAR
#undef G8_SCHED
}

struct PlainSched {
    const bf16_t* A; const bf16_t* Bt; int K, nM, nN, nwg, G, c;
    __device__ __forceinline__ void init(const bf16_t* A_, const bf16_t* Bt_, int M, int N, int K_) { A = A_; Bt = Bt_; K = K_; nM = M / BM; nN = N / BM; nwg = nM * nN; G = gridDim.x; c = blockIdx.x; }
    __device__ __forceinline__ bool next(int i, Unit& u) const {
        const long L = (long)i * G + c; if (L >= nwg) return false;
        int wgid = (int)L; { const int q = nwg / 8, r = nwg % 8, xcd = wgid % 8, off = wgid / 8; wgid = (xcd < r ? xcd * (q + 1) : r * (q + 1) + (xcd - r) * q) + off; }
        const int nig = 8 * nN, gid = wgid / nig, fm = gid * 8, gsz = (nM - fm) < 8 ? (nM - fm) : 8;
        u.pm = fm + ((wgid % nig) % gsz); u.pn = (wgid % nig) / gsz; u.e = 0; return true;
    }
    __device__ __forceinline__ const char* a_base(const Unit& u) const { return (const char*)(A + (size_t)u.pm * BM * K); }
    __device__ __forceinline__ const char* b_base(const Unit& u) const { return (const char*)(Bt + (size_t)u.pn * BM * K); }
    static constexpr bool HAS_BIAS = false, gather = false;
    __device__ __forceinline__ const int* row_addr(const Unit&, int) const { return nullptr; }
    __device__ __forceinline__ int rows_valid(const Unit&) const { return 256; }
    __device__ __forceinline__ const float* bias_src(const Unit&, int) const { return nullptr; }
};
}

__device__ __forceinline__ int w1_dst_row(int n) { const int half = n >> 10, cc = n & 1023; return (cc >> 7) * 256 + half * 128 + (cc & 127); }

struct CvtTile { const float* src; bf16_t* dst; int ld, Nsrc, k0, n0, K, mode; };
__device__ __forceinline__ CvtTile cvt_decode(const Params& p, int it) {
    constexpr int PER_L = 2960 + 512 + 256 + 16384 + 8192;
    CvtTile t; const int l = it / PER_L; int r = it % PER_L;
    if (r < 2960) { const int nt = r % 185, kt = r / 185; t.src = p.w_in + (size_t)l * D * NIN; t.ld = NIN; t.Nsrc = NIN; t.k0 = kt * 64; t.n0 = nt * 64; t.dst = p.winT + (size_t)l * NPW * D; t.K = D; t.mode = 2; }
    else if (r < 3472) { r -= 2960; const int n = r / 128; r %= 128; const int nt = r % 16, kt = r / 16;
        t.src = p.w_branch + (size_t)(l * 4 + n) * MW * D; t.ld = D; t.Nsrc = D; t.k0 = kt * 64; t.n0 = nt * 64; t.dst = p.wbT + (size_t)(l * 4 + n) * D * MW; t.K = MW; t.mode = 0; }
    else if (r < 3728) { r -= 3472; const int nt = r % 16, kt = r / 16; t.src = p.w_out + (size_t)l * D * D; t.ld = D; t.Nsrc = D; t.k0 = kt * 64; t.n0 = nt * 64; t.dst = p.woutT + (size_t)l * D * D; t.K = D; t.mode = 0; }
    else if (r < 3728 + 16384) { r -= 3728; const int ee = r / 512; r %= 512; const int nt = r % 32, kt = r / 32;
        t.src = p.moe_w1 + (size_t)(l * NE + ee) * D * 2 * D; t.ld = 2 * D; t.Nsrc = 2 * D; t.k0 = kt * 64; t.n0 = nt * 64; t.dst = p.w1T + (size_t)(l * NE + ee) * 2 * D * D; t.K = D; t.mode = 1; }
    else { r -= 3728 + 16384; const int ee = r / 256; r %= 256; const int nt = r % 16, kt = r / 16;
        t.src = p.moe_w2 + (size_t)(l * NE + ee) * D * D; t.ld = D; t.Nsrc = D; t.k0 = kt * 64; t.n0 = nt * 64; t.dst = p.w2T + (size_t)(l * NE + ee) * D * D; t.K = D; t.mode = 0; }
    return t;
}

constexpr int CVT_TOTAL = 2 * (2960 + 512 + 256 + 16384 + 8192);
constexpr int CVT_G_FIRST = 932;
constexpr int CVT_G_L0 = 8008;
constexpr int CVT_G_ALL = CVT_TOTAL / 4;
__device__ __forceinline__ void cvt_trip(const Params& p, LAS float* tile, int tid, int g) {
    constexpr int TOTAL = CVT_TOTAL;
    float4 v[4][2];
    const int rr = tid >> 4, c4 = (tid & 15) * 4;
#pragma unroll
    for (int q = 0; q < 4; ++q) {
        const int it = g * 4 + q;
        const CvtTile t = cvt_decode(p, it < TOTAL ? it : TOTAL - 1);
        const int n = t.n0 + c4; const bool ok = n < t.Nsrc; const int nc = ok ? n : t.Nsrc - 4;
#pragma unroll
        for (int i = 0; i < 2; ++i) { const float4 x = *(const float4*)(t.src + (size_t)(t.k0 + rr + i * 32) * t.ld + nc); v[q][i] = ok ? x : make_float4(0.f, 0.f, 0.f, 0.f); }
    }
#pragma unroll
    for (int q = 0; q < 4; ++q)
#pragma unroll
        for (int i = 0; i < 2; ++i) { LAS float* tp = tile + q * 4160 + (rr + i * 32) * 65 + c4; tp[0] = v[q][i].x; tp[1] = v[q][i].y; tp[2] = v[q][i].z; tp[3] = v[q][i].w; }
    __syncthreads();
#pragma unroll
    for (int q = 0; q < 4; ++q) {
        const int it = g * 4 + q;
        if (it < TOTAL) {
            const CvtTile t = cvt_decode(p, it);
            const int nl = tid >> 3, kg = tid & 7, n = t.n0 + nl;
            float w[8];
#pragma unroll
            for (int j = 0; j < 8; ++j) w[j] = tile[q * 4160 + (kg * 8 + j) * 65 + nl];
            const int drow = t.mode == 1 ? w1_dst_row(n) : t.mode == 2 ? win_dst_row(n) : n;
            if (n < t.Nsrc) *(u32x4*)(t.dst + (size_t)drow * t.K + t.k0 + kg * 8) = pack8(w);
        }
    }
    __syncthreads();
}
__device__ __forceinline__ void cvt_fill(const Params& p, LAS unsigned char* lds, int qbase, int qend, int* head) {
    LAS float* tile = (LAS float*)lds; LAS int* tk = (LAS int*)(lds + 4 * 4160 * 4);
    const int tid = opaque_tid();
    __syncthreads();
    int nxt = 0;
    if (tid == 0) nxt = atomicAdd(head, 1);
    for (;;) {
        if (tid == 0) tk[0] = nxt;
        __syncthreads();
        const int g = qbase + __builtin_amdgcn_readfirstlane(tk[0]);
        if (g >= qend) break;
        if (tid == 0) nxt = atomicAdd(head, 1);
        cvt_trip(p, tile, tid, g);
    }
}

__device__ __forceinline__ void ph_convert(const Params& p, LAS unsigned char* lds) {
    LAS float* tile = (LAS float*)lds;
    const int tid = opaque_tid();
    for (int idx = blockIdx.x * NTHREADS + tid; idx < 2 * 8 * 4 * 4096; idx += gridDim.x * NTHREADS) {
        const int i = idx & 63, j = (idx >> 6) & 63, mat = (idx >> 12) & 3, n = (idx >> 14) & 7, ll = idx >> 17, d = mat >> 1;
        p.lruT[idx] = (bf16_t)f2bf(((mat & 1) ? p.lru_wx : p.lru_wa)[(size_t)((ll * 2 + d) * 8 + n) * 4096 + i * 64 + j]);
    }
    for (int idx = blockIdx.x * NTHREADS + tid; idx < 2 * 2 * MW; idx += gridDim.x * NTHREADS) p.lsig[idx] = 8.0f * logsigmoidf_(p.lru_lambda[idx]);
    for (int idx = blockIdx.x * NTHREADS + tid; idx < TL * 64; idx += gridDim.x * NTHREADS) {
        const int t = idx >> 6, pi = idx & 63;
        const float pos = (pi < 32) ? (float)(t >> 6) : (float)(t & 63);
        const float ang = pos * exp2f(-(float)(pi & 31) * (13.287712379549449f / 32.0f));
        float sn, cs; sincosf(ang, &sn, &cs);
        p.rope[idx] = make_float2(cs, sn);
    }
    for (int idx = blockIdx.x * NTHREADS + tid; idx < 2 * 240 * (D / 8); idx += gridDim.x * NTHREADS) {
        const int ll = idx / (240 * (D / 8)), r = idx % (240 * (D / 8));
        *(u32x4*)(p.winT + ((size_t)ll * NPW + 7696) * D + (size_t)r * 8) = (u32x4){0u, 0u, 0u, 0u};
    }
    for (int g = blockIdx.x; g < CVT_G_FIRST; g += gridDim.x) cvt_trip(p, tile, tid, g);
}

__device__ __forceinline__ void ph_mod(const Params& p, LAS unsigned char* lds) {
    LAS float* sc = (LAS float*)lds;
    LAS float* red = sc + 5 * D;
    const int tid = opaque_tid(), wid = tid >> 6, lane = tid & 63;
    if ((int)blockIdx.x >= 192) return;
    for (int i = tid; i < 5 * D; i += NTHREADS) { const int r = i >> 10, k = i & 1023; const float v = r < 4 ? p.c[r * D + k] : p.c_ctx[k]; sc[i] = siluf_(v); }
    __syncthreads();
    for (int it = blockIdx.x; it < 192; it += gridDim.x) {
        const int l = it / 96, n0 = (it % 96) * 64;
        float acc[5] = {0.f, 0.f, 0.f, 0.f, 0.f};
        const float* wp = p.w_mod + (size_t)l * D * (NMOD * D) + n0 + lane;
        for (int k = wid * 128; k < wid * 128 + 128; ++k) {
            const float wv = wp[(size_t)k * (NMOD * D)];
#pragma unroll
            for (int r = 0; r < 5; ++r) acc[r] += sc[r * D + k] * wv;
        }
#pragma unroll
        for (int r = 0; r < 5; ++r) red[(wid * 5 + r) * 64 + lane] = acc[r];
        __syncthreads();
        if (tid < 320) { const int r = tid >> 6, cidx = tid & 63; float s = p.b_mod[l * NMOD * D + n0 + cidx];
#pragma unroll
            for (int w = 0; w < 8; ++w) s += red[(w * 5 + r) * 64 + cidx];
            p.mod[(size_t)(l * 5 + r) * (NMOD * D) + n0 + cidx] = s; }
        __syncthreads();
    }
}

__device__ __forceinline__ void norm_mod_store(const float4 (&v)[4], float rinv, const float* g, const float* scp, const float* shp, bf16_t* dst, int lane) {
#pragma unroll
    for (int i = 0; i < 4; ++i) {
        const int cidx = i * 256 + lane * 4;
        const float4 gv = *(const float4*)(g + cidx), sv = *(const float4*)(scp + cidx), hv = *(const float4*)(shp + cidx);
        const float h0 = v[i].x * rinv * gv.x * (1.f + sv.x) + hv.x, h1 = v[i].y * rinv * gv.y * (1.f + sv.y) + hv.y;
        const float h2 = v[i].z * rinv * gv.z * (1.f + sv.z) + hv.z, h3 = v[i].w * rinv * gv.w * (1.f + sv.w) + hv.w;
        u32x2 o; o[0] = pack2(h0, h1); o[1] = pack2(h2, h3);
        *(u32x2*)(dst + cidx) = o;
    }
}
__device__ __forceinline__ void ph_norm1_first(const Params& p) {
    const int tid = opaque_tid(), wid = tid >> 6, lane = tid & 63;
    for (int tok = blockIdx.x * NWAVES + wid; tok < NTOK; tok += gridDim.x * NWAVES) {
        const float* src = tok < NLAT ? p.x + (size_t)tok * D : p.ctx + (size_t)(tok - NLAT) * D;
        float4 v[4]; float ss = 0.f;
#pragma unroll
        for (int i = 0; i < 4; ++i) { v[i] = *(const float4*)(src + i * 256 + lane * 4); ss += v[i].x * v[i].x + v[i].y * v[i].y + v[i].z * v[i].z + v[i].w * v[i].w; }
        ss = wave_sum(ss, lane);
        const float rinv = rsqrtf(ss * (1.0f / D) + 1e-6f);
        const float* mb = p.mod + (size_t)(0 * 5 + tok_modrow(tok)) * (NMOD * D);
        norm_mod_store(v, rinv, p.norm1_g, mb + 1 * D, mb + 0 * D, p.H + (size_t)tok * D, lane);
#pragma unroll
        for (int i = 0; i < 4; ++i) *(float4*)(p.xl + (size_t)tok * D + i * 256 + lane * 4) = v[i];
    }
}

struct EpiP {
    bf16_t* O; bf16_t* gate;
    __device__ __forceinline__ bool keep(const g8::Unit&) const { return false; }
    __device__ __forceinline__ void operator()(const f32x4 (&acc)[2][2][4][2], const g8::Unit& u, int wr, int wc, int fr, int fq, const LAS float*) const {
        if (u.pn < 31) {
            const int row0 = u.pm * 256 + wr * 64 + fr, col0 = u.pn * 256 + wc * 32 + 8 * fq;
#pragma unroll
            for (int ai = 0; ai < 2; ++ai)
#pragma unroll
                for (int m = 0; m < 4; ++m) {
                    bf16_t* rowp = O + (size_t)(row0 + ai * 128 + m * 16) * NP + col0;
#pragma unroll
                    for (int bj = 0; bj < 2; ++bj) {
                        u32x4 w; w[0] = pack2(acc[ai][bj][m][0][0], acc[ai][bj][m][0][1]); w[1] = pack2(acc[ai][bj][m][0][2], acc[ai][bj][m][0][3]);
                        w[2] = pack2(acc[ai][bj][m][1][0], acc[ai][bj][m][1][1]); w[3] = pack2(acc[ai][bj][m][1][2], acc[ai][bj][m][1][3]);
                        *(u32x4*)(rowp + bj * 128) = w;
                    }
                }
        } else {
            const int g = u.pn - 31;
            bf16_t* gp = gate + ((((size_t)u.pm * 16 + g) * 8 + (wr * 4 + wc)) * 16) * 512 + (fq * 16 + fr) * 8;
#pragma unroll
            for (int ai = 0; ai < 2; ++ai)
#pragma unroll
                for (int m = 0; m < 4; ++m)
#pragma unroll
                    for (int bj = 0; bj < 2; ++bj) {
                        float s[8];
#pragma unroll
                        for (int n = 0; n < 2; ++n)
#pragma unroll
                            for (int j = 0; j < 4; ++j) s[n * 4 + j] = sigmoidf_(acc[ai][bj][m][n][j]);
                        *(u32x4*)(gp + (ai * 8 + m * 2 + bj) * 512) = pack8(s);
                    }
        }
    }
};
__device__ __forceinline__ void ph_g1(const Params& p, int l, LAS unsigned char* lds) {
    g8::PlainSched S; S.init(p.H, p.winT + (size_t)l * NPW * D, NTOK, NPW, D);
    EpiP E; E.O = p.P; E.gate = p.gate;
    g8::gemm_phase(lds, D, S, E);
}

__device__ __forceinline__ void ph_prep(const Params& p, int l, LAS unsigned char* lds) {
    const int tid = opaque_tid(), wid = tid >> 6, lane = tid & 63, fr = lane & 15, fq = lane >> 4;
    LAS float* xs = (LAS float*)lds;
    LAS bf16_t* xb = (LAS bf16_t*)(xs + 64 * 68);
    LAS bf16_t* wt = xb + 64 * 72;
    for (int it = blockIdx.x; it < (NTOK / 64) * 8; it += gridDim.x) {
        const int tile = it >> 3, n = it & 7, tok0 = tile * 64;
        {
            const int tl = tid & 63, cg = tid >> 6, tok = tok0 + tl;
            int t, T, base; tok_info(tok, t, T, base);
            float a[8];
            { const float4 b0 = *(const float4*)(p.lru_conv_b + l * MW + n * 64 + cg * 8), b1 = *(const float4*)(p.lru_conv_b + l * MW + n * 64 + cg * 8 + 4);
              a[0] = b0.x; a[1] = b0.y; a[2] = b0.z; a[3] = b0.w; a[4] = b1.x; a[5] = b1.y; a[6] = b1.z; a[7] = b1.w; }
#pragma unroll
            for (int j = 0; j < 4; ++j) {
                const int tt = t + j - 2;
                const float okf = (tt >= 0 && tt < T) ? 1.0f : 0.0f;
                const int ttc = tt < 0 ? 0 : (tt >= T ? T - 1 : tt);
                const u32x4 u = *(const u32x4*)(p.P + (size_t)(base + ttc) * NP + C_LX + n * 64 + cg * 8);
                const float* w = p.lru_conv_w + (size_t)(l * 4 + j) * MW + n * 64 + cg * 8;
                const float4 wa = *(const float4*)w, wb = *(const float4*)(w + 4);
                const float wv[8] = {wa.x * okf, wa.y * okf, wa.z * okf, wa.w * okf, wb.x * okf, wb.y * okf, wb.z * okf, wb.w * okf};
#pragma unroll
                for (int q = 0; q < 4; ++q) { a[2 * q] += wv[2 * q] * bflo(u[q]); a[2 * q + 1] += wv[2 * q + 1] * bfhi(u[q]); }
            }
            *(LAS f32x4*)(xs + tl * 68 + cg * 8) = (f32x4){a[0], a[1], a[2], a[3]}; *(LAS f32x4*)(xs + tl * 68 + cg * 8 + 4) = (f32x4){a[4], a[5], a[6], a[7]};
            *(LAS u32x4*)(xb + tl * 72 + cg * 8) = pack8(a);
            const bf16_t* wsrc = p.lruT + (size_t)((l * 8 + n) * 4) * 4096;
#pragma unroll
            for (int q = 0; q < 4; ++q) { const int e8 = tid + 512 * q, row = e8 >> 3, c8 = e8 & 7; *(LAS u32x4*)(wt + row * 72 + c8 * 8) = *(const u32x4*)(wsrc + (size_t)e8 * 8); }
        }
        __syncthreads();
        {
            const int jb = wid & 3, tb0 = (wid >> 2) * 2;
            bf16x8 xw[4][2];
#pragma unroll
            for (int m = 0; m < 4; ++m)
#pragma unroll
                for (int ks = 0; ks < 2; ++ks) xw[m][ks] = *(const LAS bf16x8*)(wt + (m * 64 + jb * 16 + fr) * 72 + ks * 32 + fq * 8);
            const int c0 = n * 64 + jb * 16 + 4 * fq;
            float4 bav[2], bxv[2], lsv[2];
#pragma unroll
            for (int d = 0; d < 2; ++d) {
                bav[d] = *(const float4*)(p.lru_ba + (l * 2 + d) * MW + c0); bxv[d] = *(const float4*)(p.lru_bx + (l * 2 + d) * MW + c0);
                lsv[d] = *(const float4*)(p.lsig + (l * 2 + d) * MW + c0);
            }
#pragma unroll
            for (int e = 0; e < 2; ++e) {
                const int tl = (tb0 + e) * 16 + fr, tok = tok0 + tl;
                f32x4 acc[4];
#pragma unroll
                for (int m = 0; m < 4; ++m) acc[m] = (f32x4){0.f, 0.f, 0.f, 0.f};
#pragma unroll
                for (int ks = 0; ks < 2; ++ks) {
                    const bf16x8 y = *(const LAS bf16x8*)(xb + tl * 72 + ks * 32 + fq * 8);
#pragma unroll
                    for (int m = 0; m < 4; ++m) acc[m] = mfma16(xw[m][ks], y, acc[m]);
                }
                const f32x4 xv = *(const LAS f32x4*)(xs + tl * 68 + jb * 16 + 4 * fq);
#pragma unroll
                for (int d = 0; d < 2; ++d) {
                    const float bar_[4] = {bav[d].x, bav[d].y, bav[d].z, bav[d].w}, bxr[4] = {bxv[d].x, bxv[d].y, bxv[d].z, bxv[d].w}, lsr[4] = {lsv[d].x, lsv[d].y, lsv[d].z, lsv[d].w};
                    float av[4], uv[4];
#pragma unroll
                    for (int r = 0; r < 4; ++r) {
                        const float gr = sigmoidf_(acc[d * 2][r] + bar_[r]), gi = sigmoidf_(acc[d * 2 + 1][r] + bxr[r]);
                        const float la = gr * lsr[r];
                        av[r] = __expf(la);
                        uv[r] = xv[r] * gi * __builtin_amdgcn_sqrtf(fmaxf(1.0f - __expf(2.0f * la), 1e-12f));
                    }
                    *(float4*)(p.prep + (PR_LA + d) * TOKW + (size_t)tok * MW + c0) = make_float4(av[0], av[1], av[2], av[3]);
                    *(float4*)(p.prep + (PR_LU + d) * TOKW + (size_t)tok * MW + c0) = make_float4(uv[0], uv[1], uv[2], uv[3]);
                }
            }
        }
        __syncthreads();
    }
}

__device__ __forceinline__ int chunk_base(int b, int d, int n) {
    if (n < 4) { const int blk = d ? 3 - n : n; return NLAT + b * TC + blk * 64; }
    const int m = n - 4, blk = d ? 63 - m : m; return b * TL + blk * 64;
}

__device__ __forceinline__ void local_gla(const Params& p, int l, int tz, int chain, int n, LAS unsigned char* lds) {
    const int tid = opaque_tid(), wid = tid >> 6, lane = tid & 63, fr = lane & 15, fq = lane >> 4;
    const int b = chain >> 3, h = (chain >> 1) & 3, d = chain & 1;
    const int base = chunk_base(b, d, n);
    const size_t item = (size_t)tz * NITEM + (size_t)chain * NCHUNK + n;
    LAS bf16_t* qh = (LAS bf16_t*)lds;
    LAS bf16_t* kh = qh + 64 * 136;
    LAS bf16_t* sc = kh + 10 * 16 * 136;
    LAS bf16_t* vT = sc + 64 * 72;
    LAS bf16_t* kT = vT + 128 * 72;
    LAS float* bc = (LAS float*)(kT + 128 * 72);
    const int vcol = tz == 1 ? C_HI : C_RQKV + 1024;
    const int ti = tid >> 3, dg = tid & 7, cA = dg * 8, cB = 64 + dg * 8;
    const int tokI = base + (d ? 63 - ti : ti);
    const bf16_t* pr = p.P + (size_t)tokI * NP;
    float qt[16], kv[16];
    {
        float lfv[16];
        if (tz == 1) {
            float lbv[16];
            {
                const float* lp0 = p.hgrn_lb + (size_t)(0 * 2 + d) * MW + h * 128; const float* lp1 = p.hgrn_lb + (size_t)(1 * 2 + d) * MW + h * 128;
                const float4 a0 = *(const float4*)(lp0 + cA), a1 = *(const float4*)(lp0 + cA + 4), a2 = *(const float4*)(lp0 + cB), a3 = *(const float4*)(lp0 + cB + 4);
                const float4 b0 = *(const float4*)(lp1 + cA), b1 = *(const float4*)(lp1 + cA + 4), b2 = *(const float4*)(lp1 + cB), b3 = *(const float4*)(lp1 + cB + 4);
                const float x0[16] = {a0.x, a0.y, a0.z, a0.w, a1.x, a1.y, a1.z, a1.w, a2.x, a2.y, a2.z, a2.w, a3.x, a3.y, a3.z, a3.w};
                const float x1[16] = {b0.x, b0.y, b0.z, b0.w, b1.x, b1.y, b1.z, b1.w, b2.x, b2.y, b2.z, b2.w, b3.x, b3.y, b3.z, b3.w};
#pragma unroll
                for (int e = 0; e < 16; ++e) lbv[e] = (l == 1) ? fminf(__builtin_amdgcn_rcpf(1.0f + __expf(x0[e] - x1[e])), 1.0f - 1e-4f) : 0.f;
            }
            const u32x4 uqa = *(const u32x4*)(pr + C_HQ + h * 128 + cA), uqb = *(const u32x4*)(pr + C_HQ + h * 128 + cB);
            const u32x4 uza = *(const u32x4*)(pr + C_HF + d * 512 + h * 128 + cA), uzb = *(const u32x4*)(pr + C_HF + d * 512 + h * 128 + cB);
#pragma unroll
            for (int e = 0; e < 16; ++e) {
                const unsigned uq = e < 8 ? uqa[(e & 7) >> 1] : uqb[(e & 7) >> 1], uz = e < 8 ? uza[(e & 7) >> 1] : uzb[(e & 7) >> 1];
                const float qraw = (e & 1) ? bfhi(uq) : bflo(uq), z = (e & 1) ? bfhi(uz) : bflo(uz);
                const float lb = lbv[e];
                const float sg = sigmoidf_(z);
                qt[e] = siluf_(qraw) * 0.08838834764831845f;
                kv[e] = (1.f - lb) * (1.f - sg);
                lfv[e] = __logf(fmaxf(lb + (1.f - lb) * sg, 1e-30f));
            }
        }
        *(LAS f32x4*)(bc + ti * 132 + cA) = (f32x4){lfv[0], lfv[1], lfv[2], lfv[3]}; *(LAS f32x4*)(bc + ti * 132 + cA + 4) = (f32x4){lfv[4], lfv[5], lfv[6], lfv[7]};
        *(LAS f32x4*)(bc + ti * 132 + cB) = (f32x4){lfv[8], lfv[9], lfv[10], lfv[11]}; *(LAS f32x4*)(bc + ti * 132 + cB + 4) = (f32x4){lfv[12], lfv[13], lfv[14], lfv[15]};
        const bf16_t* vp = pr + vcol + h * 128;
        const u32x4 v0 = *(const u32x4*)(vp + cA), v1 = *(const u32x4*)(vp + cB);
#pragma unroll
        for (int e = 0; e < 8; ++e) {
            vT[(cA + e) * 72 + ti] = (bf16_t)((e & 1) ? (v0[e >> 1] >> 16) : (v0[e >> 1] & 0xffffu));
            vT[(cB + e) * 72 + ti] = (bf16_t)((e & 1) ? (v1[e >> 1] >> 16) : (v1[e >> 1] & 0xffffu));
        }
    }
    __syncthreads();
    if (tid < 128) {
        float run = 0.f, lv[64];
#pragma unroll
        for (int i = 0; i < 64; ++i) lv[i] = bc[i * 132 + tid];
#pragma unroll
        for (int i = 0; i < 64; ++i) { run += lv[i]; bc[i * 132 + tid] = run; }
    }
    __syncthreads();
    {
        const int J = ti >> 4;
        float qhat[16];
#pragma unroll
        for (int e = 0; e < 16; ++e) {
            const int ch = e < 8 ? cA + e : cB + e - 8;
            const float bi = bc[ti * 132 + ch], rJ = J ? bc[(16 * J - 1) * 132 + ch] : 0.f, bl = bc[63 * 132 + ch];
            qhat[e] = qt[e] * __expf(bi - rJ); qt[e] = qt[e] * __expf(bi);
            kT[ch * 72 + ti] = (bf16_t)f2bf(kv[e] * __expf(bl - bi));
        }
        *(LAS u32x4*)(qh + ti * 136 + cA) = pack8(qhat); *(LAS u32x4*)(qh + ti * 136 + cB) = pack8(qhat + 8);
#pragma unroll
        for (int I = 0; I < 4; ++I) {
            if (I >= J) {
                float kk[16];
#pragma unroll
                for (int e = 0; e < 16; ++e) {
                    const int ch = e < 8 ? cA + e : cB + e - 8;
                    const float rI = I ? bc[(16 * I - 1) * 132 + ch] : 0.f, bj = bc[ti * 132 + ch];
                    kk[e] = kv[e] * __expf(fminf(rI - bj, 80.f));
                }
                LAS bf16_t* kp = kh + ((I * (I + 1) / 2 + J) * 16 + (ti & 15)) * 136;
                *(LAS u32x4*)(kp + cA) = pack8(kk); *(LAS u32x4*)(kp + cB) = pack8(kk + 8);
            }
        }
        *(LAS u32x4*)(sc + ti * 72 + dg * 8) = (u32x4){0u, 0u, 0u, 0u};
        {
            bf16_t* lqb = p.lq + item * 8192 + (size_t)((ti >> 4) * 8) * 256 + (ti & 15) * 4;
            const u32x4 pa = pack8(qt), pb = pack8(qt + 8);
            u32x2 t0; t0[0] = pa[0]; t0[1] = pa[1]; u32x2 t1; t1[0] = pa[2]; t1[1] = pa[3]; u32x2 t2; t2[0] = pb[0]; t2[1] = pb[1]; u32x2 t3; t3[0] = pb[2]; t3[1] = pb[3];
            *(u32x2*)(lqb + (dg >> 1) * 256 + ((dg & 1) * 2 + 0) * 64) = t0; *(u32x2*)(lqb + (dg >> 1) * 256 + ((dg & 1) * 2 + 1) * 64) = t1;
            *(u32x2*)(lqb + (4 + (dg >> 1)) * 256 + ((dg & 1) * 2 + 0) * 64) = t2; *(u32x2*)(lqb + (4 + (dg >> 1)) * 256 + ((dg & 1) * 2 + 1) * 64) = t3;
        }
    }
    if (tid < 128) p.ld[item * 128 + tid] = __expf(bc[63 * 132 + tid]);
    __syncthreads();
#pragma unroll
    for (int rep2 = 0; rep2 < 2; ++rep2) {
        const int t = wid + 8 * rep2;
        if (t < 10) {
            const int I = t >= 6 ? 3 : t >= 3 ? 2 : t >= 1 ? 1 : 0, J = t - I * (I + 1) / 2;
            f32x4 acc = (f32x4){0.f, 0.f, 0.f, 0.f};
#pragma unroll
            for (int ks = 0; ks < 4; ++ks)
                acc = mfma16(*(const LAS bf16x8*)(kh + (t * 16 + fr) * 136 + ks * 32 + fq * 8), *(const LAS bf16x8*)(qh + (I * 16 + fr) * 136 + ks * 32 + fq * 8), acc);
            const int i = 16 * I + fr, j0 = 16 * J + 4 * fq;
#pragma unroll
            for (int r = 0; r < 4; ++r) if (j0 + r > i) acc[r] = 0.f;
            *(LAS u32x2*)(sc + i * 72 + j0) = pack4(acc);
        }
    }
    __syncthreads();
    {
        bf16x8 xv[2], xk[2];
#pragma unroll
        for (int ks = 0; ks < 2; ++ks) { xv[ks] = *(const LAS bf16x8*)(vT + (wid * 16 + fr) * 72 + ks * 32 + fq * 8); xk[ks] = *(const LAS bf16x8*)(kT + (wid * 16 + fr) * 72 + ks * 32 + fq * 8); }
#pragma unroll
        for (int ib = 0; ib < 4; ++ib) {
            f32x4 acc = (f32x4){0.f, 0.f, 0.f, 0.f};
#pragma unroll
            for (int ks = 0; ks < 2; ++ks) acc = mfma16(xv[ks], *(const LAS bf16x8*)(sc + (ib * 16 + fr) * 72 + ks * 32 + fq * 8), acc);
            *(u32x2*)(p.lo + item * 8192 + ((wid * 4 + ib) * 64 + lane) * 4) = pack4(acc);
        }
#pragma unroll
        for (int dvb = 0; dvb < 8; ++dvb) {
            f32x4 acc = (f32x4){0.f, 0.f, 0.f, 0.f};
#pragma unroll
            for (int ks = 0; ks < 2; ++ks) acc = mfma16(xk[ks], *(const LAS bf16x8*)(vT + (dvb * 16 + fr) * 72 + ks * 32 + fq * 8), acc);
            *(u32x2*)(p.lb + item * 16384 + ((wid * 8 + dvb) * 64 + lane) * 4) = pack4(acc);
        }
    }
    __syncthreads();
}


template <int MODE> __device__ __forceinline__ void local_ret(const Params& p, int l, int chain, int n, LAS unsigned char* lds) {
    const int tid = opaque_tid(), wid = tid >> 6, lane = tid & 63, fr = lane & 15, fq = lane >> 4;
    const int b = chain >> 3, h = (chain >> 1) & 3, d = chain & 1;
    const int base = chunk_base(b, d, n);
    const size_t item = (size_t)2 * NITEM + (size_t)chain * NCHUNK + n;
    LAS bf16_t* ks_ = (LAS bf16_t*)lds;
    LAS bf16_t* qs = ks_ + 64 * 136;
    LAS bf16_t* sc = qs + 64 * 136;
    LAS bf16_t* vT = sc + 64 * 72;
    LAS bf16_t* kT = vT + 128 * 72;
    const int ti = tid >> 3, dg = tid & 7, cA = dg * 8, cB = 64 + dg * 8;
    const int tokI = base + (d ? 63 - ti : ti);
    const bf16_t* pr = p.P + (size_t)tokI * NP + C_RQKV + h * 128;
    const float lng = ret_log_gamma(h);
    {
        const u32x4 q1 = *(const u32x4*)(pr + cA), q2 = *(const u32x4*)(pr + cB), k1 = *(const u32x4*)(pr + 512 + cA), k2 = *(const u32x4*)(pr + 512 + cB);
        const u32x4 v0 = *(const u32x4*)(pr + 1024 + cA), v1 = *(const u32x4*)(pr + 1024 + cB);
        const bool lat = tokI < NLAT;
        const int t = tokI & (TL - 1);
        float qv[16], kv[16];
#pragma unroll
        for (int e = 0; e < 8; ++e) {
            float a1 = (e & 1) ? bfhi(q1[e >> 1]) : bflo(q1[e >> 1]), a2 = (e & 1) ? bfhi(q2[e >> 1]) : bflo(q2[e >> 1]);
            float b1 = (e & 1) ? bfhi(k1[e >> 1]) : bflo(k1[e >> 1]), b2 = (e & 1) ? bfhi(k2[e >> 1]) : bflo(k2[e >> 1]);
            {
                const float2 cst = p.rope[(size_t)t * 64 + cA + e];
                const float cs = lat ? cst.x : 1.0f, sn = lat ? cst.y : 0.0f;
                const float n1 = a1 * cs - a2 * sn, n2 = a1 * sn + a2 * cs, m1 = b1 * cs - b2 * sn, m2 = b1 * sn + b2 * cs;
                a1 = n1; a2 = n2; b1 = m1; b2 = m2;
            }
            qv[e] = a1; qv[8 + e] = a2; kv[e] = b1 * 0.08838834764831845f; kv[8 + e] = b2 * 0.08838834764831845f;
        }
        *(LAS u32x4*)(ks_ + ti * 136 + cA) = pack8(kv); *(LAS u32x4*)(ks_ + ti * 136 + cB) = pack8(kv + 8);
        *(LAS u32x4*)(qs + ti * 136 + cA) = pack8(qv); *(LAS u32x4*)(qs + ti * 136 + cB) = pack8(qv + 8);
        const float gq = __expf((float)(ti + 1) * lng), gk = __expf((float)(63 - ti) * lng);
#pragma unroll
        for (int e = 0; e < 8; ++e) {
            vT[(cA + e) * 72 + ti] = (bf16_t)((e & 1) ? (v0[e >> 1] >> 16) : (v0[e >> 1] & 0xffffu));
            vT[(cB + e) * 72 + ti] = (bf16_t)((e & 1) ? (v1[e >> 1] >> 16) : (v1[e >> 1] & 0xffffu));
            kT[(cA + e) * 72 + ti] = (bf16_t)f2bf(kv[e] * gk); kT[(cB + e) * 72 + ti] = (bf16_t)f2bf(kv[8 + e] * gk);
            qv[e] *= gq; qv[8 + e] *= gq;
        }
        {
            bf16_t* lqb = p.lq + item * 8192 + (size_t)((ti >> 4) * 8) * 256 + (ti & 15) * 4;
            const u32x4 pa = pack8(qv), pb = pack8(qv + 8);
            u32x2 t0; t0[0] = pa[0]; t0[1] = pa[1]; u32x2 t1; t1[0] = pa[2]; t1[1] = pa[3]; u32x2 t2; t2[0] = pb[0]; t2[1] = pb[1]; u32x2 t3; t3[0] = pb[2]; t3[1] = pb[3];
            *(u32x2*)(lqb + (dg >> 1) * 256 + ((dg & 1) * 2 + 0) * 64) = t0; *(u32x2*)(lqb + (dg >> 1) * 256 + ((dg & 1) * 2 + 1) * 64) = t1;
            *(u32x2*)(lqb + (4 + (dg >> 1)) * 256 + ((dg & 1) * 2 + 0) * 64) = t2; *(u32x2*)(lqb + (4 + (dg >> 1)) * 256 + ((dg & 1) * 2 + 1) * 64) = t3;
        }
    }
    if (tid < 128) p.ld[item * 128 + tid] = __expf(64.0f * lng);
    __syncthreads();
#pragma unroll
    for (int e = 0; e < 2; ++e) {
        const int f = wid * 2 + e, ib = f >> 2, jb = f & 3;
        const int i = 16 * ib + fr, j0 = 16 * jb + 4 * fq;
        f32x4 mq = (f32x4){0.f, 0.f, 0.f, 0.f};
        if (jb <= ib) {
#pragma unroll
            for (int ks = 0; ks < 4; ++ks)
                mq = mfma16(*(const LAS bf16x8*)(ks_ + (jb * 16 + fr) * 136 + ks * 32 + fq * 8), *(const LAS bf16x8*)(qs + i * 136 + ks * 32 + fq * 8), mq);
#pragma unroll
            for (int r = 0; r < 4; ++r) { const int j = j0 + r; mq[r] = (j <= i) ? mq[r] * __expf((float)(i - j) * lng) : 0.f; }
        }
        *(LAS u32x2*)(sc + i * 72 + j0) = pack4(mq);
    }
    __syncthreads();
    {
        bf16x8 xv[2], xk[2];
#pragma unroll
        for (int ks = 0; ks < 2; ++ks) { xv[ks] = *(const LAS bf16x8*)(vT + (wid * 16 + fr) * 72 + ks * 32 + fq * 8); xk[ks] = *(const LAS bf16x8*)(kT + (wid * 16 + fr) * 72 + ks * 32 + fq * 8); }
#pragma unroll
        for (int ib = 0; ib < 4; ++ib) {
            f32x4 acc = (f32x4){0.f, 0.f, 0.f, 0.f};
#pragma unroll
            for (int ks = 0; ks < 2; ++ks) acc = mfma16(xv[ks], *(const LAS bf16x8*)(sc + (ib * 16 + fr) * 72 + ks * 32 + fq * 8), acc);
            *(u32x2*)(p.lo + item * 8192 + ((wid * 4 + ib) * 64 + lane) * 4) = pack4(acc);
        }
#pragma unroll
        for (int dvb = 0; dvb < 8; ++dvb) {
            f32x4 acc = (f32x4){0.f, 0.f, 0.f, 0.f};
#pragma unroll
            for (int ks = 0; ks < 2; ++ks) acc = mfma16(xk[ks], *(const LAS bf16x8*)(vT + (dvb * 16 + fr) * 72 + ks * 32 + fq * 8), acc);
            *(u32x2*)(p.lb + item * 16384 + ((wid * 8 + dvb) * 64 + lane) * 4) = pack4(acc);
        }
    }
    __syncthreads();
}

__device__ __forceinline__ void local_gdn(const Params& p, int l, int bh, int seg, int blk, LAS unsigned char* lds) {
    const int tid = opaque_tid(), wid = tid >> 6, lane = tid & 63, fr = lane & 15, fq = lane >> 4;
    const int b = bh >> 2, h = bh & 3;
    const int base = seg ? b * TL + blk * 64 : NLAT + b * TC + blk * 64;
    LAS bf16_t* ks_ = (LAS bf16_t*)lds;
    LAS bf16_t* qs = ks_ + 64 * 136;
    LAS bf16_t* att = qs + 64 * 136;
    LAS bf16_t* wT = att + 64 * 72;
    LAS bf16_t* uT = wT + 128 * 72;
    LAS bf16_t* kT = uT + 128 * 72;
    LAS bf16_t* tT = kT;
    LAS bf16_t* Mneg = kT + 128 * 72;
    LAS float* Md = (LAS float*)(Mneg + 64 * 72);
    LAS float* bcs = (LAS float*)(kT + 128 * 72) + 64 * 68;
    LAS float* bts = bcs + 64;
    LAS float* rse = bts + 64;
    LAS bf16_t* vs = (LAS bf16_t*)(rse + 64);
    LAS bf16_t* Db = (LAS bf16_t*)(vs + 64 * 136);
    LAS float* cw = (LAS float*)(vs + 64 * 136);
    const int ti = tid >> 3, d0 = (tid & 7) * 16;
    const int tokI = base + ti;
    {
        int t, T, sbase; tok_info(tokI, t, T, sbase);
        u32x4 xr[3][4][2];
#pragma unroll
        for (int j = 0; j < 4; ++j) {
            const int tt = t + j - 2;
            const bool ok = (tt >= 0 && tt < T);
            const int ttc = tt < 0 ? 0 : (tt >= T ? T - 1 : tt);
            const bf16_t* xp = p.P + (size_t)(sbase + ttc) * NP + C_GQKV + h * 128 + d0;
#pragma unroll
            for (int part = 0; part < 3; ++part) {
                const u32x4 a0 = *(const u32x4*)(xp + part * 512), a1 = *(const u32x4*)(xp + part * 512 + 8);
#pragma unroll
                for (int q = 0; q < 4; ++q) { xr[part][j][0][q] = ok ? a0[q] : 0u; xr[part][j][1][q] = ok ? a1[q] : 0u; }
            }
        }
        if (tid < 384) {
            const int row = tid >> 5, c4 = (tid & 31) * 4, part = row >> 2, j = row & 3;
            *(LAS f32x4*)(cw + row * 128 + c4) = *(const f32x4*)(p.gdn_conv_w + (size_t)(l * 4 + j) * 1536 + part * 512 + h * 128 + c4);
        }
        __syncthreads();
#pragma unroll
        for (int part = 0; part < 3; ++part) {
            float a[16];
#pragma unroll
            for (int e = 0; e < 16; ++e) a[e] = 0.f;
#pragma unroll
            for (int j = 0; j < 4; ++j) {
                const u32x4 x0 = xr[part][j][0], x1 = xr[part][j][1];
                const LAS float* wp = cw + (part * 4 + j) * 128 + d0;
#pragma unroll
                for (int q = 0; q < 4; ++q) {
                    const f32x4 w0 = *(const LAS f32x4*)(wp + q * 4);
                    const unsigned ua = q < 2 ? x0[2 * q] : x1[2 * q - 4], ub = q < 2 ? x0[2 * q + 1] : x1[2 * q - 3];
                    a[q * 4] += w0[0] * bflo(ua); a[q * 4 + 1] += w0[1] * bfhi(ua); a[q * 4 + 2] += w0[2] * bflo(ub); a[q * 4 + 3] += w0[3] * bfhi(ub);
                }
            }
            float ss = 0.f;
#pragma unroll
            for (int e = 0; e < 16; ++e) { a[e] = siluf_(a[e]); ss += a[e] * a[e]; }
            if (part < 2) {
                ss += shx(ss, 1, lane); ss += shx(ss, 2, lane); ss += shx(ss, 4, lane);
                const float scl = rsqrtf(ss + 1e-6f) * (part == 0 ? 0.08838834764831845f : 1.0f);
#pragma unroll
                for (int e = 0; e < 16; ++e) a[e] *= scl;
            }
            LAS bf16_t* dstt = (part == 0 ? qs : part == 1 ? ks_ : vs) + ti * 136 + d0;
            *(LAS u32x4*)dstt = pack8(a); *(LAS u32x4*)(dstt + 8) = pack8(a + 8);
        }
    }
#pragma unroll 1
  for (int d = 0; d < 2; ++d) {
    const int n = seg ? 4 + (d ? 63 - blk : blk) : (d ? 3 - blk : blk);
    const size_t item = (size_t)(bh * 2 + d) * NCHUNK + n;
#define RR(x) (d ? 63 - (x) : (x))
    const int tid = opaque_tid(), wid = tid >> 6, lane = tid & 63, fr = lane & 15, fq = lane >> 4, ti = tid >> 3, d0 = (tid & 7) * 16;
    if (wid == 0) {
        const int tok = base + RR(lane);
        const float av = bf2f(p.P[(size_t)tok * NP + C_GA + d * 4 + h]);
        float v = -__expf(p.gdn_a_log[l * 8 + d * 4 + h]) * softplusf_(av + p.gdn_dt_bias[l * 8 + d * 4 + h]);
#pragma unroll
        for (int off = 1; off < 64; off <<= 1) { const float t = shup(v, off, lane); if (lane >= off) v += t; }
        const float btv = sigmoidf_(bf2f(p.P[(size_t)tok * NP + C_GB + d * 4 + h]));
        bcs[lane] = v; bts[lane] = btv; rse[lane] = btv * __expf(v);
    }
    __syncthreads();
#pragma unroll
    for (int e = 0; e < 2; ++e) {
        const int f = wid * 2 + e, ib = f >> 2, jb = f & 3;
        const int i = 16 * ib + fr, j0 = 16 * jb + 4 * fq;
        f32x4 mk = (f32x4){0.f, 0.f, 0.f, 0.f}, mq = (f32x4){0.f, 0.f, 0.f, 0.f};
        if (jb <= ib) {
#pragma unroll
            for (int ks = 0; ks < 4; ++ks) {
                const bf16x8 xk = *(const LAS bf16x8*)(ks_ + RR(jb * 16 + fr) * 136 + ks * 32 + fq * 8);
                mk = mfma16(xk, *(const LAS bf16x8*)(ks_ + RR(ib * 16 + fr) * 136 + ks * 32 + fq * 8), mk);
                mq = mfma16(xk, *(const LAS bf16x8*)(qs + RR(ib * 16 + fr) * 136 + ks * 32 + fq * 8), mq);
            }
            const float bi = bcs[i], bti = bts[i];
#pragma unroll
            for (int r = 0; r < 4; ++r) {
                const int j = j0 + r;
                const float dec = __expf(j <= i ? bi - bcs[j] : 0.f);
                mk[r] = (j < i) ? bti * mk[r] * dec : 0.f;
                mq[r] = (j <= i) ? mq[r] * dec : 0.f;
            }
        }
        {
            u32x2 mn; mn[0] = 0u; mn[1] = 0u;
            if (jb < ib) mn = pack4((f32x4){-mk[0], -mk[1], -mk[2], -mk[3]});
            *(LAS u32x2*)(Mneg + i * 72 + j0) = mn;
            if (jb == ib) *(LAS f32x4*)(Md + (ib * 16 + fr) * 20 + 4 * fq) = mk;
        }
        *(LAS u32x2*)(att + i * 72 + j0) = pack4(mq);
        if (e == 0) {
            const int zr = tid >> 1, zh = tid & 1;
            LAS bf16_t* zx = (zr < 128 ? uT + zr * 72 : wT + (zr - 128) * 72) + zh * 32;
#pragma unroll
            for (int q = 0; q < 4; ++q) *(LAS u32x4*)(zx + q * 8) = (u32x4){0u, 0u, 0u, 0u};
            *(LAS u32x4*)(tT + zr * 32 + 16 + zh * 8) = (u32x4){0u, 0u, 0u, 0u};
        }
    }
    __syncthreads();
    if (wid == 0) {
        const int R = lane >> 4, cc = lane & 15;
        float y[16];
#pragma unroll
        for (int i = 0; i < 16; ++i) {
            float acc = (i == cc) ? 1.0f : 0.0f;
#pragma unroll
            for (int j4 = 0; j4 < (i + 3) / 4; ++j4) {
                const f32x4 m = *(const LAS f32x4*)(Md + (R * 16 + i) * 20 + j4 * 4);
#pragma unroll
                for (int q = 0; q < 4; ++q) if (j4 * 4 + q < i) acc -= m[q] * y[j4 * 4 + q];
            }
            y[i] = acc;
            Db[(R * 16 + i) * 40 + cc] = (bf16_t)f2bf(acc);
        }
        *(LAS u32x4*)(Db + lane * 40 + 16) = (u32x4){0u, 0u, 0u, 0u}; *(LAS u32x4*)(Db + lane * 40 + 24) = (u32x4){0u, 0u, 0u, 0u};
    }
    __syncthreads();
#pragma unroll
    for (int R = 0; R < 4; ++R) {
        f32x4 tacc[2];
#pragma unroll
        for (int e = 0; e < 2; ++e) {
            const int cb = wid * 2 + e;
            const int i = 16 * R + fr;
            const u32x2 rv = *(const LAS u32x2*)((cb < 8 ? vs + cb * 16 : ks_ + (cb - 8) * 16) + RR(i) * 136 + 4 * fq);
            const float sc = cb < 8 ? bts[i] : -rse[i];
            f32x4 acc = (f32x4){bflo(rv[0]) * sc, bfhi(rv[0]) * sc, bflo(rv[1]) * sc, bfhi(rv[1]) * sc};
            if (R > 0) {
                const LAS bf16_t* xt = (cb < 8 ? uT + cb * 16 * 72 : wT + (cb - 8) * 16 * 72) + fr * 72 + fq * 8;
#pragma unroll
                for (int ks = 0; ks < (R + 1) / 2; ++ks) acc = mfma16(*(const LAS bf16x8*)(xt + ks * 32), *(const LAS bf16x8*)(Mneg + i * 72 + ks * 32 + fq * 8), acc);
            }
            tacc[e] = acc;
            LAS bf16_t* tp = tT + (cb * 16 + 4 * fq) * 32 + fr;
            tp[0] = (bf16_t)f2bf(acc[0]); tp[32] = (bf16_t)f2bf(acc[1]); tp[64] = (bf16_t)f2bf(acc[2]); tp[96] = (bf16_t)f2bf(acc[3]);
        }
        __syncthreads();
#pragma unroll
        for (int e = 0; e < 2; ++e) {
            const int cb = wid * 2 + e;
            f32x4 acc = (f32x4){0.f, 0.f, 0.f, 0.f};
            acc = mfma16(*(const LAS bf16x8*)(tT + (cb * 16 + fr) * 32 + fq * 8), *(const LAS bf16x8*)(Db + (R * 16 + fr) * 40 + fq * 8), acc);
            LAS bf16_t* xp = (cb < 8 ? uT + cb * 16 * 72 : wT + (cb - 8) * 16 * 72) + (4 * fq) * 72 + 16 * R + fr;
            xp[0] = (bf16_t)f2bf(acc[0]); xp[72] = (bf16_t)f2bf(acc[1]); xp[144] = (bf16_t)f2bf(acc[2]); xp[216] = (bf16_t)f2bf(acc[3]);
        }
        __syncthreads();
    }
    {
        const int pi = RR(ti);
        const float sc_ = __expf(bcs[63] - bcs[pi]);
#pragma unroll
        for (int e = 0; e < 16; ++e) kT[(d0 + e) * 72 + pi] = (bf16_t)f2bf(bf2f(ks_[ti * 136 + d0 + e]) * sc_);
    }
    if (tid < 128) p.ld[item * 128 + tid] = __expf(bcs[63]);
    __syncthreads();
    {
        const int tid = opaque_tid(), wid = tid >> 6, lane = tid & 63, fr = lane & 15, fq = lane >> 4;
        bf16x8 xw[2], xu[2], xk[2];
#pragma unroll
        for (int ks = 0; ks < 2; ++ks) {
            xw[ks] = *(const LAS bf16x8*)(wT + (wid * 16 + fr) * 72 + ks * 32 + fq * 8);
            xu[ks] = *(const LAS bf16x8*)(uT + (wid * 16 + fr) * 72 + ks * 32 + fq * 8);
            xk[ks] = *(const LAS bf16x8*)(kT + (wid * 16 + fr) * 72 + ks * 32 + fq * 8);
        }
#pragma unroll
        for (int ib = 0; ib < 4; ++ib) {
            const int i = ib * 16 + fr;
            const u32x2 qr = *(const LAS u32x2*)(qs + RR(i) * 136 + wid * 16 + 4 * fq);
            const float eb = __expf(bcs[i]);
            f32x4 aq = (f32x4){bflo(qr[0]) * eb, bfhi(qr[0]) * eb, bflo(qr[1]) * eb, bfhi(qr[1]) * eb};
            f32x4 ao = (f32x4){0.f, 0.f, 0.f, 0.f};
#pragma unroll
            for (int ks = 0; ks < 2; ++ks) {
                const bf16x8 ya = *(const LAS bf16x8*)(att + i * 72 + ks * 32 + fq * 8);
                aq = mfma16(xw[ks], ya, aq); ao = mfma16(xu[ks], ya, ao);
            }
            *(u32x2*)(p.lq + item * 8192 + ((ib * 8 + wid) * 64 + lane) * 4) = pack4(aq);
            *(u32x2*)(p.lo + item * 8192 + ((wid * 4 + ib) * 64 + lane) * 4) = pack4(ao);
        }
#pragma unroll
        for (int db = 0; db < 8; ++db) {
            f32x4 aa = (f32x4){0.f, 0.f, 0.f, 0.f}, ab = (f32x4){0.f, 0.f, 0.f, 0.f};
#pragma unroll
            for (int ks = 0; ks < 2; ++ks) {
                aa = mfma16(xw[ks], *(const LAS bf16x8*)(kT + (db * 16 + fr) * 72 + ks * 32 + fq * 8), aa);
                ab = mfma16(xk[ks], *(const LAS bf16x8*)(uT + (db * 16 + fr) * 72 + ks * 32 + fq * 8), ab);
            }
            *(u32x2*)(p.la + item * 16384 + ((db * 8 + wid) * 64 + lane) * 4) = pack4(aa);
            *(u32x2*)(p.lb + item * 16384 + ((wid * 8 + db) * 64 + lane) * 4) = pack4(ab);
        }
    }
    __syncthreads();
  }
#undef RR
}

__device__ __forceinline__ void ph_local(const Params& p, int l, LAS unsigned char* lds) {
    constexpr int NG = NITEM / 2;
    for (int it = blockIdx.x; it < NG + 2 * NITEM; it += gridDim.x) {
        if (it < NG) { const int bh = it / NCHUNK, c = it % NCHUNK; local_gdn(p, l, bh, c >= 4, c >= 4 ? c - 4 : c, lds); }
        else if (it < NG + NITEM) { const int idx = it - NG; local_gla(p, l, 1, idx / NCHUNK, idx % NCHUNK, lds); }
        else { const int idx = it - NG - NITEM; local_ret<0>(p, l, idx / NCHUNK, idx % NCHUNK, lds); }
    }
}

__device__ __forceinline__ void seq_matrix(const Params& p, int tz, int chain, int half, LAS unsigned char* lds) {
    const int tid = opaque_tid(), wid = tid >> 6, lane = tid & 63, fr = lane & 15, fq = lane >> 4;
    const int b = chain >> 3, h = (chain >> 1) & 3, d = chain & 1;
    LAS bf16_t* ST = (LAS bf16_t*)lds;
    bf16_t* Op = p.O + (size_t)((tz == 0 ? 0 : tz == 1 ? 1 : 3) * 2 + d) * TOKW;
    f32x4 S[4];
#pragma unroll
    for (int q = 0; q < 4; ++q) S[q] = (f32x4){0.f, 0.f, 0.f, 0.f};
    const int ib = wid >> 1, dv2 = (wid & 1) * 2;
    struct Ops { u32x2 yq[8], xa[8], oin[2], bin[4]; f32x4 dec; };
    auto load_ops = [&](int n, Ops& o) {
        const size_t item = (size_t)tz * NITEM + (size_t)chain * NCHUNK + n;
        const bf16_t* lqp = p.lq + item * 8192 + (size_t)(ib * 8) * 256 + lane * 4;
#pragma unroll
        for (int q = 0; q < 8; ++q) o.yq[q] = *(const u32x2*)(lqp + q * 256);
        if (tz == 0) {
            const bf16_t* lap = p.la + ((size_t)chain * NCHUNK + n) * 16384 + (size_t)(wid * 8) * 256 + lane * 4;
#pragma unroll
            for (int q = 0; q < 8; ++q) o.xa[q] = *(const u32x2*)(lap + q * 256);
        }
#pragma unroll
        for (int e2 = 0; e2 < 2; ++e2)
            o.oin[e2] = *(const u32x2*)(p.lo + item * 8192 + (((half * 4 + dv2 + (fq >> 1)) * 4 + ib) * 64 + fr + 16 * (2 * (fq & 1) + e2)) * 4);
#pragma unroll
        for (int q = 0; q < 4; ++q) o.bin[q] = *(const u32x2*)(p.lb + item * 16384 + ((wid * 8 + half * 4 + q) * 64 + lane) * 4);
        o.dec = *(const f32x4*)(p.ld + item * 128 + wid * 16 + 4 * fq);
    };
    Ops s0, s1; load_ops(0, s0);
    auto step = [&](int n, Ops& cur, Ops& fill) {
        load_ops(n + 1 < NCHUNK ? n + 1 : n, fill);
        LAS bf16_t* st = ST + (n & 1) * 64 * 136;
#pragma unroll
        for (int q = 0; q < 4; ++q) *(LAS u32x2*)(st + (q * 16 + fr) * 136 + 32 * (wid >> 1) + 8 * fq + 4 * (wid & 1)) = pack4(S[q]);
        __syncthreads();
        const int base = chunk_base(b, d, n);
        const int tok = base + (d ? 63 - (ib * 16 + fr) : ib * 16 + fr);
        {
            bf16x8 xo[2][4];
#pragma unroll
            for (int e2 = 0; e2 < 2; ++e2) {
                const int prow = dv2 * 16 + 8 * (fr >> 2) + 4 * e2 + (fr & 3);
#pragma unroll
                for (int ks = 0; ks < 4; ++ks) xo[e2][ks] = *(const LAS bf16x8*)(st + prow * 136 + ks * 32 + fq * 8);
            }
            asm volatile("s_waitcnt lgkmcnt(0)" ::: "memory");
            f32x4 ao[2];
#pragma unroll
            for (int e2 = 0; e2 < 2; ++e2) {
                f32x4 acc = (f32x4){bflo(cur.oin[e2][0]), bfhi(cur.oin[e2][0]), bflo(cur.oin[e2][1]), bfhi(cur.oin[e2][1])};
#pragma unroll
                for (int ks = 0; ks < 4; ++ks) {
                    u32x4 t; t[0] = cur.yq[2 * ks][0]; t[1] = cur.yq[2 * ks][1]; t[2] = cur.yq[2 * ks + 1][0]; t[3] = cur.yq[2 * ks + 1][1];
                    acc = mfma16(xo[e2][ks], __builtin_bit_cast(bf16x8, t), acc);
                }
                ao[e2] = acc;
            }
            bf16_t* op = Op + (size_t)tok * MW + h * 128 + half * 64 + dv2 * 16 + 8 * fq;
            { u32x4 w; w[0] = pack2(ao[0][0], ao[0][1]); w[1] = pack2(ao[0][2], ao[0][3]); w[2] = pack2(ao[1][0], ao[1][1]); w[3] = pack2(ao[1][2], ao[1][3]); *(u32x4*)op = w; }
#pragma unroll
            for (int qh = 0; qh < 2; ++qh) {
                bf16x8 xs[2][4];
                if (tz == 0) {
#pragma unroll
                    for (int q2 = 0; q2 < 2; ++q2)
#pragma unroll
                        for (int ks = 0; ks < 4; ++ks) xs[q2][ks] = *(const LAS bf16x8*)(st + ((qh * 2 + q2) * 16 + fr) * 136 + ks * 32 + fq * 8);
                    asm volatile("s_waitcnt lgkmcnt(0)" ::: "memory");
                }
#pragma unroll
                for (int q2 = 0; q2 < 2; ++q2) {
                    const int q = qh * 2 + q2;
                    f32x4 acc = (f32x4){cur.dec[0] * S[q][0] + bflo(cur.bin[q][0]), cur.dec[1] * S[q][1] + bfhi(cur.bin[q][0]), cur.dec[2] * S[q][2] + bflo(cur.bin[q][1]), cur.dec[3] * S[q][3] + bfhi(cur.bin[q][1])};
                    if (tz == 0) {
#pragma unroll
                        for (int ks = 0; ks < 4; ++ks) {
                            u32x4 t; t[0] = cur.xa[2 * ks][0]; t[1] = cur.xa[2 * ks][1]; t[2] = cur.xa[2 * ks + 1][0]; t[3] = cur.xa[2 * ks + 1][1];
                            acc = mfma16(__builtin_bit_cast(bf16x8, t), xs[q2][ks], acc);
                        }
                    }
                    S[q] = acc;
                }
            }
        }
    };
    for (int n = 0; n < NCHUNK; n += 2) {
        step(n, s0, s1);
        step(n + 1, s1, s0);
    }
    __syncthreads();
}

__device__ __forceinline__ void seq_lru(const Params& p, int b, int d, int cg, LAS unsigned char* lds) {
    const int tid = opaque_tid(), seg = tid >> 6, ch = cg * 64 + (tid & 63);
    LAS float* sP = (LAS float*)lds;
    LAS float* sL = sP + 512;
    const float* A = p.prep + (size_t)(PR_LA + d) * TOKW + ch; const float* U = p.prep + (size_t)(PR_LU + d) * TOKW + ch;
    bf16_t* Op = p.O + (size_t)(2 * 2 + d) * TOKW + ch;
    constexpr int SEG = (TC + TL) / 8;
    auto tok_of = [&](int pos) { return pos < TC ? NLAT + b * TC + (d ? TC - 1 - pos : pos) : b * TL + (d ? TL - 1 - (pos - TC) : pos - TC); };
    float P = 1.f, L = 0.f;
    for (int i0 = 0; i0 < SEG; i0 += 32) {
        float av[32], uv[32];
#pragma unroll
        for (int q = 0; q < 32; ++q) { const size_t o = (size_t)tok_of(seg * SEG + i0 + q) * MW; av[q] = A[o]; uv[q] = U[o]; }
#pragma unroll
        for (int q = 0; q < 32; ++q) { L = av[q] * L + uv[q]; P *= av[q]; }
    }
    sP[tid] = P; sL[tid] = L;
    __syncthreads();
    float hst = 0.f;
    for (int s = 0; s < seg; ++s) hst = sP[s * 64 + (tid & 63)] * hst + sL[s * 64 + (tid & 63)];
    for (int i0 = 0; i0 < SEG; i0 += 32) {
        float av[32], uv[32];
#pragma unroll
        for (int q = 0; q < 32; ++q) { const size_t o = (size_t)tok_of(seg * SEG + i0 + q) * MW; av[q] = A[o]; uv[q] = U[o]; }
#pragma unroll
        for (int q = 0; q < 32; ++q) { hst = av[q] * hst + uv[q]; Op[(size_t)tok_of(seg * SEG + i0 + q) * MW] = (bf16_t)f2bf(hst); }
    }
    __syncthreads();
}

__device__ __forceinline__ void ph_seq(const Params& p, int l, LAS unsigned char* lds) {
    for (int it = blockIdx.x; it < 256; it += gridDim.x) {
        if (it < 192) { const int tz = it >> 6, r = it & 63; seq_matrix(p, tz, (r & 7) | ((r >> 4) << 3), (r >> 3) & 1, lds); }
        else { const int r = it - 192; seq_lru(p, r >> 4, (r >> 3) & 1, r & 7, lds); }
    }
    cvt_fill(p, lds, l == 0 ? CVT_G_FIRST : CVT_G_L0, l == 0 ? CVT_G_L0 : CVT_G_ALL, p.cnt + 192 + l * 32);
}

__device__ __forceinline__ void ph_merge(const Params& p, int l, int M) {
    const int tid = opaque_tid(), wid = tid >> 6, lane = tid & 63;
    const bf16_t* Ob = opaque_sptr(p.O); const bf16_t* Pb = opaque_sptr(p.P); bf16_t* Yb = opaque_sptr(p.Y);
    float2 gn[3];
#pragma unroll
    for (int m = 0; m < 3; ++m) gn[m] = *(const float2*)((m == 0 ? p.gdn_norm_g : m == 1 ? p.hgrn_norm_g : p.ret_norm_g) + l * 128 + lane * 2);
    for (int tok = blockIdx.x * NWAVES + wid; tok < M; tok += gridDim.x * NWAVES) {
        unsigned o0[16], o1[16], gz[16];
#pragma unroll
        for (int r = 0; r < 16; ++r) {
            const int m = r >> 2, head = r & 3, cidx = head * 128 + lane * 2;
            const size_t o = (size_t)tok * MW + cidx;
            o0[r] = *(const unsigned*)(Ob + (size_t)(m * 2) * TOKW + o); o1[r] = *(const unsigned*)(Ob + (size_t)(m * 2 + 1) * TOKW + o);
            const int zc = m == 0 ? C_GZ : m == 1 ? C_HG : m == 2 ? C_LY : C_RG;
            gz[r] = *(const unsigned*)(Pb + (size_t)tok * NP + zc + cidx);
        }
        float a0[16], a1[16], ss[16];
#pragma unroll
        for (int r = 0; r < 16; ++r) { a0[r] = bflo(o0[r]) + bflo(o1[r]); a1[r] = bfhi(o0[r]) + bfhi(o1[r]); ss[r] = a0[r] * a0[r] + a1[r] * a1[r]; }
#pragma unroll
        for (int msk = 32; msk >= 1; msk >>= 1)
#pragma unroll
            for (int r = 0; r < 16; ++r) if ((r >> 2) != 2) ss[r] += shx(ss[r], msk, lane);
#pragma unroll
        for (int r = 0; r < 16; ++r) {
            const int m = r >> 2, head = r & 3, cidx = head * 128 + lane * 2;
            float y0, y1; int nbr;
            if (m == 2) { y0 = a0[r] * gelu_tanhf_(bflo(gz[r])); y1 = a1[r] * gelu_tanhf_(bfhi(gz[r])); nbr = 2; }
            else {
                const float rinv = rsqrtf(ss[r] * (1.0f / 128.0f) + 1e-6f);
                const float2 g = gn[m == 3 ? 2 : m];
                y0 = a0[r] * rinv * g.x * siluf_(bflo(gz[r])); y1 = a1[r] * rinv * g.y * siluf_(bfhi(gz[r])); nbr = m == 3 ? 3 : m;
            }
            *(unsigned*)(Yb + (size_t)nbr * TOKW + (size_t)tok * MW + cidx) = pack2(y0, y1);
        }
    }
}

struct G2Sched {
    const bf16_t* Y; const bf16_t* Wb; int ntiles, G, c;
    static constexpr bool HAS_BIAS = false, gather = false;
    __device__ __forceinline__ bool next(int i, g8::Unit& u) const {
        const int tile = (i >> 2) * G + c; if (tile >= ntiles) return false;
        u.pm = tile >> 2; u.pn = tile & 3; u.e = i & 3; return true;
    }
    __device__ __forceinline__ const char* a_base(const g8::Unit& u) const { return (const char*)(Y + (size_t)u.e * TOKW + (size_t)u.pm * 256 * MW); }
    __device__ __forceinline__ const char* b_base(const g8::Unit& u) const { return (const char*)(Wb + (size_t)u.e * D * MW + (size_t)u.pn * 256 * MW); }
    __device__ __forceinline__ const int* row_addr(const g8::Unit&, int) const { return nullptr; }
    __device__ __forceinline__ int rows_valid(const g8::Unit&) const { return 256; }
    __device__ __forceinline__ const float* bias_src(const g8::Unit&, int) const { return nullptr; }
};
struct EpiMix {
    const bf16_t* gate; bf16_t* O;
    __device__ __forceinline__ bool keep(const g8::Unit& u) const { return u.e < 3; }
    __device__ __forceinline__ void operator()(f32x4 (&acc)[2][2][4][2], const g8::Unit& u, int wr, int wc, int fr, int fq, const LAS float*) const {
        const int row0 = u.pm * 256 + wr * 64 + fr, col0 = u.pn * 256 + wc * 32 + 8 * fq;
        const bool lastseg = u.e == 3;
        const bf16_t* gc = gate + ((((size_t)u.pm * 16 + u.e * 4 + u.pn) * 8 + (wr * 4 + wc)) * 16) * 512 + (fq * 16 + fr) * 8;
        const bf16_t* gn = gc + (lastseg ? 0 : (size_t)4 * 8 * 16 * 512);
#pragma unroll
        for (int ah = 0; ah < 4; ++ah) {
            const int ai = ah >> 1;
            u32x4 c[4], x[4];
#pragma unroll
            for (int q = 0; q < 4; ++q) { c[q] = *(const u32x4*)(gc + (ah * 4 + q) * 512); x[q] = *(const u32x4*)(gn + (ah * 4 + q) * 512); }
#pragma unroll
            for (int q = 0; q < 4; ++q) {
                const int m = (ah & 1) * 2 + (q >> 1), bj = q & 1;
#pragma unroll
                for (int w = 0; w < 4; ++w) {
                    const float c0 = bflo(c[q][w]), c1 = bfhi(c[q][w]);
                    const float s0 = lastseg ? c0 : c0 * __builtin_amdgcn_rcpf(bflo(x[q][w])), s1 = lastseg ? c1 : c1 * __builtin_amdgcn_rcpf(bfhi(x[q][w]));
                    acc[ai][bj][m][w >> 1][(w & 1) * 2] *= s0; acc[ai][bj][m][w >> 1][(w & 1) * 2 + 1] *= s1;
                }
            }
        }
        if (lastseg) {
#pragma unroll
            for (int ai = 0; ai < 2; ++ai)
#pragma unroll
                for (int m = 0; m < 4; ++m)
#pragma unroll
                    for (int bj = 0; bj < 2; ++bj) {
                        u32x4 w; w[0] = pack2(acc[ai][bj][m][0][0], acc[ai][bj][m][0][1]); w[1] = pack2(acc[ai][bj][m][0][2], acc[ai][bj][m][0][3]);
                        w[2] = pack2(acc[ai][bj][m][1][0], acc[ai][bj][m][1][1]); w[3] = pack2(acc[ai][bj][m][1][2], acc[ai][bj][m][1][3]);
                        *(u32x4*)(O + (size_t)(row0 + ai * 128 + m * 16) * D + col0 + bj * 128) = w;
                    }
        }
    }
};
__device__ __forceinline__ void ph_g2(const Params& p, int l, int M, LAS unsigned char* lds) {
    G2Sched S; S.Y = p.Y; S.Wb = p.wbT + (size_t)l * 4 * D * MW; S.ntiles = (M / 256) * 4; S.G = gridDim.x; S.c = blockIdx.x;
    EpiMix E; E.gate = p.gate; E.O = p.mix;
    g8::gemm_phase(lds, MW, S, E);
}

struct EpiY {
    bf16_t* O;
    __device__ __forceinline__ bool keep(const g8::Unit&) const { return false; }
    __device__ __forceinline__ void operator()(const f32x4 (&acc)[2][2][4][2], const g8::Unit& u, int wr, int wc, int fr, int fq, const LAS float*) const {
        const int row0 = u.pm * 256 + wr * 64 + fr, col0 = u.pn * 256 + wc * 32 + 8 * fq;
#pragma unroll
        for (int ai = 0; ai < 2; ++ai)
#pragma unroll
            for (int m = 0; m < 4; ++m)
#pragma unroll
                for (int bj = 0; bj < 2; ++bj) {
                    u32x4 w; w[0] = pack2(acc[ai][bj][m][0][0], acc[ai][bj][m][0][1]); w[1] = pack2(acc[ai][bj][m][0][2], acc[ai][bj][m][0][3]);
                    w[2] = pack2(acc[ai][bj][m][1][0], acc[ai][bj][m][1][1]); w[3] = pack2(acc[ai][bj][m][1][2], acc[ai][bj][m][1][3]);
                    *(u32x4*)(O + (size_t)(row0 + ai * 128 + m * 16) * D + col0 + bj * 128) = w;
                }
    }
};
__device__ __forceinline__ void ph_g3(const Params& p, int l, int M, LAS unsigned char* lds) {
    g8::PlainSched S; S.init(p.mix, p.woutT + (size_t)l * D * D, M, D, D);
    EpiY E; E.O = p.Y;
    g8::gemm_phase(lds, D, S, E);
}

template <bool DRY = false> __device__ __forceinline__ void ph_route(const Params& p, int l, int M, LAS unsigned char* lds) {
    int* const r_cnt = DRY ? p.cnt + 64 : p.cnt; int* const r_list = DRY ? (int*)p.act : p.list; int* const r_ts = DRY ? (int*)p.yp : p.tokslot; float* const r_tw = DRY ? (float*)p.yp + (size_t)NTOK * 4 : p.topw;
    LAS float* fs = (LAS float*)lds;
    LAS float* lg = fs + 32 * 1028;
    LAS int* lcnt = (LAS int*)(lg + 32 * 36);
    LAS int* lbase = lcnt + 32;
    const int tid = opaque_tid(), wid = tid >> 6, lane = tid & 63;
    const float* rw = p.router_w + (size_t)l * D * NE;
    for (int it = blockIdx.x; it < M / 32; it += gridDim.x) {
        const int tok0 = it * 32;
        {
            float4 v[4][4]; float ss[4];
            const float* mb0 = p.mod + (size_t)(l * 5 + tok_modrow(tok0)) * (NMOD * D);
            u32x2 yv[4][4]; float4 g1v[4];
#pragma unroll
            for (int i = 0; i < 4; ++i) g1v[i] = *(const float4*)(mb0 + 2 * D + i * 256 + lane * 4);
#pragma unroll
            for (int q = 0; q < 4; ++q) {
                const size_t ro = (size_t)(tok0 + wid * 4 + q) * D;
#pragma unroll
                for (int i = 0; i < 4; ++i) { v[q][i] = *(const float4*)(p.xl + ro + i * 256 + lane * 4); yv[q][i] = *(const u32x2*)(p.Y + ro + i * 256 + lane * 4); }
            }
#pragma unroll
            for (int q = 0; q < 4; ++q)
#pragma unroll
                for (int i = 0; i < 4; ++i) {
                    v[q][i].x += g1v[i].x * bflo(yv[q][i][0]); v[q][i].y += g1v[i].y * bfhi(yv[q][i][0]); v[q][i].z += g1v[i].z * bflo(yv[q][i][1]); v[q][i].w += g1v[i].w * bfhi(yv[q][i][1]);
                    if (!DRY) *(float4*)(p.xl + (size_t)(tok0 + wid * 4 + q) * D + i * 256 + lane * 4) = v[q][i];
                }
#pragma unroll
            for (int q = 0; q < 4; ++q) {
                float s = 0.f;
#pragma unroll
                for (int i = 0; i < 4; ++i) s += v[q][i].x * v[q][i].x + v[q][i].y * v[q][i].y + v[q][i].z * v[q][i].z + v[q][i].w * v[q][i].w;
                ss[q] = s;
            }
#pragma unroll
            for (int m = 32; m >= 1; m >>= 1)
#pragma unroll
                for (int q = 0; q < 4; ++q) ss[q] += shx(ss[q], m, lane);
            const float* mb = mb0;
#pragma unroll
            for (int i = 0; i < 4; ++i) {
                const int cidx = i * 256 + lane * 4;
                const float4 gv = *(const float4*)(p.norm2_g + l * D + cidx), sv = *(const float4*)(mb + 4 * D + cidx), hv = *(const float4*)(mb + 3 * D + cidx);
#pragma unroll
                for (int q = 0; q < 4; ++q) {
                    const int tl = wid * 4 + q, tok = tok0 + tl;
                    const float rinv = rsqrtf(ss[q] * (1.0f / D) + 1e-6f);
                    const float h0 = v[q][i].x * rinv * gv.x * (1.f + sv.x) + hv.x, h1 = v[q][i].y * rinv * gv.y * (1.f + sv.y) + hv.y;
                    const float h2 = v[q][i].z * rinv * gv.z * (1.f + sv.z) + hv.z, h3 = v[q][i].w * rinv * gv.w * (1.f + sv.w) + hv.w;
                    u32x2 o; o[0] = pack2(h0, h1); o[1] = pack2(h2, h3);
                    *(u32x2*)(p.F + (size_t)tok * D + cidx) = o;
                    *(LAS f32x4*)(fs + tl * 1028 + cidx) = (f32x4){h0, h1, h2, h3};
                }
            }
        }
        __syncthreads();
        {
            typedef float f32x16 __attribute__((ext_vector_type(16)));
            f32x16 acc;
#pragma unroll
            for (int r = 0; r < 16; ++r) acc[r] = 0.f;
            const int tk = lane & 31, hh = lane >> 5;
            const LAS float* ap = fs + tk * 1028 + wid * 128 + 4 * hh;
            const float* bp = rw + (size_t)(wid * 128 + 4 * hh) * NE + tk;
#pragma unroll 4
            for (int kk = 0; kk < 16; ++kk) {
                const f32x4 a4 = *(const LAS f32x4*)(ap + kk * 8);
                const float b0 = bp[(kk * 8 + 0) * NE], b1 = bp[(kk * 8 + 1) * NE], b2 = bp[(kk * 8 + 2) * NE], b3 = bp[(kk * 8 + 3) * NE];
                acc = __builtin_amdgcn_mfma_f32_32x32x2f32(a4[0], b0, acc, 0, 0, 0);
                acc = __builtin_amdgcn_mfma_f32_32x32x2f32(a4[1], b1, acc, 0, 0, 0);
                acc = __builtin_amdgcn_mfma_f32_32x32x2f32(a4[2], b2, acc, 0, 0, 0);
                acc = __builtin_amdgcn_mfma_f32_32x32x2f32(a4[3], b3, acc, 0, 0, 0);
            }
            __syncthreads();
            LAS float* red = fs;
#pragma unroll
            for (int r = 0; r < 16; ++r) red[(wid * 32 + (r & 3) + 8 * (r >> 2) + 4 * hh) * 33 + tk] = acc[r];
            __syncthreads();
            const int t2 = tid >> 4, e0 = (tid & 15) * 2;
            float s0 = p.router_b[l * NE + e0], s1 = p.router_b[l * NE + e0 + 1];
#pragma unroll
            for (int w = 0; w < 8; ++w) { s0 += red[(w * 32 + t2) * 33 + e0]; s1 += red[(w * 32 + t2) * 33 + e0 + 1]; }
            lg[t2 * 36 + e0] = s0; lg[t2 * 36 + e0 + 1] = s1;
            if (tid < 32) lcnt[tid] = 0;
        }
        __syncthreads();
        float vals[4]; int idxs[4], rank[4];
        if (tid < 32) {
            float lv[32];
#pragma unroll
            for (int q = 0; q < 8; ++q) { const f32x4 t = *(const LAS f32x4*)(lg + tid * 36 + q * 4); lv[q * 4] = t[0]; lv[q * 4 + 1] = t[1]; lv[q * 4 + 2] = t[2]; lv[q * 4 + 3] = t[3]; }
#pragma unroll
            for (int k = 0; k < 4; ++k) {
                float best = lv[0]; int bi = 0;
#pragma unroll
                for (int ee = 1; ee < NE; ++ee) { const bool gt = lv[ee] > best; best = gt ? lv[ee] : best; bi = gt ? ee : bi; }
#pragma unroll
                for (int ee = 0; ee < NE; ++ee) lv[ee] = (ee == bi) ? -3.0e38f : lv[ee];
                vals[k] = best; idxs[k] = bi;
                rank[k] = atomicAdd((int*)(lcnt + bi), 1);
            }
        }
        __syncthreads();
        if (tid < 32) { const int c = lcnt[tid]; lbase[tid] = c ? atomicAdd(r_cnt + l * NE + tid, c) : 0; }
        __syncthreads();
        if (tid < 32) {
            const int tok = tok0 + tid;
            const float mx = vals[0];
            float ex[4], sum = 0.f;
#pragma unroll
            for (int k = 0; k < 4; ++k) { ex[k] = __expf(vals[k] - mx); sum += ex[k]; }
            const float inv = 1.0f / sum;
#pragma unroll
            for (int k = 0; k < 4; ++k) {
                const int ee = idxs[k];
                const int slot = lbase[ee] + rank[k];
                r_list[(size_t)ee * NTOK + slot] = tok;
                r_ts[(size_t)tok * 4 + k] = (ee << 16) | slot;
                r_tw[(size_t)tok * 4 + k] = ex[k] * inv;
            }
        }
        __syncthreads();
    }
}

__device__ __forceinline__ void build_expert_tables(const Params& p, int l, LAS int* ts, LAS int* cn, LAS int* te) {
    const int tid = opaque_tid();
    if (tid < 64) {
        const int c = tid < NE ? p.cnt[l * NE + tid] : 0;
        const int nt = (c + 255) >> 8;
        int v = nt;
#pragma unroll
        for (int off = 1; off < 32; off <<= 1) { const int t = shupi(v, off, tid); if (tid >= off) v += t; }
        if (tid < NE) { cn[tid] = c; ts[tid] = v - nt; if (tid == NE - 1) ts[NE] = v; }
        if (te && tid < NE) for (int q = 0; q < nt; ++q) te[v - nt + q] = tid;
    }
    __syncthreads();
}

struct MoeSched {
    const LAS int* ts; const LAS int* cn; const LAS int* te; const int* list; const bf16_t* A; const bf16_t* Bt; const float* bias; int K, npn, nunits, G, c, nrowsB, nbias; bool gather;
    static constexpr bool HAS_BIAS = true;
    __device__ __forceinline__ bool next(int i, g8::Unit& u) const {
        const long L = (long)i * G + c; if (L >= nunits) return false;
        u.pm = (int)(L / npn); u.pn = (int)(L % npn); u.e = te[u.pm]; return true;
    }
    __device__ __forceinline__ const char* a_base(const g8::Unit& u) const { return (const char*)(gather ? A : A + (size_t)u.pm * 256 * K); }
    __device__ __forceinline__ const char* b_base(const g8::Unit& u) const { return (const char*)(Bt + ((size_t)u.e * nrowsB + (size_t)u.pn * 256) * K); }
    __device__ __forceinline__ const int* row_addr(const g8::Unit& u, int R) const {
        const int cnt = cn[u.e], sl = (u.pm - ts[u.e]) * 256 + R;
        return list + (size_t)u.e * NTOK + (sl < cnt ? sl : 0);
    }
    __device__ __forceinline__ int rows_valid(const g8::Unit& u) const { return cn[u.e] - (u.pm - ts[u.e]) * 256; }
    __device__ __forceinline__ const float* bias_src(const g8::Unit& u, int lane) const {
        if (nbias == 2) return bias + (size_t)u.e * 2 * D + (lane < 32 ? u.pn * 128 + lane * 4 : D + u.pn * 128 + (lane - 32) * 4);
        return bias + (size_t)u.e * D + u.pn * 256 + lane * 4;
    }
};
struct EpiAct {
    bf16_t* O;
    __device__ __forceinline__ bool keep(const g8::Unit&) const { return false; }
    __device__ __forceinline__ void operator()(const f32x4 (&acc)[2][2][4][2], const g8::Unit& u, int wr, int wc, int fr, int fq, const LAS float* bias) const {
        const int row0 = u.pm * 256 + wr * 64 + fr, col0 = u.pn * 128 + wc * 32 + 8 * fq;
        const LAS float* bb = bias + wc * 32 + 8 * fq;
        const f32x4 g0 = *(const LAS f32x4*)bb, g1 = *(const LAS f32x4*)(bb + 4), l0 = *(const LAS f32x4*)(bb + 128), l1 = *(const LAS f32x4*)(bb + 132);
        const float bg[8] = {g0[0], g0[1], g0[2], g0[3], g1[0], g1[1], g1[2], g1[3]}, bl[8] = {l0[0], l0[1], l0[2], l0[3], l1[0], l1[1], l1[2], l1[3]};
#pragma unroll
        for (int ai = 0; ai < 2; ++ai)
#pragma unroll
            for (int m = 0; m < 4; ++m) {
                float o[8];
#pragma unroll
                for (int n = 0; n < 2; ++n)
#pragma unroll
                    for (int j = 0; j < 4; ++j) {
                        const float glu = fminf(acc[ai][0][m][n][j] + bg[n * 4 + j], 7.0f);
                        const float lin = fminf(fmaxf(acc[ai][1][m][n][j] + bl[n * 4 + j], -7.0f), 7.0f);
                        o[n * 4 + j] = glu * sigmoidf_(1.702f * glu) * (lin + 1.0f);
                    }
                *(u32x4*)(O + (size_t)(row0 + ai * 128 + m * 16) * D + col0) = pack8(o);
            }
    }
};
__device__ __forceinline__ void ph_g4(const Params& p, int l, LAS unsigned char* lds) {
    LAS int* ts = (LAS int*)(lds + g8::STAGE_BYTES); LAS int* cn = ts + 40; LAS int* te = ts + 80;
    build_expert_tables(p, l, ts, cn, te);
    MoeSched S; S.ts = ts; S.cn = cn; S.te = te; S.list = p.list; S.A = p.F; S.Bt = p.w1T + (size_t)l * NE * 2 * D * D; S.bias = p.moe_b1 + (size_t)l * NE * 2 * D; S.nbias = 2;
    S.K = D; S.npn = 8; S.nunits = ts[NE] * 8; S.G = gridDim.x; S.c = blockIdx.x; S.nrowsB = 2 * D; S.gather = true;
    EpiAct E; E.O = p.act;
    g8::gemm_phase(lds, D, S, E);
}

struct EpiYp {
    bf16_t* O;
    __device__ __forceinline__ bool keep(const g8::Unit&) const { return false; }
    __device__ __forceinline__ void operator()(const f32x4 (&acc)[2][2][4][2], const g8::Unit& u, int wr, int wc, int fr, int fq, const LAS float* bias) const {
        const int row0 = u.pm * 256 + wr * 64 + fr, col0 = u.pn * 256 + wc * 32 + 8 * fq;
#pragma unroll
        for (int bj = 0; bj < 2; ++bj) {
            const LAS float* bb = bias + bj * 128 + wc * 32 + 8 * fq;
            const f32x4 c0v = *(const LAS f32x4*)bb, c1v = *(const LAS f32x4*)(bb + 4);
            const float4 c0 = make_float4(c0v[0], c0v[1], c0v[2], c0v[3]), c1 = make_float4(c1v[0], c1v[1], c1v[2], c1v[3]);
#pragma unroll
            for (int ai = 0; ai < 2; ++ai)
#pragma unroll
                for (int m = 0; m < 4; ++m) {
                    u32x4 w; w[0] = pack2(acc[ai][bj][m][0][0] + c0.x, acc[ai][bj][m][0][1] + c0.y); w[1] = pack2(acc[ai][bj][m][0][2] + c0.z, acc[ai][bj][m][0][3] + c0.w);
                    w[2] = pack2(acc[ai][bj][m][1][0] + c1.x, acc[ai][bj][m][1][1] + c1.y); w[3] = pack2(acc[ai][bj][m][1][2] + c1.z, acc[ai][bj][m][1][3] + c1.w);
                    *(u32x4*)(O + (size_t)(row0 + ai * 128 + m * 16) * D + col0 + bj * 128) = w;
                }
        }
    }
};
__device__ __forceinline__ void ph_g5(const Params& p, int l, LAS unsigned char* lds) {
    LAS int* ts = (LAS int*)(lds + g8::STAGE_BYTES); LAS int* cn = ts + 40; LAS int* te = ts + 80;
    build_expert_tables(p, l, ts, cn, te);
    MoeSched S; S.ts = ts; S.cn = cn; S.te = te; S.list = p.list; S.A = p.act; S.Bt = p.w2T + (size_t)l * NE * D * D; S.bias = p.moe_b2 + (size_t)l * NE * D; S.nbias = 1;
    S.K = D; S.npn = 4; S.nunits = ts[NE] * 4; S.G = gridDim.x; S.c = blockIdx.x; S.nrowsB = D; S.gather = false;
    EpiYp E; E.O = p.yp;
    g8::gemm_phase(lds, D, S, E);
}

template <bool DRY = false> __device__ __forceinline__ void ph_combine(const Params& p, int l, int M, LAS unsigned char* lds) {
    float* const c_xl = DRY ? p.prep : p.xl; bf16_t* const c_H = DRY ? (bf16_t*)(p.prep + (size_t)NTOK * D) : p.H; float* const c_out = DRY ? p.prep : p.out;
    LAS int* ts = (LAS int*)lds; LAS int* cn = ts + 40;
    build_expert_tables(p, l, ts, cn, nullptr);
    const int tid = opaque_tid(), wid = tid >> 6, lane = tid & 63;
    const bool last = (l == 1);
    const int tstep = gridDim.x * NWAVES;
    int tok = blockIdx.x * NWAVES + wid;
    int4 nts = make_int4(0, 0, 0, 0); float4 ntw = make_float4(0.f, 0.f, 0.f, 0.f);
    if (tok < M) { nts = *(const int4*)(p.tokslot + (size_t)tok * 4); ntw = *(const float4*)(p.topw + (size_t)tok * 4); }
    for (; tok < M; tok += tstep) {
        float4 v[4];
        const float* mb = p.mod + (size_t)(l * 5 + tok_modrow(tok)) * (NMOD * D);
        const int tsl[4] = {nts.x, nts.y, nts.z, nts.w}; const float wts[4] = {ntw.x, ntw.y, ntw.z, ntw.w};
        int rows[4];
#pragma unroll
        for (int k = 0; k < 4; ++k) rows[k] = ts[tsl[k] >> 16] * 256 + (tsl[k] & 0xffff);
        if (tok + tstep < M) { nts = *(const int4*)(p.tokslot + (size_t)(tok + tstep) * 4); ntw = *(const float4*)(p.topw + (size_t)(tok + tstep) * 4); }
        u32x2 yv[4][4]; float4 xin[4], gtv[4];
#pragma unroll
        for (int i = 0; i < 4; ++i) {
            const int cidx = i * 256 + lane * 4;
#pragma unroll
            for (int k = 0; k < 4; ++k) yv[i][k] = *(const u32x2*)(p.yp + (size_t)rows[k] * D + cidx);
            xin[i] = *(const float4*)(p.xl + (size_t)tok * D + cidx);
            gtv[i] = *(const float4*)(mb + 5 * D + cidx);
        }
        float ss = 0.f;
#pragma unroll
        for (int i = 0; i < 4; ++i) {
            float m0 = 0.f, m1 = 0.f, m2 = 0.f, m3 = 0.f;
#pragma unroll
            for (int k = 0; k < 4; ++k) { m0 += wts[k] * bflo(yv[i][k][0]); m1 += wts[k] * bfhi(yv[i][k][0]); m2 += wts[k] * bflo(yv[i][k][1]); m3 += wts[k] * bfhi(yv[i][k][1]); }
            float4 xv = xin[i];
            xv.x += gtv[i].x * m0; xv.y += gtv[i].y * m1; xv.z += gtv[i].z * m2; xv.w += gtv[i].w * m3;
            v[i] = xv; ss += xv.x * xv.x + xv.y * xv.y + xv.z * xv.z + xv.w * xv.w;
        }
        ss = wave_sum(ss, lane);
        const float rinv = rsqrtf(ss * (1.0f / D) + 1e-6f);
        if (!last) {
#pragma unroll
            for (int i = 0; i < 4; ++i) *(float4*)(c_xl + (size_t)tok * D + i * 256 + lane * 4) = v[i];
            const float* mb1 = p.mod + (size_t)((l + 1) * 5 + tok_modrow(tok)) * (NMOD * D);
            norm_mod_store(v, rinv, p.norm1_g + (l + 1) * D, mb1 + 1 * D, mb1 + 0 * D, c_H + (size_t)tok * D, lane);
        } else {
#pragma unroll
            for (int i = 0; i < 4; ++i) {
                const int cidx = i * 256 + lane * 4;
                const float4 gv = *(const float4*)(p.final_norm_g + cidx);
                *(float4*)(c_out + (size_t)tok * D + cidx) = make_float4(v[i].x * rinv * gv.x, v[i].y * rinv * gv.y, v[i].z * rinv * gv.z, v[i].w * rinv * gv.w);
            }
        }
    }
}

#define XB_TMO      128
#define XB_XCNT(j)  (256  + 64 * (j))
#define XB_XSUB(j)  (1280 + 64 * (j))
#define XB_XGEN(j)  (2304 + 64 * (j))
#define XB_TOP      3328
#define XB_TOPGEN   3392
#define XCD_BAR_WORDS 3456
#define XB_SPIN_CAP (1u << 18)

__device__ __forceinline__ unsigned xb_ld(unsigned* p)              { return __hip_atomic_load(p, __ATOMIC_RELAXED, __HIP_MEMORY_SCOPE_AGENT); }
__device__ __forceinline__ unsigned xb_add(unsigned* p, unsigned v) { return __hip_atomic_fetch_add(p, v, __ATOMIC_RELAXED, __HIP_MEMORY_SCOPE_AGENT); }
__device__ __forceinline__ unsigned xb_xcc_id() { return (unsigned)__builtin_amdgcn_s_getreg((3 << 11) | 20) & 0xFu; }
#define XB_SPIN(cond, bar) do { unsigned _sp = 0; while (cond) { __builtin_amdgcn_s_sleep(1); \
    if ((++_sp & 255u) == 0u) { if (xb_ld(&(bar)[XB_TMO])) break; if (_sp > XB_SPIN_CAP) { atomicAdd(&(bar)[XB_TMO], 1u); break; } } } } while (0)

struct XcdBarrier {
    unsigned* bar; unsigned x;
    volatile LAS unsigned* st;
};

__device__ __forceinline__ XcdBarrier xcd_barrier_post(unsigned* bar, volatile LAS unsigned* st) {
    XcdBarrier b; b.bar = bar; b.x = xb_xcc_id(); b.st = st;
    if (threadIdx.x == 0) (void)xb_add(&bar[XB_XCNT(b.x)], 1u);
    return b;
}
__device__ __forceinline__ void xcd_barrier_complete(unsigned* bar, unsigned x, unsigned& nloc, unsigned& nx) {
    const unsigned G = gridDim.x * gridDim.y * gridDim.z;
    unsigned sum, cnt, mine, sp = 0u;
    for (;;) {
        sum = 0u; cnt = 0u; mine = 0u;
#pragma unroll
        for (unsigned j = 0; j < 16; ++j) { const unsigned c = xb_ld(&bar[XB_XCNT(j)]); sum += c; cnt += (c > 0u) ? 1u : 0u; mine = (j == x) ? c : mine; }
        if (sum == G) break;
        __builtin_amdgcn_s_sleep(1);
        if ((++sp & 255u) == 0u) { if (xb_ld(&bar[XB_TMO])) break; if (sp > XB_SPIN_CAP) { atomicAdd(&bar[XB_TMO], 1u); break; } }
    }
    nloc = mine > 0u ? mine : 1u; nx = cnt > 0u ? cnt : 1u;
}

__device__ __forceinline__ void xcd_barrier(const XcdBarrier& b) {
    asm volatile("s_waitcnt vmcnt(0)" ::: "memory");
    __syncthreads();
    if (threadIdx.x == 0) {
        unsigned* bar = b.bar;
        __builtin_amdgcn_s_waitcnt(0);
        unsigned nloc = b.st[0], nx = b.st[1];
        if (nloc == 0u) { xcd_barrier_complete(bar, b.x, nloc, nx); b.st[0] = nloc; b.st[1] = nx; }
        const unsigned old = xb_add(&bar[XB_XSUB(b.x)], 1u);
        const unsigned gen = old / nloc;
        if (old + 1u == (gen + 1u) * nloc) {
            __builtin_amdgcn_fence(__ATOMIC_RELEASE, "agent");
            asm volatile("s_waitcnt vmcnt(0)" ::: "memory");
            const unsigned og = xb_add(&bar[XB_TOP], 1u);
            const unsigned tg = og / nx;
            if (og + 1u == (tg + 1u) * nx) xb_add(&bar[XB_TOPGEN], 1u);
            else XB_SPIN(xb_ld(&bar[XB_TOPGEN]) == tg, bar);
            __builtin_amdgcn_fence(__ATOMIC_ACQUIRE, "agent");
            xb_add(&bar[XB_XGEN(b.x)], 1u);
            asm volatile("s_waitcnt vmcnt(0)" ::: "memory");
        } else {
            XB_SPIN(xb_ld(&bar[XB_XGEN(b.x)]) == gen, bar);
            __builtin_amdgcn_fence(__ATOMIC_ACQUIRE, "agent");
            asm volatile("s_waitcnt vmcnt(0)" ::: "memory");
        }
    }
    __syncthreads();
}


extern __shared__ __attribute__((aligned(16))) unsigned char dyn_lds[];

typedef const __attribute__((address_space(4))) unsigned char* KArgPtr;
__device__ __forceinline__ Params load_params(KArgPtr kp) {
    asm volatile("" : "+s"(kp));
    Params q;
    const __attribute__((address_space(4))) unsigned long long* k8 = (const __attribute__((address_space(4))) unsigned long long*)kp;
    unsigned long long* d8 = (unsigned long long*)&q;
#pragma unroll
    for (int i = 0; i < (int)(sizeof(Params) / 8); ++i) d8[i] = k8[i];
    return q;
}
__global__ void __launch_bounds__(NTHREADS, 2) k_mega(Params p_unused) {
    (void)p_unused;
    const KArgPtr kp = (KArgPtr)__builtin_amdgcn_kernarg_segment_ptr();
    LAS unsigned char* lds = (LAS unsigned char*)dyn_lds;
    volatile LAS unsigned* xb_words = (volatile LAS unsigned*)(lds + LDS_BYTES - 16);
    if (threadIdx.x == 0) { xb_words[0] = 0u; xb_words[1] = 0u; xb_words[2] = 0u; xb_words[3] = 0u; }
    __syncthreads();
    { const Params p = load_params(kp); (void)xcd_barrier_post(p.bar, xb_words); }
#define GRID_BARRIER() do { XcdBarrier b_; b_.bar = load_params(kp).bar; b_.x = xb_xcc_id(); b_.st = xb_words; xcd_barrier(b_); } while (0)
#define PH(stmt) do { const Params p = load_params(kp); stmt; } while (0)
    PH(ph_convert(p, lds));
    PH(ph_mod(p, lds));
    GRID_BARRIER();
    PH(ph_norm1_first(p));
    GRID_BARRIER();
    for (int l = 0; l < 2; ++l) {
        const int M = l == 0 ? NTOK : NLAT;
        { unsigned lb_ = (unsigned)(size_t)lds; asm volatile("" : "+s"(lb_)); lds = (LAS unsigned char*)(size_t)lb_; }
        PH(ph_g1(p, l, lds));
        GRID_BARRIER();
        PH(ph_prep(p, l, lds));
        PH(ph_local(p, l, lds));
        GRID_BARRIER();
        PH(ph_seq(p, l, lds));
        GRID_BARRIER();
        PH(ph_merge(p, l, M));
        GRID_BARRIER();
        PH(ph_g2(p, l, M, lds));
        GRID_BARRIER();
        PH(ph_g3(p, l, M, lds));
        GRID_BARRIER();
        PH(ph_route(p, l, M, lds));
        GRID_BARRIER();
        PH(ph_g4(p, l, lds));
        GRID_BARRIER();
        PH(ph_g5(p, l, lds));
        GRID_BARRIER();
        PH(ph_combine(p, l, M, lds));
        if (l == 0) GRID_BARRIER();
    }
}

static inline size_t align_up(size_t v, size_t a) { return (v + a - 1) / a * a; }

extern "C" void kernel_launch(void* const* d_in, const int* in_sizes, int n_in, void* d_out, int out_size, void* d_ws, size_t ws_size, hipStream_t stream) {
    (void)in_sizes; (void)n_in; (void)out_size;
    Params p{};
    const float** pf = (const float**)&p;
    for (int i = 0; i < 32; ++i) pf[i] = (const float*)d_in[i];
    p.out = (float*)d_out;
    unsigned char* w = (unsigned char*)d_ws; size_t off = 0;
    auto take = [&](size_t bytes) { void* r = w + off; off = align_up(off + bytes, 256); return r; };
    p.bar = (unsigned*)take(16384);
    p.cnt = (int*)take(1024);
    const size_t ctl_bytes = off;
    p.mod = (float*)take((size_t)2 * 5 * NMOD * D * 4);
    p.winT = (bf16_t*)take((size_t)2 * NPW * D * 2);
    p.wbT = (bf16_t*)take((size_t)2 * 4 * D * MW * 2);
    p.woutT = (bf16_t*)take((size_t)2 * D * D * 2);
    p.w1T = (bf16_t*)take((size_t)2 * NE * 2 * D * D * 2);
    p.w2T = (bf16_t*)take((size_t)2 * NE * D * D * 2);
    p.xl = (float*)take((size_t)NTOK * D * 4);
    p.H = (bf16_t*)take((size_t)NTOK * D * 2);
    p.P = (bf16_t*)take((size_t)NTOK * NP * 2);
    p.gate = (bf16_t*)take((size_t)NTOK * 4096 * 2);
    p.act = p.P; p.yp = p.P + (size_t)CAPROWS * D;
    p.prep = (float*)take(NPREP * TOKW * 4);
    p.O = (bf16_t*)take(8 * TOKW * 2);
    p.lq = (bf16_t*)take((size_t)3 * NITEM * 64 * 128 * 2);
    p.lo = (bf16_t*)take((size_t)3 * NITEM * 64 * 128 * 2);
    p.lb = (bf16_t*)take((size_t)3 * NITEM * 128 * 128 * 2);
    p.la = (bf16_t*)take((size_t)NITEM * 128 * 128 * 2);
    p.ld = (float*)take((size_t)3 * NITEM * 128 * 4);
    p.lruT = (bf16_t*)take((size_t)2 * 8 * 4 * 4096 * 2);
    p.lsig = (float*)take((size_t)2 * 2 * MW * 4);
    p.rope = (float2*)take((size_t)TL * 64 * 8);
    p.Y = (bf16_t*)take(4 * TOKW * 2);
    p.mix = (bf16_t*)take((size_t)NTOK * D * 2);
    p.F = p.H;
    p.list = (int*)take((size_t)NE * NTOK * 4);
    p.tokslot = (int*)take((size_t)NTOK * 4 * 4);
    p.topw = (float*)take((size_t)NTOK * 4 * 4);
    if (off > ws_size) { fprintf(stderr, "workspace too small: need %zu have %zu\n", off, ws_size); return; }

    static int grid = 0;
    if (!grid) {
        int dev = 0, cus = 0, occ = 0; (void)hipGetDevice(&dev); (void)hipDeviceGetAttribute(&cus, hipDeviceAttributeMultiprocessorCount, dev);
        (void)hipFuncSetAttribute((const void*)k_mega, hipFuncAttributeMaxDynamicSharedMemorySize, LDS_BYTES);
        (void)hipOccupancyMaxActiveBlocksPerMultiprocessor(&occ, (const void*)k_mega, NTHREADS, LDS_BYTES);
        if (cus <= 0) cus = 256;
        grid = cus * (occ < 1 ? 1 : 1);
        if (occ < 1) fprintf(stderr, "occupancy query says %d blocks per CU\n", occ);
    }
    (void)hipMemsetAsync(d_ws, 0, ctl_bytes, stream);
    hipLaunchKernelGGL(k_mega, dim3(grid), dim3(NTHREADS), LDS_BYTES, stream, p);
}
```

```cpp
#include <hip/hip_runtime.h>
#include <stdint.h>
#include <stdio.h>

#define LAS __attribute__((address_space(3)))
typedef unsigned short bf16_t;
typedef short bf16x8 __attribute__((ext_vector_type(8)));
typedef float f32x4 __attribute__((ext_vector_type(4)));
typedef float f32x2 __attribute__((ext_vector_type(2)));
typedef unsigned u32x2 __attribute__((ext_vector_type(2)));
typedef unsigned u32x4 __attribute__((ext_vector_type(4)));

#ifndef PROBE
#define PROBE 0
#endif

constexpr int D = 1024, NB = 4, TL = 4096, TC = 256, NLAT = NB * TL, NCTX = NB * TC, NTOK = NLAT + NCTX;
constexpr int NIN = 11792, NPW = 12032, NP = 7936, MW = 512, NE = 32, TOPK = 4, NMOD = 6;
constexpr int C_GQKV = 0, C_GZ = 1536, C_HQ = 2048, C_HI = 2560, C_HF = 3072, C_HG = 4096, C_LX = 4608,
              C_LY = 5120, C_RQKV = 5632, C_RG = 7168, C_GA = 7680, C_GB = 7688, W_MG = 7936;
__host__ __device__ __forceinline__ int win_dst_row(int n) { return n < 2048 ? n : n < 2064 ? 7680 + (n - 2048) : n < 7696 ? n - 16 : 7936 + (n - 7696); }
constexpr int NTHREADS = 512, NWAVES = 8;
constexpr int LDS_BYTES = 140 * 1024;
constexpr int CAPROWS = 77824;
constexpr size_t TOKW = (size_t)NTOK * MW;
constexpr int PR_LA = 0, PR_LU = 2, NPREP = 4;
constexpr int NCHUNK = 68, NITEM = 32 * NCHUNK;

struct Params {
    const float *x, *c, *ctx, *c_ctx, *w_mod, *b_mod, *norm1_g, *norm2_g, *w_in, *gdn_conv_w, *gdn_a_log, *gdn_dt_bias, *gdn_norm_g, *hgrn_lb,
        *hgrn_norm_g, *lru_conv_w, *lru_conv_b, *lru_wa, *lru_ba, *lru_wx, *lru_bx, *lru_lambda, *ret_norm_g, *w_branch, *w_out, *router_w,
        *router_b, *moe_w1, *moe_b1, *moe_w2, *moe_b2, *final_norm_g;
    float* out;
    unsigned* bar; int* cnt; float* mod;
    bf16_t *winT, *wbT, *woutT, *w1T, *w2T;
    float* xl; bf16_t* H; bf16_t* P; float* prep; float* gg; float* gb; bf16_t* O; bf16_t* Y; bf16_t* mix; bf16_t* F;
    int* list; int* tokslot; float* topw; bf16_t* act; bf16_t* yp;
    bf16_t *lq, *lo, *lb, *la; float* ld; bf16_t* lruT; bf16_t* gate; float* lsig; float2* rope;
};

typedef __bf16 bf16x2_t __attribute__((ext_vector_type(2)));
__device__ __forceinline__ unsigned pack2(float a, float b) { const f32x2 v = {a, b}; return __builtin_bit_cast(unsigned, __builtin_convertvector(v, bf16x2_t)); }
__device__ __forceinline__ unsigned f2bf(float f) { return pack2(f, f) & 0xffffu; }
__device__ __forceinline__ float bf2f(bf16_t b) { return __uint_as_float(((unsigned)b) << 16); }
__device__ __forceinline__ float bflo(unsigned u) { return __uint_as_float(u << 16); }
__device__ __forceinline__ float bfhi(unsigned u) { return __uint_as_float(u & 0xffff0000u); }
__device__ __forceinline__ float sigmoidf_(float x) { return __builtin_amdgcn_rcpf(1.0f + __expf(-x)); }
__device__ __forceinline__ float siluf_(float x) { return x * sigmoidf_(x); }
__device__ __forceinline__ float softplusf_(float x) { return x > 20.f ? x : __logf(1.0f + __expf(x)); }
__device__ __forceinline__ float ret_log_gamma(int h) { return h == 0 ? -0.031748698314580f : h == 1 ? -0.015748356968139f : h == 2 ? -0.007843177461025f : -0.003913899321136f; }
__device__ __forceinline__ float logsigmoidf_(float x) { return -softplusf_(-x); }
__device__ __forceinline__ float gelu_tanhf_(float x) { const float u = 0.7978845608028654f * (x + 0.044715f * x * x * x); return x * __builtin_amdgcn_rcpf(1.0f + __expf(-2.0f * u)); }
__device__ __forceinline__ float shx(float v, int m, int lane) { return __int_as_float(__builtin_amdgcn_ds_bpermute((lane ^ m) << 2, __float_as_int(v))); }
__device__ __forceinline__ float shup(float v, int off, int lane) { const int s = lane >= off ? lane - off : lane; return __int_as_float(__builtin_amdgcn_ds_bpermute(s << 2, __float_as_int(v))); }
__device__ __forceinline__ int shupi(int v, int off, int lane) { const int s = lane >= off ? lane - off : lane; return __builtin_amdgcn_ds_bpermute(s << 2, v); }
__device__ __forceinline__ float wave_sum(float v, int lane) {
#pragma unroll
    for (int m = 32; m >= 1; m >>= 1) v += shx(v, m, lane);
    return v;
}
__device__ __forceinline__ int opaque_tid() { int t = threadIdx.x; asm volatile("" : "+v"(t)); return t; }
template <class T> __device__ __forceinline__ T* opaque_sptr(T* q) { asm volatile("" : "+s"(q)); return q; }
__device__ __forceinline__ int tok_modrow(int tok) { return tok < NLAT ? (tok >> 12) : 4; }
__device__ __forceinline__ void tok_info(int tok, int& t, int& T, int& base) {
    if (tok < NLAT) { t = tok & (TL - 1); T = TL; base = tok - t; }
    else { t = (tok - NLAT) & (TC - 1); T = TC; base = tok - t; }
}

__device__ __forceinline__ f32x4 mfma16(bf16x8 a, bf16x8 b, f32x4 c) { return __builtin_amdgcn_mfma_f32_16x16x32_bf16(a, b, c, 0, 0, 0); }
__device__ __forceinline__ u32x2 pack4(f32x4 v) { u32x2 o; o[0] = pack2(v[0], v[1]); o[1] = pack2(v[2], v[3]); return o; }
__device__ __forceinline__ u32x4 pack8(const float* v) { u32x4 o; o[0] = pack2(v[0], v[1]); o[1] = pack2(v[2], v[3]); o[2] = pack2(v[4], v[5]); o[3] = pack2(v[6], v[7]); return o; }

namespace g8 {
constexpr int BM = 256, BK = 64, HALF = 128, HTB = HALF * BK * 2, STAGE_BYTES = 8 * HTB;
__device__ __forceinline__ int lds_byte(int r, int c) { const int st = (r >> 4) * 2 + (c >> 5), rr = r & 15, cc = c & 31, ob = rr * 64 + cc * 2; return st * 1024 + (ob ^ (((ob >> 9) & 1) << 5)); }
__device__ __forceinline__ void stage_rc(int b, int& R, int& C) { const int st = b / 1024, sb = b % 1024, swz = sb ^ (((sb >> 9) & 1) << 5); R = (st >> 1) * 16 + swz / 64; C = (st & 1) * 32 + (swz % 64) / 2; }
__device__ __forceinline__ int perm32(int rho) { const int n = rho >> 4, i = rho & 15; return 8 * (i >> 2) + 4 * n + (i & 3); }
struct Unit { int pm, pn, e; };

template <class Epi, class Sched>
__device__ __forceinline__ void gemm_phase(LAS unsigned char* lds, const int K, const Sched& S, const Epi& E) {
    const int tid = opaque_tid(), wid = __builtin_amdgcn_readfirstlane(tid >> 6), lane = tid & 63, wr = wid >> 2, wc = wid & 3, fr = lane & 15, fq = lane >> 4;
    const int nt = K / BK;
    int R0, C0, R1, C1; stage_rc(tid * 16, R0, C0); stage_rc(tid * 16 + 8192, R1, C1);
    unsigned voffB[2];
    voffB[0] = (unsigned)(((R0 & ~31) + perm32(R0 & 31)) * K + C0) * 2u; voffB[1] = (unsigned)(((R1 & ~31) + perm32(R1 & 31)) * K + C1) * 2u;
    const unsigned cb0 = (unsigned)C0 * 2u, cb1 = (unsigned)C1 * 2u;
    const size_t kstep = (size_t)(BK * 2);
    const size_t hstepB = (size_t)HALF * K * 2;
    const unsigned ldsw = (unsigned)wid * 1024u;
    const int aoff = lds_byte(wr * 64 + fr, fq * 8), boff = lds_byte(wc * 32 + fr, fq * 8);
#define G8_SA(b, h) (((b) * 2 + (h)) * HTB)
#define G8_SB(b, h) ((4 + (b) * 2 + (h)) * HTB)
#define G8_GL(src, dstoff) __builtin_amdgcn_global_load_lds((const unsigned*)(src), (LAS unsigned*)(lds + (dstoff)), 16, 0, 0)
#define G8_STAGE_A(bufoff, gbase, vo, h) do { G8_GL((const char*)(gbase) + (vo)[2 * (h)], (bufoff) + ldsw); G8_GL((const char*)(gbase) + (vo)[2 * (h) + 1], (bufoff) + ldsw + 8192); } while (0)
#define G8_STAGE_B(bufoff, gbase) do { G8_GL((const char*)(gbase) + voffB[0], (bufoff) + ldsw); G8_GL((const char*)(gbase) + voffB[1], (bufoff) + ldsw + 8192); } while (0)
#define G8_LDA(dst, b, h) do { _Pragma("unroll") for (int m = 0; m < 4; ++m) _Pragma("unroll") for (int k = 0; k < 2; ++k) dst[m][k] = *(const LAS bf16x8*)(lds + G8_SA(b, h) + aoff + m * 2048 + k * 1024); } while (0)
#define G8_LDB(dst, b, h) do { _Pragma("unroll") for (int n = 0; n < 2; ++n) _Pragma("unroll") for (int k = 0; k < 2; ++k) dst[n][k] = *(const LAS bf16x8*)(lds + G8_SB(b, h) + boff + n * 2048 + k * 1024); } while (0)
#define G8_MMA(ai, bj, At, Bt) do { __builtin_amdgcn_s_setprio(1); _Pragma("unroll") for (int m = 0; m < 4; ++m) _Pragma("unroll") for (int n = 0; n < 2; ++n) _Pragma("unroll") for (int k = 0; k < 2; ++k) \
        acc[ai][bj][m][n] = __builtin_amdgcn_mfma_f32_16x16x32_bf16(Bt[n][k], At[m][k], acc[ai][bj][m][n], 0, 0, 0); __builtin_amdgcn_s_setprio(0); } while (0)
#define G8_WAIT_V(n) asm volatile("s_waitcnt vmcnt(" #n ")" ::: "memory")
#define G8_WAIT_L(n) asm volatile("s_waitcnt lgkmcnt(" #n ")" ::: "memory")
#define G8_BAR __builtin_amdgcn_s_barrier()
#define G8_SCHED __builtin_amdgcn_sched_barrier(0)
    Unit cur, nxt; int ui = 0;
    if (!S.next(0, cur)) return;
    LAS float* biasbuf = (LAS float*)(lds + STAGE_BYTES + 2048);
    LAS int* rowbuf = (LAS int*)(lds + STAGE_BYTES + 4096);
    f32x4 acc[2][2][4][2];
#pragma unroll
    for (int a = 0; a < 2; ++a)
#pragma unroll
        for (int b = 0; b < 2; ++b)
#pragma unroll
            for (int m = 0; m < 4; ++m)
#pragma unroll
                for (int n = 0; n < 2; ++n) acc[a][b][m][n] = (f32x4){0.f, 0.f, 0.f, 0.f};
    bf16x8 At[4][2], B0[2][2], B1[2][2];
    unsigned vA[4];
    {
        unsigned rows[4] = {(unsigned)R0, (unsigned)R1, (unsigned)(HALF + R0), (unsigned)(HALF + R1)};
        if (S.gather) { rows[0] = (unsigned)*S.row_addr(cur, R0); rows[1] = (unsigned)*S.row_addr(cur, R1); rows[2] = (unsigned)*S.row_addr(cur, HALF + R0); rows[3] = (unsigned)*S.row_addr(cur, HALF + R1); }
        vA[0] = rows[0] * (unsigned)(K * 2) + cb0; vA[1] = rows[1] * (unsigned)(K * 2) + cb1; vA[2] = rows[2] * (unsigned)(K * 2) + cb0; vA[3] = rows[3] * (unsigned)(K * 2) + cb1;
    }
    const char* cA = S.a_base(cur); const char* cB = S.b_base(cur);
    G8_STAGE_B(G8_SB(0, 0), cB); G8_STAGE_A(G8_SA(0, 0), cA, vA, 0); G8_STAGE_B(G8_SB(0, 1), cB + hstepB); G8_STAGE_A(G8_SA(0, 1), cA, vA, 1);
    if (wr == 1) G8_BAR;
    G8_WAIT_V(4); G8_BAR;
    G8_STAGE_B(G8_SB(1, 0), cB + kstep); G8_STAGE_A(G8_SA(1, 0), cA + kstep, vA, 0); G8_STAGE_B(G8_SB(1, 1), cB + hstepB + kstep);
    G8_WAIT_V(6); G8_BAR;
    for (;;) {
        const bool has_next = S.next(ui + 1, nxt);
        const char* nA = has_next ? S.a_base(nxt) : cA; const char* nB = has_next ? S.b_base(nxt) : cB;
        const int nvalid = (S.gather && has_next) ? S.rows_valid(nxt) : 0;
        if (wid == 0) {
            if (Sched::HAS_BIAS) G8_GL(S.bias_src(cur, lane), STAGE_BYTES + 2048 + (ui & 1) * 1024);
            if (S.gather && has_next) G8_GL(S.row_addr(nxt, 0) + lane * 4, STAGE_BYTES + 4096 + ((ui + 1) & 1) * 1024);
        }
        for (int t = 0; t < nt; t += 2) {
            const bool last = (t == nt - 2);
            const char* a1 = cA + (size_t)(t + 1) * kstep;
            const char* a2 = last ? nA : cA + (size_t)(t + 2) * kstep; const char* b2 = last ? nB : cB + (size_t)(t + 2) * kstep;
            const char* a3 = a2 + kstep; const char* b3 = b2 + kstep;
            G8_LDB(B0, 0, 0); G8_SCHED; G8_LDA(At, 0, 0); G8_STAGE_A(G8_SA(1, 1), a1, vA, 1);
            if (last && S.gather && has_next) {
                const LAS int* rb = rowbuf + ((ui + 1) & 1) * 256;
                const unsigned r0 = R0 < nvalid ? (unsigned)rb[R0] : 0u, r1 = R1 < nvalid ? (unsigned)rb[R1] : 0u;
                const unsigned r2 = HALF + R0 < nvalid ? (unsigned)rb[HALF + R0] : 0u, r3 = HALF + R1 < nvalid ? (unsigned)rb[HALF + R1] : 0u;
                vA[0] = r0 * (unsigned)(K * 2) + cb0; vA[1] = r1 * (unsigned)(K * 2) + cb1; vA[2] = r2 * (unsigned)(K * 2) + cb0; vA[3] = r3 * (unsigned)(K * 2) + cb1;
            }
            G8_WAIT_L(8); G8_BAR; G8_WAIT_L(0); G8_MMA(0, 0, At, B0); G8_BAR; G8_SCHED;
            G8_LDB(B1, 0, 1); G8_STAGE_B(G8_SB(0, 0), b2);
            G8_BAR; G8_WAIT_L(0); G8_MMA(0, 1, At, B1); G8_BAR;
            G8_LDA(At, 0, 1); G8_STAGE_A(G8_SA(0, 0), a2, vA, 0);
            G8_BAR; G8_WAIT_L(0); G8_MMA(1, 0, At, B0); G8_BAR; G8_SCHED;
            G8_STAGE_B(G8_SB(0, 1), b2 + hstepB);
            G8_WAIT_V(6); G8_BAR; G8_MMA(1, 1, At, B1); G8_BAR;
            G8_LDB(B0, 1, 0); G8_SCHED; G8_LDA(At, 1, 0); G8_STAGE_A(G8_SA(0, 1), a2, vA, 1);
            G8_WAIT_L(8); G8_BAR; G8_WAIT_L(0); G8_MMA(0, 0, At, B0); G8_BAR; G8_SCHED;
            G8_LDB(B1, 1, 1); G8_STAGE_B(G8_SB(1, 0), b3);
            G8_BAR; G8_WAIT_L(0); G8_MMA(0, 1, At, B1); G8_BAR;
            G8_LDA(At, 1, 1); G8_STAGE_A(G8_SA(1, 0), a3, vA, 0);
            G8_BAR; G8_WAIT_L(0); G8_MMA(1, 0, At, B0); G8_BAR; G8_SCHED;
            G8_STAGE_B(G8_SB(1, 1), b3 + hstepB);
            G8_WAIT_V(6); G8_BAR; G8_MMA(1, 1, At, B1); G8_BAR;
        }
        E(acc, cur, wr, wc, fr, fq, biasbuf + (ui & 1) * 256);
        if (!has_next) break;
        if (!E.keep(cur))
#pragma unroll
        for (int a = 0; a < 2; ++a)
#pragma unroll
            for (int b = 0; b < 2; ++b)
#pragma unroll
                for (int m = 0; m < 4; ++m)
#pragma unroll
                    for (int n = 0; n < 2; ++n) acc[a][b][m][n] = (f32x4){0.f, 0.f, 0.f, 0.f};
        cur = nxt; cA = nA; cB = nB; ++ui;
    }
    G8_WAIT_V(0);
    if (wr == 0) G8_BAR;
    G8_BAR;
#undef G8_SA
#undef G8_SB
#undef G8_GL
#undef G8_STAGE_A
#undef G8_STAGE_B
#undef G8_LDA
#undef G8_LDB
#undef G8_MMA
#undef G8_WAIT_V
#undef G8_WAIT_L
#undef G8_BAR
#undef G8_SCHED
}

struct PlainSched {
    const bf16_t* A; const bf16_t* Bt; int K, nM, nN, nwg, G, c;
    __device__ __forceinline__ void init(const bf16_t* A_, const bf16_t* Bt_, int M, int N, int K_) { A = A_; Bt = Bt_; K = K_; nM = M / BM; nN = N / BM; nwg = nM * nN; G = gridDim.x; c = blockIdx.x; }
    __device__ __forceinline__ bool next(int i, Unit& u) const {
        const long L = (long)i * G + c; if (L >= nwg) return false;
        int wgid = (int)L; { const int q = nwg / 8, r = nwg % 8, xcd = wgid % 8, off = wgid / 8; wgid = (xcd < r ? xcd * (q + 1) : r * (q + 1) + (xcd - r) * q) + off; }
        const int nig = 8 * nN, gid = wgid / nig, fm = gid * 8, gsz = (nM - fm) < 8 ? (nM - fm) : 8;
        u.pm = fm + ((wgid % nig) % gsz); u.pn = (wgid % nig) / gsz; u.e = 0; return true;
    }
    __device__ __forceinline__ const char* a_base(const Unit& u) const { return (const char*)(A + (size_t)u.pm * BM * K); }
    __device__ __forceinline__ const char* b_base(const Unit& u) const { return (const char*)(Bt + (size_t)u.pn * BM * K); }
    static constexpr bool HAS_BIAS = false, gather = false;
    __device__ __forceinline__ const int* row_addr(const Unit&, int) const { return nullptr; }
    __device__ __forceinline__ int rows_valid(const Unit&) const { return 256; }
    __device__ __forceinline__ const float* bias_src(const Unit&, int) const { return nullptr; }
};
}

__device__ __forceinline__ int w1_dst_row(int n) { const int half = n >> 10, cc = n & 1023; return (cc >> 7) * 256 + half * 128 + (cc & 127); }

struct CvtTile { const float* src; bf16_t* dst; int ld, Nsrc, k0, n0, K, mode; };
__device__ __forceinline__ CvtTile cvt_decode(const Params& p, int it) {
    constexpr int PER_L = 2960 + 512 + 256 + 16384 + 8192;
    CvtTile t; const int l = it / PER_L; int r = it % PER_L;
    if (r < 2960) { const int nt = r % 185, kt = r / 185; t.src = p.w_in + (size_t)l * D * NIN; t.ld = NIN; t.Nsrc = NIN; t.k0 = kt * 64; t.n0 = nt * 64; t.dst = p.winT + (size_t)l * NPW * D; t.K = D; t.mode = 2; }
    else if (r < 3472) { r -= 2960; const int n = r / 128; r %= 128; const int nt = r % 16, kt = r / 16;
        t.src = p.w_branch + (size_t)(l * 4 + n) * MW * D; t.ld = D; t.Nsrc = D; t.k0 = kt * 64; t.n0 = nt * 64; t.dst = p.wbT + (size_t)(l * 4 + n) * D * MW; t.K = MW; t.mode = 0; }
    else if (r < 3728) { r -= 3472; const int nt = r % 16, kt = r / 16; t.src = p.w_out + (size_t)l * D * D; t.ld = D; t.Nsrc = D; t.k0 = kt * 64; t.n0 = nt * 64; t.dst = p.woutT + (size_t)l * D * D; t.K = D; t.mode = 0; }
    else if (r < 3728 + 16384) { r -= 3728; const int ee = r / 512; r %= 512; const int nt = r % 32, kt = r / 32;
        t.src = p.moe_w1 + (size_t)(l * NE + ee) * D * 2 * D; t.ld = 2 * D; t.Nsrc = 2 * D; t.k0 = kt * 64; t.n0 = nt * 64; t.dst = p.w1T + (size_t)(l * NE + ee) * 2 * D * D; t.K = D; t.mode = 1; }
    else { r -= 3728 + 16384; const int ee = r / 256; r %= 256; const int nt = r % 16, kt = r / 16;
        t.src = p.moe_w2 + (size_t)(l * NE + ee) * D * D; t.ld = D; t.Nsrc = D; t.k0 = kt * 64; t.n0 = nt * 64; t.dst = p.w2T + (size_t)(l * NE + ee) * D * D; t.K = D; t.mode = 0; }
    return t;
}

constexpr int CVT_TOTAL = 2 * (2960 + 512 + 256 + 16384 + 8192);
constexpr int CVT_G_FIRST = 932;
constexpr int CVT_G_L0 = 8008;
constexpr int CVT_G_ALL = CVT_TOTAL / 4;
__device__ __forceinline__ void cvt_trip(const Params& p, LAS float* tile, int tid, int g) {
    constexpr int TOTAL = CVT_TOTAL;
    float4 v[4][2];
    const int rr = tid >> 4, c4 = (tid & 15) * 4;
#pragma unroll
    for (int q = 0; q < 4; ++q) {
        const int it = g * 4 + q;
        const CvtTile t = cvt_decode(p, it < TOTAL ? it : TOTAL - 1);
        const int n = t.n0 + c4; const bool ok = n < t.Nsrc; const int nc = ok ? n : t.Nsrc - 4;
#pragma unroll
        for (int i = 0; i < 2; ++i) { const float4 x = *(const float4*)(t.src + (size_t)(t.k0 + rr + i * 32) * t.ld + nc); v[q][i] = ok ? x : make_float4(0.f, 0.f, 0.f, 0.f); }
    }
#pragma unroll
    for (int q = 0; q < 4; ++q)
#pragma unroll
        for (int i = 0; i < 2; ++i) { LAS float* tp = tile + q * 4160 + (rr + i * 32) * 65 + c4; tp[0] = v[q][i].x; tp[1] = v[q][i].y; tp[2] = v[q][i].z; tp[3] = v[q][i].w; }
    __syncthreads();
#pragma unroll
    for (int q = 0; q < 4; ++q) {
        const int it = g * 4 + q;
        if (it < TOTAL) {
            const CvtTile t = cvt_decode(p, it);
            const int nl = tid >> 3, kg = tid & 7, n = t.n0 + nl;
            float w[8];
#pragma unroll
            for (int j = 0; j < 8; ++j) w[j] = tile[q * 4160 + (kg * 8 + j) * 65 + nl];
            const int drow = t.mode == 1 ? w1_dst_row(n) : t.mode == 2 ? win_dst_row(n) : n;
            if (n < t.Nsrc) *(u32x4*)(t.dst + (size_t)drow * t.K + t.k0 + kg * 8) = pack8(w);
        }
    }
    __syncthreads();
}
__device__ __forceinline__ void cvt_fill(const Params& p, LAS unsigned char* lds, int w, int b1, int n1, int b2, int n2) {
    LAS float* tile = (LAS float*)lds; LAS int* tk = (LAS int*)(lds + 4 * 4160 * 4);
    int* const head = p.cnt + 256 + 32 * w;
    const int tid = opaque_tid();
    __syncthreads();
    int nxt = 0;
    if (tid == 0) nxt = atomicAdd(head, 1);
    for (;;) {
        if (tid == 0) tk[0] = nxt;
        __syncthreads();
        const int t = __builtin_amdgcn_readfirstlane(tk[0]);
        if (t >= n1 + n2) break;
        if (tid == 0) nxt = atomicAdd(head, 1);
        cvt_trip(p, tile, tid, t < n1 ? b1 + t : b2 + (t - n1));
    }
}
constexpr int CW_G1A = 932, CW_SEQ0A = 1932, CW_G2 = 4476, CW_G3 = 6476, CW_SEQ0B = 7076, CW_G1B = 8842, CW_SEQ1 = 9842;

__device__ __forceinline__ void ph_convert(const Params& p, LAS unsigned char* lds) {
    LAS float* tile = (LAS float*)lds;
    const int tid = opaque_tid();
    for (int idx = blockIdx.x * NTHREADS + tid; idx < 2 * 8 * 4 * 4096; idx += gridDim.x * NTHREADS) {
        const int i = idx & 63, j = (idx >> 6) & 63, mat = (idx >> 12) & 3, n = (idx >> 14) & 7, ll = idx >> 17, d = mat >> 1;
        p.lruT[idx] = (bf16_t)f2bf(((mat & 1) ? p.lru_wx : p.lru_wa)[(size_t)((ll * 2 + d) * 8 + n) * 4096 + i * 64 + j]);
    }
    for (int idx = blockIdx.x * NTHREADS + tid; idx < 2 * 2 * MW; idx += gridDim.x * NTHREADS) p.lsig[idx] = 8.0f * logsigmoidf_(p.lru_lambda[idx]);
    for (int idx = blockIdx.x * NTHREADS + tid; idx < TL * 64; idx += gridDim.x * NTHREADS) {
        const int t = idx >> 6, pi = idx & 63;
        const float pos = (pi < 32) ? (float)(t >> 6) : (float)(t & 63);
        const float ang = pos * exp2f(-(float)(pi & 31) * (13.287712379549449f / 32.0f));
        float sn, cs; sincosf(ang, &sn, &cs);
        p.rope[idx] = make_float2(cs, sn);
    }
    for (int idx = blockIdx.x * NTHREADS + tid; idx < 2 * 240 * (D / 8); idx += gridDim.x * NTHREADS) {
        const int ll = idx / (240 * (D / 8)), r = idx % (240 * (D / 8));
        *(u32x4*)(p.winT + ((size_t)ll * NPW + 7696) * D + (size_t)r * 8) = (u32x4){0u, 0u, 0u, 0u};
    }
    for (int g = blockIdx.x; g < CVT_G_FIRST; g += gridDim.x) cvt_trip(p, tile, tid, g);
}

__device__ __forceinline__ void ph_mod(const Params& p, LAS unsigned char* lds) {
    LAS float* sc = (LAS float*)lds;
    LAS float* red = sc + 5 * D;
    const int tid = opaque_tid(), wid = tid >> 6, lane = tid & 63;
    if ((int)blockIdx.x >= 192) return;
    for (int i = tid; i < 5 * D; i += NTHREADS) { const int r = i >> 10, k = i & 1023; const float v = r < 4 ? p.c[r * D + k] : p.c_ctx[k]; sc[i] = siluf_(v); }
    __syncthreads();
    for (int it = blockIdx.x; it < 192; it += gridDim.x) {
        const int l = it / 96, n0 = (it % 96) * 64;
        float acc[5] = {0.f, 0.f, 0.f, 0.f, 0.f};
        const float* wp = p.w_mod + (size_t)l * D * (NMOD * D) + n0 + lane;
        for (int k = wid * 128; k < wid * 128 + 128; ++k) {
            const float wv = wp[(size_t)k * (NMOD * D)];
#pragma unroll
            for (int r = 0; r < 5; ++r) acc[r] += sc[r * D + k] * wv;
        }
#pragma unroll
        for (int r = 0; r < 5; ++r) red[(wid * 5 + r) * 64 + lane] = acc[r];
        __syncthreads();
        if (tid < 320) { const int r = tid >> 6, cidx = tid & 63; float s = p.b_mod[l * NMOD * D + n0 + cidx];
#pragma unroll
            for (int w = 0; w < 8; ++w) s += red[(w * 5 + r) * 64 + cidx];
            p.mod[(size_t)(l * 5 + r) * (NMOD * D) + n0 + cidx] = s; }
        __syncthreads();
    }
}

__device__ __forceinline__ void norm_mod_store(const float4 (&v)[4], float rinv, const float* g, const float* scp, const float* shp, bf16_t* dst, int lane) {
#pragma unroll
    for (int i = 0; i < 4; ++i) {
        const int cidx = i * 256 + lane * 4;
        const float4 gv = *(const float4*)(g + cidx), sv = *(const float4*)(scp + cidx), hv = *(const float4*)(shp + cidx);
        const float h0 = v[i].x * rinv * gv.x * (1.f + sv.x) + hv.x, h1 = v[i].y * rinv * gv.y * (1.f + sv.y) + hv.y;
        const float h2 = v[i].z * rinv * gv.z * (1.f + sv.z) + hv.z, h3 = v[i].w * rinv * gv.w * (1.f + sv.w) + hv.w;
        u32x2 o; o[0] = pack2(h0, h1); o[1] = pack2(h2, h3);
        *(u32x2*)(dst + cidx) = o;
    }
}
__device__ __forceinline__ void ph_norm1_first(const Params& p) {
    const int tid = opaque_tid(), wid = tid >> 6, lane = tid & 63;
    for (int tok = blockIdx.x * NWAVES + wid; tok < NTOK; tok += gridDim.x * NWAVES) {
        const float* src = tok < NLAT ? p.x + (size_t)tok * D : p.ctx + (size_t)(tok - NLAT) * D;
        float4 v[4]; float ss = 0.f;
#pragma unroll
        for (int i = 0; i < 4; ++i) { v[i] = *(const float4*)(src + i * 256 + lane * 4); ss += v[i].x * v[i].x + v[i].y * v[i].y + v[i].z * v[i].z + v[i].w * v[i].w; }
        ss = wave_sum(ss, lane);
        const float rinv = rsqrtf(ss * (1.0f / D) + 1e-6f);
        const float* mb = p.mod + (size_t)(0 * 5 + tok_modrow(tok)) * (NMOD * D);
        norm_mod_store(v, rinv, p.norm1_g, mb + 1 * D, mb + 0 * D, p.H + (size_t)tok * D, lane);
#pragma unroll
        for (int i = 0; i < 4; ++i) *(float4*)(p.xl + (size_t)tok * D + i * 256 + lane * 4) = v[i];
    }
}

struct EpiP {
    bf16_t* O; bf16_t* gate;
    __device__ __forceinline__ bool keep(const g8::Unit&) const { return false; }
    __device__ __forceinline__ void operator()(const f32x4 (&acc)[2][2][4][2], const g8::Unit& u, int wr, int wc, int fr, int fq, const LAS float*) const {
        if (u.pn < 31) {
            const int row0 = u.pm * 256 + wr * 64 + fr, col0 = u.pn * 256 + wc * 32 + 8 * fq;
#pragma unroll
            for (int ai = 0; ai < 2; ++ai)
#pragma unroll
                for (int m = 0; m < 4; ++m) {
                    bf16_t* rowp = O + (size_t)(row0 + ai * 128 + m * 16) * NP + col0;
#pragma unroll
                    for (int bj = 0; bj < 2; ++bj) {
                        u32x4 w; w[0] = pack2(acc[ai][bj][m][0][0], acc[ai][bj][m][0][1]); w[1] = pack2(acc[ai][bj][m][0][2], acc[ai][bj][m][0][3]);
                        w[2] = pack2(acc[ai][bj][m][1][0], acc[ai][bj][m][1][1]); w[3] = pack2(acc[ai][bj][m][1][2], acc[ai][bj][m][1][3]);
                        *(u32x4*)(rowp + bj * 128) = w;
                    }
                }
        } else {
            const int g = u.pn - 31;
            bf16_t* gp = gate + ((((size_t)u.pm * 16 + g) * 8 + (wr * 4 + wc)) * 16) * 512 + (fq * 16 + fr) * 8;
#pragma unroll
            for (int ai = 0; ai < 2; ++ai)
#pragma unroll
                for (int m = 0; m < 4; ++m)
#pragma unroll
                    for (int bj = 0; bj < 2; ++bj) {
                        float s[8];
#pragma unroll
                        for (int n = 0; n < 2; ++n)
#pragma unroll
                            for (int j = 0; j < 4; ++j) s[n * 4 + j] = sigmoidf_(acc[ai][bj][m][n][j]);
                        *(u32x4*)(gp + (ai * 8 + m * 2 + bj) * 512) = pack8(s);
                    }
        }
    }
};
__device__ __forceinline__ void ph_g1(const Params& p, int l, LAS unsigned char* lds) {
    g8::PlainSched S; S.init(p.H, p.winT + (size_t)l * NPW * D, NTOK, NPW, D);
    EpiP E; E.O = p.P; E.gate = p.gate;
    g8::gemm_phase(lds, D, S, E);
    if ((int)blockIdx.x >= (NTOK / 256) * (NPW / 256) % 256) { if (l == 0) cvt_fill(p, lds, 2, CW_G1A, CW_SEQ0A - CW_G1A, 0, 0); else cvt_fill(p, lds, 3, CW_G1B, CW_SEQ1 - CW_G1B, 0, 0); }
}

__device__ __forceinline__ void ph_prep(const Params& p, int l, LAS unsigned char* lds) {
    const int tid = opaque_tid(), wid = tid >> 6, lane = tid & 63, fr = lane & 15, fq = lane >> 4;
    LAS float* xs = (LAS float*)lds;
    LAS bf16_t* xb = (LAS bf16_t*)(xs + 64 * 68);
    LAS bf16_t* wt = xb + 64 * 72;
    for (int it = blockIdx.x; it < (NTOK / 64) * 8; it += gridDim.x) {
        const int tile = it >> 3, n = it & 7, tok0 = tile * 64;
        {
            const int tl = tid & 63, cg = tid >> 6, tok = tok0 + tl;
            int t, T, base; tok_info(tok, t, T, base);
            float a[8];
            { const float4 b0 = *(const float4*)(p.lru_conv_b + l * MW + n * 64 + cg * 8), b1 = *(const float4*)(p.lru_conv_b + l * MW + n * 64 + cg * 8 + 4);
              a[0] = b0.x; a[1] = b0.y; a[2] = b0.z; a[3] = b0.w; a[4] = b1.x; a[5] = b1.y; a[6] = b1.z; a[7] = b1.w; }
#pragma unroll
            for (int j = 0; j < 4; ++j) {
                const int tt = t + j - 2;
                const float okf = (tt >= 0 && tt < T) ? 1.0f : 0.0f;
                const int ttc = tt < 0 ? 0 : (tt >= T ? T - 1 : tt);
                const u32x4 u = *(const u32x4*)(p.P + (size_t)(base + ttc) * NP + C_LX + n * 64 + cg * 8);
                const float* w = p.lru_conv_w + (size_t)(l * 4 + j) * MW + n * 64 + cg * 8;
                const float4 wa = *(const float4*)w, wb = *(const float4*)(w + 4);
                const float wv[8] = {wa.x * okf, wa.y * okf, wa.z * okf, wa.w * okf, wb.x * okf, wb.y * okf, wb.z * okf, wb.w * okf};
#pragma unroll
                for (int q = 0; q < 4; ++q) { a[2 * q] += wv[2 * q] * bflo(u[q]); a[2 * q + 1] += wv[2 * q + 1] * bfhi(u[q]); }
            }
            *(LAS f32x4*)(xs + tl * 68 + cg * 8) = (f32x4){a[0], a[1], a[2], a[3]}; *(LAS f32x4*)(xs + tl * 68 + cg * 8 + 4) = (f32x4){a[4], a[5], a[6], a[7]};
            *(LAS u32x4*)(xb + tl * 72 + cg * 8) = pack8(a);
            const bf16_t* wsrc = p.lruT + (size_t)((l * 8 + n) * 4) * 4096;
#pragma unroll
            for (int q = 0; q < 4; ++q) { const int e8 = tid + 512 * q, row = e8 >> 3, c8 = e8 & 7; *(LAS u32x4*)(wt + row * 72 + c8 * 8) = *(const u32x4*)(wsrc + (size_t)e8 * 8); }
        }
        __syncthreads();
        {
            const int jb = wid & 3, tb0 = (wid >> 2) * 2;
            bf16x8 xw[4][2];
#pragma unroll
            for (int m = 0; m < 4; ++m)
#pragma unroll
                for (int ks = 0; ks < 2; ++ks) xw[m][ks] = *(const LAS bf16x8*)(wt + (m * 64 + jb * 16 + fr) * 72 + ks * 32 + fq * 8);
            const int c0 = n * 64 + jb * 16 + 4 * fq;
            float4 bav[2], bxv[2], lsv[2];
#pragma unroll
            for (int d = 0; d < 2; ++d) {
                bav[d] = *(const float4*)(p.lru_ba + (l * 2 + d) * MW + c0); bxv[d] = *(const float4*)(p.lru_bx + (l * 2 + d) * MW + c0);
                lsv[d] = *(const float4*)(p.lsig + (l * 2 + d) * MW + c0);
            }
#pragma unroll
            for (int e = 0; e < 2; ++e) {
                const int tl = (tb0 + e) * 16 + fr, tok = tok0 + tl;
                f32x4 acc[4];
#pragma unroll
                for (int m = 0; m < 4; ++m) acc[m] = (f32x4){0.f, 0.f, 0.f, 0.f};
#pragma unroll
                for (int ks = 0; ks < 2; ++ks) {
                    const bf16x8 y = *(const LAS bf16x8*)(xb + tl * 72 + ks * 32 + fq * 8);
#pragma unroll
                    for (int m = 0; m < 4; ++m) acc[m] = mfma16(xw[m][ks], y, acc[m]);
                }
                const f32x4 xv = *(const LAS f32x4*)(xs + tl * 68 + jb * 16 + 4 * fq);
#pragma unroll
                for (int d = 0; d < 2; ++d) {
                    const float bar_[4] = {bav[d].x, bav[d].y, bav[d].z, bav[d].w}, bxr[4] = {bxv[d].x, bxv[d].y, bxv[d].z, bxv[d].w}, lsr[4] = {lsv[d].x, lsv[d].y, lsv[d].z, lsv[d].w};
                    float av[4], uv[4];
#pragma unroll
                    for (int r = 0; r < 4; ++r) {
                        const float gr = sigmoidf_(acc[d * 2][r] + bar_[r]), gi = sigmoidf_(acc[d * 2 + 1][r] + bxr[r]);
                        const float la = gr * lsr[r];
                        av[r] = __expf(la);
                        uv[r] = xv[r] * gi * __builtin_amdgcn_sqrtf(fmaxf(1.0f - __expf(2.0f * la), 1e-12f));
                    }
                    *(float4*)(p.prep + (PR_LA + d) * TOKW + (size_t)tok * MW + c0) = make_float4(av[0], av[1], av[2], av[3]);
                    *(float4*)(p.prep + (PR_LU + d) * TOKW + (size_t)tok * MW + c0) = make_float4(uv[0], uv[1], uv[2], uv[3]);
                }
            }
        }
        __syncthreads();
    }
}

__device__ __forceinline__ int chunk_base(int b, int d, int n) {
    if (n < 4) { const int blk = d ? 3 - n : n; return NLAT + b * TC + blk * 64; }
    const int m = n - 4, blk = d ? 63 - m : m; return b * TL + blk * 64;
}

__device__ __forceinline__ void local_gla(const Params& p, int l, int tz, int chain, int n, LAS unsigned char* lds) {
    const int tid = opaque_tid(), wid = tid >> 6, lane = tid & 63, fr = lane & 15, fq = lane >> 4;
    const int b = chain >> 3, h = (chain >> 1) & 3, d = chain & 1;
    const int base = chunk_base(b, d, n);
    const size_t item = (size_t)tz * NITEM + (size_t)chain * NCHUNK + n;
    LAS bf16_t* qh = (LAS bf16_t*)lds;
    LAS bf16_t* kh = qh + 64 * 136;
    LAS bf16_t* sc = kh + 10 * 16 * 136;
    LAS bf16_t* vT = sc + 64 * 72;
    LAS bf16_t* kT = vT + 128 * 72;
    LAS float* bc = (LAS float*)(kT + 128 * 72);
    const int vcol = tz == 1 ? C_HI : C_RQKV + 1024;
    const int ti = tid >> 3, dg = tid & 7, cA = dg * 8, cB = 64 + dg * 8;
    const int tokI = base + (d ? 63 - ti : ti);
    const bf16_t* pr = p.P + (size_t)tokI * NP;
    float qt[16], kv[16];
    {
        float lfv[16];
        if (tz == 1) {
            float lbv[16];
            {
                const float* lp0 = p.hgrn_lb + (size_t)(0 * 2 + d) * MW + h * 128; const float* lp1 = p.hgrn_lb + (size_t)(1 * 2 + d) * MW + h * 128;
                const float4 a0 = *(const float4*)(lp0 + cA), a1 = *(const float4*)(lp0 + cA + 4), a2 = *(const float4*)(lp0 + cB), a3 = *(const float4*)(lp0 + cB + 4);
                const float4 b0 = *(const float4*)(lp1 + cA), b1 = *(const float4*)(lp1 + cA + 4), b2 = *(const float4*)(lp1 + cB), b3 = *(const float4*)(lp1 + cB + 4);
                const float x0[16] = {a0.x, a0.y, a0.z, a0.w, a1.x, a1.y, a1.z, a1.w, a2.x, a2.y, a2.z, a2.w, a3.x, a3.y, a3.z, a3.w};
                const float x1[16] = {b0.x, b0.y, b0.z, b0.w, b1.x, b1.y, b1.z, b1.w, b2.x, b2.y, b2.z, b2.w, b3.x, b3.y, b3.z, b3.w};
#pragma unroll
                for (int e = 0; e < 16; ++e) lbv[e] = (l == 1) ? fminf(__builtin_amdgcn_rcpf(1.0f + __expf(x0[e] - x1[e])), 1.0f - 1e-4f) : 0.f;
            }
            const u32x4 uqa = *(const u32x4*)(pr + C_HQ + h * 128 + cA), uqb = *(const u32x4*)(pr + C_HQ + h * 128 + cB);
            const u32x4 uza = *(const u32x4*)(pr + C_HF + d * 512 + h * 128 + cA), uzb = *(const u32x4*)(pr + C_HF + d * 512 + h * 128 + cB);
#pragma unroll
            for (int e = 0; e < 16; ++e) {
                const unsigned uq = e < 8 ? uqa[(e & 7) >> 1] : uqb[(e & 7) >> 1], uz = e < 8 ? uza[(e & 7) >> 1] : uzb[(e & 7) >> 1];
                const float qraw = (e & 1) ? bfhi(uq) : bflo(uq), z = (e & 1) ? bfhi(uz) : bflo(uz);
                const float lb = lbv[e];
                const float sg = sigmoidf_(z);
                qt[e] = siluf_(qraw) * 0.08838834764831845f;
                kv[e] = (1.f - lb) * (1.f - sg);
                lfv[e] = __logf(fmaxf(lb + (1.f - lb) * sg, 1e-30f));
            }
        }
        *(LAS f32x4*)(bc + ti * 132 + cA) = (f32x4){lfv[0], lfv[1], lfv[2], lfv[3]}; *(LAS f32x4*)(bc + ti * 132 + cA + 4) = (f32x4){lfv[4], lfv[5], lfv[6], lfv[7]};
        *(LAS f32x4*)(bc + ti * 132 + cB) = (f32x4){lfv[8], lfv[9], lfv[10], lfv[11]}; *(LAS f32x4*)(bc + ti * 132 + cB + 4) = (f32x4){lfv[12], lfv[13], lfv[14], lfv[15]};
        const bf16_t* vp = pr + vcol + h * 128;
        const u32x4 v0 = *(const u32x4*)(vp + cA), v1 = *(const u32x4*)(vp + cB);
#pragma unroll
        for (int e = 0; e < 8; ++e) {
            vT[(cA + e) * 72 + ti] = (bf16_t)((e & 1) ? (v0[e >> 1] >> 16) : (v0[e >> 1] & 0xffffu));
            vT[(cB + e) * 72 + ti] = (bf16_t)((e & 1) ? (v1[e >> 1] >> 16) : (v1[e >> 1] & 0xffffu));
        }
    }
    __syncthreads();
    if (tid < 128) {
        float run = 0.f, lv[64];
#pragma unroll
        for (int i = 0; i < 64; ++i) lv[i] = bc[i * 132 + tid];
#pragma unroll
        for (int i = 0; i < 64; ++i) { run += lv[i]; bc[i * 132 + tid] = run; }
    }
    __syncthreads();
    {
        const int J = ti >> 4;
        float qhat[16];
#pragma unroll
        for (int e = 0; e < 16; ++e) {
            const int ch = e < 8 ? cA + e : cB + e - 8;
            const float bi = bc[ti * 132 + ch], rJ = J ? bc[(16 * J - 1) * 132 + ch] : 0.f, bl = bc[63 * 132 + ch];
            qhat[e] = qt[e] * __expf(bi - rJ); qt[e] = qt[e] * __expf(bi);
            kT[ch * 72 + ti] = (bf16_t)f2bf(kv[e] * __expf(bl - bi));
        }
        *(LAS u32x4*)(qh + ti * 136 + cA) = pack8(qhat); *(LAS u32x4*)(qh + ti * 136 + cB) = pack8(qhat + 8);
#pragma unroll
        for (int I = 0; I < 4; ++I) {
            if (I >= J) {
                float kk[16];
#pragma unroll
                for (int e = 0; e < 16; ++e) {
                    const int ch = e < 8 ? cA + e : cB + e - 8;
                    const float rI = I ? bc[(16 * I - 1) * 132 + ch] : 0.f, bj = bc[ti * 132 + ch];
                    kk[e] = kv[e] * __expf(fminf(rI - bj, 80.f));
                }
                LAS bf16_t* kp = kh + ((I * (I + 1) / 2 + J) * 16 + (ti & 15)) * 136;
                *(LAS u32x4*)(kp + cA) = pack8(kk); *(LAS u32x4*)(kp + cB) = pack8(kk + 8);
            }
        }
        *(LAS u32x4*)(sc + ti * 72 + dg * 8) = (u32x4){0u, 0u, 0u, 0u};
        {
            bf16_t* lqb = p.lq + item * 8192 + (size_t)((ti >> 4) * 8) * 256 + (ti & 15) * 4;
            const u32x4 pa = pack8(qt), pb = pack8(qt + 8);
            u32x2 t0; t0[0] = pa[0]; t0[1] = pa[1]; u32x2 t1; t1[0] = pa[2]; t1[1] = pa[3]; u32x2 t2; t2[0] = pb[0]; t2[1] = pb[1]; u32x2 t3; t3[0] = pb[2]; t3[1] = pb[3];
            *(u32x2*)(lqb + (dg >> 1) * 256 + ((dg & 1) * 2 + 0) * 64) = t0; *(u32x2*)(lqb + (dg >> 1) * 256 + ((dg & 1) * 2 + 1) * 64) = t1;
            *(u32x2*)(lqb + (4 + (dg >> 1)) * 256 + ((dg & 1) * 2 + 0) * 64) = t2; *(u32x2*)(lqb + (4 + (dg >> 1)) * 256 + ((dg & 1) * 2 + 1) * 64) = t3;
        }
    }
    if (tid < 128) p.ld[item * 128 + tid] = __expf(bc[63 * 132 + tid]);
    __syncthreads();
#pragma unroll
    for (int rep2 = 0; rep2 < 2; ++rep2) {
        const int t = wid + 8 * rep2;
        if (t < 10) {
            const int I = t >= 6 ? 3 : t >= 3 ? 2 : t >= 1 ? 1 : 0, J = t - I * (I + 1) / 2;
            f32x4 acc = (f32x4){0.f, 0.f, 0.f, 0.f};
#pragma unroll
            for (int ks = 0; ks < 4; ++ks)
                acc = mfma16(*(const LAS bf16x8*)(kh + (t * 16 + fr) * 136 + ks * 32 + fq * 8), *(const LAS bf16x8*)(qh + (I * 16 + fr) * 136 + ks * 32 + fq * 8), acc);
            const int i = 16 * I + fr, j0 = 16 * J + 4 * fq;
#pragma unroll
            for (int r = 0; r < 4; ++r) if (j0 + r > i) acc[r] = 0.f;
            *(LAS u32x2*)(sc + i * 72 + j0) = pack4(acc);
        }
    }
    __syncthreads();
    {
        bf16x8 xv[2], xk[2];
#pragma unroll
        for (int ks = 0; ks < 2; ++ks) { xv[ks] = *(const LAS bf16x8*)(vT + (wid * 16 + fr) * 72 + ks * 32 + fq * 8); xk[ks] = *(const LAS bf16x8*)(kT + (wid * 16 + fr) * 72 + ks * 32 + fq * 8); }
#pragma unroll
        for (int ib = 0; ib < 4; ++ib) {
            f32x4 acc = (f32x4){0.f, 0.f, 0.f, 0.f};
#pragma unroll
            for (int ks = 0; ks < 2; ++ks) acc = mfma16(xv[ks], *(const LAS bf16x8*)(sc + (ib * 16 + fr) * 72 + ks * 32 + fq * 8), acc);
            *(u32x2*)(p.lo + item * 8192 + ((wid * 4 + ib) * 64 + lane) * 4) = pack4(acc);
        }
#pragma unroll
        for (int dvb = 0; dvb < 8; ++dvb) {
            f32x4 acc = (f32x4){0.f, 0.f, 0.f, 0.f};
#pragma unroll
            for (int ks = 0; ks < 2; ++ks) acc = mfma16(xk[ks], *(const LAS bf16x8*)(vT + (dvb * 16 + fr) * 72 + ks * 32 + fq * 8), acc);
            *(u32x2*)(p.lb + item * 16384 + ((wid * 8 + dvb) * 64 + lane) * 4) = pack4(acc);
        }
    }
    __syncthreads();
}


template <int MODE> __device__ __forceinline__ void local_ret(const Params& p, int l, int chain, int n, LAS unsigned char* lds) {
    const int tid = opaque_tid(), wid = tid >> 6, lane = tid & 63, fr = lane & 15, fq = lane >> 4;
    const int b = chain >> 3, h = (chain >> 1) & 3, d = chain & 1;
    const int base = chunk_base(b, d, n);
    const size_t item = (size_t)2 * NITEM + (size_t)chain * NCHUNK + n;
    LAS bf16_t* ks_ = (LAS bf16_t*)lds;
    LAS bf16_t* qs = ks_ + 64 * 136;
    LAS bf16_t* sc = qs + 64 * 136;
    LAS bf16_t* vT = sc + 64 * 72;
    LAS bf16_t* kT = vT + 128 * 72;
    const int ti = tid >> 3, dg = tid & 7, cA = dg * 8, cB = 64 + dg * 8;
    const int tokI = base + (d ? 63 - ti : ti);
    const bf16_t* pr = p.P + (size_t)tokI * NP + C_RQKV + h * 128;
    const float lng = ret_log_gamma(h);
    {
        const u32x4 q1 = *(const u32x4*)(pr + cA), q2 = *(const u32x4*)(pr + cB), k1 = *(const u32x4*)(pr + 512 + cA), k2 = *(const u32x4*)(pr + 512 + cB);
        const u32x4 v0 = *(const u32x4*)(pr + 1024 + cA), v1 = *(const u32x4*)(pr + 1024 + cB);
        const bool lat = tokI < NLAT;
        const int t = tokI & (TL - 1);
        float qv[16], kv[16];
#pragma unroll
        for (int e = 0; e < 8; ++e) {
            float a1 = (e & 1) ? bfhi(q1[e >> 1]) : bflo(q1[e >> 1]), a2 = (e & 1) ? bfhi(q2[e >> 1]) : bflo(q2[e >> 1]);
            float b1 = (e & 1) ? bfhi(k1[e >> 1]) : bflo(k1[e >> 1]), b2 = (e & 1) ? bfhi(k2[e >> 1]) : bflo(k2[e >> 1]);
            {
                const float2 cst = p.rope[(size_t)t * 64 + cA + e];
                const float cs = lat ? cst.x : 1.0f, sn = lat ? cst.y : 0.0f;
                const float n1 = a1 * cs - a2 * sn, n2 = a1 * sn + a2 * cs, m1 = b1 * cs - b2 * sn, m2 = b1 * sn + b2 * cs;
                a1 = n1; a2 = n2; b1 = m1; b2 = m2;
            }
            qv[e] = a1; qv[8 + e] = a2; kv[e] = b1 * 0.08838834764831845f; kv[8 + e] = b2 * 0.08838834764831845f;
        }
        *(LAS u32x4*)(ks_ + ti * 136 + cA) = pack8(kv); *(LAS u32x4*)(ks_ + ti * 136 + cB) = pack8(kv + 8);
        *(LAS u32x4*)(qs + ti * 136 + cA) = pack8(qv); *(LAS u32x4*)(qs + ti * 136 + cB) = pack8(qv + 8);
        const float gq = __expf((float)(ti + 1) * lng), gk = __expf((float)(63 - ti) * lng);
#pragma unroll
        for (int e = 0; e < 8; ++e) {
            vT[(cA + e) * 72 + ti] = (bf16_t)((e & 1) ? (v0[e >> 1] >> 16) : (v0[e >> 1] & 0xffffu));
            vT[(cB + e) * 72 + ti] = (bf16_t)((e & 1) ? (v1[e >> 1] >> 16) : (v1[e >> 1] & 0xffffu));
            kT[(cA + e) * 72 + ti] = (bf16_t)f2bf(kv[e] * gk); kT[(cB + e) * 72 + ti] = (bf16_t)f2bf(kv[8 + e] * gk);
            qv[e] *= gq; qv[8 + e] *= gq;
        }
        {
            bf16_t* lqb = p.lq + item * 8192 + (size_t)((ti >> 4) * 8) * 256 + (ti & 15) * 4;
            const u32x4 pa = pack8(qv), pb = pack8(qv + 8);
            u32x2 t0; t0[0] = pa[0]; t0[1] = pa[1]; u32x2 t1; t1[0] = pa[2]; t1[1] = pa[3]; u32x2 t2; t2[0] = pb[0]; t2[1] = pb[1]; u32x2 t3; t3[0] = pb[2]; t3[1] = pb[3];
            *(u32x2*)(lqb + (dg >> 1) * 256 + ((dg & 1) * 2 + 0) * 64) = t0; *(u32x2*)(lqb + (dg >> 1) * 256 + ((dg & 1) * 2 + 1) * 64) = t1;
            *(u32x2*)(lqb + (4 + (dg >> 1)) * 256 + ((dg & 1) * 2 + 0) * 64) = t2; *(u32x2*)(lqb + (4 + (dg >> 1)) * 256 + ((dg & 1) * 2 + 1) * 64) = t3;
        }
    }
    if (tid < 128) p.ld[item * 128 + tid] = __expf(64.0f * lng);
    __syncthreads();
#pragma unroll
    for (int e = 0; e < 2; ++e) {
        const int f = wid * 2 + e, ib = f >> 2, jb = f & 3;
        const int i = 16 * ib + fr, j0 = 16 * jb + 4 * fq;
        f32x4 mq = (f32x4){0.f, 0.f, 0.f, 0.f};
        if (jb <= ib) {
#pragma unroll
            for (int ks = 0; ks < 4; ++ks)
                mq = mfma16(*(const LAS bf16x8*)(ks_ + (jb * 16 + fr) * 136 + ks * 32 + fq * 8), *(const LAS bf16x8*)(qs + i * 136 + ks * 32 + fq * 8), mq);
#pragma unroll
            for (int r = 0; r < 4; ++r) { const int j = j0 + r; mq[r] = (j <= i) ? mq[r] * __expf((float)(i - j) * lng) : 0.f; }
        }
        *(LAS u32x2*)(sc + i * 72 + j0) = pack4(mq);
    }
    __syncthreads();
    {
        bf16x8 xv[2], xk[2];
#pragma unroll
        for (int ks = 0; ks < 2; ++ks) { xv[ks] = *(const LAS bf16x8*)(vT + (wid * 16 + fr) * 72 + ks * 32 + fq * 8); xk[ks] = *(const LAS bf16x8*)(kT + (wid * 16 + fr) * 72 + ks * 32 + fq * 8); }
#pragma unroll
        for (int ib = 0; ib < 4; ++ib) {
            f32x4 acc = (f32x4){0.f, 0.f, 0.f, 0.f};
#pragma unroll
            for (int ks = 0; ks < 2; ++ks) acc = mfma16(xv[ks], *(const LAS bf16x8*)(sc + (ib * 16 + fr) * 72 + ks * 32 + fq * 8), acc);
            *(u32x2*)(p.lo + item * 8192 + ((wid * 4 + ib) * 64 + lane) * 4) = pack4(acc);
        }
#pragma unroll
        for (int dvb = 0; dvb < 8; ++dvb) {
            f32x4 acc = (f32x4){0.f, 0.f, 0.f, 0.f};
#pragma unroll
            for (int ks = 0; ks < 2; ++ks) acc = mfma16(xk[ks], *(const LAS bf16x8*)(vT + (dvb * 16 + fr) * 72 + ks * 32 + fq * 8), acc);
            *(u32x2*)(p.lb + item * 16384 + ((wid * 8 + dvb) * 64 + lane) * 4) = pack4(acc);
        }
    }
    __syncthreads();
}

__device__ __forceinline__ void local_gdn(const Params& p, int l, int bh, int seg, int blk, LAS unsigned char* lds) {
    const int tid = opaque_tid(), wid = tid >> 6, lane = tid & 63, fr = lane & 15, fq = lane >> 4;
    const int b = bh >> 2, h = bh & 3;
    const int base = seg ? b * TL + blk * 64 : NLAT + b * TC + blk * 64;
    LAS bf16_t* ks_ = (LAS bf16_t*)lds;
    LAS bf16_t* qs = ks_ + 64 * 136;
    LAS bf16_t* att = qs + 64 * 136;
    LAS bf16_t* wT = att + 64 * 72;
    LAS bf16_t* uT = wT + 128 * 72;
    LAS bf16_t* kT = uT + 128 * 72;
    LAS bf16_t* tT = kT;
    LAS bf16_t* Mneg = kT + 128 * 72;
    LAS float* Md = (LAS float*)(Mneg + 64 * 72);
    LAS float* bcs = (LAS float*)(kT + 128 * 72) + 64 * 68;
    LAS float* bts = bcs + 64;
    LAS float* rse = bts + 64;
    LAS bf16_t* vs = (LAS bf16_t*)(rse + 64);
    LAS bf16_t* Db = (LAS bf16_t*)(vs + 64 * 136);
    LAS float* cw = (LAS float*)(vs + 64 * 136);
    const int ti = tid >> 3, d0 = (tid & 7) * 16;
    const int tokI = base + ti;
    {
        int t, T, sbase; tok_info(tokI, t, T, sbase);
        u32x4 xr[3][4][2];
#pragma unroll
        for (int j = 0; j < 4; ++j) {
            const int tt = t + j - 2;
            const bool ok = (tt >= 0 && tt < T);
            const int ttc = tt < 0 ? 0 : (tt >= T ? T - 1 : tt);
            const bf16_t* xp = p.P + (size_t)(sbase + ttc) * NP + C_GQKV + h * 128 + d0;
#pragma unroll
            for (int part = 0; part < 3; ++part) {
                const u32x4 a0 = *(const u32x4*)(xp + part * 512), a1 = *(const u32x4*)(xp + part * 512 + 8);
#pragma unroll
                for (int q = 0; q < 4; ++q) { xr[part][j][0][q] = ok ? a0[q] : 0u; xr[part][j][1][q] = ok ? a1[q] : 0u; }
            }
        }
        if (tid < 384) {
            const int row = tid >> 5, c4 = (tid & 31) * 4, part = row >> 2, j = row & 3;
            *(LAS f32x4*)(cw + row * 128 + c4) = *(const f32x4*)(p.gdn_conv_w + (size_t)(l * 4 + j) * 1536 + part * 512 + h * 128 + c4);
        }
        __syncthreads();
#pragma unroll
        for (int part = 0; part < 3; ++part) {
            float a[16];
#pragma unroll
            for (int e = 0; e < 16; ++e) a[e] = 0.f;
#pragma unroll
            for (int j = 0; j < 4; ++j) {
                const u32x4 x0 = xr[part][j][0], x1 = xr[part][j][1];
                const LAS float* wp = cw + (part * 4 + j) * 128 + d0;
#pragma unroll
                for (int q = 0; q < 4; ++q) {
                    const f32x4 w0 = *(const LAS f32x4*)(wp + q * 4);
                    const unsigned ua = q < 2 ? x0[2 * q] : x1[2 * q - 4], ub = q < 2 ? x0[2 * q + 1] : x1[2 * q - 3];
                    a[q * 4] += w0[0] * bflo(ua); a[q * 4 + 1] += w0[1] * bfhi(ua); a[q * 4 + 2] += w0[2] * bflo(ub); a[q * 4 + 3] += w0[3] * bfhi(ub);
                }
            }
            float ss = 0.f;
#pragma unroll
            for (int e = 0; e < 16; ++e) { a[e] = siluf_(a[e]); ss += a[e] * a[e]; }
            if (part < 2) {
                ss += shx(ss, 1, lane); ss += shx(ss, 2, lane); ss += shx(ss, 4, lane);
                const float scl = rsqrtf(ss + 1e-6f) * (part == 0 ? 0.08838834764831845f : 1.0f);
#pragma unroll
                for (int e = 0; e < 16; ++e) a[e] *= scl;
            }
            LAS bf16_t* dstt = (part == 0 ? qs : part == 1 ? ks_ : vs) + ti * 136 + d0;
            *(LAS u32x4*)dstt = pack8(a); *(LAS u32x4*)(dstt + 8) = pack8(a + 8);
        }
    }
#pragma unroll 1
  for (int d = 0; d < 2; ++d) {
    const int n = seg ? 4 + (d ? 63 - blk : blk) : (d ? 3 - blk : blk);
    const size_t item = (size_t)(bh * 2 + d) * NCHUNK + n;
#define RR(x) (d ? 63 - (x) : (x))
    const int tid = opaque_tid(), wid = tid >> 6, lane = tid & 63, fr = lane & 15, fq = lane >> 4, ti = tid >> 3, d0 = (tid & 7) * 16;
    if (wid == 0) {
        const int tok = base + RR(lane);
        const float av = bf2f(p.P[(size_t)tok * NP + C_GA + d * 4 + h]);
        float v = -__expf(p.gdn_a_log[l * 8 + d * 4 + h]) * softplusf_(av + p.gdn_dt_bias[l * 8 + d * 4 + h]);
#pragma unroll
        for (int off = 1; off < 64; off <<= 1) { const float t = shup(v, off, lane); if (lane >= off) v += t; }
        const float btv = sigmoidf_(bf2f(p.P[(size_t)tok * NP + C_GB + d * 4 + h]));
        bcs[lane] = v; bts[lane] = btv; rse[lane] = btv * __expf(v);
    }
    __syncthreads();
#pragma unroll
    for (int e = 0; e < 2; ++e) {
        const int f = wid * 2 + e, ib = f >> 2, jb = f & 3;
        const int i = 16 * ib + fr, j0 = 16 * jb + 4 * fq;
        f32x4 mk = (f32x4){0.f, 0.f, 0.f, 0.f}, mq = (f32x4){0.f, 0.f, 0.f, 0.f};
        if (jb <= ib) {
#pragma unroll
            for (int ks = 0; ks < 4; ++ks) {
                const bf16x8 xk = *(const LAS bf16x8*)(ks_ + RR(jb * 16 + fr) * 136 + ks * 32 + fq * 8);
                mk = mfma16(xk, *(const LAS bf16x8*)(ks_ + RR(ib * 16 + fr) * 136 + ks * 32 + fq * 8), mk);
                mq = mfma16(xk, *(const LAS bf16x8*)(qs + RR(ib * 16 + fr) * 136 + ks * 32 + fq * 8), mq);
            }
            const float bi = bcs[i], bti = bts[i];
#pragma unroll
            for (int r = 0; r < 4; ++r) {
                const int j = j0 + r;
                const float dec = __expf(j <= i ? bi - bcs[j] : 0.f);
                mk[r] = (j < i) ? bti * mk[r] * dec : 0.f;
                mq[r] = (j <= i) ? mq[r] * dec : 0.f;
            }
        }
        {
            u32x2 mn; mn[0] = 0u; mn[1] = 0u;
            if (jb < ib) mn = pack4((f32x4){-mk[0], -mk[1], -mk[2], -mk[3]});
            *(LAS u32x2*)(Mneg + i * 72 + j0) = mn;
            if (jb == ib) *(LAS f32x4*)(Md + (ib * 16 + fr) * 20 + 4 * fq) = mk;
        }
        *(LAS u32x2*)(att + i * 72 + j0) = pack4(mq);
        if (e == 0) {
            const int zr = tid >> 1, zh = tid & 1;
            LAS bf16_t* zx = (zr < 128 ? uT + zr * 72 : wT + (zr - 128) * 72) + zh * 32;
#pragma unroll
            for (int q = 0; q < 4; ++q) *(LAS u32x4*)(zx + q * 8) = (u32x4){0u, 0u, 0u, 0u};
            *(LAS u32x4*)(tT + zr * 32 + 16 + zh * 8) = (u32x4){0u, 0u, 0u, 0u};
        }
    }
    __syncthreads();
    if (wid == 0) {
        const int R = lane >> 4, cc = lane & 15;
        float y[16];
#pragma unroll
        for (int i = 0; i < 16; ++i) {
            float acc = (i == cc) ? 1.0f : 0.0f;
#pragma unroll
            for (int j4 = 0; j4 < (i + 3) / 4; ++j4) {
                const f32x4 m = *(const LAS f32x4*)(Md + (R * 16 + i) * 20 + j4 * 4);
#pragma unroll
                for (int q = 0; q < 4; ++q) if (j4 * 4 + q < i) acc -= m[q] * y[j4 * 4 + q];
            }
            y[i] = acc;
            Db[(R * 16 + i) * 40 + cc] = (bf16_t)f2bf(acc);
        }
        *(LAS u32x4*)(Db + lane * 40 + 16) = (u32x4){0u, 0u, 0u, 0u}; *(LAS u32x4*)(Db + lane * 40 + 24) = (u32x4){0u, 0u, 0u, 0u};
    }
    __syncthreads();
#pragma unroll
    for (int R = 0; R < 4; ++R) {
        f32x4 tacc[2];
#pragma unroll
        for (int e = 0; e < 2; ++e) {
            const int cb = wid * 2 + e;
            const int i = 16 * R + fr;
            const u32x2 rv = *(const LAS u32x2*)((cb < 8 ? vs + cb * 16 : ks_ + (cb - 8) * 16) + RR(i) * 136 + 4 * fq);
            const float sc = cb < 8 ? bts[i] : -rse[i];
            f32x4 acc = (f32x4){bflo(rv[0]) * sc, bfhi(rv[0]) * sc, bflo(rv[1]) * sc, bfhi(rv[1]) * sc};
            if (R > 0) {
                const LAS bf16_t* xt = (cb < 8 ? uT + cb * 16 * 72 : wT + (cb - 8) * 16 * 72) + fr * 72 + fq * 8;
#pragma unroll
                for (int ks = 0; ks < (R + 1) / 2; ++ks) acc = mfma16(*(const LAS bf16x8*)(xt + ks * 32), *(const LAS bf16x8*)(Mneg + i * 72 + ks * 32 + fq * 8), acc);
            }
            tacc[e] = acc;
            LAS bf16_t* tp = tT + (cb * 16 + 4 * fq) * 32 + fr;
            tp[0] = (bf16_t)f2bf(acc[0]); tp[32] = (bf16_t)f2bf(acc[1]); tp[64] = (bf16_t)f2bf(acc[2]); tp[96] = (bf16_t)f2bf(acc[3]);
        }
        __syncthreads();
#pragma unroll
        for (int e = 0; e < 2; ++e) {
            const int cb = wid * 2 + e;
            f32x4 acc = (f32x4){0.f, 0.f, 0.f, 0.f};
            acc = mfma16(*(const LAS bf16x8*)(tT + (cb * 16 + fr) * 32 + fq * 8), *(const LAS bf16x8*)(Db + (R * 16 + fr) * 40 + fq * 8), acc);
            LAS bf16_t* xp = (cb < 8 ? uT + cb * 16 * 72 : wT + (cb - 8) * 16 * 72) + (4 * fq) * 72 + 16 * R + fr;
            xp[0] = (bf16_t)f2bf(acc[0]); xp[72] = (bf16_t)f2bf(acc[1]); xp[144] = (bf16_t)f2bf(acc[2]); xp[216] = (bf16_t)f2bf(acc[3]);
        }
        __syncthreads();
    }
    {
        const int pi = RR(ti);
        const float sc_ = __expf(bcs[63] - bcs[pi]);
#pragma unroll
        for (int e = 0; e < 16; ++e) kT[(d0 + e) * 72 + pi] = (bf16_t)f2bf(bf2f(ks_[ti * 136 + d0 + e]) * sc_);
    }
    if (tid < 128) p.ld[item * 128 + tid] = __expf(bcs[63]);
    __syncthreads();
    {
        const int tid = opaque_tid(), wid = tid >> 6, lane = tid & 63, fr = lane & 15, fq = lane >> 4;
        bf16x8 xw[2], xu[2], xk[2];
#pragma unroll
        for (int ks = 0; ks < 2; ++ks) {
            xw[ks] = *(const LAS bf16x8*)(wT + (wid * 16 + fr) * 72 + ks * 32 + fq * 8);
            xu[ks] = *(const LAS bf16x8*)(uT + (wid * 16 + fr) * 72 + ks * 32 + fq * 8);
            xk[ks] = *(const LAS bf16x8*)(kT + (wid * 16 + fr) * 72 + ks * 32 + fq * 8);
        }
#pragma unroll
        for (int ib = 0; ib < 4; ++ib) {
            const int i = ib * 16 + fr;
            const u32x2 qr = *(const LAS u32x2*)(qs + RR(i) * 136 + wid * 16 + 4 * fq);
            const float eb = __expf(bcs[i]);
            f32x4 aq = (f32x4){bflo(qr[0]) * eb, bfhi(qr[0]) * eb, bflo(qr[1]) * eb, bfhi(qr[1]) * eb};
            f32x4 ao = (f32x4){0.f, 0.f, 0.f, 0.f};
#pragma unroll
            for (int ks = 0; ks < 2; ++ks) {
                const bf16x8 ya = *(const LAS bf16x8*)(att + i * 72 + ks * 32 + fq * 8);
                aq = mfma16(xw[ks], ya, aq); ao = mfma16(xu[ks], ya, ao);
            }
            *(u32x2*)(p.lq + item * 8192 + ((ib * 8 + wid) * 64 + lane) * 4) = pack4(aq);
            *(u32x2*)(p.lo + item * 8192 + ((wid * 4 + ib) * 64 + lane) * 4) = pack4(ao);
        }
#pragma unroll
        for (int db = 0; db < 8; ++db) {
            f32x4 aa = (f32x4){0.f, 0.f, 0.f, 0.f}, ab = (f32x4){0.f, 0.f, 0.f, 0.f};
#pragma unroll
            for (int ks = 0; ks < 2; ++ks) {
                aa = mfma16(xw[ks], *(const LAS bf16x8*)(kT + (db * 16 + fr) * 72 + ks * 32 + fq * 8), aa);
                ab = mfma16(xk[ks], *(const LAS bf16x8*)(uT + (db * 16 + fr) * 72 + ks * 32 + fq * 8), ab);
            }
            *(u32x2*)(p.la + item * 16384 + ((db * 8 + wid) * 64 + lane) * 4) = pack4(aa);
            *(u32x2*)(p.lb + item * 16384 + ((wid * 8 + db) * 64 + lane) * 4) = pack4(ab);
        }
    }
    __syncthreads();
  }
#undef RR
}

__device__ __forceinline__ void ph_local(const Params& p, int l, LAS unsigned char* lds) {
    constexpr int NG = NITEM / 2;
    for (int it = blockIdx.x; it < NG + 2 * NITEM; it += gridDim.x) {
        if (it < NG) { const int bh = it / NCHUNK, c = it % NCHUNK; local_gdn(p, l, bh, c >= 4, c >= 4 ? c - 4 : c, lds); }
        else if (it < NG + NITEM) { const int idx = it - NG; local_gla(p, l, 1, idx / NCHUNK, idx % NCHUNK, lds); }
        else { const int idx = it - NG - NITEM; local_ret<0>(p, l, idx / NCHUNK, idx % NCHUNK, lds); }
    }
}

__device__ __forceinline__ void seq_matrix(const Params& p, int tz, int chain, int half, LAS unsigned char* lds) {
    const int tid = opaque_tid(), wid = tid >> 6, lane = tid & 63, fr = lane & 15, fq = lane >> 4;
    const int b = chain >> 3, h = (chain >> 1) & 3, d = chain & 1;
    LAS bf16_t* ST = (LAS bf16_t*)lds;
    bf16_t* Op = p.O + (size_t)((tz == 0 ? 0 : tz == 1 ? 1 : 3) * 2 + d) * TOKW;
    f32x4 S[4];
#pragma unroll
    for (int q = 0; q < 4; ++q) S[q] = (f32x4){0.f, 0.f, 0.f, 0.f};
    const int ib = wid >> 1, dv2 = (wid & 1) * 2;
    struct Ops { u32x2 yq[8], xa[8], oin[2], bin[4]; f32x4 dec; };
    auto load_ops = [&](int n, Ops& o) {
        const size_t item = (size_t)tz * NITEM + (size_t)chain * NCHUNK + n;
        const bf16_t* lqp = p.lq + item * 8192 + (size_t)(ib * 8) * 256 + lane * 4;
#pragma unroll
        for (int q = 0; q < 8; ++q) o.yq[q] = *(const u32x2*)(lqp + q * 256);
        if (tz == 0) {
            const bf16_t* lap = p.la + ((size_t)chain * NCHUNK + n) * 16384 + (size_t)(wid * 8) * 256 + lane * 4;
#pragma unroll
            for (int q = 0; q < 8; ++q) o.xa[q] = *(const u32x2*)(lap + q * 256);
        }
#pragma unroll
        for (int e2 = 0; e2 < 2; ++e2)
            o.oin[e2] = *(const u32x2*)(p.lo + item * 8192 + (((half * 4 + dv2 + (fq >> 1)) * 4 + ib) * 64 + fr + 16 * (2 * (fq & 1) + e2)) * 4);
#pragma unroll
        for (int q = 0; q < 4; ++q) o.bin[q] = *(const u32x2*)(p.lb + item * 16384 + ((wid * 8 + half * 4 + q) * 64 + lane) * 4);
        o.dec = *(const f32x4*)(p.ld + item * 128 + wid * 16 + 4 * fq);
    };
    Ops s0, s1; load_ops(0, s0);
    auto step = [&](int n, Ops& cur, Ops& fill) {
        load_ops(n + 1 < NCHUNK ? n + 1 : n, fill);
        LAS bf16_t* st = ST + (n & 1) * 64 * 136;
#pragma unroll
        for (int q = 0; q < 4; ++q) *(LAS u32x2*)(st + (q * 16 + fr) * 136 + 32 * (wid >> 1) + 8 * fq + 4 * (wid & 1)) = pack4(S[q]);
        __syncthreads();
        const int base = chunk_base(b, d, n);
        const int tok = base + (d ? 63 - (ib * 16 + fr) : ib * 16 + fr);
        {
            bf16x8 xo[2][4];
#pragma unroll
            for (int e2 = 0; e2 < 2; ++e2) {
                const int prow = dv2 * 16 + 8 * (fr >> 2) + 4 * e2 + (fr & 3);
#pragma unroll
                for (int ks = 0; ks < 4; ++ks) xo[e2][ks] = *(const LAS bf16x8*)(st + prow * 136 + ks * 32 + fq * 8);
            }
            asm volatile("s_waitcnt lgkmcnt(0)" ::: "memory");
            f32x4 ao[2];
#pragma unroll
            for (int e2 = 0; e2 < 2; ++e2) {
                f32x4 acc = (f32x4){bflo(cur.oin[e2][0]), bfhi(cur.oin[e2][0]), bflo(cur.oin[e2][1]), bfhi(cur.oin[e2][1])};
#pragma unroll
                for (int ks = 0; ks < 4; ++ks) {
                    u32x4 t; t[0] = cur.yq[2 * ks][0]; t[1] = cur.yq[2 * ks][1]; t[2] = cur.yq[2 * ks + 1][0]; t[3] = cur.yq[2 * ks + 1][1];
                    acc = mfma16(xo[e2][ks], __builtin_bit_cast(bf16x8, t), acc);
                }
                ao[e2] = acc;
            }
            bf16_t* op = Op + (size_t)tok * MW + h * 128 + half * 64 + dv2 * 16 + 8 * fq;
            { u32x4 w; w[0] = pack2(ao[0][0], ao[0][1]); w[1] = pack2(ao[0][2], ao[0][3]); w[2] = pack2(ao[1][0], ao[1][1]); w[3] = pack2(ao[1][2], ao[1][3]); *(u32x4*)op = w; }
#pragma unroll
            for (int qh = 0; qh < 2; ++qh) {
                bf16x8 xs[2][4];
                if (tz == 0) {
#pragma unroll
                    for (int q2 = 0; q2 < 2; ++q2)
#pragma unroll
                        for (int ks = 0; ks < 4; ++ks) xs[q2][ks] = *(const LAS bf16x8*)(st + ((qh * 2 + q2) * 16 + fr) * 136 + ks * 32 + fq * 8);
                    asm volatile("s_waitcnt lgkmcnt(0)" ::: "memory");
                }
#pragma unroll
                for (int q2 = 0; q2 < 2; ++q2) {
                    const int q = qh * 2 + q2;
                    f32x4 acc = (f32x4){cur.dec[0] * S[q][0] + bflo(cur.bin[q][0]), cur.dec[1] * S[q][1] + bfhi(cur.bin[q][0]), cur.dec[2] * S[q][2] + bflo(cur.bin[q][1]), cur.dec[3] * S[q][3] + bfhi(cur.bin[q][1])};
                    if (tz == 0) {
#pragma unroll
                        for (int ks = 0; ks < 4; ++ks) {
                            u32x4 t; t[0] = cur.xa[2 * ks][0]; t[1] = cur.xa[2 * ks][1]; t[2] = cur.xa[2 * ks + 1][0]; t[3] = cur.xa[2 * ks + 1][1];
                            acc = mfma16(__builtin_bit_cast(bf16x8, t), xs[q2][ks], acc);
                        }
                    }
                    S[q] = acc;
                }
            }
        }
    };
    for (int n = 0; n < NCHUNK; n += 2) {
        step(n, s0, s1);
        step(n + 1, s1, s0);
    }
    __syncthreads();
}

__device__ __forceinline__ void seq_lru(const Params& p, int b, int d, int cg, LAS unsigned char* lds) {
    const int tid = opaque_tid(), seg = tid >> 6, ch = cg * 64 + (tid & 63);
    LAS float* sP = (LAS float*)lds;
    LAS float* sL = sP + 512;
    const float* A = p.prep + (size_t)(PR_LA + d) * TOKW + ch; const float* U = p.prep + (size_t)(PR_LU + d) * TOKW + ch;
    bf16_t* Op = p.O + (size_t)(2 * 2 + d) * TOKW + ch;
    constexpr int SEG = (TC + TL) / 8;
    auto tok_of = [&](int pos) { return pos < TC ? NLAT + b * TC + (d ? TC - 1 - pos : pos) : b * TL + (d ? TL - 1 - (pos - TC) : pos - TC); };
    float P = 1.f, L = 0.f;
    for (int i0 = 0; i0 < SEG; i0 += 32) {
        float av[32], uv[32];
#pragma unroll
        for (int q = 0; q < 32; ++q) { const size_t o = (size_t)tok_of(seg * SEG + i0 + q) * MW; av[q] = A[o]; uv[q] = U[o]; }
#pragma unroll
        for (int q = 0; q < 32; ++q) { L = av[q] * L + uv[q]; P *= av[q]; }
    }
    sP[tid] = P; sL[tid] = L;
    __syncthreads();
    float hst = 0.f;
    for (int s = 0; s < seg; ++s) hst = sP[s * 64 + (tid & 63)] * hst + sL[s * 64 + (tid & 63)];
    for (int i0 = 0; i0 < SEG; i0 += 32) {
        float av[32], uv[32];
#pragma unroll
        for (int q = 0; q < 32; ++q) { const size_t o = (size_t)tok_of(seg * SEG + i0 + q) * MW; av[q] = A[o]; uv[q] = U[o]; }
#pragma unroll
        for (int q = 0; q < 32; ++q) { hst = av[q] * hst + uv[q]; Op[(size_t)tok_of(seg * SEG + i0 + q) * MW] = (bf16_t)f2bf(hst); }
    }
    __syncthreads();
}

__device__ __forceinline__ void ph_seq(const Params& p, int l, LAS unsigned char* lds) {
    for (int it = blockIdx.x; it < 256; it += gridDim.x) {
        if (it < 192) { const int tz = it >> 6, r = it & 63; seq_matrix(p, tz, (r & 7) | ((r >> 4) << 3), (r >> 3) & 1, lds); }
        else { const int r = it - 192; seq_lru(p, r >> 4, (r >> 3) & 1, r & 7, lds); }
    }
    if (l == 0) cvt_fill(p, lds, 0, CW_SEQ0A, CW_G2 - CW_SEQ0A, CW_SEQ0B, CW_G1B - CW_SEQ0B); else cvt_fill(p, lds, 1, CW_SEQ1, CVT_G_ALL - CW_SEQ1, 0, 0);
}

__device__ __forceinline__ void ph_merge(const Params& p, int l, int M) {
    const int tid = opaque_tid(), wid = tid >> 6, lane = tid & 63;
    const bf16_t* Ob = opaque_sptr(p.O); const bf16_t* Pb = opaque_sptr(p.P); bf16_t* Yb = opaque_sptr(p.Y);
    float2 gn[3];
#pragma unroll
    for (int m = 0; m < 3; ++m) gn[m] = *(const float2*)((m == 0 ? p.gdn_norm_g : m == 1 ? p.hgrn_norm_g : p.ret_norm_g) + l * 128 + lane * 2);
    for (int tok = blockIdx.x * NWAVES + wid; tok < M; tok += gridDim.x * NWAVES) {
        unsigned o0[16], o1[16], gz[16];
#pragma unroll
        for (int r = 0; r < 16; ++r) {
            const int m = r >> 2, head = r & 3, cidx = head * 128 + lane * 2;
            const size_t o = (size_t)tok * MW + cidx;
            o0[r] = *(const unsigned*)(Ob + (size_t)(m * 2) * TOKW + o); o1[r] = *(const unsigned*)(Ob + (size_t)(m * 2 + 1) * TOKW + o);
            const int zc = m == 0 ? C_GZ : m == 1 ? C_HG : m == 2 ? C_LY : C_RG;
            gz[r] = *(const unsigned*)(Pb + (size_t)tok * NP + zc + cidx);
        }
        float a0[16], a1[16], ss[16];
#pragma unroll
        for (int r = 0; r < 16; ++r) { a0[r] = bflo(o0[r]) + bflo(o1[r]); a1[r] = bfhi(o0[r]) + bfhi(o1[r]); ss[r] = a0[r] * a0[r] + a1[r] * a1[r]; }
#pragma unroll
        for (int msk = 32; msk >= 1; msk >>= 1)
#pragma unroll
            for (int r = 0; r < 16; ++r) if ((r >> 2) != 2) ss[r] += shx(ss[r], msk, lane);
#pragma unroll
        for (int r = 0; r < 16; ++r) {
            const int m = r >> 2, head = r & 3, cidx = head * 128 + lane * 2;
            float y0, y1; int nbr;
            if (m == 2) { y0 = a0[r] * gelu_tanhf_(bflo(gz[r])); y1 = a1[r] * gelu_tanhf_(bfhi(gz[r])); nbr = 2; }
            else {
                const float rinv = rsqrtf(ss[r] * (1.0f / 128.0f) + 1e-6f);
                const float2 g = gn[m == 3 ? 2 : m];
                y0 = a0[r] * rinv * g.x * siluf_(bflo(gz[r])); y1 = a1[r] * rinv * g.y * siluf_(bfhi(gz[r])); nbr = m == 3 ? 3 : m;
            }
            *(unsigned*)(Yb + (size_t)nbr * TOKW + (size_t)tok * MW + cidx) = pack2(y0, y1);
        }
    }
}

struct G2Sched {
    const bf16_t* Y; const bf16_t* Wb; int ntiles, G, c;
    static constexpr bool HAS_BIAS = false, gather = false;
    __device__ __forceinline__ bool next(int i, g8::Unit& u) const {
        const int tile = (i >> 2) * G + c; if (tile >= ntiles) return false;
        u.pm = tile >> 2; u.pn = tile & 3; u.e = i & 3; return true;
    }
    __device__ __forceinline__ const char* a_base(const g8::Unit& u) const { return (const char*)(Y + (size_t)u.e * TOKW + (size_t)u.pm * 256 * MW); }
    __device__ __forceinline__ const char* b_base(const g8::Unit& u) const { return (const char*)(Wb + (size_t)u.e * D * MW + (size_t)u.pn * 256 * MW); }
    __device__ __forceinline__ const int* row_addr(const g8::Unit&, int) const { return nullptr; }
    __device__ __forceinline__ int rows_valid(const g8::Unit&) const { return 256; }
    __device__ __forceinline__ const float* bias_src(const g8::Unit&, int) const { return nullptr; }
};
struct EpiMix {
    const bf16_t* gate; bf16_t* O;
    __device__ __forceinline__ bool keep(const g8::Unit& u) const { return u.e < 3; }
    __device__ __forceinline__ void operator()(f32x4 (&acc)[2][2][4][2], const g8::Unit& u, int wr, int wc, int fr, int fq, const LAS float*) const {
        const int row0 = u.pm * 256 + wr * 64 + fr, col0 = u.pn * 256 + wc * 32 + 8 * fq;
        const bool lastseg = u.e == 3;
        const bf16_t* gc = gate + ((((size_t)u.pm * 16 + u.e * 4 + u.pn) * 8 + (wr * 4 + wc)) * 16) * 512 + (fq * 16 + fr) * 8;
        const bf16_t* gn = gc + (lastseg ? 0 : (size_t)4 * 8 * 16 * 512);
#pragma unroll
        for (int ah = 0; ah < 4; ++ah) {
            const int ai = ah >> 1;
            u32x4 c[4], x[4];
#pragma unroll
            for (int q = 0; q < 4; ++q) { c[q] = *(const u32x4*)(gc + (ah * 4 + q) * 512); x[q] = *(const u32x4*)(gn + (ah * 4 + q) * 512); }
#pragma unroll
            for (int q = 0; q < 4; ++q) {
                const int m = (ah & 1) * 2 + (q >> 1), bj = q & 1;
#pragma unroll
                for (int w = 0; w < 4; ++w) {
                    const float c0 = bflo(c[q][w]), c1 = bfhi(c[q][w]);
                    const float s0 = lastseg ? c0 : c0 * __builtin_amdgcn_rcpf(bflo(x[q][w])), s1 = lastseg ? c1 : c1 * __builtin_amdgcn_rcpf(bfhi(x[q][w]));
                    acc[ai][bj][m][w >> 1][(w & 1) * 2] *= s0; acc[ai][bj][m][w >> 1][(w & 1) * 2 + 1] *= s1;
                }
            }
        }
        if (lastseg) {
#pragma unroll
            for (int ai = 0; ai < 2; ++ai)
#pragma unroll
                for (int m = 0; m < 4; ++m)
#pragma unroll
                    for (int bj = 0; bj < 2; ++bj) {
                        u32x4 w; w[0] = pack2(acc[ai][bj][m][0][0], acc[ai][bj][m][0][1]); w[1] = pack2(acc[ai][bj][m][0][2], acc[ai][bj][m][0][3]);
                        w[2] = pack2(acc[ai][bj][m][1][0], acc[ai][bj][m][1][1]); w[3] = pack2(acc[ai][bj][m][1][2], acc[ai][bj][m][1][3]);
                        *(u32x4*)(O + (size_t)(row0 + ai * 128 + m * 16) * D + col0 + bj * 128) = w;
                    }
        }
    }
};
__device__ __forceinline__ void ph_g2(const Params& p, int l, int M, LAS unsigned char* lds) {
    G2Sched S; S.Y = p.Y; S.Wb = p.wbT + (size_t)l * 4 * D * MW; S.ntiles = (M / 256) * 4; S.G = gridDim.x; S.c = blockIdx.x;
    EpiMix E; E.gate = p.gate; E.O = p.mix;
    g8::gemm_phase(lds, MW, S, E);
    if (l == 0 && (int)blockIdx.x >= (NTOK / 256) * 4 - 256) cvt_fill(p, lds, 4, CW_G2, CW_G3 - CW_G2, 0, 0);
}

struct EpiY {
    bf16_t* O;
    __device__ __forceinline__ bool keep(const g8::Unit&) const { return false; }
    __device__ __forceinline__ void operator()(const f32x4 (&acc)[2][2][4][2], const g8::Unit& u, int wr, int wc, int fr, int fq, const LAS float*) const {
        const int row0 = u.pm * 256 + wr * 64 + fr, col0 = u.pn * 256 + wc * 32 + 8 * fq;
#pragma unroll
        for (int ai = 0; ai < 2; ++ai)
#pragma unroll
            for (int m = 0; m < 4; ++m)
#pragma unroll
                for (int bj = 0; bj < 2; ++bj) {
                    u32x4 w; w[0] = pack2(acc[ai][bj][m][0][0], acc[ai][bj][m][0][1]); w[1] = pack2(acc[ai][bj][m][0][2], acc[ai][bj][m][0][3]);
                    w[2] = pack2(acc[ai][bj][m][1][0], acc[ai][bj][m][1][1]); w[3] = pack2(acc[ai][bj][m][1][2], acc[ai][bj][m][1][3]);
                    *(u32x4*)(O + (size_t)(row0 + ai * 128 + m * 16) * D + col0 + bj * 128) = w;
                }
    }
};
__device__ __forceinline__ void ph_g3(const Params& p, int l, int M, LAS unsigned char* lds) {
    g8::PlainSched S; S.init(p.mix, p.woutT + (size_t)l * D * D, M, D, D);
    EpiY E; E.O = p.Y;
    g8::gemm_phase(lds, D, S, E);
    if (l == 0 && (int)blockIdx.x >= (NTOK / 256) * 4 - 256) cvt_fill(p, lds, 5, CW_G3, CW_SEQ0B - CW_G3, 0, 0);
}

template <bool DRY = false> __device__ __forceinline__ void ph_route(const Params& p, int l, int M, LAS unsigned char* lds) {
    int* const r_cnt = DRY ? p.cnt + 64 : p.cnt; int* const r_list = DRY ? (int*)p.act : p.list; int* const r_ts = DRY ? (int*)p.yp : p.tokslot; float* const r_tw = DRY ? (float*)p.yp + (size_t)NTOK * 4 : p.topw;
    LAS float* fs = (LAS float*)lds;
    LAS float* lg = fs + 32 * 1028;
    LAS int* lcnt = (LAS int*)(lg + 32 * 36);
    LAS int* lbase = lcnt + 32;
    const int tid = opaque_tid(), wid = tid >> 6, lane = tid & 63;
    const float* rw = p.router_w + (size_t)l * D * NE;
    for (int it = blockIdx.x; it < M / 32; it += gridDim.x) {
        const int tok0 = it * 32;
        {
            float4 v[4][4]; float ss[4];
            const float* mb0 = p.mod + (size_t)(l * 5 + tok_modrow(tok0)) * (NMOD * D);
            u32x2 yv[4][4]; float4 g1v[4];
#pragma unroll
            for (int i = 0; i < 4; ++i) g1v[i] = *(const float4*)(mb0 + 2 * D + i * 256 + lane * 4);
#pragma unroll
            for (int q = 0; q < 4; ++q) {
                const size_t ro = (size_t)(tok0 + wid * 4 + q) * D;
#pragma unroll
                for (int i = 0; i < 4; ++i) { v[q][i] = *(const float4*)(p.xl + ro + i * 256 + lane * 4); yv[q][i] = *(const u32x2*)(p.Y + ro + i * 256 + lane * 4); }
            }
#pragma unroll
            for (int q = 0; q < 4; ++q)
#pragma unroll
                for (int i = 0; i < 4; ++i) {
                    v[q][i].x += g1v[i].x * bflo(yv[q][i][0]); v[q][i].y += g1v[i].y * bfhi(yv[q][i][0]); v[q][i].z += g1v[i].z * bflo(yv[q][i][1]); v[q][i].w += g1v[i].w * bfhi(yv[q][i][1]);
                    if (!DRY) *(float4*)(p.xl + (size_t)(tok0 + wid * 4 + q) * D + i * 256 + lane * 4) = v[q][i];
                }
#pragma unroll
            for (int q = 0; q < 4; ++q) {
                float s = 0.f;
#pragma unroll
                for (int i = 0; i < 4; ++i) s += v[q][i].x * v[q][i].x + v[q][i].y * v[q][i].y + v[q][i].z * v[q][i].z + v[q][i].w * v[q][i].w;
                ss[q] = s;
            }
#pragma unroll
            for (int m = 32; m >= 1; m >>= 1)
#pragma unroll
                for (int q = 0; q < 4; ++q) ss[q] += shx(ss[q], m, lane);
            const float* mb = mb0;
#pragma unroll
            for (int i = 0; i < 4; ++i) {
                const int cidx = i * 256 + lane * 4;
                const float4 gv = *(const float4*)(p.norm2_g + l * D + cidx), sv = *(const float4*)(mb + 4 * D + cidx), hv = *(const float4*)(mb + 3 * D + cidx);
#pragma unroll
                for (int q = 0; q < 4; ++q) {
                    const int tl = wid * 4 + q, tok = tok0 + tl;
                    const float rinv = rsqrtf(ss[q] * (1.0f / D) + 1e-6f);
                    const float h0 = v[q][i].x * rinv * gv.x * (1.f + sv.x) + hv.x, h1 = v[q][i].y * rinv * gv.y * (1.f + sv.y) + hv.y;
                    const float h2 = v[q][i].z * rinv * gv.z * (1.f + sv.z) + hv.z, h3 = v[q][i].w * rinv * gv.w * (1.f + sv.w) + hv.w;
                    u32x2 o; o[0] = pack2(h0, h1); o[1] = pack2(h2, h3);
                    *(u32x2*)(p.F + (size_t)tok * D + cidx) = o;
                    *(LAS f32x4*)(fs + tl * 1028 + cidx) = (f32x4){h0, h1, h2, h3};
                }
            }
        }
        __syncthreads();
        {
            typedef float f32x16 __attribute__((ext_vector_type(16)));
            f32x16 acc;
#pragma unroll
            for (int r = 0; r < 16; ++r) acc[r] = 0.f;
            const int tk = lane & 31, hh = lane >> 5;
            const LAS float* ap = fs + tk * 1028 + wid * 128 + 4 * hh;
            const float* bp = rw + (size_t)(wid * 128 + 4 * hh) * NE + tk;
#pragma unroll 4
            for (int kk = 0; kk < 16; ++kk) {
                const f32x4 a4 = *(const LAS f32x4*)(ap + kk * 8);
                const float b0 = bp[(kk * 8 + 0) * NE], b1 = bp[(kk * 8 + 1) * NE], b2 = bp[(kk * 8 + 2) * NE], b3 = bp[(kk * 8 + 3) * NE];
                acc = __builtin_amdgcn_mfma_f32_32x32x2f32(a4[0], b0, acc, 0, 0, 0);
                acc = __builtin_amdgcn_mfma_f32_32x32x2f32(a4[1], b1, acc, 0, 0, 0);
                acc = __builtin_amdgcn_mfma_f32_32x32x2f32(a4[2], b2, acc, 0, 0, 0);
                acc = __builtin_amdgcn_mfma_f32_32x32x2f32(a4[3], b3, acc, 0, 0, 0);
            }
            __syncthreads();
            LAS float* red = fs;
#pragma unroll
            for (int r = 0; r < 16; ++r) red[(wid * 32 + (r & 3) + 8 * (r >> 2) + 4 * hh) * 33 + tk] = acc[r];
            __syncthreads();
            const int t2 = tid >> 4, e0 = (tid & 15) * 2;
            float s0 = p.router_b[l * NE + e0], s1 = p.router_b[l * NE + e0 + 1];
#pragma unroll
            for (int w = 0; w < 8; ++w) { s0 += red[(w * 32 + t2) * 33 + e0]; s1 += red[(w * 32 + t2) * 33 + e0 + 1]; }
            lg[t2 * 36 + e0] = s0; lg[t2 * 36 + e0 + 1] = s1;
            if (tid < 32) lcnt[tid] = 0;
        }
        __syncthreads();
        float vals[4]; int idxs[4], rank[4];
        if (tid < 32) {
            float lv[32];
#pragma unroll
            for (int q = 0; q < 8; ++q) { const f32x4 t = *(const LAS f32x4*)(lg + tid * 36 + q * 4); lv[q * 4] = t[0]; lv[q * 4 + 1] = t[1]; lv[q * 4 + 2] = t[2]; lv[q * 4 + 3] = t[3]; }
#pragma unroll
            for (int k = 0; k < 4; ++k) {
                float best = lv[0]; int bi = 0;
#pragma unroll
                for (int ee = 1; ee < NE; ++ee) { const bool gt = lv[ee] > best; best = gt ? lv[ee] : best; bi = gt ? ee : bi; }
#pragma unroll
                for (int ee = 0; ee < NE; ++ee) lv[ee] = (ee == bi) ? -3.0e38f : lv[ee];
                vals[k] = best; idxs[k] = bi;
                rank[k] = atomicAdd((int*)(lcnt + bi), 1);
            }
        }
        __syncthreads();
        if (tid < 32) { const int c = lcnt[tid]; lbase[tid] = c ? atomicAdd(r_cnt + l * NE + tid, c) : 0; }
        __syncthreads();
        if (tid < 32) {
            const int tok = tok0 + tid;
            const float mx = vals[0];
            float ex[4], sum = 0.f;
#pragma unroll
            for (int k = 0; k < 4; ++k) { ex[k] = __expf(vals[k] - mx); sum += ex[k]; }
            const float inv = 1.0f / sum;
#pragma unroll
            for (int k = 0; k < 4; ++k) {
                const int ee = idxs[k];
                const int slot = lbase[ee] + rank[k];
                r_list[(size_t)ee * NTOK + slot] = tok;
                r_ts[(size_t)tok * 4 + k] = (ee << 16) | slot;
                r_tw[(size_t)tok * 4 + k] = ex[k] * inv;
            }
        }
        __syncthreads();
    }
}

__device__ __forceinline__ void build_expert_tables(const Params& p, int l, LAS int* ts, LAS int* cn, LAS int* te) {
    const int tid = opaque_tid();
    if (tid < 64) {
        const int c = tid < NE ? p.cnt[l * NE + tid] : 0;
        const int nt = (c + 255) >> 8;
        int v = nt;
#pragma unroll
        for (int off = 1; off < 32; off <<= 1) { const int t = shupi(v, off, tid); if (tid >= off) v += t; }
        if (tid < NE) { cn[tid] = c; ts[tid] = v - nt; if (tid == NE - 1) ts[NE] = v; }
        if (te && tid < NE) for (int q = 0; q < nt; ++q) te[v - nt + q] = tid;
    }
    __syncthreads();
}

struct MoeSched {
    const LAS int* ts; const LAS int* cn; const LAS int* te; const int* list; const bf16_t* A; const bf16_t* Bt; const float* bias; int K, npn, nunits, G, c, nrowsB, nbias; bool gather;
    static constexpr bool HAS_BIAS = true;
    __device__ __forceinline__ bool next(int i, g8::Unit& u) const {
        const long L = (long)i * G + c; if (L >= nunits) return false;
        u.pm = (int)(L / npn); u.pn = (int)(L % npn); u.e = te[u.pm]; return true;
    }
    __device__ __forceinline__ const char* a_base(const g8::Unit& u) const { return (const char*)(gather ? A : A + (size_t)u.pm * 256 * K); }
    __device__ __forceinline__ const char* b_base(const g8::Unit& u) const { return (const char*)(Bt + ((size_t)u.e * nrowsB + (size_t)u.pn * 256) * K); }
    __device__ __forceinline__ const int* row_addr(const g8::Unit& u, int R) const {
        const int cnt = cn[u.e], sl = (u.pm - ts[u.e]) * 256 + R;
        return list + (size_t)u.e * NTOK + (sl < cnt ? sl : 0);
    }
    __device__ __forceinline__ int rows_valid(const g8::Unit& u) const { return cn[u.e] - (u.pm - ts[u.e]) * 256; }
    __device__ __forceinline__ const float* bias_src(const g8::Unit& u, int lane) const {
        if (nbias == 2) return bias + (size_t)u.e * 2 * D + (lane < 32 ? u.pn * 128 + lane * 4 : D + u.pn * 128 + (lane - 32) * 4);
        return bias + (size_t)u.e * D + u.pn * 256 + lane * 4;
    }
};
struct EpiAct {
    bf16_t* O;
    __device__ __forceinline__ bool keep(const g8::Unit&) const { return false; }
    __device__ __forceinline__ void operator()(const f32x4 (&acc)[2][2][4][2], const g8::Unit& u, int wr, int wc, int fr, int fq, const LAS float* bias) const {
        const int row0 = u.pm * 256 + wr * 64 + fr, col0 = u.pn * 128 + wc * 32 + 8 * fq;
        const LAS float* bb = bias + wc * 32 + 8 * fq;
        const f32x4 g0 = *(const LAS f32x4*)bb, g1 = *(const LAS f32x4*)(bb + 4), l0 = *(const LAS f32x4*)(bb + 128), l1 = *(const LAS f32x4*)(bb + 132);
        const float bg[8] = {g0[0], g0[1], g0[2], g0[3], g1[0], g1[1], g1[2], g1[3]}, bl[8] = {l0[0], l0[1], l0[2], l0[3], l1[0], l1[1], l1[2], l1[3]};
#pragma unroll
        for (int ai = 0; ai < 2; ++ai)
#pragma unroll
            for (int m = 0; m < 4; ++m) {
                float o[8];
#pragma unroll
                for (int n = 0; n < 2; ++n)
#pragma unroll
                    for (int j = 0; j < 4; ++j) {
                        const float glu = fminf(acc[ai][0][m][n][j] + bg[n * 4 + j], 7.0f);
                        const float lin = fminf(fmaxf(acc[ai][1][m][n][j] + bl[n * 4 + j], -7.0f), 7.0f);
                        o[n * 4 + j] = glu * sigmoidf_(1.702f * glu) * (lin + 1.0f);
                    }
                *(u32x4*)(O + (size_t)(row0 + ai * 128 + m * 16) * D + col0) = pack8(o);
            }
    }
};
__device__ __forceinline__ void ph_g4(const Params& p, int l, LAS unsigned char* lds) {
    LAS int* ts = (LAS int*)(lds + g8::STAGE_BYTES); LAS int* cn = ts + 40; LAS int* te = ts + 80;
    build_expert_tables(p, l, ts, cn, te);
    MoeSched S; S.ts = ts; S.cn = cn; S.te = te; S.list = p.list; S.A = p.F; S.Bt = p.w1T + (size_t)l * NE * 2 * D * D; S.bias = p.moe_b1 + (size_t)l * NE * 2 * D; S.nbias = 2;
    S.K = D; S.npn = 8; S.nunits = ts[NE] * 8; S.G = gridDim.x; S.c = blockIdx.x; S.nrowsB = 2 * D; S.gather = true;
    EpiAct E; E.O = p.act;
    g8::gemm_phase(lds, D, S, E);
}

struct EpiYp {
    bf16_t* O;
    __device__ __forceinline__ bool keep(const g8::Unit&) const { return false; }
    __device__ __forceinline__ void operator()(const f32x4 (&acc)[2][2][4][2], const g8::Unit& u, int wr, int wc, int fr, int fq, const LAS float* bias) const {
        const int row0 = u.pm * 256 + wr * 64 + fr, col0 = u.pn * 256 + wc * 32 + 8 * fq;
#pragma unroll
        for (int bj = 0; bj < 2; ++bj) {
            const LAS float* bb = bias + bj * 128 + wc * 32 + 8 * fq;
            const f32x4 c0v = *(const LAS f32x4*)bb, c1v = *(const LAS f32x4*)(bb + 4);
            const float4 c0 = make_float4(c0v[0], c0v[1], c0v[2], c0v[3]), c1 = make_float4(c1v[0], c1v[1], c1v[2], c1v[3]);
#pragma unroll
            for (int ai = 0; ai < 2; ++ai)
#pragma unroll
                for (int m = 0; m < 4; ++m) {
                    u32x4 w; w[0] = pack2(acc[ai][bj][m][0][0] + c0.x, acc[ai][bj][m][0][1] + c0.y); w[1] = pack2(acc[ai][bj][m][0][2] + c0.z, acc[ai][bj][m][0][3] + c0.w);
                    w[2] = pack2(acc[ai][bj][m][1][0] + c1.x, acc[ai][bj][m][1][1] + c1.y); w[3] = pack2(acc[ai][bj][m][1][2] + c1.z, acc[ai][bj][m][1][3] + c1.w);
                    *(u32x4*)(O + (size_t)(row0 + ai * 128 + m * 16) * D + col0 + bj * 128) = w;
                }
        }
    }
};
__device__ __forceinline__ void ph_g5(const Params& p, int l, LAS unsigned char* lds) {
    LAS int* ts = (LAS int*)(lds + g8::STAGE_BYTES); LAS int* cn = ts + 40; LAS int* te = ts + 80;
    build_expert_tables(p, l, ts, cn, te);
    MoeSched S; S.ts = ts; S.cn = cn; S.te = te; S.list = p.list; S.A = p.act; S.Bt = p.w2T + (size_t)l * NE * D * D; S.bias = p.moe_b2 + (size_t)l * NE * D; S.nbias = 1;
    S.K = D; S.npn = 4; S.nunits = ts[NE] * 4; S.G = gridDim.x; S.c = blockIdx.x; S.nrowsB = D; S.gather = false;
    EpiYp E; E.O = p.yp;
    g8::gemm_phase(lds, D, S, E);
}

template <bool DRY = false> __device__ __forceinline__ void ph_combine(const Params& p, int l, int M, LAS unsigned char* lds) {
    float* const c_xl = DRY ? p.prep : p.xl; bf16_t* const c_H = DRY ? (bf16_t*)(p.prep + (size_t)NTOK * D) : p.H; float* const c_out = DRY ? p.prep : p.out;
    LAS int* ts = (LAS int*)lds; LAS int* cn = ts + 40;
    build_expert_tables(p, l, ts, cn, nullptr);
    const int tid = opaque_tid(), wid = tid >> 6, lane = tid & 63;
    const bool last = (l == 1);
    const int tstep = gridDim.x * NWAVES;
    int tok = blockIdx.x * NWAVES + wid;
    int4 nts = make_int4(0, 0, 0, 0); float4 ntw = make_float4(0.f, 0.f, 0.f, 0.f);
    if (tok < M) { nts = *(const int4*)(p.tokslot + (size_t)tok * 4); ntw = *(const float4*)(p.topw + (size_t)tok * 4); }
    for (; tok < M; tok += tstep) {
        float4 v[4];
        const float* mb = p.mod + (size_t)(l * 5 + tok_modrow(tok)) * (NMOD * D);
        const int tsl[4] = {nts.x, nts.y, nts.z, nts.w}; const float wts[4] = {ntw.x, ntw.y, ntw.z, ntw.w};
        int rows[4];
#pragma unroll
        for (int k = 0; k < 4; ++k) rows[k] = ts[tsl[k] >> 16] * 256 + (tsl[k] & 0xffff);
        if (tok + tstep < M) { nts = *(const int4*)(p.tokslot + (size_t)(tok + tstep) * 4); ntw = *(const float4*)(p.topw + (size_t)(tok + tstep) * 4); }
        u32x2 yv[4][4]; float4 xin[4], gtv[4];
#pragma unroll
        for (int i = 0; i < 4; ++i) {
            const int cidx = i * 256 + lane * 4;
#pragma unroll
            for (int k = 0; k < 4; ++k) yv[i][k] = *(const u32x2*)(p.yp + (size_t)rows[k] * D + cidx);
            xin[i] = *(const float4*)(p.xl + (size_t)tok * D + cidx);
            gtv[i] = *(const float4*)(mb + 5 * D + cidx);
        }
        float ss = 0.f;
#pragma unroll
        for (int i = 0; i < 4; ++i) {
            float m0 = 0.f, m1 = 0.f, m2 = 0.f, m3 = 0.f;
#pragma unroll
            for (int k = 0; k < 4; ++k) { m0 += wts[k] * bflo(yv[i][k][0]); m1 += wts[k] * bfhi(yv[i][k][0]); m2 += wts[k] * bflo(yv[i][k][1]); m3 += wts[k] * bfhi(yv[i][k][1]); }
            float4 xv = xin[i];
            xv.x += gtv[i].x * m0; xv.y += gtv[i].y * m1; xv.z += gtv[i].z * m2; xv.w += gtv[i].w * m3;
            v[i] = xv; ss += xv.x * xv.x + xv.y * xv.y + xv.z * xv.z + xv.w * xv.w;
        }
        ss = wave_sum(ss, lane);
        const float rinv = rsqrtf(ss * (1.0f / D) + 1e-6f);
        if (!last) {
#pragma unroll
            for (int i = 0; i < 4; ++i) *(float4*)(c_xl + (size_t)tok * D + i * 256 + lane * 4) = v[i];
            const float* mb1 = p.mod + (size_t)((l + 1) * 5 + tok_modrow(tok)) * (NMOD * D);
            norm_mod_store(v, rinv, p.norm1_g + (l + 1) * D, mb1 + 1 * D, mb1 + 0 * D, c_H + (size_t)tok * D, lane);
        } else {
#pragma unroll
            for (int i = 0; i < 4; ++i) {
                const int cidx = i * 256 + lane * 4;
                const float4 gv = *(const float4*)(p.final_norm_g + cidx);
                *(float4*)(c_out + (size_t)tok * D + cidx) = make_float4(v[i].x * rinv * gv.x, v[i].y * rinv * gv.y, v[i].z * rinv * gv.z, v[i].w * rinv * gv.w);
            }
        }
    }
}

#define XB_TMO      128
#define XB_XCNT(j)  (256  + 64 * (j))
#define XB_XSUB(j)  (1280 + 64 * (j))
#define XB_XGEN(j)  (2304 + 64 * (j))
#define XB_TOP      3328
#define XB_TOPGEN   3392
#define XCD_BAR_WORDS 3456
#define XB_SPIN_CAP (1u << 18)

__device__ __forceinline__ unsigned xb_ld(unsigned* p)              { return __hip_atomic_load(p, __ATOMIC_RELAXED, __HIP_MEMORY_SCOPE_AGENT); }
__device__ __forceinline__ unsigned xb_add(unsigned* p, unsigned v) { return __hip_atomic_fetch_add(p, v, __ATOMIC_RELAXED, __HIP_MEMORY_SCOPE_AGENT); }
__device__ __forceinline__ unsigned xb_xcc_id() { return (unsigned)__builtin_amdgcn_s_getreg((3 << 11) | 20) & 0xFu; }
#define XB_SPIN(cond, bar) do { unsigned _sp = 0; while (cond) { __builtin_amdgcn_s_sleep(1); \
    if ((++_sp & 255u) == 0u) { if (xb_ld(&(bar)[XB_TMO])) break; if (_sp > XB_SPIN_CAP) { atomicAdd(&(bar)[XB_TMO], 1u); break; } } } } while (0)

struct XcdBarrier {
    unsigned* bar; unsigned x;
    volatile LAS unsigned* st;
};

__device__ __forceinline__ XcdBarrier xcd_barrier_post(unsigned* bar, volatile LAS unsigned* st) {
    XcdBarrier b; b.bar = bar; b.x = xb_xcc_id(); b.st = st;
    if (threadIdx.x == 0) (void)xb_add(&bar[XB_XCNT(b.x)], 1u);
    return b;
}
__device__ __forceinline__ void xcd_barrier_complete(unsigned* bar, unsigned x, unsigned& nloc, unsigned& nx) {
    const unsigned G = gridDim.x * gridDim.y * gridDim.z;
    unsigned sum, cnt, mine, sp = 0u;
    for (;;) {
        sum = 0u; cnt = 0u; mine = 0u;
#pragma unroll
        for (unsigned j = 0; j < 16; ++j) { const unsigned c = xb_ld(&bar[XB_XCNT(j)]); sum += c; cnt += (c > 0u) ? 1u : 0u; mine = (j == x) ? c : mine; }
        if (sum == G) break;
        __builtin_amdgcn_s_sleep(1);
        if ((++sp & 255u) == 0u) { if (xb_ld(&bar[XB_TMO])) break; if (sp > XB_SPIN_CAP) { atomicAdd(&bar[XB_TMO], 1u); break; } }
    }
    nloc = mine > 0u ? mine : 1u; nx = cnt > 0u ? cnt : 1u;
}

__device__ __forceinline__ void xcd_barrier(const XcdBarrier& b) {
    asm volatile("s_waitcnt vmcnt(0)" ::: "memory");
    __syncthreads();
    if (threadIdx.x == 0) {
        unsigned* bar = b.bar;
        __builtin_amdgcn_s_waitcnt(0);
        unsigned nloc = b.st[0], nx = b.st[1];
        if (nloc == 0u) { xcd_barrier_complete(bar, b.x, nloc, nx); b.st[0] = nloc; b.st[1] = nx; }
        const unsigned old = xb_add(&bar[XB_XSUB(b.x)], 1u);
        const unsigned gen = old / nloc;
        if (old + 1u == (gen + 1u) * nloc) {
            __builtin_amdgcn_fence(__ATOMIC_RELEASE, "agent");
            asm volatile("s_waitcnt vmcnt(0)" ::: "memory");
            const unsigned og = xb_add(&bar[XB_TOP], 1u);
            const unsigned tg = og / nx;
            if (og + 1u == (tg + 1u) * nx) xb_add(&bar[XB_TOPGEN], 1u);
            else XB_SPIN(xb_ld(&bar[XB_TOPGEN]) == tg, bar);
            __builtin_amdgcn_fence(__ATOMIC_ACQUIRE, "agent");
            xb_add(&bar[XB_XGEN(b.x)], 1u);
            asm volatile("s_waitcnt vmcnt(0)" ::: "memory");
        } else {
            XB_SPIN(xb_ld(&bar[XB_XGEN(b.x)]) == gen, bar);
            __builtin_amdgcn_fence(__ATOMIC_ACQUIRE, "agent");
            asm volatile("s_waitcnt vmcnt(0)" ::: "memory");
        }
    }
    __syncthreads();
}


extern __shared__ __attribute__((aligned(16))) unsigned char dyn_lds[];

typedef const __attribute__((address_space(4))) unsigned char* KArgPtr;
__device__ __forceinline__ Params load_params(KArgPtr kp) {
    asm volatile("" : "+s"(kp));
    Params q;
    const __attribute__((address_space(4))) unsigned long long* k8 = (const __attribute__((address_space(4))) unsigned long long*)kp;
    unsigned long long* d8 = (unsigned long long*)&q;
#pragma unroll
    for (int i = 0; i < (int)(sizeof(Params) / 8); ++i) d8[i] = k8[i];
    return q;
}
__global__ void __launch_bounds__(NTHREADS, 2) k_mega(Params p_unused) {
    (void)p_unused;
    const KArgPtr kp = (KArgPtr)__builtin_amdgcn_kernarg_segment_ptr();
    LAS unsigned char* lds = (LAS unsigned char*)dyn_lds;
    volatile LAS unsigned* xb_words = (volatile LAS unsigned*)(lds + LDS_BYTES - 16);
    if (threadIdx.x == 0) { xb_words[0] = 0u; xb_words[1] = 0u; xb_words[2] = 0u; xb_words[3] = 0u; }
    __syncthreads();
    { const Params p = load_params(kp); (void)xcd_barrier_post(p.bar, xb_words); }
#define GRID_BARRIER() do { XcdBarrier b_; b_.bar = load_params(kp).bar; b_.x = xb_xcc_id(); b_.st = xb_words; xcd_barrier(b_); } while (0)
#define PH(stmt) do { const Params p = load_params(kp); stmt; } while (0)
    PH(ph_convert(p, lds));
    PH(ph_mod(p, lds));
    GRID_BARRIER();
    PH(ph_norm1_first(p));
    GRID_BARRIER();
    for (int l = 0; l < 2; ++l) {
        const int M = l == 0 ? NTOK : NLAT;
        { unsigned lb_ = (unsigned)(size_t)lds; asm volatile("" : "+s"(lb_)); lds = (LAS unsigned char*)(size_t)lb_; }
        PH(ph_g1(p, l, lds));
        GRID_BARRIER();
        PH(ph_prep(p, l, lds));
        PH(ph_local(p, l, lds));
        GRID_BARRIER();
        PH(ph_seq(p, l, lds));
        GRID_BARRIER();
        PH(ph_merge(p, l, M));
        GRID_BARRIER();
        PH(ph_g2(p, l, M, lds));
        GRID_BARRIER();
        PH(ph_g3(p, l, M, lds));
        GRID_BARRIER();
        PH(ph_route(p, l, M, lds));
        GRID_BARRIER();
        PH(ph_g4(p, l, lds));
        GRID_BARRIER();
        PH(ph_g5(p, l, lds));
        GRID_BARRIER();
        PH(ph_combine(p, l, M, lds));
        if (l == 0) GRID_BARRIER();
    }
}

static inline size_t align_up(size_t v, size_t a) { return (v + a - 1) / a * a; }

extern "C" void kernel_launch(void* const* d_in, const int* in_sizes, int n_in, void* d_out, int out_size, void* d_ws, size_t ws_size, hipStream_t stream) {
    (void)in_sizes; (void)n_in; (void)out_size;
    Params p{};
    const float** pf = (const float**)&p;
    for (int i = 0; i < 32; ++i) pf[i] = (const float*)d_in[i];
    p.out = (float*)d_out;
    unsigned char* w = (unsigned char*)d_ws; size_t off = 0;
    auto take = [&](size_t bytes) { void* r = w + off; off = align_up(off + bytes, 256); return r; };
    p.bar = (unsigned*)take(16384);
    p.cnt = (int*)take(4096);
    const size_t ctl_bytes = off;
    p.mod = (float*)take((size_t)2 * 5 * NMOD * D * 4);
    p.winT = (bf16_t*)take((size_t)2 * NPW * D * 2);
    p.wbT = (bf16_t*)take((size_t)2 * 4 * D * MW * 2);
    p.woutT = (bf16_t*)take((size_t)2 * D * D * 2);
    p.w1T = (bf16_t*)take((size_t)2 * NE * 2 * D * D * 2);
    p.w2T = (bf16_t*)take((size_t)2 * NE * D * D * 2);
    p.xl = (float*)take((size_t)NTOK * D * 4);
    p.H = (bf16_t*)take((size_t)NTOK * D * 2);
    p.P = (bf16_t*)take((size_t)NTOK * NP * 2);
    p.gate = (bf16_t*)take((size_t)NTOK * 4096 * 2);
    p.act = p.P; p.yp = p.P + (size_t)CAPROWS * D;
    p.prep = (float*)take(NPREP * TOKW * 4);
    p.O = (bf16_t*)take(8 * TOKW * 2);
    p.lq = (bf16_t*)take((size_t)3 * NITEM * 64 * 128 * 2);
    p.lo = (bf16_t*)take((size_t)3 * NITEM * 64 * 128 * 2);
    p.lb = (bf16_t*)take((size_t)3 * NITEM * 128 * 128 * 2);
    p.la = (bf16_t*)take((size_t)NITEM * 128 * 128 * 2);
    p.ld = (float*)take((size_t)3 * NITEM * 128 * 4);
    p.lruT = (bf16_t*)take((size_t)2 * 8 * 4 * 4096 * 2);
    p.lsig = (float*)take((size_t)2 * 2 * MW * 4);
    p.rope = (float2*)take((size_t)TL * 64 * 8);
    p.Y = (bf16_t*)take(4 * TOKW * 2);
    p.mix = (bf16_t*)take((size_t)NTOK * D * 2);
    p.F = p.H;
    p.list = (int*)take((size_t)NE * NTOK * 4);
    p.tokslot = (int*)take((size_t)NTOK * 4 * 4);
    p.topw = (float*)take((size_t)NTOK * 4 * 4);
    if (off > ws_size) { fprintf(stderr, "workspace too small: need %zu have %zu\n", off, ws_size); return; }

    static int grid = 0;
    if (!grid) {
        int dev = 0, cus = 0, occ = 0; (void)hipGetDevice(&dev); (void)hipDeviceGetAttribute(&cus, hipDeviceAttributeMultiprocessorCount, dev);
        (void)hipFuncSetAttribute((const void*)k_mega, hipFuncAttributeMaxDynamicSharedMemorySize, LDS_BYTES);
        (void)hipOccupancyMaxActiveBlocksPerMultiprocessor(&occ, (const void*)k_mega, NTHREADS, LDS_BYTES);
        if (cus <= 0) cus = 256;
        grid = cus * (occ < 1 ? 1 : 1);
        if (occ < 1) fprintf(stderr, "occupancy query says %d blocks per CU\n", occ);
    }
    (void)hipMemsetAsync(d_ws, 0, ctl_bytes, stream);
    hipLaunchKernelGGL(k_mega, dim3(grid), dim3(NTHREADS), LDS_BYTES, stream, p);
}
```

```cpp
#include <hip/hip_runtime.h>
#include <stdint.h>
#include <stdio.h>

#define LAS __attribute__((address_space(3)))
typedef unsigned short bf16_t;
typedef short bf16x8 __attribute__((ext_vector_type(8)));
typedef float f32x4 __attribute__((ext_vector_type(4)));
typedef float f32x2 __attribute__((ext_vector_type(2)));
typedef unsigned u32x2 __attribute__((ext_vector_type(2)));
typedef unsigned u32x4 __attribute__((ext_vector_type(4)));

#ifndef PROBE
#define PROBE 0
#endif

constexpr int D = 1024, NB = 4, TL = 4096, TC = 256, NLAT = NB * TL, NCTX = NB * TC, NTOK = NLAT + NCTX;
constexpr int NIN = 11792, NPW = 12032, NP = 7936, MW = 512, NE = 32, TOPK = 4, NMOD = 6;
constexpr int C_GQKV = 0, C_GZ = 1536, C_HQ = 2048, C_HI = 2560, C_HF = 3072, C_HG = 4096, C_LX = 4608,
              C_LY = 5120, C_RQKV = 5632, C_RG = 7168, C_GA = 7680, C_GB = 7688, W_MG = 7936;
__host__ __device__ __forceinline__ int win_dst_row(int n) {
    if (n < 7696) return n < 2048 ? n : n < 2064 ? 7680 + (n - 2048) : n - 16;
    const int q = n - 7696, seg = q >> 10, lam = q & 1023, t = lam >> 6, li = lam & 63;
    return 7936 + t * 256 + (seg >> 1) * 128 + (li >> 4) * 32 + ((li >> 2) & 3) * 8 + (seg & 1) * 4 + (li & 3);
}
constexpr int NTHREADS = 512, NWAVES = 8;
constexpr int LDS_BYTES = 140 * 1024;
constexpr int CAPROWS = 77824;
constexpr size_t TOKW = (size_t)NTOK * MW;
constexpr int PR_LA = 0, PR_LU = 2, NPREP = 4;
constexpr int NCHUNK = 68, NITEM = 32 * NCHUNK;

struct Params {
    const float *x, *c, *ctx, *c_ctx, *w_mod, *b_mod, *norm1_g, *norm2_g, *w_in, *gdn_conv_w, *gdn_a_log, *gdn_dt_bias, *gdn_norm_g, *hgrn_lb,
        *hgrn_norm_g, *lru_conv_w, *lru_conv_b, *lru_wa, *lru_ba, *lru_wx, *lru_bx, *lru_lambda, *ret_norm_g, *w_branch, *w_out, *router_w,
        *router_b, *moe_w1, *moe_b1, *moe_w2, *moe_b2, *final_norm_g;
    float* out;
    unsigned* bar; int* cnt; float* mod;
    bf16_t *winT, *wbT, *woutT, *w1T, *w2T;
    float* xl; bf16_t* H; bf16_t* P; float* prep; float* gg; float* gb; bf16_t* O; bf16_t* Y; bf16_t* mix; bf16_t* F;
    int* list; int* tokslot; float* topw; bf16_t* act; bf16_t* yp;
    bf16_t *lq, *lo, *lb, *la; float* ld; bf16_t* lruT; bf16_t* gate; float* lsig; float2* rope;
};

typedef __bf16 bf16x2_t __attribute__((ext_vector_type(2)));
__device__ __forceinline__ unsigned pack2(float a, float b) { const f32x2 v = {a, b}; return __builtin_bit_cast(unsigned, __builtin_convertvector(v, bf16x2_t)); }
__device__ __forceinline__ unsigned f2bf(float f) { return pack2(f, f) & 0xffffu; }
__device__ __forceinline__ float bf2f(bf16_t b) { return __uint_as_float(((unsigned)b) << 16); }
__device__ __forceinline__ float bflo(unsigned u) { return __uint_as_float(u << 16); }
__device__ __forceinline__ float bfhi(unsigned u) { return __uint_as_float(u & 0xffff0000u); }
__device__ __forceinline__ float sigmoidf_(float x) { return __builtin_amdgcn_rcpf(1.0f + __expf(-x)); }
__device__ __forceinline__ float siluf_(float x) { return x * sigmoidf_(x); }
__device__ __forceinline__ float softplusf_(float x) { return x > 20.f ? x : __logf(1.0f + __expf(x)); }
__device__ __forceinline__ float ret_log_gamma(int h) { return h == 0 ? -0.031748698314580f : h == 1 ? -0.015748356968139f : h == 2 ? -0.007843177461025f : -0.003913899321136f; }
__device__ __forceinline__ float logsigmoidf_(float x) { return -softplusf_(-x); }
__device__ __forceinline__ float gelu_tanhf_(float x) { const float u = 0.7978845608028654f * (x + 0.044715f * x * x * x); return x * __builtin_amdgcn_rcpf(1.0f + __expf(-2.0f * u)); }
__device__ __forceinline__ float shx(float v, int m, int lane) { return __int_as_float(__builtin_amdgcn_ds_bpermute((lane ^ m) << 2, __float_as_int(v))); }
__device__ __forceinline__ float shup(float v, int off, int lane) { const int s = lane >= off ? lane - off : lane; return __int_as_float(__builtin_amdgcn_ds_bpermute(s << 2, __float_as_int(v))); }
__device__ __forceinline__ int shupi(int v, int off, int lane) { const int s = lane >= off ? lane - off : lane; return __builtin_amdgcn_ds_bpermute(s << 2, v); }
__device__ __forceinline__ float wave_sum(float v, int lane) {
#pragma unroll
    for (int m = 32; m >= 1; m >>= 1) v += shx(v, m, lane);
    return v;
}
__device__ __forceinline__ int opaque_tid() { int t = threadIdx.x; asm volatile("" : "+v"(t)); return t; }
template <class T> __device__ __forceinline__ T* opaque_sptr(T* q) { asm volatile("" : "+s"(q)); return q; }
__device__ __forceinline__ int tok_modrow(int tok) { return tok < NLAT ? (tok >> 12) : 4; }
__device__ __forceinline__ void tok_info(int tok, int& t, int& T, int& base) {
    if (tok < NLAT) { t = tok & (TL - 1); T = TL; base = tok - t; }
    else { t = (tok - NLAT) & (TC - 1); T = TC; base = tok - t; }
}

__device__ __forceinline__ f32x4 mfma16(bf16x8 a, bf16x8 b, f32x4 c) { return __builtin_amdgcn_mfma_f32_16x16x32_bf16(a, b, c, 0, 0, 0); }
__device__ __forceinline__ u32x2 pack4(f32x4 v) { u32x2 o; o[0] = pack2(v[0], v[1]); o[1] = pack2(v[2], v[3]); return o; }
__device__ __forceinline__ u32x4 pack8(const float* v) { u32x4 o; o[0] = pack2(v[0], v[1]); o[1] = pack2(v[2], v[3]); o[2] = pack2(v[4], v[5]); o[3] = pack2(v[6], v[7]); return o; }

namespace g8 {
constexpr int BM = 256, BK = 64, HALF = 128, HTB = HALF * BK * 2, STAGE_BYTES = 8 * HTB;
__device__ __forceinline__ int lds_byte(int r, int c) { const int st = (r >> 4) * 2 + (c >> 5), rr = r & 15, cc = c & 31, ob = rr * 64 + cc * 2; return st * 1024 + (ob ^ (((ob >> 9) & 1) << 5)); }
__device__ __forceinline__ void stage_rc(int b, int& R, int& C) { const int st = b / 1024, sb = b % 1024, swz = sb ^ (((sb >> 9) & 1) << 5); R = (st >> 1) * 16 + swz / 64; C = (st & 1) * 32 + (swz % 64) / 2; }
__device__ __forceinline__ int perm32(int rho) { const int n = rho >> 4, i = rho & 15; return 8 * (i >> 2) + 4 * n + (i & 3); }
struct Unit { int pm, pn, e; };

template <class Epi, class Sched>
__device__ __forceinline__ void gemm_phase(LAS unsigned char* lds, const int K, const Sched& S, const Epi& E) {
    const int tid = opaque_tid(), wid = __builtin_amdgcn_readfirstlane(tid >> 6), lane = tid & 63, wr = wid >> 2, wc = wid & 3, fr = lane & 15, fq = lane >> 4;
    const int nt = K / BK;
    int R0, C0, R1, C1; stage_rc(tid * 16, R0, C0); stage_rc(tid * 16 + 8192, R1, C1);
    unsigned voffB[2];
    voffB[0] = (unsigned)(((R0 & ~31) + perm32(R0 & 31)) * K + C0) * 2u; voffB[1] = (unsigned)(((R1 & ~31) + perm32(R1 & 31)) * K + C1) * 2u;
    const unsigned cb0 = (unsigned)C0 * 2u, cb1 = (unsigned)C1 * 2u;
    const size_t kstep = (size_t)(BK * 2);
    const size_t hstepB = (size_t)HALF * K * 2;
    const unsigned ldsw = (unsigned)wid * 1024u;
    const int aoff = lds_byte(wr * 64 + fr, fq * 8), boff = lds_byte(wc * 32 + fr, fq * 8);
#define G8_SA(b, h) (((b) * 2 + (h)) * HTB)
#define G8_SB(b, h) ((4 + (b) * 2 + (h)) * HTB)
#define G8_GL(src, dstoff) __builtin_amdgcn_global_load_lds((const unsigned*)(src), (LAS unsigned*)(lds + (dstoff)), 16, 0, 0)
#define G8_STAGE_A(bufoff, gbase, vo, h) do { G8_GL((const char*)(gbase) + (vo)[2 * (h)], (bufoff) + ldsw); G8_GL((const char*)(gbase) + (vo)[2 * (h) + 1], (bufoff) + ldsw + 8192); } while (0)
#define G8_STAGE_B(bufoff, gbase) do { G8_GL((const char*)(gbase) + voffB[0], (bufoff) + ldsw); G8_GL((const char*)(gbase) + voffB[1], (bufoff) + ldsw + 8192); } while (0)
#define G8_LDA(dst, b, h) do { _Pragma("unroll") for (int m = 0; m < 4; ++m) _Pragma("unroll") for (int k = 0; k < 2; ++k) dst[m][k] = *(const LAS bf16x8*)(lds + G8_SA(b, h) + aoff + m * 2048 + k * 1024); } while (0)
#define G8_LDB(dst, b, h) do { _Pragma("unroll") for (int n = 0; n < 2; ++n) _Pragma("unroll") for (int k = 0; k < 2; ++k) dst[n][k] = *(const LAS bf16x8*)(lds + G8_SB(b, h) + boff + n * 2048 + k * 1024); } while (0)
#define G8_MMA(ai, bj, At, Bt) do { __builtin_amdgcn_s_setprio(1); _Pragma("unroll") for (int m = 0; m < 4; ++m) _Pragma("unroll") for (int n = 0; n < 2; ++n) _Pragma("unroll") for (int k = 0; k < 2; ++k) \
        acc[ai][bj][m][n] = __builtin_amdgcn_mfma_f32_16x16x32_bf16(Bt[n][k], At[m][k], acc[ai][bj][m][n], 0, 0, 0); __builtin_amdgcn_s_setprio(0); } while (0)
#define G8_WAIT_V(n) asm volatile("s_waitcnt vmcnt(" #n ")" ::: "memory")
#define G8_WAIT_L(n) asm volatile("s_waitcnt lgkmcnt(" #n ")" ::: "memory")
#define G8_BAR __builtin_amdgcn_s_barrier()
#define G8_SCHED __builtin_amdgcn_sched_barrier(0)
    Unit cur, nxt; int ui = 0;
    if (!S.next(0, cur)) return;
    LAS float* biasbuf = (LAS float*)(lds + STAGE_BYTES + 2048);
    LAS int* rowbuf = (LAS int*)(lds + STAGE_BYTES + 4096);
    f32x4 acc[2][2][4][2];
#pragma unroll
    for (int a = 0; a < 2; ++a)
#pragma unroll
        for (int b = 0; b < 2; ++b)
#pragma unroll
            for (int m = 0; m < 4; ++m)
#pragma unroll
                for (int n = 0; n < 2; ++n) acc[a][b][m][n] = (f32x4){0.f, 0.f, 0.f, 0.f};
    bf16x8 At[4][2], B0[2][2], B1[2][2];
    unsigned vA[4];
    {
        unsigned rows[4] = {(unsigned)R0, (unsigned)R1, (unsigned)(HALF + R0), (unsigned)(HALF + R1)};
        if (S.gather) { rows[0] = (unsigned)*S.row_addr(cur, R0); rows[1] = (unsigned)*S.row_addr(cur, R1); rows[2] = (unsigned)*S.row_addr(cur, HALF + R0); rows[3] = (unsigned)*S.row_addr(cur, HALF + R1); }
        vA[0] = rows[0] * (unsigned)(K * 2) + cb0; vA[1] = rows[1] * (unsigned)(K * 2) + cb1; vA[2] = rows[2] * (unsigned)(K * 2) + cb0; vA[3] = rows[3] * (unsigned)(K * 2) + cb1;
    }
    const char* cA = S.a_base(cur); const char* cB = S.b_base(cur);
    G8_STAGE_B(G8_SB(0, 0), cB); G8_STAGE_A(G8_SA(0, 0), cA, vA, 0); G8_STAGE_B(G8_SB(0, 1), cB + hstepB); G8_STAGE_A(G8_SA(0, 1), cA, vA, 1);
    if (wr == 1) G8_BAR;
    G8_WAIT_V(4); G8_BAR;
    G8_STAGE_B(G8_SB(1, 0), cB + kstep); G8_STAGE_A(G8_SA(1, 0), cA + kstep, vA, 0); G8_STAGE_B(G8_SB(1, 1), cB + hstepB + kstep);
    G8_WAIT_V(6); G8_BAR;
    for (;;) {
        const bool has_next = S.next(ui + 1, nxt);
        const char* nA = has_next ? S.a_base(nxt) : cA; const char* nB = has_next ? S.b_base(nxt) : cB;
        const int nvalid = (S.gather && has_next) ? S.rows_valid(nxt) : 0;
        if (wid == 0) {
            if (Sched::HAS_BIAS) G8_GL(S.bias_src(cur, lane), STAGE_BYTES + 2048 + (ui & 1) * 1024);
            if (S.gather && has_next) G8_GL(S.row_addr(nxt, 0) + lane * 4, STAGE_BYTES + 4096 + ((ui + 1) & 1) * 1024);
        }
        for (int t = 0; t < nt; t += 2) {
            const bool last = (t == nt - 2);
            const char* a1 = cA + (size_t)(t + 1) * kstep;
            const char* a2 = last ? nA : cA + (size_t)(t + 2) * kstep; const char* b2 = last ? nB : cB + (size_t)(t + 2) * kstep;
            const char* a3 = a2 + kstep; const char* b3 = b2 + kstep;
            G8_LDB(B0, 0, 0); G8_SCHED; G8_LDA(At, 0, 0); G8_STAGE_A(G8_SA(1, 1), a1, vA, 1);
            if (last && S.gather && has_next) {
                const LAS int* rb = rowbuf + ((ui + 1) & 1) * 256;
                const unsigned r0 = R0 < nvalid ? (unsigned)rb[R0] : 0u, r1 = R1 < nvalid ? (unsigned)rb[R1] : 0u;
                const unsigned r2 = HALF + R0 < nvalid ? (unsigned)rb[HALF + R0] : 0u, r3 = HALF + R1 < nvalid ? (unsigned)rb[HALF + R1] : 0u;
                vA[0] = r0 * (unsigned)(K * 2) + cb0; vA[1] = r1 * (unsigned)(K * 2) + cb1; vA[2] = r2 * (unsigned)(K * 2) + cb0; vA[3] = r3 * (unsigned)(K * 2) + cb1;
            }
            G8_WAIT_L(8); G8_BAR; G8_WAIT_L(0); G8_MMA(0, 0, At, B0); G8_BAR; G8_SCHED;
            G8_LDB(B1, 0, 1); G8_STAGE_B(G8_SB(0, 0), b2);
            G8_BAR; G8_WAIT_L(0); G8_MMA(0, 1, At, B1); G8_BAR;
            G8_LDA(At, 0, 1); G8_STAGE_A(G8_SA(0, 0), a2, vA, 0);
            G8_BAR; G8_WAIT_L(0); G8_MMA(1, 0, At, B0); G8_BAR; G8_SCHED;
            G8_STAGE_B(G8_SB(0, 1), b2 + hstepB);
            G8_WAIT_V(6); G8_BAR; G8_MMA(1, 1, At, B1); G8_BAR;
            G8_LDB(B0, 1, 0); G8_SCHED; G8_LDA(At, 1, 0); G8_STAGE_A(G8_SA(0, 1), a2, vA, 1);
            G8_WAIT_L(8); G8_BAR; G8_WAIT_L(0); G8_MMA(0, 0, At, B0); G8_BAR; G8_SCHED;
            G8_LDB(B1, 1, 1); G8_STAGE_B(G8_SB(1, 0), b3);
            G8_BAR; G8_WAIT_L(0); G8_MMA(0, 1, At, B1); G8_BAR;
            G8_LDA(At, 1, 1); G8_STAGE_A(G8_SA(1, 0), a3, vA, 0);
            G8_BAR; G8_WAIT_L(0); G8_MMA(1, 0, At, B0); G8_BAR; G8_SCHED;
            G8_STAGE_B(G8_SB(1, 1), b3 + hstepB);
            G8_WAIT_V(6); G8_BAR; G8_MMA(1, 1, At, B1); G8_BAR;
        }
        E(acc, cur, wr, wc, fr, fq, biasbuf + (ui & 1) * 256);
        if (!has_next) break;
        if (!E.keep(cur))
#pragma unroll
        for (int a = 0; a < 2; ++a)
#pragma unroll
            for (int b = 0; b < 2; ++b)
#pragma unroll
                for (int m = 0; m < 4; ++m)
#pragma unroll
                    for (int n = 0; n < 2; ++n) acc[a][b][m][n] = (f32x4){0.f, 0.f, 0.f, 0.f};
        cur = nxt; cA = nA; cB = nB; ++ui;
    }
    G8_WAIT_V(0);
    if (wr == 0) G8_BAR;
    G8_BAR;
#undef G8_SA
#undef G8_SB
#undef G8_GL
#undef G8_STAGE_A
#undef G8_STAGE_B
#undef G8_LDA
#undef G8_LDB
#undef G8_MMA
#undef G8_WAIT_V
#undef G8_WAIT_L
#undef G8_BAR
#undef G8_SCHED
}

struct PlainSched {
    const bf16_t* A; const bf16_t* Bt; int K, nM, nN, nwg, G, c;
    __device__ __forceinline__ void init(const bf16_t* A_, const bf16_t* Bt_, int M, int N, int K_) { A = A_; Bt = Bt_; K = K_; nM = M / BM; nN = N / BM; nwg = nM * nN; G = gridDim.x; c = blockIdx.x; }
    __device__ __forceinline__ bool next(int i, Unit& u) const {
        const long L = (long)i * G + c; if (L >= nwg) return false;
        int wgid = (int)L; { const int q = nwg / 8, r = nwg % 8, xcd = wgid % 8, off = wgid / 8; wgid = (xcd < r ? xcd * (q + 1) : r * (q + 1) + (xcd - r) * q) + off; }
        const int nig = 8 * nN, gid = wgid / nig, fm = gid * 8, gsz = (nM - fm) < 8 ? (nM - fm) : 8;
        u.pm = fm + ((wgid % nig) % gsz); u.pn = (wgid % nig) / gsz; u.e = 0; return true;
    }
    __device__ __forceinline__ const char* a_base(const Unit& u) const { return (const char*)(A + (size_t)u.pm * BM * K); }
    __device__ __forceinline__ const char* b_base(const Unit& u) const { return (const char*)(Bt + (size_t)u.pn * BM * K); }
    static constexpr bool HAS_BIAS = false, gather = false;
    __device__ __forceinline__ const int* row_addr(const Unit&, int) const { return nullptr; }
    __device__ __forceinline__ int rows_valid(const Unit&) const { return 256; }
    __device__ __forceinline__ const float* bias_src(const Unit&, int) const { return nullptr; }
};
}

__device__ __forceinline__ int w1_dst_row(int n) { const int half = n >> 10, cc = n & 1023; return (cc >> 7) * 256 + half * 128 + (cc & 127); }

struct CvtTile { const float* src; bf16_t* dst; int ld, Nsrc, k0, n0, K, mode; };
__device__ __forceinline__ CvtTile cvt_decode(const Params& p, int it) {
    constexpr int PER_L = 2960 + 512 + 256 + 16384 + 8192;
    CvtTile t; const int l = it / PER_L; int r = it % PER_L;
    if (r < 2960) { const int nt = r % 185, kt = r / 185; t.src = p.w_in + (size_t)l * D * NIN; t.ld = NIN; t.Nsrc = NIN; t.k0 = kt * 64; t.n0 = nt * 64; t.dst = p.winT + (size_t)l * NPW * D; t.K = D; t.mode = 2; }
    else if (r < 3472) { r -= 2960; const int n = r / 128; r %= 128; const int nt = r % 16, kt = r / 16;
        t.src = p.w_branch + (size_t)(l * 4 + n) * MW * D; t.ld = D; t.Nsrc = D; t.k0 = kt * 64; t.n0 = nt * 64; t.dst = p.wbT + (size_t)(l * 4 + n) * D * MW; t.K = MW; t.mode = 0; }
    else if (r < 3728) { r -= 3472; const int nt = r % 16, kt = r / 16; t.src = p.w_out + (size_t)l * D * D; t.ld = D; t.Nsrc = D; t.k0 = kt * 64; t.n0 = nt * 64; t.dst = p.woutT + (size_t)l * D * D; t.K = D; t.mode = 0; }
    else if (r < 3728 + 16384) { r -= 3728; const int ee = r / 512; r %= 512; const int nt = r % 32, kt = r / 32;
        t.src = p.moe_w1 + (size_t)(l * NE + ee) * D * 2 * D; t.ld = 2 * D; t.Nsrc = 2 * D; t.k0 = kt * 64; t.n0 = nt * 64; t.dst = p.w1T + (size_t)(l * NE + ee) * 2 * D * D; t.K = D; t.mode = 1; }
    else { r -= 3728 + 16384; const int ee = r / 256; r %= 256; const int nt = r % 16, kt = r / 16;
        t.src = p.moe_w2 + (size_t)(l * NE + ee) * D * D; t.ld = D; t.Nsrc = D; t.k0 = kt * 64; t.n0 = nt * 64; t.dst = p.w2T + (size_t)(l * NE + ee) * D * D; t.K = D; t.mode = 0; }
    return t;
}

constexpr int CVT_TOTAL = 2 * (2960 + 512 + 256 + 16384 + 8192);
constexpr int CVT_G_FIRST = 932;
constexpr int CVT_G_L0 = 8008;
constexpr int CVT_G_ALL = CVT_TOTAL / 4;
__device__ __forceinline__ void cvt_trip(const Params& p, LAS float* tile, int tid, int g) {
    constexpr int TOTAL = CVT_TOTAL;
    float4 v[4][2];
    const int rr = tid >> 4, c4 = (tid & 15) * 4;
#pragma unroll
    for (int q = 0; q < 4; ++q) {
        const int it = g * 4 + q;
        const CvtTile t = cvt_decode(p, it < TOTAL ? it : TOTAL - 1);
        const int n = t.n0 + c4; const bool ok = n < t.Nsrc; const int nc = ok ? n : t.Nsrc - 4;
#pragma unroll
        for (int i = 0; i < 2; ++i) { const float4 x = *(const float4*)(t.src + (size_t)(t.k0 + rr + i * 32) * t.ld + nc); v[q][i] = ok ? x : make_float4(0.f, 0.f, 0.f, 0.f); }
    }
#pragma unroll
    for (int q = 0; q < 4; ++q)
#pragma unroll
        for (int i = 0; i < 2; ++i) { LAS float* tp = tile + q * 4160 + (rr + i * 32) * 65 + c4; tp[0] = v[q][i].x; tp[1] = v[q][i].y; tp[2] = v[q][i].z; tp[3] = v[q][i].w; }
    __syncthreads();
#pragma unroll
    for (int q = 0; q < 4; ++q) {
        const int it = g * 4 + q;
        if (it < TOTAL) {
            const CvtTile t = cvt_decode(p, it);
            const int nl = tid >> 3, kg = tid & 7, n = t.n0 + nl;
            float w[8];
#pragma unroll
            for (int j = 0; j < 8; ++j) w[j] = tile[q * 4160 + (kg * 8 + j) * 65 + nl];
            const int drow = t.mode == 1 ? w1_dst_row(n) : t.mode == 2 ? win_dst_row(n) : n;
            if (n < t.Nsrc) *(u32x4*)(t.dst + (size_t)drow * t.K + t.k0 + kg * 8) = pack8(w);
        }
    }
    __syncthreads();
}
__device__ __forceinline__ void cvt_fill(const Params& p, LAS unsigned char* lds, int w, int b1, int n1, int b2, int n2) {
    LAS float* tile = (LAS float*)lds; LAS int* tk = (LAS int*)(lds + 4 * 4160 * 4);
    int* const head = p.cnt + 256 + 32 * w;
    const int tid = opaque_tid();
    __syncthreads();
    int nxt = 0;
    if (tid == 0) nxt = atomicAdd(head, 1);
    for (;;) {
        if (tid == 0) tk[0] = nxt;
        __syncthreads();
        const int t = __builtin_amdgcn_readfirstlane(tk[0]);
        if (t >= n1 + n2) break;
        if (tid == 0) nxt = atomicAdd(head, 1);
        cvt_trip(p, tile, tid, t < n1 ? b1 + t : b2 + (t - n1));
    }
}
constexpr int CW_G1A = 932, CW_SEQ0A = 1932, CW_G2 = 4476, CW_G3 = 6476, CW_SEQ0B = 7076, CW_G1B = 8842, CW_SEQ1 = 9842;

__device__ __forceinline__ void ph_convert(const Params& p, LAS unsigned char* lds) {
    LAS float* tile = (LAS float*)lds;
    const int tid = opaque_tid();
    for (int idx = blockIdx.x * NTHREADS + tid; idx < 2 * 8 * 4 * 4096; idx += gridDim.x * NTHREADS) {
        const int i = idx & 63, j = (idx >> 6) & 63, mat = (idx >> 12) & 3, n = (idx >> 14) & 7, ll = idx >> 17, d = mat >> 1;
        p.lruT[idx] = (bf16_t)f2bf(((mat & 1) ? p.lru_wx : p.lru_wa)[(size_t)((ll * 2 + d) * 8 + n) * 4096 + i * 64 + j]);
    }
    for (int idx = blockIdx.x * NTHREADS + tid; idx < 2 * 2 * MW; idx += gridDim.x * NTHREADS) p.lsig[idx] = 8.0f * logsigmoidf_(p.lru_lambda[idx]);
    for (int idx = blockIdx.x * NTHREADS + tid; idx < TL * 64; idx += gridDim.x * NTHREADS) {
        const int t = idx >> 6, pi = idx & 63;
        const float pos = (pi < 32) ? (float)(t >> 6) : (float)(t & 63);
        const float ang = pos * exp2f(-(float)(pi & 31) * (13.287712379549449f / 32.0f));
        float sn, cs; sincosf(ang, &sn, &cs);
        p.rope[idx] = make_float2(cs, sn);
    }
    for (int idx = blockIdx.x * NTHREADS + tid; idx < 2 * 240 * (D / 8); idx += gridDim.x * NTHREADS) {
        const int ll = idx / (240 * (D / 8)), r = idx % (240 * (D / 8));
        *(u32x4*)(p.winT + ((size_t)ll * NPW + 7696) * D + (size_t)r * 8) = (u32x4){0u, 0u, 0u, 0u};
    }
    for (int g = blockIdx.x; g < CVT_G_FIRST; g += gridDim.x) cvt_trip(p, tile, tid, g);
}

__device__ __forceinline__ void ph_mod(const Params& p, LAS unsigned char* lds) {
    LAS float* sc = (LAS float*)lds;
    LAS float* red = sc + 5 * D;
    const int tid = opaque_tid(), wid = tid >> 6, lane = tid & 63;
    if ((int)blockIdx.x >= 192) return;
    for (int i = tid; i < 5 * D; i += NTHREADS) { const int r = i >> 10, k = i & 1023; const float v = r < 4 ? p.c[r * D + k] : p.c_ctx[k]; sc[i] = siluf_(v); }
    __syncthreads();
    for (int it = blockIdx.x; it < 192; it += gridDim.x) {
        const int l = it / 96, n0 = (it % 96) * 64;
        float acc[5] = {0.f, 0.f, 0.f, 0.f, 0.f};
        const float* wp = p.w_mod + (size_t)l * D * (NMOD * D) + n0 + lane;
        for (int k = wid * 128; k < wid * 128 + 128; ++k) {
            const float wv = wp[(size_t)k * (NMOD * D)];
#pragma unroll
            for (int r = 0; r < 5; ++r) acc[r] += sc[r * D + k] * wv;
        }
#pragma unroll
        for (int r = 0; r < 5; ++r) red[(wid * 5 + r) * 64 + lane] = acc[r];
        __syncthreads();
        if (tid < 320) { const int r = tid >> 6, cidx = tid & 63; float s = p.b_mod[l * NMOD * D + n0 + cidx];
#pragma unroll
            for (int w = 0; w < 8; ++w) s += red[(w * 5 + r) * 64 + cidx];
            p.mod[(size_t)(l * 5 + r) * (NMOD * D) + n0 + cidx] = s; }
        __syncthreads();
    }
}

__device__ __forceinline__ void norm_mod_store(const float4 (&v)[4], float rinv, const float* g, const float* scp, const float* shp, bf16_t* dst, int lane) {
#pragma unroll
    for (int i = 0; i < 4; ++i) {
        const int cidx = i * 256 + lane * 4;
        const float4 gv = *(const float4*)(g + cidx), sv = *(const float4*)(scp + cidx), hv = *(const float4*)(shp + cidx);
        const float h0 = v[i].x * rinv * gv.x * (1.f + sv.x) + hv.x, h1 = v[i].y * rinv * gv.y * (1.f + sv.y) + hv.y;
        const float h2 = v[i].z * rinv * gv.z * (1.f + sv.z) + hv.z, h3 = v[i].w * rinv * gv.w * (1.f + sv.w) + hv.w;
        u32x2 o; o[0] = pack2(h0, h1); o[1] = pack2(h2, h3);
        *(u32x2*)(dst + cidx) = o;
    }
}
__device__ __forceinline__ void ph_norm1_first(const Params& p) {
    const int tid = opaque_tid(), wid = tid >> 6, lane = tid & 63;
    for (int tok = blockIdx.x * NWAVES + wid; tok < NTOK; tok += gridDim.x * NWAVES) {
        const float* src = tok < NLAT ? p.x + (size_t)tok * D : p.ctx + (size_t)(tok - NLAT) * D;
        float4 v[4]; float ss = 0.f;
#pragma unroll
        for (int i = 0; i < 4; ++i) { v[i] = *(const float4*)(src + i * 256 + lane * 4); ss += v[i].x * v[i].x + v[i].y * v[i].y + v[i].z * v[i].z + v[i].w * v[i].w; }
        ss = wave_sum(ss, lane);
        const float rinv = rsqrtf(ss * (1.0f / D) + 1e-6f);
        const float* mb = p.mod + (size_t)(0 * 5 + tok_modrow(tok)) * (NMOD * D);
        norm_mod_store(v, rinv, p.norm1_g, mb + 1 * D, mb + 0 * D, p.H + (size_t)tok * D, lane);
#pragma unroll
        for (int i = 0; i < 4; ++i) *(float4*)(p.xl + (size_t)tok * D + i * 256 + lane * 4) = v[i];
    }
}

struct EpiP {
    bf16_t* O; bf16_t* gate;
    __device__ __forceinline__ bool keep(const g8::Unit&) const { return false; }
    __device__ __forceinline__ void operator()(const f32x4 (&acc)[2][2][4][2], const g8::Unit& u, int wr, int wc, int fr, int fq, const LAS float*) const {
        if (u.pn < 31) {
            const int row0 = u.pm * 256 + wr * 64 + fr, col0 = u.pn * 256 + wc * 32 + 8 * fq;
#pragma unroll
            for (int ai = 0; ai < 2; ++ai)
#pragma unroll
                for (int m = 0; m < 4; ++m) {
                    bf16_t* rowp = O + (size_t)(row0 + ai * 128 + m * 16) * NP + col0;
#pragma unroll
                    for (int bj = 0; bj < 2; ++bj) {
                        u32x4 w; w[0] = pack2(acc[ai][bj][m][0][0], acc[ai][bj][m][0][1]); w[1] = pack2(acc[ai][bj][m][0][2], acc[ai][bj][m][0][3]);
                        w[2] = pack2(acc[ai][bj][m][1][0], acc[ai][bj][m][1][1]); w[3] = pack2(acc[ai][bj][m][1][2], acc[ai][bj][m][1][3]);
                        *(u32x4*)(rowp + bj * 128) = w;
                    }
                }
        } else {
            const int t = u.pn - 31;
            const int wave2 = wr * 4 + (t & 1) * 2 + (wc >> 1), lane2 = ((wc & 1) * 2 + (fq >> 1)) * 16 + fr, bj2 = (t & 3) >> 1;
            bf16_t* gp = gate + ((((size_t)u.pm * 16 + (t >> 2)) * 8 + wave2) * 16 + bj2) * 512 + lane2 * 8 + (fq & 1) * 4;
#pragma unroll
            for (int ai = 0; ai < 2; ++ai)
#pragma unroll
                for (int m = 0; m < 4; ++m) {
                    float r[4][4];
#pragma unroll
                    for (int j = 0; j < 4; ++j) {
                        float d[4];
#pragma unroll
                        for (int sg = 0; sg < 4; ++sg) d[sg] = 1.0f + __expf(-fminf(fmaxf(acc[ai][sg >> 1][m][sg & 1][j], -30.0f), 30.0f));
#pragma unroll
                        for (int sg = 0; sg < 4; ++sg) { const float gi = __builtin_amdgcn_rcpf(d[sg]); r[sg][j] = sg < 3 ? gi * d[sg + 1] : gi; }
                    }
#pragma unroll
                    for (int sg = 0; sg < 4; ++sg) {
                        uint2 w; w.x = pack2(r[sg][0], r[sg][1]); w.y = pack2(r[sg][2], r[sg][3]);
                        *(uint2*)(gp + (size_t)sg * (4 * 8 * 16 * 512) + (ai * 8 + m * 2) * 512) = w;
                    }
                }
        }
    }
};
__device__ __forceinline__ void ph_g1(const Params& p, int l, LAS unsigned char* lds) {
    g8::PlainSched S; S.init(p.H, p.winT + (size_t)l * NPW * D, NTOK, NPW, D);
    EpiP E; E.O = p.P; E.gate = p.gate;
    g8::gemm_phase(lds, D, S, E);
    if ((int)blockIdx.x >= (NTOK / 256) * (NPW / 256) % 256) { if (l == 0) cvt_fill(p, lds, 2, CW_G1A, CW_SEQ0A - CW_G1A, 0, 0); else cvt_fill(p, lds, 3, CW_G1B, CW_SEQ1 - CW_G1B, 0, 0); }
}

__device__ __forceinline__ void ph_prep(const Params& p, int l, LAS unsigned char* lds) {
    const int tid = opaque_tid(), wid = tid >> 6, lane = tid & 63, fr = lane & 15, fq = lane >> 4;
    LAS float* xs = (LAS float*)lds;
    LAS bf16_t* xb = (LAS bf16_t*)(xs + 64 * 68);
    LAS bf16_t* wt = xb + 64 * 72;
    for (int it = blockIdx.x; it < (NTOK / 64) * 8; it += gridDim.x) {
        const int tile = it >> 3, n = it & 7, tok0 = tile * 64;
        {
            const int tl = tid & 63, cg = tid >> 6, tok = tok0 + tl;
            int t, T, base; tok_info(tok, t, T, base);
            float a[8];
            { const float4 b0 = *(const float4*)(p.lru_conv_b + l * MW + n * 64 + cg * 8), b1 = *(const float4*)(p.lru_conv_b + l * MW + n * 64 + cg * 8 + 4);
              a[0] = b0.x; a[1] = b0.y; a[2] = b0.z; a[3] = b0.w; a[4] = b1.x; a[5] = b1.y; a[6] = b1.z; a[7] = b1.w; }
#pragma unroll
            for (int j = 0; j < 4; ++j) {
                const int tt = t + j - 2;
                const float okf = (tt >= 0 && tt < T) ? 1.0f : 0.0f;
                const int ttc = tt < 0 ? 0 : (tt >= T ? T - 1 : tt);
                const u32x4 u = *(const u32x4*)(p.P + (size_t)(base + ttc) * NP + C_LX + n * 64 + cg * 8);
                const float* w = p.lru_conv_w + (size_t)(l * 4 + j) * MW + n * 64 + cg * 8;
                const float4 wa = *(const float4*)w, wb = *(const float4*)(w + 4);
                const float wv[8] = {wa.x * okf, wa.y * okf, wa.z * okf, wa.w * okf, wb.x * okf, wb.y * okf, wb.z * okf, wb.w * okf};
#pragma unroll
                for (int q = 0; q < 4; ++q) { a[2 * q] += wv[2 * q] * bflo(u[q]); a[2 * q + 1] += wv[2 * q + 1] * bfhi(u[q]); }
            }
            *(LAS f32x4*)(xs + tl * 68 + cg * 8) = (f32x4){a[0], a[1], a[2], a[3]}; *(LAS f32x4*)(xs + tl * 68 + cg * 8 + 4) = (f32x4){a[4], a[5], a[6], a[7]};
            *(LAS u32x4*)(xb + tl * 72 + cg * 8) = pack8(a);
            const bf16_t* wsrc = p.lruT + (size_t)((l * 8 + n) * 4) * 4096;
#pragma unroll
            for (int q = 0; q < 4; ++q) { const int e8 = tid + 512 * q, row = e8 >> 3, c8 = e8 & 7; *(LAS u32x4*)(wt + row * 72 + c8 * 8) = *(const u32x4*)(wsrc + (size_t)e8 * 8); }
        }
        __syncthreads();
        {
            const int jb = wid & 3, tb0 = (wid >> 2) * 2;
            bf16x8 xw[4][2];
#pragma unroll
            for (int m = 0; m < 4; ++m)
#pragma unroll
                for (int ks = 0; ks < 2; ++ks) xw[m][ks] = *(const LAS bf16x8*)(wt + (m * 64 + jb * 16 + fr) * 72 + ks * 32 + fq * 8);
            const int c0 = n * 64 + jb * 16 + 4 * fq;
            float4 bav[2], bxv[2], lsv[2];
#pragma unroll
            for (int d = 0; d < 2; ++d) {
                bav[d] = *(const float4*)(p.lru_ba + (l * 2 + d) * MW + c0); bxv[d] = *(const float4*)(p.lru_bx + (l * 2 + d) * MW + c0);
                lsv[d] = *(const float4*)(p.lsig + (l * 2 + d) * MW + c0);
            }
#pragma unroll
            for (int e = 0; e < 2; ++e) {
                const int tl = (tb0 + e) * 16 + fr, tok = tok0 + tl;
                f32x4 acc[4];
#pragma unroll
                for (int m = 0; m < 4; ++m) acc[m] = (f32x4){0.f, 0.f, 0.f, 0.f};
#pragma unroll
                for (int ks = 0; ks < 2; ++ks) {
                    const bf16x8 y = *(const LAS bf16x8*)(xb + tl * 72 + ks * 32 + fq * 8);
#pragma unroll
                    for (int m = 0; m < 4; ++m) acc[m] = mfma16(xw[m][ks], y, acc[m]);
                }
                const f32x4 xv = *(const LAS f32x4*)(xs + tl * 68 + jb * 16 + 4 * fq);
#pragma unroll
                for (int d = 0; d < 2; ++d) {
                    const float bar_[4] = {bav[d].x, bav[d].y, bav[d].z, bav[d].w}, bxr[4] = {bxv[d].x, bxv[d].y, bxv[d].z, bxv[d].w}, lsr[4] = {lsv[d].x, lsv[d].y, lsv[d].z, lsv[d].w};
                    float av[4], uv[4];
#pragma unroll
                    for (int r = 0; r < 4; ++r) {
                        const float gr = sigmoidf_(acc[d * 2][r] + bar_[r]), gi = sigmoidf_(acc[d * 2 + 1][r] + bxr[r]);
                        const float la = gr * lsr[r];
                        av[r] = __expf(la);
                        uv[r] = xv[r] * gi * __builtin_amdgcn_sqrtf(fmaxf(1.0f - __expf(2.0f * la), 1e-12f));
                    }
                    *(float4*)(p.prep + (PR_LA + d) * TOKW + (size_t)tok * MW + c0) = make_float4(av[0], av[1], av[2], av[3]);
                    *(float4*)(p.prep + (PR_LU + d) * TOKW + (size_t)tok * MW + c0) = make_float4(uv[0], uv[1], uv[2], uv[3]);
                }
            }
        }
        __syncthreads();
    }
}

__device__ __forceinline__ int chunk_base(int b, int d, int n) {
    if (n < 4) { const int blk = d ? 3 - n : n; return NLAT + b * TC + blk * 64; }
    const int m = n - 4, blk = d ? 63 - m : m; return b * TL + blk * 64;
}

__device__ __forceinline__ void local_gla(const Params& p, int l, int tz, int chain, int n, LAS unsigned char* lds) {
    const int tid = opaque_tid(), wid = tid >> 6, lane = tid & 63, fr = lane & 15, fq = lane >> 4;
    const int b = chain >> 3, h = (chain >> 1) & 3, d = chain & 1;
    const int base = chunk_base(b, d, n);
    const size_t item = (size_t)tz * NITEM + (size_t)chain * NCHUNK + n;
    LAS bf16_t* qh = (LAS bf16_t*)lds;
    LAS bf16_t* kh = qh + 64 * 136;
    LAS bf16_t* sc = kh + 10 * 16 * 136;
    LAS bf16_t* vT = sc + 64 * 72;
    LAS bf16_t* kT = vT + 128 * 72;
    LAS float* bc = (LAS float*)(kT + 128 * 72);
    const int vcol = tz == 1 ? C_HI : C_RQKV + 1024;
    const int ti = tid >> 3, dg = tid & 7, cA = dg * 8, cB = 64 + dg * 8;
    const int tokI = base + (d ? 63 - ti : ti);
    const bf16_t* pr = p.P + (size_t)tokI * NP;
    float qt[16], kv[16];
    {
        float lfv[16];
        if (tz == 1) {
            float lbv[16];
            {
                const float* lp0 = p.hgrn_lb + (size_t)(0 * 2 + d) * MW + h * 128; const float* lp1 = p.hgrn_lb + (size_t)(1 * 2 + d) * MW + h * 128;
                const float4 a0 = *(const float4*)(lp0 + cA), a1 = *(const float4*)(lp0 + cA + 4), a2 = *(const float4*)(lp0 + cB), a3 = *(const float4*)(lp0 + cB + 4);
                const float4 b0 = *(const float4*)(lp1 + cA), b1 = *(const float4*)(lp1 + cA + 4), b2 = *(const float4*)(lp1 + cB), b3 = *(const float4*)(lp1 + cB + 4);
                const float x0[16] = {a0.x, a0.y, a0.z, a0.w, a1.x, a1.y, a1.z, a1.w, a2.x, a2.y, a2.z, a2.w, a3.x, a3.y, a3.z, a3.w};
                const float x1[16] = {b0.x, b0.y, b0.z, b0.w, b1.x, b1.y, b1.z, b1.w, b2.x, b2.y, b2.z, b2.w, b3.x, b3.y, b3.z, b3.w};
#pragma unroll
                for (int e = 0; e < 16; ++e) lbv[e] = (l == 1) ? fminf(__builtin_amdgcn_rcpf(1.0f + __expf(x0[e] - x1[e])), 1.0f - 1e-4f) : 0.f;
            }
            const u32x4 uqa = *(const u32x4*)(pr + C_HQ + h * 128 + cA), uqb = *(const u32x4*)(pr + C_HQ + h * 128 + cB);
            const u32x4 uza = *(const u32x4*)(pr + C_HF + d * 512 + h * 128 + cA), uzb = *(const u32x4*)(pr + C_HF + d * 512 + h * 128 + cB);
#pragma unroll
            for (int e = 0; e < 16; ++e) {
                const unsigned uq = e < 8 ? uqa[(e & 7) >> 1] : uqb[(e & 7) >> 1], uz = e < 8 ? uza[(e & 7) >> 1] : uzb[(e & 7) >> 1];
                const float qraw = (e & 1) ? bfhi(uq) : bflo(uq), z = (e & 1) ? bfhi(uz) : bflo(uz);
                const float lb = lbv[e];
                const float sg = sigmoidf_(z);
                qt[e] = siluf_(qraw) * 0.08838834764831845f;
                kv[e] = (1.f - lb) * (1.f - sg);
                lfv[e] = __logf(fmaxf(lb + (1.f - lb) * sg, 1e-30f));
            }
        }
        *(LAS f32x4*)(bc + ti * 132 + cA) = (f32x4){lfv[0], lfv[1], lfv[2], lfv[3]}; *(LAS f32x4*)(bc + ti * 132 + cA + 4) = (f32x4){lfv[4], lfv[5], lfv[6], lfv[7]};
        *(LAS f32x4*)(bc + ti * 132 + cB) = (f32x4){lfv[8], lfv[9], lfv[10], lfv[11]}; *(LAS f32x4*)(bc + ti * 132 + cB + 4) = (f32x4){lfv[12], lfv[13], lfv[14], lfv[15]};
        const bf16_t* vp = pr + vcol + h * 128;
        const u32x4 v0 = *(const u32x4*)(vp + cA), v1 = *(const u32x4*)(vp + cB);
#pragma unroll
        for (int e = 0; e < 8; ++e) {
            vT[(cA + e) * 72 + ti] = (bf16_t)((e & 1) ? (v0[e >> 1] >> 16) : (v0[e >> 1] & 0xffffu));
            vT[(cB + e) * 72 + ti] = (bf16_t)((e & 1) ? (v1[e >> 1] >> 16) : (v1[e >> 1] & 0xffffu));
        }
    }
    __syncthreads();
    if (tid < 128) {
        float run = 0.f, lv[64];
#pragma unroll
        for (int i = 0; i < 64; ++i) lv[i] = bc[i * 132 + tid];
#pragma unroll
        for (int i = 0; i < 64; ++i) { run += lv[i]; bc[i * 132 + tid] = run; }
    }
    __syncthreads();
    {
        const int J = ti >> 4;
        float qhat[16];
#pragma unroll
        for (int e = 0; e < 16; ++e) {
            const int ch = e < 8 ? cA + e : cB + e - 8;
            const float bi = bc[ti * 132 + ch], rJ = J ? bc[(16 * J - 1) * 132 + ch] : 0.f, bl = bc[63 * 132 + ch];
            qhat[e] = qt[e] * __expf(bi - rJ); qt[e] = qt[e] * __expf(bi);
            kT[ch * 72 + ti] = (bf16_t)f2bf(kv[e] * __expf(bl - bi));
        }
        *(LAS u32x4*)(qh + ti * 136 + cA) = pack8(qhat); *(LAS u32x4*)(qh + ti * 136 + cB) = pack8(qhat + 8);
#pragma unroll
        for (int I = 0; I < 4; ++I) {
            if (I >= J) {
                float kk[16];
#pragma unroll
                for (int e = 0; e < 16; ++e) {
                    const int ch = e < 8 ? cA + e : cB + e - 8;
                    const float rI = I ? bc[(16 * I - 1) * 132 + ch] : 0.f, bj = bc[ti * 132 + ch];
                    kk[e] = kv[e] * __expf(fminf(rI - bj, 80.f));
                }
                LAS bf16_t* kp = kh + ((I * (I + 1) / 2 + J) * 16 + (ti & 15)) * 136;
                *(LAS u32x4*)(kp + cA) = pack8(kk); *(LAS u32x4*)(kp + cB) = pack8(kk + 8);
            }
        }
        *(LAS u32x4*)(sc + ti * 72 + dg * 8) = (u32x4){0u, 0u, 0u, 0u};
        {
            bf16_t* lqb = p.lq + item * 8192 + (size_t)((ti >> 4) * 8) * 256 + (ti & 15) * 4;
            const u32x4 pa = pack8(qt), pb = pack8(qt + 8);
            u32x2 t0; t0[0] = pa[0]; t0[1] = pa[1]; u32x2 t1; t1[0] = pa[2]; t1[1] = pa[3]; u32x2 t2; t2[0] = pb[0]; t2[1] = pb[1]; u32x2 t3; t3[0] = pb[2]; t3[1] = pb[3];
            *(u32x2*)(lqb + (dg >> 1) * 256 + ((dg & 1) * 2 + 0) * 64) = t0; *(u32x2*)(lqb + (dg >> 1) * 256 + ((dg & 1) * 2 + 1) * 64) = t1;
            *(u32x2*)(lqb + (4 + (dg >> 1)) * 256 + ((dg & 1) * 2 + 0) * 64) = t2; *(u32x2*)(lqb + (4 + (dg >> 1)) * 256 + ((dg & 1) * 2 + 1) * 64) = t3;
        }
    }
    if (tid < 128) p.ld[item * 128 + tid] = __expf(bc[63 * 132 + tid]);
    __syncthreads();
#pragma unroll
    for (int rep2 = 0; rep2 < 2; ++rep2) {
        const int t = wid + 8 * rep2;
        if (t < 10) {
            const int I = t >= 6 ? 3 : t >= 3 ? 2 : t >= 1 ? 1 : 0, J = t - I * (I + 1) / 2;
            f32x4 acc = (f32x4){0.f, 0.f, 0.f, 0.f};
#pragma unroll
            for (int ks = 0; ks < 4; ++ks)
                acc = mfma16(*(const LAS bf16x8*)(kh + (t * 16 + fr) * 136 + ks * 32 + fq * 8), *(const LAS bf16x8*)(qh + (I * 16 + fr) * 136 + ks * 32 + fq * 8), acc);
            const int i = 16 * I + fr, j0 = 16 * J + 4 * fq;
#pragma unroll
            for (int r = 0; r < 4; ++r) if (j0 + r > i) acc[r] = 0.f;
            *(LAS u32x2*)(sc + i * 72 + j0) = pack4(acc);
        }
    }
    __syncthreads();
    {
        bf16x8 xv[2], xk[2];
#pragma unroll
        for (int ks = 0; ks < 2; ++ks) { xv[ks] = *(const LAS bf16x8*)(vT + (wid * 16 + fr) * 72 + ks * 32 + fq * 8); xk[ks] = *(const LAS bf16x8*)(kT + (wid * 16 + fr) * 72 + ks * 32 + fq * 8); }
#pragma unroll
        for (int ib = 0; ib < 4; ++ib) {
            f32x4 acc = (f32x4){0.f, 0.f, 0.f, 0.f};
#pragma unroll
            for (int ks = 0; ks < 2; ++ks) acc = mfma16(xv[ks], *(const LAS bf16x8*)(sc + (ib * 16 + fr) * 72 + ks * 32 + fq * 8), acc);
            *(u32x2*)(p.lo + item * 8192 + ((wid * 4 + ib) * 64 + lane) * 4) = pack4(acc);
        }
#pragma unroll
        for (int dvb = 0; dvb < 8; ++dvb) {
            f32x4 acc = (f32x4){0.f, 0.f, 0.f, 0.f};
#pragma unroll
            for (int ks = 0; ks < 2; ++ks) acc = mfma16(xk[ks], *(const LAS bf16x8*)(vT + (dvb * 16 + fr) * 72 + ks * 32 + fq * 8), acc);
            *(u32x2*)(p.lb + item * 16384 + ((wid * 8 + dvb) * 64 + lane) * 4) = pack4(acc);
        }
    }
    __syncthreads();
}


template <int MODE> __device__ __forceinline__ void local_ret(const Params& p, int l, int chain, int n, LAS unsigned char* lds) {
    const int tid = opaque_tid(), wid = tid >> 6, lane = tid & 63, fr = lane & 15, fq = lane >> 4;
    const int b = chain >> 3, h = (chain >> 1) & 3, d = chain & 1;
    const int base = chunk_base(b, d, n);
    const size_t item = (size_t)2 * NITEM + (size_t)chain * NCHUNK + n;
    LAS bf16_t* ks_ = (LAS bf16_t*)lds;
    LAS bf16_t* qs = ks_ + 64 * 136;
    LAS bf16_t* sc = qs + 64 * 136;
    LAS bf16_t* vT = sc + 64 * 72;
    LAS bf16_t* kT = vT + 128 * 72;
    const int ti = tid >> 3, dg = tid & 7, cA = dg * 8, cB = 64 + dg * 8;
    const int tokI = base + (d ? 63 - ti : ti);
    const bf16_t* pr = p.P + (size_t)tokI * NP + C_RQKV + h * 128;
    const float lng = ret_log_gamma(h);
    {
        const u32x4 q1 = *(const u32x4*)(pr + cA), q2 = *(const u32x4*)(pr + cB), k1 = *(const u32x4*)(pr + 512 + cA), k2 = *(const u32x4*)(pr + 512 + cB);
        const u32x4 v0 = *(const u32x4*)(pr + 1024 + cA), v1 = *(const u32x4*)(pr + 1024 + cB);
        const bool lat = tokI < NLAT;
        const int t = tokI & (TL - 1);
        float qv[16], kv[16];
#pragma unroll
        for (int e = 0; e < 8; ++e) {
            float a1 = (e & 1) ? bfhi(q1[e >> 1]) : bflo(q1[e >> 1]), a2 = (e & 1) ? bfhi(q2[e >> 1]) : bflo(q2[e >> 1]);
            float b1 = (e & 1) ? bfhi(k1[e >> 1]) : bflo(k1[e >> 1]), b2 = (e & 1) ? bfhi(k2[e >> 1]) : bflo(k2[e >> 1]);
            {
                const float2 cst = p.rope[(size_t)t * 64 + cA + e];
                const float cs = lat ? cst.x : 1.0f, sn = lat ? cst.y : 0.0f;
                const float n1 = a1 * cs - a2 * sn, n2 = a1 * sn + a2 * cs, m1 = b1 * cs - b2 * sn, m2 = b1 * sn + b2 * cs;
                a1 = n1; a2 = n2; b1 = m1; b2 = m2;
            }
            qv[e] = a1; qv[8 + e] = a2; kv[e] = b1 * 0.08838834764831845f; kv[8 + e] = b2 * 0.08838834764831845f;
        }
        *(LAS u32x4*)(ks_ + ti * 136 + cA) = pack8(kv); *(LAS u32x4*)(ks_ + ti * 136 + cB) = pack8(kv + 8);
        *(LAS u32x4*)(qs + ti * 136 + cA) = pack8(qv); *(LAS u32x4*)(qs + ti * 136 + cB) = pack8(qv + 8);
        const float gq = __expf((float)(ti + 1) * lng), gk = __expf((float)(63 - ti) * lng);
#pragma unroll
        for (int e = 0; e < 8; ++e) {
            vT[(cA + e) * 72 + ti] = (bf16_t)((e & 1) ? (v0[e >> 1] >> 16) : (v0[e >> 1] & 0xffffu));
            vT[(cB + e) * 72 + ti] = (bf16_t)((e & 1) ? (v1[e >> 1] >> 16) : (v1[e >> 1] & 0xffffu));
            kT[(cA + e) * 72 + ti] = (bf16_t)f2bf(kv[e] * gk); kT[(cB + e) * 72 + ti] = (bf16_t)f2bf(kv[8 + e] * gk);
            qv[e] *= gq; qv[8 + e] *= gq;
        }
        {
            bf16_t* lqb = p.lq + item * 8192 + (size_t)((ti >> 4) * 8) * 256 + (ti & 15) * 4;
            const u32x4 pa = pack8(qv), pb = pack8(qv + 8);
            u32x2 t0; t0[0] = pa[0]; t0[1] = pa[1]; u32x2 t1; t1[0] = pa[2]; t1[1] = pa[3]; u32x2 t2; t2[0] = pb[0]; t2[1] = pb[1]; u32x2 t3; t3[0] = pb[2]; t3[1] = pb[3];
            *(u32x2*)(lqb + (dg >> 1) * 256 + ((dg & 1) * 2 + 0) * 64) = t0; *(u32x2*)(lqb + (dg >> 1) * 256 + ((dg & 1) * 2 + 1) * 64) = t1;
            *(u32x2*)(lqb + (4 + (dg >> 1)) * 256 + ((dg & 1) * 2 + 0) * 64) = t2; *(u32x2*)(lqb + (4 + (dg >> 1)) * 256 + ((dg & 1) * 2 + 1) * 64) = t3;
        }
    }
    if (tid < 128) p.ld[item * 128 + tid] = __expf(64.0f * lng);
    __syncthreads();
#pragma unroll
    for (int e = 0; e < 2; ++e) {
        const int f = wid * 2 + e, ib = f >> 2, jb = f & 3;
        const int i = 16 * ib + fr, j0 = 16 * jb + 4 * fq;
        f32x4 mq = (f32x4){0.f, 0.f, 0.f, 0.f};
        if (jb <= ib) {
#pragma unroll
            for (int ks = 0; ks < 4; ++ks)
                mq = mfma16(*(const LAS bf16x8*)(ks_ + (jb * 16 + fr) * 136 + ks * 32 + fq * 8), *(const LAS bf16x8*)(qs + i * 136 + ks * 32 + fq * 8), mq);
#pragma unroll
            for (int r = 0; r < 4; ++r) { const int j = j0 + r; mq[r] = (j <= i) ? mq[r] * __expf((float)(i - j) * lng) : 0.f; }
        }
        *(LAS u32x2*)(sc + i * 72 + j0) = pack4(mq);
    }
    __syncthreads();
    {
        bf16x8 xv[2], xk[2];
#pragma unroll
        for (int ks = 0; ks < 2; ++ks) { xv[ks] = *(const LAS bf16x8*)(vT + (wid * 16 + fr) * 72 + ks * 32 + fq * 8); xk[ks] = *(const LAS bf16x8*)(kT + (wid * 16 + fr) * 72 + ks * 32 + fq * 8); }
#pragma unroll
        for (int ib = 0; ib < 4; ++ib) {
            f32x4 acc = (f32x4){0.f, 0.f, 0.f, 0.f};
#pragma unroll
            for (int ks = 0; ks < 2; ++ks) acc = mfma16(xv[ks], *(const LAS bf16x8*)(sc + (ib * 16 + fr) * 72 + ks * 32 + fq * 8), acc);
            *(u32x2*)(p.lo + item * 8192 + ((wid * 4 + ib) * 64 + lane) * 4) = pack4(acc);
        }
#pragma unroll
        for (int dvb = 0; dvb < 8; ++dvb) {
            f32x4 acc = (f32x4){0.f, 0.f, 0.f, 0.f};
#pragma unroll
            for (int ks = 0; ks < 2; ++ks) acc = mfma16(xk[ks], *(const LAS bf16x8*)(vT + (dvb * 16 + fr) * 72 + ks * 32 + fq * 8), acc);
            *(u32x2*)(p.lb + item * 16384 + ((wid * 8 + dvb) * 64 + lane) * 4) = pack4(acc);
        }
    }
    __syncthreads();
}

__device__ __forceinline__ void local_gdn(const Params& p, int l, int bh, int seg, int blk, LAS unsigned char* lds) {
    const int tid = opaque_tid(), wid = tid >> 6, lane = tid & 63, fr = lane & 15, fq = lane >> 4;
    const int b = bh >> 2, h = bh & 3;
    const int base = seg ? b * TL + blk * 64 : NLAT + b * TC + blk * 64;
    LAS bf16_t* ks_ = (LAS bf16_t*)lds;
    LAS bf16_t* qs = ks_ + 64 * 136;
    LAS bf16_t* att = qs + 64 * 136;
    LAS bf16_t* wT = att + 64 * 72;
    LAS bf16_t* uT = wT + 128 * 72;
    LAS bf16_t* kT = uT + 128 * 72;
    LAS bf16_t* tT = kT;
    LAS bf16_t* Mneg = kT + 128 * 72;
    LAS float* Md = (LAS float*)(Mneg + 64 * 72);
    LAS float* bcs = (LAS float*)(kT + 128 * 72) + 64 * 68;
    LAS float* bts = bcs + 64;
    LAS float* rse = bts + 64;
    LAS bf16_t* vs = (LAS bf16_t*)(rse + 64);
    LAS bf16_t* Db = (LAS bf16_t*)(vs + 64 * 136);
    LAS float* cw = (LAS float*)(vs + 64 * 136);
    const int ti = tid >> 3, d0 = (tid & 7) * 16;
    const int tokI = base + ti;
    {
        int t, T, sbase; tok_info(tokI, t, T, sbase);
        u32x4 xr[3][4][2];
#pragma unroll
        for (int j = 0; j < 4; ++j) {
            const int tt = t + j - 2;
            const bool ok = (tt >= 0 && tt < T);
            const int ttc = tt < 0 ? 0 : (tt >= T ? T - 1 : tt);
            const bf16_t* xp = p.P + (size_t)(sbase + ttc) * NP + C_GQKV + h * 128 + d0;
#pragma unroll
            for (int part = 0; part < 3; ++part) {
                const u32x4 a0 = *(const u32x4*)(xp + part * 512), a1 = *(const u32x4*)(xp + part * 512 + 8);
#pragma unroll
                for (int q = 0; q < 4; ++q) { xr[part][j][0][q] = ok ? a0[q] : 0u; xr[part][j][1][q] = ok ? a1[q] : 0u; }
            }
        }
        if (tid < 384) {
            const int row = tid >> 5, c4 = (tid & 31) * 4, part = row >> 2, j = row & 3;
            *(LAS f32x4*)(cw + row * 128 + c4) = *(const f32x4*)(p.gdn_conv_w + (size_t)(l * 4 + j) * 1536 + part * 512 + h * 128 + c4);
        }
        __syncthreads();
#pragma unroll
        for (int part = 0; part < 3; ++part) {
            float a[16];
#pragma unroll
            for (int e = 0; e < 16; ++e) a[e] = 0.f;
#pragma unroll
            for (int j = 0; j < 4; ++j) {
                const u32x4 x0 = xr[part][j][0], x1 = xr[part][j][1];
                const LAS float* wp = cw + (part * 4 + j) * 128 + d0;
#pragma unroll
                for (int q = 0; q < 4; ++q) {
                    const f32x4 w0 = *(const LAS f32x4*)(wp + q * 4);
                    const unsigned ua = q < 2 ? x0[2 * q] : x1[2 * q - 4], ub = q < 2 ? x0[2 * q + 1] : x1[2 * q - 3];
                    a[q * 4] += w0[0] * bflo(ua); a[q * 4 + 1] += w0[1] * bfhi(ua); a[q * 4 + 2] += w0[2] * bflo(ub); a[q * 4 + 3] += w0[3] * bfhi(ub);
                }
            }
            float ss = 0.f;
#pragma unroll
            for (int e = 0; e < 16; ++e) { a[e] = siluf_(a[e]); ss += a[e] * a[e]; }
            if (part < 2) {
                ss += shx(ss, 1, lane); ss += shx(ss, 2, lane); ss += shx(ss, 4, lane);
                const float scl = rsqrtf(ss + 1e-6f) * (part == 0 ? 0.08838834764831845f : 1.0f);
#pragma unroll
                for (int e = 0; e < 16; ++e) a[e] *= scl;
            }
            LAS bf16_t* dstt = (part == 0 ? qs : part == 1 ? ks_ : vs) + ti * 136 + d0;
            *(LAS u32x4*)dstt = pack8(a); *(LAS u32x4*)(dstt + 8) = pack8(a + 8);
        }
    }
#pragma unroll 1
  for (int d = 0; d < 2; ++d) {
    const int n = seg ? 4 + (d ? 63 - blk : blk) : (d ? 3 - blk : blk);
    const size_t item = (size_t)(bh * 2 + d) * NCHUNK + n;
#define RR(x) (d ? 63 - (x) : (x))
    const int tid = opaque_tid(), wid = tid >> 6, lane = tid & 63, fr = lane & 15, fq = lane >> 4, ti = tid >> 3, d0 = (tid & 7) * 16;
    if (wid == 0) {
        const int tok = base + RR(lane);
        const float av = bf2f(p.P[(size_t)tok * NP + C_GA + d * 4 + h]);
        float v = -__expf(p.gdn_a_log[l * 8 + d * 4 + h]) * softplusf_(av + p.gdn_dt_bias[l * 8 + d * 4 + h]);
#pragma unroll
        for (int off = 1; off < 64; off <<= 1) { const float t = shup(v, off, lane); if (lane >= off) v += t; }
        const float btv = sigmoidf_(bf2f(p.P[(size_t)tok * NP + C_GB + d * 4 + h]));
        bcs[lane] = v; bts[lane] = btv; rse[lane] = btv * __expf(v);
    }
    __syncthreads();
#pragma unroll
    for (int e = 0; e < 2; ++e) {
        const int f = wid * 2 + e, ib = f >> 2, jb = f & 3;
        const int i = 16 * ib + fr, j0 = 16 * jb + 4 * fq;
        f32x4 mk = (f32x4){0.f, 0.f, 0.f, 0.f}, mq = (f32x4){0.f, 0.f, 0.f, 0.f};
        if (jb <= ib) {
#pragma unroll
            for (int ks = 0; ks < 4; ++ks) {
                const bf16x8 xk = *(const LAS bf16x8*)(ks_ + RR(jb * 16 + fr) * 136 + ks * 32 + fq * 8);
                mk = mfma16(xk, *(const LAS bf16x8*)(ks_ + RR(ib * 16 + fr) * 136 + ks * 32 + fq * 8), mk);
                mq = mfma16(xk, *(const LAS bf16x8*)(qs + RR(ib * 16 + fr) * 136 + ks * 32 + fq * 8), mq);
            }
            const float bi = bcs[i], bti = bts[i];
#pragma unroll
            for (int r = 0; r < 4; ++r) {
                const int j = j0 + r;
                const float dec = __expf(j <= i ? bi - bcs[j] : 0.f);
                mk[r] = (j < i) ? bti * mk[r] * dec : 0.f;
                mq[r] = (j <= i) ? mq[r] * dec : 0.f;
            }
        }
        {
            u32x2 mn; mn[0] = 0u; mn[1] = 0u;
            if (jb < ib) mn = pack4((f32x4){-mk[0], -mk[1], -mk[2], -mk[3]});
            *(LAS u32x2*)(Mneg + i * 72 + j0) = mn;
            if (jb == ib) *(LAS f32x4*)(Md + (ib * 16 + fr) * 20 + 4 * fq) = mk;
        }
        *(LAS u32x2*)(att + i * 72 + j0) = pack4(mq);
        if (e == 0) {
            const int zr = tid >> 1, zh = tid & 1;
            LAS bf16_t* zx = (zr < 128 ? uT + zr * 72 : wT + (zr - 128) * 72) + zh * 32;
#pragma unroll
            for (int q = 0; q < 4; ++q) *(LAS u32x4*)(zx + q * 8) = (u32x4){0u, 0u, 0u, 0u};
            *(LAS u32x4*)(tT + zr * 32 + 16 + zh * 8) = (u32x4){0u, 0u, 0u, 0u};
        }
    }
    __syncthreads();
    if (wid == 0) {
        const int R = lane >> 4, cc = lane & 15;
        float y[16];
#pragma unroll
        for (int i = 0; i < 16; ++i) {
            float acc = (i == cc) ? 1.0f : 0.0f;
#pragma unroll
            for (int j4 = 0; j4 < (i + 3) / 4; ++j4) {
                const f32x4 m = *(const LAS f32x4*)(Md + (R * 16 + i) * 20 + j4 * 4);
#pragma unroll
                for (int q = 0; q < 4; ++q) if (j4 * 4 + q < i) acc -= m[q] * y[j4 * 4 + q];
            }
            y[i] = acc;
            Db[(R * 16 + i) * 40 + cc] = (bf16_t)f2bf(acc);
        }
        *(LAS u32x4*)(Db + lane * 40 + 16) = (u32x4){0u, 0u, 0u, 0u}; *(LAS u32x4*)(Db + lane * 40 + 24) = (u32x4){0u, 0u, 0u, 0u};
    }
    __syncthreads();
#pragma unroll
    for (int R = 0; R < 4; ++R) {
        f32x4 tacc[2];
#pragma unroll
        for (int e = 0; e < 2; ++e) {
            const int cb = wid * 2 + e;
            const int i = 16 * R + fr;
            const u32x2 rv = *(const LAS u32x2*)((cb < 8 ? vs + cb * 16 : ks_ + (cb - 8) * 16) + RR(i) * 136 + 4 * fq);
            const float sc = cb < 8 ? bts[i] : -rse[i];
            f32x4 acc = (f32x4){bflo(rv[0]) * sc, bfhi(rv[0]) * sc, bflo(rv[1]) * sc, bfhi(rv[1]) * sc};
            if (R > 0) {
                const LAS bf16_t* xt = (cb < 8 ? uT + cb * 16 * 72 : wT + (cb - 8) * 16 * 72) + fr * 72 + fq * 8;
#pragma unroll
                for (int ks = 0; ks < (R + 1) / 2; ++ks) acc = mfma16(*(const LAS bf16x8*)(xt + ks * 32), *(const LAS bf16x8*)(Mneg + i * 72 + ks * 32 + fq * 8), acc);
            }
            tacc[e] = acc;
            LAS bf16_t* tp = tT + (cb * 16 + 4 * fq) * 32 + fr;
            tp[0] = (bf16_t)f2bf(acc[0]); tp[32] = (bf16_t)f2bf(acc[1]); tp[64] = (bf16_t)f2bf(acc[2]); tp[96] = (bf16_t)f2bf(acc[3]);
        }
        __syncthreads();
#pragma unroll
        for (int e = 0; e < 2; ++e) {
            const int cb = wid * 2 + e;
            f32x4 acc = (f32x4){0.f, 0.f, 0.f, 0.f};
            acc = mfma16(*(const LAS bf16x8*)(tT + (cb * 16 + fr) * 32 + fq * 8), *(const LAS bf16x8*)(Db + (R * 16 + fr) * 40 + fq * 8), acc);
            LAS bf16_t* xp = (cb < 8 ? uT + cb * 16 * 72 : wT + (cb - 8) * 16 * 72) + (4 * fq) * 72 + 16 * R + fr;
            xp[0] = (bf16_t)f2bf(acc[0]); xp[72] = (bf16_t)f2bf(acc[1]); xp[144] = (bf16_t)f2bf(acc[2]); xp[216] = (bf16_t)f2bf(acc[3]);
        }
        __syncthreads();
    }
    {
        const int pi = RR(ti);
        const float sc_ = __expf(bcs[63] - bcs[pi]);
#pragma unroll
        for (int e = 0; e < 16; ++e) kT[(d0 + e) * 72 + pi] = (bf16_t)f2bf(bf2f(ks_[ti * 136 + d0 + e]) * sc_);
    }
    if (tid < 128) p.ld[item * 128 + tid] = __expf(bcs[63]);
    __syncthreads();
    {
        const int tid = opaque_tid(), wid = tid >> 6, lane = tid & 63, fr = lane & 15, fq = lane >> 4;
        bf16x8 xw[2], xu[2], xk[2];
#pragma unroll
        for (int ks = 0; ks < 2; ++ks) {
            xw[ks] = *(const LAS bf16x8*)(wT + (wid * 16 + fr) * 72 + ks * 32 + fq * 8);
            xu[ks] = *(const LAS bf16x8*)(uT + (wid * 16 + fr) * 72 + ks * 32 + fq * 8);
            xk[ks] = *(const LAS bf16x8*)(kT + (wid * 16 + fr) * 72 + ks * 32 + fq * 8);
        }
#pragma unroll
        for (int ib = 0; ib < 4; ++ib) {
            const int i = ib * 16 + fr;
            const u32x2 qr = *(const LAS u32x2*)(qs + RR(i) * 136 + wid * 16 + 4 * fq);
            const float eb = __expf(bcs[i]);
            f32x4 aq = (f32x4){bflo(qr[0]) * eb, bfhi(qr[0]) * eb, bflo(qr[1]) * eb, bfhi(qr[1]) * eb};
            f32x4 ao = (f32x4){0.f, 0.f, 0.f, 0.f};
#pragma unroll
            for (int ks = 0; ks < 2; ++ks) {
                const bf16x8 ya = *(const LAS bf16x8*)(att + i * 72 + ks * 32 + fq * 8);
                aq = mfma16(xw[ks], ya, aq); ao = mfma16(xu[ks], ya, ao);
            }
            *(u32x2*)(p.lq + item * 8192 + ((ib * 8 + wid) * 64 + lane) * 4) = pack4(aq);
            *(u32x2*)(p.lo + item * 8192 + ((wid * 4 + ib) * 64 + lane) * 4) = pack4(ao);
        }
#pragma unroll
        for (int db = 0; db < 8; ++db) {
            f32x4 aa = (f32x4){0.f, 0.f, 0.f, 0.f}, ab = (f32x4){0.f, 0.f, 0.f, 0.f};
#pragma unroll
            for (int ks = 0; ks < 2; ++ks) {
                aa = mfma16(xw[ks], *(const LAS bf16x8*)(kT + (db * 16 + fr) * 72 + ks * 32 + fq * 8), aa);
                ab = mfma16(xk[ks], *(const LAS bf16x8*)(uT + (db * 16 + fr) * 72 + ks * 32 + fq * 8), ab);
            }
            *(u32x2*)(p.la + item * 16384 + ((db * 8 + wid) * 64 + lane) * 4) = pack4(aa);
            *(u32x2*)(p.lb + item * 16384 + ((wid * 8 + db) * 64 + lane) * 4) = pack4(ab);
        }
    }
    __syncthreads();
  }
#undef RR
}

__device__ __forceinline__ void ph_local(const Params& p, int l, LAS unsigned char* lds) {
    constexpr int NG = NITEM / 2;
    for (int it = blockIdx.x; it < NG + 2 * NITEM; it += gridDim.x) {
        if (it < NG) { const int bh = it / NCHUNK, c = it % NCHUNK; local_gdn(p, l, bh, c >= 4, c >= 4 ? c - 4 : c, lds); }
        else if (it < NG + NITEM) { const int idx = it - NG; local_gla(p, l, 1, idx / NCHUNK, idx % NCHUNK, lds); }
        else { const int idx = it - NG - NITEM; local_ret<0>(p, l, idx / NCHUNK, idx % NCHUNK, lds); }
    }
}

__device__ __forceinline__ void seq_matrix(const Params& p, int tz, int chain, int half, LAS unsigned char* lds) {
    const int tid = opaque_tid(), wid = tid >> 6, lane = tid & 63, fr = lane & 15, fq = lane >> 4;
    const int b = chain >> 3, h = (chain >> 1) & 3, d = chain & 1;
    LAS bf16_t* ST = (LAS bf16_t*)lds;
    bf16_t* Op = p.O + (size_t)((tz == 0 ? 0 : tz == 1 ? 1 : 3) * 2 + d) * TOKW;
    f32x4 S[4];
#pragma unroll
    for (int q = 0; q < 4; ++q) S[q] = (f32x4){0.f, 0.f, 0.f, 0.f};
    const int ib = wid >> 1, dv2 = (wid & 1) * 2;
    struct Ops { u32x2 yq[8], xa[8], oin[2], bin[4]; f32x4 dec; };
    auto load_ops = [&](int n, Ops& o) {
        const size_t item = (size_t)tz * NITEM + (size_t)chain * NCHUNK + n;
        const bf16_t* lqp = p.lq + item * 8192 + (size_t)(ib * 8) * 256 + lane * 4;
#pragma unroll
        for (int q = 0; q < 8; ++q) o.yq[q] = *(const u32x2*)(lqp + q * 256);
        if (tz == 0) {
            const bf16_t* lap = p.la + ((size_t)chain * NCHUNK + n) * 16384 + (size_t)(wid * 8) * 256 + lane * 4;
#pragma unroll
            for (int q = 0; q < 8; ++q) o.xa[q] = *(const u32x2*)(lap + q * 256);
        }
#pragma unroll
        for (int e2 = 0; e2 < 2; ++e2)
            o.oin[e2] = *(const u32x2*)(p.lo + item * 8192 + (((half * 4 + dv2 + (fq >> 1)) * 4 + ib) * 64 + fr + 16 * (2 * (fq & 1) + e2)) * 4);
#pragma unroll
        for (int q = 0; q < 4; ++q) o.bin[q] = *(const u32x2*)(p.lb + item * 16384 + ((wid * 8 + half * 4 + q) * 64 + lane) * 4);
        o.dec = *(const f32x4*)(p.ld + item * 128 + wid * 16 + 4 * fq);
    };
    Ops s0, s1; load_ops(0, s0);
    auto step = [&](int n, Ops& cur, Ops& fill) {
        load_ops(n + 1 < NCHUNK ? n + 1 : n, fill);
        LAS bf16_t* st = ST + (n & 1) * 64 * 136;
#pragma unroll
        for (int q = 0; q < 4; ++q) *(LAS u32x2*)(st + (q * 16 + fr) * 136 + 32 * (wid >> 1) + 8 * fq + 4 * (wid & 1)) = pack4(S[q]);
        __syncthreads();
        const int base = chunk_base(b, d, n);
        const int tok = base + (d ? 63 - (ib * 16 + fr) : ib * 16 + fr);
        {
            bf16x8 xo[2][4];
#pragma unroll
            for (int e2 = 0; e2 < 2; ++e2) {
                const int prow = dv2 * 16 + 8 * (fr >> 2) + 4 * e2 + (fr & 3);
#pragma unroll
                for (int ks = 0; ks < 4; ++ks) xo[e2][ks] = *(const LAS bf16x8*)(st + prow * 136 + ks * 32 + fq * 8);
            }
            asm volatile("s_waitcnt lgkmcnt(0)" ::: "memory");
            f32x4 ao[2];
#pragma unroll
            for (int e2 = 0; e2 < 2; ++e2) {
                f32x4 acc = (f32x4){bflo(cur.oin[e2][0]), bfhi(cur.oin[e2][0]), bflo(cur.oin[e2][1]), bfhi(cur.oin[e2][1])};
#pragma unroll
                for (int ks = 0; ks < 4; ++ks) {
                    u32x4 t; t[0] = cur.yq[2 * ks][0]; t[1] = cur.yq[2 * ks][1]; t[2] = cur.yq[2 * ks + 1][0]; t[3] = cur.yq[2 * ks + 1][1];
                    acc = mfma16(xo[e2][ks], __builtin_bit_cast(bf16x8, t), acc);
                }
                ao[e2] = acc;
            }
            bf16_t* op = Op + (size_t)tok * MW + h * 128 + half * 64 + dv2 * 16 + 8 * fq;
            { u32x4 w; w[0] = pack2(ao[0][0], ao[0][1]); w[1] = pack2(ao[0][2], ao[0][3]); w[2] = pack2(ao[1][0], ao[1][1]); w[3] = pack2(ao[1][2], ao[1][3]); *(u32x4*)op = w; }
#pragma unroll
            for (int qh = 0; qh < 2; ++qh) {
                bf16x8 xs[2][4];
                if (tz == 0) {
#pragma unroll
                    for (int q2 = 0; q2 < 2; ++q2)
#pragma unroll
                        for (int ks = 0; ks < 4; ++ks) xs[q2][ks] = *(const LAS bf16x8*)(st + ((qh * 2 + q2) * 16 + fr) * 136 + ks * 32 + fq * 8);
                    asm volatile("s_waitcnt lgkmcnt(0)" ::: "memory");
                }
#pragma unroll
                for (int q2 = 0; q2 < 2; ++q2) {
                    const int q = qh * 2 + q2;
                    f32x4 acc = (f32x4){cur.dec[0] * S[q][0] + bflo(cur.bin[q][0]), cur.dec[1] * S[q][1] + bfhi(cur.bin[q][0]), cur.dec[2] * S[q][2] + bflo(cur.bin[q][1]), cur.dec[3] * S[q][3] + bfhi(cur.bin[q][1])};
                    if (tz == 0) {
#pragma unroll
                        for (int ks = 0; ks < 4; ++ks) {
                            u32x4 t; t[0] = cur.xa[2 * ks][0]; t[1] = cur.xa[2 * ks][1]; t[2] = cur.xa[2 * ks + 1][0]; t[3] = cur.xa[2 * ks + 1][1];
                            acc = mfma16(__builtin_bit_cast(bf16x8, t), xs[q2][ks], acc);
                        }
                    }
                    S[q] = acc;
                }
            }
        }
    };
    for (int n = 0; n < NCHUNK; n += 2) {
        step(n, s0, s1);
        step(n + 1, s1, s0);
    }
    __syncthreads();
}

__device__ __forceinline__ void seq_lru(const Params& p, int b, int d, int cg, LAS unsigned char* lds) {
    const int tid = opaque_tid(), seg = tid >> 6, ch = cg * 64 + (tid & 63);
    LAS float* sP = (LAS float*)lds;
    LAS float* sL = sP + 512;
    const float* A = p.prep + (size_t)(PR_LA + d) * TOKW + ch; const float* U = p.prep + (size_t)(PR_LU + d) * TOKW + ch;
    bf16_t* Op = p.O + (size_t)(2 * 2 + d) * TOKW + ch;
    constexpr int SEG = (TC + TL) / 8;
    auto tok_of = [&](int pos) { return pos < TC ? NLAT + b * TC + (d ? TC - 1 - pos : pos) : b * TL + (d ? TL - 1 - (pos - TC) : pos - TC); };
    float P = 1.f, L = 0.f;
    for (int i0 = 0; i0 < SEG; i0 += 32) {
        float av[32], uv[32];
#pragma unroll
        for (int q = 0; q < 32; ++q) { const size_t o = (size_t)tok_of(seg * SEG + i0 + q) * MW; av[q] = A[o]; uv[q] = U[o]; }
#pragma unroll
        for (int q = 0; q < 32; ++q) { L = av[q] * L + uv[q]; P *= av[q]; }
    }
    sP[tid] = P; sL[tid] = L;
    __syncthreads();
    float hst = 0.f;
    for (int s = 0; s < seg; ++s) hst = sP[s * 64 + (tid & 63)] * hst + sL[s * 64 + (tid & 63)];
    for (int i0 = 0; i0 < SEG; i0 += 32) {
        float av[32], uv[32];
#pragma unroll
        for (int q = 0; q < 32; ++q) { const size_t o = (size_t)tok_of(seg * SEG + i0 + q) * MW; av[q] = A[o]; uv[q] = U[o]; }
#pragma unroll
        for (int q = 0; q < 32; ++q) { hst = av[q] * hst + uv[q]; Op[(size_t)tok_of(seg * SEG + i0 + q) * MW] = (bf16_t)f2bf(hst); }
    }
    __syncthreads();
}

__device__ __forceinline__ void ph_seq(const Params& p, int l, LAS unsigned char* lds) {
    for (int it = blockIdx.x; it < 256; it += gridDim.x) {
        if (it < 192) { const int tz = it >> 6, r = it & 63; seq_matrix(p, tz, (r & 7) | ((r >> 4) << 3), (r >> 3) & 1, lds); }
        else { const int r = it - 192; seq_lru(p, r >> 4, (r >> 3) & 1, r & 7, lds); }
    }
    if (l == 0) cvt_fill(p, lds, 0, CW_SEQ0A, CW_G2 - CW_SEQ0A, CW_SEQ0B, CW_G1B - CW_SEQ0B); else cvt_fill(p, lds, 1, CW_SEQ1, CVT_G_ALL - CW_SEQ1, 0, 0);
}

__device__ __forceinline__ void ph_merge(const Params& p, int l, int M) {
    const int tid = opaque_tid(), wid = tid >> 6, lane = tid & 63;
    const bf16_t* Ob = opaque_sptr(p.O); const bf16_t* Pb = opaque_sptr(p.P); bf16_t* Yb = opaque_sptr(p.Y);
    float2 gn[3];
#pragma unroll
    for (int m = 0; m < 3; ++m) gn[m] = *(const float2*)((m == 0 ? p.gdn_norm_g : m == 1 ? p.hgrn_norm_g : p.ret_norm_g) + l * 128 + lane * 2);
    for (int tok = blockIdx.x * NWAVES + wid; tok < M; tok += gridDim.x * NWAVES) {
        unsigned o0[16], o1[16], gz[16];
#pragma unroll
        for (int r = 0; r < 16; ++r) {
            const int m = r >> 2, head = r & 3, cidx = head * 128 + lane * 2;
            const size_t o = (size_t)tok * MW + cidx;
            o0[r] = *(const unsigned*)(Ob + (size_t)(m * 2) * TOKW + o); o1[r] = *(const unsigned*)(Ob + (size_t)(m * 2 + 1) * TOKW + o);
            const int zc = m == 0 ? C_GZ : m == 1 ? C_HG : m == 2 ? C_LY : C_RG;
            gz[r] = *(const unsigned*)(Pb + (size_t)tok * NP + zc + cidx);
        }
        float a0[16], a1[16], ss[16];
#pragma unroll
        for (int r = 0; r < 16; ++r) { a0[r] = bflo(o0[r]) + bflo(o1[r]); a1[r] = bfhi(o0[r]) + bfhi(o1[r]); ss[r] = a0[r] * a0[r] + a1[r] * a1[r]; }
#pragma unroll
        for (int msk = 32; msk >= 1; msk >>= 1)
#pragma unroll
            for (int r = 0; r < 16; ++r) if ((r >> 2) != 2) ss[r] += shx(ss[r], msk, lane);
#pragma unroll
        for (int r = 0; r < 16; ++r) {
            const int m = r >> 2, head = r & 3, cidx = head * 128 + lane * 2;
            float y0, y1; int nbr;
            if (m == 2) { y0 = a0[r] * gelu_tanhf_(bflo(gz[r])); y1 = a1[r] * gelu_tanhf_(bfhi(gz[r])); nbr = 2; }
            else {
                const float rinv = rsqrtf(ss[r] * (1.0f / 128.0f) + 1e-6f);
                const float2 g = gn[m == 3 ? 2 : m];
                y0 = a0[r] * rinv * g.x * siluf_(bflo(gz[r])); y1 = a1[r] * rinv * g.y * siluf_(bfhi(gz[r])); nbr = m == 3 ? 3 : m;
            }
            *(unsigned*)(Yb + (size_t)nbr * TOKW + (size_t)tok * MW + cidx) = pack2(y0, y1);
        }
    }
}

struct G2Sched {
    const bf16_t* Y; const bf16_t* Wb; int ntiles, G, c;
    static constexpr bool HAS_BIAS = false, gather = false;
    __device__ __forceinline__ bool next(int i, g8::Unit& u) const {
        const int tile = (i >> 2) * G + c; if (tile >= ntiles) return false;
        u.pm = tile >> 2; u.pn = tile & 3; u.e = i & 3; return true;
    }
    __device__ __forceinline__ const char* a_base(const g8::Unit& u) const { return (const char*)(Y + (size_t)u.e * TOKW + (size_t)u.pm * 256 * MW); }
    __device__ __forceinline__ const char* b_base(const g8::Unit& u) const { return (const char*)(Wb + (size_t)u.e * D * MW + (size_t)u.pn * 256 * MW); }
    __device__ __forceinline__ const int* row_addr(const g8::Unit&, int) const { return nullptr; }
    __device__ __forceinline__ int rows_valid(const g8::Unit&) const { return 256; }
    __device__ __forceinline__ const float* bias_src(const g8::Unit&, int) const { return nullptr; }
};
struct EpiMix {
    const bf16_t* gate; bf16_t* O;
    __device__ __forceinline__ bool keep(const g8::Unit& u) const { return u.e < 3; }
    __device__ __forceinline__ void operator()(f32x4 (&acc)[2][2][4][2], const g8::Unit& u, int wr, int wc, int fr, int fq, const LAS float*) const {
        const int row0 = u.pm * 256 + wr * 64 + fr, col0 = u.pn * 256 + wc * 32 + 8 * fq;
        const bool lastseg = u.e == 3;
        const bf16_t* gc = gate + ((((size_t)u.pm * 16 + u.e * 4 + u.pn) * 8 + (wr * 4 + wc)) * 16) * 512 + (fq * 16 + fr) * 8;
#pragma unroll
        for (int ah = 0; ah < 2; ++ah) {
            u32x4 c[8];
#pragma unroll
            for (int q = 0; q < 8; ++q) c[q] = *(const u32x4*)(gc + (ah * 8 + q) * 512);
#pragma unroll
            for (int q = 0; q < 8; ++q) {
                const int m = q >> 1, bj = q & 1;
#pragma unroll
                for (int w = 0; w < 4; ++w) { acc[ah][bj][m][w >> 1][(w & 1) * 2] *= bflo(c[q][w]); acc[ah][bj][m][w >> 1][(w & 1) * 2 + 1] *= bfhi(c[q][w]); }
            }
        }
        if (lastseg) {
#pragma unroll
            for (int ai = 0; ai < 2; ++ai)
#pragma unroll
                for (int m = 0; m < 4; ++m)
#pragma unroll
                    for (int bj = 0; bj < 2; ++bj) {
                        u32x4 w; w[0] = pack2(acc[ai][bj][m][0][0], acc[ai][bj][m][0][1]); w[1] = pack2(acc[ai][bj][m][0][2], acc[ai][bj][m][0][3]);
                        w[2] = pack2(acc[ai][bj][m][1][0], acc[ai][bj][m][1][1]); w[3] = pack2(acc[ai][bj][m][1][2], acc[ai][bj][m][1][3]);
                        *(u32x4*)(O + (size_t)(row0 + ai * 128 + m * 16) * D + col0 + bj * 128) = w;
                    }
        }
    }
};
__device__ __forceinline__ void ph_g2(const Params& p, int l, int M, LAS unsigned char* lds) {
    G2Sched S; S.Y = p.Y; S.Wb = p.wbT + (size_t)l * 4 * D * MW; S.ntiles = (M / 256) * 4; S.G = gridDim.x; S.c = blockIdx.x;
    EpiMix E; E.gate = p.gate; E.O = p.mix;
    g8::gemm_phase(lds, MW, S, E);
    if (l == 0 && (int)blockIdx.x >= (NTOK / 256) * 4 - 256) cvt_fill(p, lds, 4, CW_G2, CW_G3 - CW_G2, 0, 0);
}

struct EpiY {
    bf16_t* O;
    __device__ __forceinline__ bool keep(const g8::Unit&) const { return false; }
    __device__ __forceinline__ void operator()(const f32x4 (&acc)[2][2][4][2], const g8::Unit& u, int wr, int wc, int fr, int fq, const LAS float*) const {
        const int row0 = u.pm * 256 + wr * 64 + fr, col0 = u.pn * 256 + wc * 32 + 8 * fq;
#pragma unroll
        for (int ai = 0; ai < 2; ++ai)
#pragma unroll
            for (int m = 0; m < 4; ++m)
#pragma unroll
                for (int bj = 0; bj < 2; ++bj) {
                    u32x4 w; w[0] = pack2(acc[ai][bj][m][0][0], acc[ai][bj][m][0][1]); w[1] = pack2(acc[ai][bj][m][0][2], acc[ai][bj][m][0][3]);
                    w[2] = pack2(acc[ai][bj][m][1][0], acc[ai][bj][m][1][1]); w[3] = pack2(acc[ai][bj][m][1][2], acc[ai][bj][m][1][3]);
                    *(u32x4*)(O + (size_t)(row0 + ai * 128 + m * 16) * D + col0 + bj * 128) = w;
                }
    }
};
__device__ __forceinline__ void ph_g3(const Params& p, int l, int M, LAS unsigned char* lds) {
    g8::PlainSched S; S.init(p.mix, p.woutT + (size_t)l * D * D, M, D, D);
    EpiY E; E.O = p.Y;
    g8::gemm_phase(lds, D, S, E);
    if (l == 0 && (int)blockIdx.x >= (NTOK / 256) * 4 - 256) cvt_fill(p, lds, 5, CW_G3, CW_SEQ0B - CW_G3, 0, 0);
}

template <bool DRY = false> __device__ __forceinline__ void ph_route(const Params& p, int l, int M, LAS unsigned char* lds) {
    int* const r_cnt = DRY ? p.cnt + 64 : p.cnt; int* const r_list = DRY ? (int*)p.act : p.list; int* const r_ts = DRY ? (int*)p.yp : p.tokslot; float* const r_tw = DRY ? (float*)p.yp + (size_t)NTOK * 4 : p.topw;
    LAS float* fs = (LAS float*)lds;
    LAS float* lg = fs + 32 * 1028;
    LAS int* lcnt = (LAS int*)(lg + 32 * 36);
    LAS int* lbase = lcnt + 32;
    const int tid = opaque_tid(), wid = tid >> 6, lane = tid & 63;
    const float* rw = p.router_w + (size_t)l * D * NE;
    for (int it = blockIdx.x; it < M / 32; it += gridDim.x) {
        const int tok0 = it * 32;
        {
            float4 v[4][4]; float ss[4];
            const float* mb0 = p.mod + (size_t)(l * 5 + tok_modrow(tok0)) * (NMOD * D);
            u32x2 yv[4][4]; float4 g1v[4];
#pragma unroll
            for (int i = 0; i < 4; ++i) g1v[i] = *(const float4*)(mb0 + 2 * D + i * 256 + lane * 4);
#pragma unroll
            for (int q = 0; q < 4; ++q) {
                const size_t ro = (size_t)(tok0 + wid * 4 + q) * D;
#pragma unroll
                for (int i = 0; i < 4; ++i) { v[q][i] = *(const float4*)(p.xl + ro + i * 256 + lane * 4); yv[q][i] = *(const u32x2*)(p.Y + ro + i * 256 + lane * 4); }
            }
#pragma unroll
            for (int q = 0; q < 4; ++q)
#pragma unroll
                for (int i = 0; i < 4; ++i) {
                    v[q][i].x += g1v[i].x * bflo(yv[q][i][0]); v[q][i].y += g1v[i].y * bfhi(yv[q][i][0]); v[q][i].z += g1v[i].z * bflo(yv[q][i][1]); v[q][i].w += g1v[i].w * bfhi(yv[q][i][1]);
                    if (!DRY) *(float4*)(p.xl + (size_t)(tok0 + wid * 4 + q) * D + i * 256 + lane * 4) = v[q][i];
                }
#pragma unroll
            for (int q = 0; q < 4; ++q) {
                float s = 0.f;
#pragma unroll
                for (int i = 0; i < 4; ++i) s += v[q][i].x * v[q][i].x + v[q][i].y * v[q][i].y + v[q][i].z * v[q][i].z + v[q][i].w * v[q][i].w;
                ss[q] = s;
            }
#pragma unroll
            for (int m = 32; m >= 1; m >>= 1)
#pragma unroll
                for (int q = 0; q < 4; ++q) ss[q] += shx(ss[q], m, lane);
            const float* mb = mb0;
#pragma unroll
            for (int i = 0; i < 4; ++i) {
                const int cidx = i * 256 + lane * 4;
                const float4 gv = *(const float4*)(p.norm2_g + l * D + cidx), sv = *(const float4*)(mb + 4 * D + cidx), hv = *(const float4*)(mb + 3 * D + cidx);
#pragma unroll
                for (int q = 0; q < 4; ++q) {
                    const int tl = wid * 4 + q, tok = tok0 + tl;
                    const float rinv = rsqrtf(ss[q] * (1.0f / D) + 1e-6f);
                    const float h0 = v[q][i].x * rinv * gv.x * (1.f + sv.x) + hv.x, h1 = v[q][i].y * rinv * gv.y * (1.f + sv.y) + hv.y;
                    const float h2 = v[q][i].z * rinv * gv.z * (1.f + sv.z) + hv.z, h3 = v[q][i].w * rinv * gv.w * (1.f + sv.w) + hv.w;
                    u32x2 o; o[0] = pack2(h0, h1); o[1] = pack2(h2, h3);
                    *(u32x2*)(p.F + (size_t)tok * D + cidx) = o;
                    *(LAS f32x4*)(fs + tl * 1028 + cidx) = (f32x4){h0, h1, h2, h3};
                }
            }
        }
        __syncthreads();
        {
            typedef float f32x16 __attribute__((ext_vector_type(16)));
            f32x16 acc;
#pragma unroll
            for (int r = 0; r < 16; ++r) acc[r] = 0.f;
            const int tk = lane & 31, hh = lane >> 5;
            const LAS float* ap = fs + tk * 1028 + wid * 128 + 4 * hh;
            const float* bp = rw + (size_t)(wid * 128 + 4 * hh) * NE + tk;
#pragma unroll 4
            for (int kk = 0; kk < 16; ++kk) {
                const f32x4 a4 = *(const LAS f32x4*)(ap + kk * 8);
                const float b0 = bp[(kk * 8 + 0) * NE], b1 = bp[(kk * 8 + 1) * NE], b2 = bp[(kk * 8 + 2) * NE], b3 = bp[(kk * 8 + 3) * NE];
                acc = __builtin_amdgcn_mfma_f32_32x32x2f32(a4[0], b0, acc, 0, 0, 0);
                acc = __builtin_amdgcn_mfma_f32_32x32x2f32(a4[1], b1, acc, 0, 0, 0);
                acc = __builtin_amdgcn_mfma_f32_32x32x2f32(a4[2], b2, acc, 0, 0, 0);
                acc = __builtin_amdgcn_mfma_f32_32x32x2f32(a4[3], b3, acc, 0, 0, 0);
            }
            __syncthreads();
            LAS float* red = fs;
#pragma unroll
            for (int r = 0; r < 16; ++r) red[(wid * 32 + (r & 3) + 8 * (r >> 2) + 4 * hh) * 33 + tk] = acc[r];
            __syncthreads();
            const int t2 = tid >> 4, e0 = (tid & 15) * 2;
            float s0 = p.router_b[l * NE + e0], s1 = p.router_b[l * NE + e0 + 1];
#pragma unroll
            for (int w = 0; w < 8; ++w) { s0 += red[(w * 32 + t2) * 33 + e0]; s1 += red[(w * 32 + t2) * 33 + e0 + 1]; }
            lg[t2 * 36 + e0] = s0; lg[t2 * 36 + e0 + 1] = s1;
            if (tid < 32) lcnt[tid] = 0;
        }
        __syncthreads();
        float vals[4]; int idxs[4], rank[4];
        if (tid < 32) {
            float lv[32];
#pragma unroll
            for (int q = 0; q < 8; ++q) { const f32x4 t = *(const LAS f32x4*)(lg + tid * 36 + q * 4); lv[q * 4] = t[0]; lv[q * 4 + 1] = t[1]; lv[q * 4 + 2] = t[2]; lv[q * 4 + 3] = t[3]; }
#pragma unroll
            for (int k = 0; k < 4; ++k) {
                float best = lv[0]; int bi = 0;
#pragma unroll
                for (int ee = 1; ee < NE; ++ee) { const bool gt = lv[ee] > best; best = gt ? lv[ee] : best; bi = gt ? ee : bi; }
#pragma unroll
                for (int ee = 0; ee < NE; ++ee) lv[ee] = (ee == bi) ? -3.0e38f : lv[ee];
                vals[k] = best; idxs[k] = bi;
                rank[k] = atomicAdd((int*)(lcnt + bi), 1);
            }
        }
        __syncthreads();
        if (tid < 32) { const int c = lcnt[tid]; lbase[tid] = c ? atomicAdd(r_cnt + l * NE + tid, c) : 0; }
        __syncthreads();
        if (tid < 32) {
            const int tok = tok0 + tid;
            const float mx = vals[0];
            float ex[4], sum = 0.f;
#pragma unroll
            for (int k = 0; k < 4; ++k) { ex[k] = __expf(vals[k] - mx); sum += ex[k]; }
            const float inv = 1.0f / sum;
#pragma unroll
            for (int k = 0; k < 4; ++k) {
                const int ee = idxs[k];
                const int slot = lbase[ee] + rank[k];
                r_list[(size_t)ee * NTOK + slot] = tok;
                r_ts[(size_t)tok * 4 + k] = (ee << 16) | slot;
                r_tw[(size_t)tok * 4 + k] = ex[k] * inv;
            }
        }
        __syncthreads();
    }
}

__device__ __forceinline__ void build_expert_tables(const Params& p, int l, LAS int* ts, LAS int* cn, LAS int* te) {
    const int tid = opaque_tid();
    if (tid < 64) {
        const int c = tid < NE ? p.cnt[l * NE + tid] : 0;
        const int nt = (c + 255) >> 8;
        int v = nt;
#pragma unroll
        for (int off = 1; off < 32; off <<= 1) { const int t = shupi(v, off, tid); if (tid >= off) v += t; }
        if (tid < NE) { cn[tid] = c; ts[tid] = v - nt; if (tid == NE - 1) ts[NE] = v; }
        if (te && tid < NE) for (int q = 0; q < nt; ++q) te[v - nt + q] = tid;
    }
    __syncthreads();
}

struct MoeSched {
    const LAS int* ts; const LAS int* cn; const LAS int* te; const int* list; const bf16_t* A; const bf16_t* Bt; const float* bias; int K, npn, nunits, G, c, nrowsB, nbias; bool gather;
    static constexpr bool HAS_BIAS = true;
    __device__ __forceinline__ bool next(int i, g8::Unit& u) const {
        const long L = (long)i * G + c; if (L >= nunits) return false;
        u.pm = (int)(L / npn); u.pn = (int)(L % npn); u.e = te[u.pm]; return true;
    }
    __device__ __forceinline__ const char* a_base(const g8::Unit& u) const { return (const char*)(gather ? A : A + (size_t)u.pm * 256 * K); }
    __device__ __forceinline__ const char* b_base(const g8::Unit& u) const { return (const char*)(Bt + ((size_t)u.e * nrowsB + (size_t)u.pn * 256) * K); }
    __device__ __forceinline__ const int* row_addr(const g8::Unit& u, int R) const {
        const int cnt = cn[u.e], sl = (u.pm - ts[u.e]) * 256 + R;
        return list + (size_t)u.e * NTOK + (sl < cnt ? sl : 0);
    }
    __device__ __forceinline__ int rows_valid(const g8::Unit& u) const { return cn[u.e] - (u.pm - ts[u.e]) * 256; }
    __device__ __forceinline__ const float* bias_src(const g8::Unit& u, int lane) const {
        if (nbias == 2) return bias + (size_t)u.e * 2 * D + (lane < 32 ? u.pn * 128 + lane * 4 : D + u.pn * 128 + (lane - 32) * 4);
        return bias + (size_t)u.e * D + u.pn * 256 + lane * 4;
    }
};
struct EpiAct {
    bf16_t* O;
    __device__ __forceinline__ bool keep(const g8::Unit&) const { return false; }
    __device__ __forceinline__ void operator()(const f32x4 (&acc)[2][2][4][2], const g8::Unit& u, int wr, int wc, int fr, int fq, const LAS float* bias) const {
        const int row0 = u.pm * 256 + wr * 64 + fr, col0 = u.pn * 128 + wc * 32 + 8 * fq;
        const LAS float* bb = bias + wc * 32 + 8 * fq;
        const f32x4 g0 = *(const LAS f32x4*)bb, g1 = *(const LAS f32x4*)(bb + 4), l0 = *(const LAS f32x4*)(bb + 128), l1 = *(const LAS f32x4*)(bb + 132);
        const float bg[8] = {g0[0], g0[1], g0[2], g0[3], g1[0], g1[1], g1[2], g1[3]}, bl[8] = {l0[0], l0[1], l0[2], l0[3], l1[0], l1[1], l1[2], l1[3]};
#pragma unroll
        for (int ai = 0; ai < 2; ++ai)
#pragma unroll
            for (int m = 0; m < 4; ++m) {
                float o[8];
#pragma unroll
                for (int n = 0; n < 2; ++n)
#pragma unroll
                    for (int j = 0; j < 4; ++j) {
                        const float glu = fminf(acc[ai][0][m][n][j] + bg[n * 4 + j], 7.0f);
                        const float lin = fminf(fmaxf(acc[ai][1][m][n][j] + bl[n * 4 + j], -7.0f), 7.0f);
                        o[n * 4 + j] = glu * sigmoidf_(1.702f * glu) * (lin + 1.0f);
                    }
                *(u32x4*)(O + (size_t)(row0 + ai * 128 + m * 16) * D + col0) = pack8(o);
            }
    }
};
__device__ __forceinline__ void ph_g4(const Params& p, int l, LAS unsigned char* lds) {
    LAS int* ts = (LAS int*)(lds + g8::STAGE_BYTES); LAS int* cn = ts + 40; LAS int* te = ts + 80;
    build_expert_tables(p, l, ts, cn, te);
    MoeSched S; S.ts = ts; S.cn = cn; S.te = te; S.list = p.list; S.A = p.F; S.Bt = p.w1T + (size_t)l * NE * 2 * D * D; S.bias = p.moe_b1 + (size_t)l * NE * 2 * D; S.nbias = 2;
    S.K = D; S.npn = 8; S.nunits = ts[NE] * 8; S.G = gridDim.x; S.c = blockIdx.x; S.nrowsB = 2 * D; S.gather = true;
    EpiAct E; E.O = p.act;
    g8::gemm_phase(lds, D, S, E);
}

struct EpiYp {
    bf16_t* O;
    __device__ __forceinline__ bool keep(const g8::Unit&) const { return false; }
    __device__ __forceinline__ void operator()(const f32x4 (&acc)[2][2][4][2], const g8::Unit& u, int wr, int wc, int fr, int fq, const LAS float* bias) const {
        const int row0 = u.pm * 256 + wr * 64 + fr, col0 = u.pn * 256 + wc * 32 + 8 * fq;
#pragma unroll
        for (int bj = 0; bj < 2; ++bj) {
            const LAS float* bb = bias + bj * 128 + wc * 32 + 8 * fq;
            const f32x4 c0v = *(const LAS f32x4*)bb, c1v = *(const LAS f32x4*)(bb + 4);
            const float4 c0 = make_float4(c0v[0], c0v[1], c0v[2], c0v[3]), c1 = make_float4(c1v[0], c1v[1], c1v[2], c1v[3]);
#pragma unroll
            for (int ai = 0; ai < 2; ++ai)
#pragma unroll
                for (int m = 0; m < 4; ++m) {
                    u32x4 w; w[0] = pack2(acc[ai][bj][m][0][0] + c0.x, acc[ai][bj][m][0][1] + c0.y); w[1] = pack2(acc[ai][bj][m][0][2] + c0.z, acc[ai][bj][m][0][3] + c0.w);
                    w[2] = pack2(acc[ai][bj][m][1][0] + c1.x, acc[ai][bj][m][1][1] + c1.y); w[3] = pack2(acc[ai][bj][m][1][2] + c1.z, acc[ai][bj][m][1][3] + c1.w);
                    *(u32x4*)(O + (size_t)(row0 + ai * 128 + m * 16) * D + col0 + bj * 128) = w;
                }
        }
    }
};
__device__ __forceinline__ void ph_g5(const Params& p, int l, LAS unsigned char* lds) {
    LAS int* ts = (LAS int*)(lds + g8::STAGE_BYTES); LAS int* cn = ts + 40; LAS int* te = ts + 80;
    build_expert_tables(p, l, ts, cn, te);
    MoeSched S; S.ts = ts; S.cn = cn; S.te = te; S.list = p.list; S.A = p.act; S.Bt = p.w2T + (size_t)l * NE * D * D; S.bias = p.moe_b2 + (size_t)l * NE * D; S.nbias = 1;
    S.K = D; S.npn = 4; S.nunits = ts[NE] * 4; S.G = gridDim.x; S.c = blockIdx.x; S.nrowsB = D; S.gather = false;
    EpiYp E; E.O = p.yp;
    g8::gemm_phase(lds, D, S, E);
}

template <bool DRY = false> __device__ __forceinline__ void ph_combine(const Params& p, int l, int M, LAS unsigned char* lds) {
    float* const c_xl = DRY ? p.prep : p.xl; bf16_t* const c_H = DRY ? (bf16_t*)(p.prep + (size_t)NTOK * D) : p.H; float* const c_out = DRY ? p.prep : p.out;
    LAS int* ts = (LAS int*)lds; LAS int* cn = ts + 40;
    build_expert_tables(p, l, ts, cn, nullptr);
    const int tid = opaque_tid(), wid = tid >> 6, lane = tid & 63;
    const bool last = (l == 1);
    const int tstep = gridDim.x * NWAVES;
    int tok = blockIdx.x * NWAVES + wid;
    int4 nts = make_int4(0, 0, 0, 0); float4 ntw = make_float4(0.f, 0.f, 0.f, 0.f);
    if (tok < M) { nts = *(const int4*)(p.tokslot + (size_t)tok * 4); ntw = *(const float4*)(p.topw + (size_t)tok * 4); }
    for (; tok < M; tok += tstep) {
        float4 v[4];
        const float* mb = p.mod + (size_t)(l * 5 + tok_modrow(tok)) * (NMOD * D);
        const int tsl[4] = {nts.x, nts.y, nts.z, nts.w}; const float wts[4] = {ntw.x, ntw.y, ntw.z, ntw.w};
        int rows[4];
#pragma unroll
        for (int k = 0; k < 4; ++k) rows[k] = ts[tsl[k] >> 16] * 256 + (tsl[k] & 0xffff);
        if (tok + tstep < M) { nts = *(const int4*)(p.tokslot + (size_t)(tok + tstep) * 4); ntw = *(const float4*)(p.topw + (size_t)(tok + tstep) * 4); }
        u32x2 yv[4][4]; float4 xin[4], gtv[4];
#pragma unroll
        for (int i = 0; i < 4; ++i) {
            const int cidx = i * 256 + lane * 4;
#pragma unroll
            for (int k = 0; k < 4; ++k) yv[i][k] = *(const u32x2*)(p.yp + (size_t)rows[k] * D + cidx);
            xin[i] = *(const float4*)(p.xl + (size_t)tok * D + cidx);
            gtv[i] = *(const float4*)(mb + 5 * D + cidx);
        }
        float ss = 0.f;
#pragma unroll
        for (int i = 0; i < 4; ++i) {
            float m0 = 0.f, m1 = 0.f, m2 = 0.f, m3 = 0.f;
#pragma unroll
            for (int k = 0; k < 4; ++k) { m0 += wts[k] * bflo(yv[i][k][0]); m1 += wts[k] * bfhi(yv[i][k][0]); m2 += wts[k] * bflo(yv[i][k][1]); m3 += wts[k] * bfhi(yv[i][k][1]); }
            float4 xv = xin[i];
            xv.x += gtv[i].x * m0; xv.y += gtv[i].y * m1; xv.z += gtv[i].z * m2; xv.w += gtv[i].w * m3;
            v[i] = xv; ss += xv.x * xv.x + xv.y * xv.y + xv.z * xv.z + xv.w * xv.w;
        }
        ss = wave_sum(ss, lane);
        const float rinv = rsqrtf(ss * (1.0f / D) + 1e-6f);
        if (!last) {
#pragma unroll
            for (int i = 0; i < 4; ++i) *(float4*)(c_xl + (size_t)tok * D + i * 256 + lane * 4) = v[i];
            const float* mb1 = p.mod + (size_t)((l + 1) * 5 + tok_modrow(tok)) * (NMOD * D);
            norm_mod_store(v, rinv, p.norm1_g + (l + 1) * D, mb1 + 1 * D, mb1 + 0 * D, c_H + (size_t)tok * D, lane);
        } else {
#pragma unroll
            for (int i = 0; i < 4; ++i) {
                const int cidx = i * 256 + lane * 4;
                const float4 gv = *(const float4*)(p.final_norm_g + cidx);
                *(float4*)(c_out + (size_t)tok * D + cidx) = make_float4(v[i].x * rinv * gv.x, v[i].y * rinv * gv.y, v[i].z * rinv * gv.z, v[i].w * rinv * gv.w);
            }
        }
    }
}

#define XB_TMO      128
#define XB_XCNT(j)  (256  + 64 * (j))
#define XB_XSUB(j)  (1280 + 64 * (j))
#define XB_XGEN(j)  (2304 + 64 * (j))
#define XB_TOP      3328
#define XB_TOPGEN   3392
#define XCD_BAR_WORDS 3456
#define XB_SPIN_CAP (1u << 18)

__device__ __forceinline__ unsigned xb_ld(unsigned* p)              { return __hip_atomic_load(p, __ATOMIC_RELAXED, __HIP_MEMORY_SCOPE_AGENT); }
__device__ __forceinline__ unsigned xb_add(unsigned* p, unsigned v) { return __hip_atomic_fetch_add(p, v, __ATOMIC_RELAXED, __HIP_MEMORY_SCOPE_AGENT); }
__device__ __forceinline__ unsigned xb_xcc_id() { return (unsigned)__builtin_amdgcn_s_getreg((3 << 11) | 20) & 0xFu; }
#define XB_SPIN(cond, bar) do { unsigned _sp = 0; while (cond) { __builtin_amdgcn_s_sleep(1); \
    if ((++_sp & 255u) == 0u) { if (xb_ld(&(bar)[XB_TMO])) break; if (_sp > XB_SPIN_CAP) { atomicAdd(&(bar)[XB_TMO], 1u); break; } } } } while (0)

struct XcdBarrier {
    unsigned* bar; unsigned x;
    volatile LAS unsigned* st;
};

__device__ __forceinline__ XcdBarrier xcd_barrier_post(unsigned* bar, volatile LAS unsigned* st) {
    XcdBarrier b; b.bar = bar; b.x = xb_xcc_id(); b.st = st;
    if (threadIdx.x == 0) (void)xb_add(&bar[XB_XCNT(b.x)], 1u);
    return b;
}
__device__ __forceinline__ void xcd_barrier_complete(unsigned* bar, unsigned x, unsigned& nloc, unsigned& nx) {
    const unsigned G = gridDim.x * gridDim.y * gridDim.z;
    unsigned sum, cnt, mine, sp = 0u;
    for (;;) {
        sum = 0u; cnt = 0u; mine = 0u;
#pragma unroll
        for (unsigned j = 0; j < 16; ++j) { const unsigned c = xb_ld(&bar[XB_XCNT(j)]); sum += c; cnt += (c > 0u) ? 1u : 0u; mine = (j == x) ? c : mine; }
        if (sum == G) break;
        __builtin_amdgcn_s_sleep(1);
        if ((++sp & 255u) == 0u) { if (xb_ld(&bar[XB_TMO])) break; if (sp > XB_SPIN_CAP) { atomicAdd(&bar[XB_TMO], 1u); break; } }
    }
    nloc = mine > 0u ? mine : 1u; nx = cnt > 0u ? cnt : 1u;
}

__device__ __forceinline__ void xcd_barrier(const XcdBarrier& b) {
    asm volatile("s_waitcnt vmcnt(0)" ::: "memory");
    __syncthreads();
    if (threadIdx.x == 0) {
        unsigned* bar = b.bar;
        __builtin_amdgcn_s_waitcnt(0);
        unsigned nloc = b.st[0], nx = b.st[1];
        if (nloc == 0u) { xcd_barrier_complete(bar, b.x, nloc, nx); b.st[0] = nloc; b.st[1] = nx; }
        const unsigned old = xb_add(&bar[XB_XSUB(b.x)], 1u);
        const unsigned gen = old / nloc;
        if (old + 1u == (gen + 1u) * nloc) {
            __builtin_amdgcn_fence(__ATOMIC_RELEASE, "agent");
            asm volatile("s_waitcnt vmcnt(0)" ::: "memory");
            const unsigned og = xb_add(&bar[XB_TOP], 1u);
            const unsigned tg = og / nx;
            if (og + 1u == (tg + 1u) * nx) xb_add(&bar[XB_TOPGEN], 1u);
            else XB_SPIN(xb_ld(&bar[XB_TOPGEN]) == tg, bar);
            __builtin_amdgcn_fence(__ATOMIC_ACQUIRE, "agent");
            xb_add(&bar[XB_XGEN(b.x)], 1u);
            asm volatile("s_waitcnt vmcnt(0)" ::: "memory");
        } else {
            XB_SPIN(xb_ld(&bar[XB_XGEN(b.x)]) == gen, bar);
            __builtin_amdgcn_fence(__ATOMIC_ACQUIRE, "agent");
            asm volatile("s_waitcnt vmcnt(0)" ::: "memory");
        }
    }
    __syncthreads();
}


extern __shared__ __attribute__((aligned(16))) unsigned char dyn_lds[];

typedef const __attribute__((address_space(4))) unsigned char* KArgPtr;
__device__ __forceinline__ Params load_params(KArgPtr kp) {
    asm volatile("" : "+s"(kp));
    Params q;
    const __attribute__((address_space(4))) unsigned long long* k8 = (const __attribute__((address_space(4))) unsigned long long*)kp;
    unsigned long long* d8 = (unsigned long long*)&q;
#pragma unroll
    for (int i = 0; i < (int)(sizeof(Params) / 8); ++i) d8[i] = k8[i];
    return q;
}
__global__ void __launch_bounds__(NTHREADS, 2) k_mega(Params p_unused) {
    (void)p_unused;
    const KArgPtr kp = (KArgPtr)__builtin_amdgcn_kernarg_segment_ptr();
    LAS unsigned char* lds = (LAS unsigned char*)dyn_lds;
    volatile LAS unsigned* xb_words = (volatile LAS unsigned*)(lds + LDS_BYTES - 16);
    if (threadIdx.x == 0) { xb_words[0] = 0u; xb_words[1] = 0u; xb_words[2] = 0u; xb_words[3] = 0u; }
    __syncthreads();
    { const Params p = load_params(kp); (void)xcd_barrier_post(p.bar, xb_words); }
#define GRID_BARRIER() do { XcdBarrier b_; b_.bar = load_params(kp).bar; b_.x = xb_xcc_id(); b_.st = xb_words; xcd_barrier(b_); } while (0)
#define PH(stmt) do { const Params p = load_params(kp); stmt; } while (0)
    PH(ph_convert(p, lds));
    PH(ph_mod(p, lds));
    GRID_BARRIER();
    PH(ph_norm1_first(p));
    GRID_BARRIER();
    for (int l = 0; l < 2; ++l) {
        const int M = l == 0 ? NTOK : NLAT;
        { unsigned lb_ = (unsigned)(size_t)lds; asm volatile("" : "+s"(lb_)); lds = (LAS unsigned char*)(size_t)lb_; }
        PH(ph_g1(p, l, lds));
        GRID_BARRIER();
        PH(ph_prep(p, l, lds));
        PH(ph_local(p, l, lds));
        GRID_BARRIER();
        PH(ph_seq(p, l, lds));
        GRID_BARRIER();
        PH(ph_merge(p, l, M));
        GRID_BARRIER();
        PH(ph_g2(p, l, M, lds));
        GRID_BARRIER();
        PH(ph_g3(p, l, M, lds));
        GRID_BARRIER();
        PH(ph_route(p, l, M, lds));
        GRID_BARRIER();
        PH(ph_g4(p, l, lds));
        GRID_BARRIER();
        PH(ph_g5(p, l, lds));
        GRID_BARRIER();
        PH(ph_combine(p, l, M, lds));
        if (l == 0) GRID_BARRIER();
    }
}

static inline size_t align_up(size_t v, size_t a) { return (v + a - 1) / a * a; }

extern "C" void kernel_launch(void* const* d_in, const int* in_sizes, int n_in, void* d_out, int out_size, void* d_ws, size_t ws_size, hipStream_t stream) {
    (void)in_sizes; (void)n_in; (void)out_size;
    Params p{};
    const float** pf = (const float**)&p;
    for (int i = 0; i < 32; ++i) pf[i] = (const float*)d_in[i];
    p.out = (float*)d_out;
    unsigned char* w = (unsigned char*)d_ws; size_t off = 0;
    auto take = [&](size_t bytes) { void* r = w + off; off = align_up(off + bytes, 256); return r; };
    p.bar = (unsigned*)take(16384);
    p.cnt = (int*)take(4096);
    const size_t ctl_bytes = off;
    p.mod = (float*)take((size_t)2 * 5 * NMOD * D * 4);
    p.winT = (bf16_t*)take((size_t)2 * NPW * D * 2);
    p.wbT = (bf16_t*)take((size_t)2 * 4 * D * MW * 2);
    p.woutT = (bf16_t*)take((size_t)2 * D * D * 2);
    p.w1T = (bf16_t*)take((size_t)2 * NE * 2 * D * D * 2);
    p.w2T = (bf16_t*)take((size_t)2 * NE * D * D * 2);
    p.xl = (float*)take((size_t)NTOK * D * 4);
    p.H = (bf16_t*)take((size_t)NTOK * D * 2);
    p.P = (bf16_t*)take((size_t)NTOK * NP * 2);
    p.gate = (bf16_t*)take((size_t)NTOK * 4096 * 2);
    p.act = p.P; p.yp = p.P + (size_t)CAPROWS * D;
    p.prep = (float*)take(NPREP * TOKW * 4);
    p.O = (bf16_t*)take(8 * TOKW * 2);
    p.lq = (bf16_t*)take((size_t)3 * NITEM * 64 * 128 * 2);
    p.lo = (bf16_t*)take((size_t)3 * NITEM * 64 * 128 * 2);
    p.lb = (bf16_t*)take((size_t)3 * NITEM * 128 * 128 * 2);
    p.la = (bf16_t*)take((size_t)NITEM * 128 * 128 * 2);
    p.ld = (float*)take((size_t)3 * NITEM * 128 * 4);
    p.lruT = (bf16_t*)take((size_t)2 * 8 * 4 * 4096 * 2);
    p.lsig = (float*)take((size_t)2 * 2 * MW * 4);
    p.rope = (float2*)take((size_t)TL * 64 * 8);
    p.Y = (bf16_t*)take(4 * TOKW * 2);
    p.mix = (bf16_t*)take((size_t)NTOK * D * 2);
    p.F = p.H;
    p.list = (int*)take((size_t)NE * NTOK * 4);
    p.tokslot = (int*)take((size_t)NTOK * 4 * 4);
    p.topw = (float*)take((size_t)NTOK * 4 * 4);
    if (off > ws_size) { fprintf(stderr, "workspace too small: need %zu have %zu\n", off, ws_size); return; }

    static int grid = 0;
    if (!grid) {
        int dev = 0, cus = 0, occ = 0; (void)hipGetDevice(&dev); (void)hipDeviceGetAttribute(&cus, hipDeviceAttributeMultiprocessorCount, dev);
        (void)hipFuncSetAttribute((const void*)k_mega, hipFuncAttributeMaxDynamicSharedMemorySize, LDS_BYTES);
        (void)hipOccupancyMaxActiveBlocksPerMultiprocessor(&occ, (const void*)k_mega, NTHREADS, LDS_BYTES);
        if (cus <= 0) cus = 256;
        grid = cus * (occ < 1 ? 1 : 1);
        if (occ < 1) fprintf(stderr, "occupancy query says %d blocks per CU\n", occ);
    }
    (void)hipMemsetAsync(d_ws, 0, ctl_bytes, stream);
    hipLaunchKernelGGL(k_mega, dim3(grid), dim3(NTHREADS), LDS_BYTES, stream, p);
}
```

```cpp
#include <hip/hip_runtime.h>
#include <stdint.h>
#include <stdio.h>

#define LAS __attribute__((address_space(3)))
typedef unsigned short bf16_t;
typedef short bf16x8 __attribute__((ext_vector_type(8)));
typedef float f32x4 __attribute__((ext_vector_type(4)));
typedef float f32x2 __attribute__((ext_vector_type(2)));
typedef unsigned u32x2 __attribute__((ext_vector_type(2)));
typedef unsigned u32x4 __attribute__((ext_vector_type(4)));

#ifndef PROBE
#define PROBE 0
#endif

constexpr int D = 1024, NB = 4, TL = 4096, TC = 256, NLAT = NB * TL, NCTX = NB * TC, NTOK = NLAT + NCTX;
constexpr int NIN = 11792, NPW = 12032, NP = 7936, MW = 512, NE = 32, TOPK = 4, NMOD = 6;
constexpr int C_GQKV = 0, C_GZ = 1536, C_HQ = 2048, C_HI = 2560, C_HF = 3072, C_HG = 4096, C_LX = 4608,
              C_LY = 5120, C_RQKV = 5632, C_RG = 7168, C_GA = 7680, C_GB = 7688, W_MG = 7936;
__host__ __device__ __forceinline__ int win_dst_row(int n) {
    if (n < 7696) return n < 2048 ? n : n < 2064 ? 7680 + (n - 2048) : n - 16;
    const int q = n - 7696, seg = q >> 10, lam = q & 1023, t = lam >> 6, li = lam & 63;
    return 7936 + t * 256 + (seg >> 1) * 128 + (li >> 4) * 32 + ((li >> 2) & 3) * 8 + (seg & 1) * 4 + (li & 3);
}
constexpr int NTHREADS = 512, NWAVES = 8;
constexpr int LDS_BYTES = 140 * 1024;
constexpr int CAPROWS = 77824;
constexpr size_t TOKW = (size_t)NTOK * MW;
constexpr int PR_LA = 0, PR_LU = 2, NPREP = 4;
constexpr int NCHUNK = 68, NITEM = 32 * NCHUNK;

struct Params {
    const float *x, *c, *ctx, *c_ctx, *w_mod, *b_mod, *norm1_g, *norm2_g, *w_in, *gdn_conv_w, *gdn_a_log, *gdn_dt_bias, *gdn_norm_g, *hgrn_lb,
        *hgrn_norm_g, *lru_conv_w, *lru_conv_b, *lru_wa, *lru_ba, *lru_wx, *lru_bx, *lru_lambda, *ret_norm_g, *w_branch, *w_out, *router_w,
        *router_b, *moe_w1, *moe_b1, *moe_w2, *moe_b2, *final_norm_g;
    float* out;
    unsigned* bar; int* cnt; float* mod;
    bf16_t *winT, *wbT, *woutT, *w1T, *w2T;
    float* xl; bf16_t* H; bf16_t* P; float* prep; float* gg; float* gb; bf16_t* O; bf16_t* Y; bf16_t* mix; bf16_t* F;
    int* list; int* tokslot; float* topw; bf16_t* act; bf16_t* yp;
    bf16_t *lq, *lo, *lb, *la; float* ld; bf16_t* lruT; bf16_t* gate; float* lsig; float2* rope;
};

typedef __bf16 bf16x2_t __attribute__((ext_vector_type(2)));
__device__ __forceinline__ unsigned pack2(float a, float b) { const f32x2 v = {a, b}; return __builtin_bit_cast(unsigned, __builtin_convertvector(v, bf16x2_t)); }
__device__ __forceinline__ unsigned f2bf(float f) { return pack2(f, f) & 0xffffu; }
__device__ __forceinline__ float bf2f(bf16_t b) { return __uint_as_float(((unsigned)b) << 16); }
__device__ __forceinline__ float bflo(unsigned u) { return __uint_as_float(u << 16); }
__device__ __forceinline__ float bfhi(unsigned u) { return __uint_as_float(u & 0xffff0000u); }
__device__ __forceinline__ float sigmoidf_(float x) { return __builtin_amdgcn_rcpf(1.0f + __expf(-x)); }
__device__ __forceinline__ float siluf_(float x) { return x * sigmoidf_(x); }
__device__ __forceinline__ float softplusf_(float x) { return x > 20.f ? x : __logf(1.0f + __expf(x)); }
__device__ __forceinline__ float ret_log_gamma(int h) { return h == 0 ? -0.031748698314580f : h == 1 ? -0.015748356968139f : h == 2 ? -0.007843177461025f : -0.003913899321136f; }
__device__ __forceinline__ float logsigmoidf_(float x) { return -softplusf_(-x); }
__device__ __forceinline__ float gelu_tanhf_(float x) { const float u = 0.7978845608028654f * (x + 0.044715f * x * x * x); return x * __builtin_amdgcn_rcpf(1.0f + __expf(-2.0f * u)); }
__device__ __forceinline__ float shx(float v, int m, int lane) { return __int_as_float(__builtin_amdgcn_ds_bpermute((lane ^ m) << 2, __float_as_int(v))); }
__device__ __forceinline__ float shup(float v, int off, int lane) { const int s = lane >= off ? lane - off : lane; return __int_as_float(__builtin_amdgcn_ds_bpermute(s << 2, __float_as_int(v))); }
__device__ __forceinline__ int shupi(int v, int off, int lane) { const int s = lane >= off ? lane - off : lane; return __builtin_amdgcn_ds_bpermute(s << 2, v); }
__device__ __forceinline__ float wave_sum(float v, int lane) {
#pragma unroll
    for (int m = 32; m >= 1; m >>= 1) v += shx(v, m, lane);
    return v;
}
__device__ __forceinline__ int opaque_tid() { int t = threadIdx.x; asm volatile("" : "+v"(t)); return t; }
template <class T> __device__ __forceinline__ T* opaque_sptr(T* q) { asm volatile("" : "+s"(q)); return q; }
__device__ __forceinline__ int tok_modrow(int tok) { return tok < NLAT ? (tok >> 12) : 4; }
__device__ __forceinline__ void tok_info(int tok, int& t, int& T, int& base) {
    if (tok < NLAT) { t = tok & (TL - 1); T = TL; base = tok - t; }
    else { t = (tok - NLAT) & (TC - 1); T = TC; base = tok - t; }
}

__device__ __forceinline__ f32x4 mfma16(bf16x8 a, bf16x8 b, f32x4 c) { return __builtin_amdgcn_mfma_f32_16x16x32_bf16(a, b, c, 0, 0, 0); }
__device__ __forceinline__ u32x2 pack4(f32x4 v) { u32x2 o; o[0] = pack2(v[0], v[1]); o[1] = pack2(v[2], v[3]); return o; }
__device__ __forceinline__ u32x4 pack8(const float* v) { u32x4 o; o[0] = pack2(v[0], v[1]); o[1] = pack2(v[2], v[3]); o[2] = pack2(v[4], v[5]); o[3] = pack2(v[6], v[7]); return o; }

namespace g8 {
constexpr int BM = 256, BK = 64, HALF = 128, HTB = HALF * BK * 2, STAGE_BYTES = 8 * HTB;
__device__ __forceinline__ int lds_byte(int r, int c) { const int st = (r >> 4) * 2 + (c >> 5), rr = r & 15, cc = c & 31, ob = rr * 64 + cc * 2; return st * 1024 + (ob ^ (((ob >> 9) & 1) << 5)); }
__device__ __forceinline__ void stage_rc(int b, int& R, int& C) { const int st = b / 1024, sb = b % 1024, swz = sb ^ (((sb >> 9) & 1) << 5); R = (st >> 1) * 16 + swz / 64; C = (st & 1) * 32 + (swz % 64) / 2; }
__device__ __forceinline__ int perm32(int rho) { const int n = rho >> 4, i = rho & 15; return 8 * (i >> 2) + 4 * n + (i & 3); }
struct Unit { int pm, pn, e; };

template <class Epi, class Sched>
__device__ __forceinline__ void gemm_phase(LAS unsigned char* lds, const int K, const Sched& S, const Epi& E) {
    const int tid = opaque_tid(), wid = __builtin_amdgcn_readfirstlane(tid >> 6), lane = tid & 63, wr = wid >> 2, wc = wid & 3, fr = lane & 15, fq = lane >> 4;
    const int nt = K / BK;
    int R0, C0, R1, C1; stage_rc(tid * 16, R0, C0); stage_rc(tid * 16 + 8192, R1, C1);
    unsigned voffB[2];
    voffB[0] = (unsigned)(((R0 & ~31) + perm32(R0 & 31)) * K + C0) * 2u; voffB[1] = (unsigned)(((R1 & ~31) + perm32(R1 & 31)) * K + C1) * 2u;
    const unsigned cb0 = (unsigned)C0 * 2u, cb1 = (unsigned)C1 * 2u;
    const size_t kstep = (size_t)(BK * 2);
    const size_t hstepB = (size_t)HALF * K * 2;
    const unsigned ldsw = (unsigned)wid * 1024u;
    const int aoff = lds_byte(wr * 64 + fr, fq * 8), boff = lds_byte(wc * 32 + fr, fq * 8);
#define G8_SA(b, h) (((b) * 2 + (h)) * HTB)
#define G8_SB(b, h) ((4 + (b) * 2 + (h)) * HTB)
#define G8_GL(src, dstoff) __builtin_amdgcn_global_load_lds((const unsigned*)(src), (LAS unsigned*)(lds + (dstoff)), 16, 0, 0)
#define G8_STAGE_A(bufoff, gbase, vo, h) do { G8_GL((const char*)(gbase) + (vo)[2 * (h)], (bufoff) + ldsw); G8_GL((const char*)(gbase) + (vo)[2 * (h) + 1], (bufoff) + ldsw + 8192); } while (0)
#define G8_STAGE_B(bufoff, gbase) do { G8_GL((const char*)(gbase) + voffB[0], (bufoff) + ldsw); G8_GL((const char*)(gbase) + voffB[1], (bufoff) + ldsw + 8192); } while (0)
#define G8_LDA(dst, b, h) do { _Pragma("unroll") for (int m = 0; m < 4; ++m) _Pragma("unroll") for (int k = 0; k < 2; ++k) dst[m][k] = *(const LAS bf16x8*)(lds + G8_SA(b, h) + aoff + m * 2048 + k * 1024); } while (0)
#define G8_LDB(dst, b, h) do { _Pragma("unroll") for (int n = 0; n < 2; ++n) _Pragma("unroll") for (int k = 0; k < 2; ++k) dst[n][k] = *(const LAS bf16x8*)(lds + G8_SB(b, h) + boff + n * 2048 + k * 1024); } while (0)
#define G8_MMA(ai, bj, At, Bt) do { __builtin_amdgcn_s_setprio(1); _Pragma("unroll") for (int m = 0; m < 4; ++m) _Pragma("unroll") for (int n = 0; n < 2; ++n) _Pragma("unroll") for (int k = 0; k < 2; ++k) \
        acc[ai][bj][m][n] = __builtin_amdgcn_mfma_f32_16x16x32_bf16(Bt[n][k], At[m][k], acc[ai][bj][m][n], 0, 0, 0); __builtin_amdgcn_s_setprio(0); } while (0)
#define G8_WAIT_V(n) asm volatile("s_waitcnt vmcnt(" #n ")" ::: "memory")
#define G8_WAIT_L(n) asm volatile("s_waitcnt lgkmcnt(" #n ")" ::: "memory")
#define G8_BAR __builtin_amdgcn_s_barrier()
#define G8_SCHED __builtin_amdgcn_sched_barrier(0)
    Unit cur, nxt; int ui = 0;
    if (!S.next(0, cur)) return;
    LAS float* biasbuf = (LAS float*)(lds + STAGE_BYTES + 2048);
    LAS int* rowbuf = (LAS int*)(lds + STAGE_BYTES + 4096);
    f32x4 acc[2][2][4][2];
#pragma unroll
    for (int a = 0; a < 2; ++a)
#pragma unroll
        for (int b = 0; b < 2; ++b)
#pragma unroll
            for (int m = 0; m < 4; ++m)
#pragma unroll
                for (int n = 0; n < 2; ++n) acc[a][b][m][n] = (f32x4){0.f, 0.f, 0.f, 0.f};
    bf16x8 At[4][2], B0[2][2], B1[2][2];
    unsigned vA[4];
    {
        unsigned rows[4] = {(unsigned)R0, (unsigned)R1, (unsigned)(HALF + R0), (unsigned)(HALF + R1)};
        if (S.gather) { rows[0] = (unsigned)*S.row_addr(cur, R0); rows[1] = (unsigned)*S.row_addr(cur, R1); rows[2] = (unsigned)*S.row_addr(cur, HALF + R0); rows[3] = (unsigned)*S.row_addr(cur, HALF + R1); }
        vA[0] = rows[0] * (unsigned)(K * 2) + cb0; vA[1] = rows[1] * (unsigned)(K * 2) + cb1; vA[2] = rows[2] * (unsigned)(K * 2) + cb0; vA[3] = rows[3] * (unsigned)(K * 2) + cb1;
    }
    const char* cA = S.a_base(cur); const char* cB = S.b_base(cur);
    G8_STAGE_B(G8_SB(0, 0), cB); G8_STAGE_A(G8_SA(0, 0), cA, vA, 0); G8_STAGE_B(G8_SB(0, 1), cB + hstepB); G8_STAGE_A(G8_SA(0, 1), cA, vA, 1);
    if (wr == 1) G8_BAR;
    G8_WAIT_V(4); G8_BAR;
    G8_STAGE_B(G8_SB(1, 0), cB + kstep); G8_STAGE_A(G8_SA(1, 0), cA + kstep, vA, 0); G8_STAGE_B(G8_SB(1, 1), cB + hstepB + kstep);
    G8_WAIT_V(6); G8_BAR;
    for (;;) {
        const bool has_next = S.next(ui + 1, nxt);
        const char* nA = has_next ? S.a_base(nxt) : cA; const char* nB = has_next ? S.b_base(nxt) : cB;
        const int nvalid = (S.gather && has_next) ? S.rows_valid(nxt) : 0;
        if (wid == 0) {
            if (Sched::HAS_BIAS) G8_GL(S.bias_src(cur, lane), STAGE_BYTES + 2048 + (ui & 1) * 1024);
            if (S.gather && has_next) G8_GL(S.row_addr(nxt, 0) + lane * 4, STAGE_BYTES + 4096 + ((ui + 1) & 1) * 1024);
        }
        for (int t = 0; t < nt; t += 2) {
            const bool last = (t == nt - 2);
            const char* a1 = cA + (size_t)(t + 1) * kstep;
            const char* a2 = last ? nA : cA + (size_t)(t + 2) * kstep; const char* b2 = last ? nB : cB + (size_t)(t + 2) * kstep;
            const char* a3 = a2 + kstep; const char* b3 = b2 + kstep;
            G8_LDB(B0, 0, 0); G8_SCHED; G8_LDA(At, 0, 0); G8_STAGE_A(G8_SA(1, 1), a1, vA, 1);
            if (last && S.gather && has_next) {
                const LAS int* rb = rowbuf + ((ui + 1) & 1) * 256;
                const unsigned r0 = R0 < nvalid ? (unsigned)rb[R0] : 0u, r1 = R1 < nvalid ? (unsigned)rb[R1] : 0u;
                const unsigned r2 = HALF + R0 < nvalid ? (unsigned)rb[HALF + R0] : 0u, r3 = HALF + R1 < nvalid ? (unsigned)rb[HALF + R1] : 0u;
                vA[0] = r0 * (unsigned)(K * 2) + cb0; vA[1] = r1 * (unsigned)(K * 2) + cb1; vA[2] = r2 * (unsigned)(K * 2) + cb0; vA[3] = r3 * (unsigned)(K * 2) + cb1;
            }
            G8_WAIT_L(8); G8_BAR; G8_WAIT_L(0); G8_MMA(0, 0, At, B0); G8_BAR; G8_SCHED;
            G8_LDB(B1, 0, 1); G8_STAGE_B(G8_SB(0, 0), b2);
            G8_BAR; G8_WAIT_L(0); G8_MMA(0, 1, At, B1); G8_BAR;
            G8_LDA(At, 0, 1); G8_STAGE_A(G8_SA(0, 0), a2, vA, 0);
            G8_BAR; G8_WAIT_L(0); G8_MMA(1, 0, At, B0); G8_BAR; G8_SCHED;
            G8_STAGE_B(G8_SB(0, 1), b2 + hstepB);
            G8_WAIT_V(6); G8_BAR; G8_MMA(1, 1, At, B1); G8_BAR;
            G8_LDB(B0, 1, 0); G8_SCHED; G8_LDA(At, 1, 0); G8_STAGE_A(G8_SA(0, 1), a2, vA, 1);
            G8_WAIT_L(8); G8_BAR; G8_WAIT_L(0); G8_MMA(0, 0, At, B0); G8_BAR; G8_SCHED;
            G8_LDB(B1, 1, 1); G8_STAGE_B(G8_SB(1, 0), b3);
            G8_BAR; G8_WAIT_L(0); G8_MMA(0, 1, At, B1); G8_BAR;
            G8_LDA(At, 1, 1); G8_STAGE_A(G8_SA(1, 0), a3, vA, 0);
            G8_BAR; G8_WAIT_L(0); G8_MMA(1, 0, At, B0); G8_BAR; G8_SCHED;
            G8_STAGE_B(G8_SB(1, 1), b3 + hstepB);
            G8_WAIT_V(6); G8_BAR; G8_MMA(1, 1, At, B1); G8_BAR;
        }
        E(acc, cur, wr, wc, fr, fq, biasbuf + (ui & 1) * 256);
        if (!has_next) break;
        if (!E.keep(cur))
#pragma unroll
        for (int a = 0; a < 2; ++a)
#pragma unroll
            for (int b = 0; b < 2; ++b)
#pragma unroll
                for (int m = 0; m < 4; ++m)
#pragma unroll
                    for (int n = 0; n < 2; ++n) acc[a][b][m][n] = (f32x4){0.f, 0.f, 0.f, 0.f};
        cur = nxt; cA = nA; cB = nB; ++ui;
    }
    G8_WAIT_V(0);
    if (wr == 0) G8_BAR;
    G8_BAR;
#undef G8_SA
#undef G8_SB
#undef G8_GL
#undef G8_STAGE_A
#undef G8_STAGE_B
#undef G8_LDA
#undef G8_LDB
#undef G8_MMA
#undef G8_WAIT_V
#undef G8_WAIT_L
#undef G8_BAR
#undef G8_SCHED
}

struct PlainSched {
    const bf16_t* A; const bf16_t* Bt; int K, nM, nN, nwg, G, c;
    __device__ __forceinline__ void init(const bf16_t* A_, const bf16_t* Bt_, int M, int N, int K_) { A = A_; Bt = Bt_; K = K_; nM = M / BM; nN = N / BM; nwg = nM * nN; G = gridDim.x; c = blockIdx.x; }
    __device__ __forceinline__ bool next(int i, Unit& u) const {
        const long L = (long)i * G + c; if (L >= nwg) return false;
        int wgid = (int)L; { const int q = nwg / 8, r = nwg % 8, xcd = wgid % 8, off = wgid / 8; wgid = (xcd < r ? xcd * (q + 1) : r * (q + 1) + (xcd - r) * q) + off; }
        const int nig = 8 * nN, gid = wgid / nig, fm = gid * 8, gsz = (nM - fm) < 8 ? (nM - fm) : 8;
        u.pm = fm + ((wgid % nig) % gsz); u.pn = (wgid % nig) / gsz; u.e = 0; return true;
    }
    __device__ __forceinline__ const char* a_base(const Unit& u) const { return (const char*)(A + (size_t)u.pm * BM * K); }
    __device__ __forceinline__ const char* b_base(const Unit& u) const { return (const char*)(Bt + (size_t)u.pn * BM * K); }
    static constexpr bool HAS_BIAS = false, gather = false;
    __device__ __forceinline__ const int* row_addr(const Unit&, int) const { return nullptr; }
    __device__ __forceinline__ int rows_valid(const Unit&) const { return 256; }
    __device__ __forceinline__ const float* bias_src(const Unit&, int) const { return nullptr; }
};
}

__device__ __forceinline__ int w1_dst_row(int n) { const int half = n >> 10, cc = n & 1023; return (cc >> 7) * 256 + half * 128 + (cc & 127); }

struct CvtTile { const float* src; bf16_t* dst; int ld, Nsrc, k0, n0, K, mode; };
__device__ __forceinline__ CvtTile cvt_decode(const Params& p, int it) {
    constexpr int PER_L = 2960 + 512 + 256 + 16384 + 8192;
    CvtTile t; const int l = it / PER_L; int r = it % PER_L;
    if (r < 2960) { const int nt = r % 185, kt = r / 185; t.src = p.w_in + (size_t)l * D * NIN; t.ld = NIN; t.Nsrc = NIN; t.k0 = kt * 64; t.n0 = nt * 64; t.dst = p.winT + (size_t)l * NPW * D; t.K = D; t.mode = 2; }
    else if (r < 3472) { r -= 2960; const int n = r / 128; r %= 128; const int nt = r % 16, kt = r / 16;
        t.src = p.w_branch + (size_t)(l * 4 + n) * MW * D; t.ld = D; t.Nsrc = D; t.k0 = kt * 64; t.n0 = nt * 64; t.dst = p.wbT + (size_t)(l * 4 + n) * D * MW; t.K = MW; t.mode = 0; }
    else if (r < 3728) { r -= 3472; const int nt = r % 16, kt = r / 16; t.src = p.w_out + (size_t)l * D * D; t.ld = D; t.Nsrc = D; t.k0 = kt * 64; t.n0 = nt * 64; t.dst = p.woutT + (size_t)l * D * D; t.K = D; t.mode = 0; }
    else if (r < 3728 + 16384) { r -= 3728; const int ee = r / 512; r %= 512; const int nt = r % 32, kt = r / 32;
        t.src = p.moe_w1 + (size_t)(l * NE + ee) * D * 2 * D; t.ld = 2 * D; t.Nsrc = 2 * D; t.k0 = kt * 64; t.n0 = nt * 64; t.dst = p.w1T + (size_t)(l * NE + ee) * 2 * D * D; t.K = D; t.mode = 1; }
    else { r -= 3728 + 16384; const int ee = r / 256; r %= 256; const int nt = r % 16, kt = r / 16;
        t.src = p.moe_w2 + (size_t)(l * NE + ee) * D * D; t.ld = D; t.Nsrc = D; t.k0 = kt * 64; t.n0 = nt * 64; t.dst = p.w2T + (size_t)(l * NE + ee) * D * D; t.K = D; t.mode = 0; }
    return t;
}

constexpr int CVT_TOTAL = 2 * (2960 + 512 + 256 + 16384 + 8192);
constexpr int CVT_G_FIRST = 932;
constexpr int CVT_G_L0 = 8008;
constexpr int CVT_G_ALL = CVT_TOTAL / 4;
__device__ __forceinline__ void cvt_trip(const Params& p, LAS float* tile, int tid, int g) {
    constexpr int TOTAL = CVT_TOTAL;
    float4 v[4][2];
    const int rr = tid >> 4, c4 = (tid & 15) * 4;
#pragma unroll
    for (int q = 0; q < 4; ++q) {
        const int it = g * 4 + q;
        const CvtTile t = cvt_decode(p, it < TOTAL ? it : TOTAL - 1);
        const int n = t.n0 + c4; const bool ok = n < t.Nsrc; const int nc = ok ? n : t.Nsrc - 4;
#pragma unroll
        for (int i = 0; i < 2; ++i) { const float4 x = *(const float4*)(t.src + (size_t)(t.k0 + rr + i * 32) * t.ld + nc); v[q][i] = ok ? x : make_float4(0.f, 0.f, 0.f, 0.f); }
    }
#pragma unroll
    for (int q = 0; q < 4; ++q)
#pragma unroll
        for (int i = 0; i < 2; ++i) { LAS float* tp = tile + q * 4160 + (rr + i * 32) * 65 + c4; tp[0] = v[q][i].x; tp[1] = v[q][i].y; tp[2] = v[q][i].z; tp[3] = v[q][i].w; }
    __syncthreads();
#pragma unroll
    for (int q = 0; q < 4; ++q) {
        const int it = g * 4 + q;
        if (it < TOTAL) {
            const CvtTile t = cvt_decode(p, it);
            const int nl = tid >> 3, kg = tid & 7, n = t.n0 + nl;
            float w[8];
#pragma unroll
            for (int j = 0; j < 8; ++j) w[j] = tile[q * 4160 + (kg * 8 + j) * 65 + nl];
            const int drow = t.mode == 1 ? w1_dst_row(n) : t.mode == 2 ? win_dst_row(n) : n;
            if (n < t.Nsrc) *(u32x4*)(t.dst + (size_t)drow * t.K + t.k0 + kg * 8) = pack8(w);
        }
    }
    __syncthreads();
}
__device__ __forceinline__ void cvt_fill(const Params& p, LAS unsigned char* lds, int w, int b1, int n1, int b2, int n2) {
    LAS float* tile = (LAS float*)lds; LAS int* tk = (LAS int*)(lds + 4 * 4160 * 4);
    int* const head = p.cnt + 256 + 32 * w;
    const int tid = opaque_tid();
    __syncthreads();
    int nxt = 0;
    if (tid == 0) nxt = atomicAdd(head, 1);
    for (;;) {
        if (tid == 0) tk[0] = nxt;
        __syncthreads();
        const int t = __builtin_amdgcn_readfirstlane(tk[0]);
        if (t >= n1 + n2) break;
        if (tid == 0) nxt = atomicAdd(head, 1);
        cvt_trip(p, tile, tid, t < n1 ? b1 + t : b2 + (t - n1));
    }
}
constexpr int CW_G1A = 932, CW_SEQ0A = 1932, CW_G2 = 4476, CW_G3 = 6476, CW_SEQ0B = 7076, CW_G1B = 8842, CW_SEQ1 = 9842;

__device__ __forceinline__ void ph_convert(const Params& p, LAS unsigned char* lds) {
    LAS float* tile = (LAS float*)lds;
    const int tid = opaque_tid();
    for (int idx = blockIdx.x * NTHREADS + tid; idx < 2 * 8 * 4 * 4096; idx += gridDim.x * NTHREADS) {
        const int i = idx & 63, j = (idx >> 6) & 63, mat = (idx >> 12) & 3, n = (idx >> 14) & 7, ll = idx >> 17, d = mat >> 1;
        p.lruT[idx] = (bf16_t)f2bf(((mat & 1) ? p.lru_wx : p.lru_wa)[(size_t)((ll * 2 + d) * 8 + n) * 4096 + i * 64 + j]);
    }
    for (int idx = blockIdx.x * NTHREADS + tid; idx < 2 * 2 * MW; idx += gridDim.x * NTHREADS) p.lsig[idx] = 8.0f * logsigmoidf_(p.lru_lambda[idx]);
    for (int idx = blockIdx.x * NTHREADS + tid; idx < TL * 64; idx += gridDim.x * NTHREADS) {
        const int t = idx >> 6, pi = idx & 63;
        const float pos = (pi < 32) ? (float)(t >> 6) : (float)(t & 63);
        const float ang = pos * exp2f(-(float)(pi & 31) * (13.287712379549449f / 32.0f));
        float sn, cs; sincosf(ang, &sn, &cs);
        p.rope[idx] = make_float2(cs, sn);
    }
    for (int idx = blockIdx.x * NTHREADS + tid; idx < 2 * 240 * (D / 8); idx += gridDim.x * NTHREADS) {
        const int ll = idx / (240 * (D / 8)), r = idx % (240 * (D / 8));
        *(u32x4*)(p.winT + ((size_t)ll * NPW + 7696) * D + (size_t)r * 8) = (u32x4){0u, 0u, 0u, 0u};
    }
    for (int g = blockIdx.x; g < CVT_G_FIRST; g += gridDim.x) cvt_trip(p, tile, tid, g);
}

__device__ __forceinline__ void ph_mod(const Params& p, LAS unsigned char* lds) {
    LAS float* sc = (LAS float*)lds;
    LAS float* red = sc + 5 * D;
    const int tid = opaque_tid(), wid = tid >> 6, lane = tid & 63;
    if ((int)blockIdx.x >= 192) return;
    for (int i = tid; i < 5 * D; i += NTHREADS) { const int r = i >> 10, k = i & 1023; const float v = r < 4 ? p.c[r * D + k] : p.c_ctx[k]; sc[i] = siluf_(v); }
    __syncthreads();
    for (int it = blockIdx.x; it < 192; it += gridDim.x) {
        const int l = it / 96, n0 = (it % 96) * 64;
        float acc[5] = {0.f, 0.f, 0.f, 0.f, 0.f};
        const float* wp = p.w_mod + (size_t)l * D * (NMOD * D) + n0 + lane;
        for (int k = wid * 128; k < wid * 128 + 128; ++k) {
            const float wv = wp[(size_t)k * (NMOD * D)];
#pragma unroll
            for (int r = 0; r < 5; ++r) acc[r] += sc[r * D + k] * wv;
        }
#pragma unroll
        for (int r = 0; r < 5; ++r) red[(wid * 5 + r) * 64 + lane] = acc[r];
        __syncthreads();
        if (tid < 320) { const int r = tid >> 6, cidx = tid & 63; float s = p.b_mod[l * NMOD * D + n0 + cidx];
#pragma unroll
            for (int w = 0; w < 8; ++w) s += red[(w * 5 + r) * 64 + cidx];
            p.mod[(size_t)(l * 5 + r) * (NMOD * D) + n0 + cidx] = s; }
        __syncthreads();
    }
}

__device__ __forceinline__ void norm_mod_store(const float4 (&v)[4], float rinv, const float* g, const float* scp, const float* shp, bf16_t* dst, int lane) {
#pragma unroll
    for (int i = 0; i < 4; ++i) {
        const int cidx = i * 256 + lane * 4;
        const float4 gv = *(const float4*)(g + cidx), sv = *(const float4*)(scp + cidx), hv = *(const float4*)(shp + cidx);
        const float h0 = v[i].x * rinv * gv.x * (1.f + sv.x) + hv.x, h1 = v[i].y * rinv * gv.y * (1.f + sv.y) + hv.y;
        const float h2 = v[i].z * rinv * gv.z * (1.f + sv.z) + hv.z, h3 = v[i].w * rinv * gv.w * (1.f + sv.w) + hv.w;
        u32x2 o; o[0] = pack2(h0, h1); o[1] = pack2(h2, h3);
        *(u32x2*)(dst + cidx) = o;
    }
}
__device__ __forceinline__ void ph_norm1_first(const Params& p) {
    const int tid = opaque_tid(), wid = tid >> 6, lane = tid & 63;
    for (int tok = blockIdx.x * NWAVES + wid; tok < NTOK; tok += gridDim.x * NWAVES) {
        const float* src = tok < NLAT ? p.x + (size_t)tok * D : p.ctx + (size_t)(tok - NLAT) * D;
        float4 v[4]; float ss = 0.f;
#pragma unroll
        for (int i = 0; i < 4; ++i) { v[i] = *(const float4*)(src + i * 256 + lane * 4); ss += v[i].x * v[i].x + v[i].y * v[i].y + v[i].z * v[i].z + v[i].w * v[i].w; }
        ss = wave_sum(ss, lane);
        const float rinv = rsqrtf(ss * (1.0f / D) + 1e-6f);
        const float* mb = p.mod + (size_t)(0 * 5 + tok_modrow(tok)) * (NMOD * D);
        norm_mod_store(v, rinv, p.norm1_g, mb + 1 * D, mb + 0 * D, p.H + (size_t)tok * D, lane);
#pragma unroll
        for (int i = 0; i < 4; ++i) *(float4*)(p.xl + (size_t)tok * D + i * 256 + lane * 4) = v[i];
    }
}

struct EpiP {
    bf16_t* O; bf16_t* gate;
    __device__ __forceinline__ bool keep(const g8::Unit&) const { return false; }
    __device__ __forceinline__ void operator()(const f32x4 (&acc)[2][2][4][2], const g8::Unit& u, int wr, int wc, int fr, int fq, const LAS float*) const {
        if (u.pn < 31) {
            const int row0 = u.pm * 256 + wr * 64 + fr, col0 = u.pn * 256 + wc * 32 + 8 * fq;
#pragma unroll
            for (int ai = 0; ai < 2; ++ai)
#pragma unroll
                for (int m = 0; m < 4; ++m) {
                    bf16_t* rowp = O + (size_t)(row0 + ai * 128 + m * 16) * NP + col0;
#pragma unroll
                    for (int bj = 0; bj < 2; ++bj) {
                        u32x4 w; w[0] = pack2(acc[ai][bj][m][0][0], acc[ai][bj][m][0][1]); w[1] = pack2(acc[ai][bj][m][0][2], acc[ai][bj][m][0][3]);
                        w[2] = pack2(acc[ai][bj][m][1][0], acc[ai][bj][m][1][1]); w[3] = pack2(acc[ai][bj][m][1][2], acc[ai][bj][m][1][3]);
                        *(u32x4*)(rowp + bj * 128) = w;
                    }
                }
        } else {
            const int t = u.pn - 31;
            const int wave2 = wr * 4 + (t & 1) * 2 + (wc >> 1), lane2 = ((wc & 1) * 2 + (fq >> 1)) * 16 + fr, bj2 = (t & 3) >> 1;
            bf16_t* gp = gate + ((((size_t)u.pm * 16 + (t >> 2)) * 8 + wave2) * 16 + bj2) * 512 + lane2 * 8 + (fq & 1) * 4;
#pragma unroll
            for (int ai = 0; ai < 2; ++ai)
#pragma unroll
                for (int m = 0; m < 4; ++m) {
                    float r[4][4];
#pragma unroll
                    for (int j = 0; j < 4; ++j) {
                        float d[4];
#pragma unroll
                        for (int sg = 0; sg < 4; ++sg) d[sg] = 1.0f + __expf(-fminf(fmaxf(acc[ai][sg >> 1][m][sg & 1][j], -30.0f), 30.0f));
#pragma unroll
                        for (int sg = 0; sg < 4; ++sg) { const float gi = __builtin_amdgcn_rcpf(d[sg]); r[sg][j] = sg < 3 ? gi * d[sg + 1] : gi; }
                    }
#pragma unroll
                    for (int sg = 0; sg < 4; ++sg) {
                        uint2 w; w.x = pack2(r[sg][0], r[sg][1]); w.y = pack2(r[sg][2], r[sg][3]);
                        *(uint2*)(gp + (size_t)sg * (4 * 8 * 16 * 512) + (ai * 8 + m * 2) * 512) = w;
                    }
                }
        }
    }
};
__device__ __forceinline__ void ph_g1(const Params& p, int l, LAS unsigned char* lds) {
    g8::PlainSched S; S.init(p.H, p.winT + (size_t)l * NPW * D, NTOK, NPW, D);
    EpiP E; E.O = p.P; E.gate = p.gate;
    g8::gemm_phase(lds, D, S, E);
    if ((int)blockIdx.x >= (NTOK / 256) * (NPW / 256) % 256) { if (l == 0) cvt_fill(p, lds, 2, CW_G1A, CW_SEQ0A - CW_G1A, 0, 0); else cvt_fill(p, lds, 3, CW_G1B, CW_SEQ1 - CW_G1B, 0, 0); }
}

__device__ __forceinline__ void ph_prep(const Params& p, int l, LAS unsigned char* lds) {
    const int tid = opaque_tid(), wid = tid >> 6, lane = tid & 63, fr = lane & 15, fq = lane >> 4;
    LAS float* xs = (LAS float*)lds;
    LAS bf16_t* xb = (LAS bf16_t*)(xs + 64 * 68);
    LAS bf16_t* wt = xb + 64 * 72;
    for (int it = blockIdx.x; it < (NTOK / 64) * 8; it += gridDim.x) {
        const int tile = it >> 3, n = it & 7, tok0 = tile * 64;
        {
            const int tl = tid & 63, cg = tid >> 6, tok = tok0 + tl;
            int t, T, base; tok_info(tok, t, T, base);
            float a[8];
            { const float4 b0 = *(const float4*)(p.lru_conv_b + l * MW + n * 64 + cg * 8), b1 = *(const float4*)(p.lru_conv_b + l * MW + n * 64 + cg * 8 + 4);
              a[0] = b0.x; a[1] = b0.y; a[2] = b0.z; a[3] = b0.w; a[4] = b1.x; a[5] = b1.y; a[6] = b1.z; a[7] = b1.w; }
#pragma unroll
            for (int j = 0; j < 4; ++j) {
                const int tt = t + j - 2;
                const float okf = (tt >= 0 && tt < T) ? 1.0f : 0.0f;
                const int ttc = tt < 0 ? 0 : (tt >= T ? T - 1 : tt);
                const u32x4 u = *(const u32x4*)(p.P + (size_t)(base + ttc) * NP + C_LX + n * 64 + cg * 8);
                const float* w = p.lru_conv_w + (size_t)(l * 4 + j) * MW + n * 64 + cg * 8;
                const float4 wa = *(const float4*)w, wb = *(const float4*)(w + 4);
                const float wv[8] = {wa.x * okf, wa.y * okf, wa.z * okf, wa.w * okf, wb.x * okf, wb.y * okf, wb.z * okf, wb.w * okf};
#pragma unroll
                for (int q = 0; q < 4; ++q) { a[2 * q] += wv[2 * q] * bflo(u[q]); a[2 * q + 1] += wv[2 * q + 1] * bfhi(u[q]); }
            }
            *(LAS f32x4*)(xs + tl * 68 + cg * 8) = (f32x4){a[0], a[1], a[2], a[3]}; *(LAS f32x4*)(xs + tl * 68 + cg * 8 + 4) = (f32x4){a[4], a[5], a[6], a[7]};
            *(LAS u32x4*)(xb + tl * 72 + cg * 8) = pack8(a);
            const bf16_t* wsrc = p.lruT + (size_t)((l * 8 + n) * 4) * 4096;
#pragma unroll
            for (int q = 0; q < 4; ++q) { const int e8 = tid + 512 * q, row = e8 >> 3, c8 = e8 & 7; *(LAS u32x4*)(wt + row * 72 + c8 * 8) = *(const u32x4*)(wsrc + (size_t)e8 * 8); }
        }
        __syncthreads();
        {
            const int jb = wid & 3, tb0 = (wid >> 2) * 2;
            bf16x8 xw[4][2];
#pragma unroll
            for (int m = 0; m < 4; ++m)
#pragma unroll
                for (int ks = 0; ks < 2; ++ks) xw[m][ks] = *(const LAS bf16x8*)(wt + (m * 64 + jb * 16 + fr) * 72 + ks * 32 + fq * 8);
            const int c0 = n * 64 + jb * 16 + 4 * fq;
            float4 bav[2], bxv[2], lsv[2];
#pragma unroll
            for (int d = 0; d < 2; ++d) {
                bav[d] = *(const float4*)(p.lru_ba + (l * 2 + d) * MW + c0); bxv[d] = *(const float4*)(p.lru_bx + (l * 2 + d) * MW + c0);
                lsv[d] = *(const float4*)(p.lsig + (l * 2 + d) * MW + c0);
            }
#pragma unroll
            for (int e = 0; e < 2; ++e) {
                const int tl = (tb0 + e) * 16 + fr, tok = tok0 + tl;
                f32x4 acc[4];
#pragma unroll
                for (int m = 0; m < 4; ++m) acc[m] = (f32x4){0.f, 0.f, 0.f, 0.f};
#pragma unroll
                for (int ks = 0; ks < 2; ++ks) {
                    const bf16x8 y = *(const LAS bf16x8*)(xb + tl * 72 + ks * 32 + fq * 8);
#pragma unroll
                    for (int m = 0; m < 4; ++m) acc[m] = mfma16(xw[m][ks], y, acc[m]);
                }
                const f32x4 xv = *(const LAS f32x4*)(xs + tl * 68 + jb * 16 + 4 * fq);
#pragma unroll
                for (int d = 0; d < 2; ++d) {
                    const float bar_[4] = {bav[d].x, bav[d].y, bav[d].z, bav[d].w}, bxr[4] = {bxv[d].x, bxv[d].y, bxv[d].z, bxv[d].w}, lsr[4] = {lsv[d].x, lsv[d].y, lsv[d].z, lsv[d].w};
                    float av[4], uv[4];
#pragma unroll
                    for (int r = 0; r < 4; ++r) {
                        const float gr = sigmoidf_(acc[d * 2][r] + bar_[r]), gi = sigmoidf_(acc[d * 2 + 1][r] + bxr[r]);
                        const float la = gr * lsr[r];
                        av[r] = __expf(la);
                        uv[r] = xv[r] * gi * __builtin_amdgcn_sqrtf(fmaxf(1.0f - __expf(2.0f * la), 1e-12f));
                    }
                    *(float4*)(p.prep + (PR_LA + d) * TOKW + (size_t)tok * MW + c0) = make_float4(av[0], av[1], av[2], av[3]);
                    *(float4*)(p.prep + (PR_LU + d) * TOKW + (size_t)tok * MW + c0) = make_float4(uv[0], uv[1], uv[2], uv[3]);
                }
            }
        }
        __syncthreads();
    }
}

__device__ __forceinline__ int chunk_base(int b, int d, int n) {
    if (n < 4) { const int blk = d ? 3 - n : n; return NLAT + b * TC + blk * 64; }
    const int m = n - 4, blk = d ? 63 - m : m; return b * TL + blk * 64;
}

__device__ __forceinline__ void local_gla(const Params& p, int l, int tz, int chain, int n, LAS unsigned char* lds) {
    const int tid = opaque_tid(), wid = tid >> 6, lane = tid & 63, fr = lane & 15, fq = lane >> 4;
    const int b = chain >> 3, h = (chain >> 1) & 3, d = chain & 1;
    const int base = chunk_base(b, d, n);
    const size_t item = (size_t)tz * NITEM + (size_t)chain * NCHUNK + n;
    LAS bf16_t* qh = (LAS bf16_t*)lds;
    LAS bf16_t* kh = qh + 64 * 136;
    LAS bf16_t* sc = kh + 10 * 16 * 136;
    LAS bf16_t* vT = sc + 64 * 72;
    LAS bf16_t* kT = vT + 128 * 72;
    LAS float* bc = (LAS float*)(kT + 128 * 72);
    const int vcol = tz == 1 ? C_HI : C_RQKV + 1024;
    const int ti = tid >> 3, dg = tid & 7, cA = dg * 8, cB = 64 + dg * 8;
    const int tokI = base + (d ? 63 - ti : ti);
    const bf16_t* pr = p.P + (size_t)tokI * NP;
    float qt[16], kv[16];
    {
        float lfv[16];
        if (tz == 1) {
            float lbv[16];
            {
                const float* lp0 = p.hgrn_lb + (size_t)(0 * 2 + d) * MW + h * 128; const float* lp1 = p.hgrn_lb + (size_t)(1 * 2 + d) * MW + h * 128;
                const float4 a0 = *(const float4*)(lp0 + cA), a1 = *(const float4*)(lp0 + cA + 4), a2 = *(const float4*)(lp0 + cB), a3 = *(const float4*)(lp0 + cB + 4);
                const float4 b0 = *(const float4*)(lp1 + cA), b1 = *(const float4*)(lp1 + cA + 4), b2 = *(const float4*)(lp1 + cB), b3 = *(const float4*)(lp1 + cB + 4);
                const float x0[16] = {a0.x, a0.y, a0.z, a0.w, a1.x, a1.y, a1.z, a1.w, a2.x, a2.y, a2.z, a2.w, a3.x, a3.y, a3.z, a3.w};
                const float x1[16] = {b0.x, b0.y, b0.z, b0.w, b1.x, b1.y, b1.z, b1.w, b2.x, b2.y, b2.z, b2.w, b3.x, b3.y, b3.z, b3.w};
#pragma unroll
                for (int e = 0; e < 16; ++e) lbv[e] = (l == 1) ? fminf(__builtin_amdgcn_rcpf(1.0f + __expf(x0[e] - x1[e])), 1.0f - 1e-4f) : 0.f;
            }
            const u32x4 uqa = *(const u32x4*)(pr + C_HQ + h * 128 + cA), uqb = *(const u32x4*)(pr + C_HQ + h * 128 + cB);
            const u32x4 uza = *(const u32x4*)(pr + C_HF + d * 512 + h * 128 + cA), uzb = *(const u32x4*)(pr + C_HF + d * 512 + h * 128 + cB);
#pragma unroll
            for (int e = 0; e < 16; ++e) {
                const unsigned uq = e < 8 ? uqa[(e & 7) >> 1] : uqb[(e & 7) >> 1], uz = e < 8 ? uza[(e & 7) >> 1] : uzb[(e & 7) >> 1];
                const float qraw = (e & 1) ? bfhi(uq) : bflo(uq), z = (e & 1) ? bfhi(uz) : bflo(uz);
                const float lb = lbv[e];
                const float sg = sigmoidf_(z);
                qt[e] = siluf_(qraw) * 0.08838834764831845f;
                kv[e] = (1.f - lb) * (1.f - sg);
                lfv[e] = __logf(fmaxf(lb + (1.f - lb) * sg, 1e-30f));
            }
        }
        *(LAS f32x4*)(bc + ti * 132 + cA) = (f32x4){lfv[0], lfv[1], lfv[2], lfv[3]}; *(LAS f32x4*)(bc + ti * 132 + cA + 4) = (f32x4){lfv[4], lfv[5], lfv[6], lfv[7]};
        *(LAS f32x4*)(bc + ti * 132 + cB) = (f32x4){lfv[8], lfv[9], lfv[10], lfv[11]}; *(LAS f32x4*)(bc + ti * 132 + cB + 4) = (f32x4){lfv[12], lfv[13], lfv[14], lfv[15]};
        const bf16_t* vp = pr + vcol + h * 128;
        const u32x4 v0 = *(const u32x4*)(vp + cA), v1 = *(const u32x4*)(vp + cB);
#pragma unroll
        for (int e = 0; e < 8; ++e) {
            vT[(cA + e) * 72 + ti] = (bf16_t)((e & 1) ? (v0[e >> 1] >> 16) : (v0[e >> 1] & 0xffffu));
            vT[(cB + e) * 72 + ti] = (bf16_t)((e & 1) ? (v1[e >> 1] >> 16) : (v1[e >> 1] & 0xffffu));
        }
    }
    __syncthreads();
    if (tid < 128) {
        float run = 0.f, lv[64];
#pragma unroll
        for (int i = 0; i < 64; ++i) lv[i] = bc[i * 132 + tid];
#pragma unroll
        for (int i = 0; i < 64; ++i) { run += lv[i]; bc[i * 132 + tid] = run; }
    }
    __syncthreads();
    {
        const int J = ti >> 4;
        float qhat[16];
#pragma unroll
        for (int e = 0; e < 16; ++e) {
            const int ch = e < 8 ? cA + e : cB + e - 8;
            const float bi = bc[ti * 132 + ch], rJ = J ? bc[(16 * J - 1) * 132 + ch] : 0.f, bl = bc[63 * 132 + ch];
            qhat[e] = qt[e] * __expf(bi - rJ); qt[e] = qt[e] * __expf(bi);
            kT[ch * 72 + ti] = (bf16_t)f2bf(kv[e] * __expf(bl - bi));
        }
        *(LAS u32x4*)(qh + ti * 136 + cA) = pack8(qhat); *(LAS u32x4*)(qh + ti * 136 + cB) = pack8(qhat + 8);
#pragma unroll
        for (int I = 0; I < 4; ++I) {
            if (I >= J) {
                float kk[16];
#pragma unroll
                for (int e = 0; e < 16; ++e) {
                    const int ch = e < 8 ? cA + e : cB + e - 8;
                    const float rI = I ? bc[(16 * I - 1) * 132 + ch] : 0.f, bj = bc[ti * 132 + ch];
                    kk[e] = kv[e] * __expf(fminf(rI - bj, 80.f));
                }
                LAS bf16_t* kp = kh + ((I * (I + 1) / 2 + J) * 16 + (ti & 15)) * 136;
                *(LAS u32x4*)(kp + cA) = pack8(kk); *(LAS u32x4*)(kp + cB) = pack8(kk + 8);
            }
        }
        *(LAS u32x4*)(sc + ti * 72 + dg * 8) = (u32x4){0u, 0u, 0u, 0u};
        {
            bf16_t* lqb = p.lq + item * 8192 + (size_t)((ti >> 4) * 8) * 256 + (ti & 15) * 4;
            const u32x4 pa = pack8(qt), pb = pack8(qt + 8);
            u32x2 t0; t0[0] = pa[0]; t0[1] = pa[1]; u32x2 t1; t1[0] = pa[2]; t1[1] = pa[3]; u32x2 t2; t2[0] = pb[0]; t2[1] = pb[1]; u32x2 t3; t3[0] = pb[2]; t3[1] = pb[3];
            *(u32x2*)(lqb + (dg >> 1) * 256 + ((dg & 1) * 2 + 0) * 64) = t0; *(u32x2*)(lqb + (dg >> 1) * 256 + ((dg & 1) * 2 + 1) * 64) = t1;
            *(u32x2*)(lqb + (4 + (dg >> 1)) * 256 + ((dg & 1) * 2 + 0) * 64) = t2; *(u32x2*)(lqb + (4 + (dg >> 1)) * 256 + ((dg & 1) * 2 + 1) * 64) = t3;
        }
    }
    if (tid < 128) p.ld[item * 128 + tid] = __expf(bc[63 * 132 + tid]);
    __syncthreads();
#pragma unroll
    for (int rep2 = 0; rep2 < 2; ++rep2) {
        const int t = wid + 8 * rep2;
        if (t < 10) {
            const int I = t >= 6 ? 3 : t >= 3 ? 2 : t >= 1 ? 1 : 0, J = t - I * (I + 1) / 2;
            f32x4 acc = (f32x4){0.f, 0.f, 0.f, 0.f};
#pragma unroll
            for (int ks = 0; ks < 4; ++ks)
                acc = mfma16(*(const LAS bf16x8*)(kh + (t * 16 + fr) * 136 + ks * 32 + fq * 8), *(const LAS bf16x8*)(qh + (I * 16 + fr) * 136 + ks * 32 + fq * 8), acc);
            const int i = 16 * I + fr, j0 = 16 * J + 4 * fq;
#pragma unroll
            for (int r = 0; r < 4; ++r) if (j0 + r > i) acc[r] = 0.f;
            *(LAS u32x2*)(sc + i * 72 + j0) = pack4(acc);
        }
    }
    __syncthreads();
    {
        bf16x8 xv[2], xk[2];
#pragma unroll
        for (int ks = 0; ks < 2; ++ks) { xv[ks] = *(const LAS bf16x8*)(vT + (wid * 16 + fr) * 72 + ks * 32 + fq * 8); xk[ks] = *(const LAS bf16x8*)(kT + (wid * 16 + fr) * 72 + ks * 32 + fq * 8); }
#pragma unroll
        for (int ib = 0; ib < 4; ++ib) {
            f32x4 acc = (f32x4){0.f, 0.f, 0.f, 0.f};
#pragma unroll
            for (int ks = 0; ks < 2; ++ks) acc = mfma16(xv[ks], *(const LAS bf16x8*)(sc + (ib * 16 + fr) * 72 + ks * 32 + fq * 8), acc);
            *(u32x2*)(p.lo + item * 8192 + ((wid * 4 + ib) * 64 + lane) * 4) = pack4(acc);
        }
#pragma unroll
        for (int dvb = 0; dvb < 8; ++dvb) {
            f32x4 acc = (f32x4){0.f, 0.f, 0.f, 0.f};
#pragma unroll
            for (int ks = 0; ks < 2; ++ks) acc = mfma16(xk[ks], *(const LAS bf16x8*)(vT + (dvb * 16 + fr) * 72 + ks * 32 + fq * 8), acc);
            *(u32x2*)(p.lb + item * 16384 + ((wid * 8 + dvb) * 64 + lane) * 4) = pack4(acc);
        }
    }
    __syncthreads();
}


template <int MODE> __device__ __forceinline__ void local_ret(const Params& p, int l, int chain, int n, LAS unsigned char* lds) {
    const int tid = opaque_tid(), wid = tid >> 6, lane = tid & 63, fr = lane & 15, fq = lane >> 4;
    const int b = chain >> 3, h = (chain >> 1) & 3, d = chain & 1;
    const int base = chunk_base(b, d, n);
    const size_t item = (size_t)2 * NITEM + (size_t)chain * NCHUNK + n;
    LAS bf16_t* ks_ = (LAS bf16_t*)lds;
    LAS bf16_t* qs = ks_ + 64 * 136;
    LAS bf16_t* sc = qs + 64 * 136;
    LAS bf16_t* vT = sc + 64 * 72;
    LAS bf16_t* kT = vT + 128 * 72;
    const int ti = tid >> 3, dg = tid & 7, cA = dg * 8, cB = 64 + dg * 8;
    const int tokI = base + (d ? 63 - ti : ti);
    const bf16_t* pr = p.P + (size_t)tokI * NP + C_RQKV + h * 128;
    const float lng = ret_log_gamma(h);
    {
        const u32x4 q1 = *(const u32x4*)(pr + cA), q2 = *(const u32x4*)(pr + cB), k1 = *(const u32x4*)(pr + 512 + cA), k2 = *(const u32x4*)(pr + 512 + cB);
        const u32x4 v0 = *(const u32x4*)(pr + 1024 + cA), v1 = *(const u32x4*)(pr + 1024 + cB);
        const bool lat = tokI < NLAT;
        const int t = tokI & (TL - 1);
        float qv[16], kv[16];
#pragma unroll
        for (int e = 0; e < 8; ++e) {
            float a1 = (e & 1) ? bfhi(q1[e >> 1]) : bflo(q1[e >> 1]), a2 = (e & 1) ? bfhi(q2[e >> 1]) : bflo(q2[e >> 1]);
            float b1 = (e & 1) ? bfhi(k1[e >> 1]) : bflo(k1[e >> 1]), b2 = (e & 1) ? bfhi(k2[e >> 1]) : bflo(k2[e >> 1]);
            {
                const float2 cst = p.rope[(size_t)t * 64 + cA + e];
                const float cs = lat ? cst.x : 1.0f, sn = lat ? cst.y : 0.0f;
                const float n1 = a1 * cs - a2 * sn, n2 = a1 * sn + a2 * cs, m1 = b1 * cs - b2 * sn, m2 = b1 * sn + b2 * cs;
                a1 = n1; a2 = n2; b1 = m1; b2 = m2;
            }
            qv[e] = a1; qv[8 + e] = a2; kv[e] = b1 * 0.08838834764831845f; kv[8 + e] = b2 * 0.08838834764831845f;
        }
        *(LAS u32x4*)(ks_ + ti * 136 + cA) = pack8(kv); *(LAS u32x4*)(ks_ + ti * 136 + cB) = pack8(kv + 8);
        *(LAS u32x4*)(qs + ti * 136 + cA) = pack8(qv); *(LAS u32x4*)(qs + ti * 136 + cB) = pack8(qv + 8);
        const float gq = __expf((float)(ti + 1) * lng), gk = __expf((float)(63 - ti) * lng);
#pragma unroll
        for (int e = 0; e < 8; ++e) {
            vT[(cA + e) * 72 + ti] = (bf16_t)((e & 1) ? (v0[e >> 1] >> 16) : (v0[e >> 1] & 0xffffu));
            vT[(cB + e) * 72 + ti] = (bf16_t)((e & 1) ? (v1[e >> 1] >> 16) : (v1[e >> 1] & 0xffffu));
            kT[(cA + e) * 72 + ti] = (bf16_t)f2bf(kv[e] * gk); kT[(cB + e) * 72 + ti] = (bf16_t)f2bf(kv[8 + e] * gk);
            qv[e] *= gq; qv[8 + e] *= gq;
        }
        {
            bf16_t* lqb = p.lq + item * 8192 + (size_t)((ti >> 4) * 8) * 256 + (ti & 15) * 4;
            const u32x4 pa = pack8(qv), pb = pack8(qv + 8);
            u32x2 t0; t0[0] = pa[0]; t0[1] = pa[1]; u32x2 t1; t1[0] = pa[2]; t1[1] = pa[3]; u32x2 t2; t2[0] = pb[0]; t2[1] = pb[1]; u32x2 t3; t3[0] = pb[2]; t3[1] = pb[3];
            *(u32x2*)(lqb + (dg >> 1) * 256 + ((dg & 1) * 2 + 0) * 64) = t0; *(u32x2*)(lqb + (dg >> 1) * 256 + ((dg & 1) * 2 + 1) * 64) = t1;
            *(u32x2*)(lqb + (4 + (dg >> 1)) * 256 + ((dg & 1) * 2 + 0) * 64) = t2; *(u32x2*)(lqb + (4 + (dg >> 1)) * 256 + ((dg & 1) * 2 + 1) * 64) = t3;
        }
    }
    if (tid < 128) p.ld[item * 128 + tid] = __expf(64.0f * lng);
    __syncthreads();
#pragma unroll
    for (int e = 0; e < 2; ++e) {
        const int f = wid * 2 + e, ib = f >> 2, jb = f & 3;
        const int i = 16 * ib + fr, j0 = 16 * jb + 4 * fq;
        f32x4 mq = (f32x4){0.f, 0.f, 0.f, 0.f};
        if (jb <= ib) {
#pragma unroll
            for (int ks = 0; ks < 4; ++ks)
                mq = mfma16(*(const LAS bf16x8*)(ks_ + (jb * 16 + fr) * 136 + ks * 32 + fq * 8), *(const LAS bf16x8*)(qs + i * 136 + ks * 32 + fq * 8), mq);
#pragma unroll
            for (int r = 0; r < 4; ++r) { const int j = j0 + r; mq[r] = (j <= i) ? mq[r] * __expf((float)(i - j) * lng) : 0.f; }
        }
        *(LAS u32x2*)(sc + i * 72 + j0) = pack4(mq);
    }
    __syncthreads();
    {
        bf16x8 xv[2], xk[2];
#pragma unroll
        for (int ks = 0; ks < 2; ++ks) { xv[ks] = *(const LAS bf16x8*)(vT + (wid * 16 + fr) * 72 + ks * 32 + fq * 8); xk[ks] = *(const LAS bf16x8*)(kT + (wid * 16 + fr) * 72 + ks * 32 + fq * 8); }
#pragma unroll
        for (int ib = 0; ib < 4; ++ib) {
            f32x4 acc = (f32x4){0.f, 0.f, 0.f, 0.f};
#pragma unroll
            for (int ks = 0; ks < 2; ++ks) acc = mfma16(xv[ks], *(const LAS bf16x8*)(sc + (ib * 16 + fr) * 72 + ks * 32 + fq * 8), acc);
            *(u32x2*)(p.lo + item * 8192 + ((wid * 4 + ib) * 64 + lane) * 4) = pack4(acc);
        }
#pragma unroll
        for (int dvb = 0; dvb < 8; ++dvb) {
            f32x4 acc = (f32x4){0.f, 0.f, 0.f, 0.f};
#pragma unroll
            for (int ks = 0; ks < 2; ++ks) acc = mfma16(xk[ks], *(const LAS bf16x8*)(vT + (dvb * 16 + fr) * 72 + ks * 32 + fq * 8), acc);
            *(u32x2*)(p.lb + item * 16384 + ((wid * 8 + dvb) * 64 + lane) * 4) = pack4(acc);
        }
    }
    __syncthreads();
}

__device__ __forceinline__ void local_gdn(const Params& p, int l, int bh, int seg, int blk, LAS unsigned char* lds) {
    const int tid = opaque_tid(), wid = tid >> 6, lane = tid & 63, fr = lane & 15, fq = lane >> 4;
    const int b = bh >> 2, h = bh & 3;
    const int base = seg ? b * TL + blk * 64 : NLAT + b * TC + blk * 64;
    LAS bf16_t* ks_ = (LAS bf16_t*)lds;
    LAS bf16_t* qs = ks_ + 64 * 136;
    LAS bf16_t* att = qs + 64 * 136;
    LAS bf16_t* wT = att + 64 * 72;
    LAS bf16_t* uT = wT + 128 * 72;
    LAS bf16_t* kT = uT + 128 * 72;
    LAS bf16_t* tT = kT;
    LAS bf16_t* Mneg = kT + 128 * 72;
    LAS float* Md = (LAS float*)(Mneg + 64 * 72);
    LAS float* bcs = (LAS float*)(kT + 128 * 72) + 64 * 68;
    LAS float* bts = bcs + 64;
    LAS float* rse = bts + 64;
    LAS bf16_t* vs = (LAS bf16_t*)(rse + 64);
    LAS bf16_t* Db = (LAS bf16_t*)(vs + 64 * 136);
    LAS float* cw = (LAS float*)(vs + 64 * 136);
    const int ti = tid >> 3, d0 = (tid & 7) * 16;
    const int tokI = base + ti;
    {
        int t, T, sbase; tok_info(tokI, t, T, sbase);
        u32x4 xr[3][4][2];
#pragma unroll
        for (int j = 0; j < 4; ++j) {
            const int tt = t + j - 2;
            const bool ok = (tt >= 0 && tt < T);
            const int ttc = tt < 0 ? 0 : (tt >= T ? T - 1 : tt);
            const bf16_t* xp = p.P + (size_t)(sbase + ttc) * NP + C_GQKV + h * 128 + d0;
#pragma unroll
            for (int part = 0; part < 3; ++part) {
                const u32x4 a0 = *(const u32x4*)(xp + part * 512), a1 = *(const u32x4*)(xp + part * 512 + 8);
#pragma unroll
                for (int q = 0; q < 4; ++q) { xr[part][j][0][q] = ok ? a0[q] : 0u; xr[part][j][1][q] = ok ? a1[q] : 0u; }
            }
        }
        if (tid < 384) {
            const int row = tid >> 5, c4 = (tid & 31) * 4, part = row >> 2, j = row & 3;
            *(LAS f32x4*)(cw + row * 128 + c4) = *(const f32x4*)(p.gdn_conv_w + (size_t)(l * 4 + j) * 1536 + part * 512 + h * 128 + c4);
        }
        __syncthreads();
#pragma unroll
        for (int part = 0; part < 3; ++part) {
            float a[16];
#pragma unroll
            for (int e = 0; e < 16; ++e) a[e] = 0.f;
#pragma unroll
            for (int j = 0; j < 4; ++j) {
                const u32x4 x0 = xr[part][j][0], x1 = xr[part][j][1];
                const LAS float* wp = cw + (part * 4 + j) * 128 + d0;
#pragma unroll
                for (int q = 0; q < 4; ++q) {
                    const f32x4 w0 = *(const LAS f32x4*)(wp + q * 4);
                    const unsigned ua = q < 2 ? x0[2 * q] : x1[2 * q - 4], ub = q < 2 ? x0[2 * q + 1] : x1[2 * q - 3];
                    a[q * 4] += w0[0] * bflo(ua); a[q * 4 + 1] += w0[1] * bfhi(ua); a[q * 4 + 2] += w0[2] * bflo(ub); a[q * 4 + 3] += w0[3] * bfhi(ub);
                }
            }
            float ss = 0.f;
#pragma unroll
            for (int e = 0; e < 16; ++e) { a[e] = siluf_(a[e]); ss += a[e] * a[e]; }
            if (part < 2) {
                ss += shx(ss, 1, lane); ss += shx(ss, 2, lane); ss += shx(ss, 4, lane);
                const float scl = rsqrtf(ss + 1e-6f) * (part == 0 ? 0.08838834764831845f : 1.0f);
#pragma unroll
                for (int e = 0; e < 16; ++e) a[e] *= scl;
            }
            LAS bf16_t* dstt = (part == 0 ? qs : part == 1 ? ks_ : vs) + ti * 136 + d0;
            *(LAS u32x4*)dstt = pack8(a); *(LAS u32x4*)(dstt + 8) = pack8(a + 8);
        }
    }
#pragma unroll 1
  for (int d = 0; d < 2; ++d) {
    const int n = seg ? 4 + (d ? 63 - blk : blk) : (d ? 3 - blk : blk);
    const size_t item = (size_t)(bh * 2 + d) * NCHUNK + n;
#define RR(x) (d ? 63 - (x) : (x))
    const int tid = opaque_tid(), wid = tid >> 6, lane = tid & 63, fr = lane & 15, fq = lane >> 4, ti = tid >> 3, d0 = (tid & 7) * 16;
    if (wid == 0) {
        const int tok = base + RR(lane);
        const float av = bf2f(p.P[(size_t)tok * NP + C_GA + d * 4 + h]);
        float v = -__expf(p.gdn_a_log[l * 8 + d * 4 + h]) * softplusf_(av + p.gdn_dt_bias[l * 8 + d * 4 + h]);
#pragma unroll
        for (int off = 1; off < 64; off <<= 1) { const float t = shup(v, off, lane); if (lane >= off) v += t; }
        const float btv = sigmoidf_(bf2f(p.P[(size_t)tok * NP + C_GB + d * 4 + h]));
        bcs[lane] = v; bts[lane] = btv; rse[lane] = btv * __expf(v);
    }
    __syncthreads();
#pragma unroll
    for (int e = 0; e < 2; ++e) {
        const int f = wid * 2 + e, ib = f >> 2, jb = f & 3;
        const int i = 16 * ib + fr, j0 = 16 * jb + 4 * fq;
        f32x4 mk = (f32x4){0.f, 0.f, 0.f, 0.f}, mq = (f32x4){0.f, 0.f, 0.f, 0.f};
        if (jb <= ib) {
#pragma unroll
            for (int ks = 0; ks < 4; ++ks) {
                const bf16x8 xk = *(const LAS bf16x8*)(ks_ + RR(jb * 16 + fr) * 136 + ks * 32 + fq * 8);
                mk = mfma16(xk, *(const LAS bf16x8*)(ks_ + RR(ib * 16 + fr) * 136 + ks * 32 + fq * 8), mk);
                mq = mfma16(xk, *(const LAS bf16x8*)(qs + RR(ib * 16 + fr) * 136 + ks * 32 + fq * 8), mq);
            }
            const float bi = bcs[i], bti = bts[i];
#pragma unroll
            for (int r = 0; r < 4; ++r) {
                const int j = j0 + r;
                const float dec = __expf(j <= i ? bi - bcs[j] : 0.f);
                mk[r] = (j < i) ? bti * mk[r] * dec : 0.f;
                mq[r] = (j <= i) ? mq[r] * dec : 0.f;
            }
        }
        {
            u32x2 mn; mn[0] = 0u; mn[1] = 0u;
            if (jb < ib) mn = pack4((f32x4){-mk[0], -mk[1], -mk[2], -mk[3]});
            *(LAS u32x2*)(Mneg + i * 72 + j0) = mn;
            if (jb == ib) *(LAS f32x4*)(Md + (ib * 16 + fr) * 20 + 4 * fq) = mk;
        }
        *(LAS u32x2*)(att + i * 72 + j0) = pack4(mq);
        if (e == 0) {
            const int zr = tid >> 1, zh = tid & 1;
            LAS bf16_t* zx = (zr < 128 ? uT + zr * 72 : wT + (zr - 128) * 72) + zh * 32;
#pragma unroll
            for (int q = 0; q < 4; ++q) *(LAS u32x4*)(zx + q * 8) = (u32x4){0u, 0u, 0u, 0u};
            *(LAS u32x4*)(tT + zr * 32 + 16 + zh * 8) = (u32x4){0u, 0u, 0u, 0u};
        }
    }
    __syncthreads();
    if (wid == 0) {
        const int R = lane >> 4, cc = lane & 15;
        float y[16];
#pragma unroll
        for (int i = 0; i < 16; ++i) {
            float acc = (i == cc) ? 1.0f : 0.0f;
#pragma unroll
            for (int j4 = 0; j4 < (i + 3) / 4; ++j4) {
                const f32x4 m = *(const LAS f32x4*)(Md + (R * 16 + i) * 20 + j4 * 4);
#pragma unroll
                for (int q = 0; q < 4; ++q) if (j4 * 4 + q < i) acc -= m[q] * y[j4 * 4 + q];
            }
            y[i] = acc;
            Db[(R * 16 + i) * 40 + cc] = (bf16_t)f2bf(acc);
        }
        *(LAS u32x4*)(Db + lane * 40 + 16) = (u32x4){0u, 0u, 0u, 0u}; *(LAS u32x4*)(Db + lane * 40 + 24) = (u32x4){0u, 0u, 0u, 0u};
    }
    __syncthreads();
#pragma unroll
    for (int R = 0; R < 4; ++R) {
        f32x4 tacc[2];
#pragma unroll
        for (int e = 0; e < 2; ++e) {
            const int cb = wid * 2 + e;
            const int i = 16 * R + fr;
            const u32x2 rv = *(const LAS u32x2*)((cb < 8 ? vs + cb * 16 : ks_ + (cb - 8) * 16) + RR(i) * 136 + 4 * fq);
            const float sc = cb < 8 ? bts[i] : -rse[i];
            f32x4 acc = (f32x4){bflo(rv[0]) * sc, bfhi(rv[0]) * sc, bflo(rv[1]) * sc, bfhi(rv[1]) * sc};
            if (R > 0) {
                const LAS bf16_t* xt = (cb < 8 ? uT + cb * 16 * 72 : wT + (cb - 8) * 16 * 72) + fr * 72 + fq * 8;
#pragma unroll
                for (int ks = 0; ks < (R + 1) / 2; ++ks) acc = mfma16(*(const LAS bf16x8*)(xt + ks * 32), *(const LAS bf16x8*)(Mneg + i * 72 + ks * 32 + fq * 8), acc);
            }
            tacc[e] = acc;
            LAS bf16_t* tp = tT + (cb * 16 + 4 * fq) * 32 + fr;
            tp[0] = (bf16_t)f2bf(acc[0]); tp[32] = (bf16_t)f2bf(acc[1]); tp[64] = (bf16_t)f2bf(acc[2]); tp[96] = (bf16_t)f2bf(acc[3]);
        }
        __syncthreads();
#pragma unroll
        for (int e = 0; e < 2; ++e) {
            const int cb = wid * 2 + e;
            f32x4 acc = (f32x4){0.f, 0.f, 0.f, 0.f};
            acc = mfma16(*(const LAS bf16x8*)(tT + (cb * 16 + fr) * 32 + fq * 8), *(const LAS bf16x8*)(Db + (R * 16 + fr) * 40 + fq * 8), acc);
            LAS bf16_t* xp = (cb < 8 ? uT + cb * 16 * 72 : wT + (cb - 8) * 16 * 72) + (4 * fq) * 72 + 16 * R + fr;
            xp[0] = (bf16_t)f2bf(acc[0]); xp[72] = (bf16_t)f2bf(acc[1]); xp[144] = (bf16_t)f2bf(acc[2]); xp[216] = (bf16_t)f2bf(acc[3]);
        }
        __syncthreads();
    }
    {
        const int pi = RR(ti);
        const float sc_ = __expf(bcs[63] - bcs[pi]);
#pragma unroll
        for (int e = 0; e < 16; ++e) kT[(d0 + e) * 72 + pi] = (bf16_t)f2bf(bf2f(ks_[ti * 136 + d0 + e]) * sc_);
    }
    if (tid < 128) p.ld[item * 128 + tid] = __expf(bcs[63]);
    __syncthreads();
    {
        const int tid = opaque_tid(), wid = tid >> 6, lane = tid & 63, fr = lane & 15, fq = lane >> 4;
        bf16x8 xw[2], xu[2], xk[2];
#pragma unroll
        for (int ks = 0; ks < 2; ++ks) {
            xw[ks] = *(const LAS bf16x8*)(wT + (wid * 16 + fr) * 72 + ks * 32 + fq * 8);
            xu[ks] = *(const LAS bf16x8*)(uT + (wid * 16 + fr) * 72 + ks * 32 + fq * 8);
            xk[ks] = *(const LAS bf16x8*)(kT + (wid * 16 + fr) * 72 + ks * 32 + fq * 8);
        }
#pragma unroll
        for (int ib = 0; ib < 4; ++ib) {
            const int i = ib * 16 + fr;
            const u32x2 qr = *(const LAS u32x2*)(qs + RR(i) * 136 + wid * 16 + 4 * fq);
            const float eb = __expf(bcs[i]);
            f32x4 aq = (f32x4){bflo(qr[0]) * eb, bfhi(qr[0]) * eb, bflo(qr[1]) * eb, bfhi(qr[1]) * eb};
            f32x4 ao = (f32x4){0.f, 0.f, 0.f, 0.f};
#pragma unroll
            for (int ks = 0; ks < 2; ++ks) {
                const bf16x8 ya = *(const LAS bf16x8*)(att + i * 72 + ks * 32 + fq * 8);
                aq = mfma16(xw[ks], ya, aq); ao = mfma16(xu[ks], ya, ao);
            }
            *(u32x2*)(p.lq + item * 8192 + ((ib * 8 + wid) * 64 + lane) * 4) = pack4(aq);
            *(u32x2*)(p.lo + item * 8192 + ((wid * 4 + ib) * 64 + lane) * 4) = pack4(ao);
        }
#pragma unroll
        for (int db = 0; db < 8; ++db) {
            f32x4 aa = (f32x4){0.f, 0.f, 0.f, 0.f}, ab = (f32x4){0.f, 0.f, 0.f, 0.f};
#pragma unroll
            for (int ks = 0; ks < 2; ++ks) {
                aa = mfma16(xw[ks], *(const LAS bf16x8*)(kT + (db * 16 + fr) * 72 + ks * 32 + fq * 8), aa);
                ab = mfma16(xk[ks], *(const LAS bf16x8*)(uT + (db * 16 + fr) * 72 + ks * 32 + fq * 8), ab);
            }
            *(u32x2*)(p.la + item * 16384 + ((db * 8 + wid) * 64 + lane) * 4) = pack4(aa);
            *(u32x2*)(p.lb + item * 16384 + ((wid * 8 + db) * 64 + lane) * 4) = pack4(ab);
        }
    }
    __syncthreads();
  }
#undef RR
}

__device__ __forceinline__ void ph_local(const Params& p, int l, LAS unsigned char* lds) {
    constexpr int NG = NITEM / 2;
    for (int it = blockIdx.x; it < NG + 2 * NITEM; it += gridDim.x) {
        if (it < NG) { const int bh = it / NCHUNK, c = it % NCHUNK; local_gdn(p, l, bh, c >= 4, c >= 4 ? c - 4 : c, lds); }
        else if (it < NG + NITEM) { const int idx = it - NG; local_gla(p, l, 1, idx / NCHUNK, idx % NCHUNK, lds); }
        else { const int idx = it - NG - NITEM; local_ret<0>(p, l, idx / NCHUNK, idx % NCHUNK, lds); }
    }
}

__device__ __forceinline__ void seq_matrix(const Params& p, int tz, int chain, int half, LAS unsigned char* lds) {
    const int tid = opaque_tid(), wid = tid >> 6, lane = tid & 63, fr = lane & 15, fq = lane >> 4;
    const int b = chain >> 3, h = (chain >> 1) & 3, d = chain & 1;
    LAS bf16_t* ST = (LAS bf16_t*)lds;
    bf16_t* Op = p.O + (size_t)((tz == 0 ? 0 : tz == 1 ? 1 : 3) * 2 + d) * TOKW;
    f32x4 S[4];
#pragma unroll
    for (int q = 0; q < 4; ++q) S[q] = (f32x4){0.f, 0.f, 0.f, 0.f};
    const int ib = wid >> 1, dv2 = (wid & 1) * 2;
    struct Ops { u32x2 yq[8], xa[8], oin[2], bin[4]; f32x4 dec; };
    auto load_ops = [&](int n, Ops& o) {
        const size_t item = (size_t)tz * NITEM + (size_t)chain * NCHUNK + n;
        const bf16_t* lqp = p.lq + item * 8192 + (size_t)(ib * 8) * 256 + lane * 4;
#pragma unroll
        for (int q = 0; q < 8; ++q) o.yq[q] = *(const u32x2*)(lqp + q * 256);
        if (tz == 0) {
            const bf16_t* lap = p.la + ((size_t)chain * NCHUNK + n) * 16384 + (size_t)(wid * 8) * 256 + lane * 4;
#pragma unroll
            for (int q = 0; q < 8; ++q) o.xa[q] = *(const u32x2*)(lap + q * 256);
        }
#pragma unroll
        for (int e2 = 0; e2 < 2; ++e2)
            o.oin[e2] = *(const u32x2*)(p.lo + item * 8192 + (((half * 4 + dv2 + (fq >> 1)) * 4 + ib) * 64 + fr + 16 * (2 * (fq & 1) + e2)) * 4);
#pragma unroll
        for (int q = 0; q < 4; ++q) o.bin[q] = *(const u32x2*)(p.lb + item * 16384 + ((wid * 8 + half * 4 + q) * 64 + lane) * 4);
        o.dec = *(const f32x4*)(p.ld + item * 128 + wid * 16 + 4 * fq);
    };
    Ops s0, s1; load_ops(0, s0);
    auto step = [&](int n, Ops& cur, Ops& fill) {
        load_ops(n + 1 < NCHUNK ? n + 1 : n, fill);
        LAS bf16_t* st = ST + (n & 1) * 64 * 136;
#pragma unroll
        for (int q = 0; q < 4; ++q) *(LAS u32x2*)(st + (q * 16 + fr) * 136 + 32 * (wid >> 1) + 8 * fq + 4 * (wid & 1)) = pack4(S[q]);
        __syncthreads();
        const int base = chunk_base(b, d, n);
        const int tok = base + (d ? 63 - (ib * 16 + fr) : ib * 16 + fr);
        {
            bf16x8 xo[2][4];
#pragma unroll
            for (int e2 = 0; e2 < 2; ++e2) {
                const int prow = dv2 * 16 + 8 * (fr >> 2) + 4 * e2 + (fr & 3);
#pragma unroll
                for (int ks = 0; ks < 4; ++ks) xo[e2][ks] = *(const LAS bf16x8*)(st + prow * 136 + ks * 32 + fq * 8);
            }
            asm volatile("s_waitcnt lgkmcnt(0)" ::: "memory");
            f32x4 ao[2];
#pragma unroll
            for (int e2 = 0; e2 < 2; ++e2) {
                f32x4 acc = (f32x4){bflo(cur.oin[e2][0]), bfhi(cur.oin[e2][0]), bflo(cur.oin[e2][1]), bfhi(cur.oin[e2][1])};
#pragma unroll
                for (int ks = 0; ks < 4; ++ks) {
                    u32x4 t; t[0] = cur.yq[2 * ks][0]; t[1] = cur.yq[2 * ks][1]; t[2] = cur.yq[2 * ks + 1][0]; t[3] = cur.yq[2 * ks + 1][1];
                    acc = mfma16(xo[e2][ks], __builtin_bit_cast(bf16x8, t), acc);
                }
                ao[e2] = acc;
            }
            bf16_t* op = Op + (size_t)tok * MW + h * 128 + half * 64 + dv2 * 16 + 8 * fq;
            { u32x4 w; w[0] = pack2(ao[0][0], ao[0][1]); w[1] = pack2(ao[0][2], ao[0][3]); w[2] = pack2(ao[1][0], ao[1][1]); w[3] = pack2(ao[1][2], ao[1][3]); *(u32x4*)op = w; }
#pragma unroll
            for (int qh = 0; qh < 2; ++qh) {
                bf16x8 xs[2][4];
                if (tz == 0) {
#pragma unroll
                    for (int q2 = 0; q2 < 2; ++q2)
#pragma unroll
                        for (int ks = 0; ks < 4; ++ks) xs[q2][ks] = *(const LAS bf16x8*)(st + ((qh * 2 + q2) * 16 + fr) * 136 + ks * 32 + fq * 8);
                    asm volatile("s_waitcnt lgkmcnt(0)" ::: "memory");
                }
#pragma unroll
                for (int q2 = 0; q2 < 2; ++q2) {
                    const int q = qh * 2 + q2;
                    f32x4 acc = (f32x4){cur.dec[0] * S[q][0] + bflo(cur.bin[q][0]), cur.dec[1] * S[q][1] + bfhi(cur.bin[q][0]), cur.dec[2] * S[q][2] + bflo(cur.bin[q][1]), cur.dec[3] * S[q][3] + bfhi(cur.bin[q][1])};
                    if (tz == 0) {
#pragma unroll
                        for (int ks = 0; ks < 4; ++ks) {
                            u32x4 t; t[0] = cur.xa[2 * ks][0]; t[1] = cur.xa[2 * ks][1]; t[2] = cur.xa[2 * ks + 1][0]; t[3] = cur.xa[2 * ks + 1][1];
                            acc = mfma16(__builtin_bit_cast(bf16x8, t), xs[q2][ks], acc);
                        }
                    }
                    S[q] = acc;
                }
            }
        }
    };
    for (int n = 0; n < NCHUNK; n += 2) {
        step(n, s0, s1);
        step(n + 1, s1, s0);
    }
    __syncthreads();
}

__device__ __forceinline__ void seq_lru(const Params& p, int b, int d, int cg, LAS unsigned char* lds) {
    const int tid = opaque_tid(), seg = tid >> 6, ch = cg * 64 + (tid & 63);
    LAS float* sP = (LAS float*)lds;
    LAS float* sL = sP + 512;
    const float* A = p.prep + (size_t)(PR_LA + d) * TOKW + ch; const float* U = p.prep + (size_t)(PR_LU + d) * TOKW + ch;
    bf16_t* Op = p.O + (size_t)(2 * 2 + d) * TOKW + ch;
    constexpr int SEG = (TC + TL) / 8;
    auto tok_of = [&](int pos) { return pos < TC ? NLAT + b * TC + (d ? TC - 1 - pos : pos) : b * TL + (d ? TL - 1 - (pos - TC) : pos - TC); };
    float P = 1.f, L = 0.f;
    for (int i0 = 0; i0 < SEG; i0 += 32) {
        float av[32], uv[32];
#pragma unroll
        for (int q = 0; q < 32; ++q) { const size_t o = (size_t)tok_of(seg * SEG + i0 + q) * MW; av[q] = A[o]; uv[q] = U[o]; }
#pragma unroll
        for (int q = 0; q < 32; ++q) { L = av[q] * L + uv[q]; P *= av[q]; }
    }
    sP[tid] = P; sL[tid] = L;
    __syncthreads();
    float hst = 0.f;
    for (int s = 0; s < seg; ++s) hst = sP[s * 64 + (tid & 63)] * hst + sL[s * 64 + (tid & 63)];
    for (int i0 = 0; i0 < SEG; i0 += 32) {
        float av[32], uv[32];
#pragma unroll
        for (int q = 0; q < 32; ++q) { const size_t o = (size_t)tok_of(seg * SEG + i0 + q) * MW; av[q] = A[o]; uv[q] = U[o]; }
#pragma unroll
        for (int q = 0; q < 32; ++q) { hst = av[q] * hst + uv[q]; Op[(size_t)tok_of(seg * SEG + i0 + q) * MW] = (bf16_t)f2bf(hst); }
    }
    __syncthreads();
}

__device__ __forceinline__ void ph_seq(const Params& p, int l, LAS unsigned char* lds) {
    for (int it = blockIdx.x; it < 256; it += gridDim.x) {
        if (it < 192) { const int tz = it >> 6, r = it & 63; seq_matrix(p, tz, (r & 7) | ((r >> 4) << 3), (r >> 3) & 1, lds); }
        else { const int r = it - 192; seq_lru(p, r >> 4, (r >> 3) & 1, r & 7, lds); }
    }
    if (l == 0) cvt_fill(p, lds, 0, CW_SEQ0A, CW_G2 - CW_SEQ0A, CW_SEQ0B, CW_G1B - CW_SEQ0B); else cvt_fill(p, lds, 1, CW_SEQ1, CVT_G_ALL - CW_SEQ1, 0, 0);
}

__device__ __forceinline__ void ph_merge(const Params& p, int l, int M) {
    const int tid = opaque_tid(), wid = tid >> 6, lane = tid & 63;
    const bf16_t* Ob = opaque_sptr(p.O); const bf16_t* Pb = opaque_sptr(p.P); bf16_t* Yb = opaque_sptr(p.Y);
    float2 gn[3];
#pragma unroll
    for (int m = 0; m < 3; ++m) gn[m] = *(const float2*)((m == 0 ? p.gdn_norm_g : m == 1 ? p.hgrn_norm_g : p.ret_norm_g) + l * 128 + lane * 2);
    for (int tok = blockIdx.x * NWAVES + wid; tok < M; tok += gridDim.x * NWAVES) {
        unsigned o0[16], o1[16], gz[16];
#pragma unroll
        for (int r = 0; r < 16; ++r) {
            const int m = r >> 2, head = r & 3, cidx = head * 128 + lane * 2;
            const size_t o = (size_t)tok * MW + cidx;
            o0[r] = *(const unsigned*)(Ob + (size_t)(m * 2) * TOKW + o); o1[r] = *(const unsigned*)(Ob + (size_t)(m * 2 + 1) * TOKW + o);
            const int zc = m == 0 ? C_GZ : m == 1 ? C_HG : m == 2 ? C_LY : C_RG;
            gz[r] = *(const unsigned*)(Pb + (size_t)tok * NP + zc + cidx);
        }
        float a0[16], a1[16], ss[16];
#pragma unroll
        for (int r = 0; r < 16; ++r) { a0[r] = bflo(o0[r]) + bflo(o1[r]); a1[r] = bfhi(o0[r]) + bfhi(o1[r]); ss[r] = a0[r] * a0[r] + a1[r] * a1[r]; }
#pragma unroll
        for (int msk = 32; msk >= 1; msk >>= 1)
#pragma unroll
            for (int r = 0; r < 16; ++r) if ((r >> 2) != 2) ss[r] += shx(ss[r], msk, lane);
#pragma unroll
        for (int r = 0; r < 16; ++r) {
            const int m = r >> 2, head = r & 3, cidx = head * 128 + lane * 2;
            float y0, y1; int nbr;
            if (m == 2) { y0 = a0[r] * gelu_tanhf_(bflo(gz[r])); y1 = a1[r] * gelu_tanhf_(bfhi(gz[r])); nbr = 2; }
            else {
                const float rinv = rsqrtf(ss[r] * (1.0f / 128.0f) + 1e-6f);
                const float2 g = gn[m == 3 ? 2 : m];
                y0 = a0[r] * rinv * g.x * siluf_(bflo(gz[r])); y1 = a1[r] * rinv * g.y * siluf_(bfhi(gz[r])); nbr = m == 3 ? 3 : m;
            }
            *(unsigned*)(Yb + (size_t)nbr * TOKW + (size_t)tok * MW + cidx) = pack2(y0, y1);
        }
    }
}

struct G2Sched {
    const bf16_t* Y; const bf16_t* Wb; int ntiles, G, c;
    static constexpr bool HAS_BIAS = false, gather = false;
    __device__ __forceinline__ bool next(int i, g8::Unit& u) const {
        const int r = i >> 2, tile = (r == 0 && G == 256) ? (c & 7) * 32 + (c >> 3) : r * G + c; if (tile >= ntiles) return false;
        u.pm = tile >> 2; u.pn = tile & 3; u.e = i & 3; return true;
    }
    __device__ __forceinline__ const char* a_base(const g8::Unit& u) const { return (const char*)(Y + (size_t)u.e * TOKW + (size_t)u.pm * 256 * MW); }
    __device__ __forceinline__ const char* b_base(const g8::Unit& u) const { return (const char*)(Wb + (size_t)u.e * D * MW + (size_t)u.pn * 256 * MW); }
    __device__ __forceinline__ const int* row_addr(const g8::Unit&, int) const { return nullptr; }
    __device__ __forceinline__ int rows_valid(const g8::Unit&) const { return 256; }
    __device__ __forceinline__ const float* bias_src(const g8::Unit&, int) const { return nullptr; }
};
struct EpiMix {
    const bf16_t* gate; bf16_t* O;
    __device__ __forceinline__ bool keep(const g8::Unit& u) const { return u.e < 3; }
    __device__ __forceinline__ void operator()(f32x4 (&acc)[2][2][4][2], const g8::Unit& u, int wr, int wc, int fr, int fq, const LAS float*) const {
        const int row0 = u.pm * 256 + wr * 64 + fr, col0 = u.pn * 256 + wc * 32 + 8 * fq;
        const bool lastseg = u.e == 3;
        const bf16_t* gc = gate + ((((size_t)u.pm * 16 + u.e * 4 + u.pn) * 8 + (wr * 4 + wc)) * 16) * 512 + (fq * 16 + fr) * 8;
#pragma unroll
        for (int ah = 0; ah < 2; ++ah) {
            u32x4 c[8];
#pragma unroll
            for (int q = 0; q < 8; ++q) c[q] = *(const u32x4*)(gc + (ah * 8 + q) * 512);
#pragma unroll
            for (int q = 0; q < 8; ++q) {
                const int m = q >> 1, bj = q & 1;
#pragma unroll
                for (int w = 0; w < 4; ++w) { acc[ah][bj][m][w >> 1][(w & 1) * 2] *= bflo(c[q][w]); acc[ah][bj][m][w >> 1][(w & 1) * 2 + 1] *= bfhi(c[q][w]); }
            }
        }
        if (lastseg) {
#pragma unroll
            for (int ai = 0; ai < 2; ++ai)
#pragma unroll
                for (int m = 0; m < 4; ++m)
#pragma unroll
                    for (int bj = 0; bj < 2; ++bj) {
                        u32x4 w; w[0] = pack2(acc[ai][bj][m][0][0], acc[ai][bj][m][0][1]); w[1] = pack2(acc[ai][bj][m][0][2], acc[ai][bj][m][0][3]);
                        w[2] = pack2(acc[ai][bj][m][1][0], acc[ai][bj][m][1][1]); w[3] = pack2(acc[ai][bj][m][1][2], acc[ai][bj][m][1][3]);
                        *(u32x4*)(O + (size_t)(row0 + ai * 128 + m * 16) * D + col0 + bj * 128) = w;
                    }
        }
    }
};
__device__ __forceinline__ void ph_g2(const Params& p, int l, int M, LAS unsigned char* lds) {
    G2Sched S; S.Y = p.Y; S.Wb = p.wbT + (size_t)l * 4 * D * MW; S.ntiles = (M / 256) * 4; S.G = gridDim.x; S.c = blockIdx.x;
    EpiMix E; E.gate = p.gate; E.O = p.mix;
    g8::gemm_phase(lds, MW, S, E);
    if (l == 0 && (int)blockIdx.x >= (NTOK / 256) * 4 - 256) cvt_fill(p, lds, 4, CW_G2, CW_G3 - CW_G2, 0, 0);
}

struct EpiY {
    bf16_t* O;
    __device__ __forceinline__ bool keep(const g8::Unit&) const { return false; }
    __device__ __forceinline__ void operator()(const f32x4 (&acc)[2][2][4][2], const g8::Unit& u, int wr, int wc, int fr, int fq, const LAS float*) const {
        const int row0 = u.pm * 256 + wr * 64 + fr, col0 = u.pn * 256 + wc * 32 + 8 * fq;
#pragma unroll
        for (int ai = 0; ai < 2; ++ai)
#pragma unroll
            for (int m = 0; m < 4; ++m)
#pragma unroll
                for (int bj = 0; bj < 2; ++bj) {
                    u32x4 w; w[0] = pack2(acc[ai][bj][m][0][0], acc[ai][bj][m][0][1]); w[1] = pack2(acc[ai][bj][m][0][2], acc[ai][bj][m][0][3]);
                    w[2] = pack2(acc[ai][bj][m][1][0], acc[ai][bj][m][1][1]); w[3] = pack2(acc[ai][bj][m][1][2], acc[ai][bj][m][1][3]);
                    *(u32x4*)(O + (size_t)(row0 + ai * 128 + m * 16) * D + col0 + bj * 128) = w;
                }
    }
};
__device__ __forceinline__ void ph_g3(const Params& p, int l, int M, LAS unsigned char* lds) {
    g8::PlainSched S; S.init(p.mix, p.woutT + (size_t)l * D * D, M, D, D);
    EpiY E; E.O = p.Y;
    g8::gemm_phase(lds, D, S, E);
    if (l == 0 && (int)blockIdx.x >= (NTOK / 256) * 4 - 256) cvt_fill(p, lds, 5, CW_G3, CW_SEQ0B - CW_G3, 0, 0);
}

template <bool DRY = false> __device__ __forceinline__ void ph_route(const Params& p, int l, int M, LAS unsigned char* lds) {
    int* const r_cnt = DRY ? p.cnt + 64 : p.cnt; int* const r_list = DRY ? (int*)p.act : p.list; int* const r_ts = DRY ? (int*)p.yp : p.tokslot; float* const r_tw = DRY ? (float*)p.yp + (size_t)NTOK * 4 : p.topw;
    LAS float* fs = (LAS float*)lds;
    LAS float* lg = fs + 32 * 1028;
    LAS int* lcnt = (LAS int*)(lg + 32 * 36);
    LAS int* lbase = lcnt + 32;
    const int tid = opaque_tid(), wid = tid >> 6, lane = tid & 63;
    const float* rw = p.router_w + (size_t)l * D * NE;
    for (int it = blockIdx.x; it < M / 32; it += gridDim.x) {
        const int tok0 = it * 32;
        {
            float4 v[4][4]; float ss[4];
            const float* mb0 = p.mod + (size_t)(l * 5 + tok_modrow(tok0)) * (NMOD * D);
            u32x2 yv[4][4]; float4 g1v[4];
#pragma unroll
            for (int i = 0; i < 4; ++i) g1v[i] = *(const float4*)(mb0 + 2 * D + i * 256 + lane * 4);
#pragma unroll
            for (int q = 0; q < 4; ++q) {
                const size_t ro = (size_t)(tok0 + wid * 4 + q) * D;
#pragma unroll
                for (int i = 0; i < 4; ++i) { v[q][i] = *(const float4*)(p.xl + ro + i * 256 + lane * 4); yv[q][i] = *(const u32x2*)(p.Y + ro + i * 256 + lane * 4); }
            }
#pragma unroll
            for (int q = 0; q < 4; ++q)
#pragma unroll
                for (int i = 0; i < 4; ++i) {
                    v[q][i].x += g1v[i].x * bflo(yv[q][i][0]); v[q][i].y += g1v[i].y * bfhi(yv[q][i][0]); v[q][i].z += g1v[i].z * bflo(yv[q][i][1]); v[q][i].w += g1v[i].w * bfhi(yv[q][i][1]);
                    if (!DRY) *(float4*)(p.xl + (size_t)(tok0 + wid * 4 + q) * D + i * 256 + lane * 4) = v[q][i];
                }
#pragma unroll
            for (int q = 0; q < 4; ++q) {
                float s = 0.f;
#pragma unroll
                for (int i = 0; i < 4; ++i) s += v[q][i].x * v[q][i].x + v[q][i].y * v[q][i].y + v[q][i].z * v[q][i].z + v[q][i].w * v[q][i].w;
                ss[q] = s;
            }
#pragma unroll
            for (int m = 32; m >= 1; m >>= 1)
#pragma unroll
                for (int q = 0; q < 4; ++q) ss[q] += shx(ss[q], m, lane);
            const float* mb = mb0;
#pragma unroll
            for (int i = 0; i < 4; ++i) {
                const int cidx = i * 256 + lane * 4;
                const float4 gv = *(const float4*)(p.norm2_g + l * D + cidx), sv = *(const float4*)(mb + 4 * D + cidx), hv = *(const float4*)(mb + 3 * D + cidx);
#pragma unroll
                for (int q = 0; q < 4; ++q) {
                    const int tl = wid * 4 + q, tok = tok0 + tl;
                    const float rinv = rsqrtf(ss[q] * (1.0f / D) + 1e-6f);
                    const float h0 = v[q][i].x * rinv * gv.x * (1.f + sv.x) + hv.x, h1 = v[q][i].y * rinv * gv.y * (1.f + sv.y) + hv.y;
                    const float h2 = v[q][i].z * rinv * gv.z * (1.f + sv.z) + hv.z, h3 = v[q][i].w * rinv * gv.w * (1.f + sv.w) + hv.w;
                    u32x2 o; o[0] = pack2(h0, h1); o[1] = pack2(h2, h3);
                    *(u32x2*)(p.F + (size_t)tok * D + cidx) = o;
                    *(LAS f32x4*)(fs + tl * 1028 + cidx) = (f32x4){h0, h1, h2, h3};
                }
            }
        }
        __syncthreads();
        {
            typedef float f32x16 __attribute__((ext_vector_type(16)));
            f32x16 acc;
#pragma unroll
            for (int r = 0; r < 16; ++r) acc[r] = 0.f;
            const int tk = lane & 31, hh = lane >> 5;
            const LAS float* ap = fs + tk * 1028 + wid * 128 + 4 * hh;
            const float* bp = rw + (size_t)(wid * 128 + 4 * hh) * NE + tk;
#pragma unroll 4
            for (int kk = 0; kk < 16; ++kk) {
                const f32x4 a4 = *(const LAS f32x4*)(ap + kk * 8);
                const float b0 = bp[(kk * 8 + 0) * NE], b1 = bp[(kk * 8 + 1) * NE], b2 = bp[(kk * 8 + 2) * NE], b3 = bp[(kk * 8 + 3) * NE];
                acc = __builtin_amdgcn_mfma_f32_32x32x2f32(a4[0], b0, acc, 0, 0, 0);
                acc = __builtin_amdgcn_mfma_f32_32x32x2f32(a4[1], b1, acc, 0, 0, 0);
                acc = __builtin_amdgcn_mfma_f32_32x32x2f32(a4[2], b2, acc, 0, 0, 0);
                acc = __builtin_amdgcn_mfma_f32_32x32x2f32(a4[3], b3, acc, 0, 0, 0);
            }
            __syncthreads();
            LAS float* red = fs;
#pragma unroll
            for (int r = 0; r < 16; ++r) red[(wid * 32 + (r & 3) + 8 * (r >> 2) + 4 * hh) * 33 + tk] = acc[r];
            __syncthreads();
            const int t2 = tid >> 4, e0 = (tid & 15) * 2;
            float s0 = p.router_b[l * NE + e0], s1 = p.router_b[l * NE + e0 + 1];
#pragma unroll
            for (int w = 0; w < 8; ++w) { s0 += red[(w * 32 + t2) * 33 + e0]; s1 += red[(w * 32 + t2) * 33 + e0 + 1]; }
            lg[t2 * 36 + e0] = s0; lg[t2 * 36 + e0 + 1] = s1;
            if (tid < 32) lcnt[tid] = 0;
        }
        __syncthreads();
        float vals[4]; int idxs[4], rank[4];
        if (tid < 32) {
            float lv[32];
#pragma unroll
            for (int q = 0; q < 8; ++q) { const f32x4 t = *(const LAS f32x4*)(lg + tid * 36 + q * 4); lv[q * 4] = t[0]; lv[q * 4 + 1] = t[1]; lv[q * 4 + 2] = t[2]; lv[q * 4 + 3] = t[3]; }
#pragma unroll
            for (int k = 0; k < 4; ++k) {
                float best = lv[0]; int bi = 0;
#pragma unroll
                for (int ee = 1; ee < NE; ++ee) { const bool gt = lv[ee] > best; best = gt ? lv[ee] : best; bi = gt ? ee : bi; }
#pragma unroll
                for (int ee = 0; ee < NE; ++ee) lv[ee] = (ee == bi) ? -3.0e38f : lv[ee];
                vals[k] = best; idxs[k] = bi;
                rank[k] = atomicAdd((int*)(lcnt + bi), 1);
            }
        }
        __syncthreads();
        if (tid < 32) { const int c = lcnt[tid]; lbase[tid] = c ? atomicAdd(r_cnt + l * NE + tid, c) : 0; }
        __syncthreads();
        if (tid < 32) {
            const int tok = tok0 + tid;
            const float mx = vals[0];
            float ex[4], sum = 0.f;
#pragma unroll
            for (int k = 0; k < 4; ++k) { ex[k] = __expf(vals[k] - mx); sum += ex[k]; }
            const float inv = 1.0f / sum;
#pragma unroll
            for (int k = 0; k < 4; ++k) {
                const int ee = idxs[k];
                const int slot = lbase[ee] + rank[k];
                r_list[(size_t)ee * NTOK + slot] = tok;
                r_ts[(size_t)tok * 4 + k] = (ee << 16) | slot;
                r_tw[(size_t)tok * 4 + k] = ex[k] * inv;
            }
        }
        __syncthreads();
    }
}

__device__ __forceinline__ void build_expert_tables(const Params& p, int l, LAS int* ts, LAS int* cn, LAS int* te) {
    const int tid = opaque_tid();
    if (tid < 64) {
        const int c = tid < NE ? p.cnt[l * NE + tid] : 0;
        const int nt = (c + 255) >> 8;
        int v = nt;
#pragma unroll
        for (int off = 1; off < 32; off <<= 1) { const int t = shupi(v, off, tid); if (tid >= off) v += t; }
        if (tid < NE) { cn[tid] = c; ts[tid] = v - nt; if (tid == NE - 1) ts[NE] = v; }
        if (te && tid < NE) for (int q = 0; q < nt; ++q) te[v - nt + q] = tid;
    }
    __syncthreads();
}

struct MoeSched {
    const LAS int* ts; const LAS int* cn; const LAS int* te; const int* list; const bf16_t* A; const bf16_t* Bt; const float* bias; int K, npn, nunits, G, c, nrowsB, nbias; bool gather;
    static constexpr bool HAS_BIAS = true;
    __device__ __forceinline__ bool next(int i, g8::Unit& u) const {
        if (G == 256) {
            const int x = c & 7, s = c >> 3, pm = i * (256 / npn) + x * (32 / npn) + s / npn;
            if (pm * npn >= nunits) return false;
            u.pm = pm; u.pn = s % npn; u.e = te[pm]; return true;
        }
        const long L = (long)i * G + c; if (L >= nunits) return false;
        u.pm = (int)(L / npn); u.pn = (int)(L % npn); u.e = te[u.pm]; return true;
    }
    __device__ __forceinline__ const char* a_base(const g8::Unit& u) const { return (const char*)(gather ? A : A + (size_t)u.pm * 256 * K); }
    __device__ __forceinline__ const char* b_base(const g8::Unit& u) const { return (const char*)(Bt + ((size_t)u.e * nrowsB + (size_t)u.pn * 256) * K); }
    __device__ __forceinline__ const int* row_addr(const g8::Unit& u, int R) const {
        const int cnt = cn[u.e], sl = (u.pm - ts[u.e]) * 256 + R;
        return list + (size_t)u.e * NTOK + (sl < cnt ? sl : 0);
    }
    __device__ __forceinline__ int rows_valid(const g8::Unit& u) const { return cn[u.e] - (u.pm - ts[u.e]) * 256; }
    __device__ __forceinline__ const float* bias_src(const g8::Unit& u, int lane) const {
        if (nbias == 2) return bias + (size_t)u.e * 2 * D + (lane < 32 ? u.pn * 128 + lane * 4 : D + u.pn * 128 + (lane - 32) * 4);
        return bias + (size_t)u.e * D + u.pn * 256 + lane * 4;
    }
};
struct EpiAct {
    bf16_t* O;
    __device__ __forceinline__ bool keep(const g8::Unit&) const { return false; }
    __device__ __forceinline__ void operator()(const f32x4 (&acc)[2][2][4][2], const g8::Unit& u, int wr, int wc, int fr, int fq, const LAS float* bias) const {
        const int row0 = u.pm * 256 + wr * 64 + fr, col0 = u.pn * 128 + wc * 32 + 8 * fq;
        const LAS float* bb = bias + wc * 32 + 8 * fq;
        const f32x4 g0 = *(const LAS f32x4*)bb, g1 = *(const LAS f32x4*)(bb + 4), l0 = *(const LAS f32x4*)(bb + 128), l1 = *(const LAS f32x4*)(bb + 132);
        const float bg[8] = {g0[0], g0[1], g0[2], g0[3], g1[0], g1[1], g1[2], g1[3]}, bl[8] = {l0[0], l0[1], l0[2], l0[3], l1[0], l1[1], l1[2], l1[3]};
#pragma unroll
        for (int ai = 0; ai < 2; ++ai)
#pragma unroll
            for (int m = 0; m < 4; ++m) {
                float o[8];
#pragma unroll
                for (int n = 0; n < 2; ++n)
#pragma unroll
                    for (int j = 0; j < 4; ++j) {
                        const float glu = fminf(acc[ai][0][m][n][j] + bg[n * 4 + j], 7.0f);
                        const float lin = fminf(fmaxf(acc[ai][1][m][n][j] + bl[n * 4 + j], -7.0f), 7.0f);
                        o[n * 4 + j] = glu * sigmoidf_(1.702f * glu) * (lin + 1.0f);
                    }
                *(u32x4*)(O + (size_t)(row0 + ai * 128 + m * 16) * D + col0) = pack8(o);
            }
    }
};
__device__ __forceinline__ void ph_g4(const Params& p, int l, LAS unsigned char* lds) {
    LAS int* ts = (LAS int*)(lds + g8::STAGE_BYTES); LAS int* cn = ts + 40; LAS int* te = ts + 80;
    build_expert_tables(p, l, ts, cn, te);
    MoeSched S; S.ts = ts; S.cn = cn; S.te = te; S.list = p.list; S.A = p.F; S.Bt = p.w1T + (size_t)l * NE * 2 * D * D; S.bias = p.moe_b1 + (size_t)l * NE * 2 * D; S.nbias = 2;
    S.K = D; S.npn = 8; S.nunits = ts[NE] * 8; S.G = gridDim.x; S.c = blockIdx.x; S.nrowsB = 2 * D; S.gather = true;
    EpiAct E; E.O = p.act;
    g8::gemm_phase(lds, D, S, E);
}

struct EpiYp {
    bf16_t* O;
    __device__ __forceinline__ bool keep(const g8::Unit&) const { return false; }
    __device__ __forceinline__ void operator()(const f32x4 (&acc)[2][2][4][2], const g8::Unit& u, int wr, int wc, int fr, int fq, const LAS float* bias) const {
        const int row0 = u.pm * 256 + wr * 64 + fr, col0 = u.pn * 256 + wc * 32 + 8 * fq;
#pragma unroll
        for (int bj = 0; bj < 2; ++bj) {
            const LAS float* bb = bias + bj * 128 + wc * 32 + 8 * fq;
            const f32x4 c0v = *(const LAS f32x4*)bb, c1v = *(const LAS f32x4*)(bb + 4);
            const float4 c0 = make_float4(c0v[0], c0v[1], c0v[2], c0v[3]), c1 = make_float4(c1v[0], c1v[1], c1v[2], c1v[3]);
#pragma unroll
            for (int ai = 0; ai < 2; ++ai)
#pragma unroll
                for (int m = 0; m < 4; ++m) {
                    u32x4 w; w[0] = pack2(acc[ai][bj][m][0][0] + c0.x, acc[ai][bj][m][0][1] + c0.y); w[1] = pack2(acc[ai][bj][m][0][2] + c0.z, acc[ai][bj][m][0][3] + c0.w);
                    w[2] = pack2(acc[ai][bj][m][1][0] + c1.x, acc[ai][bj][m][1][1] + c1.y); w[3] = pack2(acc[ai][bj][m][1][2] + c1.z, acc[ai][bj][m][1][3] + c1.w);
                    *(u32x4*)(O + (size_t)(row0 + ai * 128 + m * 16) * D + col0 + bj * 128) = w;
                }
        }
    }
};
__device__ __forceinline__ void ph_g5(const Params& p, int l, LAS unsigned char* lds) {
    LAS int* ts = (LAS int*)(lds + g8::STAGE_BYTES); LAS int* cn = ts + 40; LAS int* te = ts + 80;
    build_expert_tables(p, l, ts, cn, te);
    MoeSched S; S.ts = ts; S.cn = cn; S.te = te; S.list = p.list; S.A = p.act; S.Bt = p.w2T + (size_t)l * NE * D * D; S.bias = p.moe_b2 + (size_t)l * NE * D; S.nbias = 1;
    S.K = D; S.npn = 4; S.nunits = ts[NE] * 4; S.G = gridDim.x; S.c = blockIdx.x; S.nrowsB = D; S.gather = false;
    EpiYp E; E.O = p.yp;
    g8::gemm_phase(lds, D, S, E);
}

template <bool DRY = false> __device__ __forceinline__ void ph_combine(const Params& p, int l, int M, LAS unsigned char* lds) {
    float* const c_xl = DRY ? p.prep : p.xl; bf16_t* const c_H = DRY ? (bf16_t*)(p.prep + (size_t)NTOK * D) : p.H; float* const c_out = DRY ? p.prep : p.out;
    LAS int* ts = (LAS int*)lds; LAS int* cn = ts + 40;
    build_expert_tables(p, l, ts, cn, nullptr);
    const int tid = opaque_tid(), wid = tid >> 6, lane = tid & 63;
    const bool last = (l == 1);
    const int tstep = gridDim.x * NWAVES;
    int tok = blockIdx.x * NWAVES + wid;
    int4 nts = make_int4(0, 0, 0, 0); float4 ntw = make_float4(0.f, 0.f, 0.f, 0.f);
    if (tok < M) { nts = *(const int4*)(p.tokslot + (size_t)tok * 4); ntw = *(const float4*)(p.topw + (size_t)tok * 4); }
    for (; tok < M; tok += tstep) {
        float4 v[4];
        const float* mb = p.mod + (size_t)(l * 5 + tok_modrow(tok)) * (NMOD * D);
        const int tsl[4] = {nts.x, nts.y, nts.z, nts.w}; const float wts[4] = {ntw.x, ntw.y, ntw.z, ntw.w};
        int rows[4];
#pragma unroll
        for (int k = 0; k < 4; ++k) rows[k] = ts[tsl[k] >> 16] * 256 + (tsl[k] & 0xffff);
        if (tok + tstep < M) { nts = *(const int4*)(p.tokslot + (size_t)(tok + tstep) * 4); ntw = *(const float4*)(p.topw + (size_t)(tok + tstep) * 4); }
        u32x2 yv[4][4]; float4 xin[4], gtv[4];
#pragma unroll
        for (int i = 0; i < 4; ++i) {
            const int cidx = i * 256 + lane * 4;
#pragma unroll
            for (int k = 0; k < 4; ++k) yv[i][k] = *(const u32x2*)(p.yp + (size_t)rows[k] * D + cidx);
            xin[i] = *(const float4*)(p.xl + (size_t)tok * D + cidx);
            gtv[i] = *(const float4*)(mb + 5 * D + cidx);
        }
        float ss = 0.f;
#pragma unroll
        for (int i = 0; i < 4; ++i) {
            float m0 = 0.f, m1 = 0.f, m2 = 0.f, m3 = 0.f;
#pragma unroll
            for (int k = 0; k < 4; ++k) { m0 += wts[k] * bflo(yv[i][k][0]); m1 += wts[k] * bfhi(yv[i][k][0]); m2 += wts[k] * bflo(yv[i][k][1]); m3 += wts[k] * bfhi(yv[i][k][1]); }
            float4 xv = xin[i];
            xv.x += gtv[i].x * m0; xv.y += gtv[i].y * m1; xv.z += gtv[i].z * m2; xv.w += gtv[i].w * m3;
            v[i] = xv; ss += xv.x * xv.x + xv.y * xv.y + xv.z * xv.z + xv.w * xv.w;
        }
        ss = wave_sum(ss, lane);
        const float rinv = rsqrtf(ss * (1.0f / D) + 1e-6f);
        if (!last) {
#pragma unroll
            for (int i = 0; i < 4; ++i) *(float4*)(c_xl + (size_t)tok * D + i * 256 + lane * 4) = v[i];
            const float* mb1 = p.mod + (size_t)((l + 1) * 5 + tok_modrow(tok)) * (NMOD * D);
            norm_mod_store(v, rinv, p.norm1_g + (l + 1) * D, mb1 + 1 * D, mb1 + 0 * D, c_H + (size_t)tok * D, lane);
        } else {
#pragma unroll
            for (int i = 0; i < 4; ++i) {
                const int cidx = i * 256 + lane * 4;
                const float4 gv = *(const float4*)(p.final_norm_g + cidx);
                *(float4*)(c_out + (size_t)tok * D + cidx) = make_float4(v[i].x * rinv * gv.x, v[i].y * rinv * gv.y, v[i].z * rinv * gv.z, v[i].w * rinv * gv.w);
            }
        }
    }
}

#define XB_TMO      128
#define XB_XCNT(j)  (256  + 64 * (j))
#define XB_XSUB(j)  (1280 + 64 * (j))
#define XB_XGEN(j)  (2304 + 64 * (j))
#define XB_TOP      3328
#define XB_TOPGEN   3392
#define XCD_BAR_WORDS 3456
#define XB_SPIN_CAP (1u << 18)

__device__ __forceinline__ unsigned xb_ld(unsigned* p)              { return __hip_atomic_load(p, __ATOMIC_RELAXED, __HIP_MEMORY_SCOPE_AGENT); }
__device__ __forceinline__ unsigned xb_add(unsigned* p, unsigned v) { return __hip_atomic_fetch_add(p, v, __ATOMIC_RELAXED, __HIP_MEMORY_SCOPE_AGENT); }
__device__ __forceinline__ unsigned xb_xcc_id() { return (unsigned)__builtin_amdgcn_s_getreg((3 << 11) | 20) & 0xFu; }
#define XB_SPIN(cond, bar) do { unsigned _sp = 0; while (cond) { __builtin_amdgcn_s_sleep(1); \
    if ((++_sp & 255u) == 0u) { if (xb_ld(&(bar)[XB_TMO])) break; if (_sp > XB_SPIN_CAP) { atomicAdd(&(bar)[XB_TMO], 1u); break; } } } } while (0)

struct XcdBarrier {
    unsigned* bar; unsigned x;
    volatile LAS unsigned* st;
};

__device__ __forceinline__ XcdBarrier xcd_barrier_post(unsigned* bar, volatile LAS unsigned* st) {
    XcdBarrier b; b.bar = bar; b.x = xb_xcc_id(); b.st = st;
    if (threadIdx.x == 0) (void)xb_add(&bar[XB_XCNT(b.x)], 1u);
    return b;
}
__device__ __forceinline__ void xcd_barrier_complete(unsigned* bar, unsigned x, unsigned& nloc, unsigned& nx) {
    const unsigned G = gridDim.x * gridDim.y * gridDim.z;
    unsigned sum, cnt, mine, sp = 0u;
    for (;;) {
        sum = 0u; cnt = 0u; mine = 0u;
#pragma unroll
        for (unsigned j = 0; j < 16; ++j) { const unsigned c = xb_ld(&bar[XB_XCNT(j)]); sum += c; cnt += (c > 0u) ? 1u : 0u; mine = (j == x) ? c : mine; }
        if (sum == G) break;
        __builtin_amdgcn_s_sleep(1);
        if ((++sp & 255u) == 0u) { if (xb_ld(&bar[XB_TMO])) break; if (sp > XB_SPIN_CAP) { atomicAdd(&bar[XB_TMO], 1u); break; } }
    }
    nloc = mine > 0u ? mine : 1u; nx = cnt > 0u ? cnt : 1u;
}

__device__ __forceinline__ void xcd_barrier(const XcdBarrier& b) {
    asm volatile("s_waitcnt vmcnt(0)" ::: "memory");
    __syncthreads();
    if (threadIdx.x == 0) {
        unsigned* bar = b.bar;
        __builtin_amdgcn_s_waitcnt(0);
        unsigned nloc = b.st[0], nx = b.st[1];
        if (nloc == 0u) { xcd_barrier_complete(bar, b.x, nloc, nx); b.st[0] = nloc; b.st[1] = nx; }
        const unsigned old = xb_add(&bar[XB_XSUB(b.x)], 1u);
        const unsigned gen = old / nloc;
        if (old + 1u == (gen + 1u) * nloc) {
            __builtin_amdgcn_fence(__ATOMIC_RELEASE, "agent");
            asm volatile("s_waitcnt vmcnt(0)" ::: "memory");
            const unsigned og = xb_add(&bar[XB_TOP], 1u);
            const unsigned tg = og / nx;
            if (og + 1u == (tg + 1u) * nx) xb_add(&bar[XB_TOPGEN], 1u);
            else XB_SPIN(xb_ld(&bar[XB_TOPGEN]) == tg, bar);
            __builtin_amdgcn_fence(__ATOMIC_ACQUIRE, "agent");
            xb_add(&bar[XB_XGEN(b.x)], 1u);
            asm volatile("s_waitcnt vmcnt(0)" ::: "memory");
        } else {
            XB_SPIN(xb_ld(&bar[XB_XGEN(b.x)]) == gen, bar);
            __builtin_amdgcn_fence(__ATOMIC_ACQUIRE, "agent");
            asm volatile("s_waitcnt vmcnt(0)" ::: "memory");
        }
    }
    __syncthreads();
}


extern __shared__ __attribute__((aligned(16))) unsigned char dyn_lds[];

typedef const __attribute__((address_space(4))) unsigned char* KArgPtr;
__device__ __forceinline__ Params load_params(KArgPtr kp) {
    asm volatile("" : "+s"(kp));
    Params q;
    const __attribute__((address_space(4))) unsigned long long* k8 = (const __attribute__((address_space(4))) unsigned long long*)kp;
    unsigned long long* d8 = (unsigned long long*)&q;
#pragma unroll
    for (int i = 0; i < (int)(sizeof(Params) / 8); ++i) d8[i] = k8[i];
    return q;
}
__global__ void __launch_bounds__(NTHREADS, 2) k_mega(Params p_unused) {
    (void)p_unused;
    const KArgPtr kp = (KArgPtr)__builtin_amdgcn_kernarg_segment_ptr();
    LAS unsigned char* lds = (LAS unsigned char*)dyn_lds;
    volatile LAS unsigned* xb_words = (volatile LAS unsigned*)(lds + LDS_BYTES - 16);
    if (threadIdx.x == 0) { xb_words[0] = 0u; xb_words[1] = 0u; xb_words[2] = 0u; xb_words[3] = 0u; }
    __syncthreads();
    { const Params p = load_params(kp); (void)xcd_barrier_post(p.bar, xb_words); }
#define GRID_BARRIER() do { XcdBarrier b_; b_.bar = load_params(kp).bar; b_.x = xb_xcc_id(); b_.st = xb_words; xcd_barrier(b_); } while (0)
#define PH(stmt) do { const Params p = load_params(kp); stmt; } while (0)
    PH(ph_convert(p, lds));
    PH(ph_mod(p, lds));
    GRID_BARRIER();
    PH(ph_norm1_first(p));
    GRID_BARRIER();
    for (int l = 0; l < 2; ++l) {
        const int M = l == 0 ? NTOK : NLAT;
        { unsigned lb_ = (unsigned)(size_t)lds; asm volatile("" : "+s"(lb_)); lds = (LAS unsigned char*)(size_t)lb_; }
        PH(ph_g1(p, l, lds));
        GRID_BARRIER();
        PH(ph_prep(p, l, lds));
        PH(ph_local(p, l, lds));
        GRID_BARRIER();
        PH(ph_seq(p, l, lds));
        GRID_BARRIER();
        PH(ph_merge(p, l, M));
        GRID_BARRIER();
        PH(ph_g2(p, l, M, lds));
        GRID_BARRIER();
        PH(ph_g3(p, l, M, lds));
        GRID_BARRIER();
        PH(ph_route(p, l, M, lds));
        GRID_BARRIER();
        PH(ph_g4(p, l, lds));
        GRID_BARRIER();
        PH(ph_g5(p, l, lds));
        GRID_BARRIER();
        PH(ph_combine(p, l, M, lds));
        if (l == 0) GRID_BARRIER();
    }
}

static inline size_t align_up(size_t v, size_t a) { return (v + a - 1) / a * a; }

extern "C" void kernel_launch(void* const* d_in, const int* in_sizes, int n_in, void* d_out, int out_size, void* d_ws, size_t ws_size, hipStream_t stream) {
    (void)in_sizes; (void)n_in; (void)out_size;
    Params p{};
    const float** pf = (const float**)&p;
    for (int i = 0; i < 32; ++i) pf[i] = (const float*)d_in[i];
    p.out = (float*)d_out;
    unsigned char* w = (unsigned char*)d_ws; size_t off = 0;
    auto take = [&](size_t bytes) { void* r = w + off; off = align_up(off + bytes, 256); return r; };
    p.bar = (unsigned*)take(16384);
    p.cnt = (int*)take(4096);
    const size_t ctl_bytes = off;
    p.mod = (float*)take((size_t)2 * 5 * NMOD * D * 4);
    p.winT = (bf16_t*)take((size_t)2 * NPW * D * 2);
    p.wbT = (bf16_t*)take((size_t)2 * 4 * D * MW * 2);
    p.woutT = (bf16_t*)take((size_t)2 * D * D * 2);
    p.w1T = (bf16_t*)take((size_t)2 * NE * 2 * D * D * 2);
    p.w2T = (bf16_t*)take((size_t)2 * NE * D * D * 2);
    p.xl = (float*)take((size_t)NTOK * D * 4);
    p.H = (bf16_t*)take((size_t)NTOK * D * 2);
    p.P = (bf16_t*)take((size_t)NTOK * NP * 2);
    p.gate = (bf16_t*)take((size_t)NTOK * 4096 * 2);
    p.act = p.P; p.yp = p.P + (size_t)CAPROWS * D;
    p.prep = (float*)take(NPREP * TOKW * 4);
    p.O = (bf16_t*)take(8 * TOKW * 2);
    p.lq = (bf16_t*)take((size_t)3 * NITEM * 64 * 128 * 2);
    p.lo = (bf16_t*)take((size_t)3 * NITEM * 64 * 128 * 2);
    p.lb = (bf16_t*)take((size_t)3 * NITEM * 128 * 128 * 2);
    p.la = (bf16_t*)take((size_t)NITEM * 128 * 128 * 2);
    p.ld = (float*)take((size_t)3 * NITEM * 128 * 4);
    p.lruT = (bf16_t*)take((size_t)2 * 8 * 4 * 4096 * 2);
    p.lsig = (float*)take((size_t)2 * 2 * MW * 4);
    p.rope = (float2*)take((size_t)TL * 64 * 8);
    p.Y = (bf16_t*)take(4 * TOKW * 2);
    p.mix = (bf16_t*)take((size_t)NTOK * D * 2);
    p.F = p.H;
    p.list = (int*)take((size_t)NE * NTOK * 4);
    p.tokslot = (int*)take((size_t)NTOK * 4 * 4);
    p.topw = (float*)take((size_t)NTOK * 4 * 4);
    if (off > ws_size) { fprintf(stderr, "workspace too small: need %zu have %zu\n", off, ws_size); return; }

    static int grid = 0;
    if (!grid) {
        int dev = 0, cus = 0, occ = 0; (void)hipGetDevice(&dev); (void)hipDeviceGetAttribute(&cus, hipDeviceAttributeMultiprocessorCount, dev);
        (void)hipFuncSetAttribute((const void*)k_mega, hipFuncAttributeMaxDynamicSharedMemorySize, LDS_BYTES);
        (void)hipOccupancyMaxActiveBlocksPerMultiprocessor(&occ, (const void*)k_mega, NTHREADS, LDS_BYTES);
        if (cus <= 0) cus = 256;
        grid = cus * (occ < 1 ? 1 : 1);
        if (occ < 1) fprintf(stderr, "occupancy query says %d blocks per CU\n", occ);
    }
    (void)hipMemsetAsync(d_ws, 0, ctl_bytes, stream);
    hipLaunchKernelGGL(k_mega, dim3(grid), dim3(NTHREADS), LDS_BYTES, stream, p);
}
```

```cpp
#include <hip/hip_runtime.h>
#include <stdint.h>
#include <stdio.h>

#define LAS __attribute__((address_space(3)))
typedef unsigned short bf16_t;
typedef short bf16x8 __attribute__((ext_vector_type(8)));
typedef float f32x4 __attribute__((ext_vector_type(4)));
typedef float f32x2 __attribute__((ext_vector_type(2)));
typedef unsigned u32x2 __attribute__((ext_vector_type(2)));
typedef unsigned u32x4 __attribute__((ext_vector_type(4)));

#ifndef PROBE
#define PROBE 0
#endif

constexpr int D = 1024, NB = 4, TL = 4096, TC = 256, NLAT = NB * TL, NCTX = NB * TC, NTOK = NLAT + NCTX;
constexpr int NIN = 11792, NPW = 12032, NP = 7936, MW = 512, NE = 32, TOPK = 4, NMOD = 6;
constexpr int C_GQKV = 0, C_GZ = 1536, C_HQ = 2048, C_HI = 2560, C_HF = 3072, C_HG = 4096, C_LX = 4608,
              C_LY = 5120, C_RQKV = 5632, C_RG = 7168, C_GA = 7680, C_GB = 7688, W_MG = 7936;
__host__ __device__ __forceinline__ int win_dst_row(int n) {
    if (n < 7696) return n < 2048 ? n : n < 2064 ? 7680 + (n - 2048) : n - 16;
    const int q = n - 7696, seg = q >> 10, lam = q & 1023, t = lam >> 6, li = lam & 63;
    return 7936 + t * 256 + (seg >> 1) * 128 + (li >> 4) * 32 + ((li >> 2) & 3) * 8 + (seg & 1) * 4 + (li & 3);
}
constexpr int NTHREADS = 512, NWAVES = 8;
constexpr int LDS_BYTES = 140 * 1024;
constexpr int CAPROWS = 77824;
constexpr size_t TOKW = (size_t)NTOK * MW;
constexpr int PR_LA = 0, PR_LU = 2, NPREP = 4;
constexpr int NCHUNK = 68, NITEM = 32 * NCHUNK;

struct Params {
    const float *x, *c, *ctx, *c_ctx, *w_mod, *b_mod, *norm1_g, *norm2_g, *w_in, *gdn_conv_w, *gdn_a_log, *gdn_dt_bias, *gdn_norm_g, *hgrn_lb,
        *hgrn_norm_g, *lru_conv_w, *lru_conv_b, *lru_wa, *lru_ba, *lru_wx, *lru_bx, *lru_lambda, *ret_norm_g, *w_branch, *w_out, *router_w,
        *router_b, *moe_w1, *moe_b1, *moe_w2, *moe_b2, *final_norm_g;
    float* out;
    unsigned* bar; int* cnt; float* mod;
    bf16_t *winT, *wbT, *woutT, *w1T, *w2T;
    float* xl; bf16_t* H; bf16_t* P; float* prep; float* gg; float* gb; bf16_t* O; bf16_t* Y; bf16_t* mix; bf16_t* F;
    int* list; int* tokslot; float* topw; bf16_t* act; bf16_t* yp;
    bf16_t *lq, *lo, *lb, *la; float* ld; bf16_t* lruT; bf16_t* gate; float* lsig; float2* rope;
};

typedef __bf16 bf16x2_t __attribute__((ext_vector_type(2)));
__device__ __forceinline__ unsigned pack2(float a, float b) { const f32x2 v = {a, b}; return __builtin_bit_cast(unsigned, __builtin_convertvector(v, bf16x2_t)); }
__device__ __forceinline__ unsigned f2bf(float f) { return pack2(f, f) & 0xffffu; }
__device__ __forceinline__ float bf2f(bf16_t b) { return __uint_as_float(((unsigned)b) << 16); }
__device__ __forceinline__ float bflo(unsigned u) { return __uint_as_float(u << 16); }
__device__ __forceinline__ float bfhi(unsigned u) { return __uint_as_float(u & 0xffff0000u); }
__device__ __forceinline__ float sigmoidf_(float x) { return __builtin_amdgcn_rcpf(1.0f + __expf(-x)); }
__device__ __forceinline__ float siluf_(float x) { return x * sigmoidf_(x); }
__device__ __forceinline__ float softplusf_(float x) { return x > 20.f ? x : __logf(1.0f + __expf(x)); }
__device__ __forceinline__ float ret_log_gamma(int h) { return h == 0 ? -0.031748698314580f : h == 1 ? -0.015748356968139f : h == 2 ? -0.007843177461025f : -0.003913899321136f; }
__device__ __forceinline__ float logsigmoidf_(float x) { return -softplusf_(-x); }
__device__ __forceinline__ float gelu_tanhf_(float x) { const float u = 0.7978845608028654f * (x + 0.044715f * x * x * x); return x * __builtin_amdgcn_rcpf(1.0f + __expf(-2.0f * u)); }
__device__ __forceinline__ float shx(float v, int m, int lane) { return __int_as_float(__builtin_amdgcn_ds_bpermute((lane ^ m) << 2, __float_as_int(v))); }
__device__ __forceinline__ float shup(float v, int off, int lane) { const int s = lane >= off ? lane - off : lane; return __int_as_float(__builtin_amdgcn_ds_bpermute(s << 2, __float_as_int(v))); }
__device__ __forceinline__ int shupi(int v, int off, int lane) { const int s = lane >= off ? lane - off : lane; return __builtin_amdgcn_ds_bpermute(s << 2, v); }
__device__ __forceinline__ float wave_sum(float v, int lane) {
#pragma unroll
    for (int m = 32; m >= 1; m >>= 1) v += shx(v, m, lane);
    return v;
}
__device__ __forceinline__ int opaque_tid() { int t = threadIdx.x; asm volatile("" : "+v"(t)); return t; }
template <class T> __device__ __forceinline__ T* opaque_sptr(T* q) { asm volatile("" : "+s"(q)); return q; }
__device__ __forceinline__ int tok_modrow(int tok) { return tok < NLAT ? (tok >> 12) : 4; }
__device__ __forceinline__ void tok_info(int tok, int& t, int& T, int& base) {
    if (tok < NLAT) { t = tok & (TL - 1); T = TL; base = tok - t; }
    else { t = (tok - NLAT) & (TC - 1); T = TC; base = tok - t; }
}

__device__ __forceinline__ f32x4 mfma16(bf16x8 a, bf16x8 b, f32x4 c) { return __builtin_amdgcn_mfma_f32_16x16x32_bf16(a, b, c, 0, 0, 0); }
__device__ __forceinline__ u32x2 pack4(f32x4 v) { u32x2 o; o[0] = pack2(v[0], v[1]); o[1] = pack2(v[2], v[3]); return o; }
__device__ __forceinline__ u32x4 pack8(const float* v) { u32x4 o; o[0] = pack2(v[0], v[1]); o[1] = pack2(v[2], v[3]); o[2] = pack2(v[4], v[5]); o[3] = pack2(v[6], v[7]); return o; }

namespace g8 {
constexpr int BM = 256, BK = 64, HALF = 128, HTB = HALF * BK * 2, STAGE_BYTES = 8 * HTB;
__device__ __forceinline__ int lds_byte(int r, int c) { const int st = (r >> 4) * 2 + (c >> 5), rr = r & 15, cc = c & 31, ob = rr * 64 + cc * 2; return st * 1024 + (ob ^ (((ob >> 9) & 1) << 5)); }
__device__ __forceinline__ void stage_rc(int b, int& R, int& C) { const int st = b / 1024, sb = b % 1024, swz = sb ^ (((sb >> 9) & 1) << 5); R = (st >> 1) * 16 + swz / 64; C = (st & 1) * 32 + (swz % 64) / 2; }
__device__ __forceinline__ int perm32(int rho) { const int n = rho >> 4, i = rho & 15; return 8 * (i >> 2) + 4 * n + (i & 3); }
struct Unit { int pm, pn, e; };

template <class Epi, class Sched>
__device__ __forceinline__ void gemm_phase(LAS unsigned char* lds, const int K, const Sched& S, const Epi& E) {
    const int tid = opaque_tid(), wid = __builtin_amdgcn_readfirstlane(tid >> 6), lane = tid & 63, wr = wid >> 2, wc = wid & 3, fr = lane & 15, fq = lane >> 4;
    const int nt = K / BK;
    int R0, C0, R1, C1; stage_rc(tid * 16, R0, C0); stage_rc(tid * 16 + 8192, R1, C1);
    unsigned voffB[2];
    voffB[0] = (unsigned)(((R0 & ~31) + perm32(R0 & 31)) * K + C0) * 2u; voffB[1] = (unsigned)(((R1 & ~31) + perm32(R1 & 31)) * K + C1) * 2u;
    const unsigned cb0 = (unsigned)C0 * 2u, cb1 = (unsigned)C1 * 2u;
    const size_t kstep = (size_t)(BK * 2);
    const size_t hstepB = (size_t)HALF * K * 2;
    const unsigned ldsw = (unsigned)wid * 1024u;
    const int aoff = lds_byte(wr * 64 + fr, fq * 8), boff = lds_byte(wc * 32 + fr, fq * 8);
#define G8_SA(b, h) (((b) * 2 + (h)) * HTB)
#define G8_SB(b, h) ((4 + (b) * 2 + (h)) * HTB)
#define G8_GL(src, dstoff) __builtin_amdgcn_global_load_lds((const unsigned*)(src), (LAS unsigned*)(lds + (dstoff)), 16, 0, 0)
#define G8_STAGE_A(bufoff, gbase, vo, h) do { G8_GL((const char*)(gbase) + (vo)[2 * (h)], (bufoff) + ldsw); G8_GL((const char*)(gbase) + (vo)[2 * (h) + 1], (bufoff) + ldsw + 8192); } while (0)
#define G8_STAGE_B(bufoff, gbase) do { G8_GL((const char*)(gbase) + voffB[0], (bufoff) + ldsw); G8_GL((const char*)(gbase) + voffB[1], (bufoff) + ldsw + 8192); } while (0)
#define G8_LDA(dst, b, h) do { _Pragma("unroll") for (int m = 0; m < 4; ++m) _Pragma("unroll") for (int k = 0; k < 2; ++k) dst[m][k] = *(const LAS bf16x8*)(lds + G8_SA(b, h) + aoff + m * 2048 + k * 1024); } while (0)
#define G8_LDB(dst, b, h) do { _Pragma("unroll") for (int n = 0; n < 2; ++n) _Pragma("unroll") for (int k = 0; k < 2; ++k) dst[n][k] = *(const LAS bf16x8*)(lds + G8_SB(b, h) + boff + n * 2048 + k * 1024); } while (0)
#define G8_MMA(ai, bj, At, Bt) do { __builtin_amdgcn_s_setprio(1); _Pragma("unroll") for (int m = 0; m < 4; ++m) _Pragma("unroll") for (int n = 0; n < 2; ++n) _Pragma("unroll") for (int k = 0; k < 2; ++k) \
        acc[ai][bj][m][n] = __builtin_amdgcn_mfma_f32_16x16x32_bf16(Bt[n][k], At[m][k], acc[ai][bj][m][n], 0, 0, 0); __builtin_amdgcn_s_setprio(0); } while (0)
#define G8_WAIT_V(n) asm volatile("s_waitcnt vmcnt(" #n ")" ::: "memory")
#define G8_WAIT_L(n) asm volatile("s_waitcnt lgkmcnt(" #n ")" ::: "memory")
#define G8_BAR __builtin_amdgcn_s_barrier()
#define G8_SCHED __builtin_amdgcn_sched_barrier(0)
    Unit cur, nxt; int ui = 0;
    if (!S.next(0, cur)) return;
    LAS float* biasbuf = (LAS float*)(lds + STAGE_BYTES + 2048);
    LAS int* rowbuf = (LAS int*)(lds + STAGE_BYTES + 4096);
    f32x4 acc[2][2][4][2];
#pragma unroll
    for (int a = 0; a < 2; ++a)
#pragma unroll
        for (int b = 0; b < 2; ++b)
#pragma unroll
            for (int m = 0; m < 4; ++m)
#pragma unroll
                for (int n = 0; n < 2; ++n) acc[a][b][m][n] = (f32x4){0.f, 0.f, 0.f, 0.f};
    bf16x8 At[4][2], B0[2][2], B1[2][2];
    unsigned vA[4];
    {
        unsigned rows[4] = {(unsigned)R0, (unsigned)R1, (unsigned)(HALF + R0), (unsigned)(HALF + R1)};
        if (S.gather) { rows[0] = (unsigned)*S.row_addr(cur, R0); rows[1] = (unsigned)*S.row_addr(cur, R1); rows[2] = (unsigned)*S.row_addr(cur, HALF + R0); rows[3] = (unsigned)*S.row_addr(cur, HALF + R1); }
        vA[0] = rows[0] * (unsigned)(K * 2) + cb0; vA[1] = rows[1] * (unsigned)(K * 2) + cb1; vA[2] = rows[2] * (unsigned)(K * 2) + cb0; vA[3] = rows[3] * (unsigned)(K * 2) + cb1;
    }
    const char* cA = S.a_base(cur); const char* cB = S.b_base(cur);
    G8_STAGE_B(G8_SB(0, 0), cB); G8_STAGE_A(G8_SA(0, 0), cA, vA, 0); G8_STAGE_B(G8_SB(0, 1), cB + hstepB); G8_STAGE_A(G8_SA(0, 1), cA, vA, 1);
    if (wr == 1) G8_BAR;
    G8_WAIT_V(4); G8_BAR;
    G8_STAGE_B(G8_SB(1, 0), cB + kstep); G8_STAGE_A(G8_SA(1, 0), cA + kstep, vA, 0); G8_STAGE_B(G8_SB(1, 1), cB + hstepB + kstep);
    G8_WAIT_V(6); G8_BAR;
    for (;;) {
        const bool has_next = S.next(ui + 1, nxt);
        const char* nA = has_next ? S.a_base(nxt) : cA; const char* nB = has_next ? S.b_base(nxt) : cB;
        const int nvalid = (S.gather && has_next) ? S.rows_valid(nxt) : 0;
        if (wid == 0) {
            if (Sched::HAS_BIAS) G8_GL(S.bias_src(cur, lane), STAGE_BYTES + 2048 + (ui & 1) * 1024);
            if (S.gather && has_next) G8_GL(S.row_addr(nxt, 0) + lane * 4, STAGE_BYTES + 4096 + ((ui + 1) & 1) * 1024);
        }
        for (int t = 0; t < nt; t += 2) {
            const bool last = (t == nt - 2);
            const char* a1 = cA + (size_t)(t + 1) * kstep;
            const char* a2 = last ? nA : cA + (size_t)(t + 2) * kstep; const char* b2 = last ? nB : cB + (size_t)(t + 2) * kstep;
            const char* a3 = a2 + kstep; const char* b3 = b2 + kstep;
            G8_LDB(B0, 0, 0); G8_SCHED; G8_LDA(At, 0, 0); G8_STAGE_A(G8_SA(1, 1), a1, vA, 1);
            if (last && S.gather && has_next) {
                const LAS int* rb = rowbuf + ((ui + 1) & 1) * 256;
                const unsigned r0 = R0 < nvalid ? (unsigned)rb[R0] : 0u, r1 = R1 < nvalid ? (unsigned)rb[R1] : 0u;
                const unsigned r2 = HALF + R0 < nvalid ? (unsigned)rb[HALF + R0] : 0u, r3 = HALF + R1 < nvalid ? (unsigned)rb[HALF + R1] : 0u;
                vA[0] = r0 * (unsigned)(K * 2) + cb0; vA[1] = r1 * (unsigned)(K * 2) + cb1; vA[2] = r2 * (unsigned)(K * 2) + cb0; vA[3] = r3 * (unsigned)(K * 2) + cb1;
            }
            G8_WAIT_L(8); G8_BAR; G8_WAIT_L(0); G8_MMA(0, 0, At, B0); G8_BAR; G8_SCHED;
            G8_LDB(B1, 0, 1); G8_STAGE_B(G8_SB(0, 0), b2);
            G8_BAR; G8_WAIT_L(0); G8_MMA(0, 1, At, B1); G8_BAR;
            G8_LDA(At, 0, 1); G8_STAGE_A(G8_SA(0, 0), a2, vA, 0);
            G8_BAR; G8_WAIT_L(0); G8_MMA(1, 0, At, B0); G8_BAR; G8_SCHED;
            G8_STAGE_B(G8_SB(0, 1), b2 + hstepB);
            G8_WAIT_V(6); G8_BAR; G8_MMA(1, 1, At, B1); G8_BAR;
            G8_LDB(B0, 1, 0); G8_SCHED; G8_LDA(At, 1, 0); G8_STAGE_A(G8_SA(0, 1), a2, vA, 1);
            G8_WAIT_L(8); G8_BAR; G8_WAIT_L(0); G8_MMA(0, 0, At, B0); G8_BAR; G8_SCHED;
            G8_LDB(B1, 1, 1); G8_STAGE_B(G8_SB(1, 0), b3);
            G8_BAR; G8_WAIT_L(0); G8_MMA(0, 1, At, B1); G8_BAR;
            G8_LDA(At, 1, 1); G8_STAGE_A(G8_SA(1, 0), a3, vA, 0);
            G8_BAR; G8_WAIT_L(0); G8_MMA(1, 0, At, B0); G8_BAR; G8_SCHED;
            G8_STAGE_B(G8_SB(1, 1), b3 + hstepB);
            G8_WAIT_V(6); G8_BAR; G8_MMA(1, 1, At, B1); G8_BAR;
        }
        E(acc, cur, wr, wc, fr, fq, biasbuf + (ui & 1) * 256);
        if (!has_next) break;
        if (!E.keep(cur))
#pragma unroll
        for (int a = 0; a < 2; ++a)
#pragma unroll
            for (int b = 0; b < 2; ++b)
#pragma unroll
                for (int m = 0; m < 4; ++m)
#pragma unroll
                    for (int n = 0; n < 2; ++n) acc[a][b][m][n] = (f32x4){0.f, 0.f, 0.f, 0.f};
        cur = nxt; cA = nA; cB = nB; ++ui;
    }
    G8_WAIT_V(0);
    if (wr == 0) G8_BAR;
    G8_BAR;
#undef G8_SA
#undef G8_SB
#undef G8_GL
#undef G8_STAGE_A
#undef G8_STAGE_B
#undef G8_LDA
#undef G8_LDB
#undef G8_MMA
#undef G8_WAIT_V
#undef G8_WAIT_L
#undef G8_BAR
#undef G8_SCHED
}

struct PlainSched {
    const bf16_t* A; const bf16_t* Bt; int K, nM, nN, nwg, G, c;
    __device__ __forceinline__ void init(const bf16_t* A_, const bf16_t* Bt_, int M, int N, int K_) { A = A_; Bt = Bt_; K = K_; nM = M / BM; nN = N / BM; nwg = nM * nN; G = gridDim.x; c = blockIdx.x; }
    __device__ __forceinline__ bool next(int i, Unit& u) const {
        const long L = (long)i * G + c; if (L >= nwg) return false;
        int wgid = (int)L; { const int q = nwg / 8, r = nwg % 8, xcd = wgid % 8, off = wgid / 8; wgid = (xcd < r ? xcd * (q + 1) : r * (q + 1) + (xcd - r) * q) + off; }
        const int nig = 8 * nN, gid = wgid / nig, fm = gid * 8, gsz = (nM - fm) < 8 ? (nM - fm) : 8;
        u.pm = fm + ((wgid % nig) % gsz); u.pn = (wgid % nig) / gsz; u.e = 0; return true;
    }
    __device__ __forceinline__ const char* a_base(const Unit& u) const { return (const char*)(A + (size_t)u.pm * BM * K); }
    __device__ __forceinline__ const char* b_base(const Unit& u) const { return (const char*)(Bt + (size_t)u.pn * BM * K); }
    static constexpr bool HAS_BIAS = false, gather = false;
    __device__ __forceinline__ const int* row_addr(const Unit&, int) const { return nullptr; }
    __device__ __forceinline__ int rows_valid(const Unit&) const { return 256; }
    __device__ __forceinline__ const float* bias_src(const Unit&, int) const { return nullptr; }
};
}

__device__ __forceinline__ int w1_dst_row(int n) { const int half = n >> 10, cc = n & 1023; return (cc >> 7) * 256 + half * 128 + (cc & 127); }

struct CvtTile { const float* src; bf16_t* dst; int ld, Nsrc, k0, n0, K, mode; };
__device__ __forceinline__ CvtTile cvt_decode(const Params& p, int it) {
    constexpr int PER_L = 2960 + 512 + 256 + 16384 + 8192;
    CvtTile t; const int l = it / PER_L; int r = it % PER_L;
    if (r < 2960) { const int nt = r % 185, kt = r / 185; t.src = p.w_in + (size_t)l * D * NIN; t.ld = NIN; t.Nsrc = NIN; t.k0 = kt * 64; t.n0 = nt * 64; t.dst = p.winT + (size_t)l * NPW * D; t.K = D; t.mode = 2; }
    else if (r < 3472) { r -= 2960; const int n = r / 128; r %= 128; const int nt = r % 16, kt = r / 16;
        t.src = p.w_branch + (size_t)(l * 4 + n) * MW * D; t.ld = D; t.Nsrc = D; t.k0 = kt * 64; t.n0 = nt * 64; t.dst = p.wbT + (size_t)(l * 4 + n) * D * MW; t.K = MW; t.mode = 0; }
    else if (r < 3728) { r -= 3472; const int nt = r % 16, kt = r / 16; t.src = p.w_out + (size_t)l * D * D; t.ld = D; t.Nsrc = D; t.k0 = kt * 64; t.n0 = nt * 64; t.dst = p.woutT + (size_t)l * D * D; t.K = D; t.mode = 0; }
    else if (r < 3728 + 16384) { r -= 3728; const int ee = r / 512; r %= 512; const int nt = r % 32, kt = r / 32;
        t.src = p.moe_w1 + (size_t)(l * NE + ee) * D * 2 * D; t.ld = 2 * D; t.Nsrc = 2 * D; t.k0 = kt * 64; t.n0 = nt * 64; t.dst = p.w1T + (size_t)(l * NE + ee) * 2 * D * D; t.K = D; t.mode = 1; }
    else { r -= 3728 + 16384; const int ee = r / 256; r %= 256; const int nt = r % 16, kt = r / 16;
        t.src = p.moe_w2 + (size_t)(l * NE + ee) * D * D; t.ld = D; t.Nsrc = D; t.k0 = kt * 64; t.n0 = nt * 64; t.dst = p.w2T + (size_t)(l * NE + ee) * D * D; t.K = D; t.mode = 0; }
    return t;
}

constexpr int CVT_TOTAL = 2 * (2960 + 512 + 256 + 16384 + 8192);
constexpr int CVT_G_FIRST = 932;
constexpr int CVT_G_L0 = 8008;
constexpr int CVT_G_ALL = CVT_TOTAL / 4;
__device__ __forceinline__ void cvt_trip(const Params& p, LAS float* tile, int tid, int g) {
    constexpr int TOTAL = CVT_TOTAL;
    float4 v[4][2];
    const int rr = tid >> 4, c4 = (tid & 15) * 4;
#pragma unroll
    for (int q = 0; q < 4; ++q) {
        const int it = g * 4 + q;
        const CvtTile t = cvt_decode(p, it < TOTAL ? it : TOTAL - 1);
        const int n = t.n0 + c4; const bool ok = n < t.Nsrc; const int nc = ok ? n : t.Nsrc - 4;
#pragma unroll
        for (int i = 0; i < 2; ++i) { const float4 x = *(const float4*)(t.src + (size_t)(t.k0 + rr + i * 32) * t.ld + nc); v[q][i] = ok ? x : make_float4(0.f, 0.f, 0.f, 0.f); }
    }
#pragma unroll
    for (int q = 0; q < 4; ++q)
#pragma unroll
        for (int i = 0; i < 2; ++i) { LAS float* tp = tile + q * 4160 + (rr + i * 32) * 65 + c4; tp[0] = v[q][i].x; tp[1] = v[q][i].y; tp[2] = v[q][i].z; tp[3] = v[q][i].w; }
    __syncthreads();
#pragma unroll
    for (int q = 0; q < 4; ++q) {
        const int it = g * 4 + q;
        if (it < TOTAL) {
            const CvtTile t = cvt_decode(p, it);
            const int nl = tid >> 3, kg = tid & 7, n = t.n0 + nl;
            float w[8];
#pragma unroll
            for (int j = 0; j < 8; ++j) w[j] = tile[q * 4160 + (kg * 8 + j) * 65 + nl];
            const int drow = t.mode == 1 ? w1_dst_row(n) : t.mode == 2 ? win_dst_row(n) : n;
            if (n < t.Nsrc) *(u32x4*)(t.dst + (size_t)drow * t.K + t.k0 + kg * 8) = pack8(w);
        }
    }
    __syncthreads();
}
__device__ __forceinline__ void cvt_fill(const Params& p, LAS unsigned char* lds, int w, int b1, int n1, int b2, int n2) {
    LAS float* tile = (LAS float*)lds; LAS int* tk = (LAS int*)(lds + 4 * 4160 * 4);
    int* const head = p.cnt + 256 + 32 * w;
    const int tid = opaque_tid();
    __syncthreads();
    int nxt = 0;
    if (tid == 0) nxt = atomicAdd(head, 1);
    for (;;) {
        if (tid == 0) tk[0] = nxt;
        __syncthreads();
        const int t = __builtin_amdgcn_readfirstlane(tk[0]);
        if (t >= n1 + n2) break;
        if (tid == 0) nxt = atomicAdd(head, 1);
        cvt_trip(p, tile, tid, t < n1 ? b1 + t : b2 + (t - n1));
    }
}
constexpr int CW_G1A = 932, CW_SEQ0A = 1932, CW_G2 = 4476, CW_G3 = 6476, CW_SEQ0B = 7076, CW_G1B = 8842, CW_SEQ1 = 9842;

__device__ __forceinline__ void ph_convert(const Params& p, LAS unsigned char* lds) {
    LAS float* tile = (LAS float*)lds;
    const int tid = opaque_tid();
    for (int idx = blockIdx.x * NTHREADS + tid; idx < 2 * 8 * 4 * 4096; idx += gridDim.x * NTHREADS) {
        const int i = idx & 63, j = (idx >> 6) & 63, mat = (idx >> 12) & 3, n = (idx >> 14) & 7, ll = idx >> 17, d = mat >> 1;
        p.lruT[idx] = (bf16_t)f2bf(((mat & 1) ? p.lru_wx : p.lru_wa)[(size_t)((ll * 2 + d) * 8 + n) * 4096 + i * 64 + j]);
    }
    for (int idx = blockIdx.x * NTHREADS + tid; idx < 2 * 2 * MW; idx += gridDim.x * NTHREADS) p.lsig[idx] = 8.0f * logsigmoidf_(p.lru_lambda[idx]);
    for (int idx = blockIdx.x * NTHREADS + tid; idx < TL * 64; idx += gridDim.x * NTHREADS) {
        const int t = idx >> 6, pi = idx & 63;
        const float pos = (pi < 32) ? (float)(t >> 6) : (float)(t & 63);
        const float ang = pos * exp2f(-(float)(pi & 31) * (13.287712379549449f / 32.0f));
        float sn, cs; sincosf(ang, &sn, &cs);
        p.rope[idx] = make_float2(cs, sn);
    }
    for (int idx = blockIdx.x * NTHREADS + tid; idx < 2 * 240 * (D / 8); idx += gridDim.x * NTHREADS) {
        const int ll = idx / (240 * (D / 8)), r = idx % (240 * (D / 8));
        *(u32x4*)(p.winT + ((size_t)ll * NPW + 7696) * D + (size_t)r * 8) = (u32x4){0u, 0u, 0u, 0u};
    }
    for (int g = blockIdx.x; g < CVT_G_FIRST; g += gridDim.x) cvt_trip(p, tile, tid, g);
}

__device__ __forceinline__ void ph_mod(const Params& p, LAS unsigned char* lds) {
    LAS float* sc = (LAS float*)lds;
    LAS float* red = sc + 5 * D;
    const int tid = opaque_tid(), wid = tid >> 6, lane = tid & 63;
    if ((int)blockIdx.x >= 192) return;
    for (int i = tid; i < 5 * D; i += NTHREADS) { const int r = i >> 10, k = i & 1023; const float v = r < 4 ? p.c[r * D + k] : p.c_ctx[k]; sc[i] = siluf_(v); }
    __syncthreads();
    for (int it = blockIdx.x; it < 192; it += gridDim.x) {
        const int l = it / 96, n0 = (it % 96) * 64;
        float acc[5] = {0.f, 0.f, 0.f, 0.f, 0.f};
        const float* wp = p.w_mod + (size_t)l * D * (NMOD * D) + n0 + lane;
        for (int k = wid * 128; k < wid * 128 + 128; ++k) {
            const float wv = wp[(size_t)k * (NMOD * D)];
#pragma unroll
            for (int r = 0; r < 5; ++r) acc[r] += sc[r * D + k] * wv;
        }
#pragma unroll
        for (int r = 0; r < 5; ++r) red[(wid * 5 + r) * 64 + lane] = acc[r];
        __syncthreads();
        if (tid < 320) { const int r = tid >> 6, cidx = tid & 63; float s = p.b_mod[l * NMOD * D + n0 + cidx];
#pragma unroll
            for (int w = 0; w < 8; ++w) s += red[(w * 5 + r) * 64 + cidx];
            p.mod[(size_t)(l * 5 + r) * (NMOD * D) + n0 + cidx] = s; }
        __syncthreads();
    }
}

__device__ __forceinline__ void norm_mod_store(const float4 (&v)[4], float rinv, const float* g, const float* scp, const float* shp, bf16_t* dst, int lane) {
#pragma unroll
    for (int i = 0; i < 4; ++i) {
        const int cidx = i * 256 + lane * 4;
        const float4 gv = *(const float4*)(g + cidx), sv = *(const float4*)(scp + cidx), hv = *(const float4*)(shp + cidx);
        const float h0 = v[i].x * rinv * gv.x * (1.f + sv.x) + hv.x, h1 = v[i].y * rinv * gv.y * (1.f + sv.y) + hv.y;
        const float h2 = v[i].z * rinv * gv.z * (1.f + sv.z) + hv.z, h3 = v[i].w * rinv * gv.w * (1.f + sv.w) + hv.w;
        u32x2 o; o[0] = pack2(h0, h1); o[1] = pack2(h2, h3);
        *(u32x2*)(dst + cidx) = o;
    }
}
__device__ __forceinline__ void ph_norm1_first(const Params& p) {
    const int tid = opaque_tid(), wid = tid >> 6, lane = tid & 63;
    for (int tok = blockIdx.x * NWAVES + wid; tok < NTOK; tok += gridDim.x * NWAVES) {
        const float* src = tok < NLAT ? p.x + (size_t)tok * D : p.ctx + (size_t)(tok - NLAT) * D;
        float4 v[4]; float ss = 0.f;
#pragma unroll
        for (int i = 0; i < 4; ++i) { v[i] = *(const float4*)(src + i * 256 + lane * 4); ss += v[i].x * v[i].x + v[i].y * v[i].y + v[i].z * v[i].z + v[i].w * v[i].w; }
        ss = wave_sum(ss, lane);
        const float rinv = rsqrtf(ss * (1.0f / D) + 1e-6f);
        const float* mb = p.mod + (size_t)(0 * 5 + tok_modrow(tok)) * (NMOD * D);
        norm_mod_store(v, rinv, p.norm1_g, mb + 1 * D, mb + 0 * D, p.H + (size_t)tok * D, lane);
#pragma unroll
        for (int i = 0; i < 4; ++i) *(float4*)(p.xl + (size_t)tok * D + i * 256 + lane * 4) = v[i];
    }
}

struct EpiP {
    bf16_t* O; bf16_t* gate;
    __device__ __forceinline__ bool keep(const g8::Unit&) const { return false; }
    __device__ __forceinline__ void operator()(const f32x4 (&acc)[2][2][4][2], const g8::Unit& u, int wr, int wc, int fr, int fq, const LAS float*) const {
        if (u.pn < 31) {
            const int row0 = u.pm * 256 + wr * 64 + fr, col0 = u.pn * 256 + wc * 32 + 8 * fq;
#pragma unroll
            for (int ai = 0; ai < 2; ++ai)
#pragma unroll
                for (int m = 0; m < 4; ++m) {
                    bf16_t* rowp = O + (size_t)(row0 + ai * 128 + m * 16) * NP + col0;
#pragma unroll
                    for (int bj = 0; bj < 2; ++bj) {
                        u32x4 w; w[0] = pack2(acc[ai][bj][m][0][0], acc[ai][bj][m][0][1]); w[1] = pack2(acc[ai][bj][m][0][2], acc[ai][bj][m][0][3]);
                        w[2] = pack2(acc[ai][bj][m][1][0], acc[ai][bj][m][1][1]); w[3] = pack2(acc[ai][bj][m][1][2], acc[ai][bj][m][1][3]);
                        *(u32x4*)(rowp + bj * 128) = w;
                    }
                }
        } else {
            const int t = u.pn - 31;
            const int wave2 = wr * 4 + (t & 1) * 2 + (wc >> 1), lane2 = ((wc & 1) * 2 + (fq >> 1)) * 16 + fr, bj2 = (t & 3) >> 1;
            bf16_t* gp = gate + ((((size_t)u.pm * 16 + (t >> 2)) * 8 + wave2) * 16 + bj2) * 512 + lane2 * 8 + (fq & 1) * 4;
#pragma unroll
            for (int ai = 0; ai < 2; ++ai)
#pragma unroll
                for (int m = 0; m < 4; ++m) {
                    float r[4][4];
#pragma unroll
                    for (int j = 0; j < 4; ++j) {
                        float d[4];
#pragma unroll
                        for (int sg = 0; sg < 4; ++sg) d[sg] = 1.0f + __expf(-fminf(fmaxf(acc[ai][sg >> 1][m][sg & 1][j], -30.0f), 30.0f));
#pragma unroll
                        for (int sg = 0; sg < 4; ++sg) { const float gi = __builtin_amdgcn_rcpf(d[sg]); r[sg][j] = sg < 3 ? gi * d[sg + 1] : gi; }
                    }
#pragma unroll
                    for (int sg = 0; sg < 4; ++sg) {
                        uint2 w; w.x = pack2(r[sg][0], r[sg][1]); w.y = pack2(r[sg][2], r[sg][3]);
                        *(uint2*)(gp + (size_t)sg * (4 * 8 * 16 * 512) + (ai * 8 + m * 2) * 512) = w;
                    }
                }
        }
    }
};
__device__ __forceinline__ void ph_g1(const Params& p, int l, LAS unsigned char* lds) {
    g8::PlainSched S; S.init(p.H, p.winT + (size_t)l * NPW * D, NTOK, NPW, D);
    EpiP E; E.O = p.P; E.gate = p.gate;
    g8::gemm_phase(lds, D, S, E);
    if ((int)blockIdx.x >= (NTOK / 256) * (NPW / 256) % 256) { if (l == 0) cvt_fill(p, lds, 2, CW_G1A, CW_SEQ0A - CW_G1A, 0, 0); else cvt_fill(p, lds, 3, CW_G1B, CW_SEQ1 - CW_G1B, 0, 0); }
}

__device__ __forceinline__ void ph_prep(const Params& p, int l, LAS unsigned char* lds) {
    const int tid = opaque_tid(), wid = tid >> 6, lane = tid & 63, fr = lane & 15, fq = lane >> 4;
    LAS float* xs = (LAS float*)lds;
    LAS bf16_t* xb = (LAS bf16_t*)(xs + 64 * 68);
    LAS bf16_t* wt = xb + 64 * 72;
    for (int it = blockIdx.x; it < (NTOK / 64) * 8; it += gridDim.x) {
        const int tile = it >> 3, n = it & 7, tok0 = tile * 64;
        {
            const int tl = tid & 63, cg = tid >> 6, tok = tok0 + tl;
            int t, T, base; tok_info(tok, t, T, base);
            float a[8];
            { const float4 b0 = *(const float4*)(p.lru_conv_b + l * MW + n * 64 + cg * 8), b1 = *(const float4*)(p.lru_conv_b + l * MW + n * 64 + cg * 8 + 4);
              a[0] = b0.x; a[1] = b0.y; a[2] = b0.z; a[3] = b0.w; a[4] = b1.x; a[5] = b1.y; a[6] = b1.z; a[7] = b1.w; }
#pragma unroll
            for (int j = 0; j < 4; ++j) {
                const int tt = t + j - 2;
                const float okf = (tt >= 0 && tt < T) ? 1.0f : 0.0f;
                const int ttc = tt < 0 ? 0 : (tt >= T ? T - 1 : tt);
                const u32x4 u = *(const u32x4*)(p.P + (size_t)(base + ttc) * NP + C_LX + n * 64 + cg * 8);
                const float* w = p.lru_conv_w + (size_t)(l * 4 + j) * MW + n * 64 + cg * 8;
                const float4 wa = *(const float4*)w, wb = *(const float4*)(w + 4);
                const float wv[8] = {wa.x * okf, wa.y * okf, wa.z * okf, wa.w * okf, wb.x * okf, wb.y * okf, wb.z * okf, wb.w * okf};
#pragma unroll
                for (int q = 0; q < 4; ++q) { a[2 * q] += wv[2 * q] * bflo(u[q]); a[2 * q + 1] += wv[2 * q + 1] * bfhi(u[q]); }
            }
            *(LAS f32x4*)(xs + tl * 68 + cg * 8) = (f32x4){a[0], a[1], a[2], a[3]}; *(LAS f32x4*)(xs + tl * 68 + cg * 8 + 4) = (f32x4){a[4], a[5], a[6], a[7]};
            *(LAS u32x4*)(xb + tl * 72 + cg * 8) = pack8(a);
            const bf16_t* wsrc = p.lruT + (size_t)((l * 8 + n) * 4) * 4096;
#pragma unroll
            for (int q = 0; q < 4; ++q) { const int e8 = tid + 512 * q, row = e8 >> 3, c8 = e8 & 7; *(LAS u32x4*)(wt + row * 72 + c8 * 8) = *(const u32x4*)(wsrc + (size_t)e8 * 8); }
        }
        __syncthreads();
        {
            const int jb = wid & 3, tb0 = (wid >> 2) * 2;
            bf16x8 xw[4][2];
#pragma unroll
            for (int m = 0; m < 4; ++m)
#pragma unroll
                for (int ks = 0; ks < 2; ++ks) xw[m][ks] = *(const LAS bf16x8*)(wt + (m * 64 + jb * 16 + fr) * 72 + ks * 32 + fq * 8);
            const int c0 = n * 64 + jb * 16 + 4 * fq;
            float4 bav[2], bxv[2], lsv[2];
#pragma unroll
            for (int d = 0; d < 2; ++d) {
                bav[d] = *(const float4*)(p.lru_ba + (l * 2 + d) * MW + c0); bxv[d] = *(const float4*)(p.lru_bx + (l * 2 + d) * MW + c0);
                lsv[d] = *(const float4*)(p.lsig + (l * 2 + d) * MW + c0);
            }
#pragma unroll
            for (int e = 0; e < 2; ++e) {
                const int tl = (tb0 + e) * 16 + fr, tok = tok0 + tl;
                f32x4 acc[4];
#pragma unroll
                for (int m = 0; m < 4; ++m) acc[m] = (f32x4){0.f, 0.f, 0.f, 0.f};
#pragma unroll
                for (int ks = 0; ks < 2; ++ks) {
                    const bf16x8 y = *(const LAS bf16x8*)(xb + tl * 72 + ks * 32 + fq * 8);
#pragma unroll
                    for (int m = 0; m < 4; ++m) acc[m] = mfma16(xw[m][ks], y, acc[m]);
                }
                const f32x4 xv = *(const LAS f32x4*)(xs + tl * 68 + jb * 16 + 4 * fq);
#pragma unroll
                for (int d = 0; d < 2; ++d) {
                    const float bar_[4] = {bav[d].x, bav[d].y, bav[d].z, bav[d].w}, bxr[4] = {bxv[d].x, bxv[d].y, bxv[d].z, bxv[d].w}, lsr[4] = {lsv[d].x, lsv[d].y, lsv[d].z, lsv[d].w};
                    u32x4 au;
#pragma unroll
                    for (int r = 0; r < 4; ++r) {
                        const float gr = sigmoidf_(acc[d * 2][r] + bar_[r]), gi = sigmoidf_(acc[d * 2 + 1][r] + bxr[r]);
                        const float la = gr * lsr[r];
                        au[r] = pack2(la, xv[r] * gi * __builtin_amdgcn_sqrtf(fmaxf(1.0f - __expf(2.0f * la), 1e-12f)));
                    }
                    *(u32x4*)((unsigned*)p.prep + (size_t)d * TOKW + (size_t)tok * MW + c0) = au;
                }
            }
        }
        __syncthreads();
    }
}

__device__ __forceinline__ int chunk_base(int b, int d, int n) {
    if (n < 4) { const int blk = d ? 3 - n : n; return NLAT + b * TC + blk * 64; }
    const int m = n - 4, blk = d ? 63 - m : m; return b * TL + blk * 64;
}

__device__ __forceinline__ void local_gla(const Params& p, int l, int tz, int chain, int n, LAS unsigned char* lds) {
    const int tid = opaque_tid(), wid = tid >> 6, lane = tid & 63, fr = lane & 15, fq = lane >> 4;
    const int b = chain >> 3, h = (chain >> 1) & 3, d = chain & 1;
    const int base = chunk_base(b, d, n);
    const size_t item = (size_t)tz * NITEM + (size_t)chain * NCHUNK + n;
    LAS bf16_t* qh = (LAS bf16_t*)lds;
    LAS bf16_t* kh = qh + 64 * 136;
    LAS bf16_t* sc = kh + 10 * 16 * 136;
    LAS bf16_t* vT = sc + 64 * 72;
    LAS bf16_t* kT = vT + 128 * 72;
    LAS float* bc = (LAS float*)(kT + 128 * 72);
    const int vcol = tz == 1 ? C_HI : C_RQKV + 1024;
    const int ti = tid >> 3, dg = tid & 7, cA = dg * 8, cB = 64 + dg * 8;
    const int tokI = base + (d ? 63 - ti : ti);
    const bf16_t* pr = p.P + (size_t)tokI * NP;
    float qt[16], kv[16];
    {
        float lfv[16];
        if (tz == 1) {
            float lbv[16];
            {
                const float* lp0 = p.hgrn_lb + (size_t)(0 * 2 + d) * MW + h * 128; const float* lp1 = p.hgrn_lb + (size_t)(1 * 2 + d) * MW + h * 128;
                const float4 a0 = *(const float4*)(lp0 + cA), a1 = *(const float4*)(lp0 + cA + 4), a2 = *(const float4*)(lp0 + cB), a3 = *(const float4*)(lp0 + cB + 4);
                const float4 b0 = *(const float4*)(lp1 + cA), b1 = *(const float4*)(lp1 + cA + 4), b2 = *(const float4*)(lp1 + cB), b3 = *(const float4*)(lp1 + cB + 4);
                const float x0[16] = {a0.x, a0.y, a0.z, a0.w, a1.x, a1.y, a1.z, a1.w, a2.x, a2.y, a2.z, a2.w, a3.x, a3.y, a3.z, a3.w};
                const float x1[16] = {b0.x, b0.y, b0.z, b0.w, b1.x, b1.y, b1.z, b1.w, b2.x, b2.y, b2.z, b2.w, b3.x, b3.y, b3.z, b3.w};
#pragma unroll
                for (int e = 0; e < 16; ++e) lbv[e] = (l == 1) ? fminf(__builtin_amdgcn_rcpf(1.0f + __expf(x0[e] - x1[e])), 1.0f - 1e-4f) : 0.f;
            }
            const u32x4 uqa = *(const u32x4*)(pr + C_HQ + h * 128 + cA), uqb = *(const u32x4*)(pr + C_HQ + h * 128 + cB);
            const u32x4 uza = *(const u32x4*)(pr + C_HF + d * 512 + h * 128 + cA), uzb = *(const u32x4*)(pr + C_HF + d * 512 + h * 128 + cB);
#pragma unroll
            for (int e = 0; e < 16; ++e) {
                const unsigned uq = e < 8 ? uqa[(e & 7) >> 1] : uqb[(e & 7) >> 1], uz = e < 8 ? uza[(e & 7) >> 1] : uzb[(e & 7) >> 1];
                const float qraw = (e & 1) ? bfhi(uq) : bflo(uq), z = (e & 1) ? bfhi(uz) : bflo(uz);
                const float lb = lbv[e];
                const float sg = sigmoidf_(z);
                qt[e] = siluf_(qraw) * 0.08838834764831845f;
                kv[e] = (1.f - lb) * (1.f - sg);
                lfv[e] = __logf(fmaxf(lb + (1.f - lb) * sg, 1e-30f));
            }
        }
        *(LAS f32x4*)(bc + ti * 132 + cA) = (f32x4){lfv[0], lfv[1], lfv[2], lfv[3]}; *(LAS f32x4*)(bc + ti * 132 + cA + 4) = (f32x4){lfv[4], lfv[5], lfv[6], lfv[7]};
        *(LAS f32x4*)(bc + ti * 132 + cB) = (f32x4){lfv[8], lfv[9], lfv[10], lfv[11]}; *(LAS f32x4*)(bc + ti * 132 + cB + 4) = (f32x4){lfv[12], lfv[13], lfv[14], lfv[15]};
        const bf16_t* vp = pr + vcol + h * 128;
        const u32x4 v0 = *(const u32x4*)(vp + cA), v1 = *(const u32x4*)(vp + cB);
#pragma unroll
        for (int e = 0; e < 8; ++e) {
            vT[(cA + e) * 72 + ti] = (bf16_t)((e & 1) ? (v0[e >> 1] >> 16) : (v0[e >> 1] & 0xffffu));
            vT[(cB + e) * 72 + ti] = (bf16_t)((e & 1) ? (v1[e >> 1] >> 16) : (v1[e >> 1] & 0xffffu));
        }
    }
    __syncthreads();
    if (tid < 128) {
        float run = 0.f, lv[64];
#pragma unroll
        for (int i = 0; i < 64; ++i) lv[i] = bc[i * 132 + tid];
#pragma unroll
        for (int i = 0; i < 64; ++i) { run += lv[i]; bc[i * 132 + tid] = run; }
    }
    __syncthreads();
    {
        const int J = ti >> 4;
        float qhat[16];
#pragma unroll
        for (int e = 0; e < 16; ++e) {
            const int ch = e < 8 ? cA + e : cB + e - 8;
            const float bi = bc[ti * 132 + ch], rJ = J ? bc[(16 * J - 1) * 132 + ch] : 0.f, bl = bc[63 * 132 + ch];
            qhat[e] = qt[e] * __expf(bi - rJ); qt[e] = qt[e] * __expf(bi);
            kT[ch * 72 + ti] = (bf16_t)f2bf(kv[e] * __expf(bl - bi));
        }
        *(LAS u32x4*)(qh + ti * 136 + cA) = pack8(qhat); *(LAS u32x4*)(qh + ti * 136 + cB) = pack8(qhat + 8);
#pragma unroll
        for (int I = 0; I < 4; ++I) {
            if (I >= J) {
                float kk[16];
#pragma unroll
                for (int e = 0; e < 16; ++e) {
                    const int ch = e < 8 ? cA + e : cB + e - 8;
                    const float rI = I ? bc[(16 * I - 1) * 132 + ch] : 0.f, bj = bc[ti * 132 + ch];
                    kk[e] = kv[e] * __expf(fminf(rI - bj, 80.f));
                }
                LAS bf16_t* kp = kh + ((I * (I + 1) / 2 + J) * 16 + (ti & 15)) * 136;
                *(LAS u32x4*)(kp + cA) = pack8(kk); *(LAS u32x4*)(kp + cB) = pack8(kk + 8);
            }
        }
        *(LAS u32x4*)(sc + ti * 72 + dg * 8) = (u32x4){0u, 0u, 0u, 0u};
        {
            bf16_t* lqb = p.lq + item * 8192 + (size_t)((ti >> 4) * 8) * 256 + (ti & 15) * 4;
            const u32x4 pa = pack8(qt), pb = pack8(qt + 8);
            u32x2 t0; t0[0] = pa[0]; t0[1] = pa[1]; u32x2 t1; t1[0] = pa[2]; t1[1] = pa[3]; u32x2 t2; t2[0] = pb[0]; t2[1] = pb[1]; u32x2 t3; t3[0] = pb[2]; t3[1] = pb[3];
            *(u32x2*)(lqb + (dg >> 1) * 256 + ((dg & 1) * 2 + 0) * 64) = t0; *(u32x2*)(lqb + (dg >> 1) * 256 + ((dg & 1) * 2 + 1) * 64) = t1;
            *(u32x2*)(lqb + (4 + (dg >> 1)) * 256 + ((dg & 1) * 2 + 0) * 64) = t2; *(u32x2*)(lqb + (4 + (dg >> 1)) * 256 + ((dg & 1) * 2 + 1) * 64) = t3;
        }
    }
    if (tid < 128) p.ld[item * 128 + tid] = __expf(bc[63 * 132 + tid]);
    __syncthreads();
#pragma unroll
    for (int rep2 = 0; rep2 < 2; ++rep2) {
        const int t = wid + 8 * rep2;
        if (t < 10) {
            const int I = t >= 6 ? 3 : t >= 3 ? 2 : t >= 1 ? 1 : 0, J = t - I * (I + 1) / 2;
            f32x4 acc = (f32x4){0.f, 0.f, 0.f, 0.f};
#pragma unroll
            for (int ks = 0; ks < 4; ++ks)
                acc = mfma16(*(const LAS bf16x8*)(kh + (t * 16 + fr) * 136 + ks * 32 + fq * 8), *(const LAS bf16x8*)(qh + (I * 16 + fr) * 136 + ks * 32 + fq * 8), acc);
            const int i = 16 * I + fr, j0 = 16 * J + 4 * fq;
#pragma unroll
            for (int r = 0; r < 4; ++r) if (j0 + r > i) acc[r] = 0.f;
            *(LAS u32x2*)(sc + i * 72 + j0) = pack4(acc);
        }
    }
    __syncthreads();
    {
        bf16x8 xv[2], xk[2];
#pragma unroll
        for (int ks = 0; ks < 2; ++ks) { xv[ks] = *(const LAS bf16x8*)(vT + (wid * 16 + fr) * 72 + ks * 32 + fq * 8); xk[ks] = *(const LAS bf16x8*)(kT + (wid * 16 + fr) * 72 + ks * 32 + fq * 8); }
#pragma unroll
        for (int ib = 0; ib < 4; ++ib) {
            f32x4 acc = (f32x4){0.f, 0.f, 0.f, 0.f};
#pragma unroll
            for (int ks = 0; ks < 2; ++ks) acc = mfma16(xv[ks], *(const LAS bf16x8*)(sc + (ib * 16 + fr) * 72 + ks * 32 + fq * 8), acc);
            *(u32x2*)(p.lo + item * 8192 + ((wid * 4 + ib) * 64 + lane) * 4) = pack4(acc);
        }
#pragma unroll
        for (int dvb = 0; dvb < 8; ++dvb) {
            f32x4 acc = (f32x4){0.f, 0.f, 0.f, 0.f};
#pragma unroll
            for (int ks = 0; ks < 2; ++ks) acc = mfma16(xk[ks], *(const LAS bf16x8*)(vT + (dvb * 16 + fr) * 72 + ks * 32 + fq * 8), acc);
            *(u32x2*)(p.lb + item * 16384 + ((wid * 8 + dvb) * 64 + lane) * 4) = pack4(acc);
        }
    }
    __syncthreads();
}


template <int MODE> __device__ __forceinline__ void local_ret(const Params& p, int l, int chain, int n, LAS unsigned char* lds) {
    const int tid = opaque_tid(), wid = tid >> 6, lane = tid & 63, fr = lane & 15, fq = lane >> 4;
    const int b = chain >> 3, h = (chain >> 1) & 3, d = chain & 1;
    const int base = chunk_base(b, d, n);
    const size_t item = (size_t)2 * NITEM + (size_t)chain * NCHUNK + n;
    LAS bf16_t* ks_ = (LAS bf16_t*)lds;
    LAS bf16_t* qs = ks_ + 64 * 136;
    LAS bf16_t* sc = qs + 64 * 136;
    LAS bf16_t* vT = sc + 64 * 72;
    LAS bf16_t* kT = vT + 128 * 72;
    const int ti = tid >> 3, dg = tid & 7, cA = dg * 8, cB = 64 + dg * 8;
    const int tokI = base + (d ? 63 - ti : ti);
    const bf16_t* pr = p.P + (size_t)tokI * NP + C_RQKV + h * 128;
    const float lng = ret_log_gamma(h);
    {
        const u32x4 q1 = *(const u32x4*)(pr + cA), q2 = *(const u32x4*)(pr + cB), k1 = *(const u32x4*)(pr + 512 + cA), k2 = *(const u32x4*)(pr + 512 + cB);
        const u32x4 v0 = *(const u32x4*)(pr + 1024 + cA), v1 = *(const u32x4*)(pr + 1024 + cB);
        const bool lat = tokI < NLAT;
        const int t = tokI & (TL - 1);
        float qv[16], kv[16];
#pragma unroll
        for (int e = 0; e < 8; ++e) {
            float a1 = (e & 1) ? bfhi(q1[e >> 1]) : bflo(q1[e >> 1]), a2 = (e & 1) ? bfhi(q2[e >> 1]) : bflo(q2[e >> 1]);
            float b1 = (e & 1) ? bfhi(k1[e >> 1]) : bflo(k1[e >> 1]), b2 = (e & 1) ? bfhi(k2[e >> 1]) : bflo(k2[e >> 1]);
            {
                const float2 cst = p.rope[(size_t)t * 64 + cA + e];
                const float cs = lat ? cst.x : 1.0f, sn = lat ? cst.y : 0.0f;
                const float n1 = a1 * cs - a2 * sn, n2 = a1 * sn + a2 * cs, m1 = b1 * cs - b2 * sn, m2 = b1 * sn + b2 * cs;
                a1 = n1; a2 = n2; b1 = m1; b2 = m2;
            }
            qv[e] = a1; qv[8 + e] = a2; kv[e] = b1 * 0.08838834764831845f; kv[8 + e] = b2 * 0.08838834764831845f;
        }
        *(LAS u32x4*)(ks_ + ti * 136 + cA) = pack8(kv); *(LAS u32x4*)(ks_ + ti * 136 + cB) = pack8(kv + 8);
        *(LAS u32x4*)(qs + ti * 136 + cA) = pack8(qv); *(LAS u32x4*)(qs + ti * 136 + cB) = pack8(qv + 8);
        const float gq = __expf((float)(ti + 1) * lng), gk = __expf((float)(63 - ti) * lng);
#pragma unroll
        for (int e = 0; e < 8; ++e) {
            vT[(cA + e) * 72 + ti] = (bf16_t)((e & 1) ? (v0[e >> 1] >> 16) : (v0[e >> 1] & 0xffffu));
            vT[(cB + e) * 72 + ti] = (bf16_t)((e & 1) ? (v1[e >> 1] >> 16) : (v1[e >> 1] & 0xffffu));
            kT[(cA + e) * 72 + ti] = (bf16_t)f2bf(kv[e] * gk); kT[(cB + e) * 72 + ti] = (bf16_t)f2bf(kv[8 + e] * gk);
            qv[e] *= gq; qv[8 + e] *= gq;
        }
        {
            bf16_t* lqb = p.lq + item * 8192 + (size_t)((ti >> 4) * 8) * 256 + (ti & 15) * 4;
            const u32x4 pa = pack8(qv), pb = pack8(qv + 8);
            u32x2 t0; t0[0] = pa[0]; t0[1] = pa[1]; u32x2 t1; t1[0] = pa[2]; t1[1] = pa[3]; u32x2 t2; t2[0] = pb[0]; t2[1] = pb[1]; u32x2 t3; t3[0] = pb[2]; t3[1] = pb[3];
            *(u32x2*)(lqb + (dg >> 1) * 256 + ((dg & 1) * 2 + 0) * 64) = t0; *(u32x2*)(lqb + (dg >> 1) * 256 + ((dg & 1) * 2 + 1) * 64) = t1;
            *(u32x2*)(lqb + (4 + (dg >> 1)) * 256 + ((dg & 1) * 2 + 0) * 64) = t2; *(u32x2*)(lqb + (4 + (dg >> 1)) * 256 + ((dg & 1) * 2 + 1) * 64) = t3;
        }
    }
    if (tid < 128) p.ld[item * 128 + tid] = __expf(64.0f * lng);
    __syncthreads();
#pragma unroll
    for (int e = 0; e < 2; ++e) {
        const int f = wid * 2 + e, ib = f >> 2, jb = f & 3;
        const int i = 16 * ib + fr, j0 = 16 * jb + 4 * fq;
        f32x4 mq = (f32x4){0.f, 0.f, 0.f, 0.f};
        if (jb <= ib) {
#pragma unroll
            for (int ks = 0; ks < 4; ++ks)
                mq = mfma16(*(const LAS bf16x8*)(ks_ + (jb * 16 + fr) * 136 + ks * 32 + fq * 8), *(const LAS bf16x8*)(qs + i * 136 + ks * 32 + fq * 8), mq);
#pragma unroll
            for (int r = 0; r < 4; ++r) { const int j = j0 + r; mq[r] = (j <= i) ? mq[r] * __expf((float)(i - j) * lng) : 0.f; }
        }
        *(LAS u32x2*)(sc + i * 72 + j0) = pack4(mq);
    }
    __syncthreads();
    {
        bf16x8 xv[2], xk[2];
#pragma unroll
        for (int ks = 0; ks < 2; ++ks) { xv[ks] = *(const LAS bf16x8*)(vT + (wid * 16 + fr) * 72 + ks * 32 + fq * 8); xk[ks] = *(const LAS bf16x8*)(kT + (wid * 16 + fr) * 72 + ks * 32 + fq * 8); }
#pragma unroll
        for (int ib = 0; ib < 4; ++ib) {
            f32x4 acc = (f32x4){0.f, 0.f, 0.f, 0.f};
#pragma unroll
            for (int ks = 0; ks < 2; ++ks) acc = mfma16(xv[ks], *(const LAS bf16x8*)(sc + (ib * 16 + fr) * 72 + ks * 32 + fq * 8), acc);
            *(u32x2*)(p.lo + item * 8192 + ((wid * 4 + ib) * 64 + lane) * 4) = pack4(acc);
        }
#pragma unroll
        for (int dvb = 0; dvb < 8; ++dvb) {
            f32x4 acc = (f32x4){0.f, 0.f, 0.f, 0.f};
#pragma unroll
            for (int ks = 0; ks < 2; ++ks) acc = mfma16(xk[ks], *(const LAS bf16x8*)(vT + (dvb * 16 + fr) * 72 + ks * 32 + fq * 8), acc);
            *(u32x2*)(p.lb + item * 16384 + ((wid * 8 + dvb) * 64 + lane) * 4) = pack4(acc);
        }
    }
    __syncthreads();
}

__device__ __forceinline__ void local_gdn(const Params& p, int l, int bh, int seg, int blk, LAS unsigned char* lds) {
    const int tid = opaque_tid(), wid = tid >> 6, lane = tid & 63, fr = lane & 15, fq = lane >> 4;
    const int b = bh >> 2, h = bh & 3;
    const int base = seg ? b * TL + blk * 64 : NLAT + b * TC + blk * 64;
    LAS bf16_t* ks_ = (LAS bf16_t*)lds;
    LAS bf16_t* qs = ks_ + 64 * 136;
    LAS bf16_t* att = qs + 64 * 136;
    LAS bf16_t* wT = att + 64 * 72;
    LAS bf16_t* uT = wT + 128 * 72;
    LAS bf16_t* kT = uT + 128 * 72;
    LAS bf16_t* tT = kT;
    LAS bf16_t* Mneg = kT + 128 * 72;
    LAS float* Md = (LAS float*)(Mneg + 64 * 72);
    LAS float* bcs = (LAS float*)(kT + 128 * 72) + 64 * 68;
    LAS float* bts = bcs + 64;
    LAS float* rse = bts + 64;
    LAS bf16_t* vs = (LAS bf16_t*)(rse + 64);
    LAS bf16_t* Db = (LAS bf16_t*)(vs + 64 * 136);
    LAS float* cw = (LAS float*)(vs + 64 * 136);
    const int ti = tid >> 3, d0 = (tid & 7) * 16;
    const int tokI = base + ti;
    {
        int t, T, sbase; tok_info(tokI, t, T, sbase);
        u32x4 xr[3][4][2];
#pragma unroll
        for (int j = 0; j < 4; ++j) {
            const int tt = t + j - 2;
            const bool ok = (tt >= 0 && tt < T);
            const int ttc = tt < 0 ? 0 : (tt >= T ? T - 1 : tt);
            const bf16_t* xp = p.P + (size_t)(sbase + ttc) * NP + C_GQKV + h * 128 + d0;
#pragma unroll
            for (int part = 0; part < 3; ++part) {
                const u32x4 a0 = *(const u32x4*)(xp + part * 512), a1 = *(const u32x4*)(xp + part * 512 + 8);
#pragma unroll
                for (int q = 0; q < 4; ++q) { xr[part][j][0][q] = ok ? a0[q] : 0u; xr[part][j][1][q] = ok ? a1[q] : 0u; }
            }
        }
        if (tid < 384) {
            const int row = tid >> 5, c4 = (tid & 31) * 4, part = row >> 2, j = row & 3;
            *(LAS f32x4*)(cw + row * 128 + c4) = *(const f32x4*)(p.gdn_conv_w + (size_t)(l * 4 + j) * 1536 + part * 512 + h * 128 + c4);
        }
        __syncthreads();
#pragma unroll
        for (int part = 0; part < 3; ++part) {
            float a[16];
#pragma unroll
            for (int e = 0; e < 16; ++e) a[e] = 0.f;
#pragma unroll
            for (int j = 0; j < 4; ++j) {
                const u32x4 x0 = xr[part][j][0], x1 = xr[part][j][1];
                const LAS float* wp = cw + (part * 4 + j) * 128 + d0;
#pragma unroll
                for (int q = 0; q < 4; ++q) {
                    const f32x4 w0 = *(const LAS f32x4*)(wp + q * 4);
                    const unsigned ua = q < 2 ? x0[2 * q] : x1[2 * q - 4], ub = q < 2 ? x0[2 * q + 1] : x1[2 * q - 3];
                    a[q * 4] += w0[0] * bflo(ua); a[q * 4 + 1] += w0[1] * bfhi(ua); a[q * 4 + 2] += w0[2] * bflo(ub); a[q * 4 + 3] += w0[3] * bfhi(ub);
                }
            }
            float ss = 0.f;
#pragma unroll
            for (int e = 0; e < 16; ++e) { a[e] = siluf_(a[e]); ss += a[e] * a[e]; }
            if (part < 2) {
                ss += shx(ss, 1, lane); ss += shx(ss, 2, lane); ss += shx(ss, 4, lane);
                const float scl = rsqrtf(ss + 1e-6f) * (part == 0 ? 0.08838834764831845f : 1.0f);
#pragma unroll
                for (int e = 0; e < 16; ++e) a[e] *= scl;
            }
            LAS bf16_t* dstt = (part == 0 ? qs : part == 1 ? ks_ : vs) + ti * 136 + d0;
            *(LAS u32x4*)dstt = pack8(a); *(LAS u32x4*)(dstt + 8) = pack8(a + 8);
        }
    }
#pragma unroll 1
  for (int d = 0; d < 2; ++d) {
    const int n = seg ? 4 + (d ? 63 - blk : blk) : (d ? 3 - blk : blk);
    const size_t item = (size_t)(bh * 2 + d) * NCHUNK + n;
#define RR(x) (d ? 63 - (x) : (x))
    const int tid = opaque_tid(), wid = tid >> 6, lane = tid & 63, fr = lane & 15, fq = lane >> 4, ti = tid >> 3, d0 = (tid & 7) * 16;
    if (wid == 0) {
        const int tok = base + RR(lane);
        const float av = bf2f(p.P[(size_t)tok * NP + C_GA + d * 4 + h]);
        float v = -__expf(p.gdn_a_log[l * 8 + d * 4 + h]) * softplusf_(av + p.gdn_dt_bias[l * 8 + d * 4 + h]);
#pragma unroll
        for (int off = 1; off < 64; off <<= 1) { const float t = shup(v, off, lane); if (lane >= off) v += t; }
        const float btv = sigmoidf_(bf2f(p.P[(size_t)tok * NP + C_GB + d * 4 + h]));
        bcs[lane] = v; bts[lane] = btv; rse[lane] = btv * __expf(v);
    }
    __syncthreads();
#pragma unroll
    for (int e = 0; e < 2; ++e) {
        const int f = wid * 2 + e, ib = f >> 2, jb = f & 3;
        const int i = 16 * ib + fr, j0 = 16 * jb + 4 * fq;
        f32x4 mk = (f32x4){0.f, 0.f, 0.f, 0.f}, mq = (f32x4){0.f, 0.f, 0.f, 0.f};
        if (jb <= ib) {
#pragma unroll
            for (int ks = 0; ks < 4; ++ks) {
                const bf16x8 xk = *(const LAS bf16x8*)(ks_ + RR(jb * 16 + fr) * 136 + ks * 32 + fq * 8);
                mk = mfma16(xk, *(const LAS bf16x8*)(ks_ + RR(ib * 16 + fr) * 136 + ks * 32 + fq * 8), mk);
                mq = mfma16(xk, *(const LAS bf16x8*)(qs + RR(ib * 16 + fr) * 136 + ks * 32 + fq * 8), mq);
            }
            const float bi = bcs[i], bti = bts[i];
#pragma unroll
            for (int r = 0; r < 4; ++r) {
                const int j = j0 + r;
                const float dec = __expf(j <= i ? bi - bcs[j] : 0.f);
                mk[r] = (j < i) ? bti * mk[r] * dec : 0.f;
                mq[r] = (j <= i) ? mq[r] * dec : 0.f;
            }
        }
        {
            u32x2 mn; mn[0] = 0u; mn[1] = 0u;
            if (jb < ib) mn = pack4((f32x4){-mk[0], -mk[1], -mk[2], -mk[3]});
            *(LAS u32x2*)(Mneg + i * 72 + j0) = mn;
            if (jb == ib) *(LAS f32x4*)(Md + (ib * 16 + fr) * 20 + 4 * fq) = mk;
        }
        *(LAS u32x2*)(att + i * 72 + j0) = pack4(mq);
        if (e == 0) {
            const int zr = tid >> 1, zh = tid & 1;
            LAS bf16_t* zx = (zr < 128 ? uT + zr * 72 : wT + (zr - 128) * 72) + zh * 32;
#pragma unroll
            for (int q = 0; q < 4; ++q) *(LAS u32x4*)(zx + q * 8) = (u32x4){0u, 0u, 0u, 0u};
            *(LAS u32x4*)(tT + zr * 32 + 16 + zh * 8) = (u32x4){0u, 0u, 0u, 0u};
        }
    }
    __syncthreads();
    if (wid == 0) {
        const int R = lane >> 4, cc = lane & 15;
        float y[16];
#pragma unroll
        for (int i = 0; i < 16; ++i) {
            float acc = (i == cc) ? 1.0f : 0.0f;
#pragma unroll
            for (int j4 = 0; j4 < (i + 3) / 4; ++j4) {
                const f32x4 m = *(const LAS f32x4*)(Md + (R * 16 + i) * 20 + j4 * 4);
#pragma unroll
                for (int q = 0; q < 4; ++q) if (j4 * 4 + q < i) acc -= m[q] * y[j4 * 4 + q];
            }
            y[i] = acc;
            Db[(R * 16 + i) * 40 + cc] = (bf16_t)f2bf(acc);
        }
        *(LAS u32x4*)(Db + lane * 40 + 16) = (u32x4){0u, 0u, 0u, 0u}; *(LAS u32x4*)(Db + lane * 40 + 24) = (u32x4){0u, 0u, 0u, 0u};
    }
    __syncthreads();
#pragma unroll
    for (int R = 0; R < 4; ++R) {
        f32x4 tacc[2];
#pragma unroll
        for (int e = 0; e < 2; ++e) {
            const int cb = wid * 2 + e;
            const int i = 16 * R + fr;
            const u32x2 rv = *(const LAS u32x2*)((cb < 8 ? vs + cb * 16 : ks_ + (cb - 8) * 16) + RR(i) * 136 + 4 * fq);
            const float sc = cb < 8 ? bts[i] : -rse[i];
            f32x4 acc = (f32x4){bflo(rv[0]) * sc, bfhi(rv[0]) * sc, bflo(rv[1]) * sc, bfhi(rv[1]) * sc};
            if (R > 0) {
                const LAS bf16_t* xt = (cb < 8 ? uT + cb * 16 * 72 : wT + (cb - 8) * 16 * 72) + fr * 72 + fq * 8;
#pragma unroll
                for (int ks = 0; ks < (R + 1) / 2; ++ks) acc = mfma16(*(const LAS bf16x8*)(xt + ks * 32), *(const LAS bf16x8*)(Mneg + i * 72 + ks * 32 + fq * 8), acc);
            }
            tacc[e] = acc;
            LAS bf16_t* tp = tT + (cb * 16 + 4 * fq) * 32 + fr;
            tp[0] = (bf16_t)f2bf(acc[0]); tp[32] = (bf16_t)f2bf(acc[1]); tp[64] = (bf16_t)f2bf(acc[2]); tp[96] = (bf16_t)f2bf(acc[3]);
        }
        __syncthreads();
#pragma unroll
        for (int e = 0; e < 2; ++e) {
            const int cb = wid * 2 + e;
            f32x4 acc = (f32x4){0.f, 0.f, 0.f, 0.f};
            acc = mfma16(*(const LAS bf16x8*)(tT + (cb * 16 + fr) * 32 + fq * 8), *(const LAS bf16x8*)(Db + (R * 16 + fr) * 40 + fq * 8), acc);
            LAS bf16_t* xp = (cb < 8 ? uT + cb * 16 * 72 : wT + (cb - 8) * 16 * 72) + (4 * fq) * 72 + 16 * R + fr;
            xp[0] = (bf16_t)f2bf(acc[0]); xp[72] = (bf16_t)f2bf(acc[1]); xp[144] = (bf16_t)f2bf(acc[2]); xp[216] = (bf16_t)f2bf(acc[3]);
        }
        __syncthreads();
    }
    {
        const int pi = RR(ti);
        const float sc_ = __expf(bcs[63] - bcs[pi]);
#pragma unroll
        for (int e = 0; e < 16; ++e) kT[(d0 + e) * 72 + pi] = (bf16_t)f2bf(bf2f(ks_[ti * 136 + d0 + e]) * sc_);
    }
    if (tid < 128) p.ld[item * 128 + tid] = __expf(bcs[63]);
    __syncthreads();
    {
        const int tid = opaque_tid(), wid = tid >> 6, lane = tid & 63, fr = lane & 15, fq = lane >> 4;
        bf16x8 xw[2], xu[2], xk[2];
#pragma unroll
        for (int ks = 0; ks < 2; ++ks) {
            xw[ks] = *(const LAS bf16x8*)(wT + (wid * 16 + fr) * 72 + ks * 32 + fq * 8);
            xu[ks] = *(const LAS bf16x8*)(uT + (wid * 16 + fr) * 72 + ks * 32 + fq * 8);
            xk[ks] = *(const LAS bf16x8*)(kT + (wid * 16 + fr) * 72 + ks * 32 + fq * 8);
        }
#pragma unroll
        for (int ib = 0; ib < 4; ++ib) {
            const int i = ib * 16 + fr;
            const u32x2 qr = *(const LAS u32x2*)(qs + RR(i) * 136 + wid * 16 + 4 * fq);
            const float eb = __expf(bcs[i]);
            f32x4 aq = (f32x4){bflo(qr[0]) * eb, bfhi(qr[0]) * eb, bflo(qr[1]) * eb, bfhi(qr[1]) * eb};
            f32x4 ao = (f32x4){0.f, 0.f, 0.f, 0.f};
#pragma unroll
            for (int ks = 0; ks < 2; ++ks) {
                const bf16x8 ya = *(const LAS bf16x8*)(att + i * 72 + ks * 32 + fq * 8);
                aq = mfma16(xw[ks], ya, aq); ao = mfma16(xu[ks], ya, ao);
            }
            *(u32x2*)(p.lq + item * 8192 + ((ib * 8 + wid) * 64 + lane) * 4) = pack4(aq);
            *(u32x2*)(p.lo + item * 8192 + ((wid * 4 + ib) * 64 + lane) * 4) = pack4(ao);
        }
#pragma unroll
        for (int db = 0; db < 8; ++db) {
            f32x4 aa = (f32x4){0.f, 0.f, 0.f, 0.f}, ab = (f32x4){0.f, 0.f, 0.f, 0.f};
#pragma unroll
            for (int ks = 0; ks < 2; ++ks) {
                aa = mfma16(xw[ks], *(const LAS bf16x8*)(kT + (db * 16 + fr) * 72 + ks * 32 + fq * 8), aa);
                ab = mfma16(xk[ks], *(const LAS bf16x8*)(uT + (db * 16 + fr) * 72 + ks * 32 + fq * 8), ab);
            }
            *(u32x2*)(p.la + item * 16384 + ((db * 8 + wid) * 64 + lane) * 4) = pack4(aa);
            *(u32x2*)(p.lb + item * 16384 + ((wid * 8 + db) * 64 + lane) * 4) = pack4(ab);
        }
    }
    __syncthreads();
  }
#undef RR
}

__device__ __forceinline__ void ph_local(const Params& p, int l, LAS unsigned char* lds) {
    constexpr int NG = NITEM / 2;
    for (int it = blockIdx.x; it < NG + 2 * NITEM; it += gridDim.x) {
        if (it < NG) { const int bh = it / NCHUNK, c = it % NCHUNK; local_gdn(p, l, bh, c >= 4, c >= 4 ? c - 4 : c, lds); }
        else if (it < NG + NITEM) { const int idx = it - NG; local_gla(p, l, 1, idx / NCHUNK, idx % NCHUNK, lds); }
        else { const int idx = it - NG - NITEM; local_ret<0>(p, l, idx / NCHUNK, idx % NCHUNK, lds); }
    }
}

__device__ __forceinline__ void seq_matrix(const Params& p, int tz, int chain, int half, LAS unsigned char* lds) {
    const int tid = opaque_tid(), wid = tid >> 6, lane = tid & 63, fr = lane & 15, fq = lane >> 4;
    const int b = chain >> 3, h = (chain >> 1) & 3, d = chain & 1;
    LAS bf16_t* ST = (LAS bf16_t*)lds;
    bf16_t* Op = p.O + (size_t)((tz == 0 ? 0 : tz == 1 ? 1 : 3) * 2 + d) * TOKW;
    f32x4 S[4];
#pragma unroll
    for (int q = 0; q < 4; ++q) S[q] = (f32x4){0.f, 0.f, 0.f, 0.f};
    const int ib = wid >> 1, dv2 = (wid & 1) * 2;
    struct Ops { u32x2 yq[8], xa[8], oin[2], bin[4]; f32x4 dec; };
    auto load_ops = [&](int n, Ops& o) {
        const size_t item = (size_t)tz * NITEM + (size_t)chain * NCHUNK + n;
        const bf16_t* lqp = p.lq + item * 8192 + (size_t)(ib * 8) * 256 + lane * 4;
#pragma unroll
        for (int q = 0; q < 8; ++q) o.yq[q] = *(const u32x2*)(lqp + q * 256);
        if (tz == 0) {
            const bf16_t* lap = p.la + ((size_t)chain * NCHUNK + n) * 16384 + (size_t)(wid * 8) * 256 + lane * 4;
#pragma unroll
            for (int q = 0; q < 8; ++q) o.xa[q] = *(const u32x2*)(lap + q * 256);
        }
#pragma unroll
        for (int e2 = 0; e2 < 2; ++e2)
            o.oin[e2] = *(const u32x2*)(p.lo + item * 8192 + (((half * 4 + dv2 + (fq >> 1)) * 4 + ib) * 64 + fr + 16 * (2 * (fq & 1) + e2)) * 4);
#pragma unroll
        for (int q = 0; q < 4; ++q) o.bin[q] = *(const u32x2*)(p.lb + item * 16384 + ((wid * 8 + half * 4 + q) * 64 + lane) * 4);
        o.dec = *(const f32x4*)(p.ld + item * 128 + wid * 16 + 4 * fq);
    };
    Ops s0, s1; load_ops(0, s0);
    auto step = [&](int n, Ops& cur, Ops& fill) {
        load_ops(n + 1 < NCHUNK ? n + 1 : n, fill);
        LAS bf16_t* st = ST + (n & 1) * 64 * 136;
#pragma unroll
        for (int q = 0; q < 4; ++q) *(LAS u32x2*)(st + (q * 16 + fr) * 136 + 32 * (wid >> 1) + 8 * fq + 4 * (wid & 1)) = pack4(S[q]);
        __syncthreads();
        const int base = chunk_base(b, d, n);
        const int tok = base + (d ? 63 - (ib * 16 + fr) : ib * 16 + fr);
        {
            bf16x8 xo[2][4];
#pragma unroll
            for (int e2 = 0; e2 < 2; ++e2) {
                const int prow = dv2 * 16 + 8 * (fr >> 2) + 4 * e2 + (fr & 3);
#pragma unroll
                for (int ks = 0; ks < 4; ++ks) xo[e2][ks] = *(const LAS bf16x8*)(st + prow * 136 + ks * 32 + fq * 8);
            }
            asm volatile("s_waitcnt lgkmcnt(0)" ::: "memory");
            f32x4 ao[2];
#pragma unroll
            for (int e2 = 0; e2 < 2; ++e2) {
                f32x4 acc = (f32x4){bflo(cur.oin[e2][0]), bfhi(cur.oin[e2][0]), bflo(cur.oin[e2][1]), bfhi(cur.oin[e2][1])};
#pragma unroll
                for (int ks = 0; ks < 4; ++ks) {
                    u32x4 t; t[0] = cur.yq[2 * ks][0]; t[1] = cur.yq[2 * ks][1]; t[2] = cur.yq[2 * ks + 1][0]; t[3] = cur.yq[2 * ks + 1][1];
                    acc = mfma16(xo[e2][ks], __builtin_bit_cast(bf16x8, t), acc);
                }
                ao[e2] = acc;
            }
            bf16_t* op = Op + (size_t)tok * MW + h * 128 + half * 64 + dv2 * 16 + 8 * fq;
            { u32x4 w; w[0] = pack2(ao[0][0], ao[0][1]); w[1] = pack2(ao[0][2], ao[0][3]); w[2] = pack2(ao[1][0], ao[1][1]); w[3] = pack2(ao[1][2], ao[1][3]); *(u32x4*)op = w; }
#pragma unroll
            for (int qh = 0; qh < 2; ++qh) {
                bf16x8 xs[2][4];
                if (tz == 0) {
#pragma unroll
                    for (int q2 = 0; q2 < 2; ++q2)
#pragma unroll
                        for (int ks = 0; ks < 4; ++ks) xs[q2][ks] = *(const LAS bf16x8*)(st + ((qh * 2 + q2) * 16 + fr) * 136 + ks * 32 + fq * 8);
                    asm volatile("s_waitcnt lgkmcnt(0)" ::: "memory");
                }
#pragma unroll
                for (int q2 = 0; q2 < 2; ++q2) {
                    const int q = qh * 2 + q2;
                    f32x4 acc = (f32x4){cur.dec[0] * S[q][0] + bflo(cur.bin[q][0]), cur.dec[1] * S[q][1] + bfhi(cur.bin[q][0]), cur.dec[2] * S[q][2] + bflo(cur.bin[q][1]), cur.dec[3] * S[q][3] + bfhi(cur.bin[q][1])};
                    if (tz == 0) {
#pragma unroll
                        for (int ks = 0; ks < 4; ++ks) {
                            u32x4 t; t[0] = cur.xa[2 * ks][0]; t[1] = cur.xa[2 * ks][1]; t[2] = cur.xa[2 * ks + 1][0]; t[3] = cur.xa[2 * ks + 1][1];
                            acc = mfma16(__builtin_bit_cast(bf16x8, t), xs[q2][ks], acc);
                        }
                    }
                    S[q] = acc;
                }
            }
        }
    };
    for (int n = 0; n < NCHUNK; n += 2) {
        step(n, s0, s1);
        step(n + 1, s1, s0);
    }
    __syncthreads();
}

__device__ __forceinline__ void seq_lru(const Params& p, int b, int d, int cg, LAS unsigned char* lds) {
    const int tid = opaque_tid(), seg = tid >> 6, ch = cg * 64 + (tid & 63);
    LAS float* sP = (LAS float*)lds;
    LAS float* sL = sP + 512;
    const unsigned* AU = (const unsigned*)p.prep + (size_t)d * TOKW + ch;
    bf16_t* Op = p.O + (size_t)(2 * 2 + d) * TOKW + ch;
    constexpr int SEG = (TC + TL) / 8;
    auto tok_of = [&](int pos) { return pos < TC ? NLAT + b * TC + (d ? TC - 1 - pos : pos) : b * TL + (d ? TL - 1 - (pos - TC) : pos - TC); };
    float P = 1.f, L = 0.f;
    for (int i0 = 0; i0 < SEG; i0 += 32) {
        unsigned wv[32];
#pragma unroll
        for (int q = 0; q < 32; ++q) wv[q] = AU[(size_t)tok_of(seg * SEG + i0 + q) * MW];
#pragma unroll
        for (int q = 0; q < 32; ++q) { const float a = __expf(bflo(wv[q])); L = a * L + bfhi(wv[q]); P *= a; }
    }
    sP[tid] = P; sL[tid] = L;
    __syncthreads();
    float hst = 0.f;
    for (int s = 0; s < seg; ++s) hst = sP[s * 64 + (tid & 63)] * hst + sL[s * 64 + (tid & 63)];
    for (int i0 = 0; i0 < SEG; i0 += 32) {
        unsigned wv[32];
#pragma unroll
        for (int q = 0; q < 32; ++q) wv[q] = AU[(size_t)tok_of(seg * SEG + i0 + q) * MW];
#pragma unroll
        for (int q = 0; q < 32; ++q) { hst = __expf(bflo(wv[q])) * hst + bfhi(wv[q]); Op[(size_t)tok_of(seg * SEG + i0 + q) * MW] = (bf16_t)f2bf(hst); }
    }
    __syncthreads();
}

__device__ __forceinline__ void ph_seq(const Params& p, int l, LAS unsigned char* lds) {
    for (int it = blockIdx.x; it < 256; it += gridDim.x) {
        if (it < 192) { const int tz = it >> 6, r = it & 63; seq_matrix(p, tz, (r & 7) | ((r >> 4) << 3), (r >> 3) & 1, lds); }
        else { const int r = it - 192; seq_lru(p, r >> 4, (r >> 3) & 1, r & 7, lds); }
    }
    if (l == 0) cvt_fill(p, lds, 0, CW_SEQ0A, CW_G2 - CW_SEQ0A, CW_SEQ0B, CW_G1B - CW_SEQ0B); else cvt_fill(p, lds, 1, CW_SEQ1, CVT_G_ALL - CW_SEQ1, 0, 0);
}

__device__ __forceinline__ void ph_merge(const Params& p, int l, int M) {
    const int tid = opaque_tid(), wid = tid >> 6, lane = tid & 63;
    const bf16_t* Ob = opaque_sptr(p.O); const bf16_t* Pb = opaque_sptr(p.P); bf16_t* Yb = opaque_sptr(p.Y);
    float2 gn[3];
#pragma unroll
    for (int m = 0; m < 3; ++m) gn[m] = *(const float2*)((m == 0 ? p.gdn_norm_g : m == 1 ? p.hgrn_norm_g : p.ret_norm_g) + l * 128 + lane * 2);
    for (int tok = blockIdx.x * NWAVES + wid; tok < M; tok += gridDim.x * NWAVES) {
        unsigned o0[16], o1[16], gz[16];
#pragma unroll
        for (int r = 0; r < 16; ++r) {
            const int m = r >> 2, head = r & 3, cidx = head * 128 + lane * 2;
            const size_t o = (size_t)tok * MW + cidx;
            o0[r] = *(const unsigned*)(Ob + (size_t)(m * 2) * TOKW + o); o1[r] = *(const unsigned*)(Ob + (size_t)(m * 2 + 1) * TOKW + o);
            const int zc = m == 0 ? C_GZ : m == 1 ? C_HG : m == 2 ? C_LY : C_RG;
            gz[r] = *(const unsigned*)(Pb + (size_t)tok * NP + zc + cidx);
        }
        float a0[16], a1[16], ss[16];
#pragma unroll
        for (int r = 0; r < 16; ++r) { a0[r] = bflo(o0[r]) + bflo(o1[r]); a1[r] = bfhi(o0[r]) + bfhi(o1[r]); ss[r] = a0[r] * a0[r] + a1[r] * a1[r]; }
#pragma unroll
        for (int msk = 32; msk >= 1; msk >>= 1)
#pragma unroll
            for (int r = 0; r < 16; ++r) if ((r >> 2) != 2) ss[r] += shx(ss[r], msk, lane);
#pragma unroll
        for (int r = 0; r < 16; ++r) {
            const int m = r >> 2, head = r & 3, cidx = head * 128 + lane * 2;
            float y0, y1; int nbr;
            if (m == 2) { y0 = a0[r] * gelu_tanhf_(bflo(gz[r])); y1 = a1[r] * gelu_tanhf_(bfhi(gz[r])); nbr = 2; }
            else {
                const float rinv = rsqrtf(ss[r] * (1.0f / 128.0f) + 1e-6f);
                const float2 g = gn[m == 3 ? 2 : m];
                y0 = a0[r] * rinv * g.x * siluf_(bflo(gz[r])); y1 = a1[r] * rinv * g.y * siluf_(bfhi(gz[r])); nbr = m == 3 ? 3 : m;
            }
            *(unsigned*)(Yb + (size_t)nbr * TOKW + (size_t)tok * MW + cidx) = pack2(y0, y1);
        }
    }
}

struct G2Sched {
    const bf16_t* Y; const bf16_t* Wb; int ntiles, G, c;
    static constexpr bool HAS_BIAS = false, gather = false;
    __device__ __forceinline__ bool next(int i, g8::Unit& u) const {
        const int r = i >> 2, tile = (r == 0 && G == 256) ? (c & 7) * 32 + (c >> 3) : r * G + c; if (tile >= ntiles) return false;
        u.pm = tile >> 2; u.pn = tile & 3; u.e = i & 3; return true;
    }
    __device__ __forceinline__ const char* a_base(const g8::Unit& u) const { return (const char*)(Y + (size_t)u.e * TOKW + (size_t)u.pm * 256 * MW); }
    __device__ __forceinline__ const char* b_base(const g8::Unit& u) const { return (const char*)(Wb + (size_t)u.e * D * MW + (size_t)u.pn * 256 * MW); }
    __device__ __forceinline__ const int* row_addr(const g8::Unit&, int) const { return nullptr; }
    __device__ __forceinline__ int rows_valid(const g8::Unit&) const { return 256; }
    __device__ __forceinline__ const float* bias_src(const g8::Unit&, int) const { return nullptr; }
};
struct EpiMix {
    const bf16_t* gate; bf16_t* O;
    __device__ __forceinline__ bool keep(const g8::Unit& u) const { return u.e < 3; }
    __device__ __forceinline__ void operator()(f32x4 (&acc)[2][2][4][2], const g8::Unit& u, int wr, int wc, int fr, int fq, const LAS float*) const {
        const int row0 = u.pm * 256 + wr * 64 + fr, col0 = u.pn * 256 + wc * 32 + 8 * fq;
        const bool lastseg = u.e == 3;
        const bf16_t* gc = gate + ((((size_t)u.pm * 16 + u.e * 4 + u.pn) * 8 + (wr * 4 + wc)) * 16) * 512 + (fq * 16 + fr) * 8;
#pragma unroll
        for (int ah = 0; ah < 2; ++ah) {
            u32x4 c[8];
#pragma unroll
            for (int q = 0; q < 8; ++q) c[q] = *(const u32x4*)(gc + (ah * 8 + q) * 512);
#pragma unroll
            for (int q = 0; q < 8; ++q) {
                const int m = q >> 1, bj = q & 1;
#pragma unroll
                for (int w = 0; w < 4; ++w) { acc[ah][bj][m][w >> 1][(w & 1) * 2] *= bflo(c[q][w]); acc[ah][bj][m][w >> 1][(w & 1) * 2 + 1] *= bfhi(c[q][w]); }
            }
        }
        if (lastseg) {
#pragma unroll
            for (int ai = 0; ai < 2; ++ai)
#pragma unroll
                for (int m = 0; m < 4; ++m)
#pragma unroll
                    for (int bj = 0; bj < 2; ++bj) {
                        u32x4 w; w[0] = pack2(acc[ai][bj][m][0][0], acc[ai][bj][m][0][1]); w[1] = pack2(acc[ai][bj][m][0][2], acc[ai][bj][m][0][3]);
                        w[2] = pack2(acc[ai][bj][m][1][0], acc[ai][bj][m][1][1]); w[3] = pack2(acc[ai][bj][m][1][2], acc[ai][bj][m][1][3]);
                        *(u32x4*)(O + (size_t)(row0 + ai * 128 + m * 16) * D + col0 + bj * 128) = w;
                    }
        }
    }
};
__device__ __forceinline__ void ph_g2(const Params& p, int l, int M, LAS unsigned char* lds) {
    G2Sched S; S.Y = p.Y; S.Wb = p.wbT + (size_t)l * 4 * D * MW; S.ntiles = (M / 256) * 4; S.G = gridDim.x; S.c = blockIdx.x;
    EpiMix E; E.gate = p.gate; E.O = p.mix;
    g8::gemm_phase(lds, MW, S, E);
    if (l == 0 && (int)blockIdx.x >= (NTOK / 256) * 4 - 256) cvt_fill(p, lds, 4, CW_G2, CW_G3 - CW_G2, 0, 0);
}

struct EpiY {
    bf16_t* O;
    __device__ __forceinline__ bool keep(const g8::Unit&) const { return false; }
    __device__ __forceinline__ void operator()(const f32x4 (&acc)[2][2][4][2], const g8::Unit& u, int wr, int wc, int fr, int fq, const LAS float*) const {
        const int row0 = u.pm * 256 + wr * 64 + fr, col0 = u.pn * 256 + wc * 32 + 8 * fq;
#pragma unroll
        for (int ai = 0; ai < 2; ++ai)
#pragma unroll
            for (int m = 0; m < 4; ++m)
#pragma unroll
                for (int bj = 0; bj < 2; ++bj) {
                    u32x4 w; w[0] = pack2(acc[ai][bj][m][0][0], acc[ai][bj][m][0][1]); w[1] = pack2(acc[ai][bj][m][0][2], acc[ai][bj][m][0][3]);
                    w[2] = pack2(acc[ai][bj][m][1][0], acc[ai][bj][m][1][1]); w[3] = pack2(acc[ai][bj][m][1][2], acc[ai][bj][m][1][3]);
                    *(u32x4*)(O + (size_t)(row0 + ai * 128 + m * 16) * D + col0 + bj * 128) = w;
                }
    }
};
__device__ __forceinline__ void ph_g3(const Params& p, int l, int M, LAS unsigned char* lds) {
    g8::PlainSched S; S.init(p.mix, p.woutT + (size_t)l * D * D, M, D, D);
    EpiY E; E.O = p.Y;
    g8::gemm_phase(lds, D, S, E);
    if (l == 0 && (int)blockIdx.x >= (NTOK / 256) * 4 - 256) cvt_fill(p, lds, 5, CW_G3, CW_SEQ0B - CW_G3, 0, 0);
}

template <bool DRY = false> __device__ __forceinline__ void ph_route(const Params& p, int l, int M, LAS unsigned char* lds) {
    int* const r_cnt = DRY ? p.cnt + 64 : p.cnt; int* const r_list = DRY ? (int*)p.act : p.list; int* const r_ts = DRY ? (int*)p.yp : p.tokslot; float* const r_tw = DRY ? (float*)p.yp + (size_t)NTOK * 4 : p.topw;
    LAS float* fs = (LAS float*)lds;
    LAS float* lg = fs + 32 * 1028;
    LAS int* lcnt = (LAS int*)(lg + 32 * 36);
    LAS int* lbase = lcnt + 32;
    const int tid = opaque_tid(), wid = tid >> 6, lane = tid & 63;
    const float* rw = p.router_w + (size_t)l * D * NE;
    for (int it = blockIdx.x; it < M / 32; it += gridDim.x) {
        const int tok0 = it * 32;
        {
            float4 v[4][4]; float ss[4];
            const float* mb0 = p.mod + (size_t)(l * 5 + tok_modrow(tok0)) * (NMOD * D);
            u32x2 yv[4][4]; float4 g1v[4];
#pragma unroll
            for (int i = 0; i < 4; ++i) g1v[i] = *(const float4*)(mb0 + 2 * D + i * 256 + lane * 4);
#pragma unroll
            for (int q = 0; q < 4; ++q) {
                const size_t ro = (size_t)(tok0 + wid * 4 + q) * D;
#pragma unroll
                for (int i = 0; i < 4; ++i) { v[q][i] = *(const float4*)(p.xl + ro + i * 256 + lane * 4); yv[q][i] = *(const u32x2*)(p.Y + ro + i * 256 + lane * 4); }
            }
#pragma unroll
            for (int q = 0; q < 4; ++q)
#pragma unroll
                for (int i = 0; i < 4; ++i) {
                    v[q][i].x += g1v[i].x * bflo(yv[q][i][0]); v[q][i].y += g1v[i].y * bfhi(yv[q][i][0]); v[q][i].z += g1v[i].z * bflo(yv[q][i][1]); v[q][i].w += g1v[i].w * bfhi(yv[q][i][1]);
                    if (!DRY) *(float4*)(p.xl + (size_t)(tok0 + wid * 4 + q) * D + i * 256 + lane * 4) = v[q][i];
                }
#pragma unroll
            for (int q = 0; q < 4; ++q) {
                float s = 0.f;
#pragma unroll
                for (int i = 0; i < 4; ++i) s += v[q][i].x * v[q][i].x + v[q][i].y * v[q][i].y + v[q][i].z * v[q][i].z + v[q][i].w * v[q][i].w;
                ss[q] = s;
            }
#pragma unroll
            for (int m = 32; m >= 1; m >>= 1)
#pragma unroll
                for (int q = 0; q < 4; ++q) ss[q] += shx(ss[q], m, lane);
            const float* mb = mb0;
#pragma unroll
            for (int i = 0; i < 4; ++i) {
                const int cidx = i * 256 + lane * 4;
                const float4 gv = *(const float4*)(p.norm2_g + l * D + cidx), sv = *(const float4*)(mb + 4 * D + cidx), hv = *(const float4*)(mb + 3 * D + cidx);
#pragma unroll
                for (int q = 0; q < 4; ++q) {
                    const int tl = wid * 4 + q, tok = tok0 + tl;
                    const float rinv = rsqrtf(ss[q] * (1.0f / D) + 1e-6f);
                    const float h0 = v[q][i].x * rinv * gv.x * (1.f + sv.x) + hv.x, h1 = v[q][i].y * rinv * gv.y * (1.f + sv.y) + hv.y;
                    const float h2 = v[q][i].z * rinv * gv.z * (1.f + sv.z) + hv.z, h3 = v[q][i].w * rinv * gv.w * (1.f + sv.w) + hv.w;
                    u32x2 o; o[0] = pack2(h0, h1); o[1] = pack2(h2, h3);
                    *(u32x2*)(p.F + (size_t)tok * D + cidx) = o;
                    *(LAS f32x4*)(fs + tl * 1028 + cidx) = (f32x4){h0, h1, h2, h3};
                }
            }
        }
        __syncthreads();
        {
            typedef float f32x16 __attribute__((ext_vector_type(16)));
            f32x16 acc;
#pragma unroll
            for (int r = 0; r < 16; ++r) acc[r] = 0.f;
            const int tk = lane & 31, hh = lane >> 5;
            const LAS float* ap = fs + tk * 1028 + wid * 128 + 4 * hh;
            const float* bp = rw + (size_t)(wid * 128 + 4 * hh) * NE + tk;
#pragma unroll 4
            for (int kk = 0; kk < 16; ++kk) {
                const f32x4 a4 = *(const LAS f32x4*)(ap + kk * 8);
                const float b0 = bp[(kk * 8 + 0) * NE], b1 = bp[(kk * 8 + 1) * NE], b2 = bp[(kk * 8 + 2) * NE], b3 = bp[(kk * 8 + 3) * NE];
                acc = __builtin_amdgcn_mfma_f32_32x32x2f32(a4[0], b0, acc, 0, 0, 0);
                acc = __builtin_amdgcn_mfma_f32_32x32x2f32(a4[1], b1, acc, 0, 0, 0);
                acc = __builtin_amdgcn_mfma_f32_32x32x2f32(a4[2], b2, acc, 0, 0, 0);
                acc = __builtin_amdgcn_mfma_f32_32x32x2f32(a4[3], b3, acc, 0, 0, 0);
            }
            __syncthreads();
            LAS float* red = fs;
#pragma unroll
            for (int r = 0; r < 16; ++r) red[(wid * 32 + (r & 3) + 8 * (r >> 2) + 4 * hh) * 33 + tk] = acc[r];
            __syncthreads();
            const int t2 = tid >> 4, e0 = (tid & 15) * 2;
            float s0 = p.router_b[l * NE + e0], s1 = p.router_b[l * NE + e0 + 1];
#pragma unroll
            for (int w = 0; w < 8; ++w) { s0 += red[(w * 32 + t2) * 33 + e0]; s1 += red[(w * 32 + t2) * 33 + e0 + 1]; }
            lg[t2 * 36 + e0] = s0; lg[t2 * 36 + e0 + 1] = s1;
            if (tid < 32) lcnt[tid] = 0;
        }
        __syncthreads();
        float vals[4]; int idxs[4], rank[4];
        if (tid < 32) {
            float lv[32];
#pragma unroll
            for (int q = 0; q < 8; ++q) { const f32x4 t = *(const LAS f32x4*)(lg + tid * 36 + q * 4); lv[q * 4] = t[0]; lv[q * 4 + 1] = t[1]; lv[q * 4 + 2] = t[2]; lv[q * 4 + 3] = t[3]; }
#pragma unroll
            for (int k = 0; k < 4; ++k) {
                float best = lv[0]; int bi = 0;
#pragma unroll
                for (int ee = 1; ee < NE; ++ee) { const bool gt = lv[ee] > best; best = gt ? lv[ee] : best; bi = gt ? ee : bi; }
#pragma unroll
                for (int ee = 0; ee < NE; ++ee) lv[ee] = (ee == bi) ? -3.0e38f : lv[ee];
                vals[k] = best; idxs[k] = bi;
                rank[k] = atomicAdd((int*)(lcnt + bi), 1);
            }
        }
        __syncthreads();
        if (tid < 32) { const int c = lcnt[tid]; lbase[tid] = c ? atomicAdd(r_cnt + l * NE + tid, c) : 0; }
        __syncthreads();
        if (tid < 32) {
            const int tok = tok0 + tid;
            const float mx = vals[0];
            float ex[4], sum = 0.f;
#pragma unroll
            for (int k = 0; k < 4; ++k) { ex[k] = __expf(vals[k] - mx); sum += ex[k]; }
            const float inv = 1.0f / sum;
#pragma unroll
            for (int k = 0; k < 4; ++k) {
                const int ee = idxs[k];
                const int slot = lbase[ee] + rank[k];
                r_list[(size_t)ee * NTOK + slot] = tok;
                r_ts[(size_t)tok * 4 + k] = (ee << 16) | slot;
                r_tw[(size_t)tok * 4 + k] = ex[k] * inv;
            }
        }
        __syncthreads();
    }
}

__device__ __forceinline__ void build_expert_tables(const Params& p, int l, LAS int* ts, LAS int* cn, LAS int* te) {
    const int tid = opaque_tid();
    if (tid < 64) {
        const int c = tid < NE ? p.cnt[l * NE + tid] : 0;
        const int nt = (c + 255) >> 8;
        int v = nt;
#pragma unroll
        for (int off = 1; off < 32; off <<= 1) { const int t = shupi(v, off, tid); if (tid >= off) v += t; }
        if (tid < NE) { cn[tid] = c; ts[tid] = v - nt; if (tid == NE - 1) ts[NE] = v; }
        if (te && tid < NE) for (int q = 0; q < nt; ++q) te[v - nt + q] = tid;
    }
    __syncthreads();
}

struct MoeSched {
    const LAS int* ts; const LAS int* cn; const LAS int* te; const int* list; const bf16_t* A; const bf16_t* Bt; const float* bias; int K, npn, nunits, G, c, nrowsB, nbias; bool gather;
    static constexpr bool HAS_BIAS = true;
    __device__ __forceinline__ bool next(int i, g8::Unit& u) const {
        if (G == 256) {
            const int x = c & 7, s = c >> 3, pm = i * (256 / npn) + x * (32 / npn) + s / npn;
            if (pm * npn >= nunits) return false;
            u.pm = pm; u.pn = s % npn; u.e = te[pm]; return true;
        }
        const long L = (long)i * G + c; if (L >= nunits) return false;
        u.pm = (int)(L / npn); u.pn = (int)(L % npn); u.e = te[u.pm]; return true;
    }
    __device__ __forceinline__ const char* a_base(const g8::Unit& u) const { return (const char*)(gather ? A : A + (size_t)u.pm * 256 * K); }
    __device__ __forceinline__ const char* b_base(const g8::Unit& u) const { return (const char*)(Bt + ((size_t)u.e * nrowsB + (size_t)u.pn * 256) * K); }
    __device__ __forceinline__ const int* row_addr(const g8::Unit& u, int R) const {
        const int cnt = cn[u.e], sl = (u.pm - ts[u.e]) * 256 + R;
        return list + (size_t)u.e * NTOK + (sl < cnt ? sl : 0);
    }
    __device__ __forceinline__ int rows_valid(const g8::Unit& u) const { return cn[u.e] - (u.pm - ts[u.e]) * 256; }
    __device__ __forceinline__ const float* bias_src(const g8::Unit& u, int lane) const {
        if (nbias == 2) return bias + (size_t)u.e * 2 * D + (lane < 32 ? u.pn * 128 + lane * 4 : D + u.pn * 128 + (lane - 32) * 4);
        return bias + (size_t)u.e * D + u.pn * 256 + lane * 4;
    }
};
struct EpiAct {
    bf16_t* O;
    __device__ __forceinline__ bool keep(const g8::Unit&) const { return false; }
    __device__ __forceinline__ void operator()(const f32x4 (&acc)[2][2][4][2], const g8::Unit& u, int wr, int wc, int fr, int fq, const LAS float* bias) const {
        const int row0 = u.pm * 256 + wr * 64 + fr, col0 = u.pn * 128 + wc * 32 + 8 * fq;
        const LAS float* bb = bias + wc * 32 + 8 * fq;
        const f32x4 g0 = *(const LAS f32x4*)bb, g1 = *(const LAS f32x4*)(bb + 4), l0 = *(const LAS f32x4*)(bb + 128), l1 = *(const LAS f32x4*)(bb + 132);
        const float bg[8] = {g0[0], g0[1], g0[2], g0[3], g1[0], g1[1], g1[2], g1[3]}, bl[8] = {l0[0], l0[1], l0[2], l0[3], l1[0], l1[1], l1[2], l1[3]};
#pragma unroll
        for (int ai = 0; ai < 2; ++ai)
#pragma unroll
            for (int m = 0; m < 4; ++m) {
                float o[8];
#pragma unroll
                for (int n = 0; n < 2; ++n)
#pragma unroll
                    for (int j = 0; j < 4; ++j) {
                        const float glu = fminf(acc[ai][0][m][n][j] + bg[n * 4 + j], 7.0f);
                        const float lin = fminf(fmaxf(acc[ai][1][m][n][j] + bl[n * 4 + j], -7.0f), 7.0f);
                        o[n * 4 + j] = glu * sigmoidf_(1.702f * glu) * (lin + 1.0f);
                    }
                *(u32x4*)(O + (size_t)(row0 + ai * 128 + m * 16) * D + col0) = pack8(o);
            }
    }
};
__device__ __forceinline__ void ph_g4(const Params& p, int l, LAS unsigned char* lds) {
    LAS int* ts = (LAS int*)(lds + g8::STAGE_BYTES); LAS int* cn = ts + 40; LAS int* te = ts + 80;
    build_expert_tables(p, l, ts, cn, te);
    MoeSched S; S.ts = ts; S.cn = cn; S.te = te; S.list = p.list; S.A = p.F; S.Bt = p.w1T + (size_t)l * NE * 2 * D * D; S.bias = p.moe_b1 + (size_t)l * NE * 2 * D; S.nbias = 2;
    S.K = D; S.npn = 8; S.nunits = ts[NE] * 8; S.G = gridDim.x; S.c = blockIdx.x; S.nrowsB = 2 * D; S.gather = true;
    EpiAct E; E.O = p.act;
    g8::gemm_phase(lds, D, S, E);
}

struct EpiYp {
    bf16_t* O;
    __device__ __forceinline__ bool keep(const g8::Unit&) const { return false; }
    __device__ __forceinline__ void operator()(const f32x4 (&acc)[2][2][4][2], const g8::Unit& u, int wr, int wc, int fr, int fq, const LAS float* bias) const {
        const int row0 = u.pm * 256 + wr * 64 + fr, col0 = u.pn * 256 + wc * 32 + 8 * fq;
#pragma unroll
        for (int bj = 0; bj < 2; ++bj) {
            const LAS float* bb = bias + bj * 128 + wc * 32 + 8 * fq;
            const f32x4 c0v = *(const LAS f32x4*)bb, c1v = *(const LAS f32x4*)(bb + 4);
            const float4 c0 = make_float4(c0v[0], c0v[1], c0v[2], c0v[3]), c1 = make_float4(c1v[0], c1v[1], c1v[2], c1v[3]);
#pragma unroll
            for (int ai = 0; ai < 2; ++ai)
#pragma unroll
                for (int m = 0; m < 4; ++m) {
                    u32x4 w; w[0] = pack2(acc[ai][bj][m][0][0] + c0.x, acc[ai][bj][m][0][1] + c0.y); w[1] = pack2(acc[ai][bj][m][0][2] + c0.z, acc[ai][bj][m][0][3] + c0.w);
                    w[2] = pack2(acc[ai][bj][m][1][0] + c1.x, acc[ai][bj][m][1][1] + c1.y); w[3] = pack2(acc[ai][bj][m][1][2] + c1.z, acc[ai][bj][m][1][3] + c1.w);
                    *(u32x4*)(O + (size_t)(row0 + ai * 128 + m * 16) * D + col0 + bj * 128) = w;
                }
        }
    }
};
__device__ __forceinline__ void ph_g5(const Params& p, int l, LAS unsigned char* lds) {
    LAS int* ts = (LAS int*)(lds + g8::STAGE_BYTES); LAS int* cn = ts + 40; LAS int* te = ts + 80;
    build_expert_tables(p, l, ts, cn, te);
    MoeSched S; S.ts = ts; S.cn = cn; S.te = te; S.list = p.list; S.A = p.act; S.Bt = p.w2T + (size_t)l * NE * D * D; S.bias = p.moe_b2 + (size_t)l * NE * D; S.nbias = 1;
    S.K = D; S.npn = 4; S.nunits = ts[NE] * 4; S.G = gridDim.x; S.c = blockIdx.x; S.nrowsB = D; S.gather = false;
    EpiYp E; E.O = p.yp;
    g8::gemm_phase(lds, D, S, E);
}

template <bool DRY = false> __device__ __forceinline__ void ph_combine(const Params& p, int l, int M, LAS unsigned char* lds) {
    float* const c_xl = DRY ? p.prep : p.xl; bf16_t* const c_H = DRY ? (bf16_t*)(p.prep + (size_t)NTOK * D) : p.H; float* const c_out = DRY ? p.prep : p.out;
    LAS int* ts = (LAS int*)lds; LAS int* cn = ts + 40;
    build_expert_tables(p, l, ts, cn, nullptr);
    const int tid = opaque_tid(), wid = tid >> 6, lane = tid & 63;
    const bool last = (l == 1);
    const int tstep = gridDim.x * NWAVES;
    int tok = blockIdx.x * NWAVES + wid;
    int4 nts = make_int4(0, 0, 0, 0); float4 ntw = make_float4(0.f, 0.f, 0.f, 0.f);
    if (tok < M) { nts = *(const int4*)(p.tokslot + (size_t)tok * 4); ntw = *(const float4*)(p.topw + (size_t)tok * 4); }
    for (; tok < M; tok += tstep) {
        float4 v[4];
        const float* mb = p.mod + (size_t)(l * 5 + tok_modrow(tok)) * (NMOD * D);
        const int tsl[4] = {nts.x, nts.y, nts.z, nts.w}; const float wts[4] = {ntw.x, ntw.y, ntw.z, ntw.w};
        int rows[4];
#pragma unroll
        for (int k = 0; k < 4; ++k) rows[k] = ts[tsl[k] >> 16] * 256 + (tsl[k] & 0xffff);
        if (tok + tstep < M) { nts = *(const int4*)(p.tokslot + (size_t)(tok + tstep) * 4); ntw = *(const float4*)(p.topw + (size_t)(tok + tstep) * 4); }
        u32x2 yv[4][4]; float4 xin[4], gtv[4];
#pragma unroll
        for (int i = 0; i < 4; ++i) {
            const int cidx = i * 256 + lane * 4;
#pragma unroll
            for (int k = 0; k < 4; ++k) yv[i][k] = *(const u32x2*)(p.yp + (size_t)rows[k] * D + cidx);
            xin[i] = *(const float4*)(p.xl + (size_t)tok * D + cidx);
            gtv[i] = *(const float4*)(mb + 5 * D + cidx);
        }
        float ss = 0.f;
#pragma unroll
        for (int i = 0; i < 4; ++i) {
            float m0 = 0.f, m1 = 0.f, m2 = 0.f, m3 = 0.f;
#pragma unroll
            for (int k = 0; k < 4; ++k) { m0 += wts[k] * bflo(yv[i][k][0]); m1 += wts[k] * bfhi(yv[i][k][0]); m2 += wts[k] * bflo(yv[i][k][1]); m3 += wts[k] * bfhi(yv[i][k][1]); }
            float4 xv = xin[i];
            xv.x += gtv[i].x * m0; xv.y += gtv[i].y * m1; xv.z += gtv[i].z * m2; xv.w += gtv[i].w * m3;
            v[i] = xv; ss += xv.x * xv.x + xv.y * xv.y + xv.z * xv.z + xv.w * xv.w;
        }
        ss = wave_sum(ss, lane);
        const float rinv = rsqrtf(ss * (1.0f / D) + 1e-6f);
        if (!last) {
#pragma unroll
            for (int i = 0; i < 4; ++i) *(float4*)(c_xl + (size_t)tok * D + i * 256 + lane * 4) = v[i];
            const float* mb1 = p.mod + (size_t)((l + 1) * 5 + tok_modrow(tok)) * (NMOD * D);
            norm_mod_store(v, rinv, p.norm1_g + (l + 1) * D, mb1 + 1 * D, mb1 + 0 * D, c_H + (size_t)tok * D, lane);
        } else {
#pragma unroll
            for (int i = 0; i < 4; ++i) {
                const int cidx = i * 256 + lane * 4;
                const float4 gv = *(const float4*)(p.final_norm_g + cidx);
                *(float4*)(c_out + (size_t)tok * D + cidx) = make_float4(v[i].x * rinv * gv.x, v[i].y * rinv * gv.y, v[i].z * rinv * gv.z, v[i].w * rinv * gv.w);
            }
        }
    }
}

#define XB_TMO      128
#define XB_XCNT(j)  (256  + 64 * (j))
#define XB_XSUB(j)  (1280 + 64 * (j))
#define XB_XGEN(j)  (2304 + 64 * (j))
#define XB_TOP      3328
#define XB_TOPGEN   3392
#define XCD_BAR_WORDS 3456
#define XB_SPIN_CAP (1u << 18)

__device__ __forceinline__ unsigned xb_ld(unsigned* p)              { return __hip_atomic_load(p, __ATOMIC_RELAXED, __HIP_MEMORY_SCOPE_AGENT); }
__device__ __forceinline__ unsigned xb_add(unsigned* p, unsigned v) { return __hip_atomic_fetch_add(p, v, __ATOMIC_RELAXED, __HIP_MEMORY_SCOPE_AGENT); }
__device__ __forceinline__ unsigned xb_xcc_id() { return (unsigned)__builtin_amdgcn_s_getreg((3 << 11) | 20) & 0xFu; }
#define XB_SPIN(cond, bar) do { unsigned _sp = 0; while (cond) { __builtin_amdgcn_s_sleep(1); \
    if ((++_sp & 255u) == 0u) { if (xb_ld(&(bar)[XB_TMO])) break; if (_sp > XB_SPIN_CAP) { atomicAdd(&(bar)[XB_TMO], 1u); break; } } } } while (0)

struct XcdBarrier {
    unsigned* bar; unsigned x;
    volatile LAS unsigned* st;
};

__device__ __forceinline__ XcdBarrier xcd_barrier_post(unsigned* bar, volatile LAS unsigned* st) {
    XcdBarrier b; b.bar = bar; b.x = xb_xcc_id(); b.st = st;
    if (threadIdx.x == 0) (void)xb_add(&bar[XB_XCNT(b.x)], 1u);
    return b;
}
__device__ __forceinline__ void xcd_barrier_complete(unsigned* bar, unsigned x, unsigned& nloc, unsigned& nx) {
    const unsigned G = gridDim.x * gridDim.y * gridDim.z;
    unsigned sum, cnt, mine, sp = 0u;
    for (;;) {
        sum = 0u; cnt = 0u; mine = 0u;
#pragma unroll
        for (unsigned j = 0; j < 16; ++j) { const unsigned c = xb_ld(&bar[XB_XCNT(j)]); sum += c; cnt += (c > 0u) ? 1u : 0u; mine = (j == x) ? c : mine; }
        if (sum == G) break;
        __builtin_amdgcn_s_sleep(1);
        if ((++sp & 255u) == 0u) { if (xb_ld(&bar[XB_TMO])) break; if (sp > XB_SPIN_CAP) { atomicAdd(&bar[XB_TMO], 1u); break; } }
    }
    nloc = mine > 0u ? mine : 1u; nx = cnt > 0u ? cnt : 1u;
}

__device__ __forceinline__ void xcd_barrier(const XcdBarrier& b) {
    asm volatile("s_waitcnt vmcnt(0)" ::: "memory");
    __syncthreads();
    if (threadIdx.x == 0) {
        unsigned* bar = b.bar;
        __builtin_amdgcn_s_waitcnt(0);
        unsigned nloc = b.st[0], nx = b.st[1];
        if (nloc == 0u) { xcd_barrier_complete(bar, b.x, nloc, nx); b.st[0] = nloc; b.st[1] = nx; }
        const unsigned old = xb_add(&bar[XB_XSUB(b.x)], 1u);
        const unsigned gen = old / nloc;
        if (old + 1u == (gen + 1u) * nloc) {
            __builtin_amdgcn_fence(__ATOMIC_RELEASE, "agent");
            asm volatile("s_waitcnt vmcnt(0)" ::: "memory");
            const unsigned og = xb_add(&bar[XB_TOP], 1u);
            const unsigned tg = og / nx;
            if (og + 1u == (tg + 1u) * nx) xb_add(&bar[XB_TOPGEN], 1u);
            else XB_SPIN(xb_ld(&bar[XB_TOPGEN]) == tg, bar);
            __builtin_amdgcn_fence(__ATOMIC_ACQUIRE, "agent");
            xb_add(&bar[XB_XGEN(b.x)], 1u);
            asm volatile("s_waitcnt vmcnt(0)" ::: "memory");
        } else {
            XB_SPIN(xb_ld(&bar[XB_XGEN(b.x)]) == gen, bar);
            __builtin_amdgcn_fence(__ATOMIC_ACQUIRE, "agent");
            asm volatile("s_waitcnt vmcnt(0)" ::: "memory");
        }
    }
    __syncthreads();
}


extern __shared__ __attribute__((aligned(16))) unsigned char dyn_lds[];

typedef const __attribute__((address_space(4))) unsigned char* KArgPtr;
__device__ __forceinline__ Params load_params(KArgPtr kp) {
    asm volatile("" : "+s"(kp));
    Params q;
    const __attribute__((address_space(4))) unsigned long long* k8 = (const __attribute__((address_space(4))) unsigned long long*)kp;
    unsigned long long* d8 = (unsigned long long*)&q;
#pragma unroll
    for (int i = 0; i < (int)(sizeof(Params) / 8); ++i) d8[i] = k8[i];
    return q;
}
__global__ void __launch_bounds__(NTHREADS, 2) k_mega(Params p_unused) {
    (void)p_unused;
    const KArgPtr kp = (KArgPtr)__builtin_amdgcn_kernarg_segment_ptr();
    LAS unsigned char* lds = (LAS unsigned char*)dyn_lds;
    volatile LAS unsigned* xb_words = (volatile LAS unsigned*)(lds + LDS_BYTES - 16);
    if (threadIdx.x == 0) { xb_words[0] = 0u; xb_words[1] = 0u; xb_words[2] = 0u; xb_words[3] = 0u; }
    __syncthreads();
    { const Params p = load_params(kp); (void)xcd_barrier_post(p.bar, xb_words); }
#define GRID_BARRIER() do { XcdBarrier b_; b_.bar = load_params(kp).bar; b_.x = xb_xcc_id(); b_.st = xb_words; xcd_barrier(b_); } while (0)
#define PH(stmt) do { const Params p = load_params(kp); stmt; } while (0)
    PH(ph_convert(p, lds));
    PH(ph_mod(p, lds));
    GRID_BARRIER();
    PH(ph_norm1_first(p));
    GRID_BARRIER();
    for (int l = 0; l < 2; ++l) {
        const int M = l == 0 ? NTOK : NLAT;
        { unsigned lb_ = (unsigned)(size_t)lds; asm volatile("" : "+s"(lb_)); lds = (LAS unsigned char*)(size_t)lb_; }
        PH(ph_g1(p, l, lds));
        GRID_BARRIER();
        PH(ph_prep(p, l, lds));
        PH(ph_local(p, l, lds));
        GRID_BARRIER();
        PH(ph_seq(p, l, lds));
        GRID_BARRIER();
        PH(ph_merge(p, l, M));
        GRID_BARRIER();
        PH(ph_g2(p, l, M, lds));
        GRID_BARRIER();
        PH(ph_g3(p, l, M, lds));
        GRID_BARRIER();
        PH(ph_route(p, l, M, lds));
        GRID_BARRIER();
        PH(ph_g4(p, l, lds));
        GRID_BARRIER();
        PH(ph_g5(p, l, lds));
        GRID_BARRIER();
        PH(ph_combine(p, l, M, lds));
        if (l == 0) GRID_BARRIER();
    }
}

static inline size_t align_up(size_t v, size_t a) { return (v + a - 1) / a * a; }

extern "C" void kernel_launch(void* const* d_in, const int* in_sizes, int n_in, void* d_out, int out_size, void* d_ws, size_t ws_size, hipStream_t stream) {
    (void)in_sizes; (void)n_in; (void)out_size;
    Params p{};
    const float** pf = (const float**)&p;
    for (int i = 0; i < 32; ++i) pf[i] = (const float*)d_in[i];
    p.out = (float*)d_out;
    unsigned char* w = (unsigned char*)d_ws; size_t off = 0;
    auto take = [&](size_t bytes) { void* r = w + off; off = align_up(off + bytes, 256); return r; };
    p.bar = (unsigned*)take(16384);
    p.cnt = (int*)take(4096);
    const size_t ctl_bytes = off;
    p.mod = (float*)take((size_t)2 * 5 * NMOD * D * 4);
    p.winT = (bf16_t*)take((size_t)2 * NPW * D * 2);
    p.wbT = (bf16_t*)take((size_t)2 * 4 * D * MW * 2);
    p.woutT = (bf16_t*)take((size_t)2 * D * D * 2);
    p.w1T = (bf16_t*)take((size_t)2 * NE * 2 * D * D * 2);
    p.w2T = (bf16_t*)take((size_t)2 * NE * D * D * 2);
    p.xl = (float*)take((size_t)NTOK * D * 4);
    p.H = (bf16_t*)take((size_t)NTOK * D * 2);
    p.P = (bf16_t*)take((size_t)NTOK * NP * 2);
    p.gate = (bf16_t*)take((size_t)NTOK * 4096 * 2);
    p.act = p.P; p.yp = p.P + (size_t)CAPROWS * D;
    p.prep = (float*)take(NPREP * TOKW * 4);
    p.O = (bf16_t*)take(8 * TOKW * 2);
    p.lq = (bf16_t*)take((size_t)3 * NITEM * 64 * 128 * 2);
    p.lo = (bf16_t*)take((size_t)3 * NITEM * 64 * 128 * 2);
    p.lb = (bf16_t*)take((size_t)3 * NITEM * 128 * 128 * 2);
    p.la = (bf16_t*)take((size_t)NITEM * 128 * 128 * 2);
    p.ld = (float*)take((size_t)3 * NITEM * 128 * 4);
    p.lruT = (bf16_t*)take((size_t)2 * 8 * 4 * 4096 * 2);
    p.lsig = (float*)take((size_t)2 * 2 * MW * 4);
    p.rope = (float2*)take((size_t)TL * 64 * 8);
    p.Y = (bf16_t*)take(4 * TOKW * 2);
    p.mix = (bf16_t*)take((size_t)NTOK * D * 2);
    p.F = p.H;
    p.list = (int*)take((size_t)NE * NTOK * 4);
    p.tokslot = (int*)take((size_t)NTOK * 4 * 4);
    p.topw = (float*)take((size_t)NTOK * 4 * 4);
    if (off > ws_size) { fprintf(stderr, "workspace too small: need %zu have %zu\n", off, ws_size); return; }

    static int grid = 0;
    if (!grid) {
        int dev = 0, cus = 0, occ = 0; (void)hipGetDevice(&dev); (void)hipDeviceGetAttribute(&cus, hipDeviceAttributeMultiprocessorCount, dev);
        (void)hipFuncSetAttribute((const void*)k_mega, hipFuncAttributeMaxDynamicSharedMemorySize, LDS_BYTES);
        (void)hipOccupancyMaxActiveBlocksPerMultiprocessor(&occ, (const void*)k_mega, NTHREADS, LDS_BYTES);
        if (cus <= 0) cus = 256;
        grid = cus * (occ < 1 ? 1 : 1);
        if (occ < 1) fprintf(stderr, "occupancy query says %d blocks per CU\n", occ);
    }
    (void)hipMemsetAsync(d_ws, 0, ctl_bytes, stream);
    hipLaunchKernelGGL(k_mega, dim3(grid), dim3(NTHREADS), LDS_BYTES, stream, p);
}
```

```cpp
#include <hip/hip_runtime.h>
#include <stdint.h>
#include <stdio.h>

#define LAS __attribute__((address_space(3)))
typedef unsigned short bf16_t;
typedef short bf16x8 __attribute__((ext_vector_type(8)));
typedef float f32x4 __attribute__((ext_vector_type(4)));
typedef float f32x2 __attribute__((ext_vector_type(2)));
typedef unsigned u32x2 __attribute__((ext_vector_type(2)));
typedef unsigned u32x4 __attribute__((ext_vector_type(4)));

#ifndef PROBE
#define PROBE 0
#endif

constexpr int D = 1024, NB = 4, TL = 4096, TC = 256, NLAT = NB * TL, NCTX = NB * TC, NTOK = NLAT + NCTX;
constexpr int NIN = 11792, NPW = 12032, NP = 7936, MW = 512, NE = 32, TOPK = 4, NMOD = 6;
constexpr int C_GQKV = 0, C_GZ = 1536, C_HQ = 2048, C_HI = 2560, C_HF = 3072, C_HG = 4096, C_LX = 4608,
              C_LY = 5120, C_RQKV = 5632, C_RG = 7168, C_GA = 7680, C_GB = 7688, W_MG = 7936;
__host__ __device__ __forceinline__ int win_dst_row(int n) {
    if (n < 7696) return n < 2048 ? n : n < 2064 ? 7680 + (n - 2048) : n - 16;
    const int q = n - 7696, seg = q >> 10, lam = q & 1023, t = lam >> 6, li = lam & 63;
    return 7936 + t * 256 + (seg >> 1) * 128 + (li >> 4) * 32 + ((li >> 2) & 3) * 8 + (seg & 1) * 4 + (li & 3);
}
constexpr int NTHREADS = 512, NWAVES = 8;
constexpr int LDS_BYTES = 140 * 1024;
constexpr int CAPROWS = 77824;
constexpr size_t TOKW = (size_t)NTOK * MW;
constexpr int PR_LA = 0, PR_LU = 2, NPREP = 4;
constexpr int NCHUNK = 68, NITEM = 32 * NCHUNK;

struct Params {
    const float *x, *c, *ctx, *c_ctx, *w_mod, *b_mod, *norm1_g, *norm2_g, *w_in, *gdn_conv_w, *gdn_a_log, *gdn_dt_bias, *gdn_norm_g, *hgrn_lb,
        *hgrn_norm_g, *lru_conv_w, *lru_conv_b, *lru_wa, *lru_ba, *lru_wx, *lru_bx, *lru_lambda, *ret_norm_g, *w_branch, *w_out, *router_w,
        *router_b, *moe_w1, *moe_b1, *moe_w2, *moe_b2, *final_norm_g;
    float* out;
    unsigned* bar; int* cnt; float* mod;
    bf16_t *winT, *wbT, *woutT, *w1T, *w2T;
    bf16_t* xl; bf16_t* H; bf16_t* P; float* prep; float* gg; float* gb; bf16_t* O; bf16_t* Y; bf16_t* mix; bf16_t* F;
    int* list; int* tokslot; float* topw; bf16_t* act; bf16_t* yp;
    bf16_t *lq, *lo, *lb, *la; float* ld; bf16_t* lruT; bf16_t* gate; float* lsig; float2* rope;
};

typedef __bf16 bf16x2_t __attribute__((ext_vector_type(2)));
__device__ __forceinline__ unsigned pack2(float a, float b) { const f32x2 v = {a, b}; return __builtin_bit_cast(unsigned, __builtin_convertvector(v, bf16x2_t)); }
__device__ __forceinline__ unsigned f2bf(float f) { return pack2(f, f) & 0xffffu; }
__device__ __forceinline__ float bf2f(bf16_t b) { return __uint_as_float(((unsigned)b) << 16); }
__device__ __forceinline__ float bflo(unsigned u) { return __uint_as_float(u << 16); }
__device__ __forceinline__ float bfhi(unsigned u) { return __uint_as_float(u & 0xffff0000u); }
__device__ __forceinline__ float sigmoidf_(float x) { return __builtin_amdgcn_rcpf(1.0f + __expf(-x)); }
__device__ __forceinline__ float siluf_(float x) { return x * sigmoidf_(x); }
__device__ __forceinline__ float softplusf_(float x) { return x > 20.f ? x : __logf(1.0f + __expf(x)); }
__device__ __forceinline__ float ret_log_gamma(int h) { return h == 0 ? -0.031748698314580f : h == 1 ? -0.015748356968139f : h == 2 ? -0.007843177461025f : -0.003913899321136f; }
__device__ __forceinline__ float logsigmoidf_(float x) { return -softplusf_(-x); }
__device__ __forceinline__ float gelu_tanhf_(float x) { const float u = 0.7978845608028654f * (x + 0.044715f * x * x * x); return x * __builtin_amdgcn_rcpf(1.0f + __expf(-2.0f * u)); }
__device__ __forceinline__ float shx(float v, int m, int lane) { return __int_as_float(__builtin_amdgcn_ds_bpermute((lane ^ m) << 2, __float_as_int(v))); }
__device__ __forceinline__ float shup(float v, int off, int lane) { const int s = lane >= off ? lane - off : lane; return __int_as_float(__builtin_amdgcn_ds_bpermute(s << 2, __float_as_int(v))); }
__device__ __forceinline__ int shupi(int v, int off, int lane) { const int s = lane >= off ? lane - off : lane; return __builtin_amdgcn_ds_bpermute(s << 2, v); }
__device__ __forceinline__ float wave_sum(float v, int lane) {
#pragma unroll
    for (int m = 32; m >= 1; m >>= 1) v += shx(v, m, lane);
    return v;
}
__device__ __forceinline__ int opaque_tid() { int t = threadIdx.x; asm volatile("" : "+v"(t)); return t; }
template <class T> __device__ __forceinline__ T* opaque_sptr(T* q) { asm volatile("" : "+s"(q)); return q; }
__device__ __forceinline__ int tok_modrow(int tok) { return tok < NLAT ? (tok >> 12) : 4; }
__device__ __forceinline__ void tok_info(int tok, int& t, int& T, int& base) {
    if (tok < NLAT) { t = tok & (TL - 1); T = TL; base = tok - t; }
    else { t = (tok - NLAT) & (TC - 1); T = TC; base = tok - t; }
}

__device__ __forceinline__ f32x4 mfma16(bf16x8 a, bf16x8 b, f32x4 c) { return __builtin_amdgcn_mfma_f32_16x16x32_bf16(a, b, c, 0, 0, 0); }
__device__ __forceinline__ u32x2 pack4(f32x4 v) { u32x2 o; o[0] = pack2(v[0], v[1]); o[1] = pack2(v[2], v[3]); return o; }
__device__ __forceinline__ u32x4 pack8(const float* v) { u32x4 o; o[0] = pack2(v[0], v[1]); o[1] = pack2(v[2], v[3]); o[2] = pack2(v[4], v[5]); o[3] = pack2(v[6], v[7]); return o; }

namespace g8 {
constexpr int BM = 256, BK = 64, HALF = 128, HTB = HALF * BK * 2, STAGE_BYTES = 8 * HTB;
__device__ __forceinline__ int lds_byte(int r, int c) { const int st = (r >> 4) * 2 + (c >> 5), rr = r & 15, cc = c & 31, ob = rr * 64 + cc * 2; return st * 1024 + (ob ^ (((ob >> 9) & 1) << 5)); }
__device__ __forceinline__ void stage_rc(int b, int& R, int& C) { const int st = b / 1024, sb = b % 1024, swz = sb ^ (((sb >> 9) & 1) << 5); R = (st >> 1) * 16 + swz / 64; C = (st & 1) * 32 + (swz % 64) / 2; }
__device__ __forceinline__ int perm32(int rho) { const int n = rho >> 4, i = rho & 15; return 8 * (i >> 2) + 4 * n + (i & 3); }
struct Unit { int pm, pn, e; };

template <class Epi, class Sched>
__device__ __forceinline__ void gemm_phase(LAS unsigned char* lds, const int K, const Sched& S, const Epi& E) {
    const int tid = opaque_tid(), wid = __builtin_amdgcn_readfirstlane(tid >> 6), lane = tid & 63, wr = wid >> 2, wc = wid & 3, fr = lane & 15, fq = lane >> 4;
    const int nt = K / BK;
    int R0, C0, R1, C1; stage_rc(tid * 16, R0, C0); stage_rc(tid * 16 + 8192, R1, C1);
    unsigned voffB[2];
    voffB[0] = (unsigned)(((R0 & ~31) + perm32(R0 & 31)) * K + C0) * 2u; voffB[1] = (unsigned)(((R1 & ~31) + perm32(R1 & 31)) * K + C1) * 2u;
    const unsigned cb0 = (unsigned)C0 * 2u, cb1 = (unsigned)C1 * 2u;
    const size_t kstep = (size_t)(BK * 2);
    const size_t hstepB = (size_t)HALF * K * 2;
    const unsigned ldsw = (unsigned)wid * 1024u;
    const int aoff = lds_byte(wr * 64 + fr, fq * 8), boff = lds_byte(wc * 32 + fr, fq * 8);
#define G8_SA(b, h) (((b) * 2 + (h)) * HTB)
#define G8_SB(b, h) ((4 + (b) * 2 + (h)) * HTB)
#define G8_GL(src, dstoff) __builtin_amdgcn_global_load_lds((const unsigned*)(src), (LAS unsigned*)(lds + (dstoff)), 16, 0, 0)
#define G8_STAGE_A(bufoff, gbase, vo, h) do { G8_GL((const char*)(gbase) + (vo)[2 * (h)], (bufoff) + ldsw); G8_GL((const char*)(gbase) + (vo)[2 * (h) + 1], (bufoff) + ldsw + 8192); } while (0)
#define G8_STAGE_B(bufoff, gbase) do { G8_GL((const char*)(gbase) + voffB[0], (bufoff) + ldsw); G8_GL((const char*)(gbase) + voffB[1], (bufoff) + ldsw + 8192); } while (0)
#define G8_LDA(dst, b, h) do { _Pragma("unroll") for (int m = 0; m < 4; ++m) _Pragma("unroll") for (int k = 0; k < 2; ++k) dst[m][k] = *(const LAS bf16x8*)(lds + G8_SA(b, h) + aoff + m * 2048 + k * 1024); } while (0)
#define G8_LDB(dst, b, h) do { _Pragma("unroll") for (int n = 0; n < 2; ++n) _Pragma("unroll") for (int k = 0; k < 2; ++k) dst[n][k] = *(const LAS bf16x8*)(lds + G8_SB(b, h) + boff + n * 2048 + k * 1024); } while (0)
#define G8_MMA(ai, bj, At, Bt) do { __builtin_amdgcn_s_setprio(1); _Pragma("unroll") for (int m = 0; m < 4; ++m) _Pragma("unroll") for (int n = 0; n < 2; ++n) _Pragma("unroll") for (int k = 0; k < 2; ++k) \
        acc[ai][bj][m][n] = __builtin_amdgcn_mfma_f32_16x16x32_bf16(Bt[n][k], At[m][k], acc[ai][bj][m][n], 0, 0, 0); __builtin_amdgcn_s_setprio(0); } while (0)
#define G8_WAIT_V(n) asm volatile("s_waitcnt vmcnt(" #n ")" ::: "memory")
#define G8_WAIT_L(n) asm volatile("s_waitcnt lgkmcnt(" #n ")" ::: "memory")
#define G8_BAR __builtin_amdgcn_s_barrier()
#define G8_SCHED __builtin_amdgcn_sched_barrier(0)
    Unit cur, nxt; int ui = 0;
    if (!S.next(0, cur)) return;
    LAS float* biasbuf = (LAS float*)(lds + STAGE_BYTES + 2048);
    LAS int* rowbuf = (LAS int*)(lds + STAGE_BYTES + 4096);
    f32x4 acc[2][2][4][2];
#pragma unroll
    for (int a = 0; a < 2; ++a)
#pragma unroll
        for (int b = 0; b < 2; ++b)
#pragma unroll
            for (int m = 0; m < 4; ++m)
#pragma unroll
                for (int n = 0; n < 2; ++n) acc[a][b][m][n] = (f32x4){0.f, 0.f, 0.f, 0.f};
    bf16x8 At[4][2], B0[2][2], B1[2][2];
    unsigned vA[4];
    {
        unsigned rows[4] = {(unsigned)R0, (unsigned)R1, (unsigned)(HALF + R0), (unsigned)(HALF + R1)};
        if (S.gather) { rows[0] = (unsigned)*S.row_addr(cur, R0); rows[1] = (unsigned)*S.row_addr(cur, R1); rows[2] = (unsigned)*S.row_addr(cur, HALF + R0); rows[3] = (unsigned)*S.row_addr(cur, HALF + R1); }
        vA[0] = rows[0] * (unsigned)(K * 2) + cb0; vA[1] = rows[1] * (unsigned)(K * 2) + cb1; vA[2] = rows[2] * (unsigned)(K * 2) + cb0; vA[3] = rows[3] * (unsigned)(K * 2) + cb1;
    }
    const char* cA = S.a_base(cur); const char* cB = S.b_base(cur);
    G8_STAGE_B(G8_SB(0, 0), cB); G8_STAGE_A(G8_SA(0, 0), cA, vA, 0); G8_STAGE_B(G8_SB(0, 1), cB + hstepB); G8_STAGE_A(G8_SA(0, 1), cA, vA, 1);
    if (wr == 1) G8_BAR;
    G8_WAIT_V(4); G8_BAR;
    G8_STAGE_B(G8_SB(1, 0), cB + kstep); G8_STAGE_A(G8_SA(1, 0), cA + kstep, vA, 0); G8_STAGE_B(G8_SB(1, 1), cB + hstepB + kstep);
    G8_WAIT_V(6); G8_BAR;
    for (;;) {
        const bool has_next = S.next(ui + 1, nxt);
        const char* nA = has_next ? S.a_base(nxt) : cA; const char* nB = has_next ? S.b_base(nxt) : cB;
        const int nvalid = (S.gather && has_next) ? S.rows_valid(nxt) : 0;
        if (wid == 0) {
            if (Sched::HAS_BIAS) G8_GL(S.bias_src(cur, lane), STAGE_BYTES + 2048 + (ui & 1) * 1024);
            if (S.gather && has_next) G8_GL(S.row_addr(nxt, 0) + lane * 4, STAGE_BYTES + 4096 + ((ui + 1) & 1) * 1024);
        }
        for (int t = 0; t < nt; t += 2) {
            const bool last = (t == nt - 2);
            const char* a1 = cA + (size_t)(t + 1) * kstep;
            const char* a2 = last ? nA : cA + (size_t)(t + 2) * kstep; const char* b2 = last ? nB : cB + (size_t)(t + 2) * kstep;
            const char* a3 = a2 + kstep; const char* b3 = b2 + kstep;
            G8_LDB(B0, 0, 0); G8_SCHED; G8_LDA(At, 0, 0); G8_STAGE_A(G8_SA(1, 1), a1, vA, 1);
            if (last && S.gather && has_next) {
                const LAS int* rb = rowbuf + ((ui + 1) & 1) * 256;
                const unsigned r0 = R0 < nvalid ? (unsigned)rb[R0] : 0u, r1 = R1 < nvalid ? (unsigned)rb[R1] : 0u;
                const unsigned r2 = HALF + R0 < nvalid ? (unsigned)rb[HALF + R0] : 0u, r3 = HALF + R1 < nvalid ? (unsigned)rb[HALF + R1] : 0u;
                vA[0] = r0 * (unsigned)(K * 2) + cb0; vA[1] = r1 * (unsigned)(K * 2) + cb1; vA[2] = r2 * (unsigned)(K * 2) + cb0; vA[3] = r3 * (unsigned)(K * 2) + cb1;
            }
            G8_WAIT_L(8); G8_BAR; G8_WAIT_L(0); G8_MMA(0, 0, At, B0); G8_BAR; G8_SCHED;
            G8_LDB(B1, 0, 1); G8_STAGE_B(G8_SB(0, 0), b2);
            G8_BAR; G8_WAIT_L(0); G8_MMA(0, 1, At, B1); G8_BAR;
            G8_LDA(At, 0, 1); G8_STAGE_A(G8_SA(0, 0), a2, vA, 0);
            G8_BAR; G8_WAIT_L(0); G8_MMA(1, 0, At, B0); G8_BAR; G8_SCHED;
            G8_STAGE_B(G8_SB(0, 1), b2 + hstepB);
            G8_WAIT_V(6); G8_BAR; G8_MMA(1, 1, At, B1); G8_BAR;
            G8_LDB(B0, 1, 0); G8_SCHED; G8_LDA(At, 1, 0); G8_STAGE_A(G8_SA(0, 1), a2, vA, 1);
            G8_WAIT_L(8); G8_BAR; G8_WAIT_L(0); G8_MMA(0, 0, At, B0); G8_BAR; G8_SCHED;
            G8_LDB(B1, 1, 1); G8_STAGE_B(G8_SB(1, 0), b3);
            G8_BAR; G8_WAIT_L(0); G8_MMA(0, 1, At, B1); G8_BAR;
            G8_LDA(At, 1, 1); G8_STAGE_A(G8_SA(1, 0), a3, vA, 0);
            G8_BAR; G8_WAIT_L(0); G8_MMA(1, 0, At, B0); G8_BAR; G8_SCHED;
            G8_STAGE_B(G8_SB(1, 1), b3 + hstepB);
            G8_WAIT_V(6); G8_BAR; G8_MMA(1, 1, At, B1); G8_BAR;
        }
        E(acc, cur, wr, wc, fr, fq, biasbuf + (ui & 1) * 256);
        if (!has_next) break;
        if (!E.keep(cur))
#pragma unroll
        for (int a = 0; a < 2; ++a)
#pragma unroll
            for (int b = 0; b < 2; ++b)
#pragma unroll
                for (int m = 0; m < 4; ++m)
#pragma unroll
                    for (int n = 0; n < 2; ++n) acc[a][b][m][n] = (f32x4){0.f, 0.f, 0.f, 0.f};
        cur = nxt; cA = nA; cB = nB; ++ui;
    }
    G8_WAIT_V(0);
    if (wr == 0) G8_BAR;
    G8_BAR;
#undef G8_SA
#undef G8_SB
#undef G8_GL
#undef G8_STAGE_A
#undef G8_STAGE_B
#undef G8_LDA
#undef G8_LDB
#undef G8_MMA
#undef G8_WAIT_V
#undef G8_WAIT_L
#undef G8_BAR
#undef G8_SCHED
}

struct PlainSched {
    const bf16_t* A; const bf16_t* Bt; int K, nM, nN, nwg, G, c;
    __device__ __forceinline__ void init(const bf16_t* A_, const bf16_t* Bt_, int M, int N, int K_) { A = A_; Bt = Bt_; K = K_; nM = M / BM; nN = N / BM; nwg = nM * nN; G = gridDim.x; c = blockIdx.x; }
    __device__ __forceinline__ bool next(int i, Unit& u) const {
        const long L = (long)i * G + c; if (L >= nwg) return false;
        int wgid = (int)L; { const int q = nwg / 8, r = nwg % 8, xcd = wgid % 8, off = wgid / 8; wgid = (xcd < r ? xcd * (q + 1) : r * (q + 1) + (xcd - r) * q) + off; }
        const int nig = 8 * nN, gid = wgid / nig, fm = gid * 8, gsz = (nM - fm) < 8 ? (nM - fm) : 8;
        u.pm = fm + ((wgid % nig) % gsz); u.pn = (wgid % nig) / gsz; u.e = 0; return true;
    }
    __device__ __forceinline__ const char* a_base(const Unit& u) const { return (const char*)(A + (size_t)u.pm * BM * K); }
    __device__ __forceinline__ const char* b_base(const Unit& u) const { return (const char*)(Bt + (size_t)u.pn * BM * K); }
    static constexpr bool HAS_BIAS = false, gather = false;
    __device__ __forceinline__ const int* row_addr(const Unit&, int) const { return nullptr; }
    __device__ __forceinline__ int rows_valid(const Unit&) const { return 256; }
    __device__ __forceinline__ const float* bias_src(const Unit&, int) const { return nullptr; }
};
}

__device__ __forceinline__ int w1_dst_row(int n) { const int half = n >> 10, cc = n & 1023; return (cc >> 7) * 256 + half * 128 + (cc & 127); }

struct CvtTile { const float* src; bf16_t* dst; int ld, Nsrc, k0, n0, K, mode; };
__device__ __forceinline__ CvtTile cvt_decode(const Params& p, int it) {
    constexpr int PER_L = 2960 + 512 + 256 + 16384 + 8192;
    CvtTile t; const int l = it / PER_L; int r = it % PER_L;
    if (r < 2960) { const int nt = r % 185, kt = r / 185; t.src = p.w_in + (size_t)l * D * NIN; t.ld = NIN; t.Nsrc = NIN; t.k0 = kt * 64; t.n0 = nt * 64; t.dst = p.winT + (size_t)l * NPW * D; t.K = D; t.mode = 2; }
    else if (r < 3472) { r -= 2960; const int n = r / 128; r %= 128; const int nt = r % 16, kt = r / 16;
        t.src = p.w_branch + (size_t)(l * 4 + n) * MW * D; t.ld = D; t.Nsrc = D; t.k0 = kt * 64; t.n0 = nt * 64; t.dst = p.wbT + (size_t)(l * 4 + n) * D * MW; t.K = MW; t.mode = 0; }
    else if (r < 3728) { r -= 3472; const int nt = r % 16, kt = r / 16; t.src = p.w_out + (size_t)l * D * D; t.ld = D; t.Nsrc = D; t.k0 = kt * 64; t.n0 = nt * 64; t.dst = p.woutT + (size_t)l * D * D; t.K = D; t.mode = 0; }
    else if (r < 3728 + 16384) { r -= 3728; const int ee = r / 512; r %= 512; const int nt = r % 32, kt = r / 32;
        t.src = p.moe_w1 + (size_t)(l * NE + ee) * D * 2 * D; t.ld = 2 * D; t.Nsrc = 2 * D; t.k0 = kt * 64; t.n0 = nt * 64; t.dst = p.w1T + (size_t)(l * NE + ee) * 2 * D * D; t.K = D; t.mode = 1; }
    else { r -= 3728 + 16384; const int ee = r / 256; r %= 256; const int nt = r % 16, kt = r / 16;
        t.src = p.moe_w2 + (size_t)(l * NE + ee) * D * D; t.ld = D; t.Nsrc = D; t.k0 = kt * 64; t.n0 = nt * 64; t.dst = p.w2T + (size_t)(l * NE + ee) * D * D; t.K = D; t.mode = 0; }
    return t;
}

constexpr int CVT_TOTAL = 2 * (2960 + 512 + 256 + 16384 + 8192);
constexpr int CVT_G_FIRST = 932;
constexpr int CVT_G_L0 = 8008;
constexpr int CVT_G_ALL = CVT_TOTAL / 4;
__device__ __forceinline__ void cvt_trip(const Params& p, LAS float* tile, int tid, int g) {
    constexpr int TOTAL = CVT_TOTAL;
    float4 v[4][2];
    const int rr = tid >> 4, c4 = (tid & 15) * 4;
#pragma unroll
    for (int q = 0; q < 4; ++q) {
        const int it = g * 4 + q;
        const CvtTile t = cvt_decode(p, it < TOTAL ? it : TOTAL - 1);
        const int n = t.n0 + c4; const bool ok = n < t.Nsrc; const int nc = ok ? n : t.Nsrc - 4;
#pragma unroll
        for (int i = 0; i < 2; ++i) { const float4 x = *(const float4*)(t.src + (size_t)(t.k0 + rr + i * 32) * t.ld + nc); v[q][i] = ok ? x : make_float4(0.f, 0.f, 0.f, 0.f); }
    }
#pragma unroll
    for (int q = 0; q < 4; ++q)
#pragma unroll
        for (int i = 0; i < 2; ++i) { LAS float* tp = tile + q * 4160 + (rr + i * 32) * 65 + c4; tp[0] = v[q][i].x; tp[1] = v[q][i].y; tp[2] = v[q][i].z; tp[3] = v[q][i].w; }
    __syncthreads();
#pragma unroll
    for (int q = 0; q < 4; ++q) {
        const int it = g * 4 + q;
        if (it < TOTAL) {
            const CvtTile t = cvt_decode(p, it);
            const int nl = tid >> 3, kg = tid & 7, n = t.n0 + nl;
            float w[8];
#pragma unroll
            for (int j = 0; j < 8; ++j) w[j] = tile[q * 4160 + (kg * 8 + j) * 65 + nl];
            const int drow = t.mode == 1 ? w1_dst_row(n) : t.mode == 2 ? win_dst_row(n) : n;
            if (n < t.Nsrc) *(u32x4*)(t.dst + (size_t)drow * t.K + t.k0 + kg * 8) = pack8(w);
        }
    }
    __syncthreads();
}
__device__ __forceinline__ void cvt_fill(const Params& p, LAS unsigned char* lds, int w, int b1, int n1, int b2, int n2) {
    LAS float* tile = (LAS float*)lds; LAS int* tk = (LAS int*)(lds + 4 * 4160 * 4);
    int* const head = p.cnt + 256 + 32 * w;
    const int tid = opaque_tid();
    __syncthreads();
    int nxt = 0;
    if (tid == 0) nxt = atomicAdd(head, 1);
    for (;;) {
        if (tid == 0) tk[0] = nxt;
        __syncthreads();
        const int t = __builtin_amdgcn_readfirstlane(tk[0]);
        if (t >= n1 + n2) break;
        if (tid == 0) nxt = atomicAdd(head, 1);
        cvt_trip(p, tile, tid, t < n1 ? b1 + t : b2 + (t - n1));
    }
}
constexpr int CW_G1A = 932, CW_SEQ0A = 1932, CW_G2 = 4476, CW_G3 = 6476, CW_SEQ0B = 7076, CW_G1B = 8842, CW_SEQ1 = 9842;

__device__ __forceinline__ void ph_convert(const Params& p, LAS unsigned char* lds) {
    LAS float* tile = (LAS float*)lds;
    const int tid = opaque_tid();
    for (int idx = blockIdx.x * NTHREADS + tid; idx < 2 * 8 * 4 * 4096; idx += gridDim.x * NTHREADS) {
        const int i = idx & 63, j = (idx >> 6) & 63, mat = (idx >> 12) & 3, n = (idx >> 14) & 7, ll = idx >> 17, d = mat >> 1;
        p.lruT[idx] = (bf16_t)f2bf(((mat & 1) ? p.lru_wx : p.lru_wa)[(size_t)((ll * 2 + d) * 8 + n) * 4096 + i * 64 + j]);
    }
    for (int idx = blockIdx.x * NTHREADS + tid; idx < 2 * 2 * MW; idx += gridDim.x * NTHREADS) p.lsig[idx] = 8.0f * logsigmoidf_(p.lru_lambda[idx]);
    for (int idx = blockIdx.x * NTHREADS + tid; idx < TL * 64; idx += gridDim.x * NTHREADS) {
        const int t = idx >> 6, pi = idx & 63;
        const float pos = (pi < 32) ? (float)(t >> 6) : (float)(t & 63);
        const float ang = pos * exp2f(-(float)(pi & 31) * (13.287712379549449f / 32.0f));
        float sn, cs; sincosf(ang, &sn, &cs);
        p.rope[idx] = make_float2(cs, sn);
    }
    for (int idx = blockIdx.x * NTHREADS + tid; idx < 2 * 240 * (D / 8); idx += gridDim.x * NTHREADS) {
        const int ll = idx / (240 * (D / 8)), r = idx % (240 * (D / 8));
        *(u32x4*)(p.winT + ((size_t)ll * NPW + 7696) * D + (size_t)r * 8) = (u32x4){0u, 0u, 0u, 0u};
    }
    for (int g = blockIdx.x; g < CVT_G_FIRST; g += gridDim.x) cvt_trip(p, tile, tid, g);
}

__device__ __forceinline__ void ph_mod(const Params& p, LAS unsigned char* lds) {
    LAS float* sc = (LAS float*)lds;
    LAS float* red = sc + 5 * D;
    const int tid = opaque_tid(), wid = tid >> 6, lane = tid & 63;
    if ((int)blockIdx.x >= 192) return;
    for (int i = tid; i < 5 * D; i += NTHREADS) { const int r = i >> 10, k = i & 1023; const float v = r < 4 ? p.c[r * D + k] : p.c_ctx[k]; sc[i] = siluf_(v); }
    __syncthreads();
    for (int it = blockIdx.x; it < 192; it += gridDim.x) {
        const int l = it / 96, n0 = (it % 96) * 64;
        float acc[5] = {0.f, 0.f, 0.f, 0.f, 0.f};
        const float* wp = p.w_mod + (size_t)l * D * (NMOD * D) + n0 + lane;
        for (int k = wid * 128; k < wid * 128 + 128; ++k) {
            const float wv = wp[(size_t)k * (NMOD * D)];
#pragma unroll
            for (int r = 0; r < 5; ++r) acc[r] += sc[r * D + k] * wv;
        }
#pragma unroll
        for (int r = 0; r < 5; ++r) red[(wid * 5 + r) * 64 + lane] = acc[r];
        __syncthreads();
        if (tid < 320) { const int r = tid >> 6, cidx = tid & 63; float s = p.b_mod[l * NMOD * D + n0 + cidx];
#pragma unroll
            for (int w = 0; w < 8; ++w) s += red[(w * 5 + r) * 64 + cidx];
            p.mod[(size_t)(l * 5 + r) * (NMOD * D) + n0 + cidx] = s; }
        __syncthreads();
    }
}

__device__ __forceinline__ void norm_mod_store(const float4 (&v)[4], float rinv, const float* g, const float* scp, const float* shp, bf16_t* dst, int lane) {
#pragma unroll
    for (int i = 0; i < 4; ++i) {
        const int cidx = i * 256 + lane * 4;
        const float4 gv = *(const float4*)(g + cidx), sv = *(const float4*)(scp + cidx), hv = *(const float4*)(shp + cidx);
        const float h0 = v[i].x * rinv * gv.x * (1.f + sv.x) + hv.x, h1 = v[i].y * rinv * gv.y * (1.f + sv.y) + hv.y;
        const float h2 = v[i].z * rinv * gv.z * (1.f + sv.z) + hv.z, h3 = v[i].w * rinv * gv.w * (1.f + sv.w) + hv.w;
        u32x2 o; o[0] = pack2(h0, h1); o[1] = pack2(h2, h3);
        *(u32x2*)(dst + cidx) = o;
    }
}
__device__ __forceinline__ void ph_norm1_first(const Params& p) {
    const int tid = opaque_tid(), wid = tid >> 6, lane = tid & 63;
    for (int tok = blockIdx.x * NWAVES + wid; tok < NTOK; tok += gridDim.x * NWAVES) {
        const float* src = tok < NLAT ? p.x + (size_t)tok * D : p.ctx + (size_t)(tok - NLAT) * D;
        float4 v[4]; float ss = 0.f;
#pragma unroll
        for (int i = 0; i < 4; ++i) { v[i] = *(const float4*)(src + i * 256 + lane * 4); ss += v[i].x * v[i].x + v[i].y * v[i].y + v[i].z * v[i].z + v[i].w * v[i].w; }
        ss = wave_sum(ss, lane);
        const float rinv = rsqrtf(ss * (1.0f / D) + 1e-6f);
        const float* mb = p.mod + (size_t)(0 * 5 + tok_modrow(tok)) * (NMOD * D);
        norm_mod_store(v, rinv, p.norm1_g, mb + 1 * D, mb + 0 * D, p.H + (size_t)tok * D, lane);
#pragma unroll
        for (int i = 0; i < 4; ++i) { u32x2 o; o[0] = pack2(v[i].x, v[i].y); o[1] = pack2(v[i].z, v[i].w); *(u32x2*)(p.xl + (size_t)tok * D + i * 256 + lane * 4) = o; }
    }
}

struct EpiP {
    bf16_t* O; bf16_t* gate;
    __device__ __forceinline__ bool keep(const g8::Unit&) const { return false; }
    __device__ __forceinline__ void operator()(const f32x4 (&acc)[2][2][4][2], const g8::Unit& u, int wr, int wc, int fr, int fq, const LAS float*) const {
        if (u.pn < 31) {
            const int row0 = u.pm * 256 + wr * 64 + fr, col0 = u.pn * 256 + wc * 32 + 8 * fq;
#pragma unroll
            for (int ai = 0; ai < 2; ++ai)
#pragma unroll
                for (int m = 0; m < 4; ++m) {
                    bf16_t* rowp = O + (size_t)(row0 + ai * 128 + m * 16) * NP + col0;
#pragma unroll
                    for (int bj = 0; bj < 2; ++bj) {
                        u32x4 w; w[0] = pack2(acc[ai][bj][m][0][0], acc[ai][bj][m][0][1]); w[1] = pack2(acc[ai][bj][m][0][2], acc[ai][bj][m][0][3]);
                        w[2] = pack2(acc[ai][bj][m][1][0], acc[ai][bj][m][1][1]); w[3] = pack2(acc[ai][bj][m][1][2], acc[ai][bj][m][1][3]);
                        *(u32x4*)(rowp + bj * 128) = w;
                    }
                }
        } else {
            const int t = u.pn - 31;
            const int wave2 = wr * 4 + (t & 1) * 2 + (wc >> 1), lane2 = ((wc & 1) * 2 + (fq >> 1)) * 16 + fr, bj2 = (t & 3) >> 1;
            bf16_t* gp = gate + ((((size_t)u.pm * 16 + (t >> 2)) * 8 + wave2) * 16 + bj2) * 512 + lane2 * 8 + (fq & 1) * 4;
#pragma unroll
            for (int ai = 0; ai < 2; ++ai)
#pragma unroll
                for (int m = 0; m < 4; ++m) {
                    float r[4][4];
#pragma unroll
                    for (int j = 0; j < 4; ++j) {
                        float d[4];
#pragma unroll
                        for (int sg = 0; sg < 4; ++sg) d[sg] = 1.0f + __expf(-fminf(fmaxf(acc[ai][sg >> 1][m][sg & 1][j], -30.0f), 30.0f));
#pragma unroll
                        for (int sg = 0; sg < 4; ++sg) { const float gi = __builtin_amdgcn_rcpf(d[sg]); r[sg][j] = sg < 3 ? gi * d[sg + 1] : gi; }
                    }
#pragma unroll
                    for (int sg = 0; sg < 4; ++sg) {
                        uint2 w; w.x = pack2(r[sg][0], r[sg][1]); w.y = pack2(r[sg][2], r[sg][3]);
                        *(uint2*)(gp + (size_t)sg * (4 * 8 * 16 * 512) + (ai * 8 + m * 2) * 512) = w;
                    }
                }
        }
    }
};
__device__ __forceinline__ void ph_g1(const Params& p, int l, LAS unsigned char* lds) {
    g8::PlainSched S; S.init(p.H, p.winT + (size_t)l * NPW * D, NTOK, NPW, D);
    EpiP E; E.O = p.P; E.gate = p.gate;
    g8::gemm_phase(lds, D, S, E);
    if ((int)blockIdx.x >= (NTOK / 256) * (NPW / 256) % 256) { if (l == 0) cvt_fill(p, lds, 2, CW_G1A, CW_SEQ0A - CW_G1A, 0, 0); else cvt_fill(p, lds, 3, CW_G1B, CW_SEQ1 - CW_G1B, 0, 0); }
}

__device__ __forceinline__ void ph_prep(const Params& p, int l, LAS unsigned char* lds) {
    const int tid = opaque_tid(), wid = tid >> 6, lane = tid & 63, fr = lane & 15, fq = lane >> 4;
    LAS float* xs = (LAS float*)lds;
    LAS bf16_t* xb = (LAS bf16_t*)(xs + 64 * 68);
    LAS bf16_t* wt = xb + 64 * 72;
    for (int it = blockIdx.x; it < (NTOK / 64) * 8; it += gridDim.x) {
        const int tile = it >> 3, n = it & 7, tok0 = tile * 64;
        {
            const int tl = tid & 63, cg = tid >> 6, tok = tok0 + tl;
            int t, T, base; tok_info(tok, t, T, base);
            float a[8];
            { const float4 b0 = *(const float4*)(p.lru_conv_b + l * MW + n * 64 + cg * 8), b1 = *(const float4*)(p.lru_conv_b + l * MW + n * 64 + cg * 8 + 4);
              a[0] = b0.x; a[1] = b0.y; a[2] = b0.z; a[3] = b0.w; a[4] = b1.x; a[5] = b1.y; a[6] = b1.z; a[7] = b1.w; }
#pragma unroll
            for (int j = 0; j < 4; ++j) {
                const int tt = t + j - 2;
                const float okf = (tt >= 0 && tt < T) ? 1.0f : 0.0f;
                const int ttc = tt < 0 ? 0 : (tt >= T ? T - 1 : tt);
                const u32x4 u = *(const u32x4*)(p.P + (size_t)(base + ttc) * NP + C_LX + n * 64 + cg * 8);
                const float* w = p.lru_conv_w + (size_t)(l * 4 + j) * MW + n * 64 + cg * 8;
                const float4 wa = *(const float4*)w, wb = *(const float4*)(w + 4);
                const float wv[8] = {wa.x * okf, wa.y * okf, wa.z * okf, wa.w * okf, wb.x * okf, wb.y * okf, wb.z * okf, wb.w * okf};
#pragma unroll
                for (int q = 0; q < 4; ++q) { a[2 * q] += wv[2 * q] * bflo(u[q]); a[2 * q + 1] += wv[2 * q + 1] * bfhi(u[q]); }
            }
            *(LAS f32x4*)(xs + tl * 68 + cg * 8) = (f32x4){a[0], a[1], a[2], a[3]}; *(LAS f32x4*)(xs + tl * 68 + cg * 8 + 4) = (f32x4){a[4], a[5], a[6], a[7]};
            *(LAS u32x4*)(xb + tl * 72 + cg * 8) = pack8(a);
            const bf16_t* wsrc = p.lruT + (size_t)((l * 8 + n) * 4) * 4096;
#pragma unroll
            for (int q = 0; q < 4; ++q) { const int e8 = tid + 512 * q, row = e8 >> 3, c8 = e8 & 7; *(LAS u32x4*)(wt + row * 72 + c8 * 8) = *(const u32x4*)(wsrc + (size_t)e8 * 8); }
        }
        __syncthreads();
        {
            const int jb = wid & 3, tb0 = (wid >> 2) * 2;
            bf16x8 xw[4][2];
#pragma unroll
            for (int m = 0; m < 4; ++m)
#pragma unroll
                for (int ks = 0; ks < 2; ++ks) xw[m][ks] = *(const LAS bf16x8*)(wt + (m * 64 + jb * 16 + fr) * 72 + ks * 32 + fq * 8);
            const int c0 = n * 64 + jb * 16 + 4 * fq;
            float4 bav[2], bxv[2], lsv[2];
#pragma unroll
            for (int d = 0; d < 2; ++d) {
                bav[d] = *(const float4*)(p.lru_ba + (l * 2 + d) * MW + c0); bxv[d] = *(const float4*)(p.lru_bx + (l * 2 + d) * MW + c0);
                lsv[d] = *(const float4*)(p.lsig + (l * 2 + d) * MW + c0);
            }
#pragma unroll
            for (int e = 0; e < 2; ++e) {
                const int tl = (tb0 + e) * 16 + fr, tok = tok0 + tl;
                f32x4 acc[4];
#pragma unroll
                for (int m = 0; m < 4; ++m) acc[m] = (f32x4){0.f, 0.f, 0.f, 0.f};
#pragma unroll
                for (int ks = 0; ks < 2; ++ks) {
                    const bf16x8 y = *(const LAS bf16x8*)(xb + tl * 72 + ks * 32 + fq * 8);
#pragma unroll
                    for (int m = 0; m < 4; ++m) acc[m] = mfma16(xw[m][ks], y, acc[m]);
                }
                const f32x4 xv = *(const LAS f32x4*)(xs + tl * 68 + jb * 16 + 4 * fq);
#pragma unroll
                for (int d = 0; d < 2; ++d) {
                    const float bar_[4] = {bav[d].x, bav[d].y, bav[d].z, bav[d].w}, bxr[4] = {bxv[d].x, bxv[d].y, bxv[d].z, bxv[d].w}, lsr[4] = {lsv[d].x, lsv[d].y, lsv[d].z, lsv[d].w};
                    u32x4 au;
#pragma unroll
                    for (int r = 0; r < 4; ++r) {
                        const float gr = sigmoidf_(acc[d * 2][r] + bar_[r]), gi = sigmoidf_(acc[d * 2 + 1][r] + bxr[r]);
                        const float la = gr * lsr[r];
                        au[r] = pack2(la, xv[r] * gi * __builtin_amdgcn_sqrtf(fmaxf(1.0f - __expf(2.0f * la), 1e-12f)));
                    }
                    *(u32x4*)((unsigned*)p.prep + (size_t)d * TOKW + (size_t)tok * MW + c0) = au;
                }
            }
        }
        __syncthreads();
    }
}

__device__ __forceinline__ int chunk_base(int b, int d, int n) {
    if (n < 4) { const int blk = d ? 3 - n : n; return NLAT + b * TC + blk * 64; }
    const int m = n - 4, blk = d ? 63 - m : m; return b * TL + blk * 64;
}

__device__ __forceinline__ void local_gla(const Params& p, int l, int tz, int chain, int n, LAS unsigned char* lds) {
    const int tid = opaque_tid(), wid = tid >> 6, lane = tid & 63, fr = lane & 15, fq = lane >> 4;
    const int b = chain >> 3, h = (chain >> 1) & 3, d = chain & 1;
    const int base = chunk_base(b, d, n);
    const size_t item = (size_t)tz * NITEM + (size_t)chain * NCHUNK + n;
    LAS bf16_t* qh = (LAS bf16_t*)lds;
    LAS bf16_t* kh = qh + 64 * 136;
    LAS bf16_t* sc = kh + 10 * 16 * 136;
    LAS bf16_t* vT = sc + 64 * 72;
    LAS bf16_t* kT = vT + 128 * 72;
    LAS float* bc = (LAS float*)(kT + 128 * 72);
    const int vcol = tz == 1 ? C_HI : C_RQKV + 1024;
    const int ti = tid >> 3, dg = tid & 7, cA = dg * 8, cB = 64 + dg * 8;
    const int tokI = base + (d ? 63 - ti : ti);
    const bf16_t* pr = p.P + (size_t)tokI * NP;
    float qt[16], kv[16];
    {
        float lfv[16];
        if (tz == 1) {
            float lbv[16];
            {
                const float* lp0 = p.hgrn_lb + (size_t)(0 * 2 + d) * MW + h * 128; const float* lp1 = p.hgrn_lb + (size_t)(1 * 2 + d) * MW + h * 128;
                const float4 a0 = *(const float4*)(lp0 + cA), a1 = *(const float4*)(lp0 + cA + 4), a2 = *(const float4*)(lp0 + cB), a3 = *(const float4*)(lp0 + cB + 4);
                const float4 b0 = *(const float4*)(lp1 + cA), b1 = *(const float4*)(lp1 + cA + 4), b2 = *(const float4*)(lp1 + cB), b3 = *(const float4*)(lp1 + cB + 4);
                const float x0[16] = {a0.x, a0.y, a0.z, a0.w, a1.x, a1.y, a1.z, a1.w, a2.x, a2.y, a2.z, a2.w, a3.x, a3.y, a3.z, a3.w};
                const float x1[16] = {b0.x, b0.y, b0.z, b0.w, b1.x, b1.y, b1.z, b1.w, b2.x, b2.y, b2.z, b2.w, b3.x, b3.y, b3.z, b3.w};
#pragma unroll
                for (int e = 0; e < 16; ++e) lbv[e] = (l == 1) ? fminf(__builtin_amdgcn_rcpf(1.0f + __expf(x0[e] - x1[e])), 1.0f - 1e-4f) : 0.f;
            }
            const u32x4 uqa = *(const u32x4*)(pr + C_HQ + h * 128 + cA), uqb = *(const u32x4*)(pr + C_HQ + h * 128 + cB);
            const u32x4 uza = *(const u32x4*)(pr + C_HF + d * 512 + h * 128 + cA), uzb = *(const u32x4*)(pr + C_HF + d * 512 + h * 128 + cB);
#pragma unroll
            for (int e = 0; e < 16; ++e) {
                const unsigned uq = e < 8 ? uqa[(e & 7) >> 1] : uqb[(e & 7) >> 1], uz = e < 8 ? uza[(e & 7) >> 1] : uzb[(e & 7) >> 1];
                const float qraw = (e & 1) ? bfhi(uq) : bflo(uq), z = (e & 1) ? bfhi(uz) : bflo(uz);
                const float lb = lbv[e];
                const float sg = sigmoidf_(z);
                qt[e] = siluf_(qraw) * 0.08838834764831845f;
                kv[e] = (1.f - lb) * (1.f - sg);
                lfv[e] = __logf(fmaxf(lb + (1.f - lb) * sg, 1e-30f));
            }
        }
        *(LAS f32x4*)(bc + ti * 132 + cA) = (f32x4){lfv[0], lfv[1], lfv[2], lfv[3]}; *(LAS f32x4*)(bc + ti * 132 + cA + 4) = (f32x4){lfv[4], lfv[5], lfv[6], lfv[7]};
        *(LAS f32x4*)(bc + ti * 132 + cB) = (f32x4){lfv[8], lfv[9], lfv[10], lfv[11]}; *(LAS f32x4*)(bc + ti * 132 + cB + 4) = (f32x4){lfv[12], lfv[13], lfv[14], lfv[15]};
        const bf16_t* vp = pr + vcol + h * 128;
        const u32x4 v0 = *(const u32x4*)(vp + cA), v1 = *(const u32x4*)(vp + cB);
#pragma unroll
        for (int e = 0; e < 8; ++e) {
            vT[(cA + e) * 72 + ti] = (bf16_t)((e & 1) ? (v0[e >> 1] >> 16) : (v0[e >> 1] & 0xffffu));
            vT[(cB + e) * 72 + ti] = (bf16_t)((e & 1) ? (v1[e >> 1] >> 16) : (v1[e >> 1] & 0xffffu));
        }
    }
    __syncthreads();
    if (tid < 128) {
        float run = 0.f, lv[64];
#pragma unroll
        for (int i = 0; i < 64; ++i) lv[i] = bc[i * 132 + tid];
#pragma unroll
        for (int i = 0; i < 64; ++i) { run += lv[i]; bc[i * 132 + tid] = run; }
    }
    __syncthreads();
    {
        const int J = ti >> 4;
        float qhat[16];
#pragma unroll
        for (int e = 0; e < 16; ++e) {
            const int ch = e < 8 ? cA + e : cB + e - 8;
            const float bi = bc[ti * 132 + ch], rJ = J ? bc[(16 * J - 1) * 132 + ch] : 0.f, bl = bc[63 * 132 + ch];
            qhat[e] = qt[e] * __expf(bi - rJ); qt[e] = qt[e] * __expf(bi);
            kT[ch * 72 + ti] = (bf16_t)f2bf(kv[e] * __expf(bl - bi));
        }
        *(LAS u32x4*)(qh + ti * 136 + cA) = pack8(qhat); *(LAS u32x4*)(qh + ti * 136 + cB) = pack8(qhat + 8);
#pragma unroll
        for (int I = 0; I < 4; ++I) {
            if (I >= J) {
                float kk[16];
#pragma unroll
                for (int e = 0; e < 16; ++e) {
                    const int ch = e < 8 ? cA + e : cB + e - 8;
                    const float rI = I ? bc[(16 * I - 1) * 132 + ch] : 0.f, bj = bc[ti * 132 + ch];
                    kk[e] = kv[e] * __expf(fminf(rI - bj, 80.f));
                }
                LAS bf16_t* kp = kh + ((I * (I + 1) / 2 + J) * 16 + (ti & 15)) * 136;
                *(LAS u32x4*)(kp + cA) = pack8(kk); *(LAS u32x4*)(kp + cB) = pack8(kk + 8);
            }
        }
        *(LAS u32x4*)(sc + ti * 72 + dg * 8) = (u32x4){0u, 0u, 0u, 0u};
        {
            bf16_t* lqb = p.lq + item * 8192 + (size_t)((ti >> 4) * 8) * 256 + (ti & 15) * 4;
            const u32x4 pa = pack8(qt), pb = pack8(qt + 8);
            u32x2 t0; t0[0] = pa[0]; t0[1] = pa[1]; u32x2 t1; t1[0] = pa[2]; t1[1] = pa[3]; u32x2 t2; t2[0] = pb[0]; t2[1] = pb[1]; u32x2 t3; t3[0] = pb[2]; t3[1] = pb[3];
            *(u32x2*)(lqb + (dg >> 1) * 256 + ((dg & 1) * 2 + 0) * 64) = t0; *(u32x2*)(lqb + (dg >> 1) * 256 + ((dg & 1) * 2 + 1) * 64) = t1;
            *(u32x2*)(lqb + (4 + (dg >> 1)) * 256 + ((dg & 1) * 2 + 0) * 64) = t2; *(u32x2*)(lqb + (4 + (dg >> 1)) * 256 + ((dg & 1) * 2 + 1) * 64) = t3;
        }
    }
    if (tid < 128) p.ld[item * 128 + tid] = __expf(bc[63 * 132 + tid]);
    __syncthreads();
#pragma unroll
    for (int rep2 = 0; rep2 < 2; ++rep2) {
        const int t = wid + 8 * rep2;
        if (t < 10) {
            const int I = t >= 6 ? 3 : t >= 3 ? 2 : t >= 1 ? 1 : 0, J = t - I * (I + 1) / 2;
            f32x4 acc = (f32x4){0.f, 0.f, 0.f, 0.f};
#pragma unroll
            for (int ks = 0; ks < 4; ++ks)
                acc = mfma16(*(const LAS bf16x8*)(kh + (t * 16 + fr) * 136 + ks * 32 + fq * 8), *(const LAS bf16x8*)(qh + (I * 16 + fr) * 136 + ks * 32 + fq * 8), acc);
            const int i = 16 * I + fr, j0 = 16 * J + 4 * fq;
#pragma unroll
            for (int r = 0; r < 4; ++r) if (j0 + r > i) acc[r] = 0.f;
            *(LAS u32x2*)(sc + i * 72 + j0) = pack4(acc);
        }
    }
    __syncthreads();
    {
        bf16x8 xv[2], xk[2];
#pragma unroll
        for (int ks = 0; ks < 2; ++ks) { xv[ks] = *(const LAS bf16x8*)(vT + (wid * 16 + fr) * 72 + ks * 32 + fq * 8); xk[ks] = *(const LAS bf16x8*)(kT + (wid * 16 + fr) * 72 + ks * 32 + fq * 8); }
#pragma unroll
        for (int ib = 0; ib < 4; ++ib) {
            f32x4 acc = (f32x4){0.f, 0.f, 0.f, 0.f};
#pragma unroll
            for (int ks = 0; ks < 2; ++ks) acc = mfma16(xv[ks], *(const LAS bf16x8*)(sc + (ib * 16 + fr) * 72 + ks * 32 + fq * 8), acc);
            *(u32x2*)(p.lo + item * 8192 + ((wid * 4 + ib) * 64 + lane) * 4) = pack4(acc);
        }
#pragma unroll
        for (int dvb = 0; dvb < 8; ++dvb) {
            f32x4 acc = (f32x4){0.f, 0.f, 0.f, 0.f};
#pragma unroll
            for (int ks = 0; ks < 2; ++ks) acc = mfma16(xk[ks], *(const LAS bf16x8*)(vT + (dvb * 16 + fr) * 72 + ks * 32 + fq * 8), acc);
            *(u32x2*)(p.lb + item * 16384 + ((wid * 8 + dvb) * 64 + lane) * 4) = pack4(acc);
        }
    }
    __syncthreads();
}


template <int MODE> __device__ __forceinline__ void local_ret(const Params& p, int l, int chain, int n, LAS unsigned char* lds) {
    const int tid = opaque_tid(), wid = tid >> 6, lane = tid & 63, fr = lane & 15, fq = lane >> 4;
    const int b = chain >> 3, h = (chain >> 1) & 3, d = chain & 1;
    const int base = chunk_base(b, d, n);
    const size_t item = (size_t)2 * NITEM + (size_t)chain * NCHUNK + n;
    LAS bf16_t* ks_ = (LAS bf16_t*)lds;
    LAS bf16_t* qs = ks_ + 64 * 136;
    LAS bf16_t* sc = qs + 64 * 136;
    LAS bf16_t* vT = sc + 64 * 72;
    LAS bf16_t* kT = vT + 128 * 72;
    const int ti = tid >> 3, dg = tid & 7, cA = dg * 8, cB = 64 + dg * 8;
    const int tokI = base + (d ? 63 - ti : ti);
    const bf16_t* pr = p.P + (size_t)tokI * NP + C_RQKV + h * 128;
    const float lng = ret_log_gamma(h);
    {
        const u32x4 q1 = *(const u32x4*)(pr + cA), q2 = *(const u32x4*)(pr + cB), k1 = *(const u32x4*)(pr + 512 + cA), k2 = *(const u32x4*)(pr + 512 + cB);
        const u32x4 v0 = *(const u32x4*)(pr + 1024 + cA), v1 = *(const u32x4*)(pr + 1024 + cB);
        const bool lat = tokI < NLAT;
        const int t = tokI & (TL - 1);
        float qv[16], kv[16];
#pragma unroll
        for (int e = 0; e < 8; ++e) {
            float a1 = (e & 1) ? bfhi(q1[e >> 1]) : bflo(q1[e >> 1]), a2 = (e & 1) ? bfhi(q2[e >> 1]) : bflo(q2[e >> 1]);
            float b1 = (e & 1) ? bfhi(k1[e >> 1]) : bflo(k1[e >> 1]), b2 = (e & 1) ? bfhi(k2[e >> 1]) : bflo(k2[e >> 1]);
            {
                const float2 cst = p.rope[(size_t)t * 64 + cA + e];
                const float cs = lat ? cst.x : 1.0f, sn = lat ? cst.y : 0.0f;
                const float n1 = a1 * cs - a2 * sn, n2 = a1 * sn + a2 * cs, m1 = b1 * cs - b2 * sn, m2 = b1 * sn + b2 * cs;
                a1 = n1; a2 = n2; b1 = m1; b2 = m2;
            }
            qv[e] = a1; qv[8 + e] = a2; kv[e] = b1 * 0.08838834764831845f; kv[8 + e] = b2 * 0.08838834764831845f;
        }
        *(LAS u32x4*)(ks_ + ti * 136 + cA) = pack8(kv); *(LAS u32x4*)(ks_ + ti * 136 + cB) = pack8(kv + 8);
        *(LAS u32x4*)(qs + ti * 136 + cA) = pack8(qv); *(LAS u32x4*)(qs + ti * 136 + cB) = pack8(qv + 8);
        const float gq = __expf((float)(ti + 1) * lng), gk = __expf((float)(63 - ti) * lng);
#pragma unroll
        for (int e = 0; e < 8; ++e) {
            vT[(cA + e) * 72 + ti] = (bf16_t)((e & 1) ? (v0[e >> 1] >> 16) : (v0[e >> 1] & 0xffffu));
            vT[(cB + e) * 72 + ti] = (bf16_t)((e & 1) ? (v1[e >> 1] >> 16) : (v1[e >> 1] & 0xffffu));
            kT[(cA + e) * 72 + ti] = (bf16_t)f2bf(kv[e] * gk); kT[(cB + e) * 72 + ti] = (bf16_t)f2bf(kv[8 + e] * gk);
            qv[e] *= gq; qv[8 + e] *= gq;
        }
        {
            bf16_t* lqb = p.lq + item * 8192 + (size_t)((ti >> 4) * 8) * 256 + (ti & 15) * 4;
            const u32x4 pa = pack8(qv), pb = pack8(qv + 8);
            u32x2 t0; t0[0] = pa[0]; t0[1] = pa[1]; u32x2 t1; t1[0] = pa[2]; t1[1] = pa[3]; u32x2 t2; t2[0] = pb[0]; t2[1] = pb[1]; u32x2 t3; t3[0] = pb[2]; t3[1] = pb[3];
            *(u32x2*)(lqb + (dg >> 1) * 256 + ((dg & 1) * 2 + 0) * 64) = t0; *(u32x2*)(lqb + (dg >> 1) * 256 + ((dg & 1) * 2 + 1) * 64) = t1;
            *(u32x2*)(lqb + (4 + (dg >> 1)) * 256 + ((dg & 1) * 2 + 0) * 64) = t2; *(u32x2*)(lqb + (4 + (dg >> 1)) * 256 + ((dg & 1) * 2 + 1) * 64) = t3;
        }
    }
    if (tid < 128) p.ld[item * 128 + tid] = __expf(64.0f * lng);
    __syncthreads();
#pragma unroll
    for (int e = 0; e < 2; ++e) {
        const int f = wid * 2 + e, ib = f >> 2, jb = f & 3;
        const int i = 16 * ib + fr, j0 = 16 * jb + 4 * fq;
        f32x4 mq = (f32x4){0.f, 0.f, 0.f, 0.f};
        if (jb <= ib) {
#pragma unroll
            for (int ks = 0; ks < 4; ++ks)
                mq = mfma16(*(const LAS bf16x8*)(ks_ + (jb * 16 + fr) * 136 + ks * 32 + fq * 8), *(const LAS bf16x8*)(qs + i * 136 + ks * 32 + fq * 8), mq);
#pragma unroll
            for (int r = 0; r < 4; ++r) { const int j = j0 + r; mq[r] = (j <= i) ? mq[r] * __expf((float)(i - j) * lng) : 0.f; }
        }
        *(LAS u32x2*)(sc + i * 72 + j0) = pack4(mq);
    }
    __syncthreads();
    {
        bf16x8 xv[2], xk[2];
#pragma unroll
        for (int ks = 0; ks < 2; ++ks) { xv[ks] = *(const LAS bf16x8*)(vT + (wid * 16 + fr) * 72 + ks * 32 + fq * 8); xk[ks] = *(const LAS bf16x8*)(kT + (wid * 16 + fr) * 72 + ks * 32 + fq * 8); }
#pragma unroll
        for (int ib = 0; ib < 4; ++ib) {
            f32x4 acc = (f32x4){0.f, 0.f, 0.f, 0.f};
#pragma unroll
            for (int ks = 0; ks < 2; ++ks) acc = mfma16(xv[ks], *(const LAS bf16x8*)(sc + (ib * 16 + fr) * 72 + ks * 32 + fq * 8), acc);
            *(u32x2*)(p.lo + item * 8192 + ((wid * 4 + ib) * 64 + lane) * 4) = pack4(acc);
        }
#pragma unroll
        for (int dvb = 0; dvb < 8; ++dvb) {
            f32x4 acc = (f32x4){0.f, 0.f, 0.f, 0.f};
#pragma unroll
            for (int ks = 0; ks < 2; ++ks) acc = mfma16(xk[ks], *(const LAS bf16x8*)(vT + (dvb * 16 + fr) * 72 + ks * 32 + fq * 8), acc);
            *(u32x2*)(p.lb + item * 16384 + ((wid * 8 + dvb) * 64 + lane) * 4) = pack4(acc);
        }
    }
    __syncthreads();
}

__device__ __forceinline__ void local_gdn(const Params& p, int l, int bh, int seg, int blk, LAS unsigned char* lds) {
    const int tid = opaque_tid(), wid = tid >> 6, lane = tid & 63, fr = lane & 15, fq = lane >> 4;
    const int b = bh >> 2, h = bh & 3;
    const int base = seg ? b * TL + blk * 64 : NLAT + b * TC + blk * 64;
    LAS bf16_t* ks_ = (LAS bf16_t*)lds;
    LAS bf16_t* qs = ks_ + 64 * 136;
    LAS bf16_t* att = qs + 64 * 136;
    LAS bf16_t* wT = att + 64 * 72;
    LAS bf16_t* uT = wT + 128 * 72;
    LAS bf16_t* kT = uT + 128 * 72;
    LAS bf16_t* tT = kT;
    LAS bf16_t* Mneg = kT + 128 * 72;
    LAS float* Md = (LAS float*)(Mneg + 64 * 72);
    LAS float* bcs = (LAS float*)(kT + 128 * 72) + 64 * 68;
    LAS float* bts = bcs + 64;
    LAS float* rse = bts + 64;
    LAS bf16_t* vs = (LAS bf16_t*)(rse + 64);
    LAS bf16_t* Db = (LAS bf16_t*)(vs + 64 * 136);
    LAS float* cw = (LAS float*)(vs + 64 * 136);
    const int ti = tid >> 3, d0 = (tid & 7) * 16;
    const int tokI = base + ti;
    {
        int t, T, sbase; tok_info(tokI, t, T, sbase);
        u32x4 xr[3][4][2];
#pragma unroll
        for (int j = 0; j < 4; ++j) {
            const int tt = t + j - 2;
            const bool ok = (tt >= 0 && tt < T);
            const int ttc = tt < 0 ? 0 : (tt >= T ? T - 1 : tt);
            const bf16_t* xp = p.P + (size_t)(sbase + ttc) * NP + C_GQKV + h * 128 + d0;
#pragma unroll
            for (int part = 0; part < 3; ++part) {
                const u32x4 a0 = *(const u32x4*)(xp + part * 512), a1 = *(const u32x4*)(xp + part * 512 + 8);
#pragma unroll
                for (int q = 0; q < 4; ++q) { xr[part][j][0][q] = ok ? a0[q] : 0u; xr[part][j][1][q] = ok ? a1[q] : 0u; }
            }
        }
        if (tid < 384) {
            const int row = tid >> 5, c4 = (tid & 31) * 4, part = row >> 2, j = row & 3;
            *(LAS f32x4*)(cw + row * 128 + c4) = *(const f32x4*)(p.gdn_conv_w + (size_t)(l * 4 + j) * 1536 + part * 512 + h * 128 + c4);
        }
        __syncthreads();
#pragma unroll
        for (int part = 0; part < 3; ++part) {
            float a[16];
#pragma unroll
            for (int e = 0; e < 16; ++e) a[e] = 0.f;
#pragma unroll
            for (int j = 0; j < 4; ++j) {
                const u32x4 x0 = xr[part][j][0], x1 = xr[part][j][1];
                const LAS float* wp = cw + (part * 4 + j) * 128 + d0;
#pragma unroll
                for (int q = 0; q < 4; ++q) {
                    const f32x4 w0 = *(const LAS f32x4*)(wp + q * 4);
                    const unsigned ua = q < 2 ? x0[2 * q] : x1[2 * q - 4], ub = q < 2 ? x0[2 * q + 1] : x1[2 * q - 3];
                    a[q * 4] += w0[0] * bflo(ua); a[q * 4 + 1] += w0[1] * bfhi(ua); a[q * 4 + 2] += w0[2] * bflo(ub); a[q * 4 + 3] += w0[3] * bfhi(ub);
                }
            }
            float ss = 0.f;
#pragma unroll
            for (int e = 0; e < 16; ++e) { a[e] = siluf_(a[e]); ss += a[e] * a[e]; }
            if (part < 2) {
                ss += shx(ss, 1, lane); ss += shx(ss, 2, lane); ss += shx(ss, 4, lane);
                const float scl = rsqrtf(ss + 1e-6f) * (part == 0 ? 0.08838834764831845f : 1.0f);
#pragma unroll
                for (int e = 0; e < 16; ++e) a[e] *= scl;
            }
            LAS bf16_t* dstt = (part == 0 ? qs : part == 1 ? ks_ : vs) + ti * 136 + d0;
            *(LAS u32x4*)dstt = pack8(a); *(LAS u32x4*)(dstt + 8) = pack8(a + 8);
        }
    }
#pragma unroll 1
  for (int d = 0; d < 2; ++d) {
    const int n = seg ? 4 + (d ? 63 - blk : blk) : (d ? 3 - blk : blk);
    const size_t item = (size_t)(bh * 2 + d) * NCHUNK + n;
#define RR(x) (d ? 63 - (x) : (x))
    const int tid = opaque_tid(), wid = tid >> 6, lane = tid & 63, fr = lane & 15, fq = lane >> 4, ti = tid >> 3, d0 = (tid & 7) * 16;
    if (wid == 0) {
        const int tok = base + RR(lane);
        const float av = bf2f(p.P[(size_t)tok * NP + C_GA + d * 4 + h]);
        float v = -__expf(p.gdn_a_log[l * 8 + d * 4 + h]) * softplusf_(av + p.gdn_dt_bias[l * 8 + d * 4 + h]);
#pragma unroll
        for (int off = 1; off < 64; off <<= 1) { const float t = shup(v, off, lane); if (lane >= off) v += t; }
        const float btv = sigmoidf_(bf2f(p.P[(size_t)tok * NP + C_GB + d * 4 + h]));
        bcs[lane] = v; bts[lane] = btv; rse[lane] = btv * __expf(v);
    }
    __syncthreads();
#pragma unroll
    for (int e = 0; e < 2; ++e) {
        const int f = wid * 2 + e, ib = f >> 2, jb = f & 3;
        const int i = 16 * ib + fr, j0 = 16 * jb + 4 * fq;
        f32x4 mk = (f32x4){0.f, 0.f, 0.f, 0.f}, mq = (f32x4){0.f, 0.f, 0.f, 0.f};
        if (jb <= ib) {
#pragma unroll
            for (int ks = 0; ks < 4; ++ks) {
                const bf16x8 xk = *(const LAS bf16x8*)(ks_ + RR(jb * 16 + fr) * 136 + ks * 32 + fq * 8);
                mk = mfma16(xk, *(const LAS bf16x8*)(ks_ + RR(ib * 16 + fr) * 136 + ks * 32 + fq * 8), mk);
                mq = mfma16(xk, *(const LAS bf16x8*)(qs + RR(ib * 16 + fr) * 136 + ks * 32 + fq * 8), mq);
            }
            const float bi = bcs[i], bti = bts[i];
#pragma unroll
            for (int r = 0; r < 4; ++r) {
                const int j = j0 + r;
                const float dec = __expf(j <= i ? bi - bcs[j] : 0.f);
                mk[r] = (j < i) ? bti * mk[r] * dec : 0.f;
                mq[r] = (j <= i) ? mq[r] * dec : 0.f;
            }
        }
        {
            u32x2 mn; mn[0] = 0u; mn[1] = 0u;
            if (jb < ib) mn = pack4((f32x4){-mk[0], -mk[1], -mk[2], -mk[3]});
            *(LAS u32x2*)(Mneg + i * 72 + j0) = mn;
            if (jb == ib) *(LAS f32x4*)(Md + (ib * 16 + fr) * 20 + 4 * fq) = mk;
        }
        *(LAS u32x2*)(att + i * 72 + j0) = pack4(mq);
        if (e == 0) {
            const int zr = tid >> 1, zh = tid & 1;
            LAS bf16_t* zx = (zr < 128 ? uT + zr * 72 : wT + (zr - 128) * 72) + zh * 32;
#pragma unroll
            for (int q = 0; q < 4; ++q) *(LAS u32x4*)(zx + q * 8) = (u32x4){0u, 0u, 0u, 0u};
            *(LAS u32x4*)(tT + zr * 32 + 16 + zh * 8) = (u32x4){0u, 0u, 0u, 0u};
        }
    }
    __syncthreads();
    if (wid == 0) {
        const int R = lane >> 4, cc = lane & 15;
        float y[16];
#pragma unroll
        for (int i = 0; i < 16; ++i) {
            float acc = (i == cc) ? 1.0f : 0.0f;
#pragma unroll
            for (int j4 = 0; j4 < (i + 3) / 4; ++j4) {
                const f32x4 m = *(const LAS f32x4*)(Md + (R * 16 + i) * 20 + j4 * 4);
#pragma unroll
                for (int q = 0; q < 4; ++q) if (j4 * 4 + q < i) acc -= m[q] * y[j4 * 4 + q];
            }
            y[i] = acc;
            Db[(R * 16 + i) * 40 + cc] = (bf16_t)f2bf(acc);
        }
        *(LAS u32x4*)(Db + lane * 40 + 16) = (u32x4){0u, 0u, 0u, 0u}; *(LAS u32x4*)(Db + lane * 40 + 24) = (u32x4){0u, 0u, 0u, 0u};
    }
    __syncthreads();
#pragma unroll
    for (int R = 0; R < 4; ++R) {
        f32x4 tacc[2];
#pragma unroll
        for (int e = 0; e < 2; ++e) {
            const int cb = wid * 2 + e;
            const int i = 16 * R + fr;
            const u32x2 rv = *(const LAS u32x2*)((cb < 8 ? vs + cb * 16 : ks_ + (cb - 8) * 16) + RR(i) * 136 + 4 * fq);
            const float sc = cb < 8 ? bts[i] : -rse[i];
            f32x4 acc = (f32x4){bflo(rv[0]) * sc, bfhi(rv[0]) * sc, bflo(rv[1]) * sc, bfhi(rv[1]) * sc};
            if (R > 0) {
                const LAS bf16_t* xt = (cb < 8 ? uT + cb * 16 * 72 : wT + (cb - 8) * 16 * 72) + fr * 72 + fq * 8;
#pragma unroll
                for (int ks = 0; ks < (R + 1) / 2; ++ks) acc = mfma16(*(const LAS bf16x8*)(xt + ks * 32), *(const LAS bf16x8*)(Mneg + i * 72 + ks * 32 + fq * 8), acc);
            }
            tacc[e] = acc;
            LAS bf16_t* tp = tT + (cb * 16 + 4 * fq) * 32 + fr;
            tp[0] = (bf16_t)f2bf(acc[0]); tp[32] = (bf16_t)f2bf(acc[1]); tp[64] = (bf16_t)f2bf(acc[2]); tp[96] = (bf16_t)f2bf(acc[3]);
        }
        __syncthreads();
#pragma unroll
        for (int e = 0; e < 2; ++e) {
            const int cb = wid * 2 + e;
            f32x4 acc = (f32x4){0.f, 0.f, 0.f, 0.f};
            acc = mfma16(*(const LAS bf16x8*)(tT + (cb * 16 + fr) * 32 + fq * 8), *(const LAS bf16x8*)(Db + (R * 16 + fr) * 40 + fq * 8), acc);
            LAS bf16_t* xp = (cb < 8 ? uT + cb * 16 * 72 : wT + (cb - 8) * 16 * 72) + (4 * fq) * 72 + 16 * R + fr;
            xp[0] = (bf16_t)f2bf(acc[0]); xp[72] = (bf16_t)f2bf(acc[1]); xp[144] = (bf16_t)f2bf(acc[2]); xp[216] = (bf16_t)f2bf(acc[3]);
        }
        __syncthreads();
    }
    {
        const int pi = RR(ti);
        const float sc_ = __expf(bcs[63] - bcs[pi]);
#pragma unroll
        for (int e = 0; e < 16; ++e) kT[(d0 + e) * 72 + pi] = (bf16_t)f2bf(bf2f(ks_[ti * 136 + d0 + e]) * sc_);
    }
    if (tid < 128) p.ld[item * 128 + tid] = __expf(bcs[63]);
    __syncthreads();
    {
        const int tid = opaque_tid(), wid = tid >> 6, lane = tid & 63, fr = lane & 15, fq = lane >> 4;
        bf16x8 xw[2], xu[2], xk[2];
#pragma unroll
        for (int ks = 0; ks < 2; ++ks) {
            xw[ks] = *(const LAS bf16x8*)(wT + (wid * 16 + fr) * 72 + ks * 32 + fq * 8);
            xu[ks] = *(const LAS bf16x8*)(uT + (wid * 16 + fr) * 72 + ks * 32 + fq * 8);
            xk[ks] = *(const LAS bf16x8*)(kT + (wid * 16 + fr) * 72 + ks * 32 + fq * 8);
        }
#pragma unroll
        for (int ib = 0; ib < 4; ++ib) {
            const int i = ib * 16 + fr;
            const u32x2 qr = *(const LAS u32x2*)(qs + RR(i) * 136 + wid * 16 + 4 * fq);
            const float eb = __expf(bcs[i]);
            f32x4 aq = (f32x4){bflo(qr[0]) * eb, bfhi(qr[0]) * eb, bflo(qr[1]) * eb, bfhi(qr[1]) * eb};
            f32x4 ao = (f32x4){0.f, 0.f, 0.f, 0.f};
#pragma unroll
            for (int ks = 0; ks < 2; ++ks) {
                const bf16x8 ya = *(const LAS bf16x8*)(att + i * 72 + ks * 32 + fq * 8);
                aq = mfma16(xw[ks], ya, aq); ao = mfma16(xu[ks], ya, ao);
            }
            *(u32x2*)(p.lq + item * 8192 + ((ib * 8 + wid) * 64 + lane) * 4) = pack4(aq);
            *(u32x2*)(p.lo + item * 8192 + ((wid * 4 + ib) * 64 + lane) * 4) = pack4(ao);
        }
#pragma unroll
        for (int db = 0; db < 8; ++db) {
            f32x4 aa = (f32x4){0.f, 0.f, 0.f, 0.f}, ab = (f32x4){0.f, 0.f, 0.f, 0.f};
#pragma unroll
            for (int ks = 0; ks < 2; ++ks) {
                aa = mfma16(xw[ks], *(const LAS bf16x8*)(kT + (db * 16 + fr) * 72 + ks * 32 + fq * 8), aa);
                ab = mfma16(xk[ks], *(const LAS bf16x8*)(uT + (db * 16 + fr) * 72 + ks * 32 + fq * 8), ab);
            }
            *(u32x2*)(p.la + item * 16384 + ((db * 8 + wid) * 64 + lane) * 4) = pack4(aa);
            *(u32x2*)(p.lb + item * 16384 + ((wid * 8 + db) * 64 + lane) * 4) = pack4(ab);
        }
    }
    __syncthreads();
  }
#undef RR
}

__device__ __forceinline__ void ph_local(const Params& p, int l, LAS unsigned char* lds) {
    constexpr int NG = NITEM / 2;
    for (int it = blockIdx.x; it < NG + 2 * NITEM; it += gridDim.x) {
        if (it < NG) { const int bh = it / NCHUNK, c = it % NCHUNK; local_gdn(p, l, bh, c >= 4, c >= 4 ? c - 4 : c, lds); }
        else if (it < NG + NITEM) { const int idx = it - NG; local_gla(p, l, 1, idx / NCHUNK, idx % NCHUNK, lds); }
        else { const int idx = it - NG - NITEM; local_ret<0>(p, l, idx / NCHUNK, idx % NCHUNK, lds); }
    }
}

__device__ __forceinline__ void seq_matrix(const Params& p, int tz, int chain, int half, LAS unsigned char* lds) {
    const int tid = opaque_tid(), wid = tid >> 6, lane = tid & 63, fr = lane & 15, fq = lane >> 4;
    const int b = chain >> 3, h = (chain >> 1) & 3, d = chain & 1;
    LAS bf16_t* ST = (LAS bf16_t*)lds;
    bf16_t* Op = p.O + (size_t)((tz == 0 ? 0 : tz == 1 ? 1 : 3) * 2 + d) * TOKW;
    f32x4 S[4];
#pragma unroll
    for (int q = 0; q < 4; ++q) S[q] = (f32x4){0.f, 0.f, 0.f, 0.f};
    const int ib = wid >> 1, dv2 = (wid & 1) * 2;
    struct Ops { u32x2 yq[8], xa[8], oin[2], bin[4]; f32x4 dec; };
    auto load_ops = [&](int n, Ops& o) {
        const size_t item = (size_t)tz * NITEM + (size_t)chain * NCHUNK + n;
        const bf16_t* lqp = p.lq + item * 8192 + (size_t)(ib * 8) * 256 + lane * 4;
#pragma unroll
        for (int q = 0; q < 8; ++q) o.yq[q] = *(const u32x2*)(lqp + q * 256);
        if (tz == 0) {
            const bf16_t* lap = p.la + ((size_t)chain * NCHUNK + n) * 16384 + (size_t)(wid * 8) * 256 + lane * 4;
#pragma unroll
            for (int q = 0; q < 8; ++q) o.xa[q] = *(const u32x2*)(lap + q * 256);
        }
#pragma unroll
        for (int e2 = 0; e2 < 2; ++e2)
            o.oin[e2] = *(const u32x2*)(p.lo + item * 8192 + (((half * 4 + dv2 + (fq >> 1)) * 4 + ib) * 64 + fr + 16 * (2 * (fq & 1) + e2)) * 4);
#pragma unroll
        for (int q = 0; q < 4; ++q) o.bin[q] = *(const u32x2*)(p.lb + item * 16384 + ((wid * 8 + half * 4 + q) * 64 + lane) * 4);
        o.dec = *(const f32x4*)(p.ld + item * 128 + wid * 16 + 4 * fq);
    };
    Ops s0, s1; load_ops(0, s0);
    auto step = [&](int n, Ops& cur, Ops& fill) {
        load_ops(n + 1 < NCHUNK ? n + 1 : n, fill);
        LAS bf16_t* st = ST + (n & 1) * 64 * 136;
#pragma unroll
        for (int q = 0; q < 4; ++q) *(LAS u32x2*)(st + (q * 16 + fr) * 136 + 32 * (wid >> 1) + 8 * fq + 4 * (wid & 1)) = pack4(S[q]);
        __syncthreads();
        const int base = chunk_base(b, d, n);
        const int tok = base + (d ? 63 - (ib * 16 + fr) : ib * 16 + fr);
        {
            bf16x8 xo[2][4];
#pragma unroll
            for (int e2 = 0; e2 < 2; ++e2) {
                const int prow = dv2 * 16 + 8 * (fr >> 2) + 4 * e2 + (fr & 3);
#pragma unroll
                for (int ks = 0; ks < 4; ++ks) xo[e2][ks] = *(const LAS bf16x8*)(st + prow * 136 + ks * 32 + fq * 8);
            }
            asm volatile("s_waitcnt lgkmcnt(0)" ::: "memory");
            f32x4 ao[2];
#pragma unroll
            for (int e2 = 0; e2 < 2; ++e2) {
                f32x4 acc = (f32x4){bflo(cur.oin[e2][0]), bfhi(cur.oin[e2][0]), bflo(cur.oin[e2][1]), bfhi(cur.oin[e2][1])};
#pragma unroll
                for (int ks = 0; ks < 4; ++ks) {
                    u32x4 t; t[0] = cur.yq[2 * ks][0]; t[1] = cur.yq[2 * ks][1]; t[2] = cur.yq[2 * ks + 1][0]; t[3] = cur.yq[2 * ks + 1][1];
                    acc = mfma16(xo[e2][ks], __builtin_bit_cast(bf16x8, t), acc);
                }
                ao[e2] = acc;
            }
            bf16_t* op = Op + (size_t)tok * MW + h * 128 + half * 64 + dv2 * 16 + 8 * fq;
            { u32x4 w; w[0] = pack2(ao[0][0], ao[0][1]); w[1] = pack2(ao[0][2], ao[0][3]); w[2] = pack2(ao[1][0], ao[1][1]); w[3] = pack2(ao[1][2], ao[1][3]); *(u32x4*)op = w; }
#pragma unroll
            for (int qh = 0; qh < 2; ++qh) {
                bf16x8 xs[2][4];
                if (tz == 0) {
#pragma unroll
                    for (int q2 = 0; q2 < 2; ++q2)
#pragma unroll
                        for (int ks = 0; ks < 4; ++ks) xs[q2][ks] = *(const LAS bf16x8*)(st + ((qh * 2 + q2) * 16 + fr) * 136 + ks * 32 + fq * 8);
                    asm volatile("s_waitcnt lgkmcnt(0)" ::: "memory");
                }
#pragma unroll
                for (int q2 = 0; q2 < 2; ++q2) {
                    const int q = qh * 2 + q2;
                    f32x4 acc = (f32x4){cur.dec[0] * S[q][0] + bflo(cur.bin[q][0]), cur.dec[1] * S[q][1] + bfhi(cur.bin[q][0]), cur.dec[2] * S[q][2] + bflo(cur.bin[q][1]), cur.dec[3] * S[q][3] + bfhi(cur.bin[q][1])};
                    if (tz == 0) {
#pragma unroll
                        for (int ks = 0; ks < 4; ++ks) {
                            u32x4 t; t[0] = cur.xa[2 * ks][0]; t[1] = cur.xa[2 * ks][1]; t[2] = cur.xa[2 * ks + 1][0]; t[3] = cur.xa[2 * ks + 1][1];
                            acc = mfma16(__builtin_bit_cast(bf16x8, t), xs[q2][ks], acc);
                        }
                    }
                    S[q] = acc;
                }
            }
        }
    };
    for (int n = 0; n < NCHUNK; n += 2) {
        step(n, s0, s1);
        step(n + 1, s1, s0);
    }
    __syncthreads();
}

__device__ __forceinline__ void seq_lru(const Params& p, int b, int d, int cg, LAS unsigned char* lds) {
    const int tid = opaque_tid(), seg = tid >> 6, ch = cg * 64 + (tid & 63);
    LAS float* sP = (LAS float*)lds;
    LAS float* sL = sP + 512;
    const unsigned* AU = (const unsigned*)p.prep + (size_t)d * TOKW + ch;
    bf16_t* Op = p.O + (size_t)(2 * 2 + d) * TOKW + ch;
    constexpr int SEG = (TC + TL) / 8;
    auto tok_of = [&](int pos) { return pos < TC ? NLAT + b * TC + (d ? TC - 1 - pos : pos) : b * TL + (d ? TL - 1 - (pos - TC) : pos - TC); };
    float P = 1.f, L = 0.f;
    for (int i0 = 0; i0 < SEG; i0 += 32) {
        unsigned wv[32];
#pragma unroll
        for (int q = 0; q < 32; ++q) wv[q] = AU[(size_t)tok_of(seg * SEG + i0 + q) * MW];
#pragma unroll
        for (int q = 0; q < 32; ++q) { const float a = __expf(bflo(wv[q])); L = a * L + bfhi(wv[q]); P *= a; }
    }
    sP[tid] = P; sL[tid] = L;
    __syncthreads();
    float hst = 0.f;
    for (int s = 0; s < seg; ++s) hst = sP[s * 64 + (tid & 63)] * hst + sL[s * 64 + (tid & 63)];
    for (int i0 = 0; i0 < SEG; i0 += 32) {
        unsigned wv[32];
#pragma unroll
        for (int q = 0; q < 32; ++q) wv[q] = AU[(size_t)tok_of(seg * SEG + i0 + q) * MW];
#pragma unroll
        for (int q = 0; q < 32; ++q) { hst = __expf(bflo(wv[q])) * hst + bfhi(wv[q]); Op[(size_t)tok_of(seg * SEG + i0 + q) * MW] = (bf16_t)f2bf(hst); }
    }
    __syncthreads();
}

__device__ __forceinline__ void ph_seq(const Params& p, int l, LAS unsigned char* lds) {
    for (int it = blockIdx.x; it < 256; it += gridDim.x) {
        if (it < 192) { const int tz = it >> 6, r = it & 63; seq_matrix(p, tz, (r & 7) | ((r >> 4) << 3), (r >> 3) & 1, lds); }
        else { const int r = it - 192; seq_lru(p, r >> 4, (r >> 3) & 1, r & 7, lds); }
    }
    if (l == 0) cvt_fill(p, lds, 0, CW_SEQ0A, CW_G2 - CW_SEQ0A, CW_SEQ0B, CW_G1B - CW_SEQ0B); else cvt_fill(p, lds, 1, CW_SEQ1, CVT_G_ALL - CW_SEQ1, 0, 0);
}

__device__ __forceinline__ void ph_merge(const Params& p, int l, int M) {
    const int tid = opaque_tid(), wid = tid >> 6, lane = tid & 63;
    const bf16_t* Ob = opaque_sptr(p.O); const bf16_t* Pb = opaque_sptr(p.P); bf16_t* Yb = opaque_sptr(p.Y);
    float2 gn[3];
#pragma unroll
    for (int m = 0; m < 3; ++m) gn[m] = *(const float2*)((m == 0 ? p.gdn_norm_g : m == 1 ? p.hgrn_norm_g : p.ret_norm_g) + l * 128 + lane * 2);
    for (int tok = blockIdx.x * NWAVES + wid; tok < M; tok += gridDim.x * NWAVES) {
        unsigned o0[16], o1[16], gz[16];
#pragma unroll
        for (int r = 0; r < 16; ++r) {
            const int m = r >> 2, head = r & 3, cidx = head * 128 + lane * 2;
            const size_t o = (size_t)tok * MW + cidx;
            o0[r] = *(const unsigned*)(Ob + (size_t)(m * 2) * TOKW + o); o1[r] = *(const unsigned*)(Ob + (size_t)(m * 2 + 1) * TOKW + o);
            const int zc = m == 0 ? C_GZ : m == 1 ? C_HG : m == 2 ? C_LY : C_RG;
            gz[r] = *(const unsigned*)(Pb + (size_t)tok * NP + zc + cidx);
        }
        float a0[16], a1[16], ss[16];
#pragma unroll
        for (int r = 0; r < 16; ++r) { a0[r] = bflo(o0[r]) + bflo(o1[r]); a1[r] = bfhi(o0[r]) + bfhi(o1[r]); ss[r] = a0[r] * a0[r] + a1[r] * a1[r]; }
#pragma unroll
        for (int msk = 32; msk >= 1; msk >>= 1)
#pragma unroll
            for (int r = 0; r < 16; ++r) if ((r >> 2) != 2) ss[r] += shx(ss[r], msk, lane);
#pragma unroll
        for (int r = 0; r < 16; ++r) {
            const int m = r >> 2, head = r & 3, cidx = head * 128 + lane * 2;
            float y0, y1; int nbr;
            if (m == 2) { y0 = a0[r] * gelu_tanhf_(bflo(gz[r])); y1 = a1[r] * gelu_tanhf_(bfhi(gz[r])); nbr = 2; }
            else {
                const float rinv = rsqrtf(ss[r] * (1.0f / 128.0f) + 1e-6f);
                const float2 g = gn[m == 3 ? 2 : m];
                y0 = a0[r] * rinv * g.x * siluf_(bflo(gz[r])); y1 = a1[r] * rinv * g.y * siluf_(bfhi(gz[r])); nbr = m == 3 ? 3 : m;
            }
            *(unsigned*)(Yb + (size_t)nbr * TOKW + (size_t)tok * MW + cidx) = pack2(y0, y1);
        }
    }
}

struct G2Sched {
    const bf16_t* Y; const bf16_t* Wb; int ntiles, G, c;
    static constexpr bool HAS_BIAS = false, gather = false;
    __device__ __forceinline__ bool next(int i, g8::Unit& u) const {
        const int r = i >> 2, tile = (r == 0 && G == 256) ? (c & 7) * 32 + (c >> 3) : r * G + c; if (tile >= ntiles) return false;
        u.pm = tile >> 2; u.pn = tile & 3; u.e = i & 3; return true;
    }
    __device__ __forceinline__ const char* a_base(const g8::Unit& u) const { return (const char*)(Y + (size_t)u.e * TOKW + (size_t)u.pm * 256 * MW); }
    __device__ __forceinline__ const char* b_base(const g8::Unit& u) const { return (const char*)(Wb + (size_t)u.e * D * MW + (size_t)u.pn * 256 * MW); }
    __device__ __forceinline__ const int* row_addr(const g8::Unit&, int) const { return nullptr; }
    __device__ __forceinline__ int rows_valid(const g8::Unit&) const { return 256; }
    __device__ __forceinline__ const float* bias_src(const g8::Unit&, int) const { return nullptr; }
};
struct EpiMix {
    const bf16_t* gate; bf16_t* O;
    __device__ __forceinline__ bool keep(const g8::Unit& u) const { return u.e < 3; }
    __device__ __forceinline__ void operator()(f32x4 (&acc)[2][2][4][2], const g8::Unit& u, int wr, int wc, int fr, int fq, const LAS float*) const {
        const int row0 = u.pm * 256 + wr * 64 + fr, col0 = u.pn * 256 + wc * 32 + 8 * fq;
        const bool lastseg = u.e == 3;
        const bf16_t* gc = gate + ((((size_t)u.pm * 16 + u.e * 4 + u.pn) * 8 + (wr * 4 + wc)) * 16) * 512 + (fq * 16 + fr) * 8;
#pragma unroll
        for (int ah = 0; ah < 2; ++ah) {
            u32x4 c[8];
#pragma unroll
            for (int q = 0; q < 8; ++q) c[q] = *(const u32x4*)(gc + (ah * 8 + q) * 512);
#pragma unroll
            for (int q = 0; q < 8; ++q) {
                const int m = q >> 1, bj = q & 1;
#pragma unroll
                for (int w = 0; w < 4; ++w) { acc[ah][bj][m][w >> 1][(w & 1) * 2] *= bflo(c[q][w]); acc[ah][bj][m][w >> 1][(w & 1) * 2 + 1] *= bfhi(c[q][w]); }
            }
        }
        if (lastseg) {
#pragma unroll
            for (int ai = 0; ai < 2; ++ai)
#pragma unroll
                for (int m = 0; m < 4; ++m)
#pragma unroll
                    for (int bj = 0; bj < 2; ++bj) {
                        u32x4 w; w[0] = pack2(acc[ai][bj][m][0][0], acc[ai][bj][m][0][1]); w[1] = pack2(acc[ai][bj][m][0][2], acc[ai][bj][m][0][3]);
                        w[2] = pack2(acc[ai][bj][m][1][0], acc[ai][bj][m][1][1]); w[3] = pack2(acc[ai][bj][m][1][2], acc[ai][bj][m][1][3]);
                        *(u32x4*)(O + (size_t)(row0 + ai * 128 + m * 16) * D + col0 + bj * 128) = w;
                    }
        }
    }
};
__device__ __forceinline__ void ph_g2(const Params& p, int l, int M, LAS unsigned char* lds) {
    G2Sched S; S.Y = p.Y; S.Wb = p.wbT + (size_t)l * 4 * D * MW; S.ntiles = (M / 256) * 4; S.G = gridDim.x; S.c = blockIdx.x;
    EpiMix E; E.gate = p.gate; E.O = p.mix;
    g8::gemm_phase(lds, MW, S, E);
    if (l == 0 && (int)blockIdx.x >= (NTOK / 256) * 4 - 256) cvt_fill(p, lds, 4, CW_G2, CW_G3 - CW_G2, 0, 0);
}

struct EpiY {
    bf16_t* O;
    __device__ __forceinline__ bool keep(const g8::Unit&) const { return false; }
    __device__ __forceinline__ void operator()(const f32x4 (&acc)[2][2][4][2], const g8::Unit& u, int wr, int wc, int fr, int fq, const LAS float*) const {
        const int row0 = u.pm * 256 + wr * 64 + fr, col0 = u.pn * 256 + wc * 32 + 8 * fq;
#pragma unroll
        for (int ai = 0; ai < 2; ++ai)
#pragma unroll
            for (int m = 0; m < 4; ++m)
#pragma unroll
                for (int bj = 0; bj < 2; ++bj) {
                    u32x4 w; w[0] = pack2(acc[ai][bj][m][0][0], acc[ai][bj][m][0][1]); w[1] = pack2(acc[ai][bj][m][0][2], acc[ai][bj][m][0][3]);
                    w[2] = pack2(acc[ai][bj][m][1][0], acc[ai][bj][m][1][1]); w[3] = pack2(acc[ai][bj][m][1][2], acc[ai][bj][m][1][3]);
                    *(u32x4*)(O + (size_t)(row0 + ai * 128 + m * 16) * D + col0 + bj * 128) = w;
                }
    }
};
__device__ __forceinline__ void ph_g3(const Params& p, int l, int M, LAS unsigned char* lds) {
    g8::PlainSched S; S.init(p.mix, p.woutT + (size_t)l * D * D, M, D, D);
    EpiY E; E.O = p.Y;
    g8::gemm_phase(lds, D, S, E);
    if (l == 0 && (int)blockIdx.x >= (NTOK / 256) * 4 - 256) cvt_fill(p, lds, 5, CW_G3, CW_SEQ0B - CW_G3, 0, 0);
}

template <bool DRY = false> __device__ __forceinline__ void ph_route(const Params& p, int l, int M, LAS unsigned char* lds) {
    int* const r_cnt = DRY ? p.cnt + 64 : p.cnt; int* const r_list = DRY ? (int*)p.act : p.list; int* const r_ts = DRY ? (int*)p.yp : p.tokslot; float* const r_tw = DRY ? (float*)p.yp + (size_t)NTOK * 4 : p.topw;
    LAS float* fs = (LAS float*)lds;
    LAS float* lg = fs + 32 * 1028;
    LAS int* lcnt = (LAS int*)(lg + 32 * 36);
    LAS int* lbase = lcnt + 32;
    const int tid = opaque_tid(), wid = tid >> 6, lane = tid & 63;
    const float* rw = p.router_w + (size_t)l * D * NE;
    for (int it = blockIdx.x; it < M / 32; it += gridDim.x) {
        const int tok0 = it * 32;
        {
            float4 v[4][4]; float ss[4];
            const float* mb0 = p.mod + (size_t)(l * 5 + tok_modrow(tok0)) * (NMOD * D);
            u32x2 yv[4][4]; float4 g1v[4];
#pragma unroll
            for (int i = 0; i < 4; ++i) g1v[i] = *(const float4*)(mb0 + 2 * D + i * 256 + lane * 4);
#pragma unroll
            for (int q = 0; q < 4; ++q) {
                const size_t ro = (size_t)(tok0 + wid * 4 + q) * D;
#pragma unroll
                for (int i = 0; i < 4; ++i) { const u32x2 xr = *(const u32x2*)(p.xl + ro + i * 256 + lane * 4); v[q][i] = make_float4(bflo(xr[0]), bfhi(xr[0]), bflo(xr[1]), bfhi(xr[1])); yv[q][i] = *(const u32x2*)(p.Y + ro + i * 256 + lane * 4); }
            }
#pragma unroll
            for (int q = 0; q < 4; ++q)
#pragma unroll
                for (int i = 0; i < 4; ++i) {
                    v[q][i].x += g1v[i].x * bflo(yv[q][i][0]); v[q][i].y += g1v[i].y * bfhi(yv[q][i][0]); v[q][i].z += g1v[i].z * bflo(yv[q][i][1]); v[q][i].w += g1v[i].w * bfhi(yv[q][i][1]);
                    if (!DRY) { u32x2 o; o[0] = pack2(v[q][i].x, v[q][i].y); o[1] = pack2(v[q][i].z, v[q][i].w); *(u32x2*)(p.xl + (size_t)(tok0 + wid * 4 + q) * D + i * 256 + lane * 4) = o; }
                }
#pragma unroll
            for (int q = 0; q < 4; ++q) {
                float s = 0.f;
#pragma unroll
                for (int i = 0; i < 4; ++i) s += v[q][i].x * v[q][i].x + v[q][i].y * v[q][i].y + v[q][i].z * v[q][i].z + v[q][i].w * v[q][i].w;
                ss[q] = s;
            }
#pragma unroll
            for (int m = 32; m >= 1; m >>= 1)
#pragma unroll
                for (int q = 0; q < 4; ++q) ss[q] += shx(ss[q], m, lane);
            const float* mb = mb0;
#pragma unroll
            for (int i = 0; i < 4; ++i) {
                const int cidx = i * 256 + lane * 4;
                const float4 gv = *(const float4*)(p.norm2_g + l * D + cidx), sv = *(const float4*)(mb + 4 * D + cidx), hv = *(const float4*)(mb + 3 * D + cidx);
#pragma unroll
                for (int q = 0; q < 4; ++q) {
                    const int tl = wid * 4 + q, tok = tok0 + tl;
                    const float rinv = rsqrtf(ss[q] * (1.0f / D) + 1e-6f);
                    const float h0 = v[q][i].x * rinv * gv.x * (1.f + sv.x) + hv.x, h1 = v[q][i].y * rinv * gv.y * (1.f + sv.y) + hv.y;
                    const float h2 = v[q][i].z * rinv * gv.z * (1.f + sv.z) + hv.z, h3 = v[q][i].w * rinv * gv.w * (1.f + sv.w) + hv.w;
                    u32x2 o; o[0] = pack2(h0, h1); o[1] = pack2(h2, h3);
                    *(u32x2*)(p.F + (size_t)tok * D + cidx) = o;
                    *(LAS f32x4*)(fs + tl * 1028 + cidx) = (f32x4){h0, h1, h2, h3};
                }
            }
        }
        __syncthreads();
        {
            typedef float f32x16 __attribute__((ext_vector_type(16)));
            f32x16 acc;
#pragma unroll
            for (int r = 0; r < 16; ++r) acc[r] = 0.f;
            const int tk = lane & 31, hh = lane >> 5;
            const LAS float* ap = fs + tk * 1028 + wid * 128 + 4 * hh;
            const float* bp = rw + (size_t)(wid * 128 + 4 * hh) * NE + tk;
#pragma unroll 4
            for (int kk = 0; kk < 16; ++kk) {
                const f32x4 a4 = *(const LAS f32x4*)(ap + kk * 8);
                const float b0 = bp[(kk * 8 + 0) * NE], b1 = bp[(kk * 8 + 1) * NE], b2 = bp[(kk * 8 + 2) * NE], b3 = bp[(kk * 8 + 3) * NE];
                acc = __builtin_amdgcn_mfma_f32_32x32x2f32(a4[0], b0, acc, 0, 0, 0);
                acc = __builtin_amdgcn_mfma_f32_32x32x2f32(a4[1], b1, acc, 0, 0, 0);
                acc = __builtin_amdgcn_mfma_f32_32x32x2f32(a4[2], b2, acc, 0, 0, 0);
                acc = __builtin_amdgcn_mfma_f32_32x32x2f32(a4[3], b3, acc, 0, 0, 0);
            }
            __syncthreads();
            LAS float* red = fs;
#pragma unroll
            for (int r = 0; r < 16; ++r) red[(wid * 32 + (r & 3) + 8 * (r >> 2) + 4 * hh) * 33 + tk] = acc[r];
            __syncthreads();
            const int t2 = tid >> 4, e0 = (tid & 15) * 2;
            float s0 = p.router_b[l * NE + e0], s1 = p.router_b[l * NE + e0 + 1];
#pragma unroll
            for (int w = 0; w < 8; ++w) { s0 += red[(w * 32 + t2) * 33 + e0]; s1 += red[(w * 32 + t2) * 33 + e0 + 1]; }
            lg[t2 * 36 + e0] = s0; lg[t2 * 36 + e0 + 1] = s1;
            if (tid < 32) lcnt[tid] = 0;
        }
        __syncthreads();
        float vals[4]; int idxs[4], rank[4];
        if (tid < 32) {
            float lv[32];
#pragma unroll
            for (int q = 0; q < 8; ++q) { const f32x4 t = *(const LAS f32x4*)(lg + tid * 36 + q * 4); lv[q * 4] = t[0]; lv[q * 4 + 1] = t[1]; lv[q * 4 + 2] = t[2]; lv[q * 4 + 3] = t[3]; }
#pragma unroll
            for (int k = 0; k < 4; ++k) {
                float best = lv[0]; int bi = 0;
#pragma unroll
                for (int ee = 1; ee < NE; ++ee) { const bool gt = lv[ee] > best; best = gt ? lv[ee] : best; bi = gt ? ee : bi; }
#pragma unroll
                for (int ee = 0; ee < NE; ++ee) lv[ee] = (ee == bi) ? -3.0e38f : lv[ee];
                vals[k] = best; idxs[k] = bi;
                rank[k] = atomicAdd((int*)(lcnt + bi), 1);
            }
        }
        __syncthreads();
        if (tid < 32) { const int c = lcnt[tid]; lbase[tid] = c ? atomicAdd(r_cnt + l * NE + tid, c) : 0; }
        __syncthreads();
        if (tid < 32) {
            const int tok = tok0 + tid;
            const float mx = vals[0];
            float ex[4], sum = 0.f;
#pragma unroll
            for (int k = 0; k < 4; ++k) { ex[k] = __expf(vals[k] - mx); sum += ex[k]; }
            const float inv = 1.0f / sum;
#pragma unroll
            for (int k = 0; k < 4; ++k) {
                const int ee = idxs[k];
                const int slot = lbase[ee] + rank[k];
                r_list[(size_t)ee * NTOK + slot] = tok;
                r_ts[(size_t)tok * 4 + k] = (ee << 16) | slot;
                r_tw[(size_t)tok * 4 + k] = ex[k] * inv;
            }
        }
        __syncthreads();
    }
}

__device__ __forceinline__ void build_expert_tables(const Params& p, int l, LAS int* ts, LAS int* cn, LAS int* te) {
    const int tid = opaque_tid();
    if (tid < 64) {
        const int c = tid < NE ? p.cnt[l * NE + tid] : 0;
        const int nt = (c + 255) >> 8;
        int v = nt;
#pragma unroll
        for (int off = 1; off < 32; off <<= 1) { const int t = shupi(v, off, tid); if (tid >= off) v += t; }
        if (tid < NE) { cn[tid] = c; ts[tid] = v - nt; if (tid == NE - 1) ts[NE] = v; }
        if (te && tid < NE) for (int q = 0; q < nt; ++q) te[v - nt + q] = tid;
    }
    __syncthreads();
}

struct MoeSched {
    const LAS int* ts; const LAS int* cn; const LAS int* te; const int* list; const bf16_t* A; const bf16_t* Bt; const float* bias; int K, npn, nunits, G, c, nrowsB, nbias; bool gather;
    static constexpr bool HAS_BIAS = true;
    __device__ __forceinline__ bool next(int i, g8::Unit& u) const {
        if (G == 256) {
            const int x = c & 7, s = c >> 3, pm = i * (256 / npn) + x * (32 / npn) + s / npn;
            if (pm * npn >= nunits) return false;
            u.pm = pm; u.pn = s % npn; u.e = te[pm]; return true;
        }
        const long L = (long)i * G + c; if (L >= nunits) return false;
        u.pm = (int)(L / npn); u.pn = (int)(L % npn); u.e = te[u.pm]; return true;
    }
    __device__ __forceinline__ const char* a_base(const g8::Unit& u) const { return (const char*)(gather ? A : A + (size_t)u.pm * 256 * K); }
    __device__ __forceinline__ const char* b_base(const g8::Unit& u) const { return (const char*)(Bt + ((size_t)u.e * nrowsB + (size_t)u.pn * 256) * K); }
    __device__ __forceinline__ const int* row_addr(const g8::Unit& u, int R) const {
        const int cnt = cn[u.e], sl = (u.pm - ts[u.e]) * 256 + R;
        return list + (size_t)u.e * NTOK + (sl < cnt ? sl : 0);
    }
    __device__ __forceinline__ int rows_valid(const g8::Unit& u) const { return cn[u.e] - (u.pm - ts[u.e]) * 256; }
    __device__ __forceinline__ const float* bias_src(const g8::Unit& u, int lane) const {
        if (nbias == 2) return bias + (size_t)u.e * 2 * D + (lane < 32 ? u.pn * 128 + lane * 4 : D + u.pn * 128 + (lane - 32) * 4);
        return bias + (size_t)u.e * D + u.pn * 256 + lane * 4;
    }
};
struct EpiAct {
    bf16_t* O;
    __device__ __forceinline__ bool keep(const g8::Unit&) const { return false; }
    __device__ __forceinline__ void operator()(const f32x4 (&acc)[2][2][4][2], const g8::Unit& u, int wr, int wc, int fr, int fq, const LAS float* bias) const {
        const int row0 = u.pm * 256 + wr * 64 + fr, col0 = u.pn * 128 + wc * 32 + 8 * fq;
        const LAS float* bb = bias + wc * 32 + 8 * fq;
        const f32x4 g0 = *(const LAS f32x4*)bb, g1 = *(const LAS f32x4*)(bb + 4), l0 = *(const LAS f32x4*)(bb + 128), l1 = *(const LAS f32x4*)(bb + 132);
        const float bg[8] = {g0[0], g0[1], g0[2], g0[3], g1[0], g1[1], g1[2], g1[3]}, bl[8] = {l0[0], l0[1], l0[2], l0[3], l1[0], l1[1], l1[2], l1[3]};
#pragma unroll
        for (int ai = 0; ai < 2; ++ai)
#pragma unroll
            for (int m = 0; m < 4; ++m) {
                float o[8];
#pragma unroll
                for (int n = 0; n < 2; ++n)
#pragma unroll
                    for (int j = 0; j < 4; ++j) {
                        const float glu = fminf(acc[ai][0][m][n][j] + bg[n * 4 + j], 7.0f);
                        const float lin = fminf(fmaxf(acc[ai][1][m][n][j] + bl[n * 4 + j], -7.0f), 7.0f);
                        o[n * 4 + j] = glu * sigmoidf_(1.702f * glu) * (lin + 1.0f);
                    }
                *(u32x4*)(O + (size_t)(row0 + ai * 128 + m * 16) * D + col0) = pack8(o);
            }
    }
};
__device__ __forceinline__ void ph_g4(const Params& p, int l, LAS unsigned char* lds) {
    LAS int* ts = (LAS int*)(lds + g8::STAGE_BYTES); LAS int* cn = ts + 40; LAS int* te = ts + 80;
    build_expert_tables(p, l, ts, cn, te);
    MoeSched S; S.ts = ts; S.cn = cn; S.te = te; S.list = p.list; S.A = p.F; S.Bt = p.w1T + (size_t)l * NE * 2 * D * D; S.bias = p.moe_b1 + (size_t)l * NE * 2 * D; S.nbias = 2;
    S.K = D; S.npn = 8; S.nunits = ts[NE] * 8; S.G = gridDim.x; S.c = blockIdx.x; S.nrowsB = 2 * D; S.gather = true;
    EpiAct E; E.O = p.act;
    g8::gemm_phase(lds, D, S, E);
}

struct EpiYp {
    bf16_t* O;
    __device__ __forceinline__ bool keep(const g8::Unit&) const { return false; }
    __device__ __forceinline__ void operator()(const f32x4 (&acc)[2][2][4][2], const g8::Unit& u, int wr, int wc, int fr, int fq, const LAS float* bias) const {
        const int row0 = u.pm * 256 + wr * 64 + fr, col0 = u.pn * 256 + wc * 32 + 8 * fq;
#pragma unroll
        for (int bj = 0; bj < 2; ++bj) {
            const LAS float* bb = bias + bj * 128 + wc * 32 + 8 * fq;
            const f32x4 c0v = *(const LAS f32x4*)bb, c1v = *(const LAS f32x4*)(bb + 4);
            const float4 c0 = make_float4(c0v[0], c0v[1], c0v[2], c0v[3]), c1 = make_float4(c1v[0], c1v[1], c1v[2], c1v[3]);
#pragma unroll
            for (int ai = 0; ai < 2; ++ai)
#pragma unroll
                for (int m = 0; m < 4; ++m) {
                    u32x4 w; w[0] = pack2(acc[ai][bj][m][0][0] + c0.x, acc[ai][bj][m][0][1] + c0.y); w[1] = pack2(acc[ai][bj][m][0][2] + c0.z, acc[ai][bj][m][0][3] + c0.w);
                    w[2] = pack2(acc[ai][bj][m][1][0] + c1.x, acc[ai][bj][m][1][1] + c1.y); w[3] = pack2(acc[ai][bj][m][1][2] + c1.z, acc[ai][bj][m][1][3] + c1.w);
                    *(u32x4*)(O + (size_t)(row0 + ai * 128 + m * 16) * D + col0 + bj * 128) = w;
                }
        }
    }
};
__device__ __forceinline__ void ph_g5(const Params& p, int l, LAS unsigned char* lds) {
    LAS int* ts = (LAS int*)(lds + g8::STAGE_BYTES); LAS int* cn = ts + 40; LAS int* te = ts + 80;
    build_expert_tables(p, l, ts, cn, te);
    MoeSched S; S.ts = ts; S.cn = cn; S.te = te; S.list = p.list; S.A = p.act; S.Bt = p.w2T + (size_t)l * NE * D * D; S.bias = p.moe_b2 + (size_t)l * NE * D; S.nbias = 1;
    S.K = D; S.npn = 4; S.nunits = ts[NE] * 4; S.G = gridDim.x; S.c = blockIdx.x; S.nrowsB = D; S.gather = false;
    EpiYp E; E.O = p.yp;
    g8::gemm_phase(lds, D, S, E);
}

template <bool DRY = false> __device__ __forceinline__ void ph_combine(const Params& p, int l, int M, LAS unsigned char* lds) {
    bf16_t* const c_xl = DRY ? (bf16_t*)p.prep : p.xl; bf16_t* const c_H = DRY ? (bf16_t*)(p.prep + (size_t)NTOK * D) : p.H; float* const c_out = DRY ? p.prep : p.out;
    LAS int* ts = (LAS int*)lds; LAS int* cn = ts + 40;
    build_expert_tables(p, l, ts, cn, nullptr);
    const int tid = opaque_tid(), wid = tid >> 6, lane = tid & 63;
    const bool last = (l == 1);
    const int tstep = gridDim.x * NWAVES;
    int tok = blockIdx.x * NWAVES + wid;
    int4 nts = make_int4(0, 0, 0, 0); float4 ntw = make_float4(0.f, 0.f, 0.f, 0.f);
    if (tok < M) { nts = *(const int4*)(p.tokslot + (size_t)tok * 4); ntw = *(const float4*)(p.topw + (size_t)tok * 4); }
    for (; tok < M; tok += tstep) {
        float4 v[4];
        const float* mb = p.mod + (size_t)(l * 5 + tok_modrow(tok)) * (NMOD * D);
        const int tsl[4] = {nts.x, nts.y, nts.z, nts.w}; const float wts[4] = {ntw.x, ntw.y, ntw.z, ntw.w};
        int rows[4];
#pragma unroll
        for (int k = 0; k < 4; ++k) rows[k] = ts[tsl[k] >> 16] * 256 + (tsl[k] & 0xffff);
        if (tok + tstep < M) { nts = *(const int4*)(p.tokslot + (size_t)(tok + tstep) * 4); ntw = *(const float4*)(p.topw + (size_t)(tok + tstep) * 4); }
        u32x2 yv[4][4], xin[4]; float4 gtv[4];
#pragma unroll
        for (int i = 0; i < 4; ++i) {
            const int cidx = i * 256 + lane * 4;
#pragma unroll
            for (int k = 0; k < 4; ++k) yv[i][k] = *(const u32x2*)(p.yp + (size_t)rows[k] * D + cidx);
            xin[i] = *(const u32x2*)(p.xl + (size_t)tok * D + cidx);
            gtv[i] = *(const float4*)(mb + 5 * D + cidx);
        }
        float ss = 0.f;
#pragma unroll
        for (int i = 0; i < 4; ++i) {
            float m0 = 0.f, m1 = 0.f, m2 = 0.f, m3 = 0.f;
#pragma unroll
            for (int k = 0; k < 4; ++k) { m0 += wts[k] * bflo(yv[i][k][0]); m1 += wts[k] * bfhi(yv[i][k][0]); m2 += wts[k] * bflo(yv[i][k][1]); m3 += wts[k] * bfhi(yv[i][k][1]); }
            float4 xv = make_float4(bflo(xin[i][0]), bfhi(xin[i][0]), bflo(xin[i][1]), bfhi(xin[i][1]));
            xv.x += gtv[i].x * m0; xv.y += gtv[i].y * m1; xv.z += gtv[i].z * m2; xv.w += gtv[i].w * m3;
            v[i] = xv; ss += xv.x * xv.x + xv.y * xv.y + xv.z * xv.z + xv.w * xv.w;
        }
        ss = wave_sum(ss, lane);
        const float rinv = rsqrtf(ss * (1.0f / D) + 1e-6f);
        if (!last) {
#pragma unroll
            for (int i = 0; i < 4; ++i) { u32x2 o; o[0] = pack2(v[i].x, v[i].y); o[1] = pack2(v[i].z, v[i].w); *(u32x2*)(c_xl + (size_t)tok * D + i * 256 + lane * 4) = o; }
            const float* mb1 = p.mod + (size_t)((l + 1) * 5 + tok_modrow(tok)) * (NMOD * D);
            norm_mod_store(v, rinv, p.norm1_g + (l + 1) * D, mb1 + 1 * D, mb1 + 0 * D, c_H + (size_t)tok * D, lane);
        } else {
#pragma unroll
            for (int i = 0; i < 4; ++i) {
                const int cidx = i * 256 + lane * 4;
                const float4 gv = *(const float4*)(p.final_norm_g + cidx);
                *(float4*)(c_out + (size_t)tok * D + cidx) = make_float4(v[i].x * rinv * gv.x, v[i].y * rinv * gv.y, v[i].z * rinv * gv.z, v[i].w * rinv * gv.w);
            }
        }
    }
}

#define XB_TMO      128
#define XB_XCNT(j)  (256  + 64 * (j))
#define XB_XSUB(j)  (1280 + 64 * (j))
#define XB_XGEN(j)  (2304 + 64 * (j))
#define XB_TOP      3328
#define XB_TOPGEN   3392
#define XCD_BAR_WORDS 3456
#define XB_SPIN_CAP (1u << 18)

__device__ __forceinline__ unsigned xb_ld(unsigned* p)              { return __hip_atomic_load(p, __ATOMIC_RELAXED, __HIP_MEMORY_SCOPE_AGENT); }
__device__ __forceinline__ unsigned xb_add(unsigned* p, unsigned v) { return __hip_atomic_fetch_add(p, v, __ATOMIC_RELAXED, __HIP_MEMORY_SCOPE_AGENT); }
__device__ __forceinline__ unsigned xb_xcc_id() { return (unsigned)__builtin_amdgcn_s_getreg((3 << 11) | 20) & 0xFu; }
#define XB_SPIN(cond, bar) do { unsigned _sp = 0; while (cond) { __builtin_amdgcn_s_sleep(1); \
    if ((++_sp & 255u) == 0u) { if (xb_ld(&(bar)[XB_TMO])) break; if (_sp > XB_SPIN_CAP) { atomicAdd(&(bar)[XB_TMO], 1u); break; } } } } while (0)

struct XcdBarrier {
    unsigned* bar; unsigned x;
    volatile LAS unsigned* st;
};

__device__ __forceinline__ XcdBarrier xcd_barrier_post(unsigned* bar, volatile LAS unsigned* st) {
    XcdBarrier b; b.bar = bar; b.x = xb_xcc_id(); b.st = st;
    if (threadIdx.x == 0) (void)xb_add(&bar[XB_XCNT(b.x)], 1u);
    return b;
}
__device__ __forceinline__ void xcd_barrier_complete(unsigned* bar, unsigned x, unsigned& nloc, unsigned& nx) {
    const unsigned G = gridDim.x * gridDim.y * gridDim.z;
    unsigned sum, cnt, mine, sp = 0u;
    for (;;) {
        sum = 0u; cnt = 0u; mine = 0u;
#pragma unroll
        for (unsigned j = 0; j < 16; ++j) { const unsigned c = xb_ld(&bar[XB_XCNT(j)]); sum += c; cnt += (c > 0u) ? 1u : 0u; mine = (j == x) ? c : mine; }
        if (sum == G) break;
        __builtin_amdgcn_s_sleep(1);
        if ((++sp & 255u) == 0u) { if (xb_ld(&bar[XB_TMO])) break; if (sp > XB_SPIN_CAP) { atomicAdd(&bar[XB_TMO], 1u); break; } }
    }
    nloc = mine > 0u ? mine : 1u; nx = cnt > 0u ? cnt : 1u;
}

__device__ __forceinline__ void xcd_barrier(const XcdBarrier& b) {
    asm volatile("s_waitcnt vmcnt(0)" ::: "memory");
    __syncthreads();
    if (threadIdx.x == 0) {
        unsigned* bar = b.bar;
        __builtin_amdgcn_s_waitcnt(0);
        unsigned nloc = b.st[0], nx = b.st[1];
        if (nloc == 0u) { xcd_barrier_complete(bar, b.x, nloc, nx); b.st[0] = nloc; b.st[1] = nx; }
        const unsigned old = xb_add(&bar[XB_XSUB(b.x)], 1u);
        const unsigned gen = old / nloc;
        if (old + 1u == (gen + 1u) * nloc) {
            __builtin_amdgcn_fence(__ATOMIC_RELEASE, "agent");
            asm volatile("s_waitcnt vmcnt(0)" ::: "memory");
            const unsigned og = xb_add(&bar[XB_TOP], 1u);
            const unsigned tg = og / nx;
            if (og + 1u == (tg + 1u) * nx) xb_add(&bar[XB_TOPGEN], 1u);
            else XB_SPIN(xb_ld(&bar[XB_TOPGEN]) == tg, bar);
            __builtin_amdgcn_fence(__ATOMIC_ACQUIRE, "agent");
            xb_add(&bar[XB_XGEN(b.x)], 1u);
            asm volatile("s_waitcnt vmcnt(0)" ::: "memory");
        } else {
            XB_SPIN(xb_ld(&bar[XB_XGEN(b.x)]) == gen, bar);
            __builtin_amdgcn_fence(__ATOMIC_ACQUIRE, "agent");
            asm volatile("s_waitcnt vmcnt(0)" ::: "memory");
        }
    }
    __syncthreads();
}


extern __shared__ __attribute__((aligned(16))) unsigned char dyn_lds[];

typedef const __attribute__((address_space(4))) unsigned char* KArgPtr;
__device__ __forceinline__ Params load_params(KArgPtr kp) {
    asm volatile("" : "+s"(kp));
    Params q;
    const __attribute__((address_space(4))) unsigned long long* k8 = (const __attribute__((address_space(4))) unsigned long long*)kp;
    unsigned long long* d8 = (unsigned long long*)&q;
#pragma unroll
    for (int i = 0; i < (int)(sizeof(Params) / 8); ++i) d8[i] = k8[i];
    return q;
}
__global__ void __launch_bounds__(NTHREADS, 2) k_mega(Params p_unused) {
    (void)p_unused;
    const KArgPtr kp = (KArgPtr)__builtin_amdgcn_kernarg_segment_ptr();
    LAS unsigned char* lds = (LAS unsigned char*)dyn_lds;
    volatile LAS unsigned* xb_words = (volatile LAS unsigned*)(lds + LDS_BYTES - 16);
    if (threadIdx.x == 0) { xb_words[0] = 0u; xb_words[1] = 0u; xb_words[2] = 0u; xb_words[3] = 0u; }
    __syncthreads();
    { const Params p = load_params(kp); (void)xcd_barrier_post(p.bar, xb_words); }
#define GRID_BARRIER() do { XcdBarrier b_; b_.bar = load_params(kp).bar; b_.x = xb_xcc_id(); b_.st = xb_words; xcd_barrier(b_); } while (0)
#define PH(stmt) do { const Params p = load_params(kp); stmt; } while (0)
    PH(ph_convert(p, lds));
    PH(ph_mod(p, lds));
    GRID_BARRIER();
    PH(ph_norm1_first(p));
    GRID_BARRIER();
    for (int l = 0; l < 2; ++l) {
        const int M = l == 0 ? NTOK : NLAT;
        { unsigned lb_ = (unsigned)(size_t)lds; asm volatile("" : "+s"(lb_)); lds = (LAS unsigned char*)(size_t)lb_; }
        PH(ph_g1(p, l, lds));
        GRID_BARRIER();
        PH(ph_prep(p, l, lds));
        PH(ph_local(p, l, lds));
        GRID_BARRIER();
        PH(ph_seq(p, l, lds));
        GRID_BARRIER();
        PH(ph_merge(p, l, M));
        GRID_BARRIER();
        PH(ph_g2(p, l, M, lds));
        GRID_BARRIER();
        PH(ph_g3(p, l, M, lds));
        GRID_BARRIER();
        PH(ph_route(p, l, M, lds));
        GRID_BARRIER();
        PH(ph_g4(p, l, lds));
        GRID_BARRIER();
        PH(ph_g5(p, l, lds));
        GRID_BARRIER();
        PH(ph_combine(p, l, M, lds));
        if (l == 0) GRID_BARRIER();
    }
}

static inline size_t align_up(size_t v, size_t a) { return (v + a - 1) / a * a; }

extern "C" void kernel_launch(void* const* d_in, const int* in_sizes, int n_in, void* d_out, int out_size, void* d_ws, size_t ws_size, hipStream_t stream) {
    (void)in_sizes; (void)n_in; (void)out_size;
    Params p{};
    const float** pf = (const float**)&p;
    for (int i = 0; i < 32; ++i) pf[i] = (const float*)d_in[i];
    p.out = (float*)d_out;
    unsigned char* w = (unsigned char*)d_ws; size_t off = 0;
    auto take = [&](size_t bytes) { void* r = w + off; off = align_up(off + bytes, 256); return r; };
    p.bar = (unsigned*)take(16384);
    p.cnt = (int*)take(4096);
    const size_t ctl_bytes = off;
    p.mod = (float*)take((size_t)2 * 5 * NMOD * D * 4);
    p.winT = (bf16_t*)take((size_t)2 * NPW * D * 2);
    p.wbT = (bf16_t*)take((size_t)2 * 4 * D * MW * 2);
    p.woutT = (bf16_t*)take((size_t)2 * D * D * 2);
    p.w1T = (bf16_t*)take((size_t)2 * NE * 2 * D * D * 2);
    p.w2T = (bf16_t*)take((size_t)2 * NE * D * D * 2);
    p.xl = (bf16_t*)take((size_t)NTOK * D * 2);
    p.H = (bf16_t*)take((size_t)NTOK * D * 2);
    p.P = (bf16_t*)take((size_t)NTOK * NP * 2);
    p.gate = (bf16_t*)take((size_t)NTOK * 4096 * 2);
    p.act = p.P; p.yp = p.P + (size_t)CAPROWS * D;
    p.prep = (float*)take(NPREP * TOKW * 4);
    p.O = (bf16_t*)take(8 * TOKW * 2);
    p.lq = (bf16_t*)take((size_t)3 * NITEM * 64 * 128 * 2);
    p.lo = (bf16_t*)take((size_t)3 * NITEM * 64 * 128 * 2);
    p.lb = (bf16_t*)take((size_t)3 * NITEM * 128 * 128 * 2);
    p.la = (bf16_t*)take((size_t)NITEM * 128 * 128 * 2);
    p.ld = (float*)take((size_t)3 * NITEM * 128 * 4);
    p.lruT = (bf16_t*)take((size_t)2 * 8 * 4 * 4096 * 2);
    p.lsig = (float*)take((size_t)2 * 2 * MW * 4);
    p.rope = (float2*)take((size_t)TL * 64 * 8);
    p.Y = (bf16_t*)take(4 * TOKW * 2);
    p.mix = (bf16_t*)take((size_t)NTOK * D * 2);
    p.F = p.H;
    p.list = (int*)take((size_t)NE * NTOK * 4);
    p.tokslot = (int*)take((size_t)NTOK * 4 * 4);
    p.topw = (float*)take((size_t)NTOK * 4 * 4);
    if (off > ws_size) { fprintf(stderr, "workspace too small: need %zu have %zu\n", off, ws_size); return; }

    static int grid = 0;
    if (!grid) {
        int dev = 0, cus = 0, occ = 0; (void)hipGetDevice(&dev); (void)hipDeviceGetAttribute(&cus, hipDeviceAttributeMultiprocessorCount, dev);
        (void)hipFuncSetAttribute((const void*)k_mega, hipFuncAttributeMaxDynamicSharedMemorySize, LDS_BYTES);
        (void)hipOccupancyMaxActiveBlocksPerMultiprocessor(&occ, (const void*)k_mega, NTHREADS, LDS_BYTES);
        if (cus <= 0) cus = 256;
        grid = cus * (occ < 1 ? 1 : 1);
        if (occ < 1) fprintf(stderr, "occupancy query says %d blocks per CU\n", occ);
    }
    (void)hipMemsetAsync(d_ws, 0, ctl_bytes, stream);
    hipLaunchKernelGGL(k_mega, dim3(grid), dim3(NTHREADS), LDS_BYTES, stream, p);
}
```

```cpp
#include <hip/hip_runtime.h>
#include <stdint.h>
#include <stdio.h>

#define LAS __attribute__((address_space(3)))
typedef unsigned short bf16_t;
typedef short bf16x8 __attribute__((ext_vector_type(8)));
typedef float f32x4 __attribute__((ext_vector_type(4)));
typedef float f32x2 __attribute__((ext_vector_type(2)));
typedef unsigned u32x2 __attribute__((ext_vector_type(2)));
typedef unsigned u32x4 __attribute__((ext_vector_type(4)));

#ifndef PROBE
#define PROBE 0
#endif

constexpr int D = 1024, NB = 4, TL = 4096, TC = 256, NLAT = NB * TL, NCTX = NB * TC, NTOK = NLAT + NCTX;
constexpr int NIN = 11792, NPW = 12032, NP = 7936, MW = 512, NE = 32, TOPK = 4, NMOD = 6;
constexpr int C_GQKV = 0, C_GZ = 1536, C_HQ = 2048, C_HI = 2560, C_HF = 3072, C_HG = 4096, C_LX = 4608,
              C_LY = 5120, C_RQKV = 5632, C_RG = 7168, C_GA = 7680, C_GB = 7688, W_MG = 7936;
__host__ __device__ __forceinline__ int win_dst_row(int n) {
    if (n < 7696) return n < 2048 ? n : n < 2064 ? 7680 + (n - 2048) : n - 16;
    const int q = n - 7696, seg = q >> 10, lam = q & 1023, t = lam >> 6, li = lam & 63;
    return 7936 + t * 256 + (seg >> 1) * 128 + (li >> 4) * 32 + ((li >> 2) & 3) * 8 + (seg & 1) * 4 + (li & 3);
}
constexpr int NTHREADS = 512, NWAVES = 8;
constexpr int LDS_BYTES = 140 * 1024;
constexpr int CAPROWS = 77824;
constexpr size_t TOKW = (size_t)NTOK * MW;
constexpr int PR_LA = 0, PR_LU = 2, NPREP = 4;
constexpr int NCHUNK = 68, NITEM = 32 * NCHUNK;

struct Params {
    const float *x, *c, *ctx, *c_ctx, *w_mod, *b_mod, *norm1_g, *norm2_g, *w_in, *gdn_conv_w, *gdn_a_log, *gdn_dt_bias, *gdn_norm_g, *hgrn_lb,
        *hgrn_norm_g, *lru_conv_w, *lru_conv_b, *lru_wa, *lru_ba, *lru_wx, *lru_bx, *lru_lambda, *ret_norm_g, *w_branch, *w_out, *router_w,
        *router_b, *moe_w1, *moe_b1, *moe_w2, *moe_b2, *final_norm_g;
    float* out;
    unsigned* bar; int* cnt; float* mod;
    bf16_t *winT, *wbT, *woutT, *w1T, *w2T;
    bf16_t* xl; bf16_t* H; bf16_t* P; float* prep; float* gg; float* gb; bf16_t* O; bf16_t* Y; bf16_t* mix; bf16_t* F;
    int* list; int* tokslot; float* topw; bf16_t* act; bf16_t* yp;
    bf16_t *lq, *lo, *lb, *la; float* ld; bf16_t* lruT; bf16_t* gate; float* lsig; float2* rope;
};

typedef __bf16 bf16x2_t __attribute__((ext_vector_type(2)));
__device__ __forceinline__ unsigned pack2(float a, float b) { const f32x2 v = {a, b}; return __builtin_bit_cast(unsigned, __builtin_convertvector(v, bf16x2_t)); }
__device__ __forceinline__ unsigned f2bf(float f) { return pack2(f, f) & 0xffffu; }
__device__ __forceinline__ float bf2f(bf16_t b) { return __uint_as_float(((unsigned)b) << 16); }
__device__ __forceinline__ float bflo(unsigned u) { return __uint_as_float(u << 16); }
__device__ __forceinline__ float bfhi(unsigned u) { return __uint_as_float(u & 0xffff0000u); }
__device__ __forceinline__ float sigmoidf_(float x) { return __builtin_amdgcn_rcpf(1.0f + __expf(-x)); }
__device__ __forceinline__ float siluf_(float x) { return x * sigmoidf_(x); }
__device__ __forceinline__ float softplusf_(float x) { return x > 20.f ? x : __logf(1.0f + __expf(x)); }
__device__ __forceinline__ float ret_log_gamma(int h) { return h == 0 ? -0.031748698314580f : h == 1 ? -0.015748356968139f : h == 2 ? -0.007843177461025f : -0.003913899321136f; }
__device__ __forceinline__ float logsigmoidf_(float x) { return -softplusf_(-x); }
__device__ __forceinline__ float gelu_tanhf_(float x) { const float u = 0.7978845608028654f * (x + 0.044715f * x * x * x); return x * __builtin_amdgcn_rcpf(1.0f + __expf(-2.0f * u)); }
__device__ __forceinline__ float shx(float v, int m, int lane) { return __int_as_float(__builtin_amdgcn_ds_bpermute((lane ^ m) << 2, __float_as_int(v))); }
__device__ __forceinline__ float shup(float v, int off, int lane) { const int s = lane >= off ? lane - off : lane; return __int_as_float(__builtin_amdgcn_ds_bpermute(s << 2, __float_as_int(v))); }
__device__ __forceinline__ int shupi(int v, int off, int lane) { const int s = lane >= off ? lane - off : lane; return __builtin_amdgcn_ds_bpermute(s << 2, v); }
__device__ __forceinline__ float wave_sum(float v, int lane) {
#pragma unroll
    for (int m = 32; m >= 1; m >>= 1) v += shx(v, m, lane);
    return v;
}
__device__ __forceinline__ int opaque_tid() { int t = threadIdx.x; asm volatile("" : "+v"(t)); return t; }
template <class T> __device__ __forceinline__ T* opaque_sptr(T* q) { asm volatile("" : "+s"(q)); return q; }
__device__ __forceinline__ int tok_modrow(int tok) { return tok < NLAT ? (tok >> 12) : 4; }
__device__ __forceinline__ void tok_info(int tok, int& t, int& T, int& base) {
    if (tok < NLAT) { t = tok & (TL - 1); T = TL; base = tok - t; }
    else { t = (tok - NLAT) & (TC - 1); T = TC; base = tok - t; }
}

__device__ __forceinline__ f32x4 mfma16(bf16x8 a, bf16x8 b, f32x4 c) { return __builtin_amdgcn_mfma_f32_16x16x32_bf16(a, b, c, 0, 0, 0); }
__device__ __forceinline__ u32x2 pack4(f32x4 v) { u32x2 o; o[0] = pack2(v[0], v[1]); o[1] = pack2(v[2], v[3]); return o; }
__device__ __forceinline__ u32x4 pack8(const float* v) { u32x4 o; o[0] = pack2(v[0], v[1]); o[1] = pack2(v[2], v[3]); o[2] = pack2(v[4], v[5]); o[3] = pack2(v[6], v[7]); return o; }

namespace g8 {
constexpr int BM = 256, BK = 64, HALF = 128, HTB = HALF * BK * 2, STAGE_BYTES = 8 * HTB;
__device__ __forceinline__ int lds_byte(int r, int c) { const int st = (r >> 4) * 2 + (c >> 5), rr = r & 15, cc = c & 31, ob = rr * 64 + cc * 2; return st * 1024 + (ob ^ (((ob >> 9) & 1) << 5)); }
__device__ __forceinline__ void stage_rc(int b, int& R, int& C) { const int st = b / 1024, sb = b % 1024, swz = sb ^ (((sb >> 9) & 1) << 5); R = (st >> 1) * 16 + swz / 64; C = (st & 1) * 32 + (swz % 64) / 2; }
__device__ __forceinline__ int perm32(int rho) { const int n = rho >> 4, i = rho & 15; return 8 * (i >> 2) + 4 * n + (i & 3); }
struct Unit { int pm, pn, e; };

template <class Epi, class Sched>
__device__ __forceinline__ void gemm_phase(LAS unsigned char* lds, const int K, const Sched& S, const Epi& E) {
    const int tid = opaque_tid(), wid = __builtin_amdgcn_readfirstlane(tid >> 6), lane = tid & 63, wr = wid >> 2, wc = wid & 3, fr = lane & 15, fq = lane >> 4;
    const int nt = K / BK;
    int R0, C0, R1, C1; stage_rc(tid * 16, R0, C0); stage_rc(tid * 16 + 8192, R1, C1);
    unsigned voffB[2];
    voffB[0] = (unsigned)(((R0 & ~31) + perm32(R0 & 31)) * K + C0) * 2u; voffB[1] = (unsigned)(((R1 & ~31) + perm32(R1 & 31)) * K + C1) * 2u;
    const unsigned cb0 = (unsigned)C0 * 2u, cb1 = (unsigned)C1 * 2u;
    const size_t kstep = (size_t)(BK * 2);
    const size_t hstepB = (size_t)HALF * K * 2;
    const unsigned ldsw = (unsigned)wid * 1024u;
    const int aoff = lds_byte(wr * 64 + fr, fq * 8), boff = lds_byte(wc * 32 + fr, fq * 8);
#define G8_SA(b, h) (((b) * 2 + (h)) * HTB)
#define G8_SB(b, h) ((4 + (b) * 2 + (h)) * HTB)
#define G8_GL(src, dstoff) __builtin_amdgcn_global_load_lds((const unsigned*)(src), (LAS unsigned*)(lds + (dstoff)), 16, 0, 0)
#define G8_STAGE_A(bufoff, gbase, vo, h) do { G8_GL((const char*)(gbase) + (vo)[2 * (h)], (bufoff) + ldsw); G8_GL((const char*)(gbase) + (vo)[2 * (h) + 1], (bufoff) + ldsw + 8192); } while (0)
#define G8_STAGE_B(bufoff, gbase) do { G8_GL((const char*)(gbase) + voffB[0], (bufoff) + ldsw); G8_GL((const char*)(gbase) + voffB[1], (bufoff) + ldsw + 8192); } while (0)
#define G8_LDA(dst, b, h) do { _Pragma("unroll") for (int m = 0; m < 4; ++m) _Pragma("unroll") for (int k = 0; k < 2; ++k) dst[m][k] = *(const LAS bf16x8*)(lds + G8_SA(b, h) + aoff + m * 2048 + k * 1024); } while (0)
#define G8_LDB(dst, b, h) do { _Pragma("unroll") for (int n = 0; n < 2; ++n) _Pragma("unroll") for (int k = 0; k < 2; ++k) dst[n][k] = *(const LAS bf16x8*)(lds + G8_SB(b, h) + boff + n * 2048 + k * 1024); } while (0)
#define G8_MMA(ai, bj, At, Bt) do { __builtin_amdgcn_s_setprio(1); _Pragma("unroll") for (int m = 0; m < 4; ++m) _Pragma("unroll") for (int n = 0; n < 2; ++n) _Pragma("unroll") for (int k = 0; k < 2; ++k) \
        acc[ai][bj][m][n] = __builtin_amdgcn_mfma_f32_16x16x32_bf16(Bt[n][k], At[m][k], acc[ai][bj][m][n], 0, 0, 0); __builtin_amdgcn_s_setprio(0); } while (0)
#define G8_WAIT_V(n) asm volatile("s_waitcnt vmcnt(" #n ")" ::: "memory")
#define G8_WAIT_L(n) asm volatile("s_waitcnt lgkmcnt(" #n ")" ::: "memory")
#define G8_BAR __builtin_amdgcn_s_barrier()
#define G8_SCHED __builtin_amdgcn_sched_barrier(0)
    Unit cur, nxt; int ui = 0;
    if (!S.next(0, cur)) return;
    LAS float* biasbuf = (LAS float*)(lds + STAGE_BYTES + 2048);
    LAS int* rowbuf = (LAS int*)(lds + STAGE_BYTES + 4096);
    f32x4 acc[2][2][4][2];
#pragma unroll
    for (int a = 0; a < 2; ++a)
#pragma unroll
        for (int b = 0; b < 2; ++b)
#pragma unroll
            for (int m = 0; m < 4; ++m)
#pragma unroll
                for (int n = 0; n < 2; ++n) acc[a][b][m][n] = (f32x4){0.f, 0.f, 0.f, 0.f};
    bf16x8 At[4][2], B0[2][2], B1[2][2];
    unsigned vA[4];
    {
        unsigned rows[4] = {(unsigned)R0, (unsigned)R1, (unsigned)(HALF + R0), (unsigned)(HALF + R1)};
        if (S.gather) { rows[0] = (unsigned)*S.row_addr(cur, R0); rows[1] = (unsigned)*S.row_addr(cur, R1); rows[2] = (unsigned)*S.row_addr(cur, HALF + R0); rows[3] = (unsigned)*S.row_addr(cur, HALF + R1); }
        vA[0] = rows[0] * (unsigned)(K * 2) + cb0; vA[1] = rows[1] * (unsigned)(K * 2) + cb1; vA[2] = rows[2] * (unsigned)(K * 2) + cb0; vA[3] = rows[3] * (unsigned)(K * 2) + cb1;
    }
    const char* cA = S.a_base(cur); const char* cB = S.b_base(cur);
    G8_STAGE_B(G8_SB(0, 0), cB); G8_STAGE_A(G8_SA(0, 0), cA, vA, 0); G8_STAGE_B(G8_SB(0, 1), cB + hstepB); G8_STAGE_A(G8_SA(0, 1), cA, vA, 1);
    if (wr == 1) G8_BAR;
    G8_WAIT_V(4); G8_BAR;
    G8_STAGE_B(G8_SB(1, 0), cB + kstep); G8_STAGE_A(G8_SA(1, 0), cA + kstep, vA, 0); G8_STAGE_B(G8_SB(1, 1), cB + hstepB + kstep);
    G8_WAIT_V(6); G8_BAR;
    for (;;) {
        const bool has_next = S.next(ui + 1, nxt);
        const char* nA = has_next ? S.a_base(nxt) : cA; const char* nB = has_next ? S.b_base(nxt) : cB;
        const int nvalid = (S.gather && has_next) ? S.rows_valid(nxt) : 0;
        if (wid == 0) {
            if (Sched::HAS_BIAS) G8_GL(S.bias_src(cur, lane), STAGE_BYTES + 2048 + (ui & 1) * 1024);
            if (S.gather && has_next) G8_GL(S.row_addr(nxt, 0) + lane * 4, STAGE_BYTES + 4096 + ((ui + 1) & 1) * 1024);
        }
        for (int t = 0; t < nt; t += 2) {
            const bool last = (t == nt - 2);
            const char* a1 = cA + (size_t)(t + 1) * kstep;
            const char* a2 = last ? nA : cA + (size_t)(t + 2) * kstep; const char* b2 = last ? nB : cB + (size_t)(t + 2) * kstep;
            const char* a3 = a2 + kstep; const char* b3 = b2 + kstep;
            G8_LDB(B0, 0, 0); G8_SCHED; G8_LDA(At, 0, 0); G8_STAGE_A(G8_SA(1, 1), a1, vA, 1);
            if (last && S.gather && has_next) {
                const LAS int* rb = rowbuf + ((ui + 1) & 1) * 256;
                const unsigned r0 = R0 < nvalid ? (unsigned)rb[R0] : 0u, r1 = R1 < nvalid ? (unsigned)rb[R1] : 0u;
                const unsigned r2 = HALF + R0 < nvalid ? (unsigned)rb[HALF + R0] : 0u, r3 = HALF + R1 < nvalid ? (unsigned)rb[HALF + R1] : 0u;
                vA[0] = r0 * (unsigned)(K * 2) + cb0; vA[1] = r1 * (unsigned)(K * 2) + cb1; vA[2] = r2 * (unsigned)(K * 2) + cb0; vA[3] = r3 * (unsigned)(K * 2) + cb1;
            }
            G8_WAIT_L(8); G8_BAR; G8_WAIT_L(0); G8_MMA(0, 0, At, B0); G8_BAR; G8_SCHED;
            G8_LDB(B1, 0, 1); G8_STAGE_B(G8_SB(0, 0), b2);
            G8_BAR; G8_WAIT_L(0); G8_MMA(0, 1, At, B1); G8_BAR;
            G8_LDA(At, 0, 1); G8_STAGE_A(G8_SA(0, 0), a2, vA, 0);
            G8_BAR; G8_WAIT_L(0); G8_MMA(1, 0, At, B0); G8_BAR; G8_SCHED;
            G8_STAGE_B(G8_SB(0, 1), b2 + hstepB);
            G8_WAIT_V(6); G8_BAR; G8_MMA(1, 1, At, B1); G8_BAR;
            G8_LDB(B0, 1, 0); G8_SCHED; G8_LDA(At, 1, 0); G8_STAGE_A(G8_SA(0, 1), a2, vA, 1);
            G8_WAIT_L(8); G8_BAR; G8_WAIT_L(0); G8_MMA(0, 0, At, B0); G8_BAR; G8_SCHED;
            G8_LDB(B1, 1, 1); G8_STAGE_B(G8_SB(1, 0), b3);
            G8_BAR; G8_WAIT_L(0); G8_MMA(0, 1, At, B1); G8_BAR;
            G8_LDA(At, 1, 1); G8_STAGE_A(G8_SA(1, 0), a3, vA, 0);
            G8_BAR; G8_WAIT_L(0); G8_MMA(1, 0, At, B0); G8_BAR; G8_SCHED;
            G8_STAGE_B(G8_SB(1, 1), b3 + hstepB);
            G8_WAIT_V(6); G8_BAR; G8_MMA(1, 1, At, B1); G8_BAR;
        }
        E(acc, cur, wr, wc, fr, fq, biasbuf + (ui & 1) * 256);
        if (!has_next) break;
        if (!E.keep(cur))
#pragma unroll
        for (int a = 0; a < 2; ++a)
#pragma unroll
            for (int b = 0; b < 2; ++b)
#pragma unroll
                for (int m = 0; m < 4; ++m)
#pragma unroll
                    for (int n = 0; n < 2; ++n) acc[a][b][m][n] = (f32x4){0.f, 0.f, 0.f, 0.f};
        cur = nxt; cA = nA; cB = nB; ++ui;
    }
    G8_WAIT_V(0);
    if (wr == 0) G8_BAR;
    G8_BAR;
#undef G8_SA
#undef G8_SB
#undef G8_GL
#undef G8_STAGE_A
#undef G8_STAGE_B
#undef G8_LDA
#undef G8_LDB
#undef G8_MMA
#undef G8_WAIT_V
#undef G8_WAIT_L
#undef G8_BAR
#undef G8_SCHED
}

struct PlainSched {
    const bf16_t* A; const bf16_t* Bt; int K, nM, nN, nwg, G, c;
    __device__ __forceinline__ void init(const bf16_t* A_, const bf16_t* Bt_, int M, int N, int K_) { A = A_; Bt = Bt_; K = K_; nM = M / BM; nN = N / BM; nwg = nM * nN; G = gridDim.x; c = blockIdx.x; }
    __device__ __forceinline__ bool next(int i, Unit& u) const {
        const long L = (long)i * G + c; if (L >= nwg) return false;
        int wgid = (int)L; { const int q = nwg / 8, r = nwg % 8, xcd = wgid % 8, off = wgid / 8; wgid = (xcd < r ? xcd * (q + 1) : r * (q + 1) + (xcd - r) * q) + off; }
        const int nig = 8 * nN, gid = wgid / nig, fm = gid * 8, gsz = (nM - fm) < 8 ? (nM - fm) : 8;
        u.pm = fm + ((wgid % nig) % gsz); u.pn = (wgid % nig) / gsz; u.e = 0; return true;
    }
    __device__ __forceinline__ const char* a_base(const Unit& u) const { return (const char*)(A + (size_t)u.pm * BM * K); }
    __device__ __forceinline__ const char* b_base(const Unit& u) const { return (const char*)(Bt + (size_t)u.pn * BM * K); }
    static constexpr bool HAS_BIAS = false, gather = false;
    __device__ __forceinline__ const int* row_addr(const Unit&, int) const { return nullptr; }
    __device__ __forceinline__ int rows_valid(const Unit&) const { return 256; }
    __device__ __forceinline__ const float* bias_src(const Unit&, int) const { return nullptr; }
};
}

__device__ __forceinline__ int w1_dst_row(int n) { const int half = n >> 10, cc = n & 1023; return (cc >> 7) * 256 + half * 128 + (cc & 127); }

struct CvtTile { const float* src; bf16_t* dst; int ld, Nsrc, k0, n0, K, mode; };
__device__ __forceinline__ CvtTile cvt_decode(const Params& p, int it) {
    constexpr int PER_L = 2960 + 512 + 256 + 16384 + 8192;
    CvtTile t; const int l = it / PER_L; int r = it % PER_L;
    if (r < 2960) { const int nt = r % 185, kt = r / 185; t.src = p.w_in + (size_t)l * D * NIN; t.ld = NIN; t.Nsrc = NIN; t.k0 = kt * 64; t.n0 = nt * 64; t.dst = p.winT + (size_t)l * NPW * D; t.K = D; t.mode = 2; }
    else if (r < 3472) { r -= 2960; const int n = r / 128; r %= 128; const int nt = r % 16, kt = r / 16;
        t.src = p.w_branch + (size_t)(l * 4 + n) * MW * D; t.ld = D; t.Nsrc = D; t.k0 = kt * 64; t.n0 = nt * 64; t.dst = p.wbT + (size_t)(l * 4 + n) * D * MW; t.K = MW; t.mode = 0; }
    else if (r < 3728) { r -= 3472; const int nt = r % 16, kt = r / 16; t.src = p.w_out + (size_t)l * D * D; t.ld = D; t.Nsrc = D; t.k0 = kt * 64; t.n0 = nt * 64; t.dst = p.woutT + (size_t)l * D * D; t.K = D; t.mode = 0; }
    else if (r < 3728 + 16384) { r -= 3728; const int ee = r / 512; r %= 512; const int nt = r % 32, kt = r / 32;
        t.src = p.moe_w1 + (size_t)(l * NE + ee) * D * 2 * D; t.ld = 2 * D; t.Nsrc = 2 * D; t.k0 = kt * 64; t.n0 = nt * 64; t.dst = p.w1T + (size_t)(l * NE + ee) * 2 * D * D; t.K = D; t.mode = 1; }
    else { r -= 3728 + 16384; const int ee = r / 256; r %= 256; const int nt = r % 16, kt = r / 16;
        t.src = p.moe_w2 + (size_t)(l * NE + ee) * D * D; t.ld = D; t.Nsrc = D; t.k0 = kt * 64; t.n0 = nt * 64; t.dst = p.w2T + (size_t)(l * NE + ee) * D * D; t.K = D; t.mode = 0; }
    return t;
}

constexpr int CVT_TOTAL = 2 * (2960 + 512 + 256 + 16384 + 8192);
constexpr int CVT_G_FIRST = 932;
constexpr int CVT_G_L0 = 8008;
constexpr int CVT_G_ALL = CVT_TOTAL / 4;
__device__ __forceinline__ void cvt_trip(const Params& p, LAS float* tile, int tid, int g) {
    constexpr int TOTAL = CVT_TOTAL;
    float4 v[4][2];
    const int rr = tid >> 4, c4 = (tid & 15) * 4;
#pragma unroll
    for (int q = 0; q < 4; ++q) {
        const int it = g * 4 + q;
        const CvtTile t = cvt_decode(p, it < TOTAL ? it : TOTAL - 1);
        const int n = t.n0 + c4; const bool ok = n < t.Nsrc; const int nc = ok ? n : t.Nsrc - 4;
#pragma unroll
        for (int i = 0; i < 2; ++i) { const float4 x = *(const float4*)(t.src + (size_t)(t.k0 + rr + i * 32) * t.ld + nc); v[q][i] = ok ? x : make_float4(0.f, 0.f, 0.f, 0.f); }
    }
#pragma unroll
    for (int q = 0; q < 4; ++q)
#pragma unroll
        for (int i = 0; i < 2; ++i) { LAS float* tp = tile + q * 4160 + (rr + i * 32) * 65 + c4; tp[0] = v[q][i].x; tp[1] = v[q][i].y; tp[2] = v[q][i].z; tp[3] = v[q][i].w; }
    __syncthreads();
#pragma unroll
    for (int q = 0; q < 4; ++q) {
        const int it = g * 4 + q;
        if (it < TOTAL) {
            const CvtTile t = cvt_decode(p, it);
            const int nl = tid >> 3, kg = tid & 7, n = t.n0 + nl;
            float w[8];
#pragma unroll
            for (int j = 0; j < 8; ++j) w[j] = tile[q * 4160 + (kg * 8 + j) * 65 + nl];
            const int drow = t.mode == 1 ? w1_dst_row(n) : t.mode == 2 ? win_dst_row(n) : n;
            if (n < t.Nsrc) *(u32x4*)(t.dst + (size_t)drow * t.K + t.k0 + kg * 8) = pack8(w);
        }
    }
    __syncthreads();
}
__device__ __forceinline__ void cvt_fill(const Params& p, LAS unsigned char* lds, int w, int b1, int n1, int b2, int n2) {
    LAS float* tile = (LAS float*)lds; LAS int* tk = (LAS int*)(lds + 4 * 4160 * 4);
    int* const head = p.cnt + 256 + 32 * w;
    const int tid = opaque_tid();
    __syncthreads();
    int nxt = 0;
    if (tid == 0) nxt = atomicAdd(head, 1);
    for (;;) {
        if (tid == 0) tk[0] = nxt;
        __syncthreads();
        const int t = __builtin_amdgcn_readfirstlane(tk[0]);
        if (t >= n1 + n2) break;
        if (tid == 0) nxt = atomicAdd(head, 1);
        cvt_trip(p, tile, tid, t < n1 ? b1 + t : b2 + (t - n1));
    }
}
constexpr int CW_G1A = 932, CW_SEQ0A = 1932, CW_G2 = 4476, CW_G3 = 6476, CW_SEQ0B = 7076, CW_G1B = 8842, CW_SEQ1 = 9842;

__device__ __forceinline__ void ph_convert(const Params& p, LAS unsigned char* lds) {
    LAS float* tile = (LAS float*)lds;
    const int tid = opaque_tid();
    for (int idx = blockIdx.x * NTHREADS + tid; idx < 2 * 8 * 4 * 4096; idx += gridDim.x * NTHREADS) {
        const int i = idx & 63, j = (idx >> 6) & 63, mat = (idx >> 12) & 3, n = (idx >> 14) & 7, ll = idx >> 17, d = mat >> 1;
        p.lruT[idx] = (bf16_t)f2bf(((mat & 1) ? p.lru_wx : p.lru_wa)[(size_t)((ll * 2 + d) * 8 + n) * 4096 + i * 64 + j]);
    }
    for (int idx = blockIdx.x * NTHREADS + tid; idx < 2 * 2 * MW; idx += gridDim.x * NTHREADS) p.lsig[idx] = 8.0f * logsigmoidf_(p.lru_lambda[idx]);
    for (int idx = blockIdx.x * NTHREADS + tid; idx < TL * 64; idx += gridDim.x * NTHREADS) {
        const int t = idx >> 6, pi = idx & 63;
        const float pos = (pi < 32) ? (float)(t >> 6) : (float)(t & 63);
        const float ang = pos * exp2f(-(float)(pi & 31) * (13.287712379549449f / 32.0f));
        float sn, cs; sincosf(ang, &sn, &cs);
        p.rope[idx] = make_float2(cs, sn);
    }
    for (int idx = blockIdx.x * NTHREADS + tid; idx < 2 * 240 * (D / 8); idx += gridDim.x * NTHREADS) {
        const int ll = idx / (240 * (D / 8)), r = idx % (240 * (D / 8));
        *(u32x4*)(p.winT + ((size_t)ll * NPW + 7696) * D + (size_t)r * 8) = (u32x4){0u, 0u, 0u, 0u};
    }
    for (int g = blockIdx.x; g < CVT_G_FIRST; g += gridDim.x) cvt_trip(p, tile, tid, g);
}

__device__ __forceinline__ void ph_mod(const Params& p, LAS unsigned char* lds) {
    LAS float* sc = (LAS float*)lds;
    LAS float* red = sc + 5 * D;
    const int tid = opaque_tid(), wid = tid >> 6, lane = tid & 63;
    if ((int)blockIdx.x >= 192) return;
    for (int i = tid; i < 5 * D; i += NTHREADS) { const int r = i >> 10, k = i & 1023; const float v = r < 4 ? p.c[r * D + k] : p.c_ctx[k]; sc[i] = siluf_(v); }
    __syncthreads();
    for (int it = blockIdx.x; it < 192; it += gridDim.x) {
        const int l = it / 96, n0 = (it % 96) * 64;
        float acc[5] = {0.f, 0.f, 0.f, 0.f, 0.f};
        const float* wp = p.w_mod + (size_t)l * D * (NMOD * D) + n0 + lane;
        for (int k = wid * 128; k < wid * 128 + 128; ++k) {
            const float wv = wp[(size_t)k * (NMOD * D)];
#pragma unroll
            for (int r = 0; r < 5; ++r) acc[r] += sc[r * D + k] * wv;
        }
#pragma unroll
        for (int r = 0; r < 5; ++r) red[(wid * 5 + r) * 64 + lane] = acc[r];
        __syncthreads();
        if (tid < 320) { const int r = tid >> 6, cidx = tid & 63; float s = p.b_mod[l * NMOD * D + n0 + cidx];
#pragma unroll
            for (int w = 0; w < 8; ++w) s += red[(w * 5 + r) * 64 + cidx];
            p.mod[(size_t)(l * 5 + r) * (NMOD * D) + n0 + cidx] = s; }
        __syncthreads();
    }
}

__device__ __forceinline__ void norm_mod_store(const float4 (&v)[4], float rinv, const float* g, const float* scp, const float* shp, bf16_t* dst, int lane) {
#pragma unroll
    for (int i = 0; i < 4; ++i) {
        const int cidx = i * 256 + lane * 4;
        const float4 gv = *(const float4*)(g + cidx), sv = *(const float4*)(scp + cidx), hv = *(const float4*)(shp + cidx);
        const float h0 = v[i].x * rinv * gv.x * (1.f + sv.x) + hv.x, h1 = v[i].y * rinv * gv.y * (1.f + sv.y) + hv.y;
        const float h2 = v[i].z * rinv * gv.z * (1.f + sv.z) + hv.z, h3 = v[i].w * rinv * gv.w * (1.f + sv.w) + hv.w;
        u32x2 o; o[0] = pack2(h0, h1); o[1] = pack2(h2, h3);
        *(u32x2*)(dst + cidx) = o;
    }
}
__device__ __forceinline__ void ph_norm1_first(const Params& p) {
    const int tid = opaque_tid(), wid = tid >> 6, lane = tid & 63;
    for (int tok = blockIdx.x * NWAVES + wid; tok < NTOK; tok += gridDim.x * NWAVES) {
        const float* src = tok < NLAT ? p.x + (size_t)tok * D : p.ctx + (size_t)(tok - NLAT) * D;
        float4 v[4]; float ss = 0.f;
#pragma unroll
        for (int i = 0; i < 4; ++i) { v[i] = *(const float4*)(src + i * 256 + lane * 4); ss += v[i].x * v[i].x + v[i].y * v[i].y + v[i].z * v[i].z + v[i].w * v[i].w; }
        ss = wave_sum(ss, lane);
        const float rinv = rsqrtf(ss * (1.0f / D) + 1e-6f);
        const float* mb = p.mod + (size_t)(0 * 5 + tok_modrow(tok)) * (NMOD * D);
        norm_mod_store(v, rinv, p.norm1_g, mb + 1 * D, mb + 0 * D, p.H + (size_t)tok * D, lane);
#pragma unroll
        for (int i = 0; i < 4; ++i) { u32x2 o; o[0] = pack2(v[i].x, v[i].y); o[1] = pack2(v[i].z, v[i].w); *(u32x2*)(p.xl + (size_t)tok * D + i * 256 + lane * 4) = o; }
    }
}

struct EpiP {
    bf16_t* O; bf16_t* gate;
    __device__ __forceinline__ bool keep(const g8::Unit&) const { return false; }
    __device__ __forceinline__ void operator()(const f32x4 (&acc)[2][2][4][2], const g8::Unit& u, int wr, int wc, int fr, int fq, const LAS float*) const {
        if (u.pn < 31) {
            const int row0 = u.pm * 256 + wr * 64 + fr, col0 = u.pn * 256 + wc * 32 + 8 * fq;
#pragma unroll
            for (int ai = 0; ai < 2; ++ai)
#pragma unroll
                for (int m = 0; m < 4; ++m) {
                    bf16_t* rowp = O + (size_t)(row0 + ai * 128 + m * 16) * NP + col0;
#pragma unroll
                    for (int bj = 0; bj < 2; ++bj) {
                        u32x4 w; w[0] = pack2(acc[ai][bj][m][0][0], acc[ai][bj][m][0][1]); w[1] = pack2(acc[ai][bj][m][0][2], acc[ai][bj][m][0][3]);
                        w[2] = pack2(acc[ai][bj][m][1][0], acc[ai][bj][m][1][1]); w[3] = pack2(acc[ai][bj][m][1][2], acc[ai][bj][m][1][3]);
                        *(u32x4*)(rowp + bj * 128) = w;
                    }
                }
        } else {
            const int t = u.pn - 31;
            const int wave2 = wr * 4 + (t & 1) * 2 + (wc >> 1), lane2 = ((wc & 1) * 2 + (fq >> 1)) * 16 + fr, bj2 = (t & 3) >> 1;
            bf16_t* gp = gate + ((((size_t)u.pm * 16 + (t >> 2)) * 8 + wave2) * 16 + bj2) * 512 + lane2 * 8 + (fq & 1) * 4;
#pragma unroll
            for (int ai = 0; ai < 2; ++ai)
#pragma unroll
                for (int m = 0; m < 4; ++m) {
                    float r[4][4];
#pragma unroll
                    for (int j = 0; j < 4; ++j) {
                        float d[4];
#pragma unroll
                        for (int sg = 0; sg < 4; ++sg) d[sg] = 1.0f + __expf(-fminf(fmaxf(acc[ai][sg >> 1][m][sg & 1][j], -30.0f), 30.0f));
#pragma unroll
                        for (int sg = 0; sg < 4; ++sg) { const float gi = __builtin_amdgcn_rcpf(d[sg]); r[sg][j] = sg < 3 ? gi * d[sg + 1] : gi; }
                    }
#pragma unroll
                    for (int sg = 0; sg < 4; ++sg) {
                        uint2 w; w.x = pack2(r[sg][0], r[sg][1]); w.y = pack2(r[sg][2], r[sg][3]);
                        *(uint2*)(gp + (size_t)sg * (4 * 8 * 16 * 512) + (ai * 8 + m * 2) * 512) = w;
                    }
                }
        }
    }
};
__device__ __forceinline__ void ph_g1(const Params& p, int l, LAS unsigned char* lds) {
    g8::PlainSched S; S.init(p.H, p.winT + (size_t)l * NPW * D, NTOK, NPW, D);
    EpiP E; E.O = p.P; E.gate = p.gate;
    g8::gemm_phase(lds, D, S, E);
    if ((int)blockIdx.x >= (NTOK / 256) * (NPW / 256) % 256) { if (l == 0) cvt_fill(p, lds, 2, CW_G1A, CW_SEQ0A - CW_G1A, 0, 0); else cvt_fill(p, lds, 3, CW_G1B, CW_SEQ1 - CW_G1B, 0, 0); }
}

__device__ __forceinline__ void ph_prep(const Params& p, int l, LAS unsigned char* lds) {
    const int tid = opaque_tid(), wid = tid >> 6, lane = tid & 63, fr = lane & 15, fq = lane >> 4;
    LAS float* xs = (LAS float*)lds;
    LAS bf16_t* xb = (LAS bf16_t*)(xs + 64 * 68);
    LAS bf16_t* wt = xb + 64 * 72;
    for (int it = blockIdx.x; it < (NTOK / 64) * 8; it += gridDim.x) {
        const int tile = it >> 3, n = it & 7, tok0 = tile * 64;
        {
            const int tl = tid & 63, cg = tid >> 6, tok = tok0 + tl;
            int t, T, base; tok_info(tok, t, T, base);
            float a[8];
            { const float4 b0 = *(const float4*)(p.lru_conv_b + l * MW + n * 64 + cg * 8), b1 = *(const float4*)(p.lru_conv_b + l * MW + n * 64 + cg * 8 + 4);
              a[0] = b0.x; a[1] = b0.y; a[2] = b0.z; a[3] = b0.w; a[4] = b1.x; a[5] = b1.y; a[6] = b1.z; a[7] = b1.w; }
#pragma unroll
            for (int j = 0; j < 4; ++j) {
                const int tt = t + j - 2;
                const float okf = (tt >= 0 && tt < T) ? 1.0f : 0.0f;
                const int ttc = tt < 0 ? 0 : (tt >= T ? T - 1 : tt);
                const u32x4 u = *(const u32x4*)(p.P + (size_t)(base + ttc) * NP + C_LX + n * 64 + cg * 8);
                const float* w = p.lru_conv_w + (size_t)(l * 4 + j) * MW + n * 64 + cg * 8;
                const float4 wa = *(const float4*)w, wb = *(const float4*)(w + 4);
                const float wv[8] = {wa.x * okf, wa.y * okf, wa.z * okf, wa.w * okf, wb.x * okf, wb.y * okf, wb.z * okf, wb.w * okf};
#pragma unroll
                for (int q = 0; q < 4; ++q) { a[2 * q] += wv[2 * q] * bflo(u[q]); a[2 * q + 1] += wv[2 * q + 1] * bfhi(u[q]); }
            }
            *(LAS f32x4*)(xs + tl * 68 + cg * 8) = (f32x4){a[0], a[1], a[2], a[3]}; *(LAS f32x4*)(xs + tl * 68 + cg * 8 + 4) = (f32x4){a[4], a[5], a[6], a[7]};
            *(LAS u32x4*)(xb + tl * 72 + cg * 8) = pack8(a);
            const bf16_t* wsrc = p.lruT + (size_t)((l * 8 + n) * 4) * 4096;
#pragma unroll
            for (int q = 0; q < 4; ++q) { const int e8 = tid + 512 * q, row = e8 >> 3, c8 = e8 & 7; *(LAS u32x4*)(wt + row * 72 + c8 * 8) = *(const u32x4*)(wsrc + (size_t)e8 * 8); }
        }
        __syncthreads();
        {
            const int jb = wid & 3, tb0 = (wid >> 2) * 2;
            bf16x8 xw[4][2];
#pragma unroll
            for (int m = 0; m < 4; ++m)
#pragma unroll
                for (int ks = 0; ks < 2; ++ks) xw[m][ks] = *(const LAS bf16x8*)(wt + (m * 64 + jb * 16 + fr) * 72 + ks * 32 + fq * 8);
            const int c0 = n * 64 + jb * 16 + 4 * fq;
            float4 bav[2], bxv[2], lsv[2];
#pragma unroll
            for (int d = 0; d < 2; ++d) {
                bav[d] = *(const float4*)(p.lru_ba + (l * 2 + d) * MW + c0); bxv[d] = *(const float4*)(p.lru_bx + (l * 2 + d) * MW + c0);
                lsv[d] = *(const float4*)(p.lsig + (l * 2 + d) * MW + c0);
            }
#pragma unroll
            for (int e = 0; e < 2; ++e) {
                const int tl = (tb0 + e) * 16 + fr, tok = tok0 + tl;
                f32x4 acc[4];
#pragma unroll
                for (int m = 0; m < 4; ++m) acc[m] = (f32x4){0.f, 0.f, 0.f, 0.f};
#pragma unroll
                for (int ks = 0; ks < 2; ++ks) {
                    const bf16x8 y = *(const LAS bf16x8*)(xb + tl * 72 + ks * 32 + fq * 8);
#pragma unroll
                    for (int m = 0; m < 4; ++m) acc[m] = mfma16(xw[m][ks], y, acc[m]);
                }
                const f32x4 xv = *(const LAS f32x4*)(xs + tl * 68 + jb * 16 + 4 * fq);
#pragma unroll
                for (int d = 0; d < 2; ++d) {
                    const float bar_[4] = {bav[d].x, bav[d].y, bav[d].z, bav[d].w}, bxr[4] = {bxv[d].x, bxv[d].y, bxv[d].z, bxv[d].w}, lsr[4] = {lsv[d].x, lsv[d].y, lsv[d].z, lsv[d].w};
                    u32x4 au;
#pragma unroll
                    for (int r = 0; r < 4; ++r) {
                        const float gr = sigmoidf_(acc[d * 2][r] + bar_[r]), gi = sigmoidf_(acc[d * 2 + 1][r] + bxr[r]);
                        const float la = gr * lsr[r];
                        au[r] = pack2(la, xv[r] * gi * __builtin_amdgcn_sqrtf(fmaxf(1.0f - __expf(2.0f * la), 1e-12f)));
                    }
                    *(u32x4*)((unsigned*)p.prep + (size_t)d * TOKW + (size_t)tok * MW + c0) = au;
                }
            }
        }
        __syncthreads();
    }
}

__device__ __forceinline__ int chunk_base(int b, int d, int n) {
    if (n < 4) { const int blk = d ? 3 - n : n; return NLAT + b * TC + blk * 64; }
    const int m = n - 4, blk = d ? 63 - m : m; return b * TL + blk * 64;
}

typedef short s16x4 __attribute__((ext_vector_type(4)));
__device__ __forceinline__ unsigned imgb_off(unsigned row, unsigned ch) { return 256u * row + 16u * (ch ^ (((row & 3u) << 2) | ((row >> 2) & 3u))); }
__device__ __forceinline__ bf16x8 tr_frag(const LAS unsigned char* img, int lane, int c, int ks) {
    const unsigned g = (unsigned)lane >> 4, q = ((unsigned)lane & 15u) >> 2, pp = (unsigned)lane & 3u;
    const unsigned r0 = 32u * ks + 8u * g + q, chn = 2u * c + (pp >> 1);
    const s16x4 lo = __builtin_amdgcn_ds_read_tr16_b64_v4i16((LAS s16x4*)(img + imgb_off(r0, chn) + 8u * (pp & 1u)));
    const s16x4 hi = __builtin_amdgcn_ds_read_tr16_b64_v4i16((LAS s16x4*)(img + imgb_off(r0 + 4u, chn) + 8u * (pp & 1u)));
    return __builtin_shufflevector(lo, hi, 0, 1, 2, 3, 4, 5, 6, 7);
}
struct Raw6 { u32x4 r[6]; };
__device__ __forceinline__ void load_small(const Params& p, int j, int tid, Raw6& o) {
    const bool hg = j < NITEM; const int jj = hg ? j : j - NITEM, chain = jj / NCHUNK, n = jj % NCHUNK;
    const int ti = tid >> 3, dg = tid & 7, cA = dg * 8, cB = 64 + dg * 8;
    int b, h, d, tokI;
    if (hg) { b = chain >> 3; h = (chain >> 1) & 3; d = chain & 1; tokI = chunk_base(b, d, n) + (d ? 63 - ti : ti); }
    else { b = chain >> 2; h = chain & 3; d = 0; tokI = (n >= 4 ? b * TL + (n - 4) * 64 : NLAT + b * TC + n * 64) + ti; }
    const bf16_t* pr = p.P + (size_t)tokI * NP + h * 128;
    const int c0 = hg ? C_HQ : C_RQKV, c1 = hg ? C_HF + d * 512 : C_RQKV + 512, c2 = hg ? C_HI : C_RQKV + 1024;
    o.r[0] = *(const u32x4*)(pr + c0 + cA); o.r[1] = *(const u32x4*)(pr + c0 + cB); o.r[2] = *(const u32x4*)(pr + c1 + cA); o.r[3] = *(const u32x4*)(pr + c1 + cB);
    o.r[4] = *(const u32x4*)(pr + c2 + cA); o.r[5] = *(const u32x4*)(pr + c2 + cB);
}
__device__ __forceinline__ void local_gla(const Params& p, int l, int tz, int chain, int n, LAS unsigned char* lds, const Raw6& raw, int jn, Raw6& nxt) {
    const int tid = opaque_tid(), wid = tid >> 6, lane = tid & 63, fr = lane & 15, fq = lane >> 4;
    const int b = chain >> 3, h = (chain >> 1) & 3, d = chain & 1;
    const int base = chunk_base(b, d, n);
    const size_t item = (size_t)tz * NITEM + (size_t)chain * NCHUNK + n;
    LAS bf16_t* qh = (LAS bf16_t*)lds;
    LAS bf16_t* kh = qh + 64 * 136;
    LAS bf16_t* sc = kh + 10 * 16 * 136;
    LAS unsigned char* Vr = (LAS unsigned char*)(sc + 64 * 72);
    LAS unsigned char* Kr = Vr + 64 * 256;
    LAS float* bc = (LAS float*)(Kr + 64 * 256);
    const int ti = tid >> 3, dg = tid & 7, cA = dg * 8, cB = 64 + dg * 8;
    const int tokI = base + (d ? 63 - ti : ti);
    const bf16_t* pr = p.P + (size_t)tokI * NP;
    float qt[16], kv[16];
    {
        float lfv[16];
        if (tz == 1) {
            float lbv[16];
            {
                const float* lp0 = p.hgrn_lb + (size_t)(0 * 2 + d) * MW + h * 128; const float* lp1 = p.hgrn_lb + (size_t)(1 * 2 + d) * MW + h * 128;
                const float4 a0 = *(const float4*)(lp0 + cA), a1 = *(const float4*)(lp0 + cA + 4), a2 = *(const float4*)(lp0 + cB), a3 = *(const float4*)(lp0 + cB + 4);
                const float4 b0 = *(const float4*)(lp1 + cA), b1 = *(const float4*)(lp1 + cA + 4), b2 = *(const float4*)(lp1 + cB), b3 = *(const float4*)(lp1 + cB + 4);
                const float x0[16] = {a0.x, a0.y, a0.z, a0.w, a1.x, a1.y, a1.z, a1.w, a2.x, a2.y, a2.z, a2.w, a3.x, a3.y, a3.z, a3.w};
                const float x1[16] = {b0.x, b0.y, b0.z, b0.w, b1.x, b1.y, b1.z, b1.w, b2.x, b2.y, b2.z, b2.w, b3.x, b3.y, b3.z, b3.w};
#pragma unroll
                for (int e = 0; e < 16; ++e) lbv[e] = (l == 1) ? fminf(__builtin_amdgcn_rcpf(1.0f + __expf(x0[e] - x1[e])), 1.0f - 1e-4f) : 0.f;
            }
            __builtin_amdgcn_sched_barrier(0);
            load_small(p, jn, tid, nxt);
            __builtin_amdgcn_sched_barrier(0);
            const u32x4 uqa = raw.r[0], uqb = raw.r[1], uza = raw.r[2], uzb = raw.r[3];
#pragma unroll
            for (int e = 0; e < 16; ++e) {
                const unsigned uq = e < 8 ? uqa[(e & 7) >> 1] : uqb[(e & 7) >> 1], uz = e < 8 ? uza[(e & 7) >> 1] : uzb[(e & 7) >> 1];
                const float qraw = (e & 1) ? bfhi(uq) : bflo(uq), z = (e & 1) ? bfhi(uz) : bflo(uz);
                const float lb = lbv[e];
                const float sg = sigmoidf_(z);
                qt[e] = siluf_(qraw) * 0.08838834764831845f;
                kv[e] = (1.f - lb) * (1.f - sg);
                lfv[e] = __logf(fmaxf(lb + (1.f - lb) * sg, 1e-30f));
            }
        }
        *(LAS f32x4*)(bc + ti * 132 + cA) = (f32x4){lfv[0], lfv[1], lfv[2], lfv[3]}; *(LAS f32x4*)(bc + ti * 132 + cA + 4) = (f32x4){lfv[4], lfv[5], lfv[6], lfv[7]};
        *(LAS f32x4*)(bc + ti * 132 + cB) = (f32x4){lfv[8], lfv[9], lfv[10], lfv[11]}; *(LAS f32x4*)(bc + ti * 132 + cB + 4) = (f32x4){lfv[12], lfv[13], lfv[14], lfv[15]};
        *(LAS u32x4*)(Vr + imgb_off(ti, dg)) = raw.r[4]; *(LAS u32x4*)(Vr + imgb_off(ti, 8 + dg)) = raw.r[5];
    }
    __syncthreads();
    {
        const int ch = tid & 127, sg = tid >> 7;
        float run = 0.f, lv[16];
#pragma unroll
        for (int i = 0; i < 16; ++i) lv[i] = bc[(sg * 16 + i) * 132 + ch];
#pragma unroll
        for (int i = 0; i < 16; ++i) { run += lv[i]; bc[(sg * 16 + i) * 132 + ch] = run; }
    }
    __syncthreads();
    {
        const int J = ti >> 4;
        f32x4 bi4[4], rJ4[4], bl4[4], rI4[3][4];
        {
            const LAS float* bti = bc + ti * 132; const LAS float* bll = bc + 63 * 132;
#pragma unroll
            for (int q4 = 0; q4 < 4; ++q4) {
                const int off = (q4 < 2 ? cA : cB) + (q4 & 1) * 4;
                bi4[q4] = *(const LAS f32x4*)(bti + off); bl4[q4] = *(const LAS f32x4*)(bll + off);
#pragma unroll
                for (int I = 1; I < 4; ++I) rI4[I - 1][q4] = *(const LAS f32x4*)(bc + (16 * I - 1) * 132 + off);
            }
        }
        __builtin_amdgcn_sched_barrier(0);
#pragma unroll
        for (int q4 = 0; q4 < 4; ++q4) {
            rI4[1][q4] += rI4[0][q4]; rI4[2][q4] += rI4[1][q4];
            rJ4[q4] = J == 0 ? (f32x4){0.f, 0.f, 0.f, 0.f} : J == 1 ? rI4[0][q4] : J == 2 ? rI4[1][q4] : rI4[2][q4];
            bi4[q4] += rJ4[q4]; bl4[q4] += rI4[2][q4];
        }
        float qhat[16], ktv[16], biv[16];
#pragma unroll
        for (int e = 0; e < 16; ++e) {
            const float bi = bi4[e >> 2][e & 3], rJ = rJ4[e >> 2][e & 3], bl = bl4[e >> 2][e & 3];
            biv[e] = bi;
            qhat[e] = qt[e] * __expf(bi - rJ); qt[e] = qt[e] * __expf(bi);
            ktv[e] = kv[e] * __expf(bl - bi);
        }
        *(LAS u32x4*)(qh + ti * 136 + cA) = pack8(qhat); *(LAS u32x4*)(qh + ti * 136 + cB) = pack8(qhat + 8);
        *(LAS u32x4*)(Kr + imgb_off(ti, dg)) = pack8(ktv); *(LAS u32x4*)(Kr + imgb_off(ti, 8 + dg)) = pack8(ktv + 8);
#pragma unroll
        for (int I = 0; I < 4; ++I) {
            if (I >= J) {
                float kk[16];
#pragma unroll
                for (int e = 0; e < 16; ++e) {
                    const float rI = I ? rI4[I ? I - 1 : 0][e >> 2][e & 3] : 0.f;
                    kk[e] = kv[e] * __expf(fminf(rI - biv[e], 80.f));
                }
                LAS bf16_t* kp = kh + ((I * (I + 1) / 2 + J) * 16 + (ti & 15)) * 136;
                *(LAS u32x4*)(kp + cA) = pack8(kk); *(LAS u32x4*)(kp + cB) = pack8(kk + 8);
            }
        }
        *(LAS u32x4*)(sc + ti * 72 + dg * 8) = (u32x4){0u, 0u, 0u, 0u};
        {
            bf16_t* lqb = p.lq + item * 8192 + (size_t)((ti >> 4) * 8) * 256 + (ti & 15) * 4;
            const u32x4 pa = pack8(qt), pb = pack8(qt + 8);
            u32x2 t0; t0[0] = pa[0]; t0[1] = pa[1]; u32x2 t1; t1[0] = pa[2]; t1[1] = pa[3]; u32x2 t2; t2[0] = pb[0]; t2[1] = pb[1]; u32x2 t3; t3[0] = pb[2]; t3[1] = pb[3];
            *(u32x2*)(lqb + (dg >> 1) * 256 + ((dg & 1) * 2 + 0) * 64) = t0; *(u32x2*)(lqb + (dg >> 1) * 256 + ((dg & 1) * 2 + 1) * 64) = t1;
            *(u32x2*)(lqb + (4 + (dg >> 1)) * 256 + ((dg & 1) * 2 + 0) * 64) = t2; *(u32x2*)(lqb + (4 + (dg >> 1)) * 256 + ((dg & 1) * 2 + 1) * 64) = t3;
        }
    }
    if (tid < 128) p.ld[item * 128 + tid] = __expf(bc[15 * 132 + tid] + bc[31 * 132 + tid] + bc[47 * 132 + tid] + bc[63 * 132 + tid]);
    __syncthreads();
#pragma unroll
    for (int rep2 = 0; rep2 < 2; ++rep2) {
        const int t = wid + 8 * rep2;
        if (t < 10) {
            const int I = t >= 6 ? 3 : t >= 3 ? 2 : t >= 1 ? 1 : 0, J = t - I * (I + 1) / 2;
            f32x4 acc = (f32x4){0.f, 0.f, 0.f, 0.f};
#pragma unroll
            for (int ks = 0; ks < 4; ++ks)
                acc = mfma16(*(const LAS bf16x8*)(kh + (t * 16 + fr) * 136 + ks * 32 + fq * 8), *(const LAS bf16x8*)(qh + (I * 16 + fr) * 136 + ks * 32 + fq * 8), acc);
            const int i = 16 * I + fr, j0 = 16 * J + 4 * fq;
#pragma unroll
            for (int r = 0; r < 4; ++r) if (j0 + r > i) acc[r] = 0.f;
            *(LAS u32x2*)(sc + i * 72 + j0) = pack4(acc);
        }
    }
    __syncthreads();
    {
        bf16x8 xv[2], xk[2], ys[4][2];
#pragma unroll
        for (int ks = 0; ks < 2; ++ks) { xv[ks] = tr_frag(Vr, lane, wid, ks); xk[ks] = tr_frag(Kr, lane, wid, ks); }
#pragma unroll
        for (int ib = 0; ib < 4; ++ib)
#pragma unroll
            for (int ks = 0; ks < 2; ++ks) ys[ib][ks] = *(const LAS bf16x8*)(sc + (ib * 16 + fr) * 72 + ks * 32 + fq * 8);
        asm volatile("s_waitcnt lgkmcnt(0)" ::: "memory");
#pragma unroll
        for (int ib = 0; ib < 4; ++ib) {
            f32x4 acc = (f32x4){0.f, 0.f, 0.f, 0.f};
#pragma unroll
            for (int ks = 0; ks < 2; ++ks) acc = mfma16(xv[ks], ys[ib][ks], acc);
            *(u32x2*)(p.lo + item * 8192 + ((wid * 4 + ib) * 64 + lane) * 4) = pack4(acc);
        }
#pragma unroll
        for (int hb = 0; hb < 2; ++hb) {
            bf16x8 vf[4][2];
#pragma unroll
            for (int q = 0; q < 4; ++q)
#pragma unroll
                for (int ks = 0; ks < 2; ++ks) vf[q][ks] = tr_frag(Vr, lane, hb * 4 + q, ks);
            asm volatile("s_waitcnt lgkmcnt(0)" ::: "memory");
#pragma unroll
            for (int q = 0; q < 4; ++q) {
                const int dvb = hb * 4 + q;
                f32x4 acc = (f32x4){0.f, 0.f, 0.f, 0.f};
#pragma unroll
                for (int ks = 0; ks < 2; ++ks) acc = mfma16(xk[ks], vf[q][ks], acc);
                *(u32x2*)(p.lb + item * 16384 + ((wid * 8 + dvb) * 64 + lane) * 4) = pack4(acc);
            }
        }
    }
    __syncthreads();
}


template <int MODE> __device__ __forceinline__ void local_ret(const Params& p, int l, int chain, int n, LAS unsigned char* lds, const Raw6& raw, int jn, Raw6& nxt) {
    const int tid = opaque_tid(), wid = tid >> 6, lane = tid & 63, fr = lane & 15, fq = lane >> 4;
    const int b = chain >> 3, h = (chain >> 1) & 3, d = chain & 1;
    const int base = chunk_base(b, d, n);
    const size_t item = (size_t)2 * NITEM + (size_t)chain * NCHUNK + n;
    LAS bf16_t* ks_ = (LAS bf16_t*)lds;
    LAS bf16_t* qs = ks_ + 64 * 136;
    LAS bf16_t* sc = qs + 64 * 136;
    LAS unsigned char* Vr = (LAS unsigned char*)(sc + 64 * 72);
    LAS unsigned char* Kr = Vr + 64 * 256;
    const int ti = tid >> 3, dg = tid & 7, cA = dg * 8, cB = 64 + dg * 8;
    const int tokI = base + (d ? 63 - ti : ti);
    const bf16_t* pr = p.P + (size_t)tokI * NP + C_RQKV + h * 128;
    const float lng = ret_log_gamma(h);
    {
        const u32x4 q1 = raw.r[0], q2 = raw.r[1], k1 = raw.r[2], k2 = raw.r[3], v0 = raw.r[4], v1 = raw.r[5];
        const bool lat = tokI < NLAT;
        const int t = tokI & (TL - 1);
        float2 cstv[8];
#pragma unroll
        for (int e = 0; e < 8; ++e) cstv[e] = p.rope[(size_t)t * 64 + cA + e];
        __builtin_amdgcn_sched_barrier(0);
        load_small(p, jn, tid, nxt);
        __builtin_amdgcn_sched_barrier(0);
        float qv[16], kv[16];
#pragma unroll
        for (int e = 0; e < 8; ++e) {
            float a1 = (e & 1) ? bfhi(q1[e >> 1]) : bflo(q1[e >> 1]), a2 = (e & 1) ? bfhi(q2[e >> 1]) : bflo(q2[e >> 1]);
            float b1 = (e & 1) ? bfhi(k1[e >> 1]) : bflo(k1[e >> 1]), b2 = (e & 1) ? bfhi(k2[e >> 1]) : bflo(k2[e >> 1]);
            {
                const float2 cst = cstv[e];
                const float cs = lat ? cst.x : 1.0f, sn = lat ? cst.y : 0.0f;
                const float n1 = a1 * cs - a2 * sn, n2 = a1 * sn + a2 * cs, m1 = b1 * cs - b2 * sn, m2 = b1 * sn + b2 * cs;
                a1 = n1; a2 = n2; b1 = m1; b2 = m2;
            }
            qv[e] = a1; qv[8 + e] = a2; kv[e] = b1 * 0.08838834764831845f; kv[8 + e] = b2 * 0.08838834764831845f;
        }
        *(LAS u32x4*)(ks_ + ti * 136 + cA) = pack8(kv); *(LAS u32x4*)(ks_ + ti * 136 + cB) = pack8(kv + 8);
        *(LAS u32x4*)(qs + ti * 136 + cA) = pack8(qv); *(LAS u32x4*)(qs + ti * 136 + cB) = pack8(qv + 8);
        const float gq = __expf((float)(ti + 1) * lng), gk = __expf((float)(63 - ti) * lng);
        *(LAS u32x4*)(Vr + imgb_off(ti, dg)) = v0; *(LAS u32x4*)(Vr + imgb_off(ti, 8 + dg)) = v1;
        {
            float kg[16];
#pragma unroll
            for (int e = 0; e < 16; ++e) kg[e] = kv[e] * gk;
            *(LAS u32x4*)(Kr + imgb_off(ti, dg)) = pack8(kg); *(LAS u32x4*)(Kr + imgb_off(ti, 8 + dg)) = pack8(kg + 8);
        }
#pragma unroll
        for (int e = 0; e < 16; ++e) qv[e] *= gq;
        {
            bf16_t* lqb = p.lq + item * 8192 + (size_t)((ti >> 4) * 8) * 256 + (ti & 15) * 4;
            const u32x4 pa = pack8(qv), pb = pack8(qv + 8);
            u32x2 t0; t0[0] = pa[0]; t0[1] = pa[1]; u32x2 t1; t1[0] = pa[2]; t1[1] = pa[3]; u32x2 t2; t2[0] = pb[0]; t2[1] = pb[1]; u32x2 t3; t3[0] = pb[2]; t3[1] = pb[3];
            *(u32x2*)(lqb + (dg >> 1) * 256 + ((dg & 1) * 2 + 0) * 64) = t0; *(u32x2*)(lqb + (dg >> 1) * 256 + ((dg & 1) * 2 + 1) * 64) = t1;
            *(u32x2*)(lqb + (4 + (dg >> 1)) * 256 + ((dg & 1) * 2 + 0) * 64) = t2; *(u32x2*)(lqb + (4 + (dg >> 1)) * 256 + ((dg & 1) * 2 + 1) * 64) = t3;
        }
    }
    if (tid < 128) p.ld[item * 128 + tid] = __expf(64.0f * lng);
    __syncthreads();
#pragma unroll
    for (int e = 0; e < 2; ++e) {
        const int f = wid * 2 + e, ib = f >> 2, jb = f & 3;
        const int i = 16 * ib + fr, j0 = 16 * jb + 4 * fq;
        f32x4 mq = (f32x4){0.f, 0.f, 0.f, 0.f};
        if (jb <= ib) {
#pragma unroll
            for (int ks = 0; ks < 4; ++ks)
                mq = mfma16(*(const LAS bf16x8*)(ks_ + (jb * 16 + fr) * 136 + ks * 32 + fq * 8), *(const LAS bf16x8*)(qs + i * 136 + ks * 32 + fq * 8), mq);
#pragma unroll
            for (int r = 0; r < 4; ++r) { const int j = j0 + r; mq[r] = (j <= i) ? mq[r] * __expf((float)(i - j) * lng) : 0.f; }
        }
        *(LAS u32x2*)(sc + i * 72 + j0) = pack4(mq);
    }
    __syncthreads();
    {
        bf16x8 xv[2], xk[2];
#pragma unroll
        for (int ks = 0; ks < 2; ++ks) { xv[ks] = tr_frag(Vr, lane, wid, ks); xk[ks] = tr_frag(Kr, lane, wid, ks); }
#pragma unroll
        for (int ib = 0; ib < 4; ++ib) {
            f32x4 acc = (f32x4){0.f, 0.f, 0.f, 0.f};
#pragma unroll
            for (int ks = 0; ks < 2; ++ks) acc = mfma16(xv[ks], *(const LAS bf16x8*)(sc + (ib * 16 + fr) * 72 + ks * 32 + fq * 8), acc);
            *(u32x2*)(p.lo + item * 8192 + ((wid * 4 + ib) * 64 + lane) * 4) = pack4(acc);
        }
#pragma unroll
        for (int dvb = 0; dvb < 8; ++dvb) {
            f32x4 acc = (f32x4){0.f, 0.f, 0.f, 0.f};
#pragma unroll
            for (int ks = 0; ks < 2; ++ks) acc = mfma16(xk[ks], tr_frag(Vr, lane, dvb, ks), acc);
            *(u32x2*)(p.lb + item * 16384 + ((wid * 8 + dvb) * 64 + lane) * 4) = pack4(acc);
        }
    }
    __syncthreads();
}

__device__ __forceinline__ void local_ret_pair(const Params& p, int l, int bh, int seg, int blk, LAS unsigned char* lds, const Raw6& raw, int jn, Raw6& nxt) {
    const int tid = opaque_tid(), wid = tid >> 6, lane = tid & 63, fr = lane & 15, fq = lane >> 4;
    const int b = bh >> 2, h = bh & 3;
    const int base = seg ? b * TL + blk * 64 : NLAT + b * TC + blk * 64;
    const int nF = seg ? 4 + blk : blk, nB = seg ? 4 + (63 - blk) : 3 - blk;
    const size_t itemF = (size_t)2 * NITEM + (size_t)(bh * 2 + 0) * NCHUNK + nF, itemB = (size_t)2 * NITEM + (size_t)(bh * 2 + 1) * NCHUNK + nB;
    LAS bf16_t* ks_ = (LAS bf16_t*)lds;
    LAS bf16_t* qs = ks_ + 64 * 136;
    LAS bf16_t* scF = qs + 64 * 136;
    LAS bf16_t* scB = scF + 64 * 72;
    LAS unsigned char* Vr = (LAS unsigned char*)(scB + 64 * 72);
    LAS unsigned char* KrF = Vr + 64 * 256;
    LAS unsigned char* KrB = KrF + 64 * 256;
    const int ti = tid >> 3, dg = tid & 7, cA = dg * 8, cB = 64 + dg * 8;
    const int tokI = base + ti;
    const float lng = ret_log_gamma(h);
    (void)cB; (void)l;
    {
        const u32x4 q1 = raw.r[0], q2 = raw.r[1], k1 = raw.r[2], k2 = raw.r[3], v0 = raw.r[4], v1 = raw.r[5];
        const bool lat = tokI < NLAT;
        const int t = tokI & (TL - 1);
        float2 cstv[8];
#pragma unroll
        for (int e = 0; e < 8; ++e) cstv[e] = p.rope[(size_t)t * 64 + cA + e];
        __builtin_amdgcn_sched_barrier(0);
        load_small(p, jn, tid, nxt);
        __builtin_amdgcn_sched_barrier(0);
        float qv[16], kv[16];
#pragma unroll
        for (int e = 0; e < 8; ++e) {
            float a1 = (e & 1) ? bfhi(q1[e >> 1]) : bflo(q1[e >> 1]), a2 = (e & 1) ? bfhi(q2[e >> 1]) : bflo(q2[e >> 1]);
            float b1 = (e & 1) ? bfhi(k1[e >> 1]) : bflo(k1[e >> 1]), b2 = (e & 1) ? bfhi(k2[e >> 1]) : bflo(k2[e >> 1]);
            {
                const float2 cst = cstv[e];
                const float cs = lat ? cst.x : 1.0f, sn = lat ? cst.y : 0.0f;
                const float n1 = a1 * cs - a2 * sn, n2 = a1 * sn + a2 * cs, m1 = b1 * cs - b2 * sn, m2 = b1 * sn + b2 * cs;
                a1 = n1; a2 = n2; b1 = m1; b2 = m2;
            }
            qv[e] = a1; qv[8 + e] = a2; kv[e] = b1 * 0.08838834764831845f; kv[8 + e] = b2 * 0.08838834764831845f;
        }
        *(LAS u32x4*)(ks_ + ti * 136 + cA) = pack8(kv); *(LAS u32x4*)(ks_ + ti * 136 + cB) = pack8(kv + 8);
        *(LAS u32x4*)(qs + ti * 136 + cA) = pack8(qv); *(LAS u32x4*)(qs + ti * 136 + cB) = pack8(qv + 8);
        *(LAS u32x4*)(Vr + imgb_off(ti, dg)) = v0; *(LAS u32x4*)(Vr + imgb_off(ti, 8 + dg)) = v1;
        const float gkF = __expf((float)(63 - ti) * lng), gkB = __expf((float)ti * lng);
        const float gqF = __expf((float)(ti + 1) * lng), gqB = __expf((float)(64 - ti) * lng);
        {
            float kg[16];
#pragma unroll
            for (int e = 0; e < 16; ++e) kg[e] = kv[e] * gkF;
            *(LAS u32x4*)(KrF + imgb_off(ti, dg)) = pack8(kg); *(LAS u32x4*)(KrF + imgb_off(ti, 8 + dg)) = pack8(kg + 8);
#pragma unroll
            for (int e = 0; e < 16; ++e) kg[e] = kv[e] * gkB;
            *(LAS u32x4*)(KrB + imgb_off(ti, dg)) = pack8(kg); *(LAS u32x4*)(KrB + imgb_off(ti, 8 + dg)) = pack8(kg + 8);
        }
#pragma unroll
        for (int dd = 0; dd < 2; ++dd) {
            const int tl = dd ? 63 - ti : ti; const float gq = dd ? gqB : gqF;
            float qg[16];
#pragma unroll
            for (int e = 0; e < 16; ++e) qg[e] = qv[e] * gq;
            bf16_t* lqb = p.lq + (dd ? itemB : itemF) * 8192 + (size_t)((tl >> 4) * 8) * 256 + (tl & 15) * 4;
            const u32x4 pa = pack8(qg), pb = pack8(qg + 8);
            u32x2 t0; t0[0] = pa[0]; t0[1] = pa[1]; u32x2 t1; t1[0] = pa[2]; t1[1] = pa[3]; u32x2 t2; t2[0] = pb[0]; t2[1] = pb[1]; u32x2 t3; t3[0] = pb[2]; t3[1] = pb[3];
            *(u32x2*)(lqb + (dg >> 1) * 256 + ((dg & 1) * 2 + 0) * 64) = t0; *(u32x2*)(lqb + (dg >> 1) * 256 + ((dg & 1) * 2 + 1) * 64) = t1;
            *(u32x2*)(lqb + (4 + (dg >> 1)) * 256 + ((dg & 1) * 2 + 0) * 64) = t2; *(u32x2*)(lqb + (4 + (dg >> 1)) * 256 + ((dg & 1) * 2 + 1) * 64) = t3;
        }
    }
    if (tid < 256) p.ld[((tid & 128) ? itemB : itemF) * 128 + (tid & 127)] = __expf(64.0f * lng);
    __syncthreads();
#pragma unroll
    for (int e = 0; e < 2; ++e) {
        const int f = wid * 2 + e, ib = f >> 2, jb = f & 3;
        const int i = 16 * ib + fr, j0 = 16 * jb + 4 * fq;
        f32x4 mq = (f32x4){0.f, 0.f, 0.f, 0.f};
#pragma unroll
        for (int ks = 0; ks < 4; ++ks)
            mq = mfma16(*(const LAS bf16x8*)(ks_ + (jb * 16 + fr) * 136 + ks * 32 + fq * 8), *(const LAS bf16x8*)(qs + i * 136 + ks * 32 + fq * 8), mq);
        f32x4 mf, mb;
#pragma unroll
        for (int r = 0; r < 4; ++r) {
            const int j = j0 + r;
            const float dec = __expf((float)(i > j ? i - j : j - i) * lng);
            mf[r] = (j <= i) ? mq[r] * dec : 0.f; mb[r] = (j >= i) ? mq[r] * dec : 0.f;
        }
        *(LAS u32x2*)(scF + i * 72 + j0) = pack4(mf); *(LAS u32x2*)(scB + i * 72 + j0) = pack4(mb);
    }
    __syncthreads();
    {
        bf16x8 xv[2], xkF[2], xkB[2];
#pragma unroll
        for (int ks = 0; ks < 2; ++ks) { xv[ks] = tr_frag(Vr, lane, wid, ks); xkF[ks] = tr_frag(KrF, lane, wid, ks); xkB[ks] = tr_frag(KrB, lane, wid, ks); }
#pragma unroll
        for (int hb = 0; hb < 2; ++hb) {
            bf16x8 yF[2][2], yB[2][2];
#pragma unroll
            for (int q = 0; q < 2; ++q)
#pragma unroll
                for (int ks = 0; ks < 2; ++ks) {
                    yF[q][ks] = *(const LAS bf16x8*)(scF + ((hb * 2 + q) * 16 + fr) * 72 + ks * 32 + fq * 8);
                    yB[q][ks] = *(const LAS bf16x8*)(scB + ((hb * 2 + q) * 16 + fr) * 72 + ks * 32 + fq * 8);
                }
            asm volatile("s_waitcnt lgkmcnt(0)" ::: "memory");
#pragma unroll
            for (int q = 0; q < 2; ++q) {
                const int ib = hb * 2 + q;
                f32x4 aF = (f32x4){0.f, 0.f, 0.f, 0.f}, aB = (f32x4){0.f, 0.f, 0.f, 0.f};
#pragma unroll
                for (int ks = 0; ks < 2; ++ks) { aF = mfma16(xv[ks], yF[q][ks], aF); aB = mfma16(xv[ks], yB[q][ks], aB); }
                *(u32x2*)(p.lo + itemF * 8192 + ((wid * 4 + ib) * 64 + lane) * 4) = pack4(aF);
                *(u32x2*)(p.lo + itemB * 8192 + ((wid * 4 + (3 - ib)) * 64 + (15 - fr) + 16 * fq) * 4) = pack4(aB);
            }
        }
#pragma unroll
        for (int hb = 0; hb < 2; ++hb) {
            bf16x8 vf[4][2];
#pragma unroll
            for (int q = 0; q < 4; ++q)
#pragma unroll
                for (int ks = 0; ks < 2; ++ks) vf[q][ks] = tr_frag(Vr, lane, hb * 4 + q, ks);
            asm volatile("s_waitcnt lgkmcnt(0)" ::: "memory");
#pragma unroll
            for (int q = 0; q < 4; ++q) {
                const int dvb = hb * 4 + q;
                f32x4 aF = (f32x4){0.f, 0.f, 0.f, 0.f}, aB = (f32x4){0.f, 0.f, 0.f, 0.f};
#pragma unroll
                for (int ks = 0; ks < 2; ++ks) { aF = mfma16(xkF[ks], vf[q][ks], aF); aB = mfma16(xkB[ks], vf[q][ks], aB); }
                *(u32x2*)(p.lb + itemF * 16384 + ((wid * 8 + dvb) * 64 + lane) * 4) = pack4(aF);
                *(u32x2*)(p.lb + itemB * 16384 + ((wid * 8 + dvb) * 64 + lane) * 4) = pack4(aB);
            }
        }
    }
    __syncthreads();
}

__device__ __forceinline__ void local_gdn(const Params& p, int l, int bh, int seg, int blk, LAS unsigned char* lds) {
    const int tid = opaque_tid(), wid = tid >> 6, lane = tid & 63, fr = lane & 15, fq = lane >> 4;
    const int b = bh >> 2, h = bh & 3;
    const int base = seg ? b * TL + blk * 64 : NLAT + b * TC + blk * 64;
    LAS bf16_t* ks_ = (LAS bf16_t*)lds;
    LAS bf16_t* qs = ks_ + 64 * 136;
    LAS bf16_t* att = qs + 64 * 136;
    LAS bf16_t* wT = att + 64 * 72;
    LAS bf16_t* uT = wT + 128 * 72;
    LAS bf16_t* kT = uT + 128 * 72;
    LAS bf16_t* tT = kT;
    LAS bf16_t* Mneg = kT + 128 * 72;
    LAS float* Md = (LAS float*)(Mneg + 64 * 72);
    LAS float* bcs = (LAS float*)(kT + 128 * 72) + 64 * 68;
    LAS float* bts = bcs + 64;
    LAS float* rse = bts + 64;
    LAS bf16_t* vs = (LAS bf16_t*)(rse + 64);
    LAS bf16_t* Db = (LAS bf16_t*)(vs + 64 * 136);
    LAS float* cw = (LAS float*)(vs + 64 * 136);
    const int ti = tid >> 3, d0 = (tid & 7) * 16;
    const int tokI = base + ti;
    {
        int t, T, sbase; tok_info(tokI, t, T, sbase);
        u32x4 xr[3][4][2];
#pragma unroll
        for (int j = 0; j < 4; ++j) {
            const int tt = t + j - 2;
            const bool ok = (tt >= 0 && tt < T);
            const int ttc = tt < 0 ? 0 : (tt >= T ? T - 1 : tt);
            const bf16_t* xp = p.P + (size_t)(sbase + ttc) * NP + C_GQKV + h * 128 + d0;
#pragma unroll
            for (int part = 0; part < 3; ++part) {
                const u32x4 a0 = *(const u32x4*)(xp + part * 512), a1 = *(const u32x4*)(xp + part * 512 + 8);
#pragma unroll
                for (int q = 0; q < 4; ++q) { xr[part][j][0][q] = ok ? a0[q] : 0u; xr[part][j][1][q] = ok ? a1[q] : 0u; }
            }
        }
        if (tid < 384) {
            const int row = tid >> 5, c4 = (tid & 31) * 4, part = row >> 2, j = row & 3;
            *(LAS f32x4*)(cw + row * 128 + c4) = *(const f32x4*)(p.gdn_conv_w + (size_t)(l * 4 + j) * 1536 + part * 512 + h * 128 + c4);
        }
        __syncthreads();
#pragma unroll
        for (int part = 0; part < 3; ++part) {
            float a[16];
#pragma unroll
            for (int e = 0; e < 16; ++e) a[e] = 0.f;
#pragma unroll
            for (int j = 0; j < 4; ++j) {
                const u32x4 x0 = xr[part][j][0], x1 = xr[part][j][1];
                const LAS float* wp = cw + (part * 4 + j) * 128 + d0;
#pragma unroll
                for (int q = 0; q < 4; ++q) {
                    const f32x4 w0 = *(const LAS f32x4*)(wp + q * 4);
                    const unsigned ua = q < 2 ? x0[2 * q] : x1[2 * q - 4], ub = q < 2 ? x0[2 * q + 1] : x1[2 * q - 3];
                    a[q * 4] += w0[0] * bflo(ua); a[q * 4 + 1] += w0[1] * bfhi(ua); a[q * 4 + 2] += w0[2] * bflo(ub); a[q * 4 + 3] += w0[3] * bfhi(ub);
                }
            }
            float ss = 0.f;
#pragma unroll
            for (int e = 0; e < 16; ++e) { a[e] = siluf_(a[e]); ss += a[e] * a[e]; }
            if (part < 2) {
                ss += shx(ss, 1, lane); ss += shx(ss, 2, lane); ss += shx(ss, 4, lane);
                const float scl = rsqrtf(ss + 1e-6f) * (part == 0 ? 0.08838834764831845f : 1.0f);
#pragma unroll
                for (int e = 0; e < 16; ++e) a[e] *= scl;
            }
            LAS bf16_t* dstt = (part == 0 ? qs : part == 1 ? ks_ : vs) + ti * 136 + d0;
            *(LAS u32x4*)dstt = pack8(a); *(LAS u32x4*)(dstt + 8) = pack8(a + 8);
        }
    }
#pragma unroll 1
  for (int d = 0; d < 2; ++d) {
    const int n = seg ? 4 + (d ? 63 - blk : blk) : (d ? 3 - blk : blk);
    const size_t item = (size_t)(bh * 2 + d) * NCHUNK + n;
#define RR(x) (d ? 63 - (x) : (x))
    const int tid = opaque_tid(), wid = tid >> 6, lane = tid & 63, fr = lane & 15, fq = lane >> 4, ti = tid >> 3, d0 = (tid & 7) * 16;
    if (wid == 0) {
        const int tok = base + RR(lane);
        const float av = bf2f(p.P[(size_t)tok * NP + C_GA + d * 4 + h]);
        float v = -__expf(p.gdn_a_log[l * 8 + d * 4 + h]) * softplusf_(av + p.gdn_dt_bias[l * 8 + d * 4 + h]);
#pragma unroll
        for (int off = 1; off < 64; off <<= 1) { const float t = shup(v, off, lane); if (lane >= off) v += t; }
        const float btv = sigmoidf_(bf2f(p.P[(size_t)tok * NP + C_GB + d * 4 + h]));
        bcs[lane] = v; bts[lane] = btv; rse[lane] = btv * __expf(v);
    }
    __syncthreads();
#pragma unroll
    for (int e = 0; e < 2; ++e) {
        const int f = wid * 2 + e, ib = f >> 2, jb = f & 3;
        const int i = 16 * ib + fr, j0 = 16 * jb + 4 * fq;
        f32x4 mk = (f32x4){0.f, 0.f, 0.f, 0.f}, mq = (f32x4){0.f, 0.f, 0.f, 0.f};
        if (jb <= ib) {
#pragma unroll
            for (int ks = 0; ks < 4; ++ks) {
                const bf16x8 xk = *(const LAS bf16x8*)(ks_ + RR(jb * 16 + fr) * 136 + ks * 32 + fq * 8);
                mk = mfma16(xk, *(const LAS bf16x8*)(ks_ + RR(ib * 16 + fr) * 136 + ks * 32 + fq * 8), mk);
                mq = mfma16(xk, *(const LAS bf16x8*)(qs + RR(ib * 16 + fr) * 136 + ks * 32 + fq * 8), mq);
            }
            const float bi = bcs[i], bti = bts[i];
#pragma unroll
            for (int r = 0; r < 4; ++r) {
                const int j = j0 + r;
                const float dec = __expf(j <= i ? bi - bcs[j] : 0.f);
                mk[r] = (j < i) ? bti * mk[r] * dec : 0.f;
                mq[r] = (j <= i) ? mq[r] * dec : 0.f;
            }
        }
        {
            u32x2 mn; mn[0] = 0u; mn[1] = 0u;
            if (jb < ib) mn = pack4((f32x4){-mk[0], -mk[1], -mk[2], -mk[3]});
            *(LAS u32x2*)(Mneg + i * 72 + j0) = mn;
            if (jb == ib) *(LAS f32x4*)(Md + (ib * 16 + fr) * 20 + 4 * fq) = mk;
        }
        *(LAS u32x2*)(att + i * 72 + j0) = pack4(mq);
        if (e == 0) {
            const int zr = tid >> 1, zh = tid & 1;
            LAS bf16_t* zx = (zr < 128 ? uT + zr * 72 : wT + (zr - 128) * 72) + zh * 32;
#pragma unroll
            for (int q = 0; q < 4; ++q) *(LAS u32x4*)(zx + q * 8) = (u32x4){0u, 0u, 0u, 0u};
            *(LAS u32x4*)(tT + zr * 32 + 16 + zh * 8) = (u32x4){0u, 0u, 0u, 0u};
        }
    }
    __syncthreads();
    if (wid == 0) {
        const int R = lane >> 4, cc = lane & 15;
        float y[16];
#pragma unroll
        for (int i = 0; i < 16; ++i) {
            float acc = (i == cc) ? 1.0f : 0.0f;
#pragma unroll
            for (int j4 = 0; j4 < (i + 3) / 4; ++j4) {
                const f32x4 m = *(const LAS f32x4*)(Md + (R * 16 + i) * 20 + j4 * 4);
#pragma unroll
                for (int q = 0; q < 4; ++q) if (j4 * 4 + q < i) acc -= m[q] * y[j4 * 4 + q];
            }
            y[i] = acc;
            Db[(R * 16 + i) * 40 + cc] = (bf16_t)f2bf(acc);
        }
        *(LAS u32x4*)(Db + lane * 40 + 16) = (u32x4){0u, 0u, 0u, 0u}; *(LAS u32x4*)(Db + lane * 40 + 24) = (u32x4){0u, 0u, 0u, 0u};
    }
    __syncthreads();
#pragma unroll
    for (int R = 0; R < 4; ++R) {
        f32x4 tacc[2];
#pragma unroll
        for (int e = 0; e < 2; ++e) {
            const int cb = wid * 2 + e;
            const int i = 16 * R + fr;
            const u32x2 rv = *(const LAS u32x2*)((cb < 8 ? vs + cb * 16 : ks_ + (cb - 8) * 16) + RR(i) * 136 + 4 * fq);
            const float sc = cb < 8 ? bts[i] : -rse[i];
            f32x4 acc = (f32x4){bflo(rv[0]) * sc, bfhi(rv[0]) * sc, bflo(rv[1]) * sc, bfhi(rv[1]) * sc};
            if (R > 0) {
                const LAS bf16_t* xt = (cb < 8 ? uT + cb * 16 * 72 : wT + (cb - 8) * 16 * 72) + fr * 72 + fq * 8;
#pragma unroll
                for (int ks = 0; ks < (R + 1) / 2; ++ks) acc = mfma16(*(const LAS bf16x8*)(xt + ks * 32), *(const LAS bf16x8*)(Mneg + i * 72 + ks * 32 + fq * 8), acc);
            }
            tacc[e] = acc;
            LAS bf16_t* tp = tT + (cb * 16 + 4 * fq) * 32 + fr;
            tp[0] = (bf16_t)f2bf(acc[0]); tp[32] = (bf16_t)f2bf(acc[1]); tp[64] = (bf16_t)f2bf(acc[2]); tp[96] = (bf16_t)f2bf(acc[3]);
        }
        __syncthreads();
#pragma unroll
        for (int e = 0; e < 2; ++e) {
            const int cb = wid * 2 + e;
            f32x4 acc = (f32x4){0.f, 0.f, 0.f, 0.f};
            acc = mfma16(*(const LAS bf16x8*)(tT + (cb * 16 + fr) * 32 + fq * 8), *(const LAS bf16x8*)(Db + (R * 16 + fr) * 40 + fq * 8), acc);
            LAS bf16_t* xp = (cb < 8 ? uT + cb * 16 * 72 : wT + (cb - 8) * 16 * 72) + (4 * fq) * 72 + 16 * R + fr;
            xp[0] = (bf16_t)f2bf(acc[0]); xp[72] = (bf16_t)f2bf(acc[1]); xp[144] = (bf16_t)f2bf(acc[2]); xp[216] = (bf16_t)f2bf(acc[3]);
        }
        __syncthreads();
    }
    {
        const int pi = RR(ti);
        const float sc_ = __expf(bcs[63] - bcs[pi]);
        const u32x4 ka = *(const LAS u32x4*)(ks_ + ti * 136 + d0), kb = *(const LAS u32x4*)(ks_ + ti * 136 + d0 + 8);
        float kf[16];
#pragma unroll
        for (int q = 0; q < 4; ++q) { kf[2 * q] = bflo(ka[q]) * sc_; kf[2 * q + 1] = bfhi(ka[q]) * sc_; kf[8 + 2 * q] = bflo(kb[q]) * sc_; kf[9 + 2 * q] = bfhi(kb[q]) * sc_; }
        LAS unsigned char* Kr = (LAS unsigned char*)kT;
        *(LAS u32x4*)(Kr + imgb_off(pi, 2 * (tid & 7))) = pack8(kf); *(LAS u32x4*)(Kr + imgb_off(pi, 2 * (tid & 7) + 1)) = pack8(kf + 8);
    }
    if (tid < 128) p.ld[item * 128 + tid] = __expf(bcs[63]);
    __syncthreads();
    {
        const int tid = opaque_tid(), wid = tid >> 6, lane = tid & 63, fr = lane & 15, fq = lane >> 4;
        bf16x8 xw[2], xu[2], xk[2];
#pragma unroll
        for (int ks = 0; ks < 2; ++ks) {
            xw[ks] = *(const LAS bf16x8*)(wT + (wid * 16 + fr) * 72 + ks * 32 + fq * 8);
            xu[ks] = *(const LAS bf16x8*)(uT + (wid * 16 + fr) * 72 + ks * 32 + fq * 8);
            xk[ks] = tr_frag((const LAS unsigned char*)kT, lane, wid, ks);
        }
#pragma unroll
        for (int ib = 0; ib < 4; ++ib) {
            const int i = ib * 16 + fr;
            const u32x2 qr = *(const LAS u32x2*)(qs + RR(i) * 136 + wid * 16 + 4 * fq);
            const float eb = __expf(bcs[i]);
            f32x4 aq = (f32x4){bflo(qr[0]) * eb, bfhi(qr[0]) * eb, bflo(qr[1]) * eb, bfhi(qr[1]) * eb};
            f32x4 ao = (f32x4){0.f, 0.f, 0.f, 0.f};
#pragma unroll
            for (int ks = 0; ks < 2; ++ks) {
                const bf16x8 ya = *(const LAS bf16x8*)(att + i * 72 + ks * 32 + fq * 8);
                aq = mfma16(xw[ks], ya, aq); ao = mfma16(xu[ks], ya, ao);
            }
            *(u32x2*)(p.lq + item * 8192 + ((ib * 8 + wid) * 64 + lane) * 4) = pack4(aq);
            *(u32x2*)(p.lo + item * 8192 + ((wid * 4 + ib) * 64 + lane) * 4) = pack4(ao);
        }
#pragma unroll
        for (int hb = 0; hb < 4; ++hb) {
            bf16x8 kf[2][2], uf[2][2];
#pragma unroll
            for (int q = 0; q < 2; ++q)
#pragma unroll
                for (int ks = 0; ks < 2; ++ks) {
                    kf[q][ks] = tr_frag((const LAS unsigned char*)kT, lane, hb * 2 + q, ks);
                    uf[q][ks] = *(const LAS bf16x8*)(uT + ((hb * 2 + q) * 16 + fr) * 72 + ks * 32 + fq * 8);
                }
            asm volatile("s_waitcnt lgkmcnt(0)" ::: "memory");
#pragma unroll
            for (int q = 0; q < 2; ++q) {
                const int db = hb * 2 + q;
                f32x4 aa = (f32x4){0.f, 0.f, 0.f, 0.f}, ab = (f32x4){0.f, 0.f, 0.f, 0.f};
#pragma unroll
                for (int ks = 0; ks < 2; ++ks) {
                    aa = mfma16(xw[ks], kf[q][ks], aa);
                    ab = mfma16(xk[ks], uf[q][ks], ab);
                }
                *(u32x2*)(p.la + item * 16384 + ((db * 8 + wid) * 64 + lane) * 4) = pack4(aa);
                *(u32x2*)(p.lb + item * 16384 + ((wid * 8 + db) * 64 + lane) * 4) = pack4(ab);
            }
        }
    }
    __syncthreads();
  }
#undef RR
}

__device__ __forceinline__ void ph_local(const Params& p, int l, LAS unsigned char* lds) {
    constexpr int NG = NITEM / 2;
    const int G = gridDim.x;
    int it = blockIdx.x;
    for (; it < NG; it += G) { const int bh = it / NCHUNK, c = it % NCHUNK; local_gdn(p, l, bh, c >= 4, c >= 4 ? c - 4 : c, lds); }
    constexpr int NSM = NITEM + NITEM / 2;
    Raw6 nxt;
    if (it < NG + NSM) load_small(p, it - NG, opaque_tid(), nxt);
    for (; it < NG + NSM; it += G) {
        const Raw6 cur = nxt;
        const int jn = (it + G < NG + NSM ? it + G : it) - NG;
        if (it < NG + NITEM) { const int idx = it - NG; local_gla(p, l, 1, idx / NCHUNK, idx % NCHUNK, lds, cur, jn, nxt); }
        else { const int idx = it - NG - NITEM, bh = idx / NCHUNK, c = idx % NCHUNK; local_ret_pair(p, l, bh, c >= 4, c >= 4 ? c - 4 : c, lds, cur, jn, nxt); }
    }
}

__device__ __forceinline__ void seq_matrix(const Params& p, int tz, int chain, int half, LAS unsigned char* lds) {
    const int tid = opaque_tid(), wid = tid >> 6, lane = tid & 63, fr = lane & 15, fq = lane >> 4;
    const int b = chain >> 3, h = (chain >> 1) & 3, d = chain & 1;
    LAS bf16_t* ST = (LAS bf16_t*)lds;
    bf16_t* Op = p.O + (size_t)((tz == 0 ? 0 : tz == 1 ? 1 : 3) * 2 + d) * TOKW;
    f32x4 S[4];
#pragma unroll
    for (int q = 0; q < 4; ++q) S[q] = (f32x4){0.f, 0.f, 0.f, 0.f};
    const int ib = wid >> 1, dv2 = (wid & 1) * 2;
    struct Ops { u32x2 yq[8], xa[8], oin[2], bin[4]; f32x4 dec; };
    auto load_ops = [&](int n, Ops& o) {
        const size_t item = (size_t)tz * NITEM + (size_t)chain * NCHUNK + n;
        const bf16_t* lqp = p.lq + item * 8192 + (size_t)(ib * 8) * 256 + lane * 4;
#pragma unroll
        for (int q = 0; q < 8; ++q) o.yq[q] = *(const u32x2*)(lqp + q * 256);
        if (tz == 0) {
            const bf16_t* lap = p.la + ((size_t)chain * NCHUNK + n) * 16384 + (size_t)(wid * 8) * 256 + lane * 4;
#pragma unroll
            for (int q = 0; q < 8; ++q) o.xa[q] = *(const u32x2*)(lap + q * 256);
        }
#pragma unroll
        for (int e2 = 0; e2 < 2; ++e2)
            o.oin[e2] = *(const u32x2*)(p.lo + item * 8192 + (((half * 4 + dv2 + (fq >> 1)) * 4 + ib) * 64 + fr + 16 * (2 * (fq & 1) + e2)) * 4);
#pragma unroll
        for (int q = 0; q < 4; ++q) o.bin[q] = *(const u32x2*)(p.lb + item * 16384 + ((wid * 8 + half * 4 + q) * 64 + lane) * 4);
        o.dec = *(const f32x4*)(p.ld + item * 128 + wid * 16 + 4 * fq);
    };
    Ops s0, s1; load_ops(0, s0);
    auto step = [&](int n, Ops& cur, Ops& fill) {
        load_ops(n + 1 < NCHUNK ? n + 1 : n, fill);
        LAS bf16_t* st = ST + (n & 1) * 64 * 136;
#pragma unroll
        for (int q = 0; q < 4; ++q) *(LAS u32x2*)(st + (q * 16 + fr) * 136 + 32 * (wid >> 1) + 8 * fq + 4 * (wid & 1)) = pack4(S[q]);
        __syncthreads();
        const int base = chunk_base(b, d, n);
        const int tok = base + (d ? 63 - (ib * 16 + fr) : ib * 16 + fr);
        {
            bf16x8 xo[2][4];
#pragma unroll
            for (int e2 = 0; e2 < 2; ++e2) {
                const int prow = dv2 * 16 + 8 * (fr >> 2) + 4 * e2 + (fr & 3);
#pragma unroll
                for (int ks = 0; ks < 4; ++ks) xo[e2][ks] = *(const LAS bf16x8*)(st + prow * 136 + ks * 32 + fq * 8);
            }
            asm volatile("s_waitcnt lgkmcnt(0)" ::: "memory");
            f32x4 ao[2];
#pragma unroll
            for (int e2 = 0; e2 < 2; ++e2) {
                f32x4 acc = (f32x4){bflo(cur.oin[e2][0]), bfhi(cur.oin[e2][0]), bflo(cur.oin[e2][1]), bfhi(cur.oin[e2][1])};
#pragma unroll
                for (int ks = 0; ks < 4; ++ks) {
                    u32x4 t; t[0] = cur.yq[2 * ks][0]; t[1] = cur.yq[2 * ks][1]; t[2] = cur.yq[2 * ks + 1][0]; t[3] = cur.yq[2 * ks + 1][1];
                    acc = mfma16(xo[e2][ks], __builtin_bit_cast(bf16x8, t), acc);
                }
                ao[e2] = acc;
            }
            bf16_t* op = Op + (size_t)tok * MW + h * 128 + half * 64 + dv2 * 16 + 8 * fq;
            { u32x4 w; w[0] = pack2(ao[0][0], ao[0][1]); w[1] = pack2(ao[0][2], ao[0][3]); w[2] = pack2(ao[1][0], ao[1][1]); w[3] = pack2(ao[1][2], ao[1][3]); *(u32x4*)op = w; }
#pragma unroll
            for (int qh = 0; qh < 2; ++qh) {
                bf16x8 xs[2][4];
                if (tz == 0) {
#pragma unroll
                    for (int q2 = 0; q2 < 2; ++q2)
#pragma unroll
                        for (int ks = 0; ks < 4; ++ks) xs[q2][ks] = *(const LAS bf16x8*)(st + ((qh * 2 + q2) * 16 + fr) * 136 + ks * 32 + fq * 8);
                    asm volatile("s_waitcnt lgkmcnt(0)" ::: "memory");
                }
#pragma unroll
                for (int q2 = 0; q2 < 2; ++q2) {
                    const int q = qh * 2 + q2;
                    f32x4 acc = (f32x4){cur.dec[0] * S[q][0] + bflo(cur.bin[q][0]), cur.dec[1] * S[q][1] + bfhi(cur.bin[q][0]), cur.dec[2] * S[q][2] + bflo(cur.bin[q][1]), cur.dec[3] * S[q][3] + bfhi(cur.bin[q][1])};
                    if (tz == 0) {
#pragma unroll
                        for (int ks = 0; ks < 4; ++ks) {
                            u32x4 t; t[0] = cur.xa[2 * ks][0]; t[1] = cur.xa[2 * ks][1]; t[2] = cur.xa[2 * ks + 1][0]; t[3] = cur.xa[2 * ks + 1][1];
                            acc = mfma16(__builtin_bit_cast(bf16x8, t), xs[q2][ks], acc);
                        }
                    }
                    S[q] = acc;
                }
            }
        }
    };
    for (int n = 0; n < NCHUNK; n += 2) {
        step(n, s0, s1);
        step(n + 1, s1, s0);
    }
    __syncthreads();
}

__device__ __forceinline__ void seq_lru(const Params& p, int b, int d, int cg, LAS unsigned char* lds) {
    const int tid = opaque_tid(), seg = tid >> 6, ch = cg * 64 + (tid & 63);
    LAS float* sP = (LAS float*)lds;
    LAS float* sL = sP + 512;
    const unsigned* AU = (const unsigned*)p.prep + (size_t)d * TOKW + ch;
    bf16_t* Op = p.O + (size_t)(2 * 2 + d) * TOKW + ch;
    constexpr int SEG = (TC + TL) / 8;
    auto tok_of = [&](int pos) { return pos < TC ? NLAT + b * TC + (d ? TC - 1 - pos : pos) : b * TL + (d ? TL - 1 - (pos - TC) : pos - TC); };
    float P = 1.f, L = 0.f;
    for (int i0 = 0; i0 < SEG; i0 += 32) {
        unsigned wv[32];
#pragma unroll
        for (int q = 0; q < 32; ++q) wv[q] = AU[(size_t)tok_of(seg * SEG + i0 + q) * MW];
#pragma unroll
        for (int q = 0; q < 32; ++q) { const float a = __expf(bflo(wv[q])); L = a * L + bfhi(wv[q]); P *= a; }
    }
    sP[tid] = P; sL[tid] = L;
    __syncthreads();
    float hst = 0.f;
    for (int s = 0; s < seg; ++s) hst = sP[s * 64 + (tid & 63)] * hst + sL[s * 64 + (tid & 63)];
    for (int i0 = 0; i0 < SEG; i0 += 32) {
        unsigned wv[32];
#pragma unroll
        for (int q = 0; q < 32; ++q) wv[q] = AU[(size_t)tok_of(seg * SEG + i0 + q) * MW];
#pragma unroll
        for (int q = 0; q < 32; ++q) { hst = __expf(bflo(wv[q])) * hst + bfhi(wv[q]); Op[(size_t)tok_of(seg * SEG + i0 + q) * MW] = (bf16_t)f2bf(hst); }
    }
    __syncthreads();
}

__device__ __forceinline__ void ph_seq(const Params& p, int l, LAS unsigned char* lds) {
    for (int it = blockIdx.x; it < 256; it += gridDim.x) {
        if (it < 192) { const int tz = it >> 6, r = it & 63; seq_matrix(p, tz, (r & 7) | ((r >> 4) << 3), (r >> 3) & 1, lds); }
        else { const int r = it - 192; seq_lru(p, r >> 4, (r >> 3) & 1, r & 7, lds); }
    }
    if (l == 0) cvt_fill(p, lds, 0, CW_SEQ0A, CW_G2 - CW_SEQ0A, CW_SEQ0B, CW_G1B - CW_SEQ0B); else cvt_fill(p, lds, 1, CW_SEQ1, CVT_G_ALL - CW_SEQ1, 0, 0);
}

__device__ __forceinline__ void ph_merge(const Params& p, int l, int M) {
    const int tid = opaque_tid(), wid = tid >> 6, lane = tid & 63;
    const bf16_t* Ob = opaque_sptr(p.O); const bf16_t* Pb = opaque_sptr(p.P); bf16_t* Yb = opaque_sptr(p.Y);
    float2 gn[3];
#pragma unroll
    for (int m = 0; m < 3; ++m) gn[m] = *(const float2*)((m == 0 ? p.gdn_norm_g : m == 1 ? p.hgrn_norm_g : p.ret_norm_g) + l * 128 + lane * 2);
    for (int tok = blockIdx.x * NWAVES + wid; tok < M; tok += gridDim.x * NWAVES) {
        unsigned o0[16], o1[16], gz[16];
#pragma unroll
        for (int r = 0; r < 16; ++r) {
            const int m = r >> 2, head = r & 3, cidx = head * 128 + lane * 2;
            const size_t o = (size_t)tok * MW + cidx;
            o0[r] = *(const unsigned*)(Ob + (size_t)(m * 2) * TOKW + o); o1[r] = *(const unsigned*)(Ob + (size_t)(m * 2 + 1) * TOKW + o);
            const int zc = m == 0 ? C_GZ : m == 1 ? C_HG : m == 2 ? C_LY : C_RG;
            gz[r] = *(const unsigned*)(Pb + (size_t)tok * NP + zc + cidx);
        }
        float a0[16], a1[16], ss[16];
#pragma unroll
        for (int r = 0; r < 16; ++r) { a0[r] = bflo(o0[r]) + bflo(o1[r]); a1[r] = bfhi(o0[r]) + bfhi(o1[r]); ss[r] = a0[r] * a0[r] + a1[r] * a1[r]; }
#pragma unroll
        for (int msk = 32; msk >= 1; msk >>= 1)
#pragma unroll
            for (int r = 0; r < 16; ++r) if ((r >> 2) != 2) ss[r] += shx(ss[r], msk, lane);
#pragma unroll
        for (int r = 0; r < 16; ++r) {
            const int m = r >> 2, head = r & 3, cidx = head * 128 + lane * 2;
            float y0, y1; int nbr;
            if (m == 2) { y0 = a0[r] * gelu_tanhf_(bflo(gz[r])); y1 = a1[r] * gelu_tanhf_(bfhi(gz[r])); nbr = 2; }
            else {
                const float rinv = rsqrtf(ss[r] * (1.0f / 128.0f) + 1e-6f);
                const float2 g = gn[m == 3 ? 2 : m];
                y0 = a0[r] * rinv * g.x * siluf_(bflo(gz[r])); y1 = a1[r] * rinv * g.y * siluf_(bfhi(gz[r])); nbr = m == 3 ? 3 : m;
            }
            *(unsigned*)(Yb + (size_t)nbr * TOKW + (size_t)tok * MW + cidx) = pack2(y0, y1);
        }
    }
}

struct G2Sched {
    const bf16_t* Y; const bf16_t* Wb; int ntiles, G, c;
    static constexpr bool HAS_BIAS = false, gather = false;
    __device__ __forceinline__ bool next(int i, g8::Unit& u) const {
        const int r = i >> 2, tile = (r == 0 && G == 256) ? (c & 7) * 32 + (c >> 3) : r * G + c; if (tile >= ntiles) return false;
        u.pm = tile >> 2; u.pn = tile & 3; u.e = i & 3; return true;
    }
    __device__ __forceinline__ const char* a_base(const g8::Unit& u) const { return (const char*)(Y + (size_t)u.e * TOKW + (size_t)u.pm * 256 * MW); }
    __device__ __forceinline__ const char* b_base(const g8::Unit& u) const { return (const char*)(Wb + (size_t)u.e * D * MW + (size_t)u.pn * 256 * MW); }
    __device__ __forceinline__ const int* row_addr(const g8::Unit&, int) const { return nullptr; }
    __device__ __forceinline__ int rows_valid(const g8::Unit&) const { return 256; }
    __device__ __forceinline__ const float* bias_src(const g8::Unit&, int) const { return nullptr; }
};
struct EpiMix {
    const bf16_t* gate; bf16_t* O;
    __device__ __forceinline__ bool keep(const g8::Unit& u) const { return u.e < 3; }
    __device__ __forceinline__ void operator()(f32x4 (&acc)[2][2][4][2], const g8::Unit& u, int wr, int wc, int fr, int fq, const LAS float*) const {
        const int row0 = u.pm * 256 + wr * 64 + fr, col0 = u.pn * 256 + wc * 32 + 8 * fq;
        const bool lastseg = u.e == 3;
        const bf16_t* gc = gate + ((((size_t)u.pm * 16 + u.e * 4 + u.pn) * 8 + (wr * 4 + wc)) * 16) * 512 + (fq * 16 + fr) * 8;
#pragma unroll
        for (int ah = 0; ah < 2; ++ah) {
            u32x4 c[8];
#pragma unroll
            for (int q = 0; q < 8; ++q) c[q] = *(const u32x4*)(gc + (ah * 8 + q) * 512);
#pragma unroll
            for (int q = 0; q < 8; ++q) {
                const int m = q >> 1, bj = q & 1;
#pragma unroll
                for (int w = 0; w < 4; ++w) { acc[ah][bj][m][w >> 1][(w & 1) * 2] *= bflo(c[q][w]); acc[ah][bj][m][w >> 1][(w & 1) * 2 + 1] *= bfhi(c[q][w]); }
            }
        }
        if (lastseg) {
#pragma unroll
            for (int ai = 0; ai < 2; ++ai)
#pragma unroll
                for (int m = 0; m < 4; ++m)
#pragma unroll
                    for (int bj = 0; bj < 2; ++bj) {
                        u32x4 w; w[0] = pack2(acc[ai][bj][m][0][0], acc[ai][bj][m][0][1]); w[1] = pack2(acc[ai][bj][m][0][2], acc[ai][bj][m][0][3]);
                        w[2] = pack2(acc[ai][bj][m][1][0], acc[ai][bj][m][1][1]); w[3] = pack2(acc[ai][bj][m][1][2], acc[ai][bj][m][1][3]);
                        *(u32x4*)(O + (size_t)(row0 + ai * 128 + m * 16) * D + col0 + bj * 128) = w;
                    }
        }
    }
};
__device__ __forceinline__ void ph_g2(const Params& p, int l, int M, LAS unsigned char* lds) {
    G2Sched S; S.Y = p.Y; S.Wb = p.wbT + (size_t)l * 4 * D * MW; S.ntiles = (M / 256) * 4; S.G = gridDim.x; S.c = blockIdx.x;
    EpiMix E; E.gate = p.gate; E.O = p.mix;
    g8::gemm_phase(lds, MW, S, E);
    if (l == 0 && (int)blockIdx.x >= (NTOK / 256) * 4 - 256) cvt_fill(p, lds, 4, CW_G2, CW_G3 - CW_G2, 0, 0);
}

struct EpiY {
    bf16_t* O;
    __device__ __forceinline__ bool keep(const g8::Unit&) const { return false; }
    __device__ __forceinline__ void operator()(const f32x4 (&acc)[2][2][4][2], const g8::Unit& u, int wr, int wc, int fr, int fq, const LAS float*) const {
        const int row0 = u.pm * 256 + wr * 64 + fr, col0 = u.pn * 256 + wc * 32 + 8 * fq;
#pragma unroll
        for (int ai = 0; ai < 2; ++ai)
#pragma unroll
            for (int m = 0; m < 4; ++m)
#pragma unroll
                for (int bj = 0; bj < 2; ++bj) {
                    u32x4 w; w[0] = pack2(acc[ai][bj][m][0][0], acc[ai][bj][m][0][1]); w[1] = pack2(acc[ai][bj][m][0][2], acc[ai][bj][m][0][3]);
                    w[2] = pack2(acc[ai][bj][m][1][0], acc[ai][bj][m][1][1]); w[3] = pack2(acc[ai][bj][m][1][2], acc[ai][bj][m][1][3]);
                    *(u32x4*)(O + (size_t)(row0 + ai * 128 + m * 16) * D + col0 + bj * 128) = w;
                }
    }
};
__device__ __forceinline__ void ph_g3(const Params& p, int l, int M, LAS unsigned char* lds) {
    g8::PlainSched S; S.init(p.mix, p.woutT + (size_t)l * D * D, M, D, D);
    EpiY E; E.O = p.Y;
    g8::gemm_phase(lds, D, S, E);
    if (l == 0 && (int)blockIdx.x >= (NTOK / 256) * 4 - 256) cvt_fill(p, lds, 5, CW_G3, CW_SEQ0B - CW_G3, 0, 0);
}

template <bool DRY = false> __device__ __forceinline__ void ph_route(const Params& p, int l, int M, LAS unsigned char* lds) {
    int* const r_cnt = DRY ? p.cnt + 64 : p.cnt; int* const r_list = DRY ? (int*)p.act : p.list; int* const r_ts = DRY ? (int*)p.yp : p.tokslot; float* const r_tw = DRY ? (float*)p.yp + (size_t)NTOK * 4 : p.topw;
    LAS float* fs = (LAS float*)lds;
    LAS float* lg = fs + 32 * 1028;
    LAS int* lcnt = (LAS int*)(lg + 32 * 36);
    LAS int* lbase = lcnt + 32;
    const int tid = opaque_tid(), wid = tid >> 6, lane = tid & 63;
    const float* rw = p.router_w + (size_t)l * D * NE;
    for (int it = blockIdx.x; it < M / 32; it += gridDim.x) {
        const int tok0 = it * 32;
        {
            float4 v[4][4]; float ss[4];
            const float* mb0 = p.mod + (size_t)(l * 5 + tok_modrow(tok0)) * (NMOD * D);
            u32x2 yv[4][4]; float4 g1v[4];
#pragma unroll
            for (int i = 0; i < 4; ++i) g1v[i] = *(const float4*)(mb0 + 2 * D + i * 256 + lane * 4);
#pragma unroll
            for (int q = 0; q < 4; ++q) {
                const size_t ro = (size_t)(tok0 + wid * 4 + q) * D;
#pragma unroll
                for (int i = 0; i < 4; ++i) { const u32x2 xr = *(const u32x2*)(p.xl + ro + i * 256 + lane * 4); v[q][i] = make_float4(bflo(xr[0]), bfhi(xr[0]), bflo(xr[1]), bfhi(xr[1])); yv[q][i] = *(const u32x2*)(p.Y + ro + i * 256 + lane * 4); }
            }
#pragma unroll
            for (int q = 0; q < 4; ++q)
#pragma unroll
                for (int i = 0; i < 4; ++i) {
                    v[q][i].x += g1v[i].x * bflo(yv[q][i][0]); v[q][i].y += g1v[i].y * bfhi(yv[q][i][0]); v[q][i].z += g1v[i].z * bflo(yv[q][i][1]); v[q][i].w += g1v[i].w * bfhi(yv[q][i][1]);
                    if (!DRY) { u32x2 o; o[0] = pack2(v[q][i].x, v[q][i].y); o[1] = pack2(v[q][i].z, v[q][i].w); *(u32x2*)(p.xl + (size_t)(tok0 + wid * 4 + q) * D + i * 256 + lane * 4) = o; }
                }
#pragma unroll
            for (int q = 0; q < 4; ++q) {
                float s = 0.f;
#pragma unroll
                for (int i = 0; i < 4; ++i) s += v[q][i].x * v[q][i].x + v[q][i].y * v[q][i].y + v[q][i].z * v[q][i].z + v[q][i].w * v[q][i].w;
                ss[q] = s;
            }
#pragma unroll
            for (int m = 32; m >= 1; m >>= 1)
#pragma unroll
                for (int q = 0; q < 4; ++q) ss[q] += shx(ss[q], m, lane);
            const float* mb = mb0;
#pragma unroll
            for (int i = 0; i < 4; ++i) {
                const int cidx = i * 256 + lane * 4;
                const float4 gv = *(const float4*)(p.norm2_g + l * D + cidx), sv = *(const float4*)(mb + 4 * D + cidx), hv = *(const float4*)(mb + 3 * D + cidx);
#pragma unroll
                for (int q = 0; q < 4; ++q) {
                    const int tl = wid * 4 + q, tok = tok0 + tl;
                    const float rinv = rsqrtf(ss[q] * (1.0f / D) + 1e-6f);
                    const float h0 = v[q][i].x * rinv * gv.x * (1.f + sv.x) + hv.x, h1 = v[q][i].y * rinv * gv.y * (1.f + sv.y) + hv.y;
                    const float h2 = v[q][i].z * rinv * gv.z * (1.f + sv.z) + hv.z, h3 = v[q][i].w * rinv * gv.w * (1.f + sv.w) + hv.w;
                    u32x2 o; o[0] = pack2(h0, h1); o[1] = pack2(h2, h3);
                    *(u32x2*)(p.F + (size_t)tok * D + cidx) = o;
                    *(LAS f32x4*)(fs + tl * 1028 + cidx) = (f32x4){h0, h1, h2, h3};
                }
            }
        }
        __syncthreads();
        {
            typedef float f32x16 __attribute__((ext_vector_type(16)));
            f32x16 acc;
#pragma unroll
            for (int r = 0; r < 16; ++r) acc[r] = 0.f;
            const int tk = lane & 31, hh = lane >> 5;
            const LAS float* ap = fs + tk * 1028 + wid * 128 + 4 * hh;
            const float* bp = rw + (size_t)(wid * 128 + 4 * hh) * NE + tk;
#pragma unroll 4
            for (int kk = 0; kk < 16; ++kk) {
                const f32x4 a4 = *(const LAS f32x4*)(ap + kk * 8);
                const float b0 = bp[(kk * 8 + 0) * NE], b1 = bp[(kk * 8 + 1) * NE], b2 = bp[(kk * 8 + 2) * NE], b3 = bp[(kk * 8 + 3) * NE];
                acc = __builtin_amdgcn_mfma_f32_32x32x2f32(a4[0], b0, acc, 0, 0, 0);
                acc = __builtin_amdgcn_mfma_f32_32x32x2f32(a4[1], b1, acc, 0, 0, 0);
                acc = __builtin_amdgcn_mfma_f32_32x32x2f32(a4[2], b2, acc, 0, 0, 0);
                acc = __builtin_amdgcn_mfma_f32_32x32x2f32(a4[3], b3, acc, 0, 0, 0);
            }
            __syncthreads();
            LAS float* red = fs;
#pragma unroll
            for (int r = 0; r < 16; ++r) red[(wid * 32 + (r & 3) + 8 * (r >> 2) + 4 * hh) * 33 + tk] = acc[r];
            __syncthreads();
            const int t2 = tid >> 4, e0 = (tid & 15) * 2;
            float s0 = p.router_b[l * NE + e0], s1 = p.router_b[l * NE + e0 + 1];
#pragma unroll
            for (int w = 0; w < 8; ++w) { s0 += red[(w * 32 + t2) * 33 + e0]; s1 += red[(w * 32 + t2) * 33 + e0 + 1]; }
            lg[t2 * 36 + e0] = s0; lg[t2 * 36 + e0 + 1] = s1;
            if (tid < 32) lcnt[tid] = 0;
        }
        __syncthreads();
        float vals[4]; int idxs[4], rank[4];
        if (tid < 32) {
            float lv[32];
#pragma unroll
            for (int q = 0; q < 8; ++q) { const f32x4 t = *(const LAS f32x4*)(lg + tid * 36 + q * 4); lv[q * 4] = t[0]; lv[q * 4 + 1] = t[1]; lv[q * 4 + 2] = t[2]; lv[q * 4 + 3] = t[3]; }
#pragma unroll
            for (int k = 0; k < 4; ++k) {
                float best = lv[0]; int bi = 0;
#pragma unroll
                for (int ee = 1; ee < NE; ++ee) { const bool gt = lv[ee] > best; best = gt ? lv[ee] : best; bi = gt ? ee : bi; }
#pragma unroll
                for (int ee = 0; ee < NE; ++ee) lv[ee] = (ee == bi) ? -3.0e38f : lv[ee];
                vals[k] = best; idxs[k] = bi;
                rank[k] = atomicAdd((int*)(lcnt + bi), 1);
            }
        }
        __syncthreads();
        if (tid < 32) { const int c = lcnt[tid]; lbase[tid] = c ? atomicAdd(r_cnt + l * NE + tid, c) : 0; }
        __syncthreads();
        if (tid < 32) {
            const int tok = tok0 + tid;
            const float mx = vals[0];
            float ex[4], sum = 0.f;
#pragma unroll
            for (int k = 0; k < 4; ++k) { ex[k] = __expf(vals[k] - mx); sum += ex[k]; }
            const float inv = 1.0f / sum;
#pragma unroll
            for (int k = 0; k < 4; ++k) {
                const int ee = idxs[k];
                const int slot = lbase[ee] + rank[k];
                r_list[(size_t)ee * NTOK + slot] = tok;
                r_ts[(size_t)tok * 4 + k] = (ee << 16) | slot;
                r_tw[(size_t)tok * 4 + k] = ex[k] * inv;
            }
        }
        __syncthreads();
    }
}

__device__ __forceinline__ void build_expert_tables(const Params& p, int l, LAS int* ts, LAS int* cn, LAS int* te) {
    const int tid = opaque_tid();
    if (tid < 64) {
        const int c = tid < NE ? p.cnt[l * NE + tid] : 0;
        const int nt = (c + 255) >> 8;
        int v = nt;
#pragma unroll
        for (int off = 1; off < 32; off <<= 1) { const int t = shupi(v, off, tid); if (tid >= off) v += t; }
        if (tid < NE) { cn[tid] = c; ts[tid] = v - nt; if (tid == NE - 1) ts[NE] = v; }
        if (te && tid < NE) for (int q = 0; q < nt; ++q) te[v - nt + q] = tid;
    }
    __syncthreads();
}

struct MoeSched {
    const LAS int* ts; const LAS int* cn; const LAS int* te; const int* list; const bf16_t* A; const bf16_t* Bt; const float* bias; int K, npn, nunits, G, c, nrowsB, nbias; bool gather;
    static constexpr bool HAS_BIAS = true;
    __device__ __forceinline__ bool next(int i, g8::Unit& u) const {
        if (G == 256) {
            const int x = c & 7, s = c >> 3, pm = i * (256 / npn) + x * (32 / npn) + s / npn;
            if (pm * npn >= nunits) return false;
            u.pm = pm; u.pn = s % npn; u.e = te[pm]; return true;
        }
        const long L = (long)i * G + c; if (L >= nunits) return false;
        u.pm = (int)(L / npn); u.pn = (int)(L % npn); u.e = te[u.pm]; return true;
    }
    __device__ __forceinline__ const char* a_base(const g8::Unit& u) const { return (const char*)(gather ? A : A + (size_t)u.pm * 256 * K); }
    __device__ __forceinline__ const char* b_base(const g8::Unit& u) const { return (const char*)(Bt + ((size_t)u.e * nrowsB + (size_t)u.pn * 256) * K); }
    __device__ __forceinline__ const int* row_addr(const g8::Unit& u, int R) const {
        const int cnt = cn[u.e], sl = (u.pm - ts[u.e]) * 256 + R;
        return list + (size_t)u.e * NTOK + (sl < cnt ? sl : 0);
    }
    __device__ __forceinline__ int rows_valid(const g8::Unit& u) const { return cn[u.e] - (u.pm - ts[u.e]) * 256; }
    __device__ __forceinline__ const float* bias_src(const g8::Unit& u, int lane) const {
        if (nbias == 2) return bias + (size_t)u.e * 2 * D + (lane < 32 ? u.pn * 128 + lane * 4 : D + u.pn * 128 + (lane - 32) * 4);
        return bias + (size_t)u.e * D + u.pn * 256 + lane * 4;
    }
};
struct EpiAct {
    bf16_t* O;
    __device__ __forceinline__ bool keep(const g8::Unit&) const { return false; }
    __device__ __forceinline__ void operator()(const f32x4 (&acc)[2][2][4][2], const g8::Unit& u, int wr, int wc, int fr, int fq, const LAS float* bias) const {
        const int row0 = u.pm * 256 + wr * 64 + fr, col0 = u.pn * 128 + wc * 32 + 8 * fq;
        const LAS float* bb = bias + wc * 32 + 8 * fq;
        const f32x4 g0 = *(const LAS f32x4*)bb, g1 = *(const LAS f32x4*)(bb + 4), l0 = *(const LAS f32x4*)(bb + 128), l1 = *(const LAS f32x4*)(bb + 132);
        const float bg[8] = {g0[0], g0[1], g0[2], g0[3], g1[0], g1[1], g1[2], g1[3]}, bl[8] = {l0[0], l0[1], l0[2], l0[3], l1[0], l1[1], l1[2], l1[3]};
#pragma unroll
        for (int ai = 0; ai < 2; ++ai)
#pragma unroll
            for (int m = 0; m < 4; ++m) {
                float o[8];
#pragma unroll
                for (int n = 0; n < 2; ++n)
#pragma unroll
                    for (int j = 0; j < 4; ++j) {
                        const float glu = fminf(acc[ai][0][m][n][j] + bg[n * 4 + j], 7.0f);
                        const float lin = fminf(fmaxf(acc[ai][1][m][n][j] + bl[n * 4 + j], -7.0f), 7.0f);
                        o[n * 4 + j] = glu * sigmoidf_(1.702f * glu) * (lin + 1.0f);
                    }
                *(u32x4*)(O + (size_t)(row0 + ai * 128 + m * 16) * D + col0) = pack8(o);
            }
    }
};
__device__ __forceinline__ void ph_g4(const Params& p, int l, LAS unsigned char* lds) {
    LAS int* ts = (LAS int*)(lds + g8::STAGE_BYTES); LAS int* cn = ts + 40; LAS int* te = ts + 80;
    build_expert_tables(p, l, ts, cn, te);
    MoeSched S; S.ts = ts; S.cn = cn; S.te = te; S.list = p.list; S.A = p.F; S.Bt = p.w1T + (size_t)l * NE * 2 * D * D; S.bias = p.moe_b1 + (size_t)l * NE * 2 * D; S.nbias = 2;
    S.K = D; S.npn = 8; S.nunits = ts[NE] * 8; S.G = gridDim.x; S.c = blockIdx.x; S.nrowsB = 2 * D; S.gather = true;
    EpiAct E; E.O = p.act;
    g8::gemm_phase(lds, D, S, E);
}

struct EpiYp {
    bf16_t* O;
    __device__ __forceinline__ bool keep(const g8::Unit&) const { return false; }
    __device__ __forceinline__ void operator()(const f32x4 (&acc)[2][2][4][2], const g8::Unit& u, int wr, int wc, int fr, int fq, const LAS float* bias) const {
        const int row0 = u.pm * 256 + wr * 64 + fr, col0 = u.pn * 256 + wc * 32 + 8 * fq;
#pragma unroll
        for (int bj = 0; bj < 2; ++bj) {
            const LAS float* bb = bias + bj * 128 + wc * 32 + 8 * fq;
            const f32x4 c0v = *(const LAS f32x4*)bb, c1v = *(const LAS f32x4*)(bb + 4);
            const float4 c0 = make_float4(c0v[0], c0v[1], c0v[2], c0v[3]), c1 = make_float4(c1v[0], c1v[1], c1v[2], c1v[3]);
#pragma unroll
            for (int ai = 0; ai < 2; ++ai)
#pragma unroll
                for (int m = 0; m < 4; ++m) {
                    u32x4 w; w[0] = pack2(acc[ai][bj][m][0][0] + c0.x, acc[ai][bj][m][0][1] + c0.y); w[1] = pack2(acc[ai][bj][m][0][2] + c0.z, acc[ai][bj][m][0][3] + c0.w);
                    w[2] = pack2(acc[ai][bj][m][1][0] + c1.x, acc[ai][bj][m][1][1] + c1.y); w[3] = pack2(acc[ai][bj][m][1][2] + c1.z, acc[ai][bj][m][1][3] + c1.w);
                    *(u32x4*)(O + (size_t)(row0 + ai * 128 + m * 16) * D + col0 + bj * 128) = w;
                }
        }
    }
};
__device__ __forceinline__ void ph_g5(const Params& p, int l, LAS unsigned char* lds) {
    LAS int* ts = (LAS int*)(lds + g8::STAGE_BYTES); LAS int* cn = ts + 40; LAS int* te = ts + 80;
    build_expert_tables(p, l, ts, cn, te);
    MoeSched S; S.ts = ts; S.cn = cn; S.te = te; S.list = p.list; S.A = p.act; S.Bt = p.w2T + (size_t)l * NE * D * D; S.bias = p.moe_b2 + (size_t)l * NE * D; S.nbias = 1;
    S.K = D; S.npn = 4; S.nunits = ts[NE] * 4; S.G = gridDim.x; S.c = blockIdx.x; S.nrowsB = D; S.gather = false;
    EpiYp E; E.O = p.yp;
    g8::gemm_phase(lds, D, S, E);
}

template <bool DRY = false> __device__ __forceinline__ void ph_combine(const Params& p, int l, int M, LAS unsigned char* lds) {
    bf16_t* const c_xl = DRY ? (bf16_t*)p.prep : p.xl; bf16_t* const c_H = DRY ? (bf16_t*)(p.prep + (size_t)NTOK * D) : p.H; float* const c_out = DRY ? p.prep : p.out;
    LAS int* ts = (LAS int*)lds; LAS int* cn = ts + 40;
    build_expert_tables(p, l, ts, cn, nullptr);
    const int tid = opaque_tid(), wid = tid >> 6, lane = tid & 63;
    const bool last = (l == 1);
    const int tstep = gridDim.x * NWAVES;
    int tok = blockIdx.x * NWAVES + wid;
    int4 nts = make_int4(0, 0, 0, 0); float4 ntw = make_float4(0.f, 0.f, 0.f, 0.f);
    if (tok < M) { nts = *(const int4*)(p.tokslot + (size_t)tok * 4); ntw = *(const float4*)(p.topw + (size_t)tok * 4); }
    for (; tok < M; tok += tstep) {
        float4 v[4];
        const float* mb = p.mod + (size_t)(l * 5 + tok_modrow(tok)) * (NMOD * D);
        const int tsl[4] = {nts.x, nts.y, nts.z, nts.w}; const float wts[4] = {ntw.x, ntw.y, ntw.z, ntw.w};
        int rows[4];
#pragma unroll
        for (int k = 0; k < 4; ++k) rows[k] = ts[tsl[k] >> 16] * 256 + (tsl[k] & 0xffff);
        if (tok + tstep < M) { nts = *(const int4*)(p.tokslot + (size_t)(tok + tstep) * 4); ntw = *(const float4*)(p.topw + (size_t)(tok + tstep) * 4); }
        u32x2 yv[4][4], xin[4]; float4 gtv[4];
#pragma unroll
        for (int i = 0; i < 4; ++i) {
            const int cidx = i * 256 + lane * 4;
#pragma unroll
            for (int k = 0; k < 4; ++k) yv[i][k] = *(const u32x2*)(p.yp + (size_t)rows[k] * D + cidx);
            xin[i] = *(const u32x2*)(p.xl + (size_t)tok * D + cidx);
            gtv[i] = *(const float4*)(mb + 5 * D + cidx);
        }
        float ss = 0.f;
#pragma unroll
        for (int i = 0; i < 4; ++i) {
            float m0 = 0.f, m1 = 0.f, m2 = 0.f, m3 = 0.f;
#pragma unroll
            for (int k = 0; k < 4; ++k) { m0 += wts[k] * bflo(yv[i][k][0]); m1 += wts[k] * bfhi(yv[i][k][0]); m2 += wts[k] * bflo(yv[i][k][1]); m3 += wts[k] * bfhi(yv[i][k][1]); }
            float4 xv = make_float4(bflo(xin[i][0]), bfhi(xin[i][0]), bflo(xin[i][1]), bfhi(xin[i][1]));
            xv.x += gtv[i].x * m0; xv.y += gtv[i].y * m1; xv.z += gtv[i].z * m2; xv.w += gtv[i].w * m3;
            v[i] = xv; ss += xv.x * xv.x + xv.y * xv.y + xv.z * xv.z + xv.w * xv.w;
        }
        ss = wave_sum(ss, lane);
        const float rinv = rsqrtf(ss * (1.0f / D) + 1e-6f);
        if (!last) {
#pragma unroll
            for (int i = 0; i < 4; ++i) { u32x2 o; o[0] = pack2(v[i].x, v[i].y); o[1] = pack2(v[i].z, v[i].w); *(u32x2*)(c_xl + (size_t)tok * D + i * 256 + lane * 4) = o; }
            const float* mb1 = p.mod + (size_t)((l + 1) * 5 + tok_modrow(tok)) * (NMOD * D);
            norm_mod_store(v, rinv, p.norm1_g + (l + 1) * D, mb1 + 1 * D, mb1 + 0 * D, c_H + (size_t)tok * D, lane);
        } else {
#pragma unroll
            for (int i = 0; i < 4; ++i) {
                const int cidx = i * 256 + lane * 4;
                const float4 gv = *(const float4*)(p.final_norm_g + cidx);
                *(float4*)(c_out + (size_t)tok * D + cidx) = make_float4(v[i].x * rinv * gv.x, v[i].y * rinv * gv.y, v[i].z * rinv * gv.z, v[i].w * rinv * gv.w);
            }
        }
    }
}

#define XB_TMO      128
#define XB_XCNT(j)  (256  + 64 * (j))
#define XB_XSUB(j)  (1280 + 64 * (j))
#define XB_XGEN(j)  (2304 + 64 * (j))
#define XB_TOP      3328
#define XB_TOPGEN   3392
#define XCD_BAR_WORDS 3456
#define XB_SPIN_CAP (1u << 18)

__device__ __forceinline__ unsigned xb_ld(unsigned* p)              { return __hip_atomic_load(p, __ATOMIC_RELAXED, __HIP_MEMORY_SCOPE_AGENT); }
__device__ __forceinline__ unsigned xb_add(unsigned* p, unsigned v) { return __hip_atomic_fetch_add(p, v, __ATOMIC_RELAXED, __HIP_MEMORY_SCOPE_AGENT); }
__device__ __forceinline__ unsigned xb_xcc_id() { return (unsigned)__builtin_amdgcn_s_getreg((3 << 11) | 20) & 0xFu; }
#define XB_SPIN(cond, bar) do { unsigned _sp = 0; while (cond) { __builtin_amdgcn_s_sleep(1); \
    if ((++_sp & 255u) == 0u) { if (xb_ld(&(bar)[XB_TMO])) break; if (_sp > XB_SPIN_CAP) { atomicAdd(&(bar)[XB_TMO], 1u); break; } } } } while (0)

struct XcdBarrier {
    unsigned* bar; unsigned x;
    volatile LAS unsigned* st;
};

__device__ __forceinline__ XcdBarrier xcd_barrier_post(unsigned* bar, volatile LAS unsigned* st) {
    XcdBarrier b; b.bar = bar; b.x = xb_xcc_id(); b.st = st;
    if (threadIdx.x == 0) (void)xb_add(&bar[XB_XCNT(b.x)], 1u);
    return b;
}
__device__ __forceinline__ void xcd_barrier_complete(unsigned* bar, unsigned x, unsigned& nloc, unsigned& nx) {
    const unsigned G = gridDim.x * gridDim.y * gridDim.z;
    unsigned sum, cnt, mine, sp = 0u;
    for (;;) {
        sum = 0u; cnt = 0u; mine = 0u;
#pragma unroll
        for (unsigned j = 0; j < 16; ++j) { const unsigned c = xb_ld(&bar[XB_XCNT(j)]); sum += c; cnt += (c > 0u) ? 1u : 0u; mine = (j == x) ? c : mine; }
        if (sum == G) break;
        __builtin_amdgcn_s_sleep(1);
        if ((++sp & 255u) == 0u) { if (xb_ld(&bar[XB_TMO])) break; if (sp > XB_SPIN_CAP) { atomicAdd(&bar[XB_TMO], 1u); break; } }
    }
    nloc = mine > 0u ? mine : 1u; nx = cnt > 0u ? cnt : 1u;
}

__device__ __forceinline__ void xcd_barrier(const XcdBarrier& b) {
    asm volatile("s_waitcnt vmcnt(0)" ::: "memory");
    __syncthreads();
    if (threadIdx.x == 0) {
        unsigned* bar = b.bar;
        __builtin_amdgcn_s_waitcnt(0);
        unsigned nloc = b.st[0], nx = b.st[1];
        if (nloc == 0u) { xcd_barrier_complete(bar, b.x, nloc, nx); b.st[0] = nloc; b.st[1] = nx; }
        const unsigned old = xb_add(&bar[XB_XSUB(b.x)], 1u);
        const unsigned gen = old / nloc;
        if (old + 1u == (gen + 1u) * nloc) {
            __builtin_amdgcn_fence(__ATOMIC_RELEASE, "agent");
            asm volatile("s_waitcnt vmcnt(0)" ::: "memory");
            const unsigned og = xb_add(&bar[XB_TOP], 1u);
            const unsigned tg = og / nx;
            if (og + 1u == (tg + 1u) * nx) xb_add(&bar[XB_TOPGEN], 1u);
            else XB_SPIN(xb_ld(&bar[XB_TOPGEN]) == tg, bar);
            __builtin_amdgcn_fence(__ATOMIC_ACQUIRE, "agent");
            xb_add(&bar[XB_XGEN(b.x)], 1u);
            asm volatile("s_waitcnt vmcnt(0)" ::: "memory");
        } else {
            XB_SPIN(xb_ld(&bar[XB_XGEN(b.x)]) == gen, bar);
            __builtin_amdgcn_fence(__ATOMIC_ACQUIRE, "agent");
            asm volatile("s_waitcnt vmcnt(0)" ::: "memory");
        }
    }
    __syncthreads();
}


extern __shared__ __attribute__((aligned(16))) unsigned char dyn_lds[];

typedef const __attribute__((address_space(4))) unsigned char* KArgPtr;
__device__ __forceinline__ Params load_params(KArgPtr kp) {
    asm volatile("" : "+s"(kp));
    Params q;
    const __attribute__((address_space(4))) unsigned long long* k8 = (const __attribute__((address_space(4))) unsigned long long*)kp;
    unsigned long long* d8 = (unsigned long long*)&q;
#pragma unroll
    for (int i = 0; i < (int)(sizeof(Params) / 8); ++i) { const unsigned long long w = k8[i]; d8[i] = (unsigned long long)(char*)(__attribute__((address_space(1))) char*)w; }
    return q;
}
__global__ void __launch_bounds__(NTHREADS, 2) k_mega(Params p_unused) {
    (void)p_unused;
    const KArgPtr kp = (KArgPtr)__builtin_amdgcn_kernarg_segment_ptr();
    LAS unsigned char* lds = (LAS unsigned char*)dyn_lds;
    volatile LAS unsigned* xb_words = (volatile LAS unsigned*)(lds + LDS_BYTES - 16);
    if (threadIdx.x == 0) { xb_words[0] = 0u; xb_words[1] = 0u; xb_words[2] = 0u; xb_words[3] = 0u; }
    __syncthreads();
    { const Params p = load_params(kp); (void)xcd_barrier_post(p.bar, xb_words); }
#define GRID_BARRIER() do { XcdBarrier b_; b_.bar = load_params(kp).bar; b_.x = xb_xcc_id(); b_.st = xb_words; xcd_barrier(b_); } while (0)
#define PH(stmt) do { const Params p = load_params(kp); stmt; } while (0)
    PH(ph_convert(p, lds));
    PH(ph_mod(p, lds));
    GRID_BARRIER();
    PH(ph_norm1_first(p));
    GRID_BARRIER();
    for (int l = 0; l < 2; ++l) {
        const int M = l == 0 ? NTOK : NLAT;
        { unsigned lb_ = (unsigned)(size_t)lds; asm volatile("" : "+s"(lb_)); lds = (LAS unsigned char*)(size_t)lb_; }
        PH(ph_g1(p, l, lds));
        GRID_BARRIER();
        PH(ph_prep(p, l, lds));
        PH(ph_local(p, l, lds));
        GRID_BARRIER();
        PH(ph_seq(p, l, lds));
        GRID_BARRIER();
        PH(ph_merge(p, l, M));
        GRID_BARRIER();
        PH(ph_g2(p, l, M, lds));
        GRID_BARRIER();
        PH(ph_g3(p, l, M, lds));
        GRID_BARRIER();
        PH(ph_route(p, l, M, lds));
        GRID_BARRIER();
        PH(ph_g4(p, l, lds));
        GRID_BARRIER();
        PH(ph_g5(p, l, lds));
        GRID_BARRIER();
        PH(ph_combine(p, l, M, lds));
        if (l == 0) GRID_BARRIER();
    }
}

static inline size_t align_up(size_t v, size_t a) { return (v + a - 1) / a * a; }

extern "C" void kernel_launch(void* const* d_in, const int* in_sizes, int n_in, void* d_out, int out_size, void* d_ws, size_t ws_size, hipStream_t stream) {
    (void)in_sizes; (void)n_in; (void)out_size;
    Params p{};
    const float** pf = (const float**)&p;
    for (int i = 0; i < 32; ++i) pf[i] = (const float*)d_in[i];
    p.out = (float*)d_out;
    unsigned char* w = (unsigned char*)d_ws; size_t off = 0;
    auto take = [&](size_t bytes) { void* r = w + off; off = align_up(off + bytes, 256); return r; };
    p.bar = (unsigned*)take(16384);
    p.cnt = (int*)take(4096);
    const size_t ctl_bytes = off;
    p.mod = (float*)take((size_t)2 * 5 * NMOD * D * 4);
    p.winT = (bf16_t*)take((size_t)2 * NPW * D * 2);
    p.wbT = (bf16_t*)take((size_t)2 * 4 * D * MW * 2);
    p.woutT = (bf16_t*)take((size_t)2 * D * D * 2);
    p.w1T = (bf16_t*)take((size_t)2 * NE * 2 * D * D * 2);
    p.w2T = (bf16_t*)take((size_t)2 * NE * D * D * 2);
    p.xl = (bf16_t*)take((size_t)NTOK * D * 2);
    p.H = (bf16_t*)take((size_t)NTOK * D * 2);
    p.P = (bf16_t*)take((size_t)NTOK * NP * 2);
    p.gate = (bf16_t*)take((size_t)NTOK * 4096 * 2);
    p.act = p.P; p.yp = p.P + (size_t)CAPROWS * D;
    p.prep = (float*)take(NPREP * TOKW * 4);
    p.O = (bf16_t*)take(8 * TOKW * 2);
    p.lq = (bf16_t*)take((size_t)3 * NITEM * 64 * 128 * 2);
    p.lo = (bf16_t*)take((size_t)3 * NITEM * 64 * 128 * 2);
    p.lb = (bf16_t*)take((size_t)3 * NITEM * 128 * 128 * 2);
    p.la = (bf16_t*)take((size_t)NITEM * 128 * 128 * 2);
    p.ld = (float*)take((size_t)3 * NITEM * 128 * 4);
    p.lruT = (bf16_t*)take((size_t)2 * 8 * 4 * 4096 * 2);
    p.lsig = (float*)take((size_t)2 * 2 * MW * 4);
    p.rope = (float2*)take((size_t)TL * 64 * 8);
    p.Y = (bf16_t*)take(4 * TOKW * 2);
    p.mix = (bf16_t*)take((size_t)NTOK * D * 2);
    p.F = p.H;
    p.list = (int*)take((size_t)NE * NTOK * 4);
    p.tokslot = (int*)take((size_t)NTOK * 4 * 4);
    p.topw = (float*)take((size_t)NTOK * 4 * 4);
    if (off > ws_size) { fprintf(stderr, "workspace too small: need %zu have %zu\n", off, ws_size); return; }

    static int grid = 0;
    if (!grid) {
        int dev = 0, cus = 0, occ = 0; (void)hipGetDevice(&dev); (void)hipDeviceGetAttribute(&cus, hipDeviceAttributeMultiprocessorCount, dev);
        (void)hipFuncSetAttribute((const void*)k_mega, hipFuncAttributeMaxDynamicSharedMemorySize, LDS_BYTES);
        (void)hipOccupancyMaxActiveBlocksPerMultiprocessor(&occ, (const void*)k_mega, NTHREADS, LDS_BYTES);
        if (cus <= 0) cus = 256;
        grid = cus * (occ < 1 ? 1 : 1);
        if (occ < 1) fprintf(stderr, "occupancy query says %d blocks per CU\n", occ);
    }
    (void)hipMemsetAsync(d_ws, 0, ctl_bytes, stream);
    hipLaunchKernelGGL(k_mega, dim3(grid), dim3(NTHREADS), LDS_BYTES, stream, p);
}
```
